# Optimizing an MI355X kernel written in HIP

```python
import math
import jax
import jax.numpy as jnp
from jax import lax
import numpy as np

D_MODEL = 1024
BATCH = 2
SEQ = 8192
DEPTH = 2

D_MIX = D_MODEL
RMS_EPS = 1e-6

GLA_HEADS = 4
GLA_WIDTH = D_MIX // 2
GLA_DV = GLA_WIDTH // GLA_HEADS
GLA_DK = GLA_DV // 2
GLA_KDIM = GLA_HEADS * GLA_DK
GLA_GATE_RANK = 16
GLA_GATE_NORM = 16.0
GLA_CHUNK = 64

GMLP_HEADS = 4
GMLP_WIDTH = D_MIX // 4
GMLP_DH = GMLP_WIDTH // GMLP_HEADS
GMLP_CHUNK = 128

CONV_GROUPS = 4
CONV_WIDTH = D_MIX // 4
CONV_K = 3

PROJ_SIZES = (GLA_KDIM, GLA_KDIM, GLA_WIDTH, GLA_WIDTH, GLA_GATE_RANK,
              GMLP_WIDTH, GMLP_WIDTH,
              CONV_WIDTH, CONV_WIDTH, CONV_WIDTH)
D_IN = sum(PROJ_SIZES)

N_GROUPS = 4
EXPERTS_PER_GROUP = 8
N_EXPERTS = N_GROUPS * EXPERTS_PER_GROUP
TOP_K = 2
D_EXPERT = D_MODEL // 4
MOE_BLOCK = 128

kernel_name = "hymba_gla_gmlp_shortconv_hiermoe"


def rms_norm(x, gain):
    x32 = x.astype(jnp.float32)
    y = x32 * lax.rsqrt(jnp.mean(x32 * x32, axis=-1, keepdims=True) + RMS_EPS)
    return (y * gain.astype(jnp.float32)).astype(x.dtype)


def gla_mixer(q, k, v, g_out, gk_low, w_gk_up, b_gk, gla_norm):
    B, S, _ = q.shape
    N = S // GLA_CHUNK
    f32 = jnp.float32
    gk = jax.nn.log_sigmoid((gk_low @ w_gk_up + b_gk).astype(f32)) / GLA_GATE_NORM

    def to_chunks(t, d):
        return t.reshape(B, N, GLA_CHUNK, GLA_HEADS, d).transpose(0, 3, 1, 2, 4).astype(f32)

    qc = to_chunks(q, GLA_DK) * (GLA_DK ** -0.5)
    kc = to_chunks(k, GLA_DK)
    vc = to_chunks(v, GLA_DV)
    gc = to_chunks(gk, GLA_DK)
    b = jnp.cumsum(gc, axis=3)
    b_last = b[:, :, :, -1:, :]
    q_dec = qc * jnp.exp(b)
    k_inv = kc * jnp.exp(-b)
    k_dec = kc * jnp.exp(b_last - b)
    mask = jnp.tril(jnp.ones((GLA_CHUNK, GLA_CHUNK), dtype=bool))
    scores = jnp.where(mask, jnp.einsum('bhncd,bhnsd->bhncs', q_dec, k_inv), 0.0)
    o_intra = jnp.einsum('bhncs,bhnsv->bhncv', scores, vc)
    kv = jnp.einsum('bhncd,bhncv->nbhdv', k_dec, vc)
    decay = jnp.exp(b_last[:, :, :, 0, :]).transpose(2, 0, 1, 3)

    def step(state, inp):
        kv_n, d_n = inp
        return d_n[..., None] * state + kv_n, state

    s0 = jnp.zeros((B, GLA_HEADS, GLA_DK, GLA_DV), f32)
    _, s_prev = lax.scan(step, s0, (kv, decay))
    o_inter = jnp.einsum('bhncd,nbhdv->bhncv', q_dec, s_prev)
    o = (o_intra + o_inter).transpose(0, 2, 3, 1, 4).reshape(B, S, GLA_HEADS, GLA_DV)
    o = o * lax.rsqrt(jnp.mean(o * o, axis=-1, keepdims=True) + RMS_EPS) * gla_norm.astype(f32)
    gate = jax.nn.silu(g_out.astype(f32)).reshape(B, S, GLA_HEADS, GLA_DV)
    return (o * gate).reshape(B, S, GLA_WIDTH).astype(q.dtype)


def gmlp_mixer(u_raw, v_raw, gmlp_norm, w_spatial, b_spatial):
    B, S, _ = u_raw.shape
    N = S // GMLP_CHUNK
    shp = (B, N, GMLP_CHUNK, GMLP_HEADS, GMLP_DH)
    u = jax.nn.gelu(u_raw).reshape(shp)
    v32 = jax.nn.gelu(v_raw).reshape(shp).astype(jnp.float32)
    v32 = v32 * lax.rsqrt(jnp.mean(v32 * v32, axis=-1, keepdims=True) + RMS_EPS)
    v32 = v32 * gmlp_norm.reshape(GMLP_HEADS, GMLP_DH).astype(jnp.float32)
    mask = jnp.tril(jnp.ones((GMLP_CHUNK, GMLP_CHUNK), dtype=bool))
    w = jnp.where(mask[None], w_spatial, 0.0).astype(jnp.float32)
    mixed = jnp.einsum('hts,bnshd->bnthd', w, v32) + b_spatial.T.astype(jnp.float32)[:, :, None]
    return (u * mixed.astype(u.dtype)).reshape(B, S, GMLP_WIDTH)


def conv_mixer(x_in, b_gate, c_gate, w_conv):
    h = c_gate * x_in
    y = lax.conv_general_dilated(
        h, w_conv[:, None, :].astype(h.dtype), window_strides=(1,),
        padding=((CONV_K - 1, 0),), dimension_numbers=('NWC', 'WIO', 'NWC'),
        feature_group_count=CONV_WIDTH)
    return b_gate * y


def hier_moe(x2d, w_rg, b_rg, w_re, b_re, w_gate, w_up, w_down):
    T, D = x2d.shape
    f32 = jnp.float32
    g_logits = (x2d @ w_rg).astype(f32) + b_rg.astype(f32)
    g_prob = jax.nn.softmax(g_logits, axis=-1)
    g_top = jnp.argmax(g_logits, axis=-1)
    g_w = jnp.take_along_axis(g_prob, g_top[:, None], axis=-1)[:, 0]
    e_logits = ((x2d @ w_re).astype(f32) + b_re.astype(f32)).reshape(T, N_GROUPS, EXPERTS_PER_GROUP)
    e_in = jnp.take_along_axis(e_logits, g_top[:, None, None], axis=1)[:, 0]
    e_prob = jax.nn.softmax(e_in, axis=-1)
    top_p, top_i = lax.top_k(e_prob, TOP_K)
    weights = top_p / jnp.sum(top_p, axis=-1, keepdims=True) * g_w[:, None]
    expert_ids = g_top[:, None] * EXPERTS_PER_GROUP + top_i

    A = T * TOP_K
    e_flat = expert_ids.reshape(-1).astype(jnp.int32)
    t_flat = jnp.repeat(jnp.arange(T, dtype=jnp.int32), TOP_K)
    w_flat = weights.reshape(-1)
    order = jnp.argsort(e_flat)
    e_s, t_s, w_s = e_flat[order], t_flat[order], w_flat[order]
    counts = jnp.bincount(e_flat, length=N_EXPERTS)
    starts = jnp.cumsum(counts) - counts
    padded = (counts + MOE_BLOCK - 1) // MOE_BLOCK * MOE_BLOCK
    pend = jnp.cumsum(padded)
    pstarts = pend - padded
    dest = pstarts[e_s] + (jnp.arange(A, dtype=jnp.int32) - starts[e_s])
    P = ((A + MOE_BLOCK - 1) // MOE_BLOCK) * MOE_BLOCK + N_EXPERTS * MOE_BLOCK
    NB = P // MOE_BLOCK
    slot_tok = jnp.full((P,), T, dtype=jnp.int32).at[dest].set(t_s)
    slot_w = jnp.zeros((P,), f32).at[dest].set(w_s)
    block_start = jnp.arange(NB, dtype=jnp.int32) * MOE_BLOCK
    block_exp = jnp.minimum(jnp.sum(block_start[:, None] >= pend[None, :], axis=1), N_EXPERTS - 1)
    x_pad = jnp.concatenate([x2d, jnp.zeros((1, D), x2d.dtype)], axis=0)
    xb = x_pad[slot_tok].reshape(NB, MOE_BLOCK, D)

    def expert_block(args):
        xblk, e = args
        h = jax.nn.silu(xblk @ w_gate[e]) * (xblk @ w_up[e])
        return h @ w_down[e]

    yb = lax.map(expert_block, (xb, block_exp)).reshape(P, D)
    y = jax.ops.segment_sum(yb * slot_w[:, None].astype(yb.dtype), slot_tok, num_segments=T + 1)
    return y[:T]


def setup_inputs(seed: int = 0) -> dict:
    key = jax.random.key(seed)
    ks = jax.random.split(key, 24)
    L, D = DEPTH, D_MODEL

    def nrm(k, shape, scale):
        return jax.random.normal(k, shape, dtype=jnp.float32) * scale

    return {
        'x': nrm(ks[0], (BATCH, SEQ, D), 1.0),
        'attn_norm': 1.0 + nrm(ks[1], (L, D), 0.02),
        'w_in': nrm(ks[2], (L, D, D_IN), D ** -0.5),
        'w_gk_up': nrm(ks[3], (L, GLA_GATE_RANK, GLA_KDIM), GLA_GATE_RANK ** -0.5),
        'b_gk': nrm(ks[4], (L, GLA_KDIM), 0.1),
        'gla_norm': 1.0 + nrm(ks[5], (L, GLA_DV), 0.02),
        'gmlp_norm': 1.0 + nrm(ks[6], (L, GMLP_WIDTH), 0.02),
        'w_spatial': nrm(ks[7], (L, GMLP_HEADS, GMLP_CHUNK, GMLP_CHUNK), GMLP_CHUNK ** -0.5),
        'b_spatial': 1.0 + nrm(ks[8], (L, GMLP_HEADS, GMLP_CHUNK), 0.02),
        'w_conv': nrm(ks[9], (L, CONV_K, CONV_WIDTH), CONV_K ** -0.5),
        'w_out': nrm(ks[10], (L, D_MIX, D), D_MIX ** -0.5),
        'ffn_norm': 1.0 + nrm(ks[11], (L, D), 0.02),
        'w_router_group': nrm(ks[12], (L, D, N_GROUPS), D ** -0.5),
        'b_router_group': nrm(ks[13], (L, N_GROUPS), 0.01),
        'w_router_expert': nrm(ks[14], (L, D, N_EXPERTS), D ** -0.5),
        'b_router_expert': nrm(ks[15], (L, N_EXPERTS), 0.01),
        'w_gate': nrm(ks[16], (L, N_EXPERTS, D, D_EXPERT), D ** -0.5),
        'w_up': nrm(ks[17], (L, N_EXPERTS, D, D_EXPERT), D ** -0.5),
        'w_down': nrm(ks[18], (L, N_EXPERTS, D_EXPERT, D), D_EXPERT ** -0.5),
        'final_norm': 1.0 + nrm(ks[19], (D,), 0.02),
    }


def reference(x, attn_norm, w_in, w_gk_up, b_gk, gla_norm, gmlp_norm, w_spatial, b_spatial,
              w_conv, w_out, ffn_norm, w_router_group, b_router_group, w_router_expert,
              b_router_expert, w_gate, w_up, w_down, final_norm):
    B, S, D = x.shape
    split_points = []
    acc = 0
    for s in PROJ_SIZES[:-1]:
        acc += s
        split_points.append(acc)
    for l in range(DEPTH):
        h = rms_norm(x, attn_norm[l])
        proj = h @ w_in[l]
        q, k, v, g_out, gk_low, u, vg, x_in, b_gate, c_gate = jnp.split(proj, split_points, axis=-1)
        o_gla = gla_mixer(q, k, v, g_out, gk_low, w_gk_up[l], b_gk[l], gla_norm[l])
        o_gmlp = gmlp_mixer(u, vg, gmlp_norm[l], w_spatial[l], b_spatial[l])
        o_conv = conv_mixer(x_in, b_gate, c_gate, w_conv[l])
        mixed = jnp.concatenate([o_gla, o_gmlp, o_conv], axis=-1)
        x = x + mixed @ w_out[l]
        h = rms_norm(x, ffn_norm[l]).reshape(B * S, D)
        y = hier_moe(h, w_router_group[l], b_router_group[l], w_router_expert[l], b_router_expert[l],
                     w_gate[l], w_up[l], w_down[l])
        x = x + y.reshape(B, S, D)
    return rms_norm(x, final_norm)
```

```cpp
#include <hip/hip_runtime.h>
#include <hip/hip_cooperative_groups.h>
#include <cstdio>
#include <cstdint>
namespace cg = cooperative_groups;

constexpr int D = 1024, NB = 2, S = 8192, T = NB * S, DEPTH = 2;
constexpr int DIN = 2832;
constexpr int C_Q = 0, C_K = 256, C_V = 512, C_G = 1024, C_GK = 1536, C_U = 1552, C_VG = 1808, C_XI = 2064, C_BG = 2320, C_CG = 2576;
constexpr int GH = 4, GDK = 64, GDV = 128, GC = 64, GN = S / GC;
constexpr int MH = 4, MDH = 64, MC = 128, MN = S / MC;
constexpr int NE = 32, EPG = 8, NG = 4, DE = 256;
constexpr float EPS = 1e-6f;
constexpr int NTHR = 256;

struct Params {
    const float* in[20];
    float* out;
    float* A;
    float* P;
    float* Sst;
    float* decay;
    int* cnt;
    int* cursor;
    int* eid;
    float* ew;
    int* slot_tok;
    int* slot_of;
};

__device__ __forceinline__ float gelu_tanh(float x) {
    const float u = 0.7978845608028654f * (x + 0.044715f * x * x * x);
    return 0.5f * x * (1.0f + tanhf(u));
}
__device__ __forceinline__ float silu(float x) { return x / (1.0f + expf(-x)); }
__device__ __forceinline__ float log_sigmoid(float x) { return fminf(x, 0.f) - log1pf(expf(-fabsf(x))); }

__device__ void phase_rmsnorm(const float* x, const float* gain, float* y, int vb, int nvb) {
    const int lane = threadIdx.x & 63, w = threadIdx.x >> 6;
    for (int r = vb * 4 + w; r < T; r += nvb * 4) {
        const float4* xr = (const float4*)(x + (size_t)r * D);
        float4 v[4]; float s = 0.f;
#pragma unroll
        for (int j = 0; j < 4; ++j) { v[j] = xr[lane + 64 * j]; s += v[j].x * v[j].x + v[j].y * v[j].y + v[j].z * v[j].z + v[j].w * v[j].w; }
#pragma unroll
        for (int o = 1; o < 64; o <<= 1) s += __shfl_xor(s, o);
        const float rs = rsqrtf(s * (1.0f / D) + EPS);
        float4* yr = (float4*)(y + (size_t)r * D);
#pragma unroll
        for (int j = 0; j < 4; ++j) { const float4 g = ((const float4*)gain)[lane + 64 * j]; float4 o4; o4.x = v[j].x * rs * g.x; o4.y = v[j].y * rs * g.y; o4.z = v[j].z * rs * g.z; o4.w = v[j].w * rs * g.w; yr[lane + 64 * j] = o4; }
    }
}

template <bool DUAL>
__device__ __forceinline__ void gemm_core(const float* A, const int* rowoff, int K, const float* B0, const float* B1, int ldb, int n0, int N,
                                          float (&acc0)[4][4], float (&acc1)[4][4], float* As, float* Bs0, float* Bs1) {
    const int tid = threadIdx.x, tx = tid & 15, ty = tid >> 4;
    const int ar = tid >> 2, ak = (tid & 3) * 4;
    const int bk = tid >> 4, bn = (tid & 15) * 4;
    const long aoff = rowoff[ar];
    const bool bok = (n0 + bn) < N;
#pragma unroll
    for (int i = 0; i < 4; ++i)
#pragma unroll
        for (int j = 0; j < 4; ++j) { acc0[i][j] = 0.f; acc1[i][j] = 0.f; }
    for (int k0 = 0; k0 < K; k0 += 16) {
        float4 av = make_float4(0.f, 0.f, 0.f, 0.f);
        if (aoff >= 0) av = *(const float4*)(A + aoff + k0 + ak);
        float4 bv0 = make_float4(0.f, 0.f, 0.f, 0.f), bv1 = bv0;
        if (bok) { bv0 = *(const float4*)(B0 + (size_t)(k0 + bk) * ldb + n0 + bn); if (DUAL) bv1 = *(const float4*)(B1 + (size_t)(k0 + bk) * ldb + n0 + bn); }
        __syncthreads();
        As[(ak + 0) * 68 + ar] = av.x; As[(ak + 1) * 68 + ar] = av.y; As[(ak + 2) * 68 + ar] = av.z; As[(ak + 3) * 68 + ar] = av.w;
        *(float4*)(Bs0 + bk * 64 + bn) = bv0;
        if (DUAL) *(float4*)(Bs1 + bk * 64 + bn) = bv1;
        __syncthreads();
#pragma unroll
        for (int kk = 0; kk < 16; ++kk) {
            const float4 a4 = *(const float4*)(As + kk * 68 + ty * 4);
            const float4 b4 = *(const float4*)(Bs0 + kk * 64 + tx * 4);
            const float a[4] = {a4.x, a4.y, a4.z, a4.w}, b[4] = {b4.x, b4.y, b4.z, b4.w};
#pragma unroll
            for (int i = 0; i < 4; ++i)
#pragma unroll
                for (int j = 0; j < 4; ++j) acc0[i][j] += a[i] * b[j];
            if (DUAL) {
                const float4 c4 = *(const float4*)(Bs1 + kk * 64 + tx * 4);
                const float c[4] = {c4.x, c4.y, c4.z, c4.w};
#pragma unroll
                for (int i = 0; i < 4; ++i)
#pragma unroll
                    for (int j = 0; j < 4; ++j) acc1[i][j] += a[i] * c[j];
            }
        }
    }
}

__device__ void phase_gemm(const float* A, int lda, const float* B, int N, int K, float* C, const float* resid, int M, float* smem, int vb, int nvb) {
    float* As = smem; float* Bs0 = smem + 16 * 68; int* rowoff = (int*)(smem + 16 * 68 + 16 * 64 * 2);
    const int ntn = (N + 63) / 64, ntm = M / 64, nt = ntn * ntm;
    const int tid = threadIdx.x, tx = tid & 15, ty = tid >> 4;
    for (int t = vb; t < nt; t += nvb) {
        const int tm = t / ntn, tn = t % ntn, m0 = tm * 64, n0 = tn * 64;
        __syncthreads();
        if (tid < 64) rowoff[tid] = (m0 + tid) * lda;
        __syncthreads();
        float acc0[4][4], acc1[4][4];
        gemm_core<false>(A, rowoff, K, B, nullptr, N, n0, N, acc0, acc1, As, Bs0, nullptr);
        const int nn = n0 + tx * 4;
        if (nn < N) {
#pragma unroll
            for (int i = 0; i < 4; ++i) {
                const size_t off = (size_t)(m0 + ty * 4 + i) * N + nn;
                float4 o = make_float4(acc0[i][0], acc0[i][1], acc0[i][2], acc0[i][3]);
                if (resid) { const float4 r = *(const float4*)(resid + off); o.x += r.x; o.y += r.y; o.z += r.z; o.w += r.w; }
                *(float4*)(C + off) = o;
            }
        }
    }
}

__device__ __forceinline__ void gla_cumdecay(const Params& p, int l, int b, int h, int n, float* bb) {
    const float* P = p.P; const float* wup = p.in[3] + (size_t)l * 16 * 256; const float* bgk = p.in[4] + (size_t)l * 256;
    const int t0 = b * S + n * GC, tid = threadIdx.x;
    for (int e = tid; e < 64 * 64; e += NTHR) {
        const int c = e >> 6, d = e & 63;
        const float* gl = P + (size_t)(t0 + c) * DIN + C_GK;
        float a = bgk[h * 64 + d];
#pragma unroll
        for (int r = 0; r < 16; ++r) a += gl[r] * wup[r * 256 + h * 64 + d];
        bb[c * 64 + d] = log_sigmoid(a) * (1.0f / 16.0f);
    }
    __syncthreads();
    if (tid < 64) { float run = 0.f; for (int c = 0; c < 64; ++c) { run += bb[c * 64 + tid]; bb[c * 64 + tid] = run; } }
    __syncthreads();
}

__device__ void phase_gla_kv(const Params& p, int l, float* smem, int vb, int nvb) {
    float* bb = smem; float* kd = smem + 4096;
    const int tid = threadIdx.x;
    for (int ci = vb; ci < NB * GH * GN; ci += nvb) {
        const int b = ci / (GH * GN), h = (ci / GN) % GH, n = ci % GN, t0 = b * S + n * GC;
        __syncthreads();
        gla_cumdecay(p, l, b, h, n, bb);
        for (int e = tid; e < 4096; e += NTHR) { const int c = e >> 6, d = e & 63; kd[e] = p.P[(size_t)(t0 + c) * DIN + C_K + h * 64 + d] * expf(bb[63 * 64 + d] - bb[e]); }
        __syncthreads();
        const int d = tid >> 2, v0 = (tid & 3) * 32;
        float acc[32];
#pragma unroll
        for (int j = 0; j < 32; ++j) acc[j] = 0.f;
        for (int c = 0; c < 64; ++c) {
            const float kk = kd[c * 64 + d];
            const float4* vr = (const float4*)(p.P + (size_t)(t0 + c) * DIN + C_V + h * 128 + v0);
#pragma unroll
            for (int j = 0; j < 8; ++j) { const float4 v4 = vr[j]; acc[4 * j] += kk * v4.x; acc[4 * j + 1] += kk * v4.y; acc[4 * j + 2] += kk * v4.z; acc[4 * j + 3] += kk * v4.w; }
        }
        float4* o = (float4*)(p.Sst + ((size_t)ci * 64 + d) * 128 + v0);
#pragma unroll
        for (int j = 0; j < 8; ++j) o[j] = make_float4(acc[4 * j], acc[4 * j + 1], acc[4 * j + 2], acc[4 * j + 3]);
        if (tid < 64) p.decay[(size_t)ci * 64 + tid] = expf(bb[63 * 64 + tid]);
    }
}

__device__ void phase_gla_scan(const Params& p, int vb, int nvb) {
    for (int e = vb * NTHR + threadIdx.x; e < NB * GH * 64 * 128; e += nvb * NTHR) {
        const int bh = e >> 13, d = (e >> 7) & 63, v = e & 127;
        float st = 0.f;
        for (int n = 0; n < GN; ++n) {
            const size_t ci = (size_t)bh * GN + n;
            float* ptr = p.Sst + (ci * 64 + d) * 128 + v;
            const float kvv = *ptr; *ptr = st;
            st = p.decay[ci * 64 + d] * st + kvv;
        }
    }
}

__device__ void phase_gla_out(const Params& p, int l, float* smem, int vb, int nvb) {
    float* bb = smem; float* qd = smem + 4096; float* ki = smem + 4096 + 64 * 65; float* sc = bb;
    const float* gnorm = p.in[5] + (size_t)l * 128;
    const int tid = threadIdx.x;
    for (int ci = vb; ci < NB * GH * GN; ci += nvb) {
        const int b = ci / (GH * GN), h = (ci / GN) % GH, n = ci % GN, t0 = b * S + n * GC;
        __syncthreads();
        gla_cumdecay(p, l, b, h, n, bb);
        for (int e = tid; e < 4096; e += NTHR) {
            const int c = e >> 6, d = e & 63; const float bv = bb[e];
            const float* row = p.P + (size_t)(t0 + c) * DIN;
            qd[c * 65 + d] = row[C_Q + h * 64 + d] * 0.125f * expf(bv);
            ki[c * 65 + d] = row[C_K + h * 64 + d] * expf(-bv);
        }
        __syncthreads();
        {
            const int c = tid >> 2, s0 = (tid & 3) * 16;
            float a[16];
#pragma unroll
            for (int j = 0; j < 16; ++j) a[j] = 0.f;
            for (int d = 0; d < 64; ++d) { const float qv = qd[c * 65 + d];
#pragma unroll
                for (int j = 0; j < 16; ++j) a[j] += qv * ki[(s0 + j) * 65 + d]; }
#pragma unroll
            for (int j = 0; j < 16; ++j) sc[c * 64 + s0 + j] = (s0 + j <= c) ? a[j] : 0.f;
        }
        __syncthreads();
        const int c = tid >> 2, v0 = (tid & 3) * 32;
        float acc[32];
#pragma unroll
        for (int j = 0; j < 32; ++j) acc[j] = 0.f;
        for (int s = 0; s <= c; ++s) {
            const float w = sc[c * 64 + s];
            const float4* vr = (const float4*)(p.P + (size_t)(t0 + s) * DIN + C_V + h * 128 + v0);
#pragma unroll
            for (int j = 0; j < 8; ++j) { const float4 v4 = vr[j]; acc[4 * j] += w * v4.x; acc[4 * j + 1] += w * v4.y; acc[4 * j + 2] += w * v4.z; acc[4 * j + 3] += w * v4.w; }
        }
        for (int d = 0; d < 64; ++d) {
            const float w = qd[c * 65 + d];
            const float4* sr = (const float4*)(p.Sst + ((size_t)ci * 64 + d) * 128 + v0);
#pragma unroll
            for (int j = 0; j < 8; ++j) { const float4 v4 = sr[j]; acc[4 * j] += w * v4.x; acc[4 * j + 1] += w * v4.y; acc[4 * j + 2] += w * v4.z; acc[4 * j + 3] += w * v4.w; }
        }
        float ss = 0.f;
#pragma unroll
        for (int j = 0; j < 32; ++j) ss += acc[j] * acc[j];
        ss += __shfl_xor(ss, 1); ss += __shfl_xor(ss, 2);
        const float rs = rsqrtf(ss * (1.0f / 128.0f) + EPS);
        const float* grow = p.P + (size_t)(t0 + c) * DIN + C_G + h * 128 + v0;
        float* orow = p.A + (size_t)(t0 + c) * D + h * 128 + v0;
#pragma unroll
        for (int j = 0; j < 32; ++j) orow[j] = acc[j] * rs * gnorm[v0 + j] * silu(grow[j]);
    }
}

__device__ void phase_gmlp(const Params& p, int l, float* smem, int vb, int nvb) {
    float* vs = smem;
    const float* gn = p.in[6] + (size_t)l * 256; const float* wsp = p.in[7] + (size_t)l * MH * 128 * 128; const float* bsp = p.in[8] + (size_t)l * MH * 128;
    const int tid = threadIdx.x;
    for (int u = vb; u < NB * MN * MH; u += nvb) {
        const int b = u / (MN * MH), n = (u / MH) % MN, h = u % MH, t0 = b * S + n * MC;
        __syncthreads();
        const int s = tid >> 1, d0 = (tid & 1) * 32;
        {
            const float* vr = p.P + (size_t)(t0 + s) * DIN + C_VG + h * 64 + d0;
            float g[32]; float ss = 0.f;
#pragma unroll
            for (int j = 0; j < 32; ++j) { g[j] = gelu_tanh(vr[j]); ss += g[j] * g[j]; }
            ss += __shfl_xor(ss, 1);
            const float rs = rsqrtf(ss * (1.0f / 64.0f) + EPS);
#pragma unroll
            for (int j = 0; j < 32; ++j) vs[s * 64 + d0 + j] = g[j] * rs * gn[h * 64 + d0 + j];
        }
        __syncthreads();
        const int t = s;
        float acc[32];
#pragma unroll
        for (int j = 0; j < 32; ++j) acc[j] = 0.f;
        const float* wr = wsp + ((size_t)h * 128 + t) * 128;
        for (int s2 = 0; s2 <= t; ++s2) { const float w = wr[s2];
#pragma unroll
            for (int j = 0; j < 32; ++j) acc[j] += w * vs[s2 * 64 + d0 + j]; }
        const float bias = bsp[h * 128 + t];
        const float* ur = p.P + (size_t)(t0 + t) * DIN + C_U + h * 64 + d0;
        float* orow = p.A + (size_t)(t0 + t) * D + 512 + h * 64 + d0;
#pragma unroll
        for (int j = 0; j < 32; ++j) orow[j] = gelu_tanh(ur[j]) * (acc[j] + bias);
    }
}

__device__ void phase_conv(const Params& p, int l, int vb, int nvb) {
    const float* wc = p.in[9] + (size_t)l * 3 * 256;
    for (size_t e = (size_t)vb * NTHR + threadIdx.x; e < (size_t)T * 256; e += (size_t)nvb * NTHR) {
        const int t = (int)(e >> 8), c = (int)(e & 255), tl = t % S;
        const float* row = p.P + (size_t)t * DIN;
        float y = wc[2 * 256 + c] * row[C_CG + c] * row[C_XI + c];
        if (tl >= 1) y += wc[1 * 256 + c] * row[C_CG + c - DIN] * row[C_XI + c - DIN];
        if (tl >= 2) y += wc[0 * 256 + c] * row[C_CG + c - 2 * DIN] * row[C_XI + c - 2 * DIN];
        p.A[(size_t)t * D + 768 + c] = row[C_BG + c] * y;
    }
}

__device__ void phase_zero_counts(const Params& p, int vb) { if (vb == 0 && threadIdx.x < 32) { p.cnt[threadIdx.x] = 0; p.cursor[threadIdx.x] = 0; } }

__device__ void phase_router(const Params& p, int l, const float* h2, int vb, int nvb) {
    const float* wrg = p.in[12] + (size_t)l * D * 4; const float* brg = p.in[13] + (size_t)l * 4;
    const float* wre = p.in[14] + (size_t)l * D * 32; const float* bre = p.in[15] + (size_t)l * 32;
    const int lane = threadIdx.x & 63, w = threadIdx.x >> 6;
    for (int t = vb * 4 + w; t < T; t += nvb * 4) {
        float acc[36];
#pragma unroll
        for (int j = 0; j < 36; ++j) acc[j] = 0.f;
        const float* xr = h2 + (size_t)t * D;
        for (int i = 0; i < 16; ++i) {
            const int k = lane + 64 * i; const float xv = xr[k];
            const float4 g4 = *(const float4*)(wrg + (size_t)k * 4);
            acc[0] += xv * g4.x; acc[1] += xv * g4.y; acc[2] += xv * g4.z; acc[3] += xv * g4.w;
            const float4* e4 = (const float4*)(wre + (size_t)k * 32);
#pragma unroll
            for (int j = 0; j < 8; ++j) { const float4 q = e4[j]; acc[4 + 4 * j] += xv * q.x; acc[5 + 4 * j] += xv * q.y; acc[6 + 4 * j] += xv * q.z; acc[7 + 4 * j] += xv * q.w; }
        }
#pragma unroll
        for (int j = 0; j < 36; ++j) {
#pragma unroll
            for (int o = 1; o < 64; o <<= 1) acc[j] += __shfl_xor(acc[j], o);
        }
        if (lane == 0) {
            float gl[4]; int gt = 0;
#pragma unroll
            for (int j = 0; j < 4; ++j) gl[j] = acc[j] + brg[j];
            float gmax = gl[0];
#pragma unroll
            for (int j = 1; j < 4; ++j) if (gl[j] > gmax) { gmax = gl[j]; gt = j; }
            float gs = 0.f;
#pragma unroll
            for (int j = 0; j < 4; ++j) gs += expf(gl[j] - gmax);
            const float gw = 1.0f / gs;
            float el[8];
#pragma unroll
            for (int j = 0; j < 8; ++j) { float v = 0.f;
#pragma unroll
                for (int g = 0; g < 4; ++g) if (g == gt) v = acc[4 + g * 8 + j] + bre[g * 8 + j];
                el[j] = v; }
            int i0 = 0; float m0 = el[0];
#pragma unroll
            for (int j = 1; j < 8; ++j) if (el[j] > m0) { m0 = el[j]; i0 = j; }
            int i1 = -1; float m1 = -INFINITY;
#pragma unroll
            for (int j = 0; j < 8; ++j) if (j != i0 && el[j] > m1) { m1 = el[j]; i1 = j; }
            const float e1 = expf(m1 - m0);
            const float w0 = gw / (1.0f + e1), w1 = gw * e1 / (1.0f + e1);
            const int e0i = gt * 8 + i0, e1i = gt * 8 + i1;
            p.eid[2 * t] = e0i; p.eid[2 * t + 1] = e1i; p.ew[2 * t] = w0; p.ew[2 * t + 1] = w1;
            atomicAdd(&p.cnt[e0i], 1); atomicAdd(&p.cnt[e1i], 1);
        }
    }
}

__device__ void phase_scatter(const Params& p, int* ismem, int vb, int nvb) {
    int* offs = ismem;
    __syncthreads();
    if (threadIdx.x == 0) { int a = 0; for (int e = 0; e < NE; ++e) { offs[e] = a; a += p.cnt[e]; } }
    __syncthreads();
    for (int a = vb * NTHR + threadIdx.x; a < 2 * T; a += nvb * NTHR) {
        const int e = p.eid[a];
        const int pos = offs[e] + atomicAdd(&p.cursor[e], 1);
        p.slot_tok[pos] = a >> 1; p.slot_of[a] = pos;
    }
}

template <int MODE>
__device__ void phase_moe(const Params& p, int l, const float* h2, float* H1, float* Y, float* smem, int vb, int nvb) {
    float* As = smem; float* Bs0 = smem + 16 * 68; float* Bs1 = Bs0 + 16 * 64; int* rowoff = (int*)(Bs1 + 16 * 64); int* offs = rowoff + 64; int* toff = offs + 33;
    const int tid = threadIdx.x, tx = tid & 15, ty = tid >> 4;
    __syncthreads();
    if (tid == 0) { int a = 0, tt = 0; for (int e = 0; e < NE; ++e) { offs[e] = a; toff[e] = tt; const int c = p.cnt[e]; a += c; tt += (c + 63) / 64; } offs[NE] = a; toff[NE] = tt; }
    __syncthreads();
    constexpr int N = (MODE == 1) ? DE : D, K = (MODE == 1) ? D : DE, NTN = N / 64;
    const int ntiles = toff[NE] * NTN;
    for (int t = vb; t < ntiles; t += nvb) {
        const int rt = t / NTN, tn = t % NTN;
        int e = 0;
        for (int j = 1; j < NE; ++j) if (toff[j] <= rt) e = j;
        const int r0 = offs[e] + (rt - toff[e]) * 64, rend = offs[e + 1];
        __syncthreads();
        if (tid < 64) { const int r = r0 + tid; rowoff[tid] = (r < rend) ? ((MODE == 1) ? p.slot_tok[r] * D : r * DE) : -1; }
        __syncthreads();
        float acc0[4][4], acc1[4][4];
        if (MODE == 1) {
            const float* Wg = p.in[16] + ((size_t)l * NE + e) * D * DE; const float* Wu = p.in[17] + ((size_t)l * NE + e) * D * DE;
            gemm_core<true>(h2, rowoff, K, Wg, Wu, DE, tn * 64, N, acc0, acc1, As, Bs0, Bs1);
        } else {
            const float* Wd = p.in[18] + ((size_t)l * NE + e) * DE * D;
            gemm_core<false>(H1, rowoff, K, Wd, nullptr, D, tn * 64, N, acc0, acc1, As, Bs0, nullptr);
        }
#pragma unroll
        for (int i = 0; i < 4; ++i) {
            const int r = r0 + ty * 4 + i;
            if (r < rend) {
                float4 o;
                if (MODE == 1) { o.x = silu(acc0[i][0]) * acc1[i][0]; o.y = silu(acc0[i][1]) * acc1[i][1]; o.z = silu(acc0[i][2]) * acc1[i][2]; o.w = silu(acc0[i][3]) * acc1[i][3];
                    *(float4*)(H1 + (size_t)r * DE + tn * 64 + tx * 4) = o; }
                else { o = make_float4(acc0[i][0], acc0[i][1], acc0[i][2], acc0[i][3]); *(float4*)(Y + (size_t)r * D + tn * 64 + tx * 4) = o; }
            }
        }
    }
}

__device__ void phase_combine(const Params& p, float* x, const float* Y, int vb, int nvb) {
    const int lane = threadIdx.x & 63, w = threadIdx.x >> 6;
    for (int t = vb * 4 + w; t < T; t += nvb * 4) {
        const int s0 = p.slot_of[2 * t], s1 = p.slot_of[2 * t + 1]; const float w0 = p.ew[2 * t], w1 = p.ew[2 * t + 1];
        float4* xr = (float4*)(x + (size_t)t * D); const float4* y0 = (const float4*)(Y + (size_t)s0 * D); const float4* y1 = (const float4*)(Y + (size_t)s1 * D);
#pragma unroll
        for (int j = 0; j < 4; ++j) { float4 v = xr[lane + 64 * j]; const float4 a = y0[lane + 64 * j], b = y1[lane + 64 * j];
            v.x += w0 * a.x + w1 * b.x; v.y += w0 * a.y + w1 * b.y; v.z += w0 * a.z + w1 * b.z; v.w += w0 * a.w + w1 * b.w; xr[lane + 64 * j] = v; }
    }
}

__global__ void __launch_bounds__(NTHR) fwd_kernel(Params p) {
    cg::grid_group grid = cg::this_grid();
    __shared__ __attribute__((aligned(16))) float smem[3 * 4096 + 512];
    const int vb = blockIdx.x, nvb = gridDim.x;
    float* H1 = p.P; float* Y = p.P + (size_t)(2 * T + 64) * DE;
    for (int l = 0; l < DEPTH; ++l) {
        const float* xin = (l == 0) ? p.in[0] : p.out;
        phase_rmsnorm(xin, p.in[1] + (size_t)l * D, p.A, vb, nvb);
        phase_zero_counts(p, vb);
        grid.sync();
        phase_gemm(p.A, D, p.in[2] + (size_t)l * D * DIN, DIN, D, p.P, nullptr, T, smem, vb, nvb);
        grid.sync();
        phase_gla_kv(p, l, smem, vb, nvb);
        phase_gmlp(p, l, smem, vb, nvb);
        phase_conv(p, l, vb, nvb);
        grid.sync();
        phase_gla_scan(p, vb, nvb);
        grid.sync();
        phase_gla_out(p, l, smem, vb, nvb);
        grid.sync();
        phase_gemm(p.A, D, p.in[10] + (size_t)l * D * D, D, D, p.out, xin, T, smem, vb, nvb);
        grid.sync();
        phase_rmsnorm(p.out, p.in[11] + (size_t)l * D, p.A, vb, nvb);
        grid.sync();
        phase_router(p, l, p.A, vb, nvb);
        grid.sync();
        phase_scatter(p, (int*)smem, vb, nvb);
        grid.sync();
        phase_moe<1>(p, l, p.A, H1, Y, smem, vb, nvb);
        grid.sync();
        phase_moe<2>(p, l, p.A, H1, Y, smem, vb, nvb);
        grid.sync();
        phase_combine(p, p.out, Y, vb, nvb);
        grid.sync();
    }
    phase_rmsnorm(p.out, p.in[19], p.out, vb, nvb);
}

extern "C" void kernel_launch(void* const* d_in, const int* in_sizes, int n_in, void* d_out, int out_size, void* d_ws, size_t ws_size, hipStream_t stream) {
    static int grid_blocks = 0;
    if (!grid_blocks) {
        int dev = 0, cus = 0, per_cu = 0;
        hipGetDevice(&dev);
        hipDeviceGetAttribute(&cus, hipDeviceAttributeMultiprocessorCount, dev);
        hipOccupancyMaxActiveBlocksPerMultiprocessor(&per_cu, fwd_kernel, NTHR, 0);
        if (per_cu > 2) per_cu = 2;
        if (per_cu < 1) per_cu = 1;
        grid_blocks = cus * per_cu;
    }
    Params p{};
    for (int i = 0; i < 20; ++i) p.in[i] = (const float*)d_in[i];
    p.out = (float*)d_out;
    char* ws = (char*)d_ws; size_t off = 0;
    auto carve = [&](size_t bytes) { void* r = ws + off; off += (bytes + 255) & ~(size_t)255; return r; };
    p.A = (float*)carve((size_t)T * D * 4);
    p.P = (float*)carve((size_t)T * DIN * 4);
    p.Sst = (float*)carve((size_t)NB * GH * GN * 64 * 128 * 4);
    p.decay = (float*)carve((size_t)NB * GH * GN * 64 * 4);
    p.cnt = (int*)carve(32 * 4); p.cursor = (int*)carve(32 * 4);
    p.eid = (int*)carve((size_t)2 * T * 4); p.ew = (float*)carve((size_t)2 * T * 4);
    p.slot_tok = (int*)carve((size_t)2 * T * 4); p.slot_of = (int*)carve((size_t)2 * T * 4);
    if (off > ws_size) { fprintf(stderr, "workspace too small: need %zu have %zu\n", off, ws_size); return; }
    void* args[] = {&p};
    hipError_t e = hipLaunchCooperativeKernel((void*)fwd_kernel, dim3(grid_blocks), dim3(NTHR), args, 0, stream);
    if (e != hipSuccess) fprintf(stderr, "cooperative launch failed: %s (grid %d)\n", hipGetErrorString(e), grid_blocks);
}
```

```cpp
#include <hip/hip_runtime.h>
#include <hip/hip_cooperative_groups.h>
#include <cstdio>
#include <cstdint>
namespace cg = cooperative_groups;
namespace pg8 {
#define PG8_LAS __attribute__((address_space(3)))
typedef unsigned short bf16_t;
typedef short bf16x8 __attribute__((ext_vector_type(8)));
typedef float f32x4 __attribute__((ext_vector_type(4)));
typedef unsigned u32x4 __attribute__((ext_vector_type(4)));
constexpr int BM = 256, BK = 64, HALF = 128, HTB = HALF * BK * 2  , STAGE_BYTES = 8 * HTB, NXCD = 8, WGM = 8;

__host__ __device__ __forceinline__ int lds_byte(int r, int c) { const int st = (r >> 4) * 2 + (c >> 5), rr = r & 15, cc = c & 31, ob = rr * 64 + cc * 2; return st * 1024 + (ob ^ (((ob >> 9) & 1) << 5)); }
__host__ __device__ __forceinline__ void stage_rc(int b, int& R, int& C) { const int st = b / 1024, sb = b % 1024, swz = sb ^ (((sb >> 9) & 1) << 5); R = (st >> 1) * 16 + swz / 64; C = (st & 1) * 32 + (swz % 64) / 2; }
__host__ __device__ __forceinline__ int perm32(int rho) { const int n = rho >> 4, i = rho & 15; return 8 * (i >> 2) + 4 * n + (i & 3); }

struct Unit { int pm, pn; };
struct Gemm { const bf16_t* A; const bf16_t* Bt; int M, N, K; };

struct StaticOrder {
    int nM, nN, nwg, G, c;
    __host__ __device__ void init(int M, int N, int G_, int c_) { nM = M / BM; nN = N / BM; nwg = nM * nN; G = G_; c = c_; }
    __host__ __device__ bool next(int i, Unit& u) const {
        const long L = (long)i * G + c; if (L >= nwg) return false;
        int wgid = (int)L; { const int q = nwg / NXCD, r = nwg % NXCD, xcd = wgid % NXCD, off = wgid / NXCD; wgid = (xcd < r ? xcd * (q + 1) : r * (q + 1) + (xcd - r) * q) + off; }
        const int nig = WGM * nN, gid = wgid / nig, fm = gid * WGM, gsz = (nM - fm) < WGM ? (nM - fm) : WGM;
        u.pm = fm + ((wgid % nig) % gsz); u.pn = (wgid % nig) / gsz; return true;
    }
    __device__ __forceinline__ void a_ready(const Unit&) const {}
    __device__ __forceinline__ void done(const Unit&) const {}
};


__device__ __forceinline__ unsigned cvt_pk_bf16(float lo, float hi) { unsigned r; asm volatile("v_cvt_pk_bf16_f32 %0, %1, %2" : "=v"(r) : "v"(lo), "v"(hi)); return r; }
struct EpiBf16Plain {
    static constexpr bool PERM = true, AFTER_DRAIN = false;
    bf16_t* O; int ldc;
    __device__ __forceinline__ void operator()(const f32x4 (&acc)[2][2][4][2], const Unit& u, int wr, int wc, int fr, int fq) const {
        const int row0 = u.pm * BM + wr * 64 + fr, col0 = u.pn * BM + wc * 32 + 8 * fq;
#pragma unroll
        for (int ai = 0; ai < 2; ++ai)
#pragma unroll
            for (int m = 0; m < 4; ++m) { bf16_t* rowp = O + (size_t)(row0 + ai * HALF + m * 16) * ldc + col0;
#pragma unroll
                for (int bj = 0; bj < 2; ++bj) { const f32x4 v0 = acc[ai][bj][m][0], v1 = acc[ai][bj][m][1];
                    u32x4 w; w.x = cvt_pk_bf16(v0[0], v0[1]); w.y = cvt_pk_bf16(v0[2], v0[3]); w.z = cvt_pk_bf16(v1[0], v1[1]); w.w = cvt_pk_bf16(v1[2], v1[3]);
                    *(u32x4*)(rowp + bj * HALF) = w; } }
    }
};
struct EpiF32Res {
    static constexpr bool PERM = false, AFTER_DRAIN = false;
    float* C; const float* R; int ldc;
    __device__ __forceinline__ void operator()(const f32x4 (&acc)[2][2][4][2], const Unit& u, int wr, int wc, int fr, int fq) const {
        const int row0 = u.pm * BM + wr * 64 + fr, col0 = u.pn * BM + wc * 32 + 4 * fq;
#pragma unroll
        for (int ai = 0; ai < 2; ++ai)
#pragma unroll
            for (int m = 0; m < 4; ++m) { const size_t off = (size_t)(row0 + ai * HALF + m * 16) * ldc + col0;
#pragma unroll
                for (int bj = 0; bj < 2; ++bj)
#pragma unroll
                    for (int n = 0; n < 2; ++n) { const f32x4 r = *(const f32x4*)(R + off + bj * HALF + n * 16); *(f32x4*)(C + off + bj * HALF + n * 16) = r + acc[ai][bj][m][n]; } }
    }
};
template <class Epi, class Sched, bool ALIGN_EPI = false, bool SP2 = false>
__device__ __forceinline__ void gemm_phase(PG8_LAS unsigned char* lds, const Gemm g, const Sched& S, const Epi& E) {
    int tid_ = threadIdx.x; asm volatile("" : "+v"(tid_));
    const int tid = tid_, wid = __builtin_amdgcn_readfirstlane(tid >> 6), lane = tid & 63, wr = wid >> 2, wc = wid & 3, fr = lane & 15, fq = lane >> 4;
    const int K = g.K, nt = K / BK;
    unsigned voffA[2], voffB[2];
#pragma unroll
    for (int i = 0; i < 2; ++i) { int R, C; stage_rc(tid * 16 + i * 8192, R, C); const int Rb = Epi::PERM ? ((R & ~31) + perm32(R & 31)) : R;
        voffA[i] = (unsigned)(R * K + C) * 2u; voffB[i] = (unsigned)(Rb * K + C) * 2u; }
    const size_t kstep = (size_t)(BK * 2);
    const size_t hstep = (size_t)HALF * K * 2;
    const size_t tstep = 2 * hstep;
    const unsigned ldsw = (unsigned)wid * 1024u;
    const int aoff = lds_byte(wr * 64 + fr, fq * 8), boff = lds_byte(wc * 32 + fr, fq * 8);
#define PG8_SA(b, h) (((b) * 2 + (h)) * HTB)
#define PG8_SB(b, h) ((4 + (b) * 2 + (h)) * HTB)
#define PG8_STAGE(bufoff, gbase, voff) do { _Pragma("unroll") for (int _i = 0; _i < 2; ++_i) \
        __builtin_amdgcn_global_load_lds((const unsigned*)((const char*)(gbase) + (voff)[_i]), (PG8_LAS unsigned*)(lds + (bufoff) + ldsw + _i * 8192), 16, 0, 0); } while (0)
#define PG8_LDA(dst, b, h) do { _Pragma("unroll") for (int m = 0; m < 4; ++m) _Pragma("unroll") for (int k = 0; k < 2; ++k) dst[m][k] = *(const PG8_LAS bf16x8*)(lds + PG8_SA(b, h) + aoff + m * 2048 + k * 1024); } while (0)
#define PG8_LDB(dst, b, h) do { _Pragma("unroll") for (int n = 0; n < 2; ++n) _Pragma("unroll") for (int k = 0; k < 2; ++k) dst[n][k] = *(const PG8_LAS bf16x8*)(lds + PG8_SB(b, h) + boff + n * 2048 + k * 1024); } while (0)
#define PG8_MMA(ai, bj, At, Bt) do { __builtin_amdgcn_s_setprio(1); _Pragma("unroll") for (int m = 0; m < 4; ++m) _Pragma("unroll") for (int n = 0; n < 2; ++n) _Pragma("unroll") for (int k = 0; k < 2; ++k) \
        acc[ai][bj][m][n] = __builtin_amdgcn_mfma_f32_16x16x32_bf16(Bt[n][k], At[m][k], acc[ai][bj][m][n], 0, 0, 0); __builtin_amdgcn_s_setprio(0); } while (0)
#define PG8_WAIT_V(n) asm volatile("s_waitcnt vmcnt(" #n ")" ::: "memory")
#define PG8_WAIT_L(n) asm volatile("s_waitcnt lgkmcnt(" #n ")" ::: "memory")
#define PG8_BAR __builtin_amdgcn_s_barrier()
#define PG8_SCHED __builtin_amdgcn_sched_barrier(0)
    Unit cur, nxt; int ui = 0;
    if (!S.next(0, cur)) return;
    f32x4 acc[2][2][4][2];
#pragma unroll
    for (int a = 0; a < 2; ++a)
#pragma unroll
        for (int b = 0; b < 2; ++b)
#pragma unroll
            for (int m = 0; m < 4; ++m)
#pragma unroll
                for (int n = 0; n < 2; ++n) acc[a][b][m][n] = (f32x4){0.f, 0.f, 0.f, 0.f};
    bf16x8 At[4][2], B0[2][2], B1[2][2];
    const char* cA = (const char*)g.A + (size_t)cur.pm * tstep; const char* cB = (const char*)g.Bt + (size_t)cur.pn * tstep;
    S.a_ready(cur);
    if constexpr (SP2) {
        PG8_STAGE(PG8_SB(0, 0), cB, voffB); PG8_STAGE(PG8_SB(0, 1), cB + hstep, voffB); PG8_STAGE(PG8_SA(0, 0), cA, voffA); PG8_STAGE(PG8_SA(0, 1), cA + hstep, voffA);
        if (wr == 1) PG8_BAR;
        PG8_WAIT_V(2); PG8_BAR;
        PG8_STAGE(PG8_SB(1, 0), cB + kstep, voffB); PG8_STAGE(PG8_SA(1, 0), cA + kstep, voffA); PG8_STAGE(PG8_SB(1, 1), cB + hstep + kstep, voffB);
        PG8_WAIT_V(6); PG8_BAR;
    } else {
        PG8_STAGE(PG8_SB(0, 0), cB, voffB); PG8_STAGE(PG8_SA(0, 0), cA, voffA); PG8_STAGE(PG8_SB(0, 1), cB + hstep, voffB); PG8_STAGE(PG8_SA(0, 1), cA + hstep, voffA);
        if (wr == 1) PG8_BAR;
        PG8_WAIT_V(4); PG8_BAR;
        PG8_STAGE(PG8_SB(1, 0), cB + kstep, voffB); PG8_STAGE(PG8_SA(1, 0), cA + kstep, voffA); PG8_STAGE(PG8_SB(1, 1), cB + hstep + kstep, voffB);
        PG8_WAIT_V(6); PG8_BAR;
    }
    for (;;) {
        const bool has_next = S.next(ui + 1, nxt);
        const char* nA = has_next ? (const char*)g.A + (size_t)nxt.pm * tstep : cA; const char* nB = has_next ? (const char*)g.Bt + (size_t)nxt.pn * tstep : cB;
        for (int t = 0; t < nt; t += 2) {
            const bool last = (t == nt - 2);
            const char* a1 = cA + (size_t)(t + 1) * kstep;
            const char* a2 = last ? nA : cA + (size_t)(t + 2) * kstep; const char* b2 = last ? nB : cB + (size_t)(t + 2) * kstep;
            const char* a3 = a2 + kstep; const char* b3 = b2 + kstep;
            if (last && has_next) S.a_ready(nxt);
            if constexpr (SP2) {
            PG8_LDB(B0, 0, 0); PG8_LDB(B1, 0, 1); PG8_SCHED; PG8_LDA(At, 0, 0); PG8_STAGE(PG8_SA(1, 1), a1 + hstep, voffA);
            PG8_WAIT_V(8); PG8_WAIT_L(0); PG8_BAR; PG8_MMA(0, 0, At, B0); PG8_MMA(0, 1, At, B1); PG8_BAR; PG8_SCHED;
            PG8_LDA(At, 0, 1); PG8_STAGE(PG8_SB(0, 0), b2, voffB); PG8_STAGE(PG8_SB(0, 1), b2 + hstep, voffB); PG8_STAGE(PG8_SA(0, 0), a2, voffA);
            PG8_WAIT_V(8); PG8_WAIT_L(0); PG8_BAR; PG8_MMA(1, 0, At, B0); PG8_MMA(1, 1, At, B1); PG8_BAR; PG8_SCHED;
            PG8_LDB(B0, 1, 0); PG8_LDB(B1, 1, 1); PG8_SCHED; PG8_LDA(At, 1, 0); PG8_STAGE(PG8_SA(0, 1), a2 + hstep, voffA);
            PG8_WAIT_V(8); PG8_WAIT_L(0); PG8_BAR; PG8_MMA(0, 0, At, B0); PG8_MMA(0, 1, At, B1); PG8_BAR; PG8_SCHED;
            PG8_LDA(At, 1, 1); PG8_STAGE(PG8_SB(1, 0), b3, voffB); PG8_STAGE(PG8_SB(1, 1), b3 + hstep, voffB); PG8_STAGE(PG8_SA(1, 0), a3, voffA);
            PG8_WAIT_V(8); PG8_WAIT_L(0); PG8_BAR; PG8_MMA(1, 0, At, B0); PG8_MMA(1, 1, At, B1); PG8_BAR; PG8_SCHED;
            } else {
            PG8_LDB(B0, 0, 0); PG8_SCHED; PG8_LDA(At, 0, 0); PG8_STAGE(PG8_SA(1, 1), a1 + hstep, voffA);
            PG8_WAIT_L(8); PG8_BAR; PG8_WAIT_L(0); PG8_MMA(0, 0, At, B0); PG8_BAR; PG8_SCHED;
            PG8_LDB(B1, 0, 1); PG8_STAGE(PG8_SB(0, 0), b2, voffB);
            PG8_BAR; PG8_WAIT_L(0); PG8_MMA(0, 1, At, B1); PG8_BAR;
            PG8_LDA(At, 0, 1); PG8_STAGE(PG8_SA(0, 0), a2, voffA);
            PG8_BAR; PG8_WAIT_L(0); PG8_MMA(1, 0, At, B0); PG8_BAR; PG8_SCHED;
            PG8_STAGE(PG8_SB(0, 1), b2 + hstep, voffB);
            PG8_WAIT_V(6); PG8_BAR; PG8_MMA(1, 1, At, B1); PG8_BAR;
            PG8_LDB(B0, 1, 0); PG8_SCHED; PG8_LDA(At, 1, 0); PG8_STAGE(PG8_SA(0, 1), a2 + hstep, voffA);
            PG8_WAIT_L(8); PG8_BAR; PG8_WAIT_L(0); PG8_MMA(0, 0, At, B0); PG8_BAR; PG8_SCHED;
            PG8_LDB(B1, 1, 1); PG8_STAGE(PG8_SB(1, 0), b3, voffB);
            PG8_BAR; PG8_WAIT_L(0); PG8_MMA(0, 1, At, B1); PG8_BAR;
            PG8_LDA(At, 1, 1); PG8_STAGE(PG8_SA(1, 0), a3, voffA);
            PG8_BAR; PG8_WAIT_L(0); PG8_MMA(1, 0, At, B0); PG8_BAR; PG8_SCHED;
            PG8_STAGE(PG8_SB(1, 1), b3 + hstep, voffB);
            PG8_WAIT_V(6); PG8_BAR; PG8_MMA(1, 1, At, B1); PG8_BAR;
            }
        }
        if constexpr (ALIGN_EPI) { if (wr == 0) PG8_BAR; }
        if constexpr (!Epi::AFTER_DRAIN) { E(acc, cur, wr, wc, fr, fq); S.done(cur); }
        if (!has_next) break;
#pragma unroll
        for (int a = 0; a < 2; ++a)
#pragma unroll
            for (int b = 0; b < 2; ++b)
#pragma unroll
                for (int m = 0; m < 4; ++m)
#pragma unroll
                    for (int n = 0; n < 2; ++n) acc[a][b][m][n] = (f32x4){0.f, 0.f, 0.f, 0.f};
        cur = nxt; cA = nA; cB = nB; ++ui;
        if constexpr (ALIGN_EPI) { if (wr == 1) PG8_BAR; }
    }
    PG8_WAIT_V(0);
    if constexpr (!ALIGN_EPI) { if (wr == 0) PG8_BAR; }
    PG8_BAR;
    if constexpr (Epi::AFTER_DRAIN) { E.fused(acc, cur, wr, wc, fr, fq, lds, wid, lane); S.done(cur); }
#undef PG8_SA
#undef PG8_SB
#undef PG8_STAGE
#undef PG8_LDA
#undef PG8_LDB
#undef PG8_MMA
#undef PG8_WAIT_V
#undef PG8_WAIT_L
#undef PG8_BAR
#undef PG8_SCHED
}
}

#ifndef PG8_SP2
#define PG8_SP2 true
#endif
#ifndef PG8_ALIGN
#define PG8_ALIGN true
#endif

constexpr int NWAVES = 8, NT = NWAVES * 64;
constexpr int D = 1024, NB = 2, S = 8192, T = NB * S, DEPTH = 2;
constexpr int DIN = 2832, PLD = 3072;
constexpr int C_Q = 0, C_K = 256, C_V = 512, C_G = 1024, C_GK = 1536, C_U = 1552, C_VG = 1808, C_XI = 2064, C_BG = 2320, C_CG = 2576;
constexpr int GH = 4, GC = 64, GN = S / GC;
constexpr int MH = 4, MC = 128, MN = S / MC;
constexpr int NE = 32, DE = 256;
constexpr float EPS = 1e-6f;
constexpr size_t MiB = 1u << 20;
constexpr size_t WS_CTL = 0, CTL_BYTES = 1 * MiB;
constexpr size_t WS_WIN = 1 * MiB;
constexpr size_t WS_WOUT = 13 * MiB;
constexpr size_t WS_WGU = 17 * MiB;
constexpr size_t WS_WD = 81 * MiB;
constexpr size_t WS_XN = 113 * MiB;
constexpr size_t WS_P = 145 * MiB;
constexpr size_t WS_Y = WS_P + 17 * MiB;
constexpr size_t WS_S = 241 * MiB;
constexpr size_t WS_DEC = 273 * MiB;
constexpr size_t WS_MISC = 274 * MiB;
constexpr size_t WS_END = 275 * MiB;
constexpr int CW_BAR = 4096, CW_CNT = 16384;
constexpr int RING_BYTES = 131072, LDSCTL_OFF = RING_BYTES, MISC_OFF = LDSCTL_OFF + 320, LDS_BYTES = 147456;

#define GAS __attribute__((address_space(1)))
#define LAS __attribute__((address_space(3)))
typedef unsigned short bf16;
typedef unsigned v4u __attribute__((ext_vector_type(4)));
typedef unsigned v2u __attribute__((ext_vector_type(2)));
typedef float f32x4 __attribute__((ext_vector_type(4)));
__device__ __forceinline__ unsigned f2bf(float f) { unsigned u = __builtin_bit_cast(unsigned, f); return (u + 0x7fffu + ((u >> 16) & 1u)) >> 16; }
__device__ __forceinline__ unsigned pk2(float lo, float hi) { return f2bf(lo) | (f2bf(hi) << 16); }
__device__ __forceinline__ float bf2f(unsigned v) { return __uint_as_float(v << 16); }
__device__ __forceinline__ float bflo(unsigned w) { return __uint_as_float(w << 16); }
__device__ __forceinline__ float bfhi(unsigned w) { return __uint_as_float(w & 0xffff0000u); }
__device__ __forceinline__ void unpack8(const v4u q, float (&f)[8]) { f[0] = bflo(q.x); f[1] = bfhi(q.x); f[2] = bflo(q.y); f[3] = bfhi(q.y); f[4] = bflo(q.z); f[5] = bfhi(q.z); f[6] = bflo(q.w); f[7] = bfhi(q.w); }
__device__ __forceinline__ float gelu_tanh(float x) { const float u = 0.7978845608028654f * (x + 0.044715f * x * x * x); return 0.5f * x * (1.0f + tanhf(u)); }
__device__ __forceinline__ float silu(float x) { return x / (1.0f + expf(-x)); }
__device__ __forceinline__ float log_sigmoid(float x) { return fminf(x, 0.f) - log1pf(expf(-fabsf(x))); }

#define XB_TMO      128
#define XB_XCNT(j)  (256  + 64 * (j))
#define XB_XSUB(j)  (1280 + 64 * (j))
#define XB_XGEN(j)  (2304 + 64 * (j))
#define XB_TOP      3328
#define XB_TOPGEN   3392
#define XCD_BAR_WORDS 3456
#define XB_SPIN_CAP (1u << 18)

__device__ __forceinline__ unsigned xb_ld(unsigned* p)              { return __hip_atomic_load(p, __ATOMIC_RELAXED, __HIP_MEMORY_SCOPE_AGENT); }
__device__ __forceinline__ unsigned xb_add(unsigned* p, unsigned v) { return __hip_atomic_fetch_add(p, v, __ATOMIC_RELAXED, __HIP_MEMORY_SCOPE_AGENT); }
__device__ __forceinline__ unsigned xb_xcc_id() { return (unsigned)__builtin_amdgcn_s_getreg((3 << 11) | 20) & 0xFu; }
#define XB_SPIN(cond, bar) do { unsigned _sp = 0; while (cond) { __builtin_amdgcn_s_sleep(1); \
    if ((++_sp & 255u) == 0u) { if (xb_ld(&(bar)[XB_TMO])) break; if (_sp > XB_SPIN_CAP) { atomicAdd(&(bar)[XB_TMO], 1u); break; } } } } while (0)

struct XcdBarrier {
    unsigned* bar; unsigned x;
    volatile LAS unsigned* st;
};

__device__ __forceinline__ XcdBarrier xcd_barrier_post(unsigned* bar, volatile LAS unsigned* st) {
    XcdBarrier b; b.bar = bar; b.x = xb_xcc_id(); b.st = st;
    if (threadIdx.x == 0) (void)xb_add(&bar[XB_XCNT(b.x)], 1u);
    return b;
}
__device__ __forceinline__ void xcd_barrier_complete(unsigned* bar, unsigned x, unsigned& nloc, unsigned& nx) {
    const unsigned G = gridDim.x * gridDim.y * gridDim.z;
    unsigned sum, cnt, mine, sp = 0u;
    for (;;) {
        sum = 0u; cnt = 0u; mine = 0u;
#pragma unroll
        for (unsigned j = 0; j < 16; ++j) { const unsigned c = xb_ld(&bar[XB_XCNT(j)]); sum += c; cnt += (c > 0u) ? 1u : 0u; mine = (j == x) ? c : mine; }
        if (sum == G) break;
        __builtin_amdgcn_s_sleep(1);
        if ((++sp & 255u) == 0u) { if (xb_ld(&bar[XB_TMO])) break; if (sp > XB_SPIN_CAP) { atomicAdd(&bar[XB_TMO], 1u); break; } }
    }
    nloc = mine > 0u ? mine : 1u; nx = cnt > 0u ? cnt : 1u;
}

__device__ __forceinline__ void xcd_barrier(const XcdBarrier& b) {
    asm volatile("s_waitcnt vmcnt(0)" ::: "memory");
    __syncthreads();
    if (threadIdx.x == 0) {
        unsigned* bar = b.bar;
        __builtin_amdgcn_s_waitcnt(0);
        unsigned nloc = b.st[0], nx = b.st[1];
        if (nloc == 0u) { xcd_barrier_complete(bar, b.x, nloc, nx); b.st[0] = nloc; b.st[1] = nx; }
        const unsigned old = xb_add(&bar[XB_XSUB(b.x)], 1u);
        const unsigned gen = old / nloc;
        if (old + 1u == (gen + 1u) * nloc) {
            __builtin_amdgcn_fence(__ATOMIC_RELEASE, "agent");
            asm volatile("s_waitcnt vmcnt(0)" ::: "memory");
            const unsigned og = xb_add(&bar[XB_TOP], 1u);
            const unsigned tg = og / nx;
            if (og + 1u == (tg + 1u) * nx) xb_add(&bar[XB_TOPGEN], 1u);
            else XB_SPIN(xb_ld(&bar[XB_TOPGEN]) == tg, bar);
            __builtin_amdgcn_fence(__ATOMIC_ACQUIRE, "agent");
            xb_add(&bar[XB_XGEN(b.x)], 1u);
            asm volatile("s_waitcnt vmcnt(0)" ::: "memory");
        } else {
            XB_SPIN(xb_ld(&bar[XB_XGEN(b.x)]) == gen, bar);
            __builtin_amdgcn_fence(__ATOMIC_ACQUIRE, "agent");
            asm volatile("s_waitcnt vmcnt(0)" ::: "memory");
        }
    }
    __syncthreads();
}

#define AS4 __attribute__((address_space(4)))
struct KA {
    const AS4 char* ka;
    static __device__ __forceinline__ KA fresh() { KA k; k.ka = (const AS4 char*)__builtin_amdgcn_kernarg_segment_ptr(); asm volatile("" : "+s"(k.ka)); return k; }
    __device__ __forceinline__ const float* in(int i) const { return *(const float* const AS4*)(ka + 8 * i); }
    __device__ __forceinline__ float* out() const { return *(float* const AS4*)(ka + 160); }
    __device__ __forceinline__ unsigned char* ws() const { return *(unsigned char* const AS4*)(ka + 168); }
    __device__ __forceinline__ unsigned* ctl() const { return (unsigned*)(ws() + WS_CTL); }
    __device__ __forceinline__ bf16* WinT() const { return (bf16*)(ws() + WS_WIN); }
    __device__ __forceinline__ bf16* WoutT() const { return (bf16*)(ws() + WS_WOUT); }
    __device__ __forceinline__ bf16* WguT() const { return (bf16*)(ws() + WS_WGU); }
    __device__ __forceinline__ bf16* WdT() const { return (bf16*)(ws() + WS_WD); }
    __device__ __forceinline__ bf16* XN() const { return (bf16*)(ws() + WS_XN); }
    __device__ __forceinline__ bf16* P() const { return (bf16*)(ws() + WS_P); }
    __device__ __forceinline__ bf16* H1() const { return (bf16*)(ws() + WS_P); }
    __device__ __forceinline__ bf16* Y() const { return (bf16*)(ws() + WS_Y); }
    __device__ __forceinline__ float* Sst() const { return (float*)(ws() + WS_S); }
    __device__ __forceinline__ float* dec() const { return (float*)(ws() + WS_DEC); }
    __device__ __forceinline__ int* eid() const { return (int*)(ws() + WS_MISC); }
    __device__ __forceinline__ float* ew() const { return (float*)(ws() + WS_MISC + 131072); }
    __device__ __forceinline__ int* slot_tok() const { return (int*)(ws() + WS_MISC + 2 * 131072); }
    __device__ __forceinline__ int* slot_of() const { return (int*)(ws() + WS_MISC + 3 * 131072); }
};
struct Frame {
    LAS unsigned char* lds; float* smem;
    int G, bx;
};
__device__ __forceinline__ int fresh_tid() { int t = threadIdx.x; asm volatile("" : "+v"(t)); return t; }
#define PHASE_TID const int tid = fresh_tid(), lane = tid & 63, wave = __builtin_amdgcn_readfirstlane(tid >> 6); (void)lane; (void)wave

__device__ __forceinline__ float wave_sum(float v) {
#pragma unroll
    for (int o = 1; o < 64; o <<= 1) v += __shfl_xor(v, o);
    return v;
}

__device__ __forceinline__ void transpose_item(const float* W, int ldw, int nvalid, int k0, int n0, bf16* WT, int ldt, int drow0, LAS float* scr, int lane) {
    const int nl = lane & 31;
#pragma unroll 8
    for (int i = 0; i < 32; ++i) { const int kk = 2 * i + (lane >> 5); scr[kk * 33 + nl] = (nl < nvalid) ? W[(size_t)(k0 + kk) * ldw + n0 + nl] : 0.f; }
    asm volatile("s_waitcnt lgkmcnt(0)" ::: "memory");
    const int c = lane & 7;
#pragma unroll
    for (int j = 0; j < 4; ++j) { const int n = (lane >> 3) + 8 * j; const LAS float* s = scr + (8 * c) * 33 + n;
        v4u o; o.x = pk2(s[0 * 33], s[1 * 33]); o.y = pk2(s[2 * 33], s[3 * 33]); o.z = pk2(s[4 * 33], s[5 * 33]); o.w = pk2(s[6 * 33], s[7 * 33]);
        if (n < nvalid) *(GAS v4u*)(WT + (size_t)(drow0 + n) * ldt + k0 + 8 * c) = o; }
    asm volatile("s_waitcnt lgkmcnt(0)" ::: "memory");
}
__device__ __forceinline__ void rms_row_to_bf16(const float* xrow, const float* gain, bf16* orow, int lane) {
    const f32x4* xr = (const f32x4*)xrow + lane;
    f32x4 v[4]; float s = 0.f;
#pragma unroll
    for (int j = 0; j < 4; ++j) { v[j] = xr[64 * j]; s += (v[j].x * v[j].x + v[j].y * v[j].y) + (v[j].z * v[j].z + v[j].w * v[j].w); }
    const float rs = rsqrtf(wave_sum(s) * (1.f / D) + EPS);
    v2u* o8 = (v2u*)orow + lane;
#pragma unroll
    for (int j = 0; j < 4; ++j) { const f32x4 g = ((const f32x4*)gain)[lane + 64 * j]; v2u w; w.x = pk2(v[j].x * rs * g.x, v[j].y * rs * g.y); w.y = pk2(v[j].z * rs * g.z, v[j].w * rs * g.w); o8[64 * j] = w; }
}
__device__ __forceinline__ void p0_prologue(Frame& F) {
    const KA K = KA::fresh(); PHASE_TID;
    LAS float* scr = (LAS float*)(F.lds + wave * 16384);
    const int gw = F.bx * NWAVES + wave, NGW = F.G * NWAVES;
    constexpr int I_IN = 16 * 89, I_OUT = 16 * 32, I_G = 32 * 16 * 8, I_D = 32 * 4 * 32, I_L = I_IN + I_OUT + 2 * I_G + I_D;
    for (int it = gw; it < DEPTH * I_L; it += NGW) {
        const int l = it / I_L; int r = it % I_L;
        if (r < I_IN) { const int kb = r / 89, nb = r % 89; const int nv = (nb == 88) ? 16 : 32;
            transpose_item(K.in(2) + (size_t)l * D * DIN, DIN, nv, kb * 64, nb * 32, K.WinT() + (size_t)l * PLD * D, D, nb * 32, scr, lane); continue; }
        r -= I_IN;
        if (r < I_OUT) { const int kb = r / 32, nb = r % 32;
            transpose_item(K.in(10) + (size_t)l * D * D, D, 32, kb * 64, nb * 32, K.WoutT() + (size_t)l * D * D, D, nb * 32, scr, lane); continue; }
        r -= I_OUT;
        if (r < 2 * I_G) { const int sel = r / I_G; r %= I_G; const int e = r / 128, kb = (r % 128) / 8, nb = r % 8; const int n0 = nb * 32;
            const float* W = K.in(16 + sel) + ((size_t)l * NE + e) * D * DE;
            transpose_item(W, DE, 32, kb * 64, n0, K.WguT() + ((size_t)l * NE + e) * 512 * D, D, (n0 >> 7) * 256 + sel * 128 + (n0 & 127), scr, lane); continue; }
        r -= 2 * I_G;
        { const int e = r / 128, kb = (r % 128) / 32, nb = r % 32;
            transpose_item(K.in(18) + ((size_t)l * NE + e) * DE * D, D, 32, kb * 64, nb * 32, K.WdT() + ((size_t)l * NE + e) * D * DE, DE, nb * 32, scr, lane); }
    }
    for (int i = F.bx * NT + tid; i < DEPTH * 240 * 128; i += F.G * NT) { const int l = i / (240 * 128), rr = (i / 128) % 240, c = i % 128;
        *(GAS v4u*)(K.WinT() + ((size_t)l * PLD + DIN + rr) * D + c * 8) = (v4u){0u, 0u, 0u, 0u}; }
    for (int m = gw; m < T; m += NGW) rms_row_to_bf16(K.in(0) + (size_t)m * D, K.in(1), K.XN() + (size_t)m * D, lane);
}

__device__ __forceinline__ void gla_cumdecay(Frame& F, const KA& K, int tid, int l, int h, int t0, float* bb) {
    const float* wup = K.in(3) + (size_t)l * 16 * 256; const float* bgk = K.in(4) + (size_t)l * 256;
    for (int e = tid; e < 64 * 64; e += NT) {
        const int c = e >> 6, d = e & 63;
        const bf16* gl = K.P() + (size_t)(t0 + c) * PLD + C_GK;
        float a = bgk[h * 64 + d];
#pragma unroll
        for (int r = 0; r < 16; ++r) a += bf2f(gl[r]) * wup[r * 256 + h * 64 + d];
        bb[c * 64 + d] = log_sigmoid(a) * (1.0f / 16.0f);
    }
    __syncthreads();
    if (tid < 64) { float run = 0.f; for (int c = 0; c < 64; ++c) { run += bb[c * 64 + tid]; bb[c * 64 + tid] = run; } }
    __syncthreads();
}
__device__ __forceinline__ void phase_gla_kv(Frame& F, int l) {
    const KA K = KA::fresh(); PHASE_TID;
    float* bb = F.smem; float* kd = F.smem + 4096;
#pragma unroll 1
    for (int ci = F.bx; ci < NB * GH * GN; ci += F.G) {
        const int b = ci / (GH * GN), h = (ci / GN) % GH, n = ci % GN, t0 = b * S + n * GC;
        __syncthreads();
        gla_cumdecay(F, K, tid, l, h, t0, bb);
        for (int e = tid; e < 4096; e += NT) { const int c = e >> 6, d = e & 63; kd[e] = bf2f(K.P()[(size_t)(t0 + c) * PLD + C_K + h * 64 + d]) * expf(bb[63 * 64 + d] - bb[e]); }
        __syncthreads();
        const int d = tid >> 3, v0 = (tid & 7) * 16;
        float acc[16];
#pragma unroll
        for (int j = 0; j < 16; ++j) acc[j] = 0.f;
#pragma unroll 2
        for (int c = 0; c < 64; ++c) {
            const float kk = kd[c * 64 + d];
            const v4u* vr = (const v4u*)(K.P() + (size_t)(t0 + c) * PLD + C_V + h * 128 + v0);
            float f[8]; unpack8(vr[0], f);
#pragma unroll
            for (int j = 0; j < 8; ++j) acc[j] += kk * f[j];
            unpack8(vr[1], f);
#pragma unroll
            for (int j = 0; j < 8; ++j) acc[8 + j] += kk * f[j];
        }
        f32x4* o = (f32x4*)(K.Sst() + ((size_t)ci * 64 + d) * 128 + v0);
#pragma unroll
        for (int j = 0; j < 4; ++j) o[j] = (f32x4){acc[4 * j], acc[4 * j + 1], acc[4 * j + 2], acc[4 * j + 3]};
        if (tid < 64) K.dec()[(size_t)ci * 64 + tid] = expf(bb[63 * 64 + tid]);
    }
}
__device__ __forceinline__ void phase_gla_scan(Frame& F) {
    const KA K = KA::fresh(); PHASE_TID;
#pragma unroll 1
    for (int e = F.bx * NT + tid; e < NB * GH * 64 * 128; e += F.G * NT) {
        const int bh = e >> 13, d = (e >> 7) & 63, v = e & 127;
        float st = 0.f;
#pragma unroll 4
        for (int n = 0; n < GN; ++n) {
            const size_t ci = (size_t)bh * GN + n;
            float* ptr = K.Sst() + (ci * 64 + d) * 128 + v;
            const float kvv = *ptr; *ptr = st;
            st = K.dec()[ci * 64 + d] * st + kvv;
        }
    }
}
__device__ __forceinline__ void phase_gla_out(Frame& F, int l) {
    const KA K = KA::fresh(); PHASE_TID;
    float* bb = F.smem; float* qd = F.smem + 4096; float* ki = F.smem + 4096 + 64 * 65; float* sc = bb;
    const float* gnorm = K.in(5) + (size_t)l * 128;
#pragma unroll 1
    for (int ci = F.bx; ci < NB * GH * GN; ci += F.G) {
        const int b = ci / (GH * GN), h = (ci / GN) % GH, n = ci % GN, t0 = b * S + n * GC;
        __syncthreads();
        gla_cumdecay(F, K, tid, l, h, t0, bb);
        for (int e = tid; e < 4096; e += NT) {
            const int c = e >> 6, d = e & 63; const float bv = bb[e];
            const bf16* row = K.P() + (size_t)(t0 + c) * PLD;
            qd[c * 65 + d] = bf2f(row[C_Q + h * 64 + d]) * 0.125f * expf(bv);
            ki[c * 65 + d] = bf2f(row[C_K + h * 64 + d]) * expf(-bv);
        }
        __syncthreads();
        {
            const int c = tid >> 3, s0 = (tid & 7) * 8;
            float a[8];
#pragma unroll
            for (int j = 0; j < 8; ++j) a[j] = 0.f;
#pragma unroll 4
            for (int d = 0; d < 64; ++d) { const float qv = qd[c * 65 + d];
#pragma unroll
                for (int j = 0; j < 8; ++j) a[j] += qv * ki[(s0 + j) * 65 + d]; }
#pragma unroll
            for (int j = 0; j < 8; ++j) sc[c * 64 + s0 + j] = (s0 + j <= c) ? a[j] : 0.f;
        }
        __syncthreads();
        const int c = tid >> 3, v0 = (tid & 7) * 16;
        float acc[16];
#pragma unroll
        for (int j = 0; j < 16; ++j) acc[j] = 0.f;
#pragma unroll 2
        for (int s = 0; s <= c; ++s) {
            const float w = sc[c * 64 + s];
            const v4u* vr = (const v4u*)(K.P() + (size_t)(t0 + s) * PLD + C_V + h * 128 + v0);
            float f[8]; unpack8(vr[0], f);
#pragma unroll
            for (int j = 0; j < 8; ++j) acc[j] += w * f[j];
            unpack8(vr[1], f);
#pragma unroll
            for (int j = 0; j < 8; ++j) acc[8 + j] += w * f[j];
        }
#pragma unroll 2
        for (int d = 0; d < 64; ++d) {
            const float w = qd[c * 65 + d];
            const f32x4* sr = (const f32x4*)(K.Sst() + ((size_t)ci * 64 + d) * 128 + v0);
#pragma unroll
            for (int j = 0; j < 4; ++j) { const f32x4 v4 = sr[j]; acc[4 * j] += w * v4.x; acc[4 * j + 1] += w * v4.y; acc[4 * j + 2] += w * v4.z; acc[4 * j + 3] += w * v4.w; }
        }
        float ss = 0.f;
#pragma unroll
        for (int j = 0; j < 16; ++j) ss += acc[j] * acc[j];
        ss += __shfl_xor(ss, 1); ss += __shfl_xor(ss, 2); ss += __shfl_xor(ss, 4);
        const float rs = rsqrtf(ss * (1.0f / 128.0f) + EPS);
        const v4u* gr = (const v4u*)(K.P() + (size_t)(t0 + c) * PLD + C_G + h * 128 + v0);
        float g0[8], g1[8]; unpack8(gr[0], g0); unpack8(gr[1], g1);
        float o[16];
#pragma unroll
        for (int j = 0; j < 8; ++j) { o[j] = acc[j] * rs * gnorm[v0 + j] * silu(g0[j]); o[8 + j] = acc[8 + j] * rs * gnorm[v0 + 8 + j] * silu(g1[j]); }
        v4u* op = (v4u*)(K.XN() + (size_t)(t0 + c) * D + h * 128 + v0);
        op[0] = (v4u){pk2(o[0], o[1]), pk2(o[2], o[3]), pk2(o[4], o[5]), pk2(o[6], o[7])};
        op[1] = (v4u){pk2(o[8], o[9]), pk2(o[10], o[11]), pk2(o[12], o[13]), pk2(o[14], o[15])};
    }
}
__device__ __forceinline__ void phase_gmlp(Frame& F, int l) {
    const KA K = KA::fresh(); PHASE_TID;
    float* vs = F.smem;
    const float* gn = K.in(6) + (size_t)l * 256; const float* wsp = K.in(7) + (size_t)l * MH * 128 * 128; const float* bsp = K.in(8) + (size_t)l * MH * 128;
#pragma unroll 1
    for (int u = F.bx; u < NB * MN * MH; u += F.G) {
        const int b = u / (MN * MH), n = (u / MH) % MN, h = u % MH, t0 = b * S + n * MC;
        __syncthreads();
        const int s = tid >> 2, d0 = (tid & 3) * 16;
        {
            const v4u* vr = (const v4u*)(K.P() + (size_t)(t0 + s) * PLD + C_VG + h * 64 + d0);
            float g[16]; { float f[8]; unpack8(vr[0], f);
#pragma unroll
                for (int j = 0; j < 8; ++j) g[j] = gelu_tanh(f[j]);
                unpack8(vr[1], f);
#pragma unroll
                for (int j = 0; j < 8; ++j) g[8 + j] = gelu_tanh(f[j]); }
            float ss = 0.f;
#pragma unroll
            for (int j = 0; j < 16; ++j) ss += g[j] * g[j];
            ss += __shfl_xor(ss, 1); ss += __shfl_xor(ss, 2);
            const float rs = rsqrtf(ss * (1.0f / 64.0f) + EPS);
#pragma unroll
            for (int j = 0; j < 16; ++j) vs[s * 64 + d0 + j] = g[j] * rs * gn[h * 64 + d0 + j];
        }
        __syncthreads();
        const int t = s;
        float acc[16];
#pragma unroll
        for (int j = 0; j < 16; ++j) acc[j] = 0.f;
        const float* wr = wsp + ((size_t)h * 128 + t) * 128;
#pragma unroll 2
        for (int s2 = 0; s2 <= t; ++s2) { const float w = wr[s2];
#pragma unroll
            for (int j = 0; j < 16; ++j) acc[j] += w * vs[s2 * 64 + d0 + j]; }
        const float bias = bsp[h * 128 + t];
        const v4u* ur = (const v4u*)(K.P() + (size_t)(t0 + t) * PLD + C_U + h * 64 + d0);
        float u0[8], u1[8]; unpack8(ur[0], u0); unpack8(ur[1], u1);
        float o[16];
#pragma unroll
        for (int j = 0; j < 8; ++j) { o[j] = gelu_tanh(u0[j]) * (acc[j] + bias); o[8 + j] = gelu_tanh(u1[j]) * (acc[8 + j] + bias); }
        v4u* op = (v4u*)(K.XN() + (size_t)(t0 + t) * D + 512 + h * 64 + d0);
        op[0] = (v4u){pk2(o[0], o[1]), pk2(o[2], o[3]), pk2(o[4], o[5]), pk2(o[6], o[7])};
        op[1] = (v4u){pk2(o[8], o[9]), pk2(o[10], o[11]), pk2(o[12], o[13]), pk2(o[14], o[15])};
    }
}
__device__ __forceinline__ void phase_conv(Frame& F, int l) {
    const KA K = KA::fresh(); PHASE_TID;
    const float* wc = K.in(9) + (size_t)l * 3 * 256;
#pragma unroll 1
    for (int e = F.bx * NT + tid; e < T * 32; e += F.G * NT) {
        const int t = e >> 5, c0 = (e & 31) * 8, tl = t % S;
        const bf16* row = K.P() + (size_t)t * PLD;
        float y[8], xi[8], cg[8], bg[8];
        unpack8(*(const v4u*)(row + C_XI + c0), xi); unpack8(*(const v4u*)(row + C_CG + c0), cg); unpack8(*(const v4u*)(row + C_BG + c0), bg);
#pragma unroll
        for (int j = 0; j < 8; ++j) y[j] = wc[2 * 256 + c0 + j] * cg[j] * xi[j];
        if (tl >= 1) { unpack8(*(const v4u*)(row - PLD + C_XI + c0), xi); unpack8(*(const v4u*)(row - PLD + C_CG + c0), cg);
#pragma unroll
            for (int j = 0; j < 8; ++j) y[j] += wc[1 * 256 + c0 + j] * cg[j] * xi[j]; }
        if (tl >= 2) { unpack8(*(const v4u*)(row - 2 * PLD + C_XI + c0), xi); unpack8(*(const v4u*)(row - 2 * PLD + C_CG + c0), cg);
#pragma unroll
            for (int j = 0; j < 8; ++j) y[j] += wc[0 * 256 + c0 + j] * cg[j] * xi[j]; }
#pragma unroll
        for (int j = 0; j < 8; ++j) y[j] *= bg[j];
        *(v4u*)(K.XN() + (size_t)t * D + 768 + c0) = (v4u){pk2(y[0], y[1]), pk2(y[2], y[3]), pk2(y[4], y[5]), pk2(y[6], y[7])};
    }
}
__device__ __forceinline__ void phase_norm_router(Frame& F, int l) {
    const KA K = KA::fresh(); PHASE_TID;
    const float* gain = K.in(11) + (size_t)l * D;
    const float* wrg = K.in(12) + (size_t)l * D * 4; const float* brg = K.in(13) + (size_t)l * 4;
    const float* wre = K.in(14) + (size_t)l * D * 32; const float* bre = K.in(15) + (size_t)l * 32;
    int* cnt = (int*)(K.ctl() + CW_CNT + 64 * l);
#pragma unroll 1
    for (int t = F.bx * NWAVES + wave; t < T; t += F.G * NWAVES) {
        const f32x4* xr = (const f32x4*)(K.out() + (size_t)t * D) + lane;
        f32x4 v[4]; float s = 0.f;
#pragma unroll
        for (int j = 0; j < 4; ++j) { v[j] = xr[64 * j]; s += (v[j].x * v[j].x + v[j].y * v[j].y) + (v[j].z * v[j].z + v[j].w * v[j].w); }
        const float rs = rsqrtf(wave_sum(s) * (1.f / D) + EPS);
        v2u* o8 = (v2u*)(K.XN() + (size_t)t * D) + lane;
        float acc[36];
#pragma unroll
        for (int j = 0; j < 36; ++j) acc[j] = 0.f;
#pragma unroll
        for (int j = 0; j < 4; ++j) {
            const f32x4 g = ((const f32x4*)gain)[lane + 64 * j];
            const float hv[4] = {v[j].x * rs * g.x, v[j].y * rs * g.y, v[j].z * rs * g.z, v[j].w * rs * g.w};
            v2u w; w.x = pk2(hv[0], hv[1]); w.y = pk2(hv[2], hv[3]); o8[64 * j] = w;
#pragma unroll
            for (int i = 0; i < 4; ++i) {
                const int k = 4 * lane + 256 * j + i; const float xv = hv[i];
                const f32x4 g4 = *(const f32x4*)(wrg + (size_t)k * 4);
                acc[0] += xv * g4.x; acc[1] += xv * g4.y; acc[2] += xv * g4.z; acc[3] += xv * g4.w;
                const f32x4* e4 = (const f32x4*)(wre + (size_t)k * 32);
#pragma unroll
                for (int q = 0; q < 8; ++q) { const f32x4 w4 = e4[q]; acc[4 + 4 * q] += xv * w4.x; acc[5 + 4 * q] += xv * w4.y; acc[6 + 4 * q] += xv * w4.z; acc[7 + 4 * q] += xv * w4.w; }
            }
        }
#pragma unroll
        for (int j = 0; j < 36; ++j) acc[j] = wave_sum(acc[j]);
        if (lane == 0) {
            float gl[4]; int gt = 0;
#pragma unroll
            for (int j = 0; j < 4; ++j) gl[j] = acc[j] + brg[j];
            float gmax = gl[0];
#pragma unroll
            for (int j = 1; j < 4; ++j) if (gl[j] > gmax) { gmax = gl[j]; gt = j; }
            float gs = 0.f;
#pragma unroll
            for (int j = 0; j < 4; ++j) gs += expf(gl[j] - gmax);
            const float gw = 1.0f / gs;
            float el[8];
#pragma unroll
            for (int j = 0; j < 8; ++j) { float vv = 0.f;
#pragma unroll
                for (int g = 0; g < 4; ++g) if (g == gt) vv = acc[4 + g * 8 + j] + bre[g * 8 + j];
                el[j] = vv; }
            int i0 = 0; float m0 = el[0];
#pragma unroll
            for (int j = 1; j < 8; ++j) if (el[j] > m0) { m0 = el[j]; i0 = j; }
            int i1 = -1; float m1 = -INFINITY;
#pragma unroll
            for (int j = 0; j < 8; ++j) if (j != i0 && el[j] > m1) { m1 = el[j]; i1 = j; }
            const float e1 = expf(m1 - m0);
            const float w0 = gw / (1.0f + e1), w1 = gw * e1 / (1.0f + e1);
            const int e0i = gt * 8 + i0, e1i = gt * 8 + i1;
            K.eid()[2 * t] = e0i; K.eid()[2 * t + 1] = e1i; K.ew()[2 * t] = w0; K.ew()[2 * t + 1] = w1;
            atomicAdd(&cnt[e0i], 1); atomicAdd(&cnt[e1i], 1);
        }
    }
}
__device__ __forceinline__ void phase_scatter(Frame& F, int l) {
    const KA K = KA::fresh(); PHASE_TID;
    int* cnt = (int*)(K.ctl() + CW_CNT + 64 * l); int* cursor = (int*)(K.ctl() + CW_CNT + 128 + 64 * l);
    int* offs = (int*)F.smem;
    __syncthreads();
    if (tid == 0) { int a = 0; for (int e = 0; e < NE; ++e) { offs[e] = a; a += cnt[e]; } }
    __syncthreads();
    for (int a = F.bx * NT + tid; a < 2 * T; a += F.G * NT) {
        const int e = K.eid()[a];
        const int pos = offs[e] + atomicAdd(&cursor[e], 1);
        K.slot_tok()[pos] = a >> 1; K.slot_of()[a] = pos;
    }
    __syncthreads();
}
template <bool DUAL>
__device__ __forceinline__ void gemm_core(const bf16* A, const int* rowoff, int K, const float* B0, const float* B1, int ldb, int n0,
                                          float (&acc0)[4][4], float (&acc1)[4][4], float* As, float* Bs0, float* Bs1) {
    const int tid = threadIdx.x, tx = tid & 15, ty = tid >> 4;
    const int ar = tid >> 2, ak = (tid & 3) * 4;
    const int bk = (tid >> 4) & 15, bn = (tid & 15) * 4;
    const long aoff = rowoff[ar];
#pragma unroll
    for (int i = 0; i < 4; ++i)
#pragma unroll
        for (int j = 0; j < 4; ++j) { acc0[i][j] = 0.f; acc1[i][j] = 0.f; }
#pragma unroll 1
    for (int k0 = 0; k0 < K; k0 += 16) {
        v2u av = (v2u){0u, 0u};
        if (aoff >= 0) av = *(const v2u*)(A + aoff + k0 + ak);
        f32x4 bv0 = (f32x4){0.f, 0.f, 0.f, 0.f}, bv1 = bv0;
        if (tid < 256) { bv0 = *(const f32x4*)(B0 + (size_t)(k0 + bk) * ldb + n0 + bn); if (DUAL) bv1 = *(const f32x4*)(B1 + (size_t)(k0 + bk) * ldb + n0 + bn); }
        __syncthreads();
        As[(ak + 0) * 132 + ar] = bflo(av.x); As[(ak + 1) * 132 + ar] = bfhi(av.x); As[(ak + 2) * 132 + ar] = bflo(av.y); As[(ak + 3) * 132 + ar] = bfhi(av.y);
        if (tid < 256) { *(f32x4*)(Bs0 + bk * 64 + bn) = bv0; if (DUAL) *(f32x4*)(Bs1 + bk * 64 + bn) = bv1; }
        __syncthreads();
#pragma unroll
        for (int kk = 0; kk < 16; ++kk) {
            const f32x4 a4 = *(const f32x4*)(As + kk * 132 + ty * 4);
            const f32x4 b4 = *(const f32x4*)(Bs0 + kk * 64 + tx * 4);
#pragma unroll
            for (int i = 0; i < 4; ++i)
#pragma unroll
                for (int j = 0; j < 4; ++j) acc0[i][j] += a4[i] * b4[j];
            if (DUAL) {
                const f32x4 c4 = *(const f32x4*)(Bs1 + kk * 64 + tx * 4);
#pragma unroll
                for (int i = 0; i < 4; ++i)
#pragma unroll
                    for (int j = 0; j < 4; ++j) acc1[i][j] += a4[i] * c4[j];
            }
        }
    }
}
template <int MODE>
__device__ __forceinline__ void phase_moe_ref(Frame& F, int l) {
    const KA K = KA::fresh(); PHASE_TID;
    float* As = F.smem; float* Bs0 = F.smem + 16 * 132; float* Bs1 = Bs0 + 16 * 64; int* rowoff = (int*)(Bs1 + 16 * 64); int* offs = rowoff + 128; int* toff = offs + 33;
    int* cnt = (int*)(K.ctl() + CW_CNT + 64 * l);
    const int tx = tid & 15, ty = tid >> 4;
    __syncthreads();
    if (tid == 0) { int a = 0, tt = 0; for (int e = 0; e < NE; ++e) { offs[e] = a; toff[e] = tt; const int c = cnt[e]; a += c; tt += (c + 127) / 128; } offs[NE] = a; toff[NE] = tt; }
    __syncthreads();
    constexpr int N = (MODE == 1) ? DE : D, KD = (MODE == 1) ? D : DE, NTN = N / 64;
    const int ntiles = toff[NE] * NTN;
#pragma unroll 1
    for (int t = F.bx; t < ntiles; t += F.G) {
        const int rt = t / NTN, tn = t % NTN;
        int e = 0;
        for (int j = 1; j < NE; ++j) if (toff[j] <= rt) e = j;
        const int r0 = offs[e] + (rt - toff[e]) * 128, rend = offs[e + 1];
        __syncthreads();
        if (tid < 128) { const int r = r0 + tid; rowoff[tid] = (r < rend) ? ((MODE == 1) ? K.slot_tok()[r] * D : r * DE) : -1; }
        __syncthreads();
        float acc0[4][4], acc1[4][4];
        if (MODE == 1) {
            const float* Wg = K.in(16) + ((size_t)l * NE + e) * D * DE; const float* Wu = K.in(17) + ((size_t)l * NE + e) * D * DE;
            gemm_core<true>(K.XN(), rowoff, KD, Wg, Wu, DE, tn * 64, acc0, acc1, As, Bs0, Bs1);
        } else {
            const float* Wd = K.in(18) + ((size_t)l * NE + e) * DE * D;
            gemm_core<false>(K.H1(), rowoff, KD, Wd, nullptr, D, tn * 64, acc0, acc1, As, Bs0, nullptr);
        }
#pragma unroll
        for (int i = 0; i < 4; ++i) {
            const int r = r0 + ty * 4 + i;
            if (r < rend) {
                v2u o;
                if (MODE == 1) { o.x = pk2(silu(acc0[i][0]) * acc1[i][0], silu(acc0[i][1]) * acc1[i][1]); o.y = pk2(silu(acc0[i][2]) * acc1[i][2], silu(acc0[i][3]) * acc1[i][3]);
                    *(v2u*)(K.H1() + (size_t)r * DE + tn * 64 + tx * 4) = o; }
                else { o.x = pk2(acc0[i][0], acc0[i][1]); o.y = pk2(acc0[i][2], acc0[i][3]); *(v2u*)(K.Y() + (size_t)r * D + tn * 64 + tx * 4) = o; }
            }
        }
    }
    __syncthreads();
}
__device__ __forceinline__ void phase_combine(Frame& F, int l) {
    const KA K = KA::fresh(); PHASE_TID;
    const bool last = (l == DEPTH - 1);
    const float* gain = last ? K.in(19) : (K.in(1) + (size_t)(l + 1) * D);
#pragma unroll 1
    for (int t = F.bx * NWAVES + wave; t < T; t += F.G * NWAVES) {
        const int s0 = K.slot_of()[2 * t], s1 = K.slot_of()[2 * t + 1]; const float w0 = K.ew()[2 * t], w1 = K.ew()[2 * t + 1];
        f32x4* xr = (f32x4*)(K.out() + (size_t)t * D) + lane;
        const v2u* y0 = (const v2u*)(K.Y() + (size_t)s0 * D) + lane; const v2u* y1 = (const v2u*)(K.Y() + (size_t)s1 * D) + lane;
        f32x4 v[4]; float s = 0.f;
#pragma unroll
        for (int j = 0; j < 4; ++j) { v[j] = xr[64 * j]; const v2u a = y0[64 * j], b = y1[64 * j];
            v[j].x += w0 * bflo(a.x) + w1 * bflo(b.x); v[j].y += w0 * bfhi(a.x) + w1 * bfhi(b.x); v[j].z += w0 * bflo(a.y) + w1 * bflo(b.y); v[j].w += w0 * bfhi(a.y) + w1 * bfhi(b.y);
            s += (v[j].x * v[j].x + v[j].y * v[j].y) + (v[j].z * v[j].z + v[j].w * v[j].w); }
        const float rs = rsqrtf(wave_sum(s) * (1.f / D) + EPS);
        if (last) {
#pragma unroll
            for (int j = 0; j < 4; ++j) { const f32x4 g = ((const f32x4*)gain)[lane + 64 * j]; xr[64 * j] = (f32x4){v[j].x * rs * g.x, v[j].y * rs * g.y, v[j].z * rs * g.z, v[j].w * rs * g.w}; }
        } else {
            v2u* o8 = (v2u*)(K.XN() + (size_t)t * D) + lane;
#pragma unroll
            for (int j = 0; j < 4; ++j) { xr[64 * j] = v[j]; const f32x4 g = ((const f32x4*)gain)[lane + 64 * j];
                v2u w; w.x = pk2(v[j].x * rs * g.x, v[j].y * rs * g.y); w.y = pk2(v[j].z * rs * g.z, v[j].w * rs * g.w); o8[64 * j] = w; }
        }
    }
}

struct Args { const float* in[20]; float* out; unsigned char* ws; };
__global__ void __launch_bounds__(NT, 2) fwd_kernel(Args args) {
    extern __shared__ __attribute__((aligned(16))) unsigned char lds_raw[];
    cg::grid_group grid = cg::this_grid();
    Frame F;
    F.lds = (LAS unsigned char*)lds_raw; F.smem = (float*)lds_raw;
    F.G = gridDim.x; F.bx = blockIdx.x;
    volatile LAS unsigned* MISC = (volatile LAS unsigned*)(F.lds + MISC_OFF);
    for (int u = threadIdx.x; u < (LDS_BYTES - LDSCTL_OFF) / 4; u += NT) ((LAS unsigned*)(F.lds + LDSCTL_OFF))[u] = 0u;
    __syncthreads();
    XcdBarrier bar; { const KA K = KA::fresh(); bar = xcd_barrier_post(K.ctl() + CW_BAR, MISC + 8); }
#define GRID_BAR() xcd_barrier(bar)

    p0_prologue(F);
    grid.sync();
    for (int l = 0; l < DEPTH; ++l) {
        {
            const KA K = KA::fresh(); PHASE_TID;
            pg8::Gemm g{K.XN(), K.WinT() + (size_t)l * PLD * D, T, PLD, D}; pg8::StaticOrder So; So.init(T, PLD, F.G, F.bx);
            pg8::EpiBf16Plain E{K.P(), PLD};
            pg8::gemm_phase<pg8::EpiBf16Plain, pg8::StaticOrder, PG8_ALIGN, PG8_SP2>(F.lds, g, So, E);
        }
        GRID_BAR();
        phase_gla_kv(F, l);
        phase_gmlp(F, l);
        phase_conv(F, l);
        GRID_BAR();
        phase_gla_scan(F);
        GRID_BAR();
        phase_gla_out(F, l);
        GRID_BAR();
        {
            const KA K = KA::fresh(); PHASE_TID;
            pg8::Gemm g{K.XN(), K.WoutT() + (size_t)l * D * D, T, D, D}; pg8::StaticOrder So; So.init(T, D, F.G, F.bx);
            pg8::EpiF32Res E{K.out(), (l == 0) ? K.in(0) : K.out(), D};
            pg8::gemm_phase<pg8::EpiF32Res, pg8::StaticOrder, PG8_ALIGN, PG8_SP2>(F.lds, g, So, E);
        }
        GRID_BAR();
        phase_norm_router(F, l);
        GRID_BAR();
        phase_scatter(F, l);
        GRID_BAR();
        phase_moe_ref<1>(F, l);
        GRID_BAR();
        phase_moe_ref<2>(F, l);
        GRID_BAR();
        phase_combine(F, l);
        if (l + 1 < DEPTH) GRID_BAR();
    }
}

extern "C" void kernel_launch(void* const* d_in, const int* in_sizes, int n_in, void* d_out, int out_size, void* d_ws, size_t ws_size, hipStream_t stream) {
    static int grid_blocks = 0;
    if (!grid_blocks) {
        int dev = 0, cus = 0, per_cu = 0;
        (void)hipGetDevice(&dev);
        (void)hipDeviceGetAttribute(&cus, hipDeviceAttributeMultiprocessorCount, dev);
        (void)hipFuncSetAttribute((const void*)fwd_kernel, hipFuncAttributeMaxDynamicSharedMemorySize, LDS_BYTES);
        (void)hipOccupancyMaxActiveBlocksPerMultiprocessor(&per_cu, fwd_kernel, NT, LDS_BYTES);
        if (per_cu < 1) { fprintf(stderr, "kernel_launch: occupancy query says %d blocks/CU\n", per_cu); per_cu = 1; }
        grid_blocks = cus;
        if (ws_size < WS_END) { fprintf(stderr, "kernel_launch: workspace too small (%zu < %zu)\n", ws_size, (size_t)WS_END); grid_blocks = -1; }
    }
    if (grid_blocks < 0) return;
    (void)hipMemsetAsync((char*)d_ws + WS_CTL, 0, CTL_BYTES, stream);
    Args a{};
    for (int i = 0; i < 20; ++i) a.in[i] = (const float*)d_in[i];
    a.out = (float*)d_out; a.ws = (unsigned char*)d_ws;
    void* args[] = {&a};
    hipError_t e = hipLaunchCooperativeKernel((void*)fwd_kernel, dim3(grid_blocks), dim3(NT), args, LDS_BYTES, stream);
    if (e != hipSuccess) fprintf(stderr, "cooperative launch failed: %s (grid %d)\n", hipGetErrorString(e), grid_blocks);
}
```

```cpp
#include <hip/hip_runtime.h>
#include <hip/hip_cooperative_groups.h>
#include <cstdio>
#include <cstdint>
namespace cg = cooperative_groups;
__device__ __forceinline__ int fresh_lane() { unsigned m = 0xffffffffu; asm volatile("" : "+s"(m)); return (int)__builtin_amdgcn_mbcnt_hi(m, __builtin_amdgcn_mbcnt_lo(m, 0u)); }
__device__ __forceinline__ float shx(float v, int o) { return __int_as_float(__builtin_amdgcn_ds_bpermute((fresh_lane() ^ o) << 2, __float_as_int(v))); }
namespace pg8 {
#define PG8_LAS __attribute__((address_space(3)))
typedef unsigned short bf16_t;
typedef short bf16x8 __attribute__((ext_vector_type(8)));
typedef float f32x4 __attribute__((ext_vector_type(4)));
typedef unsigned u32x4 __attribute__((ext_vector_type(4)));
constexpr int BM = 256, BK = 64, HALF = 128, HTB = HALF * BK * 2  , STAGE_BYTES = 8 * HTB, NXCD = 8, WGM = 8;

__host__ __device__ __forceinline__ int lds_byte(int r, int c) { const int st = (r >> 4) * 2 + (c >> 5), rr = r & 15, cc = c & 31, ob = rr * 64 + cc * 2; return st * 1024 + (ob ^ (((ob >> 9) & 1) << 5)); }
__host__ __device__ __forceinline__ void stage_rc(int b, int& R, int& C) { const int st = b / 1024, sb = b % 1024, swz = sb ^ (((sb >> 9) & 1) << 5); R = (st >> 1) * 16 + swz / 64; C = (st & 1) * 32 + (swz % 64) / 2; }
__host__ __device__ __forceinline__ int perm32(int rho) { const int n = rho >> 4, i = rho & 15; return 8 * (i >> 2) + 4 * n + (i & 3); }

struct Unit { int pm, pn; };
struct Gemm { const bf16_t* A; const bf16_t* Bt; int M, N, K; };

struct StaticOrder {
    int nM, nN, nwg, G, c;
    __host__ __device__ void init(int M, int N, int G_, int c_) { nM = M / BM; nN = N / BM; nwg = nM * nN; G = G_; c = c_; }
    __host__ __device__ bool next(int i, Unit& u) const {
        const long L = (long)i * G + c; if (L >= nwg) return false;
        int wgid = (int)L; { const int q = nwg / NXCD, r = nwg % NXCD, xcd = wgid % NXCD, off = wgid / NXCD; wgid = (xcd < r ? xcd * (q + 1) : r * (q + 1) + (xcd - r) * q) + off; }
        const int nig = WGM * nN, gid = wgid / nig, fm = gid * WGM, gsz = (nM - fm) < WGM ? (nM - fm) : WGM;
        u.pm = fm + ((wgid % nig) % gsz); u.pn = (wgid % nig) / gsz; return true;
    }
    __device__ __forceinline__ void a_ready(const Unit&) const {}
    __device__ __forceinline__ void done(const Unit&) const {}
};


__device__ __forceinline__ unsigned cvt_pk_bf16(float lo, float hi) { unsigned r; asm volatile("v_cvt_pk_bf16_f32 %0, %1, %2" : "=v"(r) : "v"(lo), "v"(hi)); return r; }
struct EpiBf16Plain {
    static constexpr bool PERM = true, AFTER_DRAIN = false;
    bf16_t* O; int ldc;
    __device__ __forceinline__ void operator()(const f32x4 (&acc)[2][2][4][2], const Unit& u, int wr, int wc, int fr, int fq) const {
        const int row0 = u.pm * BM + wr * 64 + fr, col0 = u.pn * BM + wc * 32 + 8 * fq;
#pragma unroll
        for (int ai = 0; ai < 2; ++ai)
#pragma unroll
            for (int m = 0; m < 4; ++m) { bf16_t* rowp = O + (size_t)(row0 + ai * HALF + m * 16) * ldc + col0;
#pragma unroll
                for (int bj = 0; bj < 2; ++bj) { const f32x4 v0 = acc[ai][bj][m][0], v1 = acc[ai][bj][m][1];
                    u32x4 w; w.x = cvt_pk_bf16(v0[0], v0[1]); w.y = cvt_pk_bf16(v0[2], v0[3]); w.z = cvt_pk_bf16(v1[0], v1[1]); w.w = cvt_pk_bf16(v1[2], v1[3]);
                    *(u32x4*)(rowp + bj * HALF) = w; } }
    }
};
struct EpiF32Res {
    static constexpr bool PERM = false, AFTER_DRAIN = false;
    float* C; const float* R; int ldc;
    __device__ __forceinline__ void operator()(const f32x4 (&acc)[2][2][4][2], const Unit& u, int wr, int wc, int fr, int fq) const {
        const int row0 = u.pm * BM + wr * 64 + fr, col0 = u.pn * BM + wc * 32 + 4 * fq;
#pragma unroll
        for (int ai = 0; ai < 2; ++ai)
#pragma unroll
            for (int m = 0; m < 4; ++m) { const size_t off = (size_t)(row0 + ai * HALF + m * 16) * ldc + col0;
#pragma unroll
                for (int bj = 0; bj < 2; ++bj)
#pragma unroll
                    for (int n = 0; n < 2; ++n) { const f32x4 r = *(const f32x4*)(R + off + bj * HALF + n * 16); *(f32x4*)(C + off + bj * HALF + n * 16) = r + acc[ai][bj][m][n]; } }
    }
};
template <class Epi, class Sched, bool ALIGN_EPI = false, bool SP2 = false>
__device__ __forceinline__ void gemm_phase(PG8_LAS unsigned char* lds, const Gemm g, const Sched& S, const Epi& E, int wave_id) {
    asm volatile("" : "+s"(wave_id));
    const int lane = fresh_lane(), wid = wave_id, tid = wid * 64 + lane, wr = wid >> 2, wc = wid & 3, fr = lane & 15, fq = lane >> 4;
    const int K = g.K, nt = K / BK;
    unsigned voffA[2], voffB[2];
#pragma unroll
    for (int i = 0; i < 2; ++i) { int R, C; stage_rc(tid * 16 + i * 8192, R, C); const int Rb = Epi::PERM ? ((R & ~31) + perm32(R & 31)) : R;
        voffA[i] = (unsigned)(R * K + C) * 2u; voffB[i] = (unsigned)(Rb * K + C) * 2u; }
    const size_t kstep = (size_t)(BK * 2);
    const size_t hstep = (size_t)HALF * K * 2;
    const size_t tstep = 2 * hstep;
    const unsigned ldsw = (unsigned)wid * 1024u;
    const int aoff = lds_byte(wr * 64 + fr, fq * 8), boff = lds_byte(wc * 32 + fr, fq * 8);
#define PG8_SA(b, h) (((b) * 2 + (h)) * HTB)
#define PG8_SB(b, h) ((4 + (b) * 2 + (h)) * HTB)
#define PG8_STAGE(bufoff, gbase, voff) do { _Pragma("unroll") for (int _i = 0; _i < 2; ++_i) \
        __builtin_amdgcn_global_load_lds((const unsigned*)((const char*)(gbase) + (voff)[_i]), (PG8_LAS unsigned*)(lds + (bufoff) + ldsw + _i * 8192), 16, 0, 0); } while (0)
#define PG8_LDA(dst, b, h) do { _Pragma("unroll") for (int m = 0; m < 4; ++m) _Pragma("unroll") for (int k = 0; k < 2; ++k) dst[m][k] = *(const PG8_LAS bf16x8*)(lds + PG8_SA(b, h) + aoff + m * 2048 + k * 1024); } while (0)
#define PG8_LDB(dst, b, h) do { _Pragma("unroll") for (int n = 0; n < 2; ++n) _Pragma("unroll") for (int k = 0; k < 2; ++k) dst[n][k] = *(const PG8_LAS bf16x8*)(lds + PG8_SB(b, h) + boff + n * 2048 + k * 1024); } while (0)
#define PG8_MMA(ai, bj, At, Bt) do { __builtin_amdgcn_s_setprio(1); _Pragma("unroll") for (int m = 0; m < 4; ++m) _Pragma("unroll") for (int n = 0; n < 2; ++n) _Pragma("unroll") for (int k = 0; k < 2; ++k) \
        acc[ai][bj][m][n] = __builtin_amdgcn_mfma_f32_16x16x32_bf16(Bt[n][k], At[m][k], acc[ai][bj][m][n], 0, 0, 0); __builtin_amdgcn_s_setprio(0); } while (0)
#define PG8_WAIT_V(n) asm volatile("s_waitcnt vmcnt(" #n ")" ::: "memory")
#define PG8_WAIT_L(n) asm volatile("s_waitcnt lgkmcnt(" #n ")" ::: "memory")
#define PG8_BAR __builtin_amdgcn_s_barrier()
#define PG8_SCHED __builtin_amdgcn_sched_barrier(0)
    Unit cur, nxt; int ui = 0;
    if (!S.next(0, cur)) return;
    f32x4 acc[2][2][4][2];
#pragma unroll
    for (int a = 0; a < 2; ++a)
#pragma unroll
        for (int b = 0; b < 2; ++b)
#pragma unroll
            for (int m = 0; m < 4; ++m)
#pragma unroll
                for (int n = 0; n < 2; ++n) acc[a][b][m][n] = (f32x4){0.f, 0.f, 0.f, 0.f};
    bf16x8 At[4][2], B0[2][2], B1[2][2];
    const char* cA = (const char*)g.A + (size_t)cur.pm * tstep; const char* cB = (const char*)g.Bt + (size_t)cur.pn * tstep;
    S.a_ready(cur);
    if constexpr (SP2) {
        PG8_STAGE(PG8_SB(0, 0), cB, voffB); PG8_STAGE(PG8_SB(0, 1), cB + hstep, voffB); PG8_STAGE(PG8_SA(0, 0), cA, voffA); PG8_STAGE(PG8_SA(0, 1), cA + hstep, voffA);
        if (wr == 1) PG8_BAR;
        PG8_WAIT_V(2); PG8_BAR;
        PG8_STAGE(PG8_SB(1, 0), cB + kstep, voffB); PG8_STAGE(PG8_SA(1, 0), cA + kstep, voffA); PG8_STAGE(PG8_SB(1, 1), cB + hstep + kstep, voffB);
        PG8_WAIT_V(6); PG8_BAR;
    } else {
        PG8_STAGE(PG8_SB(0, 0), cB, voffB); PG8_STAGE(PG8_SA(0, 0), cA, voffA); PG8_STAGE(PG8_SB(0, 1), cB + hstep, voffB); PG8_STAGE(PG8_SA(0, 1), cA + hstep, voffA);
        if (wr == 1) PG8_BAR;
        PG8_WAIT_V(4); PG8_BAR;
        PG8_STAGE(PG8_SB(1, 0), cB + kstep, voffB); PG8_STAGE(PG8_SA(1, 0), cA + kstep, voffA); PG8_STAGE(PG8_SB(1, 1), cB + hstep + kstep, voffB);
        PG8_WAIT_V(6); PG8_BAR;
    }
    for (;;) {
        const bool has_next = S.next(ui + 1, nxt);
        const char* nA = has_next ? (const char*)g.A + (size_t)nxt.pm * tstep : cA; const char* nB = has_next ? (const char*)g.Bt + (size_t)nxt.pn * tstep : cB;
        for (int t = 0; t < nt; t += 2) {
            const bool last = (t == nt - 2);
            const char* a1 = cA + (size_t)(t + 1) * kstep;
            const char* a2 = last ? nA : cA + (size_t)(t + 2) * kstep; const char* b2 = last ? nB : cB + (size_t)(t + 2) * kstep;
            const char* a3 = a2 + kstep; const char* b3 = b2 + kstep;
            if (last && has_next) S.a_ready(nxt);
            if constexpr (SP2) {
            PG8_LDB(B0, 0, 0); PG8_LDB(B1, 0, 1); PG8_SCHED; PG8_LDA(At, 0, 0); PG8_STAGE(PG8_SA(1, 1), a1 + hstep, voffA);
            PG8_WAIT_V(8); PG8_WAIT_L(0); PG8_BAR; PG8_MMA(0, 0, At, B0); PG8_MMA(0, 1, At, B1); PG8_BAR; PG8_SCHED;
            PG8_LDA(At, 0, 1); PG8_STAGE(PG8_SB(0, 0), b2, voffB); PG8_STAGE(PG8_SB(0, 1), b2 + hstep, voffB); PG8_STAGE(PG8_SA(0, 0), a2, voffA);
            PG8_WAIT_V(8); PG8_WAIT_L(0); PG8_BAR; PG8_MMA(1, 0, At, B0); PG8_MMA(1, 1, At, B1); PG8_BAR; PG8_SCHED;
            PG8_LDB(B0, 1, 0); PG8_LDB(B1, 1, 1); PG8_SCHED; PG8_LDA(At, 1, 0); PG8_STAGE(PG8_SA(0, 1), a2 + hstep, voffA);
            PG8_WAIT_V(8); PG8_WAIT_L(0); PG8_BAR; PG8_MMA(0, 0, At, B0); PG8_MMA(0, 1, At, B1); PG8_BAR; PG8_SCHED;
            PG8_LDA(At, 1, 1); PG8_STAGE(PG8_SB(1, 0), b3, voffB); PG8_STAGE(PG8_SB(1, 1), b3 + hstep, voffB); PG8_STAGE(PG8_SA(1, 0), a3, voffA);
            PG8_WAIT_V(8); PG8_WAIT_L(0); PG8_BAR; PG8_MMA(1, 0, At, B0); PG8_MMA(1, 1, At, B1); PG8_BAR; PG8_SCHED;
            } else {
            PG8_LDB(B0, 0, 0); PG8_SCHED; PG8_LDA(At, 0, 0); PG8_STAGE(PG8_SA(1, 1), a1 + hstep, voffA);
            PG8_WAIT_L(8); PG8_BAR; PG8_WAIT_L(0); PG8_MMA(0, 0, At, B0); PG8_BAR; PG8_SCHED;
            PG8_LDB(B1, 0, 1); PG8_STAGE(PG8_SB(0, 0), b2, voffB);
            PG8_BAR; PG8_WAIT_L(0); PG8_MMA(0, 1, At, B1); PG8_BAR;
            PG8_LDA(At, 0, 1); PG8_STAGE(PG8_SA(0, 0), a2, voffA);
            PG8_BAR; PG8_WAIT_L(0); PG8_MMA(1, 0, At, B0); PG8_BAR; PG8_SCHED;
            PG8_STAGE(PG8_SB(0, 1), b2 + hstep, voffB);
            PG8_WAIT_V(6); PG8_BAR; PG8_MMA(1, 1, At, B1); PG8_BAR;
            PG8_LDB(B0, 1, 0); PG8_SCHED; PG8_LDA(At, 1, 0); PG8_STAGE(PG8_SA(0, 1), a2 + hstep, voffA);
            PG8_WAIT_L(8); PG8_BAR; PG8_WAIT_L(0); PG8_MMA(0, 0, At, B0); PG8_BAR; PG8_SCHED;
            PG8_LDB(B1, 1, 1); PG8_STAGE(PG8_SB(1, 0), b3, voffB);
            PG8_BAR; PG8_WAIT_L(0); PG8_MMA(0, 1, At, B1); PG8_BAR;
            PG8_LDA(At, 1, 1); PG8_STAGE(PG8_SA(1, 0), a3, voffA);
            PG8_BAR; PG8_WAIT_L(0); PG8_MMA(1, 0, At, B0); PG8_BAR; PG8_SCHED;
            PG8_STAGE(PG8_SB(1, 1), b3 + hstep, voffB);
            PG8_WAIT_V(6); PG8_BAR; PG8_MMA(1, 1, At, B1); PG8_BAR;
            }
        }
        if constexpr (ALIGN_EPI) { if (wr == 0) PG8_BAR; }
        if constexpr (!Epi::AFTER_DRAIN) { E(acc, cur, wr, wc, fr, fq); S.done(cur); }
        if (!has_next) break;
#pragma unroll
        for (int a = 0; a < 2; ++a)
#pragma unroll
            for (int b = 0; b < 2; ++b)
#pragma unroll
                for (int m = 0; m < 4; ++m)
#pragma unroll
                    for (int n = 0; n < 2; ++n) acc[a][b][m][n] = (f32x4){0.f, 0.f, 0.f, 0.f};
        cur = nxt; cA = nA; cB = nB; ++ui;
        if constexpr (ALIGN_EPI) { if (wr == 1) PG8_BAR; }
    }
    PG8_WAIT_V(0);
    if constexpr (!ALIGN_EPI) { if (wr == 0) PG8_BAR; }
    PG8_BAR;
    if constexpr (Epi::AFTER_DRAIN) { E.fused(acc, cur, wr, wc, fr, fq, lds, wid, lane); S.done(cur); }
#undef PG8_SA
#undef PG8_SB
#undef PG8_STAGE
#undef PG8_LDA
#undef PG8_LDB
#undef PG8_MMA
#undef PG8_WAIT_V
#undef PG8_WAIT_L
#undef PG8_BAR
#undef PG8_SCHED
}

struct MUnit { int r0, rend, e, pn; };
#define MG_LANE_OFFS(u, o) do { const int _t = wid * 64 + fresh_lane(); _Pragma("unroll") for (int _i = 0; _i < 2; ++_i) { int _R, _C; stage_rc(_t * 16 + _i * 8192, _R, _C); _Pragma("unroll") for (int _h = 0; _h < 2; ++_h) { const int _r = (u).r0 + _h * HALF + _R; \
        int _row = _r; if (GATHER) { _row = 0; if (_r < (u).rend) _row = slot_tok[_r]; } (o)[_h][_i] = (unsigned)(_row * K + _C) * 2u; } } } while (0)
template <class Epi, class Sched, bool GATHER, int N, int K>
__device__ __forceinline__ void gemm_phase_moe(PG8_LAS unsigned char* lds, const bf16_t* A, const bf16_t* Bt, const int* slot_tok, const Sched& S, const Epi& E, int wave_id) {
    asm volatile("" : "+s"(wave_id));
    const int lane = fresh_lane(), wid = wave_id, tid = wid * 64 + lane, wr = wid >> 2, wc = wid & 3, fr = lane & 15, fq = lane >> 4;
    constexpr int nt = K / BK;
#define MG_OFFP(par) ((PG8_LAS unsigned*)(lds + STAGE_BYTES + 8192) + (par) * 2048 + tid)
#define MG_VOFFB ((PG8_LAS unsigned*)(lds + STAGE_BYTES + 24576) + tid)
#pragma unroll
    for (int i = 0; i < 2; ++i) { int R, C; stage_rc(tid * 16 + i * 8192, R, C); const int Rb = Epi::PERM ? ((R & ~31) + perm32(R & 31)) : R; MG_VOFFB[i * 512] = (unsigned)(Rb * K + C) * 2u; }
    constexpr size_t kstep = (size_t)(BK * 2);
    constexpr size_t hstep = (size_t)HALF * K * 2;
    constexpr size_t tstep = 2 * hstep;
    constexpr size_t estep = (size_t)N * K * 2;
    const unsigned ldsw = (unsigned)wid * 1024u;
    const int aoff = lds_byte(wr * 64 + fr, fq * 8), boff = lds_byte(wc * 32 + fr, fq * 8);
#define PG8_SA(b, h) (((b) * 2 + (h)) * HTB)
#define PG8_SB(b, h) ((4 + (b) * 2 + (h)) * HTB)
#define PG8_STAGE(bufoff, gbase, voff) do { _Pragma("unroll") for (int _i = 0; _i < 2; ++_i) \
        __builtin_amdgcn_global_load_lds((const unsigned*)((const char*)(gbase) + MG_VOFFB[_i * 512]), (PG8_LAS unsigned*)(lds + (bufoff) + ldsw + _i * 8192), 16, 0, 0); } while (0)
#define MG_STAGE_A(bufoff, par, h, kb) do { _Pragma("unroll") for (int _i = 0; _i < 2; ++_i) \
        __builtin_amdgcn_global_load_lds((const unsigned*)((const char*)A + (size_t)MG_OFFP(par)[((h) * 2 + _i) * 512] + (kb)), (PG8_LAS unsigned*)(lds + (bufoff) + ldsw + _i * 8192), 16, 0, 0); } while (0)
#define PG8_LDA(dst, b, h) do { _Pragma("unroll") for (int m = 0; m < 4; ++m) _Pragma("unroll") for (int k = 0; k < 2; ++k) dst[m][k] = *(const PG8_LAS bf16x8*)(lds + PG8_SA(b, h) + aoff + m * 2048 + k * 1024); } while (0)
#define PG8_LDB(dst, b, h) do { _Pragma("unroll") for (int n = 0; n < 2; ++n) _Pragma("unroll") for (int k = 0; k < 2; ++k) dst[n][k] = *(const PG8_LAS bf16x8*)(lds + PG8_SB(b, h) + boff + n * 2048 + k * 1024); } while (0)
#define PG8_MMA(ai, bj, At, Bt_) do { __builtin_amdgcn_s_setprio(1); _Pragma("unroll") for (int m = 0; m < 4; ++m) _Pragma("unroll") for (int n = 0; n < 2; ++n) _Pragma("unroll") for (int k = 0; k < 2; ++k) \
        acc[ai][bj][m][n] = __builtin_amdgcn_mfma_f32_16x16x32_bf16(Bt_[n][k], At[m][k], acc[ai][bj][m][n], 0, 0, 0); __builtin_amdgcn_s_setprio(0); } while (0)
#define PG8_WAIT_V(n) asm volatile("s_waitcnt vmcnt(" #n ")" ::: "memory")
#define PG8_WAIT_L(n) asm volatile("s_waitcnt lgkmcnt(" #n ")" ::: "memory")
#define PG8_BAR __builtin_amdgcn_s_barrier()
#define PG8_SCHED __builtin_amdgcn_sched_barrier(0)
    MUnit cur, nxt; int ui = 0;
    if (!S.next(0, cur)) return;
    f32x4 acc[2][2][4][2];
#pragma unroll
    for (int a = 0; a < 2; ++a)
#pragma unroll
        for (int b = 0; b < 2; ++b)
#pragma unroll
            for (int m = 0; m < 4; ++m)
#pragma unroll
                for (int n = 0; n < 2; ++n) acc[a][b][m][n] = (f32x4){0.f, 0.f, 0.f, 0.f};
    bf16x8 At[4][2], B0[2][2], B1[2][2];
    { unsigned o_[2][2]; MG_LANE_OFFS(cur, o_); PG8_LAS unsigned* p_ = MG_OFFP(0); p_[0] = o_[0][0]; p_[512] = o_[0][1]; p_[1024] = o_[1][0]; p_[1536] = o_[1][1]; }
    const char* cB = (const char*)Bt + (size_t)cur.e * estep + (size_t)cur.pn * tstep;
    PG8_STAGE(PG8_SB(0, 0), cB, voffB); PG8_STAGE(PG8_SB(0, 1), cB + hstep, voffB); MG_STAGE_A(PG8_SA(0, 0), 0, 0, 0); MG_STAGE_A(PG8_SA(0, 1), 0, 1, 0);
    if (wr == 1) PG8_BAR;
    PG8_WAIT_V(2); PG8_BAR;
    PG8_STAGE(PG8_SB(1, 0), cB + kstep, voffB); MG_STAGE_A(PG8_SA(1, 0), 0, 0, kstep); PG8_STAGE(PG8_SB(1, 1), cB + hstep + kstep, voffB);
    PG8_WAIT_V(6); PG8_BAR;
    for (;;) {
        const bool has_next = S.next(ui + 1, nxt);
        const char* nB = cB;
        const int pc = ui & 1, pn_ = has_next ? (pc ^ 1) : pc;
        if (has_next) { unsigned on[2][2]; MG_LANE_OFFS(nxt, on); nB = (const char*)Bt + (size_t)nxt.e * estep + (size_t)nxt.pn * tstep;
            PG8_LAS unsigned* p_ = MG_OFFP(pn_); p_[0] = on[0][0]; p_[512] = on[0][1]; p_[1024] = on[1][0]; p_[1536] = on[1][1]; }
        for (int t = 0; t < nt; t += 2) {
            const bool last = (t == nt - 2);
            const size_t k1 = (size_t)(t + 1) * kstep, k2 = last ? (size_t)0 : (size_t)(t + 2) * kstep, k3 = k2 + kstep;
            const char* b2 = last ? nB : cB + (size_t)(t + 2) * kstep; const char* b3 = b2 + kstep;
            const int p2 = last ? pn_ : pc;
            PG8_LDB(B0, 0, 0); PG8_LDB(B1, 0, 1); PG8_SCHED; PG8_LDA(At, 0, 0); MG_STAGE_A(PG8_SA(1, 1), pc, 1, k1);
            PG8_WAIT_V(8); PG8_WAIT_L(0); PG8_BAR; PG8_MMA(0, 0, At, B0); PG8_MMA(0, 1, At, B1); PG8_BAR; PG8_SCHED;
            PG8_LDA(At, 0, 1); PG8_STAGE(PG8_SB(0, 0), b2, voffB); PG8_STAGE(PG8_SB(0, 1), b2 + hstep, voffB); MG_STAGE_A(PG8_SA(0, 0), p2, 0, k2);
            PG8_WAIT_V(8); PG8_WAIT_L(0); PG8_BAR; PG8_MMA(1, 0, At, B0); PG8_MMA(1, 1, At, B1); PG8_BAR; PG8_SCHED;
            PG8_LDB(B0, 1, 0); PG8_LDB(B1, 1, 1); PG8_SCHED; PG8_LDA(At, 1, 0); MG_STAGE_A(PG8_SA(0, 1), p2, 1, k2);
            PG8_WAIT_V(8); PG8_WAIT_L(0); PG8_BAR; PG8_MMA(0, 0, At, B0); PG8_MMA(0, 1, At, B1); PG8_BAR; PG8_SCHED;
            PG8_LDA(At, 1, 1); PG8_STAGE(PG8_SB(1, 0), b3, voffB); PG8_STAGE(PG8_SB(1, 1), b3 + hstep, voffB); MG_STAGE_A(PG8_SA(1, 0), p2, 0, k3);
            PG8_WAIT_V(8); PG8_WAIT_L(0); PG8_BAR; PG8_MMA(1, 0, At, B0); PG8_MMA(1, 1, At, B1); PG8_BAR; PG8_SCHED;
        }
        if (wr == 0) PG8_BAR;
        E(acc, cur, wr, wc, fr, fq);
        if (!has_next) break;
#pragma unroll
        for (int a = 0; a < 2; ++a)
#pragma unroll
            for (int b = 0; b < 2; ++b)
#pragma unroll
                for (int m = 0; m < 4; ++m)
#pragma unroll
                    for (int n = 0; n < 2; ++n) acc[a][b][m][n] = (f32x4){0.f, 0.f, 0.f, 0.f};
        cur = nxt; cB = nB; ++ui;
        if (wr == 1) PG8_BAR;
    }
    PG8_WAIT_V(0);
    PG8_BAR;
#undef PG8_SA
#undef PG8_SB
#undef PG8_STAGE
#undef MG_STAGE_A
#undef MG_OFFP
#undef MG_VOFFB
#undef PG8_LDA
#undef PG8_LDB
#undef PG8_MMA
#undef PG8_WAIT_V
#undef PG8_WAIT_L
#undef PG8_BAR
#undef PG8_SCHED
}
__device__ __forceinline__ float fast_silu(float x) { return x * __builtin_amdgcn_rcpf(1.0f + __builtin_amdgcn_exp2f(-1.4426950408889634f * x)); }
struct EpiMoeH {
    static constexpr bool PERM = true;
    bf16_t* H;
    __device__ __forceinline__ void operator()(const f32x4 (&acc)[2][2][4][2], const MUnit& u, int wr, int wc, int fr, int fq) const {
        { const int t_ = fresh_lane(); fr = t_ & 15; fq = t_ >> 4; }
        const int col0 = u.pn * 128 + wc * 32 + 8 * fq;
#pragma unroll
        for (int ai = 0; ai < 2; ++ai)
#pragma unroll
            for (int m = 0; m < 4; ++m) { const int r = u.r0 + ai * HALF + wr * 64 + m * 16 + fr;
                const f32x4 g0 = acc[ai][0][m][0], g1 = acc[ai][0][m][1], u0 = acc[ai][1][m][0], u1 = acc[ai][1][m][1];
                u32x4 w; w.x = cvt_pk_bf16(fast_silu(g0[0]) * u0[0], fast_silu(g0[1]) * u0[1]); w.y = cvt_pk_bf16(fast_silu(g0[2]) * u0[2], fast_silu(g0[3]) * u0[3]);
                w.z = cvt_pk_bf16(fast_silu(g1[0]) * u1[0], fast_silu(g1[1]) * u1[1]); w.w = cvt_pk_bf16(fast_silu(g1[2]) * u1[2], fast_silu(g1[3]) * u1[3]);
                if (r < u.rend) *(u32x4*)(H + (size_t)r * 256 + col0) = w; }
    }
};
struct EpiMoeY {
    static constexpr bool PERM = true;
    bf16_t* Y;
    __device__ __forceinline__ void operator()(const f32x4 (&acc)[2][2][4][2], const MUnit& u, int wr, int wc, int fr, int fq) const {
        { const int t_ = fresh_lane(); fr = t_ & 15; fq = t_ >> 4; }
        const int col0 = u.pn * BM + wc * 32 + 8 * fq;
#pragma unroll
        for (int ai = 0; ai < 2; ++ai)
#pragma unroll
            for (int m = 0; m < 4; ++m) { const int r = u.r0 + ai * HALF + wr * 64 + m * 16 + fr;
#pragma unroll
                for (int bj = 0; bj < 2; ++bj) { const f32x4 v0 = acc[ai][bj][m][0], v1 = acc[ai][bj][m][1];
                    u32x4 w; w.x = cvt_pk_bf16(v0[0], v0[1]); w.y = cvt_pk_bf16(v0[2], v0[3]); w.z = cvt_pk_bf16(v1[0], v1[1]); w.w = cvt_pk_bf16(v1[2], v1[3]);
                    if (r < u.rend) *(u32x4*)(Y + (size_t)r * 1024 + col0 + bj * HALF) = w; } }
    }
};
struct MoeSched {
    const PG8_LAS int* tab;
    int npn, G, c;
    __device__ __forceinline__ bool next(int i, MUnit& u) const {
        const int L = i * G + c, ntile = tab[0];
        if (L >= ntile * npn) return false;
        const int j = L / npn; u.pn = L % npn;
        u.e = __builtin_amdgcn_readfirstlane(tab[4 + 4 * j]); u.r0 = __builtin_amdgcn_readfirstlane(tab[5 + 4 * j]); u.rend = __builtin_amdgcn_readfirstlane(tab[6 + 4 * j]);
        return true;
    }
};
}

#ifndef PG8_SP2
#define PG8_SP2 true
#endif
#ifndef PG8_ALIGN
#define PG8_ALIGN true
#endif

constexpr int NWAVES = 8, NT = NWAVES * 64;
constexpr int D = 1024, NB = 2, S = 8192, T = NB * S, DEPTH = 2;
constexpr int DIN = 2832, PLD = 3072;
constexpr int C_Q = 0, C_K = 256, C_V = 512, C_G = 1024, C_GK = 1536, C_U = 1552, C_VG = 1808, C_XI = 2064, C_BG = 2320, C_CG = 2576;
constexpr int GH = 4, GC = 64, GN = S / GC;
constexpr int MH = 4, MC = 128, MN = S / MC;
constexpr int NE = 32, DE = 256;
constexpr float EPS = 1e-6f;
constexpr size_t MiB = 1u << 20;
constexpr size_t WS_CTL = 0, CTL_BYTES = 1 * MiB;
constexpr size_t WS_WIN = 1 * MiB;
constexpr size_t WS_WOUT = 13 * MiB;
constexpr size_t WS_WGU = 17 * MiB;
constexpr size_t WS_WD = 81 * MiB;
constexpr size_t WS_XN = 113 * MiB;
constexpr size_t WS_P = 145 * MiB;
constexpr size_t WS_Y = WS_P + 17 * MiB;
constexpr size_t WS_S = 241 * MiB;
constexpr size_t WS_DEC = 273 * MiB;
constexpr size_t WS_MISC = 274 * MiB;
constexpr size_t WS_END = 275 * MiB;
constexpr int CW_BAR = 4096, CW_CNT = 16384;
constexpr int RING_BYTES = 131072, LDSCTL_OFF = RING_BYTES, MISC_OFF = LDSCTL_OFF + 320, LDS_BYTES = 163840;

#define GAS __attribute__((address_space(1)))
#define LAS __attribute__((address_space(3)))
typedef unsigned short bf16;
typedef unsigned v4u __attribute__((ext_vector_type(4)));
typedef unsigned v2u __attribute__((ext_vector_type(2)));
typedef float f32x4 __attribute__((ext_vector_type(4)));
__device__ __forceinline__ unsigned f2bf(float f) { unsigned u = __builtin_bit_cast(unsigned, f); return (u + 0x7fffu + ((u >> 16) & 1u)) >> 16; }
__device__ __forceinline__ unsigned pk2(float lo, float hi) { return f2bf(lo) | (f2bf(hi) << 16); }
__device__ __forceinline__ float bf2f(unsigned v) { return __uint_as_float(v << 16); }
__device__ __forceinline__ float bflo(unsigned w) { return __uint_as_float(w << 16); }
__device__ __forceinline__ float bfhi(unsigned w) { return __uint_as_float(w & 0xffff0000u); }
__device__ __forceinline__ void unpack8(const v4u q, float (&f)[8]) { f[0] = bflo(q.x); f[1] = bfhi(q.x); f[2] = bflo(q.y); f[3] = bfhi(q.y); f[4] = bflo(q.z); f[5] = bfhi(q.z); f[6] = bflo(q.w); f[7] = bfhi(q.w); }
__device__ __forceinline__ float gelu_tanh(float x) { const float u = 0.7978845608028654f * (x + 0.044715f * x * x * x); return 0.5f * x * (1.0f + tanhf(u)); }
__device__ __forceinline__ float silu(float x) { return x / (1.0f + expf(-x)); }
__device__ __forceinline__ float log_sigmoid(float x) { return fminf(x, 0.f) - log1pf(expf(-fabsf(x))); }

#define XB_TMO      128
#define XB_XCNT(j)  (256  + 64 * (j))
#define XB_XSUB(j)  (1280 + 64 * (j))
#define XB_XGEN(j)  (2304 + 64 * (j))
#define XB_TOP      3328
#define XB_TOPGEN   3392
#define XCD_BAR_WORDS 3456
#define XB_SPIN_CAP (1u << 18)

__device__ __forceinline__ unsigned xb_ld(unsigned* p)              { return __hip_atomic_load(p, __ATOMIC_RELAXED, __HIP_MEMORY_SCOPE_AGENT); }
__device__ __forceinline__ unsigned xb_add(unsigned* p, unsigned v) { return __hip_atomic_fetch_add(p, v, __ATOMIC_RELAXED, __HIP_MEMORY_SCOPE_AGENT); }
__device__ __forceinline__ unsigned xb_xcc_id() { return (unsigned)__builtin_amdgcn_s_getreg((3 << 11) | 20) & 0xFu; }
#define XB_SPIN(cond, bar) do { unsigned _sp = 0; while (cond) { __builtin_amdgcn_s_sleep(1); \
    if ((++_sp & 255u) == 0u) { if (xb_ld(&(bar)[XB_TMO])) break; if (_sp > XB_SPIN_CAP) { atomicAdd(&(bar)[XB_TMO], 1u); break; } } } } while (0)

struct XcdBarrier {
    int wave;
    unsigned* bar; unsigned x;
    volatile LAS unsigned* st;
};

__device__ __forceinline__ XcdBarrier xcd_barrier_post(unsigned* bar, volatile LAS unsigned* st) {
    XcdBarrier b; b.bar = bar; b.x = xb_xcc_id(); b.st = st; b.wave = __builtin_amdgcn_readfirstlane(threadIdx.x >> 6);
    if (threadIdx.x == 0) (void)xb_add(&bar[XB_XCNT(b.x)], 1u);
    return b;
}
__device__ __forceinline__ void xcd_barrier_complete(unsigned* bar, unsigned x, unsigned& nloc, unsigned& nx) {
    const unsigned G = gridDim.x * gridDim.y * gridDim.z;
    unsigned sum, cnt, mine, sp = 0u;
    for (;;) {
        sum = 0u; cnt = 0u; mine = 0u;
#pragma unroll
        for (unsigned j = 0; j < 16; ++j) { const unsigned c = xb_ld(&bar[XB_XCNT(j)]); sum += c; cnt += (c > 0u) ? 1u : 0u; mine = (j == x) ? c : mine; }
        if (sum == G) break;
        __builtin_amdgcn_s_sleep(1);
        if ((++sp & 255u) == 0u) { if (xb_ld(&bar[XB_TMO])) break; if (sp > XB_SPIN_CAP) { atomicAdd(&bar[XB_TMO], 1u); break; } }
    }
    nloc = mine > 0u ? mine : 1u; nx = cnt > 0u ? cnt : 1u;
}

__device__ __forceinline__ void xcd_barrier(const XcdBarrier& b) {
    asm volatile("s_waitcnt vmcnt(0)" ::: "memory");
    __syncthreads();
    if (b.wave == 0 && fresh_lane() == 0) {
        unsigned* bar = b.bar; asm volatile("" : "+s"(bar));
        __builtin_amdgcn_s_waitcnt(0);
        unsigned nloc = b.st[0], nx = b.st[1];
        if (nloc == 0u) { xcd_barrier_complete(bar, b.x, nloc, nx); b.st[0] = nloc; b.st[1] = nx; }
        const unsigned old = xb_add(&bar[XB_XSUB(b.x)], 1u);
        const unsigned gen = old / nloc;
        if (old + 1u == (gen + 1u) * nloc) {
            __builtin_amdgcn_fence(__ATOMIC_RELEASE, "agent");
            asm volatile("s_waitcnt vmcnt(0)" ::: "memory");
            const unsigned og = xb_add(&bar[XB_TOP], 1u);
            const unsigned tg = og / nx;
            if (og + 1u == (tg + 1u) * nx) xb_add(&bar[XB_TOPGEN], 1u);
            else XB_SPIN(xb_ld(&bar[XB_TOPGEN]) == tg, bar);
            __builtin_amdgcn_fence(__ATOMIC_ACQUIRE, "agent");
            xb_add(&bar[XB_XGEN(b.x)], 1u);
            asm volatile("s_waitcnt vmcnt(0)" ::: "memory");
        } else {
            XB_SPIN(xb_ld(&bar[XB_XGEN(b.x)]) == gen, bar);
            __builtin_amdgcn_fence(__ATOMIC_ACQUIRE, "agent");
            asm volatile("s_waitcnt vmcnt(0)" ::: "memory");
        }
    }
    __syncthreads();
}

#define AS4 __attribute__((address_space(4)))
struct KA {
    const AS4 char* ka;
    static __device__ __forceinline__ KA fresh() { KA k; k.ka = (const AS4 char*)__builtin_amdgcn_kernarg_segment_ptr(); asm volatile("" : "+s"(k.ka)); return k; }
    __device__ __forceinline__ const float* in(int i) const { return *(const float* const AS4*)(ka + 8 * i); }
    __device__ __forceinline__ float* out() const { return *(float* const AS4*)(ka + 160); }
    __device__ __forceinline__ unsigned char* ws() const { return *(unsigned char* const AS4*)(ka + 168); }
    __device__ __forceinline__ unsigned* ctl() const { return (unsigned*)(ws() + WS_CTL); }
    __device__ __forceinline__ bf16* WinT() const { return (bf16*)(ws() + WS_WIN); }
    __device__ __forceinline__ bf16* WoutT() const { return (bf16*)(ws() + WS_WOUT); }
    __device__ __forceinline__ bf16* WguT() const { return (bf16*)(ws() + WS_WGU); }
    __device__ __forceinline__ bf16* WdT() const { return (bf16*)(ws() + WS_WD); }
    __device__ __forceinline__ bf16* XN() const { return (bf16*)(ws() + WS_XN); }
    __device__ __forceinline__ bf16* P() const { return (bf16*)(ws() + WS_P); }
    __device__ __forceinline__ bf16* H1() const { return (bf16*)(ws() + WS_P); }
    __device__ __forceinline__ bf16* Y() const { return (bf16*)(ws() + WS_Y); }
    __device__ __forceinline__ float* Sst() const { return (float*)(ws() + WS_S); }
    __device__ __forceinline__ float* dec() const { return (float*)(ws() + WS_DEC); }
    __device__ __forceinline__ int* eid() const { return (int*)(ws() + WS_MISC); }
    __device__ __forceinline__ float* ew() const { return (float*)(ws() + WS_MISC + 131072); }
    __device__ __forceinline__ int* slot_tok() const { return (int*)(ws() + WS_MISC + 2 * 131072); }
    __device__ __forceinline__ int* slot_of() const { return (int*)(ws() + WS_MISC + 3 * 131072); }
};
struct Frame {
    LAS unsigned char* lds; float* smem;
    int G, bx, wave;
};
#define PHASE_TID const int lane = fresh_lane(), wave = F.wave, tid = wave * 64 + lane; (void)lane; (void)wave; (void)tid

__device__ __forceinline__ float wave_sum(float v) {
    const int ln = fresh_lane();
#pragma unroll
    for (int o = 1; o < 64; o <<= 1) v += __int_as_float(__builtin_amdgcn_ds_bpermute((ln ^ o) << 2, __float_as_int(v)));
    return v;
}

__device__ __forceinline__ void transpose_item(const float* W, int ldw, int nvalid, int k0, int n0, bf16* WT, int ldt, int drow0, LAS float* scr, int lane) {
    const int nl = lane & 31;
#pragma unroll 8
    for (int i = 0; i < 32; ++i) { const int kk = 2 * i + (lane >> 5); scr[kk * 33 + nl] = (nl < nvalid) ? W[(size_t)(k0 + kk) * ldw + n0 + nl] : 0.f; }
    asm volatile("s_waitcnt lgkmcnt(0)" ::: "memory");
    const int c = lane & 7;
#pragma unroll
    for (int j = 0; j < 4; ++j) { const int n = (lane >> 3) + 8 * j; const LAS float* s = scr + (8 * c) * 33 + n;
        v4u o; o.x = pk2(s[0 * 33], s[1 * 33]); o.y = pk2(s[2 * 33], s[3 * 33]); o.z = pk2(s[4 * 33], s[5 * 33]); o.w = pk2(s[6 * 33], s[7 * 33]);
        if (n < nvalid) *(GAS v4u*)(WT + (size_t)(drow0 + n) * ldt + k0 + 8 * c) = o; }
    asm volatile("s_waitcnt lgkmcnt(0)" ::: "memory");
}
__device__ __forceinline__ void rms_row_to_bf16(const float* xrow, const float* gain, bf16* orow, int lane) {
    const f32x4* xr = (const f32x4*)xrow + lane;
    f32x4 v[4]; float s = 0.f;
#pragma unroll
    for (int j = 0; j < 4; ++j) { v[j] = xr[64 * j]; s += (v[j].x * v[j].x + v[j].y * v[j].y) + (v[j].z * v[j].z + v[j].w * v[j].w); }
    const float rs = rsqrtf(wave_sum(s) * (1.f / D) + EPS);
    v2u* o8 = (v2u*)orow + lane;
#pragma unroll
    for (int j = 0; j < 4; ++j) { const f32x4 g = ((const f32x4*)gain)[lane + 64 * j]; v2u w; w.x = pk2(v[j].x * rs * g.x, v[j].y * rs * g.y); w.y = pk2(v[j].z * rs * g.z, v[j].w * rs * g.w); o8[64 * j] = w; }
}
__device__ __forceinline__ void p0_prologue(Frame& F) {
    const KA K = KA::fresh(); PHASE_TID;
    LAS float* scr = (LAS float*)(F.lds + wave * 16384);
    const int gw = F.bx * NWAVES + wave, NGW = F.G * NWAVES;
    constexpr int I_IN = 16 * 89, I_OUT = 16 * 32, I_G = 32 * 16 * 8, I_D = 32 * 4 * 32, I_L = I_IN + I_OUT + 2 * I_G + I_D;
    for (int it = gw; it < DEPTH * I_L; it += NGW) {
        const int l = it / I_L; int r = it % I_L;
        if (r < I_IN) { const int kb = r / 89, nb = r % 89; const int nv = (nb == 88) ? 16 : 32;
            transpose_item(K.in(2) + (size_t)l * D * DIN, DIN, nv, kb * 64, nb * 32, K.WinT() + (size_t)l * PLD * D, D, nb * 32, scr, lane); continue; }
        r -= I_IN;
        if (r < I_OUT) { const int kb = r / 32, nb = r % 32;
            transpose_item(K.in(10) + (size_t)l * D * D, D, 32, kb * 64, nb * 32, K.WoutT() + (size_t)l * D * D, D, nb * 32, scr, lane); continue; }
        r -= I_OUT;
        if (r < 2 * I_G) { const int sel = r / I_G; r %= I_G; const int e = r / 128, kb = (r % 128) / 8, nb = r % 8; const int n0 = nb * 32;
            const float* W = K.in(16 + sel) + ((size_t)l * NE + e) * D * DE;
            transpose_item(W, DE, 32, kb * 64, n0, K.WguT() + ((size_t)l * NE + e) * 512 * D, D, (n0 >> 7) * 256 + sel * 128 + (n0 & 127), scr, lane); continue; }
        r -= 2 * I_G;
        { const int e = r / 128, kb = (r % 128) / 32, nb = r % 32;
            transpose_item(K.in(18) + ((size_t)l * NE + e) * DE * D, D, 32, kb * 64, nb * 32, K.WdT() + ((size_t)l * NE + e) * D * DE, DE, nb * 32, scr, lane); }
    }
    for (int i = F.bx * NT + tid; i < DEPTH * 240 * 128; i += F.G * NT) { const int l = i / (240 * 128), rr = (i / 128) % 240, c = i % 128;
        *(GAS v4u*)(K.WinT() + ((size_t)l * PLD + DIN + rr) * D + c * 8) = (v4u){0u, 0u, 0u, 0u}; }
    for (int m = gw; m < T; m += NGW) rms_row_to_bf16(K.in(0) + (size_t)m * D, K.in(1), K.XN() + (size_t)m * D, lane);
}

__device__ __forceinline__ void gla_cumdecay(Frame& F, const KA& K, int tid, int l, int h, int t0, float* bb) {
    const float* wup = K.in(3) + (size_t)l * 16 * 256; const float* bgk = K.in(4) + (size_t)l * 256;
    for (int e = tid; e < 64 * 64; e += NT) {
        const int c = e >> 6, d = e & 63;
        const bf16* gl = K.P() + (size_t)(t0 + c) * PLD + C_GK;
        float a = bgk[h * 64 + d];
#pragma unroll
        for (int r = 0; r < 16; ++r) a += bf2f(gl[r]) * wup[r * 256 + h * 64 + d];
        bb[c * 64 + d] = log_sigmoid(a) * (1.0f / 16.0f);
    }
    __syncthreads();
    if (tid < 64) { float run = 0.f; for (int c = 0; c < 64; ++c) { run += bb[c * 64 + tid]; bb[c * 64 + tid] = run; } }
    __syncthreads();
}
__device__ __forceinline__ void phase_gla_kv(Frame& F, int l) {
    const KA K = KA::fresh(); PHASE_TID;
    float* bb = F.smem; float* kd = F.smem + 4096;
#pragma unroll 1
    for (int ci = F.bx; ci < NB * GH * GN; ci += F.G) {
        const int b = ci / (GH * GN), h = (ci / GN) % GH, n = ci % GN, t0 = b * S + n * GC;
        __syncthreads();
        gla_cumdecay(F, K, tid, l, h, t0, bb);
        for (int e = tid; e < 4096; e += NT) { const int c = e >> 6, d = e & 63; kd[e] = bf2f(K.P()[(size_t)(t0 + c) * PLD + C_K + h * 64 + d]) * expf(bb[63 * 64 + d] - bb[e]); }
        __syncthreads();
        const int d = tid >> 3, v0 = (tid & 7) * 16;
        float acc[16];
#pragma unroll
        for (int j = 0; j < 16; ++j) acc[j] = 0.f;
#pragma unroll 2
        for (int c = 0; c < 64; ++c) {
            const float kk = kd[c * 64 + d];
            const v4u* vr = (const v4u*)(K.P() + (size_t)(t0 + c) * PLD + C_V + h * 128 + v0);
            float f[8]; unpack8(vr[0], f);
#pragma unroll
            for (int j = 0; j < 8; ++j) acc[j] += kk * f[j];
            unpack8(vr[1], f);
#pragma unroll
            for (int j = 0; j < 8; ++j) acc[8 + j] += kk * f[j];
        }
        f32x4* o = (f32x4*)(K.Sst() + ((size_t)ci * 64 + d) * 128 + v0);
#pragma unroll
        for (int j = 0; j < 4; ++j) o[j] = (f32x4){acc[4 * j], acc[4 * j + 1], acc[4 * j + 2], acc[4 * j + 3]};
        if (tid < 64) K.dec()[(size_t)ci * 64 + tid] = expf(bb[63 * 64 + tid]);
    }
}
__device__ __forceinline__ void phase_gla_scan(Frame& F) {
    const KA K = KA::fresh(); PHASE_TID;
#pragma unroll 1
    for (int e = F.bx * NT + tid; e < NB * GH * 64 * 128; e += F.G * NT) {
        const int bh = e >> 13, d = (e >> 7) & 63, v = e & 127;
        float st = 0.f;
#pragma unroll 4
        for (int n = 0; n < GN; ++n) {
            const size_t ci = (size_t)bh * GN + n;
            float* ptr = K.Sst() + (ci * 64 + d) * 128 + v;
            const float kvv = *ptr; *ptr = st;
            st = K.dec()[ci * 64 + d] * st + kvv;
        }
    }
}
__device__ __forceinline__ void phase_gla_out(Frame& F, int l) {
    const KA K = KA::fresh(); PHASE_TID;
    float* bb = F.smem; float* qd = F.smem + 4096; float* ki = F.smem + 4096 + 64 * 65; float* sc = bb;
    const float* gnorm = K.in(5) + (size_t)l * 128;
#pragma unroll 1
    for (int ci = F.bx; ci < NB * GH * GN; ci += F.G) {
        const int b = ci / (GH * GN), h = (ci / GN) % GH, n = ci % GN, t0 = b * S + n * GC;
        __syncthreads();
        gla_cumdecay(F, K, tid, l, h, t0, bb);
        for (int e = tid; e < 4096; e += NT) {
            const int c = e >> 6, d = e & 63; const float bv = bb[e];
            const bf16* row = K.P() + (size_t)(t0 + c) * PLD;
            qd[c * 65 + d] = bf2f(row[C_Q + h * 64 + d]) * 0.125f * expf(bv);
            ki[c * 65 + d] = bf2f(row[C_K + h * 64 + d]) * expf(-bv);
        }
        __syncthreads();
        {
            const int c = tid >> 3, s0 = (tid & 7) * 8;
            float a[8];
#pragma unroll
            for (int j = 0; j < 8; ++j) a[j] = 0.f;
#pragma unroll 4
            for (int d = 0; d < 64; ++d) { const float qv = qd[c * 65 + d];
#pragma unroll
                for (int j = 0; j < 8; ++j) a[j] += qv * ki[(s0 + j) * 65 + d]; }
#pragma unroll
            for (int j = 0; j < 8; ++j) sc[c * 64 + s0 + j] = (s0 + j <= c) ? a[j] : 0.f;
        }
        __syncthreads();
        const int c = tid >> 3, v0 = (tid & 7) * 16;
        float acc[16];
#pragma unroll
        for (int j = 0; j < 16; ++j) acc[j] = 0.f;
#pragma unroll 2
        for (int s = 0; s <= c; ++s) {
            const float w = sc[c * 64 + s];
            const v4u* vr = (const v4u*)(K.P() + (size_t)(t0 + s) * PLD + C_V + h * 128 + v0);
            float f[8]; unpack8(vr[0], f);
#pragma unroll
            for (int j = 0; j < 8; ++j) acc[j] += w * f[j];
            unpack8(vr[1], f);
#pragma unroll
            for (int j = 0; j < 8; ++j) acc[8 + j] += w * f[j];
        }
#pragma unroll 2
        for (int d = 0; d < 64; ++d) {
            const float w = qd[c * 65 + d];
            const f32x4* sr = (const f32x4*)(K.Sst() + ((size_t)ci * 64 + d) * 128 + v0);
#pragma unroll
            for (int j = 0; j < 4; ++j) { const f32x4 v4 = sr[j]; acc[4 * j] += w * v4.x; acc[4 * j + 1] += w * v4.y; acc[4 * j + 2] += w * v4.z; acc[4 * j + 3] += w * v4.w; }
        }
        float ss = 0.f;
#pragma unroll
        for (int j = 0; j < 16; ++j) ss += acc[j] * acc[j];
        ss += shx(ss, 1); ss += shx(ss, 2); ss += shx(ss, 4);
        const float rs = rsqrtf(ss * (1.0f / 128.0f) + EPS);
        const v4u* gr = (const v4u*)(K.P() + (size_t)(t0 + c) * PLD + C_G + h * 128 + v0);
        float g0[8], g1[8]; unpack8(gr[0], g0); unpack8(gr[1], g1);
        float o[16];
#pragma unroll
        for (int j = 0; j < 8; ++j) { o[j] = acc[j] * rs * gnorm[v0 + j] * silu(g0[j]); o[8 + j] = acc[8 + j] * rs * gnorm[v0 + 8 + j] * silu(g1[j]); }
        v4u* op = (v4u*)(K.XN() + (size_t)(t0 + c) * D + h * 128 + v0);
        op[0] = (v4u){pk2(o[0], o[1]), pk2(o[2], o[3]), pk2(o[4], o[5]), pk2(o[6], o[7])};
        op[1] = (v4u){pk2(o[8], o[9]), pk2(o[10], o[11]), pk2(o[12], o[13]), pk2(o[14], o[15])};
    }
}
__device__ __forceinline__ void phase_gmlp(Frame& F, int l) {
    const KA K = KA::fresh(); PHASE_TID;
    float* vs = F.smem;
    const float* gn = K.in(6) + (size_t)l * 256; const float* wsp = K.in(7) + (size_t)l * MH * 128 * 128; const float* bsp = K.in(8) + (size_t)l * MH * 128;
#pragma unroll 1
    for (int u = F.bx; u < NB * MN * MH; u += F.G) {
        const int b = u / (MN * MH), n = (u / MH) % MN, h = u % MH, t0 = b * S + n * MC;
        __syncthreads();
        const int s = tid >> 2, d0 = (tid & 3) * 16;
        {
            const v4u* vr = (const v4u*)(K.P() + (size_t)(t0 + s) * PLD + C_VG + h * 64 + d0);
            float g[16]; { float f[8]; unpack8(vr[0], f);
#pragma unroll
                for (int j = 0; j < 8; ++j) g[j] = gelu_tanh(f[j]);
                unpack8(vr[1], f);
#pragma unroll
                for (int j = 0; j < 8; ++j) g[8 + j] = gelu_tanh(f[j]); }
            float ss = 0.f;
#pragma unroll
            for (int j = 0; j < 16; ++j) ss += g[j] * g[j];
            ss += shx(ss, 1); ss += shx(ss, 2);
            const float rs = rsqrtf(ss * (1.0f / 64.0f) + EPS);
#pragma unroll
            for (int j = 0; j < 16; ++j) vs[s * 64 + d0 + j] = g[j] * rs * gn[h * 64 + d0 + j];
        }
        __syncthreads();
        const int t = s;
        float acc[16];
#pragma unroll
        for (int j = 0; j < 16; ++j) acc[j] = 0.f;
        const float* wr = wsp + ((size_t)h * 128 + t) * 128;
#pragma unroll 2
        for (int s2 = 0; s2 <= t; ++s2) { const float w = wr[s2];
#pragma unroll
            for (int j = 0; j < 16; ++j) acc[j] += w * vs[s2 * 64 + d0 + j]; }
        const float bias = bsp[h * 128 + t];
        const v4u* ur = (const v4u*)(K.P() + (size_t)(t0 + t) * PLD + C_U + h * 64 + d0);
        float u0[8], u1[8]; unpack8(ur[0], u0); unpack8(ur[1], u1);
        float o[16];
#pragma unroll
        for (int j = 0; j < 8; ++j) { o[j] = gelu_tanh(u0[j]) * (acc[j] + bias); o[8 + j] = gelu_tanh(u1[j]) * (acc[8 + j] + bias); }
        v4u* op = (v4u*)(K.XN() + (size_t)(t0 + t) * D + 512 + h * 64 + d0);
        op[0] = (v4u){pk2(o[0], o[1]), pk2(o[2], o[3]), pk2(o[4], o[5]), pk2(o[6], o[7])};
        op[1] = (v4u){pk2(o[8], o[9]), pk2(o[10], o[11]), pk2(o[12], o[13]), pk2(o[14], o[15])};
    }
}
__device__ __forceinline__ void phase_conv(Frame& F, int l) {
    const KA K = KA::fresh(); PHASE_TID;
    const float* wc = K.in(9) + (size_t)l * 3 * 256;
#pragma unroll 1
    for (int e = F.bx * NT + tid; e < T * 32; e += F.G * NT) {
        const int t = e >> 5, c0 = (e & 31) * 8, tl = t % S;
        const bf16* row = K.P() + (size_t)t * PLD;
        float y[8], xi[8], cg[8], bg[8];
        unpack8(*(const v4u*)(row + C_XI + c0), xi); unpack8(*(const v4u*)(row + C_CG + c0), cg); unpack8(*(const v4u*)(row + C_BG + c0), bg);
#pragma unroll
        for (int j = 0; j < 8; ++j) y[j] = wc[2 * 256 + c0 + j] * cg[j] * xi[j];
        if (tl >= 1) { unpack8(*(const v4u*)(row - PLD + C_XI + c0), xi); unpack8(*(const v4u*)(row - PLD + C_CG + c0), cg);
#pragma unroll
            for (int j = 0; j < 8; ++j) y[j] += wc[1 * 256 + c0 + j] * cg[j] * xi[j]; }
        if (tl >= 2) { unpack8(*(const v4u*)(row - 2 * PLD + C_XI + c0), xi); unpack8(*(const v4u*)(row - 2 * PLD + C_CG + c0), cg);
#pragma unroll
            for (int j = 0; j < 8; ++j) y[j] += wc[0 * 256 + c0 + j] * cg[j] * xi[j]; }
#pragma unroll
        for (int j = 0; j < 8; ++j) y[j] *= bg[j];
        *(v4u*)(K.XN() + (size_t)t * D + 768 + c0) = (v4u){pk2(y[0], y[1]), pk2(y[2], y[3]), pk2(y[4], y[5]), pk2(y[6], y[7])};
    }
}
__device__ __forceinline__ void phase_norm_router(Frame& F, int l) {
    const KA K = KA::fresh(); PHASE_TID;
    const float* gain = K.in(11) + (size_t)l * D;
    const float* wrg = K.in(12) + (size_t)l * D * 4; const float* brg = K.in(13) + (size_t)l * 4;
    const float* wre = K.in(14) + (size_t)l * D * 32; const float* bre = K.in(15) + (size_t)l * 32;
    int* cnt = (int*)(K.ctl() + CW_CNT + 64 * l);
#pragma unroll 1
    for (int t = F.bx * NWAVES + wave; t < T; t += F.G * NWAVES) {
        const f32x4* xr = (const f32x4*)(K.out() + (size_t)t * D) + lane;
        f32x4 v[4]; float s = 0.f;
#pragma unroll
        for (int j = 0; j < 4; ++j) { v[j] = xr[64 * j]; s += (v[j].x * v[j].x + v[j].y * v[j].y) + (v[j].z * v[j].z + v[j].w * v[j].w); }
        const float rs = rsqrtf(wave_sum(s) * (1.f / D) + EPS);
        v2u* o8 = (v2u*)(K.XN() + (size_t)t * D) + lane;
        float acc[36];
#pragma unroll
        for (int j = 0; j < 36; ++j) acc[j] = 0.f;
#pragma unroll
        for (int j = 0; j < 4; ++j) {
            const f32x4 g = ((const f32x4*)gain)[lane + 64 * j];
            const float hv[4] = {v[j].x * rs * g.x, v[j].y * rs * g.y, v[j].z * rs * g.z, v[j].w * rs * g.w};
            v2u w; w.x = pk2(hv[0], hv[1]); w.y = pk2(hv[2], hv[3]); o8[64 * j] = w;
#pragma unroll
            for (int i = 0; i < 4; ++i) {
                const int k = 4 * lane + 256 * j + i; const float xv = hv[i];
                const f32x4 g4 = *(const f32x4*)(wrg + (size_t)k * 4);
                acc[0] += xv * g4.x; acc[1] += xv * g4.y; acc[2] += xv * g4.z; acc[3] += xv * g4.w;
                const f32x4* e4 = (const f32x4*)(wre + (size_t)k * 32);
#pragma unroll
                for (int q = 0; q < 8; ++q) { const f32x4 w4 = e4[q]; acc[4 + 4 * q] += xv * w4.x; acc[5 + 4 * q] += xv * w4.y; acc[6 + 4 * q] += xv * w4.z; acc[7 + 4 * q] += xv * w4.w; }
            }
        }
#pragma unroll
        for (int j = 0; j < 36; ++j) acc[j] = wave_sum(acc[j]);
        if (lane == 0) {
            float gl[4]; int gt = 0;
#pragma unroll
            for (int j = 0; j < 4; ++j) gl[j] = acc[j] + brg[j];
            float gmax = gl[0];
#pragma unroll
            for (int j = 1; j < 4; ++j) if (gl[j] > gmax) { gmax = gl[j]; gt = j; }
            float gs = 0.f;
#pragma unroll
            for (int j = 0; j < 4; ++j) gs += expf(gl[j] - gmax);
            const float gw = 1.0f / gs;
            float el[8];
#pragma unroll
            for (int j = 0; j < 8; ++j) { float vv = 0.f;
#pragma unroll
                for (int g = 0; g < 4; ++g) if (g == gt) vv = acc[4 + g * 8 + j] + bre[g * 8 + j];
                el[j] = vv; }
            int i0 = 0; float m0 = el[0];
#pragma unroll
            for (int j = 1; j < 8; ++j) if (el[j] > m0) { m0 = el[j]; i0 = j; }
            int i1 = -1; float m1 = -INFINITY;
#pragma unroll
            for (int j = 0; j < 8; ++j) if (j != i0 && el[j] > m1) { m1 = el[j]; i1 = j; }
            const float e1 = expf(m1 - m0);
            const float w0 = gw / (1.0f + e1), w1 = gw * e1 / (1.0f + e1);
            const int e0i = gt * 8 + i0, e1i = gt * 8 + i1;
            K.eid()[2 * t] = e0i; K.eid()[2 * t + 1] = e1i; K.ew()[2 * t] = w0; K.ew()[2 * t + 1] = w1;
            atomicAdd(&cnt[e0i], 1); atomicAdd(&cnt[e1i], 1);
        }
    }
}
__device__ __forceinline__ void phase_scatter(Frame& F, int l) {
    const KA K = KA::fresh(); PHASE_TID;
    int* cnt = (int*)(K.ctl() + CW_CNT + 64 * l); int* cursor = (int*)(K.ctl() + CW_CNT + 128 + 64 * l);
    int* offs = (int*)F.smem;
    __syncthreads();
    if (tid == 0) { int a = 0; for (int e = 0; e < NE; ++e) { offs[e] = a; a += cnt[e]; } }
    __syncthreads();
    for (int a = F.bx * NT + tid; a < 2 * T; a += F.G * NT) {
        const int e = K.eid()[a];
        const int pos = offs[e] + atomicAdd(&cursor[e], 1);
        K.slot_tok()[pos] = a >> 1; K.slot_of()[a] = pos;
    }
    __syncthreads();
}
template <bool DUAL>
__device__ __forceinline__ void gemm_core(const bf16* A, const int* rowoff, int K, const float* B0, const float* B1, int ldb, int n0,
                                          float (&acc0)[4][4], float (&acc1)[4][4], float* As, float* Bs0, float* Bs1) {
    const int tid = __builtin_amdgcn_readfirstlane(threadIdx.x >> 6) * 64 + fresh_lane(), tx = tid & 15, ty = tid >> 4;
    const int ar = tid >> 2, ak = (tid & 3) * 4;
    const int bk = (tid >> 4) & 15, bn = (tid & 15) * 4;
    const long aoff = rowoff[ar];
#pragma unroll
    for (int i = 0; i < 4; ++i)
#pragma unroll
        for (int j = 0; j < 4; ++j) { acc0[i][j] = 0.f; acc1[i][j] = 0.f; }
#pragma unroll 1
    for (int k0 = 0; k0 < K; k0 += 16) {
        v2u av = (v2u){0u, 0u};
        if (aoff >= 0) av = *(const v2u*)(A + aoff + k0 + ak);
        f32x4 bv0 = (f32x4){0.f, 0.f, 0.f, 0.f}, bv1 = bv0;
        if (tid < 256) { bv0 = *(const f32x4*)(B0 + (size_t)(k0 + bk) * ldb + n0 + bn); if (DUAL) bv1 = *(const f32x4*)(B1 + (size_t)(k0 + bk) * ldb + n0 + bn); }
        __syncthreads();
        As[(ak + 0) * 132 + ar] = bflo(av.x); As[(ak + 1) * 132 + ar] = bfhi(av.x); As[(ak + 2) * 132 + ar] = bflo(av.y); As[(ak + 3) * 132 + ar] = bfhi(av.y);
        if (tid < 256) { *(f32x4*)(Bs0 + bk * 64 + bn) = bv0; if (DUAL) *(f32x4*)(Bs1 + bk * 64 + bn) = bv1; }
        __syncthreads();
#pragma unroll
        for (int kk = 0; kk < 16; ++kk) {
            const f32x4 a4 = *(const f32x4*)(As + kk * 132 + ty * 4);
            const f32x4 b4 = *(const f32x4*)(Bs0 + kk * 64 + tx * 4);
#pragma unroll
            for (int i = 0; i < 4; ++i)
#pragma unroll
                for (int j = 0; j < 4; ++j) acc0[i][j] += a4[i] * b4[j];
            if (DUAL) {
                const f32x4 c4 = *(const f32x4*)(Bs1 + kk * 64 + tx * 4);
#pragma unroll
                for (int i = 0; i < 4; ++i)
#pragma unroll
                    for (int j = 0; j < 4; ++j) acc1[i][j] += a4[i] * c4[j];
            }
        }
    }
}
template <int MODE>
__device__ __forceinline__ void phase_moe_ref(Frame& F, int l) {
    const KA K = KA::fresh(); PHASE_TID;
    float* As = F.smem; float* Bs0 = F.smem + 16 * 132; float* Bs1 = Bs0 + 16 * 64; int* rowoff = (int*)(Bs1 + 16 * 64); int* offs = rowoff + 128; int* toff = offs + 33;
    int* cnt = (int*)(K.ctl() + CW_CNT + 64 * l);
    const int tx = tid & 15, ty = tid >> 4;
    __syncthreads();
    if (tid == 0) { int a = 0, tt = 0; for (int e = 0; e < NE; ++e) { offs[e] = a; toff[e] = tt; const int c = cnt[e]; a += c; tt += (c + 127) / 128; } offs[NE] = a; toff[NE] = tt; }
    __syncthreads();
    constexpr int N = (MODE == 1) ? DE : D, KD = (MODE == 1) ? D : DE, NTN = N / 64;
    const int ntiles = toff[NE] * NTN;
#pragma unroll 1
    for (int t = F.bx; t < ntiles; t += F.G) {
        const int rt = t / NTN, tn = t % NTN;
        int e = 0;
        for (int j = 1; j < NE; ++j) if (toff[j] <= rt) e = j;
        const int r0 = offs[e] + (rt - toff[e]) * 128, rend = offs[e + 1];
        __syncthreads();
        if (tid < 128) { const int r = r0 + tid; rowoff[tid] = (r < rend) ? ((MODE == 1) ? K.slot_tok()[r] * D : r * DE) : -1; }
        __syncthreads();
        float acc0[4][4], acc1[4][4];
        if (MODE == 1) {
            const float* Wg = K.in(16) + ((size_t)l * NE + e) * D * DE; const float* Wu = K.in(17) + ((size_t)l * NE + e) * D * DE;
            gemm_core<true>(K.XN(), rowoff, KD, Wg, Wu, DE, tn * 64, acc0, acc1, As, Bs0, Bs1);
        } else {
            const float* Wd = K.in(18) + ((size_t)l * NE + e) * DE * D;
            gemm_core<false>(K.H1(), rowoff, KD, Wd, nullptr, D, tn * 64, acc0, acc1, As, Bs0, nullptr);
        }
#pragma unroll
        for (int i = 0; i < 4; ++i) {
            const int r = r0 + ty * 4 + i;
            if (r < rend) {
                v2u o;
                if (MODE == 1) { o.x = pk2(silu(acc0[i][0]) * acc1[i][0], silu(acc0[i][1]) * acc1[i][1]); o.y = pk2(silu(acc0[i][2]) * acc1[i][2], silu(acc0[i][3]) * acc1[i][3]);
                    *(v2u*)(K.H1() + (size_t)r * DE + tn * 64 + tx * 4) = o; }
                else { o.x = pk2(acc0[i][0], acc0[i][1]); o.y = pk2(acc0[i][2], acc0[i][3]); *(v2u*)(K.Y() + (size_t)r * D + tn * 64 + tx * 4) = o; }
            }
        }
    }
    __syncthreads();
}

constexpr int TAB_OFF = LDSCTL_OFF + 1024;
__device__ __forceinline__ void moe_tables(Frame& F, int l) {
    const KA K = KA::fresh(); PHASE_TID;
    LAS int* tab = (LAS int*)(F.lds + TAB_OFF); LAS int* offs = tab + 4 + 4 * 164; LAS int* fpre = offs + 40; LAS int* ppre = fpre + 40;
    const int* cnt = (const int*)(K.ctl() + CW_CNT + 64 * l);
    __syncthreads();
    if (tid == 0) { int a = 0, f = 0, p = 0; for (int e = 0; e < NE; ++e) { const int c = cnt[e]; offs[e] = a; fpre[e] = f; ppre[e] = p; a += c; f += c >> 8; p += (c & 255) ? 1 : 0; }
        offs[NE] = a; fpre[NE] = f; ppre[NE] = p; tab[0] = f + p; }
    __syncthreads();
    const int nfull = fpre[NE], ntile = nfull + ppre[NE];
    if (tid < ntile) {
        int e = 0;
        if (tid < nfull) { for (int j = 1; j < NE; ++j) if (fpre[j] <= tid) e = j; tab[4 + 4 * tid] = e; tab[5 + 4 * tid] = offs[e] + (tid - fpre[e]) * 256; tab[6 + 4 * tid] = offs[e + 1]; }
        else { const int q = tid - nfull; for (int j = 1; j < NE; ++j) if (ppre[j] <= q) e = j; tab[4 + 4 * tid] = e; tab[5 + 4 * tid] = offs[e] + (fpre[e + 1] - fpre[e]) * 256; tab[6 + 4 * tid] = offs[e + 1]; }
    }
    __syncthreads();
}
__device__ __forceinline__ void phase_moe_gu(Frame& F, int l) {
    moe_tables(F, l);
    const KA K = KA::fresh();
    int c_ = F.bx; asm volatile("" : "+s"(c_));
    pg8::MoeSched So{(const LAS int*)(F.lds + TAB_OFF), 2, F.G, (c_ & 7) * (F.G >> 3) + (c_ >> 3)};
    pg8::EpiMoeH E{K.H1()};
    pg8::gemm_phase_moe<pg8::EpiMoeH, pg8::MoeSched, true, 512, D>(F.lds, K.XN(), K.WguT() + (size_t)l * NE * 512 * D, K.slot_tok(), So, E, F.wave);
}
__device__ __forceinline__ void phase_moe_down(Frame& F, int l) {
    moe_tables(F, l);
    const KA K = KA::fresh();
    int c_ = F.bx; asm volatile("" : "+s"(c_));
    pg8::MoeSched So{(const LAS int*)(F.lds + TAB_OFF), 4, F.G, (c_ & 7) * (F.G >> 3) + (c_ >> 3)};
    pg8::EpiMoeY E{K.Y()};
    pg8::gemm_phase_moe<pg8::EpiMoeY, pg8::MoeSched, false, D, DE>(F.lds, K.H1(), K.WdT() + (size_t)l * NE * D * DE, nullptr, So, E, F.wave);
}
__device__ __forceinline__ void phase_combine(Frame& F, int l) {
    const KA K = KA::fresh(); PHASE_TID;
    const bool last = (l == DEPTH - 1);
    const float* gain = last ? K.in(19) : (K.in(1) + (size_t)(l + 1) * D);
#pragma unroll 1
    for (int t = F.bx * NWAVES + wave; t < T; t += F.G * NWAVES) {
        const int s0 = K.slot_of()[2 * t], s1 = K.slot_of()[2 * t + 1]; const float w0 = K.ew()[2 * t], w1 = K.ew()[2 * t + 1];
        f32x4* xr = (f32x4*)(K.out() + (size_t)t * D) + lane;
        const v2u* y0 = (const v2u*)(K.Y() + (size_t)s0 * D) + lane; const v2u* y1 = (const v2u*)(K.Y() + (size_t)s1 * D) + lane;
        f32x4 v[4]; float s = 0.f;
#pragma unroll
        for (int j = 0; j < 4; ++j) { v[j] = xr[64 * j]; const v2u a = y0[64 * j], b = y1[64 * j];
            v[j].x += w0 * bflo(a.x) + w1 * bflo(b.x); v[j].y += w0 * bfhi(a.x) + w1 * bfhi(b.x); v[j].z += w0 * bflo(a.y) + w1 * bflo(b.y); v[j].w += w0 * bfhi(a.y) + w1 * bfhi(b.y);
            s += (v[j].x * v[j].x + v[j].y * v[j].y) + (v[j].z * v[j].z + v[j].w * v[j].w); }
        const float rs = rsqrtf(wave_sum(s) * (1.f / D) + EPS);
        if (last) {
#pragma unroll
            for (int j = 0; j < 4; ++j) { const f32x4 g = ((const f32x4*)gain)[lane + 64 * j]; xr[64 * j] = (f32x4){v[j].x * rs * g.x, v[j].y * rs * g.y, v[j].z * rs * g.z, v[j].w * rs * g.w}; }
        } else {
            v2u* o8 = (v2u*)(K.XN() + (size_t)t * D) + lane;
#pragma unroll
            for (int j = 0; j < 4; ++j) { xr[64 * j] = v[j]; const f32x4 g = ((const f32x4*)gain)[lane + 64 * j];
                v2u w; w.x = pk2(v[j].x * rs * g.x, v[j].y * rs * g.y); w.y = pk2(v[j].z * rs * g.z, v[j].w * rs * g.w); o8[64 * j] = w; }
        }
    }
}

struct Args { const float* in[20]; float* out; unsigned char* ws; };
__global__ void __launch_bounds__(NT, 2) fwd_kernel(Args args) {
    extern __shared__ __attribute__((aligned(16))) unsigned char lds_raw[];
    cg::grid_group grid = cg::this_grid();
    Frame F;
    F.lds = (LAS unsigned char*)lds_raw; F.smem = (float*)lds_raw;
    F.G = gridDim.x; F.bx = blockIdx.x; F.wave = __builtin_amdgcn_readfirstlane(threadIdx.x >> 6);
    volatile LAS unsigned* MISC = (volatile LAS unsigned*)(F.lds + MISC_OFF);
    for (int u = threadIdx.x; u < (LDS_BYTES - LDSCTL_OFF) / 4; u += NT) ((LAS unsigned*)(F.lds + LDSCTL_OFF))[u] = 0u;
    __syncthreads();
    XcdBarrier bar; { const KA K = KA::fresh(); bar = xcd_barrier_post(K.ctl() + CW_BAR, MISC + 8); }
#define GRID_BAR() xcd_barrier(bar)

    p0_prologue(F);
    grid.sync();
    for (int l = 0; l < DEPTH; ++l) {
        {
            const KA K = KA::fresh(); PHASE_TID;
            pg8::Gemm g{K.XN(), K.WinT() + (size_t)l * PLD * D, T, PLD, D}; pg8::StaticOrder So; int c_ = F.bx; asm volatile("" : "+s"(c_)); So.init(T, PLD, F.G, c_);
            pg8::EpiBf16Plain E{K.P(), PLD};
            pg8::gemm_phase<pg8::EpiBf16Plain, pg8::StaticOrder, PG8_ALIGN, PG8_SP2>(F.lds, g, So, E, F.wave);
        }
        GRID_BAR();
        phase_gla_kv(F, l);
        phase_gmlp(F, l);
        phase_conv(F, l);
        GRID_BAR();
        phase_gla_scan(F);
        GRID_BAR();
        phase_gla_out(F, l);
        GRID_BAR();
        {
            const KA K = KA::fresh(); PHASE_TID;
            pg8::Gemm g{K.XN(), K.WoutT() + (size_t)l * D * D, T, D, D}; pg8::StaticOrder So; int c_ = F.bx; asm volatile("" : "+s"(c_)); So.init(T, D, F.G, c_);
            pg8::EpiF32Res E{K.out(), (l == 0) ? K.in(0) : K.out(), D};
            pg8::gemm_phase<pg8::EpiF32Res, pg8::StaticOrder, PG8_ALIGN, PG8_SP2>(F.lds, g, So, E, F.wave);
        }
        GRID_BAR();
        phase_norm_router(F, l);
        GRID_BAR();
        phase_scatter(F, l);
        GRID_BAR();
        phase_moe_gu(F, l);
        GRID_BAR();
        phase_moe_down(F, l);
        GRID_BAR();
        phase_combine(F, l);
        if (l + 1 < DEPTH) GRID_BAR();
    }
}

extern "C" void kernel_launch(void* const* d_in, const int* in_sizes, int n_in, void* d_out, int out_size, void* d_ws, size_t ws_size, hipStream_t stream) {
    static int grid_blocks = 0;
    if (!grid_blocks) {
        int dev = 0, cus = 0, per_cu = 0;
        (void)hipGetDevice(&dev);
        (void)hipDeviceGetAttribute(&cus, hipDeviceAttributeMultiprocessorCount, dev);
        (void)hipFuncSetAttribute((const void*)fwd_kernel, hipFuncAttributeMaxDynamicSharedMemorySize, LDS_BYTES);
        (void)hipOccupancyMaxActiveBlocksPerMultiprocessor(&per_cu, fwd_kernel, NT, LDS_BYTES);
        if (per_cu < 1) { fprintf(stderr, "kernel_launch: occupancy query says %d blocks/CU\n", per_cu); per_cu = 1; }
        grid_blocks = cus;
        if (ws_size < WS_END) { fprintf(stderr, "kernel_launch: workspace too small (%zu < %zu)\n", ws_size, (size_t)WS_END); grid_blocks = -1; }
    }
    if (grid_blocks < 0) return;
    (void)hipMemsetAsync((char*)d_ws + WS_CTL, 0, CTL_BYTES, stream);
    Args a{};
    for (int i = 0; i < 20; ++i) a.in[i] = (const float*)d_in[i];
    a.out = (float*)d_out; a.ws = (unsigned char*)d_ws;
    void* args[] = {&a};
    hipError_t e = hipLaunchCooperativeKernel((void*)fwd_kernel, dim3(grid_blocks), dim3(NT), args, LDS_BYTES, stream);
    if (e != hipSuccess) fprintf(stderr, "cooperative launch failed: %s (grid %d)\n", hipGetErrorString(e), grid_blocks);
}
```

```cpp
#include <hip/hip_runtime.h>
#include <hip/hip_cooperative_groups.h>
#include <cstdio>
#include <cstdint>
namespace cg = cooperative_groups;
__device__ __forceinline__ int fresh_lane() { unsigned m = 0xffffffffu; asm volatile("" : "+s"(m)); return (int)__builtin_amdgcn_mbcnt_hi(m, __builtin_amdgcn_mbcnt_lo(m, 0u)); }
__device__ __forceinline__ float shx(float v, int o) { return __int_as_float(__builtin_amdgcn_ds_bpermute((fresh_lane() ^ o) << 2, __float_as_int(v))); }
namespace pg8 {
#define PG8_LAS __attribute__((address_space(3)))
typedef unsigned short bf16_t;
typedef short bf16x8 __attribute__((ext_vector_type(8)));
typedef float f32x4 __attribute__((ext_vector_type(4)));
typedef unsigned u32x4 __attribute__((ext_vector_type(4)));
constexpr int BM = 256, BK = 64, HALF = 128, HTB = HALF * BK * 2  , STAGE_BYTES = 8 * HTB, NXCD = 8, WGM = 8;

__host__ __device__ __forceinline__ int lds_byte(int r, int c) { const int st = (r >> 4) * 2 + (c >> 5), rr = r & 15, cc = c & 31, ob = rr * 64 + cc * 2; return st * 1024 + (ob ^ (((ob >> 9) & 1) << 5)); }
__host__ __device__ __forceinline__ void stage_rc(int b, int& R, int& C) { const int st = b / 1024, sb = b % 1024, swz = sb ^ (((sb >> 9) & 1) << 5); R = (st >> 1) * 16 + swz / 64; C = (st & 1) * 32 + (swz % 64) / 2; }
__host__ __device__ __forceinline__ int perm32(int rho) { const int n = rho >> 4, i = rho & 15; return 8 * (i >> 2) + 4 * n + (i & 3); }

struct Unit { int pm, pn; };
struct Gemm { const bf16_t* A; const bf16_t* Bt; int M, N, K; };

struct StaticOrder {
    int nM, nN, nwg, G, c;
    __host__ __device__ void init(int M, int N, int G_, int c_) { nM = M / BM; nN = N / BM; nwg = nM * nN; G = G_; c = c_; }
    __host__ __device__ bool next(int i, Unit& u) const {
        const long L = (long)i * G + c; if (L >= nwg) return false;
        int wgid = (int)L; { const int q = nwg / NXCD, r = nwg % NXCD, xcd = wgid % NXCD, off = wgid / NXCD; wgid = (xcd < r ? xcd * (q + 1) : r * (q + 1) + (xcd - r) * q) + off; }
        const int nig = WGM * nN, gid = wgid / nig, fm = gid * WGM, gsz = (nM - fm) < WGM ? (nM - fm) : WGM;
        u.pm = fm + ((wgid % nig) % gsz); u.pn = (wgid % nig) / gsz; return true;
    }
    __device__ __forceinline__ void a_ready(const Unit&) const {}
    __device__ __forceinline__ void done(const Unit&) const {}
};


__device__ __forceinline__ unsigned cvt_pk_bf16(float lo, float hi) { unsigned r; asm volatile("v_cvt_pk_bf16_f32 %0, %1, %2" : "=v"(r) : "v"(lo), "v"(hi)); return r; }
struct EpiBf16Plain {
    static constexpr bool PERM = true, AFTER_DRAIN = false;
    bf16_t* O; int ldc;
    __device__ __forceinline__ void operator()(const f32x4 (&acc)[2][2][4][2], const Unit& u, int wr, int wc, int fr, int fq) const {
        const int row0 = u.pm * BM + wr * 64 + fr, col0 = u.pn * BM + wc * 32 + 8 * fq;
#pragma unroll
        for (int ai = 0; ai < 2; ++ai)
#pragma unroll
            for (int m = 0; m < 4; ++m) { bf16_t* rowp = O + (size_t)(row0 + ai * HALF + m * 16) * ldc + col0;
#pragma unroll
                for (int bj = 0; bj < 2; ++bj) { const f32x4 v0 = acc[ai][bj][m][0], v1 = acc[ai][bj][m][1];
                    u32x4 w; w.x = cvt_pk_bf16(v0[0], v0[1]); w.y = cvt_pk_bf16(v0[2], v0[3]); w.z = cvt_pk_bf16(v1[0], v1[1]); w.w = cvt_pk_bf16(v1[2], v1[3]);
                    *(u32x4*)(rowp + bj * HALF) = w; } }
    }
};
struct EpiF32Res {
    static constexpr bool PERM = false, AFTER_DRAIN = false;
    float* C; const float* R; int ldc;
    __device__ __forceinline__ void operator()(const f32x4 (&acc)[2][2][4][2], const Unit& u, int wr, int wc, int fr, int fq) const {
        const int row0 = u.pm * BM + wr * 64 + fr, col0 = u.pn * BM + wc * 32 + 4 * fq;
#pragma unroll
        for (int ai = 0; ai < 2; ++ai)
#pragma unroll
            for (int m = 0; m < 4; ++m) { const size_t off = (size_t)(row0 + ai * HALF + m * 16) * ldc + col0;
#pragma unroll
                for (int bj = 0; bj < 2; ++bj)
#pragma unroll
                    for (int n = 0; n < 2; ++n) { const f32x4 r = *(const f32x4*)(R + off + bj * HALF + n * 16); *(f32x4*)(C + off + bj * HALF + n * 16) = r + acc[ai][bj][m][n]; } }
    }
};
template <class Epi, class Sched, bool ALIGN_EPI = false, bool SP2 = false>
__device__ __forceinline__ void gemm_phase(PG8_LAS unsigned char* lds, const Gemm g, const Sched& S, const Epi& E, int wave_id) {
    asm volatile("" : "+s"(wave_id));
    const int lane = fresh_lane(), wid = wave_id, tid = wid * 64 + lane, wr = wid >> 2, wc = wid & 3, fr = lane & 15, fq = lane >> 4;
    const int K = g.K, nt = K / BK;
    unsigned voffA[2], voffB[2];
#pragma unroll
    for (int i = 0; i < 2; ++i) { int R, C; stage_rc(tid * 16 + i * 8192, R, C); const int Rb = Epi::PERM ? ((R & ~31) + perm32(R & 31)) : R;
        voffA[i] = (unsigned)(R * K + C) * 2u; voffB[i] = (unsigned)(Rb * K + C) * 2u; }
    const size_t kstep = (size_t)(BK * 2);
    const size_t hstep = (size_t)HALF * K * 2;
    const size_t tstep = 2 * hstep;
    const unsigned ldsw = (unsigned)wid * 1024u;
    const int aoff = lds_byte(wr * 64 + fr, fq * 8), boff = lds_byte(wc * 32 + fr, fq * 8);
#define PG8_SA(b, h) (((b) * 2 + (h)) * HTB)
#define PG8_SB(b, h) ((4 + (b) * 2 + (h)) * HTB)
#define PG8_STAGE(bufoff, gbase, voff) do { _Pragma("unroll") for (int _i = 0; _i < 2; ++_i) \
        __builtin_amdgcn_global_load_lds((const unsigned*)((const char*)(gbase) + (voff)[_i]), (PG8_LAS unsigned*)(lds + (bufoff) + ldsw + _i * 8192), 16, 0, 0); } while (0)
#define PG8_LDA(dst, b, h) do { _Pragma("unroll") for (int m = 0; m < 4; ++m) _Pragma("unroll") for (int k = 0; k < 2; ++k) dst[m][k] = *(const PG8_LAS bf16x8*)(lds + PG8_SA(b, h) + aoff + m * 2048 + k * 1024); } while (0)
#define PG8_LDB(dst, b, h) do { _Pragma("unroll") for (int n = 0; n < 2; ++n) _Pragma("unroll") for (int k = 0; k < 2; ++k) dst[n][k] = *(const PG8_LAS bf16x8*)(lds + PG8_SB(b, h) + boff + n * 2048 + k * 1024); } while (0)
#define PG8_MMA(ai, bj, At, Bt) do { __builtin_amdgcn_s_setprio(1); _Pragma("unroll") for (int m = 0; m < 4; ++m) _Pragma("unroll") for (int n = 0; n < 2; ++n) _Pragma("unroll") for (int k = 0; k < 2; ++k) \
        acc[ai][bj][m][n] = __builtin_amdgcn_mfma_f32_16x16x32_bf16(Bt[n][k], At[m][k], acc[ai][bj][m][n], 0, 0, 0); __builtin_amdgcn_s_setprio(0); } while (0)
#define PG8_WAIT_V(n) asm volatile("s_waitcnt vmcnt(" #n ")" ::: "memory")
#define PG8_WAIT_L(n) asm volatile("s_waitcnt lgkmcnt(" #n ")" ::: "memory")
#define PG8_BAR __builtin_amdgcn_s_barrier()
#define PG8_SCHED __builtin_amdgcn_sched_barrier(0)
    Unit cur, nxt; int ui = 0;
    if (!S.next(0, cur)) return;
    f32x4 acc[2][2][4][2];
#pragma unroll
    for (int a = 0; a < 2; ++a)
#pragma unroll
        for (int b = 0; b < 2; ++b)
#pragma unroll
            for (int m = 0; m < 4; ++m)
#pragma unroll
                for (int n = 0; n < 2; ++n) acc[a][b][m][n] = (f32x4){0.f, 0.f, 0.f, 0.f};
    bf16x8 At[4][2], B0[2][2], B1[2][2];
    const char* cA = (const char*)g.A + (size_t)cur.pm * tstep; const char* cB = (const char*)g.Bt + (size_t)cur.pn * tstep;
    S.a_ready(cur);
    if constexpr (SP2) {
        PG8_STAGE(PG8_SB(0, 0), cB, voffB); PG8_STAGE(PG8_SB(0, 1), cB + hstep, voffB); PG8_STAGE(PG8_SA(0, 0), cA, voffA); PG8_STAGE(PG8_SA(0, 1), cA + hstep, voffA);
        if (wr == 1) PG8_BAR;
        PG8_WAIT_V(2); PG8_BAR;
        PG8_STAGE(PG8_SB(1, 0), cB + kstep, voffB); PG8_STAGE(PG8_SA(1, 0), cA + kstep, voffA); PG8_STAGE(PG8_SB(1, 1), cB + hstep + kstep, voffB);
        PG8_WAIT_V(6); PG8_BAR;
    } else {
        PG8_STAGE(PG8_SB(0, 0), cB, voffB); PG8_STAGE(PG8_SA(0, 0), cA, voffA); PG8_STAGE(PG8_SB(0, 1), cB + hstep, voffB); PG8_STAGE(PG8_SA(0, 1), cA + hstep, voffA);
        if (wr == 1) PG8_BAR;
        PG8_WAIT_V(4); PG8_BAR;
        PG8_STAGE(PG8_SB(1, 0), cB + kstep, voffB); PG8_STAGE(PG8_SA(1, 0), cA + kstep, voffA); PG8_STAGE(PG8_SB(1, 1), cB + hstep + kstep, voffB);
        PG8_WAIT_V(6); PG8_BAR;
    }
    for (;;) {
        const bool has_next = S.next(ui + 1, nxt);
        const char* nA = has_next ? (const char*)g.A + (size_t)nxt.pm * tstep : cA; const char* nB = has_next ? (const char*)g.Bt + (size_t)nxt.pn * tstep : cB;
        for (int t = 0; t < nt; t += 2) {
            const bool last = (t == nt - 2);
            const char* a1 = cA + (size_t)(t + 1) * kstep;
            const char* a2 = last ? nA : cA + (size_t)(t + 2) * kstep; const char* b2 = last ? nB : cB + (size_t)(t + 2) * kstep;
            const char* a3 = a2 + kstep; const char* b3 = b2 + kstep;
            if (last && has_next) S.a_ready(nxt);
            if constexpr (SP2) {
            PG8_LDB(B0, 0, 0); PG8_LDB(B1, 0, 1); PG8_SCHED; PG8_LDA(At, 0, 0); PG8_STAGE(PG8_SA(1, 1), a1 + hstep, voffA);
            PG8_WAIT_V(8); PG8_WAIT_L(0); PG8_BAR; PG8_MMA(0, 0, At, B0); PG8_MMA(0, 1, At, B1); PG8_BAR; PG8_SCHED;
            PG8_LDA(At, 0, 1); PG8_STAGE(PG8_SB(0, 0), b2, voffB); PG8_STAGE(PG8_SB(0, 1), b2 + hstep, voffB); PG8_STAGE(PG8_SA(0, 0), a2, voffA);
            PG8_WAIT_V(8); PG8_WAIT_L(0); PG8_BAR; PG8_MMA(1, 0, At, B0); PG8_MMA(1, 1, At, B1); PG8_BAR; PG8_SCHED;
            PG8_LDB(B0, 1, 0); PG8_LDB(B1, 1, 1); PG8_SCHED; PG8_LDA(At, 1, 0); PG8_STAGE(PG8_SA(0, 1), a2 + hstep, voffA);
            PG8_WAIT_V(8); PG8_WAIT_L(0); PG8_BAR; PG8_MMA(0, 0, At, B0); PG8_MMA(0, 1, At, B1); PG8_BAR; PG8_SCHED;
            PG8_LDA(At, 1, 1); PG8_STAGE(PG8_SB(1, 0), b3, voffB); PG8_STAGE(PG8_SB(1, 1), b3 + hstep, voffB); PG8_STAGE(PG8_SA(1, 0), a3, voffA);
            PG8_WAIT_V(8); PG8_WAIT_L(0); PG8_BAR; PG8_MMA(1, 0, At, B0); PG8_MMA(1, 1, At, B1); PG8_BAR; PG8_SCHED;
            } else {
            PG8_LDB(B0, 0, 0); PG8_SCHED; PG8_LDA(At, 0, 0); PG8_STAGE(PG8_SA(1, 1), a1 + hstep, voffA);
            PG8_WAIT_L(8); PG8_BAR; PG8_WAIT_L(0); PG8_MMA(0, 0, At, B0); PG8_BAR; PG8_SCHED;
            PG8_LDB(B1, 0, 1); PG8_STAGE(PG8_SB(0, 0), b2, voffB);
            PG8_BAR; PG8_WAIT_L(0); PG8_MMA(0, 1, At, B1); PG8_BAR;
            PG8_LDA(At, 0, 1); PG8_STAGE(PG8_SA(0, 0), a2, voffA);
            PG8_BAR; PG8_WAIT_L(0); PG8_MMA(1, 0, At, B0); PG8_BAR; PG8_SCHED;
            PG8_STAGE(PG8_SB(0, 1), b2 + hstep, voffB);
            PG8_WAIT_V(6); PG8_BAR; PG8_MMA(1, 1, At, B1); PG8_BAR;
            PG8_LDB(B0, 1, 0); PG8_SCHED; PG8_LDA(At, 1, 0); PG8_STAGE(PG8_SA(0, 1), a2 + hstep, voffA);
            PG8_WAIT_L(8); PG8_BAR; PG8_WAIT_L(0); PG8_MMA(0, 0, At, B0); PG8_BAR; PG8_SCHED;
            PG8_LDB(B1, 1, 1); PG8_STAGE(PG8_SB(1, 0), b3, voffB);
            PG8_BAR; PG8_WAIT_L(0); PG8_MMA(0, 1, At, B1); PG8_BAR;
            PG8_LDA(At, 1, 1); PG8_STAGE(PG8_SA(1, 0), a3, voffA);
            PG8_BAR; PG8_WAIT_L(0); PG8_MMA(1, 0, At, B0); PG8_BAR; PG8_SCHED;
            PG8_STAGE(PG8_SB(1, 1), b3 + hstep, voffB);
            PG8_WAIT_V(6); PG8_BAR; PG8_MMA(1, 1, At, B1); PG8_BAR;
            }
        }
        if constexpr (ALIGN_EPI) { if (wr == 0) PG8_BAR; }
        if constexpr (!Epi::AFTER_DRAIN) { E(acc, cur, wr, wc, fr, fq); S.done(cur); }
        if (!has_next) break;
#pragma unroll
        for (int a = 0; a < 2; ++a)
#pragma unroll
            for (int b = 0; b < 2; ++b)
#pragma unroll
                for (int m = 0; m < 4; ++m)
#pragma unroll
                    for (int n = 0; n < 2; ++n) acc[a][b][m][n] = (f32x4){0.f, 0.f, 0.f, 0.f};
        cur = nxt; cA = nA; cB = nB; ++ui;
        if constexpr (ALIGN_EPI) { if (wr == 1) PG8_BAR; }
    }
    PG8_WAIT_V(0);
    if constexpr (!ALIGN_EPI) { if (wr == 0) PG8_BAR; }
    PG8_BAR;
    if constexpr (Epi::AFTER_DRAIN) { E.fused(acc, cur, wr, wc, fr, fq, lds, wid, lane); S.done(cur); }
#undef PG8_SA
#undef PG8_SB
#undef PG8_STAGE
#undef PG8_LDA
#undef PG8_LDB
#undef PG8_MMA
#undef PG8_WAIT_V
#undef PG8_WAIT_L
#undef PG8_BAR
#undef PG8_SCHED
}

struct MUnit { int r0, rend, e, pn; };
#define MG_LANE_OFFS(u, o) do { const int _t = wid * 64 + fresh_lane(); _Pragma("unroll") for (int _i = 0; _i < 2; ++_i) { int _R, _C; stage_rc(_t * 16 + _i * 8192, _R, _C); _Pragma("unroll") for (int _h = 0; _h < 2; ++_h) { const int _r = (u).r0 + _h * HALF + _R; \
        int _row = _r; if (GATHER) { _row = 0; if (_r < (u).rend) _row = slot_tok[_r]; } (o)[_h][_i] = (unsigned)(_row * K + _C) * 2u; } } } while (0)
template <class Epi, class Sched, bool GATHER, int N, int K>
__device__ __forceinline__ void gemm_phase_moe(PG8_LAS unsigned char* lds, const bf16_t* A, const bf16_t* Bt, const int* slot_tok, const Sched& S, const Epi& E, int wave_id) {
    asm volatile("" : "+s"(wave_id));
    const int lane = fresh_lane(), wid = wave_id, tid = wid * 64 + lane, wr = wid >> 2, wc = wid & 3, fr = lane & 15, fq = lane >> 4;
    constexpr int nt = K / BK;
#define MG_OFFP(par) ((PG8_LAS unsigned*)(lds + STAGE_BYTES + 8192) + (par) * 2048 + tid)
#define MG_VOFFB ((PG8_LAS unsigned*)(lds + STAGE_BYTES + 24576) + tid)
#pragma unroll
    for (int i = 0; i < 2; ++i) { int R, C; stage_rc(tid * 16 + i * 8192, R, C); const int Rb = Epi::PERM ? ((R & ~31) + perm32(R & 31)) : R; MG_VOFFB[i * 512] = (unsigned)(Rb * K + C) * 2u; }
    constexpr size_t kstep = (size_t)(BK * 2);
    constexpr size_t hstep = (size_t)HALF * K * 2;
    constexpr size_t tstep = 2 * hstep;
    constexpr size_t estep = (size_t)N * K * 2;
    const unsigned ldsw = (unsigned)wid * 1024u;
    const int aoff = lds_byte(wr * 64 + fr, fq * 8), boff = lds_byte(wc * 32 + fr, fq * 8);
#define PG8_SA(b, h) (((b) * 2 + (h)) * HTB)
#define PG8_SB(b, h) ((4 + (b) * 2 + (h)) * HTB)
#define PG8_STAGE(bufoff, gbase, voff) do { _Pragma("unroll") for (int _i = 0; _i < 2; ++_i) \
        __builtin_amdgcn_global_load_lds((const unsigned*)((const char*)(gbase) + MG_VOFFB[_i * 512]), (PG8_LAS unsigned*)(lds + (bufoff) + ldsw + _i * 8192), 16, 0, 0); } while (0)
#define MG_STAGE_A(bufoff, par, h, kb) do { _Pragma("unroll") for (int _i = 0; _i < 2; ++_i) \
        __builtin_amdgcn_global_load_lds((const unsigned*)((const char*)A + (size_t)MG_OFFP(par)[((h) * 2 + _i) * 512] + (kb)), (PG8_LAS unsigned*)(lds + (bufoff) + ldsw + _i * 8192), 16, 0, 0); } while (0)
#define PG8_LDA(dst, b, h) do { _Pragma("unroll") for (int m = 0; m < 4; ++m) _Pragma("unroll") for (int k = 0; k < 2; ++k) dst[m][k] = *(const PG8_LAS bf16x8*)(lds + PG8_SA(b, h) + aoff + m * 2048 + k * 1024); } while (0)
#define PG8_LDB(dst, b, h) do { _Pragma("unroll") for (int n = 0; n < 2; ++n) _Pragma("unroll") for (int k = 0; k < 2; ++k) dst[n][k] = *(const PG8_LAS bf16x8*)(lds + PG8_SB(b, h) + boff + n * 2048 + k * 1024); } while (0)
#define PG8_MMA(ai, bj, At, Bt_) do { __builtin_amdgcn_s_setprio(1); _Pragma("unroll") for (int m = 0; m < 4; ++m) _Pragma("unroll") for (int n = 0; n < 2; ++n) _Pragma("unroll") for (int k = 0; k < 2; ++k) \
        acc[ai][bj][m][n] = __builtin_amdgcn_mfma_f32_16x16x32_bf16(Bt_[n][k], At[m][k], acc[ai][bj][m][n], 0, 0, 0); __builtin_amdgcn_s_setprio(0); } while (0)
#define PG8_WAIT_V(n) asm volatile("s_waitcnt vmcnt(" #n ")" ::: "memory")
#define PG8_WAIT_L(n) asm volatile("s_waitcnt lgkmcnt(" #n ")" ::: "memory")
#define PG8_BAR __builtin_amdgcn_s_barrier()
#define PG8_SCHED __builtin_amdgcn_sched_barrier(0)
    MUnit cur, nxt; int ui = 0;
    if (!S.next(0, cur)) return;
    f32x4 acc[2][2][4][2];
#pragma unroll
    for (int a = 0; a < 2; ++a)
#pragma unroll
        for (int b = 0; b < 2; ++b)
#pragma unroll
            for (int m = 0; m < 4; ++m)
#pragma unroll
                for (int n = 0; n < 2; ++n) acc[a][b][m][n] = (f32x4){0.f, 0.f, 0.f, 0.f};
    bf16x8 At[4][2], B0[2][2], B1[2][2];
    { unsigned o_[2][2]; MG_LANE_OFFS(cur, o_); PG8_LAS unsigned* p_ = MG_OFFP(0); p_[0] = o_[0][0]; p_[512] = o_[0][1]; p_[1024] = o_[1][0]; p_[1536] = o_[1][1]; }
    const char* cB = (const char*)Bt + (size_t)cur.e * estep + (size_t)cur.pn * tstep;
    PG8_STAGE(PG8_SB(0, 0), cB, voffB); PG8_STAGE(PG8_SB(0, 1), cB + hstep, voffB); MG_STAGE_A(PG8_SA(0, 0), 0, 0, 0); MG_STAGE_A(PG8_SA(0, 1), 0, 1, 0);
    if (wr == 1) PG8_BAR;
    PG8_WAIT_V(2); PG8_BAR;
    PG8_STAGE(PG8_SB(1, 0), cB + kstep, voffB); MG_STAGE_A(PG8_SA(1, 0), 0, 0, kstep); PG8_STAGE(PG8_SB(1, 1), cB + hstep + kstep, voffB);
    PG8_WAIT_V(6); PG8_BAR;
    for (;;) {
        const bool has_next = S.next(ui + 1, nxt);
        const char* nB = cB;
        const int pc = ui & 1, pn_ = has_next ? (pc ^ 1) : pc;
        if (has_next) { unsigned on[2][2]; MG_LANE_OFFS(nxt, on); nB = (const char*)Bt + (size_t)nxt.e * estep + (size_t)nxt.pn * tstep;
            PG8_LAS unsigned* p_ = MG_OFFP(pn_); p_[0] = on[0][0]; p_[512] = on[0][1]; p_[1024] = on[1][0]; p_[1536] = on[1][1]; }
        for (int t = 0; t < nt; t += 2) {
            const bool last = (t == nt - 2);
            const size_t k1 = (size_t)(t + 1) * kstep, k2 = last ? (size_t)0 : (size_t)(t + 2) * kstep, k3 = k2 + kstep;
            const char* b2 = last ? nB : cB + (size_t)(t + 2) * kstep; const char* b3 = b2 + kstep;
            const int p2 = last ? pn_ : pc;
            PG8_LDB(B0, 0, 0); PG8_LDB(B1, 0, 1); PG8_SCHED; PG8_LDA(At, 0, 0); MG_STAGE_A(PG8_SA(1, 1), pc, 1, k1);
            PG8_WAIT_V(8); PG8_WAIT_L(0); PG8_BAR; PG8_MMA(0, 0, At, B0); PG8_MMA(0, 1, At, B1); PG8_BAR; PG8_SCHED;
            PG8_LDA(At, 0, 1); PG8_STAGE(PG8_SB(0, 0), b2, voffB); PG8_STAGE(PG8_SB(0, 1), b2 + hstep, voffB); MG_STAGE_A(PG8_SA(0, 0), p2, 0, k2);
            PG8_WAIT_V(8); PG8_WAIT_L(0); PG8_BAR; PG8_MMA(1, 0, At, B0); PG8_MMA(1, 1, At, B1); PG8_BAR; PG8_SCHED;
            PG8_LDB(B0, 1, 0); PG8_LDB(B1, 1, 1); PG8_SCHED; PG8_LDA(At, 1, 0); MG_STAGE_A(PG8_SA(0, 1), p2, 1, k2);
            PG8_WAIT_V(8); PG8_WAIT_L(0); PG8_BAR; PG8_MMA(0, 0, At, B0); PG8_MMA(0, 1, At, B1); PG8_BAR; PG8_SCHED;
            PG8_LDA(At, 1, 1); PG8_STAGE(PG8_SB(1, 0), b3, voffB); PG8_STAGE(PG8_SB(1, 1), b3 + hstep, voffB); MG_STAGE_A(PG8_SA(1, 0), p2, 0, k3);
            PG8_WAIT_V(8); PG8_WAIT_L(0); PG8_BAR; PG8_MMA(1, 0, At, B0); PG8_MMA(1, 1, At, B1); PG8_BAR; PG8_SCHED;
        }
        if (wr == 0) PG8_BAR;
        E(acc, cur, wr, wc, fr, fq);
        if (!has_next) break;
#pragma unroll
        for (int a = 0; a < 2; ++a)
#pragma unroll
            for (int b = 0; b < 2; ++b)
#pragma unroll
                for (int m = 0; m < 4; ++m)
#pragma unroll
                    for (int n = 0; n < 2; ++n) acc[a][b][m][n] = (f32x4){0.f, 0.f, 0.f, 0.f};
        cur = nxt; cB = nB; ++ui;
        if (wr == 1) PG8_BAR;
    }
    PG8_WAIT_V(0);
    PG8_BAR;
#undef PG8_SA
#undef PG8_SB
#undef PG8_STAGE
#undef MG_STAGE_A
#undef MG_OFFP
#undef MG_VOFFB
#undef PG8_LDA
#undef PG8_LDB
#undef PG8_MMA
#undef PG8_WAIT_V
#undef PG8_WAIT_L
#undef PG8_BAR
#undef PG8_SCHED
}
__device__ __forceinline__ float fast_silu(float x) { return x * __builtin_amdgcn_rcpf(1.0f + __builtin_amdgcn_exp2f(-1.4426950408889634f * x)); }
struct EpiMoeH {
    static constexpr bool PERM = true;
    bf16_t* H;
    __device__ __forceinline__ void operator()(const f32x4 (&acc)[2][2][4][2], const MUnit& u, int wr, int wc, int fr, int fq) const {
        { const int t_ = fresh_lane(); fr = t_ & 15; fq = t_ >> 4; }
        const int col0 = u.pn * 128 + wc * 32 + 8 * fq;
#pragma unroll
        for (int ai = 0; ai < 2; ++ai)
#pragma unroll
            for (int m = 0; m < 4; ++m) { const int r = u.r0 + ai * HALF + wr * 64 + m * 16 + fr;
                const f32x4 g0 = acc[ai][0][m][0], g1 = acc[ai][0][m][1], u0 = acc[ai][1][m][0], u1 = acc[ai][1][m][1];
                u32x4 w; w.x = cvt_pk_bf16(fast_silu(g0[0]) * u0[0], fast_silu(g0[1]) * u0[1]); w.y = cvt_pk_bf16(fast_silu(g0[2]) * u0[2], fast_silu(g0[3]) * u0[3]);
                w.z = cvt_pk_bf16(fast_silu(g1[0]) * u1[0], fast_silu(g1[1]) * u1[1]); w.w = cvt_pk_bf16(fast_silu(g1[2]) * u1[2], fast_silu(g1[3]) * u1[3]);
                if (r < u.rend) *(u32x4*)(H + (size_t)r * 256 + col0) = w; }
    }
};
struct EpiMoeY {
    static constexpr bool PERM = true;
    bf16_t* Y;
    __device__ __forceinline__ void operator()(const f32x4 (&acc)[2][2][4][2], const MUnit& u, int wr, int wc, int fr, int fq) const {
        { const int t_ = fresh_lane(); fr = t_ & 15; fq = t_ >> 4; }
        const int col0 = u.pn * BM + wc * 32 + 8 * fq;
#pragma unroll
        for (int ai = 0; ai < 2; ++ai)
#pragma unroll
            for (int m = 0; m < 4; ++m) { const int r = u.r0 + ai * HALF + wr * 64 + m * 16 + fr;
#pragma unroll
                for (int bj = 0; bj < 2; ++bj) { const f32x4 v0 = acc[ai][bj][m][0], v1 = acc[ai][bj][m][1];
                    u32x4 w; w.x = cvt_pk_bf16(v0[0], v0[1]); w.y = cvt_pk_bf16(v0[2], v0[3]); w.z = cvt_pk_bf16(v1[0], v1[1]); w.w = cvt_pk_bf16(v1[2], v1[3]);
                    if (r < u.rend) *(u32x4*)(Y + (size_t)r * 1024 + col0 + bj * HALF) = w; } }
    }
};
struct MoeSched {
    const PG8_LAS int* tab;
    int npn, G, c;
    __device__ __forceinline__ bool next(int i, MUnit& u) const {
        const int L = i * G + c, ntile = tab[0];
        if (L >= ntile * npn) return false;
        const int j = L / npn; u.pn = L % npn;
        u.e = __builtin_amdgcn_readfirstlane(tab[4 + 4 * j]); u.r0 = __builtin_amdgcn_readfirstlane(tab[5 + 4 * j]); u.rend = __builtin_amdgcn_readfirstlane(tab[6 + 4 * j]);
        return true;
    }
};
}

#ifndef PG8_SP2
#define PG8_SP2 true
#endif
#ifndef PG8_ALIGN
#define PG8_ALIGN true
#endif

constexpr int NWAVES = 8, NT = NWAVES * 64;
constexpr int D = 1024, NB = 2, S = 8192, T = NB * S, DEPTH = 2;
constexpr int DIN = 2832, PLD = 3072;
constexpr int C_Q = 0, C_K = 256, C_V = 512, C_G = 1024, C_GK = 1536, C_U = 1552, C_VG = 1808, C_XI = 2064, C_BG = 2320, C_CG = 2576;
constexpr int GH = 4, GC = 64, GN = S / GC;
constexpr int MH = 4, MC = 128, MN = S / MC;
constexpr int NE = 32, DE = 256;
constexpr float EPS = 1e-6f;
constexpr size_t MiB = 1u << 20;
constexpr size_t WS_CTL = 0, CTL_BYTES = 1 * MiB;
constexpr size_t WS_WIN = 1 * MiB;
constexpr size_t WS_WOUT = 13 * MiB;
constexpr size_t WS_WGU = 17 * MiB;
constexpr size_t WS_WD = 81 * MiB;
constexpr size_t WS_XN = 113 * MiB;
constexpr size_t WS_P = 145 * MiB;
constexpr size_t WS_Y = WS_P + 17 * MiB;
constexpr size_t WS_S = 241 * MiB;
constexpr size_t WS_DEC = 273 * MiB;
constexpr size_t WS_MISC = 274 * MiB;
constexpr size_t WS_WSP = WS_MISC + 524288;
constexpr size_t WS_WR = 275 * MiB;
constexpr size_t WS_END = 276 * MiB;
constexpr int CW_BAR = 4096, CW_CNT = 16384;
constexpr int RING_BYTES = 131072, LDSCTL_OFF = RING_BYTES, MISC_OFF = LDSCTL_OFF + 320, LDS_BYTES = 163840;

#define GAS __attribute__((address_space(1)))
#define LAS __attribute__((address_space(3)))
typedef unsigned short bf16;
typedef unsigned v4u __attribute__((ext_vector_type(4)));
typedef unsigned v2u __attribute__((ext_vector_type(2)));
typedef float f32x4 __attribute__((ext_vector_type(4)));
__device__ __forceinline__ unsigned f2bf(float f) { unsigned u = __builtin_bit_cast(unsigned, f); return (u + 0x7fffu + ((u >> 16) & 1u)) >> 16; }
__device__ __forceinline__ unsigned pk2(float lo, float hi) { return f2bf(lo) | (f2bf(hi) << 16); }
__device__ __forceinline__ float bf2f(unsigned v) { return __uint_as_float(v << 16); }
__device__ __forceinline__ float bflo(unsigned w) { return __uint_as_float(w << 16); }
__device__ __forceinline__ float bfhi(unsigned w) { return __uint_as_float(w & 0xffff0000u); }
__device__ __forceinline__ void unpack8(const v4u q, float (&f)[8]) { f[0] = bflo(q.x); f[1] = bfhi(q.x); f[2] = bflo(q.y); f[3] = bfhi(q.y); f[4] = bflo(q.z); f[5] = bfhi(q.z); f[6] = bflo(q.w); f[7] = bfhi(q.w); }
__device__ __forceinline__ float gelu_tanh(float x) { const float u = 0.7978845608028654f * (x + 0.044715f * x * x * x); return 0.5f * x * (1.0f + tanhf(u)); }
__device__ __forceinline__ float silu(float x) { return x / (1.0f + expf(-x)); }
__device__ __forceinline__ float log_sigmoid(float x) { return fminf(x, 0.f) - log1pf(expf(-fabsf(x))); }

#define XB_TMO      128
#define XB_XCNT(j)  (256  + 64 * (j))
#define XB_XSUB(j)  (1280 + 64 * (j))
#define XB_XGEN(j)  (2304 + 64 * (j))
#define XB_TOP      3328
#define XB_TOPGEN   3392
#define XCD_BAR_WORDS 3456
#define XB_SPIN_CAP (1u << 18)

__device__ __forceinline__ unsigned xb_ld(unsigned* p)              { return __hip_atomic_load(p, __ATOMIC_RELAXED, __HIP_MEMORY_SCOPE_AGENT); }
__device__ __forceinline__ unsigned xb_add(unsigned* p, unsigned v) { return __hip_atomic_fetch_add(p, v, __ATOMIC_RELAXED, __HIP_MEMORY_SCOPE_AGENT); }
__device__ __forceinline__ unsigned xb_xcc_id() { return (unsigned)__builtin_amdgcn_s_getreg((3 << 11) | 20) & 0xFu; }
#define XB_SPIN(cond, bar) do { unsigned _sp = 0; while (cond) { __builtin_amdgcn_s_sleep(1); \
    if ((++_sp & 255u) == 0u) { if (xb_ld(&(bar)[XB_TMO])) break; if (_sp > XB_SPIN_CAP) { atomicAdd(&(bar)[XB_TMO], 1u); break; } } } } while (0)

struct XcdBarrier {
    int wave;
    unsigned* bar; unsigned x;
    volatile LAS unsigned* st;
};

__device__ __forceinline__ XcdBarrier xcd_barrier_post(unsigned* bar, volatile LAS unsigned* st) {
    XcdBarrier b; b.bar = bar; b.x = xb_xcc_id(); b.st = st; b.wave = __builtin_amdgcn_readfirstlane(threadIdx.x >> 6);
    if (threadIdx.x == 0) (void)xb_add(&bar[XB_XCNT(b.x)], 1u);
    return b;
}
__device__ __forceinline__ void xcd_barrier_complete(unsigned* bar, unsigned x, unsigned& nloc, unsigned& nx) {
    const unsigned G = gridDim.x * gridDim.y * gridDim.z;
    unsigned sum, cnt, mine, sp = 0u;
    for (;;) {
        sum = 0u; cnt = 0u; mine = 0u;
#pragma unroll
        for (unsigned j = 0; j < 16; ++j) { const unsigned c = xb_ld(&bar[XB_XCNT(j)]); sum += c; cnt += (c > 0u) ? 1u : 0u; mine = (j == x) ? c : mine; }
        if (sum == G) break;
        __builtin_amdgcn_s_sleep(1);
        if ((++sp & 255u) == 0u) { if (xb_ld(&bar[XB_TMO])) break; if (sp > XB_SPIN_CAP) { atomicAdd(&bar[XB_TMO], 1u); break; } }
    }
    nloc = mine > 0u ? mine : 1u; nx = cnt > 0u ? cnt : 1u;
}

__device__ __forceinline__ void xcd_barrier(const XcdBarrier& b) {
    asm volatile("s_waitcnt vmcnt(0)" ::: "memory");
    __syncthreads();
    if (b.wave == 0 && fresh_lane() == 0) {
        unsigned* bar = b.bar; asm volatile("" : "+s"(bar));
        __builtin_amdgcn_s_waitcnt(0);
        unsigned nloc = b.st[0], nx = b.st[1];
        if (nloc == 0u) { xcd_barrier_complete(bar, b.x, nloc, nx); b.st[0] = nloc; b.st[1] = nx; }
        const unsigned old = xb_add(&bar[XB_XSUB(b.x)], 1u);
        const unsigned gen = old / nloc;
        if (old + 1u == (gen + 1u) * nloc) {
            __builtin_amdgcn_fence(__ATOMIC_RELEASE, "agent");
            asm volatile("s_waitcnt vmcnt(0)" ::: "memory");
            const unsigned og = xb_add(&bar[XB_TOP], 1u);
            const unsigned tg = og / nx;
            if (og + 1u == (tg + 1u) * nx) xb_add(&bar[XB_TOPGEN], 1u);
            else XB_SPIN(xb_ld(&bar[XB_TOPGEN]) == tg, bar);
            __builtin_amdgcn_fence(__ATOMIC_ACQUIRE, "agent");
            xb_add(&bar[XB_XGEN(b.x)], 1u);
            asm volatile("s_waitcnt vmcnt(0)" ::: "memory");
        } else {
            XB_SPIN(xb_ld(&bar[XB_XGEN(b.x)]) == gen, bar);
            __builtin_amdgcn_fence(__ATOMIC_ACQUIRE, "agent");
            asm volatile("s_waitcnt vmcnt(0)" ::: "memory");
        }
    }
    __syncthreads();
}

#define AS4 __attribute__((address_space(4)))
struct KA {
    const AS4 char* ka;
    static __device__ __forceinline__ KA fresh() { KA k; k.ka = (const AS4 char*)__builtin_amdgcn_kernarg_segment_ptr(); asm volatile("" : "+s"(k.ka)); return k; }
    __device__ __forceinline__ const float* in(int i) const { return *(const float* const AS4*)(ka + 8 * i); }
    __device__ __forceinline__ float* out() const { return *(float* const AS4*)(ka + 160); }
    __device__ __forceinline__ unsigned char* ws() const { return *(unsigned char* const AS4*)(ka + 168); }
    __device__ __forceinline__ unsigned* ctl() const { return (unsigned*)(ws() + WS_CTL); }
    __device__ __forceinline__ bf16* WinT() const { return (bf16*)(ws() + WS_WIN); }
    __device__ __forceinline__ bf16* WoutT() const { return (bf16*)(ws() + WS_WOUT); }
    __device__ __forceinline__ bf16* WguT() const { return (bf16*)(ws() + WS_WGU); }
    __device__ __forceinline__ bf16* WdT() const { return (bf16*)(ws() + WS_WD); }
    __device__ __forceinline__ bf16* XN() const { return (bf16*)(ws() + WS_XN); }
    __device__ __forceinline__ bf16* P() const { return (bf16*)(ws() + WS_P); }
    __device__ __forceinline__ bf16* H1() const { return (bf16*)(ws() + WS_P); }
    __device__ __forceinline__ bf16* Y() const { return (bf16*)(ws() + WS_Y); }
    __device__ __forceinline__ float* Sst() const { return (float*)(ws() + WS_S); }
    __device__ __forceinline__ float* dec() const { return (float*)(ws() + WS_DEC); }
    __device__ __forceinline__ int* eid() const { return (int*)(ws() + WS_MISC); }
    __device__ __forceinline__ float* ew() const { return (float*)(ws() + WS_MISC + 131072); }
    __device__ __forceinline__ int* slot_tok() const { return (int*)(ws() + WS_MISC + 2 * 131072); }
    __device__ __forceinline__ int* slot_of() const { return (int*)(ws() + WS_MISC + 3 * 131072); }
    __device__ __forceinline__ bf16* Wsp() const { return (bf16*)(ws() + WS_WSP); }
    __device__ __forceinline__ bf16* Wr() const { return (bf16*)(ws() + WS_WR); }
};
struct Frame {
    LAS unsigned char* lds; float* smem;
    int G, bx, wave;
};
#define PHASE_TID const int lane = fresh_lane(), wave = F.wave, tid = wave * 64 + lane; (void)lane; (void)wave; (void)tid

__device__ __forceinline__ float wave_sum(float v) {
    const int ln = fresh_lane();
#pragma unroll
    for (int o = 1; o < 64; o <<= 1) v += __int_as_float(__builtin_amdgcn_ds_bpermute((ln ^ o) << 2, __float_as_int(v)));
    return v;
}

__device__ __forceinline__ void transpose_item(const float* W, int ldw, int nvalid, int k0, int n0, bf16* WT, int ldt, int drow0, LAS float* scr, int lane) {
    const int nl = lane & 31;
#pragma unroll 8
    for (int i = 0; i < 32; ++i) { const int kk = 2 * i + (lane >> 5); scr[kk * 33 + nl] = (nl < nvalid) ? W[(size_t)(k0 + kk) * ldw + n0 + nl] : 0.f; }
    asm volatile("s_waitcnt lgkmcnt(0)" ::: "memory");
    const int c = lane & 7;
#pragma unroll
    for (int j = 0; j < 4; ++j) { const int n = (lane >> 3) + 8 * j; const LAS float* s = scr + (8 * c) * 33 + n;
        v4u o; o.x = pk2(s[0 * 33], s[1 * 33]); o.y = pk2(s[2 * 33], s[3 * 33]); o.z = pk2(s[4 * 33], s[5 * 33]); o.w = pk2(s[6 * 33], s[7 * 33]);
        if (n < nvalid) *(GAS v4u*)(WT + (size_t)(drow0 + n) * ldt + k0 + 8 * c) = o; }
    asm volatile("s_waitcnt lgkmcnt(0)" ::: "memory");
}
__device__ __forceinline__ void rms_row_to_bf16(const float* xrow, const float* gain, bf16* orow, int lane) {
    const f32x4* xr = (const f32x4*)xrow + lane;
    f32x4 v[4]; float s = 0.f;
#pragma unroll
    for (int j = 0; j < 4; ++j) { v[j] = xr[64 * j]; s += (v[j].x * v[j].x + v[j].y * v[j].y) + (v[j].z * v[j].z + v[j].w * v[j].w); }
    const float rs = rsqrtf(wave_sum(s) * (1.f / D) + EPS);
    v2u* o8 = (v2u*)orow + lane;
#pragma unroll
    for (int j = 0; j < 4; ++j) { const f32x4 g = ((const f32x4*)gain)[lane + 64 * j]; v2u w; w.x = pk2(v[j].x * rs * g.x, v[j].y * rs * g.y); w.y = pk2(v[j].z * rs * g.z, v[j].w * rs * g.w); o8[64 * j] = w; }
}
__device__ __forceinline__ void p0_prologue(Frame& F) {
    const KA K = KA::fresh(); PHASE_TID;
    LAS float* scr = (LAS float*)(F.lds + wave * 16384);
    const int gw = F.bx * NWAVES + wave, NGW = F.G * NWAVES;
    constexpr int I_IN = 16 * 89, I_OUT = 16 * 32, I_G = 32 * 16 * 8, I_D = 32 * 4 * 32, I_L = I_IN + I_OUT + 2 * I_G + I_D;
    for (int it = gw; it < DEPTH * I_L; it += NGW) {
        const int l = it / I_L; int r = it % I_L;
        if (r < I_IN) { const int kb = r / 89, nb = r % 89; const int nv = (nb == 88) ? 16 : 32;
            transpose_item(K.in(2) + (size_t)l * D * DIN, DIN, nv, kb * 64, nb * 32, K.WinT() + (size_t)l * PLD * D, D, nb * 32, scr, lane); continue; }
        r -= I_IN;
        if (r < I_OUT) { const int kb = r / 32, nb = r % 32;
            transpose_item(K.in(10) + (size_t)l * D * D, D, 32, kb * 64, nb * 32, K.WoutT() + (size_t)l * D * D, D, nb * 32, scr, lane); continue; }
        r -= I_OUT;
        if (r < 2 * I_G) { const int sel = r / I_G; r %= I_G; const int e = r / 128, kb = (r % 128) / 8, nb = r % 8; const int n0 = nb * 32;
            const float* W = K.in(16 + sel) + ((size_t)l * NE + e) * D * DE;
            transpose_item(W, DE, 32, kb * 64, n0, K.WguT() + ((size_t)l * NE + e) * 512 * D, D, (n0 >> 7) * 256 + sel * 128 + (n0 & 127), scr, lane); continue; }
        r -= 2 * I_G;
        { const int e = r / 128, kb = (r % 128) / 32, nb = r % 32;
            transpose_item(K.in(18) + ((size_t)l * NE + e) * DE * D, D, 32, kb * 64, nb * 32, K.WdT() + ((size_t)l * NE + e) * D * DE, DE, nb * 32, scr, lane); }
    }
    for (int i = F.bx * NT + tid; i < DEPTH * 240 * 128; i += F.G * NT) { const int l = i / (240 * 128), rr = (i / 128) % 240, c = i % 128;
        *(GAS v4u*)(K.WinT() + ((size_t)l * PLD + DIN + rr) * D + c * 8) = (v4u){0u, 0u, 0u, 0u}; }
    for (int i = F.bx * NT + tid; i < DEPTH * 48 * D; i += F.G * NT) { const int ll = i / (48 * D), n = (i / D) % 48, k = i % D;
        float w = 0.f;
        if (n < 4) w = K.in(12)[((size_t)ll * D + k) * 4 + n]; else if (n < 36) w = K.in(14)[((size_t)ll * D + k) * 32 + (n - 4)];
        w *= K.in(11)[(size_t)ll * D + k];
        const unsigned hi = f2bf(w), lo = f2bf(w - bf2f(hi));
        K.Wr()[((size_t)ll * 2 + 0) * 48 * D + (size_t)n * D + k] = (bf16)hi; K.Wr()[((size_t)ll * 2 + 1) * 48 * D + (size_t)n * D + k] = (bf16)lo; }
    for (int i = F.bx * NT + tid; i < DEPTH * MH * 128 * 128 / 8; i += F.G * NT) { const int e0 = i * 8, s0 = e0 & 127, t = (e0 >> 7) & 127;
        const f32x4 a = *(const f32x4*)(K.in(7) + e0), c = *(const f32x4*)(K.in(7) + e0 + 4);
        const float v[8] = {a.x, a.y, a.z, a.w, c.x, c.y, c.z, c.w}; unsigned w[4];
#pragma unroll
        for (int j = 0; j < 4; ++j) w[j] = pk2((s0 + 2 * j <= t) ? v[2 * j] : 0.f, (s0 + 2 * j + 1 <= t) ? v[2 * j + 1] : 0.f);
        *(GAS v4u*)(K.Wsp() + e0) = (v4u){w[0], w[1], w[2], w[3]}; }
    for (int m = gw; m < T; m += NGW) rms_row_to_bf16(K.in(0) + (size_t)m * D, K.in(1), K.XN() + (size_t)m * D, lane);
}

__device__ __forceinline__ void gla_cumdecay(Frame& F, const KA& K, int tid, int l, int h, int t0, float* bb) {
    const float* wup = K.in(3) + (size_t)l * 16 * 256; const float* bgk = K.in(4) + (size_t)l * 256;
    for (int e = tid; e < 64 * 64; e += NT) {
        const int c = e >> 6, d = e & 63;
        const bf16* gl = K.P() + (size_t)(t0 + c) * PLD + C_GK;
        float a = bgk[h * 64 + d];
#pragma unroll
        for (int r = 0; r < 16; ++r) a += bf2f(gl[r]) * wup[r * 256 + h * 64 + d];
        bb[c * 64 + d] = log_sigmoid(a) * (1.0f / 16.0f);
    }
    __syncthreads();
    if (tid < 64) { float run = 0.f; for (int c = 0; c < 64; ++c) { run += bb[c * 64 + tid]; bb[c * 64 + tid] = run; } }
    __syncthreads();
}
__device__ __forceinline__ void phase_gla_kv(Frame& F, int l) {
    const KA K = KA::fresh(); PHASE_TID;
    float* bb = F.smem; float* kd = F.smem + 4096;
#pragma unroll 1
    for (int ci = F.bx; ci < NB * GH * GN; ci += F.G) {
        const int b = ci / (GH * GN), h = (ci / GN) % GH, n = ci % GN, t0 = b * S + n * GC;
        __syncthreads();
        gla_cumdecay(F, K, tid, l, h, t0, bb);
        for (int e = tid; e < 4096; e += NT) { const int c = e >> 6, d = e & 63; kd[e] = bf2f(K.P()[(size_t)(t0 + c) * PLD + C_K + h * 64 + d]) * expf(bb[63 * 64 + d] - bb[e]); }
        __syncthreads();
        const int d = tid >> 3, v0 = (tid & 7) * 16;
        float acc[16];
#pragma unroll
        for (int j = 0; j < 16; ++j) acc[j] = 0.f;
#pragma unroll 2
        for (int c = 0; c < 64; ++c) {
            const float kk = kd[c * 64 + d];
            const v4u* vr = (const v4u*)(K.P() + (size_t)(t0 + c) * PLD + C_V + h * 128 + v0);
            float f[8]; unpack8(vr[0], f);
#pragma unroll
            for (int j = 0; j < 8; ++j) acc[j] += kk * f[j];
            unpack8(vr[1], f);
#pragma unroll
            for (int j = 0; j < 8; ++j) acc[8 + j] += kk * f[j];
        }
        f32x4* o = (f32x4*)(K.Sst() + ((size_t)ci * 64 + d) * 128 + v0);
#pragma unroll
        for (int j = 0; j < 4; ++j) o[j] = (f32x4){acc[4 * j], acc[4 * j + 1], acc[4 * j + 2], acc[4 * j + 3]};
        if (tid < 64) K.dec()[(size_t)ci * 64 + tid] = expf(bb[63 * 64 + tid]);
    }
}
__device__ __forceinline__ void phase_gla_scan(Frame& F) {
    const KA K = KA::fresh(); PHASE_TID;
#pragma unroll 1
    for (int e = F.bx * NT + tid; e < NB * GH * 64 * 128; e += F.G * NT) {
        const int bh = e >> 13, d = (e >> 7) & 63, v = e & 127;
        float st = 0.f;
#pragma unroll 4
        for (int n = 0; n < GN; ++n) {
            const size_t ci = (size_t)bh * GN + n;
            float* ptr = K.Sst() + (ci * 64 + d) * 128 + v;
            const float kvv = *ptr; *ptr = st;
            st = K.dec()[ci * 64 + d] * st + kvv;
        }
    }
}
__device__ __forceinline__ void phase_gla_out(Frame& F, int l) {
    const KA K = KA::fresh(); PHASE_TID;
    float* bb = F.smem; float* qd = F.smem + 4096; float* ki = F.smem + 4096 + 64 * 65; float* sc = bb;
    const float* gnorm = K.in(5) + (size_t)l * 128;
#pragma unroll 1
    for (int ci = F.bx; ci < NB * GH * GN; ci += F.G) {
        const int b = ci / (GH * GN), h = (ci / GN) % GH, n = ci % GN, t0 = b * S + n * GC;
        __syncthreads();
        gla_cumdecay(F, K, tid, l, h, t0, bb);
        for (int e = tid; e < 4096; e += NT) {
            const int c = e >> 6, d = e & 63; const float bv = bb[e];
            const bf16* row = K.P() + (size_t)(t0 + c) * PLD;
            qd[c * 65 + d] = bf2f(row[C_Q + h * 64 + d]) * 0.125f * expf(bv);
            ki[c * 65 + d] = bf2f(row[C_K + h * 64 + d]) * expf(-bv);
        }
        __syncthreads();
        {
            const int c = tid >> 3, s0 = (tid & 7) * 8;
            float a[8];
#pragma unroll
            for (int j = 0; j < 8; ++j) a[j] = 0.f;
#pragma unroll 4
            for (int d = 0; d < 64; ++d) { const float qv = qd[c * 65 + d];
#pragma unroll
                for (int j = 0; j < 8; ++j) a[j] += qv * ki[(s0 + j) * 65 + d]; }
#pragma unroll
            for (int j = 0; j < 8; ++j) sc[c * 64 + s0 + j] = (s0 + j <= c) ? a[j] : 0.f;
        }
        __syncthreads();
        const int c = tid >> 3, v0 = (tid & 7) * 16;
        float acc[16];
#pragma unroll
        for (int j = 0; j < 16; ++j) acc[j] = 0.f;
#pragma unroll 2
        for (int s = 0; s <= c; ++s) {
            const float w = sc[c * 64 + s];
            const v4u* vr = (const v4u*)(K.P() + (size_t)(t0 + s) * PLD + C_V + h * 128 + v0);
            float f[8]; unpack8(vr[0], f);
#pragma unroll
            for (int j = 0; j < 8; ++j) acc[j] += w * f[j];
            unpack8(vr[1], f);
#pragma unroll
            for (int j = 0; j < 8; ++j) acc[8 + j] += w * f[j];
        }
#pragma unroll 2
        for (int d = 0; d < 64; ++d) {
            const float w = qd[c * 65 + d];
            const f32x4* sr = (const f32x4*)(K.Sst() + ((size_t)ci * 64 + d) * 128 + v0);
#pragma unroll
            for (int j = 0; j < 4; ++j) { const f32x4 v4 = sr[j]; acc[4 * j] += w * v4.x; acc[4 * j + 1] += w * v4.y; acc[4 * j + 2] += w * v4.z; acc[4 * j + 3] += w * v4.w; }
        }
        float ss = 0.f;
#pragma unroll
        for (int j = 0; j < 16; ++j) ss += acc[j] * acc[j];
        ss += shx(ss, 1); ss += shx(ss, 2); ss += shx(ss, 4);
        const float rs = rsqrtf(ss * (1.0f / 128.0f) + EPS);
        const v4u* gr = (const v4u*)(K.P() + (size_t)(t0 + c) * PLD + C_G + h * 128 + v0);
        float g0[8], g1[8]; unpack8(gr[0], g0); unpack8(gr[1], g1);
        float o[16];
#pragma unroll
        for (int j = 0; j < 8; ++j) { o[j] = acc[j] * rs * gnorm[v0 + j] * silu(g0[j]); o[8 + j] = acc[8 + j] * rs * gnorm[v0 + 8 + j] * silu(g1[j]); }
        v4u* op = (v4u*)(K.XN() + (size_t)(t0 + c) * D + h * 128 + v0);
        op[0] = (v4u){pk2(o[0], o[1]), pk2(o[2], o[3]), pk2(o[4], o[5]), pk2(o[6], o[7])};
        op[1] = (v4u){pk2(o[8], o[9]), pk2(o[10], o[11]), pk2(o[12], o[13]), pk2(o[14], o[15])};
    }
}
__device__ __forceinline__ void phase_gmlp(Frame& F, int l) {
    const KA K = KA::fresh(); PHASE_TID;
    float* vs = F.smem;
    const float* gn = K.in(6) + (size_t)l * 256; const float* wsp = K.in(7) + (size_t)l * MH * 128 * 128; const float* bsp = K.in(8) + (size_t)l * MH * 128;
#pragma unroll 1
    for (int u = F.bx; u < NB * MN * MH; u += F.G) {
        const int b = u / (MN * MH), n = (u / MH) % MN, h = u % MH, t0 = b * S + n * MC;
        __syncthreads();
        const int s = tid >> 2, d0 = (tid & 3) * 16;
        {
            const v4u* vr = (const v4u*)(K.P() + (size_t)(t0 + s) * PLD + C_VG + h * 64 + d0);
            float g[16]; { float f[8]; unpack8(vr[0], f);
#pragma unroll
                for (int j = 0; j < 8; ++j) g[j] = gelu_tanh(f[j]);
                unpack8(vr[1], f);
#pragma unroll
                for (int j = 0; j < 8; ++j) g[8 + j] = gelu_tanh(f[j]); }
            float ss = 0.f;
#pragma unroll
            for (int j = 0; j < 16; ++j) ss += g[j] * g[j];
            ss += shx(ss, 1); ss += shx(ss, 2);
            const float rs = rsqrtf(ss * (1.0f / 64.0f) + EPS);
#pragma unroll
            for (int j = 0; j < 16; ++j) vs[s * 64 + d0 + j] = g[j] * rs * gn[h * 64 + d0 + j];
        }
        __syncthreads();
        const int t = s;
        float acc[16];
#pragma unroll
        for (int j = 0; j < 16; ++j) acc[j] = 0.f;
        const float* wr = wsp + ((size_t)h * 128 + t) * 128;
#pragma unroll 2
        for (int s2 = 0; s2 <= t; ++s2) { const float w = wr[s2];
#pragma unroll
            for (int j = 0; j < 16; ++j) acc[j] += w * vs[s2 * 64 + d0 + j]; }
        const float bias = bsp[h * 128 + t];
        const v4u* ur = (const v4u*)(K.P() + (size_t)(t0 + t) * PLD + C_U + h * 64 + d0);
        float u0[8], u1[8]; unpack8(ur[0], u0); unpack8(ur[1], u1);
        float o[16];
#pragma unroll
        for (int j = 0; j < 8; ++j) { o[j] = gelu_tanh(u0[j]) * (acc[j] + bias); o[8 + j] = gelu_tanh(u1[j]) * (acc[8 + j] + bias); }
        v4u* op = (v4u*)(K.XN() + (size_t)(t0 + t) * D + 512 + h * 64 + d0);
        op[0] = (v4u){pk2(o[0], o[1]), pk2(o[2], o[3]), pk2(o[4], o[5]), pk2(o[6], o[7])};
        op[1] = (v4u){pk2(o[8], o[9]), pk2(o[10], o[11]), pk2(o[12], o[13]), pk2(o[14], o[15])};
    }
}
typedef short bf16x8 __attribute__((ext_vector_type(8)));
__device__ __forceinline__ float fexp(float x) { return __builtin_amdgcn_exp2f(x * 1.4426950408889634f); }
__device__ __forceinline__ float logsig_fast(float x) { return fminf(x, 0.f) - __log2f(1.0f + fexp(-fabsf(x))) * 0.6931471805599453f; }
__device__ __forceinline__ float silu_fast(float x) { return x * __builtin_amdgcn_rcpf(1.0f + __builtin_amdgcn_exp2f(-1.4426950408889634f * x)); }
__device__ __forceinline__ float gelu_fast(float x) { const float u = 0.7978845608028654f * (x + 0.044715f * x * x * x); return x * __builtin_amdgcn_rcpf(1.0f + __builtin_amdgcn_exp2f(-2.8853900817779268f * u)); }
__device__ __forceinline__ f32x4 mfma16(bf16x8 a, bf16x8 b, f32x4 c) { return __builtin_amdgcn_mfma_f32_16x16x32_bf16(a, b, c, 0, 0, 0); }
constexpr int LROWB = 144;
constexpr int L_QD = 0, L_KI = 9216, L_KDT = 18432, L_VT = 27648, L_S = 46080, L_ST = 55296, L_OB = 73728, L_TOT = 107520, OBROW = 528;
#define FRAG(base, row, kel) (*(const LAS bf16x8*)(lds + (base) + (row) * LROWB + (kel) * 2))

__device__ __forceinline__ float gla_b8(const KA& K, LAS unsigned char* lds, int l, int h, int t0, int lane, int wave, float (&bv)[8]) {
    const float* wup = K.in(3) + (size_t)l * 16 * 256 + h * 64 + lane;
    float wu[16];
#pragma unroll
    for (int r = 0; r < 16; ++r) wu[r] = wup[r * 256];
    const float bg = K.in(4)[l * 256 + h * 64 + lane];
    const bf16* P = K.P();
    float run = 0.f;
#pragma unroll
    for (int j = 0; j < 8; ++j) {
        const bf16* gl = P + (size_t)(t0 + 8 * wave + j) * PLD + C_GK;
        float f0[8], f1[8]; unpack8(*(const v4u*)gl, f0); unpack8(*(const v4u*)(gl + 8), f1);
        float a = bg;
#pragma unroll
        for (int r = 0; r < 8; ++r) a += f0[r] * wu[r];
#pragma unroll
        for (int r = 0; r < 8; ++r) a += f1[r] * wu[8 + r];
        run += logsig_fast(a) * (1.0f / 16.0f); bv[j] = run;
    }
    LAS float* tot = (LAS float*)(lds + L_TOT);
    tot[wave * 64 + lane] = run;
    __syncthreads();
    float base = 0.f, all = 0.f;
#pragma unroll
    for (int g = 0; g < 8; ++g) { const float tv = tot[g * 64 + lane]; all += tv; if (g < wave) base += tv; }
#pragma unroll
    for (int j = 0; j < 8; ++j) bv[j] += base;
    return all;
}
__device__ __forceinline__ void gla_stage_vT(const bf16* P, LAS unsigned char* lds, int h, int t0, int tid) {
    const int vv = tid & 127, cq = tid >> 7;
    const bf16* vp = P + (size_t)(t0 + 16 * cq) * PLD + C_V + h * 128 + vv;
    unsigned w[8];
#pragma unroll
    for (int j = 0; j < 8; ++j) w[j] = (unsigned)vp[(size_t)(2 * j) * PLD] | ((unsigned)vp[(size_t)(2 * j + 1) * PLD] << 16);
    LAS v4u* dst = (LAS v4u*)(lds + L_VT + vv * LROWB + cq * 32);
    dst[0] = (v4u){w[0], w[1], w[2], w[3]}; dst[1] = (v4u){w[4], w[5], w[6], w[7]};
}

__device__ __forceinline__ void phase_gla_kv_mfma(Frame& F, int l) {
    const KA K = KA::fresh(); PHASE_TID;
    LAS unsigned char* lds = F.lds;
    const int fr = lane & 15, fq = lane >> 4;
#pragma unroll 1
    for (int ci = F.bx; ci < NB * GH * GN; ci += F.G) {
        const int b = ci / (GH * GN), h = (ci / GN) % GH, n = ci % GN, t0 = b * S + n * GC;
        const bf16* P = K.P();
        __syncthreads();
        float bv[8]; const float bl = gla_b8(K, lds, l, h, t0, lane, wave, bv);
        {
            const bf16* kp = P + (size_t)(t0 + 8 * wave) * PLD + C_K + h * 64 + lane;
            float kd[8];
#pragma unroll
            for (int j = 0; j < 8; ++j) kd[j] = bf2f(kp[(size_t)j * PLD]) * fexp(bl - bv[j]);
            *(LAS v4u*)(lds + L_KDT + lane * LROWB + wave * 16) = (v4u){pk2(kd[0], kd[1]), pk2(kd[2], kd[3]), pk2(kd[4], kd[5]), pk2(kd[6], kd[7])};
        }
        gla_stage_vT(P, lds, h, t0, tid);
        if (wave == 0) K.dec()[(size_t)ci * 64 + lane] = fexp(bl);
        __syncthreads();
        bf16x8 Bf[2];
#pragma unroll
        for (int ks = 0; ks < 2; ++ks) Bf[ks] = FRAG(L_VT, 16 * wave + fr, 32 * ks + 8 * fq);
        float* so = K.Sst() + (size_t)ci * 64 * 128 + 16 * wave + fr;
#pragma unroll
        for (int dt = 0; dt < 4; ++dt) {
            f32x4 acc = (f32x4){0.f, 0.f, 0.f, 0.f};
#pragma unroll
            for (int ks = 0; ks < 2; ++ks) acc = mfma16(FRAG(L_KDT, 16 * dt + fr, 32 * ks + 8 * fq), Bf[ks], acc);
#pragma unroll
            for (int r = 0; r < 4; ++r) so[(size_t)(16 * dt + 4 * fq + r) * 128] = acc[r];
        }
    }
}

__device__ __forceinline__ void phase_gla_out_mfma(Frame& F, int l) {
    const KA K = KA::fresh(); PHASE_TID;
    LAS unsigned char* lds = F.lds;
    const int fr = lane & 15, fq = lane >> 4;
    const float* gnorm = K.in(5) + (size_t)l * 128;
#pragma unroll 1
    for (int ci = F.bx; ci < NB * GH * GN; ci += F.G) {
        const int b = ci / (GH * GN), h = (ci / GN) % GH, n = ci % GN, t0 = b * S + n * GC;
        const bf16* P = K.P();
        __syncthreads();
        float bv[8]; (void)gla_b8(K, lds, l, h, t0, lane, wave, bv);
        {
            const bf16* qp = P + (size_t)(t0 + 8 * wave) * PLD + C_Q + h * 64 + lane;
            const bf16* kp = qp + (C_K - C_Q);
#pragma unroll
            for (int j = 0; j < 8; ++j) {
                const float e = fexp(bv[j]);
                const float qv = bf2f(qp[(size_t)j * PLD]) * 0.125f * e, kv = bf2f(kp[(size_t)j * PLD]) * __builtin_amdgcn_rcpf(e);
                *(LAS bf16*)(lds + L_QD + (8 * wave + j) * LROWB + lane * 2) = (bf16)f2bf(qv);
                *(LAS bf16*)(lds + L_KI + (8 * wave + j) * LROWB + lane * 2) = (bf16)f2bf(kv);
            }
        }
        gla_stage_vT(P, lds, h, t0, tid);
        {
            const int vv = tid & 127, dq = tid >> 7;
            const float* sp = K.Sst() + ((size_t)ci * 64 + 16 * dq) * 128 + vv;
            unsigned w[8];
#pragma unroll
            for (int j = 0; j < 8; ++j) w[j] = pk2(sp[(size_t)(2 * j) * 128], sp[(size_t)(2 * j + 1) * 128]);
            LAS v4u* dst = (LAS v4u*)(lds + L_ST + vv * LROWB + dq * 32);
            dst[0] = (v4u){w[0], w[1], w[2], w[3]}; dst[1] = (v4u){w[4], w[5], w[6], w[7]};
        }
        __syncthreads();
#pragma unroll
        for (int i = 0; i < 2; ++i) {
            const int tix = 2 * wave + i, st = tix >> 2, ct = tix & 3;
            f32x4 acc = (f32x4){0.f, 0.f, 0.f, 0.f};
#pragma unroll
            for (int ks = 0; ks < 2; ++ks) acc = mfma16(FRAG(L_KI, 16 * st + fr, 32 * ks + 8 * fq), FRAG(L_QD, 16 * ct + fr, 32 * ks + 8 * fq), acc);
            const int s0 = 16 * st + 4 * fq, c = 16 * ct + fr;
            float m[4];
#pragma unroll
            for (int r = 0; r < 4; ++r) m[r] = (s0 + r <= c) ? acc[r] : 0.f;
            *(LAS v2u*)(lds + L_S + c * LROWB + s0 * 2) = (v2u){pk2(m[0], m[1]), pk2(m[2], m[3])};
        }
        __syncthreads();
        {
            bf16x8 Av[2], As[2];
#pragma unroll
            for (int ks = 0; ks < 2; ++ks) { Av[ks] = FRAG(L_VT, 16 * wave + fr, 32 * ks + 8 * fq); As[ks] = FRAG(L_ST, 16 * wave + fr, 32 * ks + 8 * fq); }
#pragma unroll
            for (int ct = 0; ct < 4; ++ct) {
                f32x4 acc = (f32x4){0.f, 0.f, 0.f, 0.f};
#pragma unroll
                for (int ks = 0; ks < 2; ++ks) { acc = mfma16(Av[ks], FRAG(L_S, 16 * ct + fr, 32 * ks + 8 * fq), acc); acc = mfma16(As[ks], FRAG(L_QD, 16 * ct + fr, 32 * ks + 8 * fq), acc); }
                *(LAS f32x4*)(lds + L_OB + (16 * ct + fr) * OBROW + (16 * wave + 4 * fq) * 4) = acc;
            }
        }
        __syncthreads();
        {
            const int c = tid >> 3, vg = tid & 7;
            const LAS f32x4* ob = (const LAS f32x4*)(lds + L_OB + c * OBROW + vg * 64);
            f32x4 o[4]; float ss = 0.f;
#pragma unroll
            for (int j = 0; j < 4; ++j) { o[j] = ob[j]; ss += (o[j].x * o[j].x + o[j].y * o[j].y) + (o[j].z * o[j].z + o[j].w * o[j].w); }
            ss += shx(ss, 1); ss += shx(ss, 2); ss += shx(ss, 4);
            const float rs = rsqrtf(ss * (1.0f / 128.0f) + EPS);
            const v4u* gr = (const v4u*)(P + (size_t)(t0 + c) * PLD + C_G + h * 128 + 16 * vg);
            float g0[8], g1[8]; unpack8(gr[0], g0); unpack8(gr[1], g1);
            const f32x4* gn = (const f32x4*)(gnorm + 16 * vg);
            const f32x4 n0 = gn[0], n1 = gn[1], n2 = gn[2], n3 = gn[3];
            v4u w0, w1;
            w0.x = pk2(o[0].x * rs * n0.x * silu_fast(g0[0]), o[0].y * rs * n0.y * silu_fast(g0[1])); w0.y = pk2(o[0].z * rs * n0.z * silu_fast(g0[2]), o[0].w * rs * n0.w * silu_fast(g0[3]));
            w0.z = pk2(o[1].x * rs * n1.x * silu_fast(g0[4]), o[1].y * rs * n1.y * silu_fast(g0[5])); w0.w = pk2(o[1].z * rs * n1.z * silu_fast(g0[6]), o[1].w * rs * n1.w * silu_fast(g0[7]));
            w1.x = pk2(o[2].x * rs * n2.x * silu_fast(g1[0]), o[2].y * rs * n2.y * silu_fast(g1[1])); w1.y = pk2(o[2].z * rs * n2.z * silu_fast(g1[2]), o[2].w * rs * n2.w * silu_fast(g1[3]));
            w1.z = pk2(o[3].x * rs * n3.x * silu_fast(g1[4]), o[3].y * rs * n3.y * silu_fast(g1[5])); w1.w = pk2(o[3].z * rs * n3.z * silu_fast(g1[6]), o[3].w * rs * n3.w * silu_fast(g1[7]));
            v4u* op = (v4u*)(K.XN() + (size_t)(t0 + c) * D + h * 128 + 16 * vg);
            op[0] = w0; op[1] = w1;
        }
    }
}
#undef FRAG

constexpr int GM_ROWB = 272;
__device__ __forceinline__ void phase_gmlp_mfma(Frame& F, int l) {
    const KA K = KA::fresh(); PHASE_TID;
    LAS unsigned char* lds = F.lds;
    const int fr = lane & 15, fq = lane >> 4;
#pragma unroll 1
    for (int u = F.bx; u < NB * MN * MH; u += F.G) {
        const int b = u / (MN * MH), n = (u / MH) % MN, h = u % MH, t0 = b * S + n * MC;
        const bf16* P = K.P();
        const float gn = K.in(6)[(size_t)l * 256 + h * 64 + lane];
        __syncthreads();
#pragma unroll
        for (int q = 0; q < 2; ++q) {
            float vs[8];
#pragma unroll
            for (int i = 0; i < 8; ++i) {
                const float g = gelu_fast(bf2f(P[(size_t)(t0 + 16 * wave + 8 * q + i) * PLD + C_VG + h * 64 + lane]));
                const float ss = wave_sum(g * g);
                vs[i] = g * rsqrtf(ss * (1.0f / 64.0f) + EPS) * gn;
            }
            *(LAS v4u*)(lds + lane * GM_ROWB + (16 * wave + 8 * q) * 2) = (v4u){pk2(vs[0], vs[1]), pk2(vs[2], vs[3]), pk2(vs[4], vs[5]), pk2(vs[6], vs[7])};
        }
        __syncthreads();
        const bf16* Wb = K.Wsp() + ((size_t)(l * MH + h) * 128 + 16 * wave + fr) * 128 + 8 * fq;
        f32x4 acc[4];
#pragma unroll
        for (int dt = 0; dt < 4; ++dt) acc[dt] = (f32x4){0.f, 0.f, 0.f, 0.f};
        const int nks = (16 * wave + 15) / 32 + 1;
#pragma unroll
        for (int ks = 0; ks < 4; ++ks) if (ks < nks) {
            const bf16x8 Bf = *(const bf16x8*)(Wb + 32 * ks);
#pragma unroll
            for (int dt = 0; dt < 4; ++dt) acc[dt] = mfma16(*(const LAS bf16x8*)(lds + (16 * dt + fr) * GM_ROWB + (32 * ks + 8 * fq) * 2), Bf, acc[dt]);
        }
        const int t = 16 * wave + fr;
        const float bias = K.in(8)[(size_t)l * MH * 128 + h * 128 + t];
        const bf16* up = P + (size_t)(t0 + t) * PLD + C_U + h * 64 + 4 * fq;
        bf16* op = K.XN() + (size_t)(t0 + t) * D + 512 + h * 64 + 4 * fq;
#pragma unroll
        for (int dt = 0; dt < 4; ++dt) {
            const v2u uw = *(const v2u*)(up + 16 * dt);
            const float o0 = gelu_fast(bflo(uw.x)) * (acc[dt][0] + bias), o1 = gelu_fast(bfhi(uw.x)) * (acc[dt][1] + bias), o2 = gelu_fast(bflo(uw.y)) * (acc[dt][2] + bias), o3 = gelu_fast(bfhi(uw.y)) * (acc[dt][3] + bias);
            *(v2u*)(op + 16 * dt) = (v2u){pk2(o0, o1), pk2(o2, o3)};
        }
    }
}

__device__ __forceinline__ void phase_conv(Frame& F, int l) {
    const KA K = KA::fresh(); PHASE_TID;
    const float* wc = K.in(9) + (size_t)l * 3 * 256;
#pragma unroll 1
    for (int e = F.bx * NT + tid; e < T * 32; e += F.G * NT) {
        const int t = e >> 5, c0 = (e & 31) * 8, tl = t % S;
        const bf16* row = K.P() + (size_t)t * PLD;
        float y[8], xi[8], cg[8], bg[8];
        unpack8(*(const v4u*)(row + C_XI + c0), xi); unpack8(*(const v4u*)(row + C_CG + c0), cg); unpack8(*(const v4u*)(row + C_BG + c0), bg);
#pragma unroll
        for (int j = 0; j < 8; ++j) y[j] = wc[2 * 256 + c0 + j] * cg[j] * xi[j];
        if (tl >= 1) { unpack8(*(const v4u*)(row - PLD + C_XI + c0), xi); unpack8(*(const v4u*)(row - PLD + C_CG + c0), cg);
#pragma unroll
            for (int j = 0; j < 8; ++j) y[j] += wc[1 * 256 + c0 + j] * cg[j] * xi[j]; }
        if (tl >= 2) { unpack8(*(const v4u*)(row - 2 * PLD + C_XI + c0), xi); unpack8(*(const v4u*)(row - 2 * PLD + C_CG + c0), cg);
#pragma unroll
            for (int j = 0; j < 8; ++j) y[j] += wc[0 * 256 + c0 + j] * cg[j] * xi[j]; }
#pragma unroll
        for (int j = 0; j < 8; ++j) y[j] *= bg[j];
        *(v4u*)(K.XN() + (size_t)t * D + 768 + c0) = (v4u){pk2(y[0], y[1]), pk2(y[2], y[3]), pk2(y[4], y[5]), pk2(y[6], y[7])};
    }
}
__device__ __forceinline__ void phase_norm_router(Frame& F, int l) {
    const KA K = KA::fresh(); PHASE_TID;
    const float* gain = K.in(11) + (size_t)l * D;
    const float* wrg = K.in(12) + (size_t)l * D * 4; const float* brg = K.in(13) + (size_t)l * 4;
    const float* wre = K.in(14) + (size_t)l * D * 32; const float* bre = K.in(15) + (size_t)l * 32;
    int* cnt = (int*)(K.ctl() + CW_CNT + 64 * l);
#pragma unroll 1
    for (int t = F.bx * NWAVES + wave; t < T; t += F.G * NWAVES) {
        const f32x4* xr = (const f32x4*)(K.out() + (size_t)t * D) + lane;
        f32x4 v[4]; float s = 0.f;
#pragma unroll
        for (int j = 0; j < 4; ++j) { v[j] = xr[64 * j]; s += (v[j].x * v[j].x + v[j].y * v[j].y) + (v[j].z * v[j].z + v[j].w * v[j].w); }
        const float rs = rsqrtf(wave_sum(s) * (1.f / D) + EPS);
        v2u* o8 = (v2u*)(K.XN() + (size_t)t * D) + lane;
        float acc[36];
#pragma unroll
        for (int j = 0; j < 36; ++j) acc[j] = 0.f;
#pragma unroll
        for (int j = 0; j < 4; ++j) {
            const f32x4 g = ((const f32x4*)gain)[lane + 64 * j];
            const float hv[4] = {v[j].x * rs * g.x, v[j].y * rs * g.y, v[j].z * rs * g.z, v[j].w * rs * g.w};
            v2u w; w.x = pk2(hv[0], hv[1]); w.y = pk2(hv[2], hv[3]); o8[64 * j] = w;
#pragma unroll
            for (int i = 0; i < 4; ++i) {
                const int k = 4 * lane + 256 * j + i; const float xv = hv[i];
                const f32x4 g4 = *(const f32x4*)(wrg + (size_t)k * 4);
                acc[0] += xv * g4.x; acc[1] += xv * g4.y; acc[2] += xv * g4.z; acc[3] += xv * g4.w;
                const f32x4* e4 = (const f32x4*)(wre + (size_t)k * 32);
#pragma unroll
                for (int q = 0; q < 8; ++q) { const f32x4 w4 = e4[q]; acc[4 + 4 * q] += xv * w4.x; acc[5 + 4 * q] += xv * w4.y; acc[6 + 4 * q] += xv * w4.z; acc[7 + 4 * q] += xv * w4.w; }
            }
        }
#pragma unroll
        for (int j = 0; j < 36; ++j) acc[j] = wave_sum(acc[j]);
        if (lane == 0) {
            float gl[4]; int gt = 0;
#pragma unroll
            for (int j = 0; j < 4; ++j) gl[j] = acc[j] + brg[j];
            float gmax = gl[0];
#pragma unroll
            for (int j = 1; j < 4; ++j) if (gl[j] > gmax) { gmax = gl[j]; gt = j; }
            float gs = 0.f;
#pragma unroll
            for (int j = 0; j < 4; ++j) gs += expf(gl[j] - gmax);
            const float gw = 1.0f / gs;
            float el[8];
#pragma unroll
            for (int j = 0; j < 8; ++j) { float vv = 0.f;
#pragma unroll
                for (int g = 0; g < 4; ++g) if (g == gt) vv = acc[4 + g * 8 + j] + bre[g * 8 + j];
                el[j] = vv; }
            int i0 = 0; float m0 = el[0];
#pragma unroll
            for (int j = 1; j < 8; ++j) if (el[j] > m0) { m0 = el[j]; i0 = j; }
            int i1 = -1; float m1 = -INFINITY;
#pragma unroll
            for (int j = 0; j < 8; ++j) if (j != i0 && el[j] > m1) { m1 = el[j]; i1 = j; }
            const float e1 = expf(m1 - m0);
            const float w0 = gw / (1.0f + e1), w1 = gw * e1 / (1.0f + e1);
            const int e0i = gt * 8 + i0, e1i = gt * 8 + i1;
            K.eid()[2 * t] = e0i; K.eid()[2 * t + 1] = e1i; K.ew()[2 * t] = w0; K.ew()[2 * t + 1] = w1;
            atomicAdd(&cnt[e0i], 1); atomicAdd(&cnt[e1i], 1);
        }
    }
}
constexpr int RT_PART = 0, RT_SS = RT_PART + 4 * 2 * 16 * 48 * 4, RT_RS = RT_SS + 4 * 2 * 16 * 4;
__device__ __forceinline__ void phase_norm_router_mfma(Frame& F, int l) {
    const KA K = KA::fresh(); PHASE_TID;
    LAS unsigned char* lds = F.lds;
    const int fr = lane & 15, fq = lane >> 4, tl = wave >> 1, kh = wave & 1;
    const bf16* Whi = K.Wr() + (size_t)l * 2 * 48 * D; const bf16* Wlo = Whi + 48 * D;
    const float* gain = K.in(11) + (size_t)l * D;
    int* cnt = (int*)(K.ctl() + CW_CNT + 64 * l);
#pragma unroll 1
    for (int blk = F.bx; blk < T / 64; blk += F.G) {
        const int tok0 = blk * 64 + tl * 16;
        const float* xr = K.out() + (size_t)(tok0 + fr) * D + 512 * kh + 8 * fq;
        const bf16* whi = Whi + (size_t)fr * D + 512 * kh + 8 * fq; const bf16* wlo = Wlo + (size_t)fr * D + 512 * kh + 8 * fq;
        f32x4 acc[3];
#pragma unroll
        for (int nt = 0; nt < 3; ++nt) acc[nt] = (f32x4){0.f, 0.f, 0.f, 0.f};
        float ss = 0.f;
        __syncthreads();
#pragma unroll 2
        for (int ks = 0; ks < 16; ++ks) {
            const f32x4 x0 = *(const f32x4*)(xr + 32 * ks), x1 = *(const f32x4*)(xr + 32 * ks + 4);
            const float xv[8] = {x0.x, x0.y, x0.z, x0.w, x1.x, x1.y, x1.z, x1.w};
            unsigned hw[4], lw[4];
#pragma unroll
            for (int j = 0; j < 4; ++j) { const float a = xv[2 * j], b2 = xv[2 * j + 1]; ss += a * a + b2 * b2;
                const unsigned ha = f2bf(a), hb = f2bf(b2); hw[j] = ha | (hb << 16); lw[j] = pk2(a - bf2f(ha), b2 - bf2f(hb)); }
            bf16x8 Ah, Al; { v4u t4 = (v4u){hw[0], hw[1], hw[2], hw[3]}; Ah = __builtin_bit_cast(bf16x8, t4); t4 = (v4u){lw[0], lw[1], lw[2], lw[3]}; Al = __builtin_bit_cast(bf16x8, t4); }
#pragma unroll
            for (int nt = 0; nt < 3; ++nt) {
                const bf16x8 Bh = *(const bf16x8*)(whi + (size_t)(16 * nt) * D + 32 * ks), Bl = *(const bf16x8*)(wlo + (size_t)(16 * nt) * D + 32 * ks);
                acc[nt] = mfma16(Ah, Bh, acc[nt]); acc[nt] = mfma16(Al, Bh, acc[nt]); acc[nt] = mfma16(Ah, Bl, acc[nt]);
            }
        }
        ss += shx(ss, 16); ss += shx(ss, 32);
        {
            LAS float* part = (LAS float*)(lds + RT_PART) + (tl * 2 + kh) * 16 * 48;
#pragma unroll
            for (int nt = 0; nt < 3; ++nt)
#pragma unroll
                for (int r = 0; r < 4; ++r) part[(4 * fq + r) * 48 + 16 * nt + fr] = acc[nt][r];
            if (fq == 0) ((LAS float*)(lds + RT_SS))[(tl * 2 + kh) * 16 + fr] = ss;
        }
        __syncthreads();
        if (kh == 0 && lane < 16) {
            const int t = tok0 + lane;
            const LAS float* p0 = (const LAS float*)(lds + RT_PART) + (tl * 2) * 16 * 48 + lane * 48; const LAS float* p1 = p0 + 16 * 48;
            const LAS float* s2 = (const LAS float*)(lds + RT_SS) + (tl * 2) * 16;
            const float rs = rsqrtf((s2[lane] + s2[16 + lane]) * (1.f / D) + EPS);
            ((LAS float*)(lds + RT_RS))[tl * 16 + lane] = rs;
            const float* brg = K.in(13) + (size_t)l * 4; const float* bre = K.in(15) + (size_t)l * 32;
            float gl[4]; int gt = 0;
#pragma unroll
            for (int j = 0; j < 4; ++j) gl[j] = (p0[j] + p1[j]) * rs + brg[j];
            float gmax = gl[0];
#pragma unroll
            for (int j = 1; j < 4; ++j) if (gl[j] > gmax) { gmax = gl[j]; gt = j; }
            float gs = 0.f;
#pragma unroll
            for (int j = 0; j < 4; ++j) gs += expf(gl[j] - gmax);
            const float gw = 1.0f / gs;
            float el[8];
#pragma unroll
            for (int j = 0; j < 8; ++j) el[j] = (p0[4 + gt * 8 + j] + p1[4 + gt * 8 + j]) * rs + bre[gt * 8 + j];
            int i0 = 0; float m0 = el[0];
#pragma unroll
            for (int j = 1; j < 8; ++j) if (el[j] > m0) { m0 = el[j]; i0 = j; }
            int i1 = -1; float m1 = -INFINITY;
#pragma unroll
            for (int j = 0; j < 8; ++j) if (j != i0 && el[j] > m1) { m1 = el[j]; i1 = j; }
            const float e1 = expf(m1 - m0);
            const float w0 = gw / (1.0f + e1), w1 = gw * e1 / (1.0f + e1);
            const int e0i = gt * 8 + i0, e1i = gt * 8 + i1;
            K.eid()[2 * t] = e0i; K.eid()[2 * t + 1] = e1i; K.ew()[2 * t] = w0; K.ew()[2 * t + 1] = w1;
            atomicAdd(&cnt[e0i], 1); atomicAdd(&cnt[e1i], 1);
        }
        __syncthreads();
        {
            const float rs = ((const LAS float*)(lds + RT_RS))[tl * 16 + fr];
            bf16* hp = K.XN() + (size_t)(tok0 + fr) * D + 512 * kh + 8 * fq;
            const float* gp = gain + 512 * kh + 8 * fq;
#pragma unroll 4
            for (int ks = 0; ks < 16; ++ks) {
                const f32x4 x0 = *(const f32x4*)(xr + 32 * ks), x1 = *(const f32x4*)(xr + 32 * ks + 4);
                const f32x4 g0 = *(const f32x4*)(gp + 32 * ks), g1 = *(const f32x4*)(gp + 32 * ks + 4);
                *(v4u*)(hp + 32 * ks) = (v4u){pk2(x0.x * rs * g0.x, x0.y * rs * g0.y), pk2(x0.z * rs * g0.z, x0.w * rs * g0.w), pk2(x1.x * rs * g1.x, x1.y * rs * g1.y), pk2(x1.z * rs * g1.z, x1.w * rs * g1.w)};
            }
        }
    }
}
__device__ __forceinline__ void phase_scatter(Frame& F, int l) {
    const KA K = KA::fresh(); PHASE_TID;
    int* cnt = (int*)(K.ctl() + CW_CNT + 64 * l); int* cursor = (int*)(K.ctl() + CW_CNT + 128 + 64 * l);
    int* offs = (int*)F.smem;
    __syncthreads();
    if (tid == 0) { int a = 0; for (int e = 0; e < NE; ++e) { offs[e] = a; a += cnt[e]; } }
    __syncthreads();
    for (int a = F.bx * NT + tid; a < 2 * T; a += F.G * NT) {
        const int e = K.eid()[a];
        const int pos = offs[e] + atomicAdd(&cursor[e], 1);
        K.slot_tok()[pos] = a >> 1; K.slot_of()[a] = pos;
    }
    __syncthreads();
}
template <bool DUAL>
__device__ __forceinline__ void gemm_core(const bf16* A, const int* rowoff, int K, const float* B0, const float* B1, int ldb, int n0,
                                          float (&acc0)[4][4], float (&acc1)[4][4], float* As, float* Bs0, float* Bs1) {
    const int tid = __builtin_amdgcn_readfirstlane(threadIdx.x >> 6) * 64 + fresh_lane(), tx = tid & 15, ty = tid >> 4;
    const int ar = tid >> 2, ak = (tid & 3) * 4;
    const int bk = (tid >> 4) & 15, bn = (tid & 15) * 4;
    const long aoff = rowoff[ar];
#pragma unroll
    for (int i = 0; i < 4; ++i)
#pragma unroll
        for (int j = 0; j < 4; ++j) { acc0[i][j] = 0.f; acc1[i][j] = 0.f; }
#pragma unroll 1
    for (int k0 = 0; k0 < K; k0 += 16) {
        v2u av = (v2u){0u, 0u};
        if (aoff >= 0) av = *(const v2u*)(A + aoff + k0 + ak);
        f32x4 bv0 = (f32x4){0.f, 0.f, 0.f, 0.f}, bv1 = bv0;
        if (tid < 256) { bv0 = *(const f32x4*)(B0 + (size_t)(k0 + bk) * ldb + n0 + bn); if (DUAL) bv1 = *(const f32x4*)(B1 + (size_t)(k0 + bk) * ldb + n0 + bn); }
        __syncthreads();
        As[(ak + 0) * 132 + ar] = bflo(av.x); As[(ak + 1) * 132 + ar] = bfhi(av.x); As[(ak + 2) * 132 + ar] = bflo(av.y); As[(ak + 3) * 132 + ar] = bfhi(av.y);
        if (tid < 256) { *(f32x4*)(Bs0 + bk * 64 + bn) = bv0; if (DUAL) *(f32x4*)(Bs1 + bk * 64 + bn) = bv1; }
        __syncthreads();
#pragma unroll
        for (int kk = 0; kk < 16; ++kk) {
            const f32x4 a4 = *(const f32x4*)(As + kk * 132 + ty * 4);
            const f32x4 b4 = *(const f32x4*)(Bs0 + kk * 64 + tx * 4);
#pragma unroll
            for (int i = 0; i < 4; ++i)
#pragma unroll
                for (int j = 0; j < 4; ++j) acc0[i][j] += a4[i] * b4[j];
            if (DUAL) {
                const f32x4 c4 = *(const f32x4*)(Bs1 + kk * 64 + tx * 4);
#pragma unroll
                for (int i = 0; i < 4; ++i)
#pragma unroll
                    for (int j = 0; j < 4; ++j) acc1[i][j] += a4[i] * c4[j];
            }
        }
    }
}
template <int MODE>
__device__ __forceinline__ void phase_moe_ref(Frame& F, int l) {
    const KA K = KA::fresh(); PHASE_TID;
    float* As = F.smem; float* Bs0 = F.smem + 16 * 132; float* Bs1 = Bs0 + 16 * 64; int* rowoff = (int*)(Bs1 + 16 * 64); int* offs = rowoff + 128; int* toff = offs + 33;
    int* cnt = (int*)(K.ctl() + CW_CNT + 64 * l);
    const int tx = tid & 15, ty = tid >> 4;
    __syncthreads();
    if (tid == 0) { int a = 0, tt = 0; for (int e = 0; e < NE; ++e) { offs[e] = a; toff[e] = tt; const int c = cnt[e]; a += c; tt += (c + 127) / 128; } offs[NE] = a; toff[NE] = tt; }
    __syncthreads();
    constexpr int N = (MODE == 1) ? DE : D, KD = (MODE == 1) ? D : DE, NTN = N / 64;
    const int ntiles = toff[NE] * NTN;
#pragma unroll 1
    for (int t = F.bx; t < ntiles; t += F.G) {
        const int rt = t / NTN, tn = t % NTN;
        int e = 0;
        for (int j = 1; j < NE; ++j) if (toff[j] <= rt) e = j;
        const int r0 = offs[e] + (rt - toff[e]) * 128, rend = offs[e + 1];
        __syncthreads();
        if (tid < 128) { const int r = r0 + tid; rowoff[tid] = (r < rend) ? ((MODE == 1) ? K.slot_tok()[r] * D : r * DE) : -1; }
        __syncthreads();
        float acc0[4][4], acc1[4][4];
        if (MODE == 1) {
            const float* Wg = K.in(16) + ((size_t)l * NE + e) * D * DE; const float* Wu = K.in(17) + ((size_t)l * NE + e) * D * DE;
            gemm_core<true>(K.XN(), rowoff, KD, Wg, Wu, DE, tn * 64, acc0, acc1, As, Bs0, Bs1);
        } else {
            const float* Wd = K.in(18) + ((size_t)l * NE + e) * DE * D;
            gemm_core<false>(K.H1(), rowoff, KD, Wd, nullptr, D, tn * 64, acc0, acc1, As, Bs0, nullptr);
        }
#pragma unroll
        for (int i = 0; i < 4; ++i) {
            const int r = r0 + ty * 4 + i;
            if (r < rend) {
                v2u o;
                if (MODE == 1) { o.x = pk2(silu(acc0[i][0]) * acc1[i][0], silu(acc0[i][1]) * acc1[i][1]); o.y = pk2(silu(acc0[i][2]) * acc1[i][2], silu(acc0[i][3]) * acc1[i][3]);
                    *(v2u*)(K.H1() + (size_t)r * DE + tn * 64 + tx * 4) = o; }
                else { o.x = pk2(acc0[i][0], acc0[i][1]); o.y = pk2(acc0[i][2], acc0[i][3]); *(v2u*)(K.Y() + (size_t)r * D + tn * 64 + tx * 4) = o; }
            }
        }
    }
    __syncthreads();
}

constexpr int TAB_OFF = LDSCTL_OFF + 1024;
__device__ __forceinline__ void moe_tables(Frame& F, int l) {
    const KA K = KA::fresh(); PHASE_TID;
    LAS int* tab = (LAS int*)(F.lds + TAB_OFF); LAS int* offs = tab + 4 + 4 * 164; LAS int* fpre = offs + 40; LAS int* ppre = fpre + 40;
    const int* cnt = (const int*)(K.ctl() + CW_CNT + 64 * l);
    __syncthreads();
    if (tid == 0) { int a = 0, f = 0, p = 0; for (int e = 0; e < NE; ++e) { const int c = cnt[e]; offs[e] = a; fpre[e] = f; ppre[e] = p; a += c; f += c >> 8; p += (c & 255) ? 1 : 0; }
        offs[NE] = a; fpre[NE] = f; ppre[NE] = p; tab[0] = f + p; }
    __syncthreads();
    const int nfull = fpre[NE], ntile = nfull + ppre[NE];
    if (tid < ntile) {
        int e = 0;
        if (tid < nfull) { for (int j = 1; j < NE; ++j) if (fpre[j] <= tid) e = j; tab[4 + 4 * tid] = e; tab[5 + 4 * tid] = offs[e] + (tid - fpre[e]) * 256; tab[6 + 4 * tid] = offs[e + 1]; }
        else { const int q = tid - nfull; for (int j = 1; j < NE; ++j) if (ppre[j] <= q) e = j; tab[4 + 4 * tid] = e; tab[5 + 4 * tid] = offs[e] + (fpre[e + 1] - fpre[e]) * 256; tab[6 + 4 * tid] = offs[e + 1]; }
    }
    __syncthreads();
}
__device__ __forceinline__ void phase_moe_gu(Frame& F, int l) {
    moe_tables(F, l);
    const KA K = KA::fresh();
    int c_ = F.bx; asm volatile("" : "+s"(c_));
    pg8::MoeSched So{(const LAS int*)(F.lds + TAB_OFF), 2, F.G, (c_ & 7) * (F.G >> 3) + (c_ >> 3)};
    pg8::EpiMoeH E{K.H1()};
    pg8::gemm_phase_moe<pg8::EpiMoeH, pg8::MoeSched, true, 512, D>(F.lds, K.XN(), K.WguT() + (size_t)l * NE * 512 * D, K.slot_tok(), So, E, F.wave);
}
__device__ __forceinline__ void phase_moe_down(Frame& F, int l) {
    moe_tables(F, l);
    const KA K = KA::fresh();
    int c_ = F.bx; asm volatile("" : "+s"(c_));
    pg8::MoeSched So{(const LAS int*)(F.lds + TAB_OFF), 4, F.G, (c_ & 7) * (F.G >> 3) + (c_ >> 3)};
    pg8::EpiMoeY E{K.Y()};
    pg8::gemm_phase_moe<pg8::EpiMoeY, pg8::MoeSched, false, D, DE>(F.lds, K.H1(), K.WdT() + (size_t)l * NE * D * DE, nullptr, So, E, F.wave);
}
__device__ __forceinline__ void phase_combine(Frame& F, int l) {
    const KA K = KA::fresh(); PHASE_TID;
    const bool last = (l == DEPTH - 1);
    const float* gain = last ? K.in(19) : (K.in(1) + (size_t)(l + 1) * D);
#pragma unroll 1
    for (int t = F.bx * NWAVES + wave; t < T; t += F.G * NWAVES) {
        const int s0 = K.slot_of()[2 * t], s1 = K.slot_of()[2 * t + 1]; const float w0 = K.ew()[2 * t], w1 = K.ew()[2 * t + 1];
        f32x4* xr = (f32x4*)(K.out() + (size_t)t * D) + lane;
        const v2u* y0 = (const v2u*)(K.Y() + (size_t)s0 * D) + lane; const v2u* y1 = (const v2u*)(K.Y() + (size_t)s1 * D) + lane;
        f32x4 v[4]; float s = 0.f;
#pragma unroll
        for (int j = 0; j < 4; ++j) { v[j] = xr[64 * j]; const v2u a = y0[64 * j], b = y1[64 * j];
            v[j].x += w0 * bflo(a.x) + w1 * bflo(b.x); v[j].y += w0 * bfhi(a.x) + w1 * bfhi(b.x); v[j].z += w0 * bflo(a.y) + w1 * bflo(b.y); v[j].w += w0 * bfhi(a.y) + w1 * bfhi(b.y);
            s += (v[j].x * v[j].x + v[j].y * v[j].y) + (v[j].z * v[j].z + v[j].w * v[j].w); }
        const float rs = rsqrtf(wave_sum(s) * (1.f / D) + EPS);
        if (last) {
#pragma unroll
            for (int j = 0; j < 4; ++j) { const f32x4 g = ((const f32x4*)gain)[lane + 64 * j]; xr[64 * j] = (f32x4){v[j].x * rs * g.x, v[j].y * rs * g.y, v[j].z * rs * g.z, v[j].w * rs * g.w}; }
        } else {
            v2u* o8 = (v2u*)(K.XN() + (size_t)t * D) + lane;
#pragma unroll
            for (int j = 0; j < 4; ++j) { xr[64 * j] = v[j]; const f32x4 g = ((const f32x4*)gain)[lane + 64 * j];
                v2u w; w.x = pk2(v[j].x * rs * g.x, v[j].y * rs * g.y); w.y = pk2(v[j].z * rs * g.z, v[j].w * rs * g.w); o8[64 * j] = w; }
        }
    }
}

struct Args { const float* in[20]; float* out; unsigned char* ws; };
__global__ void __launch_bounds__(NT, 2) fwd_kernel(Args args) {
    extern __shared__ __attribute__((aligned(16))) unsigned char lds_raw[];
    cg::grid_group grid = cg::this_grid();
    Frame F;
    F.lds = (LAS unsigned char*)lds_raw; F.smem = (float*)lds_raw;
    F.G = gridDim.x; F.bx = blockIdx.x; F.wave = __builtin_amdgcn_readfirstlane(threadIdx.x >> 6);
    volatile LAS unsigned* MISC = (volatile LAS unsigned*)(F.lds + MISC_OFF);
    for (int u = threadIdx.x; u < (LDS_BYTES - LDSCTL_OFF) / 4; u += NT) ((LAS unsigned*)(F.lds + LDSCTL_OFF))[u] = 0u;
    __syncthreads();
    XcdBarrier bar; { const KA K = KA::fresh(); bar = xcd_barrier_post(K.ctl() + CW_BAR, MISC + 8); }
#define GRID_BAR() xcd_barrier(bar)

    p0_prologue(F);
    grid.sync();
    for (int l = 0; l < DEPTH; ++l) {
        {
            const KA K = KA::fresh(); PHASE_TID;
            pg8::Gemm g{K.XN(), K.WinT() + (size_t)l * PLD * D, T, PLD, D}; pg8::StaticOrder So; int c_ = F.bx; asm volatile("" : "+s"(c_)); So.init(T, PLD, F.G, c_);
            pg8::EpiBf16Plain E{K.P(), PLD};
            pg8::gemm_phase<pg8::EpiBf16Plain, pg8::StaticOrder, PG8_ALIGN, PG8_SP2>(F.lds, g, So, E, F.wave);
        }
        GRID_BAR();
        phase_gla_kv_mfma(F, l);
        phase_gmlp_mfma(F, l);
        phase_conv(F, l);
        GRID_BAR();
        phase_gla_scan(F);
        GRID_BAR();
        phase_gla_out_mfma(F, l);
        GRID_BAR();
        {
            const KA K = KA::fresh(); PHASE_TID;
            pg8::Gemm g{K.XN(), K.WoutT() + (size_t)l * D * D, T, D, D}; pg8::StaticOrder So; int c_ = F.bx; asm volatile("" : "+s"(c_)); So.init(T, D, F.G, c_);
            pg8::EpiF32Res E{K.out(), (l == 0) ? K.in(0) : K.out(), D};
            pg8::gemm_phase<pg8::EpiF32Res, pg8::StaticOrder, PG8_ALIGN, PG8_SP2>(F.lds, g, So, E, F.wave);
        }
        GRID_BAR();
        phase_norm_router_mfma(F, l);
        GRID_BAR();
        phase_scatter(F, l);
        GRID_BAR();
        phase_moe_gu(F, l);
        GRID_BAR();
        phase_moe_down(F, l);
        GRID_BAR();
        phase_combine(F, l);
        if (l + 1 < DEPTH) GRID_BAR();
    }
}

extern "C" void kernel_launch(void* const* d_in, const int* in_sizes, int n_in, void* d_out, int out_size, void* d_ws, size_t ws_size, hipStream_t stream) {
    static int grid_blocks = 0;
    if (!grid_blocks) {
        int dev = 0, cus = 0, per_cu = 0;
        (void)hipGetDevice(&dev);
        (void)hipDeviceGetAttribute(&cus, hipDeviceAttributeMultiprocessorCount, dev);
        (void)hipFuncSetAttribute((const void*)fwd_kernel, hipFuncAttributeMaxDynamicSharedMemorySize, LDS_BYTES);
        (void)hipOccupancyMaxActiveBlocksPerMultiprocessor(&per_cu, fwd_kernel, NT, LDS_BYTES);
        if (per_cu < 1) { fprintf(stderr, "kernel_launch: occupancy query says %d blocks/CU\n", per_cu); per_cu = 1; }
        grid_blocks = cus;
        if (ws_size < WS_END) { fprintf(stderr, "kernel_launch: workspace too small (%zu < %zu)\n", ws_size, (size_t)WS_END); grid_blocks = -1; }
    }
    if (grid_blocks < 0) return;
    (void)hipMemsetAsync((char*)d_ws + WS_CTL, 0, CTL_BYTES, stream);
    Args a{};
    for (int i = 0; i < 20; ++i) a.in[i] = (const float*)d_in[i];
    a.out = (float*)d_out; a.ws = (unsigned char*)d_ws;
    void* args[] = {&a};
    hipError_t e = hipLaunchCooperativeKernel((void*)fwd_kernel, dim3(grid_blocks), dim3(NT), args, LDS_BYTES, stream);
    if (e != hipSuccess) fprintf(stderr, "cooperative launch failed: %s (grid %d)\n", hipGetErrorString(e), grid_blocks);
}
```

```cpp
#include <hip/hip_runtime.h>
#include <hip/hip_cooperative_groups.h>
#include <cstdio>
#include <cstdint>
namespace cg = cooperative_groups;
__device__ __forceinline__ int fresh_lane() { unsigned m = 0xffffffffu; asm volatile("" : "+s"(m)); return (int)__builtin_amdgcn_mbcnt_hi(m, __builtin_amdgcn_mbcnt_lo(m, 0u)); }
__device__ __forceinline__ float shx(float v, int o) { return __int_as_float(__builtin_amdgcn_ds_bpermute((fresh_lane() ^ o) << 2, __float_as_int(v))); }
namespace pg8 {
#define PG8_LAS __attribute__((address_space(3)))
typedef unsigned short bf16_t;
typedef short bf16x8 __attribute__((ext_vector_type(8)));
typedef float f32x4 __attribute__((ext_vector_type(4)));
typedef unsigned u32x4 __attribute__((ext_vector_type(4)));
constexpr int BM = 256, BK = 64, HALF = 128, HTB = HALF * BK * 2  , STAGE_BYTES = 8 * HTB, NXCD = 8, WGM = 8;

__host__ __device__ __forceinline__ int lds_byte(int r, int c) { const int st = (r >> 4) * 2 + (c >> 5), rr = r & 15, cc = c & 31, ob = rr * 64 + cc * 2; return st * 1024 + (ob ^ (((ob >> 9) & 1) << 5)); }
__host__ __device__ __forceinline__ void stage_rc(int b, int& R, int& C) { const int st = b / 1024, sb = b % 1024, swz = sb ^ (((sb >> 9) & 1) << 5); R = (st >> 1) * 16 + swz / 64; C = (st & 1) * 32 + (swz % 64) / 2; }
__host__ __device__ __forceinline__ int perm32(int rho) { const int n = rho >> 4, i = rho & 15; return 8 * (i >> 2) + 4 * n + (i & 3); }

struct Unit { int pm, pn; };
struct Gemm { const bf16_t* A; const bf16_t* Bt; int M, N, K; };

struct StaticOrder {
    int nM, nN, nwg, G, c;
    __host__ __device__ void init(int M, int N, int G_, int c_) { nM = M / BM; nN = N / BM; nwg = nM * nN; G = G_; c = c_; }
    __host__ __device__ bool next(int i, Unit& u) const {
        const long L = (long)i * G + c; if (L >= nwg) return false;
        int wgid = (int)L; { const int q = nwg / NXCD, r = nwg % NXCD, xcd = wgid % NXCD, off = wgid / NXCD; wgid = (xcd < r ? xcd * (q + 1) : r * (q + 1) + (xcd - r) * q) + off; }
        const int nig = WGM * nN, gid = wgid / nig, fm = gid * WGM, gsz = (nM - fm) < WGM ? (nM - fm) : WGM;
        u.pm = fm + ((wgid % nig) % gsz); u.pn = (wgid % nig) / gsz; return true;
    }
    __device__ __forceinline__ void a_ready(const Unit&) const {}
    __device__ __forceinline__ void done(const Unit&) const {}
};


__device__ __forceinline__ unsigned cvt_pk_bf16(float lo, float hi) { unsigned r; asm volatile("v_cvt_pk_bf16_f32 %0, %1, %2" : "=v"(r) : "v"(lo), "v"(hi)); return r; }
struct EpiBf16Plain {
    static constexpr bool PERM = true, AFTER_DRAIN = false;
    bf16_t* O; int ldc;
    __device__ __forceinline__ void operator()(const f32x4 (&acc)[2][2][4][2], const Unit& u, int wr, int wc, int fr, int fq) const {
        const int row0 = u.pm * BM + wr * 64 + fr, col0 = u.pn * BM + wc * 32 + 8 * fq;
#pragma unroll
        for (int ai = 0; ai < 2; ++ai)
#pragma unroll
            for (int m = 0; m < 4; ++m) { bf16_t* rowp = O + (size_t)(row0 + ai * HALF + m * 16) * ldc + col0;
#pragma unroll
                for (int bj = 0; bj < 2; ++bj) { const f32x4 v0 = acc[ai][bj][m][0], v1 = acc[ai][bj][m][1];
                    u32x4 w; w.x = cvt_pk_bf16(v0[0], v0[1]); w.y = cvt_pk_bf16(v0[2], v0[3]); w.z = cvt_pk_bf16(v1[0], v1[1]); w.w = cvt_pk_bf16(v1[2], v1[3]);
                    *(u32x4*)(rowp + bj * HALF) = w; } }
    }
};
struct EpiF32Res {
    static constexpr bool PERM = false, AFTER_DRAIN = false;
    float* C; const float* R; int ldc;
    __device__ __forceinline__ void operator()(const f32x4 (&acc)[2][2][4][2], const Unit& u, int wr, int wc, int fr, int fq) const {
        const int row0 = u.pm * BM + wr * 64 + fr, col0 = u.pn * BM + wc * 32 + 4 * fq;
#pragma unroll
        for (int ai = 0; ai < 2; ++ai)
#pragma unroll
            for (int m = 0; m < 4; ++m) { const size_t off = (size_t)(row0 + ai * HALF + m * 16) * ldc + col0;
#pragma unroll
                for (int bj = 0; bj < 2; ++bj)
#pragma unroll
                    for (int n = 0; n < 2; ++n) { const f32x4 r = *(const f32x4*)(R + off + bj * HALF + n * 16); *(f32x4*)(C + off + bj * HALF + n * 16) = r + acc[ai][bj][m][n]; } }
    }
};
template <class Epi, class Sched, bool ALIGN_EPI = false, bool SP2 = false>
__device__ __forceinline__ void gemm_phase(PG8_LAS unsigned char* lds, const Gemm g, const Sched& S, const Epi& E, int wave_id) {
    asm volatile("" : "+s"(wave_id));
    const int lane = fresh_lane(), wid = wave_id, tid = wid * 64 + lane, wr = wid >> 2, wc = wid & 3, fr = lane & 15, fq = lane >> 4;
    const int K = g.K, nt = K / BK;
    unsigned voffA[2], voffB[2];
#pragma unroll
    for (int i = 0; i < 2; ++i) { int R, C; stage_rc(tid * 16 + i * 8192, R, C); const int Rb = Epi::PERM ? ((R & ~31) + perm32(R & 31)) : R;
        voffA[i] = (unsigned)(R * K + C) * 2u; voffB[i] = (unsigned)(Rb * K + C) * 2u; }
    const size_t kstep = (size_t)(BK * 2);
    const size_t hstep = (size_t)HALF * K * 2;
    const size_t tstep = 2 * hstep;
    const unsigned ldsw = (unsigned)wid * 1024u;
    const int aoff = lds_byte(wr * 64 + fr, fq * 8), boff = lds_byte(wc * 32 + fr, fq * 8);
#define PG8_SA(b, h) (((b) * 2 + (h)) * HTB)
#define PG8_SB(b, h) ((4 + (b) * 2 + (h)) * HTB)
#define PG8_STAGE(bufoff, gbase, voff) do { _Pragma("unroll") for (int _i = 0; _i < 2; ++_i) \
        __builtin_amdgcn_global_load_lds((const unsigned*)((const char*)(gbase) + (voff)[_i]), (PG8_LAS unsigned*)(lds + (bufoff) + ldsw + _i * 8192), 16, 0, 0); } while (0)
#define PG8_LDA(dst, b, h) do { _Pragma("unroll") for (int m = 0; m < 4; ++m) _Pragma("unroll") for (int k = 0; k < 2; ++k) dst[m][k] = *(const PG8_LAS bf16x8*)(lds + PG8_SA(b, h) + aoff + m * 2048 + k * 1024); } while (0)
#define PG8_LDB(dst, b, h) do { _Pragma("unroll") for (int n = 0; n < 2; ++n) _Pragma("unroll") for (int k = 0; k < 2; ++k) dst[n][k] = *(const PG8_LAS bf16x8*)(lds + PG8_SB(b, h) + boff + n * 2048 + k * 1024); } while (0)
#define PG8_MMA(ai, bj, At, Bt) do { __builtin_amdgcn_s_setprio(1); _Pragma("unroll") for (int m = 0; m < 4; ++m) _Pragma("unroll") for (int n = 0; n < 2; ++n) _Pragma("unroll") for (int k = 0; k < 2; ++k) \
        acc[ai][bj][m][n] = __builtin_amdgcn_mfma_f32_16x16x32_bf16(Bt[n][k], At[m][k], acc[ai][bj][m][n], 0, 0, 0); __builtin_amdgcn_s_setprio(0); } while (0)
#define PG8_WAIT_V(n) asm volatile("s_waitcnt vmcnt(" #n ")" ::: "memory")
#define PG8_WAIT_L(n) asm volatile("s_waitcnt lgkmcnt(" #n ")" ::: "memory")
#define PG8_BAR __builtin_amdgcn_s_barrier()
#define PG8_SCHED __builtin_amdgcn_sched_barrier(0)
    Unit cur, nxt; int ui = 0;
    if (!S.next(0, cur)) return;
    f32x4 acc[2][2][4][2];
#pragma unroll
    for (int a = 0; a < 2; ++a)
#pragma unroll
        for (int b = 0; b < 2; ++b)
#pragma unroll
            for (int m = 0; m < 4; ++m)
#pragma unroll
                for (int n = 0; n < 2; ++n) acc[a][b][m][n] = (f32x4){0.f, 0.f, 0.f, 0.f};
    bf16x8 At[4][2], B0[2][2], B1[2][2];
    const char* cA = (const char*)g.A + (size_t)cur.pm * tstep; const char* cB = (const char*)g.Bt + (size_t)cur.pn * tstep;
    S.a_ready(cur);
    if constexpr (SP2) {
        PG8_STAGE(PG8_SB(0, 0), cB, voffB); PG8_STAGE(PG8_SB(0, 1), cB + hstep, voffB); PG8_STAGE(PG8_SA(0, 0), cA, voffA); PG8_STAGE(PG8_SA(0, 1), cA + hstep, voffA);
        if (wr == 1) PG8_BAR;
        PG8_WAIT_V(2); PG8_BAR;
        PG8_STAGE(PG8_SB(1, 0), cB + kstep, voffB); PG8_STAGE(PG8_SA(1, 0), cA + kstep, voffA); PG8_STAGE(PG8_SB(1, 1), cB + hstep + kstep, voffB);
        PG8_WAIT_V(6); PG8_BAR;
    } else {
        PG8_STAGE(PG8_SB(0, 0), cB, voffB); PG8_STAGE(PG8_SA(0, 0), cA, voffA); PG8_STAGE(PG8_SB(0, 1), cB + hstep, voffB); PG8_STAGE(PG8_SA(0, 1), cA + hstep, voffA);
        if (wr == 1) PG8_BAR;
        PG8_WAIT_V(4); PG8_BAR;
        PG8_STAGE(PG8_SB(1, 0), cB + kstep, voffB); PG8_STAGE(PG8_SA(1, 0), cA + kstep, voffA); PG8_STAGE(PG8_SB(1, 1), cB + hstep + kstep, voffB);
        PG8_WAIT_V(6); PG8_BAR;
    }
    for (;;) {
        const bool has_next = S.next(ui + 1, nxt);
        const char* nA = has_next ? (const char*)g.A + (size_t)nxt.pm * tstep : cA; const char* nB = has_next ? (const char*)g.Bt + (size_t)nxt.pn * tstep : cB;
        for (int t = 0; t < nt; t += 2) {
            const bool last = (t == nt - 2);
            const char* a1 = cA + (size_t)(t + 1) * kstep;
            const char* a2 = last ? nA : cA + (size_t)(t + 2) * kstep; const char* b2 = last ? nB : cB + (size_t)(t + 2) * kstep;
            const char* a3 = a2 + kstep; const char* b3 = b2 + kstep;
            if (last && has_next) S.a_ready(nxt);
            if constexpr (SP2) {
            PG8_LDB(B0, 0, 0); PG8_LDB(B1, 0, 1); PG8_SCHED; PG8_LDA(At, 0, 0); PG8_STAGE(PG8_SA(1, 1), a1 + hstep, voffA);
            PG8_WAIT_V(8); PG8_WAIT_L(0); PG8_BAR; PG8_MMA(0, 0, At, B0); PG8_MMA(0, 1, At, B1); PG8_BAR; PG8_SCHED;
            PG8_LDA(At, 0, 1); PG8_STAGE(PG8_SB(0, 0), b2, voffB); PG8_STAGE(PG8_SB(0, 1), b2 + hstep, voffB); PG8_STAGE(PG8_SA(0, 0), a2, voffA);
            PG8_WAIT_V(8); PG8_WAIT_L(0); PG8_BAR; PG8_MMA(1, 0, At, B0); PG8_MMA(1, 1, At, B1); PG8_BAR; PG8_SCHED;
            PG8_LDB(B0, 1, 0); PG8_LDB(B1, 1, 1); PG8_SCHED; PG8_LDA(At, 1, 0); PG8_STAGE(PG8_SA(0, 1), a2 + hstep, voffA);
            PG8_WAIT_V(8); PG8_WAIT_L(0); PG8_BAR; PG8_MMA(0, 0, At, B0); PG8_MMA(0, 1, At, B1); PG8_BAR; PG8_SCHED;
            PG8_LDA(At, 1, 1); PG8_STAGE(PG8_SB(1, 0), b3, voffB); PG8_STAGE(PG8_SB(1, 1), b3 + hstep, voffB); PG8_STAGE(PG8_SA(1, 0), a3, voffA);
            PG8_WAIT_V(8); PG8_WAIT_L(0); PG8_BAR; PG8_MMA(1, 0, At, B0); PG8_MMA(1, 1, At, B1); PG8_BAR; PG8_SCHED;
            } else {
            PG8_LDB(B0, 0, 0); PG8_SCHED; PG8_LDA(At, 0, 0); PG8_STAGE(PG8_SA(1, 1), a1 + hstep, voffA);
            PG8_WAIT_L(8); PG8_BAR; PG8_WAIT_L(0); PG8_MMA(0, 0, At, B0); PG8_BAR; PG8_SCHED;
            PG8_LDB(B1, 0, 1); PG8_STAGE(PG8_SB(0, 0), b2, voffB);
            PG8_BAR; PG8_WAIT_L(0); PG8_MMA(0, 1, At, B1); PG8_BAR;
            PG8_LDA(At, 0, 1); PG8_STAGE(PG8_SA(0, 0), a2, voffA);
            PG8_BAR; PG8_WAIT_L(0); PG8_MMA(1, 0, At, B0); PG8_BAR; PG8_SCHED;
            PG8_STAGE(PG8_SB(0, 1), b2 + hstep, voffB);
            PG8_WAIT_V(6); PG8_BAR; PG8_MMA(1, 1, At, B1); PG8_BAR;
            PG8_LDB(B0, 1, 0); PG8_SCHED; PG8_LDA(At, 1, 0); PG8_STAGE(PG8_SA(0, 1), a2 + hstep, voffA);
            PG8_WAIT_L(8); PG8_BAR; PG8_WAIT_L(0); PG8_MMA(0, 0, At, B0); PG8_BAR; PG8_SCHED;
            PG8_LDB(B1, 1, 1); PG8_STAGE(PG8_SB(1, 0), b3, voffB);
            PG8_BAR; PG8_WAIT_L(0); PG8_MMA(0, 1, At, B1); PG8_BAR;
            PG8_LDA(At, 1, 1); PG8_STAGE(PG8_SA(1, 0), a3, voffA);
            PG8_BAR; PG8_WAIT_L(0); PG8_MMA(1, 0, At, B0); PG8_BAR; PG8_SCHED;
            PG8_STAGE(PG8_SB(1, 1), b3 + hstep, voffB);
            PG8_WAIT_V(6); PG8_BAR; PG8_MMA(1, 1, At, B1); PG8_BAR;
            }
        }
        if constexpr (ALIGN_EPI) { if (wr == 0) PG8_BAR; }
        if constexpr (!Epi::AFTER_DRAIN) { E(acc, cur, wr, wc, fr, fq); S.done(cur); }
        if (!has_next) break;
#pragma unroll
        for (int a = 0; a < 2; ++a)
#pragma unroll
            for (int b = 0; b < 2; ++b)
#pragma unroll
                for (int m = 0; m < 4; ++m)
#pragma unroll
                    for (int n = 0; n < 2; ++n) acc[a][b][m][n] = (f32x4){0.f, 0.f, 0.f, 0.f};
        cur = nxt; cA = nA; cB = nB; ++ui;
        if constexpr (ALIGN_EPI) { if (wr == 1) PG8_BAR; }
    }
    PG8_WAIT_V(0);
    if constexpr (!ALIGN_EPI) { if (wr == 0) PG8_BAR; }
    PG8_BAR;
    if constexpr (Epi::AFTER_DRAIN) { E.fused(acc, cur, wr, wc, fr, fq, lds, wid, lane); S.done(cur); }
#undef PG8_SA
#undef PG8_SB
#undef PG8_STAGE
#undef PG8_LDA
#undef PG8_LDB
#undef PG8_MMA
#undef PG8_WAIT_V
#undef PG8_WAIT_L
#undef PG8_BAR
#undef PG8_SCHED
}

struct MUnit { int r0, rend, e, pn; };
#define MG_LANE_OFFS(u, o) do { const int _t = wid * 64 + fresh_lane(); _Pragma("unroll") for (int _i = 0; _i < 2; ++_i) { int _R, _C; stage_rc(_t * 16 + _i * 8192, _R, _C); _Pragma("unroll") for (int _h = 0; _h < 2; ++_h) { const int _r = (u).r0 + _h * HALF + _R; \
        int _row = _r; if (GATHER) { _row = 0; if (_r < (u).rend) _row = slot_tok[_r]; } (o)[_h][_i] = (unsigned)(_row * K + _C) * 2u; } } } while (0)
template <class Epi, class Sched, bool GATHER, int N, int K>
__device__ __forceinline__ void gemm_phase_moe(PG8_LAS unsigned char* lds, const bf16_t* A, const bf16_t* Bt, const int* slot_tok, const Sched& S, const Epi& E, int wave_id) {
    asm volatile("" : "+s"(wave_id));
    const int lane = fresh_lane(), wid = wave_id, tid = wid * 64 + lane, wr = wid >> 2, wc = wid & 3, fr = lane & 15, fq = lane >> 4;
    constexpr int nt = K / BK;
#define MG_OFFP(par) ((PG8_LAS unsigned*)(lds + STAGE_BYTES + 8192) + (par) * 2048 + tid)
#define MG_VOFFB ((PG8_LAS unsigned*)(lds + STAGE_BYTES + 24576) + tid)
#pragma unroll
    for (int i = 0; i < 2; ++i) { int R, C; stage_rc(tid * 16 + i * 8192, R, C); const int Rb = Epi::PERM ? ((R & ~31) + perm32(R & 31)) : R; MG_VOFFB[i * 512] = (unsigned)(Rb * K + C) * 2u; }
    constexpr size_t kstep = (size_t)(BK * 2);
    constexpr size_t hstep = (size_t)HALF * K * 2;
    constexpr size_t tstep = 2 * hstep;
    constexpr size_t estep = (size_t)N * K * 2;
    const unsigned ldsw = (unsigned)wid * 1024u;
    const int aoff = lds_byte(wr * 64 + fr, fq * 8), boff = lds_byte(wc * 32 + fr, fq * 8);
#define PG8_SA(b, h) (((b) * 2 + (h)) * HTB)
#define PG8_SB(b, h) ((4 + (b) * 2 + (h)) * HTB)
#define PG8_STAGE(bufoff, gbase, voff) do { _Pragma("unroll") for (int _i = 0; _i < 2; ++_i) \
        __builtin_amdgcn_global_load_lds((const unsigned*)((const char*)(gbase) + MG_VOFFB[_i * 512]), (PG8_LAS unsigned*)(lds + (bufoff) + ldsw + _i * 8192), 16, 0, 0); } while (0)
#define MG_STAGE_A(bufoff, par, h, kb) do { _Pragma("unroll") for (int _i = 0; _i < 2; ++_i) \
        __builtin_amdgcn_global_load_lds((const unsigned*)((const char*)A + (size_t)MG_OFFP(par)[((h) * 2 + _i) * 512] + (kb)), (PG8_LAS unsigned*)(lds + (bufoff) + ldsw + _i * 8192), 16, 0, 0); } while (0)
#define PG8_LDA(dst, b, h) do { _Pragma("unroll") for (int m = 0; m < 4; ++m) _Pragma("unroll") for (int k = 0; k < 2; ++k) dst[m][k] = *(const PG8_LAS bf16x8*)(lds + PG8_SA(b, h) + aoff + m * 2048 + k * 1024); } while (0)
#define PG8_LDB(dst, b, h) do { _Pragma("unroll") for (int n = 0; n < 2; ++n) _Pragma("unroll") for (int k = 0; k < 2; ++k) dst[n][k] = *(const PG8_LAS bf16x8*)(lds + PG8_SB(b, h) + boff + n * 2048 + k * 1024); } while (0)
#define PG8_MMA(ai, bj, At, Bt_) do { __builtin_amdgcn_s_setprio(1); _Pragma("unroll") for (int m = 0; m < 4; ++m) _Pragma("unroll") for (int n = 0; n < 2; ++n) _Pragma("unroll") for (int k = 0; k < 2; ++k) \
        acc[ai][bj][m][n] = __builtin_amdgcn_mfma_f32_16x16x32_bf16(Bt_[n][k], At[m][k], acc[ai][bj][m][n], 0, 0, 0); __builtin_amdgcn_s_setprio(0); } while (0)
#define PG8_WAIT_V(n) asm volatile("s_waitcnt vmcnt(" #n ")" ::: "memory")
#define PG8_WAIT_L(n) asm volatile("s_waitcnt lgkmcnt(" #n ")" ::: "memory")
#define PG8_BAR __builtin_amdgcn_s_barrier()
#define PG8_SCHED __builtin_amdgcn_sched_barrier(0)
    MUnit cur, nxt; int ui = 0;
    if (!S.next(0, cur)) return;
    f32x4 acc[2][2][4][2];
#pragma unroll
    for (int a = 0; a < 2; ++a)
#pragma unroll
        for (int b = 0; b < 2; ++b)
#pragma unroll
            for (int m = 0; m < 4; ++m)
#pragma unroll
                for (int n = 0; n < 2; ++n) acc[a][b][m][n] = (f32x4){0.f, 0.f, 0.f, 0.f};
    bf16x8 At[4][2], B0[2][2], B1[2][2];
    { unsigned o_[2][2]; MG_LANE_OFFS(cur, o_); PG8_LAS unsigned* p_ = MG_OFFP(0); p_[0] = o_[0][0]; p_[512] = o_[0][1]; p_[1024] = o_[1][0]; p_[1536] = o_[1][1]; }
    const char* cB = (const char*)Bt + (size_t)cur.e * estep + (size_t)cur.pn * tstep;
    PG8_STAGE(PG8_SB(0, 0), cB, voffB); PG8_STAGE(PG8_SB(0, 1), cB + hstep, voffB); MG_STAGE_A(PG8_SA(0, 0), 0, 0, 0); MG_STAGE_A(PG8_SA(0, 1), 0, 1, 0);
    if (wr == 1) PG8_BAR;
    PG8_WAIT_V(2); PG8_BAR;
    PG8_STAGE(PG8_SB(1, 0), cB + kstep, voffB); MG_STAGE_A(PG8_SA(1, 0), 0, 0, kstep); PG8_STAGE(PG8_SB(1, 1), cB + hstep + kstep, voffB);
    PG8_WAIT_V(6); PG8_BAR;
    for (;;) {
        const bool has_next = S.next(ui + 1, nxt);
        const char* nB = cB;
        const int pc = ui & 1, pn_ = has_next ? (pc ^ 1) : pc;
        if (has_next) { unsigned on[2][2]; MG_LANE_OFFS(nxt, on); nB = (const char*)Bt + (size_t)nxt.e * estep + (size_t)nxt.pn * tstep;
            PG8_LAS unsigned* p_ = MG_OFFP(pn_); p_[0] = on[0][0]; p_[512] = on[0][1]; p_[1024] = on[1][0]; p_[1536] = on[1][1]; }
        for (int t = 0; t < nt; t += 2) {
            const bool last = (t == nt - 2);
            const size_t k1 = (size_t)(t + 1) * kstep, k2 = last ? (size_t)0 : (size_t)(t + 2) * kstep, k3 = k2 + kstep;
            const char* b2 = last ? nB : cB + (size_t)(t + 2) * kstep; const char* b3 = b2 + kstep;
            const int p2 = last ? pn_ : pc;
            PG8_LDB(B0, 0, 0); PG8_LDB(B1, 0, 1); PG8_SCHED; PG8_LDA(At, 0, 0); MG_STAGE_A(PG8_SA(1, 1), pc, 1, k1);
            PG8_WAIT_V(8); PG8_WAIT_L(0); PG8_BAR; PG8_MMA(0, 0, At, B0); PG8_MMA(0, 1, At, B1); PG8_BAR; PG8_SCHED;
            PG8_LDA(At, 0, 1); PG8_STAGE(PG8_SB(0, 0), b2, voffB); PG8_STAGE(PG8_SB(0, 1), b2 + hstep, voffB); MG_STAGE_A(PG8_SA(0, 0), p2, 0, k2);
            PG8_WAIT_V(8); PG8_WAIT_L(0); PG8_BAR; PG8_MMA(1, 0, At, B0); PG8_MMA(1, 1, At, B1); PG8_BAR; PG8_SCHED;
            PG8_LDB(B0, 1, 0); PG8_LDB(B1, 1, 1); PG8_SCHED; PG8_LDA(At, 1, 0); MG_STAGE_A(PG8_SA(0, 1), p2, 1, k2);
            PG8_WAIT_V(8); PG8_WAIT_L(0); PG8_BAR; PG8_MMA(0, 0, At, B0); PG8_MMA(0, 1, At, B1); PG8_BAR; PG8_SCHED;
            PG8_LDA(At, 1, 1); PG8_STAGE(PG8_SB(1, 0), b3, voffB); PG8_STAGE(PG8_SB(1, 1), b3 + hstep, voffB); MG_STAGE_A(PG8_SA(1, 0), p2, 0, k3);
            PG8_WAIT_V(8); PG8_WAIT_L(0); PG8_BAR; PG8_MMA(1, 0, At, B0); PG8_MMA(1, 1, At, B1); PG8_BAR; PG8_SCHED;
        }
        if (wr == 0) PG8_BAR;
        E(acc, cur, wr, wc, fr, fq);
        if (!has_next) break;
#pragma unroll
        for (int a = 0; a < 2; ++a)
#pragma unroll
            for (int b = 0; b < 2; ++b)
#pragma unroll
                for (int m = 0; m < 4; ++m)
#pragma unroll
                    for (int n = 0; n < 2; ++n) acc[a][b][m][n] = (f32x4){0.f, 0.f, 0.f, 0.f};
        cur = nxt; cB = nB; ++ui;
        if (wr == 1) PG8_BAR;
    }
    PG8_WAIT_V(0);
    PG8_BAR;
#undef PG8_SA
#undef PG8_SB
#undef PG8_STAGE
#undef MG_STAGE_A
#undef MG_OFFP
#undef MG_VOFFB
#undef PG8_LDA
#undef PG8_LDB
#undef PG8_MMA
#undef PG8_WAIT_V
#undef PG8_WAIT_L
#undef PG8_BAR
#undef PG8_SCHED
}
__device__ __forceinline__ float fast_silu(float x) { return x * __builtin_amdgcn_rcpf(1.0f + __builtin_amdgcn_exp2f(-1.4426950408889634f * x)); }
struct EpiMoeH {
    static constexpr bool PERM = true;
    bf16_t* H;
    __device__ __forceinline__ void operator()(const f32x4 (&acc)[2][2][4][2], const MUnit& u, int wr, int wc, int fr, int fq) const {
        { const int t_ = fresh_lane(); fr = t_ & 15; fq = t_ >> 4; }
        const int col0 = u.pn * 128 + wc * 32 + 8 * fq;
#pragma unroll
        for (int ai = 0; ai < 2; ++ai)
#pragma unroll
            for (int m = 0; m < 4; ++m) { const int r = u.r0 + ai * HALF + wr * 64 + m * 16 + fr;
                const f32x4 g0 = acc[ai][0][m][0], g1 = acc[ai][0][m][1], u0 = acc[ai][1][m][0], u1 = acc[ai][1][m][1];
                u32x4 w; w.x = cvt_pk_bf16(fast_silu(g0[0]) * u0[0], fast_silu(g0[1]) * u0[1]); w.y = cvt_pk_bf16(fast_silu(g0[2]) * u0[2], fast_silu(g0[3]) * u0[3]);
                w.z = cvt_pk_bf16(fast_silu(g1[0]) * u1[0], fast_silu(g1[1]) * u1[1]); w.w = cvt_pk_bf16(fast_silu(g1[2]) * u1[2], fast_silu(g1[3]) * u1[3]);
                if (r < u.rend) *(u32x4*)(H + (size_t)r * 256 + col0) = w; }
    }
};
struct EpiMoeY {
    static constexpr bool PERM = true;
    bf16_t* Y;
    __device__ __forceinline__ void operator()(const f32x4 (&acc)[2][2][4][2], const MUnit& u, int wr, int wc, int fr, int fq) const {
        { const int t_ = fresh_lane(); fr = t_ & 15; fq = t_ >> 4; }
        const int col0 = u.pn * BM + wc * 32 + 8 * fq;
#pragma unroll
        for (int ai = 0; ai < 2; ++ai)
#pragma unroll
            for (int m = 0; m < 4; ++m) { const int r = u.r0 + ai * HALF + wr * 64 + m * 16 + fr;
#pragma unroll
                for (int bj = 0; bj < 2; ++bj) { const f32x4 v0 = acc[ai][bj][m][0], v1 = acc[ai][bj][m][1];
                    u32x4 w; w.x = cvt_pk_bf16(v0[0], v0[1]); w.y = cvt_pk_bf16(v0[2], v0[3]); w.z = cvt_pk_bf16(v1[0], v1[1]); w.w = cvt_pk_bf16(v1[2], v1[3]);
                    if (r < u.rend) *(u32x4*)(Y + (size_t)r * 1024 + col0 + bj * HALF) = w; } }
    }
};
struct MoeSched {
    const PG8_LAS int* tab;
    int npn, G, c;
    __device__ __forceinline__ bool next(int i, MUnit& u) const {
        const int L = i * G + c, ntile = tab[0];
        if (L >= ntile * npn) return false;
        const int j = L / npn; u.pn = L % npn;
        u.e = __builtin_amdgcn_readfirstlane(tab[4 + 4 * j]); u.r0 = __builtin_amdgcn_readfirstlane(tab[5 + 4 * j]); u.rend = __builtin_amdgcn_readfirstlane(tab[6 + 4 * j]);
        return true;
    }
};
}

#ifndef PG8_SP2
#define PG8_SP2 true
#endif
#ifndef PG8_ALIGN
#define PG8_ALIGN true
#endif

constexpr int NWAVES = 8, NT = NWAVES * 64;
constexpr int D = 1024, NB = 2, S = 8192, T = NB * S, DEPTH = 2;
constexpr int DIN = 2832, PLD = 3072;
constexpr int C_Q = 0, C_K = 256, C_V = 512, C_G = 1024, C_GK = 1536, C_U = 1552, C_VG = 1808, C_XI = 2064, C_BG = 2320, C_CG = 2576;
constexpr int GH = 4, GC = 64, GN = S / GC;
constexpr int MH = 4, MC = 128, MN = S / MC;
constexpr int NE = 32, DE = 256;
constexpr float EPS = 1e-6f;
constexpr size_t MiB = 1u << 20;
constexpr size_t WS_CTL = 0, CTL_BYTES = 1 * MiB;
constexpr size_t WS_WIN = 1 * MiB;
constexpr size_t WS_WOUT = 13 * MiB;
constexpr size_t WS_WGU = 17 * MiB;
constexpr size_t WS_WD = 81 * MiB;
constexpr size_t WS_XN = 113 * MiB;
constexpr size_t WS_P = 145 * MiB;
constexpr size_t WS_Y = WS_P + 17 * MiB;
constexpr size_t WS_S = 241 * MiB;
constexpr size_t WS_DEC = 273 * MiB;
constexpr size_t WS_MISC = 274 * MiB;
constexpr size_t WS_WSP = WS_MISC + 524288;
constexpr size_t WS_WR = 275 * MiB;
constexpr size_t WS_BLKCNT = WS_WR + 524288;
constexpr size_t WS_END = 276 * MiB;
constexpr int CW_BAR = 4096, CW_CNT = 16384;
constexpr int RING_BYTES = 131072, LDSCTL_OFF = RING_BYTES, MISC_OFF = LDSCTL_OFF + 320, LDS_BYTES = 163840;

#define GAS __attribute__((address_space(1)))
#define LAS __attribute__((address_space(3)))
typedef unsigned short bf16;
typedef unsigned v4u __attribute__((ext_vector_type(4)));
typedef unsigned v2u __attribute__((ext_vector_type(2)));
typedef float f32x4 __attribute__((ext_vector_type(4)));
__device__ __forceinline__ unsigned f2bf(float f) { unsigned u = __builtin_bit_cast(unsigned, f); return (u + 0x7fffu + ((u >> 16) & 1u)) >> 16; }
__device__ __forceinline__ unsigned pk2(float lo, float hi) { return f2bf(lo) | (f2bf(hi) << 16); }
__device__ __forceinline__ float bf2f(unsigned v) { return __uint_as_float(v << 16); }
__device__ __forceinline__ float bflo(unsigned w) { return __uint_as_float(w << 16); }
__device__ __forceinline__ float bfhi(unsigned w) { return __uint_as_float(w & 0xffff0000u); }
__device__ __forceinline__ void unpack8(const v4u q, float (&f)[8]) { f[0] = bflo(q.x); f[1] = bfhi(q.x); f[2] = bflo(q.y); f[3] = bfhi(q.y); f[4] = bflo(q.z); f[5] = bfhi(q.z); f[6] = bflo(q.w); f[7] = bfhi(q.w); }
__device__ __forceinline__ float gelu_tanh(float x) { const float u = 0.7978845608028654f * (x + 0.044715f * x * x * x); return 0.5f * x * (1.0f + tanhf(u)); }
__device__ __forceinline__ float silu(float x) { return x / (1.0f + expf(-x)); }
__device__ __forceinline__ float log_sigmoid(float x) { return fminf(x, 0.f) - log1pf(expf(-fabsf(x))); }

#define XB_TMO      128
#define XB_XCNT(j)  (256  + 64 * (j))
#define XB_XSUB(j)  (1280 + 64 * (j))
#define XB_XGEN(j)  (2304 + 64 * (j))
#define XB_TOP      3328
#define XB_TOPGEN   3392
#define XCD_BAR_WORDS 3456
#define XB_SPIN_CAP (1u << 18)

__device__ __forceinline__ unsigned xb_ld(unsigned* p)              { return __hip_atomic_load(p, __ATOMIC_RELAXED, __HIP_MEMORY_SCOPE_AGENT); }
__device__ __forceinline__ unsigned xb_add(unsigned* p, unsigned v) { return __hip_atomic_fetch_add(p, v, __ATOMIC_RELAXED, __HIP_MEMORY_SCOPE_AGENT); }
__device__ __forceinline__ unsigned xb_xcc_id() { return (unsigned)__builtin_amdgcn_s_getreg((3 << 11) | 20) & 0xFu; }
#define XB_SPIN(cond, bar) do { unsigned _sp = 0; while (cond) { __builtin_amdgcn_s_sleep(1); \
    if ((++_sp & 255u) == 0u) { if (xb_ld(&(bar)[XB_TMO])) break; if (_sp > XB_SPIN_CAP) { atomicAdd(&(bar)[XB_TMO], 1u); break; } } } } while (0)

struct XcdBarrier {
    int wave;
    unsigned* bar; unsigned x;
    volatile LAS unsigned* st;
};

__device__ __forceinline__ XcdBarrier xcd_barrier_post(unsigned* bar, volatile LAS unsigned* st) {
    XcdBarrier b; b.bar = bar; b.x = xb_xcc_id(); b.st = st; b.wave = __builtin_amdgcn_readfirstlane(threadIdx.x >> 6);
    if (threadIdx.x == 0) (void)xb_add(&bar[XB_XCNT(b.x)], 1u);
    return b;
}
__device__ __forceinline__ void xcd_barrier_complete(unsigned* bar, unsigned x, unsigned& nloc, unsigned& nx) {
    const unsigned G = gridDim.x * gridDim.y * gridDim.z;
    unsigned sum, cnt, mine, sp = 0u;
    for (;;) {
        sum = 0u; cnt = 0u; mine = 0u;
#pragma unroll
        for (unsigned j = 0; j < 16; ++j) { const unsigned c = xb_ld(&bar[XB_XCNT(j)]); sum += c; cnt += (c > 0u) ? 1u : 0u; mine = (j == x) ? c : mine; }
        if (sum == G) break;
        __builtin_amdgcn_s_sleep(1);
        if ((++sp & 255u) == 0u) { if (xb_ld(&bar[XB_TMO])) break; if (sp > XB_SPIN_CAP) { atomicAdd(&bar[XB_TMO], 1u); break; } }
    }
    nloc = mine > 0u ? mine : 1u; nx = cnt > 0u ? cnt : 1u;
}

__device__ __forceinline__ void xcd_barrier(const XcdBarrier& b) {
    asm volatile("s_waitcnt vmcnt(0)" ::: "memory");
    __syncthreads();
    if (b.wave == 0 && fresh_lane() == 0) {
        unsigned* bar = b.bar; asm volatile("" : "+s"(bar));
        __builtin_amdgcn_s_waitcnt(0);
        unsigned nloc = b.st[0], nx = b.st[1];
        if (nloc == 0u) { xcd_barrier_complete(bar, b.x, nloc, nx); b.st[0] = nloc; b.st[1] = nx; }
        const unsigned old = xb_add(&bar[XB_XSUB(b.x)], 1u);
        const unsigned gen = old / nloc;
        if (old + 1u == (gen + 1u) * nloc) {
            __builtin_amdgcn_fence(__ATOMIC_RELEASE, "agent");
            asm volatile("s_waitcnt vmcnt(0)" ::: "memory");
            const unsigned og = xb_add(&bar[XB_TOP], 1u);
            const unsigned tg = og / nx;
            if (og + 1u == (tg + 1u) * nx) xb_add(&bar[XB_TOPGEN], 1u);
            else XB_SPIN(xb_ld(&bar[XB_TOPGEN]) == tg, bar);
            __builtin_amdgcn_fence(__ATOMIC_ACQUIRE, "agent");
            xb_add(&bar[XB_XGEN(b.x)], 1u);
            asm volatile("s_waitcnt vmcnt(0)" ::: "memory");
        } else {
            XB_SPIN(xb_ld(&bar[XB_XGEN(b.x)]) == gen, bar);
            __builtin_amdgcn_fence(__ATOMIC_ACQUIRE, "agent");
            asm volatile("s_waitcnt vmcnt(0)" ::: "memory");
        }
    }
    __syncthreads();
}

#define AS4 __attribute__((address_space(4)))
struct KA {
    const AS4 char* ka;
    static __device__ __forceinline__ KA fresh() { KA k; k.ka = (const AS4 char*)__builtin_amdgcn_kernarg_segment_ptr(); asm volatile("" : "+s"(k.ka)); return k; }
    __device__ __forceinline__ const float* in(int i) const { return *(const float* const AS4*)(ka + 8 * i); }
    __device__ __forceinline__ float* out() const { return *(float* const AS4*)(ka + 160); }
    __device__ __forceinline__ unsigned char* ws() const { return *(unsigned char* const AS4*)(ka + 168); }
    __device__ __forceinline__ unsigned* ctl() const { return (unsigned*)(ws() + WS_CTL); }
    __device__ __forceinline__ bf16* WinT() const { return (bf16*)(ws() + WS_WIN); }
    __device__ __forceinline__ bf16* WoutT() const { return (bf16*)(ws() + WS_WOUT); }
    __device__ __forceinline__ bf16* WguT() const { return (bf16*)(ws() + WS_WGU); }
    __device__ __forceinline__ bf16* WdT() const { return (bf16*)(ws() + WS_WD); }
    __device__ __forceinline__ bf16* XN() const { return (bf16*)(ws() + WS_XN); }
    __device__ __forceinline__ bf16* P() const { return (bf16*)(ws() + WS_P); }
    __device__ __forceinline__ bf16* H1() const { return (bf16*)(ws() + WS_P); }
    __device__ __forceinline__ bf16* Y() const { return (bf16*)(ws() + WS_Y); }
    __device__ __forceinline__ float* Sst() const { return (float*)(ws() + WS_S); }
    __device__ __forceinline__ float* dec() const { return (float*)(ws() + WS_DEC); }
    __device__ __forceinline__ int* eid() const { return (int*)(ws() + WS_MISC); }
    __device__ __forceinline__ float* ew() const { return (float*)(ws() + WS_MISC + 131072); }
    __device__ __forceinline__ int* slot_tok() const { return (int*)(ws() + WS_MISC + 2 * 131072); }
    __device__ __forceinline__ int* slot_of() const { return (int*)(ws() + WS_MISC + 3 * 131072); }
    __device__ __forceinline__ bf16* Wsp() const { return (bf16*)(ws() + WS_WSP); }
    __device__ __forceinline__ bf16* Wr() const { return (bf16*)(ws() + WS_WR); }
    __device__ __forceinline__ int* blkcnt() const { return (int*)(ws() + WS_BLKCNT); }
};
struct Frame {
    LAS unsigned char* lds; float* smem;
    int G, bx, wave;
};
#define PHASE_TID const int lane = fresh_lane(), wave = F.wave, tid = wave * 64 + lane; (void)lane; (void)wave; (void)tid

__device__ __forceinline__ float wave_sum(float v) {
    const int ln = fresh_lane();
#pragma unroll
    for (int o = 1; o < 64; o <<= 1) v += __int_as_float(__builtin_amdgcn_ds_bpermute((ln ^ o) << 2, __float_as_int(v)));
    return v;
}

__device__ __forceinline__ void transpose_item(const float* W, int ldw, int nvalid, int k0, int n0, bf16* WT, int ldt, int drow0, LAS float* scr, int lane) {
    const int nl = lane & 31;
#pragma unroll 8
    for (int i = 0; i < 32; ++i) { const int kk = 2 * i + (lane >> 5); scr[kk * 33 + nl] = (nl < nvalid) ? W[(size_t)(k0 + kk) * ldw + n0 + nl] : 0.f; }
    asm volatile("s_waitcnt lgkmcnt(0)" ::: "memory");
    const int c = lane & 7;
#pragma unroll
    for (int j = 0; j < 4; ++j) { const int n = (lane >> 3) + 8 * j; const LAS float* s = scr + (8 * c) * 33 + n;
        v4u o; o.x = pk2(s[0 * 33], s[1 * 33]); o.y = pk2(s[2 * 33], s[3 * 33]); o.z = pk2(s[4 * 33], s[5 * 33]); o.w = pk2(s[6 * 33], s[7 * 33]);
        if (n < nvalid) *(GAS v4u*)(WT + (size_t)(drow0 + n) * ldt + k0 + 8 * c) = o; }
    asm volatile("s_waitcnt lgkmcnt(0)" ::: "memory");
}
__device__ __forceinline__ void rms_row_to_bf16(const float* xrow, const float* gain, bf16* orow, int lane) {
    const f32x4* xr = (const f32x4*)xrow + lane;
    f32x4 v[4]; float s = 0.f;
#pragma unroll
    for (int j = 0; j < 4; ++j) { v[j] = xr[64 * j]; s += (v[j].x * v[j].x + v[j].y * v[j].y) + (v[j].z * v[j].z + v[j].w * v[j].w); }
    const float rs = rsqrtf(wave_sum(s) * (1.f / D) + EPS);
    v2u* o8 = (v2u*)orow + lane;
#pragma unroll
    for (int j = 0; j < 4; ++j) { const f32x4 g = ((const f32x4*)gain)[lane + 64 * j]; v2u w; w.x = pk2(v[j].x * rs * g.x, v[j].y * rs * g.y); w.y = pk2(v[j].z * rs * g.z, v[j].w * rs * g.w); o8[64 * j] = w; }
}
__device__ __forceinline__ void p0_prologue(Frame& F) {
    const KA K = KA::fresh(); PHASE_TID;
    LAS float* scr = (LAS float*)(F.lds + wave * 16384);
    const int gw = F.bx * NWAVES + wave, NGW = F.G * NWAVES;
    constexpr int I_IN = 16 * 89, I_OUT = 16 * 32, I_G = 32 * 16 * 8, I_D = 32 * 4 * 32, I_L = I_IN + I_OUT + 2 * I_G + I_D;
    for (int it = gw; it < DEPTH * I_L; it += NGW) {
        const int l = it / I_L; int r = it % I_L;
        if (r < I_IN) { const int kb = r / 89, nb = r % 89; const int nv = (nb == 88) ? 16 : 32;
            transpose_item(K.in(2) + (size_t)l * D * DIN, DIN, nv, kb * 64, nb * 32, K.WinT() + (size_t)l * PLD * D, D, nb * 32, scr, lane); continue; }
        r -= I_IN;
        if (r < I_OUT) { const int kb = r / 32, nb = r % 32;
            transpose_item(K.in(10) + (size_t)l * D * D, D, 32, kb * 64, nb * 32, K.WoutT() + (size_t)l * D * D, D, nb * 32, scr, lane); continue; }
        r -= I_OUT;
        if (r < 2 * I_G) { const int sel = r / I_G; r %= I_G; const int e = r / 128, kb = (r % 128) / 8, nb = r % 8; const int n0 = nb * 32;
            const float* W = K.in(16 + sel) + ((size_t)l * NE + e) * D * DE;
            transpose_item(W, DE, 32, kb * 64, n0, K.WguT() + ((size_t)l * NE + e) * 512 * D, D, (n0 >> 7) * 256 + sel * 128 + (n0 & 127), scr, lane); continue; }
        r -= 2 * I_G;
        { const int e = r / 128, kb = (r % 128) / 32, nb = r % 32;
            transpose_item(K.in(18) + ((size_t)l * NE + e) * DE * D, D, 32, kb * 64, nb * 32, K.WdT() + ((size_t)l * NE + e) * D * DE, DE, nb * 32, scr, lane); }
    }
    for (int i = F.bx * NT + tid; i < DEPTH * 240 * 128; i += F.G * NT) { const int l = i / (240 * 128), rr = (i / 128) % 240, c = i % 128;
        *(GAS v4u*)(K.WinT() + ((size_t)l * PLD + DIN + rr) * D + c * 8) = (v4u){0u, 0u, 0u, 0u}; }
    for (int i = F.bx * NT + tid; i < DEPTH * 48 * D; i += F.G * NT) { const int ll = i / (48 * D), n = (i / D) % 48, k = i % D;
        float w = 0.f;
        if (n < 4) w = K.in(12)[((size_t)ll * D + k) * 4 + n]; else if (n < 36) w = K.in(14)[((size_t)ll * D + k) * 32 + (n - 4)];
        w *= K.in(11)[(size_t)ll * D + k];
        const unsigned hi = f2bf(w), lo = f2bf(w - bf2f(hi));
        K.Wr()[((size_t)ll * 2 + 0) * 48 * D + (size_t)n * D + k] = (bf16)hi; K.Wr()[((size_t)ll * 2 + 1) * 48 * D + (size_t)n * D + k] = (bf16)lo; }
    for (int i = F.bx * NT + tid; i < DEPTH * MH * 128 * 128 / 8; i += F.G * NT) { const int e0 = i * 8, s0 = e0 & 127, t = (e0 >> 7) & 127;
        const f32x4 a = *(const f32x4*)(K.in(7) + e0), c = *(const f32x4*)(K.in(7) + e0 + 4);
        const float v[8] = {a.x, a.y, a.z, a.w, c.x, c.y, c.z, c.w}; unsigned w[4];
#pragma unroll
        for (int j = 0; j < 4; ++j) w[j] = pk2((s0 + 2 * j <= t) ? v[2 * j] : 0.f, (s0 + 2 * j + 1 <= t) ? v[2 * j + 1] : 0.f);
        *(GAS v4u*)(K.Wsp() + e0) = (v4u){w[0], w[1], w[2], w[3]}; }
    for (int m = gw; m < T; m += NGW) rms_row_to_bf16(K.in(0) + (size_t)m * D, K.in(1), K.XN() + (size_t)m * D, lane);
}

__device__ __forceinline__ void gla_cumdecay(Frame& F, const KA& K, int tid, int l, int h, int t0, float* bb) {
    const float* wup = K.in(3) + (size_t)l * 16 * 256; const float* bgk = K.in(4) + (size_t)l * 256;
    for (int e = tid; e < 64 * 64; e += NT) {
        const int c = e >> 6, d = e & 63;
        const bf16* gl = K.P() + (size_t)(t0 + c) * PLD + C_GK;
        float a = bgk[h * 64 + d];
#pragma unroll
        for (int r = 0; r < 16; ++r) a += bf2f(gl[r]) * wup[r * 256 + h * 64 + d];
        bb[c * 64 + d] = log_sigmoid(a) * (1.0f / 16.0f);
    }
    __syncthreads();
    if (tid < 64) { float run = 0.f; for (int c = 0; c < 64; ++c) { run += bb[c * 64 + tid]; bb[c * 64 + tid] = run; } }
    __syncthreads();
}
__device__ __forceinline__ void phase_gla_kv(Frame& F, int l) {
    const KA K = KA::fresh(); PHASE_TID;
    float* bb = F.smem; float* kd = F.smem + 4096;
#pragma unroll 1
    for (int ci = F.bx; ci < NB * GH * GN; ci += F.G) {
        const int b = ci / (GH * GN), h = (ci / GN) % GH, n = ci % GN, t0 = b * S + n * GC;
        __syncthreads();
        gla_cumdecay(F, K, tid, l, h, t0, bb);
        for (int e = tid; e < 4096; e += NT) { const int c = e >> 6, d = e & 63; kd[e] = bf2f(K.P()[(size_t)(t0 + c) * PLD + C_K + h * 64 + d]) * expf(bb[63 * 64 + d] - bb[e]); }
        __syncthreads();
        const int d = tid >> 3, v0 = (tid & 7) * 16;
        float acc[16];
#pragma unroll
        for (int j = 0; j < 16; ++j) acc[j] = 0.f;
#pragma unroll 2
        for (int c = 0; c < 64; ++c) {
            const float kk = kd[c * 64 + d];
            const v4u* vr = (const v4u*)(K.P() + (size_t)(t0 + c) * PLD + C_V + h * 128 + v0);
            float f[8]; unpack8(vr[0], f);
#pragma unroll
            for (int j = 0; j < 8; ++j) acc[j] += kk * f[j];
            unpack8(vr[1], f);
#pragma unroll
            for (int j = 0; j < 8; ++j) acc[8 + j] += kk * f[j];
        }
        f32x4* o = (f32x4*)(K.Sst() + ((size_t)ci * 64 + d) * 128 + v0);
#pragma unroll
        for (int j = 0; j < 4; ++j) o[j] = (f32x4){acc[4 * j], acc[4 * j + 1], acc[4 * j + 2], acc[4 * j + 3]};
        if (tid < 64) K.dec()[(size_t)ci * 64 + tid] = expf(bb[63 * 64 + tid]);
    }
}
__device__ __forceinline__ void phase_gla_scan(Frame& F) {
    const KA K = KA::fresh(); PHASE_TID;
#pragma unroll 1
    for (int e = F.bx * NT + tid; e < NB * GH * 64 * 128; e += F.G * NT) {
        const int bh = e >> 13, d = (e >> 7) & 63, v = e & 127;
        float* base = K.Sst() + ((size_t)bh * GN * 64 + d) * 128 + v; const float* db = K.dec() + (size_t)bh * GN * 64 + d;
        float st = 0.f;
#pragma unroll 1
        for (int n0 = 0; n0 < GN; n0 += 16) {
            float kvv[16], dd[16];
#pragma unroll
            for (int j = 0; j < 16; ++j) { kvv[j] = base[(size_t)(n0 + j) * 8192]; dd[j] = db[(n0 + j) * 64]; }
#pragma unroll
            for (int j = 0; j < 16; ++j) { base[(size_t)(n0 + j) * 8192] = st; st = dd[j] * st + kvv[j]; }
        }
    }
}
__device__ __forceinline__ void phase_gla_out(Frame& F, int l) {
    const KA K = KA::fresh(); PHASE_TID;
    float* bb = F.smem; float* qd = F.smem + 4096; float* ki = F.smem + 4096 + 64 * 65; float* sc = bb;
    const float* gnorm = K.in(5) + (size_t)l * 128;
#pragma unroll 1
    for (int ci = F.bx; ci < NB * GH * GN; ci += F.G) {
        const int b = ci / (GH * GN), h = (ci / GN) % GH, n = ci % GN, t0 = b * S + n * GC;
        __syncthreads();
        gla_cumdecay(F, K, tid, l, h, t0, bb);
        for (int e = tid; e < 4096; e += NT) {
            const int c = e >> 6, d = e & 63; const float bv = bb[e];
            const bf16* row = K.P() + (size_t)(t0 + c) * PLD;
            qd[c * 65 + d] = bf2f(row[C_Q + h * 64 + d]) * 0.125f * expf(bv);
            ki[c * 65 + d] = bf2f(row[C_K + h * 64 + d]) * expf(-bv);
        }
        __syncthreads();
        {
            const int c = tid >> 3, s0 = (tid & 7) * 8;
            float a[8];
#pragma unroll
            for (int j = 0; j < 8; ++j) a[j] = 0.f;
#pragma unroll 4
            for (int d = 0; d < 64; ++d) { const float qv = qd[c * 65 + d];
#pragma unroll
                for (int j = 0; j < 8; ++j) a[j] += qv * ki[(s0 + j) * 65 + d]; }
#pragma unroll
            for (int j = 0; j < 8; ++j) sc[c * 64 + s0 + j] = (s0 + j <= c) ? a[j] : 0.f;
        }
        __syncthreads();
        const int c = tid >> 3, v0 = (tid & 7) * 16;
        float acc[16];
#pragma unroll
        for (int j = 0; j < 16; ++j) acc[j] = 0.f;
#pragma unroll 2
        for (int s = 0; s <= c; ++s) {
            const float w = sc[c * 64 + s];
            const v4u* vr = (const v4u*)(K.P() + (size_t)(t0 + s) * PLD + C_V + h * 128 + v0);
            float f[8]; unpack8(vr[0], f);
#pragma unroll
            for (int j = 0; j < 8; ++j) acc[j] += w * f[j];
            unpack8(vr[1], f);
#pragma unroll
            for (int j = 0; j < 8; ++j) acc[8 + j] += w * f[j];
        }
#pragma unroll 2
        for (int d = 0; d < 64; ++d) {
            const float w = qd[c * 65 + d];
            const f32x4* sr = (const f32x4*)(K.Sst() + ((size_t)ci * 64 + d) * 128 + v0);
#pragma unroll
            for (int j = 0; j < 4; ++j) { const f32x4 v4 = sr[j]; acc[4 * j] += w * v4.x; acc[4 * j + 1] += w * v4.y; acc[4 * j + 2] += w * v4.z; acc[4 * j + 3] += w * v4.w; }
        }
        float ss = 0.f;
#pragma unroll
        for (int j = 0; j < 16; ++j) ss += acc[j] * acc[j];
        ss += shx(ss, 1); ss += shx(ss, 2); ss += shx(ss, 4);
        const float rs = rsqrtf(ss * (1.0f / 128.0f) + EPS);
        const v4u* gr = (const v4u*)(K.P() + (size_t)(t0 + c) * PLD + C_G + h * 128 + v0);
        float g0[8], g1[8]; unpack8(gr[0], g0); unpack8(gr[1], g1);
        float o[16];
#pragma unroll
        for (int j = 0; j < 8; ++j) { o[j] = acc[j] * rs * gnorm[v0 + j] * silu(g0[j]); o[8 + j] = acc[8 + j] * rs * gnorm[v0 + 8 + j] * silu(g1[j]); }
        v4u* op = (v4u*)(K.XN() + (size_t)(t0 + c) * D + h * 128 + v0);
        op[0] = (v4u){pk2(o[0], o[1]), pk2(o[2], o[3]), pk2(o[4], o[5]), pk2(o[6], o[7])};
        op[1] = (v4u){pk2(o[8], o[9]), pk2(o[10], o[11]), pk2(o[12], o[13]), pk2(o[14], o[15])};
    }
}
__device__ __forceinline__ void phase_gmlp(Frame& F, int l) {
    const KA K = KA::fresh(); PHASE_TID;
    float* vs = F.smem;
    const float* gn = K.in(6) + (size_t)l * 256; const float* wsp = K.in(7) + (size_t)l * MH * 128 * 128; const float* bsp = K.in(8) + (size_t)l * MH * 128;
#pragma unroll 1
    for (int u = F.bx; u < NB * MN * MH; u += F.G) {
        const int b = u / (MN * MH), n = (u / MH) % MN, h = u % MH, t0 = b * S + n * MC;
        __syncthreads();
        const int s = tid >> 2, d0 = (tid & 3) * 16;
        {
            const v4u* vr = (const v4u*)(K.P() + (size_t)(t0 + s) * PLD + C_VG + h * 64 + d0);
            float g[16]; { float f[8]; unpack8(vr[0], f);
#pragma unroll
                for (int j = 0; j < 8; ++j) g[j] = gelu_tanh(f[j]);
                unpack8(vr[1], f);
#pragma unroll
                for (int j = 0; j < 8; ++j) g[8 + j] = gelu_tanh(f[j]); }
            float ss = 0.f;
#pragma unroll
            for (int j = 0; j < 16; ++j) ss += g[j] * g[j];
            ss += shx(ss, 1); ss += shx(ss, 2);
            const float rs = rsqrtf(ss * (1.0f / 64.0f) + EPS);
#pragma unroll
            for (int j = 0; j < 16; ++j) vs[s * 64 + d0 + j] = g[j] * rs * gn[h * 64 + d0 + j];
        }
        __syncthreads();
        const int t = s;
        float acc[16];
#pragma unroll
        for (int j = 0; j < 16; ++j) acc[j] = 0.f;
        const float* wr = wsp + ((size_t)h * 128 + t) * 128;
#pragma unroll 2
        for (int s2 = 0; s2 <= t; ++s2) { const float w = wr[s2];
#pragma unroll
            for (int j = 0; j < 16; ++j) acc[j] += w * vs[s2 * 64 + d0 + j]; }
        const float bias = bsp[h * 128 + t];
        const v4u* ur = (const v4u*)(K.P() + (size_t)(t0 + t) * PLD + C_U + h * 64 + d0);
        float u0[8], u1[8]; unpack8(ur[0], u0); unpack8(ur[1], u1);
        float o[16];
#pragma unroll
        for (int j = 0; j < 8; ++j) { o[j] = gelu_tanh(u0[j]) * (acc[j] + bias); o[8 + j] = gelu_tanh(u1[j]) * (acc[8 + j] + bias); }
        v4u* op = (v4u*)(K.XN() + (size_t)(t0 + t) * D + 512 + h * 64 + d0);
        op[0] = (v4u){pk2(o[0], o[1]), pk2(o[2], o[3]), pk2(o[4], o[5]), pk2(o[6], o[7])};
        op[1] = (v4u){pk2(o[8], o[9]), pk2(o[10], o[11]), pk2(o[12], o[13]), pk2(o[14], o[15])};
    }
}
typedef short bf16x8 __attribute__((ext_vector_type(8)));
__device__ __forceinline__ float fexp(float x) { return __builtin_amdgcn_exp2f(x * 1.4426950408889634f); }
__device__ __forceinline__ float logsig_fast(float x) { return fminf(x, 0.f) - __log2f(1.0f + fexp(-fabsf(x))) * 0.6931471805599453f; }
__device__ __forceinline__ float silu_fast(float x) { return x * __builtin_amdgcn_rcpf(1.0f + __builtin_amdgcn_exp2f(-1.4426950408889634f * x)); }
__device__ __forceinline__ float gelu_fast(float x) { const float u = 0.7978845608028654f * (x + 0.044715f * x * x * x); return x * __builtin_amdgcn_rcpf(1.0f + __builtin_amdgcn_exp2f(-2.8853900817779268f * u)); }
__device__ __forceinline__ f32x4 mfma16(bf16x8 a, bf16x8 b, f32x4 c) { return __builtin_amdgcn_mfma_f32_16x16x32_bf16(a, b, c, 0, 0, 0); }
constexpr int LROWB = 144;
constexpr int L_QD = 0, L_KI = 9216, L_KDT = 18432, L_VT = 27648, L_S = 46080, L_ST = 55296, L_OB = 73728, L_TOT = 107520, OBROW = 528;
#define FRAG(base, row, kel) (*(const LAS bf16x8*)(lds + (base) + (row) * LROWB + (kel) * 2))

__device__ __forceinline__ float gla_b8(const KA& K, LAS unsigned char* lds, int l, int h, int t0, int lane, int wave, float (&bv)[8]) {
    const float* wup = K.in(3) + (size_t)l * 16 * 256 + h * 64 + lane;
    float wu[16];
#pragma unroll
    for (int r = 0; r < 16; ++r) wu[r] = wup[r * 256];
    const float bg = K.in(4)[l * 256 + h * 64 + lane];
    const bf16* P = K.P();
    float run = 0.f;
#pragma unroll
    for (int j = 0; j < 8; ++j) {
        const bf16* gl = P + (size_t)(t0 + 8 * wave + j) * PLD + C_GK;
        float f0[8], f1[8]; unpack8(*(const v4u*)gl, f0); unpack8(*(const v4u*)(gl + 8), f1);
        float a = bg;
#pragma unroll
        for (int r = 0; r < 8; ++r) a += f0[r] * wu[r];
#pragma unroll
        for (int r = 0; r < 8; ++r) a += f1[r] * wu[8 + r];
        run += logsig_fast(a) * (1.0f / 16.0f); bv[j] = run;
    }
    LAS float* tot = (LAS float*)(lds + L_TOT);
    tot[wave * 64 + lane] = run;
    __syncthreads();
    float base = 0.f, all = 0.f;
#pragma unroll
    for (int g = 0; g < 8; ++g) { const float tv = tot[g * 64 + lane]; all += tv; if (g < wave) base += tv; }
#pragma unroll
    for (int j = 0; j < 8; ++j) bv[j] += base;
    return all;
}
__device__ __forceinline__ void gla_stage_vT(const bf16* P, LAS unsigned char* lds, int h, int t0, int tid) {
    const int vv = tid & 127, cq = tid >> 7;
    const bf16* vp = P + (size_t)(t0 + 16 * cq) * PLD + C_V + h * 128 + vv;
    unsigned w[8];
#pragma unroll
    for (int j = 0; j < 8; ++j) w[j] = (unsigned)vp[(size_t)(2 * j) * PLD] | ((unsigned)vp[(size_t)(2 * j + 1) * PLD] << 16);
    LAS v4u* dst = (LAS v4u*)(lds + L_VT + vv * LROWB + cq * 32);
    dst[0] = (v4u){w[0], w[1], w[2], w[3]}; dst[1] = (v4u){w[4], w[5], w[6], w[7]};
}

__device__ __forceinline__ void phase_gla_kv_mfma(Frame& F, int l) {
    const KA K = KA::fresh(); PHASE_TID;
    LAS unsigned char* lds = F.lds;
    const int fr = lane & 15, fq = lane >> 4;
#pragma unroll 1
    for (int ci = F.bx; ci < NB * GH * GN; ci += F.G) {
        const int b = ci / (GH * GN), h = (ci / GN) % GH, n = ci % GN, t0 = b * S + n * GC;
        const bf16* P = K.P();
        __syncthreads();
        float bv[8]; const float bl = gla_b8(K, lds, l, h, t0, lane, wave, bv);
        {
            const bf16* kp = P + (size_t)(t0 + 8 * wave) * PLD + C_K + h * 64 + lane;
            float kd[8];
#pragma unroll
            for (int j = 0; j < 8; ++j) kd[j] = bf2f(kp[(size_t)j * PLD]) * fexp(bl - bv[j]);
            *(LAS v4u*)(lds + L_KDT + lane * LROWB + wave * 16) = (v4u){pk2(kd[0], kd[1]), pk2(kd[2], kd[3]), pk2(kd[4], kd[5]), pk2(kd[6], kd[7])};
        }
        gla_stage_vT(P, lds, h, t0, tid);
        if (wave == 0) K.dec()[(size_t)ci * 64 + lane] = fexp(bl);
        __syncthreads();
        bf16x8 Bf[2];
#pragma unroll
        for (int ks = 0; ks < 2; ++ks) Bf[ks] = FRAG(L_VT, 16 * wave + fr, 32 * ks + 8 * fq);
        float* so = K.Sst() + (size_t)ci * 64 * 128 + 16 * wave + fr;
#pragma unroll
        for (int dt = 0; dt < 4; ++dt) {
            f32x4 acc = (f32x4){0.f, 0.f, 0.f, 0.f};
#pragma unroll
            for (int ks = 0; ks < 2; ++ks) acc = mfma16(FRAG(L_KDT, 16 * dt + fr, 32 * ks + 8 * fq), Bf[ks], acc);
#pragma unroll
            for (int r = 0; r < 4; ++r) so[(size_t)(16 * dt + 4 * fq + r) * 128] = acc[r];
        }
    }
}

__device__ __forceinline__ void phase_gla_out_mfma(Frame& F, int l) {
    const KA K = KA::fresh(); PHASE_TID;
    LAS unsigned char* lds = F.lds;
    const int fr = lane & 15, fq = lane >> 4;
    const float* gnorm = K.in(5) + (size_t)l * 128;
#pragma unroll 1
    for (int ci = F.bx; ci < NB * GH * GN; ci += F.G) {
        const int b = ci / (GH * GN), h = (ci / GN) % GH, n = ci % GN, t0 = b * S + n * GC;
        const bf16* P = K.P();
        __syncthreads();
        float bv[8]; (void)gla_b8(K, lds, l, h, t0, lane, wave, bv);
        {
            const bf16* qp = P + (size_t)(t0 + 8 * wave) * PLD + C_Q + h * 64 + lane;
            const bf16* kp = qp + (C_K - C_Q);
#pragma unroll
            for (int j = 0; j < 8; ++j) {
                const float e = fexp(bv[j]);
                const float qv = bf2f(qp[(size_t)j * PLD]) * 0.125f * e, kv = bf2f(kp[(size_t)j * PLD]) * __builtin_amdgcn_rcpf(e);
                *(LAS bf16*)(lds + L_QD + (8 * wave + j) * LROWB + lane * 2) = (bf16)f2bf(qv);
                *(LAS bf16*)(lds + L_KI + (8 * wave + j) * LROWB + lane * 2) = (bf16)f2bf(kv);
            }
        }
        gla_stage_vT(P, lds, h, t0, tid);
        {
            const int vv = tid & 127, dq = tid >> 7;
            const float* sp = K.Sst() + ((size_t)ci * 64 + 16 * dq) * 128 + vv;
            unsigned w[8];
#pragma unroll
            for (int j = 0; j < 8; ++j) w[j] = pk2(sp[(size_t)(2 * j) * 128], sp[(size_t)(2 * j + 1) * 128]);
            LAS v4u* dst = (LAS v4u*)(lds + L_ST + vv * LROWB + dq * 32);
            dst[0] = (v4u){w[0], w[1], w[2], w[3]}; dst[1] = (v4u){w[4], w[5], w[6], w[7]};
        }
        __syncthreads();
#pragma unroll
        for (int i = 0; i < 2; ++i) {
            const int tix = 2 * wave + i, st = tix >> 2, ct = tix & 3;
            f32x4 acc = (f32x4){0.f, 0.f, 0.f, 0.f};
#pragma unroll
            for (int ks = 0; ks < 2; ++ks) acc = mfma16(FRAG(L_KI, 16 * st + fr, 32 * ks + 8 * fq), FRAG(L_QD, 16 * ct + fr, 32 * ks + 8 * fq), acc);
            const int s0 = 16 * st + 4 * fq, c = 16 * ct + fr;
            float m[4];
#pragma unroll
            for (int r = 0; r < 4; ++r) m[r] = (s0 + r <= c) ? acc[r] : 0.f;
            *(LAS v2u*)(lds + L_S + c * LROWB + s0 * 2) = (v2u){pk2(m[0], m[1]), pk2(m[2], m[3])};
        }
        __syncthreads();
        {
            bf16x8 Av[2], As[2];
#pragma unroll
            for (int ks = 0; ks < 2; ++ks) { Av[ks] = FRAG(L_VT, 16 * wave + fr, 32 * ks + 8 * fq); As[ks] = FRAG(L_ST, 16 * wave + fr, 32 * ks + 8 * fq); }
#pragma unroll
            for (int ct = 0; ct < 4; ++ct) {
                f32x4 acc = (f32x4){0.f, 0.f, 0.f, 0.f};
#pragma unroll
                for (int ks = 0; ks < 2; ++ks) { acc = mfma16(Av[ks], FRAG(L_S, 16 * ct + fr, 32 * ks + 8 * fq), acc); acc = mfma16(As[ks], FRAG(L_QD, 16 * ct + fr, 32 * ks + 8 * fq), acc); }
                *(LAS f32x4*)(lds + L_OB + (16 * ct + fr) * OBROW + (16 * wave + 4 * fq) * 4) = acc;
            }
        }
        __syncthreads();
        {
            const int c = tid >> 3, vg = tid & 7;
            const LAS f32x4* ob = (const LAS f32x4*)(lds + L_OB + c * OBROW + vg * 64);
            f32x4 o[4]; float ss = 0.f;
#pragma unroll
            for (int j = 0; j < 4; ++j) { o[j] = ob[j]; ss += (o[j].x * o[j].x + o[j].y * o[j].y) + (o[j].z * o[j].z + o[j].w * o[j].w); }
            ss += shx(ss, 1); ss += shx(ss, 2); ss += shx(ss, 4);
            const float rs = rsqrtf(ss * (1.0f / 128.0f) + EPS);
            const v4u* gr = (const v4u*)(P + (size_t)(t0 + c) * PLD + C_G + h * 128 + 16 * vg);
            float g0[8], g1[8]; unpack8(gr[0], g0); unpack8(gr[1], g1);
            const f32x4* gn = (const f32x4*)(gnorm + 16 * vg);
            const f32x4 n0 = gn[0], n1 = gn[1], n2 = gn[2], n3 = gn[3];
            v4u w0, w1;
            w0.x = pk2(o[0].x * rs * n0.x * silu_fast(g0[0]), o[0].y * rs * n0.y * silu_fast(g0[1])); w0.y = pk2(o[0].z * rs * n0.z * silu_fast(g0[2]), o[0].w * rs * n0.w * silu_fast(g0[3]));
            w0.z = pk2(o[1].x * rs * n1.x * silu_fast(g0[4]), o[1].y * rs * n1.y * silu_fast(g0[5])); w0.w = pk2(o[1].z * rs * n1.z * silu_fast(g0[6]), o[1].w * rs * n1.w * silu_fast(g0[7]));
            w1.x = pk2(o[2].x * rs * n2.x * silu_fast(g1[0]), o[2].y * rs * n2.y * silu_fast(g1[1])); w1.y = pk2(o[2].z * rs * n2.z * silu_fast(g1[2]), o[2].w * rs * n2.w * silu_fast(g1[3]));
            w1.z = pk2(o[3].x * rs * n3.x * silu_fast(g1[4]), o[3].y * rs * n3.y * silu_fast(g1[5])); w1.w = pk2(o[3].z * rs * n3.z * silu_fast(g1[6]), o[3].w * rs * n3.w * silu_fast(g1[7]));
            v4u* op = (v4u*)(K.XN() + (size_t)(t0 + c) * D + h * 128 + 16 * vg);
            op[0] = w0; op[1] = w1;
        }
    }
}
#undef FRAG

constexpr int GM_ROWB = 272;
__device__ __forceinline__ void phase_gmlp_mfma(Frame& F, int l) {
    const KA K = KA::fresh(); PHASE_TID;
    LAS unsigned char* lds = F.lds;
    const int fr = lane & 15, fq = lane >> 4;
#pragma unroll 1
    for (int u = F.bx; u < NB * MN * MH; u += F.G) {
        const int b = u / (MN * MH), n = (u / MH) % MN, h = u % MH, t0 = b * S + n * MC;
        const bf16* P = K.P();
        const float gn = K.in(6)[(size_t)l * 256 + h * 64 + lane];
        __syncthreads();
#pragma unroll
        for (int q = 0; q < 2; ++q) {
            float vs[8];
#pragma unroll
            for (int i = 0; i < 8; ++i) {
                const float g = gelu_fast(bf2f(P[(size_t)(t0 + 16 * wave + 8 * q + i) * PLD + C_VG + h * 64 + lane]));
                const float ss = wave_sum(g * g);
                vs[i] = g * rsqrtf(ss * (1.0f / 64.0f) + EPS) * gn;
            }
            *(LAS v4u*)(lds + lane * GM_ROWB + (16 * wave + 8 * q) * 2) = (v4u){pk2(vs[0], vs[1]), pk2(vs[2], vs[3]), pk2(vs[4], vs[5]), pk2(vs[6], vs[7])};
        }
        __syncthreads();
        const bf16* Wb = K.Wsp() + ((size_t)(l * MH + h) * 128 + 16 * wave + fr) * 128 + 8 * fq;
        f32x4 acc[4];
#pragma unroll
        for (int dt = 0; dt < 4; ++dt) acc[dt] = (f32x4){0.f, 0.f, 0.f, 0.f};
        const int nks = (16 * wave + 15) / 32 + 1;
#pragma unroll
        for (int ks = 0; ks < 4; ++ks) if (ks < nks) {
            const bf16x8 Bf = *(const bf16x8*)(Wb + 32 * ks);
#pragma unroll
            for (int dt = 0; dt < 4; ++dt) acc[dt] = mfma16(*(const LAS bf16x8*)(lds + (16 * dt + fr) * GM_ROWB + (32 * ks + 8 * fq) * 2), Bf, acc[dt]);
        }
        const int t = 16 * wave + fr;
        const float bias = K.in(8)[(size_t)l * MH * 128 + h * 128 + t];
        const bf16* up = P + (size_t)(t0 + t) * PLD + C_U + h * 64 + 4 * fq;
        bf16* op = K.XN() + (size_t)(t0 + t) * D + 512 + h * 64 + 4 * fq;
#pragma unroll
        for (int dt = 0; dt < 4; ++dt) {
            const v2u uw = *(const v2u*)(up + 16 * dt);
            const float o0 = gelu_fast(bflo(uw.x)) * (acc[dt][0] + bias), o1 = gelu_fast(bfhi(uw.x)) * (acc[dt][1] + bias), o2 = gelu_fast(bflo(uw.y)) * (acc[dt][2] + bias), o3 = gelu_fast(bfhi(uw.y)) * (acc[dt][3] + bias);
            *(v2u*)(op + 16 * dt) = (v2u){pk2(o0, o1), pk2(o2, o3)};
        }
    }
}

__device__ __forceinline__ void phase_conv(Frame& F, int l) {
    const KA K = KA::fresh(); PHASE_TID;
    const float* wc = K.in(9) + (size_t)l * 3 * 256;
#pragma unroll 1
    for (int e = F.bx * NT + tid; e < T * 32; e += F.G * NT) {
        const int t = e >> 5, c0 = (e & 31) * 8, tl = t % S;
        const bf16* row = K.P() + (size_t)t * PLD;
        float y[8], xi[8], cg[8], bg[8];
        unpack8(*(const v4u*)(row + C_XI + c0), xi); unpack8(*(const v4u*)(row + C_CG + c0), cg); unpack8(*(const v4u*)(row + C_BG + c0), bg);
#pragma unroll
        for (int j = 0; j < 8; ++j) y[j] = wc[2 * 256 + c0 + j] * cg[j] * xi[j];
        if (tl >= 1) { unpack8(*(const v4u*)(row - PLD + C_XI + c0), xi); unpack8(*(const v4u*)(row - PLD + C_CG + c0), cg);
#pragma unroll
            for (int j = 0; j < 8; ++j) y[j] += wc[1 * 256 + c0 + j] * cg[j] * xi[j]; }
        if (tl >= 2) { unpack8(*(const v4u*)(row - 2 * PLD + C_XI + c0), xi); unpack8(*(const v4u*)(row - 2 * PLD + C_CG + c0), cg);
#pragma unroll
            for (int j = 0; j < 8; ++j) y[j] += wc[0 * 256 + c0 + j] * cg[j] * xi[j]; }
#pragma unroll
        for (int j = 0; j < 8; ++j) y[j] *= bg[j];
        *(v4u*)(K.XN() + (size_t)t * D + 768 + c0) = (v4u){pk2(y[0], y[1]), pk2(y[2], y[3]), pk2(y[4], y[5]), pk2(y[6], y[7])};
    }
}
__device__ __forceinline__ void phase_norm_router(Frame& F, int l) {
    const KA K = KA::fresh(); PHASE_TID;
    const float* gain = K.in(11) + (size_t)l * D;
    const float* wrg = K.in(12) + (size_t)l * D * 4; const float* brg = K.in(13) + (size_t)l * 4;
    const float* wre = K.in(14) + (size_t)l * D * 32; const float* bre = K.in(15) + (size_t)l * 32;
    int* cnt = (int*)(K.ctl() + CW_CNT + 64 * l);
#pragma unroll 1
    for (int t = F.bx * NWAVES + wave; t < T; t += F.G * NWAVES) {
        const f32x4* xr = (const f32x4*)(K.out() + (size_t)t * D) + lane;
        f32x4 v[4]; float s = 0.f;
#pragma unroll
        for (int j = 0; j < 4; ++j) { v[j] = xr[64 * j]; s += (v[j].x * v[j].x + v[j].y * v[j].y) + (v[j].z * v[j].z + v[j].w * v[j].w); }
        const float rs = rsqrtf(wave_sum(s) * (1.f / D) + EPS);
        v2u* o8 = (v2u*)(K.XN() + (size_t)t * D) + lane;
        float acc[36];
#pragma unroll
        for (int j = 0; j < 36; ++j) acc[j] = 0.f;
#pragma unroll
        for (int j = 0; j < 4; ++j) {
            const f32x4 g = ((const f32x4*)gain)[lane + 64 * j];
            const float hv[4] = {v[j].x * rs * g.x, v[j].y * rs * g.y, v[j].z * rs * g.z, v[j].w * rs * g.w};
            v2u w; w.x = pk2(hv[0], hv[1]); w.y = pk2(hv[2], hv[3]); o8[64 * j] = w;
#pragma unroll
            for (int i = 0; i < 4; ++i) {
                const int k = 4 * lane + 256 * j + i; const float xv = hv[i];
                const f32x4 g4 = *(const f32x4*)(wrg + (size_t)k * 4);
                acc[0] += xv * g4.x; acc[1] += xv * g4.y; acc[2] += xv * g4.z; acc[3] += xv * g4.w;
                const f32x4* e4 = (const f32x4*)(wre + (size_t)k * 32);
#pragma unroll
                for (int q = 0; q < 8; ++q) { const f32x4 w4 = e4[q]; acc[4 + 4 * q] += xv * w4.x; acc[5 + 4 * q] += xv * w4.y; acc[6 + 4 * q] += xv * w4.z; acc[7 + 4 * q] += xv * w4.w; }
            }
        }
#pragma unroll
        for (int j = 0; j < 36; ++j) acc[j] = wave_sum(acc[j]);
        if (lane == 0) {
            float gl[4]; int gt = 0;
#pragma unroll
            for (int j = 0; j < 4; ++j) gl[j] = acc[j] + brg[j];
            float gmax = gl[0];
#pragma unroll
            for (int j = 1; j < 4; ++j) if (gl[j] > gmax) { gmax = gl[j]; gt = j; }
            float gs = 0.f;
#pragma unroll
            for (int j = 0; j < 4; ++j) gs += expf(gl[j] - gmax);
            const float gw = 1.0f / gs;
            float el[8];
#pragma unroll
            for (int j = 0; j < 8; ++j) { float vv = 0.f;
#pragma unroll
                for (int g = 0; g < 4; ++g) if (g == gt) vv = acc[4 + g * 8 + j] + bre[g * 8 + j];
                el[j] = vv; }
            int i0 = 0; float m0 = el[0];
#pragma unroll
            for (int j = 1; j < 8; ++j) if (el[j] > m0) { m0 = el[j]; i0 = j; }
            int i1 = -1; float m1 = -INFINITY;
#pragma unroll
            for (int j = 0; j < 8; ++j) if (j != i0 && el[j] > m1) { m1 = el[j]; i1 = j; }
            const float e1 = expf(m1 - m0);
            const float w0 = gw / (1.0f + e1), w1 = gw * e1 / (1.0f + e1);
            const int e0i = gt * 8 + i0, e1i = gt * 8 + i1;
            K.eid()[2 * t] = e0i; K.eid()[2 * t + 1] = e1i; K.ew()[2 * t] = w0; K.ew()[2 * t + 1] = w1;
            atomicAdd(&cnt[e0i], 1); atomicAdd(&cnt[e1i], 1);
        }
    }
}
constexpr int RT_PART = 0, RT_SS = RT_PART + 4 * 2 * 16 * 48 * 4, RT_RS = RT_SS + 4 * 2 * 16 * 4, RT_HIST = RT_RS + 4 * 16 * 4;
__device__ __forceinline__ void phase_norm_router_mfma(Frame& F, int l) {
    const KA K = KA::fresh(); PHASE_TID;
    LAS unsigned char* lds = F.lds;
    const int fr = lane & 15, fq = lane >> 4, tl = wave >> 1, kh = wave & 1;
    const bf16* Whi = K.Wr() + (size_t)l * 2 * 48 * D; const bf16* Wlo = Whi + 48 * D;
    const float* gain = K.in(11) + (size_t)l * D;
#pragma unroll 1
    for (int blk = F.bx; blk < T / 64; blk += F.G) {
        const int tok0 = blk * 64 + tl * 16;
        const float* xr = K.out() + (size_t)(tok0 + fr) * D + 512 * kh + 8 * fq;
        const bf16* whi = Whi + (size_t)fr * D + 512 * kh + 8 * fq; const bf16* wlo = Wlo + (size_t)fr * D + 512 * kh + 8 * fq;
        f32x4 acc[3];
#pragma unroll
        for (int nt = 0; nt < 3; ++nt) acc[nt] = (f32x4){0.f, 0.f, 0.f, 0.f};
        float ss = 0.f;
        __syncthreads();
        if (tid < NE) ((LAS int*)(lds + RT_HIST))[tid] = 0;
#pragma unroll 2
        for (int ks = 0; ks < 16; ++ks) {
            const f32x4 x0 = *(const f32x4*)(xr + 32 * ks), x1 = *(const f32x4*)(xr + 32 * ks + 4);
            const float xv[8] = {x0.x, x0.y, x0.z, x0.w, x1.x, x1.y, x1.z, x1.w};
            unsigned hw[4], lw[4];
#pragma unroll
            for (int j = 0; j < 4; ++j) { const float a = xv[2 * j], b2 = xv[2 * j + 1]; ss += a * a + b2 * b2;
                const unsigned ha = f2bf(a), hb = f2bf(b2); hw[j] = ha | (hb << 16); lw[j] = pk2(a - bf2f(ha), b2 - bf2f(hb)); }
            bf16x8 Ah, Al; { v4u t4 = (v4u){hw[0], hw[1], hw[2], hw[3]}; Ah = __builtin_bit_cast(bf16x8, t4); t4 = (v4u){lw[0], lw[1], lw[2], lw[3]}; Al = __builtin_bit_cast(bf16x8, t4); }
#pragma unroll
            for (int nt = 0; nt < 3; ++nt) {
                const bf16x8 Bh = *(const bf16x8*)(whi + (size_t)(16 * nt) * D + 32 * ks), Bl = *(const bf16x8*)(wlo + (size_t)(16 * nt) * D + 32 * ks);
                acc[nt] = mfma16(Ah, Bh, acc[nt]); acc[nt] = mfma16(Al, Bh, acc[nt]); acc[nt] = mfma16(Ah, Bl, acc[nt]);
            }
        }
        ss += shx(ss, 16); ss += shx(ss, 32);
        {
            LAS float* part = (LAS float*)(lds + RT_PART) + (tl * 2 + kh) * 16 * 48;
#pragma unroll
            for (int nt = 0; nt < 3; ++nt)
#pragma unroll
                for (int r = 0; r < 4; ++r) part[(4 * fq + r) * 48 + 16 * nt + fr] = acc[nt][r];
            if (fq == 0) ((LAS float*)(lds + RT_SS))[(tl * 2 + kh) * 16 + fr] = ss;
        }
        __syncthreads();
        if (kh == 0 && lane < 16) {
            const int t = tok0 + lane;
            const LAS float* p0 = (const LAS float*)(lds + RT_PART) + (tl * 2) * 16 * 48 + lane * 48; const LAS float* p1 = p0 + 16 * 48;
            const LAS float* s2 = (const LAS float*)(lds + RT_SS) + (tl * 2) * 16;
            const float rs = rsqrtf((s2[lane] + s2[16 + lane]) * (1.f / D) + EPS);
            ((LAS float*)(lds + RT_RS))[tl * 16 + lane] = rs;
            const float* brg = K.in(13) + (size_t)l * 4; const float* bre = K.in(15) + (size_t)l * 32;
            float gl[4]; int gt = 0;
#pragma unroll
            for (int j = 0; j < 4; ++j) gl[j] = (p0[j] + p1[j]) * rs + brg[j];
            float gmax = gl[0];
#pragma unroll
            for (int j = 1; j < 4; ++j) if (gl[j] > gmax) { gmax = gl[j]; gt = j; }
            float gs = 0.f;
#pragma unroll
            for (int j = 0; j < 4; ++j) gs += expf(gl[j] - gmax);
            const float gw = 1.0f / gs;
            float el[8];
#pragma unroll
            for (int j = 0; j < 8; ++j) el[j] = (p0[4 + gt * 8 + j] + p1[4 + gt * 8 + j]) * rs + bre[gt * 8 + j];
            int i0 = 0; float m0 = el[0];
#pragma unroll
            for (int j = 1; j < 8; ++j) if (el[j] > m0) { m0 = el[j]; i0 = j; }
            int i1 = -1; float m1 = -INFINITY;
#pragma unroll
            for (int j = 0; j < 8; ++j) if (j != i0 && el[j] > m1) { m1 = el[j]; i1 = j; }
            const float e1 = expf(m1 - m0);
            const float w0 = gw / (1.0f + e1), w1 = gw * e1 / (1.0f + e1);
            const int e0i = gt * 8 + i0, e1i = gt * 8 + i1;
            K.eid()[2 * t] = e0i; K.eid()[2 * t + 1] = e1i; K.ew()[2 * t] = w0; K.ew()[2 * t + 1] = w1;
            LAS int* hist = (LAS int*)(lds + RT_HIST);
            K.slot_of()[2 * t] = __hip_atomic_fetch_add(hist + e0i, 1, __ATOMIC_RELAXED, __HIP_MEMORY_SCOPE_WORKGROUP);
            K.slot_of()[2 * t + 1] = __hip_atomic_fetch_add(hist + e1i, 1, __ATOMIC_RELAXED, __HIP_MEMORY_SCOPE_WORKGROUP);
        }
        __syncthreads();
        if (tid < NE) K.blkcnt()[(size_t)(l * (T / 64) + blk) * NE + tid] = ((LAS int*)(lds + RT_HIST))[tid];
        {
            const float rs = ((const LAS float*)(lds + RT_RS))[tl * 16 + fr];
            bf16* hp = K.XN() + (size_t)(tok0 + fr) * D + 512 * kh + 8 * fq;
            const float* gp = gain + 512 * kh + 8 * fq;
#pragma unroll 4
            for (int ks = 0; ks < 16; ++ks) {
                const f32x4 x0 = *(const f32x4*)(xr + 32 * ks), x1 = *(const f32x4*)(xr + 32 * ks + 4);
                const f32x4 g0 = *(const f32x4*)(gp + 32 * ks), g1 = *(const f32x4*)(gp + 32 * ks + 4);
                *(v4u*)(hp + 32 * ks) = (v4u){pk2(x0.x * rs * g0.x, x0.y * rs * g0.y), pk2(x0.z * rs * g0.z, x0.w * rs * g0.w), pk2(x1.x * rs * g1.x, x1.y * rs * g1.y), pk2(x1.z * rs * g1.z, x1.w * rs * g1.w)};
            }
        }
    }
}
__device__ __forceinline__ void phase_scatter(Frame& F, int l) {
    const KA K = KA::fresh(); PHASE_TID;
    LAS int* sm = (LAS int*)F.lds;
    const int* bc = K.blkcnt() + (size_t)l * (T / 64) * NE;
    constexpr int NBLK = T / 64;
#pragma unroll 1
    for (int blk = F.bx; blk < NBLK; blk += F.G) {
        __syncthreads();
        {   const int e = tid & 31, part = tid >> 5;
            int tot = 0, pre = 0;
#pragma unroll
            for (int j = 0; j < NBLK / 16; ++j) { const int bb = part * (NBLK / 16) + j; const int c = bc[bb * NE + e]; tot += c; if (bb < blk) pre += c; }
            sm[part * 32 + e] = tot; sm[512 + part * 32 + e] = pre; }
        __syncthreads();
        if (tid < 32) { int tot = 0, pre = 0;
#pragma unroll
            for (int p = 0; p < 16; ++p) { tot += sm[p * 32 + tid]; pre += sm[512 + p * 32 + tid]; }
            sm[1056 + tid] = tot; sm[1024 + tid] = pre; }
        __syncthreads();
        if (tid == 0) { int a = 0; for (int e = 0; e < NE; ++e) { const int c = sm[1056 + e]; sm[1024 + e] += a; a += c; } }
        if (blk == 0 && tid < 32) ((int*)(K.ctl() + CW_CNT + 64 * l))[tid] = sm[1056 + tid];
        __syncthreads();
        if (tid < 128) { const int a = blk * 128 + tid; const int e = K.eid()[a]; const int pos = sm[1024 + e] + K.slot_of()[a]; K.slot_tok()[pos] = a >> 1; K.slot_of()[a] = pos; }
    }
    __syncthreads();
}
template <bool DUAL>
__device__ __forceinline__ void gemm_core(const bf16* A, const int* rowoff, int K, const float* B0, const float* B1, int ldb, int n0,
                                          float (&acc0)[4][4], float (&acc1)[4][4], float* As, float* Bs0, float* Bs1) {
    const int tid = __builtin_amdgcn_readfirstlane(threadIdx.x >> 6) * 64 + fresh_lane(), tx = tid & 15, ty = tid >> 4;
    const int ar = tid >> 2, ak = (tid & 3) * 4;
    const int bk = (tid >> 4) & 15, bn = (tid & 15) * 4;
    const long aoff = rowoff[ar];
#pragma unroll
    for (int i = 0; i < 4; ++i)
#pragma unroll
        for (int j = 0; j < 4; ++j) { acc0[i][j] = 0.f; acc1[i][j] = 0.f; }
#pragma unroll 1
    for (int k0 = 0; k0 < K; k0 += 16) {
        v2u av = (v2u){0u, 0u};
        if (aoff >= 0) av = *(const v2u*)(A + aoff + k0 + ak);
        f32x4 bv0 = (f32x4){0.f, 0.f, 0.f, 0.f}, bv1 = bv0;
        if (tid < 256) { bv0 = *(const f32x4*)(B0 + (size_t)(k0 + bk) * ldb + n0 + bn); if (DUAL) bv1 = *(const f32x4*)(B1 + (size_t)(k0 + bk) * ldb + n0 + bn); }
        __syncthreads();
        As[(ak + 0) * 132 + ar] = bflo(av.x); As[(ak + 1) * 132 + ar] = bfhi(av.x); As[(ak + 2) * 132 + ar] = bflo(av.y); As[(ak + 3) * 132 + ar] = bfhi(av.y);
        if (tid < 256) { *(f32x4*)(Bs0 + bk * 64 + bn) = bv0; if (DUAL) *(f32x4*)(Bs1 + bk * 64 + bn) = bv1; }
        __syncthreads();
#pragma unroll
        for (int kk = 0; kk < 16; ++kk) {
            const f32x4 a4 = *(const f32x4*)(As + kk * 132 + ty * 4);
            const f32x4 b4 = *(const f32x4*)(Bs0 + kk * 64 + tx * 4);
#pragma unroll
            for (int i = 0; i < 4; ++i)
#pragma unroll
                for (int j = 0; j < 4; ++j) acc0[i][j] += a4[i] * b4[j];
            if (DUAL) {
                const f32x4 c4 = *(const f32x4*)(Bs1 + kk * 64 + tx * 4);
#pragma unroll
                for (int i = 0; i < 4; ++i)
#pragma unroll
                    for (int j = 0; j < 4; ++j) acc1[i][j] += a4[i] * c4[j];
            }
        }
    }
}
template <int MODE>
__device__ __forceinline__ void phase_moe_ref(Frame& F, int l) {
    const KA K = KA::fresh(); PHASE_TID;
    float* As = F.smem; float* Bs0 = F.smem + 16 * 132; float* Bs1 = Bs0 + 16 * 64; int* rowoff = (int*)(Bs1 + 16 * 64); int* offs = rowoff + 128; int* toff = offs + 33;
    int* cnt = (int*)(K.ctl() + CW_CNT + 64 * l);
    const int tx = tid & 15, ty = tid >> 4;
    __syncthreads();
    if (tid == 0) { int a = 0, tt = 0; for (int e = 0; e < NE; ++e) { offs[e] = a; toff[e] = tt; const int c = cnt[e]; a += c; tt += (c + 127) / 128; } offs[NE] = a; toff[NE] = tt; }
    __syncthreads();
    constexpr int N = (MODE == 1) ? DE : D, KD = (MODE == 1) ? D : DE, NTN = N / 64;
    const int ntiles = toff[NE] * NTN;
#pragma unroll 1
    for (int t = F.bx; t < ntiles; t += F.G) {
        const int rt = t / NTN, tn = t % NTN;
        int e = 0;
        for (int j = 1; j < NE; ++j) if (toff[j] <= rt) e = j;
        const int r0 = offs[e] + (rt - toff[e]) * 128, rend = offs[e + 1];
        __syncthreads();
        if (tid < 128) { const int r = r0 + tid; rowoff[tid] = (r < rend) ? ((MODE == 1) ? K.slot_tok()[r] * D : r * DE) : -1; }
        __syncthreads();
        float acc0[4][4], acc1[4][4];
        if (MODE == 1) {
            const float* Wg = K.in(16) + ((size_t)l * NE + e) * D * DE; const float* Wu = K.in(17) + ((size_t)l * NE + e) * D * DE;
            gemm_core<true>(K.XN(), rowoff, KD, Wg, Wu, DE, tn * 64, acc0, acc1, As, Bs0, Bs1);
        } else {
            const float* Wd = K.in(18) + ((size_t)l * NE + e) * DE * D;
            gemm_core<false>(K.H1(), rowoff, KD, Wd, nullptr, D, tn * 64, acc0, acc1, As, Bs0, nullptr);
        }
#pragma unroll
        for (int i = 0; i < 4; ++i) {
            const int r = r0 + ty * 4 + i;
            if (r < rend) {
                v2u o;
                if (MODE == 1) { o.x = pk2(silu(acc0[i][0]) * acc1[i][0], silu(acc0[i][1]) * acc1[i][1]); o.y = pk2(silu(acc0[i][2]) * acc1[i][2], silu(acc0[i][3]) * acc1[i][3]);
                    *(v2u*)(K.H1() + (size_t)r * DE + tn * 64 + tx * 4) = o; }
                else { o.x = pk2(acc0[i][0], acc0[i][1]); o.y = pk2(acc0[i][2], acc0[i][3]); *(v2u*)(K.Y() + (size_t)r * D + tn * 64 + tx * 4) = o; }
            }
        }
    }
    __syncthreads();
}

constexpr int TAB_OFF = LDSCTL_OFF + 1024;
__device__ __forceinline__ void moe_tables(Frame& F, int l) {
    const KA K = KA::fresh(); PHASE_TID;
    LAS int* tab = (LAS int*)(F.lds + TAB_OFF); LAS int* offs = tab + 4 + 4 * 164; LAS int* fpre = offs + 40; LAS int* ppre = fpre + 40;
    const int* cnt = (const int*)(K.ctl() + CW_CNT + 64 * l);
    __syncthreads();
    if (tid == 0) { int a = 0, f = 0, p = 0; for (int e = 0; e < NE; ++e) { const int c = cnt[e]; offs[e] = a; fpre[e] = f; ppre[e] = p; a += c; f += c >> 8; p += (c & 255) ? 1 : 0; }
        offs[NE] = a; fpre[NE] = f; ppre[NE] = p; tab[0] = f + p; }
    __syncthreads();
    const int nfull = fpre[NE], ntile = nfull + ppre[NE];
    if (tid < ntile) {
        int e = 0;
        if (tid < nfull) { for (int j = 1; j < NE; ++j) if (fpre[j] <= tid) e = j; tab[4 + 4 * tid] = e; tab[5 + 4 * tid] = offs[e] + (tid - fpre[e]) * 256; tab[6 + 4 * tid] = offs[e + 1]; }
        else { const int q = tid - nfull; for (int j = 1; j < NE; ++j) if (ppre[j] <= q) e = j; tab[4 + 4 * tid] = e; tab[5 + 4 * tid] = offs[e] + (fpre[e + 1] - fpre[e]) * 256; tab[6 + 4 * tid] = offs[e + 1]; }
    }
    __syncthreads();
}
__device__ __forceinline__ void phase_moe_gu(Frame& F, int l) {
    moe_tables(F, l);
    const KA K = KA::fresh();
    int c_ = F.bx; asm volatile("" : "+s"(c_));
    pg8::MoeSched So{(const LAS int*)(F.lds + TAB_OFF), 2, F.G, (c_ & 7) * (F.G >> 3) + (c_ >> 3)};
    pg8::EpiMoeH E{K.H1()};
    pg8::gemm_phase_moe<pg8::EpiMoeH, pg8::MoeSched, true, 512, D>(F.lds, K.XN(), K.WguT() + (size_t)l * NE * 512 * D, K.slot_tok(), So, E, F.wave);
}
__device__ __forceinline__ void phase_moe_down(Frame& F, int l) {
    moe_tables(F, l);
    const KA K = KA::fresh();
    int c_ = F.bx; asm volatile("" : "+s"(c_));
    pg8::MoeSched So{(const LAS int*)(F.lds + TAB_OFF), 4, F.G, (c_ & 7) * (F.G >> 3) + (c_ >> 3)};
    pg8::EpiMoeY E{K.Y()};
    pg8::gemm_phase_moe<pg8::EpiMoeY, pg8::MoeSched, false, D, DE>(F.lds, K.H1(), K.WdT() + (size_t)l * NE * D * DE, nullptr, So, E, F.wave);
}
__device__ __forceinline__ void phase_combine(Frame& F, int l) {
    const KA K = KA::fresh(); PHASE_TID;
    const bool last = (l == DEPTH - 1);
    const float* gain = last ? K.in(19) : (K.in(1) + (size_t)(l + 1) * D);
#pragma unroll 1
    for (int t = F.bx * NWAVES + wave; t < T; t += F.G * NWAVES) {
        const int s0 = K.slot_of()[2 * t], s1 = K.slot_of()[2 * t + 1]; const float w0 = K.ew()[2 * t], w1 = K.ew()[2 * t + 1];
        f32x4* xr = (f32x4*)(K.out() + (size_t)t * D) + lane;
        const v2u* y0 = (const v2u*)(K.Y() + (size_t)s0 * D) + lane; const v2u* y1 = (const v2u*)(K.Y() + (size_t)s1 * D) + lane;
        f32x4 v[4]; float s = 0.f;
#pragma unroll
        for (int j = 0; j < 4; ++j) { v[j] = xr[64 * j]; const v2u a = y0[64 * j], b = y1[64 * j];
            v[j].x += w0 * bflo(a.x) + w1 * bflo(b.x); v[j].y += w0 * bfhi(a.x) + w1 * bfhi(b.x); v[j].z += w0 * bflo(a.y) + w1 * bflo(b.y); v[j].w += w0 * bfhi(a.y) + w1 * bfhi(b.y);
            s += (v[j].x * v[j].x + v[j].y * v[j].y) + (v[j].z * v[j].z + v[j].w * v[j].w); }
        const float rs = rsqrtf(wave_sum(s) * (1.f / D) + EPS);
        if (last) {
#pragma unroll
            for (int j = 0; j < 4; ++j) { const f32x4 g = ((const f32x4*)gain)[lane + 64 * j]; xr[64 * j] = (f32x4){v[j].x * rs * g.x, v[j].y * rs * g.y, v[j].z * rs * g.z, v[j].w * rs * g.w}; }
        } else {
            v2u* o8 = (v2u*)(K.XN() + (size_t)t * D) + lane;
#pragma unroll
            for (int j = 0; j < 4; ++j) { xr[64 * j] = v[j]; const f32x4 g = ((const f32x4*)gain)[lane + 64 * j];
                v2u w; w.x = pk2(v[j].x * rs * g.x, v[j].y * rs * g.y); w.y = pk2(v[j].z * rs * g.z, v[j].w * rs * g.w); o8[64 * j] = w; }
        }
    }
}

struct Args { const float* in[20]; float* out; unsigned char* ws; };
__global__ void __launch_bounds__(NT, 2) fwd_kernel(Args args) {
    extern __shared__ __attribute__((aligned(16))) unsigned char lds_raw[];
    cg::grid_group grid = cg::this_grid();
    Frame F;
    F.lds = (LAS unsigned char*)lds_raw; F.smem = (float*)lds_raw;
    F.G = gridDim.x; F.bx = blockIdx.x; F.wave = __builtin_amdgcn_readfirstlane(threadIdx.x >> 6);
    volatile LAS unsigned* MISC = (volatile LAS unsigned*)(F.lds + MISC_OFF);
    for (int u = threadIdx.x; u < (LDS_BYTES - LDSCTL_OFF) / 4; u += NT) ((LAS unsigned*)(F.lds + LDSCTL_OFF))[u] = 0u;
    __syncthreads();
    XcdBarrier bar; { const KA K = KA::fresh(); bar = xcd_barrier_post(K.ctl() + CW_BAR, MISC + 8); }
#define GRID_BAR() xcd_barrier(bar)

    p0_prologue(F);
    grid.sync();
    for (int l = 0; l < DEPTH; ++l) {
        {
            const KA K = KA::fresh(); PHASE_TID;
            pg8::Gemm g{K.XN(), K.WinT() + (size_t)l * PLD * D, T, PLD, D}; pg8::StaticOrder So; int c_ = F.bx; asm volatile("" : "+s"(c_)); So.init(T, PLD, F.G, c_);
            pg8::EpiBf16Plain E{K.P(), PLD};
            pg8::gemm_phase<pg8::EpiBf16Plain, pg8::StaticOrder, PG8_ALIGN, PG8_SP2>(F.lds, g, So, E, F.wave);
        }
        GRID_BAR();
        phase_gla_kv_mfma(F, l);
        phase_gmlp_mfma(F, l);
        phase_conv(F, l);
        GRID_BAR();
        phase_gla_scan(F);
        GRID_BAR();
        phase_gla_out_mfma(F, l);
        GRID_BAR();
        {
            const KA K = KA::fresh(); PHASE_TID;
            pg8::Gemm g{K.XN(), K.WoutT() + (size_t)l * D * D, T, D, D}; pg8::StaticOrder So; int c_ = F.bx; asm volatile("" : "+s"(c_)); So.init(T, D, F.G, c_);
            pg8::EpiF32Res E{K.out(), (l == 0) ? K.in(0) : K.out(), D};
            pg8::gemm_phase<pg8::EpiF32Res, pg8::StaticOrder, PG8_ALIGN, PG8_SP2>(F.lds, g, So, E, F.wave);
        }
        GRID_BAR();
        phase_norm_router_mfma(F, l);
        GRID_BAR();
        phase_scatter(F, l);
        GRID_BAR();
        phase_moe_gu(F, l);
        GRID_BAR();
        phase_moe_down(F, l);
        GRID_BAR();
        phase_combine(F, l);
        if (l + 1 < DEPTH) GRID_BAR();
    }
}

extern "C" void kernel_launch(void* const* d_in, const int* in_sizes, int n_in, void* d_out, int out_size, void* d_ws, size_t ws_size, hipStream_t stream) {
    static int grid_blocks = 0;
    if (!grid_blocks) {
        int dev = 0, cus = 0, per_cu = 0;
        (void)hipGetDevice(&dev);
        (void)hipDeviceGetAttribute(&cus, hipDeviceAttributeMultiprocessorCount, dev);
        (void)hipFuncSetAttribute((const void*)fwd_kernel, hipFuncAttributeMaxDynamicSharedMemorySize, LDS_BYTES);
        (void)hipOccupancyMaxActiveBlocksPerMultiprocessor(&per_cu, fwd_kernel, NT, LDS_BYTES);
        if (per_cu < 1) { fprintf(stderr, "kernel_launch: occupancy query says %d blocks/CU\n", per_cu); per_cu = 1; }
        grid_blocks = cus;
        if (ws_size < WS_END) { fprintf(stderr, "kernel_launch: workspace too small (%zu < %zu)\n", ws_size, (size_t)WS_END); grid_blocks = -1; }
    }
    if (grid_blocks < 0) return;
    (void)hipMemsetAsync((char*)d_ws + WS_CTL, 0, CTL_BYTES, stream);
    Args a{};
    for (int i = 0; i < 20; ++i) a.in[i] = (const float*)d_in[i];
    a.out = (float*)d_out; a.ws = (unsigned char*)d_ws;
    void* args[] = {&a};
    hipError_t e = hipLaunchCooperativeKernel((void*)fwd_kernel, dim3(grid_blocks), dim3(NT), args, LDS_BYTES, stream);
    if (e != hipSuccess) fprintf(stderr, "cooperative launch failed: %s (grid %d)\n", hipGetErrorString(e), grid_blocks);
}
```

```cpp
#include <hip/hip_runtime.h>
#include <hip/hip_cooperative_groups.h>
#include <cstdio>
#include <cstdint>
namespace cg = cooperative_groups;
__device__ __forceinline__ int fresh_lane() { unsigned m = 0xffffffffu; asm volatile("" : "+s"(m)); return (int)__builtin_amdgcn_mbcnt_hi(m, __builtin_amdgcn_mbcnt_lo(m, 0u)); }
__device__ __forceinline__ float shx(float v, int o) { return __int_as_float(__builtin_amdgcn_ds_bpermute((fresh_lane() ^ o) << 2, __float_as_int(v))); }
namespace pg8 {
#define PG8_LAS __attribute__((address_space(3)))
typedef unsigned short bf16_t;
typedef short bf16x8 __attribute__((ext_vector_type(8)));
typedef float f32x4 __attribute__((ext_vector_type(4)));
typedef unsigned u32x4 __attribute__((ext_vector_type(4)));
constexpr int BM = 256, BK = 64, HALF = 128, HTB = HALF * BK * 2  , STAGE_BYTES = 8 * HTB, NXCD = 8, WGM = 8;

__host__ __device__ __forceinline__ int lds_byte(int r, int c) { const int st = (r >> 4) * 2 + (c >> 5), rr = r & 15, cc = c & 31, ob = rr * 64 + cc * 2; return st * 1024 + (ob ^ (((ob >> 9) & 1) << 5)); }
__host__ __device__ __forceinline__ void stage_rc(int b, int& R, int& C) { const int st = b / 1024, sb = b % 1024, swz = sb ^ (((sb >> 9) & 1) << 5); R = (st >> 1) * 16 + swz / 64; C = (st & 1) * 32 + (swz % 64) / 2; }
__host__ __device__ __forceinline__ int perm32(int rho) { const int n = rho >> 4, i = rho & 15; return 8 * (i >> 2) + 4 * n + (i & 3); }

struct Unit { int pm, pn; };
struct Gemm { const bf16_t* A; const bf16_t* Bt; int M, N, K; };

struct StaticOrder {
    int nM, nN, nwg, G, c;
    __host__ __device__ void init(int M, int N, int G_, int c_) { nM = M / BM; nN = N / BM; nwg = nM * nN; G = G_; c = c_; }
    __host__ __device__ bool next(int i, Unit& u) const {
        const long L = (long)i * G + c; if (L >= nwg) return false;
        int wgid = (int)L; { const int q = nwg / NXCD, r = nwg % NXCD, xcd = wgid % NXCD, off = wgid / NXCD; wgid = (xcd < r ? xcd * (q + 1) : r * (q + 1) + (xcd - r) * q) + off; }
        const int nig = WGM * nN, gid = wgid / nig, fm = gid * WGM, gsz = (nM - fm) < WGM ? (nM - fm) : WGM;
        u.pm = fm + ((wgid % nig) % gsz); u.pn = (wgid % nig) / gsz; return true;
    }
    __device__ __forceinline__ void a_ready(const Unit&) const {}
    __device__ __forceinline__ void done(const Unit&) const {}
};


__device__ __forceinline__ unsigned cvt_pk_bf16(float lo, float hi) { unsigned r; asm volatile("v_cvt_pk_bf16_f32 %0, %1, %2" : "=v"(r) : "v"(lo), "v"(hi)); return r; }
struct EpiBf16Plain {
    static constexpr bool PERM = true, AFTER_DRAIN = false;
    bf16_t* O; int ldc;
    __device__ __forceinline__ void operator()(const f32x4 (&acc)[2][2][4][2], const Unit& u, int wr, int wc, int fr, int fq) const {
        const int row0 = u.pm * BM + wr * 64 + fr, col0 = u.pn * BM + wc * 32 + 8 * fq;
#pragma unroll
        for (int ai = 0; ai < 2; ++ai)
#pragma unroll
            for (int m = 0; m < 4; ++m) { bf16_t* rowp = O + (size_t)(row0 + ai * HALF + m * 16) * ldc + col0;
#pragma unroll
                for (int bj = 0; bj < 2; ++bj) { const f32x4 v0 = acc[ai][bj][m][0], v1 = acc[ai][bj][m][1];
                    u32x4 w; w.x = cvt_pk_bf16(v0[0], v0[1]); w.y = cvt_pk_bf16(v0[2], v0[3]); w.z = cvt_pk_bf16(v1[0], v1[1]); w.w = cvt_pk_bf16(v1[2], v1[3]);
                    *(u32x4*)(rowp + bj * HALF) = w; } }
    }
};
struct EpiF32Res {
    static constexpr bool PERM = false, AFTER_DRAIN = false;
    float* C; const float* R; int ldc;
    __device__ __forceinline__ void operator()(const f32x4 (&acc)[2][2][4][2], const Unit& u, int wr, int wc, int fr, int fq) const {
        const int row0 = u.pm * BM + wr * 64 + fr, col0 = u.pn * BM + wc * 32 + 4 * fq;
#pragma unroll
        for (int ai = 0; ai < 2; ++ai)
#pragma unroll
            for (int m = 0; m < 4; ++m) { const size_t off = (size_t)(row0 + ai * HALF + m * 16) * ldc + col0;
#pragma unroll
                for (int bj = 0; bj < 2; ++bj)
#pragma unroll
                    for (int n = 0; n < 2; ++n) { const f32x4 r = *(const f32x4*)(R + off + bj * HALF + n * 16); *(f32x4*)(C + off + bj * HALF + n * 16) = r + acc[ai][bj][m][n]; } }
    }
};
template <class Epi, class Sched, bool ALIGN_EPI = false, bool SP2 = false>
__device__ __forceinline__ void gemm_phase(PG8_LAS unsigned char* lds, const Gemm g, const Sched& S, const Epi& E, int wave_id) {
    asm volatile("" : "+s"(wave_id));
    const int lane = fresh_lane(), wid = wave_id, tid = wid * 64 + lane, wr = wid >> 2, wc = wid & 3, fr = lane & 15, fq = lane >> 4;
    const int K = g.K, nt = K / BK;
    unsigned voffA[2], voffB[2];
#pragma unroll
    for (int i = 0; i < 2; ++i) { int R, C; stage_rc(tid * 16 + i * 8192, R, C); const int Rb = Epi::PERM ? ((R & ~31) + perm32(R & 31)) : R;
        voffA[i] = (unsigned)(R * K + C) * 2u; voffB[i] = (unsigned)(Rb * K + C) * 2u; }
    const size_t kstep = (size_t)(BK * 2);
    const size_t hstep = (size_t)HALF * K * 2;
    const size_t tstep = 2 * hstep;
    const unsigned ldsw = (unsigned)wid * 1024u;
    const int aoff = lds_byte(wr * 64 + fr, fq * 8), boff = lds_byte(wc * 32 + fr, fq * 8);
#define PG8_SA(b, h) (((b) * 2 + (h)) * HTB)
#define PG8_SB(b, h) ((4 + (b) * 2 + (h)) * HTB)
#define PG8_STAGE(bufoff, gbase, voff) do { _Pragma("unroll") for (int _i = 0; _i < 2; ++_i) \
        __builtin_amdgcn_global_load_lds((const unsigned*)((const char*)(gbase) + (voff)[_i]), (PG8_LAS unsigned*)(lds + (bufoff) + ldsw + _i * 8192), 16, 0, 0); } while (0)
#define PG8_LDA(dst, b, h) do { _Pragma("unroll") for (int m = 0; m < 4; ++m) _Pragma("unroll") for (int k = 0; k < 2; ++k) dst[m][k] = *(const PG8_LAS bf16x8*)(lds + PG8_SA(b, h) + aoff + m * 2048 + k * 1024); } while (0)
#define PG8_LDB(dst, b, h) do { _Pragma("unroll") for (int n = 0; n < 2; ++n) _Pragma("unroll") for (int k = 0; k < 2; ++k) dst[n][k] = *(const PG8_LAS bf16x8*)(lds + PG8_SB(b, h) + boff + n * 2048 + k * 1024); } while (0)
#define PG8_MMA(ai, bj, At, Bt) do { __builtin_amdgcn_s_setprio(1); _Pragma("unroll") for (int m = 0; m < 4; ++m) _Pragma("unroll") for (int n = 0; n < 2; ++n) _Pragma("unroll") for (int k = 0; k < 2; ++k) \
        acc[ai][bj][m][n] = __builtin_amdgcn_mfma_f32_16x16x32_bf16(Bt[n][k], At[m][k], acc[ai][bj][m][n], 0, 0, 0); __builtin_amdgcn_s_setprio(0); } while (0)
#define PG8_WAIT_V(n) asm volatile("s_waitcnt vmcnt(" #n ")" ::: "memory")
#define PG8_WAIT_L(n) asm volatile("s_waitcnt lgkmcnt(" #n ")" ::: "memory")
#define PG8_BAR __builtin_amdgcn_s_barrier()
#define PG8_SCHED __builtin_amdgcn_sched_barrier(0)
    Unit cur, nxt; int ui = 0;
    if (!S.next(0, cur)) return;
    f32x4 acc[2][2][4][2];
#pragma unroll
    for (int a = 0; a < 2; ++a)
#pragma unroll
        for (int b = 0; b < 2; ++b)
#pragma unroll
            for (int m = 0; m < 4; ++m)
#pragma unroll
                for (int n = 0; n < 2; ++n) acc[a][b][m][n] = (f32x4){0.f, 0.f, 0.f, 0.f};
    bf16x8 At[4][2], B0[2][2], B1[2][2];
    const char* cA = (const char*)g.A + (size_t)cur.pm * tstep; const char* cB = (const char*)g.Bt + (size_t)cur.pn * tstep;
    S.a_ready(cur);
    if constexpr (SP2) {
        PG8_STAGE(PG8_SB(0, 0), cB, voffB); PG8_STAGE(PG8_SB(0, 1), cB + hstep, voffB); PG8_STAGE(PG8_SA(0, 0), cA, voffA); PG8_STAGE(PG8_SA(0, 1), cA + hstep, voffA);
        if (wr == 1) PG8_BAR;
        PG8_WAIT_V(2); PG8_BAR;
        PG8_STAGE(PG8_SB(1, 0), cB + kstep, voffB); PG8_STAGE(PG8_SA(1, 0), cA + kstep, voffA); PG8_STAGE(PG8_SB(1, 1), cB + hstep + kstep, voffB);
        PG8_WAIT_V(6); PG8_BAR;
    } else {
        PG8_STAGE(PG8_SB(0, 0), cB, voffB); PG8_STAGE(PG8_SA(0, 0), cA, voffA); PG8_STAGE(PG8_SB(0, 1), cB + hstep, voffB); PG8_STAGE(PG8_SA(0, 1), cA + hstep, voffA);
        if (wr == 1) PG8_BAR;
        PG8_WAIT_V(4); PG8_BAR;
        PG8_STAGE(PG8_SB(1, 0), cB + kstep, voffB); PG8_STAGE(PG8_SA(1, 0), cA + kstep, voffA); PG8_STAGE(PG8_SB(1, 1), cB + hstep + kstep, voffB);
        PG8_WAIT_V(6); PG8_BAR;
    }
    for (;;) {
        const bool has_next = S.next(ui + 1, nxt);
        const char* nA = has_next ? (const char*)g.A + (size_t)nxt.pm * tstep : cA; const char* nB = has_next ? (const char*)g.Bt + (size_t)nxt.pn * tstep : cB;
        for (int t = 0; t < nt; t += 2) {
            const bool last = (t == nt - 2);
            const char* a1 = cA + (size_t)(t + 1) * kstep;
            const char* a2 = last ? nA : cA + (size_t)(t + 2) * kstep; const char* b2 = last ? nB : cB + (size_t)(t + 2) * kstep;
            const char* a3 = a2 + kstep; const char* b3 = b2 + kstep;
            if (last && has_next) S.a_ready(nxt);
            if constexpr (SP2) {
            PG8_LDB(B0, 0, 0); PG8_LDB(B1, 0, 1); PG8_SCHED; PG8_LDA(At, 0, 0); PG8_STAGE(PG8_SA(1, 1), a1 + hstep, voffA);
            PG8_WAIT_V(8); PG8_WAIT_L(0); PG8_BAR; PG8_MMA(0, 0, At, B0); PG8_MMA(0, 1, At, B1); PG8_BAR; PG8_SCHED;
            PG8_LDA(At, 0, 1); PG8_STAGE(PG8_SB(0, 0), b2, voffB); PG8_STAGE(PG8_SB(0, 1), b2 + hstep, voffB); PG8_STAGE(PG8_SA(0, 0), a2, voffA);
            PG8_WAIT_V(8); PG8_WAIT_L(0); PG8_BAR; PG8_MMA(1, 0, At, B0); PG8_MMA(1, 1, At, B1); PG8_BAR; PG8_SCHED;
            PG8_LDB(B0, 1, 0); PG8_LDB(B1, 1, 1); PG8_SCHED; PG8_LDA(At, 1, 0); PG8_STAGE(PG8_SA(0, 1), a2 + hstep, voffA);
            PG8_WAIT_V(8); PG8_WAIT_L(0); PG8_BAR; PG8_MMA(0, 0, At, B0); PG8_MMA(0, 1, At, B1); PG8_BAR; PG8_SCHED;
            PG8_LDA(At, 1, 1); PG8_STAGE(PG8_SB(1, 0), b3, voffB); PG8_STAGE(PG8_SB(1, 1), b3 + hstep, voffB); PG8_STAGE(PG8_SA(1, 0), a3, voffA);
            PG8_WAIT_V(8); PG8_WAIT_L(0); PG8_BAR; PG8_MMA(1, 0, At, B0); PG8_MMA(1, 1, At, B1); PG8_BAR; PG8_SCHED;
            } else {
            PG8_LDB(B0, 0, 0); PG8_SCHED; PG8_LDA(At, 0, 0); PG8_STAGE(PG8_SA(1, 1), a1 + hstep, voffA);
            PG8_WAIT_L(8); PG8_BAR; PG8_WAIT_L(0); PG8_MMA(0, 0, At, B0); PG8_BAR; PG8_SCHED;
            PG8_LDB(B1, 0, 1); PG8_STAGE(PG8_SB(0, 0), b2, voffB);
            PG8_BAR; PG8_WAIT_L(0); PG8_MMA(0, 1, At, B1); PG8_BAR;
            PG8_LDA(At, 0, 1); PG8_STAGE(PG8_SA(0, 0), a2, voffA);
            PG8_BAR; PG8_WAIT_L(0); PG8_MMA(1, 0, At, B0); PG8_BAR; PG8_SCHED;
            PG8_STAGE(PG8_SB(0, 1), b2 + hstep, voffB);
            PG8_WAIT_V(6); PG8_BAR; PG8_MMA(1, 1, At, B1); PG8_BAR;
            PG8_LDB(B0, 1, 0); PG8_SCHED; PG8_LDA(At, 1, 0); PG8_STAGE(PG8_SA(0, 1), a2 + hstep, voffA);
            PG8_WAIT_L(8); PG8_BAR; PG8_WAIT_L(0); PG8_MMA(0, 0, At, B0); PG8_BAR; PG8_SCHED;
            PG8_LDB(B1, 1, 1); PG8_STAGE(PG8_SB(1, 0), b3, voffB);
            PG8_BAR; PG8_WAIT_L(0); PG8_MMA(0, 1, At, B1); PG8_BAR;
            PG8_LDA(At, 1, 1); PG8_STAGE(PG8_SA(1, 0), a3, voffA);
            PG8_BAR; PG8_WAIT_L(0); PG8_MMA(1, 0, At, B0); PG8_BAR; PG8_SCHED;
            PG8_STAGE(PG8_SB(1, 1), b3 + hstep, voffB);
            PG8_WAIT_V(6); PG8_BAR; PG8_MMA(1, 1, At, B1); PG8_BAR;
            }
        }
        if constexpr (ALIGN_EPI) { if (wr == 0) PG8_BAR; }
        if constexpr (!Epi::AFTER_DRAIN) { E(acc, cur, wr, wc, fr, fq); S.done(cur); }
        if (!has_next) break;
#pragma unroll
        for (int a = 0; a < 2; ++a)
#pragma unroll
            for (int b = 0; b < 2; ++b)
#pragma unroll
                for (int m = 0; m < 4; ++m)
#pragma unroll
                    for (int n = 0; n < 2; ++n) acc[a][b][m][n] = (f32x4){0.f, 0.f, 0.f, 0.f};
        cur = nxt; cA = nA; cB = nB; ++ui;
        if constexpr (ALIGN_EPI) { if (wr == 1) PG8_BAR; }
    }
    PG8_WAIT_V(0);
    if constexpr (!ALIGN_EPI) { if (wr == 0) PG8_BAR; }
    PG8_BAR;
    if constexpr (Epi::AFTER_DRAIN) { E.fused(acc, cur, wr, wc, fr, fq, lds, wid, lane); S.done(cur); }
#undef PG8_SA
#undef PG8_SB
#undef PG8_STAGE
#undef PG8_LDA
#undef PG8_LDB
#undef PG8_MMA
#undef PG8_WAIT_V
#undef PG8_WAIT_L
#undef PG8_BAR
#undef PG8_SCHED
}

struct MUnit { int r0, rend, e, pn; };
#define MG_LANE_OFFS(u, o) do { const int _t = wid * 64 + fresh_lane(); _Pragma("unroll") for (int _i = 0; _i < 2; ++_i) { int _R, _C; stage_rc(_t * 16 + _i * 8192, _R, _C); _Pragma("unroll") for (int _h = 0; _h < 2; ++_h) { const int _r = (u).r0 + _h * HALF + _R; \
        int _row = _r; if (GATHER) { _row = 0; if (_r < (u).rend) _row = slot_tok[_r]; } (o)[_h][_i] = (unsigned)(_row * K + _C) * 2u; } } } while (0)
template <class Epi, class Sched, bool GATHER, int N, int K>
__device__ __forceinline__ void gemm_phase_moe(PG8_LAS unsigned char* lds, const bf16_t* A, const bf16_t* Bt, const int* slot_tok, const Sched& S, const Epi& E, int wave_id) {
    asm volatile("" : "+s"(wave_id));
    const int lane = fresh_lane(), wid = wave_id, tid = wid * 64 + lane, wr = wid >> 2, wc = wid & 3, fr = lane & 15, fq = lane >> 4;
    constexpr int nt = K / BK;
#define MG_OFFP(par) ((PG8_LAS unsigned*)(lds + STAGE_BYTES + 8192) + (par) * 2048 + tid)
#define MG_VOFFB ((PG8_LAS unsigned*)(lds + STAGE_BYTES + 24576) + tid)
#pragma unroll
    for (int i = 0; i < 2; ++i) { int R, C; stage_rc(tid * 16 + i * 8192, R, C); const int Rb = Epi::PERM ? ((R & ~31) + perm32(R & 31)) : R; MG_VOFFB[i * 512] = (unsigned)(Rb * K + C) * 2u; }
    constexpr size_t kstep = (size_t)(BK * 2);
    constexpr size_t hstep = (size_t)HALF * K * 2;
    constexpr size_t tstep = 2 * hstep;
    constexpr size_t estep = (size_t)N * K * 2;
    const unsigned ldsw = (unsigned)wid * 1024u;
    const int aoff = lds_byte(wr * 64 + fr, fq * 8), boff = lds_byte(wc * 32 + fr, fq * 8);
#define PG8_SA(b, h) (((b) * 2 + (h)) * HTB)
#define PG8_SB(b, h) ((4 + (b) * 2 + (h)) * HTB)
#define PG8_STAGE(bufoff, gbase, voff) do { _Pragma("unroll") for (int _i = 0; _i < 2; ++_i) \
        __builtin_amdgcn_global_load_lds((const unsigned*)((const char*)(gbase) + MG_VOFFB[_i * 512]), (PG8_LAS unsigned*)(lds + (bufoff) + ldsw + _i * 8192), 16, 0, 0); } while (0)
#define MG_STAGE_A(bufoff, par, h, kb) do { _Pragma("unroll") for (int _i = 0; _i < 2; ++_i) \
        __builtin_amdgcn_global_load_lds((const unsigned*)((const char*)A + (size_t)MG_OFFP(par)[((h) * 2 + _i) * 512] + (kb)), (PG8_LAS unsigned*)(lds + (bufoff) + ldsw + _i * 8192), 16, 0, 0); } while (0)
#define PG8_LDA(dst, b, h) do { _Pragma("unroll") for (int m = 0; m < 4; ++m) _Pragma("unroll") for (int k = 0; k < 2; ++k) dst[m][k] = *(const PG8_LAS bf16x8*)(lds + PG8_SA(b, h) + aoff + m * 2048 + k * 1024); } while (0)
#define PG8_LDB(dst, b, h) do { _Pragma("unroll") for (int n = 0; n < 2; ++n) _Pragma("unroll") for (int k = 0; k < 2; ++k) dst[n][k] = *(const PG8_LAS bf16x8*)(lds + PG8_SB(b, h) + boff + n * 2048 + k * 1024); } while (0)
#define PG8_MMA(ai, bj, At, Bt_) do { __builtin_amdgcn_s_setprio(1); _Pragma("unroll") for (int m = 0; m < 4; ++m) _Pragma("unroll") for (int n = 0; n < 2; ++n) _Pragma("unroll") for (int k = 0; k < 2; ++k) \
        acc[ai][bj][m][n] = __builtin_amdgcn_mfma_f32_16x16x32_bf16(Bt_[n][k], At[m][k], acc[ai][bj][m][n], 0, 0, 0); __builtin_amdgcn_s_setprio(0); } while (0)
#define PG8_WAIT_V(n) asm volatile("s_waitcnt vmcnt(" #n ")" ::: "memory")
#define PG8_WAIT_L(n) asm volatile("s_waitcnt lgkmcnt(" #n ")" ::: "memory")
#define PG8_BAR __builtin_amdgcn_s_barrier()
#define PG8_SCHED __builtin_amdgcn_sched_barrier(0)
    MUnit cur, nxt; int ui = 0;
    if (!S.next(0, cur)) return;
    f32x4 acc[2][2][4][2];
#pragma unroll
    for (int a = 0; a < 2; ++a)
#pragma unroll
        for (int b = 0; b < 2; ++b)
#pragma unroll
            for (int m = 0; m < 4; ++m)
#pragma unroll
                for (int n = 0; n < 2; ++n) acc[a][b][m][n] = (f32x4){0.f, 0.f, 0.f, 0.f};
    bf16x8 At[4][2], B0[2][2], B1[2][2];
    { unsigned o_[2][2]; MG_LANE_OFFS(cur, o_); PG8_LAS unsigned* p_ = MG_OFFP(0); p_[0] = o_[0][0]; p_[512] = o_[0][1]; p_[1024] = o_[1][0]; p_[1536] = o_[1][1]; }
    const char* cB = (const char*)Bt + (size_t)cur.e * estep + (size_t)cur.pn * tstep;
    PG8_STAGE(PG8_SB(0, 0), cB, voffB); PG8_STAGE(PG8_SB(0, 1), cB + hstep, voffB); MG_STAGE_A(PG8_SA(0, 0), 0, 0, 0); MG_STAGE_A(PG8_SA(0, 1), 0, 1, 0);
    if (wr == 1) PG8_BAR;
    PG8_WAIT_V(2); PG8_BAR;
    PG8_STAGE(PG8_SB(1, 0), cB + kstep, voffB); MG_STAGE_A(PG8_SA(1, 0), 0, 0, kstep); PG8_STAGE(PG8_SB(1, 1), cB + hstep + kstep, voffB);
    PG8_WAIT_V(6); PG8_BAR;
    for (;;) {
        const bool has_next = S.next(ui + 1, nxt);
        const char* nB = cB;
        const int pc = ui & 1, pn_ = has_next ? (pc ^ 1) : pc;
        if (has_next) { unsigned on[2][2]; MG_LANE_OFFS(nxt, on); nB = (const char*)Bt + (size_t)nxt.e * estep + (size_t)nxt.pn * tstep;
            PG8_LAS unsigned* p_ = MG_OFFP(pn_); p_[0] = on[0][0]; p_[512] = on[0][1]; p_[1024] = on[1][0]; p_[1536] = on[1][1]; }
        for (int t = 0; t < nt; t += 2) {
            const bool last = (t == nt - 2);
            const size_t k1 = (size_t)(t + 1) * kstep, k2 = last ? (size_t)0 : (size_t)(t + 2) * kstep, k3 = k2 + kstep;
            const char* b2 = last ? nB : cB + (size_t)(t + 2) * kstep; const char* b3 = b2 + kstep;
            const int p2 = last ? pn_ : pc;
            PG8_LDB(B0, 0, 0); PG8_LDB(B1, 0, 1); PG8_SCHED; PG8_LDA(At, 0, 0); MG_STAGE_A(PG8_SA(1, 1), pc, 1, k1);
            PG8_WAIT_V(8); PG8_WAIT_L(0); PG8_BAR; PG8_MMA(0, 0, At, B0); PG8_MMA(0, 1, At, B1); PG8_BAR; PG8_SCHED;
            PG8_LDA(At, 0, 1); PG8_STAGE(PG8_SB(0, 0), b2, voffB); PG8_STAGE(PG8_SB(0, 1), b2 + hstep, voffB); MG_STAGE_A(PG8_SA(0, 0), p2, 0, k2);
            PG8_WAIT_V(8); PG8_WAIT_L(0); PG8_BAR; PG8_MMA(1, 0, At, B0); PG8_MMA(1, 1, At, B1); PG8_BAR; PG8_SCHED;
            PG8_LDB(B0, 1, 0); PG8_LDB(B1, 1, 1); PG8_SCHED; PG8_LDA(At, 1, 0); MG_STAGE_A(PG8_SA(0, 1), p2, 1, k2);
            PG8_WAIT_V(8); PG8_WAIT_L(0); PG8_BAR; PG8_MMA(0, 0, At, B0); PG8_MMA(0, 1, At, B1); PG8_BAR; PG8_SCHED;
            PG8_LDA(At, 1, 1); PG8_STAGE(PG8_SB(1, 0), b3, voffB); PG8_STAGE(PG8_SB(1, 1), b3 + hstep, voffB); MG_STAGE_A(PG8_SA(1, 0), p2, 0, k3);
            PG8_WAIT_V(8); PG8_WAIT_L(0); PG8_BAR; PG8_MMA(1, 0, At, B0); PG8_MMA(1, 1, At, B1); PG8_BAR; PG8_SCHED;
        }
        if (wr == 0) PG8_BAR;
        E(acc, cur, wr, wc, fr, fq);
        if (!has_next) break;
#pragma unroll
        for (int a = 0; a < 2; ++a)
#pragma unroll
            for (int b = 0; b < 2; ++b)
#pragma unroll
                for (int m = 0; m < 4; ++m)
#pragma unroll
                    for (int n = 0; n < 2; ++n) acc[a][b][m][n] = (f32x4){0.f, 0.f, 0.f, 0.f};
        cur = nxt; cB = nB; ++ui;
        if (wr == 1) PG8_BAR;
    }
    PG8_WAIT_V(0);
    PG8_BAR;
#undef PG8_SA
#undef PG8_SB
#undef PG8_STAGE
#undef MG_STAGE_A
#undef MG_OFFP
#undef MG_VOFFB
#undef PG8_LDA
#undef PG8_LDB
#undef PG8_MMA
#undef PG8_WAIT_V
#undef PG8_WAIT_L
#undef PG8_BAR
#undef PG8_SCHED
}
__device__ __forceinline__ float fast_silu(float x) { return x * __builtin_amdgcn_rcpf(1.0f + __builtin_amdgcn_exp2f(-1.4426950408889634f * x)); }
struct EpiMoeH {
    static constexpr bool PERM = true;
    bf16_t* H;
    __device__ __forceinline__ void operator()(const f32x4 (&acc)[2][2][4][2], const MUnit& u, int wr, int wc, int fr, int fq) const {
        { const int t_ = fresh_lane(); fr = t_ & 15; fq = t_ >> 4; }
        const int col0 = u.pn * 128 + wc * 32 + 8 * fq;
#pragma unroll
        for (int ai = 0; ai < 2; ++ai)
#pragma unroll
            for (int m = 0; m < 4; ++m) { const int r = u.r0 + ai * HALF + wr * 64 + m * 16 + fr;
                const f32x4 g0 = acc[ai][0][m][0], g1 = acc[ai][0][m][1], u0 = acc[ai][1][m][0], u1 = acc[ai][1][m][1];
                u32x4 w; w.x = cvt_pk_bf16(fast_silu(g0[0]) * u0[0], fast_silu(g0[1]) * u0[1]); w.y = cvt_pk_bf16(fast_silu(g0[2]) * u0[2], fast_silu(g0[3]) * u0[3]);
                w.z = cvt_pk_bf16(fast_silu(g1[0]) * u1[0], fast_silu(g1[1]) * u1[1]); w.w = cvt_pk_bf16(fast_silu(g1[2]) * u1[2], fast_silu(g1[3]) * u1[3]);
                if (r < u.rend) *(u32x4*)(H + (size_t)r * 256 + col0) = w; }
    }
};
struct EpiMoeY {
    static constexpr bool PERM = true;
    bf16_t* Y;
    __device__ __forceinline__ void operator()(const f32x4 (&acc)[2][2][4][2], const MUnit& u, int wr, int wc, int fr, int fq) const {
        { const int t_ = fresh_lane(); fr = t_ & 15; fq = t_ >> 4; }
        const int col0 = u.pn * BM + wc * 32 + 8 * fq;
#pragma unroll
        for (int ai = 0; ai < 2; ++ai)
#pragma unroll
            for (int m = 0; m < 4; ++m) { const int r = u.r0 + ai * HALF + wr * 64 + m * 16 + fr;
#pragma unroll
                for (int bj = 0; bj < 2; ++bj) { const f32x4 v0 = acc[ai][bj][m][0], v1 = acc[ai][bj][m][1];
                    u32x4 w; w.x = cvt_pk_bf16(v0[0], v0[1]); w.y = cvt_pk_bf16(v0[2], v0[3]); w.z = cvt_pk_bf16(v1[0], v1[1]); w.w = cvt_pk_bf16(v1[2], v1[3]);
                    if (r < u.rend) *(u32x4*)(Y + (size_t)r * 1024 + col0 + bj * HALF) = w; } }
    }
};
struct MoeSched {
    const PG8_LAS int* tab;
    int npn, G, c;
    __device__ __forceinline__ bool next(int i, MUnit& u) const {
        const int L = i * G + c, ntile = tab[0];
        if (L >= ntile * npn) return false;
        const int j = L / npn; u.pn = L % npn;
        u.e = __builtin_amdgcn_readfirstlane(tab[4 + 4 * j]); u.r0 = __builtin_amdgcn_readfirstlane(tab[5 + 4 * j]); u.rend = __builtin_amdgcn_readfirstlane(tab[6 + 4 * j]);
        return true;
    }
};
}

#ifndef PG8_SP2
#define PG8_SP2 true
#endif
#ifndef PG8_ALIGN
#define PG8_ALIGN true
#endif

constexpr int NWAVES = 8, NT = NWAVES * 64;
constexpr int D = 1024, NB = 2, S = 8192, T = NB * S, DEPTH = 2;
constexpr int DIN = 2832, PLD = 3072;
constexpr int C_Q = 0, C_K = 256, C_V = 512, C_G = 1024, C_GK = 1536, C_U = 1552, C_VG = 1808, C_XI = 2064, C_BG = 2320, C_CG = 2576;
constexpr int GH = 4, GC = 64, GN = S / GC;
constexpr int MH = 4, MC = 128, MN = S / MC;
constexpr int NE = 32, DE = 256;
constexpr float EPS = 1e-6f;
constexpr size_t MiB = 1u << 20;
constexpr size_t WS_CTL = 0, CTL_BYTES = 1 * MiB;
constexpr size_t WS_WIN = 1 * MiB;
constexpr size_t WS_WOUT = 13 * MiB;
constexpr size_t WS_WGU = 17 * MiB;
constexpr size_t WS_WD = 81 * MiB;
constexpr size_t WS_XN = 113 * MiB;
constexpr size_t WS_P = 145 * MiB;
constexpr size_t WS_Y = WS_P + 17 * MiB;
constexpr size_t WS_S = 241 * MiB;
constexpr size_t WS_DEC = 273 * MiB;
constexpr size_t WS_MISC = 274 * MiB;
constexpr size_t WS_WSP = WS_MISC + 524288;
constexpr size_t WS_WR = 275 * MiB;
constexpr size_t WS_BLKCNT = WS_WR + 524288;
constexpr size_t WS_END = 276 * MiB;
constexpr int CW_BAR = 4096, CW_CNT = 16384;
constexpr int RING_BYTES = 131072, LDSCTL_OFF = RING_BYTES, MISC_OFF = LDSCTL_OFF + 320, LDS_BYTES = 163840;

#define GAS __attribute__((address_space(1)))
#define LAS __attribute__((address_space(3)))
typedef unsigned short bf16;
typedef unsigned v4u __attribute__((ext_vector_type(4)));
typedef unsigned v2u __attribute__((ext_vector_type(2)));
typedef float f32x4 __attribute__((ext_vector_type(4)));
__device__ __forceinline__ unsigned f2bf(float f) { unsigned u = __builtin_bit_cast(unsigned, f); return (u + 0x7fffu + ((u >> 16) & 1u)) >> 16; }
__device__ __forceinline__ unsigned pk2(float lo, float hi) { return f2bf(lo) | (f2bf(hi) << 16); }
__device__ __forceinline__ float bf2f(unsigned v) { return __uint_as_float(v << 16); }
__device__ __forceinline__ float bflo(unsigned w) { return __uint_as_float(w << 16); }
__device__ __forceinline__ float bfhi(unsigned w) { return __uint_as_float(w & 0xffff0000u); }
__device__ __forceinline__ void unpack8(const v4u q, float (&f)[8]) { f[0] = bflo(q.x); f[1] = bfhi(q.x); f[2] = bflo(q.y); f[3] = bfhi(q.y); f[4] = bflo(q.z); f[5] = bfhi(q.z); f[6] = bflo(q.w); f[7] = bfhi(q.w); }
__device__ __forceinline__ float gelu_tanh(float x) { const float u = 0.7978845608028654f * (x + 0.044715f * x * x * x); return 0.5f * x * (1.0f + tanhf(u)); }
__device__ __forceinline__ float silu(float x) { return x / (1.0f + expf(-x)); }
__device__ __forceinline__ float log_sigmoid(float x) { return fminf(x, 0.f) - log1pf(expf(-fabsf(x))); }

#define XB_TMO      128
#define XB_XCNT(j)  (256  + 64 * (j))
#define XB_XSUB(j)  (1280 + 64 * (j))
#define XB_XGEN(j)  (2304 + 64 * (j))
#define XB_TOP      3328
#define XB_TOPGEN   3392
#define XCD_BAR_WORDS 3456
#define XB_SPIN_CAP (1u << 18)

__device__ __forceinline__ unsigned xb_ld(unsigned* p)              { return __hip_atomic_load(p, __ATOMIC_RELAXED, __HIP_MEMORY_SCOPE_AGENT); }
__device__ __forceinline__ unsigned xb_add(unsigned* p, unsigned v) { return __hip_atomic_fetch_add(p, v, __ATOMIC_RELAXED, __HIP_MEMORY_SCOPE_AGENT); }
__device__ __forceinline__ unsigned xb_xcc_id() { return (unsigned)__builtin_amdgcn_s_getreg((3 << 11) | 20) & 0xFu; }
#define XB_SPIN(cond, bar) do { unsigned _sp = 0; while (cond) { __builtin_amdgcn_s_sleep(1); \
    if ((++_sp & 255u) == 0u) { if (xb_ld(&(bar)[XB_TMO])) break; if (_sp > XB_SPIN_CAP) { atomicAdd(&(bar)[XB_TMO], 1u); break; } } } } while (0)

struct XcdBarrier {
    int wave;
    unsigned* bar; unsigned x;
    volatile LAS unsigned* st;
};

__device__ __forceinline__ XcdBarrier xcd_barrier_post(unsigned* bar, volatile LAS unsigned* st) {
    XcdBarrier b; b.bar = bar; b.x = xb_xcc_id(); b.st = st; b.wave = __builtin_amdgcn_readfirstlane(threadIdx.x >> 6);
    if (threadIdx.x == 0) (void)xb_add(&bar[XB_XCNT(b.x)], 1u);
    return b;
}
__device__ __forceinline__ void xcd_barrier_complete(unsigned* bar, unsigned x, unsigned& nloc, unsigned& nx) {
    const unsigned G = gridDim.x * gridDim.y * gridDim.z;
    unsigned sum, cnt, mine, sp = 0u;
    for (;;) {
        sum = 0u; cnt = 0u; mine = 0u;
#pragma unroll
        for (unsigned j = 0; j < 16; ++j) { const unsigned c = xb_ld(&bar[XB_XCNT(j)]); sum += c; cnt += (c > 0u) ? 1u : 0u; mine = (j == x) ? c : mine; }
        if (sum == G) break;
        __builtin_amdgcn_s_sleep(1);
        if ((++sp & 255u) == 0u) { if (xb_ld(&bar[XB_TMO])) break; if (sp > XB_SPIN_CAP) { atomicAdd(&bar[XB_TMO], 1u); break; } }
    }
    nloc = mine > 0u ? mine : 1u; nx = cnt > 0u ? cnt : 1u;
}

__device__ __forceinline__ void xcd_barrier(const XcdBarrier& b) {
    asm volatile("s_waitcnt vmcnt(0)" ::: "memory");
    __syncthreads();
    if (b.wave == 0 && fresh_lane() == 0) {
        unsigned* bar = b.bar; asm volatile("" : "+s"(bar));
        __builtin_amdgcn_s_waitcnt(0);
        unsigned nloc = b.st[0], nx = b.st[1];
        if (nloc == 0u) { xcd_barrier_complete(bar, b.x, nloc, nx); b.st[0] = nloc; b.st[1] = nx; }
        const unsigned old = xb_add(&bar[XB_XSUB(b.x)], 1u);
        const unsigned gen = old / nloc;
        if (old + 1u == (gen + 1u) * nloc) {
            __builtin_amdgcn_fence(__ATOMIC_RELEASE, "agent");
            asm volatile("s_waitcnt vmcnt(0)" ::: "memory");
            const unsigned og = xb_add(&bar[XB_TOP], 1u);
            const unsigned tg = og / nx;
            if (og + 1u == (tg + 1u) * nx) xb_add(&bar[XB_TOPGEN], 1u);
            else XB_SPIN(xb_ld(&bar[XB_TOPGEN]) == tg, bar);
            __builtin_amdgcn_fence(__ATOMIC_ACQUIRE, "agent");
            xb_add(&bar[XB_XGEN(b.x)], 1u);
            asm volatile("s_waitcnt vmcnt(0)" ::: "memory");
        } else {
            XB_SPIN(xb_ld(&bar[XB_XGEN(b.x)]) == gen, bar);
            __builtin_amdgcn_fence(__ATOMIC_ACQUIRE, "agent");
            asm volatile("s_waitcnt vmcnt(0)" ::: "memory");
        }
    }
    __syncthreads();
}

#define AS4 __attribute__((address_space(4)))
struct KA {
    const AS4 char* ka;
    static __device__ __forceinline__ KA fresh() { KA k; k.ka = (const AS4 char*)__builtin_amdgcn_kernarg_segment_ptr(); asm volatile("" : "+s"(k.ka)); return k; }
    __device__ __forceinline__ const float* in(int i) const { return *(const float* const AS4*)(ka + 8 * i); }
    __device__ __forceinline__ float* out() const { return *(float* const AS4*)(ka + 160); }
    __device__ __forceinline__ unsigned char* ws() const { return *(unsigned char* const AS4*)(ka + 168); }
    __device__ __forceinline__ unsigned* ctl() const { return (unsigned*)(ws() + WS_CTL); }
    __device__ __forceinline__ bf16* WinT() const { return (bf16*)(ws() + WS_WIN); }
    __device__ __forceinline__ bf16* WoutT() const { return (bf16*)(ws() + WS_WOUT); }
    __device__ __forceinline__ bf16* WguT() const { return (bf16*)(ws() + WS_WGU); }
    __device__ __forceinline__ bf16* WdT() const { return (bf16*)(ws() + WS_WD); }
    __device__ __forceinline__ bf16* XN() const { return (bf16*)(ws() + WS_XN); }
    __device__ __forceinline__ bf16* P() const { return (bf16*)(ws() + WS_P); }
    __device__ __forceinline__ bf16* H1() const { return (bf16*)(ws() + WS_P); }
    __device__ __forceinline__ bf16* Y() const { return (bf16*)(ws() + WS_Y); }
    __device__ __forceinline__ float* Sst() const { return (float*)(ws() + WS_S); }
    __device__ __forceinline__ float* dec() const { return (float*)(ws() + WS_DEC); }
    __device__ __forceinline__ int* eid() const { return (int*)(ws() + WS_MISC); }
    __device__ __forceinline__ float* ew() const { return (float*)(ws() + WS_MISC + 131072); }
    __device__ __forceinline__ int* slot_tok() const { return (int*)(ws() + WS_MISC + 2 * 131072); }
    __device__ __forceinline__ int* slot_of() const { return (int*)(ws() + WS_MISC + 3 * 131072); }
    __device__ __forceinline__ bf16* Wsp() const { return (bf16*)(ws() + WS_WSP); }
    __device__ __forceinline__ bf16* Wr() const { return (bf16*)(ws() + WS_WR); }
    __device__ __forceinline__ int* blkcnt() const { return (int*)(ws() + WS_BLKCNT); }
};
struct Frame {
    LAS unsigned char* lds; float* smem;
    int G, bx, wave;
};
#define PHASE_TID const int lane = fresh_lane(), wave = F.wave, tid = wave * 64 + lane; (void)lane; (void)wave; (void)tid

__device__ __forceinline__ float wave_sum(float v) {
    const int ln = fresh_lane();
#pragma unroll
    for (int o = 1; o < 64; o <<= 1) v += __int_as_float(__builtin_amdgcn_ds_bpermute((ln ^ o) << 2, __float_as_int(v)));
    return v;
}

__device__ __forceinline__ void transpose_item(const float* W, int ldw, int nvalid, int k0, int n0, bf16* WT, int ldt, int drow0, LAS float* scr, int lane) {
    const int nl = lane & 31;
#pragma unroll 8
    for (int i = 0; i < 32; ++i) { const int kk = 2 * i + (lane >> 5); scr[kk * 33 + nl] = (nl < nvalid) ? W[(size_t)(k0 + kk) * ldw + n0 + nl] : 0.f; }
    asm volatile("s_waitcnt lgkmcnt(0)" ::: "memory");
    const int c = lane & 7;
#pragma unroll
    for (int j = 0; j < 4; ++j) { const int n = (lane >> 3) + 8 * j; const LAS float* s = scr + (8 * c) * 33 + n;
        v4u o; o.x = pk2(s[0 * 33], s[1 * 33]); o.y = pk2(s[2 * 33], s[3 * 33]); o.z = pk2(s[4 * 33], s[5 * 33]); o.w = pk2(s[6 * 33], s[7 * 33]);
        if (n < nvalid) *(GAS v4u*)(WT + (size_t)(drow0 + n) * ldt + k0 + 8 * c) = o; }
    asm volatile("s_waitcnt lgkmcnt(0)" ::: "memory");
}
__device__ __forceinline__ void rms_row_to_bf16(const float* xrow, const float* gain, bf16* orow, int lane) {
    const f32x4* xr = (const f32x4*)xrow + lane;
    f32x4 v[4]; float s = 0.f;
#pragma unroll
    for (int j = 0; j < 4; ++j) { v[j] = xr[64 * j]; s += (v[j].x * v[j].x + v[j].y * v[j].y) + (v[j].z * v[j].z + v[j].w * v[j].w); }
    const float rs = rsqrtf(wave_sum(s) * (1.f / D) + EPS);
    v2u* o8 = (v2u*)orow + lane;
#pragma unroll
    for (int j = 0; j < 4; ++j) { const f32x4 g = ((const f32x4*)gain)[lane + 64 * j]; v2u w; w.x = pk2(v[j].x * rs * g.x, v[j].y * rs * g.y); w.y = pk2(v[j].z * rs * g.z, v[j].w * rs * g.w); o8[64 * j] = w; }
}
__device__ __forceinline__ void p0_prologue(Frame& F) {
    const KA K = KA::fresh(); PHASE_TID;
    LAS float* scr = (LAS float*)(F.lds + wave * 16384);
    const int gw = F.bx * NWAVES + wave, NGW = F.G * NWAVES;
    constexpr int I_IN = 16 * 89, I_OUT = 16 * 32, I_G = 32 * 16 * 8, I_D = 32 * 4 * 32, I_L = I_IN + I_OUT + 2 * I_G + I_D;
    for (int it = gw; it < DEPTH * I_L; it += NGW) {
        const int l = it / I_L; int r = it % I_L;
        if (r < I_IN) { const int kb = r / 89, nb = r % 89; const int nv = (nb == 88) ? 16 : 32;
            transpose_item(K.in(2) + (size_t)l * D * DIN, DIN, nv, kb * 64, nb * 32, K.WinT() + (size_t)l * PLD * D, D, nb * 32, scr, lane); continue; }
        r -= I_IN;
        if (r < I_OUT) { const int kb = r / 32, nb = r % 32;
            transpose_item(K.in(10) + (size_t)l * D * D, D, 32, kb * 64, nb * 32, K.WoutT() + (size_t)l * D * D, D, nb * 32, scr, lane); continue; }
        r -= I_OUT;
        if (r < 2 * I_G) { const int sel = r / I_G; r %= I_G; const int e = r / 128, kb = (r % 128) / 8, nb = r % 8; const int n0 = nb * 32;
            const float* W = K.in(16 + sel) + ((size_t)l * NE + e) * D * DE;
            transpose_item(W, DE, 32, kb * 64, n0, K.WguT() + ((size_t)l * NE + e) * 512 * D, D, (n0 >> 7) * 256 + sel * 128 + (n0 & 127), scr, lane); continue; }
        r -= 2 * I_G;
        { const int e = r / 128, kb = (r % 128) / 32, nb = r % 32;
            transpose_item(K.in(18) + ((size_t)l * NE + e) * DE * D, D, 32, kb * 64, nb * 32, K.WdT() + ((size_t)l * NE + e) * D * DE, DE, nb * 32, scr, lane); }
    }
    for (int i = F.bx * NT + tid; i < DEPTH * 240 * 128; i += F.G * NT) { const int l = i / (240 * 128), rr = (i / 128) % 240, c = i % 128;
        *(GAS v4u*)(K.WinT() + ((size_t)l * PLD + DIN + rr) * D + c * 8) = (v4u){0u, 0u, 0u, 0u}; }
    for (int i = F.bx * NT + tid; i < DEPTH * 48 * D; i += F.G * NT) { const int ll = i / (48 * D), n = (i / D) % 48, k = i % D;
        float w = 0.f;
        if (n < 4) w = K.in(12)[((size_t)ll * D + k) * 4 + n]; else if (n < 36) w = K.in(14)[((size_t)ll * D + k) * 32 + (n - 4)];
        w *= K.in(11)[(size_t)ll * D + k];
        const unsigned hi = f2bf(w), lo = f2bf(w - bf2f(hi));
        K.Wr()[((size_t)ll * 2 + 0) * 48 * D + (size_t)n * D + k] = (bf16)hi; K.Wr()[((size_t)ll * 2 + 1) * 48 * D + (size_t)n * D + k] = (bf16)lo; }
    for (int i = F.bx * NT + tid; i < DEPTH * MH * 128 * 128 / 8; i += F.G * NT) { const int e0 = i * 8, s0 = e0 & 127, t = (e0 >> 7) & 127;
        const f32x4 a = *(const f32x4*)(K.in(7) + e0), c = *(const f32x4*)(K.in(7) + e0 + 4);
        const float v[8] = {a.x, a.y, a.z, a.w, c.x, c.y, c.z, c.w}; unsigned w[4];
#pragma unroll
        for (int j = 0; j < 4; ++j) w[j] = pk2((s0 + 2 * j <= t) ? v[2 * j] : 0.f, (s0 + 2 * j + 1 <= t) ? v[2 * j + 1] : 0.f);
        *(GAS v4u*)(K.Wsp() + e0) = (v4u){w[0], w[1], w[2], w[3]}; }
    for (int m = gw; m < T; m += NGW) rms_row_to_bf16(K.in(0) + (size_t)m * D, K.in(1), K.XN() + (size_t)m * D, lane);
}

__device__ __forceinline__ void gla_cumdecay(Frame& F, const KA& K, int tid, int l, int h, int t0, float* bb) {
    const float* wup = K.in(3) + (size_t)l * 16 * 256; const float* bgk = K.in(4) + (size_t)l * 256;
    for (int e = tid; e < 64 * 64; e += NT) {
        const int c = e >> 6, d = e & 63;
        const bf16* gl = K.P() + (size_t)(t0 + c) * PLD + C_GK;
        float a = bgk[h * 64 + d];
#pragma unroll
        for (int r = 0; r < 16; ++r) a += bf2f(gl[r]) * wup[r * 256 + h * 64 + d];
        bb[c * 64 + d] = log_sigmoid(a) * (1.0f / 16.0f);
    }
    __syncthreads();
    if (tid < 64) { float run = 0.f; for (int c = 0; c < 64; ++c) { run += bb[c * 64 + tid]; bb[c * 64 + tid] = run; } }
    __syncthreads();
}
__device__ __forceinline__ void phase_gla_kv(Frame& F, int l) {
    const KA K = KA::fresh(); PHASE_TID;
    float* bb = F.smem; float* kd = F.smem + 4096;
#pragma unroll 1
    for (int ci = F.bx; ci < NB * GH * GN; ci += F.G) {
        const int b = ci / (GH * GN), h = (ci / GN) % GH, n = ci % GN, t0 = b * S + n * GC;
        __syncthreads();
        gla_cumdecay(F, K, tid, l, h, t0, bb);
        for (int e = tid; e < 4096; e += NT) { const int c = e >> 6, d = e & 63; kd[e] = bf2f(K.P()[(size_t)(t0 + c) * PLD + C_K + h * 64 + d]) * expf(bb[63 * 64 + d] - bb[e]); }
        __syncthreads();
        const int d = tid >> 3, v0 = (tid & 7) * 16;
        float acc[16];
#pragma unroll
        for (int j = 0; j < 16; ++j) acc[j] = 0.f;
#pragma unroll 2
        for (int c = 0; c < 64; ++c) {
            const float kk = kd[c * 64 + d];
            const v4u* vr = (const v4u*)(K.P() + (size_t)(t0 + c) * PLD + C_V + h * 128 + v0);
            float f[8]; unpack8(vr[0], f);
#pragma unroll
            for (int j = 0; j < 8; ++j) acc[j] += kk * f[j];
            unpack8(vr[1], f);
#pragma unroll
            for (int j = 0; j < 8; ++j) acc[8 + j] += kk * f[j];
        }
        f32x4* o = (f32x4*)(K.Sst() + ((size_t)ci * 64 + d) * 128 + v0);
#pragma unroll
        for (int j = 0; j < 4; ++j) o[j] = (f32x4){acc[4 * j], acc[4 * j + 1], acc[4 * j + 2], acc[4 * j + 3]};
        if (tid < 64) K.dec()[(size_t)ci * 64 + tid] = expf(bb[63 * 64 + tid]);
    }
}
__device__ __forceinline__ void phase_gla_scan(Frame& F) {
    const KA K = KA::fresh(); PHASE_TID;
#pragma unroll 1
    for (int e = F.bx * NT + tid; e < NB * GH * 64 * 128; e += F.G * NT) {
        const int bh = e >> 13, d = (e >> 7) & 63, v = e & 127;
        float* base = K.Sst() + ((size_t)bh * GN * 64 + d) * 128 + v; const float* db = K.dec() + (size_t)bh * GN * 64 + d;
        float st = 0.f;
#pragma unroll 1
        for (int n0 = 0; n0 < GN; n0 += 16) {
            float kvv[16], dd[16];
#pragma unroll
            for (int j = 0; j < 16; ++j) { kvv[j] = base[(size_t)(n0 + j) * 8192]; dd[j] = db[(n0 + j) * 64]; }
#pragma unroll
            for (int j = 0; j < 16; ++j) { base[(size_t)(n0 + j) * 8192] = st; st = dd[j] * st + kvv[j]; }
        }
    }
}
__device__ __forceinline__ void phase_gla_out(Frame& F, int l) {
    const KA K = KA::fresh(); PHASE_TID;
    float* bb = F.smem; float* qd = F.smem + 4096; float* ki = F.smem + 4096 + 64 * 65; float* sc = bb;
    const float* gnorm = K.in(5) + (size_t)l * 128;
#pragma unroll 1
    for (int ci = F.bx; ci < NB * GH * GN; ci += F.G) {
        const int b = ci / (GH * GN), h = (ci / GN) % GH, n = ci % GN, t0 = b * S + n * GC;
        __syncthreads();
        gla_cumdecay(F, K, tid, l, h, t0, bb);
        for (int e = tid; e < 4096; e += NT) {
            const int c = e >> 6, d = e & 63; const float bv = bb[e];
            const bf16* row = K.P() + (size_t)(t0 + c) * PLD;
            qd[c * 65 + d] = bf2f(row[C_Q + h * 64 + d]) * 0.125f * expf(bv);
            ki[c * 65 + d] = bf2f(row[C_K + h * 64 + d]) * expf(-bv);
        }
        __syncthreads();
        {
            const int c = tid >> 3, s0 = (tid & 7) * 8;
            float a[8];
#pragma unroll
            for (int j = 0; j < 8; ++j) a[j] = 0.f;
#pragma unroll 4
            for (int d = 0; d < 64; ++d) { const float qv = qd[c * 65 + d];
#pragma unroll
                for (int j = 0; j < 8; ++j) a[j] += qv * ki[(s0 + j) * 65 + d]; }
#pragma unroll
            for (int j = 0; j < 8; ++j) sc[c * 64 + s0 + j] = (s0 + j <= c) ? a[j] : 0.f;
        }
        __syncthreads();
        const int c = tid >> 3, v0 = (tid & 7) * 16;
        float acc[16];
#pragma unroll
        for (int j = 0; j < 16; ++j) acc[j] = 0.f;
#pragma unroll 2
        for (int s = 0; s <= c; ++s) {
            const float w = sc[c * 64 + s];
            const v4u* vr = (const v4u*)(K.P() + (size_t)(t0 + s) * PLD + C_V + h * 128 + v0);
            float f[8]; unpack8(vr[0], f);
#pragma unroll
            for (int j = 0; j < 8; ++j) acc[j] += w * f[j];
            unpack8(vr[1], f);
#pragma unroll
            for (int j = 0; j < 8; ++j) acc[8 + j] += w * f[j];
        }
#pragma unroll 2
        for (int d = 0; d < 64; ++d) {
            const float w = qd[c * 65 + d];
            const f32x4* sr = (const f32x4*)(K.Sst() + ((size_t)ci * 64 + d) * 128 + v0);
#pragma unroll
            for (int j = 0; j < 4; ++j) { const f32x4 v4 = sr[j]; acc[4 * j] += w * v4.x; acc[4 * j + 1] += w * v4.y; acc[4 * j + 2] += w * v4.z; acc[4 * j + 3] += w * v4.w; }
        }
        float ss = 0.f;
#pragma unroll
        for (int j = 0; j < 16; ++j) ss += acc[j] * acc[j];
        ss += shx(ss, 1); ss += shx(ss, 2); ss += shx(ss, 4);
        const float rs = rsqrtf(ss * (1.0f / 128.0f) + EPS);
        const v4u* gr = (const v4u*)(K.P() + (size_t)(t0 + c) * PLD + C_G + h * 128 + v0);
        float g0[8], g1[8]; unpack8(gr[0], g0); unpack8(gr[1], g1);
        float o[16];
#pragma unroll
        for (int j = 0; j < 8; ++j) { o[j] = acc[j] * rs * gnorm[v0 + j] * silu(g0[j]); o[8 + j] = acc[8 + j] * rs * gnorm[v0 + 8 + j] * silu(g1[j]); }
        v4u* op = (v4u*)(K.XN() + (size_t)(t0 + c) * D + h * 128 + v0);
        op[0] = (v4u){pk2(o[0], o[1]), pk2(o[2], o[3]), pk2(o[4], o[5]), pk2(o[6], o[7])};
        op[1] = (v4u){pk2(o[8], o[9]), pk2(o[10], o[11]), pk2(o[12], o[13]), pk2(o[14], o[15])};
    }
}
__device__ __forceinline__ void phase_gmlp(Frame& F, int l) {
    const KA K = KA::fresh(); PHASE_TID;
    float* vs = F.smem;
    const float* gn = K.in(6) + (size_t)l * 256; const float* wsp = K.in(7) + (size_t)l * MH * 128 * 128; const float* bsp = K.in(8) + (size_t)l * MH * 128;
#pragma unroll 1
    for (int u = F.bx; u < NB * MN * MH; u += F.G) {
        const int b = u / (MN * MH), n = (u / MH) % MN, h = u % MH, t0 = b * S + n * MC;
        __syncthreads();
        const int s = tid >> 2, d0 = (tid & 3) * 16;
        {
            const v4u* vr = (const v4u*)(K.P() + (size_t)(t0 + s) * PLD + C_VG + h * 64 + d0);
            float g[16]; { float f[8]; unpack8(vr[0], f);
#pragma unroll
                for (int j = 0; j < 8; ++j) g[j] = gelu_tanh(f[j]);
                unpack8(vr[1], f);
#pragma unroll
                for (int j = 0; j < 8; ++j) g[8 + j] = gelu_tanh(f[j]); }
            float ss = 0.f;
#pragma unroll
            for (int j = 0; j < 16; ++j) ss += g[j] * g[j];
            ss += shx(ss, 1); ss += shx(ss, 2);
            const float rs = rsqrtf(ss * (1.0f / 64.0f) + EPS);
#pragma unroll
            for (int j = 0; j < 16; ++j) vs[s * 64 + d0 + j] = g[j] * rs * gn[h * 64 + d0 + j];
        }
        __syncthreads();
        const int t = s;
        float acc[16];
#pragma unroll
        for (int j = 0; j < 16; ++j) acc[j] = 0.f;
        const float* wr = wsp + ((size_t)h * 128 + t) * 128;
#pragma unroll 2
        for (int s2 = 0; s2 <= t; ++s2) { const float w = wr[s2];
#pragma unroll
            for (int j = 0; j < 16; ++j) acc[j] += w * vs[s2 * 64 + d0 + j]; }
        const float bias = bsp[h * 128 + t];
        const v4u* ur = (const v4u*)(K.P() + (size_t)(t0 + t) * PLD + C_U + h * 64 + d0);
        float u0[8], u1[8]; unpack8(ur[0], u0); unpack8(ur[1], u1);
        float o[16];
#pragma unroll
        for (int j = 0; j < 8; ++j) { o[j] = gelu_tanh(u0[j]) * (acc[j] + bias); o[8 + j] = gelu_tanh(u1[j]) * (acc[8 + j] + bias); }
        v4u* op = (v4u*)(K.XN() + (size_t)(t0 + t) * D + 512 + h * 64 + d0);
        op[0] = (v4u){pk2(o[0], o[1]), pk2(o[2], o[3]), pk2(o[4], o[5]), pk2(o[6], o[7])};
        op[1] = (v4u){pk2(o[8], o[9]), pk2(o[10], o[11]), pk2(o[12], o[13]), pk2(o[14], o[15])};
    }
}
typedef short bf16x8 __attribute__((ext_vector_type(8)));
__device__ __forceinline__ float fexp(float x) { return __builtin_amdgcn_exp2f(x * 1.4426950408889634f); }
__device__ __forceinline__ float logsig_fast(float x) { return fminf(x, 0.f) - __log2f(1.0f + fexp(-fabsf(x))) * 0.6931471805599453f; }
__device__ __forceinline__ float silu_fast(float x) { return x * __builtin_amdgcn_rcpf(1.0f + __builtin_amdgcn_exp2f(-1.4426950408889634f * x)); }
__device__ __forceinline__ float gelu_fast(float x) { const float u = 0.7978845608028654f * (x + 0.044715f * x * x * x); return x * __builtin_amdgcn_rcpf(1.0f + __builtin_amdgcn_exp2f(-2.8853900817779268f * u)); }
__device__ __forceinline__ f32x4 mfma16(bf16x8 a, bf16x8 b, f32x4 c) { return __builtin_amdgcn_mfma_f32_16x16x32_bf16(a, b, c, 0, 0, 0); }
constexpr int LROWB = 144;
constexpr int L_QD = 0, L_KI = 9216, L_KDT = 18432, L_VT = 27648, L_S = 46080, L_ST = 55296, L_OB = 73728, L_TOT = 107520, OBROW = 528;
#define FRAG(base, row, kel) (*(const LAS bf16x8*)(lds + (base) + (row) * LROWB + (kel) * 2))

__device__ __forceinline__ float gla_b8(const KA& K, LAS unsigned char* lds, int l, int h, int t0, int lane, int wave, float (&bv)[8]) {
    const float* wup = K.in(3) + (size_t)l * 16 * 256 + h * 64 + lane;
    float wu[16];
#pragma unroll
    for (int r = 0; r < 16; ++r) wu[r] = wup[r * 256];
    const float bg = K.in(4)[l * 256 + h * 64 + lane];
    const bf16* P = K.P();
    float run = 0.f;
#pragma unroll
    for (int j = 0; j < 8; ++j) {
        const bf16* gl = P + (size_t)(t0 + 8 * wave + j) * PLD + C_GK;
        float f0[8], f1[8]; unpack8(*(const v4u*)gl, f0); unpack8(*(const v4u*)(gl + 8), f1);
        float a = bg;
#pragma unroll
        for (int r = 0; r < 8; ++r) a += f0[r] * wu[r];
#pragma unroll
        for (int r = 0; r < 8; ++r) a += f1[r] * wu[8 + r];
        run += logsig_fast(a) * (1.0f / 16.0f); bv[j] = run;
    }
    LAS float* tot = (LAS float*)(lds + L_TOT);
    tot[wave * 64 + lane] = run;
    __syncthreads();
    float base = 0.f, all = 0.f;
#pragma unroll
    for (int g = 0; g < 8; ++g) { const float tv = tot[g * 64 + lane]; all += tv; if (g < wave) base += tv; }
#pragma unroll
    for (int j = 0; j < 8; ++j) bv[j] += base;
    return all;
}
__device__ __forceinline__ void gla_stage_vT(const bf16* P, LAS unsigned char* lds, int h, int t0, int tid) {
    const int vv = tid & 127, cq = tid >> 7;
    const bf16* vp = P + (size_t)(t0 + 16 * cq) * PLD + C_V + h * 128 + vv;
    unsigned w[8];
#pragma unroll
    for (int j = 0; j < 8; ++j) w[j] = (unsigned)vp[(size_t)(2 * j) * PLD] | ((unsigned)vp[(size_t)(2 * j + 1) * PLD] << 16);
    LAS v4u* dst = (LAS v4u*)(lds + L_VT + vv * LROWB + cq * 32);
    dst[0] = (v4u){w[0], w[1], w[2], w[3]}; dst[1] = (v4u){w[4], w[5], w[6], w[7]};
}

__device__ __forceinline__ void phase_gla_kv_mfma(Frame& F, int l) {
    const KA K = KA::fresh(); PHASE_TID;
    LAS unsigned char* lds = F.lds;
    const int fr = lane & 15, fq = lane >> 4;
#pragma unroll 1
    for (int ci = F.bx; ci < NB * GH * GN; ci += F.G) {
        const int b = ci / (GH * GN), h = (ci / GN) % GH, n = ci % GN, t0 = b * S + n * GC;
        const bf16* P = K.P();
        __syncthreads();
        float bv[8]; const float bl = gla_b8(K, lds, l, h, t0, lane, wave, bv);
        {
            const bf16* kp = P + (size_t)(t0 + 8 * wave) * PLD + C_K + h * 64 + lane;
            float kd[8];
#pragma unroll
            for (int j = 0; j < 8; ++j) kd[j] = bf2f(kp[(size_t)j * PLD]) * fexp(bl - bv[j]);
            *(LAS v4u*)(lds + L_KDT + lane * LROWB + wave * 16) = (v4u){pk2(kd[0], kd[1]), pk2(kd[2], kd[3]), pk2(kd[4], kd[5]), pk2(kd[6], kd[7])};
        }
        gla_stage_vT(P, lds, h, t0, tid);
        if (wave == 0) K.dec()[(size_t)ci * 64 + lane] = fexp(bl);
        __syncthreads();
        bf16x8 Bf[2];
#pragma unroll
        for (int ks = 0; ks < 2; ++ks) Bf[ks] = FRAG(L_VT, 16 * wave + fr, 32 * ks + 8 * fq);
        float* so = K.Sst() + (size_t)ci * 64 * 128 + 16 * wave + fr;
#pragma unroll
        for (int dt = 0; dt < 4; ++dt) {
            f32x4 acc = (f32x4){0.f, 0.f, 0.f, 0.f};
#pragma unroll
            for (int ks = 0; ks < 2; ++ks) acc = mfma16(FRAG(L_KDT, 16 * dt + fr, 32 * ks + 8 * fq), Bf[ks], acc);
#pragma unroll
            for (int r = 0; r < 4; ++r) so[(size_t)(16 * dt + 4 * fq + r) * 128] = acc[r];
        }
    }
}

__device__ __forceinline__ void phase_gla_out_mfma(Frame& F, int l) {
    const KA K = KA::fresh(); PHASE_TID;
    LAS unsigned char* lds = F.lds;
    const int fr = lane & 15, fq = lane >> 4;
    const float* gnorm = K.in(5) + (size_t)l * 128;
#pragma unroll 1
    for (int ci = F.bx; ci < NB * GH * GN; ci += F.G) {
        const int b = ci / (GH * GN), h = (ci / GN) % GH, n = ci % GN, t0 = b * S + n * GC;
        const bf16* P = K.P();
        __syncthreads();
        float bv[8]; (void)gla_b8(K, lds, l, h, t0, lane, wave, bv);
        {
            const bf16* qp = P + (size_t)(t0 + 8 * wave) * PLD + C_Q + h * 64 + lane;
            const bf16* kp = qp + (C_K - C_Q);
#pragma unroll
            for (int j = 0; j < 8; ++j) {
                const float e = fexp(bv[j]);
                const float qv = bf2f(qp[(size_t)j * PLD]) * 0.125f * e, kv = bf2f(kp[(size_t)j * PLD]) * __builtin_amdgcn_rcpf(e);
                *(LAS bf16*)(lds + L_QD + (8 * wave + j) * LROWB + lane * 2) = (bf16)f2bf(qv);
                *(LAS bf16*)(lds + L_KI + (8 * wave + j) * LROWB + lane * 2) = (bf16)f2bf(kv);
            }
        }
        gla_stage_vT(P, lds, h, t0, tid);
        {
            const int vv = tid & 127, dq = tid >> 7;
            const float* sp = K.Sst() + ((size_t)ci * 64 + 16 * dq) * 128 + vv;
            unsigned w[8];
#pragma unroll
            for (int j = 0; j < 8; ++j) w[j] = pk2(sp[(size_t)(2 * j) * 128], sp[(size_t)(2 * j + 1) * 128]);
            LAS v4u* dst = (LAS v4u*)(lds + L_ST + vv * LROWB + dq * 32);
            dst[0] = (v4u){w[0], w[1], w[2], w[3]}; dst[1] = (v4u){w[4], w[5], w[6], w[7]};
        }
        __syncthreads();
#pragma unroll
        for (int i = 0; i < 2; ++i) {
            const int tix = 2 * wave + i, st = tix >> 2, ct = tix & 3;
            f32x4 acc = (f32x4){0.f, 0.f, 0.f, 0.f};
#pragma unroll
            for (int ks = 0; ks < 2; ++ks) acc = mfma16(FRAG(L_KI, 16 * st + fr, 32 * ks + 8 * fq), FRAG(L_QD, 16 * ct + fr, 32 * ks + 8 * fq), acc);
            const int s0 = 16 * st + 4 * fq, c = 16 * ct + fr;
            float m[4];
#pragma unroll
            for (int r = 0; r < 4; ++r) m[r] = (s0 + r <= c) ? acc[r] : 0.f;
            *(LAS v2u*)(lds + L_S + c * LROWB + s0 * 2) = (v2u){pk2(m[0], m[1]), pk2(m[2], m[3])};
        }
        __syncthreads();
        {
            bf16x8 Av[2], As[2];
#pragma unroll
            for (int ks = 0; ks < 2; ++ks) { Av[ks] = FRAG(L_VT, 16 * wave + fr, 32 * ks + 8 * fq); As[ks] = FRAG(L_ST, 16 * wave + fr, 32 * ks + 8 * fq); }
#pragma unroll
            for (int ct = 0; ct < 4; ++ct) {
                f32x4 acc = (f32x4){0.f, 0.f, 0.f, 0.f};
#pragma unroll
                for (int ks = 0; ks < 2; ++ks) { acc = mfma16(Av[ks], FRAG(L_S, 16 * ct + fr, 32 * ks + 8 * fq), acc); acc = mfma16(As[ks], FRAG(L_QD, 16 * ct + fr, 32 * ks + 8 * fq), acc); }
                *(LAS f32x4*)(lds + L_OB + (16 * ct + fr) * OBROW + (16 * wave + 4 * fq) * 4) = acc;
            }
        }
        __syncthreads();
        {
            const int c = tid >> 3, vg = tid & 7;
            const LAS f32x4* ob = (const LAS f32x4*)(lds + L_OB + c * OBROW + vg * 64);
            f32x4 o[4]; float ss = 0.f;
#pragma unroll
            for (int j = 0; j < 4; ++j) { o[j] = ob[j]; ss += (o[j].x * o[j].x + o[j].y * o[j].y) + (o[j].z * o[j].z + o[j].w * o[j].w); }
            ss += shx(ss, 1); ss += shx(ss, 2); ss += shx(ss, 4);
            const float rs = rsqrtf(ss * (1.0f / 128.0f) + EPS);
            const v4u* gr = (const v4u*)(P + (size_t)(t0 + c) * PLD + C_G + h * 128 + 16 * vg);
            float g0[8], g1[8]; unpack8(gr[0], g0); unpack8(gr[1], g1);
            const f32x4* gn = (const f32x4*)(gnorm + 16 * vg);
            const f32x4 n0 = gn[0], n1 = gn[1], n2 = gn[2], n3 = gn[3];
            v4u w0, w1;
            w0.x = pk2(o[0].x * rs * n0.x * silu_fast(g0[0]), o[0].y * rs * n0.y * silu_fast(g0[1])); w0.y = pk2(o[0].z * rs * n0.z * silu_fast(g0[2]), o[0].w * rs * n0.w * silu_fast(g0[3]));
            w0.z = pk2(o[1].x * rs * n1.x * silu_fast(g0[4]), o[1].y * rs * n1.y * silu_fast(g0[5])); w0.w = pk2(o[1].z * rs * n1.z * silu_fast(g0[6]), o[1].w * rs * n1.w * silu_fast(g0[7]));
            w1.x = pk2(o[2].x * rs * n2.x * silu_fast(g1[0]), o[2].y * rs * n2.y * silu_fast(g1[1])); w1.y = pk2(o[2].z * rs * n2.z * silu_fast(g1[2]), o[2].w * rs * n2.w * silu_fast(g1[3]));
            w1.z = pk2(o[3].x * rs * n3.x * silu_fast(g1[4]), o[3].y * rs * n3.y * silu_fast(g1[5])); w1.w = pk2(o[3].z * rs * n3.z * silu_fast(g1[6]), o[3].w * rs * n3.w * silu_fast(g1[7]));
            v4u* op = (v4u*)(K.XN() + (size_t)(t0 + c) * D + h * 128 + 16 * vg);
            op[0] = w0; op[1] = w1;
        }
    }
}
#undef FRAG

constexpr int GM_ROWB = 272;
__device__ __forceinline__ void phase_gmlp_mfma(Frame& F, int l) {
    const KA K = KA::fresh(); PHASE_TID;
    LAS unsigned char* lds = F.lds;
    const int fr = lane & 15, fq = lane >> 4;
#pragma unroll 1
    for (int u = F.bx; u < NB * MN * MH; u += F.G) {
        const int b = u / (MN * MH), n = (u / MH) % MN, h = u % MH, t0 = b * S + n * MC;
        const bf16* P = K.P();
        const float gn = K.in(6)[(size_t)l * 256 + h * 64 + lane];
        __syncthreads();
#pragma unroll
        for (int q = 0; q < 2; ++q) {
            float vs[8];
#pragma unroll
            for (int i = 0; i < 8; ++i) {
                const float g = gelu_fast(bf2f(P[(size_t)(t0 + 16 * wave + 8 * q + i) * PLD + C_VG + h * 64 + lane]));
                const float ss = wave_sum(g * g);
                vs[i] = g * rsqrtf(ss * (1.0f / 64.0f) + EPS) * gn;
            }
            *(LAS v4u*)(lds + lane * GM_ROWB + (16 * wave + 8 * q) * 2) = (v4u){pk2(vs[0], vs[1]), pk2(vs[2], vs[3]), pk2(vs[4], vs[5]), pk2(vs[6], vs[7])};
        }
        __syncthreads();
        const bf16* Wb = K.Wsp() + ((size_t)(l * MH + h) * 128 + 16 * wave + fr) * 128 + 8 * fq;
        f32x4 acc[4];
#pragma unroll
        for (int dt = 0; dt < 4; ++dt) acc[dt] = (f32x4){0.f, 0.f, 0.f, 0.f};
        const int nks = (16 * wave + 15) / 32 + 1;
#pragma unroll
        for (int ks = 0; ks < 4; ++ks) if (ks < nks) {
            const bf16x8 Bf = *(const bf16x8*)(Wb + 32 * ks);
#pragma unroll
            for (int dt = 0; dt < 4; ++dt) acc[dt] = mfma16(*(const LAS bf16x8*)(lds + (16 * dt + fr) * GM_ROWB + (32 * ks + 8 * fq) * 2), Bf, acc[dt]);
        }
        const int t = 16 * wave + fr;
        const float bias = K.in(8)[(size_t)l * MH * 128 + h * 128 + t];
        const bf16* up = P + (size_t)(t0 + t) * PLD + C_U + h * 64 + 4 * fq;
        bf16* op = K.XN() + (size_t)(t0 + t) * D + 512 + h * 64 + 4 * fq;
#pragma unroll
        for (int dt = 0; dt < 4; ++dt) {
            const v2u uw = *(const v2u*)(up + 16 * dt);
            const float o0 = gelu_fast(bflo(uw.x)) * (acc[dt][0] + bias), o1 = gelu_fast(bfhi(uw.x)) * (acc[dt][1] + bias), o2 = gelu_fast(bflo(uw.y)) * (acc[dt][2] + bias), o3 = gelu_fast(bfhi(uw.y)) * (acc[dt][3] + bias);
            *(v2u*)(op + 16 * dt) = (v2u){pk2(o0, o1), pk2(o2, o3)};
        }
    }
}

__device__ __forceinline__ void phase_conv(Frame& F, int l) {
    const KA K = KA::fresh(); PHASE_TID;
    const float* wc = K.in(9) + (size_t)l * 3 * 256;
#pragma unroll 1
    for (int e = F.bx * NT + tid; e < T * 32; e += F.G * NT) {
        const int t = e >> 5, c0 = (e & 31) * 8, tl = t % S;
        const bf16* row = K.P() + (size_t)t * PLD;
        float y[8], xi[8], cg[8], bg[8];
        unpack8(*(const v4u*)(row + C_XI + c0), xi); unpack8(*(const v4u*)(row + C_CG + c0), cg); unpack8(*(const v4u*)(row + C_BG + c0), bg);
#pragma unroll
        for (int j = 0; j < 8; ++j) y[j] = wc[2 * 256 + c0 + j] * cg[j] * xi[j];
        if (tl >= 1) { unpack8(*(const v4u*)(row - PLD + C_XI + c0), xi); unpack8(*(const v4u*)(row - PLD + C_CG + c0), cg);
#pragma unroll
            for (int j = 0; j < 8; ++j) y[j] += wc[1 * 256 + c0 + j] * cg[j] * xi[j]; }
        if (tl >= 2) { unpack8(*(const v4u*)(row - 2 * PLD + C_XI + c0), xi); unpack8(*(const v4u*)(row - 2 * PLD + C_CG + c0), cg);
#pragma unroll
            for (int j = 0; j < 8; ++j) y[j] += wc[0 * 256 + c0 + j] * cg[j] * xi[j]; }
#pragma unroll
        for (int j = 0; j < 8; ++j) y[j] *= bg[j];
        *(v4u*)(K.XN() + (size_t)t * D + 768 + c0) = (v4u){pk2(y[0], y[1]), pk2(y[2], y[3]), pk2(y[4], y[5]), pk2(y[6], y[7])};
    }
}
__device__ __forceinline__ void phase_norm_router(Frame& F, int l) {
    const KA K = KA::fresh(); PHASE_TID;
    const float* gain = K.in(11) + (size_t)l * D;
    const float* wrg = K.in(12) + (size_t)l * D * 4; const float* brg = K.in(13) + (size_t)l * 4;
    const float* wre = K.in(14) + (size_t)l * D * 32; const float* bre = K.in(15) + (size_t)l * 32;
    int* cnt = (int*)(K.ctl() + CW_CNT + 64 * l);
#pragma unroll 1
    for (int t = F.bx * NWAVES + wave; t < T; t += F.G * NWAVES) {
        const f32x4* xr = (const f32x4*)(K.out() + (size_t)t * D) + lane;
        f32x4 v[4]; float s = 0.f;
#pragma unroll
        for (int j = 0; j < 4; ++j) { v[j] = xr[64 * j]; s += (v[j].x * v[j].x + v[j].y * v[j].y) + (v[j].z * v[j].z + v[j].w * v[j].w); }
        const float rs = rsqrtf(wave_sum(s) * (1.f / D) + EPS);
        v2u* o8 = (v2u*)(K.XN() + (size_t)t * D) + lane;
        float acc[36];
#pragma unroll
        for (int j = 0; j < 36; ++j) acc[j] = 0.f;
#pragma unroll
        for (int j = 0; j < 4; ++j) {
            const f32x4 g = ((const f32x4*)gain)[lane + 64 * j];
            const float hv[4] = {v[j].x * rs * g.x, v[j].y * rs * g.y, v[j].z * rs * g.z, v[j].w * rs * g.w};
            v2u w; w.x = pk2(hv[0], hv[1]); w.y = pk2(hv[2], hv[3]); o8[64 * j] = w;
#pragma unroll
            for (int i = 0; i < 4; ++i) {
                const int k = 4 * lane + 256 * j + i; const float xv = hv[i];
                const f32x4 g4 = *(const f32x4*)(wrg + (size_t)k * 4);
                acc[0] += xv * g4.x; acc[1] += xv * g4.y; acc[2] += xv * g4.z; acc[3] += xv * g4.w;
                const f32x4* e4 = (const f32x4*)(wre + (size_t)k * 32);
#pragma unroll
                for (int q = 0; q < 8; ++q) { const f32x4 w4 = e4[q]; acc[4 + 4 * q] += xv * w4.x; acc[5 + 4 * q] += xv * w4.y; acc[6 + 4 * q] += xv * w4.z; acc[7 + 4 * q] += xv * w4.w; }
            }
        }
#pragma unroll
        for (int j = 0; j < 36; ++j) acc[j] = wave_sum(acc[j]);
        if (lane == 0) {
            float gl[4]; int gt = 0;
#pragma unroll
            for (int j = 0; j < 4; ++j) gl[j] = acc[j] + brg[j];
            float gmax = gl[0];
#pragma unroll
            for (int j = 1; j < 4; ++j) if (gl[j] > gmax) { gmax = gl[j]; gt = j; }
            float gs = 0.f;
#pragma unroll
            for (int j = 0; j < 4; ++j) gs += expf(gl[j] - gmax);
            const float gw = 1.0f / gs;
            float el[8];
#pragma unroll
            for (int j = 0; j < 8; ++j) { float vv = 0.f;
#pragma unroll
                for (int g = 0; g < 4; ++g) if (g == gt) vv = acc[4 + g * 8 + j] + bre[g * 8 + j];
                el[j] = vv; }
            int i0 = 0; float m0 = el[0];
#pragma unroll
            for (int j = 1; j < 8; ++j) if (el[j] > m0) { m0 = el[j]; i0 = j; }
            int i1 = -1; float m1 = -INFINITY;
#pragma unroll
            for (int j = 0; j < 8; ++j) if (j != i0 && el[j] > m1) { m1 = el[j]; i1 = j; }
            const float e1 = expf(m1 - m0);
            const float w0 = gw / (1.0f + e1), w1 = gw * e1 / (1.0f + e1);
            const int e0i = gt * 8 + i0, e1i = gt * 8 + i1;
            K.eid()[2 * t] = e0i; K.eid()[2 * t + 1] = e1i; K.ew()[2 * t] = w0; K.ew()[2 * t + 1] = w1;
            atomicAdd(&cnt[e0i], 1); atomicAdd(&cnt[e1i], 1);
        }
    }
}
constexpr int RT_PART = 0, RT_SS = RT_PART + 2 * 4 * 16 * 48 * 4, RT_RS = RT_SS + 2 * 4 * 16 * 4, RT_HIST = RT_RS + 2 * 16 * 4;
__device__ __forceinline__ void phase_norm_router_mfma(Frame& F, int l) {
    const KA K = KA::fresh(); PHASE_TID;
    LAS unsigned char* lds = F.lds;
    const int fr = lane & 15, fq = lane >> 4, tl = wave >> 2, kq = wave & 3;
    const bf16* Whi = K.Wr() + (size_t)l * 2 * 48 * D; const bf16* Wlo = Whi + 48 * D;
    const float* gain = K.in(11) + (size_t)l * D;
#pragma unroll 1
    for (int blk = F.bx; blk < T / 64; blk += F.G) {
        __syncthreads();
        if (tid < NE) ((LAS int*)(lds + RT_HIST))[tid] = 0;
#pragma unroll 1
        for (int half = 0; half < 2; ++half) {
            const int tok0 = blk * 64 + half * 32 + tl * 16;
            const float* xr = K.out() + (size_t)(tok0 + fr) * D + 256 * kq + 8 * fq;
            const bf16* whi = Whi + (size_t)fr * D + 256 * kq + 8 * fq; const bf16* wlo = Wlo + (size_t)fr * D + 256 * kq + 8 * fq;
            f32x4 acc[3];
#pragma unroll
            for (int nt = 0; nt < 3; ++nt) acc[nt] = (f32x4){0.f, 0.f, 0.f, 0.f};
            float ss = 0.f;
            f32x4 xa[8], xb[8];
#pragma unroll
            for (int ks = 0; ks < 8; ++ks) { xa[ks] = *(const f32x4*)(xr + 32 * ks); xb[ks] = *(const f32x4*)(xr + 32 * ks + 4); }
#pragma unroll
            for (int ks = 0; ks < 8; ++ks) {
                if ((ks & 1) == 0) __builtin_amdgcn_sched_barrier(0);
                const f32x4 x0 = xa[ks], x1 = xb[ks];
                const float xv[8] = {x0.x, x0.y, x0.z, x0.w, x1.x, x1.y, x1.z, x1.w};
                unsigned hw[4], lw[4];
#pragma unroll
                for (int j = 0; j < 4; ++j) { const float a = xv[2 * j], b2 = xv[2 * j + 1]; ss += a * a + b2 * b2;
                    const unsigned ha = f2bf(a), hb = f2bf(b2); hw[j] = ha | (hb << 16); lw[j] = pk2(a - bf2f(ha), b2 - bf2f(hb)); }
                bf16x8 Ah, Al; { v4u t4 = (v4u){hw[0], hw[1], hw[2], hw[3]}; Ah = __builtin_bit_cast(bf16x8, t4); t4 = (v4u){lw[0], lw[1], lw[2], lw[3]}; Al = __builtin_bit_cast(bf16x8, t4); }
#pragma unroll
                for (int nt = 0; nt < 3; ++nt) {
                    const bf16x8 Bh = *(const bf16x8*)(whi + (size_t)(16 * nt) * D + 32 * ks), Bl = *(const bf16x8*)(wlo + (size_t)(16 * nt) * D + 32 * ks);
                    acc[nt] = mfma16(Ah, Bh, acc[nt]); acc[nt] = mfma16(Al, Bh, acc[nt]); acc[nt] = mfma16(Ah, Bl, acc[nt]);
                }
            }
            ss += shx(ss, 16); ss += shx(ss, 32);
            {
                LAS float* part = (LAS float*)(lds + RT_PART) + (tl * 4 + kq) * 16 * 48;
#pragma unroll
                for (int nt = 0; nt < 3; ++nt)
#pragma unroll
                    for (int r = 0; r < 4; ++r) part[(4 * fq + r) * 48 + 16 * nt + fr] = acc[nt][r];
                if (fq == 0) ((LAS float*)(lds + RT_SS))[(tl * 4 + kq) * 16 + fr] = ss;
            }
            __syncthreads();
            if (kq == 0 && lane < 16) {
                const int t = tok0 + lane;
                const LAS float* p0 = (const LAS float*)(lds + RT_PART) + (tl * 4) * 16 * 48 + lane * 48;
                const LAS float* s2 = (const LAS float*)(lds + RT_SS) + (tl * 4) * 16 + lane;
                const float rs = rsqrtf(((s2[0] + s2[16]) + (s2[32] + s2[48])) * (1.f / D) + EPS);
                ((LAS float*)(lds + RT_RS))[tl * 16 + lane] = rs;
                const float* brg = K.in(13) + (size_t)l * 4; const float* bre = K.in(15) + (size_t)l * 32;
#define RT_DOT(n) ((p0[(n)] + p0[768 + (n)]) + (p0[1536 + (n)] + p0[2304 + (n)]))
                float gl[4]; int gt = 0;
#pragma unroll
                for (int j = 0; j < 4; ++j) gl[j] = RT_DOT(j) * rs + brg[j];
                float gmax = gl[0];
#pragma unroll
                for (int j = 1; j < 4; ++j) if (gl[j] > gmax) { gmax = gl[j]; gt = j; }
                float gs = 0.f;
#pragma unroll
                for (int j = 0; j < 4; ++j) gs += expf(gl[j] - gmax);
                const float gw = 1.0f / gs;
                float el[8];
#pragma unroll
                for (int j = 0; j < 8; ++j) el[j] = RT_DOT(4 + gt * 8 + j) * rs + bre[gt * 8 + j];
#undef RT_DOT
                int i0 = 0; float m0 = el[0];
#pragma unroll
                for (int j = 1; j < 8; ++j) if (el[j] > m0) { m0 = el[j]; i0 = j; }
                int i1 = -1; float m1 = -INFINITY;
#pragma unroll
                for (int j = 0; j < 8; ++j) if (j != i0 && el[j] > m1) { m1 = el[j]; i1 = j; }
                const float e1 = expf(m1 - m0);
                const float w0 = gw / (1.0f + e1), w1 = gw * e1 / (1.0f + e1);
                const int e0i = gt * 8 + i0, e1i = gt * 8 + i1;
                K.eid()[2 * t] = e0i; K.eid()[2 * t + 1] = e1i; K.ew()[2 * t] = w0; K.ew()[2 * t + 1] = w1;
                LAS int* hist = (LAS int*)(lds + RT_HIST);
                K.slot_of()[2 * t] = __hip_atomic_fetch_add(hist + e0i, 1, __ATOMIC_RELAXED, __HIP_MEMORY_SCOPE_WORKGROUP);
                K.slot_of()[2 * t + 1] = __hip_atomic_fetch_add(hist + e1i, 1, __ATOMIC_RELAXED, __HIP_MEMORY_SCOPE_WORKGROUP);
            }
            __syncthreads();
            {
                const float rs = ((const LAS float*)(lds + RT_RS))[tl * 16 + fr];
                bf16* hp = K.XN() + (size_t)(tok0 + fr) * D + 256 * kq + 8 * fq;
                const float* gp = gain + 256 * kq + 8 * fq;
#pragma unroll
                for (int ks = 0; ks < 8; ++ks) {
                    const f32x4 x0 = xa[ks], x1 = xb[ks];
                    const f32x4 g0 = *(const f32x4*)(gp + 32 * ks), g1 = *(const f32x4*)(gp + 32 * ks + 4);
                    *(v4u*)(hp + 32 * ks) = (v4u){pk2(x0.x * rs * g0.x, x0.y * rs * g0.y), pk2(x0.z * rs * g0.z, x0.w * rs * g0.w), pk2(x1.x * rs * g1.x, x1.y * rs * g1.y), pk2(x1.z * rs * g1.z, x1.w * rs * g1.w)};
                }
            }
        }
        __syncthreads();
        if (tid < NE) K.blkcnt()[(size_t)(l * (T / 64) + blk) * NE + tid] = ((LAS int*)(lds + RT_HIST))[tid];
    }
}
__device__ __forceinline__ void phase_scatter(Frame& F, int l) {
    const KA K = KA::fresh(); PHASE_TID;
    LAS int* sm = (LAS int*)F.lds;
    const int* bc = K.blkcnt() + (size_t)l * (T / 64) * NE;
    constexpr int NBLK = T / 64;
#pragma unroll 1
    for (int blk = F.bx; blk < NBLK; blk += F.G) {
        __syncthreads();
        {   const int e = tid & 31, part = tid >> 5;
            int tot = 0, pre = 0;
#pragma unroll
            for (int j = 0; j < NBLK / 16; ++j) { const int bb = part * (NBLK / 16) + j; const int c = bc[bb * NE + e]; tot += c; if (bb < blk) pre += c; }
            sm[part * 32 + e] = tot; sm[512 + part * 32 + e] = pre; }
        __syncthreads();
        if (tid < 32) { int tot = 0, pre = 0;
#pragma unroll
            for (int p = 0; p < 16; ++p) { tot += sm[p * 32 + tid]; pre += sm[512 + p * 32 + tid]; }
            sm[1056 + tid] = tot; sm[1024 + tid] = pre; }
        __syncthreads();
        if (tid == 0) { int a = 0; for (int e = 0; e < NE; ++e) { const int c = sm[1056 + e]; sm[1024 + e] += a; a += c; } }
        if (blk == 0 && tid < 32) ((int*)(K.ctl() + CW_CNT + 64 * l))[tid] = sm[1056 + tid];
        __syncthreads();
        if (tid < 128) { const int a = blk * 128 + tid; const int e = K.eid()[a]; const int pos = sm[1024 + e] + K.slot_of()[a]; K.slot_tok()[pos] = a >> 1; K.slot_of()[a] = pos; }
    }
    __syncthreads();
}
template <bool DUAL>
__device__ __forceinline__ void gemm_core(const bf16* A, const int* rowoff, int K, const float* B0, const float* B1, int ldb, int n0,
                                          float (&acc0)[4][4], float (&acc1)[4][4], float* As, float* Bs0, float* Bs1) {
    const int tid = __builtin_amdgcn_readfirstlane(threadIdx.x >> 6) * 64 + fresh_lane(), tx = tid & 15, ty = tid >> 4;
    const int ar = tid >> 2, ak = (tid & 3) * 4;
    const int bk = (tid >> 4) & 15, bn = (tid & 15) * 4;
    const long aoff = rowoff[ar];
#pragma unroll
    for (int i = 0; i < 4; ++i)
#pragma unroll
        for (int j = 0; j < 4; ++j) { acc0[i][j] = 0.f; acc1[i][j] = 0.f; }
#pragma unroll 1
    for (int k0 = 0; k0 < K; k0 += 16) {
        v2u av = (v2u){0u, 0u};
        if (aoff >= 0) av = *(const v2u*)(A + aoff + k0 + ak);
        f32x4 bv0 = (f32x4){0.f, 0.f, 0.f, 0.f}, bv1 = bv0;
        if (tid < 256) { bv0 = *(const f32x4*)(B0 + (size_t)(k0 + bk) * ldb + n0 + bn); if (DUAL) bv1 = *(const f32x4*)(B1 + (size_t)(k0 + bk) * ldb + n0 + bn); }
        __syncthreads();
        As[(ak + 0) * 132 + ar] = bflo(av.x); As[(ak + 1) * 132 + ar] = bfhi(av.x); As[(ak + 2) * 132 + ar] = bflo(av.y); As[(ak + 3) * 132 + ar] = bfhi(av.y);
        if (tid < 256) { *(f32x4*)(Bs0 + bk * 64 + bn) = bv0; if (DUAL) *(f32x4*)(Bs1 + bk * 64 + bn) = bv1; }
        __syncthreads();
#pragma unroll
        for (int kk = 0; kk < 16; ++kk) {
            const f32x4 a4 = *(const f32x4*)(As + kk * 132 + ty * 4);
            const f32x4 b4 = *(const f32x4*)(Bs0 + kk * 64 + tx * 4);
#pragma unroll
            for (int i = 0; i < 4; ++i)
#pragma unroll
                for (int j = 0; j < 4; ++j) acc0[i][j] += a4[i] * b4[j];
            if (DUAL) {
                const f32x4 c4 = *(const f32x4*)(Bs1 + kk * 64 + tx * 4);
#pragma unroll
                for (int i = 0; i < 4; ++i)
#pragma unroll
                    for (int j = 0; j < 4; ++j) acc1[i][j] += a4[i] * c4[j];
            }
        }
    }
}
template <int MODE>
__device__ __forceinline__ void phase_moe_ref(Frame& F, int l) {
    const KA K = KA::fresh(); PHASE_TID;
    float* As = F.smem; float* Bs0 = F.smem + 16 * 132; float* Bs1 = Bs0 + 16 * 64; int* rowoff = (int*)(Bs1 + 16 * 64); int* offs = rowoff + 128; int* toff = offs + 33;
    int* cnt = (int*)(K.ctl() + CW_CNT + 64 * l);
    const int tx = tid & 15, ty = tid >> 4;
    __syncthreads();
    if (tid == 0) { int a = 0, tt = 0; for (int e = 0; e < NE; ++e) { offs[e] = a; toff[e] = tt; const int c = cnt[e]; a += c; tt += (c + 127) / 128; } offs[NE] = a; toff[NE] = tt; }
    __syncthreads();
    constexpr int N = (MODE == 1) ? DE : D, KD = (MODE == 1) ? D : DE, NTN = N / 64;
    const int ntiles = toff[NE] * NTN;
#pragma unroll 1
    for (int t = F.bx; t < ntiles; t += F.G) {
        const int rt = t / NTN, tn = t % NTN;
        int e = 0;
        for (int j = 1; j < NE; ++j) if (toff[j] <= rt) e = j;
        const int r0 = offs[e] + (rt - toff[e]) * 128, rend = offs[e + 1];
        __syncthreads();
        if (tid < 128) { const int r = r0 + tid; rowoff[tid] = (r < rend) ? ((MODE == 1) ? K.slot_tok()[r] * D : r * DE) : -1; }
        __syncthreads();
        float acc0[4][4], acc1[4][4];
        if (MODE == 1) {
            const float* Wg = K.in(16) + ((size_t)l * NE + e) * D * DE; const float* Wu = K.in(17) + ((size_t)l * NE + e) * D * DE;
            gemm_core<true>(K.XN(), rowoff, KD, Wg, Wu, DE, tn * 64, acc0, acc1, As, Bs0, Bs1);
        } else {
            const float* Wd = K.in(18) + ((size_t)l * NE + e) * DE * D;
            gemm_core<false>(K.H1(), rowoff, KD, Wd, nullptr, D, tn * 64, acc0, acc1, As, Bs0, nullptr);
        }
#pragma unroll
        for (int i = 0; i < 4; ++i) {
            const int r = r0 + ty * 4 + i;
            if (r < rend) {
                v2u o;
                if (MODE == 1) { o.x = pk2(silu(acc0[i][0]) * acc1[i][0], silu(acc0[i][1]) * acc1[i][1]); o.y = pk2(silu(acc0[i][2]) * acc1[i][2], silu(acc0[i][3]) * acc1[i][3]);
                    *(v2u*)(K.H1() + (size_t)r * DE + tn * 64 + tx * 4) = o; }
                else { o.x = pk2(acc0[i][0], acc0[i][1]); o.y = pk2(acc0[i][2], acc0[i][3]); *(v2u*)(K.Y() + (size_t)r * D + tn * 64 + tx * 4) = o; }
            }
        }
    }
    __syncthreads();
}

constexpr int TAB_OFF = LDSCTL_OFF + 1024;
__device__ __forceinline__ void moe_tables(Frame& F, int l) {
    const KA K = KA::fresh(); PHASE_TID;
    LAS int* tab = (LAS int*)(F.lds + TAB_OFF); LAS int* offs = tab + 4 + 4 * 164; LAS int* fpre = offs + 40; LAS int* ppre = fpre + 40;
    const int* cnt = (const int*)(K.ctl() + CW_CNT + 64 * l);
    __syncthreads();
    if (tid == 0) { int a = 0, f = 0, p = 0; for (int e = 0; e < NE; ++e) { const int c = cnt[e]; offs[e] = a; fpre[e] = f; ppre[e] = p; a += c; f += c >> 8; p += (c & 255) ? 1 : 0; }
        offs[NE] = a; fpre[NE] = f; ppre[NE] = p; tab[0] = f + p; }
    __syncthreads();
    const int nfull = fpre[NE], ntile = nfull + ppre[NE];
    if (tid < ntile) {
        int e = 0;
        if (tid < nfull) { for (int j = 1; j < NE; ++j) if (fpre[j] <= tid) e = j; tab[4 + 4 * tid] = e; tab[5 + 4 * tid] = offs[e] + (tid - fpre[e]) * 256; tab[6 + 4 * tid] = offs[e + 1]; }
        else { const int q = tid - nfull; for (int j = 1; j < NE; ++j) if (ppre[j] <= q) e = j; tab[4 + 4 * tid] = e; tab[5 + 4 * tid] = offs[e] + (fpre[e + 1] - fpre[e]) * 256; tab[6 + 4 * tid] = offs[e + 1]; }
    }
    __syncthreads();
}
__device__ __forceinline__ void phase_moe_gu(Frame& F, int l) {
    moe_tables(F, l);
    const KA K = KA::fresh();
    int c_ = F.bx; asm volatile("" : "+s"(c_));
    pg8::MoeSched So{(const LAS int*)(F.lds + TAB_OFF), 2, F.G, (c_ & 7) * (F.G >> 3) + (c_ >> 3)};
    pg8::EpiMoeH E{K.H1()};
    pg8::gemm_phase_moe<pg8::EpiMoeH, pg8::MoeSched, true, 512, D>(F.lds, K.XN(), K.WguT() + (size_t)l * NE * 512 * D, K.slot_tok(), So, E, F.wave);
}
__device__ __forceinline__ void phase_moe_down(Frame& F, int l) {
    moe_tables(F, l);
    const KA K = KA::fresh();
    int c_ = F.bx; asm volatile("" : "+s"(c_));
    pg8::MoeSched So{(const LAS int*)(F.lds + TAB_OFF), 4, F.G, (c_ & 7) * (F.G >> 3) + (c_ >> 3)};
    pg8::EpiMoeY E{K.Y()};
    pg8::gemm_phase_moe<pg8::EpiMoeY, pg8::MoeSched, false, D, DE>(F.lds, K.H1(), K.WdT() + (size_t)l * NE * D * DE, nullptr, So, E, F.wave);
}
__device__ __forceinline__ void phase_combine(Frame& F, int l) {
    const KA K = KA::fresh(); PHASE_TID;
    const bool last = (l == DEPTH - 1);
    const float* gain = last ? K.in(19) : (K.in(1) + (size_t)(l + 1) * D);
#pragma unroll 1
    for (int t = F.bx * NWAVES + wave; t < T; t += F.G * NWAVES) {
        const int s0 = K.slot_of()[2 * t], s1 = K.slot_of()[2 * t + 1]; const float w0 = K.ew()[2 * t], w1 = K.ew()[2 * t + 1];
        f32x4* xr = (f32x4*)(K.out() + (size_t)t * D) + lane;
        const v2u* y0 = (const v2u*)(K.Y() + (size_t)s0 * D) + lane; const v2u* y1 = (const v2u*)(K.Y() + (size_t)s1 * D) + lane;
        f32x4 v[4]; float s = 0.f;
#pragma unroll
        for (int j = 0; j < 4; ++j) { v[j] = xr[64 * j]; const v2u a = y0[64 * j], b = y1[64 * j];
            v[j].x += w0 * bflo(a.x) + w1 * bflo(b.x); v[j].y += w0 * bfhi(a.x) + w1 * bfhi(b.x); v[j].z += w0 * bflo(a.y) + w1 * bflo(b.y); v[j].w += w0 * bfhi(a.y) + w1 * bfhi(b.y);
            s += (v[j].x * v[j].x + v[j].y * v[j].y) + (v[j].z * v[j].z + v[j].w * v[j].w); }
        const float rs = rsqrtf(wave_sum(s) * (1.f / D) + EPS);
        if (last) {
#pragma unroll
            for (int j = 0; j < 4; ++j) { const f32x4 g = ((const f32x4*)gain)[lane + 64 * j]; xr[64 * j] = (f32x4){v[j].x * rs * g.x, v[j].y * rs * g.y, v[j].z * rs * g.z, v[j].w * rs * g.w}; }
        } else {
            v2u* o8 = (v2u*)(K.XN() + (size_t)t * D) + lane;
#pragma unroll
            for (int j = 0; j < 4; ++j) { xr[64 * j] = v[j]; const f32x4 g = ((const f32x4*)gain)[lane + 64 * j];
                v2u w; w.x = pk2(v[j].x * rs * g.x, v[j].y * rs * g.y); w.y = pk2(v[j].z * rs * g.z, v[j].w * rs * g.w); o8[64 * j] = w; }
        }
    }
}

struct Args { const float* in[20]; float* out; unsigned char* ws; };
__global__ void __launch_bounds__(NT, 2) fwd_kernel(Args args) {
    extern __shared__ __attribute__((aligned(16))) unsigned char lds_raw[];
    Frame F;
    F.lds = (LAS unsigned char*)lds_raw; F.smem = (float*)lds_raw;
    F.G = gridDim.x; F.bx = blockIdx.x; F.wave = __builtin_amdgcn_readfirstlane(threadIdx.x >> 6);
    volatile LAS unsigned* MISC = (volatile LAS unsigned*)(F.lds + MISC_OFF);
    for (int u = threadIdx.x; u < (LDS_BYTES - LDSCTL_OFF) / 4; u += NT) ((LAS unsigned*)(F.lds + LDSCTL_OFF))[u] = 0u;
    __syncthreads();
    XcdBarrier bar; { const KA K = KA::fresh(); bar = xcd_barrier_post(K.ctl() + CW_BAR, MISC + 8); }
#define GRID_BAR() xcd_barrier(bar)

    p0_prologue(F);
    GRID_BAR();
    for (int l = 0; l < DEPTH; ++l) {
        {
            const KA K = KA::fresh(); PHASE_TID;
            pg8::Gemm g{K.XN(), K.WinT() + (size_t)l * PLD * D, T, PLD, D}; pg8::StaticOrder So; int c_ = F.bx; asm volatile("" : "+s"(c_)); So.init(T, PLD, F.G, c_);
            pg8::EpiBf16Plain E{K.P(), PLD};
            pg8::gemm_phase<pg8::EpiBf16Plain, pg8::StaticOrder, PG8_ALIGN, PG8_SP2>(F.lds, g, So, E, F.wave);
        }
        GRID_BAR();
        phase_gla_kv_mfma(F, l);
        phase_gmlp_mfma(F, l);
        phase_conv(F, l);
        GRID_BAR();
        phase_gla_scan(F);
        GRID_BAR();
        phase_gla_out_mfma(F, l);
        GRID_BAR();
        {
            const KA K = KA::fresh(); PHASE_TID;
            pg8::Gemm g{K.XN(), K.WoutT() + (size_t)l * D * D, T, D, D}; pg8::StaticOrder So; int c_ = F.bx; asm volatile("" : "+s"(c_)); So.init(T, D, F.G, c_);
            pg8::EpiF32Res E{K.out(), (l == 0) ? K.in(0) : K.out(), D};
            pg8::gemm_phase<pg8::EpiF32Res, pg8::StaticOrder, PG8_ALIGN, PG8_SP2>(F.lds, g, So, E, F.wave);
        }
        GRID_BAR();
        phase_norm_router_mfma(F, l);
        GRID_BAR();
        phase_scatter(F, l);
        GRID_BAR();
        phase_moe_gu(F, l);
        GRID_BAR();
        phase_moe_down(F, l);
        GRID_BAR();
        phase_combine(F, l);
        if (l + 1 < DEPTH) GRID_BAR();
    }
}

extern "C" void kernel_launch(void* const* d_in, const int* in_sizes, int n_in, void* d_out, int out_size, void* d_ws, size_t ws_size, hipStream_t stream) {
    static int grid_blocks = 0;
    if (!grid_blocks) {
        int dev = 0, cus = 0, per_cu = 0;
        (void)hipGetDevice(&dev);
        (void)hipDeviceGetAttribute(&cus, hipDeviceAttributeMultiprocessorCount, dev);
        (void)hipFuncSetAttribute((const void*)fwd_kernel, hipFuncAttributeMaxDynamicSharedMemorySize, LDS_BYTES);
        (void)hipOccupancyMaxActiveBlocksPerMultiprocessor(&per_cu, fwd_kernel, NT, LDS_BYTES);
        if (per_cu < 1) { fprintf(stderr, "kernel_launch: occupancy query says %d blocks/CU\n", per_cu); per_cu = 1; }
        grid_blocks = cus;
        if (ws_size < WS_END) { fprintf(stderr, "kernel_launch: workspace too small (%zu < %zu)\n", ws_size, (size_t)WS_END); grid_blocks = -1; }
    }
    if (grid_blocks < 0) return;
    (void)hipMemsetAsync((char*)d_ws + WS_CTL, 0, CTL_BYTES, stream);
    Args a{};
    for (int i = 0; i < 20; ++i) a.in[i] = (const float*)d_in[i];
    a.out = (float*)d_out; a.ws = (unsigned char*)d_ws;
    void* args[] = {&a};
    hipError_t e = hipLaunchCooperativeKernel((void*)fwd_kernel, dim3(grid_blocks), dim3(NT), args, LDS_BYTES, stream);
    if (e != hipSuccess) fprintf(stderr, "cooperative launch failed: %s (grid %d)\n", hipGetErrorString(e), grid_blocks);
}
```

```cpp
#include <hip/hip_runtime.h>
#include <hip/hip_cooperative_groups.h>
#include <cstdio>
#include <cstdint>
namespace cg = cooperative_groups;
__device__ __forceinline__ int fresh_lane() { unsigned m = 0xffffffffu; asm volatile("" : "+s"(m)); return (int)__builtin_amdgcn_mbcnt_hi(m, __builtin_amdgcn_mbcnt_lo(m, 0u)); }
__device__ __forceinline__ float shx(float v, int o) { return __int_as_float(__builtin_amdgcn_ds_bpermute((fresh_lane() ^ o) << 2, __float_as_int(v))); }
namespace pg8 {
#define PG8_LAS __attribute__((address_space(3)))
typedef unsigned short bf16_t;
typedef short bf16x8 __attribute__((ext_vector_type(8)));
typedef float f32x4 __attribute__((ext_vector_type(4)));
typedef unsigned u32x4 __attribute__((ext_vector_type(4)));
constexpr int BM = 256, BK = 64, HALF = 128, HTB = HALF * BK * 2  , STAGE_BYTES = 8 * HTB, NXCD = 8, WGM = 8;

__host__ __device__ __forceinline__ int lds_byte(int r, int c) { const int st = (r >> 4) * 2 + (c >> 5), rr = r & 15, cc = c & 31, ob = rr * 64 + cc * 2; return st * 1024 + (ob ^ (((ob >> 9) & 1) << 5)); }
__host__ __device__ __forceinline__ void stage_rc(int b, int& R, int& C) { const int st = b / 1024, sb = b % 1024, swz = sb ^ (((sb >> 9) & 1) << 5); R = (st >> 1) * 16 + swz / 64; C = (st & 1) * 32 + (swz % 64) / 2; }
__host__ __device__ __forceinline__ int perm32(int rho) { const int n = rho >> 4, i = rho & 15; return 8 * (i >> 2) + 4 * n + (i & 3); }

struct Unit { int pm, pn; };
struct Gemm { const bf16_t* A; const bf16_t* Bt; int M, N, K; };

struct StaticOrder {
    int nM, nN, nwg, G, c;
    __host__ __device__ void init(int M, int N, int G_, int c_) { nM = M / BM; nN = N / BM; nwg = nM * nN; G = G_; c = c_; }
    __host__ __device__ bool next(int i, Unit& u) const {
        const long L = (long)i * G + c; if (L >= nwg) return false;
        int wgid = (int)L; { const int q = nwg / NXCD, r = nwg % NXCD, xcd = wgid % NXCD, off = wgid / NXCD; wgid = (xcd < r ? xcd * (q + 1) : r * (q + 1) + (xcd - r) * q) + off; }
        const int nig = WGM * nN, gid = wgid / nig, fm = gid * WGM, gsz = (nM - fm) < WGM ? (nM - fm) : WGM;
        u.pm = fm + ((wgid % nig) % gsz); u.pn = (wgid % nig) / gsz; return true;
    }
    __device__ __forceinline__ void a_ready(const Unit&) const {}
    __device__ __forceinline__ void done(const Unit&) const {}
};


__device__ __forceinline__ unsigned cvt_pk_bf16(float lo, float hi) { unsigned r; asm volatile("v_cvt_pk_bf16_f32 %0, %1, %2" : "=v"(r) : "v"(lo), "v"(hi)); return r; }
struct EpiBf16Plain {
    static constexpr bool PERM = true, AFTER_DRAIN = false;
    bf16_t* O; int ldc;
    __device__ __forceinline__ void operator()(const f32x4 (&acc)[2][2][4][2], const Unit& u, int wr, int wc, int fr, int fq) const {
        const int row0 = u.pm * BM + wr * 64 + fr, col0 = u.pn * BM + wc * 32 + 8 * fq;
#pragma unroll
        for (int ai = 0; ai < 2; ++ai)
#pragma unroll
            for (int m = 0; m < 4; ++m) { bf16_t* rowp = O + (size_t)(row0 + ai * HALF + m * 16) * ldc + col0;
#pragma unroll
                for (int bj = 0; bj < 2; ++bj) { const f32x4 v0 = acc[ai][bj][m][0], v1 = acc[ai][bj][m][1];
                    u32x4 w; w.x = cvt_pk_bf16(v0[0], v0[1]); w.y = cvt_pk_bf16(v0[2], v0[3]); w.z = cvt_pk_bf16(v1[0], v1[1]); w.w = cvt_pk_bf16(v1[2], v1[3]);
                    *(u32x4*)(rowp + bj * HALF) = w; } }
    }
};
struct EpiF32Res {
    static constexpr bool PERM = false, AFTER_DRAIN = false;
    float* C; const float* R; int ldc;
    __device__ __forceinline__ void operator()(const f32x4 (&acc)[2][2][4][2], const Unit& u, int wr, int wc, int fr, int fq) const {
        const int row0 = u.pm * BM + wr * 64 + fr, col0 = u.pn * BM + wc * 32 + 4 * fq;
#pragma unroll
        for (int ai = 0; ai < 2; ++ai)
#pragma unroll
            for (int m = 0; m < 4; ++m) { const size_t off = (size_t)(row0 + ai * HALF + m * 16) * ldc + col0;
#pragma unroll
                for (int bj = 0; bj < 2; ++bj)
#pragma unroll
                    for (int n = 0; n < 2; ++n) { const f32x4 r = *(const f32x4*)(R + off + bj * HALF + n * 16); *(f32x4*)(C + off + bj * HALF + n * 16) = r + acc[ai][bj][m][n]; } }
    }
};
template <class Epi, class Sched, bool ALIGN_EPI = false, bool SP2 = false>
__device__ __forceinline__ void gemm_phase(PG8_LAS unsigned char* lds, const Gemm g, const Sched& S, const Epi& E, int wave_id) {
    asm volatile("" : "+s"(wave_id));
    const int lane = fresh_lane(), wid = wave_id, tid = wid * 64 + lane, wr = wid >> 2, wc = wid & 3, fr = lane & 15, fq = lane >> 4;
    const int K = g.K, nt = K / BK;
    unsigned voffA[2], voffB[2];
#pragma unroll
    for (int i = 0; i < 2; ++i) { int R, C; stage_rc(tid * 16 + i * 8192, R, C); const int Rb = Epi::PERM ? ((R & ~31) + perm32(R & 31)) : R;
        voffA[i] = (unsigned)(R * K + C) * 2u; voffB[i] = (unsigned)(Rb * K + C) * 2u; }
    const size_t kstep = (size_t)(BK * 2);
    const size_t hstep = (size_t)HALF * K * 2;
    const size_t tstep = 2 * hstep;
    const unsigned ldsw = (unsigned)wid * 1024u;
    const int aoff = lds_byte(wr * 64 + fr, fq * 8), boff = lds_byte(wc * 32 + fr, fq * 8);
#define PG8_SA(b, h) (((b) * 2 + (h)) * HTB)
#define PG8_SB(b, h) ((4 + (b) * 2 + (h)) * HTB)
#define PG8_STAGE(bufoff, gbase, voff) do { _Pragma("unroll") for (int _i = 0; _i < 2; ++_i) \
        __builtin_amdgcn_global_load_lds((const unsigned*)((const char*)(gbase) + (voff)[_i]), (PG8_LAS unsigned*)(lds + (bufoff) + ldsw + _i * 8192), 16, 0, 0); } while (0)
#define PG8_LDA(dst, b, h) do { _Pragma("unroll") for (int m = 0; m < 4; ++m) _Pragma("unroll") for (int k = 0; k < 2; ++k) dst[m][k] = *(const PG8_LAS bf16x8*)(lds + PG8_SA(b, h) + aoff + m * 2048 + k * 1024); } while (0)
#define PG8_LDB(dst, b, h) do { _Pragma("unroll") for (int n = 0; n < 2; ++n) _Pragma("unroll") for (int k = 0; k < 2; ++k) dst[n][k] = *(const PG8_LAS bf16x8*)(lds + PG8_SB(b, h) + boff + n * 2048 + k * 1024); } while (0)
#define PG8_MMA(ai, bj, At, Bt) do { __builtin_amdgcn_s_setprio(1); _Pragma("unroll") for (int m = 0; m < 4; ++m) _Pragma("unroll") for (int n = 0; n < 2; ++n) _Pragma("unroll") for (int k = 0; k < 2; ++k) \
        acc[ai][bj][m][n] = __builtin_amdgcn_mfma_f32_16x16x32_bf16(Bt[n][k], At[m][k], acc[ai][bj][m][n], 0, 0, 0); __builtin_amdgcn_s_setprio(0); } while (0)
#define PG8_WAIT_V(n) asm volatile("s_waitcnt vmcnt(" #n ")" ::: "memory")
#define PG8_WAIT_L(n) asm volatile("s_waitcnt lgkmcnt(" #n ")" ::: "memory")
#define PG8_BAR __builtin_amdgcn_s_barrier()
#define PG8_SCHED __builtin_amdgcn_sched_barrier(0)
    Unit cur, nxt; int ui = 0;
    if (!S.next(0, cur)) return;
    f32x4 acc[2][2][4][2];
#pragma unroll
    for (int a = 0; a < 2; ++a)
#pragma unroll
        for (int b = 0; b < 2; ++b)
#pragma unroll
            for (int m = 0; m < 4; ++m)
#pragma unroll
                for (int n = 0; n < 2; ++n) acc[a][b][m][n] = (f32x4){0.f, 0.f, 0.f, 0.f};
    bf16x8 At[4][2], B0[2][2], B1[2][2];
    const char* cA = (const char*)g.A + (size_t)cur.pm * tstep; const char* cB = (const char*)g.Bt + (size_t)cur.pn * tstep;
    S.a_ready(cur);
    if constexpr (SP2) {
        PG8_STAGE(PG8_SB(0, 0), cB, voffB); PG8_STAGE(PG8_SB(0, 1), cB + hstep, voffB); PG8_STAGE(PG8_SA(0, 0), cA, voffA); PG8_STAGE(PG8_SA(0, 1), cA + hstep, voffA);
        if (wr == 1) PG8_BAR;
        PG8_WAIT_V(2); PG8_BAR;
        PG8_STAGE(PG8_SB(1, 0), cB + kstep, voffB); PG8_STAGE(PG8_SA(1, 0), cA + kstep, voffA); PG8_STAGE(PG8_SB(1, 1), cB + hstep + kstep, voffB);
        PG8_WAIT_V(6); PG8_BAR;
    } else {
        PG8_STAGE(PG8_SB(0, 0), cB, voffB); PG8_STAGE(PG8_SA(0, 0), cA, voffA); PG8_STAGE(PG8_SB(0, 1), cB + hstep, voffB); PG8_STAGE(PG8_SA(0, 1), cA + hstep, voffA);
        if (wr == 1) PG8_BAR;
        PG8_WAIT_V(4); PG8_BAR;
        PG8_STAGE(PG8_SB(1, 0), cB + kstep, voffB); PG8_STAGE(PG8_SA(1, 0), cA + kstep, voffA); PG8_STAGE(PG8_SB(1, 1), cB + hstep + kstep, voffB);
        PG8_WAIT_V(6); PG8_BAR;
    }
    for (;;) {
        const bool has_next = S.next(ui + 1, nxt);
        const char* nA = has_next ? (const char*)g.A + (size_t)nxt.pm * tstep : cA; const char* nB = has_next ? (const char*)g.Bt + (size_t)nxt.pn * tstep : cB;
        for (int t = 0; t < nt; t += 2) {
            const bool last = (t == nt - 2);
            const char* a1 = cA + (size_t)(t + 1) * kstep;
            const char* a2 = last ? nA : cA + (size_t)(t + 2) * kstep; const char* b2 = last ? nB : cB + (size_t)(t + 2) * kstep;
            const char* a3 = a2 + kstep; const char* b3 = b2 + kstep;
            if (last && has_next) S.a_ready(nxt);
            if constexpr (SP2) {
            PG8_LDB(B0, 0, 0); PG8_LDB(B1, 0, 1); PG8_SCHED; PG8_LDA(At, 0, 0); PG8_STAGE(PG8_SA(1, 1), a1 + hstep, voffA);
            PG8_WAIT_V(8); PG8_WAIT_L(0); PG8_BAR; PG8_MMA(0, 0, At, B0); PG8_MMA(0, 1, At, B1); PG8_BAR; PG8_SCHED;
            PG8_LDA(At, 0, 1); PG8_STAGE(PG8_SB(0, 0), b2, voffB); PG8_STAGE(PG8_SB(0, 1), b2 + hstep, voffB); PG8_STAGE(PG8_SA(0, 0), a2, voffA);
            PG8_WAIT_V(8); PG8_WAIT_L(0); PG8_BAR; PG8_MMA(1, 0, At, B0); PG8_MMA(1, 1, At, B1); PG8_BAR; PG8_SCHED;
            PG8_LDB(B0, 1, 0); PG8_LDB(B1, 1, 1); PG8_SCHED; PG8_LDA(At, 1, 0); PG8_STAGE(PG8_SA(0, 1), a2 + hstep, voffA);
            PG8_WAIT_V(8); PG8_WAIT_L(0); PG8_BAR; PG8_MMA(0, 0, At, B0); PG8_MMA(0, 1, At, B1); PG8_BAR; PG8_SCHED;
            PG8_LDA(At, 1, 1); PG8_STAGE(PG8_SB(1, 0), b3, voffB); PG8_STAGE(PG8_SB(1, 1), b3 + hstep, voffB); PG8_STAGE(PG8_SA(1, 0), a3, voffA);
            PG8_WAIT_V(8); PG8_WAIT_L(0); PG8_BAR; PG8_MMA(1, 0, At, B0); PG8_MMA(1, 1, At, B1); PG8_BAR; PG8_SCHED;
            } else {
            PG8_LDB(B0, 0, 0); PG8_SCHED; PG8_LDA(At, 0, 0); PG8_STAGE(PG8_SA(1, 1), a1 + hstep, voffA);
            PG8_WAIT_L(8); PG8_BAR; PG8_WAIT_L(0); PG8_MMA(0, 0, At, B0); PG8_BAR; PG8_SCHED;
            PG8_LDB(B1, 0, 1); PG8_STAGE(PG8_SB(0, 0), b2, voffB);
            PG8_BAR; PG8_WAIT_L(0); PG8_MMA(0, 1, At, B1); PG8_BAR;
            PG8_LDA(At, 0, 1); PG8_STAGE(PG8_SA(0, 0), a2, voffA);
            PG8_BAR; PG8_WAIT_L(0); PG8_MMA(1, 0, At, B0); PG8_BAR; PG8_SCHED;
            PG8_STAGE(PG8_SB(0, 1), b2 + hstep, voffB);
            PG8_WAIT_V(6); PG8_BAR; PG8_MMA(1, 1, At, B1); PG8_BAR;
            PG8_LDB(B0, 1, 0); PG8_SCHED; PG8_LDA(At, 1, 0); PG8_STAGE(PG8_SA(0, 1), a2 + hstep, voffA);
            PG8_WAIT_L(8); PG8_BAR; PG8_WAIT_L(0); PG8_MMA(0, 0, At, B0); PG8_BAR; PG8_SCHED;
            PG8_LDB(B1, 1, 1); PG8_STAGE(PG8_SB(1, 0), b3, voffB);
            PG8_BAR; PG8_WAIT_L(0); PG8_MMA(0, 1, At, B1); PG8_BAR;
            PG8_LDA(At, 1, 1); PG8_STAGE(PG8_SA(1, 0), a3, voffA);
            PG8_BAR; PG8_WAIT_L(0); PG8_MMA(1, 0, At, B0); PG8_BAR; PG8_SCHED;
            PG8_STAGE(PG8_SB(1, 1), b3 + hstep, voffB);
            PG8_WAIT_V(6); PG8_BAR; PG8_MMA(1, 1, At, B1); PG8_BAR;
            }
        }
        if constexpr (ALIGN_EPI) { if (wr == 0) PG8_BAR; }
        if constexpr (!Epi::AFTER_DRAIN) { E(acc, cur, wr, wc, fr, fq); S.done(cur); }
        if (!has_next) break;
#pragma unroll
        for (int a = 0; a < 2; ++a)
#pragma unroll
            for (int b = 0; b < 2; ++b)
#pragma unroll
                for (int m = 0; m < 4; ++m)
#pragma unroll
                    for (int n = 0; n < 2; ++n) acc[a][b][m][n] = (f32x4){0.f, 0.f, 0.f, 0.f};
        cur = nxt; cA = nA; cB = nB; ++ui;
        if constexpr (ALIGN_EPI) { if (wr == 1) PG8_BAR; }
    }
    PG8_WAIT_V(0);
    if constexpr (!ALIGN_EPI) { if (wr == 0) PG8_BAR; }
    PG8_BAR;
    if constexpr (Epi::AFTER_DRAIN) { E.fused(acc, cur, wr, wc, fr, fq, lds, wid, lane); S.done(cur); }
#undef PG8_SA
#undef PG8_SB
#undef PG8_STAGE
#undef PG8_LDA
#undef PG8_LDB
#undef PG8_MMA
#undef PG8_WAIT_V
#undef PG8_WAIT_L
#undef PG8_BAR
#undef PG8_SCHED
}

struct MUnit { int r0, rend, e, pn; };
#define MG_LANE_OFFS(u, o) do { const int _t = wid * 64 + fresh_lane(); _Pragma("unroll") for (int _i = 0; _i < 2; ++_i) { int _R, _C; stage_rc(_t * 16 + _i * 8192, _R, _C); _Pragma("unroll") for (int _h = 0; _h < 2; ++_h) { const int _r = (u).r0 + _h * HALF + _R; \
        int _row = _r; if (GATHER) { _row = 0; if (_r < (u).rend) _row = slot_tok[_r]; } (o)[_h][_i] = (unsigned)(_row * K + _C) * 2u; } } } while (0)
template <class Epi, class Sched, bool GATHER, int N, int K>
__device__ __forceinline__ void gemm_phase_moe(PG8_LAS unsigned char* lds, const bf16_t* A, const bf16_t* Bt, const int* slot_tok, const Sched& S, const Epi& E, int wave_id) {
    asm volatile("" : "+s"(wave_id));
    const int lane = fresh_lane(), wid = wave_id, tid = wid * 64 + lane, wr = wid >> 2, wc = wid & 3, fr = lane & 15, fq = lane >> 4;
    constexpr int nt = K / BK;
#define MG_OFFP(par) ((PG8_LAS unsigned*)(lds + STAGE_BYTES + 8192) + (par) * 2048 + tid)
#define MG_VOFFB ((PG8_LAS unsigned*)(lds + STAGE_BYTES + 24576) + tid)
#pragma unroll
    for (int i = 0; i < 2; ++i) { int R, C; stage_rc(tid * 16 + i * 8192, R, C); const int Rb = Epi::PERM ? ((R & ~31) + perm32(R & 31)) : R; MG_VOFFB[i * 512] = (unsigned)(Rb * K + C) * 2u; }
    constexpr size_t kstep = (size_t)(BK * 2);
    constexpr size_t hstep = (size_t)HALF * K * 2;
    constexpr size_t tstep = 2 * hstep;
    constexpr size_t estep = (size_t)N * K * 2;
    const unsigned ldsw = (unsigned)wid * 1024u;
    const int aoff = lds_byte(wr * 64 + fr, fq * 8), boff = lds_byte(wc * 32 + fr, fq * 8);
#define PG8_SA(b, h) (((b) * 2 + (h)) * HTB)
#define PG8_SB(b, h) ((4 + (b) * 2 + (h)) * HTB)
#define PG8_STAGE(bufoff, gbase, voff) do { _Pragma("unroll") for (int _i = 0; _i < 2; ++_i) \
        __builtin_amdgcn_global_load_lds((const unsigned*)((const char*)(gbase) + MG_VOFFB[_i * 512]), (PG8_LAS unsigned*)(lds + (bufoff) + ldsw + _i * 8192), 16, 0, 0); } while (0)
#define MG_STAGE_A(bufoff, par, h, kb) do { _Pragma("unroll") for (int _i = 0; _i < 2; ++_i) \
        __builtin_amdgcn_global_load_lds((const unsigned*)((const char*)A + (size_t)MG_OFFP(par)[((h) * 2 + _i) * 512] + (kb)), (PG8_LAS unsigned*)(lds + (bufoff) + ldsw + _i * 8192), 16, 0, 0); } while (0)
#define PG8_LDA(dst, b, h) do { _Pragma("unroll") for (int m = 0; m < 4; ++m) _Pragma("unroll") for (int k = 0; k < 2; ++k) dst[m][k] = *(const PG8_LAS bf16x8*)(lds + PG8_SA(b, h) + aoff + m * 2048 + k * 1024); } while (0)
#define PG8_LDB(dst, b, h) do { _Pragma("unroll") for (int n = 0; n < 2; ++n) _Pragma("unroll") for (int k = 0; k < 2; ++k) dst[n][k] = *(const PG8_LAS bf16x8*)(lds + PG8_SB(b, h) + boff + n * 2048 + k * 1024); } while (0)
#define PG8_MMA(ai, bj, At, Bt_) do { __builtin_amdgcn_s_setprio(1); _Pragma("unroll") for (int m = 0; m < 4; ++m) _Pragma("unroll") for (int n = 0; n < 2; ++n) _Pragma("unroll") for (int k = 0; k < 2; ++k) \
        acc[ai][bj][m][n] = __builtin_amdgcn_mfma_f32_16x16x32_bf16(Bt_[n][k], At[m][k], acc[ai][bj][m][n], 0, 0, 0); __builtin_amdgcn_s_setprio(0); } while (0)
#define PG8_WAIT_V(n) asm volatile("s_waitcnt vmcnt(" #n ")" ::: "memory")
#define PG8_WAIT_L(n) asm volatile("s_waitcnt lgkmcnt(" #n ")" ::: "memory")
#define PG8_BAR __builtin_amdgcn_s_barrier()
#define PG8_SCHED __builtin_amdgcn_sched_barrier(0)
    MUnit cur, nxt; int ui = 0;
    if (!S.next(0, cur)) return;
    f32x4 acc[2][2][4][2];
#pragma unroll
    for (int a = 0; a < 2; ++a)
#pragma unroll
        for (int b = 0; b < 2; ++b)
#pragma unroll
            for (int m = 0; m < 4; ++m)
#pragma unroll
                for (int n = 0; n < 2; ++n) acc[a][b][m][n] = (f32x4){0.f, 0.f, 0.f, 0.f};
    bf16x8 At[4][2], B0[2][2], B1[2][2];
    { unsigned o_[2][2]; MG_LANE_OFFS(cur, o_); PG8_LAS unsigned* p_ = MG_OFFP(0); p_[0] = o_[0][0]; p_[512] = o_[0][1]; p_[1024] = o_[1][0]; p_[1536] = o_[1][1]; }
    const char* cB = (const char*)Bt + (size_t)cur.e * estep + (size_t)cur.pn * tstep;
    PG8_STAGE(PG8_SB(0, 0), cB, voffB); PG8_STAGE(PG8_SB(0, 1), cB + hstep, voffB); MG_STAGE_A(PG8_SA(0, 0), 0, 0, 0); MG_STAGE_A(PG8_SA(0, 1), 0, 1, 0);
    if (wr == 1) PG8_BAR;
    PG8_WAIT_V(2); PG8_BAR;
    PG8_STAGE(PG8_SB(1, 0), cB + kstep, voffB); MG_STAGE_A(PG8_SA(1, 0), 0, 0, kstep); PG8_STAGE(PG8_SB(1, 1), cB + hstep + kstep, voffB);
    PG8_WAIT_V(6); PG8_BAR;
    for (;;) {
        const bool has_next = S.next(ui + 1, nxt);
        const char* nB = cB;
        const int pc = ui & 1, pn_ = has_next ? (pc ^ 1) : pc;
        if (has_next) { unsigned on[2][2]; MG_LANE_OFFS(nxt, on); nB = (const char*)Bt + (size_t)nxt.e * estep + (size_t)nxt.pn * tstep;
            PG8_LAS unsigned* p_ = MG_OFFP(pn_); p_[0] = on[0][0]; p_[512] = on[0][1]; p_[1024] = on[1][0]; p_[1536] = on[1][1]; }
        for (int t = 0; t < nt; t += 2) {
            const bool last = (t == nt - 2);
            const size_t k1 = (size_t)(t + 1) * kstep, k2 = last ? (size_t)0 : (size_t)(t + 2) * kstep, k3 = k2 + kstep;
            const char* b2 = last ? nB : cB + (size_t)(t + 2) * kstep; const char* b3 = b2 + kstep;
            const int p2 = last ? pn_ : pc;
            PG8_LDB(B0, 0, 0); PG8_LDB(B1, 0, 1); PG8_SCHED; PG8_LDA(At, 0, 0); MG_STAGE_A(PG8_SA(1, 1), pc, 1, k1);
            PG8_WAIT_V(8); PG8_WAIT_L(0); PG8_BAR; PG8_MMA(0, 0, At, B0); PG8_MMA(0, 1, At, B1); PG8_BAR; PG8_SCHED;
            PG8_LDA(At, 0, 1); PG8_STAGE(PG8_SB(0, 0), b2, voffB); PG8_STAGE(PG8_SB(0, 1), b2 + hstep, voffB); MG_STAGE_A(PG8_SA(0, 0), p2, 0, k2);
            PG8_WAIT_V(8); PG8_WAIT_L(0); PG8_BAR; PG8_MMA(1, 0, At, B0); PG8_MMA(1, 1, At, B1); PG8_BAR; PG8_SCHED;
            PG8_LDB(B0, 1, 0); PG8_LDB(B1, 1, 1); PG8_SCHED; PG8_LDA(At, 1, 0); MG_STAGE_A(PG8_SA(0, 1), p2, 1, k2);
            PG8_WAIT_V(8); PG8_WAIT_L(0); PG8_BAR; PG8_MMA(0, 0, At, B0); PG8_MMA(0, 1, At, B1); PG8_BAR; PG8_SCHED;
            PG8_LDA(At, 1, 1); PG8_STAGE(PG8_SB(1, 0), b3, voffB); PG8_STAGE(PG8_SB(1, 1), b3 + hstep, voffB); MG_STAGE_A(PG8_SA(1, 0), p2, 0, k3);
            PG8_WAIT_V(8); PG8_WAIT_L(0); PG8_BAR; PG8_MMA(1, 0, At, B0); PG8_MMA(1, 1, At, B1); PG8_BAR; PG8_SCHED;
        }
        if (wr == 0) PG8_BAR;
        E(acc, cur, wr, wc, fr, fq);
        if (!has_next) break;
#pragma unroll
        for (int a = 0; a < 2; ++a)
#pragma unroll
            for (int b = 0; b < 2; ++b)
#pragma unroll
                for (int m = 0; m < 4; ++m)
#pragma unroll
                    for (int n = 0; n < 2; ++n) acc[a][b][m][n] = (f32x4){0.f, 0.f, 0.f, 0.f};
        cur = nxt; cB = nB; ++ui;
        if (wr == 1) PG8_BAR;
    }
    PG8_WAIT_V(0);
    PG8_BAR;
#undef PG8_SA
#undef PG8_SB
#undef PG8_STAGE
#undef MG_STAGE_A
#undef MG_OFFP
#undef MG_VOFFB
#undef PG8_LDA
#undef PG8_LDB
#undef PG8_MMA
#undef PG8_WAIT_V
#undef PG8_WAIT_L
#undef PG8_BAR
#undef PG8_SCHED
}
__device__ __forceinline__ float fast_silu(float x) { return x * __builtin_amdgcn_rcpf(1.0f + __builtin_amdgcn_exp2f(-1.4426950408889634f * x)); }
struct EpiMoeH {
    static constexpr bool PERM = true;
    bf16_t* H;
    __device__ __forceinline__ void operator()(const f32x4 (&acc)[2][2][4][2], const MUnit& u, int wr, int wc, int fr, int fq) const {
        { const int t_ = fresh_lane(); fr = t_ & 15; fq = t_ >> 4; }
        const int col0 = u.pn * 128 + wc * 32 + 8 * fq;
#pragma unroll
        for (int ai = 0; ai < 2; ++ai)
#pragma unroll
            for (int m = 0; m < 4; ++m) { const int r = u.r0 + ai * HALF + wr * 64 + m * 16 + fr;
                const f32x4 g0 = acc[ai][0][m][0], g1 = acc[ai][0][m][1], u0 = acc[ai][1][m][0], u1 = acc[ai][1][m][1];
                u32x4 w; w.x = cvt_pk_bf16(fast_silu(g0[0]) * u0[0], fast_silu(g0[1]) * u0[1]); w.y = cvt_pk_bf16(fast_silu(g0[2]) * u0[2], fast_silu(g0[3]) * u0[3]);
                w.z = cvt_pk_bf16(fast_silu(g1[0]) * u1[0], fast_silu(g1[1]) * u1[1]); w.w = cvt_pk_bf16(fast_silu(g1[2]) * u1[2], fast_silu(g1[3]) * u1[3]);
                if (r < u.rend) *(u32x4*)(H + (size_t)r * 256 + col0) = w; }
    }
};
struct EpiMoeY {
    static constexpr bool PERM = true;
    bf16_t* Y;
    __device__ __forceinline__ void operator()(const f32x4 (&acc)[2][2][4][2], const MUnit& u, int wr, int wc, int fr, int fq) const {
        { const int t_ = fresh_lane(); fr = t_ & 15; fq = t_ >> 4; }
        const int col0 = u.pn * BM + wc * 32 + 8 * fq;
#pragma unroll
        for (int ai = 0; ai < 2; ++ai)
#pragma unroll
            for (int m = 0; m < 4; ++m) { const int r = u.r0 + ai * HALF + wr * 64 + m * 16 + fr;
#pragma unroll
                for (int bj = 0; bj < 2; ++bj) { const f32x4 v0 = acc[ai][bj][m][0], v1 = acc[ai][bj][m][1];
                    u32x4 w; w.x = cvt_pk_bf16(v0[0], v0[1]); w.y = cvt_pk_bf16(v0[2], v0[3]); w.z = cvt_pk_bf16(v1[0], v1[1]); w.w = cvt_pk_bf16(v1[2], v1[3]);
                    if (r < u.rend) *(u32x4*)(Y + (size_t)r * 1024 + col0 + bj * HALF) = w; } }
    }
};
struct MoeSched {
    const PG8_LAS int* tab;
    int npn, G, c;
    __device__ __forceinline__ bool next(int i, MUnit& u) const {
        const int L = i * G + c, ntile = tab[0];
        if (L >= ntile * npn) return false;
        const int j = L / npn; u.pn = L % npn;
        u.e = __builtin_amdgcn_readfirstlane(tab[4 + 4 * j]); u.r0 = __builtin_amdgcn_readfirstlane(tab[5 + 4 * j]); u.rend = __builtin_amdgcn_readfirstlane(tab[6 + 4 * j]);
        return true;
    }
};
}

#ifndef PG8_SP2
#define PG8_SP2 true
#endif
#ifndef PG8_ALIGN
#define PG8_ALIGN true
#endif

constexpr int NWAVES = 8, NT = NWAVES * 64;
constexpr int D = 1024, NB = 2, S = 8192, T = NB * S, DEPTH = 2;
constexpr int DIN = 2832, PLD = 3072;
constexpr int C_Q = 0, C_K = 256, C_V = 512, C_G = 1024, C_GK = 1536, C_U = 1552, C_VG = 1808, C_XI = 2064, C_BG = 2320, C_CG = 2576;
constexpr int GH = 4, GC = 64, GN = S / GC;
constexpr int MH = 4, MC = 128, MN = S / MC;
constexpr int NE = 32, DE = 256;
constexpr float EPS = 1e-6f;
constexpr size_t MiB = 1u << 20;
constexpr size_t WS_CTL = 0, CTL_BYTES = 1 * MiB;
constexpr size_t WS_WIN = 1 * MiB;
constexpr size_t WS_WOUT = 13 * MiB;
constexpr size_t WS_WGU = 17 * MiB;
constexpr size_t WS_WD = 81 * MiB;
constexpr size_t WS_XN = 113 * MiB;
constexpr size_t WS_P = 145 * MiB;
constexpr size_t WS_Y = WS_P + 17 * MiB;
constexpr size_t WS_S = 241 * MiB;
constexpr size_t WS_DEC = 273 * MiB;
constexpr size_t WS_MISC = 274 * MiB;
constexpr size_t WS_WSP = WS_MISC + 524288;
constexpr size_t WS_WR = 275 * MiB;
constexpr size_t WS_BLKCNT = WS_WR + 524288;
constexpr size_t WS_END = 276 * MiB;
constexpr int CW_BAR = 4096, CW_CNT = 16384;
constexpr int RING_BYTES = 131072, LDSCTL_OFF = RING_BYTES, MISC_OFF = LDSCTL_OFF + 320, LDS_BYTES = 163840;

#define GAS __attribute__((address_space(1)))
#define LAS __attribute__((address_space(3)))
typedef unsigned short bf16;
typedef unsigned v4u __attribute__((ext_vector_type(4)));
typedef unsigned v2u __attribute__((ext_vector_type(2)));
typedef float f32x4 __attribute__((ext_vector_type(4)));
__device__ __forceinline__ unsigned f2bf(float f) { unsigned u = __builtin_bit_cast(unsigned, f); return (u + 0x7fffu + ((u >> 16) & 1u)) >> 16; }
__device__ __forceinline__ unsigned pk2(float lo, float hi) { return f2bf(lo) | (f2bf(hi) << 16); }
__device__ __forceinline__ float bf2f(unsigned v) { return __uint_as_float(v << 16); }
__device__ __forceinline__ float bflo(unsigned w) { return __uint_as_float(w << 16); }
__device__ __forceinline__ float bfhi(unsigned w) { return __uint_as_float(w & 0xffff0000u); }
__device__ __forceinline__ void unpack8(const v4u q, float (&f)[8]) { f[0] = bflo(q.x); f[1] = bfhi(q.x); f[2] = bflo(q.y); f[3] = bfhi(q.y); f[4] = bflo(q.z); f[5] = bfhi(q.z); f[6] = bflo(q.w); f[7] = bfhi(q.w); }
__device__ __forceinline__ float gelu_tanh(float x) { const float u = 0.7978845608028654f * (x + 0.044715f * x * x * x); return 0.5f * x * (1.0f + tanhf(u)); }
__device__ __forceinline__ float silu(float x) { return x / (1.0f + expf(-x)); }
__device__ __forceinline__ float log_sigmoid(float x) { return fminf(x, 0.f) - log1pf(expf(-fabsf(x))); }

#define XB_TMO      128
#define XB_XCNT(j)  (256  + 64 * (j))
#define XB_XSUB(j)  (1280 + 64 * (j))
#define XB_XGEN(j)  (2304 + 64 * (j))
#define XB_TOP      3328
#define XB_TOPGEN   3392
#define XCD_BAR_WORDS 3456
#define XB_SPIN_CAP (1u << 18)

__device__ __forceinline__ unsigned xb_ld(unsigned* p)              { return __hip_atomic_load(p, __ATOMIC_RELAXED, __HIP_MEMORY_SCOPE_AGENT); }
__device__ __forceinline__ unsigned xb_add(unsigned* p, unsigned v) { return __hip_atomic_fetch_add(p, v, __ATOMIC_RELAXED, __HIP_MEMORY_SCOPE_AGENT); }
__device__ __forceinline__ unsigned xb_xcc_id() { return (unsigned)__builtin_amdgcn_s_getreg((3 << 11) | 20) & 0xFu; }
#define XB_SPIN(cond, bar) do { unsigned _sp = 0; while (cond) { __builtin_amdgcn_s_sleep(1); \
    if ((++_sp & 255u) == 0u) { if (xb_ld(&(bar)[XB_TMO])) break; if (_sp > XB_SPIN_CAP) { atomicAdd(&(bar)[XB_TMO], 1u); break; } } } } while (0)

struct XcdBarrier {
    int wave;
    unsigned* bar; unsigned x;
    volatile LAS unsigned* st;
};

__device__ __forceinline__ XcdBarrier xcd_barrier_post(unsigned* bar, volatile LAS unsigned* st) {
    XcdBarrier b; b.bar = bar; b.x = xb_xcc_id(); b.st = st; b.wave = __builtin_amdgcn_readfirstlane(threadIdx.x >> 6);
    if (threadIdx.x == 0) (void)xb_add(&bar[XB_XCNT(b.x)], 1u);
    return b;
}
__device__ __forceinline__ void xcd_barrier_complete(unsigned* bar, unsigned x, unsigned& nloc, unsigned& nx) {
    const unsigned G = gridDim.x * gridDim.y * gridDim.z;
    unsigned sum, cnt, mine, sp = 0u;
    for (;;) {
        sum = 0u; cnt = 0u; mine = 0u;
#pragma unroll
        for (unsigned j = 0; j < 16; ++j) { const unsigned c = xb_ld(&bar[XB_XCNT(j)]); sum += c; cnt += (c > 0u) ? 1u : 0u; mine = (j == x) ? c : mine; }
        if (sum == G) break;
        __builtin_amdgcn_s_sleep(1);
        if ((++sp & 255u) == 0u) { if (xb_ld(&bar[XB_TMO])) break; if (sp > XB_SPIN_CAP) { atomicAdd(&bar[XB_TMO], 1u); break; } }
    }
    nloc = mine > 0u ? mine : 1u; nx = cnt > 0u ? cnt : 1u;
}

__device__ __forceinline__ void xcd_barrier(const XcdBarrier& b) {
    asm volatile("s_waitcnt vmcnt(0)" ::: "memory");
    __syncthreads();
    if (b.wave == 0 && fresh_lane() == 0) {
        unsigned* bar = b.bar; asm volatile("" : "+s"(bar));
        __builtin_amdgcn_s_waitcnt(0);
        unsigned nloc = b.st[0], nx = b.st[1];
        if (nloc == 0u) { xcd_barrier_complete(bar, b.x, nloc, nx); b.st[0] = nloc; b.st[1] = nx; }
        const unsigned old = xb_add(&bar[XB_XSUB(b.x)], 1u);
        const unsigned gen = old / nloc;
        if (old + 1u == (gen + 1u) * nloc) {
            __builtin_amdgcn_fence(__ATOMIC_RELEASE, "agent");
            asm volatile("s_waitcnt vmcnt(0)" ::: "memory");
            const unsigned og = xb_add(&bar[XB_TOP], 1u);
            const unsigned tg = og / nx;
            if (og + 1u == (tg + 1u) * nx) xb_add(&bar[XB_TOPGEN], 1u);
            else XB_SPIN(xb_ld(&bar[XB_TOPGEN]) == tg, bar);
            __builtin_amdgcn_fence(__ATOMIC_ACQUIRE, "agent");
            xb_add(&bar[XB_XGEN(b.x)], 1u);
            asm volatile("s_waitcnt vmcnt(0)" ::: "memory");
        } else {
            XB_SPIN(xb_ld(&bar[XB_XGEN(b.x)]) == gen, bar);
            __builtin_amdgcn_fence(__ATOMIC_ACQUIRE, "agent");
            asm volatile("s_waitcnt vmcnt(0)" ::: "memory");
        }
    }
    __syncthreads();
}

#define AS4 __attribute__((address_space(4)))
struct KA {
    const AS4 char* ka;
    static __device__ __forceinline__ KA fresh() { KA k; k.ka = (const AS4 char*)__builtin_amdgcn_kernarg_segment_ptr(); asm volatile("" : "+s"(k.ka)); return k; }
    __device__ __forceinline__ const float* in(int i) const { return *(const float* const AS4*)(ka + 8 * i); }
    __device__ __forceinline__ float* out() const { return *(float* const AS4*)(ka + 160); }
    __device__ __forceinline__ unsigned char* ws() const { return *(unsigned char* const AS4*)(ka + 168); }
    __device__ __forceinline__ unsigned* ctl() const { return (unsigned*)(ws() + WS_CTL); }
    __device__ __forceinline__ bf16* WinT() const { return (bf16*)(ws() + WS_WIN); }
    __device__ __forceinline__ bf16* WoutT() const { return (bf16*)(ws() + WS_WOUT); }
    __device__ __forceinline__ bf16* WguT() const { return (bf16*)(ws() + WS_WGU); }
    __device__ __forceinline__ bf16* WdT() const { return (bf16*)(ws() + WS_WD); }
    __device__ __forceinline__ bf16* XN() const { return (bf16*)(ws() + WS_XN); }
    __device__ __forceinline__ bf16* P() const { return (bf16*)(ws() + WS_P); }
    __device__ __forceinline__ bf16* H1() const { return (bf16*)(ws() + WS_P); }
    __device__ __forceinline__ bf16* Y() const { return (bf16*)(ws() + WS_Y); }
    __device__ __forceinline__ float* Sst() const { return (float*)(ws() + WS_S); }
    __device__ __forceinline__ float* dec() const { return (float*)(ws() + WS_DEC); }
    __device__ __forceinline__ int* eid() const { return (int*)(ws() + WS_MISC); }
    __device__ __forceinline__ float* ew() const { return (float*)(ws() + WS_MISC + 131072); }
    __device__ __forceinline__ int* slot_tok() const { return (int*)(ws() + WS_MISC + 2 * 131072); }
    __device__ __forceinline__ int* slot_of() const { return (int*)(ws() + WS_MISC + 3 * 131072); }
    __device__ __forceinline__ bf16* Wsp() const { return (bf16*)(ws() + WS_WSP); }
    __device__ __forceinline__ bf16* Wr() const { return (bf16*)(ws() + WS_WR); }
    __device__ __forceinline__ int* blkcnt() const { return (int*)(ws() + WS_BLKCNT); }
};
struct Frame {
    LAS unsigned char* lds; float* smem;
    int G, bx, wave;
};
#define PHASE_TID const int lane = fresh_lane(), wave = F.wave, tid = wave * 64 + lane; (void)lane; (void)wave; (void)tid

__device__ __forceinline__ float wave_sum(float v) {
    const int ln = fresh_lane();
#pragma unroll
    for (int o = 1; o < 64; o <<= 1) v += __int_as_float(__builtin_amdgcn_ds_bpermute((ln ^ o) << 2, __float_as_int(v)));
    return v;
}

__device__ __forceinline__ void transpose_item(const float* W, int ldw, int nvalid, int k0, int n0, bf16* WT, int ldt, int drow0, LAS float* scr, int lane) {
    const int nl = lane & 31;
#pragma unroll 8
    for (int i = 0; i < 32; ++i) { const int kk = 2 * i + (lane >> 5); scr[kk * 33 + nl] = (nl < nvalid) ? W[(size_t)(k0 + kk) * ldw + n0 + nl] : 0.f; }
    asm volatile("s_waitcnt lgkmcnt(0)" ::: "memory");
    const int c = lane & 7;
#pragma unroll
    for (int j = 0; j < 4; ++j) { const int n = (lane >> 3) + 8 * j; const LAS float* s = scr + (8 * c) * 33 + n;
        v4u o; o.x = pk2(s[0 * 33], s[1 * 33]); o.y = pk2(s[2 * 33], s[3 * 33]); o.z = pk2(s[4 * 33], s[5 * 33]); o.w = pk2(s[6 * 33], s[7 * 33]);
        if (n < nvalid) *(GAS v4u*)(WT + (size_t)(drow0 + n) * ldt + k0 + 8 * c) = o; }
    asm volatile("s_waitcnt lgkmcnt(0)" ::: "memory");
}
__device__ __forceinline__ void rms_row_to_bf16(const float* xrow, const float* gain, bf16* orow, int lane) {
    const f32x4* xr = (const f32x4*)xrow + lane;
    f32x4 v[4]; float s = 0.f;
#pragma unroll
    for (int j = 0; j < 4; ++j) { v[j] = xr[64 * j]; s += (v[j].x * v[j].x + v[j].y * v[j].y) + (v[j].z * v[j].z + v[j].w * v[j].w); }
    const float rs = rsqrtf(wave_sum(s) * (1.f / D) + EPS);
    v2u* o8 = (v2u*)orow + lane;
#pragma unroll
    for (int j = 0; j < 4; ++j) { const f32x4 g = ((const f32x4*)gain)[lane + 64 * j]; v2u w; w.x = pk2(v[j].x * rs * g.x, v[j].y * rs * g.y); w.y = pk2(v[j].z * rs * g.z, v[j].w * rs * g.w); o8[64 * j] = w; }
}
__device__ __forceinline__ void p0_prologue(Frame& F) {
    const KA K = KA::fresh(); PHASE_TID;
    LAS float* scr = (LAS float*)(F.lds + wave * 16384);
    const int gw = F.bx * NWAVES + wave, NGW = F.G * NWAVES;
    constexpr int I_IN = 16 * 89, I_OUT = 16 * 32, I_G = 32 * 16 * 8, I_D = 32 * 4 * 32, I_L = I_IN + I_OUT + 2 * I_G + I_D;
    for (int it = gw; it < DEPTH * I_L; it += NGW) {
        const int l = it / I_L; int r = it % I_L;
        if (r < I_IN) { const int kb = r / 89, nb = r % 89; const int nv = (nb == 88) ? 16 : 32;
            transpose_item(K.in(2) + (size_t)l * D * DIN, DIN, nv, kb * 64, nb * 32, K.WinT() + (size_t)l * PLD * D, D, nb * 32, scr, lane); continue; }
        r -= I_IN;
        if (r < I_OUT) { const int kb = r / 32, nb = r % 32;
            transpose_item(K.in(10) + (size_t)l * D * D, D, 32, kb * 64, nb * 32, K.WoutT() + (size_t)l * D * D, D, nb * 32, scr, lane); continue; }
        r -= I_OUT;
        if (r < 2 * I_G) { const int sel = r / I_G; r %= I_G; const int e = r / 128, kb = (r % 128) / 8, nb = r % 8; const int n0 = nb * 32;
            const float* W = K.in(16 + sel) + ((size_t)l * NE + e) * D * DE;
            transpose_item(W, DE, 32, kb * 64, n0, K.WguT() + ((size_t)l * NE + e) * 512 * D, D, (n0 >> 7) * 256 + sel * 128 + (n0 & 127), scr, lane); continue; }
        r -= 2 * I_G;
        { const int e = r / 128, kb = (r % 128) / 32, nb = r % 32;
            transpose_item(K.in(18) + ((size_t)l * NE + e) * DE * D, D, 32, kb * 64, nb * 32, K.WdT() + ((size_t)l * NE + e) * D * DE, DE, nb * 32, scr, lane); }
    }
    for (int i = F.bx * NT + tid; i < DEPTH * 240 * 128; i += F.G * NT) { const int l = i / (240 * 128), rr = (i / 128) % 240, c = i % 128;
        *(GAS v4u*)(K.WinT() + ((size_t)l * PLD + DIN + rr) * D + c * 8) = (v4u){0u, 0u, 0u, 0u}; }
    for (int i = F.bx * NT + tid; i < DEPTH * 48 * D; i += F.G * NT) { const int ll = i / (48 * D), n = (i / D) % 48, k = i % D;
        float w = 0.f;
        if (n < 4) w = K.in(12)[((size_t)ll * D + k) * 4 + n]; else if (n < 36) w = K.in(14)[((size_t)ll * D + k) * 32 + (n - 4)];
        w *= K.in(11)[(size_t)ll * D + k];
        const unsigned hi = f2bf(w), lo = f2bf(w - bf2f(hi));
        K.Wr()[((size_t)ll * 2 + 0) * 48 * D + (size_t)n * D + k] = (bf16)hi; K.Wr()[((size_t)ll * 2 + 1) * 48 * D + (size_t)n * D + k] = (bf16)lo; }
    for (int i = F.bx * NT + tid; i < DEPTH * MH * 128 * 128 / 8; i += F.G * NT) { const int e0 = i * 8, s0 = e0 & 127, t = (e0 >> 7) & 127;
        const f32x4 a = *(const f32x4*)(K.in(7) + e0), c = *(const f32x4*)(K.in(7) + e0 + 4);
        const float v[8] = {a.x, a.y, a.z, a.w, c.x, c.y, c.z, c.w}; unsigned w[4];
#pragma unroll
        for (int j = 0; j < 4; ++j) w[j] = pk2((s0 + 2 * j <= t) ? v[2 * j] : 0.f, (s0 + 2 * j + 1 <= t) ? v[2 * j + 1] : 0.f);
        *(GAS v4u*)(K.Wsp() + e0) = (v4u){w[0], w[1], w[2], w[3]}; }
    for (int m = gw; m < T; m += NGW) rms_row_to_bf16(K.in(0) + (size_t)m * D, K.in(1), K.XN() + (size_t)m * D, lane);
}

__device__ __forceinline__ void gla_cumdecay(Frame& F, const KA& K, int tid, int l, int h, int t0, float* bb) {
    const float* wup = K.in(3) + (size_t)l * 16 * 256; const float* bgk = K.in(4) + (size_t)l * 256;
    for (int e = tid; e < 64 * 64; e += NT) {
        const int c = e >> 6, d = e & 63;
        const bf16* gl = K.P() + (size_t)(t0 + c) * PLD + C_GK;
        float a = bgk[h * 64 + d];
#pragma unroll
        for (int r = 0; r < 16; ++r) a += bf2f(gl[r]) * wup[r * 256 + h * 64 + d];
        bb[c * 64 + d] = log_sigmoid(a) * (1.0f / 16.0f);
    }
    __syncthreads();
    if (tid < 64) { float run = 0.f; for (int c = 0; c < 64; ++c) { run += bb[c * 64 + tid]; bb[c * 64 + tid] = run; } }
    __syncthreads();
}
__device__ __forceinline__ void phase_gla_kv(Frame& F, int l) {
    const KA K = KA::fresh(); PHASE_TID;
    float* bb = F.smem; float* kd = F.smem + 4096;
#pragma unroll 1
    for (int ci = F.bx; ci < NB * GH * GN; ci += F.G) {
        const int b = ci / (GH * GN), h = (ci / GN) % GH, n = ci % GN, t0 = b * S + n * GC;
        __syncthreads();
        gla_cumdecay(F, K, tid, l, h, t0, bb);
        for (int e = tid; e < 4096; e += NT) { const int c = e >> 6, d = e & 63; kd[e] = bf2f(K.P()[(size_t)(t0 + c) * PLD + C_K + h * 64 + d]) * expf(bb[63 * 64 + d] - bb[e]); }
        __syncthreads();
        const int d = tid >> 3, v0 = (tid & 7) * 16;
        float acc[16];
#pragma unroll
        for (int j = 0; j < 16; ++j) acc[j] = 0.f;
#pragma unroll 2
        for (int c = 0; c < 64; ++c) {
            const float kk = kd[c * 64 + d];
            const v4u* vr = (const v4u*)(K.P() + (size_t)(t0 + c) * PLD + C_V + h * 128 + v0);
            float f[8]; unpack8(vr[0], f);
#pragma unroll
            for (int j = 0; j < 8; ++j) acc[j] += kk * f[j];
            unpack8(vr[1], f);
#pragma unroll
            for (int j = 0; j < 8; ++j) acc[8 + j] += kk * f[j];
        }
        f32x4* o = (f32x4*)(K.Sst() + ((size_t)ci * 64 + d) * 128 + v0);
#pragma unroll
        for (int j = 0; j < 4; ++j) o[j] = (f32x4){acc[4 * j], acc[4 * j + 1], acc[4 * j + 2], acc[4 * j + 3]};
        if (tid < 64) K.dec()[(size_t)ci * 64 + tid] = expf(bb[63 * 64 + tid]);
    }
}
__device__ __forceinline__ void phase_gla_scan(Frame& F) {
    const KA K = KA::fresh(); PHASE_TID;
#pragma unroll 1
    for (int e = F.bx * NT + tid; e < NB * GH * 64 * 128; e += F.G * NT) {
        const int bh = e >> 13, d = (e >> 7) & 63, v = e & 127;
        float* base = K.Sst() + ((size_t)bh * GN * 64 + d) * 128 + v; const float* db = K.dec() + (size_t)bh * GN * 64 + d;
        float st = 0.f;
#pragma unroll 1
        for (int n0 = 0; n0 < GN; n0 += 16) {
            float kvv[16], dd[16];
#pragma unroll
            for (int j = 0; j < 16; ++j) { kvv[j] = base[(size_t)(n0 + j) * 8192]; dd[j] = db[(n0 + j) * 64]; }
#pragma unroll
            for (int j = 0; j < 16; ++j) { base[(size_t)(n0 + j) * 8192] = st; st = dd[j] * st + kvv[j]; }
        }
    }
}
__device__ __forceinline__ void phase_gla_out(Frame& F, int l) {
    const KA K = KA::fresh(); PHASE_TID;
    float* bb = F.smem; float* qd = F.smem + 4096; float* ki = F.smem + 4096 + 64 * 65; float* sc = bb;
    const float* gnorm = K.in(5) + (size_t)l * 128;
#pragma unroll 1
    for (int ci = F.bx; ci < NB * GH * GN; ci += F.G) {
        const int b = ci / (GH * GN), h = (ci / GN) % GH, n = ci % GN, t0 = b * S + n * GC;
        __syncthreads();
        gla_cumdecay(F, K, tid, l, h, t0, bb);
        for (int e = tid; e < 4096; e += NT) {
            const int c = e >> 6, d = e & 63; const float bv = bb[e];
            const bf16* row = K.P() + (size_t)(t0 + c) * PLD;
            qd[c * 65 + d] = bf2f(row[C_Q + h * 64 + d]) * 0.125f * expf(bv);
            ki[c * 65 + d] = bf2f(row[C_K + h * 64 + d]) * expf(-bv);
        }
        __syncthreads();
        {
            const int c = tid >> 3, s0 = (tid & 7) * 8;
            float a[8];
#pragma unroll
            for (int j = 0; j < 8; ++j) a[j] = 0.f;
#pragma unroll 4
            for (int d = 0; d < 64; ++d) { const float qv = qd[c * 65 + d];
#pragma unroll
                for (int j = 0; j < 8; ++j) a[j] += qv * ki[(s0 + j) * 65 + d]; }
#pragma unroll
            for (int j = 0; j < 8; ++j) sc[c * 64 + s0 + j] = (s0 + j <= c) ? a[j] : 0.f;
        }
        __syncthreads();
        const int c = tid >> 3, v0 = (tid & 7) * 16;
        float acc[16];
#pragma unroll
        for (int j = 0; j < 16; ++j) acc[j] = 0.f;
#pragma unroll 2
        for (int s = 0; s <= c; ++s) {
            const float w = sc[c * 64 + s];
            const v4u* vr = (const v4u*)(K.P() + (size_t)(t0 + s) * PLD + C_V + h * 128 + v0);
            float f[8]; unpack8(vr[0], f);
#pragma unroll
            for (int j = 0; j < 8; ++j) acc[j] += w * f[j];
            unpack8(vr[1], f);
#pragma unroll
            for (int j = 0; j < 8; ++j) acc[8 + j] += w * f[j];
        }
#pragma unroll 2
        for (int d = 0; d < 64; ++d) {
            const float w = qd[c * 65 + d];
            const f32x4* sr = (const f32x4*)(K.Sst() + ((size_t)ci * 64 + d) * 128 + v0);
#pragma unroll
            for (int j = 0; j < 4; ++j) { const f32x4 v4 = sr[j]; acc[4 * j] += w * v4.x; acc[4 * j + 1] += w * v4.y; acc[4 * j + 2] += w * v4.z; acc[4 * j + 3] += w * v4.w; }
        }
        float ss = 0.f;
#pragma unroll
        for (int j = 0; j < 16; ++j) ss += acc[j] * acc[j];
        ss += shx(ss, 1); ss += shx(ss, 2); ss += shx(ss, 4);
        const float rs = rsqrtf(ss * (1.0f / 128.0f) + EPS);
        const v4u* gr = (const v4u*)(K.P() + (size_t)(t0 + c) * PLD + C_G + h * 128 + v0);
        float g0[8], g1[8]; unpack8(gr[0], g0); unpack8(gr[1], g1);
        float o[16];
#pragma unroll
        for (int j = 0; j < 8; ++j) { o[j] = acc[j] * rs * gnorm[v0 + j] * silu(g0[j]); o[8 + j] = acc[8 + j] * rs * gnorm[v0 + 8 + j] * silu(g1[j]); }
        v4u* op = (v4u*)(K.XN() + (size_t)(t0 + c) * D + h * 128 + v0);
        op[0] = (v4u){pk2(o[0], o[1]), pk2(o[2], o[3]), pk2(o[4], o[5]), pk2(o[6], o[7])};
        op[1] = (v4u){pk2(o[8], o[9]), pk2(o[10], o[11]), pk2(o[12], o[13]), pk2(o[14], o[15])};
    }
}
__device__ __forceinline__ void phase_gmlp(Frame& F, int l) {
    const KA K = KA::fresh(); PHASE_TID;
    float* vs = F.smem;
    const float* gn = K.in(6) + (size_t)l * 256; const float* wsp = K.in(7) + (size_t)l * MH * 128 * 128; const float* bsp = K.in(8) + (size_t)l * MH * 128;
#pragma unroll 1
    for (int u = F.bx; u < NB * MN * MH; u += F.G) {
        const int b = u / (MN * MH), n = (u / MH) % MN, h = u % MH, t0 = b * S + n * MC;
        __syncthreads();
        const int s = tid >> 2, d0 = (tid & 3) * 16;
        {
            const v4u* vr = (const v4u*)(K.P() + (size_t)(t0 + s) * PLD + C_VG + h * 64 + d0);
            float g[16]; { float f[8]; unpack8(vr[0], f);
#pragma unroll
                for (int j = 0; j < 8; ++j) g[j] = gelu_tanh(f[j]);
                unpack8(vr[1], f);
#pragma unroll
                for (int j = 0; j < 8; ++j) g[8 + j] = gelu_tanh(f[j]); }
            float ss = 0.f;
#pragma unroll
            for (int j = 0; j < 16; ++j) ss += g[j] * g[j];
            ss += shx(ss, 1); ss += shx(ss, 2);
            const float rs = rsqrtf(ss * (1.0f / 64.0f) + EPS);
#pragma unroll
            for (int j = 0; j < 16; ++j) vs[s * 64 + d0 + j] = g[j] * rs * gn[h * 64 + d0 + j];
        }
        __syncthreads();
        const int t = s;
        float acc[16];
#pragma unroll
        for (int j = 0; j < 16; ++j) acc[j] = 0.f;
        const float* wr = wsp + ((size_t)h * 128 + t) * 128;
#pragma unroll 2
        for (int s2 = 0; s2 <= t; ++s2) { const float w = wr[s2];
#pragma unroll
            for (int j = 0; j < 16; ++j) acc[j] += w * vs[s2 * 64 + d0 + j]; }
        const float bias = bsp[h * 128 + t];
        const v4u* ur = (const v4u*)(K.P() + (size_t)(t0 + t) * PLD + C_U + h * 64 + d0);
        float u0[8], u1[8]; unpack8(ur[0], u0); unpack8(ur[1], u1);
        float o[16];
#pragma unroll
        for (int j = 0; j < 8; ++j) { o[j] = gelu_tanh(u0[j]) * (acc[j] + bias); o[8 + j] = gelu_tanh(u1[j]) * (acc[8 + j] + bias); }
        v4u* op = (v4u*)(K.XN() + (size_t)(t0 + t) * D + 512 + h * 64 + d0);
        op[0] = (v4u){pk2(o[0], o[1]), pk2(o[2], o[3]), pk2(o[4], o[5]), pk2(o[6], o[7])};
        op[1] = (v4u){pk2(o[8], o[9]), pk2(o[10], o[11]), pk2(o[12], o[13]), pk2(o[14], o[15])};
    }
}
typedef short bf16x8 __attribute__((ext_vector_type(8)));
__device__ __forceinline__ float fexp(float x) { return __builtin_amdgcn_exp2f(x * 1.4426950408889634f); }
__device__ __forceinline__ float logsig_fast(float x) { return fminf(x, 0.f) - __log2f(1.0f + fexp(-fabsf(x))) * 0.6931471805599453f; }
__device__ __forceinline__ float silu_fast(float x) { return x * __builtin_amdgcn_rcpf(1.0f + __builtin_amdgcn_exp2f(-1.4426950408889634f * x)); }
__device__ __forceinline__ float gelu_fast(float x) { const float u = 0.7978845608028654f * (x + 0.044715f * x * x * x); return x * __builtin_amdgcn_rcpf(1.0f + __builtin_amdgcn_exp2f(-2.8853900817779268f * u)); }
__device__ __forceinline__ f32x4 mfma16(bf16x8 a, bf16x8 b, f32x4 c) { return __builtin_amdgcn_mfma_f32_16x16x32_bf16(a, b, c, 0, 0, 0); }
constexpr int LROWB = 144;
constexpr int L_QD = 0, L_KI = 9216, L_KDT = 18432, L_VT = 27648, L_S = 46080, L_ST = 55296, L_OB = 73728, L_TOT = 107520, OBROW = 528;
#define FRAG(base, row, kel) (*(const LAS bf16x8*)(lds + (base) + (row) * LROWB + (kel) * 2))

__device__ __forceinline__ float gla_b8(const KA& K, LAS unsigned char* lds, int l, int h, int t0, int lane, int wave, float (&bv)[8]) {
    const float* wup = K.in(3) + (size_t)l * 16 * 256 + h * 64 + lane;
    float wu[16];
#pragma unroll
    for (int r = 0; r < 16; ++r) wu[r] = wup[r * 256];
    const float bg = K.in(4)[l * 256 + h * 64 + lane];
    const bf16* P = K.P();
    float run = 0.f;
#pragma unroll
    for (int j = 0; j < 8; ++j) {
        const bf16* gl = P + (size_t)(t0 + 8 * wave + j) * PLD + C_GK;
        float f0[8], f1[8]; unpack8(*(const v4u*)gl, f0); unpack8(*(const v4u*)(gl + 8), f1);
        float a = bg;
#pragma unroll
        for (int r = 0; r < 8; ++r) a += f0[r] * wu[r];
#pragma unroll
        for (int r = 0; r < 8; ++r) a += f1[r] * wu[8 + r];
        run += logsig_fast(a) * (1.0f / 16.0f); bv[j] = run;
    }
    LAS float* tot = (LAS float*)(lds + L_TOT);
    tot[wave * 64 + lane] = run;
    __syncthreads();
    float base = 0.f, all = 0.f;
#pragma unroll
    for (int g = 0; g < 8; ++g) { const float tv = tot[g * 64 + lane]; all += tv; if (g < wave) base += tv; }
#pragma unroll
    for (int j = 0; j < 8; ++j) bv[j] += base;
    return all;
}
__device__ __forceinline__ void gla_stage_vT(const bf16* P, LAS unsigned char* lds, int h, int t0, int tid) {
    const int vv = tid & 127, cq = tid >> 7;
    const bf16* vp = P + (size_t)(t0 + 16 * cq) * PLD + C_V + h * 128 + vv;
    unsigned w[8];
#pragma unroll
    for (int j = 0; j < 8; ++j) w[j] = (unsigned)vp[(size_t)(2 * j) * PLD] | ((unsigned)vp[(size_t)(2 * j + 1) * PLD] << 16);
    LAS v4u* dst = (LAS v4u*)(lds + L_VT + vv * LROWB + cq * 32);
    dst[0] = (v4u){w[0], w[1], w[2], w[3]}; dst[1] = (v4u){w[4], w[5], w[6], w[7]};
}

__device__ __forceinline__ void phase_gla_kv_mfma(Frame& F, int l) {
    const KA K = KA::fresh(); PHASE_TID;
    LAS unsigned char* lds = F.lds;
    const int fr = lane & 15, fq = lane >> 4;
#pragma unroll 1
    for (int ci = F.bx; ci < NB * GH * GN; ci += F.G) {
        const int b = ci / (GH * GN), h = (ci / GN) % GH, n = ci % GN, t0 = b * S + n * GC;
        const bf16* P = K.P();
        __syncthreads();
        float bv[8]; const float bl = gla_b8(K, lds, l, h, t0, lane, wave, bv);
        {
            const bf16* kp = P + (size_t)(t0 + 8 * wave) * PLD + C_K + h * 64 + lane;
            float kd[8];
#pragma unroll
            for (int j = 0; j < 8; ++j) kd[j] = bf2f(kp[(size_t)j * PLD]) * fexp(bl - bv[j]);
            *(LAS v4u*)(lds + L_KDT + lane * LROWB + wave * 16) = (v4u){pk2(kd[0], kd[1]), pk2(kd[2], kd[3]), pk2(kd[4], kd[5]), pk2(kd[6], kd[7])};
        }
        gla_stage_vT(P, lds, h, t0, tid);
        if (wave == 0) K.dec()[(size_t)ci * 64 + lane] = fexp(bl);
        __syncthreads();
        bf16x8 Bf[2];
#pragma unroll
        for (int ks = 0; ks < 2; ++ks) Bf[ks] = FRAG(L_VT, 16 * wave + fr, 32 * ks + 8 * fq);
        float* so = K.Sst() + (size_t)ci * 64 * 128 + 16 * wave + fr;
#pragma unroll
        for (int dt = 0; dt < 4; ++dt) {
            f32x4 acc = (f32x4){0.f, 0.f, 0.f, 0.f};
#pragma unroll
            for (int ks = 0; ks < 2; ++ks) acc = mfma16(FRAG(L_KDT, 16 * dt + fr, 32 * ks + 8 * fq), Bf[ks], acc);
#pragma unroll
            for (int r = 0; r < 4; ++r) so[(size_t)(16 * dt + 4 * fq + r) * 128] = acc[r];
        }
    }
}

__device__ __forceinline__ void phase_gla_out_mfma(Frame& F, int l) {
    const KA K = KA::fresh(); PHASE_TID;
    LAS unsigned char* lds = F.lds;
    const int fr = lane & 15, fq = lane >> 4;
    const float* gnorm = K.in(5) + (size_t)l * 128;
#pragma unroll 1
    for (int ci = F.bx; ci < NB * GH * GN; ci += F.G) {
        const int b = ci / (GH * GN), h = (ci / GN) % GH, n = ci % GN, t0 = b * S + n * GC;
        const bf16* P = K.P();
        __syncthreads();
        float bv[8]; (void)gla_b8(K, lds, l, h, t0, lane, wave, bv);
        {
            const bf16* qp = P + (size_t)(t0 + 8 * wave) * PLD + C_Q + h * 64 + lane;
            const bf16* kp = qp + (C_K - C_Q);
#pragma unroll
            for (int j = 0; j < 8; ++j) {
                const float e = fexp(bv[j]);
                const float qv = bf2f(qp[(size_t)j * PLD]) * 0.125f * e, kv = bf2f(kp[(size_t)j * PLD]) * __builtin_amdgcn_rcpf(e);
                *(LAS bf16*)(lds + L_QD + (8 * wave + j) * LROWB + lane * 2) = (bf16)f2bf(qv);
                *(LAS bf16*)(lds + L_KI + (8 * wave + j) * LROWB + lane * 2) = (bf16)f2bf(kv);
            }
        }
        gla_stage_vT(P, lds, h, t0, tid);
        {
            const int vv = tid & 127, dq = tid >> 7;
            const float* sp = K.Sst() + ((size_t)ci * 64 + 16 * dq) * 128 + vv;
            unsigned w[8];
#pragma unroll
            for (int j = 0; j < 8; ++j) w[j] = pk2(sp[(size_t)(2 * j) * 128], sp[(size_t)(2 * j + 1) * 128]);
            LAS v4u* dst = (LAS v4u*)(lds + L_ST + vv * LROWB + dq * 32);
            dst[0] = (v4u){w[0], w[1], w[2], w[3]}; dst[1] = (v4u){w[4], w[5], w[6], w[7]};
        }
        __syncthreads();
#pragma unroll
        for (int i = 0; i < 2; ++i) {
            const int tix = 2 * wave + i, st = tix >> 2, ct = tix & 3;
            f32x4 acc = (f32x4){0.f, 0.f, 0.f, 0.f};
#pragma unroll
            for (int ks = 0; ks < 2; ++ks) acc = mfma16(FRAG(L_KI, 16 * st + fr, 32 * ks + 8 * fq), FRAG(L_QD, 16 * ct + fr, 32 * ks + 8 * fq), acc);
            const int s0 = 16 * st + 4 * fq, c = 16 * ct + fr;
            float m[4];
#pragma unroll
            for (int r = 0; r < 4; ++r) m[r] = (s0 + r <= c) ? acc[r] : 0.f;
            *(LAS v2u*)(lds + L_S + c * LROWB + s0 * 2) = (v2u){pk2(m[0], m[1]), pk2(m[2], m[3])};
        }
        __syncthreads();
        {
            bf16x8 Av[2], As[2];
#pragma unroll
            for (int ks = 0; ks < 2; ++ks) { Av[ks] = FRAG(L_VT, 16 * wave + fr, 32 * ks + 8 * fq); As[ks] = FRAG(L_ST, 16 * wave + fr, 32 * ks + 8 * fq); }
#pragma unroll
            for (int ct = 0; ct < 4; ++ct) {
                f32x4 acc = (f32x4){0.f, 0.f, 0.f, 0.f};
#pragma unroll
                for (int ks = 0; ks < 2; ++ks) { acc = mfma16(Av[ks], FRAG(L_S, 16 * ct + fr, 32 * ks + 8 * fq), acc); acc = mfma16(As[ks], FRAG(L_QD, 16 * ct + fr, 32 * ks + 8 * fq), acc); }
                *(LAS f32x4*)(lds + L_OB + (16 * ct + fr) * OBROW + (16 * wave + 4 * fq) * 4) = acc;
            }
        }
        __syncthreads();
        {
            const int c = tid >> 3, vg = tid & 7;
            const LAS f32x4* ob = (const LAS f32x4*)(lds + L_OB + c * OBROW + vg * 64);
            f32x4 o[4]; float ss = 0.f;
#pragma unroll
            for (int j = 0; j < 4; ++j) { o[j] = ob[j]; ss += (o[j].x * o[j].x + o[j].y * o[j].y) + (o[j].z * o[j].z + o[j].w * o[j].w); }
            ss += shx(ss, 1); ss += shx(ss, 2); ss += shx(ss, 4);
            const float rs = rsqrtf(ss * (1.0f / 128.0f) + EPS);
            const v4u* gr = (const v4u*)(P + (size_t)(t0 + c) * PLD + C_G + h * 128 + 16 * vg);
            float g0[8], g1[8]; unpack8(gr[0], g0); unpack8(gr[1], g1);
            const f32x4* gn = (const f32x4*)(gnorm + 16 * vg);
            const f32x4 n0 = gn[0], n1 = gn[1], n2 = gn[2], n3 = gn[3];
            v4u w0, w1;
            w0.x = pk2(o[0].x * rs * n0.x * silu_fast(g0[0]), o[0].y * rs * n0.y * silu_fast(g0[1])); w0.y = pk2(o[0].z * rs * n0.z * silu_fast(g0[2]), o[0].w * rs * n0.w * silu_fast(g0[3]));
            w0.z = pk2(o[1].x * rs * n1.x * silu_fast(g0[4]), o[1].y * rs * n1.y * silu_fast(g0[5])); w0.w = pk2(o[1].z * rs * n1.z * silu_fast(g0[6]), o[1].w * rs * n1.w * silu_fast(g0[7]));
            w1.x = pk2(o[2].x * rs * n2.x * silu_fast(g1[0]), o[2].y * rs * n2.y * silu_fast(g1[1])); w1.y = pk2(o[2].z * rs * n2.z * silu_fast(g1[2]), o[2].w * rs * n2.w * silu_fast(g1[3]));
            w1.z = pk2(o[3].x * rs * n3.x * silu_fast(g1[4]), o[3].y * rs * n3.y * silu_fast(g1[5])); w1.w = pk2(o[3].z * rs * n3.z * silu_fast(g1[6]), o[3].w * rs * n3.w * silu_fast(g1[7]));
            v4u* op = (v4u*)(K.XN() + (size_t)(t0 + c) * D + h * 128 + 16 * vg);
            op[0] = w0; op[1] = w1;
        }
    }
}
#undef FRAG


constexpr int L_GKL = 109568, L_BL = 117760, SCN = 4, NSC = GN / SCN, NITEM = NB * GH * NSC;
#define FRAG(base, row, kel) (*(const LAS bf16x8*)(lds + (base) + (row) * LROWB + (kel) * 2))
struct GlaPre { unsigned short k[8], q[8], v[16]; v4u g0, g1; };
template <bool WITH_Q>
__device__ __forceinline__ void gla_prefetch(GlaPre& p, const bf16* P, int h, int t0, int tid, int lane, int wave) {
    const bf16* kp = P + (size_t)(t0 + 8 * wave) * PLD + C_K + h * 64 + lane;
#pragma unroll
    for (int j = 0; j < 8; ++j) p.k[j] = kp[(size_t)j * PLD];
    const int vv = tid & 127, cq = tid >> 7;
    const bf16* vp = P + (size_t)(t0 + 16 * cq) * PLD + C_V + h * 128 + vv;
#pragma unroll
    for (int j = 0; j < 16; ++j) p.v[j] = vp[(size_t)j * PLD];
    if (WITH_Q) {
        const bf16* qp = kp + (C_Q - C_K);
#pragma unroll
        for (int j = 0; j < 8; ++j) p.q[j] = qp[(size_t)j * PLD];
        const v4u* gr = (const v4u*)(P + (size_t)(t0 + (tid >> 3)) * PLD + C_G + h * 128 + 16 * (tid & 7));
        p.g0 = gr[0]; p.g1 = gr[1];
    }
}
__device__ __forceinline__ void gla_stage_gkl(const bf16* P, LAS unsigned char* lds, int tok0, int tid) {
    *(LAS v4u*)(lds + L_GKL + tid * 16) = *(const v4u*)(P + (size_t)(tok0 + (tid >> 1)) * PLD + C_GK + 8 * (tid & 1));
}
__device__ __forceinline__ void gla_b8_part(LAS unsigned char* lds, const float (&wu)[16], float bg, int n, int lane, int wave, float (&bv)[8]) {
    float run = 0.f;
#pragma unroll
    for (int j = 0; j < 8; ++j) {
        const LAS v4u* gl = (const LAS v4u*)(lds + L_GKL + (n * 64 + 8 * wave + j) * 32);
        float f0[8], f1[8]; unpack8(gl[0], f0); unpack8(gl[1], f1);
        float a = bg;
#pragma unroll
        for (int r = 0; r < 8; ++r) a += f0[r] * wu[r];
#pragma unroll
        for (int r = 0; r < 8; ++r) a += f1[r] * wu[8 + r];
        run += logsig_fast(a) * (1.0f / 16.0f); bv[j] = run;
    }
    ((LAS float*)(lds + L_TOT))[wave * 64 + lane] = run;
}
__device__ __forceinline__ float gla_b8_finish(LAS unsigned char* lds, int lane, int wave, float (&bv)[8]) {
    const LAS float* tot = (const LAS float*)(lds + L_TOT);
    float base = 0.f, all = 0.f;
#pragma unroll
    for (int g = 0; g < 8; ++g) { const float tv = tot[g * 64 + lane]; all += tv; if (g < wave) base += tv; }
#pragma unroll
    for (int j = 0; j < 8; ++j) bv[j] += base;
    return all;
}
__device__ __forceinline__ void gla_write_kdT_vT(LAS unsigned char* lds, const GlaPre& p, const float (&bv)[8], float bl, int tid, int lane, int wave) {
    float kd[8];
#pragma unroll
    for (int j = 0; j < 8; ++j) kd[j] = bf2f(p.k[j]) * fexp(bl - bv[j]);
    *(LAS v4u*)(lds + L_KDT + lane * LROWB + wave * 16) = (v4u){pk2(kd[0], kd[1]), pk2(kd[2], kd[3]), pk2(kd[4], kd[5]), pk2(kd[6], kd[7])};
    const int vv = tid & 127, cq = tid >> 7;
    LAS v4u* dst = (LAS v4u*)(lds + L_VT + vv * LROWB + cq * 32);
    dst[0] = (v4u){(unsigned)p.v[0] | ((unsigned)p.v[1] << 16), (unsigned)p.v[2] | ((unsigned)p.v[3] << 16), (unsigned)p.v[4] | ((unsigned)p.v[5] << 16), (unsigned)p.v[6] | ((unsigned)p.v[7] << 16)};
    dst[1] = (v4u){(unsigned)p.v[8] | ((unsigned)p.v[9] << 16), (unsigned)p.v[10] | ((unsigned)p.v[11] << 16), (unsigned)p.v[12] | ((unsigned)p.v[13] << 16), (unsigned)p.v[14] | ((unsigned)p.v[15] << 16)};
    if (wave == 0) ((LAS float*)(lds + L_BL))[lane] = bl;
}
__device__ __forceinline__ void gla_kv_mfma(LAS unsigned char* lds, int wave, int fr, int fq, f32x4 (&acc)[4]) {
    bf16x8 Bf[2];
#pragma unroll
    for (int ks = 0; ks < 2; ++ks) Bf[ks] = FRAG(L_VT, 16 * wave + fr, 32 * ks + 8 * fq);
#pragma unroll
    for (int dt = 0; dt < 4; ++dt) { acc[dt] = (f32x4){0.f, 0.f, 0.f, 0.f};
#pragma unroll
        for (int ks = 0; ks < 2; ++ks) acc[dt] = mfma16(FRAG(L_KDT, 16 * dt + fr, 32 * ks + 8 * fq), Bf[ks], acc[dt]); }
}

__device__ __forceinline__ void phase_gla_A2(Frame& F, int l) {
    const KA K = KA::fresh(); PHASE_TID;
    LAS unsigned char* lds = F.lds;
    const int fr = lane & 15, fq = lane >> 4;
#pragma unroll 1
    for (int it = F.bx; it < NITEM; it += F.G) {
        const int b = it / (GH * NSC), h = (it / NSC) % GH, sc = it % NSC, tok0 = b * S + sc * SCN * GC;
        const bf16* P = K.P();
        float wu[16];
        { const float* wup = K.in(3) + (size_t)l * 16 * 256 + h * 64 + lane;
#pragma unroll
          for (int r = 0; r < 16; ++r) wu[r] = wup[r * 256]; }
        const float bg = K.in(4)[l * 256 + h * 64 + lane];
        GlaPre pre; gla_prefetch<false>(pre, P, h, tok0, tid, lane, wave);
        __syncthreads();
        gla_stage_gkl(P, lds, tok0, tid);
        __syncthreads();
        f32x4 Sl[4], bs[4];
#pragma unroll
        for (int dt = 0; dt < 4; ++dt) { Sl[dt] = (f32x4){0.f, 0.f, 0.f, 0.f}; bs[dt] = (f32x4){0.f, 0.f, 0.f, 0.f}; }
#pragma unroll 1
        for (int n = 0; n < SCN; ++n) {
            float bv[8]; gla_b8_part(lds, wu, bg, n, lane, wave, bv);
            __syncthreads();
            const float bl = gla_b8_finish(lds, lane, wave, bv);
            gla_write_kdT_vT(lds, pre, bv, bl, tid, lane, wave);
            if (n + 1 < SCN) gla_prefetch<false>(pre, P, h, tok0 + (n + 1) * GC, tid, lane, wave);
            __syncthreads();
            f32x4 acc[4]; gla_kv_mfma(lds, wave, fr, fq, acc);
#pragma unroll
            for (int dt = 0; dt < 4; ++dt) { const f32x4 bl4 = *(const LAS f32x4*)(lds + L_BL + (16 * dt + 4 * fq) * 4);
                bs[dt] = bs[dt] + bl4;
#pragma unroll
                for (int r = 0; r < 4; ++r) Sl[dt][r] = fexp(bl4[r]) * Sl[dt][r] + acc[dt][r]; }
        }
        f32x4* ag = (f32x4*)K.Sst() + ((size_t)(it * 8 + wave) * 4) * 64 + lane;
#pragma unroll
        for (int dt = 0; dt < 4; ++dt) ag[dt * 64] = Sl[dt];
        if (wave == 0 && fr == 0) { f32x4* dp = (f32x4*)K.dec() + (size_t)it * 16 + fq;
#pragma unroll
            for (int dt = 0; dt < 4; ++dt) dp[dt * 4] = (f32x4){fexp(bs[dt][0]), fexp(bs[dt][1]), fexp(bs[dt][2]), fexp(bs[dt][3])}; }
    }
}

__device__ __forceinline__ void phase_gla_C2(Frame& F, int l) {
    const KA K = KA::fresh(); PHASE_TID;
    LAS unsigned char* lds = F.lds;
    const int fr = lane & 15, fq = lane >> 4;
    const float* gnorm = K.in(5) + (size_t)l * 128;
#pragma unroll 1
    for (int it = F.bx; it < NITEM; it += F.G) {
        const int b = it / (GH * NSC), h = (it / NSC) % GH, sc = it % NSC, tok0 = b * S + sc * SCN * GC;
        const bf16* P = K.P();
        float wu[16];
        { const float* wup = K.in(3) + (size_t)l * 16 * 256 + h * 64 + lane;
#pragma unroll
          for (int r = 0; r < 16; ++r) wu[r] = wup[r * 256]; }
        const float bg = K.in(4)[l * 256 + h * 64 + lane];
        GlaPre pre; gla_prefetch<true>(pre, P, h, tok0, tid, lane, wave);
        __syncthreads();
        gla_stage_gkl(P, lds, tok0, tid);
        f32x4 Sm[4];
#pragma unroll
        for (int dt = 0; dt < 4; ++dt) Sm[dt] = (f32x4){0.f, 0.f, 0.f, 0.f};
        {
            const f32x4* ag = (const f32x4*)K.Sst() + ((size_t)((it - sc) * 8 + wave) * 4) * 64 + lane; const f32x4* dp = (const f32x4*)K.dec() + (size_t)(it - sc) * 16 + fq;
#pragma unroll 2
            for (int j = 0; j < sc; ++j) {
#pragma unroll
                for (int dt = 0; dt < 4; ++dt) Sm[dt] = dp[(size_t)j * 16 + dt * 4] * Sm[dt] + ag[(size_t)j * 2048 + dt * 64];
            }
        }
        __syncthreads();
#pragma unroll 1
        for (int n = 0; n < SCN; ++n) {
            const int t0 = tok0 + n * GC;
            float bv[8]; gla_b8_part(lds, wu, bg, n, lane, wave, bv);
            __syncthreads();
            const float bl = gla_b8_finish(lds, lane, wave, bv);
            gla_write_kdT_vT(lds, pre, bv, bl, tid, lane, wave);
#pragma unroll
            for (int j = 0; j < 8; ++j) {
                const float e = fexp(bv[j]);
                *(LAS bf16*)(lds + L_QD + (8 * wave + j) * LROWB + lane * 2) = (bf16)f2bf(bf2f(pre.q[j]) * 0.125f * e);
                *(LAS bf16*)(lds + L_KI + (8 * wave + j) * LROWB + lane * 2) = (bf16)f2bf(bf2f(pre.k[j]) * __builtin_amdgcn_rcpf(e));
            }
#pragma unroll
            for (int dt = 0; dt < 4; ++dt) *(LAS v2u*)(lds + L_ST + (16 * wave + fr) * LROWB + (16 * dt + 4 * fq) * 2) = (v2u){pk2(Sm[dt][0], Sm[dt][1]), pk2(Sm[dt][2], Sm[dt][3])};
            const v4u gq0 = pre.g0, gq1 = pre.g1;
            if (n + 1 < SCN) gla_prefetch<true>(pre, P, h, t0 + GC, tid, lane, wave);
            __syncthreads();
#pragma unroll
            for (int i = 0; i < 2; ++i) {
                const int tix = 2 * wave + i, st = tix >> 2, ct = tix & 3;
                f32x4 a = (f32x4){0.f, 0.f, 0.f, 0.f};
#pragma unroll
                for (int ks = 0; ks < 2; ++ks) a = mfma16(FRAG(L_KI, 16 * st + fr, 32 * ks + 8 * fq), FRAG(L_QD, 16 * ct + fr, 32 * ks + 8 * fq), a);
                const int s0 = 16 * st + 4 * fq, c = 16 * ct + fr;
                float m[4];
#pragma unroll
                for (int r = 0; r < 4; ++r) m[r] = (s0 + r <= c) ? a[r] : 0.f;
                *(LAS v2u*)(lds + L_S + c * LROWB + s0 * 2) = (v2u){pk2(m[0], m[1]), pk2(m[2], m[3])};
            }
            f32x4 kv[4]; gla_kv_mfma(lds, wave, fr, fq, kv);
            __syncthreads();
            {
                bf16x8 Av[2], As[2];
#pragma unroll
                for (int ks = 0; ks < 2; ++ks) { Av[ks] = FRAG(L_VT, 16 * wave + fr, 32 * ks + 8 * fq); As[ks] = FRAG(L_ST, 16 * wave + fr, 32 * ks + 8 * fq); }
#pragma unroll
                for (int ct = 0; ct < 4; ++ct) {
                    f32x4 a = (f32x4){0.f, 0.f, 0.f, 0.f};
#pragma unroll
                    for (int ks = 0; ks < 2; ++ks) { a = mfma16(Av[ks], FRAG(L_S, 16 * ct + fr, 32 * ks + 8 * fq), a); a = mfma16(As[ks], FRAG(L_QD, 16 * ct + fr, 32 * ks + 8 * fq), a); }
                    *(LAS f32x4*)(lds + L_OB + (16 * ct + fr) * OBROW + (16 * wave + 4 * fq) * 4) = a;
                }
            }
#pragma unroll
            for (int dt = 0; dt < 4; ++dt) { const f32x4 bl4 = *(const LAS f32x4*)(lds + L_BL + (16 * dt + 4 * fq) * 4);
#pragma unroll
                for (int r = 0; r < 4; ++r) Sm[dt][r] = fexp(bl4[r]) * Sm[dt][r] + kv[dt][r]; }
            __syncthreads();
            {
                const int c = tid >> 3, vg = tid & 7;
                const LAS f32x4* ob = (const LAS f32x4*)(lds + L_OB + c * OBROW + vg * 64);
                f32x4 o[4]; float ss = 0.f;
#pragma unroll
                for (int j = 0; j < 4; ++j) { o[j] = ob[j]; ss += (o[j].x * o[j].x + o[j].y * o[j].y) + (o[j].z * o[j].z + o[j].w * o[j].w); }
                ss += shx(ss, 1); ss += shx(ss, 2); ss += shx(ss, 4);
                const float rs = rsqrtf(ss * (1.0f / 128.0f) + EPS);
                float g0[8], g1[8]; unpack8(gq0, g0); unpack8(gq1, g1);
                const f32x4* gn = (const f32x4*)(gnorm + 16 * vg);
                const f32x4 n0 = gn[0], n1 = gn[1], n2 = gn[2], n3 = gn[3];
                v4u w0, w1;
                w0.x = pk2(o[0].x * rs * n0.x * silu_fast(g0[0]), o[0].y * rs * n0.y * silu_fast(g0[1])); w0.y = pk2(o[0].z * rs * n0.z * silu_fast(g0[2]), o[0].w * rs * n0.w * silu_fast(g0[3]));
                w0.z = pk2(o[1].x * rs * n1.x * silu_fast(g0[4]), o[1].y * rs * n1.y * silu_fast(g0[5])); w0.w = pk2(o[1].z * rs * n1.z * silu_fast(g0[6]), o[1].w * rs * n1.w * silu_fast(g0[7]));
                w1.x = pk2(o[2].x * rs * n2.x * silu_fast(g1[0]), o[2].y * rs * n2.y * silu_fast(g1[1])); w1.y = pk2(o[2].z * rs * n2.z * silu_fast(g1[2]), o[2].w * rs * n2.w * silu_fast(g1[3]));
                w1.z = pk2(o[3].x * rs * n3.x * silu_fast(g1[4]), o[3].y * rs * n3.y * silu_fast(g1[5])); w1.w = pk2(o[3].z * rs * n3.z * silu_fast(g1[6]), o[3].w * rs * n3.w * silu_fast(g1[7]));
                v4u* op = (v4u*)(K.XN() + (size_t)(t0 + c) * D + h * 128 + 16 * vg);
                op[0] = w0; op[1] = w1;
            }
        }
    }
}
#undef FRAG

constexpr int GM_ROWB = 272;
__device__ __forceinline__ void phase_gmlp_mfma(Frame& F, int l) {
    const KA K = KA::fresh(); PHASE_TID;
    LAS unsigned char* lds = F.lds;
    const int fr = lane & 15, fq = lane >> 4;
#pragma unroll 1
    for (int u = F.bx; u < NB * MN * MH; u += F.G) {
        const int b = u / (MN * MH), n = (u / MH) % MN, h = u % MH, t0 = b * S + n * MC;
        const bf16* P = K.P();
        const float gn = K.in(6)[(size_t)l * 256 + h * 64 + lane];
        __syncthreads();
#pragma unroll
        for (int q = 0; q < 2; ++q) {
            float vs[8];
#pragma unroll
            for (int i = 0; i < 8; ++i) {
                const float g = gelu_fast(bf2f(P[(size_t)(t0 + 16 * wave + 8 * q + i) * PLD + C_VG + h * 64 + lane]));
                const float ss = wave_sum(g * g);
                vs[i] = g * rsqrtf(ss * (1.0f / 64.0f) + EPS) * gn;
            }
            *(LAS v4u*)(lds + lane * GM_ROWB + (16 * wave + 8 * q) * 2) = (v4u){pk2(vs[0], vs[1]), pk2(vs[2], vs[3]), pk2(vs[4], vs[5]), pk2(vs[6], vs[7])};
        }
        __syncthreads();
        const bf16* Wb = K.Wsp() + ((size_t)(l * MH + h) * 128 + 16 * wave + fr) * 128 + 8 * fq;
        f32x4 acc[4];
#pragma unroll
        for (int dt = 0; dt < 4; ++dt) acc[dt] = (f32x4){0.f, 0.f, 0.f, 0.f};
        const int nks = (16 * wave + 15) / 32 + 1;
#pragma unroll
        for (int ks = 0; ks < 4; ++ks) if (ks < nks) {
            const bf16x8 Bf = *(const bf16x8*)(Wb + 32 * ks);
#pragma unroll
            for (int dt = 0; dt < 4; ++dt) acc[dt] = mfma16(*(const LAS bf16x8*)(lds + (16 * dt + fr) * GM_ROWB + (32 * ks + 8 * fq) * 2), Bf, acc[dt]);
        }
        const int t = 16 * wave + fr;
        const float bias = K.in(8)[(size_t)l * MH * 128 + h * 128 + t];
        const bf16* up = P + (size_t)(t0 + t) * PLD + C_U + h * 64 + 4 * fq;
        bf16* op = K.XN() + (size_t)(t0 + t) * D + 512 + h * 64 + 4 * fq;
#pragma unroll
        for (int dt = 0; dt < 4; ++dt) {
            const v2u uw = *(const v2u*)(up + 16 * dt);
            const float o0 = gelu_fast(bflo(uw.x)) * (acc[dt][0] + bias), o1 = gelu_fast(bfhi(uw.x)) * (acc[dt][1] + bias), o2 = gelu_fast(bflo(uw.y)) * (acc[dt][2] + bias), o3 = gelu_fast(bfhi(uw.y)) * (acc[dt][3] + bias);
            *(v2u*)(op + 16 * dt) = (v2u){pk2(o0, o1), pk2(o2, o3)};
        }
    }
}

__device__ __forceinline__ void phase_conv(Frame& F, int l) {
    const KA K = KA::fresh(); PHASE_TID;
    const float* wc = K.in(9) + (size_t)l * 3 * 256;
#pragma unroll 1
    for (int e = F.bx * NT + tid; e < T * 32; e += F.G * NT) {
        const int t = e >> 5, c0 = (e & 31) * 8, tl = t % S;
        const bf16* row = K.P() + (size_t)t * PLD;
        float y[8], xi[8], cg[8], bg[8];
        unpack8(*(const v4u*)(row + C_XI + c0), xi); unpack8(*(const v4u*)(row + C_CG + c0), cg); unpack8(*(const v4u*)(row + C_BG + c0), bg);
#pragma unroll
        for (int j = 0; j < 8; ++j) y[j] = wc[2 * 256 + c0 + j] * cg[j] * xi[j];
        if (tl >= 1) { unpack8(*(const v4u*)(row - PLD + C_XI + c0), xi); unpack8(*(const v4u*)(row - PLD + C_CG + c0), cg);
#pragma unroll
            for (int j = 0; j < 8; ++j) y[j] += wc[1 * 256 + c0 + j] * cg[j] * xi[j]; }
        if (tl >= 2) { unpack8(*(const v4u*)(row - 2 * PLD + C_XI + c0), xi); unpack8(*(const v4u*)(row - 2 * PLD + C_CG + c0), cg);
#pragma unroll
            for (int j = 0; j < 8; ++j) y[j] += wc[0 * 256 + c0 + j] * cg[j] * xi[j]; }
#pragma unroll
        for (int j = 0; j < 8; ++j) y[j] *= bg[j];
        *(v4u*)(K.XN() + (size_t)t * D + 768 + c0) = (v4u){pk2(y[0], y[1]), pk2(y[2], y[3]), pk2(y[4], y[5]), pk2(y[6], y[7])};
    }
}
__device__ __forceinline__ void phase_norm_router(Frame& F, int l) {
    const KA K = KA::fresh(); PHASE_TID;
    const float* gain = K.in(11) + (size_t)l * D;
    const float* wrg = K.in(12) + (size_t)l * D * 4; const float* brg = K.in(13) + (size_t)l * 4;
    const float* wre = K.in(14) + (size_t)l * D * 32; const float* bre = K.in(15) + (size_t)l * 32;
    int* cnt = (int*)(K.ctl() + CW_CNT + 64 * l);
#pragma unroll 1
    for (int t = F.bx * NWAVES + wave; t < T; t += F.G * NWAVES) {
        const f32x4* xr = (const f32x4*)(K.out() + (size_t)t * D) + lane;
        f32x4 v[4]; float s = 0.f;
#pragma unroll
        for (int j = 0; j < 4; ++j) { v[j] = xr[64 * j]; s += (v[j].x * v[j].x + v[j].y * v[j].y) + (v[j].z * v[j].z + v[j].w * v[j].w); }
        const float rs = rsqrtf(wave_sum(s) * (1.f / D) + EPS);
        v2u* o8 = (v2u*)(K.XN() + (size_t)t * D) + lane;
        float acc[36];
#pragma unroll
        for (int j = 0; j < 36; ++j) acc[j] = 0.f;
#pragma unroll
        for (int j = 0; j < 4; ++j) {
            const f32x4 g = ((const f32x4*)gain)[lane + 64 * j];
            const float hv[4] = {v[j].x * rs * g.x, v[j].y * rs * g.y, v[j].z * rs * g.z, v[j].w * rs * g.w};
            v2u w; w.x = pk2(hv[0], hv[1]); w.y = pk2(hv[2], hv[3]); o8[64 * j] = w;
#pragma unroll
            for (int i = 0; i < 4; ++i) {
                const int k = 4 * lane + 256 * j + i; const float xv = hv[i];
                const f32x4 g4 = *(const f32x4*)(wrg + (size_t)k * 4);
                acc[0] += xv * g4.x; acc[1] += xv * g4.y; acc[2] += xv * g4.z; acc[3] += xv * g4.w;
                const f32x4* e4 = (const f32x4*)(wre + (size_t)k * 32);
#pragma unroll
                for (int q = 0; q < 8; ++q) { const f32x4 w4 = e4[q]; acc[4 + 4 * q] += xv * w4.x; acc[5 + 4 * q] += xv * w4.y; acc[6 + 4 * q] += xv * w4.z; acc[7 + 4 * q] += xv * w4.w; }
            }
        }
#pragma unroll
        for (int j = 0; j < 36; ++j) acc[j] = wave_sum(acc[j]);
        if (lane == 0) {
            float gl[4]; int gt = 0;
#pragma unroll
            for (int j = 0; j < 4; ++j) gl[j] = acc[j] + brg[j];
            float gmax = gl[0];
#pragma unroll
            for (int j = 1; j < 4; ++j) if (gl[j] > gmax) { gmax = gl[j]; gt = j; }
            float gs = 0.f;
#pragma unroll
            for (int j = 0; j < 4; ++j) gs += expf(gl[j] - gmax);
            const float gw = 1.0f / gs;
            float el[8];
#pragma unroll
            for (int j = 0; j < 8; ++j) { float vv = 0.f;
#pragma unroll
                for (int g = 0; g < 4; ++g) if (g == gt) vv = acc[4 + g * 8 + j] + bre[g * 8 + j];
                el[j] = vv; }
            int i0 = 0; float m0 = el[0];
#pragma unroll
            for (int j = 1; j < 8; ++j) if (el[j] > m0) { m0 = el[j]; i0 = j; }
            int i1 = -1; float m1 = -INFINITY;
#pragma unroll
            for (int j = 0; j < 8; ++j) if (j != i0 && el[j] > m1) { m1 = el[j]; i1 = j; }
            const float e1 = expf(m1 - m0);
            const float w0 = gw / (1.0f + e1), w1 = gw * e1 / (1.0f + e1);
            const int e0i = gt * 8 + i0, e1i = gt * 8 + i1;
            K.eid()[2 * t] = e0i; K.eid()[2 * t + 1] = e1i; K.ew()[2 * t] = w0; K.ew()[2 * t + 1] = w1;
            atomicAdd(&cnt[e0i], 1); atomicAdd(&cnt[e1i], 1);
        }
    }
}
constexpr int RT_PART = 0, RT_SS = RT_PART + 2 * 4 * 16 * 48 * 4, RT_RS = RT_SS + 2 * 4 * 16 * 4, RT_HIST = RT_RS + 2 * 16 * 4;
__device__ __forceinline__ void phase_norm_router_mfma(Frame& F, int l) {
    const KA K = KA::fresh(); PHASE_TID;
    LAS unsigned char* lds = F.lds;
    const int fr = lane & 15, fq = lane >> 4, tl = wave >> 2, kq = wave & 3;
    const bf16* Whi = K.Wr() + (size_t)l * 2 * 48 * D; const bf16* Wlo = Whi + 48 * D;
    const float* gain = K.in(11) + (size_t)l * D;
#pragma unroll 1
    for (int blk = F.bx; blk < T / 64; blk += F.G) {
        __syncthreads();
        if (tid < NE) ((LAS int*)(lds + RT_HIST))[tid] = 0;
#pragma unroll 1
        for (int half = 0; half < 2; ++half) {
            const int tok0 = blk * 64 + half * 32 + tl * 16;
            const float* xr = K.out() + (size_t)(tok0 + fr) * D + 256 * kq + 8 * fq;
            const bf16* whi = Whi + (size_t)fr * D + 256 * kq + 8 * fq; const bf16* wlo = Wlo + (size_t)fr * D + 256 * kq + 8 * fq;
            f32x4 acc[3];
#pragma unroll
            for (int nt = 0; nt < 3; ++nt) acc[nt] = (f32x4){0.f, 0.f, 0.f, 0.f};
            float ss = 0.f;
            f32x4 xa[8], xb[8];
#pragma unroll
            for (int ks = 0; ks < 8; ++ks) { xa[ks] = *(const f32x4*)(xr + 32 * ks); xb[ks] = *(const f32x4*)(xr + 32 * ks + 4); }
#pragma unroll
            for (int ks = 0; ks < 8; ++ks) {
                if ((ks & 1) == 0) __builtin_amdgcn_sched_barrier(0);
                const f32x4 x0 = xa[ks], x1 = xb[ks];
                const float xv[8] = {x0.x, x0.y, x0.z, x0.w, x1.x, x1.y, x1.z, x1.w};
                unsigned hw[4], lw[4];
#pragma unroll
                for (int j = 0; j < 4; ++j) { const float a = xv[2 * j], b2 = xv[2 * j + 1]; ss += a * a + b2 * b2;
                    const unsigned ha = f2bf(a), hb = f2bf(b2); hw[j] = ha | (hb << 16); lw[j] = pk2(a - bf2f(ha), b2 - bf2f(hb)); }
                bf16x8 Ah, Al; { v4u t4 = (v4u){hw[0], hw[1], hw[2], hw[3]}; Ah = __builtin_bit_cast(bf16x8, t4); t4 = (v4u){lw[0], lw[1], lw[2], lw[3]}; Al = __builtin_bit_cast(bf16x8, t4); }
#pragma unroll
                for (int nt = 0; nt < 3; ++nt) {
                    const bf16x8 Bh = *(const bf16x8*)(whi + (size_t)(16 * nt) * D + 32 * ks), Bl = *(const bf16x8*)(wlo + (size_t)(16 * nt) * D + 32 * ks);
                    acc[nt] = mfma16(Ah, Bh, acc[nt]); acc[nt] = mfma16(Al, Bh, acc[nt]); acc[nt] = mfma16(Ah, Bl, acc[nt]);
                }
            }
            ss += shx(ss, 16); ss += shx(ss, 32);
            {
                LAS float* part = (LAS float*)(lds + RT_PART) + (tl * 4 + kq) * 16 * 48;
#pragma unroll
                for (int nt = 0; nt < 3; ++nt)
#pragma unroll
                    for (int r = 0; r < 4; ++r) part[(4 * fq + r) * 48 + 16 * nt + fr] = acc[nt][r];
                if (fq == 0) ((LAS float*)(lds + RT_SS))[(tl * 4 + kq) * 16 + fr] = ss;
            }
            __syncthreads();
            if (kq == 0 && lane < 16) {
                const int t = tok0 + lane;
                const LAS float* p0 = (const LAS float*)(lds + RT_PART) + (tl * 4) * 16 * 48 + lane * 48;
                const LAS float* s2 = (const LAS float*)(lds + RT_SS) + (tl * 4) * 16 + lane;
                const float rs = rsqrtf(((s2[0] + s2[16]) + (s2[32] + s2[48])) * (1.f / D) + EPS);
                ((LAS float*)(lds + RT_RS))[tl * 16 + lane] = rs;
                const float* brg = K.in(13) + (size_t)l * 4; const float* bre = K.in(15) + (size_t)l * 32;
#define RT_DOT(n) ((p0[(n)] + p0[768 + (n)]) + (p0[1536 + (n)] + p0[2304 + (n)]))
                float gl[4]; int gt = 0;
#pragma unroll
                for (int j = 0; j < 4; ++j) gl[j] = RT_DOT(j) * rs + brg[j];
                float gmax = gl[0];
#pragma unroll
                for (int j = 1; j < 4; ++j) if (gl[j] > gmax) { gmax = gl[j]; gt = j; }
                float gs = 0.f;
#pragma unroll
                for (int j = 0; j < 4; ++j) gs += expf(gl[j] - gmax);
                const float gw = 1.0f / gs;
                float el[8];
#pragma unroll
                for (int j = 0; j < 8; ++j) el[j] = RT_DOT(4 + gt * 8 + j) * rs + bre[gt * 8 + j];
#undef RT_DOT
                int i0 = 0; float m0 = el[0];
#pragma unroll
                for (int j = 1; j < 8; ++j) if (el[j] > m0) { m0 = el[j]; i0 = j; }
                int i1 = -1; float m1 = -INFINITY;
#pragma unroll
                for (int j = 0; j < 8; ++j) if (j != i0 && el[j] > m1) { m1 = el[j]; i1 = j; }
                const float e1 = expf(m1 - m0);
                const float w0 = gw / (1.0f + e1), w1 = gw * e1 / (1.0f + e1);
                const int e0i = gt * 8 + i0, e1i = gt * 8 + i1;
                K.eid()[2 * t] = e0i; K.eid()[2 * t + 1] = e1i; K.ew()[2 * t] = w0; K.ew()[2 * t + 1] = w1;
                LAS int* hist = (LAS int*)(lds + RT_HIST);
                K.slot_of()[2 * t] = __hip_atomic_fetch_add(hist + e0i, 1, __ATOMIC_RELAXED, __HIP_MEMORY_SCOPE_WORKGROUP);
                K.slot_of()[2 * t + 1] = __hip_atomic_fetch_add(hist + e1i, 1, __ATOMIC_RELAXED, __HIP_MEMORY_SCOPE_WORKGROUP);
            }
            __syncthreads();
            {
                const float rs = ((const LAS float*)(lds + RT_RS))[tl * 16 + fr];
                bf16* hp = K.XN() + (size_t)(tok0 + fr) * D + 256 * kq + 8 * fq;
                const float* gp = gain + 256 * kq + 8 * fq;
#pragma unroll
                for (int ks = 0; ks < 8; ++ks) {
                    const f32x4 x0 = xa[ks], x1 = xb[ks];
                    const f32x4 g0 = *(const f32x4*)(gp + 32 * ks), g1 = *(const f32x4*)(gp + 32 * ks + 4);
                    *(v4u*)(hp + 32 * ks) = (v4u){pk2(x0.x * rs * g0.x, x0.y * rs * g0.y), pk2(x0.z * rs * g0.z, x0.w * rs * g0.w), pk2(x1.x * rs * g1.x, x1.y * rs * g1.y), pk2(x1.z * rs * g1.z, x1.w * rs * g1.w)};
                }
            }
        }
        __syncthreads();
        if (tid < NE) K.blkcnt()[(size_t)(l * (T / 64) + blk) * NE + tid] = ((LAS int*)(lds + RT_HIST))[tid];
    }
}
__device__ __forceinline__ void phase_scatter(Frame& F, int l) {
    const KA K = KA::fresh(); PHASE_TID;
    LAS int* sm = (LAS int*)F.lds;
    const int* bc = K.blkcnt() + (size_t)l * (T / 64) * NE;
    constexpr int NBLK = T / 64;
#pragma unroll 1
    for (int blk = F.bx; blk < NBLK; blk += F.G) {
        __syncthreads();
        {   const int e = tid & 31, part = tid >> 5;
            int tot = 0, pre = 0;
#pragma unroll
            for (int j = 0; j < NBLK / 16; ++j) { const int bb = part * (NBLK / 16) + j; const int c = bc[bb * NE + e]; tot += c; if (bb < blk) pre += c; }
            sm[part * 32 + e] = tot; sm[512 + part * 32 + e] = pre; }
        __syncthreads();
        if (tid < 32) { int tot = 0, pre = 0;
#pragma unroll
            for (int p = 0; p < 16; ++p) { tot += sm[p * 32 + tid]; pre += sm[512 + p * 32 + tid]; }
            sm[1056 + tid] = tot; sm[1024 + tid] = pre; }
        __syncthreads();
        if (tid == 0) { int a = 0; for (int e = 0; e < NE; ++e) { const int c = sm[1056 + e]; sm[1024 + e] += a; a += c; } }
        if (blk == 0 && tid < 32) ((int*)(K.ctl() + CW_CNT + 64 * l))[tid] = sm[1056 + tid];
        __syncthreads();
        if (tid < 128) { const int a = blk * 128 + tid; const int e = K.eid()[a]; const int pos = sm[1024 + e] + K.slot_of()[a]; K.slot_tok()[pos] = a >> 1; K.slot_of()[a] = pos; }
    }
    __syncthreads();
}
template <bool DUAL>
__device__ __forceinline__ void gemm_core(const bf16* A, const int* rowoff, int K, const float* B0, const float* B1, int ldb, int n0,
                                          float (&acc0)[4][4], float (&acc1)[4][4], float* As, float* Bs0, float* Bs1) {
    const int tid = __builtin_amdgcn_readfirstlane(threadIdx.x >> 6) * 64 + fresh_lane(), tx = tid & 15, ty = tid >> 4;
    const int ar = tid >> 2, ak = (tid & 3) * 4;
    const int bk = (tid >> 4) & 15, bn = (tid & 15) * 4;
    const long aoff = rowoff[ar];
#pragma unroll
    for (int i = 0; i < 4; ++i)
#pragma unroll
        for (int j = 0; j < 4; ++j) { acc0[i][j] = 0.f; acc1[i][j] = 0.f; }
#pragma unroll 1
    for (int k0 = 0; k0 < K; k0 += 16) {
        v2u av = (v2u){0u, 0u};
        if (aoff >= 0) av = *(const v2u*)(A + aoff + k0 + ak);
        f32x4 bv0 = (f32x4){0.f, 0.f, 0.f, 0.f}, bv1 = bv0;
        if (tid < 256) { bv0 = *(const f32x4*)(B0 + (size_t)(k0 + bk) * ldb + n0 + bn); if (DUAL) bv1 = *(const f32x4*)(B1 + (size_t)(k0 + bk) * ldb + n0 + bn); }
        __syncthreads();
        As[(ak + 0) * 132 + ar] = bflo(av.x); As[(ak + 1) * 132 + ar] = bfhi(av.x); As[(ak + 2) * 132 + ar] = bflo(av.y); As[(ak + 3) * 132 + ar] = bfhi(av.y);
        if (tid < 256) { *(f32x4*)(Bs0 + bk * 64 + bn) = bv0; if (DUAL) *(f32x4*)(Bs1 + bk * 64 + bn) = bv1; }
        __syncthreads();
#pragma unroll
        for (int kk = 0; kk < 16; ++kk) {
            const f32x4 a4 = *(const f32x4*)(As + kk * 132 + ty * 4);
            const f32x4 b4 = *(const f32x4*)(Bs0 + kk * 64 + tx * 4);
#pragma unroll
            for (int i = 0; i < 4; ++i)
#pragma unroll
                for (int j = 0; j < 4; ++j) acc0[i][j] += a4[i] * b4[j];
            if (DUAL) {
                const f32x4 c4 = *(const f32x4*)(Bs1 + kk * 64 + tx * 4);
#pragma unroll
                for (int i = 0; i < 4; ++i)
#pragma unroll
                    for (int j = 0; j < 4; ++j) acc1[i][j] += a4[i] * c4[j];
            }
        }
    }
}
template <int MODE>
__device__ __forceinline__ void phase_moe_ref(Frame& F, int l) {
    const KA K = KA::fresh(); PHASE_TID;
    float* As = F.smem; float* Bs0 = F.smem + 16 * 132; float* Bs1 = Bs0 + 16 * 64; int* rowoff = (int*)(Bs1 + 16 * 64); int* offs = rowoff + 128; int* toff = offs + 33;
    int* cnt = (int*)(K.ctl() + CW_CNT + 64 * l);
    const int tx = tid & 15, ty = tid >> 4;
    __syncthreads();
    if (tid == 0) { int a = 0, tt = 0; for (int e = 0; e < NE; ++e) { offs[e] = a; toff[e] = tt; const int c = cnt[e]; a += c; tt += (c + 127) / 128; } offs[NE] = a; toff[NE] = tt; }
    __syncthreads();
    constexpr int N = (MODE == 1) ? DE : D, KD = (MODE == 1) ? D : DE, NTN = N / 64;
    const int ntiles = toff[NE] * NTN;
#pragma unroll 1
    for (int t = F.bx; t < ntiles; t += F.G) {
        const int rt = t / NTN, tn = t % NTN;
        int e = 0;
        for (int j = 1; j < NE; ++j) if (toff[j] <= rt) e = j;
        const int r0 = offs[e] + (rt - toff[e]) * 128, rend = offs[e + 1];
        __syncthreads();
        if (tid < 128) { const int r = r0 + tid; rowoff[tid] = (r < rend) ? ((MODE == 1) ? K.slot_tok()[r] * D : r * DE) : -1; }
        __syncthreads();
        float acc0[4][4], acc1[4][4];
        if (MODE == 1) {
            const float* Wg = K.in(16) + ((size_t)l * NE + e) * D * DE; const float* Wu = K.in(17) + ((size_t)l * NE + e) * D * DE;
            gemm_core<true>(K.XN(), rowoff, KD, Wg, Wu, DE, tn * 64, acc0, acc1, As, Bs0, Bs1);
        } else {
            const float* Wd = K.in(18) + ((size_t)l * NE + e) * DE * D;
            gemm_core<false>(K.H1(), rowoff, KD, Wd, nullptr, D, tn * 64, acc0, acc1, As, Bs0, nullptr);
        }
#pragma unroll
        for (int i = 0; i < 4; ++i) {
            const int r = r0 + ty * 4 + i;
            if (r < rend) {
                v2u o;
                if (MODE == 1) { o.x = pk2(silu(acc0[i][0]) * acc1[i][0], silu(acc0[i][1]) * acc1[i][1]); o.y = pk2(silu(acc0[i][2]) * acc1[i][2], silu(acc0[i][3]) * acc1[i][3]);
                    *(v2u*)(K.H1() + (size_t)r * DE + tn * 64 + tx * 4) = o; }
                else { o.x = pk2(acc0[i][0], acc0[i][1]); o.y = pk2(acc0[i][2], acc0[i][3]); *(v2u*)(K.Y() + (size_t)r * D + tn * 64 + tx * 4) = o; }
            }
        }
    }
    __syncthreads();
}

constexpr int TAB_OFF = LDSCTL_OFF + 1024;
__device__ __forceinline__ void moe_tables(Frame& F, int l) {
    const KA K = KA::fresh(); PHASE_TID;
    LAS int* tab = (LAS int*)(F.lds + TAB_OFF); LAS int* offs = tab + 4 + 4 * 164; LAS int* fpre = offs + 40; LAS int* ppre = fpre + 40;
    const int* cnt = (const int*)(K.ctl() + CW_CNT + 64 * l);
    __syncthreads();
    if (tid == 0) { int a = 0, f = 0, p = 0; for (int e = 0; e < NE; ++e) { const int c = cnt[e]; offs[e] = a; fpre[e] = f; ppre[e] = p; a += c; f += c >> 8; p += (c & 255) ? 1 : 0; }
        offs[NE] = a; fpre[NE] = f; ppre[NE] = p; tab[0] = f + p; }
    __syncthreads();
    const int nfull = fpre[NE], ntile = nfull + ppre[NE];
    if (tid < ntile) {
        int e = 0;
        if (tid < nfull) { for (int j = 1; j < NE; ++j) if (fpre[j] <= tid) e = j; tab[4 + 4 * tid] = e; tab[5 + 4 * tid] = offs[e] + (tid - fpre[e]) * 256; tab[6 + 4 * tid] = offs[e + 1]; }
        else { const int q = tid - nfull; for (int j = 1; j < NE; ++j) if (ppre[j] <= q) e = j; tab[4 + 4 * tid] = e; tab[5 + 4 * tid] = offs[e] + (fpre[e + 1] - fpre[e]) * 256; tab[6 + 4 * tid] = offs[e + 1]; }
    }
    __syncthreads();
}
__device__ __forceinline__ void phase_moe_gu(Frame& F, int l) {
    moe_tables(F, l);
    const KA K = KA::fresh();
    int c_ = F.bx; asm volatile("" : "+s"(c_));
    pg8::MoeSched So{(const LAS int*)(F.lds + TAB_OFF), 2, F.G, (c_ & 7) * (F.G >> 3) + (c_ >> 3)};
    pg8::EpiMoeH E{K.H1()};
    pg8::gemm_phase_moe<pg8::EpiMoeH, pg8::MoeSched, true, 512, D>(F.lds, K.XN(), K.WguT() + (size_t)l * NE * 512 * D, K.slot_tok(), So, E, F.wave);
}
__device__ __forceinline__ void phase_moe_down(Frame& F, int l) {
    moe_tables(F, l);
    const KA K = KA::fresh();
    int c_ = F.bx; asm volatile("" : "+s"(c_));
    pg8::MoeSched So{(const LAS int*)(F.lds + TAB_OFF), 4, F.G, (c_ & 7) * (F.G >> 3) + (c_ >> 3)};
    pg8::EpiMoeY E{K.Y()};
    pg8::gemm_phase_moe<pg8::EpiMoeY, pg8::MoeSched, false, D, DE>(F.lds, K.H1(), K.WdT() + (size_t)l * NE * D * DE, nullptr, So, E, F.wave);
}
__device__ __forceinline__ void phase_combine(Frame& F, int l) {
    const KA K = KA::fresh(); PHASE_TID;
    const bool last = (l == DEPTH - 1);
    const float* gain = last ? K.in(19) : (K.in(1) + (size_t)(l + 1) * D);
#pragma unroll 1
    for (int t = F.bx * NWAVES + wave; t < T; t += F.G * NWAVES) {
        const int s0 = K.slot_of()[2 * t], s1 = K.slot_of()[2 * t + 1]; const float w0 = K.ew()[2 * t], w1 = K.ew()[2 * t + 1];
        f32x4* xr = (f32x4*)(K.out() + (size_t)t * D) + lane;
        const v2u* y0 = (const v2u*)(K.Y() + (size_t)s0 * D) + lane; const v2u* y1 = (const v2u*)(K.Y() + (size_t)s1 * D) + lane;
        f32x4 v[4]; float s = 0.f;
#pragma unroll
        for (int j = 0; j < 4; ++j) { v[j] = xr[64 * j]; const v2u a = y0[64 * j], b = y1[64 * j];
            v[j].x += w0 * bflo(a.x) + w1 * bflo(b.x); v[j].y += w0 * bfhi(a.x) + w1 * bfhi(b.x); v[j].z += w0 * bflo(a.y) + w1 * bflo(b.y); v[j].w += w0 * bfhi(a.y) + w1 * bfhi(b.y);
            s += (v[j].x * v[j].x + v[j].y * v[j].y) + (v[j].z * v[j].z + v[j].w * v[j].w); }
        const float rs = rsqrtf(wave_sum(s) * (1.f / D) + EPS);
        if (last) {
#pragma unroll
            for (int j = 0; j < 4; ++j) { const f32x4 g = ((const f32x4*)gain)[lane + 64 * j]; xr[64 * j] = (f32x4){v[j].x * rs * g.x, v[j].y * rs * g.y, v[j].z * rs * g.z, v[j].w * rs * g.w}; }
        } else {
            v2u* o8 = (v2u*)(K.XN() + (size_t)t * D) + lane;
#pragma unroll
            for (int j = 0; j < 4; ++j) { xr[64 * j] = v[j]; const f32x4 g = ((const f32x4*)gain)[lane + 64 * j];
                v2u w; w.x = pk2(v[j].x * rs * g.x, v[j].y * rs * g.y); w.y = pk2(v[j].z * rs * g.z, v[j].w * rs * g.w); o8[64 * j] = w; }
        }
    }
}

struct Args { const float* in[20]; float* out; unsigned char* ws; };
__global__ void __launch_bounds__(NT, 2) fwd_kernel(Args args) {
    extern __shared__ __attribute__((aligned(16))) unsigned char lds_raw[];
    Frame F;
    F.lds = (LAS unsigned char*)lds_raw; F.smem = (float*)lds_raw;
    F.G = gridDim.x; F.bx = blockIdx.x; F.wave = __builtin_amdgcn_readfirstlane(threadIdx.x >> 6);
    volatile LAS unsigned* MISC = (volatile LAS unsigned*)(F.lds + MISC_OFF);
    for (int u = threadIdx.x; u < (LDS_BYTES - LDSCTL_OFF) / 4; u += NT) ((LAS unsigned*)(F.lds + LDSCTL_OFF))[u] = 0u;
    __syncthreads();
    XcdBarrier bar; { const KA K = KA::fresh(); bar = xcd_barrier_post(K.ctl() + CW_BAR, MISC + 8); }
#define GRID_BAR() xcd_barrier(bar)

    p0_prologue(F);
    GRID_BAR();
    for (int l = 0; l < DEPTH; ++l) {
        {
            const KA K = KA::fresh(); PHASE_TID;
            pg8::Gemm g{K.XN(), K.WinT() + (size_t)l * PLD * D, T, PLD, D}; pg8::StaticOrder So; int c_ = F.bx; asm volatile("" : "+s"(c_)); So.init(T, PLD, F.G, c_);
            pg8::EpiBf16Plain E{K.P(), PLD};
            pg8::gemm_phase<pg8::EpiBf16Plain, pg8::StaticOrder, PG8_ALIGN, PG8_SP2>(F.lds, g, So, E, F.wave);
        }
        GRID_BAR();
        phase_gla_A2(F, l);
        phase_gmlp_mfma(F, l);
        phase_conv(F, l);
        GRID_BAR();
        phase_gla_C2(F, l);
        GRID_BAR();
        {
            const KA K = KA::fresh(); PHASE_TID;
            pg8::Gemm g{K.XN(), K.WoutT() + (size_t)l * D * D, T, D, D}; pg8::StaticOrder So; int c_ = F.bx; asm volatile("" : "+s"(c_)); So.init(T, D, F.G, c_);
            pg8::EpiF32Res E{K.out(), (l == 0) ? K.in(0) : K.out(), D};
            pg8::gemm_phase<pg8::EpiF32Res, pg8::StaticOrder, PG8_ALIGN, PG8_SP2>(F.lds, g, So, E, F.wave);
        }
        GRID_BAR();
        phase_norm_router_mfma(F, l);
        GRID_BAR();
        phase_scatter(F, l);
        GRID_BAR();
        phase_moe_gu(F, l);
        GRID_BAR();
        phase_moe_down(F, l);
        GRID_BAR();
        phase_combine(F, l);
        if (l + 1 < DEPTH) GRID_BAR();
    }
}

extern "C" void kernel_launch(void* const* d_in, const int* in_sizes, int n_in, void* d_out, int out_size, void* d_ws, size_t ws_size, hipStream_t stream) {
    static int grid_blocks = 0;
    if (!grid_blocks) {
        int dev = 0, cus = 0, per_cu = 0;
        (void)hipGetDevice(&dev);
        (void)hipDeviceGetAttribute(&cus, hipDeviceAttributeMultiprocessorCount, dev);
        (void)hipFuncSetAttribute((const void*)fwd_kernel, hipFuncAttributeMaxDynamicSharedMemorySize, LDS_BYTES);
        (void)hipOccupancyMaxActiveBlocksPerMultiprocessor(&per_cu, fwd_kernel, NT, LDS_BYTES);
        if (per_cu < 1) { fprintf(stderr, "kernel_launch: occupancy query says %d blocks/CU\n", per_cu); per_cu = 1; }
        grid_blocks = cus;
        if (ws_size < WS_END) { fprintf(stderr, "kernel_launch: workspace too small (%zu < %zu)\n", ws_size, (size_t)WS_END); grid_blocks = -1; }
    }
    if (grid_blocks < 0) return;
    (void)hipMemsetAsync((char*)d_ws + WS_CTL, 0, CTL_BYTES, stream);
    Args a{};
    for (int i = 0; i < 20; ++i) a.in[i] = (const float*)d_in[i];
    a.out = (float*)d_out; a.ws = (unsigned char*)d_ws;
    void* args[] = {&a};
    hipError_t e = hipLaunchCooperativeKernel((void*)fwd_kernel, dim3(grid_blocks), dim3(NT), args, LDS_BYTES, stream);
    if (e != hipSuccess) fprintf(stderr, "cooperative launch failed: %s (grid %d)\n", hipGetErrorString(e), grid_blocks);
}
```

```cpp
#include <hip/hip_runtime.h>
#include <hip/hip_cooperative_groups.h>
#include <cstdio>
#include <cstdint>
namespace cg = cooperative_groups;
__device__ __forceinline__ int fresh_lane() { unsigned m = 0xffffffffu; asm volatile("" : "+s"(m)); return (int)__builtin_amdgcn_mbcnt_hi(m, __builtin_amdgcn_mbcnt_lo(m, 0u)); }
__device__ __forceinline__ float shx(float v, int o) { return __int_as_float(__builtin_amdgcn_ds_bpermute((fresh_lane() ^ o) << 2, __float_as_int(v))); }
namespace pg8 {
#define PG8_LAS __attribute__((address_space(3)))
typedef unsigned short bf16_t;
typedef short bf16x8 __attribute__((ext_vector_type(8)));
typedef float f32x4 __attribute__((ext_vector_type(4)));
typedef unsigned u32x4 __attribute__((ext_vector_type(4)));
constexpr int BM = 256, BK = 64, HALF = 128, HTB = HALF * BK * 2  , STAGE_BYTES = 8 * HTB, NXCD = 8, WGM = 8;

__host__ __device__ __forceinline__ int lds_byte(int r, int c) { const int st = (r >> 4) * 2 + (c >> 5), rr = r & 15, cc = c & 31, ob = rr * 64 + cc * 2; return st * 1024 + (ob ^ (((ob >> 9) & 1) << 5)); }
__host__ __device__ __forceinline__ void stage_rc(int b, int& R, int& C) { const int st = b / 1024, sb = b % 1024, swz = sb ^ (((sb >> 9) & 1) << 5); R = (st >> 1) * 16 + swz / 64; C = (st & 1) * 32 + (swz % 64) / 2; }
__host__ __device__ __forceinline__ int perm32(int rho) { const int n = rho >> 4, i = rho & 15; return 8 * (i >> 2) + 4 * n + (i & 3); }

struct Unit { int pm, pn; };
struct Gemm { const bf16_t* A; const bf16_t* Bt; int M, N, K; };

struct StaticOrder {
    int nM, nN, nwg, G, c;
    __host__ __device__ void init(int M, int N, int G_, int c_) { nM = M / BM; nN = N / BM; nwg = nM * nN; G = G_; c = c_; }
    __host__ __device__ bool next(int i, Unit& u) const {
        const long L = (long)i * G + c; if (L >= nwg) return false;
        int wgid = (int)L; { const int q = nwg / NXCD, r = nwg % NXCD, xcd = wgid % NXCD, off = wgid / NXCD; wgid = (xcd < r ? xcd * (q + 1) : r * (q + 1) + (xcd - r) * q) + off; }
        const int nig = WGM * nN, gid = wgid / nig, fm = gid * WGM, gsz = (nM - fm) < WGM ? (nM - fm) : WGM;
        u.pm = fm + ((wgid % nig) % gsz); u.pn = (wgid % nig) / gsz; return true;
    }
    __device__ __forceinline__ void a_ready(const Unit&) const {}
    __device__ __forceinline__ void done(const Unit&) const {}
};


__device__ __forceinline__ unsigned cvt_pk_bf16(float lo, float hi) { unsigned r; asm volatile("v_cvt_pk_bf16_f32 %0, %1, %2" : "=v"(r) : "v"(lo), "v"(hi)); return r; }
struct EpiBf16Plain {
    static constexpr bool PERM = true, AFTER_DRAIN = false;
    bf16_t* O; int ldc;
    __device__ __forceinline__ void operator()(const f32x4 (&acc)[2][2][4][2], const Unit& u, int wr, int wc, int fr, int fq) const {
        const int row0 = u.pm * BM + wr * 64 + fr, col0 = u.pn * BM + wc * 32 + 8 * fq;
#pragma unroll
        for (int ai = 0; ai < 2; ++ai)
#pragma unroll
            for (int m = 0; m < 4; ++m) { bf16_t* rowp = O + (size_t)(row0 + ai * HALF + m * 16) * ldc + col0;
#pragma unroll
                for (int bj = 0; bj < 2; ++bj) { const f32x4 v0 = acc[ai][bj][m][0], v1 = acc[ai][bj][m][1];
                    u32x4 w; w.x = cvt_pk_bf16(v0[0], v0[1]); w.y = cvt_pk_bf16(v0[2], v0[3]); w.z = cvt_pk_bf16(v1[0], v1[1]); w.w = cvt_pk_bf16(v1[2], v1[3]);
                    *(u32x4*)(rowp + bj * HALF) = w; } }
    }
};
struct EpiF32Res {
    static constexpr bool PERM = false, AFTER_DRAIN = false;
    float* C; const float* R; int ldc;
    __device__ __forceinline__ void operator()(const f32x4 (&acc)[2][2][4][2], const Unit& u, int wr, int wc, int fr, int fq) const {
        const int row0 = u.pm * BM + wr * 64 + fr, col0 = u.pn * BM + wc * 32 + 4 * fq;
#pragma unroll
        for (int ai = 0; ai < 2; ++ai)
#pragma unroll
            for (int m = 0; m < 4; ++m) { const size_t off = (size_t)(row0 + ai * HALF + m * 16) * ldc + col0;
#pragma unroll
                for (int bj = 0; bj < 2; ++bj)
#pragma unroll
                    for (int n = 0; n < 2; ++n) { const f32x4 r = *(const f32x4*)(R + off + bj * HALF + n * 16); *(f32x4*)(C + off + bj * HALF + n * 16) = r + acc[ai][bj][m][n]; } }
    }
};
template <class Epi, class Sched, bool ALIGN_EPI = false, bool SP2 = false>
__device__ __forceinline__ void gemm_phase(PG8_LAS unsigned char* lds, const Gemm g, const Sched& S, const Epi& E, int wave_id) {
    asm volatile("" : "+s"(wave_id));
    const int lane = fresh_lane(), wid = wave_id, tid = wid * 64 + lane, wr = wid >> 2, wc = wid & 3, fr = lane & 15, fq = lane >> 4;
    const int K = g.K, nt = K / BK;
    unsigned voffA[2], voffB[2];
#pragma unroll
    for (int i = 0; i < 2; ++i) { int R, C; stage_rc(tid * 16 + i * 8192, R, C); const int Rb = Epi::PERM ? ((R & ~31) + perm32(R & 31)) : R;
        voffA[i] = (unsigned)(R * K + C) * 2u; voffB[i] = (unsigned)(Rb * K + C) * 2u; }
    const size_t kstep = (size_t)(BK * 2);
    const size_t hstep = (size_t)HALF * K * 2;
    const size_t tstep = 2 * hstep;
    const unsigned ldsw = (unsigned)wid * 1024u;
    const int aoff = lds_byte(wr * 64 + fr, fq * 8), boff = lds_byte(wc * 32 + fr, fq * 8);
#define PG8_SA(b, h) (((b) * 2 + (h)) * HTB)
#define PG8_SB(b, h) ((4 + (b) * 2 + (h)) * HTB)
#define PG8_STAGE(bufoff, gbase, voff) do { _Pragma("unroll") for (int _i = 0; _i < 2; ++_i) \
        __builtin_amdgcn_global_load_lds((const unsigned*)((const char*)(gbase) + (voff)[_i]), (PG8_LAS unsigned*)(lds + (bufoff) + ldsw + _i * 8192), 16, 0, 0); } while (0)
#define PG8_LDA(dst, b, h) do { _Pragma("unroll") for (int m = 0; m < 4; ++m) _Pragma("unroll") for (int k = 0; k < 2; ++k) dst[m][k] = *(const PG8_LAS bf16x8*)(lds + PG8_SA(b, h) + aoff + m * 2048 + k * 1024); } while (0)
#define PG8_LDB(dst, b, h) do { _Pragma("unroll") for (int n = 0; n < 2; ++n) _Pragma("unroll") for (int k = 0; k < 2; ++k) dst[n][k] = *(const PG8_LAS bf16x8*)(lds + PG8_SB(b, h) + boff + n * 2048 + k * 1024); } while (0)
#define PG8_MMA(ai, bj, At, Bt) do { __builtin_amdgcn_s_setprio(1); _Pragma("unroll") for (int m = 0; m < 4; ++m) _Pragma("unroll") for (int n = 0; n < 2; ++n) _Pragma("unroll") for (int k = 0; k < 2; ++k) \
        acc[ai][bj][m][n] = __builtin_amdgcn_mfma_f32_16x16x32_bf16(Bt[n][k], At[m][k], acc[ai][bj][m][n], 0, 0, 0); __builtin_amdgcn_s_setprio(0); } while (0)
#define PG8_WAIT_V(n) asm volatile("s_waitcnt vmcnt(" #n ")" ::: "memory")
#define PG8_WAIT_L(n) asm volatile("s_waitcnt lgkmcnt(" #n ")" ::: "memory")
#define PG8_BAR __builtin_amdgcn_s_barrier()
#define PG8_SCHED __builtin_amdgcn_sched_barrier(0)
    Unit cur, nxt; int ui = 0;
    if (!S.next(0, cur)) return;
    f32x4 acc[2][2][4][2];
#pragma unroll
    for (int a = 0; a < 2; ++a)
#pragma unroll
        for (int b = 0; b < 2; ++b)
#pragma unroll
            for (int m = 0; m < 4; ++m)
#pragma unroll
                for (int n = 0; n < 2; ++n) acc[a][b][m][n] = (f32x4){0.f, 0.f, 0.f, 0.f};
    bf16x8 At[4][2], B0[2][2], B1[2][2];
    const char* cA = (const char*)g.A + (size_t)cur.pm * tstep; const char* cB = (const char*)g.Bt + (size_t)cur.pn * tstep;
    S.a_ready(cur);
    if constexpr (SP2) {
        PG8_STAGE(PG8_SB(0, 0), cB, voffB); PG8_STAGE(PG8_SB(0, 1), cB + hstep, voffB); PG8_STAGE(PG8_SA(0, 0), cA, voffA); PG8_STAGE(PG8_SA(0, 1), cA + hstep, voffA);
        if (wr == 1) PG8_BAR;
        PG8_WAIT_V(2); PG8_BAR;
        PG8_STAGE(PG8_SB(1, 0), cB + kstep, voffB); PG8_STAGE(PG8_SA(1, 0), cA + kstep, voffA); PG8_STAGE(PG8_SB(1, 1), cB + hstep + kstep, voffB);
        PG8_WAIT_V(6); PG8_BAR;
    } else {
        PG8_STAGE(PG8_SB(0, 0), cB, voffB); PG8_STAGE(PG8_SA(0, 0), cA, voffA); PG8_STAGE(PG8_SB(0, 1), cB + hstep, voffB); PG8_STAGE(PG8_SA(0, 1), cA + hstep, voffA);
        if (wr == 1) PG8_BAR;
        PG8_WAIT_V(4); PG8_BAR;
        PG8_STAGE(PG8_SB(1, 0), cB + kstep, voffB); PG8_STAGE(PG8_SA(1, 0), cA + kstep, voffA); PG8_STAGE(PG8_SB(1, 1), cB + hstep + kstep, voffB);
        PG8_WAIT_V(6); PG8_BAR;
    }
    for (;;) {
        const bool has_next = S.next(ui + 1, nxt);
        const char* nA = has_next ? (const char*)g.A + (size_t)nxt.pm * tstep : cA; const char* nB = has_next ? (const char*)g.Bt + (size_t)nxt.pn * tstep : cB;
        for (int t = 0; t < nt; t += 2) {
            const bool last = (t == nt - 2);
            const char* a1 = cA + (size_t)(t + 1) * kstep;
            const char* a2 = last ? nA : cA + (size_t)(t + 2) * kstep; const char* b2 = last ? nB : cB + (size_t)(t + 2) * kstep;
            const char* a3 = a2 + kstep; const char* b3 = b2 + kstep;
            if (last && has_next) S.a_ready(nxt);
            if constexpr (SP2) {
            PG8_LDB(B0, 0, 0); PG8_LDB(B1, 0, 1); PG8_SCHED; PG8_LDA(At, 0, 0); PG8_STAGE(PG8_SA(1, 1), a1 + hstep, voffA);
            PG8_WAIT_V(8); PG8_WAIT_L(0); PG8_BAR; PG8_MMA(0, 0, At, B0); PG8_MMA(0, 1, At, B1); PG8_BAR; PG8_SCHED;
            PG8_LDA(At, 0, 1); PG8_STAGE(PG8_SB(0, 0), b2, voffB); PG8_STAGE(PG8_SB(0, 1), b2 + hstep, voffB); PG8_STAGE(PG8_SA(0, 0), a2, voffA);
            PG8_WAIT_V(8); PG8_WAIT_L(0); PG8_BAR; PG8_MMA(1, 0, At, B0); PG8_MMA(1, 1, At, B1); PG8_BAR; PG8_SCHED;
            PG8_LDB(B0, 1, 0); PG8_LDB(B1, 1, 1); PG8_SCHED; PG8_LDA(At, 1, 0); PG8_STAGE(PG8_SA(0, 1), a2 + hstep, voffA);
            PG8_WAIT_V(8); PG8_WAIT_L(0); PG8_BAR; PG8_MMA(0, 0, At, B0); PG8_MMA(0, 1, At, B1); PG8_BAR; PG8_SCHED;
            PG8_LDA(At, 1, 1); PG8_STAGE(PG8_SB(1, 0), b3, voffB); PG8_STAGE(PG8_SB(1, 1), b3 + hstep, voffB); PG8_STAGE(PG8_SA(1, 0), a3, voffA);
            PG8_WAIT_V(8); PG8_WAIT_L(0); PG8_BAR; PG8_MMA(1, 0, At, B0); PG8_MMA(1, 1, At, B1); PG8_BAR; PG8_SCHED;
            } else {
            PG8_LDB(B0, 0, 0); PG8_SCHED; PG8_LDA(At, 0, 0); PG8_STAGE(PG8_SA(1, 1), a1 + hstep, voffA);
            PG8_WAIT_L(8); PG8_BAR; PG8_WAIT_L(0); PG8_MMA(0, 0, At, B0); PG8_BAR; PG8_SCHED;
            PG8_LDB(B1, 0, 1); PG8_STAGE(PG8_SB(0, 0), b2, voffB);
            PG8_BAR; PG8_WAIT_L(0); PG8_MMA(0, 1, At, B1); PG8_BAR;
            PG8_LDA(At, 0, 1); PG8_STAGE(PG8_SA(0, 0), a2, voffA);
            PG8_BAR; PG8_WAIT_L(0); PG8_MMA(1, 0, At, B0); PG8_BAR; PG8_SCHED;
            PG8_STAGE(PG8_SB(0, 1), b2 + hstep, voffB);
            PG8_WAIT_V(6); PG8_BAR; PG8_MMA(1, 1, At, B1); PG8_BAR;
            PG8_LDB(B0, 1, 0); PG8_SCHED; PG8_LDA(At, 1, 0); PG8_STAGE(PG8_SA(0, 1), a2 + hstep, voffA);
            PG8_WAIT_L(8); PG8_BAR; PG8_WAIT_L(0); PG8_MMA(0, 0, At, B0); PG8_BAR; PG8_SCHED;
            PG8_LDB(B1, 1, 1); PG8_STAGE(PG8_SB(1, 0), b3, voffB);
            PG8_BAR; PG8_WAIT_L(0); PG8_MMA(0, 1, At, B1); PG8_BAR;
            PG8_LDA(At, 1, 1); PG8_STAGE(PG8_SA(1, 0), a3, voffA);
            PG8_BAR; PG8_WAIT_L(0); PG8_MMA(1, 0, At, B0); PG8_BAR; PG8_SCHED;
            PG8_STAGE(PG8_SB(1, 1), b3 + hstep, voffB);
            PG8_WAIT_V(6); PG8_BAR; PG8_MMA(1, 1, At, B1); PG8_BAR;
            }
        }
        if constexpr (ALIGN_EPI) { if (wr == 0) PG8_BAR; }
        if constexpr (!Epi::AFTER_DRAIN) { E(acc, cur, wr, wc, fr, fq); S.done(cur); }
        if (!has_next) break;
#pragma unroll
        for (int a = 0; a < 2; ++a)
#pragma unroll
            for (int b = 0; b < 2; ++b)
#pragma unroll
                for (int m = 0; m < 4; ++m)
#pragma unroll
                    for (int n = 0; n < 2; ++n) acc[a][b][m][n] = (f32x4){0.f, 0.f, 0.f, 0.f};
        cur = nxt; cA = nA; cB = nB; ++ui;
        if constexpr (ALIGN_EPI) { if (wr == 1) PG8_BAR; }
    }
    PG8_WAIT_V(0);
    if constexpr (!ALIGN_EPI) { if (wr == 0) PG8_BAR; }
    PG8_BAR;
    if constexpr (Epi::AFTER_DRAIN) { E.fused(acc, cur, wr, wc, fr, fq, lds, wid, lane); S.done(cur); }
#undef PG8_SA
#undef PG8_SB
#undef PG8_STAGE
#undef PG8_LDA
#undef PG8_LDB
#undef PG8_MMA
#undef PG8_WAIT_V
#undef PG8_WAIT_L
#undef PG8_BAR
#undef PG8_SCHED
}

struct MUnit { int r0, rend, e, pn; };
#define MG_LANE_OFFS(u, o) do { const int _t = wid * 64 + fresh_lane(); _Pragma("unroll") for (int _i = 0; _i < 2; ++_i) { int _R, _C; stage_rc(_t * 16 + _i * 8192, _R, _C); _Pragma("unroll") for (int _h = 0; _h < 2; ++_h) { const int _r = (u).r0 + _h * HALF + _R; \
        int _row = _r; if (GATHER) { _row = 0; if (_r < (u).rend) _row = slot_tok[_r]; } (o)[_h][_i] = (unsigned)(_row * K + _C) * 2u; } } } while (0)
template <class Epi, class Sched, bool GATHER, int N, int K>
__device__ __forceinline__ void gemm_phase_moe(PG8_LAS unsigned char* lds, const bf16_t* A, const bf16_t* Bt, const int* slot_tok, const Sched& S, const Epi& E, int wave_id) {
    asm volatile("" : "+s"(wave_id));
    const int lane = fresh_lane(), wid = wave_id, tid = wid * 64 + lane, wr = wid >> 2, wc = wid & 3, fr = lane & 15, fq = lane >> 4;
    constexpr int nt = K / BK;
#define MG_OFFP(par) ((PG8_LAS unsigned*)(lds + STAGE_BYTES + 8192) + (par) * 2048 + tid)
#define MG_VOFFB ((PG8_LAS unsigned*)(lds + STAGE_BYTES + 24576) + tid)
#pragma unroll
    for (int i = 0; i < 2; ++i) { int R, C; stage_rc(tid * 16 + i * 8192, R, C); const int Rb = Epi::PERM ? ((R & ~31) + perm32(R & 31)) : R; MG_VOFFB[i * 512] = (unsigned)(Rb * K + C) * 2u; }
    constexpr size_t kstep = (size_t)(BK * 2);
    constexpr size_t hstep = (size_t)HALF * K * 2;
    constexpr size_t tstep = 2 * hstep;
    constexpr size_t estep = (size_t)N * K * 2;
    const unsigned ldsw = (unsigned)wid * 1024u;
    const int aoff = lds_byte(wr * 64 + fr, fq * 8), boff = lds_byte(wc * 32 + fr, fq * 8);
#define PG8_SA(b, h) (((b) * 2 + (h)) * HTB)
#define PG8_SB(b, h) ((4 + (b) * 2 + (h)) * HTB)
#define PG8_STAGE(bufoff, gbase, voff) do { _Pragma("unroll") for (int _i = 0; _i < 2; ++_i) \
        __builtin_amdgcn_global_load_lds((const unsigned*)((const char*)(gbase) + MG_VOFFB[_i * 512]), (PG8_LAS unsigned*)(lds + (bufoff) + ldsw + _i * 8192), 16, 0, 0); } while (0)
#define MG_STAGE_A(bufoff, par, h, kb) do { _Pragma("unroll") for (int _i = 0; _i < 2; ++_i) \
        __builtin_amdgcn_global_load_lds((const unsigned*)((const char*)A + (size_t)MG_OFFP(par)[((h) * 2 + _i) * 512] + (kb)), (PG8_LAS unsigned*)(lds + (bufoff) + ldsw + _i * 8192), 16, 0, 0); } while (0)
#define PG8_LDA(dst, b, h) do { _Pragma("unroll") for (int m = 0; m < 4; ++m) _Pragma("unroll") for (int k = 0; k < 2; ++k) dst[m][k] = *(const PG8_LAS bf16x8*)(lds + PG8_SA(b, h) + aoff + m * 2048 + k * 1024); } while (0)
#define PG8_LDB(dst, b, h) do { _Pragma("unroll") for (int n = 0; n < 2; ++n) _Pragma("unroll") for (int k = 0; k < 2; ++k) dst[n][k] = *(const PG8_LAS bf16x8*)(lds + PG8_SB(b, h) + boff + n * 2048 + k * 1024); } while (0)
#define PG8_MMA(ai, bj, At, Bt_) do { __builtin_amdgcn_s_setprio(1); _Pragma("unroll") for (int m = 0; m < 4; ++m) _Pragma("unroll") for (int n = 0; n < 2; ++n) _Pragma("unroll") for (int k = 0; k < 2; ++k) \
        acc[ai][bj][m][n] = __builtin_amdgcn_mfma_f32_16x16x32_bf16(Bt_[n][k], At[m][k], acc[ai][bj][m][n], 0, 0, 0); __builtin_amdgcn_s_setprio(0); } while (0)
#define PG8_WAIT_V(n) asm volatile("s_waitcnt vmcnt(" #n ")" ::: "memory")
#define PG8_WAIT_L(n) asm volatile("s_waitcnt lgkmcnt(" #n ")" ::: "memory")
#define PG8_BAR __builtin_amdgcn_s_barrier()
#define PG8_SCHED __builtin_amdgcn_sched_barrier(0)
    MUnit cur, nxt; int ui = 0;
    if (!S.next(0, cur)) return;
    f32x4 acc[2][2][4][2];
#pragma unroll
    for (int a = 0; a < 2; ++a)
#pragma unroll
        for (int b = 0; b < 2; ++b)
#pragma unroll
            for (int m = 0; m < 4; ++m)
#pragma unroll
                for (int n = 0; n < 2; ++n) acc[a][b][m][n] = (f32x4){0.f, 0.f, 0.f, 0.f};
    bf16x8 At[4][2], B0[2][2], B1[2][2];
    { unsigned o_[2][2]; MG_LANE_OFFS(cur, o_); PG8_LAS unsigned* p_ = MG_OFFP(0); p_[0] = o_[0][0]; p_[512] = o_[0][1]; p_[1024] = o_[1][0]; p_[1536] = o_[1][1]; }
    const char* cB = (const char*)Bt + (size_t)cur.e * estep + (size_t)cur.pn * tstep;
    PG8_STAGE(PG8_SB(0, 0), cB, voffB); PG8_STAGE(PG8_SB(0, 1), cB + hstep, voffB); MG_STAGE_A(PG8_SA(0, 0), 0, 0, 0); MG_STAGE_A(PG8_SA(0, 1), 0, 1, 0);
    if (wr == 1) PG8_BAR;
    PG8_WAIT_V(2); PG8_BAR;
    PG8_STAGE(PG8_SB(1, 0), cB + kstep, voffB); MG_STAGE_A(PG8_SA(1, 0), 0, 0, kstep); PG8_STAGE(PG8_SB(1, 1), cB + hstep + kstep, voffB);
    PG8_WAIT_V(6); PG8_BAR;
    for (;;) {
        const bool has_next = S.next(ui + 1, nxt);
        const char* nB = cB;
        const int pc = ui & 1, pn_ = has_next ? (pc ^ 1) : pc;
        if (has_next) { unsigned on[2][2]; MG_LANE_OFFS(nxt, on); nB = (const char*)Bt + (size_t)nxt.e * estep + (size_t)nxt.pn * tstep;
            PG8_LAS unsigned* p_ = MG_OFFP(pn_); p_[0] = on[0][0]; p_[512] = on[0][1]; p_[1024] = on[1][0]; p_[1536] = on[1][1]; }
        for (int t = 0; t < nt; t += 2) {
            const bool last = (t == nt - 2);
            const size_t k1 = (size_t)(t + 1) * kstep, k2 = last ? (size_t)0 : (size_t)(t + 2) * kstep, k3 = k2 + kstep;
            const char* b2 = last ? nB : cB + (size_t)(t + 2) * kstep; const char* b3 = b2 + kstep;
            const int p2 = last ? pn_ : pc;
            PG8_LDB(B0, 0, 0); PG8_LDB(B1, 0, 1); PG8_SCHED; PG8_LDA(At, 0, 0); MG_STAGE_A(PG8_SA(1, 1), pc, 1, k1);
            PG8_WAIT_V(8); PG8_WAIT_L(0); PG8_BAR; PG8_MMA(0, 0, At, B0); PG8_MMA(0, 1, At, B1); PG8_BAR; PG8_SCHED;
            PG8_LDA(At, 0, 1); PG8_STAGE(PG8_SB(0, 0), b2, voffB); PG8_STAGE(PG8_SB(0, 1), b2 + hstep, voffB); MG_STAGE_A(PG8_SA(0, 0), p2, 0, k2);
            PG8_WAIT_V(8); PG8_WAIT_L(0); PG8_BAR; PG8_MMA(1, 0, At, B0); PG8_MMA(1, 1, At, B1); PG8_BAR; PG8_SCHED;
            PG8_LDB(B0, 1, 0); PG8_LDB(B1, 1, 1); PG8_SCHED; PG8_LDA(At, 1, 0); MG_STAGE_A(PG8_SA(0, 1), p2, 1, k2);
            PG8_WAIT_V(8); PG8_WAIT_L(0); PG8_BAR; PG8_MMA(0, 0, At, B0); PG8_MMA(0, 1, At, B1); PG8_BAR; PG8_SCHED;
            PG8_LDA(At, 1, 1); PG8_STAGE(PG8_SB(1, 0), b3, voffB); PG8_STAGE(PG8_SB(1, 1), b3 + hstep, voffB); MG_STAGE_A(PG8_SA(1, 0), p2, 0, k3);
            PG8_WAIT_V(8); PG8_WAIT_L(0); PG8_BAR; PG8_MMA(1, 0, At, B0); PG8_MMA(1, 1, At, B1); PG8_BAR; PG8_SCHED;
        }
        if (wr == 0) PG8_BAR;
        E(acc, cur, wr, wc, fr, fq);
        if (!has_next) break;
#pragma unroll
        for (int a = 0; a < 2; ++a)
#pragma unroll
            for (int b = 0; b < 2; ++b)
#pragma unroll
                for (int m = 0; m < 4; ++m)
#pragma unroll
                    for (int n = 0; n < 2; ++n) acc[a][b][m][n] = (f32x4){0.f, 0.f, 0.f, 0.f};
        cur = nxt; cB = nB; ++ui;
        if (wr == 1) PG8_BAR;
    }
    PG8_WAIT_V(0);
    PG8_BAR;
#undef PG8_SA
#undef PG8_SB
#undef PG8_STAGE
#undef MG_STAGE_A
#undef MG_OFFP
#undef MG_VOFFB
#undef PG8_LDA
#undef PG8_LDB
#undef PG8_MMA
#undef PG8_WAIT_V
#undef PG8_WAIT_L
#undef PG8_BAR
#undef PG8_SCHED
}
__device__ __forceinline__ float fast_silu(float x) { return x * __builtin_amdgcn_rcpf(1.0f + __builtin_amdgcn_exp2f(-1.4426950408889634f * x)); }
struct EpiMoeH {
    static constexpr bool PERM = true;
    bf16_t* H;
    __device__ __forceinline__ void operator()(const f32x4 (&acc)[2][2][4][2], const MUnit& u, int wr, int wc, int fr, int fq) const {
        { const int t_ = fresh_lane(); fr = t_ & 15; fq = t_ >> 4; }
        const int col0 = u.pn * 128 + wc * 32 + 8 * fq;
#pragma unroll
        for (int ai = 0; ai < 2; ++ai)
#pragma unroll
            for (int m = 0; m < 4; ++m) { const int r = u.r0 + ai * HALF + wr * 64 + m * 16 + fr;
                const f32x4 g0 = acc[ai][0][m][0], g1 = acc[ai][0][m][1], u0 = acc[ai][1][m][0], u1 = acc[ai][1][m][1];
                u32x4 w; w.x = cvt_pk_bf16(fast_silu(g0[0]) * u0[0], fast_silu(g0[1]) * u0[1]); w.y = cvt_pk_bf16(fast_silu(g0[2]) * u0[2], fast_silu(g0[3]) * u0[3]);
                w.z = cvt_pk_bf16(fast_silu(g1[0]) * u1[0], fast_silu(g1[1]) * u1[1]); w.w = cvt_pk_bf16(fast_silu(g1[2]) * u1[2], fast_silu(g1[3]) * u1[3]);
                if (r < u.rend) *(u32x4*)(H + (size_t)r * 256 + col0) = w; }
    }
};
struct EpiMoeY {
    static constexpr bool PERM = true;
    bf16_t* Y;
    __device__ __forceinline__ void operator()(const f32x4 (&acc)[2][2][4][2], const MUnit& u, int wr, int wc, int fr, int fq) const {
        { const int t_ = fresh_lane(); fr = t_ & 15; fq = t_ >> 4; }
        const int col0 = u.pn * BM + wc * 32 + 8 * fq;
#pragma unroll
        for (int ai = 0; ai < 2; ++ai)
#pragma unroll
            for (int m = 0; m < 4; ++m) { const int r = u.r0 + ai * HALF + wr * 64 + m * 16 + fr;
#pragma unroll
                for (int bj = 0; bj < 2; ++bj) { const f32x4 v0 = acc[ai][bj][m][0], v1 = acc[ai][bj][m][1];
                    u32x4 w; w.x = cvt_pk_bf16(v0[0], v0[1]); w.y = cvt_pk_bf16(v0[2], v0[3]); w.z = cvt_pk_bf16(v1[0], v1[1]); w.w = cvt_pk_bf16(v1[2], v1[3]);
                    if (r < u.rend) *(u32x4*)(Y + (size_t)r * 1024 + col0 + bj * HALF) = w; } }
    }
};
struct MoeSched {
    const PG8_LAS int* tab;
    int npn, G, c;
    __device__ __forceinline__ bool next(int i, MUnit& u) const {
        const int L = i * G + c, ntile = tab[0];
        if (L >= ntile * npn) return false;
        const int j = L / npn; u.pn = L % npn;
        u.e = __builtin_amdgcn_readfirstlane(tab[4 + 4 * j]); u.r0 = __builtin_amdgcn_readfirstlane(tab[5 + 4 * j]); u.rend = __builtin_amdgcn_readfirstlane(tab[6 + 4 * j]);
        return true;
    }
};
}

#ifndef PG8_SP2
#define PG8_SP2 true
#endif
#ifndef PG8_ALIGN
#define PG8_ALIGN true
#endif

constexpr int NWAVES = 8, NT = NWAVES * 64;
constexpr int D = 1024, NB = 2, S = 8192, T = NB * S, DEPTH = 2;
constexpr int DIN = 2832, PLD = 3072;
constexpr int C_Q = 0, C_K = 256, C_V = 512, C_G = 1024, C_GK = 1536, C_U = 1552, C_VG = 1808, C_XI = 2064, C_BG = 2320, C_CG = 2576;
constexpr int GH = 4, GC = 64, GN = S / GC;
constexpr int MH = 4, MC = 128, MN = S / MC;
constexpr int NE = 32, DE = 256;
constexpr float EPS = 1e-6f;
constexpr size_t MiB = 1u << 20;
constexpr size_t WS_CTL = 0, CTL_BYTES = 1 * MiB;
constexpr size_t WS_WIN = 1 * MiB;
constexpr size_t WS_WOUT = 13 * MiB;
constexpr size_t WS_WGU = 17 * MiB;
constexpr size_t WS_WD = 81 * MiB;
constexpr size_t WS_XN = 113 * MiB;
constexpr size_t WS_P = 145 * MiB;
constexpr size_t WS_Y = WS_P + 17 * MiB;
constexpr size_t WS_S = 241 * MiB;
constexpr size_t WS_DEC = 273 * MiB;
constexpr size_t WS_MISC = 274 * MiB;
constexpr size_t WS_WSP = WS_MISC + 524288;
constexpr size_t WS_WR = 275 * MiB;
constexpr size_t WS_BLKCNT = WS_WR + 524288;
constexpr size_t WS_END = 276 * MiB;
constexpr int CW_BAR = 4096, CW_CNT = 16384;
constexpr int RING_BYTES = 131072, LDSCTL_OFF = RING_BYTES, MISC_OFF = LDSCTL_OFF + 320, LDS_BYTES = 163840;

#define GAS __attribute__((address_space(1)))
#define LAS __attribute__((address_space(3)))
typedef unsigned short bf16;
typedef unsigned v4u __attribute__((ext_vector_type(4)));
typedef unsigned v2u __attribute__((ext_vector_type(2)));
typedef float f32x4 __attribute__((ext_vector_type(4)));
typedef __bf16 bf16x2_t __attribute__((ext_vector_type(2)));
typedef float f32x2_t __attribute__((ext_vector_type(2)));
__device__ __forceinline__ unsigned f2bf(float f) { return (unsigned)__builtin_bit_cast(unsigned short, (__bf16)f); }
__device__ __forceinline__ unsigned pk2(float lo, float hi) { f32x2_t v = {lo, hi}; bf16x2_t b = __builtin_convertvector(v, bf16x2_t); return __builtin_bit_cast(unsigned, b); }
__device__ __forceinline__ float bf2f(unsigned v) { return __uint_as_float(v << 16); }
__device__ __forceinline__ float bflo(unsigned w) { return __uint_as_float(w << 16); }
__device__ __forceinline__ float bfhi(unsigned w) { return __uint_as_float(w & 0xffff0000u); }
__device__ __forceinline__ void unpack8(const v4u q, float (&f)[8]) { f[0] = bflo(q.x); f[1] = bfhi(q.x); f[2] = bflo(q.y); f[3] = bfhi(q.y); f[4] = bflo(q.z); f[5] = bfhi(q.z); f[6] = bflo(q.w); f[7] = bfhi(q.w); }
__device__ __forceinline__ float gelu_tanh(float x) { const float u = 0.7978845608028654f * (x + 0.044715f * x * x * x); return 0.5f * x * (1.0f + tanhf(u)); }
__device__ __forceinline__ float silu(float x) { return x / (1.0f + expf(-x)); }
__device__ __forceinline__ float log_sigmoid(float x) { return fminf(x, 0.f) - log1pf(expf(-fabsf(x))); }

#define XB_TMO      128
#define XB_XCNT(j)  (256  + 64 * (j))
#define XB_XSUB(j)  (1280 + 64 * (j))
#define XB_XGEN(j)  (2304 + 64 * (j))
#define XB_TOP      3328
#define XB_TOPGEN   3392
#define XCD_BAR_WORDS 3456
#define XB_SPIN_CAP (1u << 18)

__device__ __forceinline__ unsigned xb_ld(unsigned* p)              { return __hip_atomic_load(p, __ATOMIC_RELAXED, __HIP_MEMORY_SCOPE_AGENT); }
__device__ __forceinline__ unsigned xb_add(unsigned* p, unsigned v) { return __hip_atomic_fetch_add(p, v, __ATOMIC_RELAXED, __HIP_MEMORY_SCOPE_AGENT); }
__device__ __forceinline__ unsigned xb_xcc_id() { return (unsigned)__builtin_amdgcn_s_getreg((3 << 11) | 20) & 0xFu; }
#define XB_SPIN(cond, bar) do { unsigned _sp = 0; while (cond) { __builtin_amdgcn_s_sleep(1); \
    if ((++_sp & 255u) == 0u) { if (xb_ld(&(bar)[XB_TMO])) break; if (_sp > XB_SPIN_CAP) { atomicAdd(&(bar)[XB_TMO], 1u); break; } } } } while (0)

struct XcdBarrier {
    int wave;
    unsigned* bar; unsigned x;
    volatile LAS unsigned* st;
};

__device__ __forceinline__ XcdBarrier xcd_barrier_post(unsigned* bar, volatile LAS unsigned* st) {
    XcdBarrier b; b.bar = bar; b.x = xb_xcc_id(); b.st = st; b.wave = __builtin_amdgcn_readfirstlane(threadIdx.x >> 6);
    if (threadIdx.x == 0) (void)xb_add(&bar[XB_XCNT(b.x)], 1u);
    return b;
}
__device__ __forceinline__ void xcd_barrier_complete(unsigned* bar, unsigned x, unsigned& nloc, unsigned& nx) {
    const unsigned G = gridDim.x * gridDim.y * gridDim.z;
    unsigned sum, cnt, mine, sp = 0u;
    for (;;) {
        sum = 0u; cnt = 0u; mine = 0u;
#pragma unroll
        for (unsigned j = 0; j < 16; ++j) { const unsigned c = xb_ld(&bar[XB_XCNT(j)]); sum += c; cnt += (c > 0u) ? 1u : 0u; mine = (j == x) ? c : mine; }
        if (sum == G) break;
        __builtin_amdgcn_s_sleep(1);
        if ((++sp & 255u) == 0u) { if (xb_ld(&bar[XB_TMO])) break; if (sp > XB_SPIN_CAP) { atomicAdd(&bar[XB_TMO], 1u); break; } }
    }
    nloc = mine > 0u ? mine : 1u; nx = cnt > 0u ? cnt : 1u;
}

__device__ __forceinline__ void xcd_barrier(const XcdBarrier& b) {
    asm volatile("s_waitcnt vmcnt(0)" ::: "memory");
    __syncthreads();
    if (b.wave == 0 && fresh_lane() == 0) {
        unsigned* bar = b.bar; asm volatile("" : "+s"(bar));
        __builtin_amdgcn_s_waitcnt(0);
        unsigned nloc = b.st[0], nx = b.st[1];
        if (nloc == 0u) { xcd_barrier_complete(bar, b.x, nloc, nx); b.st[0] = nloc; b.st[1] = nx; }
        const unsigned old = xb_add(&bar[XB_XSUB(b.x)], 1u);
        const unsigned gen = old / nloc;
        if (old + 1u == (gen + 1u) * nloc) {
            __builtin_amdgcn_fence(__ATOMIC_RELEASE, "agent");
            asm volatile("s_waitcnt vmcnt(0)" ::: "memory");
            const unsigned og = xb_add(&bar[XB_TOP], 1u);
            const unsigned tg = og / nx;
            if (og + 1u == (tg + 1u) * nx) xb_add(&bar[XB_TOPGEN], 1u);
            else XB_SPIN(xb_ld(&bar[XB_TOPGEN]) == tg, bar);
            __builtin_amdgcn_fence(__ATOMIC_ACQUIRE, "agent");
            xb_add(&bar[XB_XGEN(b.x)], 1u);
            asm volatile("s_waitcnt vmcnt(0)" ::: "memory");
        } else {
            XB_SPIN(xb_ld(&bar[XB_XGEN(b.x)]) == gen, bar);
            __builtin_amdgcn_fence(__ATOMIC_ACQUIRE, "agent");
            asm volatile("s_waitcnt vmcnt(0)" ::: "memory");
        }
    }
    __syncthreads();
}

#define AS4 __attribute__((address_space(4)))
struct KA {
    const AS4 char* ka;
    static __device__ __forceinline__ KA fresh() { KA k; k.ka = (const AS4 char*)__builtin_amdgcn_kernarg_segment_ptr(); asm volatile("" : "+s"(k.ka)); return k; }
    __device__ __forceinline__ const float* in(int i) const { return *(const float* const AS4*)(ka + 8 * i); }
    __device__ __forceinline__ float* out() const { return *(float* const AS4*)(ka + 160); }
    __device__ __forceinline__ unsigned char* ws() const { return *(unsigned char* const AS4*)(ka + 168); }
    __device__ __forceinline__ unsigned* ctl() const { return (unsigned*)(ws() + WS_CTL); }
    __device__ __forceinline__ bf16* WinT() const { return (bf16*)(ws() + WS_WIN); }
    __device__ __forceinline__ bf16* WoutT() const { return (bf16*)(ws() + WS_WOUT); }
    __device__ __forceinline__ bf16* WguT() const { return (bf16*)(ws() + WS_WGU); }
    __device__ __forceinline__ bf16* WdT() const { return (bf16*)(ws() + WS_WD); }
    __device__ __forceinline__ bf16* XN() const { return (bf16*)(ws() + WS_XN); }
    __device__ __forceinline__ bf16* P() const { return (bf16*)(ws() + WS_P); }
    __device__ __forceinline__ bf16* H1() const { return (bf16*)(ws() + WS_P); }
    __device__ __forceinline__ bf16* Y() const { return (bf16*)(ws() + WS_Y); }
    __device__ __forceinline__ float* Sst() const { return (float*)(ws() + WS_S); }
    __device__ __forceinline__ float* dec() const { return (float*)(ws() + WS_DEC); }
    __device__ __forceinline__ int* eid() const { return (int*)(ws() + WS_MISC); }
    __device__ __forceinline__ float* ew() const { return (float*)(ws() + WS_MISC + 131072); }
    __device__ __forceinline__ int* slot_tok() const { return (int*)(ws() + WS_MISC + 2 * 131072); }
    __device__ __forceinline__ int* slot_of() const { return (int*)(ws() + WS_MISC + 3 * 131072); }
    __device__ __forceinline__ bf16* Wsp() const { return (bf16*)(ws() + WS_WSP); }
    __device__ __forceinline__ bf16* Wr() const { return (bf16*)(ws() + WS_WR); }
    __device__ __forceinline__ int* blkcnt() const { return (int*)(ws() + WS_BLKCNT); }
};
struct Frame {
    LAS unsigned char* lds; float* smem;
    int G, bx, wave;
};
#define PHASE_TID const int lane = fresh_lane(), wave = F.wave, tid = wave * 64 + lane; (void)lane; (void)wave; (void)tid

__device__ __forceinline__ float wave_sum(float v) {
    const int ln = fresh_lane();
#pragma unroll
    for (int o = 1; o < 64; o <<= 1) v += __int_as_float(__builtin_amdgcn_ds_bpermute((ln ^ o) << 2, __float_as_int(v)));
    return v;
}

__device__ __forceinline__ void transpose_item(const float* W, int ldw, int nvalid, int k0, int n0, bf16* WT, int ldt, int drow0, LAS float* scr, int lane) {
    const int nl = lane & 31;
#pragma unroll 8
    for (int i = 0; i < 32; ++i) { const int kk = 2 * i + (lane >> 5); scr[kk * 33 + nl] = (nl < nvalid) ? W[(size_t)(k0 + kk) * ldw + n0 + nl] : 0.f; }
    asm volatile("s_waitcnt lgkmcnt(0)" ::: "memory");
    const int c = lane & 7;
#pragma unroll
    for (int j = 0; j < 4; ++j) { const int n = (lane >> 3) + 8 * j; const LAS float* s = scr + (8 * c) * 33 + n;
        v4u o; o.x = pk2(s[0 * 33], s[1 * 33]); o.y = pk2(s[2 * 33], s[3 * 33]); o.z = pk2(s[4 * 33], s[5 * 33]); o.w = pk2(s[6 * 33], s[7 * 33]);
        if (n < nvalid) *(GAS v4u*)(WT + (size_t)(drow0 + n) * ldt + k0 + 8 * c) = o; }
    asm volatile("s_waitcnt lgkmcnt(0)" ::: "memory");
}
__device__ __forceinline__ void rms_row_to_bf16(const float* xrow, const float* gain, bf16* orow, int lane) {
    const f32x4* xr = (const f32x4*)xrow + lane;
    f32x4 v[4]; float s = 0.f;
#pragma unroll
    for (int j = 0; j < 4; ++j) { v[j] = xr[64 * j]; s += (v[j].x * v[j].x + v[j].y * v[j].y) + (v[j].z * v[j].z + v[j].w * v[j].w); }
    const float rs = rsqrtf(wave_sum(s) * (1.f / D) + EPS);
    v2u* o8 = (v2u*)orow + lane;
#pragma unroll
    for (int j = 0; j < 4; ++j) { const f32x4 g = ((const f32x4*)gain)[lane + 64 * j]; v2u w; w.x = pk2(v[j].x * rs * g.x, v[j].y * rs * g.y); w.y = pk2(v[j].z * rs * g.z, v[j].w * rs * g.w); o8[64 * j] = w; }
}
__device__ __forceinline__ void p0_prologue(Frame& F) {
    const KA K = KA::fresh(); PHASE_TID;
    LAS float* scr = (LAS float*)(F.lds + wave * 16384);
    const int gw = F.bx * NWAVES + wave, NGW = F.G * NWAVES;
    constexpr int I_IN = 16 * 89, I_OUT = 16 * 32, I_G = 32 * 16 * 8, I_D = 32 * 4 * 32, I_L = I_IN + I_OUT + 2 * I_G + I_D;
    for (int it = gw; it < DEPTH * I_L; it += NGW) {
        const int l = it / I_L; int r = it % I_L;
        if (r < I_IN) { const int kb = r / 89, nb = r % 89; const int nv = (nb == 88) ? 16 : 32;
            transpose_item(K.in(2) + (size_t)l * D * DIN, DIN, nv, kb * 64, nb * 32, K.WinT() + (size_t)l * PLD * D, D, nb * 32, scr, lane); continue; }
        r -= I_IN;
        if (r < I_OUT) { const int kb = r / 32, nb = r % 32;
            transpose_item(K.in(10) + (size_t)l * D * D, D, 32, kb * 64, nb * 32, K.WoutT() + (size_t)l * D * D, D, nb * 32, scr, lane); continue; }
        r -= I_OUT;
        if (r < 2 * I_G) { const int sel = r / I_G; r %= I_G; const int e = r / 128, kb = (r % 128) / 8, nb = r % 8; const int n0 = nb * 32;
            const float* W = K.in(16 + sel) + ((size_t)l * NE + e) * D * DE;
            transpose_item(W, DE, 32, kb * 64, n0, K.WguT() + ((size_t)l * NE + e) * 512 * D, D, (n0 >> 7) * 256 + sel * 128 + (n0 & 127), scr, lane); continue; }
        r -= 2 * I_G;
        { const int e = r / 128, kb = (r % 128) / 32, nb = r % 32;
            transpose_item(K.in(18) + ((size_t)l * NE + e) * DE * D, D, 32, kb * 64, nb * 32, K.WdT() + ((size_t)l * NE + e) * D * DE, DE, nb * 32, scr, lane); }
    }
    for (int i = F.bx * NT + tid; i < DEPTH * 240 * 128; i += F.G * NT) { const int l = i / (240 * 128), rr = (i / 128) % 240, c = i % 128;
        *(GAS v4u*)(K.WinT() + ((size_t)l * PLD + DIN + rr) * D + c * 8) = (v4u){0u, 0u, 0u, 0u}; }
    for (int i = F.bx * NT + tid; i < DEPTH * 48 * D; i += F.G * NT) { const int ll = i / (48 * D), n = (i / D) % 48, k = i % D;
        float w = 0.f;
        if (n < 4) w = K.in(12)[((size_t)ll * D + k) * 4 + n]; else if (n < 36) w = K.in(14)[((size_t)ll * D + k) * 32 + (n - 4)];
        w *= K.in(11)[(size_t)ll * D + k];
        const unsigned hi = f2bf(w), lo = f2bf(w - bf2f(hi));
        K.Wr()[((size_t)ll * 2 + 0) * 48 * D + (size_t)n * D + k] = (bf16)hi; K.Wr()[((size_t)ll * 2 + 1) * 48 * D + (size_t)n * D + k] = (bf16)lo; }
    for (int i = F.bx * NT + tid; i < DEPTH * MH * 128 * 128 / 8; i += F.G * NT) { const int e0 = i * 8, s0 = e0 & 127, t = (e0 >> 7) & 127;
        const f32x4 a = *(const f32x4*)(K.in(7) + e0), c = *(const f32x4*)(K.in(7) + e0 + 4);
        const float v[8] = {a.x, a.y, a.z, a.w, c.x, c.y, c.z, c.w}; unsigned w[4];
#pragma unroll
        for (int j = 0; j < 4; ++j) w[j] = pk2((s0 + 2 * j <= t) ? v[2 * j] : 0.f, (s0 + 2 * j + 1 <= t) ? v[2 * j + 1] : 0.f);
        *(GAS v4u*)(K.Wsp() + e0) = (v4u){w[0], w[1], w[2], w[3]}; }
    for (int m = gw; m < T; m += NGW) rms_row_to_bf16(K.in(0) + (size_t)m * D, K.in(1), K.XN() + (size_t)m * D, lane);
}

__device__ __forceinline__ void gla_cumdecay(Frame& F, const KA& K, int tid, int l, int h, int t0, float* bb) {
    const float* wup = K.in(3) + (size_t)l * 16 * 256; const float* bgk = K.in(4) + (size_t)l * 256;
    for (int e = tid; e < 64 * 64; e += NT) {
        const int c = e >> 6, d = e & 63;
        const bf16* gl = K.P() + (size_t)(t0 + c) * PLD + C_GK;
        float a = bgk[h * 64 + d];
#pragma unroll
        for (int r = 0; r < 16; ++r) a += bf2f(gl[r]) * wup[r * 256 + h * 64 + d];
        bb[c * 64 + d] = log_sigmoid(a) * (1.0f / 16.0f);
    }
    __syncthreads();
    if (tid < 64) { float run = 0.f; for (int c = 0; c < 64; ++c) { run += bb[c * 64 + tid]; bb[c * 64 + tid] = run; } }
    __syncthreads();
}
__device__ __forceinline__ void phase_gla_kv(Frame& F, int l) {
    const KA K = KA::fresh(); PHASE_TID;
    float* bb = F.smem; float* kd = F.smem + 4096;
#pragma unroll 1
    for (int ci = F.bx; ci < NB * GH * GN; ci += F.G) {
        const int b = ci / (GH * GN), h = (ci / GN) % GH, n = ci % GN, t0 = b * S + n * GC;
        __syncthreads();
        gla_cumdecay(F, K, tid, l, h, t0, bb);
        for (int e = tid; e < 4096; e += NT) { const int c = e >> 6, d = e & 63; kd[e] = bf2f(K.P()[(size_t)(t0 + c) * PLD + C_K + h * 64 + d]) * expf(bb[63 * 64 + d] - bb[e]); }
        __syncthreads();
        const int d = tid >> 3, v0 = (tid & 7) * 16;
        float acc[16];
#pragma unroll
        for (int j = 0; j < 16; ++j) acc[j] = 0.f;
#pragma unroll 2
        for (int c = 0; c < 64; ++c) {
            const float kk = kd[c * 64 + d];
            const v4u* vr = (const v4u*)(K.P() + (size_t)(t0 + c) * PLD + C_V + h * 128 + v0);
            float f[8]; unpack8(vr[0], f);
#pragma unroll
            for (int j = 0; j < 8; ++j) acc[j] += kk * f[j];
            unpack8(vr[1], f);
#pragma unroll
            for (int j = 0; j < 8; ++j) acc[8 + j] += kk * f[j];
        }
        f32x4* o = (f32x4*)(K.Sst() + ((size_t)ci * 64 + d) * 128 + v0);
#pragma unroll
        for (int j = 0; j < 4; ++j) o[j] = (f32x4){acc[4 * j], acc[4 * j + 1], acc[4 * j + 2], acc[4 * j + 3]};
        if (tid < 64) K.dec()[(size_t)ci * 64 + tid] = expf(bb[63 * 64 + tid]);
    }
}
__device__ __forceinline__ void phase_gla_scan(Frame& F) {
    const KA K = KA::fresh(); PHASE_TID;
#pragma unroll 1
    for (int e = F.bx * NT + tid; e < NB * GH * 64 * 128; e += F.G * NT) {
        const int bh = e >> 13, d = (e >> 7) & 63, v = e & 127;
        float* base = K.Sst() + ((size_t)bh * GN * 64 + d) * 128 + v; const float* db = K.dec() + (size_t)bh * GN * 64 + d;
        float st = 0.f;
#pragma unroll 1
        for (int n0 = 0; n0 < GN; n0 += 16) {
            float kvv[16], dd[16];
#pragma unroll
            for (int j = 0; j < 16; ++j) { kvv[j] = base[(size_t)(n0 + j) * 8192]; dd[j] = db[(n0 + j) * 64]; }
#pragma unroll
            for (int j = 0; j < 16; ++j) { base[(size_t)(n0 + j) * 8192] = st; st = dd[j] * st + kvv[j]; }
        }
    }
}
__device__ __forceinline__ void phase_gla_out(Frame& F, int l) {
    const KA K = KA::fresh(); PHASE_TID;
    float* bb = F.smem; float* qd = F.smem + 4096; float* ki = F.smem + 4096 + 64 * 65; float* sc = bb;
    const float* gnorm = K.in(5) + (size_t)l * 128;
#pragma unroll 1
    for (int ci = F.bx; ci < NB * GH * GN; ci += F.G) {
        const int b = ci / (GH * GN), h = (ci / GN) % GH, n = ci % GN, t0 = b * S + n * GC;
        __syncthreads();
        gla_cumdecay(F, K, tid, l, h, t0, bb);
        for (int e = tid; e < 4096; e += NT) {
            const int c = e >> 6, d = e & 63; const float bv = bb[e];
            const bf16* row = K.P() + (size_t)(t0 + c) * PLD;
            qd[c * 65 + d] = bf2f(row[C_Q + h * 64 + d]) * 0.125f * expf(bv);
            ki[c * 65 + d] = bf2f(row[C_K + h * 64 + d]) * expf(-bv);
        }
        __syncthreads();
        {
            const int c = tid >> 3, s0 = (tid & 7) * 8;
            float a[8];
#pragma unroll
            for (int j = 0; j < 8; ++j) a[j] = 0.f;
#pragma unroll 4
            for (int d = 0; d < 64; ++d) { const float qv = qd[c * 65 + d];
#pragma unroll
                for (int j = 0; j < 8; ++j) a[j] += qv * ki[(s0 + j) * 65 + d]; }
#pragma unroll
            for (int j = 0; j < 8; ++j) sc[c * 64 + s0 + j] = (s0 + j <= c) ? a[j] : 0.f;
        }
        __syncthreads();
        const int c = tid >> 3, v0 = (tid & 7) * 16;
        float acc[16];
#pragma unroll
        for (int j = 0; j < 16; ++j) acc[j] = 0.f;
#pragma unroll 2
        for (int s = 0; s <= c; ++s) {
            const float w = sc[c * 64 + s];
            const v4u* vr = (const v4u*)(K.P() + (size_t)(t0 + s) * PLD + C_V + h * 128 + v0);
            float f[8]; unpack8(vr[0], f);
#pragma unroll
            for (int j = 0; j < 8; ++j) acc[j] += w * f[j];
            unpack8(vr[1], f);
#pragma unroll
            for (int j = 0; j < 8; ++j) acc[8 + j] += w * f[j];
        }
#pragma unroll 2
        for (int d = 0; d < 64; ++d) {
            const float w = qd[c * 65 + d];
            const f32x4* sr = (const f32x4*)(K.Sst() + ((size_t)ci * 64 + d) * 128 + v0);
#pragma unroll
            for (int j = 0; j < 4; ++j) { const f32x4 v4 = sr[j]; acc[4 * j] += w * v4.x; acc[4 * j + 1] += w * v4.y; acc[4 * j + 2] += w * v4.z; acc[4 * j + 3] += w * v4.w; }
        }
        float ss = 0.f;
#pragma unroll
        for (int j = 0; j < 16; ++j) ss += acc[j] * acc[j];
        ss += shx(ss, 1); ss += shx(ss, 2); ss += shx(ss, 4);
        const float rs = rsqrtf(ss * (1.0f / 128.0f) + EPS);
        const v4u* gr = (const v4u*)(K.P() + (size_t)(t0 + c) * PLD + C_G + h * 128 + v0);
        float g0[8], g1[8]; unpack8(gr[0], g0); unpack8(gr[1], g1);
        float o[16];
#pragma unroll
        for (int j = 0; j < 8; ++j) { o[j] = acc[j] * rs * gnorm[v0 + j] * silu(g0[j]); o[8 + j] = acc[8 + j] * rs * gnorm[v0 + 8 + j] * silu(g1[j]); }
        v4u* op = (v4u*)(K.XN() + (size_t)(t0 + c) * D + h * 128 + v0);
        op[0] = (v4u){pk2(o[0], o[1]), pk2(o[2], o[3]), pk2(o[4], o[5]), pk2(o[6], o[7])};
        op[1] = (v4u){pk2(o[8], o[9]), pk2(o[10], o[11]), pk2(o[12], o[13]), pk2(o[14], o[15])};
    }
}
__device__ __forceinline__ void phase_gmlp(Frame& F, int l) {
    const KA K = KA::fresh(); PHASE_TID;
    float* vs = F.smem;
    const float* gn = K.in(6) + (size_t)l * 256; const float* wsp = K.in(7) + (size_t)l * MH * 128 * 128; const float* bsp = K.in(8) + (size_t)l * MH * 128;
#pragma unroll 1
    for (int u = F.bx; u < NB * MN * MH; u += F.G) {
        const int b = u / (MN * MH), n = (u / MH) % MN, h = u % MH, t0 = b * S + n * MC;
        __syncthreads();
        const int s = tid >> 2, d0 = (tid & 3) * 16;
        {
            const v4u* vr = (const v4u*)(K.P() + (size_t)(t0 + s) * PLD + C_VG + h * 64 + d0);
            float g[16]; { float f[8]; unpack8(vr[0], f);
#pragma unroll
                for (int j = 0; j < 8; ++j) g[j] = gelu_tanh(f[j]);
                unpack8(vr[1], f);
#pragma unroll
                for (int j = 0; j < 8; ++j) g[8 + j] = gelu_tanh(f[j]); }
            float ss = 0.f;
#pragma unroll
            for (int j = 0; j < 16; ++j) ss += g[j] * g[j];
            ss += shx(ss, 1); ss += shx(ss, 2);
            const float rs = rsqrtf(ss * (1.0f / 64.0f) + EPS);
#pragma unroll
            for (int j = 0; j < 16; ++j) vs[s * 64 + d0 + j] = g[j] * rs * gn[h * 64 + d0 + j];
        }
        __syncthreads();
        const int t = s;
        float acc[16];
#pragma unroll
        for (int j = 0; j < 16; ++j) acc[j] = 0.f;
        const float* wr = wsp + ((size_t)h * 128 + t) * 128;
#pragma unroll 2
        for (int s2 = 0; s2 <= t; ++s2) { const float w = wr[s2];
#pragma unroll
            for (int j = 0; j < 16; ++j) acc[j] += w * vs[s2 * 64 + d0 + j]; }
        const float bias = bsp[h * 128 + t];
        const v4u* ur = (const v4u*)(K.P() + (size_t)(t0 + t) * PLD + C_U + h * 64 + d0);
        float u0[8], u1[8]; unpack8(ur[0], u0); unpack8(ur[1], u1);
        float o[16];
#pragma unroll
        for (int j = 0; j < 8; ++j) { o[j] = gelu_tanh(u0[j]) * (acc[j] + bias); o[8 + j] = gelu_tanh(u1[j]) * (acc[8 + j] + bias); }
        v4u* op = (v4u*)(K.XN() + (size_t)(t0 + t) * D + 512 + h * 64 + d0);
        op[0] = (v4u){pk2(o[0], o[1]), pk2(o[2], o[3]), pk2(o[4], o[5]), pk2(o[6], o[7])};
        op[1] = (v4u){pk2(o[8], o[9]), pk2(o[10], o[11]), pk2(o[12], o[13]), pk2(o[14], o[15])};
    }
}
typedef short bf16x8 __attribute__((ext_vector_type(8)));
__device__ __forceinline__ float fexp(float x) { return __builtin_amdgcn_exp2f(x * 1.4426950408889634f); }
__device__ __forceinline__ float logsig_fast(float x) { return fminf(x, 0.f) - __log2f(1.0f + fexp(-fabsf(x))) * 0.6931471805599453f; }
__device__ __forceinline__ float silu_fast(float x) { return x * __builtin_amdgcn_rcpf(1.0f + __builtin_amdgcn_exp2f(-1.4426950408889634f * x)); }
__device__ __forceinline__ float gelu_fast(float x) { const float u = 0.7978845608028654f * (x + 0.044715f * x * x * x); return x * __builtin_amdgcn_rcpf(1.0f + __builtin_amdgcn_exp2f(-2.8853900817779268f * u)); }
__device__ __forceinline__ f32x4 mfma16(bf16x8 a, bf16x8 b, f32x4 c) { return __builtin_amdgcn_mfma_f32_16x16x32_bf16(a, b, c, 0, 0, 0); }
constexpr int LROWB = 144;
constexpr int L_QD = 0, L_KI = 9216, L_KDT = 18432, L_VT = 27648, L_S = 46080, L_ST = 55296, L_OB = 73728, L_TOT = 107520, OBROW = 528;
#define FRAG(base, row, kel) (*(const LAS bf16x8*)(lds + (base) + (row) * LROWB + (kel) * 2))

__device__ __forceinline__ float gla_b8(const KA& K, LAS unsigned char* lds, int l, int h, int t0, int lane, int wave, float (&bv)[8]) {
    const float* wup = K.in(3) + (size_t)l * 16 * 256 + h * 64 + lane;
    float wu[16];
#pragma unroll
    for (int r = 0; r < 16; ++r) wu[r] = wup[r * 256];
    const float bg = K.in(4)[l * 256 + h * 64 + lane];
    const bf16* P = K.P();
    float run = 0.f;
#pragma unroll
    for (int j = 0; j < 8; ++j) {
        const bf16* gl = P + (size_t)(t0 + 8 * wave + j) * PLD + C_GK;
        float f0[8], f1[8]; unpack8(*(const v4u*)gl, f0); unpack8(*(const v4u*)(gl + 8), f1);
        float a = bg;
#pragma unroll
        for (int r = 0; r < 8; ++r) a += f0[r] * wu[r];
#pragma unroll
        for (int r = 0; r < 8; ++r) a += f1[r] * wu[8 + r];
        run += logsig_fast(a) * (1.0f / 16.0f); bv[j] = run;
    }
    LAS float* tot = (LAS float*)(lds + L_TOT);
    tot[wave * 64 + lane] = run;
    __syncthreads();
    float base = 0.f, all = 0.f;
#pragma unroll
    for (int g = 0; g < 8; ++g) { const float tv = tot[g * 64 + lane]; all += tv; if (g < wave) base += tv; }
#pragma unroll
    for (int j = 0; j < 8; ++j) bv[j] += base;
    return all;
}
__device__ __forceinline__ void gla_stage_vT(const bf16* P, LAS unsigned char* lds, int h, int t0, int tid) {
    const int vv = tid & 127, cq = tid >> 7;
    const bf16* vp = P + (size_t)(t0 + 16 * cq) * PLD + C_V + h * 128 + vv;
    unsigned w[8];
#pragma unroll
    for (int j = 0; j < 8; ++j) w[j] = (unsigned)vp[(size_t)(2 * j) * PLD] | ((unsigned)vp[(size_t)(2 * j + 1) * PLD] << 16);
    LAS v4u* dst = (LAS v4u*)(lds + L_VT + vv * LROWB + cq * 32);
    dst[0] = (v4u){w[0], w[1], w[2], w[3]}; dst[1] = (v4u){w[4], w[5], w[6], w[7]};
}

__device__ __forceinline__ void phase_gla_kv_mfma(Frame& F, int l) {
    const KA K = KA::fresh(); PHASE_TID;
    LAS unsigned char* lds = F.lds;
    const int fr = lane & 15, fq = lane >> 4;
#pragma unroll 1
    for (int ci = F.bx; ci < NB * GH * GN; ci += F.G) {
        const int b = ci / (GH * GN), h = (ci / GN) % GH, n = ci % GN, t0 = b * S + n * GC;
        const bf16* P = K.P();
        __syncthreads();
        float bv[8]; const float bl = gla_b8(K, lds, l, h, t0, lane, wave, bv);
        {
            const bf16* kp = P + (size_t)(t0 + 8 * wave) * PLD + C_K + h * 64 + lane;
            float kd[8];
#pragma unroll
            for (int j = 0; j < 8; ++j) kd[j] = bf2f(kp[(size_t)j * PLD]) * fexp(bl - bv[j]);
            *(LAS v4u*)(lds + L_KDT + lane * LROWB + wave * 16) = (v4u){pk2(kd[0], kd[1]), pk2(kd[2], kd[3]), pk2(kd[4], kd[5]), pk2(kd[6], kd[7])};
        }
        gla_stage_vT(P, lds, h, t0, tid);
        if (wave == 0) K.dec()[(size_t)ci * 64 + lane] = fexp(bl);
        __syncthreads();
        bf16x8 Bf[2];
#pragma unroll
        for (int ks = 0; ks < 2; ++ks) Bf[ks] = FRAG(L_VT, 16 * wave + fr, 32 * ks + 8 * fq);
        float* so = K.Sst() + (size_t)ci * 64 * 128 + 16 * wave + fr;
#pragma unroll
        for (int dt = 0; dt < 4; ++dt) {
            f32x4 acc = (f32x4){0.f, 0.f, 0.f, 0.f};
#pragma unroll
            for (int ks = 0; ks < 2; ++ks) acc = mfma16(FRAG(L_KDT, 16 * dt + fr, 32 * ks + 8 * fq), Bf[ks], acc);
#pragma unroll
            for (int r = 0; r < 4; ++r) so[(size_t)(16 * dt + 4 * fq + r) * 128] = acc[r];
        }
    }
}

__device__ __forceinline__ void phase_gla_out_mfma(Frame& F, int l) {
    const KA K = KA::fresh(); PHASE_TID;
    LAS unsigned char* lds = F.lds;
    const int fr = lane & 15, fq = lane >> 4;
    const float* gnorm = K.in(5) + (size_t)l * 128;
#pragma unroll 1
    for (int ci = F.bx; ci < NB * GH * GN; ci += F.G) {
        const int b = ci / (GH * GN), h = (ci / GN) % GH, n = ci % GN, t0 = b * S + n * GC;
        const bf16* P = K.P();
        __syncthreads();
        float bv[8]; (void)gla_b8(K, lds, l, h, t0, lane, wave, bv);
        {
            const bf16* qp = P + (size_t)(t0 + 8 * wave) * PLD + C_Q + h * 64 + lane;
            const bf16* kp = qp + (C_K - C_Q);
#pragma unroll
            for (int j = 0; j < 8; ++j) {
                const float e = fexp(bv[j]);
                const float qv = bf2f(qp[(size_t)j * PLD]) * 0.125f * e, kv = bf2f(kp[(size_t)j * PLD]) * __builtin_amdgcn_rcpf(e);
                *(LAS bf16*)(lds + L_QD + (8 * wave + j) * LROWB + lane * 2) = (bf16)f2bf(qv);
                *(LAS bf16*)(lds + L_KI + (8 * wave + j) * LROWB + lane * 2) = (bf16)f2bf(kv);
            }
        }
        gla_stage_vT(P, lds, h, t0, tid);
        {
            const int vv = tid & 127, dq = tid >> 7;
            const float* sp = K.Sst() + ((size_t)ci * 64 + 16 * dq) * 128 + vv;
            unsigned w[8];
#pragma unroll
            for (int j = 0; j < 8; ++j) w[j] = pk2(sp[(size_t)(2 * j) * 128], sp[(size_t)(2 * j + 1) * 128]);
            LAS v4u* dst = (LAS v4u*)(lds + L_ST + vv * LROWB + dq * 32);
            dst[0] = (v4u){w[0], w[1], w[2], w[3]}; dst[1] = (v4u){w[4], w[5], w[6], w[7]};
        }
        __syncthreads();
#pragma unroll
        for (int i = 0; i < 2; ++i) {
            const int tix = 2 * wave + i, st = tix >> 2, ct = tix & 3;
            f32x4 acc = (f32x4){0.f, 0.f, 0.f, 0.f};
#pragma unroll
            for (int ks = 0; ks < 2; ++ks) acc = mfma16(FRAG(L_KI, 16 * st + fr, 32 * ks + 8 * fq), FRAG(L_QD, 16 * ct + fr, 32 * ks + 8 * fq), acc);
            const int s0 = 16 * st + 4 * fq, c = 16 * ct + fr;
            float m[4];
#pragma unroll
            for (int r = 0; r < 4; ++r) m[r] = (s0 + r <= c) ? acc[r] : 0.f;
            *(LAS v2u*)(lds + L_S + c * LROWB + s0 * 2) = (v2u){pk2(m[0], m[1]), pk2(m[2], m[3])};
        }
        __syncthreads();
        {
            bf16x8 Av[2], As[2];
#pragma unroll
            for (int ks = 0; ks < 2; ++ks) { Av[ks] = FRAG(L_VT, 16 * wave + fr, 32 * ks + 8 * fq); As[ks] = FRAG(L_ST, 16 * wave + fr, 32 * ks + 8 * fq); }
#pragma unroll
            for (int ct = 0; ct < 4; ++ct) {
                f32x4 acc = (f32x4){0.f, 0.f, 0.f, 0.f};
#pragma unroll
                for (int ks = 0; ks < 2; ++ks) { acc = mfma16(Av[ks], FRAG(L_S, 16 * ct + fr, 32 * ks + 8 * fq), acc); acc = mfma16(As[ks], FRAG(L_QD, 16 * ct + fr, 32 * ks + 8 * fq), acc); }
                *(LAS f32x4*)(lds + L_OB + (16 * ct + fr) * OBROW + (16 * wave + 4 * fq) * 4) = acc;
            }
        }
        __syncthreads();
        {
            const int c = tid >> 3, vg = tid & 7;
            const LAS f32x4* ob = (const LAS f32x4*)(lds + L_OB + c * OBROW + vg * 64);
            f32x4 o[4]; float ss = 0.f;
#pragma unroll
            for (int j = 0; j < 4; ++j) { o[j] = ob[j]; ss += (o[j].x * o[j].x + o[j].y * o[j].y) + (o[j].z * o[j].z + o[j].w * o[j].w); }
            ss += shx(ss, 1); ss += shx(ss, 2); ss += shx(ss, 4);
            const float rs = rsqrtf(ss * (1.0f / 128.0f) + EPS);
            const v4u* gr = (const v4u*)(P + (size_t)(t0 + c) * PLD + C_G + h * 128 + 16 * vg);
            float g0[8], g1[8]; unpack8(gr[0], g0); unpack8(gr[1], g1);
            const f32x4* gn = (const f32x4*)(gnorm + 16 * vg);
            const f32x4 n0 = gn[0], n1 = gn[1], n2 = gn[2], n3 = gn[3];
            v4u w0, w1;
            w0.x = pk2(o[0].x * rs * n0.x * silu_fast(g0[0]), o[0].y * rs * n0.y * silu_fast(g0[1])); w0.y = pk2(o[0].z * rs * n0.z * silu_fast(g0[2]), o[0].w * rs * n0.w * silu_fast(g0[3]));
            w0.z = pk2(o[1].x * rs * n1.x * silu_fast(g0[4]), o[1].y * rs * n1.y * silu_fast(g0[5])); w0.w = pk2(o[1].z * rs * n1.z * silu_fast(g0[6]), o[1].w * rs * n1.w * silu_fast(g0[7]));
            w1.x = pk2(o[2].x * rs * n2.x * silu_fast(g1[0]), o[2].y * rs * n2.y * silu_fast(g1[1])); w1.y = pk2(o[2].z * rs * n2.z * silu_fast(g1[2]), o[2].w * rs * n2.w * silu_fast(g1[3]));
            w1.z = pk2(o[3].x * rs * n3.x * silu_fast(g1[4]), o[3].y * rs * n3.y * silu_fast(g1[5])); w1.w = pk2(o[3].z * rs * n3.z * silu_fast(g1[6]), o[3].w * rs * n3.w * silu_fast(g1[7]));
            v4u* op = (v4u*)(K.XN() + (size_t)(t0 + c) * D + h * 128 + 16 * vg);
            op[0] = w0; op[1] = w1;
        }
    }
}
#undef FRAG


constexpr int L_GKL = 109568, L_BL = 117760, SCN = 4, NSC = GN / SCN, NITEM = NB * GH * NSC;
#define FRAG(base, row, kel) (*(const LAS bf16x8*)(lds + (base) + (row) * LROWB + (kel) * 2))
struct GlaPre { unsigned short k[8], q[8], v[16]; v4u g0, g1; };
template <bool WITH_Q>
__device__ __forceinline__ void gla_prefetch(GlaPre& p, const bf16* P, int h, int t0, int tid, int lane, int wave) {
    const bf16* kp = P + (size_t)(t0 + 8 * wave) * PLD + C_K + h * 64 + lane;
#pragma unroll
    for (int j = 0; j < 8; ++j) p.k[j] = kp[(size_t)j * PLD];
    const int vv = tid & 127, cq = tid >> 7;
    const bf16* vp = P + (size_t)(t0 + 16 * cq) * PLD + C_V + h * 128 + vv;
#pragma unroll
    for (int j = 0; j < 16; ++j) p.v[j] = vp[(size_t)j * PLD];
    if (WITH_Q) {
        const bf16* qp = kp + (C_Q - C_K);
#pragma unroll
        for (int j = 0; j < 8; ++j) p.q[j] = qp[(size_t)j * PLD];
        const v4u* gr = (const v4u*)(P + (size_t)(t0 + (tid >> 3)) * PLD + C_G + h * 128 + 16 * (tid & 7));
        p.g0 = gr[0]; p.g1 = gr[1];
    }
}
__device__ __forceinline__ void gla_stage_gkl(const bf16* P, LAS unsigned char* lds, int tok0, int tid) {
    *(LAS v4u*)(lds + L_GKL + tid * 16) = *(const v4u*)(P + (size_t)(tok0 + (tid >> 1)) * PLD + C_GK + 8 * (tid & 1));
}
__device__ __forceinline__ void gla_b8_part(LAS unsigned char* lds, const float (&wu)[16], float bg, int n, int lane, int wave, float (&bv)[8]) {
    float run = 0.f;
#pragma unroll
    for (int j = 0; j < 8; ++j) {
        const LAS v4u* gl = (const LAS v4u*)(lds + L_GKL + (n * 64 + 8 * wave + j) * 32);
        float f0[8], f1[8]; unpack8(gl[0], f0); unpack8(gl[1], f1);
        float a = bg;
#pragma unroll
        for (int r = 0; r < 8; ++r) a += f0[r] * wu[r];
#pragma unroll
        for (int r = 0; r < 8; ++r) a += f1[r] * wu[8 + r];
        run += logsig_fast(a) * (1.0f / 16.0f); bv[j] = run;
    }
    ((LAS float*)(lds + L_TOT))[wave * 64 + lane] = run;
}
__device__ __forceinline__ float gla_b8_finish(LAS unsigned char* lds, int lane, int wave, float (&bv)[8]) {
    const LAS float* tot = (const LAS float*)(lds + L_TOT);
    float base = 0.f, all = 0.f;
#pragma unroll
    for (int g = 0; g < 8; ++g) { const float tv = tot[g * 64 + lane]; all += tv; if (g < wave) base += tv; }
#pragma unroll
    for (int j = 0; j < 8; ++j) bv[j] += base;
    return all;
}
__device__ __forceinline__ void gla_write_kdT_vT(LAS unsigned char* lds, const GlaPre& p, const float (&bv)[8], float bl, int tid, int lane, int wave) {
    float kd[8];
#pragma unroll
    for (int j = 0; j < 8; ++j) kd[j] = bf2f(p.k[j]) * fexp(bl - bv[j]);
    *(LAS v4u*)(lds + L_KDT + lane * LROWB + wave * 16) = (v4u){pk2(kd[0], kd[1]), pk2(kd[2], kd[3]), pk2(kd[4], kd[5]), pk2(kd[6], kd[7])};
    const int vv = tid & 127, cq = tid >> 7;
    LAS v4u* dst = (LAS v4u*)(lds + L_VT + vv * LROWB + cq * 32);
    dst[0] = (v4u){(unsigned)p.v[0] | ((unsigned)p.v[1] << 16), (unsigned)p.v[2] | ((unsigned)p.v[3] << 16), (unsigned)p.v[4] | ((unsigned)p.v[5] << 16), (unsigned)p.v[6] | ((unsigned)p.v[7] << 16)};
    dst[1] = (v4u){(unsigned)p.v[8] | ((unsigned)p.v[9] << 16), (unsigned)p.v[10] | ((unsigned)p.v[11] << 16), (unsigned)p.v[12] | ((unsigned)p.v[13] << 16), (unsigned)p.v[14] | ((unsigned)p.v[15] << 16)};
    if (wave == 0) ((LAS float*)(lds + L_BL))[lane] = bl;
}
__device__ __forceinline__ void gla_kv_mfma(LAS unsigned char* lds, int wave, int fr, int fq, f32x4 (&acc)[4]) {
    bf16x8 Bf[2];
#pragma unroll
    for (int ks = 0; ks < 2; ++ks) Bf[ks] = FRAG(L_VT, 16 * wave + fr, 32 * ks + 8 * fq);
#pragma unroll
    for (int dt = 0; dt < 4; ++dt) { acc[dt] = (f32x4){0.f, 0.f, 0.f, 0.f};
#pragma unroll
        for (int ks = 0; ks < 2; ++ks) acc[dt] = mfma16(FRAG(L_KDT, 16 * dt + fr, 32 * ks + 8 * fq), Bf[ks], acc[dt]); }
}

__device__ __forceinline__ void phase_gla_A2(Frame& F, int l) {
    const KA K = KA::fresh(); PHASE_TID;
    LAS unsigned char* lds = F.lds;
    const int fr = lane & 15, fq = lane >> 4;
#pragma unroll 1
    for (int it = F.bx; it < NITEM; it += F.G) {
        const int b = it / (GH * NSC), h = (it / NSC) % GH, sc = it % NSC, tok0 = b * S + sc * SCN * GC;
        const bf16* P = K.P();
        float wu[16];
        { const float* wup = K.in(3) + (size_t)l * 16 * 256 + h * 64 + lane;
#pragma unroll
          for (int r = 0; r < 16; ++r) wu[r] = wup[r * 256]; }
        const float bg = K.in(4)[l * 256 + h * 64 + lane];
        GlaPre pre[2]; gla_prefetch<false>(pre[0], P, h, tok0, tid, lane, wave); gla_prefetch<false>(pre[1], P, h, tok0 + GC, tid, lane, wave);
        __syncthreads();
        gla_stage_gkl(P, lds, tok0, tid);
        __syncthreads();
        f32x4 Sl[4], bs[4];
#pragma unroll
        for (int dt = 0; dt < 4; ++dt) { Sl[dt] = (f32x4){0.f, 0.f, 0.f, 0.f}; bs[dt] = (f32x4){0.f, 0.f, 0.f, 0.f}; }
#pragma unroll
        for (int n = 0; n < SCN; ++n) {
            float bv[8]; gla_b8_part(lds, wu, bg, n, lane, wave, bv);
            __syncthreads();
            const float bl = gla_b8_finish(lds, lane, wave, bv);
            gla_write_kdT_vT(lds, pre[n & 1], bv, bl, tid, lane, wave);
            if (n + 2 < SCN) gla_prefetch<false>(pre[n & 1], P, h, tok0 + (n + 2) * GC, tid, lane, wave);
            __syncthreads();
            f32x4 acc[4]; gla_kv_mfma(lds, wave, fr, fq, acc);
#pragma unroll
            for (int dt = 0; dt < 4; ++dt) { const f32x4 bl4 = *(const LAS f32x4*)(lds + L_BL + (16 * dt + 4 * fq) * 4);
                bs[dt] = bs[dt] + bl4;
#pragma unroll
                for (int r = 0; r < 4; ++r) Sl[dt][r] = fexp(bl4[r]) * Sl[dt][r] + acc[dt][r]; }
        }
        f32x4* ag = (f32x4*)K.Sst() + ((size_t)(it * 8 + wave) * 4) * 64 + lane;
#pragma unroll
        for (int dt = 0; dt < 4; ++dt) ag[dt * 64] = Sl[dt];
        if (wave == 0 && fr == 0) { f32x4* dp = (f32x4*)K.dec() + (size_t)it * 16 + fq;
#pragma unroll
            for (int dt = 0; dt < 4; ++dt) dp[dt * 4] = (f32x4){fexp(bs[dt][0]), fexp(bs[dt][1]), fexp(bs[dt][2]), fexp(bs[dt][3])}; }
    }
}


__device__ __forceinline__ void phase_gla_aggscan(Frame& F) {
    const KA K = KA::fresh(); PHASE_TID;
#pragma unroll 1
    for (int e = F.bx * NT + tid; e < NB * GH * 8192; e += F.G * NT) {
        const int bh = e >> 13, el = e & 8191, ln = (el >> 2) & 63, dt = (el >> 8) & 3, r = el & 3;
        float* ap = K.Sst() + (size_t)bh * NSC * 8192 + el; const float* dp = K.dec() + (size_t)bh * NSC * 64 + dt * 16 + (ln >> 4) * 4 + r;
        float a[NSC], d[NSC];
#pragma unroll
        for (int j = 0; j < NSC; ++j) { a[j] = ap[(size_t)j * 8192]; d[j] = dp[j * 64]; }
        float st = 0.f;
#pragma unroll
        for (int j = 0; j < NSC; ++j) { ap[(size_t)j * 8192] = st; st = d[j] * st + a[j]; }
    }
}
__device__ __forceinline__ void phase_gla_C2(Frame& F, int l) {
    const KA K = KA::fresh(); PHASE_TID;
    LAS unsigned char* lds = F.lds;
    const int fr = lane & 15, fq = lane >> 4;
    const float* gnorm = K.in(5) + (size_t)l * 128;
#pragma unroll 1
    for (int it = F.bx; it < NITEM; it += F.G) {
        const int b = it / (GH * NSC), h = (it / NSC) % GH, sc = it % NSC, tok0 = b * S + sc * SCN * GC;
        const bf16* P = K.P();
        float wu[16];
        { const float* wup = K.in(3) + (size_t)l * 16 * 256 + h * 64 + lane;
#pragma unroll
          for (int r = 0; r < 16; ++r) wu[r] = wup[r * 256]; }
        const float bg = K.in(4)[l * 256 + h * 64 + lane];
        GlaPre pre[2]; gla_prefetch<true>(pre[0], P, h, tok0, tid, lane, wave); gla_prefetch<true>(pre[1], P, h, tok0 + GC, tid, lane, wave);
        __syncthreads();
        gla_stage_gkl(P, lds, tok0, tid);
        f32x4 Sm[4];
        { const f32x4* ag = (const f32x4*)K.Sst() + ((size_t)(it * 8 + wave) * 4) * 64 + lane;
#pragma unroll
          for (int dt = 0; dt < 4; ++dt) Sm[dt] = ag[dt * 64]; }
        __syncthreads();
#pragma unroll
        for (int n = 0; n < SCN; ++n) {
            const int t0 = tok0 + n * GC;
            GlaPre& pr = pre[n & 1];
            float bv[8]; gla_b8_part(lds, wu, bg, n, lane, wave, bv);
            __syncthreads();
            const float bl = gla_b8_finish(lds, lane, wave, bv);
            gla_write_kdT_vT(lds, pr, bv, bl, tid, lane, wave);
#pragma unroll
            for (int j = 0; j < 8; ++j) {
                const float e = fexp(bv[j]);
                *(LAS bf16*)(lds + L_QD + (8 * wave + j) * LROWB + lane * 2) = (bf16)f2bf(bf2f(pr.q[j]) * 0.125f * e);
                *(LAS bf16*)(lds + L_KI + (8 * wave + j) * LROWB + lane * 2) = (bf16)f2bf(bf2f(pr.k[j]) * __builtin_amdgcn_rcpf(e));
            }
#pragma unroll
            for (int dt = 0; dt < 4; ++dt) *(LAS v2u*)(lds + L_ST + (16 * wave + fr) * LROWB + (16 * dt + 4 * fq) * 2) = (v2u){pk2(Sm[dt][0], Sm[dt][1]), pk2(Sm[dt][2], Sm[dt][3])};
            const v4u gq0 = pr.g0, gq1 = pr.g1;
            if (n + 2 < SCN) gla_prefetch<true>(pr, P, h, t0 + 2 * GC, tid, lane, wave);
            __syncthreads();
#pragma unroll
            for (int i = 0; i < 2; ++i) {
                const int tix = 2 * wave + i, st = tix >> 2, ct = tix & 3;
                f32x4 a = (f32x4){0.f, 0.f, 0.f, 0.f};
#pragma unroll
                for (int ks = 0; ks < 2; ++ks) a = mfma16(FRAG(L_KI, 16 * st + fr, 32 * ks + 8 * fq), FRAG(L_QD, 16 * ct + fr, 32 * ks + 8 * fq), a);
                const int s0 = 16 * st + 4 * fq, c = 16 * ct + fr;
                float m[4];
#pragma unroll
                for (int r = 0; r < 4; ++r) m[r] = (s0 + r <= c) ? a[r] : 0.f;
                *(LAS v2u*)(lds + L_S + c * LROWB + s0 * 2) = (v2u){pk2(m[0], m[1]), pk2(m[2], m[3])};
            }
            f32x4 kv[4]; gla_kv_mfma(lds, wave, fr, fq, kv);
            __syncthreads();
            {
                bf16x8 Av[2], As[2];
#pragma unroll
                for (int ks = 0; ks < 2; ++ks) { Av[ks] = FRAG(L_VT, 16 * wave + fr, 32 * ks + 8 * fq); As[ks] = FRAG(L_ST, 16 * wave + fr, 32 * ks + 8 * fq); }
#pragma unroll
                for (int ct = 0; ct < 4; ++ct) {
                    f32x4 a = (f32x4){0.f, 0.f, 0.f, 0.f};
#pragma unroll
                    for (int ks = 0; ks < 2; ++ks) { a = mfma16(Av[ks], FRAG(L_S, 16 * ct + fr, 32 * ks + 8 * fq), a); a = mfma16(As[ks], FRAG(L_QD, 16 * ct + fr, 32 * ks + 8 * fq), a); }
                    *(LAS f32x4*)(lds + L_OB + (16 * ct + fr) * OBROW + (16 * wave + 4 * fq) * 4) = a;
                }
            }
#pragma unroll
            for (int dt = 0; dt < 4; ++dt) { const f32x4 bl4 = *(const LAS f32x4*)(lds + L_BL + (16 * dt + 4 * fq) * 4);
#pragma unroll
                for (int r = 0; r < 4; ++r) Sm[dt][r] = fexp(bl4[r]) * Sm[dt][r] + kv[dt][r]; }
            __syncthreads();
            {
                const int c = tid >> 3, vg = tid & 7;
                const LAS f32x4* ob = (const LAS f32x4*)(lds + L_OB + c * OBROW + vg * 64);
                f32x4 o[4]; float ss = 0.f;
#pragma unroll
                for (int j = 0; j < 4; ++j) { o[j] = ob[j]; ss += (o[j].x * o[j].x + o[j].y * o[j].y) + (o[j].z * o[j].z + o[j].w * o[j].w); }
                ss += shx(ss, 1); ss += shx(ss, 2); ss += shx(ss, 4);
                const float rs = rsqrtf(ss * (1.0f / 128.0f) + EPS);
                float g0[8], g1[8]; unpack8(gq0, g0); unpack8(gq1, g1);
                const f32x4* gn = (const f32x4*)(gnorm + 16 * vg);
                const f32x4 n0 = gn[0], n1 = gn[1], n2 = gn[2], n3 = gn[3];
                v4u w0, w1;
                w0.x = pk2(o[0].x * rs * n0.x * silu_fast(g0[0]), o[0].y * rs * n0.y * silu_fast(g0[1])); w0.y = pk2(o[0].z * rs * n0.z * silu_fast(g0[2]), o[0].w * rs * n0.w * silu_fast(g0[3]));
                w0.z = pk2(o[1].x * rs * n1.x * silu_fast(g0[4]), o[1].y * rs * n1.y * silu_fast(g0[5])); w0.w = pk2(o[1].z * rs * n1.z * silu_fast(g0[6]), o[1].w * rs * n1.w * silu_fast(g0[7]));
                w1.x = pk2(o[2].x * rs * n2.x * silu_fast(g1[0]), o[2].y * rs * n2.y * silu_fast(g1[1])); w1.y = pk2(o[2].z * rs * n2.z * silu_fast(g1[2]), o[2].w * rs * n2.w * silu_fast(g1[3]));
                w1.z = pk2(o[3].x * rs * n3.x * silu_fast(g1[4]), o[3].y * rs * n3.y * silu_fast(g1[5])); w1.w = pk2(o[3].z * rs * n3.z * silu_fast(g1[6]), o[3].w * rs * n3.w * silu_fast(g1[7]));
                v4u* op = (v4u*)(K.XN() + (size_t)(t0 + c) * D + h * 128 + 16 * vg);
                op[0] = w0; op[1] = w1;
            }
        }
    }
}
#undef FRAG

constexpr int GM_ROWB = 272;
__device__ __forceinline__ void phase_gmlp_mfma(Frame& F, int l) {
    const KA K = KA::fresh(); PHASE_TID;
    LAS unsigned char* lds = F.lds;
    const int fr = lane & 15, fq = lane >> 4;
#pragma unroll 1
    for (int u = F.bx; u < NB * MN * MH; u += F.G) {
        const int b = u / (MN * MH), n = (u / MH) % MN, h = u % MH, t0 = b * S + n * MC;
        const bf16* P = K.P();
        const float gn = K.in(6)[(size_t)l * 256 + h * 64 + lane];
        __syncthreads();
#pragma unroll
        for (int q = 0; q < 2; ++q) {
            float vs[8];
#pragma unroll
            for (int i = 0; i < 8; ++i) {
                const float g = gelu_fast(bf2f(P[(size_t)(t0 + 16 * wave + 8 * q + i) * PLD + C_VG + h * 64 + lane]));
                const float ss = wave_sum(g * g);
                vs[i] = g * rsqrtf(ss * (1.0f / 64.0f) + EPS) * gn;
            }
            *(LAS v4u*)(lds + lane * GM_ROWB + (16 * wave + 8 * q) * 2) = (v4u){pk2(vs[0], vs[1]), pk2(vs[2], vs[3]), pk2(vs[4], vs[5]), pk2(vs[6], vs[7])};
        }
        __syncthreads();
        const bf16* Wb = K.Wsp() + ((size_t)(l * MH + h) * 128 + 16 * wave + fr) * 128 + 8 * fq;
        f32x4 acc[4];
#pragma unroll
        for (int dt = 0; dt < 4; ++dt) acc[dt] = (f32x4){0.f, 0.f, 0.f, 0.f};
        const int nks = (16 * wave + 15) / 32 + 1;
#pragma unroll
        for (int ks = 0; ks < 4; ++ks) if (ks < nks) {
            const bf16x8 Bf = *(const bf16x8*)(Wb + 32 * ks);
#pragma unroll
            for (int dt = 0; dt < 4; ++dt) acc[dt] = mfma16(*(const LAS bf16x8*)(lds + (16 * dt + fr) * GM_ROWB + (32 * ks + 8 * fq) * 2), Bf, acc[dt]);
        }
        const int t = 16 * wave + fr;
        const float bias = K.in(8)[(size_t)l * MH * 128 + h * 128 + t];
        const bf16* up = P + (size_t)(t0 + t) * PLD + C_U + h * 64 + 4 * fq;
        bf16* op = K.XN() + (size_t)(t0 + t) * D + 512 + h * 64 + 4 * fq;
#pragma unroll
        for (int dt = 0; dt < 4; ++dt) {
            const v2u uw = *(const v2u*)(up + 16 * dt);
            const float o0 = gelu_fast(bflo(uw.x)) * (acc[dt][0] + bias), o1 = gelu_fast(bfhi(uw.x)) * (acc[dt][1] + bias), o2 = gelu_fast(bflo(uw.y)) * (acc[dt][2] + bias), o3 = gelu_fast(bfhi(uw.y)) * (acc[dt][3] + bias);
            *(v2u*)(op + 16 * dt) = (v2u){pk2(o0, o1), pk2(o2, o3)};
        }
    }
}

__device__ __forceinline__ void phase_conv(Frame& F, int l) {
    const KA K = KA::fresh(); PHASE_TID;
    const float* wc = K.in(9) + (size_t)l * 3 * 256;
#pragma unroll 1
    for (int e = F.bx * NT + tid; e < T * 32; e += F.G * NT) {
        const int t = e >> 5, c0 = (e & 31) * 8, tl = t % S;
        const bf16* row = K.P() + (size_t)t * PLD;
        float y[8], xi[8], cg[8], bg[8];
        unpack8(*(const v4u*)(row + C_XI + c0), xi); unpack8(*(const v4u*)(row + C_CG + c0), cg); unpack8(*(const v4u*)(row + C_BG + c0), bg);
#pragma unroll
        for (int j = 0; j < 8; ++j) y[j] = wc[2 * 256 + c0 + j] * cg[j] * xi[j];
        if (tl >= 1) { unpack8(*(const v4u*)(row - PLD + C_XI + c0), xi); unpack8(*(const v4u*)(row - PLD + C_CG + c0), cg);
#pragma unroll
            for (int j = 0; j < 8; ++j) y[j] += wc[1 * 256 + c0 + j] * cg[j] * xi[j]; }
        if (tl >= 2) { unpack8(*(const v4u*)(row - 2 * PLD + C_XI + c0), xi); unpack8(*(const v4u*)(row - 2 * PLD + C_CG + c0), cg);
#pragma unroll
            for (int j = 0; j < 8; ++j) y[j] += wc[0 * 256 + c0 + j] * cg[j] * xi[j]; }
#pragma unroll
        for (int j = 0; j < 8; ++j) y[j] *= bg[j];
        *(v4u*)(K.XN() + (size_t)t * D + 768 + c0) = (v4u){pk2(y[0], y[1]), pk2(y[2], y[3]), pk2(y[4], y[5]), pk2(y[6], y[7])};
    }
}
__device__ __forceinline__ void phase_norm_router(Frame& F, int l) {
    const KA K = KA::fresh(); PHASE_TID;
    const float* gain = K.in(11) + (size_t)l * D;
    const float* wrg = K.in(12) + (size_t)l * D * 4; const float* brg = K.in(13) + (size_t)l * 4;
    const float* wre = K.in(14) + (size_t)l * D * 32; const float* bre = K.in(15) + (size_t)l * 32;
    int* cnt = (int*)(K.ctl() + CW_CNT + 64 * l);
#pragma unroll 1
    for (int t = F.bx * NWAVES + wave; t < T; t += F.G * NWAVES) {
        const f32x4* xr = (const f32x4*)(K.out() + (size_t)t * D) + lane;
        f32x4 v[4]; float s = 0.f;
#pragma unroll
        for (int j = 0; j < 4; ++j) { v[j] = xr[64 * j]; s += (v[j].x * v[j].x + v[j].y * v[j].y) + (v[j].z * v[j].z + v[j].w * v[j].w); }
        const float rs = rsqrtf(wave_sum(s) * (1.f / D) + EPS);
        v2u* o8 = (v2u*)(K.XN() + (size_t)t * D) + lane;
        float acc[36];
#pragma unroll
        for (int j = 0; j < 36; ++j) acc[j] = 0.f;
#pragma unroll
        for (int j = 0; j < 4; ++j) {
            const f32x4 g = ((const f32x4*)gain)[lane + 64 * j];
            const float hv[4] = {v[j].x * rs * g.x, v[j].y * rs * g.y, v[j].z * rs * g.z, v[j].w * rs * g.w};
            v2u w; w.x = pk2(hv[0], hv[1]); w.y = pk2(hv[2], hv[3]); o8[64 * j] = w;
#pragma unroll
            for (int i = 0; i < 4; ++i) {
                const int k = 4 * lane + 256 * j + i; const float xv = hv[i];
                const f32x4 g4 = *(const f32x4*)(wrg + (size_t)k * 4);
                acc[0] += xv * g4.x; acc[1] += xv * g4.y; acc[2] += xv * g4.z; acc[3] += xv * g4.w;
                const f32x4* e4 = (const f32x4*)(wre + (size_t)k * 32);
#pragma unroll
                for (int q = 0; q < 8; ++q) { const f32x4 w4 = e4[q]; acc[4 + 4 * q] += xv * w4.x; acc[5 + 4 * q] += xv * w4.y; acc[6 + 4 * q] += xv * w4.z; acc[7 + 4 * q] += xv * w4.w; }
            }
        }
#pragma unroll
        for (int j = 0; j < 36; ++j) acc[j] = wave_sum(acc[j]);
        if (lane == 0) {
            float gl[4]; int gt = 0;
#pragma unroll
            for (int j = 0; j < 4; ++j) gl[j] = acc[j] + brg[j];
            float gmax = gl[0];
#pragma unroll
            for (int j = 1; j < 4; ++j) if (gl[j] > gmax) { gmax = gl[j]; gt = j; }
            float gs = 0.f;
#pragma unroll
            for (int j = 0; j < 4; ++j) gs += expf(gl[j] - gmax);
            const float gw = 1.0f / gs;
            float el[8];
#pragma unroll
            for (int j = 0; j < 8; ++j) { float vv = 0.f;
#pragma unroll
                for (int g = 0; g < 4; ++g) if (g == gt) vv = acc[4 + g * 8 + j] + bre[g * 8 + j];
                el[j] = vv; }
            int i0 = 0; float m0 = el[0];
#pragma unroll
            for (int j = 1; j < 8; ++j) if (el[j] > m0) { m0 = el[j]; i0 = j; }
            int i1 = -1; float m1 = -INFINITY;
#pragma unroll
            for (int j = 0; j < 8; ++j) if (j != i0 && el[j] > m1) { m1 = el[j]; i1 = j; }
            const float e1 = expf(m1 - m0);
            const float w0 = gw / (1.0f + e1), w1 = gw * e1 / (1.0f + e1);
            const int e0i = gt * 8 + i0, e1i = gt * 8 + i1;
            K.eid()[2 * t] = e0i; K.eid()[2 * t + 1] = e1i; K.ew()[2 * t] = w0; K.ew()[2 * t + 1] = w1;
            atomicAdd(&cnt[e0i], 1); atomicAdd(&cnt[e1i], 1);
        }
    }
}
constexpr int RT_PART = 0, RT_SS = RT_PART + 2 * 4 * 16 * 48 * 4, RT_RS = RT_SS + 2 * 4 * 16 * 4, RT_HIST = RT_RS + 2 * 16 * 4;
__device__ __forceinline__ void phase_norm_router_mfma(Frame& F, int l) {
    const KA K = KA::fresh(); PHASE_TID;
    LAS unsigned char* lds = F.lds;
    const int fr = lane & 15, fq = lane >> 4, tl = wave >> 2, kq = wave & 3;
    const bf16* Whi = K.Wr() + (size_t)l * 2 * 48 * D; const bf16* Wlo = Whi + 48 * D;
    const float* gain = K.in(11) + (size_t)l * D;
#pragma unroll 1
    for (int blk = F.bx; blk < T / 64; blk += F.G) {
        __syncthreads();
        if (tid < NE) ((LAS int*)(lds + RT_HIST))[tid] = 0;
#pragma unroll 1
        for (int half = 0; half < 2; ++half) {
            const int tok0 = blk * 64 + half * 32 + tl * 16;
            const float* xr = K.out() + (size_t)(tok0 + fr) * D + 256 * kq + 8 * fq;
            const bf16* whi = Whi + (size_t)fr * D + 256 * kq + 8 * fq; const bf16* wlo = Wlo + (size_t)fr * D + 256 * kq + 8 * fq;
            f32x4 acc[3];
#pragma unroll
            for (int nt = 0; nt < 3; ++nt) acc[nt] = (f32x4){0.f, 0.f, 0.f, 0.f};
            float ss = 0.f;
            f32x4 xa[8], xb[8];
#pragma unroll
            for (int ks = 0; ks < 8; ++ks) { xa[ks] = *(const f32x4*)(xr + 32 * ks); xb[ks] = *(const f32x4*)(xr + 32 * ks + 4); }
#pragma unroll
            for (int ks = 0; ks < 8; ++ks) {
                if ((ks & 1) == 0) __builtin_amdgcn_sched_barrier(0);
                const f32x4 x0 = xa[ks], x1 = xb[ks];
                const float xv[8] = {x0.x, x0.y, x0.z, x0.w, x1.x, x1.y, x1.z, x1.w};
                unsigned hw[4], lw[4];
#pragma unroll
                for (int j = 0; j < 4; ++j) { const float a = xv[2 * j], b2 = xv[2 * j + 1]; ss += a * a + b2 * b2;
                    const unsigned ha = f2bf(a), hb = f2bf(b2); hw[j] = ha | (hb << 16); lw[j] = pk2(a - bf2f(ha), b2 - bf2f(hb)); }
                bf16x8 Ah, Al; { v4u t4 = (v4u){hw[0], hw[1], hw[2], hw[3]}; Ah = __builtin_bit_cast(bf16x8, t4); t4 = (v4u){lw[0], lw[1], lw[2], lw[3]}; Al = __builtin_bit_cast(bf16x8, t4); }
#pragma unroll
                for (int nt = 0; nt < 3; ++nt) {
                    const bf16x8 Bh = *(const bf16x8*)(whi + (size_t)(16 * nt) * D + 32 * ks), Bl = *(const bf16x8*)(wlo + (size_t)(16 * nt) * D + 32 * ks);
                    acc[nt] = mfma16(Ah, Bh, acc[nt]); acc[nt] = mfma16(Al, Bh, acc[nt]); acc[nt] = mfma16(Ah, Bl, acc[nt]);
                }
            }
            ss += shx(ss, 16); ss += shx(ss, 32);
            {
                LAS float* part = (LAS float*)(lds + RT_PART) + (tl * 4 + kq) * 16 * 48;
#pragma unroll
                for (int nt = 0; nt < 3; ++nt)
#pragma unroll
                    for (int r = 0; r < 4; ++r) part[(4 * fq + r) * 48 + 16 * nt + fr] = acc[nt][r];
                if (fq == 0) ((LAS float*)(lds + RT_SS))[(tl * 4 + kq) * 16 + fr] = ss;
            }
            __syncthreads();
            if (kq == 0 && lane < 16) {
                const int t = tok0 + lane;
                const LAS float* p0 = (const LAS float*)(lds + RT_PART) + (tl * 4) * 16 * 48 + lane * 48;
                const LAS float* s2 = (const LAS float*)(lds + RT_SS) + (tl * 4) * 16 + lane;
                const float rs = rsqrtf(((s2[0] + s2[16]) + (s2[32] + s2[48])) * (1.f / D) + EPS);
                ((LAS float*)(lds + RT_RS))[tl * 16 + lane] = rs;
                const float* brg = K.in(13) + (size_t)l * 4; const float* bre = K.in(15) + (size_t)l * 32;
#define RT_DOT(n) ((p0[(n)] + p0[768 + (n)]) + (p0[1536 + (n)] + p0[2304 + (n)]))
                float gl[4]; int gt = 0;
#pragma unroll
                for (int j = 0; j < 4; ++j) gl[j] = RT_DOT(j) * rs + brg[j];
                float gmax = gl[0];
#pragma unroll
                for (int j = 1; j < 4; ++j) if (gl[j] > gmax) { gmax = gl[j]; gt = j; }
                float gs = 0.f;
#pragma unroll
                for (int j = 0; j < 4; ++j) gs += expf(gl[j] - gmax);
                const float gw = 1.0f / gs;
                float el[8];
#pragma unroll
                for (int j = 0; j < 8; ++j) el[j] = RT_DOT(4 + gt * 8 + j) * rs + bre[gt * 8 + j];
#undef RT_DOT
                int i0 = 0; float m0 = el[0];
#pragma unroll
                for (int j = 1; j < 8; ++j) if (el[j] > m0) { m0 = el[j]; i0 = j; }
                int i1 = -1; float m1 = -INFINITY;
#pragma unroll
                for (int j = 0; j < 8; ++j) if (j != i0 && el[j] > m1) { m1 = el[j]; i1 = j; }
                const float e1 = expf(m1 - m0);
                const float w0 = gw / (1.0f + e1), w1 = gw * e1 / (1.0f + e1);
                const int e0i = gt * 8 + i0, e1i = gt * 8 + i1;
                K.eid()[2 * t] = e0i; K.eid()[2 * t + 1] = e1i; K.ew()[2 * t] = w0; K.ew()[2 * t + 1] = w1;
                LAS int* hist = (LAS int*)(lds + RT_HIST);
                K.slot_of()[2 * t] = __hip_atomic_fetch_add(hist + e0i, 1, __ATOMIC_RELAXED, __HIP_MEMORY_SCOPE_WORKGROUP);
                K.slot_of()[2 * t + 1] = __hip_atomic_fetch_add(hist + e1i, 1, __ATOMIC_RELAXED, __HIP_MEMORY_SCOPE_WORKGROUP);
            }
            __syncthreads();
            {
                const float rs = ((const LAS float*)(lds + RT_RS))[tl * 16 + fr];
                bf16* hp = K.XN() + (size_t)(tok0 + fr) * D + 256 * kq + 8 * fq;
                const float* gp = gain + 256 * kq + 8 * fq;
#pragma unroll
                for (int ks = 0; ks < 8; ++ks) {
                    const f32x4 x0 = xa[ks], x1 = xb[ks];
                    const f32x4 g0 = *(const f32x4*)(gp + 32 * ks), g1 = *(const f32x4*)(gp + 32 * ks + 4);
                    *(v4u*)(hp + 32 * ks) = (v4u){pk2(x0.x * rs * g0.x, x0.y * rs * g0.y), pk2(x0.z * rs * g0.z, x0.w * rs * g0.w), pk2(x1.x * rs * g1.x, x1.y * rs * g1.y), pk2(x1.z * rs * g1.z, x1.w * rs * g1.w)};
                }
            }
        }
        __syncthreads();
        if (tid < NE) K.blkcnt()[(size_t)(l * (T / 64) + blk) * NE + tid] = ((LAS int*)(lds + RT_HIST))[tid];
    }
}
__device__ __forceinline__ void phase_scatter(Frame& F, int l) {
    const KA K = KA::fresh(); PHASE_TID;
    LAS int* sm = (LAS int*)F.lds;
    const int* bc = K.blkcnt() + (size_t)l * (T / 64) * NE;
    constexpr int NBLK = T / 64;
#pragma unroll 1
    for (int blk = F.bx; blk < NBLK; blk += F.G) {
        __syncthreads();
        {   const int e = tid & 31, part = tid >> 5;
            int tot = 0, pre = 0;
#pragma unroll
            for (int j = 0; j < NBLK / 16; ++j) { const int bb = part * (NBLK / 16) + j; const int c = bc[bb * NE + e]; tot += c; if (bb < blk) pre += c; }
            sm[part * 32 + e] = tot; sm[512 + part * 32 + e] = pre; }
        __syncthreads();
        if (tid < 32) { int tot = 0, pre = 0;
#pragma unroll
            for (int p = 0; p < 16; ++p) { tot += sm[p * 32 + tid]; pre += sm[512 + p * 32 + tid]; }
            sm[1056 + tid] = tot; sm[1024 + tid] = pre; }
        __syncthreads();
        if (tid == 0) { int a = 0; for (int e = 0; e < NE; ++e) { const int c = sm[1056 + e]; sm[1024 + e] += a; a += c; } }
        if (blk == 0 && tid < 32) ((int*)(K.ctl() + CW_CNT + 64 * l))[tid] = sm[1056 + tid];
        __syncthreads();
        if (tid < 128) { const int a = blk * 128 + tid; const int e = K.eid()[a]; const int pos = sm[1024 + e] + K.slot_of()[a]; K.slot_tok()[pos] = a >> 1; K.slot_of()[a] = pos; }
    }
    __syncthreads();
}
template <bool DUAL>
__device__ __forceinline__ void gemm_core(const bf16* A, const int* rowoff, int K, const float* B0, const float* B1, int ldb, int n0,
                                          float (&acc0)[4][4], float (&acc1)[4][4], float* As, float* Bs0, float* Bs1) {
    const int tid = __builtin_amdgcn_readfirstlane(threadIdx.x >> 6) * 64 + fresh_lane(), tx = tid & 15, ty = tid >> 4;
    const int ar = tid >> 2, ak = (tid & 3) * 4;
    const int bk = (tid >> 4) & 15, bn = (tid & 15) * 4;
    const long aoff = rowoff[ar];
#pragma unroll
    for (int i = 0; i < 4; ++i)
#pragma unroll
        for (int j = 0; j < 4; ++j) { acc0[i][j] = 0.f; acc1[i][j] = 0.f; }
#pragma unroll 1
    for (int k0 = 0; k0 < K; k0 += 16) {
        v2u av = (v2u){0u, 0u};
        if (aoff >= 0) av = *(const v2u*)(A + aoff + k0 + ak);
        f32x4 bv0 = (f32x4){0.f, 0.f, 0.f, 0.f}, bv1 = bv0;
        if (tid < 256) { bv0 = *(const f32x4*)(B0 + (size_t)(k0 + bk) * ldb + n0 + bn); if (DUAL) bv1 = *(const f32x4*)(B1 + (size_t)(k0 + bk) * ldb + n0 + bn); }
        __syncthreads();
        As[(ak + 0) * 132 + ar] = bflo(av.x); As[(ak + 1) * 132 + ar] = bfhi(av.x); As[(ak + 2) * 132 + ar] = bflo(av.y); As[(ak + 3) * 132 + ar] = bfhi(av.y);
        if (tid < 256) { *(f32x4*)(Bs0 + bk * 64 + bn) = bv0; if (DUAL) *(f32x4*)(Bs1 + bk * 64 + bn) = bv1; }
        __syncthreads();
#pragma unroll
        for (int kk = 0; kk < 16; ++kk) {
            const f32x4 a4 = *(const f32x4*)(As + kk * 132 + ty * 4);
            const f32x4 b4 = *(const f32x4*)(Bs0 + kk * 64 + tx * 4);
#pragma unroll
            for (int i = 0; i < 4; ++i)
#pragma unroll
                for (int j = 0; j < 4; ++j) acc0[i][j] += a4[i] * b4[j];
            if (DUAL) {
                const f32x4 c4 = *(const f32x4*)(Bs1 + kk * 64 + tx * 4);
#pragma unroll
                for (int i = 0; i < 4; ++i)
#pragma unroll
                    for (int j = 0; j < 4; ++j) acc1[i][j] += a4[i] * c4[j];
            }
        }
    }
}
template <int MODE>
__device__ __forceinline__ void phase_moe_ref(Frame& F, int l) {
    const KA K = KA::fresh(); PHASE_TID;
    float* As = F.smem; float* Bs0 = F.smem + 16 * 132; float* Bs1 = Bs0 + 16 * 64; int* rowoff = (int*)(Bs1 + 16 * 64); int* offs = rowoff + 128; int* toff = offs + 33;
    int* cnt = (int*)(K.ctl() + CW_CNT + 64 * l);
    const int tx = tid & 15, ty = tid >> 4;
    __syncthreads();
    if (tid == 0) { int a = 0, tt = 0; for (int e = 0; e < NE; ++e) { offs[e] = a; toff[e] = tt; const int c = cnt[e]; a += c; tt += (c + 127) / 128; } offs[NE] = a; toff[NE] = tt; }
    __syncthreads();
    constexpr int N = (MODE == 1) ? DE : D, KD = (MODE == 1) ? D : DE, NTN = N / 64;
    const int ntiles = toff[NE] * NTN;
#pragma unroll 1
    for (int t = F.bx; t < ntiles; t += F.G) {
        const int rt = t / NTN, tn = t % NTN;
        int e = 0;
        for (int j = 1; j < NE; ++j) if (toff[j] <= rt) e = j;
        const int r0 = offs[e] + (rt - toff[e]) * 128, rend = offs[e + 1];
        __syncthreads();
        if (tid < 128) { const int r = r0 + tid; rowoff[tid] = (r < rend) ? ((MODE == 1) ? K.slot_tok()[r] * D : r * DE) : -1; }
        __syncthreads();
        float acc0[4][4], acc1[4][4];
        if (MODE == 1) {
            const float* Wg = K.in(16) + ((size_t)l * NE + e) * D * DE; const float* Wu = K.in(17) + ((size_t)l * NE + e) * D * DE;
            gemm_core<true>(K.XN(), rowoff, KD, Wg, Wu, DE, tn * 64, acc0, acc1, As, Bs0, Bs1);
        } else {
            const float* Wd = K.in(18) + ((size_t)l * NE + e) * DE * D;
            gemm_core<false>(K.H1(), rowoff, KD, Wd, nullptr, D, tn * 64, acc0, acc1, As, Bs0, nullptr);
        }
#pragma unroll
        for (int i = 0; i < 4; ++i) {
            const int r = r0 + ty * 4 + i;
            if (r < rend) {
                v2u o;
                if (MODE == 1) { o.x = pk2(silu(acc0[i][0]) * acc1[i][0], silu(acc0[i][1]) * acc1[i][1]); o.y = pk2(silu(acc0[i][2]) * acc1[i][2], silu(acc0[i][3]) * acc1[i][3]);
                    *(v2u*)(K.H1() + (size_t)r * DE + tn * 64 + tx * 4) = o; }
                else { o.x = pk2(acc0[i][0], acc0[i][1]); o.y = pk2(acc0[i][2], acc0[i][3]); *(v2u*)(K.Y() + (size_t)r * D + tn * 64 + tx * 4) = o; }
            }
        }
    }
    __syncthreads();
}

constexpr int TAB_OFF = LDSCTL_OFF + 1024;
__device__ __forceinline__ void moe_tables(Frame& F, int l) {
    const KA K = KA::fresh(); PHASE_TID;
    LAS int* tab = (LAS int*)(F.lds + TAB_OFF); LAS int* offs = tab + 4 + 4 * 164; LAS int* fpre = offs + 40; LAS int* ppre = fpre + 40;
    const int* cnt = (const int*)(K.ctl() + CW_CNT + 64 * l);
    __syncthreads();
    if (tid == 0) { int a = 0, f = 0, p = 0; for (int e = 0; e < NE; ++e) { const int c = cnt[e]; offs[e] = a; fpre[e] = f; ppre[e] = p; a += c; f += c >> 8; p += (c & 255) ? 1 : 0; }
        offs[NE] = a; fpre[NE] = f; ppre[NE] = p; tab[0] = f + p; }
    __syncthreads();
    const int nfull = fpre[NE], ntile = nfull + ppre[NE];
    if (tid < ntile) {
        int e = 0;
        if (tid < nfull) { for (int j = 1; j < NE; ++j) if (fpre[j] <= tid) e = j; tab[4 + 4 * tid] = e; tab[5 + 4 * tid] = offs[e] + (tid - fpre[e]) * 256; tab[6 + 4 * tid] = offs[e + 1]; }
        else { const int q = tid - nfull; for (int j = 1; j < NE; ++j) if (ppre[j] <= q) e = j; tab[4 + 4 * tid] = e; tab[5 + 4 * tid] = offs[e] + (fpre[e + 1] - fpre[e]) * 256; tab[6 + 4 * tid] = offs[e + 1]; }
    }
    __syncthreads();
}
__device__ __forceinline__ void phase_moe_gu(Frame& F, int l) {
    moe_tables(F, l);
    const KA K = KA::fresh();
    int c_ = F.bx; asm volatile("" : "+s"(c_));
    pg8::MoeSched So{(const LAS int*)(F.lds + TAB_OFF), 2, F.G, (c_ & 7) * (F.G >> 3) + (c_ >> 3)};
    pg8::EpiMoeH E{K.H1()};
    pg8::gemm_phase_moe<pg8::EpiMoeH, pg8::MoeSched, true, 512, D>(F.lds, K.XN(), K.WguT() + (size_t)l * NE * 512 * D, K.slot_tok(), So, E, F.wave);
}
__device__ __forceinline__ void phase_moe_down(Frame& F, int l) {
    moe_tables(F, l);
    const KA K = KA::fresh();
    int c_ = F.bx; asm volatile("" : "+s"(c_));
    pg8::MoeSched So{(const LAS int*)(F.lds + TAB_OFF), 4, F.G, (c_ & 7) * (F.G >> 3) + (c_ >> 3)};
    pg8::EpiMoeY E{K.Y()};
    pg8::gemm_phase_moe<pg8::EpiMoeY, pg8::MoeSched, false, D, DE>(F.lds, K.H1(), K.WdT() + (size_t)l * NE * D * DE, nullptr, So, E, F.wave);
}
__device__ __forceinline__ void phase_combine(Frame& F, int l) {
    const KA K = KA::fresh(); PHASE_TID;
    const bool last = (l == DEPTH - 1);
    const float* gain = last ? K.in(19) : (K.in(1) + (size_t)(l + 1) * D);
#pragma unroll 1
    for (int t = F.bx * NWAVES + wave; t < T; t += F.G * NWAVES) {
        const int s0 = K.slot_of()[2 * t], s1 = K.slot_of()[2 * t + 1]; const float w0 = K.ew()[2 * t], w1 = K.ew()[2 * t + 1];
        f32x4* xr = (f32x4*)(K.out() + (size_t)t * D) + lane;
        const v2u* y0 = (const v2u*)(K.Y() + (size_t)s0 * D) + lane; const v2u* y1 = (const v2u*)(K.Y() + (size_t)s1 * D) + lane;
        f32x4 v[4]; float s = 0.f;
#pragma unroll
        for (int j = 0; j < 4; ++j) { v[j] = xr[64 * j]; const v2u a = y0[64 * j], b = y1[64 * j];
            v[j].x += w0 * bflo(a.x) + w1 * bflo(b.x); v[j].y += w0 * bfhi(a.x) + w1 * bfhi(b.x); v[j].z += w0 * bflo(a.y) + w1 * bflo(b.y); v[j].w += w0 * bfhi(a.y) + w1 * bfhi(b.y);
            s += (v[j].x * v[j].x + v[j].y * v[j].y) + (v[j].z * v[j].z + v[j].w * v[j].w); }
        const float rs = rsqrtf(wave_sum(s) * (1.f / D) + EPS);
        if (last) {
#pragma unroll
            for (int j = 0; j < 4; ++j) { const f32x4 g = ((const f32x4*)gain)[lane + 64 * j]; xr[64 * j] = (f32x4){v[j].x * rs * g.x, v[j].y * rs * g.y, v[j].z * rs * g.z, v[j].w * rs * g.w}; }
        } else {
            v2u* o8 = (v2u*)(K.XN() + (size_t)t * D) + lane;
#pragma unroll
            for (int j = 0; j < 4; ++j) { xr[64 * j] = v[j]; const f32x4 g = ((const f32x4*)gain)[lane + 64 * j];
                v2u w; w.x = pk2(v[j].x * rs * g.x, v[j].y * rs * g.y); w.y = pk2(v[j].z * rs * g.z, v[j].w * rs * g.w); o8[64 * j] = w; }
        }
    }
}

struct Args { const float* in[20]; float* out; unsigned char* ws; };
__global__ void __launch_bounds__(NT, 2) fwd_kernel(Args args) {
    extern __shared__ __attribute__((aligned(16))) unsigned char lds_raw[];
    Frame F;
    F.lds = (LAS unsigned char*)lds_raw; F.smem = (float*)lds_raw;
    F.G = gridDim.x; F.bx = blockIdx.x; F.wave = __builtin_amdgcn_readfirstlane(threadIdx.x >> 6);
    volatile LAS unsigned* MISC = (volatile LAS unsigned*)(F.lds + MISC_OFF);
    for (int u = threadIdx.x; u < (LDS_BYTES - LDSCTL_OFF) / 4; u += NT) ((LAS unsigned*)(F.lds + LDSCTL_OFF))[u] = 0u;
    __syncthreads();
    XcdBarrier bar; { const KA K = KA::fresh(); bar = xcd_barrier_post(K.ctl() + CW_BAR, MISC + 8); }
#define GRID_BAR() xcd_barrier(bar)

    p0_prologue(F);
    GRID_BAR();
    for (int l = 0; l < DEPTH; ++l) {
        {
            const KA K = KA::fresh(); PHASE_TID;
            pg8::Gemm g{K.XN(), K.WinT() + (size_t)l * PLD * D, T, PLD, D}; pg8::StaticOrder So; int c_ = F.bx; asm volatile("" : "+s"(c_)); So.init(T, PLD, F.G, c_);
            pg8::EpiBf16Plain E{K.P(), PLD};
            pg8::gemm_phase<pg8::EpiBf16Plain, pg8::StaticOrder, PG8_ALIGN, PG8_SP2>(F.lds, g, So, E, F.wave);
        }
        GRID_BAR();
        phase_gla_A2(F, l);
        phase_gmlp_mfma(F, l);
        phase_conv(F, l);
        GRID_BAR();
        phase_gla_aggscan(F);
        GRID_BAR();
        phase_gla_C2(F, l);
        GRID_BAR();
        {
            const KA K = KA::fresh(); PHASE_TID;
            pg8::Gemm g{K.XN(), K.WoutT() + (size_t)l * D * D, T, D, D}; pg8::StaticOrder So; int c_ = F.bx; asm volatile("" : "+s"(c_)); So.init(T, D, F.G, c_);
            pg8::EpiF32Res E{K.out(), (l == 0) ? K.in(0) : K.out(), D};
            pg8::gemm_phase<pg8::EpiF32Res, pg8::StaticOrder, PG8_ALIGN, PG8_SP2>(F.lds, g, So, E, F.wave);
        }
        GRID_BAR();
        phase_norm_router_mfma(F, l);
        GRID_BAR();
        phase_scatter(F, l);
        GRID_BAR();
        phase_moe_gu(F, l);
        GRID_BAR();
        phase_moe_down(F, l);
        GRID_BAR();
        phase_combine(F, l);
        if (l + 1 < DEPTH) GRID_BAR();
    }
}

extern "C" void kernel_launch(void* const* d_in, const int* in_sizes, int n_in, void* d_out, int out_size, void* d_ws, size_t ws_size, hipStream_t stream) {
    static int grid_blocks = 0;
    if (!grid_blocks) {
        int dev = 0, cus = 0, per_cu = 0;
        (void)hipGetDevice(&dev);
        (void)hipDeviceGetAttribute(&cus, hipDeviceAttributeMultiprocessorCount, dev);
        (void)hipFuncSetAttribute((const void*)fwd_kernel, hipFuncAttributeMaxDynamicSharedMemorySize, LDS_BYTES);
        (void)hipOccupancyMaxActiveBlocksPerMultiprocessor(&per_cu, fwd_kernel, NT, LDS_BYTES);
        if (per_cu < 1) { fprintf(stderr, "kernel_launch: occupancy query says %d blocks/CU\n", per_cu); per_cu = 1; }
        grid_blocks = cus;
        if (ws_size < WS_END) { fprintf(stderr, "kernel_launch: workspace too small (%zu < %zu)\n", ws_size, (size_t)WS_END); grid_blocks = -1; }
    }
    if (grid_blocks < 0) return;
    (void)hipMemsetAsync((char*)d_ws + WS_CTL, 0, CTL_BYTES, stream);
    Args a{};
    for (int i = 0; i < 20; ++i) a.in[i] = (const float*)d_in[i];
    a.out = (float*)d_out; a.ws = (unsigned char*)d_ws;
    void* args[] = {&a};
    hipError_t e = hipLaunchCooperativeKernel((void*)fwd_kernel, dim3(grid_blocks), dim3(NT), args, LDS_BYTES, stream);
    if (e != hipSuccess) fprintf(stderr, "cooperative launch failed: %s (grid %d)\n", hipGetErrorString(e), grid_blocks);
}
```

```cpp
#include <hip/hip_runtime.h>
#include <hip/hip_cooperative_groups.h>
#include <cstdio>
#include <cstdint>
namespace cg = cooperative_groups;
__device__ __forceinline__ int fresh_lane() { unsigned m = 0xffffffffu; asm volatile("" : "+s"(m)); return (int)__builtin_amdgcn_mbcnt_hi(m, __builtin_amdgcn_mbcnt_lo(m, 0u)); }
__device__ __forceinline__ float shx(float v, int o) { return __int_as_float(__builtin_amdgcn_ds_bpermute((fresh_lane() ^ o) << 2, __float_as_int(v))); }
namespace pg8 {
#define PG8_LAS __attribute__((address_space(3)))
typedef unsigned short bf16_t;
typedef short bf16x8 __attribute__((ext_vector_type(8)));
typedef float f32x4 __attribute__((ext_vector_type(4)));
typedef unsigned u32x4 __attribute__((ext_vector_type(4)));
constexpr int BM = 256, BK = 64, HALF = 128, HTB = HALF * BK * 2  , STAGE_BYTES = 8 * HTB, NXCD = 8, WGM = 8;

__host__ __device__ __forceinline__ int lds_byte(int r, int c) { const int st = (r >> 4) * 2 + (c >> 5), rr = r & 15, cc = c & 31, ob = rr * 64 + cc * 2; return st * 1024 + (ob ^ (((ob >> 9) & 1) << 5)); }
__host__ __device__ __forceinline__ void stage_rc(int b, int& R, int& C) { const int st = b / 1024, sb = b % 1024, swz = sb ^ (((sb >> 9) & 1) << 5); R = (st >> 1) * 16 + swz / 64; C = (st & 1) * 32 + (swz % 64) / 2; }
__host__ __device__ __forceinline__ int perm32(int rho) { const int n = rho >> 4, i = rho & 15; return 8 * (i >> 2) + 4 * n + (i & 3); }

struct Unit { int pm, pn; };
struct Gemm { const bf16_t* A; const bf16_t* Bt; int M, N, K; };

struct StaticOrder {
    int nM, nN, nwg, G, c;
    __host__ __device__ void init(int M, int N, int G_, int c_) { nM = M / BM; nN = N / BM; nwg = nM * nN; G = G_; c = c_; }
    __host__ __device__ bool next(int i, Unit& u) const {
        const long L = (long)i * G + c; if (L >= nwg) return false;
        int wgid = (int)L; { const int q = nwg / NXCD, r = nwg % NXCD, xcd = wgid % NXCD, off = wgid / NXCD; wgid = (xcd < r ? xcd * (q + 1) : r * (q + 1) + (xcd - r) * q) + off; }
        const int nig = WGM * nN, gid = wgid / nig, fm = gid * WGM, gsz = (nM - fm) < WGM ? (nM - fm) : WGM;
        u.pm = fm + ((wgid % nig) % gsz); u.pn = (wgid % nig) / gsz; return true;
    }
    __device__ __forceinline__ void a_ready(const Unit&) const {}
    __device__ __forceinline__ void done(const Unit&) const {}
};


__device__ __forceinline__ unsigned cvt_pk_bf16(float lo, float hi) { unsigned r; asm volatile("v_cvt_pk_bf16_f32 %0, %1, %2" : "=v"(r) : "v"(lo), "v"(hi)); return r; }
struct EpiBf16Plain {
    static constexpr bool PERM = true, AFTER_DRAIN = false;
    bf16_t* O; int ldc;
    __device__ __forceinline__ void operator()(const f32x4 (&acc)[2][2][4][2], const Unit& u, int wr, int wc, int fr, int fq) const {
        const int row0 = u.pm * BM + wr * 64 + fr, col0 = u.pn * BM + wc * 32 + 8 * fq;
#pragma unroll
        for (int ai = 0; ai < 2; ++ai)
#pragma unroll
            for (int m = 0; m < 4; ++m) { bf16_t* rowp = O + (size_t)(row0 + ai * HALF + m * 16) * ldc + col0;
#pragma unroll
                for (int bj = 0; bj < 2; ++bj) { const f32x4 v0 = acc[ai][bj][m][0], v1 = acc[ai][bj][m][1];
                    u32x4 w; w.x = cvt_pk_bf16(v0[0], v0[1]); w.y = cvt_pk_bf16(v0[2], v0[3]); w.z = cvt_pk_bf16(v1[0], v1[1]); w.w = cvt_pk_bf16(v1[2], v1[3]);
                    *(u32x4*)(rowp + bj * HALF) = w; } }
    }
};
struct EpiF32Res {
    static constexpr bool PERM = false, AFTER_DRAIN = false;
    float* C; const float* R; int ldc;
    __device__ __forceinline__ void operator()(const f32x4 (&acc)[2][2][4][2], const Unit& u, int wr, int wc, int fr, int fq) const {
        const int row0 = u.pm * BM + wr * 64 + fr, col0 = u.pn * BM + wc * 32 + 4 * fq;
#pragma unroll
        for (int ai = 0; ai < 2; ++ai)
#pragma unroll
            for (int m = 0; m < 4; ++m) { const size_t off = (size_t)(row0 + ai * HALF + m * 16) * ldc + col0;
#pragma unroll
                for (int bj = 0; bj < 2; ++bj)
#pragma unroll
                    for (int n = 0; n < 2; ++n) { const f32x4 r = *(const f32x4*)(R + off + bj * HALF + n * 16); *(f32x4*)(C + off + bj * HALF + n * 16) = r + acc[ai][bj][m][n]; } }
    }
};
template <class Epi, class Sched, bool ALIGN_EPI = false, bool SP2 = false>
__device__ __forceinline__ void gemm_phase(PG8_LAS unsigned char* lds, const Gemm g, const Sched& S, const Epi& E, int wave_id) {
    asm volatile("" : "+s"(wave_id));
    const int lane = fresh_lane(), wid = wave_id, tid = wid * 64 + lane, wr = wid >> 2, wc = wid & 3, fr = lane & 15, fq = lane >> 4;
    const int K = g.K, nt = K / BK;
    unsigned voffA[2], voffB[2];
#pragma unroll
    for (int i = 0; i < 2; ++i) { int R, C; stage_rc(tid * 16 + i * 8192, R, C); const int Rb = Epi::PERM ? ((R & ~31) + perm32(R & 31)) : R;
        voffA[i] = (unsigned)(R * K + C) * 2u; voffB[i] = (unsigned)(Rb * K + C) * 2u; }
    const size_t kstep = (size_t)(BK * 2);
    const size_t hstep = (size_t)HALF * K * 2;
    const size_t tstep = 2 * hstep;
    const unsigned ldsw = (unsigned)wid * 1024u;
    const int aoff = lds_byte(wr * 64 + fr, fq * 8), boff = lds_byte(wc * 32 + fr, fq * 8);
#define PG8_SA(b, h) (((b) * 2 + (h)) * HTB)
#define PG8_SB(b, h) ((4 + (b) * 2 + (h)) * HTB)
#define PG8_STAGE(bufoff, gbase, voff) do { _Pragma("unroll") for (int _i = 0; _i < 2; ++_i) \
        __builtin_amdgcn_global_load_lds((const unsigned*)((const char*)(gbase) + (voff)[_i]), (PG8_LAS unsigned*)(lds + (bufoff) + ldsw + _i * 8192), 16, 0, 0); } while (0)
#define PG8_LDA(dst, b, h) do { _Pragma("unroll") for (int m = 0; m < 4; ++m) _Pragma("unroll") for (int k = 0; k < 2; ++k) dst[m][k] = *(const PG8_LAS bf16x8*)(lds + PG8_SA(b, h) + aoff + m * 2048 + k * 1024); } while (0)
#define PG8_LDB(dst, b, h) do { _Pragma("unroll") for (int n = 0; n < 2; ++n) _Pragma("unroll") for (int k = 0; k < 2; ++k) dst[n][k] = *(const PG8_LAS bf16x8*)(lds + PG8_SB(b, h) + boff + n * 2048 + k * 1024); } while (0)
#define PG8_MMA(ai, bj, At, Bt) do { __builtin_amdgcn_s_setprio(1); _Pragma("unroll") for (int m = 0; m < 4; ++m) _Pragma("unroll") for (int n = 0; n < 2; ++n) _Pragma("unroll") for (int k = 0; k < 2; ++k) \
        acc[ai][bj][m][n] = __builtin_amdgcn_mfma_f32_16x16x32_bf16(Bt[n][k], At[m][k], acc[ai][bj][m][n], 0, 0, 0); __builtin_amdgcn_s_setprio(0); } while (0)
#define PG8_WAIT_V(n) asm volatile("s_waitcnt vmcnt(" #n ")" ::: "memory")
#define PG8_WAIT_L(n) asm volatile("s_waitcnt lgkmcnt(" #n ")" ::: "memory")
#define PG8_BAR __builtin_amdgcn_s_barrier()
#define PG8_SCHED __builtin_amdgcn_sched_barrier(0)
    Unit cur, nxt; int ui = 0;
    if (!S.next(0, cur)) return;
    f32x4 acc[2][2][4][2];
#pragma unroll
    for (int a = 0; a < 2; ++a)
#pragma unroll
        for (int b = 0; b < 2; ++b)
#pragma unroll
            for (int m = 0; m < 4; ++m)
#pragma unroll
                for (int n = 0; n < 2; ++n) acc[a][b][m][n] = (f32x4){0.f, 0.f, 0.f, 0.f};
    bf16x8 At[4][2], B0[2][2], B1[2][2];
    const char* cA = (const char*)g.A + (size_t)cur.pm * tstep; const char* cB = (const char*)g.Bt + (size_t)cur.pn * tstep;
    S.a_ready(cur);
    if constexpr (SP2) {
        PG8_STAGE(PG8_SB(0, 0), cB, voffB); PG8_STAGE(PG8_SB(0, 1), cB + hstep, voffB); PG8_STAGE(PG8_SA(0, 0), cA, voffA); PG8_STAGE(PG8_SA(0, 1), cA + hstep, voffA);
        if (wr == 1) PG8_BAR;
        PG8_WAIT_V(2); PG8_BAR;
        PG8_STAGE(PG8_SB(1, 0), cB + kstep, voffB); PG8_STAGE(PG8_SA(1, 0), cA + kstep, voffA); PG8_STAGE(PG8_SB(1, 1), cB + hstep + kstep, voffB);
        PG8_WAIT_V(6); PG8_BAR;
    } else {
        PG8_STAGE(PG8_SB(0, 0), cB, voffB); PG8_STAGE(PG8_SA(0, 0), cA, voffA); PG8_STAGE(PG8_SB(0, 1), cB + hstep, voffB); PG8_STAGE(PG8_SA(0, 1), cA + hstep, voffA);
        if (wr == 1) PG8_BAR;
        PG8_WAIT_V(4); PG8_BAR;
        PG8_STAGE(PG8_SB(1, 0), cB + kstep, voffB); PG8_STAGE(PG8_SA(1, 0), cA + kstep, voffA); PG8_STAGE(PG8_SB(1, 1), cB + hstep + kstep, voffB);
        PG8_WAIT_V(6); PG8_BAR;
    }
    for (;;) {
        const bool has_next = S.next(ui + 1, nxt);
        const char* nA = has_next ? (const char*)g.A + (size_t)nxt.pm * tstep : cA; const char* nB = has_next ? (const char*)g.Bt + (size_t)nxt.pn * tstep : cB;
        for (int t = 0; t < nt; t += 2) {
            const bool last = (t == nt - 2);
            const char* a1 = cA + (size_t)(t + 1) * kstep;
            const char* a2 = last ? nA : cA + (size_t)(t + 2) * kstep; const char* b2 = last ? nB : cB + (size_t)(t + 2) * kstep;
            const char* a3 = a2 + kstep; const char* b3 = b2 + kstep;
            if (last && has_next) S.a_ready(nxt);
            if constexpr (SP2) {
            PG8_LDB(B0, 0, 0); PG8_LDB(B1, 0, 1); PG8_SCHED; PG8_LDA(At, 0, 0); PG8_STAGE(PG8_SA(1, 1), a1 + hstep, voffA);
            PG8_WAIT_V(8); PG8_WAIT_L(0); PG8_BAR; PG8_MMA(0, 0, At, B0); PG8_MMA(0, 1, At, B1); PG8_BAR; PG8_SCHED;
            PG8_LDA(At, 0, 1); PG8_STAGE(PG8_SB(0, 0), b2, voffB); PG8_STAGE(PG8_SB(0, 1), b2 + hstep, voffB); PG8_STAGE(PG8_SA(0, 0), a2, voffA);
            PG8_WAIT_V(8); PG8_WAIT_L(0); PG8_BAR; PG8_MMA(1, 0, At, B0); PG8_MMA(1, 1, At, B1); PG8_BAR; PG8_SCHED;
            PG8_LDB(B0, 1, 0); PG8_LDB(B1, 1, 1); PG8_SCHED; PG8_LDA(At, 1, 0); PG8_STAGE(PG8_SA(0, 1), a2 + hstep, voffA);
            PG8_WAIT_V(8); PG8_WAIT_L(0); PG8_BAR; PG8_MMA(0, 0, At, B0); PG8_MMA(0, 1, At, B1); PG8_BAR; PG8_SCHED;
            PG8_LDA(At, 1, 1); PG8_STAGE(PG8_SB(1, 0), b3, voffB); PG8_STAGE(PG8_SB(1, 1), b3 + hstep, voffB); PG8_STAGE(PG8_SA(1, 0), a3, voffA);
            PG8_WAIT_V(8); PG8_WAIT_L(0); PG8_BAR; PG8_MMA(1, 0, At, B0); PG8_MMA(1, 1, At, B1); PG8_BAR; PG8_SCHED;
            } else {
            PG8_LDB(B0, 0, 0); PG8_SCHED; PG8_LDA(At, 0, 0); PG8_STAGE(PG8_SA(1, 1), a1 + hstep, voffA);
            PG8_WAIT_L(8); PG8_BAR; PG8_WAIT_L(0); PG8_MMA(0, 0, At, B0); PG8_BAR; PG8_SCHED;
            PG8_LDB(B1, 0, 1); PG8_STAGE(PG8_SB(0, 0), b2, voffB);
            PG8_BAR; PG8_WAIT_L(0); PG8_MMA(0, 1, At, B1); PG8_BAR;
            PG8_LDA(At, 0, 1); PG8_STAGE(PG8_SA(0, 0), a2, voffA);
            PG8_BAR; PG8_WAIT_L(0); PG8_MMA(1, 0, At, B0); PG8_BAR; PG8_SCHED;
            PG8_STAGE(PG8_SB(0, 1), b2 + hstep, voffB);
            PG8_WAIT_V(6); PG8_BAR; PG8_MMA(1, 1, At, B1); PG8_BAR;
            PG8_LDB(B0, 1, 0); PG8_SCHED; PG8_LDA(At, 1, 0); PG8_STAGE(PG8_SA(0, 1), a2 + hstep, voffA);
            PG8_WAIT_L(8); PG8_BAR; PG8_WAIT_L(0); PG8_MMA(0, 0, At, B0); PG8_BAR; PG8_SCHED;
            PG8_LDB(B1, 1, 1); PG8_STAGE(PG8_SB(1, 0), b3, voffB);
            PG8_BAR; PG8_WAIT_L(0); PG8_MMA(0, 1, At, B1); PG8_BAR;
            PG8_LDA(At, 1, 1); PG8_STAGE(PG8_SA(1, 0), a3, voffA);
            PG8_BAR; PG8_WAIT_L(0); PG8_MMA(1, 0, At, B0); PG8_BAR; PG8_SCHED;
            PG8_STAGE(PG8_SB(1, 1), b3 + hstep, voffB);
            PG8_WAIT_V(6); PG8_BAR; PG8_MMA(1, 1, At, B1); PG8_BAR;
            }
        }
        if constexpr (ALIGN_EPI) { if (wr == 0) PG8_BAR; }
        if constexpr (!Epi::AFTER_DRAIN) { E(acc, cur, wr, wc, fr, fq); S.done(cur); }
        if (!has_next) break;
#pragma unroll
        for (int a = 0; a < 2; ++a)
#pragma unroll
            for (int b = 0; b < 2; ++b)
#pragma unroll
                for (int m = 0; m < 4; ++m)
#pragma unroll
                    for (int n = 0; n < 2; ++n) acc[a][b][m][n] = (f32x4){0.f, 0.f, 0.f, 0.f};
        cur = nxt; cA = nA; cB = nB; ++ui;
        if constexpr (ALIGN_EPI) { if (wr == 1) PG8_BAR; }
    }
    PG8_WAIT_V(0);
    if constexpr (!ALIGN_EPI) { if (wr == 0) PG8_BAR; }
    PG8_BAR;
    if constexpr (Epi::AFTER_DRAIN) { E.fused(acc, cur, wr, wc, fr, fq, lds, wid, lane); S.done(cur); }
#undef PG8_SA
#undef PG8_SB
#undef PG8_STAGE
#undef PG8_LDA
#undef PG8_LDB
#undef PG8_MMA
#undef PG8_WAIT_V
#undef PG8_WAIT_L
#undef PG8_BAR
#undef PG8_SCHED
}

struct MUnit { int r0, rend, e, pn; };
#define MG_LANE_OFFS(u, o) do { const int _t = wid * 64 + fresh_lane(); _Pragma("unroll") for (int _i = 0; _i < 2; ++_i) { int _R, _C; stage_rc(_t * 16 + _i * 8192, _R, _C); _Pragma("unroll") for (int _h = 0; _h < 2; ++_h) { const int _r = (u).r0 + _h * HALF + _R; \
        int _row = _r; if (GATHER) { _row = 0; if (_r < (u).rend) _row = slot_tok[_r]; } (o)[_h][_i] = (unsigned)(_row * K + _C) * 2u; } } } while (0)
template <class Epi, class Sched, bool GATHER, int N, int K>
__device__ __forceinline__ void gemm_phase_moe(PG8_LAS unsigned char* lds, const bf16_t* A, const bf16_t* Bt, const int* slot_tok, const Sched& S, const Epi& E, int wave_id) {
    asm volatile("" : "+s"(wave_id));
    const int lane = fresh_lane(), wid = wave_id, tid = wid * 64 + lane, wr = wid >> 2, wc = wid & 3, fr = lane & 15, fq = lane >> 4;
    constexpr int nt = K / BK;
#define MG_OFFP(par) ((PG8_LAS unsigned*)(lds + STAGE_BYTES + 8192) + (par) * 2048 + tid)
#define MG_VOFFB ((PG8_LAS unsigned*)(lds + STAGE_BYTES + 24576) + tid)
#pragma unroll
    for (int i = 0; i < 2; ++i) { int R, C; stage_rc(tid * 16 + i * 8192, R, C); const int Rb = Epi::PERM ? ((R & ~31) + perm32(R & 31)) : R; MG_VOFFB[i * 512] = (unsigned)(Rb * K + C) * 2u; }
    constexpr size_t kstep = (size_t)(BK * 2);
    constexpr size_t hstep = (size_t)HALF * K * 2;
    constexpr size_t tstep = 2 * hstep;
    constexpr size_t estep = (size_t)N * K * 2;
    const unsigned ldsw = (unsigned)wid * 1024u;
    const int aoff = lds_byte(wr * 64 + fr, fq * 8), boff = lds_byte(wc * 32 + fr, fq * 8);
#define PG8_SA(b, h) (((b) * 2 + (h)) * HTB)
#define PG8_SB(b, h) ((4 + (b) * 2 + (h)) * HTB)
#define PG8_STAGE(bufoff, gbase, voff) do { _Pragma("unroll") for (int _i = 0; _i < 2; ++_i) \
        __builtin_amdgcn_global_load_lds((const unsigned*)((const char*)(gbase) + MG_VOFFB[_i * 512]), (PG8_LAS unsigned*)(lds + (bufoff) + ldsw + _i * 8192), 16, 0, 0); } while (0)
#define MG_STAGE_A(bufoff, par, h, kb) do { _Pragma("unroll") for (int _i = 0; _i < 2; ++_i) \
        __builtin_amdgcn_global_load_lds((const unsigned*)((const char*)A + (size_t)MG_OFFP(par)[((h) * 2 + _i) * 512] + (kb)), (PG8_LAS unsigned*)(lds + (bufoff) + ldsw + _i * 8192), 16, 0, 0); } while (0)
#define PG8_LDA(dst, b, h) do { _Pragma("unroll") for (int m = 0; m < 4; ++m) _Pragma("unroll") for (int k = 0; k < 2; ++k) dst[m][k] = *(const PG8_LAS bf16x8*)(lds + PG8_SA(b, h) + aoff + m * 2048 + k * 1024); } while (0)
#define PG8_LDB(dst, b, h) do { _Pragma("unroll") for (int n = 0; n < 2; ++n) _Pragma("unroll") for (int k = 0; k < 2; ++k) dst[n][k] = *(const PG8_LAS bf16x8*)(lds + PG8_SB(b, h) + boff + n * 2048 + k * 1024); } while (0)
#define PG8_MMA(ai, bj, At, Bt_) do { __builtin_amdgcn_s_setprio(1); _Pragma("unroll") for (int m = 0; m < 4; ++m) _Pragma("unroll") for (int n = 0; n < 2; ++n) _Pragma("unroll") for (int k = 0; k < 2; ++k) \
        acc[ai][bj][m][n] = __builtin_amdgcn_mfma_f32_16x16x32_bf16(Bt_[n][k], At[m][k], acc[ai][bj][m][n], 0, 0, 0); __builtin_amdgcn_s_setprio(0); } while (0)
#define PG8_WAIT_V(n) asm volatile("s_waitcnt vmcnt(" #n ")" ::: "memory")
#define PG8_WAIT_L(n) asm volatile("s_waitcnt lgkmcnt(" #n ")" ::: "memory")
#define PG8_BAR __builtin_amdgcn_s_barrier()
#define PG8_SCHED __builtin_amdgcn_sched_barrier(0)
    MUnit cur, nxt; int ui = 0;
    if (!S.next(0, cur)) return;
    f32x4 acc[2][2][4][2];
#pragma unroll
    for (int a = 0; a < 2; ++a)
#pragma unroll
        for (int b = 0; b < 2; ++b)
#pragma unroll
            for (int m = 0; m < 4; ++m)
#pragma unroll
                for (int n = 0; n < 2; ++n) acc[a][b][m][n] = (f32x4){0.f, 0.f, 0.f, 0.f};
    bf16x8 At[4][2], B0[2][2], B1[2][2];
    { unsigned o_[2][2]; MG_LANE_OFFS(cur, o_); PG8_LAS unsigned* p_ = MG_OFFP(0); p_[0] = o_[0][0]; p_[512] = o_[0][1]; p_[1024] = o_[1][0]; p_[1536] = o_[1][1]; }
    const char* cB = (const char*)Bt + (size_t)cur.e * estep + (size_t)cur.pn * tstep;
    PG8_STAGE(PG8_SB(0, 0), cB, voffB); PG8_STAGE(PG8_SB(0, 1), cB + hstep, voffB); MG_STAGE_A(PG8_SA(0, 0), 0, 0, 0); MG_STAGE_A(PG8_SA(0, 1), 0, 1, 0);
    if (wr == 1) PG8_BAR;
    PG8_WAIT_V(2); PG8_BAR;
    PG8_STAGE(PG8_SB(1, 0), cB + kstep, voffB); MG_STAGE_A(PG8_SA(1, 0), 0, 0, kstep); PG8_STAGE(PG8_SB(1, 1), cB + hstep + kstep, voffB);
    PG8_WAIT_V(6); PG8_BAR;
    for (;;) {
        const bool has_next = S.next(ui + 1, nxt);
        const char* nB = cB;
        const int pc = ui & 1, pn_ = has_next ? (pc ^ 1) : pc;
        if (has_next) { unsigned on[2][2]; MG_LANE_OFFS(nxt, on); nB = (const char*)Bt + (size_t)nxt.e * estep + (size_t)nxt.pn * tstep;
            PG8_LAS unsigned* p_ = MG_OFFP(pn_); p_[0] = on[0][0]; p_[512] = on[0][1]; p_[1024] = on[1][0]; p_[1536] = on[1][1]; }
        for (int t = 0; t < nt; t += 2) {
            const bool last = (t == nt - 2);
            const size_t k1 = (size_t)(t + 1) * kstep, k2 = last ? (size_t)0 : (size_t)(t + 2) * kstep, k3 = k2 + kstep;
            const char* b2 = last ? nB : cB + (size_t)(t + 2) * kstep; const char* b3 = b2 + kstep;
            const int p2 = last ? pn_ : pc;
            PG8_LDB(B0, 0, 0); PG8_LDB(B1, 0, 1); PG8_SCHED; PG8_LDA(At, 0, 0); MG_STAGE_A(PG8_SA(1, 1), pc, 1, k1);
            PG8_WAIT_V(8); PG8_WAIT_L(0); PG8_BAR; PG8_MMA(0, 0, At, B0); PG8_MMA(0, 1, At, B1); PG8_BAR; PG8_SCHED;
            PG8_LDA(At, 0, 1); PG8_STAGE(PG8_SB(0, 0), b2, voffB); PG8_STAGE(PG8_SB(0, 1), b2 + hstep, voffB); MG_STAGE_A(PG8_SA(0, 0), p2, 0, k2);
            PG8_WAIT_V(8); PG8_WAIT_L(0); PG8_BAR; PG8_MMA(1, 0, At, B0); PG8_MMA(1, 1, At, B1); PG8_BAR; PG8_SCHED;
            PG8_LDB(B0, 1, 0); PG8_LDB(B1, 1, 1); PG8_SCHED; PG8_LDA(At, 1, 0); MG_STAGE_A(PG8_SA(0, 1), p2, 1, k2);
            PG8_WAIT_V(8); PG8_WAIT_L(0); PG8_BAR; PG8_MMA(0, 0, At, B0); PG8_MMA(0, 1, At, B1); PG8_BAR; PG8_SCHED;
            PG8_LDA(At, 1, 1); PG8_STAGE(PG8_SB(1, 0), b3, voffB); PG8_STAGE(PG8_SB(1, 1), b3 + hstep, voffB); MG_STAGE_A(PG8_SA(1, 0), p2, 0, k3);
            PG8_WAIT_V(8); PG8_WAIT_L(0); PG8_BAR; PG8_MMA(1, 0, At, B0); PG8_MMA(1, 1, At, B1); PG8_BAR; PG8_SCHED;
        }
        if (wr == 0) PG8_BAR;
        E(acc, cur, wr, wc, fr, fq);
        if (!has_next) break;
#pragma unroll
        for (int a = 0; a < 2; ++a)
#pragma unroll
            for (int b = 0; b < 2; ++b)
#pragma unroll
                for (int m = 0; m < 4; ++m)
#pragma unroll
                    for (int n = 0; n < 2; ++n) acc[a][b][m][n] = (f32x4){0.f, 0.f, 0.f, 0.f};
        cur = nxt; cB = nB; ++ui;
        if (wr == 1) PG8_BAR;
    }
    PG8_WAIT_V(0);
    PG8_BAR;
#undef PG8_SA
#undef PG8_SB
#undef PG8_STAGE
#undef MG_STAGE_A
#undef MG_OFFP
#undef MG_VOFFB
#undef PG8_LDA
#undef PG8_LDB
#undef PG8_MMA
#undef PG8_WAIT_V
#undef PG8_WAIT_L
#undef PG8_BAR
#undef PG8_SCHED
}
__device__ __forceinline__ float fast_silu(float x) { return x * __builtin_amdgcn_rcpf(1.0f + __builtin_amdgcn_exp2f(-1.4426950408889634f * x)); }
struct EpiMoeH {
    static constexpr bool PERM = true;
    bf16_t* H;
    __device__ __forceinline__ void operator()(const f32x4 (&acc)[2][2][4][2], const MUnit& u, int wr, int wc, int fr, int fq) const {
        { const int t_ = fresh_lane(); fr = t_ & 15; fq = t_ >> 4; }
        const int col0 = u.pn * 128 + wc * 32 + 8 * fq;
#pragma unroll
        for (int ai = 0; ai < 2; ++ai)
#pragma unroll
            for (int m = 0; m < 4; ++m) { const int r = u.r0 + ai * HALF + wr * 64 + m * 16 + fr;
                const f32x4 g0 = acc[ai][0][m][0], g1 = acc[ai][0][m][1], u0 = acc[ai][1][m][0], u1 = acc[ai][1][m][1];
                u32x4 w; w.x = cvt_pk_bf16(fast_silu(g0[0]) * u0[0], fast_silu(g0[1]) * u0[1]); w.y = cvt_pk_bf16(fast_silu(g0[2]) * u0[2], fast_silu(g0[3]) * u0[3]);
                w.z = cvt_pk_bf16(fast_silu(g1[0]) * u1[0], fast_silu(g1[1]) * u1[1]); w.w = cvt_pk_bf16(fast_silu(g1[2]) * u1[2], fast_silu(g1[3]) * u1[3]);
                if (r < u.rend) *(u32x4*)(H + (size_t)r * 256 + col0) = w; }
    }
};
struct EpiMoeY {
    static constexpr bool PERM = true;
    bf16_t* Y;
    __device__ __forceinline__ void operator()(const f32x4 (&acc)[2][2][4][2], const MUnit& u, int wr, int wc, int fr, int fq) const {
        { const int t_ = fresh_lane(); fr = t_ & 15; fq = t_ >> 4; }
        const int col0 = u.pn * BM + wc * 32 + 8 * fq;
#pragma unroll
        for (int ai = 0; ai < 2; ++ai)
#pragma unroll
            for (int m = 0; m < 4; ++m) { const int r = u.r0 + ai * HALF + wr * 64 + m * 16 + fr;
#pragma unroll
                for (int bj = 0; bj < 2; ++bj) { const f32x4 v0 = acc[ai][bj][m][0], v1 = acc[ai][bj][m][1];
                    u32x4 w; w.x = cvt_pk_bf16(v0[0], v0[1]); w.y = cvt_pk_bf16(v0[2], v0[3]); w.z = cvt_pk_bf16(v1[0], v1[1]); w.w = cvt_pk_bf16(v1[2], v1[3]);
                    if (r < u.rend) *(u32x4*)(Y + (size_t)r * 1024 + col0 + bj * HALF) = w; } }
    }
};
struct MoeSched {
    const PG8_LAS int* tab;
    int npn, G, c;
    __device__ __forceinline__ bool next(int i, MUnit& u) const {
        const int L = i * G + c, ntile = tab[0];
        if (L >= ntile * npn) return false;
        const int j = L / npn; u.pn = L % npn;
        u.e = __builtin_amdgcn_readfirstlane(tab[4 + 4 * j]); u.r0 = __builtin_amdgcn_readfirstlane(tab[5 + 4 * j]); u.rend = __builtin_amdgcn_readfirstlane(tab[6 + 4 * j]);
        return true;
    }
};
}

#ifndef PG8_SP2
#define PG8_SP2 true
#endif
#ifndef PG8_ALIGN
#define PG8_ALIGN true
#endif

constexpr int NWAVES = 8, NT = NWAVES * 64;
constexpr int D = 1024, NB = 2, S = 8192, T = NB * S, DEPTH = 2;
constexpr int DIN = 2832, PLD = 3072;
constexpr int C_Q = 0, C_K = 256, C_V = 512, C_G = 1024, C_GK = 1536, C_U = 1552, C_VG = 1808, C_XI = 2064, C_BG = 2320, C_CG = 2576;
constexpr int GH = 4, GC = 64, GN = S / GC;
constexpr int MH = 4, MC = 128, MN = S / MC;
constexpr int NE = 32, DE = 256;
constexpr float EPS = 1e-6f;
constexpr size_t MiB = 1u << 20;
constexpr size_t WS_CTL = 0, CTL_BYTES = 1 * MiB;
constexpr size_t WS_WIN = 1 * MiB;
constexpr size_t WS_WOUT = 13 * MiB;
constexpr size_t WS_WGU = 17 * MiB;
constexpr size_t WS_WD = 81 * MiB;
constexpr size_t WS_XN = 113 * MiB;
constexpr size_t WS_P = 145 * MiB;
constexpr size_t WS_Y = WS_P + 17 * MiB;
constexpr size_t WS_S = 241 * MiB;
constexpr size_t WS_DEC = 273 * MiB;
constexpr size_t WS_MISC = 274 * MiB;
constexpr size_t WS_WSP = WS_MISC + 524288;
constexpr size_t WS_WR = 275 * MiB;
constexpr size_t WS_BLKCNT = WS_WR + 524288;
constexpr size_t WS_END = 276 * MiB;
constexpr int CW_BAR = 4096, CW_CNT = 16384;
constexpr int RING_BYTES = 131072, LDSCTL_OFF = RING_BYTES, MISC_OFF = LDSCTL_OFF + 320, LDS_BYTES = 163840;

#define GAS __attribute__((address_space(1)))
#define LAS __attribute__((address_space(3)))
typedef unsigned short bf16;
typedef unsigned v4u __attribute__((ext_vector_type(4)));
typedef unsigned v2u __attribute__((ext_vector_type(2)));
typedef float f32x4 __attribute__((ext_vector_type(4)));
typedef __bf16 bf16x2_t __attribute__((ext_vector_type(2)));
typedef float f32x2_t __attribute__((ext_vector_type(2)));
__device__ __forceinline__ unsigned f2bf(float f) { return (unsigned)__builtin_bit_cast(unsigned short, (__bf16)f); }
__device__ __forceinline__ unsigned pk2(float lo, float hi) { f32x2_t v = {lo, hi}; bf16x2_t b = __builtin_convertvector(v, bf16x2_t); return __builtin_bit_cast(unsigned, b); }
__device__ __forceinline__ float bf2f(unsigned v) { return __uint_as_float(v << 16); }
__device__ __forceinline__ float bflo(unsigned w) { return __uint_as_float(w << 16); }
__device__ __forceinline__ float bfhi(unsigned w) { return __uint_as_float(w & 0xffff0000u); }
__device__ __forceinline__ void unpack8(const v4u q, float (&f)[8]) { f[0] = bflo(q.x); f[1] = bfhi(q.x); f[2] = bflo(q.y); f[3] = bfhi(q.y); f[4] = bflo(q.z); f[5] = bfhi(q.z); f[6] = bflo(q.w); f[7] = bfhi(q.w); }
__device__ __forceinline__ float gelu_tanh(float x) { const float u = 0.7978845608028654f * (x + 0.044715f * x * x * x); return 0.5f * x * (1.0f + tanhf(u)); }
__device__ __forceinline__ float silu(float x) { return x / (1.0f + expf(-x)); }
__device__ __forceinline__ float log_sigmoid(float x) { return fminf(x, 0.f) - log1pf(expf(-fabsf(x))); }

#define XB_TMO      128
#define XB_XCNT(j)  (256  + 64 * (j))
#define XB_XSUB(j)  (1280 + 64 * (j))
#define XB_XGEN(j)  (2304 + 64 * (j))
#define XB_TOP      3328
#define XB_TOPGEN   3392
#define XCD_BAR_WORDS 3456
#define XB_SPIN_CAP (1u << 18)

__device__ __forceinline__ unsigned xb_ld(unsigned* p)              { return __hip_atomic_load(p, __ATOMIC_RELAXED, __HIP_MEMORY_SCOPE_AGENT); }
__device__ __forceinline__ unsigned xb_add(unsigned* p, unsigned v) { return __hip_atomic_fetch_add(p, v, __ATOMIC_RELAXED, __HIP_MEMORY_SCOPE_AGENT); }
__device__ __forceinline__ unsigned xb_xcc_id() { return (unsigned)__builtin_amdgcn_s_getreg((3 << 11) | 20) & 0xFu; }
#define XB_SPIN(cond, bar) do { unsigned _sp = 0; while (cond) { __builtin_amdgcn_s_sleep(1); \
    if ((++_sp & 255u) == 0u) { if (xb_ld(&(bar)[XB_TMO])) break; if (_sp > XB_SPIN_CAP) { atomicAdd(&(bar)[XB_TMO], 1u); break; } } } } while (0)

struct XcdBarrier {
    int wave;
    unsigned* bar; unsigned x;
    volatile LAS unsigned* st;
};

__device__ __forceinline__ XcdBarrier xcd_barrier_post(unsigned* bar, volatile LAS unsigned* st) {
    XcdBarrier b; b.bar = bar; b.x = xb_xcc_id(); b.st = st; b.wave = __builtin_amdgcn_readfirstlane(threadIdx.x >> 6);
    if (threadIdx.x == 0) (void)xb_add(&bar[XB_XCNT(b.x)], 1u);
    return b;
}
__device__ __forceinline__ void xcd_barrier_complete(unsigned* bar, unsigned x, unsigned& nloc, unsigned& nx) {
    const unsigned G = gridDim.x * gridDim.y * gridDim.z;
    unsigned sum, cnt, mine, sp = 0u;
    for (;;) {
        sum = 0u; cnt = 0u; mine = 0u;
#pragma unroll
        for (unsigned j = 0; j < 16; ++j) { const unsigned c = xb_ld(&bar[XB_XCNT(j)]); sum += c; cnt += (c > 0u) ? 1u : 0u; mine = (j == x) ? c : mine; }
        if (sum == G) break;
        __builtin_amdgcn_s_sleep(1);
        if ((++sp & 255u) == 0u) { if (xb_ld(&bar[XB_TMO])) break; if (sp > XB_SPIN_CAP) { atomicAdd(&bar[XB_TMO], 1u); break; } }
    }
    nloc = mine > 0u ? mine : 1u; nx = cnt > 0u ? cnt : 1u;
}

__device__ __forceinline__ void xcd_barrier(const XcdBarrier& b) {
    asm volatile("s_waitcnt vmcnt(0)" ::: "memory");
    __syncthreads();
    if (b.wave == 0 && fresh_lane() == 0) {
        unsigned* bar = b.bar; asm volatile("" : "+s"(bar));
        __builtin_amdgcn_s_waitcnt(0);
        unsigned nloc = b.st[0], nx = b.st[1];
        if (nloc == 0u) { xcd_barrier_complete(bar, b.x, nloc, nx); b.st[0] = nloc; b.st[1] = nx; }
        const unsigned old = xb_add(&bar[XB_XSUB(b.x)], 1u);
        const unsigned gen = old / nloc;
        if (old + 1u == (gen + 1u) * nloc) {
            __builtin_amdgcn_fence(__ATOMIC_RELEASE, "agent");
            asm volatile("s_waitcnt vmcnt(0)" ::: "memory");
            const unsigned og = xb_add(&bar[XB_TOP], 1u);
            const unsigned tg = og / nx;
            if (og + 1u == (tg + 1u) * nx) xb_add(&bar[XB_TOPGEN], 1u);
            else XB_SPIN(xb_ld(&bar[XB_TOPGEN]) == tg, bar);
            __builtin_amdgcn_fence(__ATOMIC_ACQUIRE, "agent");
            xb_add(&bar[XB_XGEN(b.x)], 1u);
            asm volatile("s_waitcnt vmcnt(0)" ::: "memory");
        } else {
            XB_SPIN(xb_ld(&bar[XB_XGEN(b.x)]) == gen, bar);
            __builtin_amdgcn_fence(__ATOMIC_ACQUIRE, "agent");
            asm volatile("s_waitcnt vmcnt(0)" ::: "memory");
        }
    }
    __syncthreads();
}

#define AS4 __attribute__((address_space(4)))
struct KA {
    const AS4 char* ka;
    static __device__ __forceinline__ KA fresh() { KA k; k.ka = (const AS4 char*)__builtin_amdgcn_kernarg_segment_ptr(); asm volatile("" : "+s"(k.ka)); return k; }
    __device__ __forceinline__ const float* in(int i) const { return *(const float* const AS4*)(ka + 8 * i); }
    __device__ __forceinline__ float* out() const { return *(float* const AS4*)(ka + 160); }
    __device__ __forceinline__ unsigned char* ws() const { return *(unsigned char* const AS4*)(ka + 168); }
    __device__ __forceinline__ unsigned* ctl() const { return (unsigned*)(ws() + WS_CTL); }
    __device__ __forceinline__ bf16* WinT() const { return (bf16*)(ws() + WS_WIN); }
    __device__ __forceinline__ bf16* WoutT() const { return (bf16*)(ws() + WS_WOUT); }
    __device__ __forceinline__ bf16* WguT() const { return (bf16*)(ws() + WS_WGU); }
    __device__ __forceinline__ bf16* WdT() const { return (bf16*)(ws() + WS_WD); }
    __device__ __forceinline__ bf16* XN() const { return (bf16*)(ws() + WS_XN); }
    __device__ __forceinline__ bf16* P() const { return (bf16*)(ws() + WS_P); }
    __device__ __forceinline__ bf16* H1() const { return (bf16*)(ws() + WS_P); }
    __device__ __forceinline__ bf16* Y() const { return (bf16*)(ws() + WS_Y); }
    __device__ __forceinline__ float* Sst() const { return (float*)(ws() + WS_S); }
    __device__ __forceinline__ float* dec() const { return (float*)(ws() + WS_DEC); }
    __device__ __forceinline__ int* eid() const { return (int*)(ws() + WS_MISC); }
    __device__ __forceinline__ float* ew() const { return (float*)(ws() + WS_MISC + 131072); }
    __device__ __forceinline__ int* slot_tok() const { return (int*)(ws() + WS_MISC + 2 * 131072); }
    __device__ __forceinline__ int* slot_of() const { return (int*)(ws() + WS_MISC + 3 * 131072); }
    __device__ __forceinline__ bf16* Wsp() const { return (bf16*)(ws() + WS_WSP); }
    __device__ __forceinline__ bf16* Wr() const { return (bf16*)(ws() + WS_WR); }
    __device__ __forceinline__ int* blkcnt() const { return (int*)(ws() + WS_BLKCNT); }
};
struct Frame {
    LAS unsigned char* lds; float* smem;
    int G, bx, wave;
};
#define PHASE_TID const int lane = fresh_lane(), wave = F.wave, tid = wave * 64 + lane; (void)lane; (void)wave; (void)tid

__device__ __forceinline__ float wave_sum(float v) {
    const int ln = fresh_lane();
#pragma unroll
    for (int o = 1; o < 64; o <<= 1) v += __int_as_float(__builtin_amdgcn_ds_bpermute((ln ^ o) << 2, __float_as_int(v)));
    return v;
}

__device__ __forceinline__ void transpose_item(const float* W, int ldw, int nvalid, int k0, int n0, bf16* WT, int ldt, int drow0, LAS float* scr, int lane) {
    const int sub = lane >> 3, c4 = (lane & 7) * 4;
    f32x4 v[8];
#pragma unroll
    for (int i = 0; i < 8; ++i) v[i] = (c4 < nvalid) ? __builtin_nontemporal_load((const f32x4*)(W + (size_t)(k0 + 8 * i + sub) * ldw + n0 + c4)) : (f32x4){0.f, 0.f, 0.f, 0.f};
#pragma unroll
    for (int i = 0; i < 8; ++i) { LAS float* d = scr + (8 * i + sub) * 33 + c4; d[0] = v[i].x; d[1] = v[i].y; d[2] = v[i].z; d[3] = v[i].w; }
    asm volatile("s_waitcnt lgkmcnt(0)" ::: "memory");
    const int c = lane & 7;
#pragma unroll
    for (int j = 0; j < 4; ++j) { const int n = (lane >> 3) + 8 * j; const LAS float* s = scr + (8 * c) * 33 + n;
        v4u o; o.x = pk2(s[0 * 33], s[1 * 33]); o.y = pk2(s[2 * 33], s[3 * 33]); o.z = pk2(s[4 * 33], s[5 * 33]); o.w = pk2(s[6 * 33], s[7 * 33]);
        if (n < nvalid) *(GAS v4u*)(WT + (size_t)(drow0 + n) * ldt + k0 + 8 * c) = o; }
    asm volatile("s_waitcnt lgkmcnt(0)" ::: "memory");
}
__device__ __forceinline__ void rms_row_to_bf16(const float* xrow, const float* gain, bf16* orow, int lane) {
    const f32x4* xr = (const f32x4*)xrow + lane;
    f32x4 v[4]; float s = 0.f;
#pragma unroll
    for (int j = 0; j < 4; ++j) { v[j] = xr[64 * j]; s += (v[j].x * v[j].x + v[j].y * v[j].y) + (v[j].z * v[j].z + v[j].w * v[j].w); }
    const float rs = rsqrtf(wave_sum(s) * (1.f / D) + EPS);
    v2u* o8 = (v2u*)orow + lane;
#pragma unroll
    for (int j = 0; j < 4; ++j) { const f32x4 g = ((const f32x4*)gain)[lane + 64 * j]; v2u w; w.x = pk2(v[j].x * rs * g.x, v[j].y * rs * g.y); w.y = pk2(v[j].z * rs * g.z, v[j].w * rs * g.w); o8[64 * j] = w; }
}
__device__ __forceinline__ void p0_prologue(Frame& F) {
    const KA K = KA::fresh(); PHASE_TID;
    LAS float* scr = (LAS float*)(F.lds + wave * 16384);
    const int gw = F.bx * NWAVES + wave, NGW = F.G * NWAVES;
    constexpr int I_IN = 16 * 89, I_OUT = 16 * 32, I_G = 32 * 16 * 8, I_D = 32 * 4 * 32, I_L = I_IN + I_OUT + 2 * I_G + I_D;
    for (int it = gw; it < DEPTH * I_L; it += NGW) {
        const int l = it / I_L; int r = it % I_L;
        if (r < I_IN) { const int kb = r / 89, nb = r % 89; const int nv = (nb == 88) ? 16 : 32;
            transpose_item(K.in(2) + (size_t)l * D * DIN, DIN, nv, kb * 64, nb * 32, K.WinT() + (size_t)l * PLD * D, D, nb * 32, scr, lane); continue; }
        r -= I_IN;
        if (r < I_OUT) { const int kb = r / 32, nb = r % 32;
            transpose_item(K.in(10) + (size_t)l * D * D, D, 32, kb * 64, nb * 32, K.WoutT() + (size_t)l * D * D, D, nb * 32, scr, lane); continue; }
        r -= I_OUT;
        if (r < 2 * I_G) { const int sel = r / I_G; r %= I_G; const int e = r / 128, kb = (r % 128) / 8, nb = r % 8; const int n0 = nb * 32;
            const float* W = K.in(16 + sel) + ((size_t)l * NE + e) * D * DE;
            transpose_item(W, DE, 32, kb * 64, n0, K.WguT() + ((size_t)l * NE + e) * 512 * D, D, (n0 >> 7) * 256 + sel * 128 + (n0 & 127), scr, lane); continue; }
        r -= 2 * I_G;
        { const int e = r / 128, kb = (r % 128) / 32, nb = r % 32;
            transpose_item(K.in(18) + ((size_t)l * NE + e) * DE * D, D, 32, kb * 64, nb * 32, K.WdT() + ((size_t)l * NE + e) * D * DE, DE, nb * 32, scr, lane); }
    }
    for (int i = F.bx * NT + tid; i < DEPTH * 240 * 128; i += F.G * NT) { const int l = i / (240 * 128), rr = (i / 128) % 240, c = i % 128;
        *(GAS v4u*)(K.WinT() + ((size_t)l * PLD + DIN + rr) * D + c * 8) = (v4u){0u, 0u, 0u, 0u}; }
    for (int i = F.bx * NT + tid; i < DEPTH * 48 * D; i += F.G * NT) { const int ll = i / (48 * D), n = (i / D) % 48, k = i % D;
        float w = 0.f;
        if (n < 4) w = K.in(12)[((size_t)ll * D + k) * 4 + n]; else if (n < 36) w = K.in(14)[((size_t)ll * D + k) * 32 + (n - 4)];
        w *= K.in(11)[(size_t)ll * D + k];
        const unsigned hi = f2bf(w), lo = f2bf(w - bf2f(hi));
        K.Wr()[((size_t)ll * 2 + 0) * 48 * D + (size_t)n * D + k] = (bf16)hi; K.Wr()[((size_t)ll * 2 + 1) * 48 * D + (size_t)n * D + k] = (bf16)lo; }
    for (int i = F.bx * NT + tid; i < DEPTH * MH * 128 * 128 / 8; i += F.G * NT) { const int e0 = i * 8, s0 = e0 & 127, t = (e0 >> 7) & 127;
        const f32x4 a = *(const f32x4*)(K.in(7) + e0), c = *(const f32x4*)(K.in(7) + e0 + 4);
        const float v[8] = {a.x, a.y, a.z, a.w, c.x, c.y, c.z, c.w}; unsigned w[4];
#pragma unroll
        for (int j = 0; j < 4; ++j) w[j] = pk2((s0 + 2 * j <= t) ? v[2 * j] : 0.f, (s0 + 2 * j + 1 <= t) ? v[2 * j + 1] : 0.f);
        *(GAS v4u*)(K.Wsp() + e0) = (v4u){w[0], w[1], w[2], w[3]}; }
    for (int m = gw; m < T; m += NGW) rms_row_to_bf16(K.in(0) + (size_t)m * D, K.in(1), K.XN() + (size_t)m * D, lane);
}

__device__ __forceinline__ void gla_cumdecay(Frame& F, const KA& K, int tid, int l, int h, int t0, float* bb) {
    const float* wup = K.in(3) + (size_t)l * 16 * 256; const float* bgk = K.in(4) + (size_t)l * 256;
    for (int e = tid; e < 64 * 64; e += NT) {
        const int c = e >> 6, d = e & 63;
        const bf16* gl = K.P() + (size_t)(t0 + c) * PLD + C_GK;
        float a = bgk[h * 64 + d];
#pragma unroll
        for (int r = 0; r < 16; ++r) a += bf2f(gl[r]) * wup[r * 256 + h * 64 + d];
        bb[c * 64 + d] = log_sigmoid(a) * (1.0f / 16.0f);
    }
    __syncthreads();
    if (tid < 64) { float run = 0.f; for (int c = 0; c < 64; ++c) { run += bb[c * 64 + tid]; bb[c * 64 + tid] = run; } }
    __syncthreads();
}
__device__ __forceinline__ void phase_gla_kv(Frame& F, int l) {
    const KA K = KA::fresh(); PHASE_TID;
    float* bb = F.smem; float* kd = F.smem + 4096;
#pragma unroll 1
    for (int ci = F.bx; ci < NB * GH * GN; ci += F.G) {
        const int b = ci / (GH * GN), h = (ci / GN) % GH, n = ci % GN, t0 = b * S + n * GC;
        __syncthreads();
        gla_cumdecay(F, K, tid, l, h, t0, bb);
        for (int e = tid; e < 4096; e += NT) { const int c = e >> 6, d = e & 63; kd[e] = bf2f(K.P()[(size_t)(t0 + c) * PLD + C_K + h * 64 + d]) * expf(bb[63 * 64 + d] - bb[e]); }
        __syncthreads();
        const int d = tid >> 3, v0 = (tid & 7) * 16;
        float acc[16];
#pragma unroll
        for (int j = 0; j < 16; ++j) acc[j] = 0.f;
#pragma unroll 2
        for (int c = 0; c < 64; ++c) {
            const float kk = kd[c * 64 + d];
            const v4u* vr = (const v4u*)(K.P() + (size_t)(t0 + c) * PLD + C_V + h * 128 + v0);
            float f[8]; unpack8(vr[0], f);
#pragma unroll
            for (int j = 0; j < 8; ++j) acc[j] += kk * f[j];
            unpack8(vr[1], f);
#pragma unroll
            for (int j = 0; j < 8; ++j) acc[8 + j] += kk * f[j];
        }
        f32x4* o = (f32x4*)(K.Sst() + ((size_t)ci * 64 + d) * 128 + v0);
#pragma unroll
        for (int j = 0; j < 4; ++j) o[j] = (f32x4){acc[4 * j], acc[4 * j + 1], acc[4 * j + 2], acc[4 * j + 3]};
        if (tid < 64) K.dec()[(size_t)ci * 64 + tid] = expf(bb[63 * 64 + tid]);
    }
}
__device__ __forceinline__ void phase_gla_scan(Frame& F) {
    const KA K = KA::fresh(); PHASE_TID;
#pragma unroll 1
    for (int e = F.bx * NT + tid; e < NB * GH * 64 * 128; e += F.G * NT) {
        const int bh = e >> 13, d = (e >> 7) & 63, v = e & 127;
        float* base = K.Sst() + ((size_t)bh * GN * 64 + d) * 128 + v; const float* db = K.dec() + (size_t)bh * GN * 64 + d;
        float st = 0.f;
#pragma unroll 1
        for (int n0 = 0; n0 < GN; n0 += 16) {
            float kvv[16], dd[16];
#pragma unroll
            for (int j = 0; j < 16; ++j) { kvv[j] = base[(size_t)(n0 + j) * 8192]; dd[j] = db[(n0 + j) * 64]; }
#pragma unroll
            for (int j = 0; j < 16; ++j) { base[(size_t)(n0 + j) * 8192] = st; st = dd[j] * st + kvv[j]; }
        }
    }
}
__device__ __forceinline__ void phase_gla_out(Frame& F, int l) {
    const KA K = KA::fresh(); PHASE_TID;
    float* bb = F.smem; float* qd = F.smem + 4096; float* ki = F.smem + 4096 + 64 * 65; float* sc = bb;
    const float* gnorm = K.in(5) + (size_t)l * 128;
#pragma unroll 1
    for (int ci = F.bx; ci < NB * GH * GN; ci += F.G) {
        const int b = ci / (GH * GN), h = (ci / GN) % GH, n = ci % GN, t0 = b * S + n * GC;
        __syncthreads();
        gla_cumdecay(F, K, tid, l, h, t0, bb);
        for (int e = tid; e < 4096; e += NT) {
            const int c = e >> 6, d = e & 63; const float bv = bb[e];
            const bf16* row = K.P() + (size_t)(t0 + c) * PLD;
            qd[c * 65 + d] = bf2f(row[C_Q + h * 64 + d]) * 0.125f * expf(bv);
            ki[c * 65 + d] = bf2f(row[C_K + h * 64 + d]) * expf(-bv);
        }
        __syncthreads();
        {
            const int c = tid >> 3, s0 = (tid & 7) * 8;
            float a[8];
#pragma unroll
            for (int j = 0; j < 8; ++j) a[j] = 0.f;
#pragma unroll 4
            for (int d = 0; d < 64; ++d) { const float qv = qd[c * 65 + d];
#pragma unroll
                for (int j = 0; j < 8; ++j) a[j] += qv * ki[(s0 + j) * 65 + d]; }
#pragma unroll
            for (int j = 0; j < 8; ++j) sc[c * 64 + s0 + j] = (s0 + j <= c) ? a[j] : 0.f;
        }
        __syncthreads();
        const int c = tid >> 3, v0 = (tid & 7) * 16;
        float acc[16];
#pragma unroll
        for (int j = 0; j < 16; ++j) acc[j] = 0.f;
#pragma unroll 2
        for (int s = 0; s <= c; ++s) {
            const float w = sc[c * 64 + s];
            const v4u* vr = (const v4u*)(K.P() + (size_t)(t0 + s) * PLD + C_V + h * 128 + v0);
            float f[8]; unpack8(vr[0], f);
#pragma unroll
            for (int j = 0; j < 8; ++j) acc[j] += w * f[j];
            unpack8(vr[1], f);
#pragma unroll
            for (int j = 0; j < 8; ++j) acc[8 + j] += w * f[j];
        }
#pragma unroll 2
        for (int d = 0; d < 64; ++d) {
            const float w = qd[c * 65 + d];
            const f32x4* sr = (const f32x4*)(K.Sst() + ((size_t)ci * 64 + d) * 128 + v0);
#pragma unroll
            for (int j = 0; j < 4; ++j) { const f32x4 v4 = sr[j]; acc[4 * j] += w * v4.x; acc[4 * j + 1] += w * v4.y; acc[4 * j + 2] += w * v4.z; acc[4 * j + 3] += w * v4.w; }
        }
        float ss = 0.f;
#pragma unroll
        for (int j = 0; j < 16; ++j) ss += acc[j] * acc[j];
        ss += shx(ss, 1); ss += shx(ss, 2); ss += shx(ss, 4);
        const float rs = rsqrtf(ss * (1.0f / 128.0f) + EPS);
        const v4u* gr = (const v4u*)(K.P() + (size_t)(t0 + c) * PLD + C_G + h * 128 + v0);
        float g0[8], g1[8]; unpack8(gr[0], g0); unpack8(gr[1], g1);
        float o[16];
#pragma unroll
        for (int j = 0; j < 8; ++j) { o[j] = acc[j] * rs * gnorm[v0 + j] * silu(g0[j]); o[8 + j] = acc[8 + j] * rs * gnorm[v0 + 8 + j] * silu(g1[j]); }
        v4u* op = (v4u*)(K.XN() + (size_t)(t0 + c) * D + h * 128 + v0);
        op[0] = (v4u){pk2(o[0], o[1]), pk2(o[2], o[3]), pk2(o[4], o[5]), pk2(o[6], o[7])};
        op[1] = (v4u){pk2(o[8], o[9]), pk2(o[10], o[11]), pk2(o[12], o[13]), pk2(o[14], o[15])};
    }
}
__device__ __forceinline__ void phase_gmlp(Frame& F, int l) {
    const KA K = KA::fresh(); PHASE_TID;
    float* vs = F.smem;
    const float* gn = K.in(6) + (size_t)l * 256; const float* wsp = K.in(7) + (size_t)l * MH * 128 * 128; const float* bsp = K.in(8) + (size_t)l * MH * 128;
#pragma unroll 1
    for (int u = F.bx; u < NB * MN * MH; u += F.G) {
        const int b = u / (MN * MH), n = (u / MH) % MN, h = u % MH, t0 = b * S + n * MC;
        __syncthreads();
        const int s = tid >> 2, d0 = (tid & 3) * 16;
        {
            const v4u* vr = (const v4u*)(K.P() + (size_t)(t0 + s) * PLD + C_VG + h * 64 + d0);
            float g[16]; { float f[8]; unpack8(vr[0], f);
#pragma unroll
                for (int j = 0; j < 8; ++j) g[j] = gelu_tanh(f[j]);
                unpack8(vr[1], f);
#pragma unroll
                for (int j = 0; j < 8; ++j) g[8 + j] = gelu_tanh(f[j]); }
            float ss = 0.f;
#pragma unroll
            for (int j = 0; j < 16; ++j) ss += g[j] * g[j];
            ss += shx(ss, 1); ss += shx(ss, 2);
            const float rs = rsqrtf(ss * (1.0f / 64.0f) + EPS);
#pragma unroll
            for (int j = 0; j < 16; ++j) vs[s * 64 + d0 + j] = g[j] * rs * gn[h * 64 + d0 + j];
        }
        __syncthreads();
        const int t = s;
        float acc[16];
#pragma unroll
        for (int j = 0; j < 16; ++j) acc[j] = 0.f;
        const float* wr = wsp + ((size_t)h * 128 + t) * 128;
#pragma unroll 2
        for (int s2 = 0; s2 <= t; ++s2) { const float w = wr[s2];
#pragma unroll
            for (int j = 0; j < 16; ++j) acc[j] += w * vs[s2 * 64 + d0 + j]; }
        const float bias = bsp[h * 128 + t];
        const v4u* ur = (const v4u*)(K.P() + (size_t)(t0 + t) * PLD + C_U + h * 64 + d0);
        float u0[8], u1[8]; unpack8(ur[0], u0); unpack8(ur[1], u1);
        float o[16];
#pragma unroll
        for (int j = 0; j < 8; ++j) { o[j] = gelu_tanh(u0[j]) * (acc[j] + bias); o[8 + j] = gelu_tanh(u1[j]) * (acc[8 + j] + bias); }
        v4u* op = (v4u*)(K.XN() + (size_t)(t0 + t) * D + 512 + h * 64 + d0);
        op[0] = (v4u){pk2(o[0], o[1]), pk2(o[2], o[3]), pk2(o[4], o[5]), pk2(o[6], o[7])};
        op[1] = (v4u){pk2(o[8], o[9]), pk2(o[10], o[11]), pk2(o[12], o[13]), pk2(o[14], o[15])};
    }
}
typedef short bf16x8 __attribute__((ext_vector_type(8)));
__device__ __forceinline__ float fexp(float x) { return __builtin_amdgcn_exp2f(x * 1.4426950408889634f); }
__device__ __forceinline__ float logsig_fast(float x) { return fminf(x, 0.f) - __log2f(1.0f + fexp(-fabsf(x))) * 0.6931471805599453f; }
__device__ __forceinline__ float silu_fast(float x) { return x * __builtin_amdgcn_rcpf(1.0f + __builtin_amdgcn_exp2f(-1.4426950408889634f * x)); }
__device__ __forceinline__ float gelu_fast(float x) { const float u = 0.7978845608028654f * (x + 0.044715f * x * x * x); return x * __builtin_amdgcn_rcpf(1.0f + __builtin_amdgcn_exp2f(-2.8853900817779268f * u)); }
__device__ __forceinline__ f32x4 mfma16(bf16x8 a, bf16x8 b, f32x4 c) { return __builtin_amdgcn_mfma_f32_16x16x32_bf16(a, b, c, 0, 0, 0); }
constexpr int LROWB = 144;
constexpr int L_QD = 0, L_KI = 9216, L_KDT = 18432, L_VT = 27648, L_S = 46080, L_ST = 55296, L_OB = 73728, L_TOT = 107520, OBROW = 528;
#define FRAG(base, row, kel) (*(const LAS bf16x8*)(lds + (base) + (row) * LROWB + (kel) * 2))

__device__ __forceinline__ float gla_b8(const KA& K, LAS unsigned char* lds, int l, int h, int t0, int lane, int wave, float (&bv)[8]) {
    const float* wup = K.in(3) + (size_t)l * 16 * 256 + h * 64 + lane;
    float wu[16];
#pragma unroll
    for (int r = 0; r < 16; ++r) wu[r] = wup[r * 256];
    const float bg = K.in(4)[l * 256 + h * 64 + lane];
    const bf16* P = K.P();
    float run = 0.f;
#pragma unroll
    for (int j = 0; j < 8; ++j) {
        const bf16* gl = P + (size_t)(t0 + 8 * wave + j) * PLD + C_GK;
        float f0[8], f1[8]; unpack8(*(const v4u*)gl, f0); unpack8(*(const v4u*)(gl + 8), f1);
        float a = bg;
#pragma unroll
        for (int r = 0; r < 8; ++r) a += f0[r] * wu[r];
#pragma unroll
        for (int r = 0; r < 8; ++r) a += f1[r] * wu[8 + r];
        run += logsig_fast(a) * (1.0f / 16.0f); bv[j] = run;
    }
    LAS float* tot = (LAS float*)(lds + L_TOT);
    tot[wave * 64 + lane] = run;
    __syncthreads();
    float base = 0.f, all = 0.f;
#pragma unroll
    for (int g = 0; g < 8; ++g) { const float tv = tot[g * 64 + lane]; all += tv; if (g < wave) base += tv; }
#pragma unroll
    for (int j = 0; j < 8; ++j) bv[j] += base;
    return all;
}
__device__ __forceinline__ void gla_stage_vT(const bf16* P, LAS unsigned char* lds, int h, int t0, int tid) {
    const int vv = tid & 127, cq = tid >> 7;
    const bf16* vp = P + (size_t)(t0 + 16 * cq) * PLD + C_V + h * 128 + vv;
    unsigned w[8];
#pragma unroll
    for (int j = 0; j < 8; ++j) w[j] = (unsigned)vp[(size_t)(2 * j) * PLD] | ((unsigned)vp[(size_t)(2 * j + 1) * PLD] << 16);
    LAS v4u* dst = (LAS v4u*)(lds + L_VT + vv * LROWB + cq * 32);
    dst[0] = (v4u){w[0], w[1], w[2], w[3]}; dst[1] = (v4u){w[4], w[5], w[6], w[7]};
}

__device__ __forceinline__ void phase_gla_kv_mfma(Frame& F, int l) {
    const KA K = KA::fresh(); PHASE_TID;
    LAS unsigned char* lds = F.lds;
    const int fr = lane & 15, fq = lane >> 4;
#pragma unroll 1
    for (int ci = F.bx; ci < NB * GH * GN; ci += F.G) {
        const int b = ci / (GH * GN), h = (ci / GN) % GH, n = ci % GN, t0 = b * S + n * GC;
        const bf16* P = K.P();
        __syncthreads();
        float bv[8]; const float bl = gla_b8(K, lds, l, h, t0, lane, wave, bv);
        {
            const bf16* kp = P + (size_t)(t0 + 8 * wave) * PLD + C_K + h * 64 + lane;
            float kd[8];
#pragma unroll
            for (int j = 0; j < 8; ++j) kd[j] = bf2f(kp[(size_t)j * PLD]) * fexp(bl - bv[j]);
            *(LAS v4u*)(lds + L_KDT + lane * LROWB + wave * 16) = (v4u){pk2(kd[0], kd[1]), pk2(kd[2], kd[3]), pk2(kd[4], kd[5]), pk2(kd[6], kd[7])};
        }
        gla_stage_vT(P, lds, h, t0, tid);
        if (wave == 0) K.dec()[(size_t)ci * 64 + lane] = fexp(bl);
        __syncthreads();
        bf16x8 Bf[2];
#pragma unroll
        for (int ks = 0; ks < 2; ++ks) Bf[ks] = FRAG(L_VT, 16 * wave + fr, 32 * ks + 8 * fq);
        float* so = K.Sst() + (size_t)ci * 64 * 128 + 16 * wave + fr;
#pragma unroll
        for (int dt = 0; dt < 4; ++dt) {
            f32x4 acc = (f32x4){0.f, 0.f, 0.f, 0.f};
#pragma unroll
            for (int ks = 0; ks < 2; ++ks) acc = mfma16(FRAG(L_KDT, 16 * dt + fr, 32 * ks + 8 * fq), Bf[ks], acc);
#pragma unroll
            for (int r = 0; r < 4; ++r) so[(size_t)(16 * dt + 4 * fq + r) * 128] = acc[r];
        }
    }
}

__device__ __forceinline__ void phase_gla_out_mfma(Frame& F, int l) {
    const KA K = KA::fresh(); PHASE_TID;
    LAS unsigned char* lds = F.lds;
    const int fr = lane & 15, fq = lane >> 4;
    const float* gnorm = K.in(5) + (size_t)l * 128;
#pragma unroll 1
    for (int ci = F.bx; ci < NB * GH * GN; ci += F.G) {
        const int b = ci / (GH * GN), h = (ci / GN) % GH, n = ci % GN, t0 = b * S + n * GC;
        const bf16* P = K.P();
        __syncthreads();
        float bv[8]; (void)gla_b8(K, lds, l, h, t0, lane, wave, bv);
        {
            const bf16* qp = P + (size_t)(t0 + 8 * wave) * PLD + C_Q + h * 64 + lane;
            const bf16* kp = qp + (C_K - C_Q);
#pragma unroll
            for (int j = 0; j < 8; ++j) {
                const float e = fexp(bv[j]);
                const float qv = bf2f(qp[(size_t)j * PLD]) * 0.125f * e, kv = bf2f(kp[(size_t)j * PLD]) * __builtin_amdgcn_rcpf(e);
                *(LAS bf16*)(lds + L_QD + (8 * wave + j) * LROWB + lane * 2) = (bf16)f2bf(qv);
                *(LAS bf16*)(lds + L_KI + (8 * wave + j) * LROWB + lane * 2) = (bf16)f2bf(kv);
            }
        }
        gla_stage_vT(P, lds, h, t0, tid);
        {
            const int vv = tid & 127, dq = tid >> 7;
            const float* sp = K.Sst() + ((size_t)ci * 64 + 16 * dq) * 128 + vv;
            unsigned w[8];
#pragma unroll
            for (int j = 0; j < 8; ++j) w[j] = pk2(sp[(size_t)(2 * j) * 128], sp[(size_t)(2 * j + 1) * 128]);
            LAS v4u* dst = (LAS v4u*)(lds + L_ST + vv * LROWB + dq * 32);
            dst[0] = (v4u){w[0], w[1], w[2], w[3]}; dst[1] = (v4u){w[4], w[5], w[6], w[7]};
        }
        __syncthreads();
#pragma unroll
        for (int i = 0; i < 2; ++i) {
            const int tix = 2 * wave + i, st = tix >> 2, ct = tix & 3;
            f32x4 acc = (f32x4){0.f, 0.f, 0.f, 0.f};
#pragma unroll
            for (int ks = 0; ks < 2; ++ks) acc = mfma16(FRAG(L_KI, 16 * st + fr, 32 * ks + 8 * fq), FRAG(L_QD, 16 * ct + fr, 32 * ks + 8 * fq), acc);
            const int s0 = 16 * st + 4 * fq, c = 16 * ct + fr;
            float m[4];
#pragma unroll
            for (int r = 0; r < 4; ++r) m[r] = (s0 + r <= c) ? acc[r] : 0.f;
            *(LAS v2u*)(lds + L_S + c * LROWB + s0 * 2) = (v2u){pk2(m[0], m[1]), pk2(m[2], m[3])};
        }
        __syncthreads();
        {
            bf16x8 Av[2], As[2];
#pragma unroll
            for (int ks = 0; ks < 2; ++ks) { Av[ks] = FRAG(L_VT, 16 * wave + fr, 32 * ks + 8 * fq); As[ks] = FRAG(L_ST, 16 * wave + fr, 32 * ks + 8 * fq); }
#pragma unroll
            for (int ct = 0; ct < 4; ++ct) {
                f32x4 acc = (f32x4){0.f, 0.f, 0.f, 0.f};
#pragma unroll
                for (int ks = 0; ks < 2; ++ks) { acc = mfma16(Av[ks], FRAG(L_S, 16 * ct + fr, 32 * ks + 8 * fq), acc); acc = mfma16(As[ks], FRAG(L_QD, 16 * ct + fr, 32 * ks + 8 * fq), acc); }
                *(LAS f32x4*)(lds + L_OB + (16 * ct + fr) * OBROW + (16 * wave + 4 * fq) * 4) = acc;
            }
        }
        __syncthreads();
        {
            const int c = tid >> 3, vg = tid & 7;
            const LAS f32x4* ob = (const LAS f32x4*)(lds + L_OB + c * OBROW + vg * 64);
            f32x4 o[4]; float ss = 0.f;
#pragma unroll
            for (int j = 0; j < 4; ++j) { o[j] = ob[j]; ss += (o[j].x * o[j].x + o[j].y * o[j].y) + (o[j].z * o[j].z + o[j].w * o[j].w); }
            ss += shx(ss, 1); ss += shx(ss, 2); ss += shx(ss, 4);
            const float rs = rsqrtf(ss * (1.0f / 128.0f) + EPS);
            const v4u* gr = (const v4u*)(P + (size_t)(t0 + c) * PLD + C_G + h * 128 + 16 * vg);
            float g0[8], g1[8]; unpack8(gr[0], g0); unpack8(gr[1], g1);
            const f32x4* gn = (const f32x4*)(gnorm + 16 * vg);
            const f32x4 n0 = gn[0], n1 = gn[1], n2 = gn[2], n3 = gn[3];
            v4u w0, w1;
            w0.x = pk2(o[0].x * rs * n0.x * silu_fast(g0[0]), o[0].y * rs * n0.y * silu_fast(g0[1])); w0.y = pk2(o[0].z * rs * n0.z * silu_fast(g0[2]), o[0].w * rs * n0.w * silu_fast(g0[3]));
            w0.z = pk2(o[1].x * rs * n1.x * silu_fast(g0[4]), o[1].y * rs * n1.y * silu_fast(g0[5])); w0.w = pk2(o[1].z * rs * n1.z * silu_fast(g0[6]), o[1].w * rs * n1.w * silu_fast(g0[7]));
            w1.x = pk2(o[2].x * rs * n2.x * silu_fast(g1[0]), o[2].y * rs * n2.y * silu_fast(g1[1])); w1.y = pk2(o[2].z * rs * n2.z * silu_fast(g1[2]), o[2].w * rs * n2.w * silu_fast(g1[3]));
            w1.z = pk2(o[3].x * rs * n3.x * silu_fast(g1[4]), o[3].y * rs * n3.y * silu_fast(g1[5])); w1.w = pk2(o[3].z * rs * n3.z * silu_fast(g1[6]), o[3].w * rs * n3.w * silu_fast(g1[7]));
            v4u* op = (v4u*)(K.XN() + (size_t)(t0 + c) * D + h * 128 + 16 * vg);
            op[0] = w0; op[1] = w1;
        }
    }
}
#undef FRAG


constexpr int L_GKL = 109568, L_BL = 117760, SCN = 4, NSC = GN / SCN, NITEM = NB * GH * NSC;
#define FRAG(base, row, kel) (*(const LAS bf16x8*)(lds + (base) + (row) * LROWB + (kel) * 2))
struct GlaPre { unsigned short k[8], q[8], v[16]; v4u g0, g1; };
template <bool WITH_Q>
__device__ __forceinline__ void gla_prefetch(GlaPre& p, const bf16* P, int h, int t0, int tid, int lane, int wave) {
    const bf16* kp = P + (size_t)(t0 + 8 * wave) * PLD + C_K + h * 64 + lane;
#pragma unroll
    for (int j = 0; j < 8; ++j) p.k[j] = kp[(size_t)j * PLD];
    const int vv = tid & 127, cq = tid >> 7;
    const bf16* vp = P + (size_t)(t0 + 16 * cq) * PLD + C_V + h * 128 + vv;
#pragma unroll
    for (int j = 0; j < 16; ++j) p.v[j] = vp[(size_t)j * PLD];
    if (WITH_Q) {
        const bf16* qp = kp + (C_Q - C_K);
#pragma unroll
        for (int j = 0; j < 8; ++j) p.q[j] = qp[(size_t)j * PLD];
        const v4u* gr = (const v4u*)(P + (size_t)(t0 + (tid >> 3)) * PLD + C_G + h * 128 + 16 * (tid & 7));
        p.g0 = gr[0]; p.g1 = gr[1];
    }
}
__device__ __forceinline__ void gla_stage_gkl(const bf16* P, LAS unsigned char* lds, int tok0, int tid) {
    *(LAS v4u*)(lds + L_GKL + tid * 16) = *(const v4u*)(P + (size_t)(tok0 + (tid >> 1)) * PLD + C_GK + 8 * (tid & 1));
}
__device__ __forceinline__ void gla_b8_part(LAS unsigned char* lds, const float (&wu)[16], float bg, int n, int lane, int wave, float (&bv)[8]) {
    float run = 0.f;
#pragma unroll
    for (int j = 0; j < 8; ++j) {
        const LAS v4u* gl = (const LAS v4u*)(lds + L_GKL + (n * 64 + 8 * wave + j) * 32);
        float f0[8], f1[8]; unpack8(gl[0], f0); unpack8(gl[1], f1);
        float a = bg;
#pragma unroll
        for (int r = 0; r < 8; ++r) a += f0[r] * wu[r];
#pragma unroll
        for (int r = 0; r < 8; ++r) a += f1[r] * wu[8 + r];
        run += logsig_fast(a) * (1.0f / 16.0f); bv[j] = run;
    }
    ((LAS float*)(lds + L_TOT))[wave * 64 + lane] = run;
}
__device__ __forceinline__ float gla_b8_finish(LAS unsigned char* lds, int lane, int wave, float (&bv)[8]) {
    const LAS float* tot = (const LAS float*)(lds + L_TOT);
    float base = 0.f, all = 0.f;
#pragma unroll
    for (int g = 0; g < 8; ++g) { const float tv = tot[g * 64 + lane]; all += tv; if (g < wave) base += tv; }
#pragma unroll
    for (int j = 0; j < 8; ++j) bv[j] += base;
    return all;
}
__device__ __forceinline__ void gla_write_kdT_vT(LAS unsigned char* lds, const GlaPre& p, const float (&bv)[8], float bl, int tid, int lane, int wave) {
    float kd[8];
#pragma unroll
    for (int j = 0; j < 8; ++j) kd[j] = bf2f(p.k[j]) * fexp(bl - bv[j]);
    *(LAS v4u*)(lds + L_KDT + lane * LROWB + wave * 16) = (v4u){pk2(kd[0], kd[1]), pk2(kd[2], kd[3]), pk2(kd[4], kd[5]), pk2(kd[6], kd[7])};
    const int vv = tid & 127, cq = tid >> 7;
    LAS v4u* dst = (LAS v4u*)(lds + L_VT + vv * LROWB + cq * 32);
    dst[0] = (v4u){(unsigned)p.v[0] | ((unsigned)p.v[1] << 16), (unsigned)p.v[2] | ((unsigned)p.v[3] << 16), (unsigned)p.v[4] | ((unsigned)p.v[5] << 16), (unsigned)p.v[6] | ((unsigned)p.v[7] << 16)};
    dst[1] = (v4u){(unsigned)p.v[8] | ((unsigned)p.v[9] << 16), (unsigned)p.v[10] | ((unsigned)p.v[11] << 16), (unsigned)p.v[12] | ((unsigned)p.v[13] << 16), (unsigned)p.v[14] | ((unsigned)p.v[15] << 16)};
    if (wave == 0) ((LAS float*)(lds + L_BL))[lane] = bl;
}
__device__ __forceinline__ void gla_kv_mfma(LAS unsigned char* lds, int wave, int fr, int fq, f32x4 (&acc)[4]) {
    bf16x8 Bf[2];
#pragma unroll
    for (int ks = 0; ks < 2; ++ks) Bf[ks] = FRAG(L_VT, 16 * wave + fr, 32 * ks + 8 * fq);
#pragma unroll
    for (int dt = 0; dt < 4; ++dt) { acc[dt] = (f32x4){0.f, 0.f, 0.f, 0.f};
#pragma unroll
        for (int ks = 0; ks < 2; ++ks) acc[dt] = mfma16(FRAG(L_KDT, 16 * dt + fr, 32 * ks + 8 * fq), Bf[ks], acc[dt]); }
}

__device__ __forceinline__ void phase_gla_A2(Frame& F, int l) {
    const KA K = KA::fresh(); PHASE_TID;
    LAS unsigned char* lds = F.lds;
    const int fr = lane & 15, fq = lane >> 4;
#pragma unroll 1
    for (int it = F.bx; it < NITEM; it += F.G) {
        const int b = it / (GH * NSC), h = (it / NSC) % GH, sc = it % NSC, tok0 = b * S + sc * SCN * GC;
        const bf16* P = K.P();
        float wu[16];
        { const float* wup = K.in(3) + (size_t)l * 16 * 256 + h * 64 + lane;
#pragma unroll
          for (int r = 0; r < 16; ++r) wu[r] = wup[r * 256]; }
        const float bg = K.in(4)[l * 256 + h * 64 + lane];
        GlaPre pre[2]; gla_prefetch<false>(pre[0], P, h, tok0, tid, lane, wave); gla_prefetch<false>(pre[1], P, h, tok0 + GC, tid, lane, wave);
        __syncthreads();
        gla_stage_gkl(P, lds, tok0, tid);
        __syncthreads();
        f32x4 Sl[4], bs[4];
#pragma unroll
        for (int dt = 0; dt < 4; ++dt) { Sl[dt] = (f32x4){0.f, 0.f, 0.f, 0.f}; bs[dt] = (f32x4){0.f, 0.f, 0.f, 0.f}; }
#pragma unroll
        for (int n = 0; n < SCN; ++n) {
            float bv[8]; gla_b8_part(lds, wu, bg, n, lane, wave, bv);
            __syncthreads();
            const float bl = gla_b8_finish(lds, lane, wave, bv);
            gla_write_kdT_vT(lds, pre[n & 1], bv, bl, tid, lane, wave);
            if (n + 2 < SCN) gla_prefetch<false>(pre[n & 1], P, h, tok0 + (n + 2) * GC, tid, lane, wave);
            __syncthreads();
            f32x4 acc[4]; gla_kv_mfma(lds, wave, fr, fq, acc);
#pragma unroll
            for (int dt = 0; dt < 4; ++dt) { const f32x4 bl4 = *(const LAS f32x4*)(lds + L_BL + (16 * dt + 4 * fq) * 4);
                bs[dt] = bs[dt] + bl4;
#pragma unroll
                for (int r = 0; r < 4; ++r) Sl[dt][r] = fexp(bl4[r]) * Sl[dt][r] + acc[dt][r]; }
        }
        f32x4* ag = (f32x4*)K.Sst() + ((size_t)(it * 8 + wave) * 4) * 64 + lane;
#pragma unroll
        for (int dt = 0; dt < 4; ++dt) ag[dt * 64] = Sl[dt];
        if (wave == 0 && fr == 0) { f32x4* dp = (f32x4*)K.dec() + (size_t)it * 16 + fq;
#pragma unroll
            for (int dt = 0; dt < 4; ++dt) dp[dt * 4] = (f32x4){fexp(bs[dt][0]), fexp(bs[dt][1]), fexp(bs[dt][2]), fexp(bs[dt][3])}; }
    }
}


__device__ __forceinline__ void phase_gla_aggscan(Frame& F) {
    const KA K = KA::fresh(); PHASE_TID;
#pragma unroll 1
    for (int e = F.bx * NT + tid; e < NB * GH * 8192; e += F.G * NT) {
        const int bh = e >> 13, el = e & 8191, ln = (el >> 2) & 63, dt = (el >> 8) & 3, r = el & 3;
        float* ap = K.Sst() + (size_t)bh * NSC * 8192 + el; const float* dp = K.dec() + (size_t)bh * NSC * 64 + dt * 16 + (ln >> 4) * 4 + r;
        float a[NSC], d[NSC];
#pragma unroll
        for (int j = 0; j < NSC; ++j) { a[j] = ap[(size_t)j * 8192]; d[j] = dp[j * 64]; }
        float st = 0.f;
#pragma unroll
        for (int j = 0; j < NSC; ++j) { ap[(size_t)j * 8192] = st; st = d[j] * st + a[j]; }
    }
}
__device__ __forceinline__ void phase_gla_C2(Frame& F, int l) {
    const KA K = KA::fresh(); PHASE_TID;
    LAS unsigned char* lds = F.lds;
    const int fr = lane & 15, fq = lane >> 4;
    const float* gnorm = K.in(5) + (size_t)l * 128;
#pragma unroll 1
    for (int it = F.bx; it < NITEM; it += F.G) {
        const int b = it / (GH * NSC), h = (it / NSC) % GH, sc = it % NSC, tok0 = b * S + sc * SCN * GC;
        const bf16* P = K.P();
        float wu[16];
        { const float* wup = K.in(3) + (size_t)l * 16 * 256 + h * 64 + lane;
#pragma unroll
          for (int r = 0; r < 16; ++r) wu[r] = wup[r * 256]; }
        const float bg = K.in(4)[l * 256 + h * 64 + lane];
        GlaPre pre[2]; gla_prefetch<true>(pre[0], P, h, tok0, tid, lane, wave); gla_prefetch<true>(pre[1], P, h, tok0 + GC, tid, lane, wave);
        __syncthreads();
        gla_stage_gkl(P, lds, tok0, tid);
        f32x4 Sm[4];
        { const f32x4* ag = (const f32x4*)K.Sst() + ((size_t)(it * 8 + wave) * 4) * 64 + lane;
#pragma unroll
          for (int dt = 0; dt < 4; ++dt) Sm[dt] = ag[dt * 64]; }
        __syncthreads();
#pragma unroll
        for (int n = 0; n < SCN; ++n) {
            const int t0 = tok0 + n * GC;
            GlaPre& pr = pre[n & 1];
            float bv[8]; gla_b8_part(lds, wu, bg, n, lane, wave, bv);
            __syncthreads();
            const float bl = gla_b8_finish(lds, lane, wave, bv);
            gla_write_kdT_vT(lds, pr, bv, bl, tid, lane, wave);
#pragma unroll
            for (int j = 0; j < 8; ++j) {
                const float e = fexp(bv[j]);
                *(LAS bf16*)(lds + L_QD + (8 * wave + j) * LROWB + lane * 2) = (bf16)f2bf(bf2f(pr.q[j]) * 0.125f * e);
                *(LAS bf16*)(lds + L_KI + (8 * wave + j) * LROWB + lane * 2) = (bf16)f2bf(bf2f(pr.k[j]) * __builtin_amdgcn_rcpf(e));
            }
#pragma unroll
            for (int dt = 0; dt < 4; ++dt) *(LAS v2u*)(lds + L_ST + (16 * wave + fr) * LROWB + (16 * dt + 4 * fq) * 2) = (v2u){pk2(Sm[dt][0], Sm[dt][1]), pk2(Sm[dt][2], Sm[dt][3])};
            const v4u gq0 = pr.g0, gq1 = pr.g1;
            if (n + 2 < SCN) gla_prefetch<true>(pr, P, h, t0 + 2 * GC, tid, lane, wave);
            __syncthreads();
#pragma unroll
            for (int i = 0; i < 2; ++i) {
                const int tix = 2 * wave + i, st = tix >> 2, ct = tix & 3;
                f32x4 a = (f32x4){0.f, 0.f, 0.f, 0.f};
#pragma unroll
                for (int ks = 0; ks < 2; ++ks) a = mfma16(FRAG(L_KI, 16 * st + fr, 32 * ks + 8 * fq), FRAG(L_QD, 16 * ct + fr, 32 * ks + 8 * fq), a);
                const int s0 = 16 * st + 4 * fq, c = 16 * ct + fr;
                float m[4];
#pragma unroll
                for (int r = 0; r < 4; ++r) m[r] = (s0 + r <= c) ? a[r] : 0.f;
                *(LAS v2u*)(lds + L_S + c * LROWB + s0 * 2) = (v2u){pk2(m[0], m[1]), pk2(m[2], m[3])};
            }
            f32x4 kv[4]; gla_kv_mfma(lds, wave, fr, fq, kv);
            __syncthreads();
            {
                bf16x8 Av[2], As[2];
#pragma unroll
                for (int ks = 0; ks < 2; ++ks) { Av[ks] = FRAG(L_VT, 16 * wave + fr, 32 * ks + 8 * fq); As[ks] = FRAG(L_ST, 16 * wave + fr, 32 * ks + 8 * fq); }
#pragma unroll
                for (int ct = 0; ct < 4; ++ct) {
                    f32x4 a = (f32x4){0.f, 0.f, 0.f, 0.f};
#pragma unroll
                    for (int ks = 0; ks < 2; ++ks) { a = mfma16(Av[ks], FRAG(L_S, 16 * ct + fr, 32 * ks + 8 * fq), a); a = mfma16(As[ks], FRAG(L_QD, 16 * ct + fr, 32 * ks + 8 * fq), a); }
                    *(LAS f32x4*)(lds + L_OB + (16 * ct + fr) * OBROW + (16 * wave + 4 * fq) * 4) = a;
                }
            }
#pragma unroll
            for (int dt = 0; dt < 4; ++dt) { const f32x4 bl4 = *(const LAS f32x4*)(lds + L_BL + (16 * dt + 4 * fq) * 4);
#pragma unroll
                for (int r = 0; r < 4; ++r) Sm[dt][r] = fexp(bl4[r]) * Sm[dt][r] + kv[dt][r]; }
            __syncthreads();
            {
                const int c = tid >> 3, vg = tid & 7;
                const LAS f32x4* ob = (const LAS f32x4*)(lds + L_OB + c * OBROW + vg * 64);
                f32x4 o[4]; float ss = 0.f;
#pragma unroll
                for (int j = 0; j < 4; ++j) { o[j] = ob[j]; ss += (o[j].x * o[j].x + o[j].y * o[j].y) + (o[j].z * o[j].z + o[j].w * o[j].w); }
                ss += shx(ss, 1); ss += shx(ss, 2); ss += shx(ss, 4);
                const float rs = rsqrtf(ss * (1.0f / 128.0f) + EPS);
                float g0[8], g1[8]; unpack8(gq0, g0); unpack8(gq1, g1);
                const f32x4* gn = (const f32x4*)(gnorm + 16 * vg);
                const f32x4 n0 = gn[0], n1 = gn[1], n2 = gn[2], n3 = gn[3];
                v4u w0, w1;
                w0.x = pk2(o[0].x * rs * n0.x * silu_fast(g0[0]), o[0].y * rs * n0.y * silu_fast(g0[1])); w0.y = pk2(o[0].z * rs * n0.z * silu_fast(g0[2]), o[0].w * rs * n0.w * silu_fast(g0[3]));
                w0.z = pk2(o[1].x * rs * n1.x * silu_fast(g0[4]), o[1].y * rs * n1.y * silu_fast(g0[5])); w0.w = pk2(o[1].z * rs * n1.z * silu_fast(g0[6]), o[1].w * rs * n1.w * silu_fast(g0[7]));
                w1.x = pk2(o[2].x * rs * n2.x * silu_fast(g1[0]), o[2].y * rs * n2.y * silu_fast(g1[1])); w1.y = pk2(o[2].z * rs * n2.z * silu_fast(g1[2]), o[2].w * rs * n2.w * silu_fast(g1[3]));
                w1.z = pk2(o[3].x * rs * n3.x * silu_fast(g1[4]), o[3].y * rs * n3.y * silu_fast(g1[5])); w1.w = pk2(o[3].z * rs * n3.z * silu_fast(g1[6]), o[3].w * rs * n3.w * silu_fast(g1[7]));
                v4u* op = (v4u*)(K.XN() + (size_t)(t0 + c) * D + h * 128 + 16 * vg);
                op[0] = w0; op[1] = w1;
            }
        }
    }
}
#undef FRAG

constexpr int GM_ROWB = 272;
__device__ __forceinline__ void phase_gmlp_mfma(Frame& F, int l) {
    const KA K = KA::fresh(); PHASE_TID;
    LAS unsigned char* lds = F.lds;
    const int fr = lane & 15, fq = lane >> 4;
#pragma unroll 1
    for (int u = F.bx; u < NB * MN * MH; u += F.G) {
        const int b = u / (MN * MH), n = (u / MH) % MN, h = u % MH, t0 = b * S + n * MC;
        const bf16* P = K.P();
        const float gn = K.in(6)[(size_t)l * 256 + h * 64 + lane];
        __syncthreads();
#pragma unroll
        for (int q = 0; q < 2; ++q) {
            float vs[8];
#pragma unroll
            for (int i = 0; i < 8; ++i) {
                const float g = gelu_fast(bf2f(P[(size_t)(t0 + 16 * wave + 8 * q + i) * PLD + C_VG + h * 64 + lane]));
                const float ss = wave_sum(g * g);
                vs[i] = g * rsqrtf(ss * (1.0f / 64.0f) + EPS) * gn;
            }
            *(LAS v4u*)(lds + lane * GM_ROWB + (16 * wave + 8 * q) * 2) = (v4u){pk2(vs[0], vs[1]), pk2(vs[2], vs[3]), pk2(vs[4], vs[5]), pk2(vs[6], vs[7])};
        }
        __syncthreads();
        const bf16* Wb = K.Wsp() + ((size_t)(l * MH + h) * 128 + 16 * wave + fr) * 128 + 8 * fq;
        f32x4 acc[4];
#pragma unroll
        for (int dt = 0; dt < 4; ++dt) acc[dt] = (f32x4){0.f, 0.f, 0.f, 0.f};
        const int nks = (16 * wave + 15) / 32 + 1;
#pragma unroll
        for (int ks = 0; ks < 4; ++ks) if (ks < nks) {
            const bf16x8 Bf = *(const bf16x8*)(Wb + 32 * ks);
#pragma unroll
            for (int dt = 0; dt < 4; ++dt) acc[dt] = mfma16(*(const LAS bf16x8*)(lds + (16 * dt + fr) * GM_ROWB + (32 * ks + 8 * fq) * 2), Bf, acc[dt]);
        }
        const int t = 16 * wave + fr;
        const float bias = K.in(8)[(size_t)l * MH * 128 + h * 128 + t];
        const bf16* up = P + (size_t)(t0 + t) * PLD + C_U + h * 64 + 4 * fq;
        bf16* op = K.XN() + (size_t)(t0 + t) * D + 512 + h * 64 + 4 * fq;
#pragma unroll
        for (int dt = 0; dt < 4; ++dt) {
            const v2u uw = *(const v2u*)(up + 16 * dt);
            const float o0 = gelu_fast(bflo(uw.x)) * (acc[dt][0] + bias), o1 = gelu_fast(bfhi(uw.x)) * (acc[dt][1] + bias), o2 = gelu_fast(bflo(uw.y)) * (acc[dt][2] + bias), o3 = gelu_fast(bfhi(uw.y)) * (acc[dt][3] + bias);
            *(v2u*)(op + 16 * dt) = (v2u){pk2(o0, o1), pk2(o2, o3)};
        }
    }
}

__device__ __forceinline__ void phase_conv(Frame& F, int l) {
    const KA K = KA::fresh(); PHASE_TID;
    const float* wc = K.in(9) + (size_t)l * 3 * 256;
#pragma unroll 1
    for (int e = F.bx * NT + tid; e < T * 32; e += F.G * NT) {
        const int t = e >> 5, c0 = (e & 31) * 8, tl = t % S;
        const bf16* row = K.P() + (size_t)t * PLD;
        float y[8], xi[8], cg[8], bg[8];
        unpack8(*(const v4u*)(row + C_XI + c0), xi); unpack8(*(const v4u*)(row + C_CG + c0), cg); unpack8(*(const v4u*)(row + C_BG + c0), bg);
#pragma unroll
        for (int j = 0; j < 8; ++j) y[j] = wc[2 * 256 + c0 + j] * cg[j] * xi[j];
        if (tl >= 1) { unpack8(*(const v4u*)(row - PLD + C_XI + c0), xi); unpack8(*(const v4u*)(row - PLD + C_CG + c0), cg);
#pragma unroll
            for (int j = 0; j < 8; ++j) y[j] += wc[1 * 256 + c0 + j] * cg[j] * xi[j]; }
        if (tl >= 2) { unpack8(*(const v4u*)(row - 2 * PLD + C_XI + c0), xi); unpack8(*(const v4u*)(row - 2 * PLD + C_CG + c0), cg);
#pragma unroll
            for (int j = 0; j < 8; ++j) y[j] += wc[0 * 256 + c0 + j] * cg[j] * xi[j]; }
#pragma unroll
        for (int j = 0; j < 8; ++j) y[j] *= bg[j];
        *(v4u*)(K.XN() + (size_t)t * D + 768 + c0) = (v4u){pk2(y[0], y[1]), pk2(y[2], y[3]), pk2(y[4], y[5]), pk2(y[6], y[7])};
    }
}
__device__ __forceinline__ void phase_norm_router(Frame& F, int l) {
    const KA K = KA::fresh(); PHASE_TID;
    const float* gain = K.in(11) + (size_t)l * D;
    const float* wrg = K.in(12) + (size_t)l * D * 4; const float* brg = K.in(13) + (size_t)l * 4;
    const float* wre = K.in(14) + (size_t)l * D * 32; const float* bre = K.in(15) + (size_t)l * 32;
    int* cnt = (int*)(K.ctl() + CW_CNT + 64 * l);
#pragma unroll 1
    for (int t = F.bx * NWAVES + wave; t < T; t += F.G * NWAVES) {
        const f32x4* xr = (const f32x4*)(K.out() + (size_t)t * D) + lane;
        f32x4 v[4]; float s = 0.f;
#pragma unroll
        for (int j = 0; j < 4; ++j) { v[j] = xr[64 * j]; s += (v[j].x * v[j].x + v[j].y * v[j].y) + (v[j].z * v[j].z + v[j].w * v[j].w); }
        const float rs = rsqrtf(wave_sum(s) * (1.f / D) + EPS);
        v2u* o8 = (v2u*)(K.XN() + (size_t)t * D) + lane;
        float acc[36];
#pragma unroll
        for (int j = 0; j < 36; ++j) acc[j] = 0.f;
#pragma unroll
        for (int j = 0; j < 4; ++j) {
            const f32x4 g = ((const f32x4*)gain)[lane + 64 * j];
            const float hv[4] = {v[j].x * rs * g.x, v[j].y * rs * g.y, v[j].z * rs * g.z, v[j].w * rs * g.w};
            v2u w; w.x = pk2(hv[0], hv[1]); w.y = pk2(hv[2], hv[3]); o8[64 * j] = w;
#pragma unroll
            for (int i = 0; i < 4; ++i) {
                const int k = 4 * lane + 256 * j + i; const float xv = hv[i];
                const f32x4 g4 = *(const f32x4*)(wrg + (size_t)k * 4);
                acc[0] += xv * g4.x; acc[1] += xv * g4.y; acc[2] += xv * g4.z; acc[3] += xv * g4.w;
                const f32x4* e4 = (const f32x4*)(wre + (size_t)k * 32);
#pragma unroll
                for (int q = 0; q < 8; ++q) { const f32x4 w4 = e4[q]; acc[4 + 4 * q] += xv * w4.x; acc[5 + 4 * q] += xv * w4.y; acc[6 + 4 * q] += xv * w4.z; acc[7 + 4 * q] += xv * w4.w; }
            }
        }
#pragma unroll
        for (int j = 0; j < 36; ++j) acc[j] = wave_sum(acc[j]);
        if (lane == 0) {
            float gl[4]; int gt = 0;
#pragma unroll
            for (int j = 0; j < 4; ++j) gl[j] = acc[j] + brg[j];
            float gmax = gl[0];
#pragma unroll
            for (int j = 1; j < 4; ++j) if (gl[j] > gmax) { gmax = gl[j]; gt = j; }
            float gs = 0.f;
#pragma unroll
            for (int j = 0; j < 4; ++j) gs += expf(gl[j] - gmax);
            const float gw = 1.0f / gs;
            float el[8];
#pragma unroll
            for (int j = 0; j < 8; ++j) { float vv = 0.f;
#pragma unroll
                for (int g = 0; g < 4; ++g) if (g == gt) vv = acc[4 + g * 8 + j] + bre[g * 8 + j];
                el[j] = vv; }
            int i0 = 0; float m0 = el[0];
#pragma unroll
            for (int j = 1; j < 8; ++j) if (el[j] > m0) { m0 = el[j]; i0 = j; }
            int i1 = -1; float m1 = -INFINITY;
#pragma unroll
            for (int j = 0; j < 8; ++j) if (j != i0 && el[j] > m1) { m1 = el[j]; i1 = j; }
            const float e1 = expf(m1 - m0);
            const float w0 = gw / (1.0f + e1), w1 = gw * e1 / (1.0f + e1);
            const int e0i = gt * 8 + i0, e1i = gt * 8 + i1;
            K.eid()[2 * t] = e0i; K.eid()[2 * t + 1] = e1i; K.ew()[2 * t] = w0; K.ew()[2 * t + 1] = w1;
            atomicAdd(&cnt[e0i], 1); atomicAdd(&cnt[e1i], 1);
        }
    }
}
constexpr int RT_PART = 0, RT_SS = RT_PART + 2 * 4 * 16 * 48 * 4, RT_RS = RT_SS + 2 * 4 * 16 * 4, RT_HIST = RT_RS + 2 * 16 * 4;
__device__ __forceinline__ void phase_norm_router_mfma(Frame& F, int l) {
    const KA K = KA::fresh(); PHASE_TID;
    LAS unsigned char* lds = F.lds;
    const int fr = lane & 15, fq = lane >> 4, tl = wave >> 2, kq = wave & 3;
    const bf16* Whi = K.Wr() + (size_t)l * 2 * 48 * D; const bf16* Wlo = Whi + 48 * D;
    const float* gain = K.in(11) + (size_t)l * D;
#pragma unroll 1
    for (int blk = F.bx; blk < T / 64; blk += F.G) {
        __syncthreads();
        if (tid < NE) ((LAS int*)(lds + RT_HIST))[tid] = 0;
#pragma unroll 1
        for (int half = 0; half < 2; ++half) {
            const int tok0 = blk * 64 + half * 32 + tl * 16;
            const float* xr = K.out() + (size_t)(tok0 + fr) * D + 256 * kq + 8 * fq;
            const bf16* whi = Whi + (size_t)fr * D + 256 * kq + 8 * fq; const bf16* wlo = Wlo + (size_t)fr * D + 256 * kq + 8 * fq;
            f32x4 acc[3];
#pragma unroll
            for (int nt = 0; nt < 3; ++nt) acc[nt] = (f32x4){0.f, 0.f, 0.f, 0.f};
            float ss = 0.f;
            f32x4 xa[8], xb[8];
#pragma unroll
            for (int ks = 0; ks < 8; ++ks) { xa[ks] = *(const f32x4*)(xr + 32 * ks); xb[ks] = *(const f32x4*)(xr + 32 * ks + 4); }
#pragma unroll
            for (int ks = 0; ks < 8; ++ks) {
                if ((ks & 1) == 0) __builtin_amdgcn_sched_barrier(0);
                const f32x4 x0 = xa[ks], x1 = xb[ks];
                const float xv[8] = {x0.x, x0.y, x0.z, x0.w, x1.x, x1.y, x1.z, x1.w};
                unsigned hw[4], lw[4];
#pragma unroll
                for (int j = 0; j < 4; ++j) { const float a = xv[2 * j], b2 = xv[2 * j + 1]; ss += a * a + b2 * b2;
                    const unsigned ha = f2bf(a), hb = f2bf(b2); hw[j] = ha | (hb << 16); lw[j] = pk2(a - bf2f(ha), b2 - bf2f(hb)); }
                bf16x8 Ah, Al; { v4u t4 = (v4u){hw[0], hw[1], hw[2], hw[3]}; Ah = __builtin_bit_cast(bf16x8, t4); t4 = (v4u){lw[0], lw[1], lw[2], lw[3]}; Al = __builtin_bit_cast(bf16x8, t4); }
#pragma unroll
                for (int nt = 0; nt < 3; ++nt) {
                    const bf16x8 Bh = *(const bf16x8*)(whi + (size_t)(16 * nt) * D + 32 * ks), Bl = *(const bf16x8*)(wlo + (size_t)(16 * nt) * D + 32 * ks);
                    acc[nt] = mfma16(Ah, Bh, acc[nt]); acc[nt] = mfma16(Al, Bh, acc[nt]); acc[nt] = mfma16(Ah, Bl, acc[nt]);
                }
            }
            ss += shx(ss, 16); ss += shx(ss, 32);
            {
                LAS float* part = (LAS float*)(lds + RT_PART) + (tl * 4 + kq) * 16 * 48;
#pragma unroll
                for (int nt = 0; nt < 3; ++nt)
#pragma unroll
                    for (int r = 0; r < 4; ++r) part[(4 * fq + r) * 48 + 16 * nt + fr] = acc[nt][r];
                if (fq == 0) ((LAS float*)(lds + RT_SS))[(tl * 4 + kq) * 16 + fr] = ss;
            }
            __syncthreads();
            if (kq == 0 && lane < 16) {
                const int t = tok0 + lane;
                const LAS float* p0 = (const LAS float*)(lds + RT_PART) + (tl * 4) * 16 * 48 + lane * 48;
                const LAS float* s2 = (const LAS float*)(lds + RT_SS) + (tl * 4) * 16 + lane;
                const float rs = rsqrtf(((s2[0] + s2[16]) + (s2[32] + s2[48])) * (1.f / D) + EPS);
                ((LAS float*)(lds + RT_RS))[tl * 16 + lane] = rs;
                const float* brg = K.in(13) + (size_t)l * 4; const float* bre = K.in(15) + (size_t)l * 32;
#define RT_DOT(n) ((p0[(n)] + p0[768 + (n)]) + (p0[1536 + (n)] + p0[2304 + (n)]))
                float gl[4]; int gt = 0;
#pragma unroll
                for (int j = 0; j < 4; ++j) gl[j] = RT_DOT(j) * rs + brg[j];
                float gmax = gl[0];
#pragma unroll
                for (int j = 1; j < 4; ++j) if (gl[j] > gmax) { gmax = gl[j]; gt = j; }
                float gs = 0.f;
#pragma unroll
                for (int j = 0; j < 4; ++j) gs += expf(gl[j] - gmax);
                const float gw = 1.0f / gs;
                float el[8];
#pragma unroll
                for (int j = 0; j < 8; ++j) el[j] = RT_DOT(4 + gt * 8 + j) * rs + bre[gt * 8 + j];
#undef RT_DOT
                int i0 = 0; float m0 = el[0];
#pragma unroll
                for (int j = 1; j < 8; ++j) if (el[j] > m0) { m0 = el[j]; i0 = j; }
                int i1 = -1; float m1 = -INFINITY;
#pragma unroll
                for (int j = 0; j < 8; ++j) if (j != i0 && el[j] > m1) { m1 = el[j]; i1 = j; }
                const float e1 = expf(m1 - m0);
                const float w0 = gw / (1.0f + e1), w1 = gw * e1 / (1.0f + e1);
                const int e0i = gt * 8 + i0, e1i = gt * 8 + i1;
                K.eid()[2 * t] = e0i; K.eid()[2 * t + 1] = e1i; K.ew()[2 * t] = w0; K.ew()[2 * t + 1] = w1;
                LAS int* hist = (LAS int*)(lds + RT_HIST);
                K.slot_of()[2 * t] = __hip_atomic_fetch_add(hist + e0i, 1, __ATOMIC_RELAXED, __HIP_MEMORY_SCOPE_WORKGROUP);
                K.slot_of()[2 * t + 1] = __hip_atomic_fetch_add(hist + e1i, 1, __ATOMIC_RELAXED, __HIP_MEMORY_SCOPE_WORKGROUP);
            }
            __syncthreads();
            {
                const float rs = ((const LAS float*)(lds + RT_RS))[tl * 16 + fr];
                bf16* hp = K.XN() + (size_t)(tok0 + fr) * D + 256 * kq + 8 * fq;
                const float* gp = gain + 256 * kq + 8 * fq;
#pragma unroll
                for (int ks = 0; ks < 8; ++ks) {
                    const f32x4 x0 = xa[ks], x1 = xb[ks];
                    const f32x4 g0 = *(const f32x4*)(gp + 32 * ks), g1 = *(const f32x4*)(gp + 32 * ks + 4);
                    *(v4u*)(hp + 32 * ks) = (v4u){pk2(x0.x * rs * g0.x, x0.y * rs * g0.y), pk2(x0.z * rs * g0.z, x0.w * rs * g0.w), pk2(x1.x * rs * g1.x, x1.y * rs * g1.y), pk2(x1.z * rs * g1.z, x1.w * rs * g1.w)};
                }
            }
        }
        __syncthreads();
        if (tid < NE) K.blkcnt()[(size_t)(l * (T / 64) + blk) * NE + tid] = ((LAS int*)(lds + RT_HIST))[tid];
    }
}
__device__ __forceinline__ void phase_scatter(Frame& F, int l) {
    const KA K = KA::fresh(); PHASE_TID;
    LAS int* sm = (LAS int*)F.lds;
    const int* bc = K.blkcnt() + (size_t)l * (T / 64) * NE;
    constexpr int NBLK = T / 64;
#pragma unroll 1
    for (int blk = F.bx; blk < NBLK; blk += F.G) {
        __syncthreads();
        {   const int e = tid & 31, part = tid >> 5;
            int tot = 0, pre = 0;
#pragma unroll
            for (int j = 0; j < NBLK / 16; ++j) { const int bb = part * (NBLK / 16) + j; const int c = bc[bb * NE + e]; tot += c; if (bb < blk) pre += c; }
            sm[part * 32 + e] = tot; sm[512 + part * 32 + e] = pre; }
        __syncthreads();
        if (tid < 32) { int tot = 0, pre = 0;
#pragma unroll
            for (int p = 0; p < 16; ++p) { tot += sm[p * 32 + tid]; pre += sm[512 + p * 32 + tid]; }
            sm[1056 + tid] = tot; sm[1024 + tid] = pre; }
        __syncthreads();
        if (tid == 0) { int a = 0; for (int e = 0; e < NE; ++e) { const int c = sm[1056 + e]; sm[1024 + e] += a; a += c; } }
        if (blk == 0 && tid < 32) ((int*)(K.ctl() + CW_CNT + 64 * l))[tid] = sm[1056 + tid];
        __syncthreads();
        if (tid < 128) { const int a = blk * 128 + tid; const int e = K.eid()[a]; const int pos = sm[1024 + e] + K.slot_of()[a]; K.slot_tok()[pos] = a >> 1; K.slot_of()[a] = pos; }
    }
    __syncthreads();
}
template <bool DUAL>
__device__ __forceinline__ void gemm_core(const bf16* A, const int* rowoff, int K, const float* B0, const float* B1, int ldb, int n0,
                                          float (&acc0)[4][4], float (&acc1)[4][4], float* As, float* Bs0, float* Bs1) {
    const int tid = __builtin_amdgcn_readfirstlane(threadIdx.x >> 6) * 64 + fresh_lane(), tx = tid & 15, ty = tid >> 4;
    const int ar = tid >> 2, ak = (tid & 3) * 4;
    const int bk = (tid >> 4) & 15, bn = (tid & 15) * 4;
    const long aoff = rowoff[ar];
#pragma unroll
    for (int i = 0; i < 4; ++i)
#pragma unroll
        for (int j = 0; j < 4; ++j) { acc0[i][j] = 0.f; acc1[i][j] = 0.f; }
#pragma unroll 1
    for (int k0 = 0; k0 < K; k0 += 16) {
        v2u av = (v2u){0u, 0u};
        if (aoff >= 0) av = *(const v2u*)(A + aoff + k0 + ak);
        f32x4 bv0 = (f32x4){0.f, 0.f, 0.f, 0.f}, bv1 = bv0;
        if (tid < 256) { bv0 = *(const f32x4*)(B0 + (size_t)(k0 + bk) * ldb + n0 + bn); if (DUAL) bv1 = *(const f32x4*)(B1 + (size_t)(k0 + bk) * ldb + n0 + bn); }
        __syncthreads();
        As[(ak + 0) * 132 + ar] = bflo(av.x); As[(ak + 1) * 132 + ar] = bfhi(av.x); As[(ak + 2) * 132 + ar] = bflo(av.y); As[(ak + 3) * 132 + ar] = bfhi(av.y);
        if (tid < 256) { *(f32x4*)(Bs0 + bk * 64 + bn) = bv0; if (DUAL) *(f32x4*)(Bs1 + bk * 64 + bn) = bv1; }
        __syncthreads();
#pragma unroll
        for (int kk = 0; kk < 16; ++kk) {
            const f32x4 a4 = *(const f32x4*)(As + kk * 132 + ty * 4);
            const f32x4 b4 = *(const f32x4*)(Bs0 + kk * 64 + tx * 4);
#pragma unroll
            for (int i = 0; i < 4; ++i)
#pragma unroll
                for (int j = 0; j < 4; ++j) acc0[i][j] += a4[i] * b4[j];
            if (DUAL) {
                const f32x4 c4 = *(const f32x4*)(Bs1 + kk * 64 + tx * 4);
#pragma unroll
                for (int i = 0; i < 4; ++i)
#pragma unroll
                    for (int j = 0; j < 4; ++j) acc1[i][j] += a4[i] * c4[j];
            }
        }
    }
}
template <int MODE>
__device__ __forceinline__ void phase_moe_ref(Frame& F, int l) {
    const KA K = KA::fresh(); PHASE_TID;
    float* As = F.smem; float* Bs0 = F.smem + 16 * 132; float* Bs1 = Bs0 + 16 * 64; int* rowoff = (int*)(Bs1 + 16 * 64); int* offs = rowoff + 128; int* toff = offs + 33;
    int* cnt = (int*)(K.ctl() + CW_CNT + 64 * l);
    const int tx = tid & 15, ty = tid >> 4;
    __syncthreads();
    if (tid == 0) { int a = 0, tt = 0; for (int e = 0; e < NE; ++e) { offs[e] = a; toff[e] = tt; const int c = cnt[e]; a += c; tt += (c + 127) / 128; } offs[NE] = a; toff[NE] = tt; }
    __syncthreads();
    constexpr int N = (MODE == 1) ? DE : D, KD = (MODE == 1) ? D : DE, NTN = N / 64;
    const int ntiles = toff[NE] * NTN;
#pragma unroll 1
    for (int t = F.bx; t < ntiles; t += F.G) {
        const int rt = t / NTN, tn = t % NTN;
        int e = 0;
        for (int j = 1; j < NE; ++j) if (toff[j] <= rt) e = j;
        const int r0 = offs[e] + (rt - toff[e]) * 128, rend = offs[e + 1];
        __syncthreads();
        if (tid < 128) { const int r = r0 + tid; rowoff[tid] = (r < rend) ? ((MODE == 1) ? K.slot_tok()[r] * D : r * DE) : -1; }
        __syncthreads();
        float acc0[4][4], acc1[4][4];
        if (MODE == 1) {
            const float* Wg = K.in(16) + ((size_t)l * NE + e) * D * DE; const float* Wu = K.in(17) + ((size_t)l * NE + e) * D * DE;
            gemm_core<true>(K.XN(), rowoff, KD, Wg, Wu, DE, tn * 64, acc0, acc1, As, Bs0, Bs1);
        } else {
            const float* Wd = K.in(18) + ((size_t)l * NE + e) * DE * D;
            gemm_core<false>(K.H1(), rowoff, KD, Wd, nullptr, D, tn * 64, acc0, acc1, As, Bs0, nullptr);
        }
#pragma unroll
        for (int i = 0; i < 4; ++i) {
            const int r = r0 + ty * 4 + i;
            if (r < rend) {
                v2u o;
                if (MODE == 1) { o.x = pk2(silu(acc0[i][0]) * acc1[i][0], silu(acc0[i][1]) * acc1[i][1]); o.y = pk2(silu(acc0[i][2]) * acc1[i][2], silu(acc0[i][3]) * acc1[i][3]);
                    *(v2u*)(K.H1() + (size_t)r * DE + tn * 64 + tx * 4) = o; }
                else { o.x = pk2(acc0[i][0], acc0[i][1]); o.y = pk2(acc0[i][2], acc0[i][3]); *(v2u*)(K.Y() + (size_t)r * D + tn * 64 + tx * 4) = o; }
            }
        }
    }
    __syncthreads();
}

constexpr int TAB_OFF = LDSCTL_OFF + 1024;
__device__ __forceinline__ void moe_tables(Frame& F, int l) {
    const KA K = KA::fresh(); PHASE_TID;
    LAS int* tab = (LAS int*)(F.lds + TAB_OFF); LAS int* offs = tab + 4 + 4 * 164; LAS int* fpre = offs + 40; LAS int* ppre = fpre + 40;
    const int* cnt = (const int*)(K.ctl() + CW_CNT + 64 * l);
    __syncthreads();
    if (tid == 0) { int a = 0, f = 0, p = 0; for (int e = 0; e < NE; ++e) { const int c = cnt[e]; offs[e] = a; fpre[e] = f; ppre[e] = p; a += c; f += c >> 8; p += (c & 255) ? 1 : 0; }
        offs[NE] = a; fpre[NE] = f; ppre[NE] = p; tab[0] = f + p; }
    __syncthreads();
    const int nfull = fpre[NE], ntile = nfull + ppre[NE];
    if (tid < ntile) {
        int e = 0;
        if (tid < nfull) { for (int j = 1; j < NE; ++j) if (fpre[j] <= tid) e = j; tab[4 + 4 * tid] = e; tab[5 + 4 * tid] = offs[e] + (tid - fpre[e]) * 256; tab[6 + 4 * tid] = offs[e + 1]; }
        else { const int q = tid - nfull; for (int j = 1; j < NE; ++j) if (ppre[j] <= q) e = j; tab[4 + 4 * tid] = e; tab[5 + 4 * tid] = offs[e] + (fpre[e + 1] - fpre[e]) * 256; tab[6 + 4 * tid] = offs[e + 1]; }
    }
    __syncthreads();
}
__device__ __forceinline__ void phase_moe_gu(Frame& F, int l) {
    moe_tables(F, l);
    const KA K = KA::fresh();
    int c_ = F.bx; asm volatile("" : "+s"(c_));
    pg8::MoeSched So{(const LAS int*)(F.lds + TAB_OFF), 2, F.G, (c_ & 7) * (F.G >> 3) + (c_ >> 3)};
    pg8::EpiMoeH E{K.H1()};
    pg8::gemm_phase_moe<pg8::EpiMoeH, pg8::MoeSched, true, 512, D>(F.lds, K.XN(), K.WguT() + (size_t)l * NE * 512 * D, K.slot_tok(), So, E, F.wave);
}
__device__ __forceinline__ void phase_moe_down(Frame& F, int l) {
    moe_tables(F, l);
    const KA K = KA::fresh();
    int c_ = F.bx; asm volatile("" : "+s"(c_));
    pg8::MoeSched So{(const LAS int*)(F.lds + TAB_OFF), 4, F.G, (c_ & 7) * (F.G >> 3) + (c_ >> 3)};
    pg8::EpiMoeY E{K.Y()};
    pg8::gemm_phase_moe<pg8::EpiMoeY, pg8::MoeSched, false, D, DE>(F.lds, K.H1(), K.WdT() + (size_t)l * NE * D * DE, nullptr, So, E, F.wave);
}
__device__ __forceinline__ void phase_combine(Frame& F, int l) {
    const KA K = KA::fresh(); PHASE_TID;
    const bool last = (l == DEPTH - 1);
    const float* gain = last ? K.in(19) : (K.in(1) + (size_t)(l + 1) * D);
#pragma unroll 1
    for (int t = F.bx * NWAVES + wave; t < T; t += F.G * NWAVES) {
        const int s0 = K.slot_of()[2 * t], s1 = K.slot_of()[2 * t + 1]; const float w0 = K.ew()[2 * t], w1 = K.ew()[2 * t + 1];
        f32x4* xr = (f32x4*)(K.out() + (size_t)t * D) + lane;
        const v2u* y0 = (const v2u*)(K.Y() + (size_t)s0 * D) + lane; const v2u* y1 = (const v2u*)(K.Y() + (size_t)s1 * D) + lane;
        f32x4 v[4]; float s = 0.f;
#pragma unroll
        for (int j = 0; j < 4; ++j) { v[j] = xr[64 * j]; const v2u a = y0[64 * j], b = y1[64 * j];
            v[j].x += w0 * bflo(a.x) + w1 * bflo(b.x); v[j].y += w0 * bfhi(a.x) + w1 * bfhi(b.x); v[j].z += w0 * bflo(a.y) + w1 * bflo(b.y); v[j].w += w0 * bfhi(a.y) + w1 * bfhi(b.y);
            s += (v[j].x * v[j].x + v[j].y * v[j].y) + (v[j].z * v[j].z + v[j].w * v[j].w); }
        const float rs = rsqrtf(wave_sum(s) * (1.f / D) + EPS);
        if (last) {
#pragma unroll
            for (int j = 0; j < 4; ++j) { const f32x4 g = ((const f32x4*)gain)[lane + 64 * j]; xr[64 * j] = (f32x4){v[j].x * rs * g.x, v[j].y * rs * g.y, v[j].z * rs * g.z, v[j].w * rs * g.w}; }
        } else {
            v2u* o8 = (v2u*)(K.XN() + (size_t)t * D) + lane;
#pragma unroll
            for (int j = 0; j < 4; ++j) { xr[64 * j] = v[j]; const f32x4 g = ((const f32x4*)gain)[lane + 64 * j];
                v2u w; w.x = pk2(v[j].x * rs * g.x, v[j].y * rs * g.y); w.y = pk2(v[j].z * rs * g.z, v[j].w * rs * g.w); o8[64 * j] = w; }
        }
    }
}

struct Args { const float* in[20]; float* out; unsigned char* ws; };
__global__ void __launch_bounds__(NT, 2) fwd_kernel(Args args) {
    extern __shared__ __attribute__((aligned(16))) unsigned char lds_raw[];
    Frame F;
    F.lds = (LAS unsigned char*)lds_raw; F.smem = (float*)lds_raw;
    F.G = gridDim.x; F.bx = blockIdx.x; F.wave = __builtin_amdgcn_readfirstlane(threadIdx.x >> 6);
    volatile LAS unsigned* MISC = (volatile LAS unsigned*)(F.lds + MISC_OFF);
    for (int u = threadIdx.x; u < (LDS_BYTES - LDSCTL_OFF) / 4; u += NT) ((LAS unsigned*)(F.lds + LDSCTL_OFF))[u] = 0u;
    __syncthreads();
    XcdBarrier bar; { const KA K = KA::fresh(); bar = xcd_barrier_post(K.ctl() + CW_BAR, MISC + 8); }
#define GRID_BAR() xcd_barrier(bar)

    p0_prologue(F);
    GRID_BAR();
    for (int l = 0; l < DEPTH; ++l) {
        {
            const KA K = KA::fresh(); PHASE_TID;
            pg8::Gemm g{K.XN(), K.WinT() + (size_t)l * PLD * D, T, PLD, D}; pg8::StaticOrder So; int c_ = F.bx; asm volatile("" : "+s"(c_)); So.init(T, PLD, F.G, c_);
            pg8::EpiBf16Plain E{K.P(), PLD};
            pg8::gemm_phase<pg8::EpiBf16Plain, pg8::StaticOrder, PG8_ALIGN, PG8_SP2>(F.lds, g, So, E, F.wave);
        }
        GRID_BAR();
        phase_gla_A2(F, l);
        phase_gmlp_mfma(F, l);
        phase_conv(F, l);
        GRID_BAR();
        phase_gla_aggscan(F);
        GRID_BAR();
        phase_gla_C2(F, l);
        GRID_BAR();
        {
            const KA K = KA::fresh(); PHASE_TID;
            pg8::Gemm g{K.XN(), K.WoutT() + (size_t)l * D * D, T, D, D}; pg8::StaticOrder So; int c_ = F.bx; asm volatile("" : "+s"(c_)); So.init(T, D, F.G, c_);
            pg8::EpiF32Res E{K.out(), (l == 0) ? K.in(0) : K.out(), D};
            pg8::gemm_phase<pg8::EpiF32Res, pg8::StaticOrder, PG8_ALIGN, PG8_SP2>(F.lds, g, So, E, F.wave);
        }
        GRID_BAR();
        phase_norm_router_mfma(F, l);
        GRID_BAR();
        phase_scatter(F, l);
        GRID_BAR();
        phase_moe_gu(F, l);
        GRID_BAR();
        phase_moe_down(F, l);
        GRID_BAR();
        phase_combine(F, l);
        if (l + 1 < DEPTH) GRID_BAR();
    }
}

extern "C" void kernel_launch(void* const* d_in, const int* in_sizes, int n_in, void* d_out, int out_size, void* d_ws, size_t ws_size, hipStream_t stream) {
    static int grid_blocks = 0;
    if (!grid_blocks) {
        int dev = 0, cus = 0, per_cu = 0;
        (void)hipGetDevice(&dev);
        (void)hipDeviceGetAttribute(&cus, hipDeviceAttributeMultiprocessorCount, dev);
        (void)hipFuncSetAttribute((const void*)fwd_kernel, hipFuncAttributeMaxDynamicSharedMemorySize, LDS_BYTES);
        (void)hipOccupancyMaxActiveBlocksPerMultiprocessor(&per_cu, fwd_kernel, NT, LDS_BYTES);
        if (per_cu < 1) { fprintf(stderr, "kernel_launch: occupancy query says %d blocks/CU\n", per_cu); per_cu = 1; }
        grid_blocks = cus;
        if (ws_size < WS_END) { fprintf(stderr, "kernel_launch: workspace too small (%zu < %zu)\n", ws_size, (size_t)WS_END); grid_blocks = -1; }
    }
    if (grid_blocks < 0) return;
    (void)hipMemsetAsync((char*)d_ws + WS_CTL, 0, CTL_BYTES, stream);
    Args a{};
    for (int i = 0; i < 20; ++i) a.in[i] = (const float*)d_in[i];
    a.out = (float*)d_out; a.ws = (unsigned char*)d_ws;
    void* args[] = {&a};
    hipError_t e = hipLaunchCooperativeKernel((void*)fwd_kernel, dim3(grid_blocks), dim3(NT), args, LDS_BYTES, stream);
    if (e != hipSuccess) fprintf(stderr, "cooperative launch failed: %s (grid %d)\n", hipGetErrorString(e), grid_blocks);
}
```

```cpp
#include <hip/hip_runtime.h>
#include <hip/hip_cooperative_groups.h>
#include <cstdio>
#include <cstdint>
namespace cg = cooperative_groups;
__device__ __forceinline__ int fresh_lane() { unsigned m = 0xffffffffu; asm volatile("" : "+s"(m)); return (int)__builtin_amdgcn_mbcnt_hi(m, __builtin_amdgcn_mbcnt_lo(m, 0u)); }
__device__ __forceinline__ float shx(float v, int o) { return __int_as_float(__builtin_amdgcn_ds_bpermute((fresh_lane() ^ o) << 2, __float_as_int(v))); }
namespace pg8 {
#define PG8_LAS __attribute__((address_space(3)))
typedef unsigned short bf16_t;
typedef short bf16x8 __attribute__((ext_vector_type(8)));
typedef float f32x4 __attribute__((ext_vector_type(4)));
typedef unsigned u32x4 __attribute__((ext_vector_type(4)));
constexpr int BM = 256, BK = 64, HALF = 128, HTB = HALF * BK * 2  , STAGE_BYTES = 8 * HTB, NXCD = 8, WGM = 8;

__host__ __device__ __forceinline__ int lds_byte(int r, int c) { const int st = (r >> 4) * 2 + (c >> 5), rr = r & 15, cc = c & 31, ob = rr * 64 + cc * 2; return st * 1024 + (ob ^ (((ob >> 9) & 1) << 5)); }
__host__ __device__ __forceinline__ void stage_rc(int b, int& R, int& C) { const int st = b / 1024, sb = b % 1024, swz = sb ^ (((sb >> 9) & 1) << 5); R = (st >> 1) * 16 + swz / 64; C = (st & 1) * 32 + (swz % 64) / 2; }
__host__ __device__ __forceinline__ int perm32(int rho) { const int n = rho >> 4, i = rho & 15; return 8 * (i >> 2) + 4 * n + (i & 3); }

struct Unit { int pm, pn; };
struct Gemm { const bf16_t* A; const bf16_t* Bt; int M, N, K; };

struct StaticOrder {
    int nM, nN, nwg, G, c;
    __host__ __device__ void init(int M, int N, int G_, int c_) { nM = M / BM; nN = N / BM; nwg = nM * nN; G = G_; c = c_; }
    __host__ __device__ bool next(int i, Unit& u) const {
        const long L = (long)i * G + c; if (L >= nwg) return false;
        int wgid = (int)L; { const int q = nwg / NXCD, r = nwg % NXCD, xcd = wgid % NXCD, off = wgid / NXCD; wgid = (xcd < r ? xcd * (q + 1) : r * (q + 1) + (xcd - r) * q) + off; }
        const int nig = WGM * nN, gid = wgid / nig, fm = gid * WGM, gsz = (nM - fm) < WGM ? (nM - fm) : WGM;
        u.pm = fm + ((wgid % nig) % gsz); u.pn = (wgid % nig) / gsz; return true;
    }
    __device__ __forceinline__ void a_ready(const Unit&) const {}
    __device__ __forceinline__ void done(const Unit&) const {}
};


__device__ __forceinline__ unsigned cvt_pk_bf16(float lo, float hi) { unsigned r; asm volatile("v_cvt_pk_bf16_f32 %0, %1, %2" : "=v"(r) : "v"(lo), "v"(hi)); return r; }
struct EpiBf16Plain {
    static constexpr bool PERM = true, AFTER_DRAIN = false;
    bf16_t* O; int ldc;
    __device__ __forceinline__ void operator()(const f32x4 (&acc)[2][2][4][2], const Unit& u, int wr, int wc, int fr, int fq) const {
        const int row0 = u.pm * BM + wr * 64 + fr, col0 = u.pn * BM + wc * 32 + 8 * fq;
#pragma unroll
        for (int ai = 0; ai < 2; ++ai)
#pragma unroll
            for (int m = 0; m < 4; ++m) { bf16_t* rowp = O + (size_t)(row0 + ai * HALF + m * 16) * ldc + col0;
#pragma unroll
                for (int bj = 0; bj < 2; ++bj) { const f32x4 v0 = acc[ai][bj][m][0], v1 = acc[ai][bj][m][1];
                    u32x4 w; w.x = cvt_pk_bf16(v0[0], v0[1]); w.y = cvt_pk_bf16(v0[2], v0[3]); w.z = cvt_pk_bf16(v1[0], v1[1]); w.w = cvt_pk_bf16(v1[2], v1[3]);
                    *(u32x4*)(rowp + bj * HALF) = w; } }
    }
};
struct EpiF32Res {
    static constexpr bool PERM = false, AFTER_DRAIN = false;
    float* C; const float* R; int ldc;
    __device__ __forceinline__ void operator()(const f32x4 (&acc)[2][2][4][2], const Unit& u, int wr, int wc, int fr, int fq) const {
        const int row0 = u.pm * BM + wr * 64 + fr, col0 = u.pn * BM + wc * 32 + 4 * fq;
#pragma unroll
        for (int ai = 0; ai < 2; ++ai)
#pragma unroll
            for (int m = 0; m < 4; ++m) { const size_t off = (size_t)(row0 + ai * HALF + m * 16) * ldc + col0;
#pragma unroll
                for (int bj = 0; bj < 2; ++bj)
#pragma unroll
                    for (int n = 0; n < 2; ++n) { const f32x4 r = *(const f32x4*)(R + off + bj * HALF + n * 16); *(f32x4*)(C + off + bj * HALF + n * 16) = r + acc[ai][bj][m][n]; } }
    }
};
template <class Epi, class Sched, bool ALIGN_EPI = false, bool SP2 = false>
__device__ __forceinline__ void gemm_phase(PG8_LAS unsigned char* lds, const Gemm g, const Sched& S, const Epi& E, int wave_id) {
    asm volatile("" : "+s"(wave_id));
    const int lane = fresh_lane(), wid = wave_id, tid = wid * 64 + lane, wr = wid >> 2, wc = wid & 3, fr = lane & 15, fq = lane >> 4;
    const int K = g.K, nt = K / BK;
    unsigned voffA[2], voffB[2];
#pragma unroll
    for (int i = 0; i < 2; ++i) { int R, C; stage_rc(tid * 16 + i * 8192, R, C); const int Rb = Epi::PERM ? ((R & ~31) + perm32(R & 31)) : R;
        voffA[i] = (unsigned)(R * K + C) * 2u; voffB[i] = (unsigned)(Rb * K + C) * 2u; }
    const size_t kstep = (size_t)(BK * 2);
    const size_t hstep = (size_t)HALF * K * 2;
    const size_t tstep = 2 * hstep;
    const unsigned ldsw = (unsigned)wid * 1024u;
    const int aoff = lds_byte(wr * 64 + fr, fq * 8), boff = lds_byte(wc * 32 + fr, fq * 8);
#define PG8_SA(b, h) (((b) * 2 + (h)) * HTB)
#define PG8_SB(b, h) ((4 + (b) * 2 + (h)) * HTB)
#define PG8_STAGE(bufoff, gbase, voff) do { _Pragma("unroll") for (int _i = 0; _i < 2; ++_i) \
        __builtin_amdgcn_global_load_lds((const unsigned*)((const char*)(gbase) + (voff)[_i]), (PG8_LAS unsigned*)(lds + (bufoff) + ldsw + _i * 8192), 16, 0, 0); } while (0)
#define PG8_LDA(dst, b, h) do { _Pragma("unroll") for (int m = 0; m < 4; ++m) _Pragma("unroll") for (int k = 0; k < 2; ++k) dst[m][k] = *(const PG8_LAS bf16x8*)(lds + PG8_SA(b, h) + aoff + m * 2048 + k * 1024); } while (0)
#define PG8_LDB(dst, b, h) do { _Pragma("unroll") for (int n = 0; n < 2; ++n) _Pragma("unroll") for (int k = 0; k < 2; ++k) dst[n][k] = *(const PG8_LAS bf16x8*)(lds + PG8_SB(b, h) + boff + n * 2048 + k * 1024); } while (0)
#define PG8_MMA(ai, bj, At, Bt) do { __builtin_amdgcn_s_setprio(1); _Pragma("unroll") for (int m = 0; m < 4; ++m) _Pragma("unroll") for (int n = 0; n < 2; ++n) _Pragma("unroll") for (int k = 0; k < 2; ++k) \
        acc[ai][bj][m][n] = __builtin_amdgcn_mfma_f32_16x16x32_bf16(Bt[n][k], At[m][k], acc[ai][bj][m][n], 0, 0, 0); __builtin_amdgcn_s_setprio(0); } while (0)
#define PG8_WAIT_V(n) asm volatile("s_waitcnt vmcnt(" #n ")" ::: "memory")
#define PG8_WAIT_L(n) asm volatile("s_waitcnt lgkmcnt(" #n ")" ::: "memory")
#define PG8_BAR __builtin_amdgcn_s_barrier()
#define PG8_SCHED __builtin_amdgcn_sched_barrier(0)
    Unit cur, nxt; int ui = 0;
    if (!S.next(0, cur)) return;
    f32x4 acc[2][2][4][2];
#pragma unroll
    for (int a = 0; a < 2; ++a)
#pragma unroll
        for (int b = 0; b < 2; ++b)
#pragma unroll
            for (int m = 0; m < 4; ++m)
#pragma unroll
                for (int n = 0; n < 2; ++n) acc[a][b][m][n] = (f32x4){0.f, 0.f, 0.f, 0.f};
    bf16x8 At[4][2], B0[2][2], B1[2][2];
    const char* cA = (const char*)g.A + (size_t)cur.pm * tstep; const char* cB = (const char*)g.Bt + (size_t)cur.pn * tstep;
    S.a_ready(cur);
    if constexpr (SP2) {
        PG8_STAGE(PG8_SB(0, 0), cB, voffB); PG8_STAGE(PG8_SB(0, 1), cB + hstep, voffB); PG8_STAGE(PG8_SA(0, 0), cA, voffA); PG8_STAGE(PG8_SA(0, 1), cA + hstep, voffA);
        if (wr == 1) PG8_BAR;
        PG8_WAIT_V(2); PG8_BAR;
        PG8_STAGE(PG8_SB(1, 0), cB + kstep, voffB); PG8_STAGE(PG8_SA(1, 0), cA + kstep, voffA); PG8_STAGE(PG8_SB(1, 1), cB + hstep + kstep, voffB);
        PG8_WAIT_V(6); PG8_BAR;
    } else {
        PG8_STAGE(PG8_SB(0, 0), cB, voffB); PG8_STAGE(PG8_SA(0, 0), cA, voffA); PG8_STAGE(PG8_SB(0, 1), cB + hstep, voffB); PG8_STAGE(PG8_SA(0, 1), cA + hstep, voffA);
        if (wr == 1) PG8_BAR;
        PG8_WAIT_V(4); PG8_BAR;
        PG8_STAGE(PG8_SB(1, 0), cB + kstep, voffB); PG8_STAGE(PG8_SA(1, 0), cA + kstep, voffA); PG8_STAGE(PG8_SB(1, 1), cB + hstep + kstep, voffB);
        PG8_WAIT_V(6); PG8_BAR;
    }
    for (;;) {
        const bool has_next = S.next(ui + 1, nxt);
        const char* nA = has_next ? (const char*)g.A + (size_t)nxt.pm * tstep : cA; const char* nB = has_next ? (const char*)g.Bt + (size_t)nxt.pn * tstep : cB;
        for (int t = 0; t < nt; t += 2) {
            const bool last = (t == nt - 2);
            const char* a1 = cA + (size_t)(t + 1) * kstep;
            const char* a2 = last ? nA : cA + (size_t)(t + 2) * kstep; const char* b2 = last ? nB : cB + (size_t)(t + 2) * kstep;
            const char* a3 = a2 + kstep; const char* b3 = b2 + kstep;
            if (last && has_next) S.a_ready(nxt);
            if constexpr (SP2) {
            PG8_LDB(B0, 0, 0); PG8_LDB(B1, 0, 1); PG8_SCHED; PG8_LDA(At, 0, 0); PG8_STAGE(PG8_SA(1, 1), a1 + hstep, voffA);
            PG8_WAIT_V(8); PG8_WAIT_L(0); PG8_BAR; PG8_MMA(0, 0, At, B0); PG8_MMA(0, 1, At, B1); PG8_BAR; PG8_SCHED;
            PG8_LDA(At, 0, 1); PG8_STAGE(PG8_SB(0, 0), b2, voffB); PG8_STAGE(PG8_SB(0, 1), b2 + hstep, voffB); PG8_STAGE(PG8_SA(0, 0), a2, voffA);
            PG8_WAIT_V(8); PG8_WAIT_L(0); PG8_BAR; PG8_MMA(1, 0, At, B0); PG8_MMA(1, 1, At, B1); PG8_BAR; PG8_SCHED;
            PG8_LDB(B0, 1, 0); PG8_LDB(B1, 1, 1); PG8_SCHED; PG8_LDA(At, 1, 0); PG8_STAGE(PG8_SA(0, 1), a2 + hstep, voffA);
            PG8_WAIT_V(8); PG8_WAIT_L(0); PG8_BAR; PG8_MMA(0, 0, At, B0); PG8_MMA(0, 1, At, B1); PG8_BAR; PG8_SCHED;
            PG8_LDA(At, 1, 1); PG8_STAGE(PG8_SB(1, 0), b3, voffB); PG8_STAGE(PG8_SB(1, 1), b3 + hstep, voffB); PG8_STAGE(PG8_SA(1, 0), a3, voffA);
            PG8_WAIT_V(8); PG8_WAIT_L(0); PG8_BAR; PG8_MMA(1, 0, At, B0); PG8_MMA(1, 1, At, B1); PG8_BAR; PG8_SCHED;
            } else {
            PG8_LDB(B0, 0, 0); PG8_SCHED; PG8_LDA(At, 0, 0); PG8_STAGE(PG8_SA(1, 1), a1 + hstep, voffA);
            PG8_WAIT_L(8); PG8_BAR; PG8_WAIT_L(0); PG8_MMA(0, 0, At, B0); PG8_BAR; PG8_SCHED;
            PG8_LDB(B1, 0, 1); PG8_STAGE(PG8_SB(0, 0), b2, voffB);
            PG8_BAR; PG8_WAIT_L(0); PG8_MMA(0, 1, At, B1); PG8_BAR;
            PG8_LDA(At, 0, 1); PG8_STAGE(PG8_SA(0, 0), a2, voffA);
            PG8_BAR; PG8_WAIT_L(0); PG8_MMA(1, 0, At, B0); PG8_BAR; PG8_SCHED;
            PG8_STAGE(PG8_SB(0, 1), b2 + hstep, voffB);
            PG8_WAIT_V(6); PG8_BAR; PG8_MMA(1, 1, At, B1); PG8_BAR;
            PG8_LDB(B0, 1, 0); PG8_SCHED; PG8_LDA(At, 1, 0); PG8_STAGE(PG8_SA(0, 1), a2 + hstep, voffA);
            PG8_WAIT_L(8); PG8_BAR; PG8_WAIT_L(0); PG8_MMA(0, 0, At, B0); PG8_BAR; PG8_SCHED;
            PG8_LDB(B1, 1, 1); PG8_STAGE(PG8_SB(1, 0), b3, voffB);
            PG8_BAR; PG8_WAIT_L(0); PG8_MMA(0, 1, At, B1); PG8_BAR;
            PG8_LDA(At, 1, 1); PG8_STAGE(PG8_SA(1, 0), a3, voffA);
            PG8_BAR; PG8_WAIT_L(0); PG8_MMA(1, 0, At, B0); PG8_BAR; PG8_SCHED;
            PG8_STAGE(PG8_SB(1, 1), b3 + hstep, voffB);
            PG8_WAIT_V(6); PG8_BAR; PG8_MMA(1, 1, At, B1); PG8_BAR;
            }
        }
        if constexpr (ALIGN_EPI) { if (wr == 0) PG8_BAR; }
        if constexpr (!Epi::AFTER_DRAIN) { E(acc, cur, wr, wc, fr, fq); S.done(cur); }
        if (!has_next) break;
#pragma unroll
        for (int a = 0; a < 2; ++a)
#pragma unroll
            for (int b = 0; b < 2; ++b)
#pragma unroll
                for (int m = 0; m < 4; ++m)
#pragma unroll
                    for (int n = 0; n < 2; ++n) acc[a][b][m][n] = (f32x4){0.f, 0.f, 0.f, 0.f};
        cur = nxt; cA = nA; cB = nB; ++ui;
        if constexpr (ALIGN_EPI) { if (wr == 1) PG8_BAR; }
    }
    PG8_WAIT_V(0);
    if constexpr (!ALIGN_EPI) { if (wr == 0) PG8_BAR; }
    PG8_BAR;
    if constexpr (Epi::AFTER_DRAIN) { E.fused(acc, cur, wr, wc, fr, fq, lds, wid, lane); S.done(cur); }
#undef PG8_SA
#undef PG8_SB
#undef PG8_STAGE
#undef PG8_LDA
#undef PG8_LDB
#undef PG8_MMA
#undef PG8_WAIT_V
#undef PG8_WAIT_L
#undef PG8_BAR
#undef PG8_SCHED
}

struct MUnit { int r0, rend, e, pn; };
#define MG_LANE_OFFS(u, o) do { const int _t = wid * 64 + fresh_lane(); _Pragma("unroll") for (int _i = 0; _i < 2; ++_i) { int _R, _C; stage_rc(_t * 16 + _i * 8192, _R, _C); _Pragma("unroll") for (int _h = 0; _h < 2; ++_h) { const int _r = (u).r0 + _h * HALF + _R; \
        int _row = _r; if (GATHER) { _row = 0; if (_r < (u).rend) _row = slot_tok[_r]; } (o)[_h][_i] = (unsigned)(_row * K + _C) * 2u; } } } while (0)
template <class Epi, class Sched, bool GATHER, int N, int K>
__device__ __forceinline__ void gemm_phase_moe(PG8_LAS unsigned char* lds, const bf16_t* A, const bf16_t* Bt, const int* slot_tok, const Sched& S, const Epi& E, int wave_id) {
    asm volatile("" : "+s"(wave_id));
    const int lane = fresh_lane(), wid = wave_id, tid = wid * 64 + lane, wr = wid >> 2, wc = wid & 3, fr = lane & 15, fq = lane >> 4;
    constexpr int nt = K / BK;
#define MG_OFFP(par) ((PG8_LAS unsigned*)(lds + STAGE_BYTES + 8192) + (par) * 2048 + tid)
#define MG_VOFFB ((PG8_LAS unsigned*)(lds + STAGE_BYTES + 24576) + tid)
#pragma unroll
    for (int i = 0; i < 2; ++i) { int R, C; stage_rc(tid * 16 + i * 8192, R, C); const int Rb = Epi::PERM ? ((R & ~31) + perm32(R & 31)) : R; MG_VOFFB[i * 512] = (unsigned)(Rb * K + C) * 2u; }
    constexpr size_t kstep = (size_t)(BK * 2);
    constexpr size_t hstep = (size_t)HALF * K * 2;
    constexpr size_t tstep = 2 * hstep;
    constexpr size_t estep = (size_t)N * K * 2;
    const unsigned ldsw = (unsigned)wid * 1024u;
    const int aoff = lds_byte(wr * 64 + fr, fq * 8), boff = lds_byte(wc * 32 + fr, fq * 8);
#define PG8_SA(b, h) (((b) * 2 + (h)) * HTB)
#define PG8_SB(b, h) ((4 + (b) * 2 + (h)) * HTB)
#define PG8_STAGE(bufoff, gbase, voff) do { _Pragma("unroll") for (int _i = 0; _i < 2; ++_i) \
        __builtin_amdgcn_global_load_lds((const unsigned*)((const char*)(gbase) + MG_VOFFB[_i * 512]), (PG8_LAS unsigned*)(lds + (bufoff) + ldsw + _i * 8192), 16, 0, 0); } while (0)
#define MG_STAGE_A(bufoff, par, h, kb) do { _Pragma("unroll") for (int _i = 0; _i < 2; ++_i) \
        __builtin_amdgcn_global_load_lds((const unsigned*)((const char*)A + (size_t)MG_OFFP(par)[((h) * 2 + _i) * 512] + (kb)), (PG8_LAS unsigned*)(lds + (bufoff) + ldsw + _i * 8192), 16, 0, 0); } while (0)
#define PG8_LDA(dst, b, h) do { _Pragma("unroll") for (int m = 0; m < 4; ++m) _Pragma("unroll") for (int k = 0; k < 2; ++k) dst[m][k] = *(const PG8_LAS bf16x8*)(lds + PG8_SA(b, h) + aoff + m * 2048 + k * 1024); } while (0)
#define PG8_LDB(dst, b, h) do { _Pragma("unroll") for (int n = 0; n < 2; ++n) _Pragma("unroll") for (int k = 0; k < 2; ++k) dst[n][k] = *(const PG8_LAS bf16x8*)(lds + PG8_SB(b, h) + boff + n * 2048 + k * 1024); } while (0)
#define PG8_MMA(ai, bj, At, Bt_) do { __builtin_amdgcn_s_setprio(1); _Pragma("unroll") for (int m = 0; m < 4; ++m) _Pragma("unroll") for (int n = 0; n < 2; ++n) _Pragma("unroll") for (int k = 0; k < 2; ++k) \
        acc[ai][bj][m][n] = __builtin_amdgcn_mfma_f32_16x16x32_bf16(Bt_[n][k], At[m][k], acc[ai][bj][m][n], 0, 0, 0); __builtin_amdgcn_s_setprio(0); } while (0)
#define PG8_WAIT_V(n) asm volatile("s_waitcnt vmcnt(" #n ")" ::: "memory")
#define PG8_WAIT_L(n) asm volatile("s_waitcnt lgkmcnt(" #n ")" ::: "memory")
#define PG8_BAR __builtin_amdgcn_s_barrier()
#define PG8_SCHED __builtin_amdgcn_sched_barrier(0)
    MUnit cur, nxt; int ui = 0;
    if (!S.next(0, cur)) return;
    f32x4 acc[2][2][4][2];
#pragma unroll
    for (int a = 0; a < 2; ++a)
#pragma unroll
        for (int b = 0; b < 2; ++b)
#pragma unroll
            for (int m = 0; m < 4; ++m)
#pragma unroll
                for (int n = 0; n < 2; ++n) acc[a][b][m][n] = (f32x4){0.f, 0.f, 0.f, 0.f};
    bf16x8 At[4][2], B0[2][2], B1[2][2];
    { unsigned o_[2][2]; MG_LANE_OFFS(cur, o_); PG8_LAS unsigned* p_ = MG_OFFP(0); p_[0] = o_[0][0]; p_[512] = o_[0][1]; p_[1024] = o_[1][0]; p_[1536] = o_[1][1]; }
    const char* cB = (const char*)Bt + (size_t)cur.e * estep + (size_t)cur.pn * tstep;
    PG8_STAGE(PG8_SB(0, 0), cB, voffB); PG8_STAGE(PG8_SB(0, 1), cB + hstep, voffB); MG_STAGE_A(PG8_SA(0, 0), 0, 0, 0); MG_STAGE_A(PG8_SA(0, 1), 0, 1, 0);
    if (wr == 1) PG8_BAR;
    PG8_WAIT_V(2); PG8_BAR;
    PG8_STAGE(PG8_SB(1, 0), cB + kstep, voffB); MG_STAGE_A(PG8_SA(1, 0), 0, 0, kstep); PG8_STAGE(PG8_SB(1, 1), cB + hstep + kstep, voffB);
    PG8_WAIT_V(6); PG8_BAR;
    for (;;) {
        const bool has_next = S.next(ui + 1, nxt);
        const bool hi_rows = (cur.rend - cur.r0) > HALF;
        const char* nB = cB;
        const int pc = ui & 1, pn_ = has_next ? (pc ^ 1) : pc;
        if (has_next) { unsigned on[2][2]; MG_LANE_OFFS(nxt, on); nB = (const char*)Bt + (size_t)nxt.e * estep + (size_t)nxt.pn * tstep;
            PG8_LAS unsigned* p_ = MG_OFFP(pn_); p_[0] = on[0][0]; p_[512] = on[0][1]; p_[1024] = on[1][0]; p_[1536] = on[1][1]; }
        for (int t = 0; t < nt; t += 2) {
            const bool last = (t == nt - 2);
            const size_t k1 = (size_t)(t + 1) * kstep, k2 = last ? (size_t)0 : (size_t)(t + 2) * kstep, k3 = k2 + kstep;
            const char* b2 = last ? nB : cB + (size_t)(t + 2) * kstep; const char* b3 = b2 + kstep;
            const int p2 = last ? pn_ : pc;
            PG8_LDB(B0, 0, 0); PG8_LDB(B1, 0, 1); PG8_SCHED; PG8_LDA(At, 0, 0); MG_STAGE_A(PG8_SA(1, 1), pc, 1, k1);
            PG8_WAIT_V(8); PG8_WAIT_L(0); PG8_BAR; PG8_MMA(0, 0, At, B0); PG8_MMA(0, 1, At, B1); PG8_BAR; PG8_SCHED;
            PG8_LDA(At, 0, 1); PG8_STAGE(PG8_SB(0, 0), b2, voffB); PG8_STAGE(PG8_SB(0, 1), b2 + hstep, voffB); MG_STAGE_A(PG8_SA(0, 0), p2, 0, k2);
            PG8_WAIT_V(8); PG8_WAIT_L(0); PG8_BAR; if (hi_rows) { PG8_MMA(1, 0, At, B0); PG8_MMA(1, 1, At, B1); } PG8_BAR; PG8_SCHED;
            PG8_LDB(B0, 1, 0); PG8_LDB(B1, 1, 1); PG8_SCHED; PG8_LDA(At, 1, 0); MG_STAGE_A(PG8_SA(0, 1), p2, 1, k2);
            PG8_WAIT_V(8); PG8_WAIT_L(0); PG8_BAR; PG8_MMA(0, 0, At, B0); PG8_MMA(0, 1, At, B1); PG8_BAR; PG8_SCHED;
            PG8_LDA(At, 1, 1); PG8_STAGE(PG8_SB(1, 0), b3, voffB); PG8_STAGE(PG8_SB(1, 1), b3 + hstep, voffB); MG_STAGE_A(PG8_SA(1, 0), p2, 0, k3);
            PG8_WAIT_V(8); PG8_WAIT_L(0); PG8_BAR; if (hi_rows) { PG8_MMA(1, 0, At, B0); PG8_MMA(1, 1, At, B1); } PG8_BAR; PG8_SCHED;
        }
        if (wr == 0) PG8_BAR;
        E(acc, cur, wr, wc, fr, fq);
        if (!has_next) break;
#pragma unroll
        for (int a = 0; a < 2; ++a)
#pragma unroll
            for (int b = 0; b < 2; ++b)
#pragma unroll
                for (int m = 0; m < 4; ++m)
#pragma unroll
                    for (int n = 0; n < 2; ++n) acc[a][b][m][n] = (f32x4){0.f, 0.f, 0.f, 0.f};
        cur = nxt; cB = nB; ++ui;
        if (wr == 1) PG8_BAR;
    }
    PG8_WAIT_V(0);
    PG8_BAR;
#undef PG8_SA
#undef PG8_SB
#undef PG8_STAGE
#undef MG_STAGE_A
#undef MG_OFFP
#undef MG_VOFFB
#undef PG8_LDA
#undef PG8_LDB
#undef PG8_MMA
#undef PG8_WAIT_V
#undef PG8_WAIT_L
#undef PG8_BAR
#undef PG8_SCHED
}
__device__ __forceinline__ float fast_silu(float x) { return x * __builtin_amdgcn_rcpf(1.0f + __builtin_amdgcn_exp2f(-1.4426950408889634f * x)); }
struct EpiMoeH {
    static constexpr bool PERM = true;
    bf16_t* H;
    __device__ __forceinline__ void operator()(const f32x4 (&acc)[2][2][4][2], const MUnit& u, int wr, int wc, int fr, int fq) const {
        { const int t_ = fresh_lane(); fr = t_ & 15; fq = t_ >> 4; }
        const int col0 = u.pn * 128 + wc * 32 + 8 * fq;
#pragma unroll
        for (int ai = 0; ai < 2; ++ai)
#pragma unroll
            for (int m = 0; m < 4; ++m) { const int r = u.r0 + ai * HALF + wr * 64 + m * 16 + fr;
                const f32x4 g0 = acc[ai][0][m][0], g1 = acc[ai][0][m][1], u0 = acc[ai][1][m][0], u1 = acc[ai][1][m][1];
                u32x4 w; w.x = cvt_pk_bf16(fast_silu(g0[0]) * u0[0], fast_silu(g0[1]) * u0[1]); w.y = cvt_pk_bf16(fast_silu(g0[2]) * u0[2], fast_silu(g0[3]) * u0[3]);
                w.z = cvt_pk_bf16(fast_silu(g1[0]) * u1[0], fast_silu(g1[1]) * u1[1]); w.w = cvt_pk_bf16(fast_silu(g1[2]) * u1[2], fast_silu(g1[3]) * u1[3]);
                if (r < u.rend) *(u32x4*)(H + (size_t)r * 256 + col0) = w; }
    }
};
struct EpiMoeY {
    static constexpr bool PERM = true;
    bf16_t* Y;
    __device__ __forceinline__ void operator()(const f32x4 (&acc)[2][2][4][2], const MUnit& u, int wr, int wc, int fr, int fq) const {
        { const int t_ = fresh_lane(); fr = t_ & 15; fq = t_ >> 4; }
        const int col0 = u.pn * BM + wc * 32 + 8 * fq;
#pragma unroll
        for (int ai = 0; ai < 2; ++ai)
#pragma unroll
            for (int m = 0; m < 4; ++m) { const int r = u.r0 + ai * HALF + wr * 64 + m * 16 + fr;
#pragma unroll
                for (int bj = 0; bj < 2; ++bj) { const f32x4 v0 = acc[ai][bj][m][0], v1 = acc[ai][bj][m][1];
                    u32x4 w; w.x = cvt_pk_bf16(v0[0], v0[1]); w.y = cvt_pk_bf16(v0[2], v0[3]); w.z = cvt_pk_bf16(v1[0], v1[1]); w.w = cvt_pk_bf16(v1[2], v1[3]);
                    if (r < u.rend) *(u32x4*)(Y + (size_t)r * 1024 + col0 + bj * HALF) = w; } }
    }
};
struct MoeSched {
    const PG8_LAS int* tab;
    int npn, first, end, stride, c;
    __device__ __forceinline__ bool next(int i, MUnit& u) const {
        const int L = first + c + i * stride;
        if (c < 0 || L >= end) return false;
        const int j = L / npn; u.pn = L % npn;
        u.e = __builtin_amdgcn_readfirstlane(tab[4 + 4 * j]); u.r0 = __builtin_amdgcn_readfirstlane(tab[5 + 4 * j]); u.rend = __builtin_amdgcn_readfirstlane(tab[6 + 4 * j]);
        return true;
    }
};
}

#ifndef PG8_SP2
#define PG8_SP2 true
#endif
#ifndef PG8_ALIGN
#define PG8_ALIGN true
#endif

constexpr int NWAVES = 8, NT = NWAVES * 64;
constexpr int D = 1024, NB = 2, S = 8192, T = NB * S, DEPTH = 2;
constexpr int DIN = 2832, PLD = 3072;
constexpr int C_Q = 0, C_K = 256, C_V = 512, C_G = 1024, C_GK = 1536, C_U = 1552, C_VG = 1808, C_XI = 2064, C_BG = 2320, C_CG = 2576;
constexpr int GH = 4, GC = 64, GN = S / GC;
constexpr int MH = 4, MC = 128, MN = S / MC;
constexpr int NE = 32, DE = 256;
constexpr float EPS = 1e-6f;
constexpr size_t MiB = 1u << 20;
constexpr size_t WS_CTL = 0, CTL_BYTES = 1 * MiB;
constexpr size_t WS_WIN = 1 * MiB;
constexpr size_t WS_WOUT = 13 * MiB;
constexpr size_t WS_WGU = 17 * MiB;
constexpr size_t WS_WD = 81 * MiB;
constexpr size_t WS_XN = 113 * MiB;
constexpr size_t WS_P = 145 * MiB;
constexpr size_t WS_Y = WS_P + 17 * MiB;
constexpr size_t WS_S = 241 * MiB;
constexpr size_t WS_DEC = 273 * MiB;
constexpr size_t WS_MISC = 274 * MiB;
constexpr size_t WS_WSP = WS_MISC + 524288;
constexpr size_t WS_WR = 275 * MiB;
constexpr size_t WS_BLKCNT = WS_WR + 524288;
constexpr size_t WS_END = 276 * MiB;
constexpr int CW_BAR = 4096, CW_CNT = 16384;
constexpr int RING_BYTES = 131072, LDSCTL_OFF = RING_BYTES, MISC_OFF = LDSCTL_OFF + 320, LDS_BYTES = 163840;

#define GAS __attribute__((address_space(1)))
#define LAS __attribute__((address_space(3)))
typedef unsigned short bf16;
typedef unsigned v4u __attribute__((ext_vector_type(4)));
typedef unsigned v2u __attribute__((ext_vector_type(2)));
typedef float f32x4 __attribute__((ext_vector_type(4)));
typedef __bf16 bf16x2_t __attribute__((ext_vector_type(2)));
typedef float f32x2_t __attribute__((ext_vector_type(2)));
__device__ __forceinline__ unsigned f2bf(float f) { return (unsigned)__builtin_bit_cast(unsigned short, (__bf16)f); }
__device__ __forceinline__ unsigned pk2(float lo, float hi) { f32x2_t v = {lo, hi}; bf16x2_t b = __builtin_convertvector(v, bf16x2_t); return __builtin_bit_cast(unsigned, b); }
__device__ __forceinline__ float bf2f(unsigned v) { return __uint_as_float(v << 16); }
__device__ __forceinline__ float bflo(unsigned w) { return __uint_as_float(w << 16); }
__device__ __forceinline__ float bfhi(unsigned w) { return __uint_as_float(w & 0xffff0000u); }
__device__ __forceinline__ void unpack8(const v4u q, float (&f)[8]) { f[0] = bflo(q.x); f[1] = bfhi(q.x); f[2] = bflo(q.y); f[3] = bfhi(q.y); f[4] = bflo(q.z); f[5] = bfhi(q.z); f[6] = bflo(q.w); f[7] = bfhi(q.w); }
__device__ __forceinline__ float gelu_tanh(float x) { const float u = 0.7978845608028654f * (x + 0.044715f * x * x * x); return 0.5f * x * (1.0f + tanhf(u)); }
__device__ __forceinline__ float silu(float x) { return x / (1.0f + expf(-x)); }
__device__ __forceinline__ float log_sigmoid(float x) { return fminf(x, 0.f) - log1pf(expf(-fabsf(x))); }

#define XB_TMO      128
#define XB_XCNT(j)  (256  + 64 * (j))
#define XB_XSUB(j)  (1280 + 64 * (j))
#define XB_XGEN(j)  (2304 + 64 * (j))
#define XB_TOP      3328
#define XB_TOPGEN   3392
#define XCD_BAR_WORDS 3456
#define XB_SPIN_CAP (1u << 18)

__device__ __forceinline__ unsigned xb_ld(unsigned* p)              { return __hip_atomic_load(p, __ATOMIC_RELAXED, __HIP_MEMORY_SCOPE_AGENT); }
__device__ __forceinline__ unsigned xb_add(unsigned* p, unsigned v) { return __hip_atomic_fetch_add(p, v, __ATOMIC_RELAXED, __HIP_MEMORY_SCOPE_AGENT); }
__device__ __forceinline__ unsigned xb_xcc_id() { return (unsigned)__builtin_amdgcn_s_getreg((3 << 11) | 20) & 0xFu; }
#define XB_SPIN(cond, bar) do { unsigned _sp = 0; while (cond) { __builtin_amdgcn_s_sleep(1); \
    if ((++_sp & 255u) == 0u) { if (xb_ld(&(bar)[XB_TMO])) break; if (_sp > XB_SPIN_CAP) { atomicAdd(&(bar)[XB_TMO], 1u); break; } } } } while (0)

struct XcdBarrier {
    int wave;
    unsigned* bar; unsigned x;
    volatile LAS unsigned* st;
};

__device__ __forceinline__ XcdBarrier xcd_barrier_post(unsigned* bar, volatile LAS unsigned* st) {
    XcdBarrier b; b.bar = bar; b.x = xb_xcc_id(); b.st = st; b.wave = __builtin_amdgcn_readfirstlane(threadIdx.x >> 6);
    if (threadIdx.x == 0) (void)xb_add(&bar[XB_XCNT(b.x)], 1u);
    return b;
}
__device__ __forceinline__ void xcd_barrier_complete(unsigned* bar, unsigned x, unsigned& nloc, unsigned& nx) {
    const unsigned G = gridDim.x * gridDim.y * gridDim.z;
    unsigned sum, cnt, mine, sp = 0u;
    for (;;) {
        sum = 0u; cnt = 0u; mine = 0u;
#pragma unroll
        for (unsigned j = 0; j < 16; ++j) { const unsigned c = xb_ld(&bar[XB_XCNT(j)]); sum += c; cnt += (c > 0u) ? 1u : 0u; mine = (j == x) ? c : mine; }
        if (sum == G) break;
        __builtin_amdgcn_s_sleep(1);
        if ((++sp & 255u) == 0u) { if (xb_ld(&bar[XB_TMO])) break; if (sp > XB_SPIN_CAP) { atomicAdd(&bar[XB_TMO], 1u); break; } }
    }
    nloc = mine > 0u ? mine : 1u; nx = cnt > 0u ? cnt : 1u;
}

__device__ __forceinline__ void xcd_barrier(const XcdBarrier& b) {
    asm volatile("s_waitcnt vmcnt(0)" ::: "memory");
    __syncthreads();
    if (b.wave == 0 && fresh_lane() == 0) {
        unsigned* bar = b.bar; asm volatile("" : "+s"(bar));
        __builtin_amdgcn_s_waitcnt(0);
        unsigned nloc = b.st[0], nx = b.st[1];
        if (nloc == 0u) { xcd_barrier_complete(bar, b.x, nloc, nx); b.st[0] = nloc; b.st[1] = nx; }
        const unsigned old = xb_add(&bar[XB_XSUB(b.x)], 1u);
        const unsigned gen = old / nloc;
        if (old + 1u == (gen + 1u) * nloc) {
            __builtin_amdgcn_fence(__ATOMIC_RELEASE, "agent");
            asm volatile("s_waitcnt vmcnt(0)" ::: "memory");
            const unsigned og = xb_add(&bar[XB_TOP], 1u);
            const unsigned tg = og / nx;
            if (og + 1u == (tg + 1u) * nx) xb_add(&bar[XB_TOPGEN], 1u);
            else XB_SPIN(xb_ld(&bar[XB_TOPGEN]) == tg, bar);
            __builtin_amdgcn_fence(__ATOMIC_ACQUIRE, "agent");
            xb_add(&bar[XB_XGEN(b.x)], 1u);
            asm volatile("s_waitcnt vmcnt(0)" ::: "memory");
        } else {
            XB_SPIN(xb_ld(&bar[XB_XGEN(b.x)]) == gen, bar);
            __builtin_amdgcn_fence(__ATOMIC_ACQUIRE, "agent");
            asm volatile("s_waitcnt vmcnt(0)" ::: "memory");
        }
    }
    __syncthreads();
}

#define AS4 __attribute__((address_space(4)))
struct KA {
    const AS4 char* ka;
    static __device__ __forceinline__ KA fresh() { KA k; k.ka = (const AS4 char*)__builtin_amdgcn_kernarg_segment_ptr(); asm volatile("" : "+s"(k.ka)); return k; }
    __device__ __forceinline__ const float* in(int i) const { return *(const float* const AS4*)(ka + 8 * i); }
    __device__ __forceinline__ float* out() const { return *(float* const AS4*)(ka + 160); }
    __device__ __forceinline__ unsigned char* ws() const { return *(unsigned char* const AS4*)(ka + 168); }
    __device__ __forceinline__ unsigned* ctl() const { return (unsigned*)(ws() + WS_CTL); }
    __device__ __forceinline__ bf16* WinT() const { return (bf16*)(ws() + WS_WIN); }
    __device__ __forceinline__ bf16* WoutT() const { return (bf16*)(ws() + WS_WOUT); }
    __device__ __forceinline__ bf16* WguT() const { return (bf16*)(ws() + WS_WGU); }
    __device__ __forceinline__ bf16* WdT() const { return (bf16*)(ws() + WS_WD); }
    __device__ __forceinline__ bf16* XN() const { return (bf16*)(ws() + WS_XN); }
    __device__ __forceinline__ bf16* P() const { return (bf16*)(ws() + WS_P); }
    __device__ __forceinline__ bf16* H1() const { return (bf16*)(ws() + WS_P); }
    __device__ __forceinline__ bf16* Y() const { return (bf16*)(ws() + WS_Y); }
    __device__ __forceinline__ float* Sst() const { return (float*)(ws() + WS_S); }
    __device__ __forceinline__ float* dec() const { return (float*)(ws() + WS_DEC); }
    __device__ __forceinline__ int* eid() const { return (int*)(ws() + WS_MISC); }
    __device__ __forceinline__ float* ew() const { return (float*)(ws() + WS_MISC + 131072); }
    __device__ __forceinline__ int* slot_tok() const { return (int*)(ws() + WS_MISC + 2 * 131072); }
    __device__ __forceinline__ int* slot_of() const { return (int*)(ws() + WS_MISC + 3 * 131072); }
    __device__ __forceinline__ bf16* Wsp() const { return (bf16*)(ws() + WS_WSP); }
    __device__ __forceinline__ bf16* Wr() const { return (bf16*)(ws() + WS_WR); }
    __device__ __forceinline__ int* blkcnt() const { return (int*)(ws() + WS_BLKCNT); }
};
struct Frame {
    LAS unsigned char* lds; float* smem;
    int G, bx, wave;
};
#define PHASE_TID const int lane = fresh_lane(), wave = F.wave, tid = wave * 64 + lane; (void)lane; (void)wave; (void)tid

__device__ __forceinline__ float wave_sum(float v) {
    const int ln = fresh_lane();
#pragma unroll
    for (int o = 1; o < 64; o <<= 1) v += __int_as_float(__builtin_amdgcn_ds_bpermute((ln ^ o) << 2, __float_as_int(v)));
    return v;
}

__device__ __forceinline__ void transpose_item(const float* W, int ldw, int nvalid, int k0, int n0, bf16* WT, int ldt, int drow0, LAS float* scr, int lane) {
    const int sub = lane >> 3, c4 = (lane & 7) * 4;
    f32x4 v[8];
#pragma unroll
    for (int i = 0; i < 8; ++i) v[i] = (c4 < nvalid) ? __builtin_nontemporal_load((const f32x4*)(W + (size_t)(k0 + 8 * i + sub) * ldw + n0 + c4)) : (f32x4){0.f, 0.f, 0.f, 0.f};
#pragma unroll
    for (int i = 0; i < 8; ++i) { LAS float* d = scr + (8 * i + sub) * 33 + c4; d[0] = v[i].x; d[1] = v[i].y; d[2] = v[i].z; d[3] = v[i].w; }
    asm volatile("s_waitcnt lgkmcnt(0)" ::: "memory");
    const int c = lane & 7;
#pragma unroll
    for (int j = 0; j < 4; ++j) { const int n = (lane >> 3) + 8 * j; const LAS float* s = scr + (8 * c) * 33 + n;
        v4u o; o.x = pk2(s[0 * 33], s[1 * 33]); o.y = pk2(s[2 * 33], s[3 * 33]); o.z = pk2(s[4 * 33], s[5 * 33]); o.w = pk2(s[6 * 33], s[7 * 33]);
        if (n < nvalid) *(GAS v4u*)(WT + (size_t)(drow0 + n) * ldt + k0 + 8 * c) = o; }
    asm volatile("s_waitcnt lgkmcnt(0)" ::: "memory");
}
__device__ __forceinline__ void rms_row_to_bf16(const float* xrow, const float* gain, bf16* orow, int lane) {
    const f32x4* xr = (const f32x4*)xrow + lane;
    f32x4 v[4]; float s = 0.f;
#pragma unroll
    for (int j = 0; j < 4; ++j) { v[j] = xr[64 * j]; s += (v[j].x * v[j].x + v[j].y * v[j].y) + (v[j].z * v[j].z + v[j].w * v[j].w); }
    const float rs = rsqrtf(wave_sum(s) * (1.f / D) + EPS);
    v2u* o8 = (v2u*)orow + lane;
#pragma unroll
    for (int j = 0; j < 4; ++j) { const f32x4 g = ((const f32x4*)gain)[lane + 64 * j]; v2u w; w.x = pk2(v[j].x * rs * g.x, v[j].y * rs * g.y); w.y = pk2(v[j].z * rs * g.z, v[j].w * rs * g.w); o8[64 * j] = w; }
}
__device__ __forceinline__ void p0_prologue(Frame& F) {
    const KA K = KA::fresh(); PHASE_TID;
    LAS float* scr = (LAS float*)(F.lds + wave * 16384);
    const int gw = F.bx * NWAVES + wave, NGW = F.G * NWAVES;
    constexpr int I_IN = 16 * 89, I_OUT = 16 * 32, I_G = 32 * 16 * 8, I_D = 32 * 4 * 32, I_L = I_IN + I_OUT + 2 * I_G + I_D;
    for (int it = gw; it < DEPTH * I_L; it += NGW) {
        const int l = it / I_L; int r = it % I_L;
        if (r < I_IN) { const int kb = r / 89, nb = r % 89; const int nv = (nb == 88) ? 16 : 32;
            transpose_item(K.in(2) + (size_t)l * D * DIN, DIN, nv, kb * 64, nb * 32, K.WinT() + (size_t)l * PLD * D, D, nb * 32, scr, lane); continue; }
        r -= I_IN;
        if (r < I_OUT) { const int kb = r / 32, nb = r % 32;
            transpose_item(K.in(10) + (size_t)l * D * D, D, 32, kb * 64, nb * 32, K.WoutT() + (size_t)l * D * D, D, nb * 32, scr, lane); continue; }
        r -= I_OUT;
        if (r < 2 * I_G) { const int sel = r / I_G; r %= I_G; const int e = r / 128, kb = (r % 128) / 8, nb = r % 8; const int n0 = nb * 32;
            const float* W = K.in(16 + sel) + ((size_t)l * NE + e) * D * DE;
            transpose_item(W, DE, 32, kb * 64, n0, K.WguT() + ((size_t)l * NE + e) * 512 * D, D, (n0 >> 7) * 256 + sel * 128 + (n0 & 127), scr, lane); continue; }
        r -= 2 * I_G;
        { const int e = r / 128, kb = (r % 128) / 32, nb = r % 32;
            transpose_item(K.in(18) + ((size_t)l * NE + e) * DE * D, D, 32, kb * 64, nb * 32, K.WdT() + ((size_t)l * NE + e) * D * DE, DE, nb * 32, scr, lane); }
    }
    for (int i = F.bx * NT + tid; i < DEPTH * 240 * 128; i += F.G * NT) { const int l = i / (240 * 128), rr = (i / 128) % 240, c = i % 128;
        *(GAS v4u*)(K.WinT() + ((size_t)l * PLD + DIN + rr) * D + c * 8) = (v4u){0u, 0u, 0u, 0u}; }
    for (int i = F.bx * NT + tid; i < DEPTH * 48 * D; i += F.G * NT) { const int ll = i / (48 * D), n = (i / D) % 48, k = i % D;
        float w = 0.f;
        if (n < 4) w = K.in(12)[((size_t)ll * D + k) * 4 + n]; else if (n < 36) w = K.in(14)[((size_t)ll * D + k) * 32 + (n - 4)];
        w *= K.in(11)[(size_t)ll * D + k];
        const unsigned hi = f2bf(w), lo = f2bf(w - bf2f(hi));
        K.Wr()[((size_t)ll * 2 + 0) * 48 * D + (size_t)n * D + k] = (bf16)hi; K.Wr()[((size_t)ll * 2 + 1) * 48 * D + (size_t)n * D + k] = (bf16)lo; }
    for (int i = F.bx * NT + tid; i < DEPTH * MH * 128 * 128 / 8; i += F.G * NT) { const int e0 = i * 8, s0 = e0 & 127, t = (e0 >> 7) & 127;
        const f32x4 a = *(const f32x4*)(K.in(7) + e0), c = *(const f32x4*)(K.in(7) + e0 + 4);
        const float v[8] = {a.x, a.y, a.z, a.w, c.x, c.y, c.z, c.w}; unsigned w[4];
#pragma unroll
        for (int j = 0; j < 4; ++j) w[j] = pk2((s0 + 2 * j <= t) ? v[2 * j] : 0.f, (s0 + 2 * j + 1 <= t) ? v[2 * j + 1] : 0.f);
        *(GAS v4u*)(K.Wsp() + e0) = (v4u){w[0], w[1], w[2], w[3]}; }
    for (int m = gw; m < T; m += NGW) rms_row_to_bf16(K.in(0) + (size_t)m * D, K.in(1), K.XN() + (size_t)m * D, lane);
}

__device__ __forceinline__ void gla_cumdecay(Frame& F, const KA& K, int tid, int l, int h, int t0, float* bb) {
    const float* wup = K.in(3) + (size_t)l * 16 * 256; const float* bgk = K.in(4) + (size_t)l * 256;
    for (int e = tid; e < 64 * 64; e += NT) {
        const int c = e >> 6, d = e & 63;
        const bf16* gl = K.P() + (size_t)(t0 + c) * PLD + C_GK;
        float a = bgk[h * 64 + d];
#pragma unroll
        for (int r = 0; r < 16; ++r) a += bf2f(gl[r]) * wup[r * 256 + h * 64 + d];
        bb[c * 64 + d] = log_sigmoid(a) * (1.0f / 16.0f);
    }
    __syncthreads();
    if (tid < 64) { float run = 0.f; for (int c = 0; c < 64; ++c) { run += bb[c * 64 + tid]; bb[c * 64 + tid] = run; } }
    __syncthreads();
}
__device__ __forceinline__ void phase_gla_kv(Frame& F, int l) {
    const KA K = KA::fresh(); PHASE_TID;
    float* bb = F.smem; float* kd = F.smem + 4096;
#pragma unroll 1
    for (int ci = F.bx; ci < NB * GH * GN; ci += F.G) {
        const int b = ci / (GH * GN), h = (ci / GN) % GH, n = ci % GN, t0 = b * S + n * GC;
        __syncthreads();
        gla_cumdecay(F, K, tid, l, h, t0, bb);
        for (int e = tid; e < 4096; e += NT) { const int c = e >> 6, d = e & 63; kd[e] = bf2f(K.P()[(size_t)(t0 + c) * PLD + C_K + h * 64 + d]) * expf(bb[63 * 64 + d] - bb[e]); }
        __syncthreads();
        const int d = tid >> 3, v0 = (tid & 7) * 16;
        float acc[16];
#pragma unroll
        for (int j = 0; j < 16; ++j) acc[j] = 0.f;
#pragma unroll 2
        for (int c = 0; c < 64; ++c) {
            const float kk = kd[c * 64 + d];
            const v4u* vr = (const v4u*)(K.P() + (size_t)(t0 + c) * PLD + C_V + h * 128 + v0);
            float f[8]; unpack8(vr[0], f);
#pragma unroll
            for (int j = 0; j < 8; ++j) acc[j] += kk * f[j];
            unpack8(vr[1], f);
#pragma unroll
            for (int j = 0; j < 8; ++j) acc[8 + j] += kk * f[j];
        }
        f32x4* o = (f32x4*)(K.Sst() + ((size_t)ci * 64 + d) * 128 + v0);
#pragma unroll
        for (int j = 0; j < 4; ++j) o[j] = (f32x4){acc[4 * j], acc[4 * j + 1], acc[4 * j + 2], acc[4 * j + 3]};
        if (tid < 64) K.dec()[(size_t)ci * 64 + tid] = expf(bb[63 * 64 + tid]);
    }
}
__device__ __forceinline__ void phase_gla_scan(Frame& F) {
    const KA K = KA::fresh(); PHASE_TID;
#pragma unroll 1
    for (int e = F.bx * NT + tid; e < NB * GH * 64 * 128; e += F.G * NT) {
        const int bh = e >> 13, d = (e >> 7) & 63, v = e & 127;
        float* base = K.Sst() + ((size_t)bh * GN * 64 + d) * 128 + v; const float* db = K.dec() + (size_t)bh * GN * 64 + d;
        float st = 0.f;
#pragma unroll 1
        for (int n0 = 0; n0 < GN; n0 += 16) {
            float kvv[16], dd[16];
#pragma unroll
            for (int j = 0; j < 16; ++j) { kvv[j] = base[(size_t)(n0 + j) * 8192]; dd[j] = db[(n0 + j) * 64]; }
#pragma unroll
            for (int j = 0; j < 16; ++j) { base[(size_t)(n0 + j) * 8192] = st; st = dd[j] * st + kvv[j]; }
        }
    }
}
__device__ __forceinline__ void phase_gla_out(Frame& F, int l) {
    const KA K = KA::fresh(); PHASE_TID;
    float* bb = F.smem; float* qd = F.smem + 4096; float* ki = F.smem + 4096 + 64 * 65; float* sc = bb;
    const float* gnorm = K.in(5) + (size_t)l * 128;
#pragma unroll 1
    for (int ci = F.bx; ci < NB * GH * GN; ci += F.G) {
        const int b = ci / (GH * GN), h = (ci / GN) % GH, n = ci % GN, t0 = b * S + n * GC;
        __syncthreads();
        gla_cumdecay(F, K, tid, l, h, t0, bb);
        for (int e = tid; e < 4096; e += NT) {
            const int c = e >> 6, d = e & 63; const float bv = bb[e];
            const bf16* row = K.P() + (size_t)(t0 + c) * PLD;
            qd[c * 65 + d] = bf2f(row[C_Q + h * 64 + d]) * 0.125f * expf(bv);
            ki[c * 65 + d] = bf2f(row[C_K + h * 64 + d]) * expf(-bv);
        }
        __syncthreads();
        {
            const int c = tid >> 3, s0 = (tid & 7) * 8;
            float a[8];
#pragma unroll
            for (int j = 0; j < 8; ++j) a[j] = 0.f;
#pragma unroll 4
            for (int d = 0; d < 64; ++d) { const float qv = qd[c * 65 + d];
#pragma unroll
                for (int j = 0; j < 8; ++j) a[j] += qv * ki[(s0 + j) * 65 + d]; }
#pragma unroll
            for (int j = 0; j < 8; ++j) sc[c * 64 + s0 + j] = (s0 + j <= c) ? a[j] : 0.f;
        }
        __syncthreads();
        const int c = tid >> 3, v0 = (tid & 7) * 16;
        float acc[16];
#pragma unroll
        for (int j = 0; j < 16; ++j) acc[j] = 0.f;
#pragma unroll 2
        for (int s = 0; s <= c; ++s) {
            const float w = sc[c * 64 + s];
            const v4u* vr = (const v4u*)(K.P() + (size_t)(t0 + s) * PLD + C_V + h * 128 + v0);
            float f[8]; unpack8(vr[0], f);
#pragma unroll
            for (int j = 0; j < 8; ++j) acc[j] += w * f[j];
            unpack8(vr[1], f);
#pragma unroll
            for (int j = 0; j < 8; ++j) acc[8 + j] += w * f[j];
        }
#pragma unroll 2
        for (int d = 0; d < 64; ++d) {
            const float w = qd[c * 65 + d];
            const f32x4* sr = (const f32x4*)(K.Sst() + ((size_t)ci * 64 + d) * 128 + v0);
#pragma unroll
            for (int j = 0; j < 4; ++j) { const f32x4 v4 = sr[j]; acc[4 * j] += w * v4.x; acc[4 * j + 1] += w * v4.y; acc[4 * j + 2] += w * v4.z; acc[4 * j + 3] += w * v4.w; }
        }
        float ss = 0.f;
#pragma unroll
        for (int j = 0; j < 16; ++j) ss += acc[j] * acc[j];
        ss += shx(ss, 1); ss += shx(ss, 2); ss += shx(ss, 4);
        const float rs = rsqrtf(ss * (1.0f / 128.0f) + EPS);
        const v4u* gr = (const v4u*)(K.P() + (size_t)(t0 + c) * PLD + C_G + h * 128 + v0);
        float g0[8], g1[8]; unpack8(gr[0], g0); unpack8(gr[1], g1);
        float o[16];
#pragma unroll
        for (int j = 0; j < 8; ++j) { o[j] = acc[j] * rs * gnorm[v0 + j] * silu(g0[j]); o[8 + j] = acc[8 + j] * rs * gnorm[v0 + 8 + j] * silu(g1[j]); }
        v4u* op = (v4u*)(K.XN() + (size_t)(t0 + c) * D + h * 128 + v0);
        op[0] = (v4u){pk2(o[0], o[1]), pk2(o[2], o[3]), pk2(o[4], o[5]), pk2(o[6], o[7])};
        op[1] = (v4u){pk2(o[8], o[9]), pk2(o[10], o[11]), pk2(o[12], o[13]), pk2(o[14], o[15])};
    }
}
__device__ __forceinline__ void phase_gmlp(Frame& F, int l) {
    const KA K = KA::fresh(); PHASE_TID;
    float* vs = F.smem;
    const float* gn = K.in(6) + (size_t)l * 256; const float* wsp = K.in(7) + (size_t)l * MH * 128 * 128; const float* bsp = K.in(8) + (size_t)l * MH * 128;
#pragma unroll 1
    for (int u = F.bx; u < NB * MN * MH; u += F.G) {
        const int b = u / (MN * MH), n = (u / MH) % MN, h = u % MH, t0 = b * S + n * MC;
        __syncthreads();
        const int s = tid >> 2, d0 = (tid & 3) * 16;
        {
            const v4u* vr = (const v4u*)(K.P() + (size_t)(t0 + s) * PLD + C_VG + h * 64 + d0);
            float g[16]; { float f[8]; unpack8(vr[0], f);
#pragma unroll
                for (int j = 0; j < 8; ++j) g[j] = gelu_tanh(f[j]);
                unpack8(vr[1], f);
#pragma unroll
                for (int j = 0; j < 8; ++j) g[8 + j] = gelu_tanh(f[j]); }
            float ss = 0.f;
#pragma unroll
            for (int j = 0; j < 16; ++j) ss += g[j] * g[j];
            ss += shx(ss, 1); ss += shx(ss, 2);
            const float rs = rsqrtf(ss * (1.0f / 64.0f) + EPS);
#pragma unroll
            for (int j = 0; j < 16; ++j) vs[s * 64 + d0 + j] = g[j] * rs * gn[h * 64 + d0 + j];
        }
        __syncthreads();
        const int t = s;
        float acc[16];
#pragma unroll
        for (int j = 0; j < 16; ++j) acc[j] = 0.f;
        const float* wr = wsp + ((size_t)h * 128 + t) * 128;
#pragma unroll 2
        for (int s2 = 0; s2 <= t; ++s2) { const float w = wr[s2];
#pragma unroll
            for (int j = 0; j < 16; ++j) acc[j] += w * vs[s2 * 64 + d0 + j]; }
        const float bias = bsp[h * 128 + t];
        const v4u* ur = (const v4u*)(K.P() + (size_t)(t0 + t) * PLD + C_U + h * 64 + d0);
        float u0[8], u1[8]; unpack8(ur[0], u0); unpack8(ur[1], u1);
        float o[16];
#pragma unroll
        for (int j = 0; j < 8; ++j) { o[j] = gelu_tanh(u0[j]) * (acc[j] + bias); o[8 + j] = gelu_tanh(u1[j]) * (acc[8 + j] + bias); }
        v4u* op = (v4u*)(K.XN() + (size_t)(t0 + t) * D + 512 + h * 64 + d0);
        op[0] = (v4u){pk2(o[0], o[1]), pk2(o[2], o[3]), pk2(o[4], o[5]), pk2(o[6], o[7])};
        op[1] = (v4u){pk2(o[8], o[9]), pk2(o[10], o[11]), pk2(o[12], o[13]), pk2(o[14], o[15])};
    }
}
typedef short bf16x8 __attribute__((ext_vector_type(8)));
__device__ __forceinline__ float fexp(float x) { return __builtin_amdgcn_exp2f(x * 1.4426950408889634f); }
__device__ __forceinline__ float logsig_fast(float x) { return fminf(x, 0.f) - __log2f(1.0f + fexp(-fabsf(x))) * 0.6931471805599453f; }
__device__ __forceinline__ float silu_fast(float x) { return x * __builtin_amdgcn_rcpf(1.0f + __builtin_amdgcn_exp2f(-1.4426950408889634f * x)); }
__device__ __forceinline__ float gelu_fast(float x) { const float u = 0.7978845608028654f * (x + 0.044715f * x * x * x); return x * __builtin_amdgcn_rcpf(1.0f + __builtin_amdgcn_exp2f(-2.8853900817779268f * u)); }
__device__ __forceinline__ f32x4 mfma16(bf16x8 a, bf16x8 b, f32x4 c) { return __builtin_amdgcn_mfma_f32_16x16x32_bf16(a, b, c, 0, 0, 0); }
constexpr int LROWB = 144;
constexpr int L_QD = 0, L_KI = 9216, L_KDT = 18432, L_VT = 27648, L_S = 46080, L_ST = 55296, L_OB = 73728, L_TOT = 107520, OBROW = 528;
#define FRAG(base, row, kel) (*(const LAS bf16x8*)(lds + (base) + (row) * LROWB + (kel) * 2))

__device__ __forceinline__ float gla_b8(const KA& K, LAS unsigned char* lds, int l, int h, int t0, int lane, int wave, float (&bv)[8]) {
    const float* wup = K.in(3) + (size_t)l * 16 * 256 + h * 64 + lane;
    float wu[16];
#pragma unroll
    for (int r = 0; r < 16; ++r) wu[r] = wup[r * 256];
    const float bg = K.in(4)[l * 256 + h * 64 + lane];
    const bf16* P = K.P();
    float run = 0.f;
#pragma unroll
    for (int j = 0; j < 8; ++j) {
        const bf16* gl = P + (size_t)(t0 + 8 * wave + j) * PLD + C_GK;
        float f0[8], f1[8]; unpack8(*(const v4u*)gl, f0); unpack8(*(const v4u*)(gl + 8), f1);
        float a = bg;
#pragma unroll
        for (int r = 0; r < 8; ++r) a += f0[r] * wu[r];
#pragma unroll
        for (int r = 0; r < 8; ++r) a += f1[r] * wu[8 + r];
        run += logsig_fast(a) * (1.0f / 16.0f); bv[j] = run;
    }
    LAS float* tot = (LAS float*)(lds + L_TOT);
    tot[wave * 64 + lane] = run;
    __syncthreads();
    float base = 0.f, all = 0.f;
#pragma unroll
    for (int g = 0; g < 8; ++g) { const float tv = tot[g * 64 + lane]; all += tv; if (g < wave) base += tv; }
#pragma unroll
    for (int j = 0; j < 8; ++j) bv[j] += base;
    return all;
}
__device__ __forceinline__ void gla_stage_vT(const bf16* P, LAS unsigned char* lds, int h, int t0, int tid) {
    const int vv = tid & 127, cq = tid >> 7;
    const bf16* vp = P + (size_t)(t0 + 16 * cq) * PLD + C_V + h * 128 + vv;
    unsigned w[8];
#pragma unroll
    for (int j = 0; j < 8; ++j) w[j] = (unsigned)vp[(size_t)(2 * j) * PLD] | ((unsigned)vp[(size_t)(2 * j + 1) * PLD] << 16);
    LAS v4u* dst = (LAS v4u*)(lds + L_VT + vv * LROWB + cq * 32);
    dst[0] = (v4u){w[0], w[1], w[2], w[3]}; dst[1] = (v4u){w[4], w[5], w[6], w[7]};
}

__device__ __forceinline__ void phase_gla_kv_mfma(Frame& F, int l) {
    const KA K = KA::fresh(); PHASE_TID;
    LAS unsigned char* lds = F.lds;
    const int fr = lane & 15, fq = lane >> 4;
#pragma unroll 1
    for (int ci = F.bx; ci < NB * GH * GN; ci += F.G) {
        const int b = ci / (GH * GN), h = (ci / GN) % GH, n = ci % GN, t0 = b * S + n * GC;
        const bf16* P = K.P();
        __syncthreads();
        float bv[8]; const float bl = gla_b8(K, lds, l, h, t0, lane, wave, bv);
        {
            const bf16* kp = P + (size_t)(t0 + 8 * wave) * PLD + C_K + h * 64 + lane;
            float kd[8];
#pragma unroll
            for (int j = 0; j < 8; ++j) kd[j] = bf2f(kp[(size_t)j * PLD]) * fexp(bl - bv[j]);
            *(LAS v4u*)(lds + L_KDT + lane * LROWB + wave * 16) = (v4u){pk2(kd[0], kd[1]), pk2(kd[2], kd[3]), pk2(kd[4], kd[5]), pk2(kd[6], kd[7])};
        }
        gla_stage_vT(P, lds, h, t0, tid);
        if (wave == 0) K.dec()[(size_t)ci * 64 + lane] = fexp(bl);
        __syncthreads();
        bf16x8 Bf[2];
#pragma unroll
        for (int ks = 0; ks < 2; ++ks) Bf[ks] = FRAG(L_VT, 16 * wave + fr, 32 * ks + 8 * fq);
        float* so = K.Sst() + (size_t)ci * 64 * 128 + 16 * wave + fr;
#pragma unroll
        for (int dt = 0; dt < 4; ++dt) {
            f32x4 acc = (f32x4){0.f, 0.f, 0.f, 0.f};
#pragma unroll
            for (int ks = 0; ks < 2; ++ks) acc = mfma16(FRAG(L_KDT, 16 * dt + fr, 32 * ks + 8 * fq), Bf[ks], acc);
#pragma unroll
            for (int r = 0; r < 4; ++r) so[(size_t)(16 * dt + 4 * fq + r) * 128] = acc[r];
        }
    }
}

__device__ __forceinline__ void phase_gla_out_mfma(Frame& F, int l) {
    const KA K = KA::fresh(); PHASE_TID;
    LAS unsigned char* lds = F.lds;
    const int fr = lane & 15, fq = lane >> 4;
    const float* gnorm = K.in(5) + (size_t)l * 128;
#pragma unroll 1
    for (int ci = F.bx; ci < NB * GH * GN; ci += F.G) {
        const int b = ci / (GH * GN), h = (ci / GN) % GH, n = ci % GN, t0 = b * S + n * GC;
        const bf16* P = K.P();
        __syncthreads();
        float bv[8]; (void)gla_b8(K, lds, l, h, t0, lane, wave, bv);
        {
            const bf16* qp = P + (size_t)(t0 + 8 * wave) * PLD + C_Q + h * 64 + lane;
            const bf16* kp = qp + (C_K - C_Q);
#pragma unroll
            for (int j = 0; j < 8; ++j) {
                const float e = fexp(bv[j]);
                const float qv = bf2f(qp[(size_t)j * PLD]) * 0.125f * e, kv = bf2f(kp[(size_t)j * PLD]) * __builtin_amdgcn_rcpf(e);
                *(LAS bf16*)(lds + L_QD + (8 * wave + j) * LROWB + lane * 2) = (bf16)f2bf(qv);
                *(LAS bf16*)(lds + L_KI + (8 * wave + j) * LROWB + lane * 2) = (bf16)f2bf(kv);
            }
        }
        gla_stage_vT(P, lds, h, t0, tid);
        {
            const int vv = tid & 127, dq = tid >> 7;
            const float* sp = K.Sst() + ((size_t)ci * 64 + 16 * dq) * 128 + vv;
            unsigned w[8];
#pragma unroll
            for (int j = 0; j < 8; ++j) w[j] = pk2(sp[(size_t)(2 * j) * 128], sp[(size_t)(2 * j + 1) * 128]);
            LAS v4u* dst = (LAS v4u*)(lds + L_ST + vv * LROWB + dq * 32);
            dst[0] = (v4u){w[0], w[1], w[2], w[3]}; dst[1] = (v4u){w[4], w[5], w[6], w[7]};
        }
        __syncthreads();
#pragma unroll
        for (int i = 0; i < 2; ++i) {
            const int tix = 2 * wave + i, st = tix >> 2, ct = tix & 3;
            f32x4 acc = (f32x4){0.f, 0.f, 0.f, 0.f};
#pragma unroll
            for (int ks = 0; ks < 2; ++ks) acc = mfma16(FRAG(L_KI, 16 * st + fr, 32 * ks + 8 * fq), FRAG(L_QD, 16 * ct + fr, 32 * ks + 8 * fq), acc);
            const int s0 = 16 * st + 4 * fq, c = 16 * ct + fr;
            float m[4];
#pragma unroll
            for (int r = 0; r < 4; ++r) m[r] = (s0 + r <= c) ? acc[r] : 0.f;
            *(LAS v2u*)(lds + L_S + c * LROWB + s0 * 2) = (v2u){pk2(m[0], m[1]), pk2(m[2], m[3])};
        }
        __syncthreads();
        {
            bf16x8 Av[2], As[2];
#pragma unroll
            for (int ks = 0; ks < 2; ++ks) { Av[ks] = FRAG(L_VT, 16 * wave + fr, 32 * ks + 8 * fq); As[ks] = FRAG(L_ST, 16 * wave + fr, 32 * ks + 8 * fq); }
#pragma unroll
            for (int ct = 0; ct < 4; ++ct) {
                f32x4 acc = (f32x4){0.f, 0.f, 0.f, 0.f};
#pragma unroll
                for (int ks = 0; ks < 2; ++ks) { acc = mfma16(Av[ks], FRAG(L_S, 16 * ct + fr, 32 * ks + 8 * fq), acc); acc = mfma16(As[ks], FRAG(L_QD, 16 * ct + fr, 32 * ks + 8 * fq), acc); }
                *(LAS f32x4*)(lds + L_OB + (16 * ct + fr) * OBROW + (16 * wave + 4 * fq) * 4) = acc;
            }
        }
        __syncthreads();
        {
            const int c = tid >> 3, vg = tid & 7;
            const LAS f32x4* ob = (const LAS f32x4*)(lds + L_OB + c * OBROW + vg * 64);
            f32x4 o[4]; float ss = 0.f;
#pragma unroll
            for (int j = 0; j < 4; ++j) { o[j] = ob[j]; ss += (o[j].x * o[j].x + o[j].y * o[j].y) + (o[j].z * o[j].z + o[j].w * o[j].w); }
            ss += shx(ss, 1); ss += shx(ss, 2); ss += shx(ss, 4);
            const float rs = rsqrtf(ss * (1.0f / 128.0f) + EPS);
            const v4u* gr = (const v4u*)(P + (size_t)(t0 + c) * PLD + C_G + h * 128 + 16 * vg);
            float g0[8], g1[8]; unpack8(gr[0], g0); unpack8(gr[1], g1);
            const f32x4* gn = (const f32x4*)(gnorm + 16 * vg);
            const f32x4 n0 = gn[0], n1 = gn[1], n2 = gn[2], n3 = gn[3];
            v4u w0, w1;
            w0.x = pk2(o[0].x * rs * n0.x * silu_fast(g0[0]), o[0].y * rs * n0.y * silu_fast(g0[1])); w0.y = pk2(o[0].z * rs * n0.z * silu_fast(g0[2]), o[0].w * rs * n0.w * silu_fast(g0[3]));
            w0.z = pk2(o[1].x * rs * n1.x * silu_fast(g0[4]), o[1].y * rs * n1.y * silu_fast(g0[5])); w0.w = pk2(o[1].z * rs * n1.z * silu_fast(g0[6]), o[1].w * rs * n1.w * silu_fast(g0[7]));
            w1.x = pk2(o[2].x * rs * n2.x * silu_fast(g1[0]), o[2].y * rs * n2.y * silu_fast(g1[1])); w1.y = pk2(o[2].z * rs * n2.z * silu_fast(g1[2]), o[2].w * rs * n2.w * silu_fast(g1[3]));
            w1.z = pk2(o[3].x * rs * n3.x * silu_fast(g1[4]), o[3].y * rs * n3.y * silu_fast(g1[5])); w1.w = pk2(o[3].z * rs * n3.z * silu_fast(g1[6]), o[3].w * rs * n3.w * silu_fast(g1[7]));
            v4u* op = (v4u*)(K.XN() + (size_t)(t0 + c) * D + h * 128 + 16 * vg);
            op[0] = w0; op[1] = w1;
        }
    }
}
#undef FRAG


constexpr int L_GKL = 109568, L_BL = 117760, SCN = 4, NSC = GN / SCN, NITEM = NB * GH * NSC;
#define FRAG(base, row, kel) (*(const LAS bf16x8*)(lds + (base) + (row) * LROWB + (kel) * 2))
struct GlaPre { unsigned short k[8], q[8], v[16]; v4u g0, g1; };
template <bool WITH_Q>
__device__ __forceinline__ void gla_prefetch(GlaPre& p, const bf16* P, int h, int t0, int tid, int lane, int wave) {
    const bf16* kp = P + (size_t)(t0 + 8 * wave) * PLD + C_K + h * 64 + lane;
#pragma unroll
    for (int j = 0; j < 8; ++j) p.k[j] = kp[(size_t)j * PLD];
    const int vv = tid & 127, cq = tid >> 7;
    const bf16* vp = P + (size_t)(t0 + 16 * cq) * PLD + C_V + h * 128 + vv;
#pragma unroll
    for (int j = 0; j < 16; ++j) p.v[j] = vp[(size_t)j * PLD];
    if (WITH_Q) {
        const bf16* qp = kp + (C_Q - C_K);
#pragma unroll
        for (int j = 0; j < 8; ++j) p.q[j] = qp[(size_t)j * PLD];
        const v4u* gr = (const v4u*)(P + (size_t)(t0 + (tid >> 3)) * PLD + C_G + h * 128 + 16 * (tid & 7));
        p.g0 = gr[0]; p.g1 = gr[1];
    }
}
__device__ __forceinline__ void gla_stage_gkl(const bf16* P, LAS unsigned char* lds, int tok0, int tid) {
    *(LAS v4u*)(lds + L_GKL + tid * 16) = *(const v4u*)(P + (size_t)(tok0 + (tid >> 1)) * PLD + C_GK + 8 * (tid & 1));
}
__device__ __forceinline__ void gla_b8_part(LAS unsigned char* lds, const float (&wu)[16], float bg, int n, int lane, int wave, float (&bv)[8]) {
    float run = 0.f;
#pragma unroll
    for (int j = 0; j < 8; ++j) {
        const LAS v4u* gl = (const LAS v4u*)(lds + L_GKL + (n * 64 + 8 * wave + j) * 32);
        float f0[8], f1[8]; unpack8(gl[0], f0); unpack8(gl[1], f1);
        float a = bg;
#pragma unroll
        for (int r = 0; r < 8; ++r) a += f0[r] * wu[r];
#pragma unroll
        for (int r = 0; r < 8; ++r) a += f1[r] * wu[8 + r];
        run += logsig_fast(a) * (1.0f / 16.0f); bv[j] = run;
    }
    ((LAS float*)(lds + L_TOT))[wave * 64 + lane] = run;
}
__device__ __forceinline__ float gla_b8_finish(LAS unsigned char* lds, int lane, int wave, float (&bv)[8]) {
    const LAS float* tot = (const LAS float*)(lds + L_TOT);
    float base = 0.f, all = 0.f;
#pragma unroll
    for (int g = 0; g < 8; ++g) { const float tv = tot[g * 64 + lane]; all += tv; if (g < wave) base += tv; }
#pragma unroll
    for (int j = 0; j < 8; ++j) bv[j] += base;
    return all;
}
__device__ __forceinline__ void gla_write_kdT_vT(LAS unsigned char* lds, const GlaPre& p, const float (&bv)[8], float bl, int tid, int lane, int wave) {
    float kd[8];
#pragma unroll
    for (int j = 0; j < 8; ++j) kd[j] = bf2f(p.k[j]) * fexp(bl - bv[j]);
    *(LAS v4u*)(lds + L_KDT + lane * LROWB + wave * 16) = (v4u){pk2(kd[0], kd[1]), pk2(kd[2], kd[3]), pk2(kd[4], kd[5]), pk2(kd[6], kd[7])};
    const int vv = tid & 127, cq = tid >> 7;
    LAS v4u* dst = (LAS v4u*)(lds + L_VT + vv * LROWB + cq * 32);
    dst[0] = (v4u){(unsigned)p.v[0] | ((unsigned)p.v[1] << 16), (unsigned)p.v[2] | ((unsigned)p.v[3] << 16), (unsigned)p.v[4] | ((unsigned)p.v[5] << 16), (unsigned)p.v[6] | ((unsigned)p.v[7] << 16)};
    dst[1] = (v4u){(unsigned)p.v[8] | ((unsigned)p.v[9] << 16), (unsigned)p.v[10] | ((unsigned)p.v[11] << 16), (unsigned)p.v[12] | ((unsigned)p.v[13] << 16), (unsigned)p.v[14] | ((unsigned)p.v[15] << 16)};
    if (wave == 0) ((LAS float*)(lds + L_BL))[lane] = bl;
}
__device__ __forceinline__ void gla_kv_mfma(LAS unsigned char* lds, int wave, int fr, int fq, f32x4 (&acc)[4]) {
    bf16x8 Bf[2];
#pragma unroll
    for (int ks = 0; ks < 2; ++ks) Bf[ks] = FRAG(L_VT, 16 * wave + fr, 32 * ks + 8 * fq);
#pragma unroll
    for (int dt = 0; dt < 4; ++dt) { acc[dt] = (f32x4){0.f, 0.f, 0.f, 0.f};
#pragma unroll
        for (int ks = 0; ks < 2; ++ks) acc[dt] = mfma16(FRAG(L_KDT, 16 * dt + fr, 32 * ks + 8 * fq), Bf[ks], acc[dt]); }
}

__device__ __forceinline__ void phase_gla_A2(Frame& F, int l) {
    const KA K = KA::fresh(); PHASE_TID;
    LAS unsigned char* lds = F.lds;
    const int fr = lane & 15, fq = lane >> 4;
#pragma unroll 1
    for (int it = F.bx; it < NITEM; it += F.G) {
        const int b = it / (GH * NSC), h = (it / NSC) % GH, sc = it % NSC, tok0 = b * S + sc * SCN * GC;
        const bf16* P = K.P();
        float wu[16];
        { const float* wup = K.in(3) + (size_t)l * 16 * 256 + h * 64 + lane;
#pragma unroll
          for (int r = 0; r < 16; ++r) wu[r] = wup[r * 256]; }
        const float bg = K.in(4)[l * 256 + h * 64 + lane];
        GlaPre pre[2]; gla_prefetch<false>(pre[0], P, h, tok0, tid, lane, wave); gla_prefetch<false>(pre[1], P, h, tok0 + GC, tid, lane, wave);
        __syncthreads();
        gla_stage_gkl(P, lds, tok0, tid);
        __syncthreads();
        f32x4 Sl[4], bs[4];
#pragma unroll
        for (int dt = 0; dt < 4; ++dt) { Sl[dt] = (f32x4){0.f, 0.f, 0.f, 0.f}; bs[dt] = (f32x4){0.f, 0.f, 0.f, 0.f}; }
#pragma unroll
        for (int n = 0; n < SCN; ++n) {
            float bv[8]; gla_b8_part(lds, wu, bg, n, lane, wave, bv);
            __syncthreads();
            const float bl = gla_b8_finish(lds, lane, wave, bv);
            gla_write_kdT_vT(lds, pre[n & 1], bv, bl, tid, lane, wave);
            if (n + 2 < SCN) gla_prefetch<false>(pre[n & 1], P, h, tok0 + (n + 2) * GC, tid, lane, wave);
            __syncthreads();
            f32x4 acc[4]; gla_kv_mfma(lds, wave, fr, fq, acc);
#pragma unroll
            for (int dt = 0; dt < 4; ++dt) { const f32x4 bl4 = *(const LAS f32x4*)(lds + L_BL + (16 * dt + 4 * fq) * 4);
                bs[dt] = bs[dt] + bl4;
#pragma unroll
                for (int r = 0; r < 4; ++r) Sl[dt][r] = fexp(bl4[r]) * Sl[dt][r] + acc[dt][r]; }
        }
        f32x4* ag = (f32x4*)K.Sst() + ((size_t)(it * 8 + wave) * 4) * 64 + lane;
#pragma unroll
        for (int dt = 0; dt < 4; ++dt) ag[dt * 64] = Sl[dt];
        if (wave == 0 && fr == 0) { f32x4* dp = (f32x4*)K.dec() + (size_t)it * 16 + fq;
#pragma unroll
            for (int dt = 0; dt < 4; ++dt) dp[dt * 4] = (f32x4){fexp(bs[dt][0]), fexp(bs[dt][1]), fexp(bs[dt][2]), fexp(bs[dt][3])}; }
    }
}


__device__ __forceinline__ void phase_gla_aggscan(Frame& F) {
    const KA K = KA::fresh(); PHASE_TID;
#pragma unroll 1
    for (int e = F.bx * NT + tid; e < NB * GH * 8192; e += F.G * NT) {
        const int bh = e >> 13, el = e & 8191, ln = (el >> 2) & 63, dt = (el >> 8) & 3, r = el & 3;
        float* ap = K.Sst() + (size_t)bh * NSC * 8192 + el; const float* dp = K.dec() + (size_t)bh * NSC * 64 + dt * 16 + (ln >> 4) * 4 + r;
        float a[NSC], d[NSC];
#pragma unroll
        for (int j = 0; j < NSC; ++j) { a[j] = ap[(size_t)j * 8192]; d[j] = dp[j * 64]; }
        float st = 0.f;
#pragma unroll
        for (int j = 0; j < NSC; ++j) { ap[(size_t)j * 8192] = st; st = d[j] * st + a[j]; }
    }
}
__device__ __forceinline__ void phase_gla_C2(Frame& F, int l) {
    const KA K = KA::fresh(); PHASE_TID;
    LAS unsigned char* lds = F.lds;
    const int fr = lane & 15, fq = lane >> 4;
    const float* gnorm = K.in(5) + (size_t)l * 128;
#pragma unroll 1
    for (int it = F.bx; it < NITEM; it += F.G) {
        const int b = it / (GH * NSC), h = (it / NSC) % GH, sc = it % NSC, tok0 = b * S + sc * SCN * GC;
        const bf16* P = K.P();
        float wu[16];
        { const float* wup = K.in(3) + (size_t)l * 16 * 256 + h * 64 + lane;
#pragma unroll
          for (int r = 0; r < 16; ++r) wu[r] = wup[r * 256]; }
        const float bg = K.in(4)[l * 256 + h * 64 + lane];
        GlaPre pre[2]; gla_prefetch<true>(pre[0], P, h, tok0, tid, lane, wave); gla_prefetch<true>(pre[1], P, h, tok0 + GC, tid, lane, wave);
        __syncthreads();
        gla_stage_gkl(P, lds, tok0, tid);
        f32x4 Sm[4];
        { const f32x4* ag = (const f32x4*)K.Sst() + ((size_t)(it * 8 + wave) * 4) * 64 + lane;
#pragma unroll
          for (int dt = 0; dt < 4; ++dt) Sm[dt] = ag[dt * 64]; }
        __syncthreads();
#pragma unroll
        for (int n = 0; n < SCN; ++n) {
            const int t0 = tok0 + n * GC;
            GlaPre& pr = pre[n & 1];
            float bv[8]; gla_b8_part(lds, wu, bg, n, lane, wave, bv);
            __syncthreads();
            const float bl = gla_b8_finish(lds, lane, wave, bv);
            gla_write_kdT_vT(lds, pr, bv, bl, tid, lane, wave);
#pragma unroll
            for (int j = 0; j < 8; ++j) {
                const float e = fexp(bv[j]);
                *(LAS bf16*)(lds + L_QD + (8 * wave + j) * LROWB + lane * 2) = (bf16)f2bf(bf2f(pr.q[j]) * 0.125f * e);
                *(LAS bf16*)(lds + L_KI + (8 * wave + j) * LROWB + lane * 2) = (bf16)f2bf(bf2f(pr.k[j]) * __builtin_amdgcn_rcpf(e));
            }
#pragma unroll
            for (int dt = 0; dt < 4; ++dt) *(LAS v2u*)(lds + L_ST + (16 * wave + fr) * LROWB + (16 * dt + 4 * fq) * 2) = (v2u){pk2(Sm[dt][0], Sm[dt][1]), pk2(Sm[dt][2], Sm[dt][3])};
            const v4u gq0 = pr.g0, gq1 = pr.g1;
            if (n + 2 < SCN) gla_prefetch<true>(pr, P, h, t0 + 2 * GC, tid, lane, wave);
            __syncthreads();
#pragma unroll
            for (int i = 0; i < 2; ++i) {
                const int tix = 2 * wave + i, st = tix >> 2, ct = tix & 3;
                f32x4 a = (f32x4){0.f, 0.f, 0.f, 0.f};
#pragma unroll
                for (int ks = 0; ks < 2; ++ks) a = mfma16(FRAG(L_KI, 16 * st + fr, 32 * ks + 8 * fq), FRAG(L_QD, 16 * ct + fr, 32 * ks + 8 * fq), a);
                const int s0 = 16 * st + 4 * fq, c = 16 * ct + fr;
                float m[4];
#pragma unroll
                for (int r = 0; r < 4; ++r) m[r] = (s0 + r <= c) ? a[r] : 0.f;
                *(LAS v2u*)(lds + L_S + c * LROWB + s0 * 2) = (v2u){pk2(m[0], m[1]), pk2(m[2], m[3])};
            }
            f32x4 kv[4]; gla_kv_mfma(lds, wave, fr, fq, kv);
            __syncthreads();
            {
                bf16x8 Av[2], As[2];
#pragma unroll
                for (int ks = 0; ks < 2; ++ks) { Av[ks] = FRAG(L_VT, 16 * wave + fr, 32 * ks + 8 * fq); As[ks] = FRAG(L_ST, 16 * wave + fr, 32 * ks + 8 * fq); }
#pragma unroll
                for (int ct = 0; ct < 4; ++ct) {
                    f32x4 a = (f32x4){0.f, 0.f, 0.f, 0.f};
#pragma unroll
                    for (int ks = 0; ks < 2; ++ks) { a = mfma16(Av[ks], FRAG(L_S, 16 * ct + fr, 32 * ks + 8 * fq), a); a = mfma16(As[ks], FRAG(L_QD, 16 * ct + fr, 32 * ks + 8 * fq), a); }
                    *(LAS f32x4*)(lds + L_OB + (16 * ct + fr) * OBROW + (16 * wave + 4 * fq) * 4) = a;
                }
            }
#pragma unroll
            for (int dt = 0; dt < 4; ++dt) { const f32x4 bl4 = *(const LAS f32x4*)(lds + L_BL + (16 * dt + 4 * fq) * 4);
#pragma unroll
                for (int r = 0; r < 4; ++r) Sm[dt][r] = fexp(bl4[r]) * Sm[dt][r] + kv[dt][r]; }
            __syncthreads();
            {
                const int c = tid >> 3, vg = tid & 7;
                const LAS f32x4* ob = (const LAS f32x4*)(lds + L_OB + c * OBROW + vg * 64);
                f32x4 o[4]; float ss = 0.f;
#pragma unroll
                for (int j = 0; j < 4; ++j) { o[j] = ob[j]; ss += (o[j].x * o[j].x + o[j].y * o[j].y) + (o[j].z * o[j].z + o[j].w * o[j].w); }
                ss += shx(ss, 1); ss += shx(ss, 2); ss += shx(ss, 4);
                const float rs = rsqrtf(ss * (1.0f / 128.0f) + EPS);
                float g0[8], g1[8]; unpack8(gq0, g0); unpack8(gq1, g1);
                const f32x4* gn = (const f32x4*)(gnorm + 16 * vg);
                const f32x4 n0 = gn[0], n1 = gn[1], n2 = gn[2], n3 = gn[3];
                v4u w0, w1;
                w0.x = pk2(o[0].x * rs * n0.x * silu_fast(g0[0]), o[0].y * rs * n0.y * silu_fast(g0[1])); w0.y = pk2(o[0].z * rs * n0.z * silu_fast(g0[2]), o[0].w * rs * n0.w * silu_fast(g0[3]));
                w0.z = pk2(o[1].x * rs * n1.x * silu_fast(g0[4]), o[1].y * rs * n1.y * silu_fast(g0[5])); w0.w = pk2(o[1].z * rs * n1.z * silu_fast(g0[6]), o[1].w * rs * n1.w * silu_fast(g0[7]));
                w1.x = pk2(o[2].x * rs * n2.x * silu_fast(g1[0]), o[2].y * rs * n2.y * silu_fast(g1[1])); w1.y = pk2(o[2].z * rs * n2.z * silu_fast(g1[2]), o[2].w * rs * n2.w * silu_fast(g1[3]));
                w1.z = pk2(o[3].x * rs * n3.x * silu_fast(g1[4]), o[3].y * rs * n3.y * silu_fast(g1[5])); w1.w = pk2(o[3].z * rs * n3.z * silu_fast(g1[6]), o[3].w * rs * n3.w * silu_fast(g1[7]));
                v4u* op = (v4u*)(K.XN() + (size_t)(t0 + c) * D + h * 128 + 16 * vg);
                op[0] = w0; op[1] = w1;
            }
        }
    }
}
#undef FRAG

constexpr int GM_ROWB = 272;
__device__ __forceinline__ void phase_gmlp_mfma(Frame& F, int l) {
    const KA K = KA::fresh(); PHASE_TID;
    LAS unsigned char* lds = F.lds;
    const int fr = lane & 15, fq = lane >> 4;
#pragma unroll 1
    for (int u = F.bx; u < NB * MN * MH; u += F.G) {
        const int b = u / (MN * MH), n = (u / MH) % MN, h = u % MH, t0 = b * S + n * MC;
        const bf16* P = K.P();
        const float gn = K.in(6)[(size_t)l * 256 + h * 64 + lane];
        __syncthreads();
#pragma unroll
        for (int q = 0; q < 2; ++q) {
            float vs[8];
#pragma unroll
            for (int i = 0; i < 8; ++i) {
                const float g = gelu_fast(bf2f(P[(size_t)(t0 + 16 * wave + 8 * q + i) * PLD + C_VG + h * 64 + lane]));
                const float ss = wave_sum(g * g);
                vs[i] = g * rsqrtf(ss * (1.0f / 64.0f) + EPS) * gn;
            }
            *(LAS v4u*)(lds + lane * GM_ROWB + (16 * wave + 8 * q) * 2) = (v4u){pk2(vs[0], vs[1]), pk2(vs[2], vs[3]), pk2(vs[4], vs[5]), pk2(vs[6], vs[7])};
        }
        __syncthreads();
        const bf16* Wb = K.Wsp() + ((size_t)(l * MH + h) * 128 + 16 * wave + fr) * 128 + 8 * fq;
        f32x4 acc[4];
#pragma unroll
        for (int dt = 0; dt < 4; ++dt) acc[dt] = (f32x4){0.f, 0.f, 0.f, 0.f};
        const int nks = (16 * wave + 15) / 32 + 1;
#pragma unroll
        for (int ks = 0; ks < 4; ++ks) if (ks < nks) {
            const bf16x8 Bf = *(const bf16x8*)(Wb + 32 * ks);
#pragma unroll
            for (int dt = 0; dt < 4; ++dt) acc[dt] = mfma16(*(const LAS bf16x8*)(lds + (16 * dt + fr) * GM_ROWB + (32 * ks + 8 * fq) * 2), Bf, acc[dt]);
        }
        const int t = 16 * wave + fr;
        const float bias = K.in(8)[(size_t)l * MH * 128 + h * 128 + t];
        const bf16* up = P + (size_t)(t0 + t) * PLD + C_U + h * 64 + 4 * fq;
        bf16* op = K.XN() + (size_t)(t0 + t) * D + 512 + h * 64 + 4 * fq;
#pragma unroll
        for (int dt = 0; dt < 4; ++dt) {
            const v2u uw = *(const v2u*)(up + 16 * dt);
            const float o0 = gelu_fast(bflo(uw.x)) * (acc[dt][0] + bias), o1 = gelu_fast(bfhi(uw.x)) * (acc[dt][1] + bias), o2 = gelu_fast(bflo(uw.y)) * (acc[dt][2] + bias), o3 = gelu_fast(bfhi(uw.y)) * (acc[dt][3] + bias);
            *(v2u*)(op + 16 * dt) = (v2u){pk2(o0, o1), pk2(o2, o3)};
        }
    }
}

__device__ __forceinline__ void phase_conv(Frame& F, int l) {
    const KA K = KA::fresh(); PHASE_TID;
    const float* wc = K.in(9) + (size_t)l * 3 * 256;
#pragma unroll 1
    for (int e = F.bx * NT + tid; e < T * 32; e += F.G * NT) {
        const int t = e >> 5, c0 = (e & 31) * 8, tl = t % S;
        const bf16* row = K.P() + (size_t)t * PLD;
        float y[8], xi[8], cg[8], bg[8];
        unpack8(*(const v4u*)(row + C_XI + c0), xi); unpack8(*(const v4u*)(row + C_CG + c0), cg); unpack8(*(const v4u*)(row + C_BG + c0), bg);
#pragma unroll
        for (int j = 0; j < 8; ++j) y[j] = wc[2 * 256 + c0 + j] * cg[j] * xi[j];
        if (tl >= 1) { unpack8(*(const v4u*)(row - PLD + C_XI + c0), xi); unpack8(*(const v4u*)(row - PLD + C_CG + c0), cg);
#pragma unroll
            for (int j = 0; j < 8; ++j) y[j] += wc[1 * 256 + c0 + j] * cg[j] * xi[j]; }
        if (tl >= 2) { unpack8(*(const v4u*)(row - 2 * PLD + C_XI + c0), xi); unpack8(*(const v4u*)(row - 2 * PLD + C_CG + c0), cg);
#pragma unroll
            for (int j = 0; j < 8; ++j) y[j] += wc[0 * 256 + c0 + j] * cg[j] * xi[j]; }
#pragma unroll
        for (int j = 0; j < 8; ++j) y[j] *= bg[j];
        *(v4u*)(K.XN() + (size_t)t * D + 768 + c0) = (v4u){pk2(y[0], y[1]), pk2(y[2], y[3]), pk2(y[4], y[5]), pk2(y[6], y[7])};
    }
}
__device__ __forceinline__ void phase_norm_router(Frame& F, int l) {
    const KA K = KA::fresh(); PHASE_TID;
    const float* gain = K.in(11) + (size_t)l * D;
    const float* wrg = K.in(12) + (size_t)l * D * 4; const float* brg = K.in(13) + (size_t)l * 4;
    const float* wre = K.in(14) + (size_t)l * D * 32; const float* bre = K.in(15) + (size_t)l * 32;
    int* cnt = (int*)(K.ctl() + CW_CNT + 64 * l);
#pragma unroll 1
    for (int t = F.bx * NWAVES + wave; t < T; t += F.G * NWAVES) {
        const f32x4* xr = (const f32x4*)(K.out() + (size_t)t * D) + lane;
        f32x4 v[4]; float s = 0.f;
#pragma unroll
        for (int j = 0; j < 4; ++j) { v[j] = xr[64 * j]; s += (v[j].x * v[j].x + v[j].y * v[j].y) + (v[j].z * v[j].z + v[j].w * v[j].w); }
        const float rs = rsqrtf(wave_sum(s) * (1.f / D) + EPS);
        v2u* o8 = (v2u*)(K.XN() + (size_t)t * D) + lane;
        float acc[36];
#pragma unroll
        for (int j = 0; j < 36; ++j) acc[j] = 0.f;
#pragma unroll
        for (int j = 0; j < 4; ++j) {
            const f32x4 g = ((const f32x4*)gain)[lane + 64 * j];
            const float hv[4] = {v[j].x * rs * g.x, v[j].y * rs * g.y, v[j].z * rs * g.z, v[j].w * rs * g.w};
            v2u w; w.x = pk2(hv[0], hv[1]); w.y = pk2(hv[2], hv[3]); o8[64 * j] = w;
#pragma unroll
            for (int i = 0; i < 4; ++i) {
                const int k = 4 * lane + 256 * j + i; const float xv = hv[i];
                const f32x4 g4 = *(const f32x4*)(wrg + (size_t)k * 4);
                acc[0] += xv * g4.x; acc[1] += xv * g4.y; acc[2] += xv * g4.z; acc[3] += xv * g4.w;
                const f32x4* e4 = (const f32x4*)(wre + (size_t)k * 32);
#pragma unroll
                for (int q = 0; q < 8; ++q) { const f32x4 w4 = e4[q]; acc[4 + 4 * q] += xv * w4.x; acc[5 + 4 * q] += xv * w4.y; acc[6 + 4 * q] += xv * w4.z; acc[7 + 4 * q] += xv * w4.w; }
            }
        }
#pragma unroll
        for (int j = 0; j < 36; ++j) acc[j] = wave_sum(acc[j]);
        if (lane == 0) {
            float gl[4]; int gt = 0;
#pragma unroll
            for (int j = 0; j < 4; ++j) gl[j] = acc[j] + brg[j];
            float gmax = gl[0];
#pragma unroll
            for (int j = 1; j < 4; ++j) if (gl[j] > gmax) { gmax = gl[j]; gt = j; }
            float gs = 0.f;
#pragma unroll
            for (int j = 0; j < 4; ++j) gs += expf(gl[j] - gmax);
            const float gw = 1.0f / gs;
            float el[8];
#pragma unroll
            for (int j = 0; j < 8; ++j) { float vv = 0.f;
#pragma unroll
                for (int g = 0; g < 4; ++g) if (g == gt) vv = acc[4 + g * 8 + j] + bre[g * 8 + j];
                el[j] = vv; }
            int i0 = 0; float m0 = el[0];
#pragma unroll
            for (int j = 1; j < 8; ++j) if (el[j] > m0) { m0 = el[j]; i0 = j; }
            int i1 = -1; float m1 = -INFINITY;
#pragma unroll
            for (int j = 0; j < 8; ++j) if (j != i0 && el[j] > m1) { m1 = el[j]; i1 = j; }
            const float e1 = expf(m1 - m0);
            const float w0 = gw / (1.0f + e1), w1 = gw * e1 / (1.0f + e1);
            const int e0i = gt * 8 + i0, e1i = gt * 8 + i1;
            K.eid()[2 * t] = e0i; K.eid()[2 * t + 1] = e1i; K.ew()[2 * t] = w0; K.ew()[2 * t + 1] = w1;
            atomicAdd(&cnt[e0i], 1); atomicAdd(&cnt[e1i], 1);
        }
    }
}
constexpr int RT_PART = 0, RT_SS = RT_PART + 2 * 4 * 16 * 48 * 4, RT_RS = RT_SS + 2 * 4 * 16 * 4, RT_HIST = RT_RS + 2 * 16 * 4;
__device__ __forceinline__ void phase_norm_router_mfma(Frame& F, int l) {
    const KA K = KA::fresh(); PHASE_TID;
    LAS unsigned char* lds = F.lds;
    const int fr = lane & 15, fq = lane >> 4, tl = wave >> 2, kq = wave & 3;
    const bf16* Whi = K.Wr() + (size_t)l * 2 * 48 * D; const bf16* Wlo = Whi + 48 * D;
    const float* gain = K.in(11) + (size_t)l * D;
#pragma unroll 1
    for (int blk = F.bx; blk < T / 64; blk += F.G) {
        __syncthreads();
        if (tid < NE) ((LAS int*)(lds + RT_HIST))[tid] = 0;
#pragma unroll 1
        for (int half = 0; half < 2; ++half) {
            const int tok0 = blk * 64 + half * 32 + tl * 16;
            const float* xr = K.out() + (size_t)(tok0 + fr) * D + 256 * kq + 8 * fq;
            const bf16* whi = Whi + (size_t)fr * D + 256 * kq + 8 * fq; const bf16* wlo = Wlo + (size_t)fr * D + 256 * kq + 8 * fq;
            f32x4 acc[3];
#pragma unroll
            for (int nt = 0; nt < 3; ++nt) acc[nt] = (f32x4){0.f, 0.f, 0.f, 0.f};
            float ss = 0.f;
            f32x4 xa[8], xb[8];
            bf16x8 Wh[3][3], Wl[3][3];
#define RT_LOADW(slot, ks) do { _Pragma("unroll") for (int nt = 0; nt < 3; ++nt) { Wh[slot][nt] = *(const bf16x8*)(whi + (size_t)(16 * nt) * D + 32 * (ks)); Wl[slot][nt] = *(const bf16x8*)(wlo + (size_t)(16 * nt) * D + 32 * (ks)); } } while (0)
#pragma unroll
            for (int ks = 0; ks < 8; ++ks) { xa[ks] = *(const f32x4*)(xr + 32 * ks); xb[ks] = *(const f32x4*)(xr + 32 * ks + 4); }
            RT_LOADW(0, 0); RT_LOADW(1, 1); RT_LOADW(2, 2);
#pragma unroll
            for (int ks = 0; ks < 8; ++ks) {
                __builtin_amdgcn_sched_barrier(0);
                const f32x4 x0 = xa[ks], x1 = xb[ks];
                const float xv[8] = {x0.x, x0.y, x0.z, x0.w, x1.x, x1.y, x1.z, x1.w};
                unsigned hw[4], lw[4];
#pragma unroll
                for (int j = 0; j < 4; ++j) { const float a = xv[2 * j], b2 = xv[2 * j + 1]; ss += a * a + b2 * b2;
                    const unsigned hp2 = pk2(a, b2); hw[j] = hp2; lw[j] = pk2(a - bflo(hp2), b2 - bfhi(hp2)); }
                bf16x8 Ah, Al; { v4u t4 = (v4u){hw[0], hw[1], hw[2], hw[3]}; Ah = __builtin_bit_cast(bf16x8, t4); t4 = (v4u){lw[0], lw[1], lw[2], lw[3]}; Al = __builtin_bit_cast(bf16x8, t4); }
#pragma unroll
                for (int nt = 0; nt < 3; ++nt) { acc[nt] = mfma16(Ah, Wh[ks % 3][nt], acc[nt]); acc[nt] = mfma16(Al, Wh[ks % 3][nt], acc[nt]); acc[nt] = mfma16(Ah, Wl[ks % 3][nt], acc[nt]); }
                __builtin_amdgcn_sched_barrier(0);
                if (ks + 3 < 8) RT_LOADW(ks % 3, ks + 3);
            }
#undef RT_LOADW
            ss += shx(ss, 16); ss += shx(ss, 32);
            {
                LAS float* part = (LAS float*)(lds + RT_PART) + (tl * 4 + kq) * 16 * 48;
#pragma unroll
                for (int nt = 0; nt < 3; ++nt)
#pragma unroll
                    for (int r = 0; r < 4; ++r) part[(4 * fq + r) * 48 + 16 * nt + fr] = acc[nt][r];
                if (fq == 0) ((LAS float*)(lds + RT_SS))[(tl * 4 + kq) * 16 + fr] = ss;
            }
            __syncthreads();
            if (kq < 2) {
                const int tt = kq * 8 + (lane >> 3), j = lane & 7, t = tok0 + tt;
                const LAS float* p0 = (const LAS float*)(lds + RT_PART) + (tl * 4) * 16 * 48 + tt * 48;
                const LAS float* s2 = (const LAS float*)(lds + RT_SS) + (tl * 4) * 16 + tt;
                const float rs = rsqrtf(((s2[0] + s2[16]) + (s2[32] + s2[48])) * (1.f / D) + EPS);
#define RT_DOT(n) ((p0[(n)] + p0[768 + (n)]) + (p0[1536 + (n)] + p0[2304 + (n)]))
                float gv = (j < 4) ? RT_DOT(j & 3) * rs + K.in(13)[(size_t)l * 4 + (j & 3)] : -INFINITY; int gi = j;
                const float gmine = gv;
#pragma unroll
                for (int o = 1; o < 8; o <<= 1) { const float ov = shx(gv, o); const int oi = __float_as_int(shx(__int_as_float(gi), o)); if (ov > gv || (ov == gv && oi < gi)) { gv = ov; gi = oi; } }
                float ge = (j < 4) ? expf(gmine - gv) : 0.f;
#pragma unroll
                for (int o = 1; o < 8; o <<= 1) ge += shx(ge, o);
                const float gw = 1.0f / ge; const int gt = gi;
                const float ev = RT_DOT(4 + gt * 8 + j) * rs + K.in(15)[(size_t)l * 32 + gt * 8 + j];
#undef RT_DOT
                float m0 = ev; int i0 = j;
#pragma unroll
                for (int o = 1; o < 8; o <<= 1) { const float ov = shx(m0, o); const int oi = __float_as_int(shx(__int_as_float(i0), o)); if (ov > m0 || (ov == m0 && oi < i0)) { m0 = ov; i0 = oi; } }
                float m1 = (j == i0) ? -INFINITY : ev; int i1 = j;
#pragma unroll
                for (int o = 1; o < 8; o <<= 1) { const float ov = shx(m1, o); const int oi = __float_as_int(shx(__int_as_float(i1), o)); if (ov > m1 || (ov == m1 && oi < i1)) { m1 = ov; i1 = oi; } }
                if (j == 0) {
                    ((LAS float*)(lds + RT_RS))[tl * 16 + tt] = rs;
                    const float e1 = expf(m1 - m0);
                    const float w0 = gw / (1.0f + e1), w1 = gw * e1 / (1.0f + e1);
                    const int e0i = gt * 8 + i0, e1i = gt * 8 + i1;
                    K.eid()[2 * t] = e0i; K.eid()[2 * t + 1] = e1i; K.ew()[2 * t] = w0; K.ew()[2 * t + 1] = w1;
                    LAS int* hist = (LAS int*)(lds + RT_HIST);
                    K.slot_of()[2 * t] = __hip_atomic_fetch_add(hist + e0i, 1, __ATOMIC_RELAXED, __HIP_MEMORY_SCOPE_WORKGROUP);
                    K.slot_of()[2 * t + 1] = __hip_atomic_fetch_add(hist + e1i, 1, __ATOMIC_RELAXED, __HIP_MEMORY_SCOPE_WORKGROUP);
                }
            }
            __syncthreads();
            {
                const float rs = ((const LAS float*)(lds + RT_RS))[tl * 16 + fr];
                bf16* hp = K.XN() + (size_t)(tok0 + fr) * D + 256 * kq + 8 * fq;
                const float* gp = gain + 256 * kq + 8 * fq;
#pragma unroll
                for (int ks = 0; ks < 8; ++ks) {
                    const f32x4 x0 = xa[ks], x1 = xb[ks];
                    const f32x4 g0 = *(const f32x4*)(gp + 32 * ks), g1 = *(const f32x4*)(gp + 32 * ks + 4);
                    *(v4u*)(hp + 32 * ks) = (v4u){pk2(x0.x * rs * g0.x, x0.y * rs * g0.y), pk2(x0.z * rs * g0.z, x0.w * rs * g0.w), pk2(x1.x * rs * g1.x, x1.y * rs * g1.y), pk2(x1.z * rs * g1.z, x1.w * rs * g1.w)};
                }
            }
        }
        __syncthreads();
        if (tid < NE) K.blkcnt()[(size_t)(l * (T / 64) + blk) * NE + tid] = ((LAS int*)(lds + RT_HIST))[tid];
    }
}
__device__ __forceinline__ void phase_scatter(Frame& F, int l) {
    const KA K = KA::fresh(); PHASE_TID;
    LAS int* sm = (LAS int*)F.lds;
    const int* bc = K.blkcnt() + (size_t)l * (T / 64) * NE;
    constexpr int NBLK = T / 64;
#pragma unroll 1
    for (int blk = F.bx; blk < NBLK; blk += F.G) {
        __syncthreads();
        {   const int e = tid & 31, part = tid >> 5;
            int tot = 0, pre = 0;
#pragma unroll
            for (int j = 0; j < NBLK / 16; ++j) { const int bb = part * (NBLK / 16) + j; const int c = bc[bb * NE + e]; tot += c; if (bb < blk) pre += c; }
            sm[part * 32 + e] = tot; sm[512 + part * 32 + e] = pre; }
        __syncthreads();
        if (tid < 32) { int tot = 0, pre = 0;
#pragma unroll
            for (int p = 0; p < 16; ++p) { tot += sm[p * 32 + tid]; pre += sm[512 + p * 32 + tid]; }
            sm[1056 + tid] = tot; sm[1024 + tid] = pre; }
        __syncthreads();
        if (tid == 0) { int a = 0; for (int e = 0; e < NE; ++e) { const int c = sm[1056 + e]; sm[1024 + e] += a; a += c; } }
        if (blk == 0 && tid < 32) ((int*)(K.ctl() + CW_CNT + 64 * l))[tid] = sm[1056 + tid];
        __syncthreads();
        if (tid < 128) { const int a = blk * 128 + tid; const int e = K.eid()[a]; const int pos = sm[1024 + e] + K.slot_of()[a]; K.slot_tok()[pos] = a >> 1; K.slot_of()[a] = pos; }
    }
    __syncthreads();
}
template <bool DUAL>
__device__ __forceinline__ void gemm_core(const bf16* A, const int* rowoff, int K, const float* B0, const float* B1, int ldb, int n0,
                                          float (&acc0)[4][4], float (&acc1)[4][4], float* As, float* Bs0, float* Bs1) {
    const int tid = __builtin_amdgcn_readfirstlane(threadIdx.x >> 6) * 64 + fresh_lane(), tx = tid & 15, ty = tid >> 4;
    const int ar = tid >> 2, ak = (tid & 3) * 4;
    const int bk = (tid >> 4) & 15, bn = (tid & 15) * 4;
    const long aoff = rowoff[ar];
#pragma unroll
    for (int i = 0; i < 4; ++i)
#pragma unroll
        for (int j = 0; j < 4; ++j) { acc0[i][j] = 0.f; acc1[i][j] = 0.f; }
#pragma unroll 1
    for (int k0 = 0; k0 < K; k0 += 16) {
        v2u av = (v2u){0u, 0u};
        if (aoff >= 0) av = *(const v2u*)(A + aoff + k0 + ak);
        f32x4 bv0 = (f32x4){0.f, 0.f, 0.f, 0.f}, bv1 = bv0;
        if (tid < 256) { bv0 = *(const f32x4*)(B0 + (size_t)(k0 + bk) * ldb + n0 + bn); if (DUAL) bv1 = *(const f32x4*)(B1 + (size_t)(k0 + bk) * ldb + n0 + bn); }
        __syncthreads();
        As[(ak + 0) * 132 + ar] = bflo(av.x); As[(ak + 1) * 132 + ar] = bfhi(av.x); As[(ak + 2) * 132 + ar] = bflo(av.y); As[(ak + 3) * 132 + ar] = bfhi(av.y);
        if (tid < 256) { *(f32x4*)(Bs0 + bk * 64 + bn) = bv0; if (DUAL) *(f32x4*)(Bs1 + bk * 64 + bn) = bv1; }
        __syncthreads();
#pragma unroll
        for (int kk = 0; kk < 16; ++kk) {
            const f32x4 a4 = *(const f32x4*)(As + kk * 132 + ty * 4);
            const f32x4 b4 = *(const f32x4*)(Bs0 + kk * 64 + tx * 4);
#pragma unroll
            for (int i = 0; i < 4; ++i)
#pragma unroll
                for (int j = 0; j < 4; ++j) acc0[i][j] += a4[i] * b4[j];
            if (DUAL) {
                const f32x4 c4 = *(const f32x4*)(Bs1 + kk * 64 + tx * 4);
#pragma unroll
                for (int i = 0; i < 4; ++i)
#pragma unroll
                    for (int j = 0; j < 4; ++j) acc1[i][j] += a4[i] * c4[j];
            }
        }
    }
}
template <int MODE>
__device__ __forceinline__ void phase_moe_ref(Frame& F, int l) {
    const KA K = KA::fresh(); PHASE_TID;
    float* As = F.smem; float* Bs0 = F.smem + 16 * 132; float* Bs1 = Bs0 + 16 * 64; int* rowoff = (int*)(Bs1 + 16 * 64); int* offs = rowoff + 128; int* toff = offs + 33;
    int* cnt = (int*)(K.ctl() + CW_CNT + 64 * l);
    const int tx = tid & 15, ty = tid >> 4;
    __syncthreads();
    if (tid == 0) { int a = 0, tt = 0; for (int e = 0; e < NE; ++e) { offs[e] = a; toff[e] = tt; const int c = cnt[e]; a += c; tt += (c + 127) / 128; } offs[NE] = a; toff[NE] = tt; }
    __syncthreads();
    constexpr int N = (MODE == 1) ? DE : D, KD = (MODE == 1) ? D : DE, NTN = N / 64;
    const int ntiles = toff[NE] * NTN;
#pragma unroll 1
    for (int t = F.bx; t < ntiles; t += F.G) {
        const int rt = t / NTN, tn = t % NTN;
        int e = 0;
        for (int j = 1; j < NE; ++j) if (toff[j] <= rt) e = j;
        const int r0 = offs[e] + (rt - toff[e]) * 128, rend = offs[e + 1];
        __syncthreads();
        if (tid < 128) { const int r = r0 + tid; rowoff[tid] = (r < rend) ? ((MODE == 1) ? K.slot_tok()[r] * D : r * DE) : -1; }
        __syncthreads();
        float acc0[4][4], acc1[4][4];
        if (MODE == 1) {
            const float* Wg = K.in(16) + ((size_t)l * NE + e) * D * DE; const float* Wu = K.in(17) + ((size_t)l * NE + e) * D * DE;
            gemm_core<true>(K.XN(), rowoff, KD, Wg, Wu, DE, tn * 64, acc0, acc1, As, Bs0, Bs1);
        } else {
            const float* Wd = K.in(18) + ((size_t)l * NE + e) * DE * D;
            gemm_core<false>(K.H1(), rowoff, KD, Wd, nullptr, D, tn * 64, acc0, acc1, As, Bs0, nullptr);
        }
#pragma unroll
        for (int i = 0; i < 4; ++i) {
            const int r = r0 + ty * 4 + i;
            if (r < rend) {
                v2u o;
                if (MODE == 1) { o.x = pk2(silu(acc0[i][0]) * acc1[i][0], silu(acc0[i][1]) * acc1[i][1]); o.y = pk2(silu(acc0[i][2]) * acc1[i][2], silu(acc0[i][3]) * acc1[i][3]);
                    *(v2u*)(K.H1() + (size_t)r * DE + tn * 64 + tx * 4) = o; }
                else { o.x = pk2(acc0[i][0], acc0[i][1]); o.y = pk2(acc0[i][2], acc0[i][3]); *(v2u*)(K.Y() + (size_t)r * D + tn * 64 + tx * 4) = o; }
            }
        }
    }
    __syncthreads();
}

constexpr int TAB_OFF = LDSCTL_OFF + 1024;
__device__ __forceinline__ void moe_tables(Frame& F, int l) {
    const KA K = KA::fresh(); PHASE_TID;
    LAS int* tab = (LAS int*)(F.lds + TAB_OFF); LAS int* offs = tab + 4 + 4 * 164; LAS int* fpre = offs + 40; LAS int* ppre = fpre + 40;
    const int* cnt = (const int*)(K.ctl() + CW_CNT + 64 * l);
    __syncthreads();
    if (tid == 0) { int a = 0, f = 0, p = 0; for (int e = 0; e < NE; ++e) { const int c = cnt[e]; offs[e] = a; fpre[e] = f; ppre[e] = p; a += c; f += c >> 8; p += (c & 255) ? 1 : 0; }
        offs[NE] = a; fpre[NE] = f; ppre[NE] = p; tab[0] = f + p; }
    __syncthreads();
    const int nfull = fpre[NE], ntile = nfull + ppre[NE];
    if (tid < nfull) { int e = 0; for (int j = 1; j < NE; ++j) if (fpre[j] <= tid) e = j; tab[4 + 4 * tid] = e; tab[5 + 4 * tid] = offs[e] + (tid - fpre[e]) * 256; tab[6 + 4 * tid] = offs[e + 1]; }
    else if (tid < nfull + NE) {
        const int e = tid - nfull, rows = (offs[e + 1] - offs[e]) & 255;
        if (rows) { int rank = 0; for (int j = 0; j < NE; ++j) { const int rj = (offs[j + 1] - offs[j]) & 255; rank += (rj > rows || (rj == rows && j < e)) ? 1 : 0; }
            const int q = nfull + rank; tab[4 + 4 * q] = e; tab[5 + 4 * q] = offs[e] + (fpre[e + 1] - fpre[e]) * 256; tab[6 + 4 * q] = offs[e + 1]; }
    }
    __syncthreads();
    (void)ntile;
}
template <int SUB>
__device__ __forceinline__ void phase_moe(Frame& F, int l) {
    if (SUB == 0) moe_tables(F, l);
    const KA K = KA::fresh();
    int c_ = F.bx; asm volatile("" : "+s"(c_));
    const int G = F.G, c = (c_ & 7) * (G >> 3) + (c_ >> 3);
    const LAS int* tab = (const LAS int*)(F.lds + TAB_OFF);
    const int ntile = __builtin_amdgcn_readfirstlane(tab[0]), ngu = 2 * ntile, nleft = ngu > G ? ngu - G : 0, jX = ngu > G ? (G >> 1) : ntile, W = G - nleft;
    const int yd = (jX * 4 < 2 * W) ? jX * 4 : 2 * W;
    bool do_gu = false, do_dn = false; pg8::MoeSched So{tab, 2, 0, 0, G, c};
    if (SUB == 0) { do_gu = true; So.npn = 2; So.first = 0; So.end = ngu < G ? ngu : G; So.stride = G; So.c = c; }
    if (SUB == 1) { if (c < nleft) { do_gu = true; So.npn = 2; So.first = G; So.end = ngu; So.stride = G; So.c = c; }
                    else { do_dn = true; So.npn = 4; So.first = 0; So.end = yd; So.stride = W; So.c = c - nleft; } }
    if (SUB == 2) { do_dn = true; So.npn = 4; So.first = yd; So.end = ntile * 4; So.stride = G; So.c = c; }
    if (do_gu) { pg8::EpiMoeH E{K.H1()};
        pg8::gemm_phase_moe<pg8::EpiMoeH, pg8::MoeSched, true, 512, D>(F.lds, K.XN(), K.WguT() + (size_t)l * NE * 512 * D, K.slot_tok(), So, E, F.wave); }
    if (do_dn) { pg8::EpiMoeY E{K.Y()};
        pg8::gemm_phase_moe<pg8::EpiMoeY, pg8::MoeSched, false, D, DE>(F.lds, K.H1(), K.WdT() + (size_t)l * NE * D * DE, nullptr, So, E, F.wave); }
}
__device__ __forceinline__ void phase_combine(Frame& F, int l) {
    const KA K = KA::fresh(); PHASE_TID;
    const bool last = (l == DEPTH - 1);
    const float* gain = last ? K.in(19) : (K.in(1) + (size_t)(l + 1) * D);
#pragma unroll 1
    for (int t = F.bx * NWAVES + wave; t < T; t += F.G * NWAVES) {
        const int s0 = K.slot_of()[2 * t], s1 = K.slot_of()[2 * t + 1]; const float w0 = K.ew()[2 * t], w1 = K.ew()[2 * t + 1];
        f32x4* xr = (f32x4*)(K.out() + (size_t)t * D) + lane;
        const v2u* y0 = (const v2u*)(K.Y() + (size_t)s0 * D) + lane; const v2u* y1 = (const v2u*)(K.Y() + (size_t)s1 * D) + lane;
        f32x4 v[4]; float s = 0.f;
#pragma unroll
        for (int j = 0; j < 4; ++j) { v[j] = xr[64 * j]; const v2u a = y0[64 * j], b = y1[64 * j];
            v[j].x += w0 * bflo(a.x) + w1 * bflo(b.x); v[j].y += w0 * bfhi(a.x) + w1 * bfhi(b.x); v[j].z += w0 * bflo(a.y) + w1 * bflo(b.y); v[j].w += w0 * bfhi(a.y) + w1 * bfhi(b.y);
            s += (v[j].x * v[j].x + v[j].y * v[j].y) + (v[j].z * v[j].z + v[j].w * v[j].w); }
        const float rs = rsqrtf(wave_sum(s) * (1.f / D) + EPS);
        if (last) {
#pragma unroll
            for (int j = 0; j < 4; ++j) { const f32x4 g = ((const f32x4*)gain)[lane + 64 * j]; xr[64 * j] = (f32x4){v[j].x * rs * g.x, v[j].y * rs * g.y, v[j].z * rs * g.z, v[j].w * rs * g.w}; }
        } else {
            v2u* o8 = (v2u*)(K.XN() + (size_t)t * D) + lane;
#pragma unroll
            for (int j = 0; j < 4; ++j) { xr[64 * j] = v[j]; const f32x4 g = ((const f32x4*)gain)[lane + 64 * j];
                v2u w; w.x = pk2(v[j].x * rs * g.x, v[j].y * rs * g.y); w.y = pk2(v[j].z * rs * g.z, v[j].w * rs * g.w); o8[64 * j] = w; }
        }
    }
}

struct Args { const float* in[20]; float* out; unsigned char* ws; };
__global__ void __launch_bounds__(NT, 2) fwd_kernel(Args args) {
    extern __shared__ __attribute__((aligned(16))) unsigned char lds_raw[];
    Frame F;
    F.lds = (LAS unsigned char*)lds_raw; F.smem = (float*)lds_raw;
    F.G = gridDim.x; F.bx = blockIdx.x; F.wave = __builtin_amdgcn_readfirstlane(threadIdx.x >> 6);
    volatile LAS unsigned* MISC = (volatile LAS unsigned*)(F.lds + MISC_OFF);
    for (int u = threadIdx.x; u < (LDS_BYTES - LDSCTL_OFF) / 4; u += NT) ((LAS unsigned*)(F.lds + LDSCTL_OFF))[u] = 0u;
    __syncthreads();
    XcdBarrier bar; { const KA K = KA::fresh(); bar = xcd_barrier_post(K.ctl() + CW_BAR, MISC + 8); }
#define GRID_BAR() xcd_barrier(bar)

    p0_prologue(F);
    GRID_BAR();
    for (int l = 0; l < DEPTH; ++l) {
        {
            const KA K = KA::fresh(); PHASE_TID;
            pg8::Gemm g{K.XN(), K.WinT() + (size_t)l * PLD * D, T, PLD, D}; pg8::StaticOrder So; int c_ = F.bx; asm volatile("" : "+s"(c_)); So.init(T, PLD, F.G, c_);
            pg8::EpiBf16Plain E{K.P(), PLD};
            pg8::gemm_phase<pg8::EpiBf16Plain, pg8::StaticOrder, PG8_ALIGN, PG8_SP2>(F.lds, g, So, E, F.wave);
        }
        GRID_BAR();
        phase_gla_A2(F, l);
        phase_gmlp_mfma(F, l);
        phase_conv(F, l);
        GRID_BAR();
        phase_gla_aggscan(F);
        GRID_BAR();
        phase_gla_C2(F, l);
        GRID_BAR();
        {
            const KA K = KA::fresh(); PHASE_TID;
            pg8::Gemm g{K.XN(), K.WoutT() + (size_t)l * D * D, T, D, D}; pg8::StaticOrder So; int c_ = F.bx; asm volatile("" : "+s"(c_)); So.init(T, D, F.G, c_);
            pg8::EpiF32Res E{K.out(), (l == 0) ? K.in(0) : K.out(), D};
            pg8::gemm_phase<pg8::EpiF32Res, pg8::StaticOrder, PG8_ALIGN, PG8_SP2>(F.lds, g, So, E, F.wave);
        }
        GRID_BAR();
        phase_norm_router_mfma(F, l);
        GRID_BAR();
        phase_scatter(F, l);
        GRID_BAR();
        phase_moe<0>(F, l);
        GRID_BAR();
        phase_moe<1>(F, l);
        GRID_BAR();
        phase_moe<2>(F, l);
        GRID_BAR();
        phase_combine(F, l);
        if (l + 1 < DEPTH) GRID_BAR();
    }
}

extern "C" void kernel_launch(void* const* d_in, const int* in_sizes, int n_in, void* d_out, int out_size, void* d_ws, size_t ws_size, hipStream_t stream) {
    static int grid_blocks = 0;
    if (!grid_blocks) {
        int dev = 0, cus = 0, per_cu = 0;
        (void)hipGetDevice(&dev);
        (void)hipDeviceGetAttribute(&cus, hipDeviceAttributeMultiprocessorCount, dev);
        (void)hipFuncSetAttribute((const void*)fwd_kernel, hipFuncAttributeMaxDynamicSharedMemorySize, LDS_BYTES);
        (void)hipOccupancyMaxActiveBlocksPerMultiprocessor(&per_cu, fwd_kernel, NT, LDS_BYTES);
        if (per_cu < 1) { fprintf(stderr, "kernel_launch: occupancy query says %d blocks/CU\n", per_cu); per_cu = 1; }
        grid_blocks = cus;
        if (ws_size < WS_END) { fprintf(stderr, "kernel_launch: workspace too small (%zu < %zu)\n", ws_size, (size_t)WS_END); grid_blocks = -1; }
    }
    if (grid_blocks < 0) return;
    (void)hipMemsetAsync((char*)d_ws + WS_CTL, 0, CTL_BYTES, stream);
    Args a{};
    for (int i = 0; i < 20; ++i) a.in[i] = (const float*)d_in[i];
    a.out = (float*)d_out; a.ws = (unsigned char*)d_ws;
    void* args[] = {&a};
    hipError_t e = hipLaunchCooperativeKernel((void*)fwd_kernel, dim3(grid_blocks), dim3(NT), args, LDS_BYTES, stream);
    if (e != hipSuccess) fprintf(stderr, "cooperative launch failed: %s (grid %d)\n", hipGetErrorString(e), grid_blocks);
}
```

```cpp
#include <hip/hip_runtime.h>
#include <hip/hip_cooperative_groups.h>
#include <cstdio>
#include <cstdint>
namespace cg = cooperative_groups;
__device__ __forceinline__ int fresh_lane() { unsigned m = 0xffffffffu; asm volatile("" : "+s"(m)); return (int)__builtin_amdgcn_mbcnt_hi(m, __builtin_amdgcn_mbcnt_lo(m, 0u)); }
__device__ __forceinline__ float shx(float v, int o) { return __int_as_float(__builtin_amdgcn_ds_bpermute((fresh_lane() ^ o) << 2, __float_as_int(v))); }
namespace pg8 {
#define PG8_LAS __attribute__((address_space(3)))
typedef unsigned short bf16_t;
typedef short bf16x8 __attribute__((ext_vector_type(8)));
typedef float f32x4 __attribute__((ext_vector_type(4)));
typedef unsigned u32x4 __attribute__((ext_vector_type(4)));
constexpr int BM = 256, BK = 64, HALF = 128, HTB = HALF * BK * 2  , STAGE_BYTES = 8 * HTB, NXCD = 8, WGM = 8;

__host__ __device__ __forceinline__ int lds_byte(int r, int c) { const int st = (r >> 4) * 2 + (c >> 5), rr = r & 15, cc = c & 31, ob = rr * 64 + cc * 2; return st * 1024 + (ob ^ (((ob >> 9) & 1) << 5)); }
__host__ __device__ __forceinline__ void stage_rc(int b, int& R, int& C) { const int st = b / 1024, sb = b % 1024, swz = sb ^ (((sb >> 9) & 1) << 5); R = (st >> 1) * 16 + swz / 64; C = (st & 1) * 32 + (swz % 64) / 2; }
__host__ __device__ __forceinline__ int perm32(int rho) { const int n = rho >> 4, i = rho & 15; return 8 * (i >> 2) + 4 * n + (i & 3); }

struct Unit { int pm, pn; };
struct Gemm { const bf16_t* A; const bf16_t* Bt; int M, N, K; };

struct StaticOrder {
    int nM, nN, nwg, G, c;
    __host__ __device__ void init(int M, int N, int G_, int c_) { nM = M / BM; nN = N / BM; nwg = nM * nN; G = G_; c = c_; }
    __host__ __device__ bool next(int i, Unit& u) const {
        const long L = (long)i * G + c; if (L >= nwg) return false;
        int wgid = (int)L; { const int q = nwg / NXCD, r = nwg % NXCD, xcd = wgid % NXCD, off = wgid / NXCD; wgid = (xcd < r ? xcd * (q + 1) : r * (q + 1) + (xcd - r) * q) + off; }
        const int nig = WGM * nN, gid = wgid / nig, fm = gid * WGM, gsz = (nM - fm) < WGM ? (nM - fm) : WGM;
        u.pm = fm + ((wgid % nig) % gsz); u.pn = (wgid % nig) / gsz; return true;
    }
    __device__ __forceinline__ void a_ready(const Unit&) const {}
    __device__ __forceinline__ void done(const Unit&) const {}
};


__device__ __forceinline__ unsigned cvt_pk_bf16(float lo, float hi) { unsigned r; asm volatile("v_cvt_pk_bf16_f32 %0, %1, %2" : "=v"(r) : "v"(lo), "v"(hi)); return r; }
struct EpiBf16Plain {
    static constexpr bool PERM = true, AFTER_DRAIN = false;
    bf16_t* O; int ldc;
    __device__ __forceinline__ void operator()(const f32x4 (&acc)[2][2][4][2], const Unit& u, int wr, int wc, int fr, int fq) const {
        const int row0 = u.pm * BM + wr * 64 + fr, col0 = u.pn * BM + wc * 32 + 8 * fq;
#pragma unroll
        for (int ai = 0; ai < 2; ++ai)
#pragma unroll
            for (int m = 0; m < 4; ++m) { bf16_t* rowp = O + (size_t)(row0 + ai * HALF + m * 16) * ldc + col0;
#pragma unroll
                for (int bj = 0; bj < 2; ++bj) { const f32x4 v0 = acc[ai][bj][m][0], v1 = acc[ai][bj][m][1];
                    u32x4 w; w.x = cvt_pk_bf16(v0[0], v0[1]); w.y = cvt_pk_bf16(v0[2], v0[3]); w.z = cvt_pk_bf16(v1[0], v1[1]); w.w = cvt_pk_bf16(v1[2], v1[3]);
                    *(u32x4*)(rowp + bj * HALF) = w; } }
    }
};
template <bool RES_F32>
struct EpiBf16Res {
    static constexpr bool PERM = true, AFTER_DRAIN = false;
    bf16_t* O; const void* R; int ldc;
    __device__ __forceinline__ void operator()(const f32x4 (&acc)[2][2][4][2], const Unit& u, int wr, int wc, int fr, int fq) const {
        const int row0 = u.pm * BM + wr * 64 + fr, col0 = u.pn * BM + wc * 32 + 8 * fq;
#pragma unroll
        for (int ai = 0; ai < 2; ++ai)
#pragma unroll
            for (int m = 0; m < 4; ++m) { const size_t off = (size_t)(row0 + ai * HALF + m * 16) * ldc + col0;
#pragma unroll
                for (int bj = 0; bj < 2; ++bj) { f32x4 v0 = acc[ai][bj][m][0], v1 = acc[ai][bj][m][1];
                    if (RES_F32) { const float* rp = (const float*)R + off + bj * HALF; v0 += *(const f32x4*)rp; v1 += *(const f32x4*)(rp + 4); }
                    else { const u32x4 rw = *(const u32x4*)((const bf16_t*)R + off + bj * HALF);
                        v0[0] += __uint_as_float(rw.x << 16); v0[1] += __uint_as_float(rw.x & 0xffff0000u); v0[2] += __uint_as_float(rw.y << 16); v0[3] += __uint_as_float(rw.y & 0xffff0000u);
                        v1[0] += __uint_as_float(rw.z << 16); v1[1] += __uint_as_float(rw.z & 0xffff0000u); v1[2] += __uint_as_float(rw.w << 16); v1[3] += __uint_as_float(rw.w & 0xffff0000u); }
                    u32x4 w; w.x = cvt_pk_bf16(v0[0], v0[1]); w.y = cvt_pk_bf16(v0[2], v0[3]); w.z = cvt_pk_bf16(v1[0], v1[1]); w.w = cvt_pk_bf16(v1[2], v1[3]);
                    *(u32x4*)(O + off + bj * HALF) = w; } }
    }
};
struct EpiF32Res {
    static constexpr bool PERM = false, AFTER_DRAIN = false;
    float* C; const float* R; int ldc;
    __device__ __forceinline__ void operator()(const f32x4 (&acc)[2][2][4][2], const Unit& u, int wr, int wc, int fr, int fq) const {
        const int row0 = u.pm * BM + wr * 64 + fr, col0 = u.pn * BM + wc * 32 + 4 * fq;
#pragma unroll
        for (int ai = 0; ai < 2; ++ai)
#pragma unroll
            for (int m = 0; m < 4; ++m) { const size_t off = (size_t)(row0 + ai * HALF + m * 16) * ldc + col0;
#pragma unroll
                for (int bj = 0; bj < 2; ++bj)
#pragma unroll
                    for (int n = 0; n < 2; ++n) { const f32x4 r = *(const f32x4*)(R + off + bj * HALF + n * 16); *(f32x4*)(C + off + bj * HALF + n * 16) = r + acc[ai][bj][m][n]; } }
    }
};
template <class Epi, class Sched, bool ALIGN_EPI = false, bool SP2 = false>
__device__ __forceinline__ void gemm_phase(PG8_LAS unsigned char* lds, const Gemm g, const Sched& S, const Epi& E, int wave_id) {
    asm volatile("" : "+s"(wave_id));
    const int lane = fresh_lane(), wid = wave_id, tid = wid * 64 + lane, wr = wid >> 2, wc = wid & 3, fr = lane & 15, fq = lane >> 4;
    const int K = g.K, nt = K / BK;
    unsigned voffA[2], voffB[2];
#pragma unroll
    for (int i = 0; i < 2; ++i) { int R, C; stage_rc(tid * 16 + i * 8192, R, C); const int Rb = Epi::PERM ? ((R & ~31) + perm32(R & 31)) : R;
        voffA[i] = (unsigned)(R * K + C) * 2u; voffB[i] = (unsigned)(Rb * K + C) * 2u; }
    const size_t kstep = (size_t)(BK * 2);
    const size_t hstep = (size_t)HALF * K * 2;
    const size_t tstep = 2 * hstep;
    const unsigned ldsw = (unsigned)wid * 1024u;
    const int aoff = lds_byte(wr * 64 + fr, fq * 8), boff = lds_byte(wc * 32 + fr, fq * 8);
#define PG8_SA(b, h) (((b) * 2 + (h)) * HTB)
#define PG8_SB(b, h) ((4 + (b) * 2 + (h)) * HTB)
#define PG8_STAGE(bufoff, gbase, voff) do { _Pragma("unroll") for (int _i = 0; _i < 2; ++_i) \
        __builtin_amdgcn_global_load_lds((const unsigned*)((const char*)(gbase) + (voff)[_i]), (PG8_LAS unsigned*)(lds + (bufoff) + ldsw + _i * 8192), 16, 0, 0); } while (0)
#define PG8_LDA(dst, b, h) do { _Pragma("unroll") for (int m = 0; m < 4; ++m) _Pragma("unroll") for (int k = 0; k < 2; ++k) dst[m][k] = *(const PG8_LAS bf16x8*)(lds + PG8_SA(b, h) + aoff + m * 2048 + k * 1024); } while (0)
#define PG8_LDB(dst, b, h) do { _Pragma("unroll") for (int n = 0; n < 2; ++n) _Pragma("unroll") for (int k = 0; k < 2; ++k) dst[n][k] = *(const PG8_LAS bf16x8*)(lds + PG8_SB(b, h) + boff + n * 2048 + k * 1024); } while (0)
#define PG8_MMA(ai, bj, At, Bt) do { __builtin_amdgcn_s_setprio(1); _Pragma("unroll") for (int m = 0; m < 4; ++m) _Pragma("unroll") for (int n = 0; n < 2; ++n) _Pragma("unroll") for (int k = 0; k < 2; ++k) \
        acc[ai][bj][m][n] = __builtin_amdgcn_mfma_f32_16x16x32_bf16(Bt[n][k], At[m][k], acc[ai][bj][m][n], 0, 0, 0); __builtin_amdgcn_s_setprio(0); } while (0)
#define PG8_WAIT_V(n) asm volatile("s_waitcnt vmcnt(" #n ")" ::: "memory")
#define PG8_WAIT_L(n) asm volatile("s_waitcnt lgkmcnt(" #n ")" ::: "memory")
#define PG8_BAR __builtin_amdgcn_s_barrier()
#define PG8_SCHED __builtin_amdgcn_sched_barrier(0)
    Unit cur, nxt; int ui = 0;
    if (!S.next(0, cur)) return;
    f32x4 acc[2][2][4][2];
#pragma unroll
    for (int a = 0; a < 2; ++a)
#pragma unroll
        for (int b = 0; b < 2; ++b)
#pragma unroll
            for (int m = 0; m < 4; ++m)
#pragma unroll
                for (int n = 0; n < 2; ++n) acc[a][b][m][n] = (f32x4){0.f, 0.f, 0.f, 0.f};
    bf16x8 At[4][2], B0[2][2], B1[2][2];
    const char* cA = (const char*)g.A + (size_t)cur.pm * tstep; const char* cB = (const char*)g.Bt + (size_t)cur.pn * tstep;
    S.a_ready(cur);
    if constexpr (SP2) {
        PG8_STAGE(PG8_SB(0, 0), cB, voffB); PG8_STAGE(PG8_SB(0, 1), cB + hstep, voffB); PG8_STAGE(PG8_SA(0, 0), cA, voffA); PG8_STAGE(PG8_SA(0, 1), cA + hstep, voffA);
        if (wr == 1) PG8_BAR;
        PG8_WAIT_V(2); PG8_BAR;
        PG8_STAGE(PG8_SB(1, 0), cB + kstep, voffB); PG8_STAGE(PG8_SA(1, 0), cA + kstep, voffA); PG8_STAGE(PG8_SB(1, 1), cB + hstep + kstep, voffB);
        PG8_WAIT_V(6); PG8_BAR;
    } else {
        PG8_STAGE(PG8_SB(0, 0), cB, voffB); PG8_STAGE(PG8_SA(0, 0), cA, voffA); PG8_STAGE(PG8_SB(0, 1), cB + hstep, voffB); PG8_STAGE(PG8_SA(0, 1), cA + hstep, voffA);
        if (wr == 1) PG8_BAR;
        PG8_WAIT_V(4); PG8_BAR;
        PG8_STAGE(PG8_SB(1, 0), cB + kstep, voffB); PG8_STAGE(PG8_SA(1, 0), cA + kstep, voffA); PG8_STAGE(PG8_SB(1, 1), cB + hstep + kstep, voffB);
        PG8_WAIT_V(6); PG8_BAR;
    }
    for (;;) {
        const bool has_next = S.next(ui + 1, nxt);
        const char* nA = has_next ? (const char*)g.A + (size_t)nxt.pm * tstep : cA; const char* nB = has_next ? (const char*)g.Bt + (size_t)nxt.pn * tstep : cB;
        for (int t = 0; t < nt; t += 2) {
            const bool last = (t == nt - 2);
            const char* a1 = cA + (size_t)(t + 1) * kstep;
            const char* a2 = last ? nA : cA + (size_t)(t + 2) * kstep; const char* b2 = last ? nB : cB + (size_t)(t + 2) * kstep;
            const char* a3 = a2 + kstep; const char* b3 = b2 + kstep;
            if (last && has_next) S.a_ready(nxt);
            if constexpr (SP2) {
            PG8_LDB(B0, 0, 0); PG8_LDB(B1, 0, 1); PG8_SCHED; PG8_LDA(At, 0, 0); PG8_STAGE(PG8_SA(1, 1), a1 + hstep, voffA);
            PG8_WAIT_V(8); PG8_WAIT_L(0); PG8_BAR; PG8_MMA(0, 0, At, B0); PG8_MMA(0, 1, At, B1); PG8_BAR; PG8_SCHED;
            PG8_LDA(At, 0, 1); PG8_STAGE(PG8_SB(0, 0), b2, voffB); PG8_STAGE(PG8_SB(0, 1), b2 + hstep, voffB); PG8_STAGE(PG8_SA(0, 0), a2, voffA);
            PG8_WAIT_V(8); PG8_WAIT_L(0); PG8_BAR; PG8_MMA(1, 0, At, B0); PG8_MMA(1, 1, At, B1); PG8_BAR; PG8_SCHED;
            PG8_LDB(B0, 1, 0); PG8_LDB(B1, 1, 1); PG8_SCHED; PG8_LDA(At, 1, 0); PG8_STAGE(PG8_SA(0, 1), a2 + hstep, voffA);
            PG8_WAIT_V(8); PG8_WAIT_L(0); PG8_BAR; PG8_MMA(0, 0, At, B0); PG8_MMA(0, 1, At, B1); PG8_BAR; PG8_SCHED;
            PG8_LDA(At, 1, 1); PG8_STAGE(PG8_SB(1, 0), b3, voffB); PG8_STAGE(PG8_SB(1, 1), b3 + hstep, voffB); PG8_STAGE(PG8_SA(1, 0), a3, voffA);
            PG8_WAIT_V(8); PG8_WAIT_L(0); PG8_BAR; PG8_MMA(1, 0, At, B0); PG8_MMA(1, 1, At, B1); PG8_BAR; PG8_SCHED;
            } else {
            PG8_LDB(B0, 0, 0); PG8_SCHED; PG8_LDA(At, 0, 0); PG8_STAGE(PG8_SA(1, 1), a1 + hstep, voffA);
            PG8_WAIT_L(8); PG8_BAR; PG8_WAIT_L(0); PG8_MMA(0, 0, At, B0); PG8_BAR; PG8_SCHED;
            PG8_LDB(B1, 0, 1); PG8_STAGE(PG8_SB(0, 0), b2, voffB);
            PG8_BAR; PG8_WAIT_L(0); PG8_MMA(0, 1, At, B1); PG8_BAR;
            PG8_LDA(At, 0, 1); PG8_STAGE(PG8_SA(0, 0), a2, voffA);
            PG8_BAR; PG8_WAIT_L(0); PG8_MMA(1, 0, At, B0); PG8_BAR; PG8_SCHED;
            PG8_STAGE(PG8_SB(0, 1), b2 + hstep, voffB);
            PG8_WAIT_V(6); PG8_BAR; PG8_MMA(1, 1, At, B1); PG8_BAR;
            PG8_LDB(B0, 1, 0); PG8_SCHED; PG8_LDA(At, 1, 0); PG8_STAGE(PG8_SA(0, 1), a2 + hstep, voffA);
            PG8_WAIT_L(8); PG8_BAR; PG8_WAIT_L(0); PG8_MMA(0, 0, At, B0); PG8_BAR; PG8_SCHED;
            PG8_LDB(B1, 1, 1); PG8_STAGE(PG8_SB(1, 0), b3, voffB);
            PG8_BAR; PG8_WAIT_L(0); PG8_MMA(0, 1, At, B1); PG8_BAR;
            PG8_LDA(At, 1, 1); PG8_STAGE(PG8_SA(1, 0), a3, voffA);
            PG8_BAR; PG8_WAIT_L(0); PG8_MMA(1, 0, At, B0); PG8_BAR; PG8_SCHED;
            PG8_STAGE(PG8_SB(1, 1), b3 + hstep, voffB);
            PG8_WAIT_V(6); PG8_BAR; PG8_MMA(1, 1, At, B1); PG8_BAR;
            }
        }
        if constexpr (ALIGN_EPI) { if (wr == 0) PG8_BAR; }
        if constexpr (!Epi::AFTER_DRAIN) { E(acc, cur, wr, wc, fr, fq); S.done(cur); }
        if (!has_next) break;
#pragma unroll
        for (int a = 0; a < 2; ++a)
#pragma unroll
            for (int b = 0; b < 2; ++b)
#pragma unroll
                for (int m = 0; m < 4; ++m)
#pragma unroll
                    for (int n = 0; n < 2; ++n) acc[a][b][m][n] = (f32x4){0.f, 0.f, 0.f, 0.f};
        cur = nxt; cA = nA; cB = nB; ++ui;
        if constexpr (ALIGN_EPI) { if (wr == 1) PG8_BAR; }
    }
    PG8_WAIT_V(0);
    if constexpr (!ALIGN_EPI) { if (wr == 0) PG8_BAR; }
    PG8_BAR;
    if constexpr (Epi::AFTER_DRAIN) { E.fused(acc, cur, wr, wc, fr, fq, lds, wid, lane); S.done(cur); }
#undef PG8_SA
#undef PG8_SB
#undef PG8_STAGE
#undef PG8_LDA
#undef PG8_LDB
#undef PG8_MMA
#undef PG8_WAIT_V
#undef PG8_WAIT_L
#undef PG8_BAR
#undef PG8_SCHED
}

struct MUnit { int r0, rend, e, pn; };
#define MG_LANE_OFFS(u, o) do { const int _t = wid * 64 + fresh_lane(); _Pragma("unroll") for (int _i = 0; _i < 2; ++_i) { int _R, _C; stage_rc(_t * 16 + _i * 8192, _R, _C); _Pragma("unroll") for (int _h = 0; _h < 2; ++_h) { const int _r = (u).r0 + _h * HALF + _R; \
        int _row = _r; if (GATHER) { _row = 0; if (_r < (u).rend) _row = slot_tok[_r]; } (o)[_h][_i] = (unsigned)(_row * K + _C) * 2u; } } } while (0)
template <class Epi, class Sched, bool GATHER, int N, int K>
__device__ __forceinline__ void gemm_phase_moe(PG8_LAS unsigned char* lds, const bf16_t* A, const bf16_t* Bt, const int* slot_tok, const Sched& S, const Epi& E, int wave_id) {
    asm volatile("" : "+s"(wave_id));
    const int lane = fresh_lane(), wid = wave_id, tid = wid * 64 + lane, wr = wid >> 2, wc = wid & 3, fr = lane & 15, fq = lane >> 4;
    constexpr int nt = K / BK;
#define MG_OFFP(par) ((PG8_LAS unsigned*)(lds + STAGE_BYTES + 8192) + (par) * 2048 + tid)
#define MG_VOFFB ((PG8_LAS unsigned*)(lds + STAGE_BYTES + 24576) + tid)
#pragma unroll
    for (int i = 0; i < 2; ++i) { int R, C; stage_rc(tid * 16 + i * 8192, R, C); const int Rb = Epi::PERM ? ((R & ~31) + perm32(R & 31)) : R; MG_VOFFB[i * 512] = (unsigned)(Rb * K + C) * 2u; }
    constexpr size_t kstep = (size_t)(BK * 2);
    constexpr size_t hstep = (size_t)HALF * K * 2;
    constexpr size_t tstep = 2 * hstep;
    constexpr size_t estep = (size_t)N * K * 2;
    const unsigned ldsw = (unsigned)wid * 1024u;
    const int aoff = lds_byte(wr * 64 + fr, fq * 8), boff = lds_byte(wc * 32 + fr, fq * 8);
#define PG8_SA(b, h) (((b) * 2 + (h)) * HTB)
#define PG8_SB(b, h) ((4 + (b) * 2 + (h)) * HTB)
#define PG8_STAGE(bufoff, gbase, voff) do { _Pragma("unroll") for (int _i = 0; _i < 2; ++_i) \
        __builtin_amdgcn_global_load_lds((const unsigned*)((const char*)(gbase) + MG_VOFFB[_i * 512]), (PG8_LAS unsigned*)(lds + (bufoff) + ldsw + _i * 8192), 16, 0, 0); } while (0)
#define MG_STAGE_A(bufoff, par, h, kb) do { _Pragma("unroll") for (int _i = 0; _i < 2; ++_i) \
        __builtin_amdgcn_global_load_lds((const unsigned*)((const char*)A + (size_t)MG_OFFP(par)[((h) * 2 + _i) * 512] + (kb)), (PG8_LAS unsigned*)(lds + (bufoff) + ldsw + _i * 8192), 16, 0, 0); } while (0)
#define PG8_LDA(dst, b, h) do { _Pragma("unroll") for (int m = 0; m < 4; ++m) _Pragma("unroll") for (int k = 0; k < 2; ++k) dst[m][k] = *(const PG8_LAS bf16x8*)(lds + PG8_SA(b, h) + aoff + m * 2048 + k * 1024); } while (0)
#define PG8_LDB(dst, b, h) do { _Pragma("unroll") for (int n = 0; n < 2; ++n) _Pragma("unroll") for (int k = 0; k < 2; ++k) dst[n][k] = *(const PG8_LAS bf16x8*)(lds + PG8_SB(b, h) + boff + n * 2048 + k * 1024); } while (0)
#define PG8_MMA(ai, bj, At, Bt_) do { __builtin_amdgcn_s_setprio(1); _Pragma("unroll") for (int m = 0; m < 4; ++m) _Pragma("unroll") for (int n = 0; n < 2; ++n) _Pragma("unroll") for (int k = 0; k < 2; ++k) \
        acc[ai][bj][m][n] = __builtin_amdgcn_mfma_f32_16x16x32_bf16(Bt_[n][k], At[m][k], acc[ai][bj][m][n], 0, 0, 0); __builtin_amdgcn_s_setprio(0); } while (0)
#define PG8_WAIT_V(n) asm volatile("s_waitcnt vmcnt(" #n ")" ::: "memory")
#define PG8_WAIT_L(n) asm volatile("s_waitcnt lgkmcnt(" #n ")" ::: "memory")
#define PG8_BAR __builtin_amdgcn_s_barrier()
#define PG8_SCHED __builtin_amdgcn_sched_barrier(0)
    MUnit cur, nxt; int ui = 0;
    if (!S.next(0, cur)) return;
    f32x4 acc[2][2][4][2];
#pragma unroll
    for (int a = 0; a < 2; ++a)
#pragma unroll
        for (int b = 0; b < 2; ++b)
#pragma unroll
            for (int m = 0; m < 4; ++m)
#pragma unroll
                for (int n = 0; n < 2; ++n) acc[a][b][m][n] = (f32x4){0.f, 0.f, 0.f, 0.f};
    bf16x8 At[4][2], B0[2][2], B1[2][2];
    { unsigned o_[2][2]; MG_LANE_OFFS(cur, o_); PG8_LAS unsigned* p_ = MG_OFFP(0); p_[0] = o_[0][0]; p_[512] = o_[0][1]; p_[1024] = o_[1][0]; p_[1536] = o_[1][1]; }
    const char* cB = (const char*)Bt + (size_t)cur.e * estep + (size_t)cur.pn * tstep;
    PG8_STAGE(PG8_SB(0, 0), cB, voffB); PG8_STAGE(PG8_SB(0, 1), cB + hstep, voffB); MG_STAGE_A(PG8_SA(0, 0), 0, 0, 0); MG_STAGE_A(PG8_SA(0, 1), 0, 1, 0);
    if (wr == 1) PG8_BAR;
    PG8_WAIT_V(2); PG8_BAR;
    PG8_STAGE(PG8_SB(1, 0), cB + kstep, voffB); MG_STAGE_A(PG8_SA(1, 0), 0, 0, kstep); PG8_STAGE(PG8_SB(1, 1), cB + hstep + kstep, voffB);
    PG8_WAIT_V(6); PG8_BAR;
    for (;;) {
        const bool has_next = S.next(ui + 1, nxt);
        const bool hi_rows = (cur.rend - cur.r0) > HALF;
        const char* nB = cB;
        const int pc = ui & 1, pn_ = has_next ? (pc ^ 1) : pc;
        if (has_next) { unsigned on[2][2]; MG_LANE_OFFS(nxt, on); nB = (const char*)Bt + (size_t)nxt.e * estep + (size_t)nxt.pn * tstep;
            PG8_LAS unsigned* p_ = MG_OFFP(pn_); p_[0] = on[0][0]; p_[512] = on[0][1]; p_[1024] = on[1][0]; p_[1536] = on[1][1]; }
        for (int t = 0; t < nt; t += 2) {
            const bool last = (t == nt - 2);
            const size_t k1 = (size_t)(t + 1) * kstep, k2 = last ? (size_t)0 : (size_t)(t + 2) * kstep, k3 = k2 + kstep;
            const char* b2 = last ? nB : cB + (size_t)(t + 2) * kstep; const char* b3 = b2 + kstep;
            const int p2 = last ? pn_ : pc;
            PG8_LDB(B0, 0, 0); PG8_LDB(B1, 0, 1); PG8_SCHED; PG8_LDA(At, 0, 0); MG_STAGE_A(PG8_SA(1, 1), pc, 1, k1);
            PG8_WAIT_V(8); PG8_WAIT_L(0); PG8_BAR; PG8_MMA(0, 0, At, B0); PG8_MMA(0, 1, At, B1); PG8_BAR; PG8_SCHED;
            PG8_LDA(At, 0, 1); PG8_STAGE(PG8_SB(0, 0), b2, voffB); PG8_STAGE(PG8_SB(0, 1), b2 + hstep, voffB); MG_STAGE_A(PG8_SA(0, 0), p2, 0, k2);
            PG8_WAIT_V(8); PG8_WAIT_L(0); PG8_BAR; if (hi_rows) { PG8_MMA(1, 0, At, B0); PG8_MMA(1, 1, At, B1); } PG8_BAR; PG8_SCHED;
            PG8_LDB(B0, 1, 0); PG8_LDB(B1, 1, 1); PG8_SCHED; PG8_LDA(At, 1, 0); MG_STAGE_A(PG8_SA(0, 1), p2, 1, k2);
            PG8_WAIT_V(8); PG8_WAIT_L(0); PG8_BAR; PG8_MMA(0, 0, At, B0); PG8_MMA(0, 1, At, B1); PG8_BAR; PG8_SCHED;
            PG8_LDA(At, 1, 1); PG8_STAGE(PG8_SB(1, 0), b3, voffB); PG8_STAGE(PG8_SB(1, 1), b3 + hstep, voffB); MG_STAGE_A(PG8_SA(1, 0), p2, 0, k3);
            PG8_WAIT_V(8); PG8_WAIT_L(0); PG8_BAR; if (hi_rows) { PG8_MMA(1, 0, At, B0); PG8_MMA(1, 1, At, B1); } PG8_BAR; PG8_SCHED;
        }
        if (wr == 0) PG8_BAR;
        E(acc, cur, wr, wc, fr, fq);
        if (!has_next) break;
#pragma unroll
        for (int a = 0; a < 2; ++a)
#pragma unroll
            for (int b = 0; b < 2; ++b)
#pragma unroll
                for (int m = 0; m < 4; ++m)
#pragma unroll
                    for (int n = 0; n < 2; ++n) acc[a][b][m][n] = (f32x4){0.f, 0.f, 0.f, 0.f};
        cur = nxt; cB = nB; ++ui;
        if (wr == 1) PG8_BAR;
    }
    PG8_WAIT_V(0);
    PG8_BAR;
#undef PG8_SA
#undef PG8_SB
#undef PG8_STAGE
#undef MG_STAGE_A
#undef MG_OFFP
#undef MG_VOFFB
#undef PG8_LDA
#undef PG8_LDB
#undef PG8_MMA
#undef PG8_WAIT_V
#undef PG8_WAIT_L
#undef PG8_BAR
#undef PG8_SCHED
}
__device__ __forceinline__ float fast_silu(float x) { return x * __builtin_amdgcn_rcpf(1.0f + __builtin_amdgcn_exp2f(-1.4426950408889634f * x)); }
struct EpiMoeH {
    static constexpr bool PERM = true;
    bf16_t* H;
    __device__ __forceinline__ void operator()(const f32x4 (&acc)[2][2][4][2], const MUnit& u, int wr, int wc, int fr, int fq) const {
        { const int t_ = fresh_lane(); fr = t_ & 15; fq = t_ >> 4; }
        const int col0 = u.pn * 128 + wc * 32 + 8 * fq;
#pragma unroll
        for (int ai = 0; ai < 2; ++ai)
#pragma unroll
            for (int m = 0; m < 4; ++m) { const int r = u.r0 + ai * HALF + wr * 64 + m * 16 + fr;
                const f32x4 g0 = acc[ai][0][m][0], g1 = acc[ai][0][m][1], u0 = acc[ai][1][m][0], u1 = acc[ai][1][m][1];
                u32x4 w; w.x = cvt_pk_bf16(fast_silu(g0[0]) * u0[0], fast_silu(g0[1]) * u0[1]); w.y = cvt_pk_bf16(fast_silu(g0[2]) * u0[2], fast_silu(g0[3]) * u0[3]);
                w.z = cvt_pk_bf16(fast_silu(g1[0]) * u1[0], fast_silu(g1[1]) * u1[1]); w.w = cvt_pk_bf16(fast_silu(g1[2]) * u1[2], fast_silu(g1[3]) * u1[3]);
                if (r < u.rend) *(u32x4*)(H + (size_t)r * 256 + col0) = w; }
    }
};
struct EpiMoeY {
    static constexpr bool PERM = true;
    bf16_t* Y;
    __device__ __forceinline__ void operator()(const f32x4 (&acc)[2][2][4][2], const MUnit& u, int wr, int wc, int fr, int fq) const {
        { const int t_ = fresh_lane(); fr = t_ & 15; fq = t_ >> 4; }
        const int col0 = u.pn * BM + wc * 32 + 8 * fq;
#pragma unroll
        for (int ai = 0; ai < 2; ++ai)
#pragma unroll
            for (int m = 0; m < 4; ++m) { const int r = u.r0 + ai * HALF + wr * 64 + m * 16 + fr;
#pragma unroll
                for (int bj = 0; bj < 2; ++bj) { const f32x4 v0 = acc[ai][bj][m][0], v1 = acc[ai][bj][m][1];
                    u32x4 w; w.x = cvt_pk_bf16(v0[0], v0[1]); w.y = cvt_pk_bf16(v0[2], v0[3]); w.z = cvt_pk_bf16(v1[0], v1[1]); w.w = cvt_pk_bf16(v1[2], v1[3]);
                    if (r < u.rend) *(u32x4*)(Y + (size_t)r * 1024 + col0 + bj * HALF) = w; } }
    }
};
struct MoeSched {
    const PG8_LAS int* tab;
    int npn, first, end, stride, c;
    __device__ __forceinline__ bool next(int i, MUnit& u) const {
        const int L = first + c + i * stride;
        if (c < 0 || L >= end) return false;
        const int j = L / npn; u.pn = L % npn;
        u.e = __builtin_amdgcn_readfirstlane(tab[4 + 4 * j]); u.r0 = __builtin_amdgcn_readfirstlane(tab[5 + 4 * j]); u.rend = __builtin_amdgcn_readfirstlane(tab[6 + 4 * j]);
        return true;
    }
};
}

#ifndef PG8_SP2
#define PG8_SP2 true
#endif
#ifndef PG8_ALIGN
#define PG8_ALIGN true
#endif

constexpr int NWAVES = 8, NT = NWAVES * 64;
constexpr int D = 1024, NB = 2, S = 8192, T = NB * S, DEPTH = 2;
constexpr int DIN = 2832, PLD = 3072;
constexpr int C_Q = 0, C_K = 256, C_V = 512, C_G = 1024, C_GK = 1536, C_U = 1552, C_VG = 1808, C_XI = 2064, C_BG = 2320, C_CG = 2576;
constexpr int GH = 4, GC = 64, GN = S / GC;
constexpr int MH = 4, MC = 128, MN = S / MC;
constexpr int NE = 32, DE = 256;
constexpr float EPS = 1e-6f;
constexpr size_t MiB = 1u << 20;
constexpr size_t WS_CTL = 0, CTL_BYTES = 1 * MiB;
constexpr size_t WS_WIN = 1 * MiB;
constexpr size_t WS_WOUT = 13 * MiB;
constexpr size_t WS_WGU = 17 * MiB;
constexpr size_t WS_WD = 81 * MiB;
constexpr size_t WS_XN = 113 * MiB;
constexpr size_t WS_P = 145 * MiB;
constexpr size_t WS_Y = WS_P + 17 * MiB;
constexpr size_t WS_S = 276 * MiB;
constexpr size_t WS_XRES = 241 * MiB;
constexpr size_t WS_DEC = 273 * MiB;
constexpr size_t WS_MISC = 274 * MiB;
constexpr size_t WS_WSP = WS_MISC + 524288;
constexpr size_t WS_WR = 275 * MiB;
constexpr size_t WS_BLKCNT = WS_WR + 524288;
constexpr size_t WS_END = 284 * MiB;
constexpr int CW_BAR = 4096, CW_CNT = 16384;
constexpr int RING_BYTES = 131072, LDSCTL_OFF = RING_BYTES, MISC_OFF = LDSCTL_OFF + 320, LDS_BYTES = 163840;

#define GAS __attribute__((address_space(1)))
#define LAS __attribute__((address_space(3)))
typedef unsigned short bf16;
typedef unsigned v4u __attribute__((ext_vector_type(4)));
typedef unsigned v2u __attribute__((ext_vector_type(2)));
typedef float f32x4 __attribute__((ext_vector_type(4)));
typedef __bf16 bf16x2_t __attribute__((ext_vector_type(2)));
typedef float f32x2_t __attribute__((ext_vector_type(2)));
__device__ __forceinline__ unsigned f2bf(float f) { return (unsigned)__builtin_bit_cast(unsigned short, (__bf16)f); }
__device__ __forceinline__ unsigned pk2(float lo, float hi) { f32x2_t v = {lo, hi}; bf16x2_t b = __builtin_convertvector(v, bf16x2_t); return __builtin_bit_cast(unsigned, b); }
__device__ __forceinline__ float bf2f(unsigned v) { return __uint_as_float(v << 16); }
__device__ __forceinline__ float bflo(unsigned w) { return __uint_as_float(w << 16); }
__device__ __forceinline__ float bfhi(unsigned w) { return __uint_as_float(w & 0xffff0000u); }
__device__ __forceinline__ void unpack8(const v4u q, float (&f)[8]) { f[0] = bflo(q.x); f[1] = bfhi(q.x); f[2] = bflo(q.y); f[3] = bfhi(q.y); f[4] = bflo(q.z); f[5] = bfhi(q.z); f[6] = bflo(q.w); f[7] = bfhi(q.w); }
__device__ __forceinline__ float gelu_tanh(float x) { const float u = 0.7978845608028654f * (x + 0.044715f * x * x * x); return 0.5f * x * (1.0f + tanhf(u)); }
__device__ __forceinline__ float silu(float x) { return x / (1.0f + expf(-x)); }
__device__ __forceinline__ float log_sigmoid(float x) { return fminf(x, 0.f) - log1pf(expf(-fabsf(x))); }

#define XB_TMO      128
#define XB_XCNT(j)  (256  + 64 * (j))
#define XB_XSUB(j)  (1280 + 64 * (j))
#define XB_XGEN(j)  (2304 + 64 * (j))
#define XB_TOP      3328
#define XB_TOPGEN   3392
#define XCD_BAR_WORDS 3456
#define XB_SPIN_CAP (1u << 18)

__device__ __forceinline__ unsigned xb_ld(unsigned* p)              { return __hip_atomic_load(p, __ATOMIC_RELAXED, __HIP_MEMORY_SCOPE_AGENT); }
__device__ __forceinline__ unsigned xb_add(unsigned* p, unsigned v) { return __hip_atomic_fetch_add(p, v, __ATOMIC_RELAXED, __HIP_MEMORY_SCOPE_AGENT); }
__device__ __forceinline__ unsigned xb_xcc_id() { return (unsigned)__builtin_amdgcn_s_getreg((3 << 11) | 20) & 0xFu; }
#define XB_SPIN(cond, bar) do { unsigned _sp = 0; while (cond) { __builtin_amdgcn_s_sleep(1); \
    if ((++_sp & 255u) == 0u) { if (xb_ld(&(bar)[XB_TMO])) break; if (_sp > XB_SPIN_CAP) { atomicAdd(&(bar)[XB_TMO], 1u); break; } } } } while (0)

struct XcdBarrier {
    int wave;
    unsigned* bar; unsigned x;
    volatile LAS unsigned* st;
};

__device__ __forceinline__ XcdBarrier xcd_barrier_post(unsigned* bar, volatile LAS unsigned* st) {
    XcdBarrier b; b.bar = bar; b.x = xb_xcc_id(); b.st = st; b.wave = __builtin_amdgcn_readfirstlane(threadIdx.x >> 6);
    if (threadIdx.x == 0) (void)xb_add(&bar[XB_XCNT(b.x)], 1u);
    return b;
}
__device__ __forceinline__ void xcd_barrier_complete(unsigned* bar, unsigned x, unsigned& nloc, unsigned& nx) {
    const unsigned G = gridDim.x * gridDim.y * gridDim.z;
    unsigned sum, cnt, mine, sp = 0u;
    for (;;) {
        sum = 0u; cnt = 0u; mine = 0u;
#pragma unroll
        for (unsigned j = 0; j < 16; ++j) { const unsigned c = xb_ld(&bar[XB_XCNT(j)]); sum += c; cnt += (c > 0u) ? 1u : 0u; mine = (j == x) ? c : mine; }
        if (sum == G) break;
        __builtin_amdgcn_s_sleep(1);
        if ((++sp & 255u) == 0u) { if (xb_ld(&bar[XB_TMO])) break; if (sp > XB_SPIN_CAP) { atomicAdd(&bar[XB_TMO], 1u); break; } }
    }
    nloc = mine > 0u ? mine : 1u; nx = cnt > 0u ? cnt : 1u;
}

__device__ __forceinline__ void xcd_barrier(const XcdBarrier& b) {
    asm volatile("s_waitcnt vmcnt(0)" ::: "memory");
    __syncthreads();
    if (b.wave == 0 && fresh_lane() == 0) {
        unsigned* bar = b.bar; asm volatile("" : "+s"(bar));
        __builtin_amdgcn_s_waitcnt(0);
        unsigned nloc = b.st[0], nx = b.st[1];
        if (nloc == 0u) { xcd_barrier_complete(bar, b.x, nloc, nx); b.st[0] = nloc; b.st[1] = nx; }
        const unsigned old = xb_add(&bar[XB_XSUB(b.x)], 1u);
        const unsigned gen = old / nloc;
        if (old + 1u == (gen + 1u) * nloc) {
            __builtin_amdgcn_fence(__ATOMIC_RELEASE, "agent");
            asm volatile("s_waitcnt vmcnt(0)" ::: "memory");
            const unsigned og = xb_add(&bar[XB_TOP], 1u);
            const unsigned tg = og / nx;
            if (og + 1u == (tg + 1u) * nx) xb_add(&bar[XB_TOPGEN], 1u);
            else XB_SPIN(xb_ld(&bar[XB_TOPGEN]) == tg, bar);
            __builtin_amdgcn_fence(__ATOMIC_ACQUIRE, "agent");
            xb_add(&bar[XB_XGEN(b.x)], 1u);
            asm volatile("s_waitcnt vmcnt(0)" ::: "memory");
        } else {
            XB_SPIN(xb_ld(&bar[XB_XGEN(b.x)]) == gen, bar);
            __builtin_amdgcn_fence(__ATOMIC_ACQUIRE, "agent");
            asm volatile("s_waitcnt vmcnt(0)" ::: "memory");
        }
    }
    __syncthreads();
}

#define AS4 __attribute__((address_space(4)))
struct KA {
    const AS4 char* ka;
    static __device__ __forceinline__ KA fresh() { KA k; k.ka = (const AS4 char*)__builtin_amdgcn_kernarg_segment_ptr(); asm volatile("" : "+s"(k.ka)); return k; }
    __device__ __forceinline__ const float* in(int i) const { return *(const float* const AS4*)(ka + 8 * i); }
    __device__ __forceinline__ float* out() const { return *(float* const AS4*)(ka + 160); }
    __device__ __forceinline__ unsigned char* ws() const { return *(unsigned char* const AS4*)(ka + 168); }
    __device__ __forceinline__ unsigned* ctl() const { return (unsigned*)(ws() + WS_CTL); }
    __device__ __forceinline__ bf16* WinT() const { return (bf16*)(ws() + WS_WIN); }
    __device__ __forceinline__ bf16* WoutT() const { return (bf16*)(ws() + WS_WOUT); }
    __device__ __forceinline__ bf16* WguT() const { return (bf16*)(ws() + WS_WGU); }
    __device__ __forceinline__ bf16* WdT() const { return (bf16*)(ws() + WS_WD); }
    __device__ __forceinline__ bf16* XN() const { return (bf16*)(ws() + WS_XN); }
    __device__ __forceinline__ bf16* P() const { return (bf16*)(ws() + WS_P); }
    __device__ __forceinline__ bf16* H1() const { return (bf16*)(ws() + WS_P); }
    __device__ __forceinline__ bf16* Y() const { return (bf16*)(ws() + WS_Y); }
    __device__ __forceinline__ float* Sst() const { return (float*)(ws() + WS_S); }
    __device__ __forceinline__ float* dec() const { return (float*)(ws() + WS_DEC); }
    __device__ __forceinline__ int* eid() const { return (int*)(ws() + WS_MISC); }
    __device__ __forceinline__ float* ew() const { return (float*)(ws() + WS_MISC + 131072); }
    __device__ __forceinline__ int* slot_tok() const { return (int*)(ws() + WS_MISC + 2 * 131072); }
    __device__ __forceinline__ int* slot_of() const { return (int*)(ws() + WS_MISC + 3 * 131072); }
    __device__ __forceinline__ bf16* Wsp() const { return (bf16*)(ws() + WS_WSP); }
    __device__ __forceinline__ bf16* Wr() const { return (bf16*)(ws() + WS_WR); }
    __device__ __forceinline__ bf16* XR() const { return (bf16*)(ws() + WS_XRES); }
    __device__ __forceinline__ int* blkcnt() const { return (int*)(ws() + WS_BLKCNT); }
};
struct Frame {
    LAS unsigned char* lds; float* smem;
    int G, bx, wave;
};
#define PHASE_TID const int lane = fresh_lane(), wave = F.wave, tid = wave * 64 + lane; (void)lane; (void)wave; (void)tid

__device__ __forceinline__ float wave_sum(float v) {
    const int ln = fresh_lane();
#pragma unroll
    for (int o = 1; o < 64; o <<= 1) v += __int_as_float(__builtin_amdgcn_ds_bpermute((ln ^ o) << 2, __float_as_int(v)));
    return v;
}

__device__ __forceinline__ void transpose_item(const float* W, int ldw, int nvalid, int k0, int n0, bf16* WT, int ldt, int drow0, LAS float* scr, int lane) {
    const int sub = lane >> 3, c4 = (lane & 7) * 4;
    f32x4 v[8];
#pragma unroll
    for (int i = 0; i < 8; ++i) v[i] = (c4 < nvalid) ? __builtin_nontemporal_load((const f32x4*)(W + (size_t)(k0 + 8 * i + sub) * ldw + n0 + c4)) : (f32x4){0.f, 0.f, 0.f, 0.f};
#pragma unroll
    for (int i = 0; i < 8; ++i) { LAS float* d = scr + (8 * i + sub) * 33 + c4; d[0] = v[i].x; d[1] = v[i].y; d[2] = v[i].z; d[3] = v[i].w; }
    asm volatile("s_waitcnt lgkmcnt(0)" ::: "memory");
    const int c = lane & 7;
#pragma unroll
    for (int j = 0; j < 4; ++j) { const int n = (lane >> 3) + 8 * j; const LAS float* s = scr + (8 * c) * 33 + n;
        v4u o; o.x = pk2(s[0 * 33], s[1 * 33]); o.y = pk2(s[2 * 33], s[3 * 33]); o.z = pk2(s[4 * 33], s[5 * 33]); o.w = pk2(s[6 * 33], s[7 * 33]);
        if (n < nvalid) *(GAS v4u*)(WT + (size_t)(drow0 + n) * ldt + k0 + 8 * c) = o; }
    asm volatile("s_waitcnt lgkmcnt(0)" ::: "memory");
}
__device__ __forceinline__ void rms_row_to_bf16(const float* xrow, const float* gain, bf16* orow, int lane) {
    const f32x4* xr = (const f32x4*)xrow + lane;
    f32x4 v[4]; float s = 0.f;
#pragma unroll
    for (int j = 0; j < 4; ++j) { v[j] = xr[64 * j]; s += (v[j].x * v[j].x + v[j].y * v[j].y) + (v[j].z * v[j].z + v[j].w * v[j].w); }
    const float rs = rsqrtf(wave_sum(s) * (1.f / D) + EPS);
    v2u* o8 = (v2u*)orow + lane;
#pragma unroll
    for (int j = 0; j < 4; ++j) { const f32x4 g = ((const f32x4*)gain)[lane + 64 * j]; v2u w; w.x = pk2(v[j].x * rs * g.x, v[j].y * rs * g.y); w.y = pk2(v[j].z * rs * g.z, v[j].w * rs * g.w); o8[64 * j] = w; }
}
__device__ __forceinline__ void p0_prologue(Frame& F) {
    const KA K = KA::fresh(); PHASE_TID;
    LAS float* scr = (LAS float*)(F.lds + wave * 16384);
    const int gw = F.bx * NWAVES + wave, NGW = F.G * NWAVES;
    constexpr int I_IN = 16 * 89, I_OUT = 16 * 32, I_G = 32 * 16 * 8, I_D = 32 * 4 * 32, I_L = I_IN + I_OUT + 2 * I_G + I_D;
    for (int it = gw; it < DEPTH * I_L; it += NGW) {
        const int l = it / I_L; int r = it % I_L;
        if (r < I_IN) { const int kb = r / 89, nb = r % 89; const int nv = (nb == 88) ? 16 : 32;
            transpose_item(K.in(2) + (size_t)l * D * DIN, DIN, nv, kb * 64, nb * 32, K.WinT() + (size_t)l * PLD * D, D, nb * 32, scr, lane); continue; }
        r -= I_IN;
        if (r < I_OUT) { const int kb = r / 32, nb = r % 32;
            transpose_item(K.in(10) + (size_t)l * D * D, D, 32, kb * 64, nb * 32, K.WoutT() + (size_t)l * D * D, D, nb * 32, scr, lane); continue; }
        r -= I_OUT;
        if (r < 2 * I_G) { const int sel = r / I_G; r %= I_G; const int e = r / 128, kb = (r % 128) / 8, nb = r % 8; const int n0 = nb * 32;
            const float* W = K.in(16 + sel) + ((size_t)l * NE + e) * D * DE;
            transpose_item(W, DE, 32, kb * 64, n0, K.WguT() + ((size_t)l * NE + e) * 512 * D, D, (n0 >> 7) * 256 + sel * 128 + (n0 & 127), scr, lane); continue; }
        r -= 2 * I_G;
        { const int e = r / 128, kb = (r % 128) / 32, nb = r % 32;
            transpose_item(K.in(18) + ((size_t)l * NE + e) * DE * D, D, 32, kb * 64, nb * 32, K.WdT() + ((size_t)l * NE + e) * D * DE, DE, nb * 32, scr, lane); }
    }
    for (int i = F.bx * NT + tid; i < DEPTH * 240 * 128; i += F.G * NT) { const int l = i / (240 * 128), rr = (i / 128) % 240, c = i % 128;
        *(GAS v4u*)(K.WinT() + ((size_t)l * PLD + DIN + rr) * D + c * 8) = (v4u){0u, 0u, 0u, 0u}; }
    for (int i = F.bx * NT + tid; i < DEPTH * 48 * D; i += F.G * NT) { const int ll = i / (48 * D), n = (i / D) % 48, k = i % D;
        float w = 0.f;
        if (n < 4) w = K.in(12)[((size_t)ll * D + k) * 4 + n]; else if (n < 36) w = K.in(14)[((size_t)ll * D + k) * 32 + (n - 4)];
        w *= K.in(11)[(size_t)ll * D + k];
        const unsigned hi = f2bf(w), lo = f2bf(w - bf2f(hi));
        K.Wr()[((size_t)ll * 2 + 0) * 48 * D + (size_t)n * D + k] = (bf16)hi; K.Wr()[((size_t)ll * 2 + 1) * 48 * D + (size_t)n * D + k] = (bf16)lo; }
    for (int i = F.bx * NT + tid; i < DEPTH * MH * 128 * 128 / 8; i += F.G * NT) { const int e0 = i * 8, s0 = e0 & 127, t = (e0 >> 7) & 127;
        const f32x4 a = *(const f32x4*)(K.in(7) + e0), c = *(const f32x4*)(K.in(7) + e0 + 4);
        const float v[8] = {a.x, a.y, a.z, a.w, c.x, c.y, c.z, c.w}; unsigned w[4];
#pragma unroll
        for (int j = 0; j < 4; ++j) w[j] = pk2((s0 + 2 * j <= t) ? v[2 * j] : 0.f, (s0 + 2 * j + 1 <= t) ? v[2 * j + 1] : 0.f);
        *(GAS v4u*)(K.Wsp() + e0) = (v4u){w[0], w[1], w[2], w[3]}; }
    for (int m = gw; m < T; m += NGW) rms_row_to_bf16(K.in(0) + (size_t)m * D, K.in(1), K.XN() + (size_t)m * D, lane);
}

__device__ __forceinline__ void gla_cumdecay(Frame& F, const KA& K, int tid, int l, int h, int t0, float* bb) {
    const float* wup = K.in(3) + (size_t)l * 16 * 256; const float* bgk = K.in(4) + (size_t)l * 256;
    for (int e = tid; e < 64 * 64; e += NT) {
        const int c = e >> 6, d = e & 63;
        const bf16* gl = K.P() + (size_t)(t0 + c) * PLD + C_GK;
        float a = bgk[h * 64 + d];
#pragma unroll
        for (int r = 0; r < 16; ++r) a += bf2f(gl[r]) * wup[r * 256 + h * 64 + d];
        bb[c * 64 + d] = log_sigmoid(a) * (1.0f / 16.0f);
    }
    __syncthreads();
    if (tid < 64) { float run = 0.f; for (int c = 0; c < 64; ++c) { run += bb[c * 64 + tid]; bb[c * 64 + tid] = run; } }
    __syncthreads();
}
__device__ __forceinline__ void phase_gla_kv(Frame& F, int l) {
    const KA K = KA::fresh(); PHASE_TID;
    float* bb = F.smem; float* kd = F.smem + 4096;
#pragma unroll 1
    for (int ci = F.bx; ci < NB * GH * GN; ci += F.G) {
        const int b = ci / (GH * GN), h = (ci / GN) % GH, n = ci % GN, t0 = b * S + n * GC;
        __syncthreads();
        gla_cumdecay(F, K, tid, l, h, t0, bb);
        for (int e = tid; e < 4096; e += NT) { const int c = e >> 6, d = e & 63; kd[e] = bf2f(K.P()[(size_t)(t0 + c) * PLD + C_K + h * 64 + d]) * expf(bb[63 * 64 + d] - bb[e]); }
        __syncthreads();
        const int d = tid >> 3, v0 = (tid & 7) * 16;
        float acc[16];
#pragma unroll
        for (int j = 0; j < 16; ++j) acc[j] = 0.f;
#pragma unroll 2
        for (int c = 0; c < 64; ++c) {
            const float kk = kd[c * 64 + d];
            const v4u* vr = (const v4u*)(K.P() + (size_t)(t0 + c) * PLD + C_V + h * 128 + v0);
            float f[8]; unpack8(vr[0], f);
#pragma unroll
            for (int j = 0; j < 8; ++j) acc[j] += kk * f[j];
            unpack8(vr[1], f);
#pragma unroll
            for (int j = 0; j < 8; ++j) acc[8 + j] += kk * f[j];
        }
        f32x4* o = (f32x4*)(K.Sst() + ((size_t)ci * 64 + d) * 128 + v0);
#pragma unroll
        for (int j = 0; j < 4; ++j) o[j] = (f32x4){acc[4 * j], acc[4 * j + 1], acc[4 * j + 2], acc[4 * j + 3]};
        if (tid < 64) K.dec()[(size_t)ci * 64 + tid] = expf(bb[63 * 64 + tid]);
    }
}
__device__ __forceinline__ void phase_gla_scan(Frame& F) {
    const KA K = KA::fresh(); PHASE_TID;
#pragma unroll 1
    for (int e = F.bx * NT + tid; e < NB * GH * 64 * 128; e += F.G * NT) {
        const int bh = e >> 13, d = (e >> 7) & 63, v = e & 127;
        float* base = K.Sst() + ((size_t)bh * GN * 64 + d) * 128 + v; const float* db = K.dec() + (size_t)bh * GN * 64 + d;
        float st = 0.f;
#pragma unroll 1
        for (int n0 = 0; n0 < GN; n0 += 16) {
            float kvv[16], dd[16];
#pragma unroll
            for (int j = 0; j < 16; ++j) { kvv[j] = base[(size_t)(n0 + j) * 8192]; dd[j] = db[(n0 + j) * 64]; }
#pragma unroll
            for (int j = 0; j < 16; ++j) { base[(size_t)(n0 + j) * 8192] = st; st = dd[j] * st + kvv[j]; }
        }
    }
}
__device__ __forceinline__ void phase_gla_out(Frame& F, int l) {
    const KA K = KA::fresh(); PHASE_TID;
    float* bb = F.smem; float* qd = F.smem + 4096; float* ki = F.smem + 4096 + 64 * 65; float* sc = bb;
    const float* gnorm = K.in(5) + (size_t)l * 128;
#pragma unroll 1
    for (int ci = F.bx; ci < NB * GH * GN; ci += F.G) {
        const int b = ci / (GH * GN), h = (ci / GN) % GH, n = ci % GN, t0 = b * S + n * GC;
        __syncthreads();
        gla_cumdecay(F, K, tid, l, h, t0, bb);
        for (int e = tid; e < 4096; e += NT) {
            const int c = e >> 6, d = e & 63; const float bv = bb[e];
            const bf16* row = K.P() + (size_t)(t0 + c) * PLD;
            qd[c * 65 + d] = bf2f(row[C_Q + h * 64 + d]) * 0.125f * expf(bv);
            ki[c * 65 + d] = bf2f(row[C_K + h * 64 + d]) * expf(-bv);
        }
        __syncthreads();
        {
            const int c = tid >> 3, s0 = (tid & 7) * 8;
            float a[8];
#pragma unroll
            for (int j = 0; j < 8; ++j) a[j] = 0.f;
#pragma unroll 4
            for (int d = 0; d < 64; ++d) { const float qv = qd[c * 65 + d];
#pragma unroll
                for (int j = 0; j < 8; ++j) a[j] += qv * ki[(s0 + j) * 65 + d]; }
#pragma unroll
            for (int j = 0; j < 8; ++j) sc[c * 64 + s0 + j] = (s0 + j <= c) ? a[j] : 0.f;
        }
        __syncthreads();
        const int c = tid >> 3, v0 = (tid & 7) * 16;
        float acc[16];
#pragma unroll
        for (int j = 0; j < 16; ++j) acc[j] = 0.f;
#pragma unroll 2
        for (int s = 0; s <= c; ++s) {
            const float w = sc[c * 64 + s];
            const v4u* vr = (const v4u*)(K.P() + (size_t)(t0 + s) * PLD + C_V + h * 128 + v0);
            float f[8]; unpack8(vr[0], f);
#pragma unroll
            for (int j = 0; j < 8; ++j) acc[j] += w * f[j];
            unpack8(vr[1], f);
#pragma unroll
            for (int j = 0; j < 8; ++j) acc[8 + j] += w * f[j];
        }
#pragma unroll 2
        for (int d = 0; d < 64; ++d) {
            const float w = qd[c * 65 + d];
            const f32x4* sr = (const f32x4*)(K.Sst() + ((size_t)ci * 64 + d) * 128 + v0);
#pragma unroll
            for (int j = 0; j < 4; ++j) { const f32x4 v4 = sr[j]; acc[4 * j] += w * v4.x; acc[4 * j + 1] += w * v4.y; acc[4 * j + 2] += w * v4.z; acc[4 * j + 3] += w * v4.w; }
        }
        float ss = 0.f;
#pragma unroll
        for (int j = 0; j < 16; ++j) ss += acc[j] * acc[j];
        ss += shx(ss, 1); ss += shx(ss, 2); ss += shx(ss, 4);
        const float rs = rsqrtf(ss * (1.0f / 128.0f) + EPS);
        const v4u* gr = (const v4u*)(K.P() + (size_t)(t0 + c) * PLD + C_G + h * 128 + v0);
        float g0[8], g1[8]; unpack8(gr[0], g0); unpack8(gr[1], g1);
        float o[16];
#pragma unroll
        for (int j = 0; j < 8; ++j) { o[j] = acc[j] * rs * gnorm[v0 + j] * silu(g0[j]); o[8 + j] = acc[8 + j] * rs * gnorm[v0 + 8 + j] * silu(g1[j]); }
        v4u* op = (v4u*)(K.XN() + (size_t)(t0 + c) * D + h * 128 + v0);
        op[0] = (v4u){pk2(o[0], o[1]), pk2(o[2], o[3]), pk2(o[4], o[5]), pk2(o[6], o[7])};
        op[1] = (v4u){pk2(o[8], o[9]), pk2(o[10], o[11]), pk2(o[12], o[13]), pk2(o[14], o[15])};
    }
}
__device__ __forceinline__ void phase_gmlp(Frame& F, int l) {
    const KA K = KA::fresh(); PHASE_TID;
    float* vs = F.smem;
    const float* gn = K.in(6) + (size_t)l * 256; const float* wsp = K.in(7) + (size_t)l * MH * 128 * 128; const float* bsp = K.in(8) + (size_t)l * MH * 128;
#pragma unroll 1
    for (int u = F.bx; u < NB * MN * MH; u += F.G) {
        const int b = u / (MN * MH), n = (u / MH) % MN, h = u % MH, t0 = b * S + n * MC;
        __syncthreads();
        const int s = tid >> 2, d0 = (tid & 3) * 16;
        {
            const v4u* vr = (const v4u*)(K.P() + (size_t)(t0 + s) * PLD + C_VG + h * 64 + d0);
            float g[16]; { float f[8]; unpack8(vr[0], f);
#pragma unroll
                for (int j = 0; j < 8; ++j) g[j] = gelu_tanh(f[j]);
                unpack8(vr[1], f);
#pragma unroll
                for (int j = 0; j < 8; ++j) g[8 + j] = gelu_tanh(f[j]); }
            float ss = 0.f;
#pragma unroll
            for (int j = 0; j < 16; ++j) ss += g[j] * g[j];
            ss += shx(ss, 1); ss += shx(ss, 2);
            const float rs = rsqrtf(ss * (1.0f / 64.0f) + EPS);
#pragma unroll
            for (int j = 0; j < 16; ++j) vs[s * 64 + d0 + j] = g[j] * rs * gn[h * 64 + d0 + j];
        }
        __syncthreads();
        const int t = s;
        float acc[16];
#pragma unroll
        for (int j = 0; j < 16; ++j) acc[j] = 0.f;
        const float* wr = wsp + ((size_t)h * 128 + t) * 128;
#pragma unroll 2
        for (int s2 = 0; s2 <= t; ++s2) { const float w = wr[s2];
#pragma unroll
            for (int j = 0; j < 16; ++j) acc[j] += w * vs[s2 * 64 + d0 + j]; }
        const float bias = bsp[h * 128 + t];
        const v4u* ur = (const v4u*)(K.P() + (size_t)(t0 + t) * PLD + C_U + h * 64 + d0);
        float u0[8], u1[8]; unpack8(ur[0], u0); unpack8(ur[1], u1);
        float o[16];
#pragma unroll
        for (int j = 0; j < 8; ++j) { o[j] = gelu_tanh(u0[j]) * (acc[j] + bias); o[8 + j] = gelu_tanh(u1[j]) * (acc[8 + j] + bias); }
        v4u* op = (v4u*)(K.XN() + (size_t)(t0 + t) * D + 512 + h * 64 + d0);
        op[0] = (v4u){pk2(o[0], o[1]), pk2(o[2], o[3]), pk2(o[4], o[5]), pk2(o[6], o[7])};
        op[1] = (v4u){pk2(o[8], o[9]), pk2(o[10], o[11]), pk2(o[12], o[13]), pk2(o[14], o[15])};
    }
}
typedef short bf16x8 __attribute__((ext_vector_type(8)));
__device__ __forceinline__ float fexp(float x) { return __builtin_amdgcn_exp2f(x * 1.4426950408889634f); }
__device__ __forceinline__ float logsig_fast(float x) { return fminf(x, 0.f) - __log2f(1.0f + fexp(-fabsf(x))) * 0.6931471805599453f; }
__device__ __forceinline__ float silu_fast(float x) { return x * __builtin_amdgcn_rcpf(1.0f + __builtin_amdgcn_exp2f(-1.4426950408889634f * x)); }
__device__ __forceinline__ float gelu_fast(float x) { const float u = 0.7978845608028654f * (x + 0.044715f * x * x * x); return x * __builtin_amdgcn_rcpf(1.0f + __builtin_amdgcn_exp2f(-2.8853900817779268f * u)); }
__device__ __forceinline__ f32x4 mfma16(bf16x8 a, bf16x8 b, f32x4 c) { return __builtin_amdgcn_mfma_f32_16x16x32_bf16(a, b, c, 0, 0, 0); }
constexpr int LROWB = 144;
constexpr int L_QD = 0, L_KI = 9216, L_KDT = 18432, L_VT = 27648, L_S = 46080, L_ST = 55296, L_OB = 73728, L_TOT = 107520, OBROW = 528;
#define FRAG(base, row, kel) (*(const LAS bf16x8*)(lds + (base) + (row) * LROWB + (kel) * 2))

__device__ __forceinline__ float gla_b8(const KA& K, LAS unsigned char* lds, int l, int h, int t0, int lane, int wave, float (&bv)[8]) {
    const float* wup = K.in(3) + (size_t)l * 16 * 256 + h * 64 + lane;
    float wu[16];
#pragma unroll
    for (int r = 0; r < 16; ++r) wu[r] = wup[r * 256];
    const float bg = K.in(4)[l * 256 + h * 64 + lane];
    const bf16* P = K.P();
    float run = 0.f;
#pragma unroll
    for (int j = 0; j < 8; ++j) {
        const bf16* gl = P + (size_t)(t0 + 8 * wave + j) * PLD + C_GK;
        float f0[8], f1[8]; unpack8(*(const v4u*)gl, f0); unpack8(*(const v4u*)(gl + 8), f1);
        float a = bg;
#pragma unroll
        for (int r = 0; r < 8; ++r) a += f0[r] * wu[r];
#pragma unroll
        for (int r = 0; r < 8; ++r) a += f1[r] * wu[8 + r];
        run += logsig_fast(a) * (1.0f / 16.0f); bv[j] = run;
    }
    LAS float* tot = (LAS float*)(lds + L_TOT);
    tot[wave * 64 + lane] = run;
    __syncthreads();
    float base = 0.f, all = 0.f;
#pragma unroll
    for (int g = 0; g < 8; ++g) { const float tv = tot[g * 64 + lane]; all += tv; if (g < wave) base += tv; }
#pragma unroll
    for (int j = 0; j < 8; ++j) bv[j] += base;
    return all;
}
__device__ __forceinline__ void gla_stage_vT(const bf16* P, LAS unsigned char* lds, int h, int t0, int tid) {
    const int vv = tid & 127, cq = tid >> 7;
    const bf16* vp = P + (size_t)(t0 + 16 * cq) * PLD + C_V + h * 128 + vv;
    unsigned w[8];
#pragma unroll
    for (int j = 0; j < 8; ++j) w[j] = (unsigned)vp[(size_t)(2 * j) * PLD] | ((unsigned)vp[(size_t)(2 * j + 1) * PLD] << 16);
    LAS v4u* dst = (LAS v4u*)(lds + L_VT + vv * LROWB + cq * 32);
    dst[0] = (v4u){w[0], w[1], w[2], w[3]}; dst[1] = (v4u){w[4], w[5], w[6], w[7]};
}

__device__ __forceinline__ void phase_gla_kv_mfma(Frame& F, int l) {
    const KA K = KA::fresh(); PHASE_TID;
    LAS unsigned char* lds = F.lds;
    const int fr = lane & 15, fq = lane >> 4;
#pragma unroll 1
    for (int ci = F.bx; ci < NB * GH * GN; ci += F.G) {
        const int b = ci / (GH * GN), h = (ci / GN) % GH, n = ci % GN, t0 = b * S + n * GC;
        const bf16* P = K.P();
        __syncthreads();
        float bv[8]; const float bl = gla_b8(K, lds, l, h, t0, lane, wave, bv);
        {
            const bf16* kp = P + (size_t)(t0 + 8 * wave) * PLD + C_K + h * 64 + lane;
            float kd[8];
#pragma unroll
            for (int j = 0; j < 8; ++j) kd[j] = bf2f(kp[(size_t)j * PLD]) * fexp(bl - bv[j]);
            *(LAS v4u*)(lds + L_KDT + lane * LROWB + wave * 16) = (v4u){pk2(kd[0], kd[1]), pk2(kd[2], kd[3]), pk2(kd[4], kd[5]), pk2(kd[6], kd[7])};
        }
        gla_stage_vT(P, lds, h, t0, tid);
        if (wave == 0) K.dec()[(size_t)ci * 64 + lane] = fexp(bl);
        __syncthreads();
        bf16x8 Bf[2];
#pragma unroll
        for (int ks = 0; ks < 2; ++ks) Bf[ks] = FRAG(L_VT, 16 * wave + fr, 32 * ks + 8 * fq);
        float* so = K.Sst() + (size_t)ci * 64 * 128 + 16 * wave + fr;
#pragma unroll
        for (int dt = 0; dt < 4; ++dt) {
            f32x4 acc = (f32x4){0.f, 0.f, 0.f, 0.f};
#pragma unroll
            for (int ks = 0; ks < 2; ++ks) acc = mfma16(FRAG(L_KDT, 16 * dt + fr, 32 * ks + 8 * fq), Bf[ks], acc);
#pragma unroll
            for (int r = 0; r < 4; ++r) so[(size_t)(16 * dt + 4 * fq + r) * 128] = acc[r];
        }
    }
}

__device__ __forceinline__ void phase_gla_out_mfma(Frame& F, int l) {
    const KA K = KA::fresh(); PHASE_TID;
    LAS unsigned char* lds = F.lds;
    const int fr = lane & 15, fq = lane >> 4;
    const float* gnorm = K.in(5) + (size_t)l * 128;
#pragma unroll 1
    for (int ci = F.bx; ci < NB * GH * GN; ci += F.G) {
        const int b = ci / (GH * GN), h = (ci / GN) % GH, n = ci % GN, t0 = b * S + n * GC;
        const bf16* P = K.P();
        __syncthreads();
        float bv[8]; (void)gla_b8(K, lds, l, h, t0, lane, wave, bv);
        {
            const bf16* qp = P + (size_t)(t0 + 8 * wave) * PLD + C_Q + h * 64 + lane;
            const bf16* kp = qp + (C_K - C_Q);
#pragma unroll
            for (int j = 0; j < 8; ++j) {
                const float e = fexp(bv[j]);
                const float qv = bf2f(qp[(size_t)j * PLD]) * 0.125f * e, kv = bf2f(kp[(size_t)j * PLD]) * __builtin_amdgcn_rcpf(e);
                *(LAS bf16*)(lds + L_QD + (8 * wave + j) * LROWB + lane * 2) = (bf16)f2bf(qv);
                *(LAS bf16*)(lds + L_KI + (8 * wave + j) * LROWB + lane * 2) = (bf16)f2bf(kv);
            }
        }
        gla_stage_vT(P, lds, h, t0, tid);
        {
            const int vv = tid & 127, dq = tid >> 7;
            const float* sp = K.Sst() + ((size_t)ci * 64 + 16 * dq) * 128 + vv;
            unsigned w[8];
#pragma unroll
            for (int j = 0; j < 8; ++j) w[j] = pk2(sp[(size_t)(2 * j) * 128], sp[(size_t)(2 * j + 1) * 128]);
            LAS v4u* dst = (LAS v4u*)(lds + L_ST + vv * LROWB + dq * 32);
            dst[0] = (v4u){w[0], w[1], w[2], w[3]}; dst[1] = (v4u){w[4], w[5], w[6], w[7]};
        }
        __syncthreads();
#pragma unroll
        for (int i = 0; i < 2; ++i) {
            const int tix = 2 * wave + i, st = tix >> 2, ct = tix & 3;
            f32x4 acc = (f32x4){0.f, 0.f, 0.f, 0.f};
#pragma unroll
            for (int ks = 0; ks < 2; ++ks) acc = mfma16(FRAG(L_KI, 16 * st + fr, 32 * ks + 8 * fq), FRAG(L_QD, 16 * ct + fr, 32 * ks + 8 * fq), acc);
            const int s0 = 16 * st + 4 * fq, c = 16 * ct + fr;
            float m[4];
#pragma unroll
            for (int r = 0; r < 4; ++r) m[r] = (s0 + r <= c) ? acc[r] : 0.f;
            *(LAS v2u*)(lds + L_S + c * LROWB + s0 * 2) = (v2u){pk2(m[0], m[1]), pk2(m[2], m[3])};
        }
        __syncthreads();
        {
            bf16x8 Av[2], As[2];
#pragma unroll
            for (int ks = 0; ks < 2; ++ks) { Av[ks] = FRAG(L_VT, 16 * wave + fr, 32 * ks + 8 * fq); As[ks] = FRAG(L_ST, 16 * wave + fr, 32 * ks + 8 * fq); }
#pragma unroll
            for (int ct = 0; ct < 4; ++ct) {
                f32x4 acc = (f32x4){0.f, 0.f, 0.f, 0.f};
#pragma unroll
                for (int ks = 0; ks < 2; ++ks) { acc = mfma16(Av[ks], FRAG(L_S, 16 * ct + fr, 32 * ks + 8 * fq), acc); acc = mfma16(As[ks], FRAG(L_QD, 16 * ct + fr, 32 * ks + 8 * fq), acc); }
                *(LAS f32x4*)(lds + L_OB + (16 * ct + fr) * OBROW + (16 * wave + 4 * fq) * 4) = acc;
            }
        }
        __syncthreads();
        {
            const int c = tid >> 3, vg = tid & 7;
            const LAS f32x4* ob = (const LAS f32x4*)(lds + L_OB + c * OBROW + vg * 64);
            f32x4 o[4]; float ss = 0.f;
#pragma unroll
            for (int j = 0; j < 4; ++j) { o[j] = ob[j]; ss += (o[j].x * o[j].x + o[j].y * o[j].y) + (o[j].z * o[j].z + o[j].w * o[j].w); }
            ss += shx(ss, 1); ss += shx(ss, 2); ss += shx(ss, 4);
            const float rs = rsqrtf(ss * (1.0f / 128.0f) + EPS);
            const v4u* gr = (const v4u*)(P + (size_t)(t0 + c) * PLD + C_G + h * 128 + 16 * vg);
            float g0[8], g1[8]; unpack8(gr[0], g0); unpack8(gr[1], g1);
            const f32x4* gn = (const f32x4*)(gnorm + 16 * vg);
            const f32x4 n0 = gn[0], n1 = gn[1], n2 = gn[2], n3 = gn[3];
            v4u w0, w1;
            w0.x = pk2(o[0].x * rs * n0.x * silu_fast(g0[0]), o[0].y * rs * n0.y * silu_fast(g0[1])); w0.y = pk2(o[0].z * rs * n0.z * silu_fast(g0[2]), o[0].w * rs * n0.w * silu_fast(g0[3]));
            w0.z = pk2(o[1].x * rs * n1.x * silu_fast(g0[4]), o[1].y * rs * n1.y * silu_fast(g0[5])); w0.w = pk2(o[1].z * rs * n1.z * silu_fast(g0[6]), o[1].w * rs * n1.w * silu_fast(g0[7]));
            w1.x = pk2(o[2].x * rs * n2.x * silu_fast(g1[0]), o[2].y * rs * n2.y * silu_fast(g1[1])); w1.y = pk2(o[2].z * rs * n2.z * silu_fast(g1[2]), o[2].w * rs * n2.w * silu_fast(g1[3]));
            w1.z = pk2(o[3].x * rs * n3.x * silu_fast(g1[4]), o[3].y * rs * n3.y * silu_fast(g1[5])); w1.w = pk2(o[3].z * rs * n3.z * silu_fast(g1[6]), o[3].w * rs * n3.w * silu_fast(g1[7]));
            v4u* op = (v4u*)(K.XN() + (size_t)(t0 + c) * D + h * 128 + 16 * vg);
            op[0] = w0; op[1] = w1;
        }
    }
}
#undef FRAG


constexpr int L_GKL = 109568, L_BL = 117760, SCN = 4, NSC = GN / SCN, NITEM = NB * GH * NSC;
#define FRAG(base, row, kel) (*(const LAS bf16x8*)(lds + (base) + (row) * LROWB + (kel) * 2))
struct GlaPre { unsigned short k[8], q[8], v[16]; v4u g0, g1; };
template <bool WITH_Q>
__device__ __forceinline__ void gla_prefetch(GlaPre& p, const bf16* P, int h, int t0, int tid, int lane, int wave) {
    const bf16* kp = P + (size_t)(t0 + 8 * wave) * PLD + C_K + h * 64 + lane;
#pragma unroll
    for (int j = 0; j < 8; ++j) p.k[j] = kp[(size_t)j * PLD];
    const int vv = tid & 127, cq = tid >> 7;
    const bf16* vp = P + (size_t)(t0 + 16 * cq) * PLD + C_V + h * 128 + vv;
#pragma unroll
    for (int j = 0; j < 16; ++j) p.v[j] = vp[(size_t)j * PLD];
    if (WITH_Q) {
        const bf16* qp = kp + (C_Q - C_K);
#pragma unroll
        for (int j = 0; j < 8; ++j) p.q[j] = qp[(size_t)j * PLD];
        const v4u* gr = (const v4u*)(P + (size_t)(t0 + (tid >> 3)) * PLD + C_G + h * 128 + 16 * (tid & 7));
        p.g0 = gr[0]; p.g1 = gr[1];
    }
}
__device__ __forceinline__ void gla_stage_gkl(const bf16* P, LAS unsigned char* lds, int tok0, int tid) {
    *(LAS v4u*)(lds + L_GKL + tid * 16) = *(const v4u*)(P + (size_t)(tok0 + (tid >> 1)) * PLD + C_GK + 8 * (tid & 1));
}
__device__ __forceinline__ void gla_b8_part(LAS unsigned char* lds, const float (&wu)[16], float bg, int n, int lane, int wave, float (&bv)[8]) {
    float run = 0.f;
#pragma unroll
    for (int j = 0; j < 8; ++j) {
        const LAS v4u* gl = (const LAS v4u*)(lds + L_GKL + (n * 64 + 8 * wave + j) * 32);
        float f0[8], f1[8]; unpack8(gl[0], f0); unpack8(gl[1], f1);
        float a = bg;
#pragma unroll
        for (int r = 0; r < 8; ++r) a += f0[r] * wu[r];
#pragma unroll
        for (int r = 0; r < 8; ++r) a += f1[r] * wu[8 + r];
        run += logsig_fast(a) * (1.0f / 16.0f); bv[j] = run;
    }
    ((LAS float*)(lds + L_TOT))[wave * 64 + lane] = run;
}
__device__ __forceinline__ float gla_b8_finish(LAS unsigned char* lds, int lane, int wave, float (&bv)[8]) {
    const LAS float* tot = (const LAS float*)(lds + L_TOT);
    float base = 0.f, all = 0.f;
#pragma unroll
    for (int g = 0; g < 8; ++g) { const float tv = tot[g * 64 + lane]; all += tv; if (g < wave) base += tv; }
#pragma unroll
    for (int j = 0; j < 8; ++j) bv[j] += base;
    return all;
}
__device__ __forceinline__ void gla_write_kdT_vT(LAS unsigned char* lds, const GlaPre& p, const float (&bv)[8], float bl, int tid, int lane, int wave) {
    float kd[8];
#pragma unroll
    for (int j = 0; j < 8; ++j) kd[j] = bf2f(p.k[j]) * fexp(bl - bv[j]);
    *(LAS v4u*)(lds + L_KDT + lane * LROWB + wave * 16) = (v4u){pk2(kd[0], kd[1]), pk2(kd[2], kd[3]), pk2(kd[4], kd[5]), pk2(kd[6], kd[7])};
    const int vv = tid & 127, cq = tid >> 7;
    LAS v4u* dst = (LAS v4u*)(lds + L_VT + vv * LROWB + cq * 32);
    dst[0] = (v4u){(unsigned)p.v[0] | ((unsigned)p.v[1] << 16), (unsigned)p.v[2] | ((unsigned)p.v[3] << 16), (unsigned)p.v[4] | ((unsigned)p.v[5] << 16), (unsigned)p.v[6] | ((unsigned)p.v[7] << 16)};
    dst[1] = (v4u){(unsigned)p.v[8] | ((unsigned)p.v[9] << 16), (unsigned)p.v[10] | ((unsigned)p.v[11] << 16), (unsigned)p.v[12] | ((unsigned)p.v[13] << 16), (unsigned)p.v[14] | ((unsigned)p.v[15] << 16)};
    if (wave == 0) ((LAS float*)(lds + L_BL))[lane] = bl;
}
__device__ __forceinline__ void gla_kv_mfma(LAS unsigned char* lds, int wave, int fr, int fq, f32x4 (&acc)[4]) {
    bf16x8 Bf[2];
#pragma unroll
    for (int ks = 0; ks < 2; ++ks) Bf[ks] = FRAG(L_VT, 16 * wave + fr, 32 * ks + 8 * fq);
#pragma unroll
    for (int dt = 0; dt < 4; ++dt) { acc[dt] = (f32x4){0.f, 0.f, 0.f, 0.f};
#pragma unroll
        for (int ks = 0; ks < 2; ++ks) acc[dt] = mfma16(FRAG(L_KDT, 16 * dt + fr, 32 * ks + 8 * fq), Bf[ks], acc[dt]); }
}

__device__ __forceinline__ void phase_gla_A2(Frame& F, int l) {
    const KA K = KA::fresh(); PHASE_TID;
    LAS unsigned char* lds = F.lds;
    const int fr = lane & 15, fq = lane >> 4;
#pragma unroll 1
    for (int it = F.bx; it < NITEM; it += F.G) {
        const int b = it / (GH * NSC), h = (it / NSC) % GH, sc = it % NSC, tok0 = b * S + sc * SCN * GC;
        const bf16* P = K.P();
        float wu[16];
        { const float* wup = K.in(3) + (size_t)l * 16 * 256 + h * 64 + lane;
#pragma unroll
          for (int r = 0; r < 16; ++r) wu[r] = wup[r * 256]; }
        const float bg = K.in(4)[l * 256 + h * 64 + lane];
        GlaPre pre[2]; gla_prefetch<false>(pre[0], P, h, tok0, tid, lane, wave); gla_prefetch<false>(pre[1], P, h, tok0 + GC, tid, lane, wave);
        __syncthreads();
        gla_stage_gkl(P, lds, tok0, tid);
        __syncthreads();
        f32x4 Sl[4], bs[4];
#pragma unroll
        for (int dt = 0; dt < 4; ++dt) { Sl[dt] = (f32x4){0.f, 0.f, 0.f, 0.f}; bs[dt] = (f32x4){0.f, 0.f, 0.f, 0.f}; }
#pragma unroll
        for (int n = 0; n < SCN; ++n) {
            float bv[8]; gla_b8_part(lds, wu, bg, n, lane, wave, bv);
            __syncthreads();
            const float bl = gla_b8_finish(lds, lane, wave, bv);
            gla_write_kdT_vT(lds, pre[n & 1], bv, bl, tid, lane, wave);
            if (n + 2 < SCN) gla_prefetch<false>(pre[n & 1], P, h, tok0 + (n + 2) * GC, tid, lane, wave);
            __syncthreads();
            f32x4 acc[4]; gla_kv_mfma(lds, wave, fr, fq, acc);
#pragma unroll
            for (int dt = 0; dt < 4; ++dt) { const f32x4 bl4 = *(const LAS f32x4*)(lds + L_BL + (16 * dt + 4 * fq) * 4);
                bs[dt] = bs[dt] + bl4;
#pragma unroll
                for (int r = 0; r < 4; ++r) Sl[dt][r] = fexp(bl4[r]) * Sl[dt][r] + acc[dt][r]; }
        }
        f32x4* ag = (f32x4*)K.Sst() + ((size_t)(it * 8 + wave) * 4) * 64 + lane;
#pragma unroll
        for (int dt = 0; dt < 4; ++dt) ag[dt * 64] = Sl[dt];
        if (wave == 0 && fr == 0) { f32x4* dp = (f32x4*)K.dec() + (size_t)it * 16 + fq;
#pragma unroll
            for (int dt = 0; dt < 4; ++dt) dp[dt * 4] = (f32x4){fexp(bs[dt][0]), fexp(bs[dt][1]), fexp(bs[dt][2]), fexp(bs[dt][3])}; }
    }
}


__device__ __forceinline__ void phase_gla_aggscan(Frame& F) {
    const KA K = KA::fresh(); PHASE_TID;
#pragma unroll 1
    for (int e = F.bx * NT + tid; e < NB * GH * 8192; e += F.G * NT) {
        const int bh = e >> 13, el = e & 8191, ln = (el >> 2) & 63, dt = (el >> 8) & 3, r = el & 3;
        float* ap = K.Sst() + (size_t)bh * NSC * 8192 + el; const float* dp = K.dec() + (size_t)bh * NSC * 64 + dt * 16 + (ln >> 4) * 4 + r;
        float a[NSC], d[NSC];
#pragma unroll
        for (int j = 0; j < NSC; ++j) { a[j] = ap[(size_t)j * 8192]; d[j] = dp[j * 64]; }
        float st = 0.f;
#pragma unroll
        for (int j = 0; j < NSC; ++j) { ap[(size_t)j * 8192] = st; st = d[j] * st + a[j]; }
    }
}
__device__ __forceinline__ void phase_gla_C2(Frame& F, int l) {
    const KA K = KA::fresh(); PHASE_TID;
    LAS unsigned char* lds = F.lds;
    const int fr = lane & 15, fq = lane >> 4;
    const float* gnorm = K.in(5) + (size_t)l * 128;
#pragma unroll 1
    for (int it = F.bx; it < NITEM; it += F.G) {
        const int b = it / (GH * NSC), h = (it / NSC) % GH, sc = it % NSC, tok0 = b * S + sc * SCN * GC;
        const bf16* P = K.P();
        float wu[16];
        { const float* wup = K.in(3) + (size_t)l * 16 * 256 + h * 64 + lane;
#pragma unroll
          for (int r = 0; r < 16; ++r) wu[r] = wup[r * 256]; }
        const float bg = K.in(4)[l * 256 + h * 64 + lane];
        GlaPre pre[2]; gla_prefetch<true>(pre[0], P, h, tok0, tid, lane, wave); gla_prefetch<true>(pre[1], P, h, tok0 + GC, tid, lane, wave);
        __syncthreads();
        gla_stage_gkl(P, lds, tok0, tid);
        f32x4 Sm[4];
        { const f32x4* ag = (const f32x4*)K.Sst() + ((size_t)(it * 8 + wave) * 4) * 64 + lane;
#pragma unroll
          for (int dt = 0; dt < 4; ++dt) Sm[dt] = ag[dt * 64]; }
        __syncthreads();
#pragma unroll
        for (int n = 0; n < SCN; ++n) {
            const int t0 = tok0 + n * GC;
            GlaPre& pr = pre[n & 1];
            float bv[8]; gla_b8_part(lds, wu, bg, n, lane, wave, bv);
            __syncthreads();
            const float bl = gla_b8_finish(lds, lane, wave, bv);
            gla_write_kdT_vT(lds, pr, bv, bl, tid, lane, wave);
#pragma unroll
            for (int j = 0; j < 8; ++j) {
                const float e = fexp(bv[j]);
                *(LAS bf16*)(lds + L_QD + (8 * wave + j) * LROWB + lane * 2) = (bf16)f2bf(bf2f(pr.q[j]) * 0.125f * e);
                *(LAS bf16*)(lds + L_KI + (8 * wave + j) * LROWB + lane * 2) = (bf16)f2bf(bf2f(pr.k[j]) * __builtin_amdgcn_rcpf(e));
            }
#pragma unroll
            for (int dt = 0; dt < 4; ++dt) *(LAS v2u*)(lds + L_ST + (16 * wave + fr) * LROWB + (16 * dt + 4 * fq) * 2) = (v2u){pk2(Sm[dt][0], Sm[dt][1]), pk2(Sm[dt][2], Sm[dt][3])};
            const v4u gq0 = pr.g0, gq1 = pr.g1;
            if (n + 2 < SCN) gla_prefetch<true>(pr, P, h, t0 + 2 * GC, tid, lane, wave);
            __syncthreads();
#pragma unroll
            for (int i = 0; i < 2; ++i) {
                const int tix = 2 * wave + i, st = tix >> 2, ct = tix & 3;
                f32x4 a = (f32x4){0.f, 0.f, 0.f, 0.f};
#pragma unroll
                for (int ks = 0; ks < 2; ++ks) a = mfma16(FRAG(L_KI, 16 * st + fr, 32 * ks + 8 * fq), FRAG(L_QD, 16 * ct + fr, 32 * ks + 8 * fq), a);
                const int s0 = 16 * st + 4 * fq, c = 16 * ct + fr;
                float m[4];
#pragma unroll
                for (int r = 0; r < 4; ++r) m[r] = (s0 + r <= c) ? a[r] : 0.f;
                *(LAS v2u*)(lds + L_S + c * LROWB + s0 * 2) = (v2u){pk2(m[0], m[1]), pk2(m[2], m[3])};
            }
            f32x4 kv[4]; gla_kv_mfma(lds, wave, fr, fq, kv);
            __syncthreads();
            {
                bf16x8 Av[2], As[2];
#pragma unroll
                for (int ks = 0; ks < 2; ++ks) { Av[ks] = FRAG(L_VT, 16 * wave + fr, 32 * ks + 8 * fq); As[ks] = FRAG(L_ST, 16 * wave + fr, 32 * ks + 8 * fq); }
#pragma unroll
                for (int ct = 0; ct < 4; ++ct) {
                    f32x4 a = (f32x4){0.f, 0.f, 0.f, 0.f};
#pragma unroll
                    for (int ks = 0; ks < 2; ++ks) { a = mfma16(Av[ks], FRAG(L_S, 16 * ct + fr, 32 * ks + 8 * fq), a); a = mfma16(As[ks], FRAG(L_QD, 16 * ct + fr, 32 * ks + 8 * fq), a); }
                    *(LAS f32x4*)(lds + L_OB + (16 * ct + fr) * OBROW + (16 * wave + 4 * fq) * 4) = a;
                }
            }
#pragma unroll
            for (int dt = 0; dt < 4; ++dt) { const f32x4 bl4 = *(const LAS f32x4*)(lds + L_BL + (16 * dt + 4 * fq) * 4);
#pragma unroll
                for (int r = 0; r < 4; ++r) Sm[dt][r] = fexp(bl4[r]) * Sm[dt][r] + kv[dt][r]; }
            __syncthreads();
            {
                const int c = tid >> 3, vg = tid & 7;
                const LAS f32x4* ob = (const LAS f32x4*)(lds + L_OB + c * OBROW + vg * 64);
                f32x4 o[4]; float ss = 0.f;
#pragma unroll
                for (int j = 0; j < 4; ++j) { o[j] = ob[j]; ss += (o[j].x * o[j].x + o[j].y * o[j].y) + (o[j].z * o[j].z + o[j].w * o[j].w); }
                ss += shx(ss, 1); ss += shx(ss, 2); ss += shx(ss, 4);
                const float rs = rsqrtf(ss * (1.0f / 128.0f) + EPS);
                float g0[8], g1[8]; unpack8(gq0, g0); unpack8(gq1, g1);
                const f32x4* gn = (const f32x4*)(gnorm + 16 * vg);
                const f32x4 n0 = gn[0], n1 = gn[1], n2 = gn[2], n3 = gn[3];
                v4u w0, w1;
                w0.x = pk2(o[0].x * rs * n0.x * silu_fast(g0[0]), o[0].y * rs * n0.y * silu_fast(g0[1])); w0.y = pk2(o[0].z * rs * n0.z * silu_fast(g0[2]), o[0].w * rs * n0.w * silu_fast(g0[3]));
                w0.z = pk2(o[1].x * rs * n1.x * silu_fast(g0[4]), o[1].y * rs * n1.y * silu_fast(g0[5])); w0.w = pk2(o[1].z * rs * n1.z * silu_fast(g0[6]), o[1].w * rs * n1.w * silu_fast(g0[7]));
                w1.x = pk2(o[2].x * rs * n2.x * silu_fast(g1[0]), o[2].y * rs * n2.y * silu_fast(g1[1])); w1.y = pk2(o[2].z * rs * n2.z * silu_fast(g1[2]), o[2].w * rs * n2.w * silu_fast(g1[3]));
                w1.z = pk2(o[3].x * rs * n3.x * silu_fast(g1[4]), o[3].y * rs * n3.y * silu_fast(g1[5])); w1.w = pk2(o[3].z * rs * n3.z * silu_fast(g1[6]), o[3].w * rs * n3.w * silu_fast(g1[7]));
                v4u* op = (v4u*)(K.XN() + (size_t)(t0 + c) * D + h * 128 + 16 * vg);
                op[0] = w0; op[1] = w1;
            }
        }
    }
}
#undef FRAG

constexpr int GM_ROWB = 272;
__device__ __forceinline__ void phase_gmlp_mfma(Frame& F, int l) {
    const KA K = KA::fresh(); PHASE_TID;
    LAS unsigned char* lds = F.lds;
    const int fr = lane & 15, fq = lane >> 4;
#pragma unroll 1
    for (int u = F.bx; u < NB * MN * MH; u += F.G) {
        const int b = u / (MN * MH), n = (u / MH) % MN, h = u % MH, t0 = b * S + n * MC;
        const bf16* P = K.P();
        const float gn = K.in(6)[(size_t)l * 256 + h * 64 + lane];
        __syncthreads();
#pragma unroll
        for (int q = 0; q < 2; ++q) {
            float vs[8];
#pragma unroll
            for (int i = 0; i < 8; ++i) {
                const float g = gelu_fast(bf2f(P[(size_t)(t0 + 16 * wave + 8 * q + i) * PLD + C_VG + h * 64 + lane]));
                const float ss = wave_sum(g * g);
                vs[i] = g * rsqrtf(ss * (1.0f / 64.0f) + EPS) * gn;
            }
            *(LAS v4u*)(lds + lane * GM_ROWB + (16 * wave + 8 * q) * 2) = (v4u){pk2(vs[0], vs[1]), pk2(vs[2], vs[3]), pk2(vs[4], vs[5]), pk2(vs[6], vs[7])};
        }
        __syncthreads();
        const bf16* Wb = K.Wsp() + ((size_t)(l * MH + h) * 128 + 16 * wave + fr) * 128 + 8 * fq;
        f32x4 acc[4];
#pragma unroll
        for (int dt = 0; dt < 4; ++dt) acc[dt] = (f32x4){0.f, 0.f, 0.f, 0.f};
        const int nks = (16 * wave + 15) / 32 + 1;
#pragma unroll
        for (int ks = 0; ks < 4; ++ks) if (ks < nks) {
            const bf16x8 Bf = *(const bf16x8*)(Wb + 32 * ks);
#pragma unroll
            for (int dt = 0; dt < 4; ++dt) acc[dt] = mfma16(*(const LAS bf16x8*)(lds + (16 * dt + fr) * GM_ROWB + (32 * ks + 8 * fq) * 2), Bf, acc[dt]);
        }
        const int t = 16 * wave + fr;
        const float bias = K.in(8)[(size_t)l * MH * 128 + h * 128 + t];
        const bf16* up = P + (size_t)(t0 + t) * PLD + C_U + h * 64 + 4 * fq;
        bf16* op = K.XN() + (size_t)(t0 + t) * D + 512 + h * 64 + 4 * fq;
#pragma unroll
        for (int dt = 0; dt < 4; ++dt) {
            const v2u uw = *(const v2u*)(up + 16 * dt);
            const float o0 = gelu_fast(bflo(uw.x)) * (acc[dt][0] + bias), o1 = gelu_fast(bfhi(uw.x)) * (acc[dt][1] + bias), o2 = gelu_fast(bflo(uw.y)) * (acc[dt][2] + bias), o3 = gelu_fast(bfhi(uw.y)) * (acc[dt][3] + bias);
            *(v2u*)(op + 16 * dt) = (v2u){pk2(o0, o1), pk2(o2, o3)};
        }
    }
}

__device__ __forceinline__ void phase_conv(Frame& F, int l) {
    const KA K = KA::fresh(); PHASE_TID;
    const float* wc = K.in(9) + (size_t)l * 3 * 256;
#pragma unroll 1
    for (int e = F.bx * NT + tid; e < T * 32; e += F.G * NT) {
        const int t = e >> 5, c0 = (e & 31) * 8, tl = t % S;
        const bf16* row = K.P() + (size_t)t * PLD;
        float y[8], xi[8], cg[8], bg[8];
        unpack8(*(const v4u*)(row + C_XI + c0), xi); unpack8(*(const v4u*)(row + C_CG + c0), cg); unpack8(*(const v4u*)(row + C_BG + c0), bg);
#pragma unroll
        for (int j = 0; j < 8; ++j) y[j] = wc[2 * 256 + c0 + j] * cg[j] * xi[j];
        if (tl >= 1) { unpack8(*(const v4u*)(row - PLD + C_XI + c0), xi); unpack8(*(const v4u*)(row - PLD + C_CG + c0), cg);
#pragma unroll
            for (int j = 0; j < 8; ++j) y[j] += wc[1 * 256 + c0 + j] * cg[j] * xi[j]; }
        if (tl >= 2) { unpack8(*(const v4u*)(row - 2 * PLD + C_XI + c0), xi); unpack8(*(const v4u*)(row - 2 * PLD + C_CG + c0), cg);
#pragma unroll
            for (int j = 0; j < 8; ++j) y[j] += wc[0 * 256 + c0 + j] * cg[j] * xi[j]; }
#pragma unroll
        for (int j = 0; j < 8; ++j) y[j] *= bg[j];
        *(v4u*)(K.XN() + (size_t)t * D + 768 + c0) = (v4u){pk2(y[0], y[1]), pk2(y[2], y[3]), pk2(y[4], y[5]), pk2(y[6], y[7])};
    }
}
__device__ __forceinline__ void phase_norm_router(Frame& F, int l) {
    const KA K = KA::fresh(); PHASE_TID;
    const float* gain = K.in(11) + (size_t)l * D;
    const float* wrg = K.in(12) + (size_t)l * D * 4; const float* brg = K.in(13) + (size_t)l * 4;
    const float* wre = K.in(14) + (size_t)l * D * 32; const float* bre = K.in(15) + (size_t)l * 32;
    int* cnt = (int*)(K.ctl() + CW_CNT + 64 * l);
#pragma unroll 1
    for (int t = F.bx * NWAVES + wave; t < T; t += F.G * NWAVES) {
        const f32x4* xr = (const f32x4*)(K.out() + (size_t)t * D) + lane;
        f32x4 v[4]; float s = 0.f;
#pragma unroll
        for (int j = 0; j < 4; ++j) { v[j] = xr[64 * j]; s += (v[j].x * v[j].x + v[j].y * v[j].y) + (v[j].z * v[j].z + v[j].w * v[j].w); }
        const float rs = rsqrtf(wave_sum(s) * (1.f / D) + EPS);
        v2u* o8 = (v2u*)(K.XN() + (size_t)t * D) + lane;
        float acc[36];
#pragma unroll
        for (int j = 0; j < 36; ++j) acc[j] = 0.f;
#pragma unroll
        for (int j = 0; j < 4; ++j) {
            const f32x4 g = ((const f32x4*)gain)[lane + 64 * j];
            const float hv[4] = {v[j].x * rs * g.x, v[j].y * rs * g.y, v[j].z * rs * g.z, v[j].w * rs * g.w};
            v2u w; w.x = pk2(hv[0], hv[1]); w.y = pk2(hv[2], hv[3]); o8[64 * j] = w;
#pragma unroll
            for (int i = 0; i < 4; ++i) {
                const int k = 4 * lane + 256 * j + i; const float xv = hv[i];
                const f32x4 g4 = *(const f32x4*)(wrg + (size_t)k * 4);
                acc[0] += xv * g4.x; acc[1] += xv * g4.y; acc[2] += xv * g4.z; acc[3] += xv * g4.w;
                const f32x4* e4 = (const f32x4*)(wre + (size_t)k * 32);
#pragma unroll
                for (int q = 0; q < 8; ++q) { const f32x4 w4 = e4[q]; acc[4 + 4 * q] += xv * w4.x; acc[5 + 4 * q] += xv * w4.y; acc[6 + 4 * q] += xv * w4.z; acc[7 + 4 * q] += xv * w4.w; }
            }
        }
#pragma unroll
        for (int j = 0; j < 36; ++j) acc[j] = wave_sum(acc[j]);
        if (lane == 0) {
            float gl[4]; int gt = 0;
#pragma unroll
            for (int j = 0; j < 4; ++j) gl[j] = acc[j] + brg[j];
            float gmax = gl[0];
#pragma unroll
            for (int j = 1; j < 4; ++j) if (gl[j] > gmax) { gmax = gl[j]; gt = j; }
            float gs = 0.f;
#pragma unroll
            for (int j = 0; j < 4; ++j) gs += expf(gl[j] - gmax);
            const float gw = 1.0f / gs;
            float el[8];
#pragma unroll
            for (int j = 0; j < 8; ++j) { float vv = 0.f;
#pragma unroll
                for (int g = 0; g < 4; ++g) if (g == gt) vv = acc[4 + g * 8 + j] + bre[g * 8 + j];
                el[j] = vv; }
            int i0 = 0; float m0 = el[0];
#pragma unroll
            for (int j = 1; j < 8; ++j) if (el[j] > m0) { m0 = el[j]; i0 = j; }
            int i1 = -1; float m1 = -INFINITY;
#pragma unroll
            for (int j = 0; j < 8; ++j) if (j != i0 && el[j] > m1) { m1 = el[j]; i1 = j; }
            const float e1 = expf(m1 - m0);
            const float w0 = gw / (1.0f + e1), w1 = gw * e1 / (1.0f + e1);
            const int e0i = gt * 8 + i0, e1i = gt * 8 + i1;
            K.eid()[2 * t] = e0i; K.eid()[2 * t + 1] = e1i; K.ew()[2 * t] = w0; K.ew()[2 * t + 1] = w1;
            atomicAdd(&cnt[e0i], 1); atomicAdd(&cnt[e1i], 1);
        }
    }
}
constexpr int RT_PART = 0, RT_SS = RT_PART + 2 * 4 * 16 * 48 * 4, RT_RS = RT_SS + 2 * 4 * 16 * 4, RT_HIST = RT_RS + 2 * 16 * 4;
__device__ __forceinline__ void phase_norm_router_mfma(Frame& F, int l) {
    const KA K = KA::fresh(); PHASE_TID;
    LAS unsigned char* lds = F.lds;
    const int fr = lane & 15, fq = lane >> 4, tl = wave >> 2, kq = wave & 3;
    const bf16* Whi = K.Wr() + (size_t)l * 2 * 48 * D; const bf16* Wlo = Whi + 48 * D;
    const float* gain = K.in(11) + (size_t)l * D;
#pragma unroll 1
    for (int blk = F.bx; blk < T / 64; blk += F.G) {
        __syncthreads();
        if (tid < NE) ((LAS int*)(lds + RT_HIST))[tid] = 0;
#pragma unroll 1
        for (int half = 0; half < 2; ++half) {
            const int tok0 = blk * 64 + half * 32 + tl * 16;
            const bf16* xr = K.XR() + (size_t)(tok0 + fr) * D + 256 * kq + 8 * fq;
            const bf16* whi = Whi + (size_t)fr * D + 256 * kq + 8 * fq; const bf16* wlo = Wlo + (size_t)fr * D + 256 * kq + 8 * fq;
            f32x4 acc[3];
#pragma unroll
            for (int nt = 0; nt < 3; ++nt) acc[nt] = (f32x4){0.f, 0.f, 0.f, 0.f};
            float ss = 0.f;
            v4u xa[8];
            bf16x8 Wh[3][3], Wl[3][3];
#define RT_LOADW(slot, ks) do { _Pragma("unroll") for (int nt = 0; nt < 3; ++nt) { Wh[slot][nt] = *(const bf16x8*)(whi + (size_t)(16 * nt) * D + 32 * (ks)); Wl[slot][nt] = *(const bf16x8*)(wlo + (size_t)(16 * nt) * D + 32 * (ks)); } } while (0)
#pragma unroll
            for (int ks = 0; ks < 8; ++ks) xa[ks] = *(const v4u*)(xr + 32 * ks);
            RT_LOADW(0, 0); RT_LOADW(1, 1); RT_LOADW(2, 2);
#pragma unroll
            for (int ks = 0; ks < 8; ++ks) {
                __builtin_amdgcn_sched_barrier(0);
                float xv[8]; unpack8(xa[ks], xv);
#pragma unroll
                for (int j = 0; j < 8; ++j) ss += xv[j] * xv[j];
                const bf16x8 Ah = __builtin_bit_cast(bf16x8, xa[ks]);
#pragma unroll
                for (int nt = 0; nt < 3; ++nt) { acc[nt] = mfma16(Ah, Wh[ks % 3][nt], acc[nt]); acc[nt] = mfma16(Ah, Wl[ks % 3][nt], acc[nt]); }
                __builtin_amdgcn_sched_barrier(0);
                if (ks + 3 < 8) RT_LOADW(ks % 3, ks + 3);
            }
#undef RT_LOADW
            ss += shx(ss, 16); ss += shx(ss, 32);
            {
                LAS float* part = (LAS float*)(lds + RT_PART) + (tl * 4 + kq) * 16 * 48;
#pragma unroll
                for (int nt = 0; nt < 3; ++nt)
#pragma unroll
                    for (int r = 0; r < 4; ++r) part[(4 * fq + r) * 48 + 16 * nt + fr] = acc[nt][r];
                if (fq == 0) ((LAS float*)(lds + RT_SS))[(tl * 4 + kq) * 16 + fr] = ss;
            }
            __syncthreads();
            if (kq < 2) {
                const int tt = kq * 8 + (lane >> 3), j = lane & 7, t = tok0 + tt;
                const LAS float* p0 = (const LAS float*)(lds + RT_PART) + (tl * 4) * 16 * 48 + tt * 48;
                const LAS float* s2 = (const LAS float*)(lds + RT_SS) + (tl * 4) * 16 + tt;
                const float rs = rsqrtf(((s2[0] + s2[16]) + (s2[32] + s2[48])) * (1.f / D) + EPS);
#define RT_DOT(n) ((p0[(n)] + p0[768 + (n)]) + (p0[1536 + (n)] + p0[2304 + (n)]))
                float gv = (j < 4) ? RT_DOT(j & 3) * rs + K.in(13)[(size_t)l * 4 + (j & 3)] : -INFINITY; int gi = j;
                const float gmine = gv;
#pragma unroll
                for (int o = 1; o < 8; o <<= 1) { const float ov = shx(gv, o); const int oi = __float_as_int(shx(__int_as_float(gi), o)); if (ov > gv || (ov == gv && oi < gi)) { gv = ov; gi = oi; } }
                float ge = (j < 4) ? expf(gmine - gv) : 0.f;
#pragma unroll
                for (int o = 1; o < 8; o <<= 1) ge += shx(ge, o);
                const float gw = 1.0f / ge; const int gt = gi;
                const float ev = RT_DOT(4 + gt * 8 + j) * rs + K.in(15)[(size_t)l * 32 + gt * 8 + j];
#undef RT_DOT
                float m0 = ev; int i0 = j;
#pragma unroll
                for (int o = 1; o < 8; o <<= 1) { const float ov = shx(m0, o); const int oi = __float_as_int(shx(__int_as_float(i0), o)); if (ov > m0 || (ov == m0 && oi < i0)) { m0 = ov; i0 = oi; } }
                float m1 = (j == i0) ? -INFINITY : ev; int i1 = j;
#pragma unroll
                for (int o = 1; o < 8; o <<= 1) { const float ov = shx(m1, o); const int oi = __float_as_int(shx(__int_as_float(i1), o)); if (ov > m1 || (ov == m1 && oi < i1)) { m1 = ov; i1 = oi; } }
                if (j == 0) {
                    ((LAS float*)(lds + RT_RS))[tl * 16 + tt] = rs;
                    const float e1 = expf(m1 - m0);
                    const float w0 = gw / (1.0f + e1), w1 = gw * e1 / (1.0f + e1);
                    const int e0i = gt * 8 + i0, e1i = gt * 8 + i1;
                    K.eid()[2 * t] = e0i; K.eid()[2 * t + 1] = e1i; K.ew()[2 * t] = w0; K.ew()[2 * t + 1] = w1;
                    LAS int* hist = (LAS int*)(lds + RT_HIST);
                    K.slot_of()[2 * t] = __hip_atomic_fetch_add(hist + e0i, 1, __ATOMIC_RELAXED, __HIP_MEMORY_SCOPE_WORKGROUP);
                    K.slot_of()[2 * t + 1] = __hip_atomic_fetch_add(hist + e1i, 1, __ATOMIC_RELAXED, __HIP_MEMORY_SCOPE_WORKGROUP);
                }
            }
            __syncthreads();
            {
                const float rs = ((const LAS float*)(lds + RT_RS))[tl * 16 + fr];
                bf16* hp = K.XN() + (size_t)(tok0 + fr) * D + 256 * kq + 8 * fq;
                const float* gp = gain + 256 * kq + 8 * fq;
#pragma unroll
                for (int ks = 0; ks < 8; ++ks) {
                    asm volatile("" : "+v"(xa[ks]));
                    float xv[8]; unpack8(xa[ks], xv);
                    const f32x4 g0 = *(const f32x4*)(gp + 32 * ks), g1 = *(const f32x4*)(gp + 32 * ks + 4);
                    *(v4u*)(hp + 32 * ks) = (v4u){pk2(xv[0] * rs * g0.x, xv[1] * rs * g0.y), pk2(xv[2] * rs * g0.z, xv[3] * rs * g0.w), pk2(xv[4] * rs * g1.x, xv[5] * rs * g1.y), pk2(xv[6] * rs * g1.z, xv[7] * rs * g1.w)};
                }
            }
        }
        __syncthreads();
        if (tid < NE) K.blkcnt()[(size_t)(l * (T / 64) + blk) * NE + tid] = ((LAS int*)(lds + RT_HIST))[tid];
    }
}
__device__ __forceinline__ void phase_scatter(Frame& F, int l) {
    const KA K = KA::fresh(); PHASE_TID;
    LAS int* sm = (LAS int*)F.lds;
    const int* bc = K.blkcnt() + (size_t)l * (T / 64) * NE;
    constexpr int NBLK = T / 64;
#pragma unroll 1
    for (int blk = F.bx; blk < NBLK; blk += F.G) {
        __syncthreads();
        {   const int e = tid & 31, part = tid >> 5;
            int tot = 0, pre = 0;
#pragma unroll
            for (int j = 0; j < NBLK / 16; ++j) { const int bb = part * (NBLK / 16) + j; const int c = bc[bb * NE + e]; tot += c; if (bb < blk) pre += c; }
            sm[part * 32 + e] = tot; sm[512 + part * 32 + e] = pre; }
        __syncthreads();
        if (tid < 32) { int tot = 0, pre = 0;
#pragma unroll
            for (int p = 0; p < 16; ++p) { tot += sm[p * 32 + tid]; pre += sm[512 + p * 32 + tid]; }
            sm[1056 + tid] = tot; sm[1024 + tid] = pre; }
        __syncthreads();
        if (tid == 0) { int a = 0; for (int e = 0; e < NE; ++e) { const int c = sm[1056 + e]; sm[1024 + e] += a; a += c; } }
        if (blk == 0 && tid < 32) ((int*)(K.ctl() + CW_CNT + 64 * l))[tid] = sm[1056 + tid];
        __syncthreads();
        if (tid < 128) { const int a = blk * 128 + tid; const int e = K.eid()[a]; const int pos = sm[1024 + e] + K.slot_of()[a]; K.slot_tok()[pos] = a >> 1; K.slot_of()[a] = pos; }
    }
    __syncthreads();
}
template <bool DUAL>
__device__ __forceinline__ void gemm_core(const bf16* A, const int* rowoff, int K, const float* B0, const float* B1, int ldb, int n0,
                                          float (&acc0)[4][4], float (&acc1)[4][4], float* As, float* Bs0, float* Bs1) {
    const int tid = __builtin_amdgcn_readfirstlane(threadIdx.x >> 6) * 64 + fresh_lane(), tx = tid & 15, ty = tid >> 4;
    const int ar = tid >> 2, ak = (tid & 3) * 4;
    const int bk = (tid >> 4) & 15, bn = (tid & 15) * 4;
    const long aoff = rowoff[ar];
#pragma unroll
    for (int i = 0; i < 4; ++i)
#pragma unroll
        for (int j = 0; j < 4; ++j) { acc0[i][j] = 0.f; acc1[i][j] = 0.f; }
#pragma unroll 1
    for (int k0 = 0; k0 < K; k0 += 16) {
        v2u av = (v2u){0u, 0u};
        if (aoff >= 0) av = *(const v2u*)(A + aoff + k0 + ak);
        f32x4 bv0 = (f32x4){0.f, 0.f, 0.f, 0.f}, bv1 = bv0;
        if (tid < 256) { bv0 = *(const f32x4*)(B0 + (size_t)(k0 + bk) * ldb + n0 + bn); if (DUAL) bv1 = *(const f32x4*)(B1 + (size_t)(k0 + bk) * ldb + n0 + bn); }
        __syncthreads();
        As[(ak + 0) * 132 + ar] = bflo(av.x); As[(ak + 1) * 132 + ar] = bfhi(av.x); As[(ak + 2) * 132 + ar] = bflo(av.y); As[(ak + 3) * 132 + ar] = bfhi(av.y);
        if (tid < 256) { *(f32x4*)(Bs0 + bk * 64 + bn) = bv0; if (DUAL) *(f32x4*)(Bs1 + bk * 64 + bn) = bv1; }
        __syncthreads();
#pragma unroll
        for (int kk = 0; kk < 16; ++kk) {
            const f32x4 a4 = *(const f32x4*)(As + kk * 132 + ty * 4);
            const f32x4 b4 = *(const f32x4*)(Bs0 + kk * 64 + tx * 4);
#pragma unroll
            for (int i = 0; i < 4; ++i)
#pragma unroll
                for (int j = 0; j < 4; ++j) acc0[i][j] += a4[i] * b4[j];
            if (DUAL) {
                const f32x4 c4 = *(const f32x4*)(Bs1 + kk * 64 + tx * 4);
#pragma unroll
                for (int i = 0; i < 4; ++i)
#pragma unroll
                    for (int j = 0; j < 4; ++j) acc1[i][j] += a4[i] * c4[j];
            }
        }
    }
}
template <int MODE>
__device__ __forceinline__ void phase_moe_ref(Frame& F, int l) {
    const KA K = KA::fresh(); PHASE_TID;
    float* As = F.smem; float* Bs0 = F.smem + 16 * 132; float* Bs1 = Bs0 + 16 * 64; int* rowoff = (int*)(Bs1 + 16 * 64); int* offs = rowoff + 128; int* toff = offs + 33;
    int* cnt = (int*)(K.ctl() + CW_CNT + 64 * l);
    const int tx = tid & 15, ty = tid >> 4;
    __syncthreads();
    if (tid == 0) { int a = 0, tt = 0; for (int e = 0; e < NE; ++e) { offs[e] = a; toff[e] = tt; const int c = cnt[e]; a += c; tt += (c + 127) / 128; } offs[NE] = a; toff[NE] = tt; }
    __syncthreads();
    constexpr int N = (MODE == 1) ? DE : D, KD = (MODE == 1) ? D : DE, NTN = N / 64;
    const int ntiles = toff[NE] * NTN;
#pragma unroll 1
    for (int t = F.bx; t < ntiles; t += F.G) {
        const int rt = t / NTN, tn = t % NTN;
        int e = 0;
        for (int j = 1; j < NE; ++j) if (toff[j] <= rt) e = j;
        const int r0 = offs[e] + (rt - toff[e]) * 128, rend = offs[e + 1];
        __syncthreads();
        if (tid < 128) { const int r = r0 + tid; rowoff[tid] = (r < rend) ? ((MODE == 1) ? K.slot_tok()[r] * D : r * DE) : -1; }
        __syncthreads();
        float acc0[4][4], acc1[4][4];
        if (MODE == 1) {
            const float* Wg = K.in(16) + ((size_t)l * NE + e) * D * DE; const float* Wu = K.in(17) + ((size_t)l * NE + e) * D * DE;
            gemm_core<true>(K.XN(), rowoff, KD, Wg, Wu, DE, tn * 64, acc0, acc1, As, Bs0, Bs1);
        } else {
            const float* Wd = K.in(18) + ((size_t)l * NE + e) * DE * D;
            gemm_core<false>(K.H1(), rowoff, KD, Wd, nullptr, D, tn * 64, acc0, acc1, As, Bs0, nullptr);
        }
#pragma unroll
        for (int i = 0; i < 4; ++i) {
            const int r = r0 + ty * 4 + i;
            if (r < rend) {
                v2u o;
                if (MODE == 1) { o.x = pk2(silu(acc0[i][0]) * acc1[i][0], silu(acc0[i][1]) * acc1[i][1]); o.y = pk2(silu(acc0[i][2]) * acc1[i][2], silu(acc0[i][3]) * acc1[i][3]);
                    *(v2u*)(K.H1() + (size_t)r * DE + tn * 64 + tx * 4) = o; }
                else { o.x = pk2(acc0[i][0], acc0[i][1]); o.y = pk2(acc0[i][2], acc0[i][3]); *(v2u*)(K.Y() + (size_t)r * D + tn * 64 + tx * 4) = o; }
            }
        }
    }
    __syncthreads();
}

constexpr int TAB_OFF = LDSCTL_OFF + 1024;
__device__ __forceinline__ void moe_tables(Frame& F, int l) {
    const KA K = KA::fresh(); PHASE_TID;
    LAS int* tab = (LAS int*)(F.lds + TAB_OFF); LAS int* offs = tab + 4 + 4 * 164; LAS int* fpre = offs + 40; LAS int* ppre = fpre + 40;
    const int* cnt = (const int*)(K.ctl() + CW_CNT + 64 * l);
    __syncthreads();
    if (tid == 0) { int a = 0, f = 0, p = 0; for (int e = 0; e < NE; ++e) { const int c = cnt[e]; offs[e] = a; fpre[e] = f; ppre[e] = p; a += c; f += c >> 8; p += (c & 255) ? 1 : 0; }
        offs[NE] = a; fpre[NE] = f; ppre[NE] = p; tab[0] = f + p; }
    __syncthreads();
    const int nfull = fpre[NE], ntile = nfull + ppre[NE];
    if (tid < nfull) { int e = 0; for (int j = 1; j < NE; ++j) if (fpre[j] <= tid) e = j; tab[4 + 4 * tid] = e; tab[5 + 4 * tid] = offs[e] + (tid - fpre[e]) * 256; tab[6 + 4 * tid] = offs[e + 1]; }
    else if (tid < nfull + NE) {
        const int e = tid - nfull, rows = (offs[e + 1] - offs[e]) & 255;
        if (rows) { int rank = 0; for (int j = 0; j < NE; ++j) { const int rj = (offs[j + 1] - offs[j]) & 255; rank += (rj > rows || (rj == rows && j < e)) ? 1 : 0; }
            const int q = nfull + rank; tab[4 + 4 * q] = e; tab[5 + 4 * q] = offs[e] + (fpre[e + 1] - fpre[e]) * 256; tab[6 + 4 * q] = offs[e + 1]; }
    }
    __syncthreads();
    (void)ntile;
}
template <int SUB>
__device__ __forceinline__ void phase_moe(Frame& F, int l) {
    if (SUB == 0) moe_tables(F, l);
    const KA K = KA::fresh();
    int c_ = F.bx; asm volatile("" : "+s"(c_));
    const int G = F.G, c = (c_ & 7) * (G >> 3) + (c_ >> 3);
    const LAS int* tab = (const LAS int*)(F.lds + TAB_OFF);
    const int ntile = __builtin_amdgcn_readfirstlane(tab[0]), ngu = 2 * ntile, nleft = ngu > G ? ngu - G : 0, jX = ngu > G ? (G >> 1) : ntile, W = G - nleft;
    const int yd = (jX * 4 < 2 * W) ? jX * 4 : 2 * W;
    bool do_gu = false, do_dn = false; pg8::MoeSched So{tab, 2, 0, 0, G, c};
    if (SUB == 0) { do_gu = true; So.npn = 2; So.first = 0; So.end = ngu < G ? ngu : G; So.stride = G; So.c = c; }
    if (SUB == 1) { if (c < nleft) { do_gu = true; So.npn = 2; So.first = G; So.end = ngu; So.stride = G; So.c = c; }
                    else { do_dn = true; So.npn = 4; So.first = 0; So.end = yd; So.stride = W; So.c = c - nleft; } }
    if (SUB == 2) { do_dn = true; So.npn = 4; So.first = yd; So.end = ntile * 4; So.stride = G; So.c = c; }
    if (do_gu) { pg8::EpiMoeH E{K.H1()};
        pg8::gemm_phase_moe<pg8::EpiMoeH, pg8::MoeSched, true, 512, D>(F.lds, K.XN(), K.WguT() + (size_t)l * NE * 512 * D, K.slot_tok(), So, E, F.wave); }
    if (do_dn) { pg8::EpiMoeY E{K.Y()};
        pg8::gemm_phase_moe<pg8::EpiMoeY, pg8::MoeSched, false, D, DE>(F.lds, K.H1(), K.WdT() + (size_t)l * NE * D * DE, nullptr, So, E, F.wave); }
}
__device__ __forceinline__ void phase_combine(Frame& F, int l) {
    const KA K = KA::fresh(); PHASE_TID;
    const bool last = (l == DEPTH - 1);
    const float* gain = last ? K.in(19) : (K.in(1) + (size_t)(l + 1) * D);
#pragma unroll 1
    for (int t = F.bx * NWAVES + wave; t < T; t += F.G * NWAVES) {
        const int s0 = K.slot_of()[2 * t], s1 = K.slot_of()[2 * t + 1]; const float w0 = K.ew()[2 * t], w1 = K.ew()[2 * t + 1];
        v2u* xr = (v2u*)(K.XR() + (size_t)t * D) + lane;
        const v2u* y0 = (const v2u*)(K.Y() + (size_t)s0 * D) + lane; const v2u* y1 = (const v2u*)(K.Y() + (size_t)s1 * D) + lane;
        f32x4 v[4]; float s = 0.f;
#pragma unroll
        for (int j = 0; j < 4; ++j) { const v2u xw = xr[64 * j], a = y0[64 * j], b = y1[64 * j];
            v[j].x = bflo(xw.x) + w0 * bflo(a.x) + w1 * bflo(b.x); v[j].y = bfhi(xw.x) + w0 * bfhi(a.x) + w1 * bfhi(b.x); v[j].z = bflo(xw.y) + w0 * bflo(a.y) + w1 * bflo(b.y); v[j].w = bfhi(xw.y) + w0 * bfhi(a.y) + w1 * bfhi(b.y);
            s += (v[j].x * v[j].x + v[j].y * v[j].y) + (v[j].z * v[j].z + v[j].w * v[j].w); }
        const float rs = rsqrtf(wave_sum(s) * (1.f / D) + EPS);
        if (last) {
            f32x4* orow = (f32x4*)(K.out() + (size_t)t * D) + lane;
#pragma unroll
            for (int j = 0; j < 4; ++j) { const f32x4 g = ((const f32x4*)gain)[lane + 64 * j]; orow[64 * j] = (f32x4){v[j].x * rs * g.x, v[j].y * rs * g.y, v[j].z * rs * g.z, v[j].w * rs * g.w}; }
        } else {
            v2u* o8 = (v2u*)(K.XN() + (size_t)t * D) + lane;
#pragma unroll
            for (int j = 0; j < 4; ++j) { xr[64 * j] = (v2u){pk2(v[j].x, v[j].y), pk2(v[j].z, v[j].w)}; const f32x4 g = ((const f32x4*)gain)[lane + 64 * j];
                o8[64 * j] = (v2u){pk2(v[j].x * rs * g.x, v[j].y * rs * g.y), pk2(v[j].z * rs * g.z, v[j].w * rs * g.w)}; }
        }
    }
}

struct Args { const float* in[20]; float* out; unsigned char* ws; };
__global__ void __launch_bounds__(NT, 2) fwd_kernel(Args args) {
    extern __shared__ __attribute__((aligned(16))) unsigned char lds_raw[];
    Frame F;
    F.lds = (LAS unsigned char*)lds_raw; F.smem = (float*)lds_raw;
    F.G = gridDim.x; F.bx = blockIdx.x; F.wave = __builtin_amdgcn_readfirstlane(threadIdx.x >> 6);
    volatile LAS unsigned* MISC = (volatile LAS unsigned*)(F.lds + MISC_OFF);
    for (int u = threadIdx.x; u < (LDS_BYTES - LDSCTL_OFF) / 4; u += NT) ((LAS unsigned*)(F.lds + LDSCTL_OFF))[u] = 0u;
    __syncthreads();
    XcdBarrier bar; { const KA K = KA::fresh(); bar = xcd_barrier_post(K.ctl() + CW_BAR, MISC + 8); }
#define GRID_BAR() xcd_barrier(bar)

    p0_prologue(F);
    GRID_BAR();
    for (int l = 0; l < DEPTH; ++l) {
        {
            const KA K = KA::fresh(); PHASE_TID;
            pg8::Gemm g{K.XN(), K.WinT() + (size_t)l * PLD * D, T, PLD, D}; pg8::StaticOrder So; int c_ = F.bx; asm volatile("" : "+s"(c_)); So.init(T, PLD, F.G, c_);
            pg8::EpiBf16Plain E{K.P(), PLD};
            pg8::gemm_phase<pg8::EpiBf16Plain, pg8::StaticOrder, PG8_ALIGN, PG8_SP2>(F.lds, g, So, E, F.wave);
        }
        GRID_BAR();
        phase_gla_A2(F, l);
        phase_gmlp_mfma(F, l);
        phase_conv(F, l);
        GRID_BAR();
        phase_gla_aggscan(F);
        GRID_BAR();
        phase_gla_C2(F, l);
        GRID_BAR();
        {
            const KA K = KA::fresh(); PHASE_TID;
            pg8::Gemm g{K.XN(), K.WoutT() + (size_t)l * D * D, T, D, D}; pg8::StaticOrder So; int c_ = F.bx; asm volatile("" : "+s"(c_)); So.init(T, D, F.G, c_);
            if (l == 0) { pg8::EpiBf16Res<true> E{K.XR(), K.in(0), D}; pg8::gemm_phase<pg8::EpiBf16Res<true>, pg8::StaticOrder, PG8_ALIGN, PG8_SP2>(F.lds, g, So, E, F.wave); }
            else { pg8::EpiBf16Res<false> E{K.XR(), K.XR(), D}; pg8::gemm_phase<pg8::EpiBf16Res<false>, pg8::StaticOrder, PG8_ALIGN, PG8_SP2>(F.lds, g, So, E, F.wave); }
        }
        GRID_BAR();
        phase_norm_router_mfma(F, l);
        GRID_BAR();
        phase_scatter(F, l);
        GRID_BAR();
        phase_moe<0>(F, l);
        GRID_BAR();
        phase_moe<1>(F, l);
        GRID_BAR();
        phase_moe<2>(F, l);
        GRID_BAR();
        phase_combine(F, l);
        if (l + 1 < DEPTH) GRID_BAR();
    }
}

extern "C" void kernel_launch(void* const* d_in, const int* in_sizes, int n_in, void* d_out, int out_size, void* d_ws, size_t ws_size, hipStream_t stream) {
    static int grid_blocks = 0;
    if (!grid_blocks) {
        int dev = 0, cus = 0, per_cu = 0;
        (void)hipGetDevice(&dev);
        (void)hipDeviceGetAttribute(&cus, hipDeviceAttributeMultiprocessorCount, dev);
        (void)hipFuncSetAttribute((const void*)fwd_kernel, hipFuncAttributeMaxDynamicSharedMemorySize, LDS_BYTES);
        (void)hipOccupancyMaxActiveBlocksPerMultiprocessor(&per_cu, fwd_kernel, NT, LDS_BYTES);
        if (per_cu < 1) { fprintf(stderr, "kernel_launch: occupancy query says %d blocks/CU\n", per_cu); per_cu = 1; }
        grid_blocks = cus;
        if (ws_size < WS_END) { fprintf(stderr, "kernel_launch: workspace too small (%zu < %zu)\n", ws_size, (size_t)WS_END); grid_blocks = -1; }
    }
    if (grid_blocks < 0) return;
    (void)hipMemsetAsync((char*)d_ws + WS_CTL, 0, CTL_BYTES, stream);
    Args a{};
    for (int i = 0; i < 20; ++i) a.in[i] = (const float*)d_in[i];
    a.out = (float*)d_out; a.ws = (unsigned char*)d_ws;
    void* args[] = {&a};
    hipError_t e = hipLaunchCooperativeKernel((void*)fwd_kernel, dim3(grid_blocks), dim3(NT), args, LDS_BYTES, stream);
    if (e != hipSuccess) fprintf(stderr, "cooperative launch failed: %s (grid %d)\n", hipGetErrorString(e), grid_blocks);
}
```

```cpp
#include <hip/hip_runtime.h>
#include <hip/hip_cooperative_groups.h>
#include <cstdio>
#include <cstdint>
namespace cg = cooperative_groups;
__device__ __forceinline__ int fresh_lane() { unsigned m = 0xffffffffu; asm volatile("" : "+s"(m)); return (int)__builtin_amdgcn_mbcnt_hi(m, __builtin_amdgcn_mbcnt_lo(m, 0u)); }
__device__ __forceinline__ float shx(float v, int o) { return __int_as_float(__builtin_amdgcn_ds_bpermute((fresh_lane() ^ o) << 2, __float_as_int(v))); }
namespace pg8 {
#define PG8_LAS __attribute__((address_space(3)))
typedef unsigned short bf16_t;
typedef short bf16x8 __attribute__((ext_vector_type(8)));
typedef float f32x4 __attribute__((ext_vector_type(4)));
typedef unsigned u32x4 __attribute__((ext_vector_type(4)));
constexpr int BM = 256, BK = 64, HALF = 128, HTB = HALF * BK * 2  , STAGE_BYTES = 8 * HTB, NXCD = 8, WGM = 8;

__host__ __device__ __forceinline__ int lds_byte(int r, int c) { const int st = (r >> 4) * 2 + (c >> 5), rr = r & 15, cc = c & 31, ob = rr * 64 + cc * 2; return st * 1024 + (ob ^ (((ob >> 9) & 1) << 5)); }
__host__ __device__ __forceinline__ void stage_rc(int b, int& R, int& C) { const int st = b / 1024, sb = b % 1024, swz = sb ^ (((sb >> 9) & 1) << 5); R = (st >> 1) * 16 + swz / 64; C = (st & 1) * 32 + (swz % 64) / 2; }
__host__ __device__ __forceinline__ int perm32(int rho) { const int n = rho >> 4, i = rho & 15; return 8 * (i >> 2) + 4 * n + (i & 3); }

struct Unit { int pm, pn; };
struct Gemm { const bf16_t* A; const bf16_t* Bt; int M, N, K; };

struct StaticOrder {
    int nM, nN, nwg, G, c;
    __host__ __device__ void init(int M, int N, int G_, int c_) { nM = M / BM; nN = N / BM; nwg = nM * nN; G = G_; c = c_; }
    __host__ __device__ bool next(int i, Unit& u) const {
        const long L = (long)i * G + c; if (L >= nwg) return false;
        int wgid = (int)L; { const int q = nwg / NXCD, r = nwg % NXCD, xcd = wgid % NXCD, off = wgid / NXCD; wgid = (xcd < r ? xcd * (q + 1) : r * (q + 1) + (xcd - r) * q) + off; }
        const int nig = WGM * nN, gid = wgid / nig, fm = gid * WGM, gsz = (nM - fm) < WGM ? (nM - fm) : WGM;
        u.pm = fm + ((wgid % nig) % gsz); u.pn = (wgid % nig) / gsz; return true;
    }
    __device__ __forceinline__ void a_ready(const Unit&) const {}
    __device__ __forceinline__ void done(const Unit&) const {}
};


__device__ __forceinline__ unsigned cvt_pk_bf16(float lo, float hi) { unsigned r; asm volatile("v_cvt_pk_bf16_f32 %0, %1, %2" : "=v"(r) : "v"(lo), "v"(hi)); return r; }
struct EpiBf16Plain {
    static constexpr bool PERM = true, AFTER_DRAIN = false;
    bf16_t* O; int ldc;
    __device__ __forceinline__ void operator()(const f32x4 (&acc)[2][2][4][2], const Unit& u, int wr, int wc, int fr, int fq) const {
        const int row0 = u.pm * BM + wr * 64 + fr, col0 = u.pn * BM + wc * 32 + 8 * fq;
#pragma unroll
        for (int ai = 0; ai < 2; ++ai)
#pragma unroll
            for (int m = 0; m < 4; ++m) { bf16_t* rowp = O + (size_t)(row0 + ai * HALF + m * 16) * ldc + col0;
#pragma unroll
                for (int bj = 0; bj < 2; ++bj) { const f32x4 v0 = acc[ai][bj][m][0], v1 = acc[ai][bj][m][1];
                    u32x4 w; w.x = cvt_pk_bf16(v0[0], v0[1]); w.y = cvt_pk_bf16(v0[2], v0[3]); w.z = cvt_pk_bf16(v1[0], v1[1]); w.w = cvt_pk_bf16(v1[2], v1[3]);
                    *(u32x4*)(rowp + bj * HALF) = w; } }
    }
};
template <bool RES_F32>
struct EpiBf16Res {
    static constexpr bool PERM = true, AFTER_DRAIN = false;
    bf16_t* O; const void* R; int ldc;
    __device__ __forceinline__ void operator()(const f32x4 (&acc)[2][2][4][2], const Unit& u, int wr, int wc, int fr, int fq) const {
        const int row0 = u.pm * BM + wr * 64 + fr, col0 = u.pn * BM + wc * 32 + 8 * fq;
#pragma unroll
        for (int ai = 0; ai < 2; ++ai)
#pragma unroll
            for (int m = 0; m < 4; ++m) { const size_t off = (size_t)(row0 + ai * HALF + m * 16) * ldc + col0;
#pragma unroll
                for (int bj = 0; bj < 2; ++bj) { f32x4 v0 = acc[ai][bj][m][0], v1 = acc[ai][bj][m][1];
                    if (RES_F32) { const float* rp = (const float*)R + off + bj * HALF; v0 += *(const f32x4*)rp; v1 += *(const f32x4*)(rp + 4); }
                    else { const u32x4 rw = *(const u32x4*)((const bf16_t*)R + off + bj * HALF);
                        v0[0] += __uint_as_float(rw.x << 16); v0[1] += __uint_as_float(rw.x & 0xffff0000u); v0[2] += __uint_as_float(rw.y << 16); v0[3] += __uint_as_float(rw.y & 0xffff0000u);
                        v1[0] += __uint_as_float(rw.z << 16); v1[1] += __uint_as_float(rw.z & 0xffff0000u); v1[2] += __uint_as_float(rw.w << 16); v1[3] += __uint_as_float(rw.w & 0xffff0000u); }
                    u32x4 w; w.x = cvt_pk_bf16(v0[0], v0[1]); w.y = cvt_pk_bf16(v0[2], v0[3]); w.z = cvt_pk_bf16(v1[0], v1[1]); w.w = cvt_pk_bf16(v1[2], v1[3]);
                    *(u32x4*)(O + off + bj * HALF) = w; } }
    }
};
struct EpiF32Res {
    static constexpr bool PERM = false, AFTER_DRAIN = false;
    float* C; const float* R; int ldc;
    __device__ __forceinline__ void operator()(const f32x4 (&acc)[2][2][4][2], const Unit& u, int wr, int wc, int fr, int fq) const {
        const int row0 = u.pm * BM + wr * 64 + fr, col0 = u.pn * BM + wc * 32 + 4 * fq;
#pragma unroll
        for (int ai = 0; ai < 2; ++ai)
#pragma unroll
            for (int m = 0; m < 4; ++m) { const size_t off = (size_t)(row0 + ai * HALF + m * 16) * ldc + col0;
#pragma unroll
                for (int bj = 0; bj < 2; ++bj)
#pragma unroll
                    for (int n = 0; n < 2; ++n) { const f32x4 r = *(const f32x4*)(R + off + bj * HALF + n * 16); *(f32x4*)(C + off + bj * HALF + n * 16) = r + acc[ai][bj][m][n]; } }
    }
};
template <class Epi, class Sched, bool ALIGN_EPI = false, bool SP2 = false>
__device__ __forceinline__ void gemm_phase(PG8_LAS unsigned char* lds, const Gemm g, const Sched& S, const Epi& E, int wave_id) {
    asm volatile("" : "+s"(wave_id));
    const int lane = fresh_lane(), wid = wave_id, tid = wid * 64 + lane, wr = wid >> 2, wc = wid & 3, fr = lane & 15, fq = lane >> 4;
    const int K = g.K, nt = K / BK;
    unsigned voffA[2], voffB[2];
#pragma unroll
    for (int i = 0; i < 2; ++i) { int R, C; stage_rc(tid * 16 + i * 8192, R, C); const int Rb = Epi::PERM ? ((R & ~31) + perm32(R & 31)) : R;
        voffA[i] = (unsigned)(R * K + C) * 2u; voffB[i] = (unsigned)(Rb * K + C) * 2u; }
    const size_t kstep = (size_t)(BK * 2);
    const size_t hstep = (size_t)HALF * K * 2;
    const size_t tstep = 2 * hstep;
    const unsigned ldsw = (unsigned)wid * 1024u;
    const int aoff = lds_byte(wr * 64 + fr, fq * 8), boff = lds_byte(wc * 32 + fr, fq * 8);
#define PG8_SA(b, h) (((b) * 2 + (h)) * HTB)
#define PG8_SB(b, h) ((4 + (b) * 2 + (h)) * HTB)
#define PG8_STAGE(bufoff, gbase, voff) do { _Pragma("unroll") for (int _i = 0; _i < 2; ++_i) \
        __builtin_amdgcn_global_load_lds((const unsigned*)((const char*)(gbase) + (voff)[_i]), (PG8_LAS unsigned*)(lds + (bufoff) + ldsw + _i * 8192), 16, 0, 0); } while (0)
#define PG8_LDA(dst, b, h) do { _Pragma("unroll") for (int m = 0; m < 4; ++m) _Pragma("unroll") for (int k = 0; k < 2; ++k) dst[m][k] = *(const PG8_LAS bf16x8*)(lds + PG8_SA(b, h) + aoff + m * 2048 + k * 1024); } while (0)
#define PG8_LDB(dst, b, h) do { _Pragma("unroll") for (int n = 0; n < 2; ++n) _Pragma("unroll") for (int k = 0; k < 2; ++k) dst[n][k] = *(const PG8_LAS bf16x8*)(lds + PG8_SB(b, h) + boff + n * 2048 + k * 1024); } while (0)
#define PG8_MMA(ai, bj, At, Bt) do { __builtin_amdgcn_s_setprio(1); _Pragma("unroll") for (int m = 0; m < 4; ++m) _Pragma("unroll") for (int n = 0; n < 2; ++n) _Pragma("unroll") for (int k = 0; k < 2; ++k) \
        acc[ai][bj][m][n] = __builtin_amdgcn_mfma_f32_16x16x32_bf16(Bt[n][k], At[m][k], acc[ai][bj][m][n], 0, 0, 0); __builtin_amdgcn_s_setprio(0); } while (0)
#define PG8_WAIT_V(n) asm volatile("s_waitcnt vmcnt(" #n ")" ::: "memory")
#define PG8_WAIT_L(n) asm volatile("s_waitcnt lgkmcnt(" #n ")" ::: "memory")
#define PG8_BAR __builtin_amdgcn_s_barrier()
#define PG8_SCHED __builtin_amdgcn_sched_barrier(0)
    Unit cur, nxt; int ui = 0;
    if (!S.next(0, cur)) return;
    f32x4 acc[2][2][4][2];
#pragma unroll
    for (int a = 0; a < 2; ++a)
#pragma unroll
        for (int b = 0; b < 2; ++b)
#pragma unroll
            for (int m = 0; m < 4; ++m)
#pragma unroll
                for (int n = 0; n < 2; ++n) acc[a][b][m][n] = (f32x4){0.f, 0.f, 0.f, 0.f};
    bf16x8 At[4][2], B0[2][2], B1[2][2];
    const char* cA = (const char*)g.A + (size_t)cur.pm * tstep; const char* cB = (const char*)g.Bt + (size_t)cur.pn * tstep;
    S.a_ready(cur);
    if constexpr (SP2) {
        PG8_STAGE(PG8_SB(0, 0), cB, voffB); PG8_STAGE(PG8_SB(0, 1), cB + hstep, voffB); PG8_STAGE(PG8_SA(0, 0), cA, voffA); PG8_STAGE(PG8_SA(0, 1), cA + hstep, voffA);
        if (wr == 1) PG8_BAR;
        PG8_WAIT_V(2); PG8_BAR;
        PG8_STAGE(PG8_SB(1, 0), cB + kstep, voffB); PG8_STAGE(PG8_SA(1, 0), cA + kstep, voffA); PG8_STAGE(PG8_SB(1, 1), cB + hstep + kstep, voffB);
        PG8_WAIT_V(6); PG8_BAR;
    } else {
        PG8_STAGE(PG8_SB(0, 0), cB, voffB); PG8_STAGE(PG8_SA(0, 0), cA, voffA); PG8_STAGE(PG8_SB(0, 1), cB + hstep, voffB); PG8_STAGE(PG8_SA(0, 1), cA + hstep, voffA);
        if (wr == 1) PG8_BAR;
        PG8_WAIT_V(4); PG8_BAR;
        PG8_STAGE(PG8_SB(1, 0), cB + kstep, voffB); PG8_STAGE(PG8_SA(1, 0), cA + kstep, voffA); PG8_STAGE(PG8_SB(1, 1), cB + hstep + kstep, voffB);
        PG8_WAIT_V(6); PG8_BAR;
    }
    for (;;) {
        const bool has_next = S.next(ui + 1, nxt);
        const char* nA = has_next ? (const char*)g.A + (size_t)nxt.pm * tstep : cA; const char* nB = has_next ? (const char*)g.Bt + (size_t)nxt.pn * tstep : cB;
        for (int t = 0; t < nt; t += 2) {
            const bool last = (t == nt - 2);
            const char* a1 = cA + (size_t)(t + 1) * kstep;
            const char* a2 = last ? nA : cA + (size_t)(t + 2) * kstep; const char* b2 = last ? nB : cB + (size_t)(t + 2) * kstep;
            const char* a3 = a2 + kstep; const char* b3 = b2 + kstep;
            if (last && has_next) S.a_ready(nxt);
            if constexpr (SP2) {
            PG8_LDB(B0, 0, 0); PG8_LDB(B1, 0, 1); PG8_SCHED; PG8_LDA(At, 0, 0); PG8_STAGE(PG8_SA(1, 1), a1 + hstep, voffA);
            PG8_WAIT_V(8); PG8_WAIT_L(0); PG8_BAR; PG8_MMA(0, 0, At, B0); PG8_MMA(0, 1, At, B1); PG8_BAR; PG8_SCHED;
            PG8_LDA(At, 0, 1); PG8_STAGE(PG8_SB(0, 0), b2, voffB); PG8_STAGE(PG8_SB(0, 1), b2 + hstep, voffB); PG8_STAGE(PG8_SA(0, 0), a2, voffA);
            PG8_WAIT_V(8); PG8_WAIT_L(0); PG8_BAR; PG8_MMA(1, 0, At, B0); PG8_MMA(1, 1, At, B1); PG8_BAR; PG8_SCHED;
            PG8_LDB(B0, 1, 0); PG8_LDB(B1, 1, 1); PG8_SCHED; PG8_LDA(At, 1, 0); PG8_STAGE(PG8_SA(0, 1), a2 + hstep, voffA);
            PG8_WAIT_V(8); PG8_WAIT_L(0); PG8_BAR; PG8_MMA(0, 0, At, B0); PG8_MMA(0, 1, At, B1); PG8_BAR; PG8_SCHED;
            PG8_LDA(At, 1, 1); PG8_STAGE(PG8_SB(1, 0), b3, voffB); PG8_STAGE(PG8_SB(1, 1), b3 + hstep, voffB); PG8_STAGE(PG8_SA(1, 0), a3, voffA);
            PG8_WAIT_V(8); PG8_WAIT_L(0); PG8_BAR; PG8_MMA(1, 0, At, B0); PG8_MMA(1, 1, At, B1); PG8_BAR; PG8_SCHED;
            } else {
            PG8_LDB(B0, 0, 0); PG8_SCHED; PG8_LDA(At, 0, 0); PG8_STAGE(PG8_SA(1, 1), a1 + hstep, voffA);
            PG8_WAIT_L(8); PG8_BAR; PG8_WAIT_L(0); PG8_MMA(0, 0, At, B0); PG8_BAR; PG8_SCHED;
            PG8_LDB(B1, 0, 1); PG8_STAGE(PG8_SB(0, 0), b2, voffB);
            PG8_BAR; PG8_WAIT_L(0); PG8_MMA(0, 1, At, B1); PG8_BAR;
            PG8_LDA(At, 0, 1); PG8_STAGE(PG8_SA(0, 0), a2, voffA);
            PG8_BAR; PG8_WAIT_L(0); PG8_MMA(1, 0, At, B0); PG8_BAR; PG8_SCHED;
            PG8_STAGE(PG8_SB(0, 1), b2 + hstep, voffB);
            PG8_WAIT_V(6); PG8_BAR; PG8_MMA(1, 1, At, B1); PG8_BAR;
            PG8_LDB(B0, 1, 0); PG8_SCHED; PG8_LDA(At, 1, 0); PG8_STAGE(PG8_SA(0, 1), a2 + hstep, voffA);
            PG8_WAIT_L(8); PG8_BAR; PG8_WAIT_L(0); PG8_MMA(0, 0, At, B0); PG8_BAR; PG8_SCHED;
            PG8_LDB(B1, 1, 1); PG8_STAGE(PG8_SB(1, 0), b3, voffB);
            PG8_BAR; PG8_WAIT_L(0); PG8_MMA(0, 1, At, B1); PG8_BAR;
            PG8_LDA(At, 1, 1); PG8_STAGE(PG8_SA(1, 0), a3, voffA);
            PG8_BAR; PG8_WAIT_L(0); PG8_MMA(1, 0, At, B0); PG8_BAR; PG8_SCHED;
            PG8_STAGE(PG8_SB(1, 1), b3 + hstep, voffB);
            PG8_WAIT_V(6); PG8_BAR; PG8_MMA(1, 1, At, B1); PG8_BAR;
            }
        }
        if constexpr (ALIGN_EPI) { if (wr == 0) PG8_BAR; }
        if constexpr (!Epi::AFTER_DRAIN) { E(acc, cur, wr, wc, fr, fq); S.done(cur); }
        if (!has_next) break;
#pragma unroll
        for (int a = 0; a < 2; ++a)
#pragma unroll
            for (int b = 0; b < 2; ++b)
#pragma unroll
                for (int m = 0; m < 4; ++m)
#pragma unroll
                    for (int n = 0; n < 2; ++n) acc[a][b][m][n] = (f32x4){0.f, 0.f, 0.f, 0.f};
        cur = nxt; cA = nA; cB = nB; ++ui;
        if constexpr (ALIGN_EPI) { if (wr == 1) PG8_BAR; }
    }
    PG8_WAIT_V(0);
    if constexpr (!ALIGN_EPI) { if (wr == 0) PG8_BAR; }
    PG8_BAR;
    if constexpr (Epi::AFTER_DRAIN) { E.fused(acc, cur, wr, wc, fr, fq, lds, wid, lane); S.done(cur); }
#undef PG8_SA
#undef PG8_SB
#undef PG8_STAGE
#undef PG8_LDA
#undef PG8_LDB
#undef PG8_MMA
#undef PG8_WAIT_V
#undef PG8_WAIT_L
#undef PG8_BAR
#undef PG8_SCHED
}

struct MUnit { int r0, rend, e, pn; };
#define MG_LANE_OFFS(u, o) do { const int _t = wid * 64 + fresh_lane(); _Pragma("unroll") for (int _i = 0; _i < 2; ++_i) { int _R, _C; stage_rc(_t * 16 + _i * 8192, _R, _C); _Pragma("unroll") for (int _h = 0; _h < 2; ++_h) { const int _r = (u).r0 + _h * HALF + _R; \
        int _row = _r; if (GATHER) { _row = 0; if (_r < (u).rend) _row = slot_tok[_r]; } (o)[_h][_i] = (unsigned)(_row * K + _C) * 2u; } } } while (0)
template <class Epi, class Sched, bool GATHER, int N, int K>
__device__ __forceinline__ void gemm_phase_moe(PG8_LAS unsigned char* lds, const bf16_t* A, const bf16_t* Bt, const int* slot_tok, const Sched& S, const Epi& E, int wave_id) {
    asm volatile("" : "+s"(wave_id));
    const int lane = fresh_lane(), wid = wave_id, tid = wid * 64 + lane, wr = wid >> 2, wc = wid & 3, fr = lane & 15, fq = lane >> 4;
    constexpr int nt = K / BK;
#define MG_OFFP(par) ((PG8_LAS unsigned*)(lds + STAGE_BYTES + 8192) + (par) * 2048 + tid)
#define MG_VOFFB ((PG8_LAS unsigned*)(lds + STAGE_BYTES + 24576) + tid)
#pragma unroll
    for (int i = 0; i < 2; ++i) { int R, C; stage_rc(tid * 16 + i * 8192, R, C); const int Rb = Epi::PERM ? ((R & ~31) + perm32(R & 31)) : R; MG_VOFFB[i * 512] = (unsigned)(Rb * K + C) * 2u; }
    constexpr size_t kstep = (size_t)(BK * 2);
    constexpr size_t hstep = (size_t)HALF * K * 2;
    constexpr size_t tstep = 2 * hstep;
    constexpr size_t estep = (size_t)N * K * 2;
    const unsigned ldsw = (unsigned)wid * 1024u;
    const int aoff = lds_byte(wr * 64 + fr, fq * 8), boff = lds_byte(wc * 32 + fr, fq * 8);
#define PG8_SA(b, h) (((b) * 2 + (h)) * HTB)
#define PG8_SB(b, h) ((4 + (b) * 2 + (h)) * HTB)
#define PG8_STAGE(bufoff, gbase, voff) do { _Pragma("unroll") for (int _i = 0; _i < 2; ++_i) \
        __builtin_amdgcn_global_load_lds((const unsigned*)((const char*)(gbase) + MG_VOFFB[_i * 512]), (PG8_LAS unsigned*)(lds + (bufoff) + ldsw + _i * 8192), 16, 0, 0); } while (0)
#define MG_STAGE_A(bufoff, par, h, kb) do { _Pragma("unroll") for (int _i = 0; _i < 2; ++_i) \
        __builtin_amdgcn_global_load_lds((const unsigned*)((const char*)A + (size_t)MG_OFFP(par)[((h) * 2 + _i) * 512] + (kb)), (PG8_LAS unsigned*)(lds + (bufoff) + ldsw + _i * 8192), 16, 0, 0); } while (0)
#define PG8_LDA(dst, b, h) do { _Pragma("unroll") for (int m = 0; m < 4; ++m) _Pragma("unroll") for (int k = 0; k < 2; ++k) dst[m][k] = *(const PG8_LAS bf16x8*)(lds + PG8_SA(b, h) + aoff + m * 2048 + k * 1024); } while (0)
#define PG8_LDB(dst, b, h) do { _Pragma("unroll") for (int n = 0; n < 2; ++n) _Pragma("unroll") for (int k = 0; k < 2; ++k) dst[n][k] = *(const PG8_LAS bf16x8*)(lds + PG8_SB(b, h) + boff + n * 2048 + k * 1024); } while (0)
#define PG8_MMA(ai, bj, At, Bt_) do { __builtin_amdgcn_s_setprio(1); _Pragma("unroll") for (int m = 0; m < 4; ++m) _Pragma("unroll") for (int n = 0; n < 2; ++n) _Pragma("unroll") for (int k = 0; k < 2; ++k) \
        acc[ai][bj][m][n] = __builtin_amdgcn_mfma_f32_16x16x32_bf16(Bt_[n][k], At[m][k], acc[ai][bj][m][n], 0, 0, 0); __builtin_amdgcn_s_setprio(0); } while (0)
#define PG8_WAIT_V(n) asm volatile("s_waitcnt vmcnt(" #n ")" ::: "memory")
#define PG8_WAIT_L(n) asm volatile("s_waitcnt lgkmcnt(" #n ")" ::: "memory")
#define PG8_BAR __builtin_amdgcn_s_barrier()
#define PG8_SCHED __builtin_amdgcn_sched_barrier(0)
    MUnit cur, nxt; int ui = 0;
    if (!S.next(0, cur)) return;
    f32x4 acc[2][2][4][2];
#pragma unroll
    for (int a = 0; a < 2; ++a)
#pragma unroll
        for (int b = 0; b < 2; ++b)
#pragma unroll
            for (int m = 0; m < 4; ++m)
#pragma unroll
                for (int n = 0; n < 2; ++n) acc[a][b][m][n] = (f32x4){0.f, 0.f, 0.f, 0.f};
    bf16x8 At[4][2], B0[2][2], B1[2][2];
    { unsigned o_[2][2]; MG_LANE_OFFS(cur, o_); PG8_LAS unsigned* p_ = MG_OFFP(0); p_[0] = o_[0][0]; p_[512] = o_[0][1]; p_[1024] = o_[1][0]; p_[1536] = o_[1][1]; }
    const char* cB = (const char*)Bt + (size_t)cur.e * estep + (size_t)cur.pn * tstep;
    PG8_STAGE(PG8_SB(0, 0), cB, voffB); PG8_STAGE(PG8_SB(0, 1), cB + hstep, voffB); MG_STAGE_A(PG8_SA(0, 0), 0, 0, 0); MG_STAGE_A(PG8_SA(0, 1), 0, 1, 0);
    if (wr == 1) PG8_BAR;
    PG8_WAIT_V(2); PG8_BAR;
    PG8_STAGE(PG8_SB(1, 0), cB + kstep, voffB); MG_STAGE_A(PG8_SA(1, 0), 0, 0, kstep); PG8_STAGE(PG8_SB(1, 1), cB + hstep + kstep, voffB);
    PG8_WAIT_V(6); PG8_BAR;
    for (;;) {
        const bool has_next = S.next(ui + 1, nxt);
        const bool hi_rows = (cur.rend - cur.r0) > HALF;
        const char* nB = cB;
        const int pc = ui & 1, pn_ = has_next ? (pc ^ 1) : pc;
        if (has_next) { unsigned on[2][2]; MG_LANE_OFFS(nxt, on); nB = (const char*)Bt + (size_t)nxt.e * estep + (size_t)nxt.pn * tstep;
            PG8_LAS unsigned* p_ = MG_OFFP(pn_); p_[0] = on[0][0]; p_[512] = on[0][1]; p_[1024] = on[1][0]; p_[1536] = on[1][1]; }
        for (int t = 0; t < nt; t += 2) {
            const bool last = (t == nt - 2);
            const size_t k1 = (size_t)(t + 1) * kstep, k2 = last ? (size_t)0 : (size_t)(t + 2) * kstep, k3 = k2 + kstep;
            const char* b2 = last ? nB : cB + (size_t)(t + 2) * kstep; const char* b3 = b2 + kstep;
            const int p2 = last ? pn_ : pc;
            PG8_LDB(B0, 0, 0); PG8_LDB(B1, 0, 1); PG8_SCHED; PG8_LDA(At, 0, 0); MG_STAGE_A(PG8_SA(1, 1), pc, 1, k1);
            PG8_WAIT_V(8); PG8_WAIT_L(0); PG8_BAR; PG8_MMA(0, 0, At, B0); PG8_MMA(0, 1, At, B1); PG8_BAR; PG8_SCHED;
            PG8_LDA(At, 0, 1); PG8_STAGE(PG8_SB(0, 0), b2, voffB); PG8_STAGE(PG8_SB(0, 1), b2 + hstep, voffB); MG_STAGE_A(PG8_SA(0, 0), p2, 0, k2);
            PG8_WAIT_V(8); PG8_WAIT_L(0); PG8_BAR; if (hi_rows) { PG8_MMA(1, 0, At, B0); PG8_MMA(1, 1, At, B1); } PG8_BAR; PG8_SCHED;
            PG8_LDB(B0, 1, 0); PG8_LDB(B1, 1, 1); PG8_SCHED; PG8_LDA(At, 1, 0); MG_STAGE_A(PG8_SA(0, 1), p2, 1, k2);
            PG8_WAIT_V(8); PG8_WAIT_L(0); PG8_BAR; PG8_MMA(0, 0, At, B0); PG8_MMA(0, 1, At, B1); PG8_BAR; PG8_SCHED;
            PG8_LDA(At, 1, 1); PG8_STAGE(PG8_SB(1, 0), b3, voffB); PG8_STAGE(PG8_SB(1, 1), b3 + hstep, voffB); MG_STAGE_A(PG8_SA(1, 0), p2, 0, k3);
            PG8_WAIT_V(8); PG8_WAIT_L(0); PG8_BAR; if (hi_rows) { PG8_MMA(1, 0, At, B0); PG8_MMA(1, 1, At, B1); } PG8_BAR; PG8_SCHED;
        }
        if (wr == 0) PG8_BAR;
        E(acc, cur, wr, wc, fr, fq);
        if (!has_next) break;
#pragma unroll
        for (int a = 0; a < 2; ++a)
#pragma unroll
            for (int b = 0; b < 2; ++b)
#pragma unroll
                for (int m = 0; m < 4; ++m)
#pragma unroll
                    for (int n = 0; n < 2; ++n) acc[a][b][m][n] = (f32x4){0.f, 0.f, 0.f, 0.f};
        cur = nxt; cB = nB; ++ui;
        if (wr == 1) PG8_BAR;
    }
    PG8_WAIT_V(0);
    PG8_BAR;
#undef PG8_SA
#undef PG8_SB
#undef PG8_STAGE
#undef MG_STAGE_A
#undef MG_OFFP
#undef MG_VOFFB
#undef PG8_LDA
#undef PG8_LDB
#undef PG8_MMA
#undef PG8_WAIT_V
#undef PG8_WAIT_L
#undef PG8_BAR
#undef PG8_SCHED
}
__device__ __forceinline__ float fast_silu(float x) { return x * __builtin_amdgcn_rcpf(1.0f + __builtin_amdgcn_exp2f(-1.4426950408889634f * x)); }
struct EpiMoeH {
    static constexpr bool PERM = true;
    bf16_t* H;
    __device__ __forceinline__ void operator()(const f32x4 (&acc)[2][2][4][2], const MUnit& u, int wr, int wc, int fr, int fq) const {
        { const int t_ = fresh_lane(); fr = t_ & 15; fq = t_ >> 4; }
        const int col0 = u.pn * 128 + wc * 32 + 8 * fq;
#pragma unroll
        for (int ai = 0; ai < 2; ++ai)
#pragma unroll
            for (int m = 0; m < 4; ++m) { const int r = u.r0 + ai * HALF + wr * 64 + m * 16 + fr;
                const f32x4 g0 = acc[ai][0][m][0], g1 = acc[ai][0][m][1], u0 = acc[ai][1][m][0], u1 = acc[ai][1][m][1];
                u32x4 w; w.x = cvt_pk_bf16(fast_silu(g0[0]) * u0[0], fast_silu(g0[1]) * u0[1]); w.y = cvt_pk_bf16(fast_silu(g0[2]) * u0[2], fast_silu(g0[3]) * u0[3]);
                w.z = cvt_pk_bf16(fast_silu(g1[0]) * u1[0], fast_silu(g1[1]) * u1[1]); w.w = cvt_pk_bf16(fast_silu(g1[2]) * u1[2], fast_silu(g1[3]) * u1[3]);
                if (r < u.rend) *(u32x4*)(H + (size_t)r * 256 + col0) = w; }
    }
};
struct EpiMoeY {
    static constexpr bool PERM = true;
    bf16_t* Y;
    __device__ __forceinline__ void operator()(const f32x4 (&acc)[2][2][4][2], const MUnit& u, int wr, int wc, int fr, int fq) const {
        { const int t_ = fresh_lane(); fr = t_ & 15; fq = t_ >> 4; }
        const int col0 = u.pn * BM + wc * 32 + 8 * fq;
#pragma unroll
        for (int ai = 0; ai < 2; ++ai)
#pragma unroll
            for (int m = 0; m < 4; ++m) { const int r = u.r0 + ai * HALF + wr * 64 + m * 16 + fr;
#pragma unroll
                for (int bj = 0; bj < 2; ++bj) { const f32x4 v0 = acc[ai][bj][m][0], v1 = acc[ai][bj][m][1];
                    u32x4 w; w.x = cvt_pk_bf16(v0[0], v0[1]); w.y = cvt_pk_bf16(v0[2], v0[3]); w.z = cvt_pk_bf16(v1[0], v1[1]); w.w = cvt_pk_bf16(v1[2], v1[3]);
                    if (r < u.rend) *(u32x4*)(Y + (size_t)r * 1024 + col0 + bj * HALF) = w; } }
    }
};
struct MoeSched {
    const PG8_LAS int* tab;
    int npn, first, end, stride, c;
    __device__ __forceinline__ bool next(int i, MUnit& u) const {
        const int L = first + c + i * stride;
        if (c < 0 || L >= end) return false;
        const int j = L / npn; u.pn = L % npn;
        u.e = __builtin_amdgcn_readfirstlane(tab[4 + 4 * j]); u.r0 = __builtin_amdgcn_readfirstlane(tab[5 + 4 * j]); u.rend = __builtin_amdgcn_readfirstlane(tab[6 + 4 * j]);
        return true;
    }
};
}

#ifndef PG8_SP2
#define PG8_SP2 true
#endif
#ifndef PG8_ALIGN
#define PG8_ALIGN true
#endif

constexpr int NWAVES = 8, NT = NWAVES * 64;
constexpr int D = 1024, NB = 2, S = 8192, T = NB * S, DEPTH = 2;
constexpr int DIN = 2832, PLD = 3072;
constexpr int C_Q = 0, C_K = 256, C_V = 512, C_G = 1024, C_GK = 1536, C_U = 1552, C_VG = 1808, C_XI = 2064, C_BG = 2320, C_CG = 2576;
constexpr int GH = 4, GC = 64, GN = S / GC;
constexpr int MH = 4, MC = 128, MN = S / MC;
constexpr int NE = 32, DE = 256;
constexpr float EPS = 1e-6f;
constexpr size_t MiB = 1u << 20;
constexpr size_t WS_CTL = 0, CTL_BYTES = 1 * MiB;
constexpr size_t WS_WIN = 1 * MiB;
constexpr size_t WS_WOUT = 13 * MiB;
constexpr size_t WS_WGU = 17 * MiB;
constexpr size_t WS_WD = 81 * MiB;
constexpr size_t WS_XN = 113 * MiB;
constexpr size_t WS_P = 145 * MiB;
constexpr size_t WS_Y = WS_P + 17 * MiB;
constexpr size_t WS_S = 276 * MiB;
constexpr size_t WS_XRES = 241 * MiB;
constexpr size_t WS_DEC = 273 * MiB;
constexpr size_t WS_MISC = 274 * MiB;
constexpr size_t WS_WSP = WS_MISC + 524288;
constexpr size_t WS_WR = 275 * MiB;
constexpr size_t WS_BLKCNT = WS_WR + 524288;
constexpr size_t WS_END = 284 * MiB;
constexpr int CW_BAR = 4096, CW_CNT = 16384;
constexpr int RING_BYTES = 131072, LDSCTL_OFF = RING_BYTES, MISC_OFF = LDSCTL_OFF + 320, LDS_BYTES = 163840;

#define GAS __attribute__((address_space(1)))
#define LAS __attribute__((address_space(3)))
typedef unsigned short bf16;
typedef unsigned v4u __attribute__((ext_vector_type(4)));
typedef unsigned v2u __attribute__((ext_vector_type(2)));
typedef float f32x4 __attribute__((ext_vector_type(4)));
typedef __bf16 bf16x2_t __attribute__((ext_vector_type(2)));
typedef float f32x2_t __attribute__((ext_vector_type(2)));
__device__ __forceinline__ unsigned f2bf(float f) { return (unsigned)__builtin_bit_cast(unsigned short, (__bf16)f); }
__device__ __forceinline__ unsigned pk2(float lo, float hi) { f32x2_t v = {lo, hi}; bf16x2_t b = __builtin_convertvector(v, bf16x2_t); return __builtin_bit_cast(unsigned, b); }
__device__ __forceinline__ float bf2f(unsigned v) { return __uint_as_float(v << 16); }
__device__ __forceinline__ float bflo(unsigned w) { return __uint_as_float(w << 16); }
__device__ __forceinline__ float bfhi(unsigned w) { return __uint_as_float(w & 0xffff0000u); }
__device__ __forceinline__ void unpack8(const v4u q, float (&f)[8]) { f[0] = bflo(q.x); f[1] = bfhi(q.x); f[2] = bflo(q.y); f[3] = bfhi(q.y); f[4] = bflo(q.z); f[5] = bfhi(q.z); f[6] = bflo(q.w); f[7] = bfhi(q.w); }
__device__ __forceinline__ float gelu_tanh(float x) { const float u = 0.7978845608028654f * (x + 0.044715f * x * x * x); return 0.5f * x * (1.0f + tanhf(u)); }
__device__ __forceinline__ float silu(float x) { return x / (1.0f + expf(-x)); }
__device__ __forceinline__ float log_sigmoid(float x) { return fminf(x, 0.f) - log1pf(expf(-fabsf(x))); }

#define XB_TMO      128
#define XB_XCNT(j)  (256  + 64 * (j))
#define XB_XSUB(j)  (1280 + 64 * (j))
#define XB_XGEN(j)  (2304 + 64 * (j))
#define XB_TOP      3328
#define XB_TOPGEN   3392
#define XCD_BAR_WORDS 3456
#define XB_SPIN_CAP (1u << 18)

__device__ __forceinline__ unsigned xb_ld(unsigned* p)              { return __hip_atomic_load(p, __ATOMIC_RELAXED, __HIP_MEMORY_SCOPE_AGENT); }
__device__ __forceinline__ unsigned xb_add(unsigned* p, unsigned v) { return __hip_atomic_fetch_add(p, v, __ATOMIC_RELAXED, __HIP_MEMORY_SCOPE_AGENT); }
__device__ __forceinline__ unsigned xb_xcc_id() { return (unsigned)__builtin_amdgcn_s_getreg((3 << 11) | 20) & 0xFu; }
#define XB_SPIN(cond, bar) do { unsigned _sp = 0; while (cond) { __builtin_amdgcn_s_sleep(1); \
    if ((++_sp & 255u) == 0u) { if (xb_ld(&(bar)[XB_TMO])) break; if (_sp > XB_SPIN_CAP) { atomicAdd(&(bar)[XB_TMO], 1u); break; } } } } while (0)

struct XcdBarrier {
    int wave;
    unsigned* bar; unsigned x;
    volatile LAS unsigned* st;
};

__device__ __forceinline__ XcdBarrier xcd_barrier_post(unsigned* bar, volatile LAS unsigned* st) {
    XcdBarrier b; b.bar = bar; b.x = xb_xcc_id(); b.st = st; b.wave = __builtin_amdgcn_readfirstlane(threadIdx.x >> 6);
    if (threadIdx.x == 0) (void)xb_add(&bar[XB_XCNT(b.x)], 1u);
    return b;
}
__device__ __forceinline__ void xcd_barrier_complete(unsigned* bar, unsigned x, unsigned& nloc, unsigned& nx) {
    const unsigned G = gridDim.x * gridDim.y * gridDim.z;
    unsigned sum, cnt, mine, sp = 0u;
    for (;;) {
        sum = 0u; cnt = 0u; mine = 0u;
#pragma unroll
        for (unsigned j = 0; j < 16; ++j) { const unsigned c = xb_ld(&bar[XB_XCNT(j)]); sum += c; cnt += (c > 0u) ? 1u : 0u; mine = (j == x) ? c : mine; }
        if (sum == G) break;
        __builtin_amdgcn_s_sleep(1);
        if ((++sp & 255u) == 0u) { if (xb_ld(&bar[XB_TMO])) break; if (sp > XB_SPIN_CAP) { atomicAdd(&bar[XB_TMO], 1u); break; } }
    }
    nloc = mine > 0u ? mine : 1u; nx = cnt > 0u ? cnt : 1u;
}

__device__ __forceinline__ void xcd_barrier(const XcdBarrier& b) {
    asm volatile("s_waitcnt vmcnt(0)" ::: "memory");
    __syncthreads();
    if (b.wave == 0 && fresh_lane() == 0) {
        unsigned* bar = b.bar; asm volatile("" : "+s"(bar));
        __builtin_amdgcn_s_waitcnt(0);
        unsigned nloc = b.st[0], nx = b.st[1];
        if (nloc == 0u) { xcd_barrier_complete(bar, b.x, nloc, nx); b.st[0] = nloc; b.st[1] = nx; }
        const unsigned old = xb_add(&bar[XB_XSUB(b.x)], 1u);
        const unsigned gen = old / nloc;
        if (old + 1u == (gen + 1u) * nloc) {
            __builtin_amdgcn_fence(__ATOMIC_RELEASE, "agent");
            asm volatile("s_waitcnt vmcnt(0)" ::: "memory");
            const unsigned og = xb_add(&bar[XB_TOP], 1u);
            const unsigned tg = og / nx;
            if (og + 1u == (tg + 1u) * nx) xb_add(&bar[XB_TOPGEN], 1u);
            else XB_SPIN(xb_ld(&bar[XB_TOPGEN]) == tg, bar);
            __builtin_amdgcn_fence(__ATOMIC_ACQUIRE, "agent");
            xb_add(&bar[XB_XGEN(b.x)], 1u);
            asm volatile("s_waitcnt vmcnt(0)" ::: "memory");
        } else {
            XB_SPIN(xb_ld(&bar[XB_XGEN(b.x)]) == gen, bar);
            __builtin_amdgcn_fence(__ATOMIC_ACQUIRE, "agent");
            asm volatile("s_waitcnt vmcnt(0)" ::: "memory");
        }
    }
    __syncthreads();
}

#define AS4 __attribute__((address_space(4)))
struct KA {
    const AS4 char* ka;
    static __device__ __forceinline__ KA fresh() { KA k; k.ka = (const AS4 char*)__builtin_amdgcn_kernarg_segment_ptr(); asm volatile("" : "+s"(k.ka)); return k; }
    __device__ __forceinline__ const float* in(int i) const { return *(const float* const AS4*)(ka + 8 * i); }
    __device__ __forceinline__ float* out() const { return *(float* const AS4*)(ka + 160); }
    __device__ __forceinline__ unsigned char* ws() const { return *(unsigned char* const AS4*)(ka + 168); }
    __device__ __forceinline__ unsigned* ctl() const { return (unsigned*)(ws() + WS_CTL); }
    __device__ __forceinline__ bf16* WinT() const { return (bf16*)(ws() + WS_WIN); }
    __device__ __forceinline__ bf16* WoutT() const { return (bf16*)(ws() + WS_WOUT); }
    __device__ __forceinline__ bf16* WguT() const { return (bf16*)(ws() + WS_WGU); }
    __device__ __forceinline__ bf16* WdT() const { return (bf16*)(ws() + WS_WD); }
    __device__ __forceinline__ bf16* XN() const { return (bf16*)(ws() + WS_XN); }
    __device__ __forceinline__ bf16* P() const { return (bf16*)(ws() + WS_P); }
    __device__ __forceinline__ bf16* H1() const { return (bf16*)(ws() + WS_P); }
    __device__ __forceinline__ bf16* Y() const { return (bf16*)(ws() + WS_Y); }
    __device__ __forceinline__ float* Sst() const { return (float*)(ws() + WS_S); }
    __device__ __forceinline__ float* dec() const { return (float*)(ws() + WS_DEC); }
    __device__ __forceinline__ int* eid() const { return (int*)(ws() + WS_MISC); }
    __device__ __forceinline__ float* ew() const { return (float*)(ws() + WS_MISC + 131072); }
    __device__ __forceinline__ int* slot_tok() const { return (int*)(ws() + WS_MISC + 2 * 131072); }
    __device__ __forceinline__ int* slot_of() const { return (int*)(ws() + WS_MISC + 3 * 131072); }
    __device__ __forceinline__ bf16* Wsp() const { return (bf16*)(ws() + WS_WSP); }
    __device__ __forceinline__ bf16* Wr() const { return (bf16*)(ws() + WS_WR); }
    __device__ __forceinline__ bf16* XR() const { return (bf16*)(ws() + WS_XRES); }
    __device__ __forceinline__ int* blkcnt() const { return (int*)(ws() + WS_BLKCNT); }
};
struct Frame {
    LAS unsigned char* lds; float* smem;
    int G, bx, wave;
};
#define PHASE_TID const int lane = fresh_lane(), wave = F.wave, tid = wave * 64 + lane; (void)lane; (void)wave; (void)tid

__device__ __forceinline__ float wave_sum(float v) {
    const int ln = fresh_lane();
#pragma unroll
    for (int o = 1; o < 64; o <<= 1) v += __int_as_float(__builtin_amdgcn_ds_bpermute((ln ^ o) << 2, __float_as_int(v)));
    return v;
}

__device__ __forceinline__ void transpose_item(const float* W, int ldw, int nvalid, int k0, int n0, bf16* WT, int ldt, int drow0, LAS float* scr, int lane) {
    const int sub = lane >> 3, c4 = (lane & 7) * 4;
    f32x4 v[8];
#pragma unroll
    for (int i = 0; i < 8; ++i) v[i] = (c4 < nvalid) ? __builtin_nontemporal_load((const f32x4*)(W + (size_t)(k0 + 8 * i + sub) * ldw + n0 + c4)) : (f32x4){0.f, 0.f, 0.f, 0.f};
#pragma unroll
    for (int i = 0; i < 8; ++i) { LAS float* d = scr + (8 * i + sub) * 33 + c4; d[0] = v[i].x; d[1] = v[i].y; d[2] = v[i].z; d[3] = v[i].w; }
    asm volatile("s_waitcnt lgkmcnt(0)" ::: "memory");
    const int c = lane & 7;
#pragma unroll
    for (int j = 0; j < 4; ++j) { const int n = (lane >> 3) + 8 * j; const LAS float* s = scr + (8 * c) * 33 + n;
        v4u o; o.x = pk2(s[0 * 33], s[1 * 33]); o.y = pk2(s[2 * 33], s[3 * 33]); o.z = pk2(s[4 * 33], s[5 * 33]); o.w = pk2(s[6 * 33], s[7 * 33]);
        if (n < nvalid) *(GAS v4u*)(WT + (size_t)(drow0 + n) * ldt + k0 + 8 * c) = o; }
    asm volatile("s_waitcnt lgkmcnt(0)" ::: "memory");
}
__device__ __forceinline__ void rms_row_to_bf16(const float* xrow, const float* gain, bf16* orow, int lane) {
    const f32x4* xr = (const f32x4*)xrow + lane;
    f32x4 v[4]; float s = 0.f;
#pragma unroll
    for (int j = 0; j < 4; ++j) { v[j] = xr[64 * j]; s += (v[j].x * v[j].x + v[j].y * v[j].y) + (v[j].z * v[j].z + v[j].w * v[j].w); }
    const float rs = rsqrtf(wave_sum(s) * (1.f / D) + EPS);
    v2u* o8 = (v2u*)orow + lane;
#pragma unroll
    for (int j = 0; j < 4; ++j) { const f32x4 g = ((const f32x4*)gain)[lane + 64 * j]; v2u w; w.x = pk2(v[j].x * rs * g.x, v[j].y * rs * g.y); w.y = pk2(v[j].z * rs * g.z, v[j].w * rs * g.w); o8[64 * j] = w; }
}
__device__ __forceinline__ void p0_prologue(Frame& F) {
    const KA K = KA::fresh(); PHASE_TID;
    LAS float* scr = (LAS float*)(F.lds + wave * 16384);
    const int gw = F.bx * NWAVES + wave, NGW = F.G * NWAVES;
    constexpr int I_IN = 16 * 89, I_OUT = 16 * 32, I_G = 32 * 16 * 8, I_D = 32 * 4 * 32, I_L = I_IN + I_OUT + 2 * I_G + I_D;
    for (int it = gw; it < DEPTH * I_L; it += NGW) {
        const int l = it / I_L; int r = it % I_L;
        if (r < I_IN) { const int kb = r / 89, nb = r % 89; const int nv = (nb == 88) ? 16 : 32;
            transpose_item(K.in(2) + (size_t)l * D * DIN, DIN, nv, kb * 64, nb * 32, K.WinT() + (size_t)l * PLD * D, D, nb * 32, scr, lane); continue; }
        r -= I_IN;
        if (r < I_OUT) { const int kb = r / 32, nb = r % 32;
            transpose_item(K.in(10) + (size_t)l * D * D, D, 32, kb * 64, nb * 32, K.WoutT() + (size_t)l * D * D, D, nb * 32, scr, lane); continue; }
        r -= I_OUT;
        if (r < 2 * I_G) { const int sel = r / I_G; r %= I_G; const int e = r / 128, kb = (r % 128) / 8, nb = r % 8; const int n0 = nb * 32;
            const float* W = K.in(16 + sel) + ((size_t)l * NE + e) * D * DE;
            transpose_item(W, DE, 32, kb * 64, n0, K.WguT() + ((size_t)l * NE + e) * 512 * D, D, (n0 >> 7) * 256 + sel * 128 + (n0 & 127), scr, lane); continue; }
        r -= 2 * I_G;
        { const int e = r / 128, kb = (r % 128) / 32, nb = r % 32;
            transpose_item(K.in(18) + ((size_t)l * NE + e) * DE * D, D, 32, kb * 64, nb * 32, K.WdT() + ((size_t)l * NE + e) * D * DE, DE, nb * 32, scr, lane); }
    }
    for (int i = F.bx * NT + tid; i < DEPTH * 240 * 128; i += F.G * NT) { const int l = i / (240 * 128), rr = (i / 128) % 240, c = i % 128;
        *(GAS v4u*)(K.WinT() + ((size_t)l * PLD + DIN + rr) * D + c * 8) = (v4u){0u, 0u, 0u, 0u}; }
    for (int i = F.bx * NT + tid; i < DEPTH * 48 * D; i += F.G * NT) { const int ll = i / (48 * D), n = (i / D) % 48, k = i % D;
        float w = 0.f;
        if (n < 4) w = K.in(12)[((size_t)ll * D + k) * 4 + n]; else if (n < 36) w = K.in(14)[((size_t)ll * D + k) * 32 + (n - 4)];
        w *= K.in(11)[(size_t)ll * D + k];
        const unsigned hi = f2bf(w), lo = f2bf(w - bf2f(hi));
        K.Wr()[((size_t)ll * 2 + 0) * 48 * D + (size_t)n * D + k] = (bf16)hi; K.Wr()[((size_t)ll * 2 + 1) * 48 * D + (size_t)n * D + k] = (bf16)lo; }
    for (int i = F.bx * NT + tid; i < DEPTH * MH * 128 * 128 / 8; i += F.G * NT) { const int e0 = i * 8, s0 = e0 & 127, t = (e0 >> 7) & 127;
        const f32x4 a = *(const f32x4*)(K.in(7) + e0), c = *(const f32x4*)(K.in(7) + e0 + 4);
        const float v[8] = {a.x, a.y, a.z, a.w, c.x, c.y, c.z, c.w}; unsigned w[4];
#pragma unroll
        for (int j = 0; j < 4; ++j) w[j] = pk2((s0 + 2 * j <= t) ? v[2 * j] : 0.f, (s0 + 2 * j + 1 <= t) ? v[2 * j + 1] : 0.f);
        *(GAS v4u*)(K.Wsp() + e0) = (v4u){w[0], w[1], w[2], w[3]}; }
    for (int m = gw; m < T; m += NGW) rms_row_to_bf16(K.in(0) + (size_t)m * D, K.in(1), K.XN() + (size_t)m * D, lane);
}

__device__ __forceinline__ void gla_cumdecay(Frame& F, const KA& K, int tid, int l, int h, int t0, float* bb) {
    const float* wup = K.in(3) + (size_t)l * 16 * 256; const float* bgk = K.in(4) + (size_t)l * 256;
    for (int e = tid; e < 64 * 64; e += NT) {
        const int c = e >> 6, d = e & 63;
        const bf16* gl = K.P() + (size_t)(t0 + c) * PLD + C_GK;
        float a = bgk[h * 64 + d];
#pragma unroll
        for (int r = 0; r < 16; ++r) a += bf2f(gl[r]) * wup[r * 256 + h * 64 + d];
        bb[c * 64 + d] = log_sigmoid(a) * (1.0f / 16.0f);
    }
    __syncthreads();
    if (tid < 64) { float run = 0.f; for (int c = 0; c < 64; ++c) { run += bb[c * 64 + tid]; bb[c * 64 + tid] = run; } }
    __syncthreads();
}
__device__ __forceinline__ void phase_gla_kv(Frame& F, int l) {
    const KA K = KA::fresh(); PHASE_TID;
    float* bb = F.smem; float* kd = F.smem + 4096;
#pragma unroll 1
    for (int ci = F.bx; ci < NB * GH * GN; ci += F.G) {
        const int b = ci / (GH * GN), h = (ci / GN) % GH, n = ci % GN, t0 = b * S + n * GC;
        __syncthreads();
        gla_cumdecay(F, K, tid, l, h, t0, bb);
        for (int e = tid; e < 4096; e += NT) { const int c = e >> 6, d = e & 63; kd[e] = bf2f(K.P()[(size_t)(t0 + c) * PLD + C_K + h * 64 + d]) * expf(bb[63 * 64 + d] - bb[e]); }
        __syncthreads();
        const int d = tid >> 3, v0 = (tid & 7) * 16;
        float acc[16];
#pragma unroll
        for (int j = 0; j < 16; ++j) acc[j] = 0.f;
#pragma unroll 2
        for (int c = 0; c < 64; ++c) {
            const float kk = kd[c * 64 + d];
            const v4u* vr = (const v4u*)(K.P() + (size_t)(t0 + c) * PLD + C_V + h * 128 + v0);
            float f[8]; unpack8(vr[0], f);
#pragma unroll
            for (int j = 0; j < 8; ++j) acc[j] += kk * f[j];
            unpack8(vr[1], f);
#pragma unroll
            for (int j = 0; j < 8; ++j) acc[8 + j] += kk * f[j];
        }
        f32x4* o = (f32x4*)(K.Sst() + ((size_t)ci * 64 + d) * 128 + v0);
#pragma unroll
        for (int j = 0; j < 4; ++j) o[j] = (f32x4){acc[4 * j], acc[4 * j + 1], acc[4 * j + 2], acc[4 * j + 3]};
        if (tid < 64) K.dec()[(size_t)ci * 64 + tid] = expf(bb[63 * 64 + tid]);
    }
}
__device__ __forceinline__ void phase_gla_scan(Frame& F) {
    const KA K = KA::fresh(); PHASE_TID;
#pragma unroll 1
    for (int e = F.bx * NT + tid; e < NB * GH * 64 * 128; e += F.G * NT) {
        const int bh = e >> 13, d = (e >> 7) & 63, v = e & 127;
        float* base = K.Sst() + ((size_t)bh * GN * 64 + d) * 128 + v; const float* db = K.dec() + (size_t)bh * GN * 64 + d;
        float st = 0.f;
#pragma unroll 1
        for (int n0 = 0; n0 < GN; n0 += 16) {
            float kvv[16], dd[16];
#pragma unroll
            for (int j = 0; j < 16; ++j) { kvv[j] = base[(size_t)(n0 + j) * 8192]; dd[j] = db[(n0 + j) * 64]; }
#pragma unroll
            for (int j = 0; j < 16; ++j) { base[(size_t)(n0 + j) * 8192] = st; st = dd[j] * st + kvv[j]; }
        }
    }
}
__device__ __forceinline__ void phase_gla_out(Frame& F, int l) {
    const KA K = KA::fresh(); PHASE_TID;
    float* bb = F.smem; float* qd = F.smem + 4096; float* ki = F.smem + 4096 + 64 * 65; float* sc = bb;
    const float* gnorm = K.in(5) + (size_t)l * 128;
#pragma unroll 1
    for (int ci = F.bx; ci < NB * GH * GN; ci += F.G) {
        const int b = ci / (GH * GN), h = (ci / GN) % GH, n = ci % GN, t0 = b * S + n * GC;
        __syncthreads();
        gla_cumdecay(F, K, tid, l, h, t0, bb);
        for (int e = tid; e < 4096; e += NT) {
            const int c = e >> 6, d = e & 63; const float bv = bb[e];
            const bf16* row = K.P() + (size_t)(t0 + c) * PLD;
            qd[c * 65 + d] = bf2f(row[C_Q + h * 64 + d]) * 0.125f * expf(bv);
            ki[c * 65 + d] = bf2f(row[C_K + h * 64 + d]) * expf(-bv);
        }
        __syncthreads();
        {
            const int c = tid >> 3, s0 = (tid & 7) * 8;
            float a[8];
#pragma unroll
            for (int j = 0; j < 8; ++j) a[j] = 0.f;
#pragma unroll 4
            for (int d = 0; d < 64; ++d) { const float qv = qd[c * 65 + d];
#pragma unroll
                for (int j = 0; j < 8; ++j) a[j] += qv * ki[(s0 + j) * 65 + d]; }
#pragma unroll
            for (int j = 0; j < 8; ++j) sc[c * 64 + s0 + j] = (s0 + j <= c) ? a[j] : 0.f;
        }
        __syncthreads();
        const int c = tid >> 3, v0 = (tid & 7) * 16;
        float acc[16];
#pragma unroll
        for (int j = 0; j < 16; ++j) acc[j] = 0.f;
#pragma unroll 2
        for (int s = 0; s <= c; ++s) {
            const float w = sc[c * 64 + s];
            const v4u* vr = (const v4u*)(K.P() + (size_t)(t0 + s) * PLD + C_V + h * 128 + v0);
            float f[8]; unpack8(vr[0], f);
#pragma unroll
            for (int j = 0; j < 8; ++j) acc[j] += w * f[j];
            unpack8(vr[1], f);
#pragma unroll
            for (int j = 0; j < 8; ++j) acc[8 + j] += w * f[j];
        }
#pragma unroll 2
        for (int d = 0; d < 64; ++d) {
            const float w = qd[c * 65 + d];
            const f32x4* sr = (const f32x4*)(K.Sst() + ((size_t)ci * 64 + d) * 128 + v0);
#pragma unroll
            for (int j = 0; j < 4; ++j) { const f32x4 v4 = sr[j]; acc[4 * j] += w * v4.x; acc[4 * j + 1] += w * v4.y; acc[4 * j + 2] += w * v4.z; acc[4 * j + 3] += w * v4.w; }
        }
        float ss = 0.f;
#pragma unroll
        for (int j = 0; j < 16; ++j) ss += acc[j] * acc[j];
        ss += shx(ss, 1); ss += shx(ss, 2); ss += shx(ss, 4);
        const float rs = rsqrtf(ss * (1.0f / 128.0f) + EPS);
        const v4u* gr = (const v4u*)(K.P() + (size_t)(t0 + c) * PLD + C_G + h * 128 + v0);
        float g0[8], g1[8]; unpack8(gr[0], g0); unpack8(gr[1], g1);
        float o[16];
#pragma unroll
        for (int j = 0; j < 8; ++j) { o[j] = acc[j] * rs * gnorm[v0 + j] * silu(g0[j]); o[8 + j] = acc[8 + j] * rs * gnorm[v0 + 8 + j] * silu(g1[j]); }
        v4u* op = (v4u*)(K.XN() + (size_t)(t0 + c) * D + h * 128 + v0);
        op[0] = (v4u){pk2(o[0], o[1]), pk2(o[2], o[3]), pk2(o[4], o[5]), pk2(o[6], o[7])};
        op[1] = (v4u){pk2(o[8], o[9]), pk2(o[10], o[11]), pk2(o[12], o[13]), pk2(o[14], o[15])};
    }
}
__device__ __forceinline__ void phase_gmlp(Frame& F, int l) {
    const KA K = KA::fresh(); PHASE_TID;
    float* vs = F.smem;
    const float* gn = K.in(6) + (size_t)l * 256; const float* wsp = K.in(7) + (size_t)l * MH * 128 * 128; const float* bsp = K.in(8) + (size_t)l * MH * 128;
#pragma unroll 1
    for (int u = F.bx; u < NB * MN * MH; u += F.G) {
        const int b = u / (MN * MH), n = (u / MH) % MN, h = u % MH, t0 = b * S + n * MC;
        __syncthreads();
        const int s = tid >> 2, d0 = (tid & 3) * 16;
        {
            const v4u* vr = (const v4u*)(K.P() + (size_t)(t0 + s) * PLD + C_VG + h * 64 + d0);
            float g[16]; { float f[8]; unpack8(vr[0], f);
#pragma unroll
                for (int j = 0; j < 8; ++j) g[j] = gelu_tanh(f[j]);
                unpack8(vr[1], f);
#pragma unroll
                for (int j = 0; j < 8; ++j) g[8 + j] = gelu_tanh(f[j]); }
            float ss = 0.f;
#pragma unroll
            for (int j = 0; j < 16; ++j) ss += g[j] * g[j];
            ss += shx(ss, 1); ss += shx(ss, 2);
            const float rs = rsqrtf(ss * (1.0f / 64.0f) + EPS);
#pragma unroll
            for (int j = 0; j < 16; ++j) vs[s * 64 + d0 + j] = g[j] * rs * gn[h * 64 + d0 + j];
        }
        __syncthreads();
        const int t = s;
        float acc[16];
#pragma unroll
        for (int j = 0; j < 16; ++j) acc[j] = 0.f;
        const float* wr = wsp + ((size_t)h * 128 + t) * 128;
#pragma unroll 2
        for (int s2 = 0; s2 <= t; ++s2) { const float w = wr[s2];
#pragma unroll
            for (int j = 0; j < 16; ++j) acc[j] += w * vs[s2 * 64 + d0 + j]; }
        const float bias = bsp[h * 128 + t];
        const v4u* ur = (const v4u*)(K.P() + (size_t)(t0 + t) * PLD + C_U + h * 64 + d0);
        float u0[8], u1[8]; unpack8(ur[0], u0); unpack8(ur[1], u1);
        float o[16];
#pragma unroll
        for (int j = 0; j < 8; ++j) { o[j] = gelu_tanh(u0[j]) * (acc[j] + bias); o[8 + j] = gelu_tanh(u1[j]) * (acc[8 + j] + bias); }
        v4u* op = (v4u*)(K.XN() + (size_t)(t0 + t) * D + 512 + h * 64 + d0);
        op[0] = (v4u){pk2(o[0], o[1]), pk2(o[2], o[3]), pk2(o[4], o[5]), pk2(o[6], o[7])};
        op[1] = (v4u){pk2(o[8], o[9]), pk2(o[10], o[11]), pk2(o[12], o[13]), pk2(o[14], o[15])};
    }
}
typedef short bf16x8 __attribute__((ext_vector_type(8)));
__device__ __forceinline__ float fexp(float x) { return __builtin_amdgcn_exp2f(x * 1.4426950408889634f); }
__device__ __forceinline__ float logsig_fast(float x) { return fminf(x, 0.f) - __log2f(1.0f + fexp(-fabsf(x))) * 0.6931471805599453f; }
__device__ __forceinline__ float silu_fast(float x) { return x * __builtin_amdgcn_rcpf(1.0f + __builtin_amdgcn_exp2f(-1.4426950408889634f * x)); }
__device__ __forceinline__ float gelu_fast(float x) { const float u = 0.7978845608028654f * (x + 0.044715f * x * x * x); return x * __builtin_amdgcn_rcpf(1.0f + __builtin_amdgcn_exp2f(-2.8853900817779268f * u)); }
__device__ __forceinline__ f32x4 mfma16(bf16x8 a, bf16x8 b, f32x4 c) { return __builtin_amdgcn_mfma_f32_16x16x32_bf16(a, b, c, 0, 0, 0); }
constexpr int LROWB = 144;
constexpr int L_QD = 0, L_KI = 9216, L_KDT = 18432, L_VT = 27648, L_S = 46080, L_ST = 55296, L_OB = 73728, L_TOT = 107520, OBROW = 528;
#define FRAG(base, row, kel) (*(const LAS bf16x8*)(lds + (base) + (row) * LROWB + (kel) * 2))

__device__ __forceinline__ float gla_b8(const KA& K, LAS unsigned char* lds, int l, int h, int t0, int lane, int wave, float (&bv)[8]) {
    const float* wup = K.in(3) + (size_t)l * 16 * 256 + h * 64 + lane;
    float wu[16];
#pragma unroll
    for (int r = 0; r < 16; ++r) wu[r] = wup[r * 256];
    const float bg = K.in(4)[l * 256 + h * 64 + lane];
    const bf16* P = K.P();
    float run = 0.f;
#pragma unroll
    for (int j = 0; j < 8; ++j) {
        const bf16* gl = P + (size_t)(t0 + 8 * wave + j) * PLD + C_GK;
        float f0[8], f1[8]; unpack8(*(const v4u*)gl, f0); unpack8(*(const v4u*)(gl + 8), f1);
        float a = bg;
#pragma unroll
        for (int r = 0; r < 8; ++r) a += f0[r] * wu[r];
#pragma unroll
        for (int r = 0; r < 8; ++r) a += f1[r] * wu[8 + r];
        run += logsig_fast(a) * (1.0f / 16.0f); bv[j] = run;
    }
    LAS float* tot = (LAS float*)(lds + L_TOT);
    tot[wave * 64 + lane] = run;
    __syncthreads();
    float base = 0.f, all = 0.f;
#pragma unroll
    for (int g = 0; g < 8; ++g) { const float tv = tot[g * 64 + lane]; all += tv; if (g < wave) base += tv; }
#pragma unroll
    for (int j = 0; j < 8; ++j) bv[j] += base;
    return all;
}
__device__ __forceinline__ void gla_stage_vT(const bf16* P, LAS unsigned char* lds, int h, int t0, int tid) {
    const int vv = tid & 127, cq = tid >> 7;
    const bf16* vp = P + (size_t)(t0 + 16 * cq) * PLD + C_V + h * 128 + vv;
    unsigned w[8];
#pragma unroll
    for (int j = 0; j < 8; ++j) w[j] = (unsigned)vp[(size_t)(2 * j) * PLD] | ((unsigned)vp[(size_t)(2 * j + 1) * PLD] << 16);
    LAS v4u* dst = (LAS v4u*)(lds + L_VT + vv * LROWB + cq * 32);
    dst[0] = (v4u){w[0], w[1], w[2], w[3]}; dst[1] = (v4u){w[4], w[5], w[6], w[7]};
}

__device__ __forceinline__ void phase_gla_kv_mfma(Frame& F, int l) {
    const KA K = KA::fresh(); PHASE_TID;
    LAS unsigned char* lds = F.lds;
    const int fr = lane & 15, fq = lane >> 4;
#pragma unroll 1
    for (int ci = F.bx; ci < NB * GH * GN; ci += F.G) {
        const int b = ci / (GH * GN), h = (ci / GN) % GH, n = ci % GN, t0 = b * S + n * GC;
        const bf16* P = K.P();
        __syncthreads();
        float bv[8]; const float bl = gla_b8(K, lds, l, h, t0, lane, wave, bv);
        {
            const bf16* kp = P + (size_t)(t0 + 8 * wave) * PLD + C_K + h * 64 + lane;
            float kd[8];
#pragma unroll
            for (int j = 0; j < 8; ++j) kd[j] = bf2f(kp[(size_t)j * PLD]) * fexp(bl - bv[j]);
            *(LAS v4u*)(lds + L_KDT + lane * LROWB + wave * 16) = (v4u){pk2(kd[0], kd[1]), pk2(kd[2], kd[3]), pk2(kd[4], kd[5]), pk2(kd[6], kd[7])};
        }
        gla_stage_vT(P, lds, h, t0, tid);
        if (wave == 0) K.dec()[(size_t)ci * 64 + lane] = fexp(bl);
        __syncthreads();
        bf16x8 Bf[2];
#pragma unroll
        for (int ks = 0; ks < 2; ++ks) Bf[ks] = FRAG(L_VT, 16 * wave + fr, 32 * ks + 8 * fq);
        float* so = K.Sst() + (size_t)ci * 64 * 128 + 16 * wave + fr;
#pragma unroll
        for (int dt = 0; dt < 4; ++dt) {
            f32x4 acc = (f32x4){0.f, 0.f, 0.f, 0.f};
#pragma unroll
            for (int ks = 0; ks < 2; ++ks) acc = mfma16(FRAG(L_KDT, 16 * dt + fr, 32 * ks + 8 * fq), Bf[ks], acc);
#pragma unroll
            for (int r = 0; r < 4; ++r) so[(size_t)(16 * dt + 4 * fq + r) * 128] = acc[r];
        }
    }
}

__device__ __forceinline__ void phase_gla_out_mfma(Frame& F, int l) {
    const KA K = KA::fresh(); PHASE_TID;
    LAS unsigned char* lds = F.lds;
    const int fr = lane & 15, fq = lane >> 4;
    const float* gnorm = K.in(5) + (size_t)l * 128;
#pragma unroll 1
    for (int ci = F.bx; ci < NB * GH * GN; ci += F.G) {
        const int b = ci / (GH * GN), h = (ci / GN) % GH, n = ci % GN, t0 = b * S + n * GC;
        const bf16* P = K.P();
        __syncthreads();
        float bv[8]; (void)gla_b8(K, lds, l, h, t0, lane, wave, bv);
        {
            const bf16* qp = P + (size_t)(t0 + 8 * wave) * PLD + C_Q + h * 64 + lane;
            const bf16* kp = qp + (C_K - C_Q);
#pragma unroll
            for (int j = 0; j < 8; ++j) {
                const float e = fexp(bv[j]);
                const float qv = bf2f(qp[(size_t)j * PLD]) * 0.125f * e, kv = bf2f(kp[(size_t)j * PLD]) * __builtin_amdgcn_rcpf(e);
                *(LAS bf16*)(lds + L_QD + (8 * wave + j) * LROWB + lane * 2) = (bf16)f2bf(qv);
                *(LAS bf16*)(lds + L_KI + (8 * wave + j) * LROWB + lane * 2) = (bf16)f2bf(kv);
            }
        }
        gla_stage_vT(P, lds, h, t0, tid);
        {
            const int vv = tid & 127, dq = tid >> 7;
            const float* sp = K.Sst() + ((size_t)ci * 64 + 16 * dq) * 128 + vv;
            unsigned w[8];
#pragma unroll
            for (int j = 0; j < 8; ++j) w[j] = pk2(sp[(size_t)(2 * j) * 128], sp[(size_t)(2 * j + 1) * 128]);
            LAS v4u* dst = (LAS v4u*)(lds + L_ST + vv * LROWB + dq * 32);
            dst[0] = (v4u){w[0], w[1], w[2], w[3]}; dst[1] = (v4u){w[4], w[5], w[6], w[7]};
        }
        __syncthreads();
#pragma unroll
        for (int i = 0; i < 2; ++i) {
            const int tix = 2 * wave + i, st = tix >> 2, ct = tix & 3;
            f32x4 acc = (f32x4){0.f, 0.f, 0.f, 0.f};
#pragma unroll
            for (int ks = 0; ks < 2; ++ks) acc = mfma16(FRAG(L_KI, 16 * st + fr, 32 * ks + 8 * fq), FRAG(L_QD, 16 * ct + fr, 32 * ks + 8 * fq), acc);
            const int s0 = 16 * st + 4 * fq, c = 16 * ct + fr;
            float m[4];
#pragma unroll
            for (int r = 0; r < 4; ++r) m[r] = (s0 + r <= c) ? acc[r] : 0.f;
            *(LAS v2u*)(lds + L_S + c * LROWB + s0 * 2) = (v2u){pk2(m[0], m[1]), pk2(m[2], m[3])};
        }
        __syncthreads();
        {
            bf16x8 Av[2], As[2];
#pragma unroll
            for (int ks = 0; ks < 2; ++ks) { Av[ks] = FRAG(L_VT, 16 * wave + fr, 32 * ks + 8 * fq); As[ks] = FRAG(L_ST, 16 * wave + fr, 32 * ks + 8 * fq); }
#pragma unroll
            for (int ct = 0; ct < 4; ++ct) {
                f32x4 acc = (f32x4){0.f, 0.f, 0.f, 0.f};
#pragma unroll
                for (int ks = 0; ks < 2; ++ks) { acc = mfma16(Av[ks], FRAG(L_S, 16 * ct + fr, 32 * ks + 8 * fq), acc); acc = mfma16(As[ks], FRAG(L_QD, 16 * ct + fr, 32 * ks + 8 * fq), acc); }
                *(LAS f32x4*)(lds + L_OB + (16 * ct + fr) * OBROW + (16 * wave + 4 * fq) * 4) = acc;
            }
        }
        __syncthreads();
        {
            const int c = tid >> 3, vg = tid & 7;
            const LAS f32x4* ob = (const LAS f32x4*)(lds + L_OB + c * OBROW + vg * 64);
            f32x4 o[4]; float ss = 0.f;
#pragma unroll
            for (int j = 0; j < 4; ++j) { o[j] = ob[j]; ss += (o[j].x * o[j].x + o[j].y * o[j].y) + (o[j].z * o[j].z + o[j].w * o[j].w); }
            ss += shx(ss, 1); ss += shx(ss, 2); ss += shx(ss, 4);
            const float rs = rsqrtf(ss * (1.0f / 128.0f) + EPS);
            const v4u* gr = (const v4u*)(P + (size_t)(t0 + c) * PLD + C_G + h * 128 + 16 * vg);
            float g0[8], g1[8]; unpack8(gr[0], g0); unpack8(gr[1], g1);
            const f32x4* gn = (const f32x4*)(gnorm + 16 * vg);
            const f32x4 n0 = gn[0], n1 = gn[1], n2 = gn[2], n3 = gn[3];
            v4u w0, w1;
            w0.x = pk2(o[0].x * rs * n0.x * silu_fast(g0[0]), o[0].y * rs * n0.y * silu_fast(g0[1])); w0.y = pk2(o[0].z * rs * n0.z * silu_fast(g0[2]), o[0].w * rs * n0.w * silu_fast(g0[3]));
            w0.z = pk2(o[1].x * rs * n1.x * silu_fast(g0[4]), o[1].y * rs * n1.y * silu_fast(g0[5])); w0.w = pk2(o[1].z * rs * n1.z * silu_fast(g0[6]), o[1].w * rs * n1.w * silu_fast(g0[7]));
            w1.x = pk2(o[2].x * rs * n2.x * silu_fast(g1[0]), o[2].y * rs * n2.y * silu_fast(g1[1])); w1.y = pk2(o[2].z * rs * n2.z * silu_fast(g1[2]), o[2].w * rs * n2.w * silu_fast(g1[3]));
            w1.z = pk2(o[3].x * rs * n3.x * silu_fast(g1[4]), o[3].y * rs * n3.y * silu_fast(g1[5])); w1.w = pk2(o[3].z * rs * n3.z * silu_fast(g1[6]), o[3].w * rs * n3.w * silu_fast(g1[7]));
            v4u* op = (v4u*)(K.XN() + (size_t)(t0 + c) * D + h * 128 + 16 * vg);
            op[0] = w0; op[1] = w1;
        }
    }
}
#undef FRAG


constexpr int L_GKL = 109568, L_BL = 117760, SCN = 4, NSC = GN / SCN, NITEM = NB * GH * NSC;
#define FRAG(base, row, kel) (*(const LAS bf16x8*)(lds + (base) + (row) * LROWB + (kel) * 2))
struct GlaPre { unsigned short k[8], q[8], v[16]; v4u g0, g1; };
template <bool WITH_Q>
__device__ __forceinline__ void gla_prefetch(GlaPre& p, const bf16* P, int h, int t0, int tid, int lane, int wave) {
    const bf16* kp = P + (size_t)(t0 + 8 * wave) * PLD + C_K + h * 64 + lane;
#pragma unroll
    for (int j = 0; j < 8; ++j) p.k[j] = kp[(size_t)j * PLD];
    const int vv = tid & 127, cq = tid >> 7;
    const bf16* vp = P + (size_t)(t0 + 16 * cq) * PLD + C_V + h * 128 + vv;
#pragma unroll
    for (int j = 0; j < 16; ++j) p.v[j] = vp[(size_t)j * PLD];
    if (WITH_Q) {
        const bf16* qp = kp + (C_Q - C_K);
#pragma unroll
        for (int j = 0; j < 8; ++j) p.q[j] = qp[(size_t)j * PLD];
        const v4u* gr = (const v4u*)(P + (size_t)(t0 + (tid >> 3)) * PLD + C_G + h * 128 + 16 * (tid & 7));
        p.g0 = gr[0]; p.g1 = gr[1];
    }
}
__device__ __forceinline__ void gla_stage_gkl(const bf16* P, LAS unsigned char* lds, int tok0, int tid) {
    *(LAS v4u*)(lds + L_GKL + tid * 16) = *(const v4u*)(P + (size_t)(tok0 + (tid >> 1)) * PLD + C_GK + 8 * (tid & 1));
}
__device__ __forceinline__ void gla_b8_part(LAS unsigned char* lds, const float (&wu)[16], float bg, int n, int lane, int wave, float (&bv)[8]) {
    float run = 0.f;
#pragma unroll
    for (int j = 0; j < 8; ++j) {
        const LAS v4u* gl = (const LAS v4u*)(lds + L_GKL + (n * 64 + 8 * wave + j) * 32);
        float f0[8], f1[8]; unpack8(gl[0], f0); unpack8(gl[1], f1);
        float a = bg;
#pragma unroll
        for (int r = 0; r < 8; ++r) a += f0[r] * wu[r];
#pragma unroll
        for (int r = 0; r < 8; ++r) a += f1[r] * wu[8 + r];
        run += logsig_fast(a) * (1.0f / 16.0f); bv[j] = run;
    }
    ((LAS float*)(lds + L_TOT))[wave * 64 + lane] = run;
}
__device__ __forceinline__ float gla_b8_finish(LAS unsigned char* lds, int lane, int wave, float (&bv)[8]) {
    const LAS float* tot = (const LAS float*)(lds + L_TOT);
    float base = 0.f, all = 0.f;
#pragma unroll
    for (int g = 0; g < 8; ++g) { const float tv = tot[g * 64 + lane]; all += tv; if (g < wave) base += tv; }
#pragma unroll
    for (int j = 0; j < 8; ++j) bv[j] += base;
    return all;
}
__device__ __forceinline__ void gla_write_kdT_vT(LAS unsigned char* lds, const GlaPre& p, const float (&bv)[8], float bl, int tid, int lane, int wave) {
    float kd[8];
#pragma unroll
    for (int j = 0; j < 8; ++j) kd[j] = bf2f(p.k[j]) * fexp(bl - bv[j]);
    *(LAS v4u*)(lds + L_KDT + lane * LROWB + wave * 16) = (v4u){pk2(kd[0], kd[1]), pk2(kd[2], kd[3]), pk2(kd[4], kd[5]), pk2(kd[6], kd[7])};
    const int vv = tid & 127, cq = tid >> 7;
    LAS v4u* dst = (LAS v4u*)(lds + L_VT + vv * LROWB + cq * 32);
    dst[0] = (v4u){(unsigned)p.v[0] | ((unsigned)p.v[1] << 16), (unsigned)p.v[2] | ((unsigned)p.v[3] << 16), (unsigned)p.v[4] | ((unsigned)p.v[5] << 16), (unsigned)p.v[6] | ((unsigned)p.v[7] << 16)};
    dst[1] = (v4u){(unsigned)p.v[8] | ((unsigned)p.v[9] << 16), (unsigned)p.v[10] | ((unsigned)p.v[11] << 16), (unsigned)p.v[12] | ((unsigned)p.v[13] << 16), (unsigned)p.v[14] | ((unsigned)p.v[15] << 16)};
    if (wave == 0) ((LAS float*)(lds + L_BL))[lane] = bl;
}
__device__ __forceinline__ void gla_kv_mfma(LAS unsigned char* lds, int wave, int fr, int fq, f32x4 (&acc)[4]) {
    bf16x8 Bf[2];
#pragma unroll
    for (int ks = 0; ks < 2; ++ks) Bf[ks] = FRAG(L_VT, 16 * wave + fr, 32 * ks + 8 * fq);
#pragma unroll
    for (int dt = 0; dt < 4; ++dt) { acc[dt] = (f32x4){0.f, 0.f, 0.f, 0.f};
#pragma unroll
        for (int ks = 0; ks < 2; ++ks) acc[dt] = mfma16(FRAG(L_KDT, 16 * dt + fr, 32 * ks + 8 * fq), Bf[ks], acc[dt]); }
}

__device__ __forceinline__ void phase_gla_A2(Frame& F, int l) {
    const KA K = KA::fresh(); PHASE_TID;
    LAS unsigned char* lds = F.lds;
    const int fr = lane & 15, fq = lane >> 4;
#pragma unroll 1
    for (int it = F.bx; it < NITEM; it += F.G) {
        const int b = it / (GH * NSC), h = (it / NSC) % GH, sc = it % NSC, tok0 = b * S + sc * SCN * GC;
        const bf16* P = K.P();
        float wu[16];
        { const float* wup = K.in(3) + (size_t)l * 16 * 256 + h * 64 + lane;
#pragma unroll
          for (int r = 0; r < 16; ++r) wu[r] = wup[r * 256]; }
        const float bg = K.in(4)[l * 256 + h * 64 + lane];
        GlaPre pre[2]; gla_prefetch<false>(pre[0], P, h, tok0, tid, lane, wave); gla_prefetch<false>(pre[1], P, h, tok0 + GC, tid, lane, wave);
        __syncthreads();
        gla_stage_gkl(P, lds, tok0, tid);
        __syncthreads();
        f32x4 Sl[4], bs[4];
#pragma unroll
        for (int dt = 0; dt < 4; ++dt) { Sl[dt] = (f32x4){0.f, 0.f, 0.f, 0.f}; bs[dt] = (f32x4){0.f, 0.f, 0.f, 0.f}; }
#pragma unroll
        for (int n = 0; n < SCN; ++n) {
            float bv[8]; gla_b8_part(lds, wu, bg, n, lane, wave, bv);
            __syncthreads();
            const float bl = gla_b8_finish(lds, lane, wave, bv);
            gla_write_kdT_vT(lds, pre[n & 1], bv, bl, tid, lane, wave);
            if (n + 2 < SCN) gla_prefetch<false>(pre[n & 1], P, h, tok0 + (n + 2) * GC, tid, lane, wave);
            __syncthreads();
            f32x4 acc[4]; gla_kv_mfma(lds, wave, fr, fq, acc);
#pragma unroll
            for (int dt = 0; dt < 4; ++dt) { const f32x4 bl4 = *(const LAS f32x4*)(lds + L_BL + (16 * dt + 4 * fq) * 4);
                bs[dt] = bs[dt] + bl4;
#pragma unroll
                for (int r = 0; r < 4; ++r) Sl[dt][r] = fexp(bl4[r]) * Sl[dt][r] + acc[dt][r]; }
        }
        f32x4* ag = (f32x4*)K.Sst() + ((size_t)(it * 8 + wave) * 4) * 64 + lane;
#pragma unroll
        for (int dt = 0; dt < 4; ++dt) ag[dt * 64] = Sl[dt];
        if (wave == 0 && fr == 0) { f32x4* dp = (f32x4*)K.dec() + (size_t)it * 16 + fq;
#pragma unroll
            for (int dt = 0; dt < 4; ++dt) dp[dt * 4] = (f32x4){fexp(bs[dt][0]), fexp(bs[dt][1]), fexp(bs[dt][2]), fexp(bs[dt][3])}; }
    }
}


__device__ __forceinline__ void phase_gla_aggscan(Frame& F) {
    const KA K = KA::fresh(); PHASE_TID;
#pragma unroll 1
    for (int e = F.bx * NT + tid; e < NB * GH * 8192; e += F.G * NT) {
        const int bh = e >> 13, el = e & 8191, ln = (el >> 2) & 63, dt = (el >> 8) & 3, r = el & 3;
        float* ap = K.Sst() + (size_t)bh * NSC * 8192 + el; const float* dp = K.dec() + (size_t)bh * NSC * 64 + dt * 16 + (ln >> 4) * 4 + r;
        float a[NSC], d[NSC];
#pragma unroll
        for (int j = 0; j < NSC; ++j) { a[j] = ap[(size_t)j * 8192]; d[j] = dp[j * 64]; }
        float st = 0.f;
#pragma unroll
        for (int j = 0; j < NSC; ++j) { ap[(size_t)j * 8192] = st; st = d[j] * st + a[j]; }
    }
}
__device__ __forceinline__ void phase_gla_C2(Frame& F, int l) {
    const KA K = KA::fresh(); PHASE_TID;
    LAS unsigned char* lds = F.lds;
    const int fr = lane & 15, fq = lane >> 4;
    const float* gnorm = K.in(5) + (size_t)l * 128;
#pragma unroll 1
    for (int it = F.bx; it < NITEM; it += F.G) {
        const int b = it / (GH * NSC), h = (it / NSC) % GH, sc = it % NSC, tok0 = b * S + sc * SCN * GC;
        const bf16* P = K.P();
        float wu[16];
        { const float* wup = K.in(3) + (size_t)l * 16 * 256 + h * 64 + lane;
#pragma unroll
          for (int r = 0; r < 16; ++r) wu[r] = wup[r * 256]; }
        const float bg = K.in(4)[l * 256 + h * 64 + lane];
        GlaPre pre[2]; gla_prefetch<true>(pre[0], P, h, tok0, tid, lane, wave); gla_prefetch<true>(pre[1], P, h, tok0 + GC, tid, lane, wave);
        __syncthreads();
        gla_stage_gkl(P, lds, tok0, tid);
        f32x4 Sm[4];
        { const f32x4* ag = (const f32x4*)K.Sst() + ((size_t)(it * 8 + wave) * 4) * 64 + lane;
#pragma unroll
          for (int dt = 0; dt < 4; ++dt) Sm[dt] = ag[dt * 64]; }
        __syncthreads();
#pragma unroll
        for (int n = 0; n < SCN; ++n) {
            const int t0 = tok0 + n * GC;
            GlaPre& pr = pre[n & 1];
            float bv[8]; gla_b8_part(lds, wu, bg, n, lane, wave, bv);
            __syncthreads();
            const float bl = gla_b8_finish(lds, lane, wave, bv);
            gla_write_kdT_vT(lds, pr, bv, bl, tid, lane, wave);
#pragma unroll
            for (int j = 0; j < 8; ++j) {
                const float e = fexp(bv[j]);
                *(LAS bf16*)(lds + L_QD + (8 * wave + j) * LROWB + lane * 2) = (bf16)f2bf(bf2f(pr.q[j]) * 0.125f * e);
                *(LAS bf16*)(lds + L_KI + (8 * wave + j) * LROWB + lane * 2) = (bf16)f2bf(bf2f(pr.k[j]) * __builtin_amdgcn_rcpf(e));
            }
#pragma unroll
            for (int dt = 0; dt < 4; ++dt) *(LAS v2u*)(lds + L_ST + (16 * wave + fr) * LROWB + (16 * dt + 4 * fq) * 2) = (v2u){pk2(Sm[dt][0], Sm[dt][1]), pk2(Sm[dt][2], Sm[dt][3])};
            const v4u gq0 = pr.g0, gq1 = pr.g1;
            if (n + 2 < SCN) gla_prefetch<true>(pr, P, h, t0 + 2 * GC, tid, lane, wave);
            __syncthreads();
#pragma unroll
            for (int i = 0; i < 2; ++i) {
                const int tix = 2 * wave + i, st = tix >> 2, ct = tix & 3;
                f32x4 a = (f32x4){0.f, 0.f, 0.f, 0.f};
#pragma unroll
                for (int ks = 0; ks < 2; ++ks) a = mfma16(FRAG(L_KI, 16 * st + fr, 32 * ks + 8 * fq), FRAG(L_QD, 16 * ct + fr, 32 * ks + 8 * fq), a);
                const int s0 = 16 * st + 4 * fq, c = 16 * ct + fr;
                float m[4];
#pragma unroll
                for (int r = 0; r < 4; ++r) m[r] = (s0 + r <= c) ? a[r] : 0.f;
                *(LAS v2u*)(lds + L_S + c * LROWB + s0 * 2) = (v2u){pk2(m[0], m[1]), pk2(m[2], m[3])};
            }
            f32x4 kv[4]; gla_kv_mfma(lds, wave, fr, fq, kv);
            __syncthreads();
            {
                bf16x8 Av[2], As[2];
#pragma unroll
                for (int ks = 0; ks < 2; ++ks) { Av[ks] = FRAG(L_VT, 16 * wave + fr, 32 * ks + 8 * fq); As[ks] = FRAG(L_ST, 16 * wave + fr, 32 * ks + 8 * fq); }
#pragma unroll
                for (int ct = 0; ct < 4; ++ct) {
                    f32x4 a = (f32x4){0.f, 0.f, 0.f, 0.f};
#pragma unroll
                    for (int ks = 0; ks < 2; ++ks) { a = mfma16(Av[ks], FRAG(L_S, 16 * ct + fr, 32 * ks + 8 * fq), a); a = mfma16(As[ks], FRAG(L_QD, 16 * ct + fr, 32 * ks + 8 * fq), a); }
                    *(LAS f32x4*)(lds + L_OB + (16 * ct + fr) * OBROW + (16 * wave + 4 * fq) * 4) = a;
                }
            }
#pragma unroll
            for (int dt = 0; dt < 4; ++dt) { const f32x4 bl4 = *(const LAS f32x4*)(lds + L_BL + (16 * dt + 4 * fq) * 4);
#pragma unroll
                for (int r = 0; r < 4; ++r) Sm[dt][r] = fexp(bl4[r]) * Sm[dt][r] + kv[dt][r]; }
            __syncthreads();
            {
                const int c = tid >> 3, vg = tid & 7;
                const LAS f32x4* ob = (const LAS f32x4*)(lds + L_OB + c * OBROW + vg * 64);
                f32x4 o[4]; float ss = 0.f;
#pragma unroll
                for (int j = 0; j < 4; ++j) { o[j] = ob[j]; ss += (o[j].x * o[j].x + o[j].y * o[j].y) + (o[j].z * o[j].z + o[j].w * o[j].w); }
                ss += shx(ss, 1); ss += shx(ss, 2); ss += shx(ss, 4);
                const float rs = rsqrtf(ss * (1.0f / 128.0f) + EPS);
                float g0[8], g1[8]; unpack8(gq0, g0); unpack8(gq1, g1);
                const f32x4* gn = (const f32x4*)(gnorm + 16 * vg);
                const f32x4 n0 = gn[0], n1 = gn[1], n2 = gn[2], n3 = gn[3];
                v4u w0, w1;
                w0.x = pk2(o[0].x * rs * n0.x * silu_fast(g0[0]), o[0].y * rs * n0.y * silu_fast(g0[1])); w0.y = pk2(o[0].z * rs * n0.z * silu_fast(g0[2]), o[0].w * rs * n0.w * silu_fast(g0[3]));
                w0.z = pk2(o[1].x * rs * n1.x * silu_fast(g0[4]), o[1].y * rs * n1.y * silu_fast(g0[5])); w0.w = pk2(o[1].z * rs * n1.z * silu_fast(g0[6]), o[1].w * rs * n1.w * silu_fast(g0[7]));
                w1.x = pk2(o[2].x * rs * n2.x * silu_fast(g1[0]), o[2].y * rs * n2.y * silu_fast(g1[1])); w1.y = pk2(o[2].z * rs * n2.z * silu_fast(g1[2]), o[2].w * rs * n2.w * silu_fast(g1[3]));
                w1.z = pk2(o[3].x * rs * n3.x * silu_fast(g1[4]), o[3].y * rs * n3.y * silu_fast(g1[5])); w1.w = pk2(o[3].z * rs * n3.z * silu_fast(g1[6]), o[3].w * rs * n3.w * silu_fast(g1[7]));
                v4u* op = (v4u*)(K.XN() + (size_t)(t0 + c) * D + h * 128 + 16 * vg);
                op[0] = w0; op[1] = w1;
            }
        }
    }
}
#undef FRAG

constexpr int GM_ROWB = 272;
__device__ __forceinline__ void phase_gmlp_mfma(Frame& F, int l) {
    const KA K = KA::fresh(); PHASE_TID;
    LAS unsigned char* lds = F.lds;
    const int fr = lane & 15, fq = lane >> 4;
#pragma unroll 1
    for (int u = F.bx; u < NB * MN * MH; u += F.G) {
        const int b = u / (MN * MH), n = (u / MH) % MN, h = u % MH, t0 = b * S + n * MC;
        const bf16* P = K.P();
        const float gn = K.in(6)[(size_t)l * 256 + h * 64 + lane];
        __syncthreads();
#pragma unroll
        for (int q = 0; q < 2; ++q) {
            float vs[8];
#pragma unroll
            for (int i = 0; i < 8; ++i) {
                const float g = gelu_fast(bf2f(P[(size_t)(t0 + 16 * wave + 8 * q + i) * PLD + C_VG + h * 64 + lane]));
                const float ss = wave_sum(g * g);
                vs[i] = g * rsqrtf(ss * (1.0f / 64.0f) + EPS) * gn;
            }
            *(LAS v4u*)(lds + lane * GM_ROWB + (16 * wave + 8 * q) * 2) = (v4u){pk2(vs[0], vs[1]), pk2(vs[2], vs[3]), pk2(vs[4], vs[5]), pk2(vs[6], vs[7])};
        }
        __syncthreads();
        const bf16* Wb = K.Wsp() + ((size_t)(l * MH + h) * 128 + 16 * wave + fr) * 128 + 8 * fq;
        f32x4 acc[4];
#pragma unroll
        for (int dt = 0; dt < 4; ++dt) acc[dt] = (f32x4){0.f, 0.f, 0.f, 0.f};
        const int nks = (16 * wave + 15) / 32 + 1;
#pragma unroll
        for (int ks = 0; ks < 4; ++ks) if (ks < nks) {
            const bf16x8 Bf = *(const bf16x8*)(Wb + 32 * ks);
#pragma unroll
            for (int dt = 0; dt < 4; ++dt) acc[dt] = mfma16(*(const LAS bf16x8*)(lds + (16 * dt + fr) * GM_ROWB + (32 * ks + 8 * fq) * 2), Bf, acc[dt]);
        }
        const int t = 16 * wave + fr;
        const float bias = K.in(8)[(size_t)l * MH * 128 + h * 128 + t];
        const bf16* up = P + (size_t)(t0 + t) * PLD + C_U + h * 64 + 4 * fq;
        bf16* op = K.XN() + (size_t)(t0 + t) * D + 512 + h * 64 + 4 * fq;
#pragma unroll
        for (int dt = 0; dt < 4; ++dt) {
            const v2u uw = *(const v2u*)(up + 16 * dt);
            const float o0 = gelu_fast(bflo(uw.x)) * (acc[dt][0] + bias), o1 = gelu_fast(bfhi(uw.x)) * (acc[dt][1] + bias), o2 = gelu_fast(bflo(uw.y)) * (acc[dt][2] + bias), o3 = gelu_fast(bfhi(uw.y)) * (acc[dt][3] + bias);
            *(v2u*)(op + 16 * dt) = (v2u){pk2(o0, o1), pk2(o2, o3)};
        }
    }
}

__device__ __forceinline__ void phase_conv(Frame& F, int l) {
    const KA K = KA::fresh(); PHASE_TID;
    const float* wc = K.in(9) + (size_t)l * 3 * 256;
#pragma unroll 1
    for (int e = F.bx * NT + tid; e < T * 32; e += F.G * NT) {
        const int t = e >> 5, c0 = (e & 31) * 8, tl = t % S;
        const bf16* row = K.P() + (size_t)t * PLD;
        float y[8], xi[8], cg[8], bg[8];
        unpack8(*(const v4u*)(row + C_XI + c0), xi); unpack8(*(const v4u*)(row + C_CG + c0), cg); unpack8(*(const v4u*)(row + C_BG + c0), bg);
#pragma unroll
        for (int j = 0; j < 8; ++j) y[j] = wc[2 * 256 + c0 + j] * cg[j] * xi[j];
        if (tl >= 1) { unpack8(*(const v4u*)(row - PLD + C_XI + c0), xi); unpack8(*(const v4u*)(row - PLD + C_CG + c0), cg);
#pragma unroll
            for (int j = 0; j < 8; ++j) y[j] += wc[1 * 256 + c0 + j] * cg[j] * xi[j]; }
        if (tl >= 2) { unpack8(*(const v4u*)(row - 2 * PLD + C_XI + c0), xi); unpack8(*(const v4u*)(row - 2 * PLD + C_CG + c0), cg);
#pragma unroll
            for (int j = 0; j < 8; ++j) y[j] += wc[0 * 256 + c0 + j] * cg[j] * xi[j]; }
#pragma unroll
        for (int j = 0; j < 8; ++j) y[j] *= bg[j];
        *(v4u*)(K.XN() + (size_t)t * D + 768 + c0) = (v4u){pk2(y[0], y[1]), pk2(y[2], y[3]), pk2(y[4], y[5]), pk2(y[6], y[7])};
    }
}
__device__ __forceinline__ void phase_norm_router(Frame& F, int l) {
    const KA K = KA::fresh(); PHASE_TID;
    const float* gain = K.in(11) + (size_t)l * D;
    const float* wrg = K.in(12) + (size_t)l * D * 4; const float* brg = K.in(13) + (size_t)l * 4;
    const float* wre = K.in(14) + (size_t)l * D * 32; const float* bre = K.in(15) + (size_t)l * 32;
    int* cnt = (int*)(K.ctl() + CW_CNT + 64 * l);
#pragma unroll 1
    for (int t = F.bx * NWAVES + wave; t < T; t += F.G * NWAVES) {
        const f32x4* xr = (const f32x4*)(K.out() + (size_t)t * D) + lane;
        f32x4 v[4]; float s = 0.f;
#pragma unroll
        for (int j = 0; j < 4; ++j) { v[j] = xr[64 * j]; s += (v[j].x * v[j].x + v[j].y * v[j].y) + (v[j].z * v[j].z + v[j].w * v[j].w); }
        const float rs = rsqrtf(wave_sum(s) * (1.f / D) + EPS);
        v2u* o8 = (v2u*)(K.XN() + (size_t)t * D) + lane;
        float acc[36];
#pragma unroll
        for (int j = 0; j < 36; ++j) acc[j] = 0.f;
#pragma unroll
        for (int j = 0; j < 4; ++j) {
            const f32x4 g = ((const f32x4*)gain)[lane + 64 * j];
            const float hv[4] = {v[j].x * rs * g.x, v[j].y * rs * g.y, v[j].z * rs * g.z, v[j].w * rs * g.w};
            v2u w; w.x = pk2(hv[0], hv[1]); w.y = pk2(hv[2], hv[3]); o8[64 * j] = w;
#pragma unroll
            for (int i = 0; i < 4; ++i) {
                const int k = 4 * lane + 256 * j + i; const float xv = hv[i];
                const f32x4 g4 = *(const f32x4*)(wrg + (size_t)k * 4);
                acc[0] += xv * g4.x; acc[1] += xv * g4.y; acc[2] += xv * g4.z; acc[3] += xv * g4.w;
                const f32x4* e4 = (const f32x4*)(wre + (size_t)k * 32);
#pragma unroll
                for (int q = 0; q < 8; ++q) { const f32x4 w4 = e4[q]; acc[4 + 4 * q] += xv * w4.x; acc[5 + 4 * q] += xv * w4.y; acc[6 + 4 * q] += xv * w4.z; acc[7 + 4 * q] += xv * w4.w; }
            }
        }
#pragma unroll
        for (int j = 0; j < 36; ++j) acc[j] = wave_sum(acc[j]);
        if (lane == 0) {
            float gl[4]; int gt = 0;
#pragma unroll
            for (int j = 0; j < 4; ++j) gl[j] = acc[j] + brg[j];
            float gmax = gl[0];
#pragma unroll
            for (int j = 1; j < 4; ++j) if (gl[j] > gmax) { gmax = gl[j]; gt = j; }
            float gs = 0.f;
#pragma unroll
            for (int j = 0; j < 4; ++j) gs += expf(gl[j] - gmax);
            const float gw = 1.0f / gs;
            float el[8];
#pragma unroll
            for (int j = 0; j < 8; ++j) { float vv = 0.f;
#pragma unroll
                for (int g = 0; g < 4; ++g) if (g == gt) vv = acc[4 + g * 8 + j] + bre[g * 8 + j];
                el[j] = vv; }
            int i0 = 0; float m0 = el[0];
#pragma unroll
            for (int j = 1; j < 8; ++j) if (el[j] > m0) { m0 = el[j]; i0 = j; }
            int i1 = -1; float m1 = -INFINITY;
#pragma unroll
            for (int j = 0; j < 8; ++j) if (j != i0 && el[j] > m1) { m1 = el[j]; i1 = j; }
            const float e1 = expf(m1 - m0);
            const float w0 = gw / (1.0f + e1), w1 = gw * e1 / (1.0f + e1);
            const int e0i = gt * 8 + i0, e1i = gt * 8 + i1;
            K.eid()[2 * t] = e0i; K.eid()[2 * t + 1] = e1i; K.ew()[2 * t] = w0; K.ew()[2 * t + 1] = w1;
            atomicAdd(&cnt[e0i], 1); atomicAdd(&cnt[e1i], 1);
        }
    }
}
constexpr int RT_PART = 0, RT_SS = RT_PART + 4 * 8 * 16 * 48 * 4, RT_RS = RT_SS + 4 * 8 * 16 * 4, RT_HIST = RT_RS + 64 * 4;
__device__ __forceinline__ void phase_norm_router_mfma(Frame& F, int l) {
    const KA K = KA::fresh(); PHASE_TID;
    LAS unsigned char* lds = F.lds;
    const int fr = lane & 15, fq = lane >> 4;
    const bf16* whi = K.Wr() + (size_t)l * 2 * 48 * D + (size_t)fr * D + 128 * wave + 8 * fq; const bf16* wlo = whi + 48 * D;
    bf16x8 Wh[4][3], Wl[4][3];
#pragma unroll
    for (int ks = 0; ks < 4; ++ks)
#pragma unroll
        for (int nt = 0; nt < 3; ++nt) { Wh[ks][nt] = *(const bf16x8*)(whi + (size_t)(16 * nt) * D + 32 * ks); Wl[ks][nt] = *(const bf16x8*)(wlo + (size_t)(16 * nt) * D + 32 * ks); }
    f32x4 g0[4], g1[4];
    { const float* gp = K.in(11) + (size_t)l * D + 128 * wave + 8 * fq;
#pragma unroll
      for (int ks = 0; ks < 4; ++ks) { g0[ks] = *(const f32x4*)(gp + 32 * ks); g1[ks] = *(const f32x4*)(gp + 32 * ks + 4); } }
#pragma unroll 1
    for (int blk = F.bx; blk < T / 64; blk += F.G) {
        const bf16* xr = K.XR() + (size_t)(blk * 64 + fr) * D + 128 * wave + 8 * fq;
        __syncthreads();
        if (tid < NE) ((LAS int*)(lds + RT_HIST))[tid] = 0;
#pragma unroll
        for (int tp = 0; tp < 2; ++tp) {
            v4u xa[2][4];
#pragma unroll
            for (int t2 = 0; t2 < 2; ++t2)
#pragma unroll
                for (int ks = 0; ks < 4; ++ks) xa[t2][ks] = *(const v4u*)(xr + (size_t)(16 * (2 * tp + t2)) * D + 32 * ks);
#pragma unroll
            for (int t2 = 0; t2 < 2; ++t2) {
                const int t = 2 * tp + t2;
                f32x4 acc[3]; float ss = 0.f;
#pragma unroll
                for (int nt = 0; nt < 3; ++nt) acc[nt] = (f32x4){0.f, 0.f, 0.f, 0.f};
#pragma unroll
                for (int ks = 0; ks < 4; ++ks) {
                    float xv[8]; unpack8(xa[t2][ks], xv);
#pragma unroll
                    for (int j = 0; j < 8; ++j) ss += xv[j] * xv[j];
                    const bf16x8 Ah = __builtin_bit_cast(bf16x8, xa[t2][ks]);
#pragma unroll
                    for (int nt = 0; nt < 3; ++nt) { acc[nt] = mfma16(Ah, Wh[ks][nt], acc[nt]); acc[nt] = mfma16(Ah, Wl[ks][nt], acc[nt]); }
                }
                ss += shx(ss, 16); ss += shx(ss, 32);
                LAS float* part = (LAS float*)(lds + RT_PART) + (t * 8 + wave) * 16 * 48;
#pragma unroll
                for (int nt = 0; nt < 3; ++nt)
#pragma unroll
                    for (int r = 0; r < 4; ++r) part[(4 * fq + r) * 48 + 16 * nt + fr] = acc[nt][r];
                if (fq == 0) ((LAS float*)(lds + RT_SS))[(t * 8 + wave) * 16 + fr] = ss;
            }
        }
        __syncthreads();
        {
            const int tt = tid >> 3, j = tid & 7, t = blk * 64 + tt;
            const LAS float* p0 = (const LAS float*)(lds + RT_PART) + ((tt >> 4) * 8 * 16 + (tt & 15)) * 48;
            const LAS float* s2 = (const LAS float*)(lds + RT_SS) + (tt >> 4) * 8 * 16 + (tt & 15);
            float sq = 0.f;
#pragma unroll
            for (int w = 0; w < 8; ++w) sq += s2[w * 16];
            const float rs = rsqrtf(sq * (1.f / D) + EPS);
#define RT_DOT(n) (((p0[(n)] + p0[768 + (n)]) + (p0[1536 + (n)] + p0[2304 + (n)])) + ((p0[3072 + (n)] + p0[3840 + (n)]) + (p0[4608 + (n)] + p0[5376 + (n)])))
            float gv = (j < 4) ? RT_DOT(j & 3) * rs + K.in(13)[(size_t)l * 4 + (j & 3)] : -INFINITY; int gi = j;
            const float gmine = gv;
#pragma unroll
            for (int o = 1; o < 8; o <<= 1) { const float ov = shx(gv, o); const int oi = __float_as_int(shx(__int_as_float(gi), o)); if (ov > gv || (ov == gv && oi < gi)) { gv = ov; gi = oi; } }
            float ge = (j < 4) ? expf(gmine - gv) : 0.f;
#pragma unroll
            for (int o = 1; o < 8; o <<= 1) ge += shx(ge, o);
            const float gw = 1.0f / ge; const int gt = gi;
            const float ev = RT_DOT(4 + gt * 8 + j) * rs + K.in(15)[(size_t)l * 32 + gt * 8 + j];
#undef RT_DOT
            float m0 = ev; int i0 = j;
#pragma unroll
            for (int o = 1; o < 8; o <<= 1) { const float ov = shx(m0, o); const int oi = __float_as_int(shx(__int_as_float(i0), o)); if (ov > m0 || (ov == m0 && oi < i0)) { m0 = ov; i0 = oi; } }
            float m1 = (j == i0) ? -INFINITY : ev; int i1 = j;
#pragma unroll
            for (int o = 1; o < 8; o <<= 1) { const float ov = shx(m1, o); const int oi = __float_as_int(shx(__int_as_float(i1), o)); if (ov > m1 || (ov == m1 && oi < i1)) { m1 = ov; i1 = oi; } }
            if (j == 0) {
                ((LAS float*)(lds + RT_RS))[tt] = rs;
                const float e1 = expf(m1 - m0);
                const float w0 = gw / (1.0f + e1), w1 = gw * e1 / (1.0f + e1);
                const int e0i = gt * 8 + i0, e1i = gt * 8 + i1;
                K.eid()[2 * t] = e0i; K.eid()[2 * t + 1] = e1i; K.ew()[2 * t] = w0; K.ew()[2 * t + 1] = w1;
                LAS int* hist = (LAS int*)(lds + RT_HIST);
                K.slot_of()[2 * t] = __hip_atomic_fetch_add(hist + e0i, 1, __ATOMIC_RELAXED, __HIP_MEMORY_SCOPE_WORKGROUP);
                K.slot_of()[2 * t + 1] = __hip_atomic_fetch_add(hist + e1i, 1, __ATOMIC_RELAXED, __HIP_MEMORY_SCOPE_WORKGROUP);
            }
        }
        __syncthreads();
        if (tid < NE) K.blkcnt()[(size_t)(l * (T / 64) + blk) * NE + tid] = ((LAS int*)(lds + RT_HIST))[tid];
        {
            bf16* hp = K.XN() + (size_t)(blk * 64 + fr) * D + 128 * wave + 8 * fq;
#pragma unroll
            for (int t = 0; t < 4; ++t) {
                const float rs = ((const LAS float*)(lds + RT_RS))[16 * t + fr];
#pragma unroll
                for (int ks = 0; ks < 4; ++ks) {
                    float xv[8]; unpack8(*(const v4u*)(xr + (size_t)(16 * t) * D + 32 * ks), xv);
                    *(v4u*)(hp + (size_t)(16 * t) * D + 32 * ks) = (v4u){pk2(xv[0] * rs * g0[ks].x, xv[1] * rs * g0[ks].y), pk2(xv[2] * rs * g0[ks].z, xv[3] * rs * g0[ks].w), pk2(xv[4] * rs * g1[ks].x, xv[5] * rs * g1[ks].y), pk2(xv[6] * rs * g1[ks].z, xv[7] * rs * g1[ks].w)};
                }
            }
        }
    }
}
__device__ __forceinline__ void phase_scatter(Frame& F, int l) {
    const KA K = KA::fresh(); PHASE_TID;
    LAS int* sm = (LAS int*)F.lds;
    const int* bc = K.blkcnt() + (size_t)l * (T / 64) * NE;
    constexpr int NBLK = T / 64;
#pragma unroll 1
    for (int blk = F.bx; blk < NBLK; blk += F.G) {
        __syncthreads();
        {   const int e = tid & 31, part = tid >> 5;
            int tot = 0, pre = 0;
#pragma unroll
            for (int j = 0; j < NBLK / 16; ++j) { const int bb = part * (NBLK / 16) + j; const int c = bc[bb * NE + e]; tot += c; if (bb < blk) pre += c; }
            sm[part * 32 + e] = tot; sm[512 + part * 32 + e] = pre; }
        __syncthreads();
        if (tid < 32) { int tot = 0, pre = 0;
#pragma unroll
            for (int p = 0; p < 16; ++p) { tot += sm[p * 32 + tid]; pre += sm[512 + p * 32 + tid]; }
            sm[1056 + tid] = tot; sm[1024 + tid] = pre; }
        __syncthreads();
        if (tid == 0) { int a = 0; for (int e = 0; e < NE; ++e) { const int c = sm[1056 + e]; sm[1024 + e] += a; a += c; } }
        if (blk == 0 && tid < 32) ((int*)(K.ctl() + CW_CNT + 64 * l))[tid] = sm[1056 + tid];
        __syncthreads();
        if (tid < 128) { const int a = blk * 128 + tid; const int e = K.eid()[a]; const int pos = sm[1024 + e] + K.slot_of()[a]; K.slot_tok()[pos] = a >> 1; K.slot_of()[a] = pos; }
    }
    __syncthreads();
}
template <bool DUAL>
__device__ __forceinline__ void gemm_core(const bf16* A, const int* rowoff, int K, const float* B0, const float* B1, int ldb, int n0,
                                          float (&acc0)[4][4], float (&acc1)[4][4], float* As, float* Bs0, float* Bs1) {
    const int tid = __builtin_amdgcn_readfirstlane(threadIdx.x >> 6) * 64 + fresh_lane(), tx = tid & 15, ty = tid >> 4;
    const int ar = tid >> 2, ak = (tid & 3) * 4;
    const int bk = (tid >> 4) & 15, bn = (tid & 15) * 4;
    const long aoff = rowoff[ar];
#pragma unroll
    for (int i = 0; i < 4; ++i)
#pragma unroll
        for (int j = 0; j < 4; ++j) { acc0[i][j] = 0.f; acc1[i][j] = 0.f; }
#pragma unroll 1
    for (int k0 = 0; k0 < K; k0 += 16) {
        v2u av = (v2u){0u, 0u};
        if (aoff >= 0) av = *(const v2u*)(A + aoff + k0 + ak);
        f32x4 bv0 = (f32x4){0.f, 0.f, 0.f, 0.f}, bv1 = bv0;
        if (tid < 256) { bv0 = *(const f32x4*)(B0 + (size_t)(k0 + bk) * ldb + n0 + bn); if (DUAL) bv1 = *(const f32x4*)(B1 + (size_t)(k0 + bk) * ldb + n0 + bn); }
        __syncthreads();
        As[(ak + 0) * 132 + ar] = bflo(av.x); As[(ak + 1) * 132 + ar] = bfhi(av.x); As[(ak + 2) * 132 + ar] = bflo(av.y); As[(ak + 3) * 132 + ar] = bfhi(av.y);
        if (tid < 256) { *(f32x4*)(Bs0 + bk * 64 + bn) = bv0; if (DUAL) *(f32x4*)(Bs1 + bk * 64 + bn) = bv1; }
        __syncthreads();
#pragma unroll
        for (int kk = 0; kk < 16; ++kk) {
            const f32x4 a4 = *(const f32x4*)(As + kk * 132 + ty * 4);
            const f32x4 b4 = *(const f32x4*)(Bs0 + kk * 64 + tx * 4);
#pragma unroll
            for (int i = 0; i < 4; ++i)
#pragma unroll
                for (int j = 0; j < 4; ++j) acc0[i][j] += a4[i] * b4[j];
            if (DUAL) {
                const f32x4 c4 = *(const f32x4*)(Bs1 + kk * 64 + tx * 4);
#pragma unroll
                for (int i = 0; i < 4; ++i)
#pragma unroll
                    for (int j = 0; j < 4; ++j) acc1[i][j] += a4[i] * c4[j];
            }
        }
    }
}
template <int MODE>
__device__ __forceinline__ void phase_moe_ref(Frame& F, int l) {
    const KA K = KA::fresh(); PHASE_TID;
    float* As = F.smem; float* Bs0 = F.smem + 16 * 132; float* Bs1 = Bs0 + 16 * 64; int* rowoff = (int*)(Bs1 + 16 * 64); int* offs = rowoff + 128; int* toff = offs + 33;
    int* cnt = (int*)(K.ctl() + CW_CNT + 64 * l);
    const int tx = tid & 15, ty = tid >> 4;
    __syncthreads();
    if (tid == 0) { int a = 0, tt = 0; for (int e = 0; e < NE; ++e) { offs[e] = a; toff[e] = tt; const int c = cnt[e]; a += c; tt += (c + 127) / 128; } offs[NE] = a; toff[NE] = tt; }
    __syncthreads();
    constexpr int N = (MODE == 1) ? DE : D, KD = (MODE == 1) ? D : DE, NTN = N / 64;
    const int ntiles = toff[NE] * NTN;
#pragma unroll 1
    for (int t = F.bx; t < ntiles; t += F.G) {
        const int rt = t / NTN, tn = t % NTN;
        int e = 0;
        for (int j = 1; j < NE; ++j) if (toff[j] <= rt) e = j;
        const int r0 = offs[e] + (rt - toff[e]) * 128, rend = offs[e + 1];
        __syncthreads();
        if (tid < 128) { const int r = r0 + tid; rowoff[tid] = (r < rend) ? ((MODE == 1) ? K.slot_tok()[r] * D : r * DE) : -1; }
        __syncthreads();
        float acc0[4][4], acc1[4][4];
        if (MODE == 1) {
            const float* Wg = K.in(16) + ((size_t)l * NE + e) * D * DE; const float* Wu = K.in(17) + ((size_t)l * NE + e) * D * DE;
            gemm_core<true>(K.XN(), rowoff, KD, Wg, Wu, DE, tn * 64, acc0, acc1, As, Bs0, Bs1);
        } else {
            const float* Wd = K.in(18) + ((size_t)l * NE + e) * DE * D;
            gemm_core<false>(K.H1(), rowoff, KD, Wd, nullptr, D, tn * 64, acc0, acc1, As, Bs0, nullptr);
        }
#pragma unroll
        for (int i = 0; i < 4; ++i) {
            const int r = r0 + ty * 4 + i;
            if (r < rend) {
                v2u o;
                if (MODE == 1) { o.x = pk2(silu(acc0[i][0]) * acc1[i][0], silu(acc0[i][1]) * acc1[i][1]); o.y = pk2(silu(acc0[i][2]) * acc1[i][2], silu(acc0[i][3]) * acc1[i][3]);
                    *(v2u*)(K.H1() + (size_t)r * DE + tn * 64 + tx * 4) = o; }
                else { o.x = pk2(acc0[i][0], acc0[i][1]); o.y = pk2(acc0[i][2], acc0[i][3]); *(v2u*)(K.Y() + (size_t)r * D + tn * 64 + tx * 4) = o; }
            }
        }
    }
    __syncthreads();
}

constexpr int TAB_OFF = LDSCTL_OFF + 1024;
__device__ __forceinline__ void moe_tables(Frame& F, int l) {
    const KA K = KA::fresh(); PHASE_TID;
    LAS int* tab = (LAS int*)(F.lds + TAB_OFF); LAS int* offs = tab + 4 + 4 * 164; LAS int* fpre = offs + 40; LAS int* ppre = fpre + 40;
    const int* cnt = (const int*)(K.ctl() + CW_CNT + 64 * l);
    __syncthreads();
    if (tid == 0) { int a = 0, f = 0, p = 0; for (int e = 0; e < NE; ++e) { const int c = cnt[e]; offs[e] = a; fpre[e] = f; ppre[e] = p; a += c; f += c >> 8; p += (c & 255) ? 1 : 0; }
        offs[NE] = a; fpre[NE] = f; ppre[NE] = p; tab[0] = f + p; }
    __syncthreads();
    const int nfull = fpre[NE], ntile = nfull + ppre[NE];
    if (tid < nfull) { int e = 0; for (int j = 1; j < NE; ++j) if (fpre[j] <= tid) e = j; tab[4 + 4 * tid] = e; tab[5 + 4 * tid] = offs[e] + (tid - fpre[e]) * 256; tab[6 + 4 * tid] = offs[e + 1]; }
    else if (tid < nfull + NE) {
        const int e = tid - nfull, rows = (offs[e + 1] - offs[e]) & 255;
        if (rows) { int rank = 0; for (int j = 0; j < NE; ++j) { const int rj = (offs[j + 1] - offs[j]) & 255; rank += (rj > rows || (rj == rows && j < e)) ? 1 : 0; }
            const int q = nfull + rank; tab[4 + 4 * q] = e; tab[5 + 4 * q] = offs[e] + (fpre[e + 1] - fpre[e]) * 256; tab[6 + 4 * q] = offs[e + 1]; }
    }
    __syncthreads();
    (void)ntile;
}
template <int SUB>
__device__ __forceinline__ void phase_moe(Frame& F, int l) {
    if (SUB == 0) moe_tables(F, l);
    const KA K = KA::fresh();
    int c_ = F.bx; asm volatile("" : "+s"(c_));
    const int G = F.G, c = (c_ & 7) * (G >> 3) + (c_ >> 3);
    const LAS int* tab = (const LAS int*)(F.lds + TAB_OFF);
    const int ntile = __builtin_amdgcn_readfirstlane(tab[0]), ngu = 2 * ntile, nleft = ngu > G ? ngu - G : 0, jX = ngu > G ? (G >> 1) : ntile, W = G - nleft;
    const int yd = (jX * 4 < 2 * W) ? jX * 4 : 2 * W;
    bool do_gu = false, do_dn = false; pg8::MoeSched So{tab, 2, 0, 0, G, c};
    if (SUB == 0) { do_gu = true; So.npn = 2; So.first = 0; So.end = ngu < G ? ngu : G; So.stride = G; So.c = c; }
    if (SUB == 1) { if (c < nleft) { do_gu = true; So.npn = 2; So.first = G; So.end = ngu; So.stride = G; So.c = c; }
                    else { do_dn = true; So.npn = 4; So.first = 0; So.end = yd; So.stride = W; So.c = c - nleft; } }
    if (SUB == 2) { do_dn = true; So.npn = 4; So.first = yd; So.end = ntile * 4; So.stride = G; So.c = c; }
    if (do_gu) { pg8::EpiMoeH E{K.H1()};
        pg8::gemm_phase_moe<pg8::EpiMoeH, pg8::MoeSched, true, 512, D>(F.lds, K.XN(), K.WguT() + (size_t)l * NE * 512 * D, K.slot_tok(), So, E, F.wave); }
    if (do_dn) { pg8::EpiMoeY E{K.Y()};
        pg8::gemm_phase_moe<pg8::EpiMoeY, pg8::MoeSched, false, D, DE>(F.lds, K.H1(), K.WdT() + (size_t)l * NE * D * DE, nullptr, So, E, F.wave); }
}
__device__ __forceinline__ void phase_combine(Frame& F, int l) {
    const KA K = KA::fresh(); PHASE_TID;
    const bool last = (l == DEPTH - 1);
    const float* gain = last ? K.in(19) : (K.in(1) + (size_t)(l + 1) * D);
#pragma unroll 1
    for (int t = F.bx * NWAVES + wave; t < T; t += F.G * NWAVES) {
        const int s0 = K.slot_of()[2 * t], s1 = K.slot_of()[2 * t + 1]; const float w0 = K.ew()[2 * t], w1 = K.ew()[2 * t + 1];
        v2u* xr = (v2u*)(K.XR() + (size_t)t * D) + lane;
        const v2u* y0 = (const v2u*)(K.Y() + (size_t)s0 * D) + lane; const v2u* y1 = (const v2u*)(K.Y() + (size_t)s1 * D) + lane;
        f32x4 v[4]; float s = 0.f;
#pragma unroll
        for (int j = 0; j < 4; ++j) { const v2u xw = xr[64 * j], a = y0[64 * j], b = y1[64 * j];
            v[j].x = bflo(xw.x) + w0 * bflo(a.x) + w1 * bflo(b.x); v[j].y = bfhi(xw.x) + w0 * bfhi(a.x) + w1 * bfhi(b.x); v[j].z = bflo(xw.y) + w0 * bflo(a.y) + w1 * bflo(b.y); v[j].w = bfhi(xw.y) + w0 * bfhi(a.y) + w1 * bfhi(b.y);
            s += (v[j].x * v[j].x + v[j].y * v[j].y) + (v[j].z * v[j].z + v[j].w * v[j].w); }
        const float rs = rsqrtf(wave_sum(s) * (1.f / D) + EPS);
        if (last) {
            f32x4* orow = (f32x4*)(K.out() + (size_t)t * D) + lane;
#pragma unroll
            for (int j = 0; j < 4; ++j) { const f32x4 g = ((const f32x4*)gain)[lane + 64 * j]; orow[64 * j] = (f32x4){v[j].x * rs * g.x, v[j].y * rs * g.y, v[j].z * rs * g.z, v[j].w * rs * g.w}; }
        } else {
            v2u* o8 = (v2u*)(K.XN() + (size_t)t * D) + lane;
#pragma unroll
            for (int j = 0; j < 4; ++j) { xr[64 * j] = (v2u){pk2(v[j].x, v[j].y), pk2(v[j].z, v[j].w)}; const f32x4 g = ((const f32x4*)gain)[lane + 64 * j];
                o8[64 * j] = (v2u){pk2(v[j].x * rs * g.x, v[j].y * rs * g.y), pk2(v[j].z * rs * g.z, v[j].w * rs * g.w)}; }
        }
    }
}

struct Args { const float* in[20]; float* out; unsigned char* ws; };
__global__ void __launch_bounds__(NT, 2) fwd_kernel(Args args) {
    extern __shared__ __attribute__((aligned(16))) unsigned char lds_raw[];
    Frame F;
    F.lds = (LAS unsigned char*)lds_raw; F.smem = (float*)lds_raw;
    F.G = gridDim.x; F.bx = blockIdx.x; F.wave = __builtin_amdgcn_readfirstlane(threadIdx.x >> 6);
    volatile LAS unsigned* MISC = (volatile LAS unsigned*)(F.lds + MISC_OFF);
    for (int u = threadIdx.x; u < (LDS_BYTES - LDSCTL_OFF) / 4; u += NT) ((LAS unsigned*)(F.lds + LDSCTL_OFF))[u] = 0u;
    __syncthreads();
    XcdBarrier bar; { const KA K = KA::fresh(); bar = xcd_barrier_post(K.ctl() + CW_BAR, MISC + 8); }
#define GRID_BAR() xcd_barrier(bar)

    p0_prologue(F);
    GRID_BAR();
    for (int l = 0; l < DEPTH; ++l) {
        {
            const KA K = KA::fresh(); PHASE_TID;
            pg8::Gemm g{K.XN(), K.WinT() + (size_t)l * PLD * D, T, PLD, D}; pg8::StaticOrder So; int c_ = F.bx; asm volatile("" : "+s"(c_)); So.init(T, PLD, F.G, c_);
            pg8::EpiBf16Plain E{K.P(), PLD};
            pg8::gemm_phase<pg8::EpiBf16Plain, pg8::StaticOrder, PG8_ALIGN, PG8_SP2>(F.lds, g, So, E, F.wave);
        }
        GRID_BAR();
        phase_gla_A2(F, l);
        phase_gmlp_mfma(F, l);
        phase_conv(F, l);
        GRID_BAR();
        phase_gla_aggscan(F);
        GRID_BAR();
        phase_gla_C2(F, l);
        GRID_BAR();
        {
            const KA K = KA::fresh(); PHASE_TID;
            pg8::Gemm g{K.XN(), K.WoutT() + (size_t)l * D * D, T, D, D}; pg8::StaticOrder So; int c_ = F.bx; asm volatile("" : "+s"(c_)); So.init(T, D, F.G, c_);
            if (l == 0) { pg8::EpiBf16Res<true> E{K.XR(), K.in(0), D}; pg8::gemm_phase<pg8::EpiBf16Res<true>, pg8::StaticOrder, PG8_ALIGN, PG8_SP2>(F.lds, g, So, E, F.wave); }
            else { pg8::EpiBf16Res<false> E{K.XR(), K.XR(), D}; pg8::gemm_phase<pg8::EpiBf16Res<false>, pg8::StaticOrder, PG8_ALIGN, PG8_SP2>(F.lds, g, So, E, F.wave); }
        }
        GRID_BAR();
        phase_norm_router_mfma(F, l);
        GRID_BAR();
        phase_scatter(F, l);
        GRID_BAR();
        phase_moe<0>(F, l);
        GRID_BAR();
        phase_moe<1>(F, l);
        GRID_BAR();
        phase_moe<2>(F, l);
        GRID_BAR();
        phase_combine(F, l);
        if (l + 1 < DEPTH) GRID_BAR();
    }
}

extern "C" void kernel_launch(void* const* d_in, const int* in_sizes, int n_in, void* d_out, int out_size, void* d_ws, size_t ws_size, hipStream_t stream) {
    static int grid_blocks = 0;
    if (!grid_blocks) {
        int dev = 0, cus = 0, per_cu = 0;
        (void)hipGetDevice(&dev);
        (void)hipDeviceGetAttribute(&cus, hipDeviceAttributeMultiprocessorCount, dev);
        (void)hipFuncSetAttribute((const void*)fwd_kernel, hipFuncAttributeMaxDynamicSharedMemorySize, LDS_BYTES);
        (void)hipOccupancyMaxActiveBlocksPerMultiprocessor(&per_cu, fwd_kernel, NT, LDS_BYTES);
        if (per_cu < 1) { fprintf(stderr, "kernel_launch: occupancy query says %d blocks/CU\n", per_cu); per_cu = 1; }
        grid_blocks = cus;
        if (ws_size < WS_END) { fprintf(stderr, "kernel_launch: workspace too small (%zu < %zu)\n", ws_size, (size_t)WS_END); grid_blocks = -1; }
    }
    if (grid_blocks < 0) return;
    (void)hipMemsetAsync((char*)d_ws + WS_CTL, 0, CTL_BYTES, stream);
    Args a{};
    for (int i = 0; i < 20; ++i) a.in[i] = (const float*)d_in[i];
    a.out = (float*)d_out; a.ws = (unsigned char*)d_ws;
    void* args[] = {&a};
    hipError_t e = hipLaunchCooperativeKernel((void*)fwd_kernel, dim3(grid_blocks), dim3(NT), args, LDS_BYTES, stream);
    if (e != hipSuccess) fprintf(stderr, "cooperative launch failed: %s (grid %d)\n", hipGetErrorString(e), grid_blocks);
}
```

```cpp
#include <hip/hip_runtime.h>
#include <hip/hip_cooperative_groups.h>
#include <cstdio>
#include <cstdint>
namespace cg = cooperative_groups;
__device__ __forceinline__ int fresh_lane() { unsigned m = 0xffffffffu; asm volatile("" : "+s"(m)); return (int)__builtin_amdgcn_mbcnt_hi(m, __builtin_amdgcn_mbcnt_lo(m, 0u)); }
__device__ __forceinline__ float shx(float v, int o) { return __int_as_float(__builtin_amdgcn_ds_bpermute((fresh_lane() ^ o) << 2, __float_as_int(v))); }
__device__ __forceinline__ int dpp_x1(int v) { return __builtin_amdgcn_update_dpp(v, v, 0xB1, 0xF, 0xF, false); }
__device__ __forceinline__ int dpp_x2(int v) { return __builtin_amdgcn_update_dpp(v, v, 0x4E, 0xF, 0xF, false); }
__device__ __forceinline__ int dpp_hm(int v) { return __builtin_amdgcn_update_dpp(v, v, 0x141, 0xF, 0xF, false); }
__device__ __forceinline__ int dpp_rm(int v) { return __builtin_amdgcn_update_dpp(v, v, 0x140, 0xF, 0xF, false); }
__device__ __forceinline__ float dppf_x1(float v) { return __int_as_float(dpp_x1(__float_as_int(v))); }
__device__ __forceinline__ float dppf_x2(float v) { return __int_as_float(dpp_x2(__float_as_int(v))); }
__device__ __forceinline__ float dppf_hm(float v) { return __int_as_float(dpp_hm(__float_as_int(v))); }
__device__ __forceinline__ float dppf_rm(float v) { return __int_as_float(dpp_rm(__float_as_int(v))); }
__device__ __forceinline__ float sum8(float v) { v += dppf_x1(v); v += dppf_x2(v); v += dppf_hm(v); return v; }
__device__ __forceinline__ float sum16(float v) { v = sum8(v); v += dppf_rm(v); return v; }
namespace pg8 {
#define PG8_LAS __attribute__((address_space(3)))
typedef unsigned short bf16_t;
typedef short bf16x8 __attribute__((ext_vector_type(8)));
typedef float f32x4 __attribute__((ext_vector_type(4)));
typedef unsigned u32x4 __attribute__((ext_vector_type(4)));
constexpr int BM = 256, BK = 64, HALF = 128, HTB = HALF * BK * 2  , STAGE_BYTES = 8 * HTB, NXCD = 8, WGM = 8;

__host__ __device__ __forceinline__ int lds_byte(int r, int c) { const int st = (r >> 4) * 2 + (c >> 5), rr = r & 15, cc = c & 31, ob = rr * 64 + cc * 2; return st * 1024 + (ob ^ (((ob >> 9) & 1) << 5)); }
__host__ __device__ __forceinline__ void stage_rc(int b, int& R, int& C) { const int st = b / 1024, sb = b % 1024, swz = sb ^ (((sb >> 9) & 1) << 5); R = (st >> 1) * 16 + swz / 64; C = (st & 1) * 32 + (swz % 64) / 2; }
__host__ __device__ __forceinline__ int perm32(int rho) { const int n = rho >> 4, i = rho & 15; return 8 * (i >> 2) + 4 * n + (i & 3); }

struct Unit { int pm, pn; };
struct Gemm { const bf16_t* A; const bf16_t* Bt; int M, N, K; };

struct StaticOrder {
    int nM, nN, nwg, G, c;
    __host__ __device__ void init(int M, int N, int G_, int c_) { nM = M / BM; nN = N / BM; nwg = nM * nN; G = G_; c = c_; }
    __host__ __device__ bool next(int i, Unit& u) const {
        const long L = (long)i * G + c; if (L >= nwg) return false;
        int wgid = (int)L; { const int q = nwg / NXCD, r = nwg % NXCD, xcd = wgid % NXCD, off = wgid / NXCD; wgid = (xcd < r ? xcd * (q + 1) : r * (q + 1) + (xcd - r) * q) + off; }
        const int nig = WGM * nN, gid = wgid / nig, fm = gid * WGM, gsz = (nM - fm) < WGM ? (nM - fm) : WGM;
        u.pm = fm + ((wgid % nig) % gsz); u.pn = (wgid % nig) / gsz; return true;
    }
    __device__ __forceinline__ void a_ready(const Unit&) const {}
    __device__ __forceinline__ void done(const Unit&) const {}
};


__device__ __forceinline__ unsigned cvt_pk_bf16(float lo, float hi) { unsigned r; asm volatile("v_cvt_pk_bf16_f32 %0, %1, %2" : "=v"(r) : "v"(lo), "v"(hi)); return r; }
struct EpiBf16Plain {
    static constexpr bool PERM = true, AFTER_DRAIN = false;
    bf16_t* O; int ldc;
    __device__ __forceinline__ void operator()(const f32x4 (&acc)[2][2][4][2], const Unit& u, int wr, int wc, int fr, int fq) const {
        const int row0 = u.pm * BM + wr * 64 + fr, col0 = u.pn * BM + wc * 32 + 8 * fq;
#pragma unroll
        for (int ai = 0; ai < 2; ++ai)
#pragma unroll
            for (int m = 0; m < 4; ++m) { bf16_t* rowp = O + (size_t)(row0 + ai * HALF + m * 16) * ldc + col0;
#pragma unroll
                for (int bj = 0; bj < 2; ++bj) { const f32x4 v0 = acc[ai][bj][m][0], v1 = acc[ai][bj][m][1];
                    u32x4 w; w.x = cvt_pk_bf16(v0[0], v0[1]); w.y = cvt_pk_bf16(v0[2], v0[3]); w.z = cvt_pk_bf16(v1[0], v1[1]); w.w = cvt_pk_bf16(v1[2], v1[3]);
                    *(u32x4*)(rowp + bj * HALF) = w; } }
    }
};
template <bool RES_F32>
struct EpiBf16Res {
    static constexpr bool PERM = true, AFTER_DRAIN = false;
    bf16_t* O; const void* R; int ldc;
    __device__ __forceinline__ void operator()(const f32x4 (&acc)[2][2][4][2], const Unit& u, int wr, int wc, int fr, int fq) const {
        const int row0 = u.pm * BM + wr * 64 + fr, col0 = u.pn * BM + wc * 32 + 8 * fq;
#pragma unroll
        for (int ai = 0; ai < 2; ++ai)
#pragma unroll
            for (int m = 0; m < 4; ++m) { const size_t off = (size_t)(row0 + ai * HALF + m * 16) * ldc + col0;
#pragma unroll
                for (int bj = 0; bj < 2; ++bj) { f32x4 v0 = acc[ai][bj][m][0], v1 = acc[ai][bj][m][1];
                    if (RES_F32) { const float* rp = (const float*)R + off + bj * HALF; v0 += *(const f32x4*)rp; v1 += *(const f32x4*)(rp + 4); }
                    else { const u32x4 rw = *(const u32x4*)((const bf16_t*)R + off + bj * HALF);
                        v0[0] += __uint_as_float(rw.x << 16); v0[1] += __uint_as_float(rw.x & 0xffff0000u); v0[2] += __uint_as_float(rw.y << 16); v0[3] += __uint_as_float(rw.y & 0xffff0000u);
                        v1[0] += __uint_as_float(rw.z << 16); v1[1] += __uint_as_float(rw.z & 0xffff0000u); v1[2] += __uint_as_float(rw.w << 16); v1[3] += __uint_as_float(rw.w & 0xffff0000u); }
                    u32x4 w; w.x = cvt_pk_bf16(v0[0], v0[1]); w.y = cvt_pk_bf16(v0[2], v0[3]); w.z = cvt_pk_bf16(v1[0], v1[1]); w.w = cvt_pk_bf16(v1[2], v1[3]);
                    *(u32x4*)(O + off + bj * HALF) = w; } }
    }
};
struct EpiF32Res {
    static constexpr bool PERM = false, AFTER_DRAIN = false;
    float* C; const float* R; int ldc;
    __device__ __forceinline__ void operator()(const f32x4 (&acc)[2][2][4][2], const Unit& u, int wr, int wc, int fr, int fq) const {
        const int row0 = u.pm * BM + wr * 64 + fr, col0 = u.pn * BM + wc * 32 + 4 * fq;
#pragma unroll
        for (int ai = 0; ai < 2; ++ai)
#pragma unroll
            for (int m = 0; m < 4; ++m) { const size_t off = (size_t)(row0 + ai * HALF + m * 16) * ldc + col0;
#pragma unroll
                for (int bj = 0; bj < 2; ++bj)
#pragma unroll
                    for (int n = 0; n < 2; ++n) { const f32x4 r = *(const f32x4*)(R + off + bj * HALF + n * 16); *(f32x4*)(C + off + bj * HALF + n * 16) = r + acc[ai][bj][m][n]; } }
    }
};
template <class Epi, class Sched, bool ALIGN_EPI = false, bool SP2 = false>
__device__ __forceinline__ void gemm_phase(PG8_LAS unsigned char* lds, const Gemm g, const Sched& S, const Epi& E, int wave_id) {
    asm volatile("" : "+s"(wave_id));
    const int lane = fresh_lane(), wid = wave_id, tid = wid * 64 + lane, wr = wid >> 2, wc = wid & 3, fr = lane & 15, fq = lane >> 4;
    const int K = g.K, nt = K / BK;
    unsigned voffA[2], voffB[2];
#pragma unroll
    for (int i = 0; i < 2; ++i) { int R, C; stage_rc(tid * 16 + i * 8192, R, C); const int Rb = Epi::PERM ? ((R & ~31) + perm32(R & 31)) : R;
        voffA[i] = (unsigned)(R * K + C) * 2u; voffB[i] = (unsigned)(Rb * K + C) * 2u; }
    const size_t kstep = (size_t)(BK * 2);
    const size_t hstep = (size_t)HALF * K * 2;
    const size_t tstep = 2 * hstep;
    const unsigned ldsw = (unsigned)wid * 1024u;
    const int aoff = lds_byte(wr * 64 + fr, fq * 8), boff = lds_byte(wc * 32 + fr, fq * 8);
#define PG8_SA(b, h) (((b) * 2 + (h)) * HTB)
#define PG8_SB(b, h) ((4 + (b) * 2 + (h)) * HTB)
#define PG8_STAGE(bufoff, gbase, voff) do { _Pragma("unroll") for (int _i = 0; _i < 2; ++_i) \
        __builtin_amdgcn_global_load_lds((const unsigned*)((const char*)(gbase) + (voff)[_i]), (PG8_LAS unsigned*)(lds + (bufoff) + ldsw + _i * 8192), 16, 0, 0); } while (0)
#define PG8_LDA(dst, b, h) do { _Pragma("unroll") for (int m = 0; m < 4; ++m) _Pragma("unroll") for (int k = 0; k < 2; ++k) dst[m][k] = *(const PG8_LAS bf16x8*)(lds + PG8_SA(b, h) + aoff + m * 2048 + k * 1024); } while (0)
#define PG8_LDB(dst, b, h) do { _Pragma("unroll") for (int n = 0; n < 2; ++n) _Pragma("unroll") for (int k = 0; k < 2; ++k) dst[n][k] = *(const PG8_LAS bf16x8*)(lds + PG8_SB(b, h) + boff + n * 2048 + k * 1024); } while (0)
#define PG8_MMA(ai, bj, At, Bt) do { __builtin_amdgcn_s_setprio(1); _Pragma("unroll") for (int m = 0; m < 4; ++m) _Pragma("unroll") for (int n = 0; n < 2; ++n) _Pragma("unroll") for (int k = 0; k < 2; ++k) \
        acc[ai][bj][m][n] = __builtin_amdgcn_mfma_f32_16x16x32_bf16(Bt[n][k], At[m][k], acc[ai][bj][m][n], 0, 0, 0); __builtin_amdgcn_s_setprio(0); } while (0)
#define PG8_WAIT_V(n) asm volatile("s_waitcnt vmcnt(" #n ")" ::: "memory")
#define PG8_WAIT_L(n) asm volatile("s_waitcnt lgkmcnt(" #n ")" ::: "memory")
#define PG8_BAR __builtin_amdgcn_s_barrier()
#define PG8_SCHED __builtin_amdgcn_sched_barrier(0)
    Unit cur, nxt; int ui = 0;
    if (!S.next(0, cur)) return;
    f32x4 acc[2][2][4][2];
#pragma unroll
    for (int a = 0; a < 2; ++a)
#pragma unroll
        for (int b = 0; b < 2; ++b)
#pragma unroll
            for (int m = 0; m < 4; ++m)
#pragma unroll
                for (int n = 0; n < 2; ++n) acc[a][b][m][n] = (f32x4){0.f, 0.f, 0.f, 0.f};
    bf16x8 At[4][2], B0[2][2], B1[2][2];
    const char* cA = (const char*)g.A + (size_t)cur.pm * tstep; const char* cB = (const char*)g.Bt + (size_t)cur.pn * tstep;
    S.a_ready(cur);
    if constexpr (SP2) {
        PG8_STAGE(PG8_SB(0, 0), cB, voffB); PG8_STAGE(PG8_SB(0, 1), cB + hstep, voffB); PG8_STAGE(PG8_SA(0, 0), cA, voffA); PG8_STAGE(PG8_SA(0, 1), cA + hstep, voffA);
        if (wr == 1) PG8_BAR;
        PG8_WAIT_V(2); PG8_BAR;
        PG8_STAGE(PG8_SB(1, 0), cB + kstep, voffB); PG8_STAGE(PG8_SA(1, 0), cA + kstep, voffA); PG8_STAGE(PG8_SB(1, 1), cB + hstep + kstep, voffB);
        PG8_WAIT_V(6); PG8_BAR;
    } else {
        PG8_STAGE(PG8_SB(0, 0), cB, voffB); PG8_STAGE(PG8_SA(0, 0), cA, voffA); PG8_STAGE(PG8_SB(0, 1), cB + hstep, voffB); PG8_STAGE(PG8_SA(0, 1), cA + hstep, voffA);
        if (wr == 1) PG8_BAR;
        PG8_WAIT_V(4); PG8_BAR;
        PG8_STAGE(PG8_SB(1, 0), cB + kstep, voffB); PG8_STAGE(PG8_SA(1, 0), cA + kstep, voffA); PG8_STAGE(PG8_SB(1, 1), cB + hstep + kstep, voffB);
        PG8_WAIT_V(6); PG8_BAR;
    }
    for (;;) {
        const bool has_next = S.next(ui + 1, nxt);
        const char* nA = has_next ? (const char*)g.A + (size_t)nxt.pm * tstep : cA; const char* nB = has_next ? (const char*)g.Bt + (size_t)nxt.pn * tstep : cB;
        for (int t = 0; t < nt; t += 2) {
            const bool last = (t == nt - 2);
            const char* a1 = cA + (size_t)(t + 1) * kstep;
            const char* a2 = last ? nA : cA + (size_t)(t + 2) * kstep; const char* b2 = last ? nB : cB + (size_t)(t + 2) * kstep;
            const char* a3 = a2 + kstep; const char* b3 = b2 + kstep;
            if (last && has_next) S.a_ready(nxt);
            if constexpr (SP2) {
            PG8_LDB(B0, 0, 0); PG8_LDB(B1, 0, 1); PG8_SCHED; PG8_LDA(At, 0, 0); PG8_STAGE(PG8_SA(1, 1), a1 + hstep, voffA);
            PG8_WAIT_V(8); PG8_WAIT_L(0); PG8_BAR; PG8_MMA(0, 0, At, B0); PG8_MMA(0, 1, At, B1); PG8_BAR; PG8_SCHED;
            PG8_LDA(At, 0, 1); PG8_STAGE(PG8_SB(0, 0), b2, voffB); PG8_STAGE(PG8_SB(0, 1), b2 + hstep, voffB); PG8_STAGE(PG8_SA(0, 0), a2, voffA);
            PG8_WAIT_V(8); PG8_WAIT_L(0); PG8_BAR; PG8_MMA(1, 0, At, B0); PG8_MMA(1, 1, At, B1); PG8_BAR; PG8_SCHED;
            PG8_LDB(B0, 1, 0); PG8_LDB(B1, 1, 1); PG8_SCHED; PG8_LDA(At, 1, 0); PG8_STAGE(PG8_SA(0, 1), a2 + hstep, voffA);
            PG8_WAIT_V(8); PG8_WAIT_L(0); PG8_BAR; PG8_MMA(0, 0, At, B0); PG8_MMA(0, 1, At, B1); PG8_BAR; PG8_SCHED;
            PG8_LDA(At, 1, 1); PG8_STAGE(PG8_SB(1, 0), b3, voffB); PG8_STAGE(PG8_SB(1, 1), b3 + hstep, voffB); PG8_STAGE(PG8_SA(1, 0), a3, voffA);
            PG8_WAIT_V(8); PG8_WAIT_L(0); PG8_BAR; PG8_MMA(1, 0, At, B0); PG8_MMA(1, 1, At, B1); PG8_BAR; PG8_SCHED;
            } else {
            PG8_LDB(B0, 0, 0); PG8_SCHED; PG8_LDA(At, 0, 0); PG8_STAGE(PG8_SA(1, 1), a1 + hstep, voffA);
            PG8_WAIT_L(8); PG8_BAR; PG8_WAIT_L(0); PG8_MMA(0, 0, At, B0); PG8_BAR; PG8_SCHED;
            PG8_LDB(B1, 0, 1); PG8_STAGE(PG8_SB(0, 0), b2, voffB);
            PG8_BAR; PG8_WAIT_L(0); PG8_MMA(0, 1, At, B1); PG8_BAR;
            PG8_LDA(At, 0, 1); PG8_STAGE(PG8_SA(0, 0), a2, voffA);
            PG8_BAR; PG8_WAIT_L(0); PG8_MMA(1, 0, At, B0); PG8_BAR; PG8_SCHED;
            PG8_STAGE(PG8_SB(0, 1), b2 + hstep, voffB);
            PG8_WAIT_V(6); PG8_BAR; PG8_MMA(1, 1, At, B1); PG8_BAR;
            PG8_LDB(B0, 1, 0); PG8_SCHED; PG8_LDA(At, 1, 0); PG8_STAGE(PG8_SA(0, 1), a2 + hstep, voffA);
            PG8_WAIT_L(8); PG8_BAR; PG8_WAIT_L(0); PG8_MMA(0, 0, At, B0); PG8_BAR; PG8_SCHED;
            PG8_LDB(B1, 1, 1); PG8_STAGE(PG8_SB(1, 0), b3, voffB);
            PG8_BAR; PG8_WAIT_L(0); PG8_MMA(0, 1, At, B1); PG8_BAR;
            PG8_LDA(At, 1, 1); PG8_STAGE(PG8_SA(1, 0), a3, voffA);
            PG8_BAR; PG8_WAIT_L(0); PG8_MMA(1, 0, At, B0); PG8_BAR; PG8_SCHED;
            PG8_STAGE(PG8_SB(1, 1), b3 + hstep, voffB);
            PG8_WAIT_V(6); PG8_BAR; PG8_MMA(1, 1, At, B1); PG8_BAR;
            }
        }
        if constexpr (ALIGN_EPI) { if (wr == 0) PG8_BAR; }
        if constexpr (!Epi::AFTER_DRAIN) { E(acc, cur, wr, wc, fr, fq); S.done(cur); }
        if (!has_next) break;
#pragma unroll
        for (int a = 0; a < 2; ++a)
#pragma unroll
            for (int b = 0; b < 2; ++b)
#pragma unroll
                for (int m = 0; m < 4; ++m)
#pragma unroll
                    for (int n = 0; n < 2; ++n) acc[a][b][m][n] = (f32x4){0.f, 0.f, 0.f, 0.f};
        cur = nxt; cA = nA; cB = nB; ++ui;
        if constexpr (ALIGN_EPI) { if (wr == 1) PG8_BAR; }
    }
    PG8_WAIT_V(0);
    if constexpr (!ALIGN_EPI) { if (wr == 0) PG8_BAR; }
    PG8_BAR;
    if constexpr (Epi::AFTER_DRAIN) { E.fused(acc, cur, wr, wc, fr, fq, lds, wid, lane); S.done(cur); }
#undef PG8_SA
#undef PG8_SB
#undef PG8_STAGE
#undef PG8_LDA
#undef PG8_LDB
#undef PG8_MMA
#undef PG8_WAIT_V
#undef PG8_WAIT_L
#undef PG8_BAR
#undef PG8_SCHED
}

struct MUnit { int r0, rend, e, pn; };
#define MG_LANE_OFFS(u, o) do { const int _t = wid * 64 + fresh_lane(); _Pragma("unroll") for (int _i = 0; _i < 2; ++_i) { int _R, _C; stage_rc(_t * 16 + _i * 8192, _R, _C); _Pragma("unroll") for (int _h = 0; _h < 2; ++_h) { const int _r = (u).r0 + _h * HALF + _R; \
        int _row = _r; if (GATHER) { _row = 0; if (_r < (u).rend) _row = slot_tok[_r]; } (o)[_h][_i] = (unsigned)(_row * K + _C) * 2u; } } } while (0)
template <class Epi, class Sched, bool GATHER, int N, int K>
__device__ __forceinline__ void gemm_phase_moe(PG8_LAS unsigned char* lds, const bf16_t* A, const bf16_t* Bt, const int* slot_tok, const Sched& S, const Epi& E, int wave_id) {
    asm volatile("" : "+s"(wave_id));
    const int lane = fresh_lane(), wid = wave_id, tid = wid * 64 + lane, wr = wid >> 2, wc = wid & 3, fr = lane & 15, fq = lane >> 4;
    constexpr int nt = K / BK;
#define MG_OFFP(par) ((PG8_LAS unsigned*)(lds + STAGE_BYTES + 8192) + (par) * 2048 + tid)
#define MG_VOFFB ((PG8_LAS unsigned*)(lds + STAGE_BYTES + 24576) + tid)
#pragma unroll
    for (int i = 0; i < 2; ++i) { int R, C; stage_rc(tid * 16 + i * 8192, R, C); const int Rb = Epi::PERM ? ((R & ~31) + perm32(R & 31)) : R; MG_VOFFB[i * 512] = (unsigned)(Rb * K + C) * 2u; }
    constexpr size_t kstep = (size_t)(BK * 2);
    constexpr size_t hstep = (size_t)HALF * K * 2;
    constexpr size_t tstep = 2 * hstep;
    constexpr size_t estep = (size_t)N * K * 2;
    const unsigned ldsw = (unsigned)wid * 1024u;
    const int aoff = lds_byte(wr * 64 + fr, fq * 8), boff = lds_byte(wc * 32 + fr, fq * 8);
#define PG8_SA(b, h) (((b) * 2 + (h)) * HTB)
#define PG8_SB(b, h) ((4 + (b) * 2 + (h)) * HTB)
#define PG8_STAGE(bufoff, gbase, voff) do { _Pragma("unroll") for (int _i = 0; _i < 2; ++_i) \
        __builtin_amdgcn_global_load_lds((const unsigned*)((const char*)(gbase) + MG_VOFFB[_i * 512]), (PG8_LAS unsigned*)(lds + (bufoff) + ldsw + _i * 8192), 16, 0, 0); } while (0)
#define MG_STAGE_A(bufoff, par, h, kb) do { _Pragma("unroll") for (int _i = 0; _i < 2; ++_i) \
        __builtin_amdgcn_global_load_lds((const unsigned*)((const char*)A + (size_t)MG_OFFP(par)[((h) * 2 + _i) * 512] + (kb)), (PG8_LAS unsigned*)(lds + (bufoff) + ldsw + _i * 8192), 16, 0, 0); } while (0)
#define PG8_LDA(dst, b, h) do { _Pragma("unroll") for (int m = 0; m < 4; ++m) _Pragma("unroll") for (int k = 0; k < 2; ++k) dst[m][k] = *(const PG8_LAS bf16x8*)(lds + PG8_SA(b, h) + aoff + m * 2048 + k * 1024); } while (0)
#define PG8_LDB(dst, b, h) do { _Pragma("unroll") for (int n = 0; n < 2; ++n) _Pragma("unroll") for (int k = 0; k < 2; ++k) dst[n][k] = *(const PG8_LAS bf16x8*)(lds + PG8_SB(b, h) + boff + n * 2048 + k * 1024); } while (0)
#define PG8_MMA(ai, bj, At, Bt_) do { __builtin_amdgcn_s_setprio(1); _Pragma("unroll") for (int m = 0; m < 4; ++m) _Pragma("unroll") for (int n = 0; n < 2; ++n) _Pragma("unroll") for (int k = 0; k < 2; ++k) \
        acc[ai][bj][m][n] = __builtin_amdgcn_mfma_f32_16x16x32_bf16(Bt_[n][k], At[m][k], acc[ai][bj][m][n], 0, 0, 0); __builtin_amdgcn_s_setprio(0); } while (0)
#define PG8_WAIT_V(n) asm volatile("s_waitcnt vmcnt(" #n ")" ::: "memory")
#define PG8_WAIT_L(n) asm volatile("s_waitcnt lgkmcnt(" #n ")" ::: "memory")
#define PG8_BAR __builtin_amdgcn_s_barrier()
#define PG8_SCHED __builtin_amdgcn_sched_barrier(0)
    MUnit cur, nxt; int ui = 0;
    if (!S.next(0, cur)) return;
    f32x4 acc[2][2][4][2];
#pragma unroll
    for (int a = 0; a < 2; ++a)
#pragma unroll
        for (int b = 0; b < 2; ++b)
#pragma unroll
            for (int m = 0; m < 4; ++m)
#pragma unroll
                for (int n = 0; n < 2; ++n) acc[a][b][m][n] = (f32x4){0.f, 0.f, 0.f, 0.f};
    bf16x8 At[4][2], B0[2][2], B1[2][2];
    { unsigned o_[2][2]; MG_LANE_OFFS(cur, o_); PG8_LAS unsigned* p_ = MG_OFFP(0); p_[0] = o_[0][0]; p_[512] = o_[0][1]; p_[1024] = o_[1][0]; p_[1536] = o_[1][1]; }
    const char* cB = (const char*)Bt + (size_t)cur.e * estep + (size_t)cur.pn * tstep;
    PG8_STAGE(PG8_SB(0, 0), cB, voffB); PG8_STAGE(PG8_SB(0, 1), cB + hstep, voffB); MG_STAGE_A(PG8_SA(0, 0), 0, 0, 0); MG_STAGE_A(PG8_SA(0, 1), 0, 1, 0);
    if (wr == 1) PG8_BAR;
    PG8_WAIT_V(2); PG8_BAR;
    PG8_STAGE(PG8_SB(1, 0), cB + kstep, voffB); MG_STAGE_A(PG8_SA(1, 0), 0, 0, kstep); PG8_STAGE(PG8_SB(1, 1), cB + hstep + kstep, voffB);
    PG8_WAIT_V(6); PG8_BAR;
    for (;;) {
        const bool has_next = S.next(ui + 1, nxt);
        const bool hi_rows = (cur.rend - cur.r0) > HALF;
        const char* nB = cB;
        const int pc = ui & 1, pn_ = has_next ? (pc ^ 1) : pc;
        if (has_next) { unsigned on[2][2]; MG_LANE_OFFS(nxt, on); nB = (const char*)Bt + (size_t)nxt.e * estep + (size_t)nxt.pn * tstep;
            PG8_LAS unsigned* p_ = MG_OFFP(pn_); p_[0] = on[0][0]; p_[512] = on[0][1]; p_[1024] = on[1][0]; p_[1536] = on[1][1]; }
        for (int t = 0; t < nt; t += 2) {
            const bool last = (t == nt - 2);
            const size_t k1 = (size_t)(t + 1) * kstep, k2 = last ? (size_t)0 : (size_t)(t + 2) * kstep, k3 = k2 + kstep;
            const char* b2 = last ? nB : cB + (size_t)(t + 2) * kstep; const char* b3 = b2 + kstep;
            const int p2 = last ? pn_ : pc;
            PG8_LDB(B0, 0, 0); PG8_LDB(B1, 0, 1); PG8_SCHED; PG8_LDA(At, 0, 0); MG_STAGE_A(PG8_SA(1, 1), pc, 1, k1);
            PG8_WAIT_V(8); PG8_WAIT_L(0); PG8_BAR; PG8_MMA(0, 0, At, B0); PG8_MMA(0, 1, At, B1); PG8_BAR; PG8_SCHED;
            PG8_LDA(At, 0, 1); PG8_STAGE(PG8_SB(0, 0), b2, voffB); PG8_STAGE(PG8_SB(0, 1), b2 + hstep, voffB); MG_STAGE_A(PG8_SA(0, 0), p2, 0, k2);
            PG8_WAIT_V(8); PG8_WAIT_L(0); PG8_BAR; if (hi_rows) { PG8_MMA(1, 0, At, B0); PG8_MMA(1, 1, At, B1); } PG8_BAR; PG8_SCHED;
            PG8_LDB(B0, 1, 0); PG8_LDB(B1, 1, 1); PG8_SCHED; PG8_LDA(At, 1, 0); MG_STAGE_A(PG8_SA(0, 1), p2, 1, k2);
            PG8_WAIT_V(8); PG8_WAIT_L(0); PG8_BAR; PG8_MMA(0, 0, At, B0); PG8_MMA(0, 1, At, B1); PG8_BAR; PG8_SCHED;
            PG8_LDA(At, 1, 1); PG8_STAGE(PG8_SB(1, 0), b3, voffB); PG8_STAGE(PG8_SB(1, 1), b3 + hstep, voffB); MG_STAGE_A(PG8_SA(1, 0), p2, 0, k3);
            PG8_WAIT_V(8); PG8_WAIT_L(0); PG8_BAR; if (hi_rows) { PG8_MMA(1, 0, At, B0); PG8_MMA(1, 1, At, B1); } PG8_BAR; PG8_SCHED;
        }
        if (wr == 0) PG8_BAR;
        E(acc, cur, wr, wc, fr, fq);
        if (!has_next) break;
#pragma unroll
        for (int a = 0; a < 2; ++a)
#pragma unroll
            for (int b = 0; b < 2; ++b)
#pragma unroll
                for (int m = 0; m < 4; ++m)
#pragma unroll
                    for (int n = 0; n < 2; ++n) acc[a][b][m][n] = (f32x4){0.f, 0.f, 0.f, 0.f};
        cur = nxt; cB = nB; ++ui;
        if (wr == 1) PG8_BAR;
    }
    PG8_WAIT_V(0);
    PG8_BAR;
#undef PG8_SA
#undef PG8_SB
#undef PG8_STAGE
#undef MG_STAGE_A
#undef MG_OFFP
#undef MG_VOFFB
#undef PG8_LDA
#undef PG8_LDB
#undef PG8_MMA
#undef PG8_WAIT_V
#undef PG8_WAIT_L
#undef PG8_BAR
#undef PG8_SCHED
}
__device__ __forceinline__ float fast_silu(float x) { return x * __builtin_amdgcn_rcpf(1.0f + __builtin_amdgcn_exp2f(-1.4426950408889634f * x)); }
struct EpiMoeH {
    static constexpr bool PERM = true;
    bf16_t* H;
    __device__ __forceinline__ void operator()(const f32x4 (&acc)[2][2][4][2], const MUnit& u, int wr, int wc, int fr, int fq) const {
        { const int t_ = fresh_lane(); fr = t_ & 15; fq = t_ >> 4; }
        const int col0 = u.pn * 128 + wc * 32 + 8 * fq;
#pragma unroll
        for (int ai = 0; ai < 2; ++ai)
#pragma unroll
            for (int m = 0; m < 4; ++m) { const int r = u.r0 + ai * HALF + wr * 64 + m * 16 + fr;
                const f32x4 g0 = acc[ai][0][m][0], g1 = acc[ai][0][m][1], u0 = acc[ai][1][m][0], u1 = acc[ai][1][m][1];
                u32x4 w; w.x = cvt_pk_bf16(fast_silu(g0[0]) * u0[0], fast_silu(g0[1]) * u0[1]); w.y = cvt_pk_bf16(fast_silu(g0[2]) * u0[2], fast_silu(g0[3]) * u0[3]);
                w.z = cvt_pk_bf16(fast_silu(g1[0]) * u1[0], fast_silu(g1[1]) * u1[1]); w.w = cvt_pk_bf16(fast_silu(g1[2]) * u1[2], fast_silu(g1[3]) * u1[3]);
                if (r < u.rend) *(u32x4*)(H + (size_t)r * 256 + col0) = w; }
    }
};
struct EpiMoeY {
    static constexpr bool PERM = true;
    bf16_t* Y;
    __device__ __forceinline__ void operator()(const f32x4 (&acc)[2][2][4][2], const MUnit& u, int wr, int wc, int fr, int fq) const {
        { const int t_ = fresh_lane(); fr = t_ & 15; fq = t_ >> 4; }
        const int col0 = u.pn * BM + wc * 32 + 8 * fq;
#pragma unroll
        for (int ai = 0; ai < 2; ++ai)
#pragma unroll
            for (int m = 0; m < 4; ++m) { const int r = u.r0 + ai * HALF + wr * 64 + m * 16 + fr;
#pragma unroll
                for (int bj = 0; bj < 2; ++bj) { const f32x4 v0 = acc[ai][bj][m][0], v1 = acc[ai][bj][m][1];
                    u32x4 w; w.x = cvt_pk_bf16(v0[0], v0[1]); w.y = cvt_pk_bf16(v0[2], v0[3]); w.z = cvt_pk_bf16(v1[0], v1[1]); w.w = cvt_pk_bf16(v1[2], v1[3]);
                    if (r < u.rend) *(u32x4*)(Y + (size_t)r * 1024 + col0 + bj * HALF) = w; } }
    }
};
struct MoeSched {
    const PG8_LAS int* tab;
    int npn, first, end, stride, c;
    __device__ __forceinline__ bool next(int i, MUnit& u) const {
        const int L = first + c + i * stride;
        if (c < 0 || L >= end) return false;
        const int j = L / npn; u.pn = L % npn;
        u.e = __builtin_amdgcn_readfirstlane(tab[4 + 4 * j]); u.r0 = __builtin_amdgcn_readfirstlane(tab[5 + 4 * j]); u.rend = __builtin_amdgcn_readfirstlane(tab[6 + 4 * j]);
        return true;
    }
};
}

#ifndef PG8_SP2
#define PG8_SP2 true
#endif
#ifndef PG8_ALIGN
#define PG8_ALIGN true
#endif

constexpr int NWAVES = 8, NT = NWAVES * 64;
constexpr int D = 1024, NB = 2, S = 8192, T = NB * S, DEPTH = 2;
constexpr int DIN = 2832, PLD = 3072;
constexpr int C_Q = 0, C_K = 256, C_V = 512, C_G = 1024, C_GK = 1536, C_U = 1552, C_VG = 1808, C_XI = 2064, C_BG = 2320, C_CG = 2576;
constexpr int GH = 4, GC = 64, GN = S / GC;
constexpr int MH = 4, MC = 128, MN = S / MC;
constexpr int NE = 32, DE = 256;
constexpr float EPS = 1e-6f;
constexpr size_t MiB = 1u << 20;
constexpr size_t WS_CTL = 0, CTL_BYTES = 1 * MiB;
constexpr size_t WS_WIN = 1 * MiB;
constexpr size_t WS_WOUT = 13 * MiB;
constexpr size_t WS_WGU = 17 * MiB;
constexpr size_t WS_WD = 81 * MiB;
constexpr size_t WS_XN = 113 * MiB;
constexpr size_t WS_P = 145 * MiB;
constexpr size_t WS_Y = WS_P + 17 * MiB;
constexpr size_t WS_S = 276 * MiB;
constexpr size_t WS_XRES = 241 * MiB;
constexpr size_t WS_DEC = 273 * MiB;
constexpr size_t WS_MISC = 274 * MiB;
constexpr size_t WS_WSP = WS_MISC + 524288;
constexpr size_t WS_WR = 275 * MiB;
constexpr size_t WS_BLKCNT = WS_WR + 524288;
constexpr size_t WS_END = 284 * MiB;
constexpr int CW_BAR = 4096, CW_CNT = 16384;
constexpr int RING_BYTES = 131072, LDSCTL_OFF = RING_BYTES, MISC_OFF = LDSCTL_OFF + 320, LDS_BYTES = 163840;

#define GAS __attribute__((address_space(1)))
#define LAS __attribute__((address_space(3)))
typedef unsigned short bf16;
typedef unsigned v4u __attribute__((ext_vector_type(4)));
typedef unsigned v2u __attribute__((ext_vector_type(2)));
typedef float f32x4 __attribute__((ext_vector_type(4)));
typedef __bf16 bf16x2_t __attribute__((ext_vector_type(2)));
typedef float f32x2_t __attribute__((ext_vector_type(2)));
__device__ __forceinline__ unsigned f2bf(float f) { return (unsigned)__builtin_bit_cast(unsigned short, (__bf16)f); }
__device__ __forceinline__ unsigned pk2(float lo, float hi) { f32x2_t v = {lo, hi}; bf16x2_t b = __builtin_convertvector(v, bf16x2_t); return __builtin_bit_cast(unsigned, b); }
__device__ __forceinline__ float bf2f(unsigned v) { return __uint_as_float(v << 16); }
__device__ __forceinline__ float bflo(unsigned w) { return __uint_as_float(w << 16); }
__device__ __forceinline__ float bfhi(unsigned w) { return __uint_as_float(w & 0xffff0000u); }
__device__ __forceinline__ void unpack8(const v4u q, float (&f)[8]) { f[0] = bflo(q.x); f[1] = bfhi(q.x); f[2] = bflo(q.y); f[3] = bfhi(q.y); f[4] = bflo(q.z); f[5] = bfhi(q.z); f[6] = bflo(q.w); f[7] = bfhi(q.w); }
__device__ __forceinline__ float gelu_tanh(float x) { const float u = 0.7978845608028654f * (x + 0.044715f * x * x * x); return 0.5f * x * (1.0f + tanhf(u)); }
__device__ __forceinline__ float silu(float x) { return x / (1.0f + expf(-x)); }
__device__ __forceinline__ float log_sigmoid(float x) { return fminf(x, 0.f) - log1pf(expf(-fabsf(x))); }

#define XB_TMO      128
#define XB_XCNT(j)  (256  + 64 * (j))
#define XB_XSUB(j)  (1280 + 64 * (j))
#define XB_XGEN(j)  (2304 + 64 * (j))
#define XB_TOP      3328
#define XB_TOPGEN   3392
#define XCD_BAR_WORDS 3456
#define XB_SPIN_CAP (1u << 18)

__device__ __forceinline__ unsigned xb_ld(unsigned* p)              { return __hip_atomic_load(p, __ATOMIC_RELAXED, __HIP_MEMORY_SCOPE_AGENT); }
__device__ __forceinline__ unsigned xb_add(unsigned* p, unsigned v) { return __hip_atomic_fetch_add(p, v, __ATOMIC_RELAXED, __HIP_MEMORY_SCOPE_AGENT); }
__device__ __forceinline__ unsigned xb_xcc_id() { return (unsigned)__builtin_amdgcn_s_getreg((3 << 11) | 20) & 0xFu; }
#define XB_SPIN(cond, bar) do { unsigned _sp = 0; while (cond) { __builtin_amdgcn_s_sleep(1); \
    if ((++_sp & 255u) == 0u) { if (xb_ld(&(bar)[XB_TMO])) break; if (_sp > XB_SPIN_CAP) { atomicAdd(&(bar)[XB_TMO], 1u); break; } } } } while (0)

struct XcdBarrier {
    int wave;
    unsigned* bar; unsigned x;
    volatile LAS unsigned* st;
};

__device__ __forceinline__ XcdBarrier xcd_barrier_post(unsigned* bar, volatile LAS unsigned* st) {
    XcdBarrier b; b.bar = bar; b.x = xb_xcc_id(); b.st = st; b.wave = __builtin_amdgcn_readfirstlane(threadIdx.x >> 6);
    if (threadIdx.x == 0) (void)xb_add(&bar[XB_XCNT(b.x)], 1u);
    return b;
}
__device__ __forceinline__ void xcd_barrier_complete(unsigned* bar, unsigned x, unsigned& nloc, unsigned& nx) {
    const unsigned G = gridDim.x * gridDim.y * gridDim.z;
    unsigned sum, cnt, mine, sp = 0u;
    for (;;) {
        sum = 0u; cnt = 0u; mine = 0u;
#pragma unroll
        for (unsigned j = 0; j < 16; ++j) { const unsigned c = xb_ld(&bar[XB_XCNT(j)]); sum += c; cnt += (c > 0u) ? 1u : 0u; mine = (j == x) ? c : mine; }
        if (sum == G) break;
        __builtin_amdgcn_s_sleep(1);
        if ((++sp & 255u) == 0u) { if (xb_ld(&bar[XB_TMO])) break; if (sp > XB_SPIN_CAP) { atomicAdd(&bar[XB_TMO], 1u); break; } }
    }
    nloc = mine > 0u ? mine : 1u; nx = cnt > 0u ? cnt : 1u;
}

__device__ __forceinline__ void xcd_barrier(const XcdBarrier& b) {
    asm volatile("s_waitcnt vmcnt(0)" ::: "memory");
    __syncthreads();
    if (b.wave == 0 && fresh_lane() == 0) {
        unsigned* bar = b.bar; asm volatile("" : "+s"(bar));
        __builtin_amdgcn_s_waitcnt(0);
        unsigned nloc = b.st[0], nx = b.st[1];
        if (nloc == 0u) { xcd_barrier_complete(bar, b.x, nloc, nx); b.st[0] = nloc; b.st[1] = nx; }
        const unsigned old = xb_add(&bar[XB_XSUB(b.x)], 1u);
        const unsigned gen = old / nloc;
        if (old + 1u == (gen + 1u) * nloc) {
            __builtin_amdgcn_fence(__ATOMIC_RELEASE, "agent");
            asm volatile("s_waitcnt vmcnt(0)" ::: "memory");
            const unsigned og = xb_add(&bar[XB_TOP], 1u);
            const unsigned tg = og / nx;
            if (og + 1u == (tg + 1u) * nx) xb_add(&bar[XB_TOPGEN], 1u);
            else XB_SPIN(xb_ld(&bar[XB_TOPGEN]) == tg, bar);
            __builtin_amdgcn_fence(__ATOMIC_ACQUIRE, "agent");
            xb_add(&bar[XB_XGEN(b.x)], 1u);
            asm volatile("s_waitcnt vmcnt(0)" ::: "memory");
        } else {
            XB_SPIN(xb_ld(&bar[XB_XGEN(b.x)]) == gen, bar);
            __builtin_amdgcn_fence(__ATOMIC_ACQUIRE, "agent");
            asm volatile("s_waitcnt vmcnt(0)" ::: "memory");
        }
    }
    __syncthreads();
}

#define AS4 __attribute__((address_space(4)))
struct KA {
    const AS4 char* ka;
    static __device__ __forceinline__ KA fresh() { KA k; k.ka = (const AS4 char*)__builtin_amdgcn_kernarg_segment_ptr(); asm volatile("" : "+s"(k.ka)); return k; }
    __device__ __forceinline__ const float* in(int i) const { return *(const float* const AS4*)(ka + 8 * i); }
    __device__ __forceinline__ float* out() const { return *(float* const AS4*)(ka + 160); }
    __device__ __forceinline__ unsigned char* ws() const { return *(unsigned char* const AS4*)(ka + 168); }
    __device__ __forceinline__ unsigned* ctl() const { return (unsigned*)(ws() + WS_CTL); }
    __device__ __forceinline__ bf16* WinT() const { return (bf16*)(ws() + WS_WIN); }
    __device__ __forceinline__ bf16* WoutT() const { return (bf16*)(ws() + WS_WOUT); }
    __device__ __forceinline__ bf16* WguT() const { return (bf16*)(ws() + WS_WGU); }
    __device__ __forceinline__ bf16* WdT() const { return (bf16*)(ws() + WS_WD); }
    __device__ __forceinline__ bf16* XN() const { return (bf16*)(ws() + WS_XN); }
    __device__ __forceinline__ bf16* P() const { return (bf16*)(ws() + WS_P); }
    __device__ __forceinline__ bf16* H1() const { return (bf16*)(ws() + WS_P); }
    __device__ __forceinline__ bf16* Y() const { return (bf16*)(ws() + WS_Y); }
    __device__ __forceinline__ float* Sst() const { return (float*)(ws() + WS_S); }
    __device__ __forceinline__ float* dec() const { return (float*)(ws() + WS_DEC); }
    __device__ __forceinline__ int* eid() const { return (int*)(ws() + WS_MISC); }
    __device__ __forceinline__ float* ew() const { return (float*)(ws() + WS_MISC + 131072); }
    __device__ __forceinline__ int* slot_tok() const { return (int*)(ws() + WS_MISC + 2 * 131072); }
    __device__ __forceinline__ int* slot_of() const { return (int*)(ws() + WS_MISC + 3 * 131072); }
    __device__ __forceinline__ bf16* Wsp() const { return (bf16*)(ws() + WS_WSP); }
    __device__ __forceinline__ bf16* Wr() const { return (bf16*)(ws() + WS_WR); }
    __device__ __forceinline__ bf16* XR() const { return (bf16*)(ws() + WS_XRES); }
    __device__ __forceinline__ int* blkcnt() const { return (int*)(ws() + WS_BLKCNT); }
};
struct Frame {
    LAS unsigned char* lds; float* smem;
    int G, bx, wave;
};
#define PHASE_TID const int lane = fresh_lane(), wave = F.wave, tid = wave * 64 + lane; (void)lane; (void)wave; (void)tid

__device__ __forceinline__ float wave_sum(float v) {
    v = sum16(v);
    const int iv = __float_as_int(v);
    return (__int_as_float(__builtin_amdgcn_readlane(iv, 0)) + __int_as_float(__builtin_amdgcn_readlane(iv, 16))) + (__int_as_float(__builtin_amdgcn_readlane(iv, 32)) + __int_as_float(__builtin_amdgcn_readlane(iv, 48)));
}

struct TrItem { const float* W; bf16* WT; int ldw, nvalid, k0, n0, ldt, drow0; };
__device__ __forceinline__ void transpose_load(const TrItem& t, int lane, f32x4 (&v)[8]) {
    const int sub = lane >> 3, c4 = (lane & 7) * 4;
#pragma unroll
    for (int i = 0; i < 8; ++i) v[i] = (c4 < t.nvalid) ? __builtin_nontemporal_load((const f32x4*)(t.W + (size_t)(t.k0 + 8 * i + sub) * t.ldw + t.n0 + c4)) : (f32x4){0.f, 0.f, 0.f, 0.f};
}
__device__ __forceinline__ void transpose_store(const TrItem& t, int lane, const f32x4 (&v)[8], LAS float* scr) {
    const int sub = lane >> 3, c4 = (lane & 7) * 4;
#pragma unroll
    for (int i = 0; i < 8; ++i) { LAS float* d = scr + (8 * i + sub) * 33 + c4; d[0] = v[i].x; d[1] = v[i].y; d[2] = v[i].z; d[3] = v[i].w; }
    asm volatile("s_waitcnt lgkmcnt(0)" ::: "memory");
    const int c = lane & 7;
#pragma unroll
    for (int j = 0; j < 4; ++j) { const int n = (lane >> 3) + 8 * j; const LAS float* s = scr + (8 * c) * 33 + n;
        v4u o; o.x = pk2(s[0 * 33], s[1 * 33]); o.y = pk2(s[2 * 33], s[3 * 33]); o.z = pk2(s[4 * 33], s[5 * 33]); o.w = pk2(s[6 * 33], s[7 * 33]);
        if (n < t.nvalid) *(GAS v4u*)(t.WT + (size_t)(t.drow0 + n) * t.ldt + t.k0 + 8 * c) = o; }
    asm volatile("s_waitcnt lgkmcnt(0)" ::: "memory");
}
__device__ __forceinline__ void rms_row_to_bf16(const float* xrow, const float* gain, bf16* orow, int lane) {
    const f32x4* xr = (const f32x4*)xrow + lane;
    f32x4 v[4]; float s = 0.f;
#pragma unroll
    for (int j = 0; j < 4; ++j) { v[j] = xr[64 * j]; s += (v[j].x * v[j].x + v[j].y * v[j].y) + (v[j].z * v[j].z + v[j].w * v[j].w); }
    const float rs = rsqrtf(wave_sum(s) * (1.f / D) + EPS);
    v2u* o8 = (v2u*)orow + lane;
#pragma unroll
    for (int j = 0; j < 4; ++j) { const f32x4 g = ((const f32x4*)gain)[lane + 64 * j]; v2u w; w.x = pk2(v[j].x * rs * g.x, v[j].y * rs * g.y); w.y = pk2(v[j].z * rs * g.z, v[j].w * rs * g.w); o8[64 * j] = w; }
}
__device__ __forceinline__ void p0_prologue(Frame& F) {
    const KA K = KA::fresh(); PHASE_TID;
    LAS float* scr = (LAS float*)(F.lds + wave * 16384);
    const int gw = F.bx * NWAVES + wave, NGW = F.G * NWAVES;
    constexpr int I_IN = 16 * 89, I_OUT = 16 * 32, I_G = 32 * 16 * 8, I_D = 32 * 4 * 32, I_L = I_IN + I_OUT + 2 * I_G + I_D;
#define TR_DECODE(it_, t_) do { const int l_ = (it_) / I_L; int r_ = (it_) % I_L; \
        if (r_ < I_IN) { const int kb = r_ / 89, nb = r_ % 89; t_ = TrItem{K.in(2) + (size_t)l_ * D * DIN, K.WinT() + (size_t)l_ * PLD * D, DIN, (nb == 88) ? 16 : 32, kb * 64, nb * 32, D, nb * 32}; } \
        else if (r_ < I_IN + I_OUT) { r_ -= I_IN; const int kb = r_ / 32, nb = r_ % 32; t_ = TrItem{K.in(10) + (size_t)l_ * D * D, K.WoutT() + (size_t)l_ * D * D, D, 32, kb * 64, nb * 32, D, nb * 32}; } \
        else if (r_ < I_IN + I_OUT + 2 * I_G) { r_ -= I_IN + I_OUT; const int sel = r_ / I_G; r_ %= I_G; const int e = r_ / 128, kb = (r_ % 128) / 8, n0 = (r_ % 8) * 32; \
            t_ = TrItem{K.in(16 + sel) + ((size_t)l_ * NE + e) * D * DE, K.WguT() + ((size_t)l_ * NE + e) * 512 * D, DE, 32, kb * 64, n0, D, (n0 >> 7) * 256 + sel * 128 + (n0 & 127)}; } \
        else { r_ -= I_IN + I_OUT + 2 * I_G; const int e = r_ / 128, kb = (r_ % 128) / 32, nb = r_ % 32; t_ = TrItem{K.in(18) + ((size_t)l_ * NE + e) * DE * D, K.WdT() + ((size_t)l_ * NE + e) * D * DE, D, 32, kb * 64, nb * 32, DE, nb * 32}; } } while (0)
    {
        TrItem cur, nxt; f32x4 vc[8], vn[8];
        int it = gw;
        if (it < DEPTH * I_L) { TR_DECODE(it, cur); transpose_load(cur, lane, vc); }
#pragma unroll 1
        for (; it < DEPTH * I_L; it += NGW) {
            const bool more = it + NGW < DEPTH * I_L;
            if (more) { TR_DECODE(it + NGW, nxt); transpose_load(nxt, lane, vn); }
            transpose_store(cur, lane, vc, scr);
            cur = nxt;
#pragma unroll
            for (int i = 0; i < 8; ++i) vc[i] = vn[i];
        }
    }
#undef TR_DECODE
    for (int i = F.bx * NT + tid; i < DEPTH * 240 * 128; i += F.G * NT) { const int l = i / (240 * 128), rr = (i / 128) % 240, c = i % 128;
        *(GAS v4u*)(K.WinT() + ((size_t)l * PLD + DIN + rr) * D + c * 8) = (v4u){0u, 0u, 0u, 0u}; }
    for (int i = F.bx * NT + tid; i < DEPTH * 48 * D; i += F.G * NT) { const int ll = i / (48 * D), n = (i / D) % 48, k = i % D;
        float w = 0.f;
        if (n < 4) w = K.in(12)[((size_t)ll * D + k) * 4 + n]; else if (n < 36) w = K.in(14)[((size_t)ll * D + k) * 32 + (n - 4)];
        w *= K.in(11)[(size_t)ll * D + k];
        const unsigned hi = f2bf(w), lo = f2bf(w - bf2f(hi));
        K.Wr()[((size_t)ll * 2 + 0) * 48 * D + (size_t)n * D + k] = (bf16)hi; K.Wr()[((size_t)ll * 2 + 1) * 48 * D + (size_t)n * D + k] = (bf16)lo; }
    for (int i = F.bx * NT + tid; i < DEPTH * MH * 128 * 128 / 8; i += F.G * NT) { const int e0 = i * 8, s0 = e0 & 127, t = (e0 >> 7) & 127;
        const f32x4 a = *(const f32x4*)(K.in(7) + e0), c = *(const f32x4*)(K.in(7) + e0 + 4);
        const float v[8] = {a.x, a.y, a.z, a.w, c.x, c.y, c.z, c.w}; unsigned w[4];
#pragma unroll
        for (int j = 0; j < 4; ++j) w[j] = pk2((s0 + 2 * j <= t) ? v[2 * j] : 0.f, (s0 + 2 * j + 1 <= t) ? v[2 * j + 1] : 0.f);
        *(GAS v4u*)(K.Wsp() + e0) = (v4u){w[0], w[1], w[2], w[3]}; }
    for (int m = gw; m < T; m += NGW) rms_row_to_bf16(K.in(0) + (size_t)m * D, K.in(1), K.XN() + (size_t)m * D, lane);
}

__device__ __forceinline__ void gla_cumdecay(Frame& F, const KA& K, int tid, int l, int h, int t0, float* bb) {
    const float* wup = K.in(3) + (size_t)l * 16 * 256; const float* bgk = K.in(4) + (size_t)l * 256;
    for (int e = tid; e < 64 * 64; e += NT) {
        const int c = e >> 6, d = e & 63;
        const bf16* gl = K.P() + (size_t)(t0 + c) * PLD + C_GK;
        float a = bgk[h * 64 + d];
#pragma unroll
        for (int r = 0; r < 16; ++r) a += bf2f(gl[r]) * wup[r * 256 + h * 64 + d];
        bb[c * 64 + d] = log_sigmoid(a) * (1.0f / 16.0f);
    }
    __syncthreads();
    if (tid < 64) { float run = 0.f; for (int c = 0; c < 64; ++c) { run += bb[c * 64 + tid]; bb[c * 64 + tid] = run; } }
    __syncthreads();
}
__device__ __forceinline__ void phase_gla_kv(Frame& F, int l) {
    const KA K = KA::fresh(); PHASE_TID;
    float* bb = F.smem; float* kd = F.smem + 4096;
#pragma unroll 1
    for (int ci = F.bx; ci < NB * GH * GN; ci += F.G) {
        const int b = ci / (GH * GN), h = (ci / GN) % GH, n = ci % GN, t0 = b * S + n * GC;
        __syncthreads();
        gla_cumdecay(F, K, tid, l, h, t0, bb);
        for (int e = tid; e < 4096; e += NT) { const int c = e >> 6, d = e & 63; kd[e] = bf2f(K.P()[(size_t)(t0 + c) * PLD + C_K + h * 64 + d]) * expf(bb[63 * 64 + d] - bb[e]); }
        __syncthreads();
        const int d = tid >> 3, v0 = (tid & 7) * 16;
        float acc[16];
#pragma unroll
        for (int j = 0; j < 16; ++j) acc[j] = 0.f;
#pragma unroll 2
        for (int c = 0; c < 64; ++c) {
            const float kk = kd[c * 64 + d];
            const v4u* vr = (const v4u*)(K.P() + (size_t)(t0 + c) * PLD + C_V + h * 128 + v0);
            float f[8]; unpack8(vr[0], f);
#pragma unroll
            for (int j = 0; j < 8; ++j) acc[j] += kk * f[j];
            unpack8(vr[1], f);
#pragma unroll
            for (int j = 0; j < 8; ++j) acc[8 + j] += kk * f[j];
        }
        f32x4* o = (f32x4*)(K.Sst() + ((size_t)ci * 64 + d) * 128 + v0);
#pragma unroll
        for (int j = 0; j < 4; ++j) o[j] = (f32x4){acc[4 * j], acc[4 * j + 1], acc[4 * j + 2], acc[4 * j + 3]};
        if (tid < 64) K.dec()[(size_t)ci * 64 + tid] = expf(bb[63 * 64 + tid]);
    }
}
__device__ __forceinline__ void phase_gla_scan(Frame& F) {
    const KA K = KA::fresh(); PHASE_TID;
#pragma unroll 1
    for (int e = F.bx * NT + tid; e < NB * GH * 64 * 128; e += F.G * NT) {
        const int bh = e >> 13, d = (e >> 7) & 63, v = e & 127;
        float* base = K.Sst() + ((size_t)bh * GN * 64 + d) * 128 + v; const float* db = K.dec() + (size_t)bh * GN * 64 + d;
        float st = 0.f;
#pragma unroll 1
        for (int n0 = 0; n0 < GN; n0 += 16) {
            float kvv[16], dd[16];
#pragma unroll
            for (int j = 0; j < 16; ++j) { kvv[j] = base[(size_t)(n0 + j) * 8192]; dd[j] = db[(n0 + j) * 64]; }
#pragma unroll
            for (int j = 0; j < 16; ++j) { base[(size_t)(n0 + j) * 8192] = st; st = dd[j] * st + kvv[j]; }
        }
    }
}
__device__ __forceinline__ void phase_gla_out(Frame& F, int l) {
    const KA K = KA::fresh(); PHASE_TID;
    float* bb = F.smem; float* qd = F.smem + 4096; float* ki = F.smem + 4096 + 64 * 65; float* sc = bb;
    const float* gnorm = K.in(5) + (size_t)l * 128;
#pragma unroll 1
    for (int ci = F.bx; ci < NB * GH * GN; ci += F.G) {
        const int b = ci / (GH * GN), h = (ci / GN) % GH, n = ci % GN, t0 = b * S + n * GC;
        __syncthreads();
        gla_cumdecay(F, K, tid, l, h, t0, bb);
        for (int e = tid; e < 4096; e += NT) {
            const int c = e >> 6, d = e & 63; const float bv = bb[e];
            const bf16* row = K.P() + (size_t)(t0 + c) * PLD;
            qd[c * 65 + d] = bf2f(row[C_Q + h * 64 + d]) * 0.125f * expf(bv);
            ki[c * 65 + d] = bf2f(row[C_K + h * 64 + d]) * expf(-bv);
        }
        __syncthreads();
        {
            const int c = tid >> 3, s0 = (tid & 7) * 8;
            float a[8];
#pragma unroll
            for (int j = 0; j < 8; ++j) a[j] = 0.f;
#pragma unroll 4
            for (int d = 0; d < 64; ++d) { const float qv = qd[c * 65 + d];
#pragma unroll
                for (int j = 0; j < 8; ++j) a[j] += qv * ki[(s0 + j) * 65 + d]; }
#pragma unroll
            for (int j = 0; j < 8; ++j) sc[c * 64 + s0 + j] = (s0 + j <= c) ? a[j] : 0.f;
        }
        __syncthreads();
        const int c = tid >> 3, v0 = (tid & 7) * 16;
        float acc[16];
#pragma unroll
        for (int j = 0; j < 16; ++j) acc[j] = 0.f;
#pragma unroll 2
        for (int s = 0; s <= c; ++s) {
            const float w = sc[c * 64 + s];
            const v4u* vr = (const v4u*)(K.P() + (size_t)(t0 + s) * PLD + C_V + h * 128 + v0);
            float f[8]; unpack8(vr[0], f);
#pragma unroll
            for (int j = 0; j < 8; ++j) acc[j] += w * f[j];
            unpack8(vr[1], f);
#pragma unroll
            for (int j = 0; j < 8; ++j) acc[8 + j] += w * f[j];
        }
#pragma unroll 2
        for (int d = 0; d < 64; ++d) {
            const float w = qd[c * 65 + d];
            const f32x4* sr = (const f32x4*)(K.Sst() + ((size_t)ci * 64 + d) * 128 + v0);
#pragma unroll
            for (int j = 0; j < 4; ++j) { const f32x4 v4 = sr[j]; acc[4 * j] += w * v4.x; acc[4 * j + 1] += w * v4.y; acc[4 * j + 2] += w * v4.z; acc[4 * j + 3] += w * v4.w; }
        }
        float ss = 0.f;
#pragma unroll
        for (int j = 0; j < 16; ++j) ss += acc[j] * acc[j];
        ss = sum8(ss);
        const float rs = rsqrtf(ss * (1.0f / 128.0f) + EPS);
        const v4u* gr = (const v4u*)(K.P() + (size_t)(t0 + c) * PLD + C_G + h * 128 + v0);
        float g0[8], g1[8]; unpack8(gr[0], g0); unpack8(gr[1], g1);
        float o[16];
#pragma unroll
        for (int j = 0; j < 8; ++j) { o[j] = acc[j] * rs * gnorm[v0 + j] * silu(g0[j]); o[8 + j] = acc[8 + j] * rs * gnorm[v0 + 8 + j] * silu(g1[j]); }
        v4u* op = (v4u*)(K.XN() + (size_t)(t0 + c) * D + h * 128 + v0);
        op[0] = (v4u){pk2(o[0], o[1]), pk2(o[2], o[3]), pk2(o[4], o[5]), pk2(o[6], o[7])};
        op[1] = (v4u){pk2(o[8], o[9]), pk2(o[10], o[11]), pk2(o[12], o[13]), pk2(o[14], o[15])};
    }
}
__device__ __forceinline__ void phase_gmlp(Frame& F, int l) {
    const KA K = KA::fresh(); PHASE_TID;
    float* vs = F.smem;
    const float* gn = K.in(6) + (size_t)l * 256; const float* wsp = K.in(7) + (size_t)l * MH * 128 * 128; const float* bsp = K.in(8) + (size_t)l * MH * 128;
#pragma unroll 1
    for (int u = F.bx; u < NB * MN * MH; u += F.G) {
        const int b = u / (MN * MH), n = (u / MH) % MN, h = u % MH, t0 = b * S + n * MC;
        __syncthreads();
        const int s = tid >> 2, d0 = (tid & 3) * 16;
        {
            const v4u* vr = (const v4u*)(K.P() + (size_t)(t0 + s) * PLD + C_VG + h * 64 + d0);
            float g[16]; { float f[8]; unpack8(vr[0], f);
#pragma unroll
                for (int j = 0; j < 8; ++j) g[j] = gelu_tanh(f[j]);
                unpack8(vr[1], f);
#pragma unroll
                for (int j = 0; j < 8; ++j) g[8 + j] = gelu_tanh(f[j]); }
            float ss = 0.f;
#pragma unroll
            for (int j = 0; j < 16; ++j) ss += g[j] * g[j];
            ss += shx(ss, 1); ss += shx(ss, 2);
            const float rs = rsqrtf(ss * (1.0f / 64.0f) + EPS);
#pragma unroll
            for (int j = 0; j < 16; ++j) vs[s * 64 + d0 + j] = g[j] * rs * gn[h * 64 + d0 + j];
        }
        __syncthreads();
        const int t = s;
        float acc[16];
#pragma unroll
        for (int j = 0; j < 16; ++j) acc[j] = 0.f;
        const float* wr = wsp + ((size_t)h * 128 + t) * 128;
#pragma unroll 2
        for (int s2 = 0; s2 <= t; ++s2) { const float w = wr[s2];
#pragma unroll
            for (int j = 0; j < 16; ++j) acc[j] += w * vs[s2 * 64 + d0 + j]; }
        const float bias = bsp[h * 128 + t];
        const v4u* ur = (const v4u*)(K.P() + (size_t)(t0 + t) * PLD + C_U + h * 64 + d0);
        float u0[8], u1[8]; unpack8(ur[0], u0); unpack8(ur[1], u1);
        float o[16];
#pragma unroll
        for (int j = 0; j < 8; ++j) { o[j] = gelu_tanh(u0[j]) * (acc[j] + bias); o[8 + j] = gelu_tanh(u1[j]) * (acc[8 + j] + bias); }
        v4u* op = (v4u*)(K.XN() + (size_t)(t0 + t) * D + 512 + h * 64 + d0);
        op[0] = (v4u){pk2(o[0], o[1]), pk2(o[2], o[3]), pk2(o[4], o[5]), pk2(o[6], o[7])};
        op[1] = (v4u){pk2(o[8], o[9]), pk2(o[10], o[11]), pk2(o[12], o[13]), pk2(o[14], o[15])};
    }
}
typedef short bf16x8 __attribute__((ext_vector_type(8)));
__device__ __forceinline__ float fexp(float x) { return __builtin_amdgcn_exp2f(x * 1.4426950408889634f); }
__device__ __forceinline__ float logsig_fast(float x) { return fminf(x, 0.f) - __log2f(1.0f + fexp(-fabsf(x))) * 0.6931471805599453f; }
__device__ __forceinline__ float silu_fast(float x) { return x * __builtin_amdgcn_rcpf(1.0f + __builtin_amdgcn_exp2f(-1.4426950408889634f * x)); }
__device__ __forceinline__ float gelu_fast(float x) { const float u = 0.7978845608028654f * (x + 0.044715f * x * x * x); return x * __builtin_amdgcn_rcpf(1.0f + __builtin_amdgcn_exp2f(-2.8853900817779268f * u)); }
__device__ __forceinline__ f32x4 mfma16(bf16x8 a, bf16x8 b, f32x4 c) { return __builtin_amdgcn_mfma_f32_16x16x32_bf16(a, b, c, 0, 0, 0); }
constexpr int LROWB = 144;
constexpr int L_QD = 0, L_KI = 9216, L_KDT = 18432, L_VT = 27648, L_S = 46080, L_ST = 55296, L_OB = 73728, L_TOT = 107520, OBROW = 528;
#define FRAG(base, row, kel) (*(const LAS bf16x8*)(lds + (base) + (row) * LROWB + (kel) * 2))

__device__ __forceinline__ float gla_b8(const KA& K, LAS unsigned char* lds, int l, int h, int t0, int lane, int wave, float (&bv)[8]) {
    const float* wup = K.in(3) + (size_t)l * 16 * 256 + h * 64 + lane;
    float wu[16];
#pragma unroll
    for (int r = 0; r < 16; ++r) wu[r] = wup[r * 256];
    const float bg = K.in(4)[l * 256 + h * 64 + lane];
    const bf16* P = K.P();
    float run = 0.f;
#pragma unroll
    for (int j = 0; j < 8; ++j) {
        const bf16* gl = P + (size_t)(t0 + 8 * wave + j) * PLD + C_GK;
        float f0[8], f1[8]; unpack8(*(const v4u*)gl, f0); unpack8(*(const v4u*)(gl + 8), f1);
        float a = bg;
#pragma unroll
        for (int r = 0; r < 8; ++r) a += f0[r] * wu[r];
#pragma unroll
        for (int r = 0; r < 8; ++r) a += f1[r] * wu[8 + r];
        run += logsig_fast(a) * (1.0f / 16.0f); bv[j] = run;
    }
    LAS float* tot = (LAS float*)(lds + L_TOT);
    tot[wave * 64 + lane] = run;
    __syncthreads();
    float base = 0.f, all = 0.f;
#pragma unroll
    for (int g = 0; g < 8; ++g) { const float tv = tot[g * 64 + lane]; all += tv; if (g < wave) base += tv; }
#pragma unroll
    for (int j = 0; j < 8; ++j) bv[j] += base;
    return all;
}
__device__ __forceinline__ void gla_stage_vT(const bf16* P, LAS unsigned char* lds, int h, int t0, int tid) {
    const int vv = tid & 127, cq = tid >> 7;
    const bf16* vp = P + (size_t)(t0 + 16 * cq) * PLD + C_V + h * 128 + vv;
    unsigned w[8];
#pragma unroll
    for (int j = 0; j < 8; ++j) w[j] = (unsigned)vp[(size_t)(2 * j) * PLD] | ((unsigned)vp[(size_t)(2 * j + 1) * PLD] << 16);
    LAS v4u* dst = (LAS v4u*)(lds + L_VT + vv * LROWB + cq * 32);
    dst[0] = (v4u){w[0], w[1], w[2], w[3]}; dst[1] = (v4u){w[4], w[5], w[6], w[7]};
}

__device__ __forceinline__ void phase_gla_kv_mfma(Frame& F, int l) {
    const KA K = KA::fresh(); PHASE_TID;
    LAS unsigned char* lds = F.lds;
    const int fr = lane & 15, fq = lane >> 4;
#pragma unroll 1
    for (int ci = F.bx; ci < NB * GH * GN; ci += F.G) {
        const int b = ci / (GH * GN), h = (ci / GN) % GH, n = ci % GN, t0 = b * S + n * GC;
        const bf16* P = K.P();
        __syncthreads();
        float bv[8]; const float bl = gla_b8(K, lds, l, h, t0, lane, wave, bv);
        {
            const bf16* kp = P + (size_t)(t0 + 8 * wave) * PLD + C_K + h * 64 + lane;
            float kd[8];
#pragma unroll
            for (int j = 0; j < 8; ++j) kd[j] = bf2f(kp[(size_t)j * PLD]) * fexp(bl - bv[j]);
            *(LAS v4u*)(lds + L_KDT + lane * LROWB + wave * 16) = (v4u){pk2(kd[0], kd[1]), pk2(kd[2], kd[3]), pk2(kd[4], kd[5]), pk2(kd[6], kd[7])};
        }
        gla_stage_vT(P, lds, h, t0, tid);
        if (wave == 0) K.dec()[(size_t)ci * 64 + lane] = fexp(bl);
        __syncthreads();
        bf16x8 Bf[2];
#pragma unroll
        for (int ks = 0; ks < 2; ++ks) Bf[ks] = FRAG(L_VT, 16 * wave + fr, 32 * ks + 8 * fq);
        float* so = K.Sst() + (size_t)ci * 64 * 128 + 16 * wave + fr;
#pragma unroll
        for (int dt = 0; dt < 4; ++dt) {
            f32x4 acc = (f32x4){0.f, 0.f, 0.f, 0.f};
#pragma unroll
            for (int ks = 0; ks < 2; ++ks) acc = mfma16(FRAG(L_KDT, 16 * dt + fr, 32 * ks + 8 * fq), Bf[ks], acc);
#pragma unroll
            for (int r = 0; r < 4; ++r) so[(size_t)(16 * dt + 4 * fq + r) * 128] = acc[r];
        }
    }
}

__device__ __forceinline__ void phase_gla_out_mfma(Frame& F, int l) {
    const KA K = KA::fresh(); PHASE_TID;
    LAS unsigned char* lds = F.lds;
    const int fr = lane & 15, fq = lane >> 4;
    const float* gnorm = K.in(5) + (size_t)l * 128;
#pragma unroll 1
    for (int ci = F.bx; ci < NB * GH * GN; ci += F.G) {
        const int b = ci / (GH * GN), h = (ci / GN) % GH, n = ci % GN, t0 = b * S + n * GC;
        const bf16* P = K.P();
        __syncthreads();
        float bv[8]; (void)gla_b8(K, lds, l, h, t0, lane, wave, bv);
        {
            const bf16* qp = P + (size_t)(t0 + 8 * wave) * PLD + C_Q + h * 64 + lane;
            const bf16* kp = qp + (C_K - C_Q);
#pragma unroll
            for (int j = 0; j < 8; ++j) {
                const float e = fexp(bv[j]);
                const float qv = bf2f(qp[(size_t)j * PLD]) * 0.125f * e, kv = bf2f(kp[(size_t)j * PLD]) * __builtin_amdgcn_rcpf(e);
                *(LAS bf16*)(lds + L_QD + (8 * wave + j) * LROWB + lane * 2) = (bf16)f2bf(qv);
                *(LAS bf16*)(lds + L_KI + (8 * wave + j) * LROWB + lane * 2) = (bf16)f2bf(kv);
            }
        }
        gla_stage_vT(P, lds, h, t0, tid);
        {
            const int vv = tid & 127, dq = tid >> 7;
            const float* sp = K.Sst() + ((size_t)ci * 64 + 16 * dq) * 128 + vv;
            unsigned w[8];
#pragma unroll
            for (int j = 0; j < 8; ++j) w[j] = pk2(sp[(size_t)(2 * j) * 128], sp[(size_t)(2 * j + 1) * 128]);
            LAS v4u* dst = (LAS v4u*)(lds + L_ST + vv * LROWB + dq * 32);
            dst[0] = (v4u){w[0], w[1], w[2], w[3]}; dst[1] = (v4u){w[4], w[5], w[6], w[7]};
        }
        __syncthreads();
#pragma unroll
        for (int i = 0; i < 2; ++i) {
            const int tix = 2 * wave + i, st = tix >> 2, ct = tix & 3;
            f32x4 acc = (f32x4){0.f, 0.f, 0.f, 0.f};
#pragma unroll
            for (int ks = 0; ks < 2; ++ks) acc = mfma16(FRAG(L_KI, 16 * st + fr, 32 * ks + 8 * fq), FRAG(L_QD, 16 * ct + fr, 32 * ks + 8 * fq), acc);
            const int s0 = 16 * st + 4 * fq, c = 16 * ct + fr;
            float m[4];
#pragma unroll
            for (int r = 0; r < 4; ++r) m[r] = (s0 + r <= c) ? acc[r] : 0.f;
            *(LAS v2u*)(lds + L_S + c * LROWB + s0 * 2) = (v2u){pk2(m[0], m[1]), pk2(m[2], m[3])};
        }
        __syncthreads();
        {
            bf16x8 Av[2], As[2];
#pragma unroll
            for (int ks = 0; ks < 2; ++ks) { Av[ks] = FRAG(L_VT, 16 * wave + fr, 32 * ks + 8 * fq); As[ks] = FRAG(L_ST, 16 * wave + fr, 32 * ks + 8 * fq); }
#pragma unroll
            for (int ct = 0; ct < 4; ++ct) {
                f32x4 acc = (f32x4){0.f, 0.f, 0.f, 0.f};
#pragma unroll
                for (int ks = 0; ks < 2; ++ks) { acc = mfma16(Av[ks], FRAG(L_S, 16 * ct + fr, 32 * ks + 8 * fq), acc); acc = mfma16(As[ks], FRAG(L_QD, 16 * ct + fr, 32 * ks + 8 * fq), acc); }
                *(LAS f32x4*)(lds + L_OB + (16 * ct + fr) * OBROW + (16 * wave + 4 * fq) * 4) = acc;
            }
        }
        __syncthreads();
        {
            const int c = tid >> 3, vg = tid & 7;
            const LAS f32x4* ob = (const LAS f32x4*)(lds + L_OB + c * OBROW + vg * 64);
            f32x4 o[4]; float ss = 0.f;
#pragma unroll
            for (int j = 0; j < 4; ++j) { o[j] = ob[j]; ss += (o[j].x * o[j].x + o[j].y * o[j].y) + (o[j].z * o[j].z + o[j].w * o[j].w); }
            ss = sum8(ss);
            const float rs = rsqrtf(ss * (1.0f / 128.0f) + EPS);
            const v4u* gr = (const v4u*)(P + (size_t)(t0 + c) * PLD + C_G + h * 128 + 16 * vg);
            float g0[8], g1[8]; unpack8(gr[0], g0); unpack8(gr[1], g1);
            const f32x4* gn = (const f32x4*)(gnorm + 16 * vg);
            const f32x4 n0 = gn[0], n1 = gn[1], n2 = gn[2], n3 = gn[3];
            v4u w0, w1;
            w0.x = pk2(o[0].x * rs * n0.x * silu_fast(g0[0]), o[0].y * rs * n0.y * silu_fast(g0[1])); w0.y = pk2(o[0].z * rs * n0.z * silu_fast(g0[2]), o[0].w * rs * n0.w * silu_fast(g0[3]));
            w0.z = pk2(o[1].x * rs * n1.x * silu_fast(g0[4]), o[1].y * rs * n1.y * silu_fast(g0[5])); w0.w = pk2(o[1].z * rs * n1.z * silu_fast(g0[6]), o[1].w * rs * n1.w * silu_fast(g0[7]));
            w1.x = pk2(o[2].x * rs * n2.x * silu_fast(g1[0]), o[2].y * rs * n2.y * silu_fast(g1[1])); w1.y = pk2(o[2].z * rs * n2.z * silu_fast(g1[2]), o[2].w * rs * n2.w * silu_fast(g1[3]));
            w1.z = pk2(o[3].x * rs * n3.x * silu_fast(g1[4]), o[3].y * rs * n3.y * silu_fast(g1[5])); w1.w = pk2(o[3].z * rs * n3.z * silu_fast(g1[6]), o[3].w * rs * n3.w * silu_fast(g1[7]));
            v4u* op = (v4u*)(K.XN() + (size_t)(t0 + c) * D + h * 128 + 16 * vg);
            op[0] = w0; op[1] = w1;
        }
    }
}
#undef FRAG


constexpr int L_GKL = 109568, L_BL = 117760, SCN = 4, NSC = GN / SCN, NITEM = NB * GH * NSC;
#define FRAG(base, row, kel) (*(const LAS bf16x8*)(lds + (base) + (row) * LROWB + (kel) * 2))
struct GlaPre { unsigned short k[8], q[8], v[16]; v4u g0, g1; };
template <bool WITH_Q>
__device__ __forceinline__ void gla_prefetch(GlaPre& p, const bf16* P, int h, int t0, int tid, int lane, int wave) {
    const bf16* kp = P + (size_t)(t0 + 8 * wave) * PLD + C_K + h * 64 + lane;
#pragma unroll
    for (int j = 0; j < 8; ++j) p.k[j] = kp[(size_t)j * PLD];
    const int vv = tid & 127, cq = tid >> 7;
    const bf16* vp = P + (size_t)(t0 + 16 * cq) * PLD + C_V + h * 128 + vv;
#pragma unroll
    for (int j = 0; j < 16; ++j) p.v[j] = vp[(size_t)j * PLD];
    if (WITH_Q) {
        const bf16* qp = kp + (C_Q - C_K);
#pragma unroll
        for (int j = 0; j < 8; ++j) p.q[j] = qp[(size_t)j * PLD];
        const v4u* gr = (const v4u*)(P + (size_t)(t0 + (tid >> 3)) * PLD + C_G + h * 128 + 16 * (tid & 7));
        p.g0 = gr[0]; p.g1 = gr[1];
    }
}
__device__ __forceinline__ void gla_stage_gkl(const bf16* P, LAS unsigned char* lds, int tok0, int tid) {
    *(LAS v4u*)(lds + L_GKL + tid * 16) = *(const v4u*)(P + (size_t)(tok0 + (tid >> 1)) * PLD + C_GK + 8 * (tid & 1));
}
__device__ __forceinline__ void gla_b8_part(LAS unsigned char* lds, const float (&wu)[16], float bg, int n, int lane, int wave, float (&bv)[8]) {
    float run = 0.f;
#pragma unroll
    for (int j = 0; j < 8; ++j) {
        const LAS v4u* gl = (const LAS v4u*)(lds + L_GKL + (n * 64 + 8 * wave + j) * 32);
        float f0[8], f1[8]; unpack8(gl[0], f0); unpack8(gl[1], f1);
        float a = bg;
#pragma unroll
        for (int r = 0; r < 8; ++r) a += f0[r] * wu[r];
#pragma unroll
        for (int r = 0; r < 8; ++r) a += f1[r] * wu[8 + r];
        run += logsig_fast(a) * (1.0f / 16.0f); bv[j] = run;
    }
    ((LAS float*)(lds + L_TOT))[wave * 64 + lane] = run;
}
__device__ __forceinline__ float gla_b8_finish(LAS unsigned char* lds, int lane, int wave, float (&bv)[8]) {
    const LAS float* tot = (const LAS float*)(lds + L_TOT);
    float base = 0.f, all = 0.f;
#pragma unroll
    for (int g = 0; g < 8; ++g) { const float tv = tot[g * 64 + lane]; all += tv; if (g < wave) base += tv; }
#pragma unroll
    for (int j = 0; j < 8; ++j) bv[j] += base;
    return all;
}
__device__ __forceinline__ void gla_write_kdT_vT(LAS unsigned char* lds, const GlaPre& p, const float (&bv)[8], float bl, int tid, int lane, int wave) {
    float kd[8];
#pragma unroll
    for (int j = 0; j < 8; ++j) kd[j] = bf2f(p.k[j]) * fexp(bl - bv[j]);
    *(LAS v4u*)(lds + L_KDT + lane * LROWB + wave * 16) = (v4u){pk2(kd[0], kd[1]), pk2(kd[2], kd[3]), pk2(kd[4], kd[5]), pk2(kd[6], kd[7])};
    const int vv = tid & 127, cq = tid >> 7;
    LAS v4u* dst = (LAS v4u*)(lds + L_VT + vv * LROWB + cq * 32);
    dst[0] = (v4u){(unsigned)p.v[0] | ((unsigned)p.v[1] << 16), (unsigned)p.v[2] | ((unsigned)p.v[3] << 16), (unsigned)p.v[4] | ((unsigned)p.v[5] << 16), (unsigned)p.v[6] | ((unsigned)p.v[7] << 16)};
    dst[1] = (v4u){(unsigned)p.v[8] | ((unsigned)p.v[9] << 16), (unsigned)p.v[10] | ((unsigned)p.v[11] << 16), (unsigned)p.v[12] | ((unsigned)p.v[13] << 16), (unsigned)p.v[14] | ((unsigned)p.v[15] << 16)};
    if (wave == 0) ((LAS float*)(lds + L_BL))[lane] = bl;
}
__device__ __forceinline__ void gla_kv_mfma(LAS unsigned char* lds, int wave, int fr, int fq, f32x4 (&acc)[4]) {
    bf16x8 Bf[2];
#pragma unroll
    for (int ks = 0; ks < 2; ++ks) Bf[ks] = FRAG(L_VT, 16 * wave + fr, 32 * ks + 8 * fq);
#pragma unroll
    for (int dt = 0; dt < 4; ++dt) { acc[dt] = (f32x4){0.f, 0.f, 0.f, 0.f};
#pragma unroll
        for (int ks = 0; ks < 2; ++ks) acc[dt] = mfma16(FRAG(L_KDT, 16 * dt + fr, 32 * ks + 8 * fq), Bf[ks], acc[dt]); }
}

__device__ __forceinline__ void phase_gla_A2(Frame& F, int l) {
    const KA K = KA::fresh(); PHASE_TID;
    LAS unsigned char* lds = F.lds;
    const int fr = lane & 15, fq = lane >> 4;
#pragma unroll 1
    for (int it = F.bx; it < NITEM; it += F.G) {
        const int b = it / (GH * NSC), h = (it / NSC) % GH, sc = it % NSC, tok0 = b * S + sc * SCN * GC;
        const bf16* P = K.P();
        float wu[16];
        { const float* wup = K.in(3) + (size_t)l * 16 * 256 + h * 64 + lane;
#pragma unroll
          for (int r = 0; r < 16; ++r) wu[r] = wup[r * 256]; }
        const float bg = K.in(4)[l * 256 + h * 64 + lane];
        GlaPre pre[2]; gla_prefetch<false>(pre[0], P, h, tok0, tid, lane, wave); gla_prefetch<false>(pre[1], P, h, tok0 + GC, tid, lane, wave);
        __syncthreads();
        gla_stage_gkl(P, lds, tok0, tid);
        __syncthreads();
        f32x4 Sl[4], bs[4];
#pragma unroll
        for (int dt = 0; dt < 4; ++dt) { Sl[dt] = (f32x4){0.f, 0.f, 0.f, 0.f}; bs[dt] = (f32x4){0.f, 0.f, 0.f, 0.f}; }
#pragma unroll
        for (int n = 0; n < SCN; ++n) {
            float bv[8]; gla_b8_part(lds, wu, bg, n, lane, wave, bv);
            __syncthreads();
            const float bl = gla_b8_finish(lds, lane, wave, bv);
            gla_write_kdT_vT(lds, pre[n & 1], bv, bl, tid, lane, wave);
            if (n + 2 < SCN) gla_prefetch<false>(pre[n & 1], P, h, tok0 + (n + 2) * GC, tid, lane, wave);
            __syncthreads();
            f32x4 acc[4]; gla_kv_mfma(lds, wave, fr, fq, acc);
#pragma unroll
            for (int dt = 0; dt < 4; ++dt) { const f32x4 bl4 = *(const LAS f32x4*)(lds + L_BL + (16 * dt + 4 * fq) * 4);
                bs[dt] = bs[dt] + bl4;
#pragma unroll
                for (int r = 0; r < 4; ++r) Sl[dt][r] = fexp(bl4[r]) * Sl[dt][r] + acc[dt][r]; }
        }
        f32x4* ag = (f32x4*)K.Sst() + ((size_t)(it * 8 + wave) * 4) * 64 + lane;
#pragma unroll
        for (int dt = 0; dt < 4; ++dt) ag[dt * 64] = Sl[dt];
        if (wave == 0 && fr == 0) { f32x4* dp = (f32x4*)K.dec() + (size_t)it * 16 + fq;
#pragma unroll
            for (int dt = 0; dt < 4; ++dt) dp[dt * 4] = (f32x4){fexp(bs[dt][0]), fexp(bs[dt][1]), fexp(bs[dt][2]), fexp(bs[dt][3])}; }
    }
}


__device__ __forceinline__ void phase_gla_aggscan(Frame& F) {
    const KA K = KA::fresh(); PHASE_TID;
#pragma unroll 1
    for (int e = F.bx * NT + tid; e < NB * GH * 8192; e += F.G * NT) {
        const int bh = e >> 13, el = e & 8191, ln = (el >> 2) & 63, dt = (el >> 8) & 3, r = el & 3;
        float* ap = K.Sst() + (size_t)bh * NSC * 8192 + el; const float* dp = K.dec() + (size_t)bh * NSC * 64 + dt * 16 + (ln >> 4) * 4 + r;
        float a[NSC], d[NSC];
#pragma unroll
        for (int j = 0; j < NSC; ++j) { a[j] = ap[(size_t)j * 8192]; d[j] = dp[j * 64]; }
        float st = 0.f;
#pragma unroll
        for (int j = 0; j < NSC; ++j) { ap[(size_t)j * 8192] = st; st = d[j] * st + a[j]; }
    }
}
__device__ __forceinline__ void phase_gla_C2(Frame& F, int l) {
    const KA K = KA::fresh(); PHASE_TID;
    LAS unsigned char* lds = F.lds;
    const int fr = lane & 15, fq = lane >> 4;
    const float* gnorm = K.in(5) + (size_t)l * 128;
#pragma unroll 1
    for (int it = F.bx; it < NITEM; it += F.G) {
        const int b = it / (GH * NSC), h = (it / NSC) % GH, sc = it % NSC, tok0 = b * S + sc * SCN * GC;
        const bf16* P = K.P();
        float wu[16];
        { const float* wup = K.in(3) + (size_t)l * 16 * 256 + h * 64 + lane;
#pragma unroll
          for (int r = 0; r < 16; ++r) wu[r] = wup[r * 256]; }
        const float bg = K.in(4)[l * 256 + h * 64 + lane];
        GlaPre pre[2]; gla_prefetch<true>(pre[0], P, h, tok0, tid, lane, wave); gla_prefetch<true>(pre[1], P, h, tok0 + GC, tid, lane, wave);
        __syncthreads();
        gla_stage_gkl(P, lds, tok0, tid);
        f32x4 Sm[4];
        { const f32x4* ag = (const f32x4*)K.Sst() + ((size_t)(it * 8 + wave) * 4) * 64 + lane;
#pragma unroll
          for (int dt = 0; dt < 4; ++dt) Sm[dt] = ag[dt * 64]; }
        __syncthreads();
#pragma unroll
        for (int n = 0; n < SCN; ++n) {
            const int t0 = tok0 + n * GC;
            GlaPre& pr = pre[n & 1];
            float bv[8]; gla_b8_part(lds, wu, bg, n, lane, wave, bv);
            __syncthreads();
            const float bl = gla_b8_finish(lds, lane, wave, bv);
            gla_write_kdT_vT(lds, pr, bv, bl, tid, lane, wave);
#pragma unroll
            for (int j = 0; j < 8; ++j) {
                const float e = fexp(bv[j]);
                *(LAS bf16*)(lds + L_QD + (8 * wave + j) * LROWB + lane * 2) = (bf16)f2bf(bf2f(pr.q[j]) * 0.125f * e);
                *(LAS bf16*)(lds + L_KI + (8 * wave + j) * LROWB + lane * 2) = (bf16)f2bf(bf2f(pr.k[j]) * __builtin_amdgcn_rcpf(e));
            }
#pragma unroll
            for (int dt = 0; dt < 4; ++dt) *(LAS v2u*)(lds + L_ST + (16 * wave + fr) * LROWB + (16 * dt + 4 * fq) * 2) = (v2u){pk2(Sm[dt][0], Sm[dt][1]), pk2(Sm[dt][2], Sm[dt][3])};
            const v4u gq0 = pr.g0, gq1 = pr.g1;
            if (n + 2 < SCN) gla_prefetch<true>(pr, P, h, t0 + 2 * GC, tid, lane, wave);
            __syncthreads();
#pragma unroll
            for (int i = 0; i < 2; ++i) {
                const int tix = 2 * wave + i, st = tix >> 2, ct = tix & 3;
                f32x4 a = (f32x4){0.f, 0.f, 0.f, 0.f};
#pragma unroll
                for (int ks = 0; ks < 2; ++ks) a = mfma16(FRAG(L_KI, 16 * st + fr, 32 * ks + 8 * fq), FRAG(L_QD, 16 * ct + fr, 32 * ks + 8 * fq), a);
                const int s0 = 16 * st + 4 * fq, c = 16 * ct + fr;
                float m[4];
#pragma unroll
                for (int r = 0; r < 4; ++r) m[r] = (s0 + r <= c) ? a[r] : 0.f;
                *(LAS v2u*)(lds + L_S + c * LROWB + s0 * 2) = (v2u){pk2(m[0], m[1]), pk2(m[2], m[3])};
            }
            f32x4 kv[4]; gla_kv_mfma(lds, wave, fr, fq, kv);
            __syncthreads();
            {
                bf16x8 Av[2], As[2];
#pragma unroll
                for (int ks = 0; ks < 2; ++ks) { Av[ks] = FRAG(L_VT, 16 * wave + fr, 32 * ks + 8 * fq); As[ks] = FRAG(L_ST, 16 * wave + fr, 32 * ks + 8 * fq); }
#pragma unroll
                for (int ct = 0; ct < 4; ++ct) {
                    f32x4 a = (f32x4){0.f, 0.f, 0.f, 0.f};
#pragma unroll
                    for (int ks = 0; ks < 2; ++ks) { a = mfma16(Av[ks], FRAG(L_S, 16 * ct + fr, 32 * ks + 8 * fq), a); a = mfma16(As[ks], FRAG(L_QD, 16 * ct + fr, 32 * ks + 8 * fq), a); }
                    *(LAS f32x4*)(lds + L_OB + (16 * ct + fr) * OBROW + (16 * wave + 4 * fq) * 4) = a;
                }
            }
#pragma unroll
            for (int dt = 0; dt < 4; ++dt) { const f32x4 bl4 = *(const LAS f32x4*)(lds + L_BL + (16 * dt + 4 * fq) * 4);
#pragma unroll
                for (int r = 0; r < 4; ++r) Sm[dt][r] = fexp(bl4[r]) * Sm[dt][r] + kv[dt][r]; }
            __syncthreads();
            {
                const int c = tid >> 3, vg = tid & 7;
                const LAS f32x4* ob = (const LAS f32x4*)(lds + L_OB + c * OBROW + vg * 64);
                f32x4 o[4]; float ss = 0.f;
#pragma unroll
                for (int j = 0; j < 4; ++j) { o[j] = ob[j]; ss += (o[j].x * o[j].x + o[j].y * o[j].y) + (o[j].z * o[j].z + o[j].w * o[j].w); }
                ss = sum8(ss);
                const float rs = rsqrtf(ss * (1.0f / 128.0f) + EPS);
                float g0[8], g1[8]; unpack8(gq0, g0); unpack8(gq1, g1);
                const f32x4* gn = (const f32x4*)(gnorm + 16 * vg);
                const f32x4 n0 = gn[0], n1 = gn[1], n2 = gn[2], n3 = gn[3];
                v4u w0, w1;
                w0.x = pk2(o[0].x * rs * n0.x * silu_fast(g0[0]), o[0].y * rs * n0.y * silu_fast(g0[1])); w0.y = pk2(o[0].z * rs * n0.z * silu_fast(g0[2]), o[0].w * rs * n0.w * silu_fast(g0[3]));
                w0.z = pk2(o[1].x * rs * n1.x * silu_fast(g0[4]), o[1].y * rs * n1.y * silu_fast(g0[5])); w0.w = pk2(o[1].z * rs * n1.z * silu_fast(g0[6]), o[1].w * rs * n1.w * silu_fast(g0[7]));
                w1.x = pk2(o[2].x * rs * n2.x * silu_fast(g1[0]), o[2].y * rs * n2.y * silu_fast(g1[1])); w1.y = pk2(o[2].z * rs * n2.z * silu_fast(g1[2]), o[2].w * rs * n2.w * silu_fast(g1[3]));
                w1.z = pk2(o[3].x * rs * n3.x * silu_fast(g1[4]), o[3].y * rs * n3.y * silu_fast(g1[5])); w1.w = pk2(o[3].z * rs * n3.z * silu_fast(g1[6]), o[3].w * rs * n3.w * silu_fast(g1[7]));
                v4u* op = (v4u*)(K.XN() + (size_t)(t0 + c) * D + h * 128 + 16 * vg);
                op[0] = w0; op[1] = w1;
            }
        }
    }
}
#undef FRAG

constexpr int GM_ROWB = 272;
__device__ __forceinline__ void phase_gmlp_mfma(Frame& F, int l) {
    const KA K = KA::fresh(); PHASE_TID;
    LAS unsigned char* lds = F.lds;
    const int fr = lane & 15, fq = lane >> 4;
#pragma unroll 1
    for (int u = F.bx; u < NB * MN * MH; u += F.G) {
        const int b = u / (MN * MH), n = (u / MH) % MN, h = u % MH, t0 = b * S + n * MC;
        const bf16* P = K.P();
        const float gn = K.in(6)[(size_t)l * 256 + h * 64 + lane];
        __syncthreads();
#pragma unroll
        for (int q = 0; q < 2; ++q) {
            float vs[8];
#pragma unroll
            for (int i = 0; i < 8; ++i) {
                const float g = gelu_fast(bf2f(P[(size_t)(t0 + 16 * wave + 8 * q + i) * PLD + C_VG + h * 64 + lane]));
                const float ss = wave_sum(g * g);
                vs[i] = g * rsqrtf(ss * (1.0f / 64.0f) + EPS) * gn;
            }
            *(LAS v4u*)(lds + lane * GM_ROWB + (16 * wave + 8 * q) * 2) = (v4u){pk2(vs[0], vs[1]), pk2(vs[2], vs[3]), pk2(vs[4], vs[5]), pk2(vs[6], vs[7])};
        }
        __syncthreads();
        const bf16* Wb = K.Wsp() + ((size_t)(l * MH + h) * 128 + 16 * wave + fr) * 128 + 8 * fq;
        f32x4 acc[4];
#pragma unroll
        for (int dt = 0; dt < 4; ++dt) acc[dt] = (f32x4){0.f, 0.f, 0.f, 0.f};
        const int nks = (16 * wave + 15) / 32 + 1;
#pragma unroll
        for (int ks = 0; ks < 4; ++ks) if (ks < nks) {
            const bf16x8 Bf = *(const bf16x8*)(Wb + 32 * ks);
#pragma unroll
            for (int dt = 0; dt < 4; ++dt) acc[dt] = mfma16(*(const LAS bf16x8*)(lds + (16 * dt + fr) * GM_ROWB + (32 * ks + 8 * fq) * 2), Bf, acc[dt]);
        }
        const int t = 16 * wave + fr;
        const float bias = K.in(8)[(size_t)l * MH * 128 + h * 128 + t];
        const bf16* up = P + (size_t)(t0 + t) * PLD + C_U + h * 64 + 4 * fq;
        bf16* op = K.XN() + (size_t)(t0 + t) * D + 512 + h * 64 + 4 * fq;
#pragma unroll
        for (int dt = 0; dt < 4; ++dt) {
            const v2u uw = *(const v2u*)(up + 16 * dt);
            const float o0 = gelu_fast(bflo(uw.x)) * (acc[dt][0] + bias), o1 = gelu_fast(bfhi(uw.x)) * (acc[dt][1] + bias), o2 = gelu_fast(bflo(uw.y)) * (acc[dt][2] + bias), o3 = gelu_fast(bfhi(uw.y)) * (acc[dt][3] + bias);
            *(v2u*)(op + 16 * dt) = (v2u){pk2(o0, o1), pk2(o2, o3)};
        }
    }
}

__device__ __forceinline__ void phase_conv(Frame& F, int l) {
    const KA K = KA::fresh(); PHASE_TID;
    const float* wc = K.in(9) + (size_t)l * 3 * 256;
#pragma unroll 1
    for (int e = F.bx * NT + tid; e < T * 32; e += F.G * NT) {
        const int t = e >> 5, c0 = (e & 31) * 8, tl = t % S;
        const bf16* row = K.P() + (size_t)t * PLD;
        float y[8], xi[8], cg[8], bg[8];
        unpack8(*(const v4u*)(row + C_XI + c0), xi); unpack8(*(const v4u*)(row + C_CG + c0), cg); unpack8(*(const v4u*)(row + C_BG + c0), bg);
#pragma unroll
        for (int j = 0; j < 8; ++j) y[j] = wc[2 * 256 + c0 + j] * cg[j] * xi[j];
        if (tl >= 1) { unpack8(*(const v4u*)(row - PLD + C_XI + c0), xi); unpack8(*(const v4u*)(row - PLD + C_CG + c0), cg);
#pragma unroll
            for (int j = 0; j < 8; ++j) y[j] += wc[1 * 256 + c0 + j] * cg[j] * xi[j]; }
        if (tl >= 2) { unpack8(*(const v4u*)(row - 2 * PLD + C_XI + c0), xi); unpack8(*(const v4u*)(row - 2 * PLD + C_CG + c0), cg);
#pragma unroll
            for (int j = 0; j < 8; ++j) y[j] += wc[0 * 256 + c0 + j] * cg[j] * xi[j]; }
#pragma unroll
        for (int j = 0; j < 8; ++j) y[j] *= bg[j];
        *(v4u*)(K.XN() + (size_t)t * D + 768 + c0) = (v4u){pk2(y[0], y[1]), pk2(y[2], y[3]), pk2(y[4], y[5]), pk2(y[6], y[7])};
    }
}
__device__ __forceinline__ void phase_norm_router(Frame& F, int l) {
    const KA K = KA::fresh(); PHASE_TID;
    const float* gain = K.in(11) + (size_t)l * D;
    const float* wrg = K.in(12) + (size_t)l * D * 4; const float* brg = K.in(13) + (size_t)l * 4;
    const float* wre = K.in(14) + (size_t)l * D * 32; const float* bre = K.in(15) + (size_t)l * 32;
    int* cnt = (int*)(K.ctl() + CW_CNT + 64 * l);
#pragma unroll 1
    for (int t = F.bx * NWAVES + wave; t < T; t += F.G * NWAVES) {
        const f32x4* xr = (const f32x4*)(K.out() + (size_t)t * D) + lane;
        f32x4 v[4]; float s = 0.f;
#pragma unroll
        for (int j = 0; j < 4; ++j) { v[j] = xr[64 * j]; s += (v[j].x * v[j].x + v[j].y * v[j].y) + (v[j].z * v[j].z + v[j].w * v[j].w); }
        const float rs = rsqrtf(wave_sum(s) * (1.f / D) + EPS);
        v2u* o8 = (v2u*)(K.XN() + (size_t)t * D) + lane;
        float acc[36];
#pragma unroll
        for (int j = 0; j < 36; ++j) acc[j] = 0.f;
#pragma unroll
        for (int j = 0; j < 4; ++j) {
            const f32x4 g = ((const f32x4*)gain)[lane + 64 * j];
            const float hv[4] = {v[j].x * rs * g.x, v[j].y * rs * g.y, v[j].z * rs * g.z, v[j].w * rs * g.w};
            v2u w; w.x = pk2(hv[0], hv[1]); w.y = pk2(hv[2], hv[3]); o8[64 * j] = w;
#pragma unroll
            for (int i = 0; i < 4; ++i) {
                const int k = 4 * lane + 256 * j + i; const float xv = hv[i];
                const f32x4 g4 = *(const f32x4*)(wrg + (size_t)k * 4);
                acc[0] += xv * g4.x; acc[1] += xv * g4.y; acc[2] += xv * g4.z; acc[3] += xv * g4.w;
                const f32x4* e4 = (const f32x4*)(wre + (size_t)k * 32);
#pragma unroll
                for (int q = 0; q < 8; ++q) { const f32x4 w4 = e4[q]; acc[4 + 4 * q] += xv * w4.x; acc[5 + 4 * q] += xv * w4.y; acc[6 + 4 * q] += xv * w4.z; acc[7 + 4 * q] += xv * w4.w; }
            }
        }
#pragma unroll
        for (int j = 0; j < 36; ++j) acc[j] = wave_sum(acc[j]);
        if (lane == 0) {
            float gl[4]; int gt = 0;
#pragma unroll
            for (int j = 0; j < 4; ++j) gl[j] = acc[j] + brg[j];
            float gmax = gl[0];
#pragma unroll
            for (int j = 1; j < 4; ++j) if (gl[j] > gmax) { gmax = gl[j]; gt = j; }
            float gs = 0.f;
#pragma unroll
            for (int j = 0; j < 4; ++j) gs += expf(gl[j] - gmax);
            const float gw = 1.0f / gs;
            float el[8];
#pragma unroll
            for (int j = 0; j < 8; ++j) { float vv = 0.f;
#pragma unroll
                for (int g = 0; g < 4; ++g) if (g == gt) vv = acc[4 + g * 8 + j] + bre[g * 8 + j];
                el[j] = vv; }
            int i0 = 0; float m0 = el[0];
#pragma unroll
            for (int j = 1; j < 8; ++j) if (el[j] > m0) { m0 = el[j]; i0 = j; }
            int i1 = -1; float m1 = -INFINITY;
#pragma unroll
            for (int j = 0; j < 8; ++j) if (j != i0 && el[j] > m1) { m1 = el[j]; i1 = j; }
            const float e1 = expf(m1 - m0);
            const float w0 = gw / (1.0f + e1), w1 = gw * e1 / (1.0f + e1);
            const int e0i = gt * 8 + i0, e1i = gt * 8 + i1;
            K.eid()[2 * t] = e0i; K.eid()[2 * t + 1] = e1i; K.ew()[2 * t] = w0; K.ew()[2 * t + 1] = w1;
            atomicAdd(&cnt[e0i], 1); atomicAdd(&cnt[e1i], 1);
        }
    }
}
constexpr int RT_PART = 0, RT_SS = RT_PART + 4 * 8 * 16 * 48 * 4, RT_RS = RT_SS + 4 * 8 * 16 * 4, RT_HIST = RT_RS + 64 * 4;
__device__ __forceinline__ void phase_norm_router_mfma(Frame& F, int l) {
    const KA K = KA::fresh(); PHASE_TID;
    LAS unsigned char* lds = F.lds;
    const int fr = lane & 15, fq = lane >> 4;
    const bf16* whi = K.Wr() + (size_t)l * 2 * 48 * D + (size_t)fr * D + 128 * wave + 8 * fq; const bf16* wlo = whi + 48 * D;
    bf16x8 Wh[4][3], Wl[4][3];
#pragma unroll
    for (int ks = 0; ks < 4; ++ks)
#pragma unroll
        for (int nt = 0; nt < 3; ++nt) { Wh[ks][nt] = *(const bf16x8*)(whi + (size_t)(16 * nt) * D + 32 * ks); Wl[ks][nt] = *(const bf16x8*)(wlo + (size_t)(16 * nt) * D + 32 * ks); }
    f32x4 g0[4], g1[4];
    { const float* gp = K.in(11) + (size_t)l * D + 128 * wave + 8 * fq;
#pragma unroll
      for (int ks = 0; ks < 4; ++ks) { g0[ks] = *(const f32x4*)(gp + 32 * ks); g1[ks] = *(const f32x4*)(gp + 32 * ks + 4); } }
#pragma unroll 1
    for (int blk = F.bx; blk < T / 64; blk += F.G) {
        const bf16* xr = K.XR() + (size_t)(blk * 64 + fr) * D + 128 * wave + 8 * fq;
        __syncthreads();
        if (tid < NE) ((LAS int*)(lds + RT_HIST))[tid] = 0;
#pragma unroll
        for (int tp = 0; tp < 2; ++tp) {
            v4u xa[2][4];
#pragma unroll
            for (int t2 = 0; t2 < 2; ++t2)
#pragma unroll
                for (int ks = 0; ks < 4; ++ks) xa[t2][ks] = *(const v4u*)(xr + (size_t)(16 * (2 * tp + t2)) * D + 32 * ks);
#pragma unroll
            for (int t2 = 0; t2 < 2; ++t2) {
                const int t = 2 * tp + t2;
                f32x4 acc[3]; float ss = 0.f;
#pragma unroll
                for (int nt = 0; nt < 3; ++nt) acc[nt] = (f32x4){0.f, 0.f, 0.f, 0.f};
#pragma unroll
                for (int ks = 0; ks < 4; ++ks) {
                    float xv[8]; unpack8(xa[t2][ks], xv);
#pragma unroll
                    for (int j = 0; j < 8; ++j) ss += xv[j] * xv[j];
                    const bf16x8 Ah = __builtin_bit_cast(bf16x8, xa[t2][ks]);
#pragma unroll
                    for (int nt = 0; nt < 3; ++nt) { acc[nt] = mfma16(Ah, Wh[ks][nt], acc[nt]); acc[nt] = mfma16(Ah, Wl[ks][nt], acc[nt]); }
                }
                ss += shx(ss, 16); ss += shx(ss, 32);
                LAS float* part = (LAS float*)(lds + RT_PART) + (t * 8 + wave) * 16 * 48;
#pragma unroll
                for (int nt = 0; nt < 3; ++nt)
#pragma unroll
                    for (int r = 0; r < 4; ++r) part[(4 * fq + r) * 48 + 16 * nt + fr] = acc[nt][r];
                if (fq == 0) ((LAS float*)(lds + RT_SS))[(t * 8 + wave) * 16 + fr] = ss;
            }
        }
        __syncthreads();
        {
            const int tt = tid >> 3, j = tid & 7, t = blk * 64 + tt;
            const LAS float* p0 = (const LAS float*)(lds + RT_PART) + ((tt >> 4) * 8 * 16 + (tt & 15)) * 48;
            const LAS float* s2 = (const LAS float*)(lds + RT_SS) + (tt >> 4) * 8 * 16 + (tt & 15);
            float sq = 0.f;
#pragma unroll
            for (int w = 0; w < 8; ++w) sq += s2[w * 16];
            const float rs = rsqrtf(sq * (1.f / D) + EPS);
#define RT_DOT(n) (((p0[(n)] + p0[768 + (n)]) + (p0[1536 + (n)] + p0[2304 + (n)])) + ((p0[3072 + (n)] + p0[3840 + (n)]) + (p0[4608 + (n)] + p0[5376 + (n)])))
            float gv = (j < 4) ? RT_DOT(j & 3) * rs + K.in(13)[(size_t)l * 4 + (j & 3)] : -INFINITY; int gi = j;
            const float gmine = gv;
#define RT_ARGMAX_STEP(V, I, FV, FI) do { const float ov = FV(V); const int oi = FI(I); if (ov > V || (ov == V && oi < I)) { V = ov; I = oi; } } while (0)
            RT_ARGMAX_STEP(gv, gi, dppf_x1, dpp_x1); RT_ARGMAX_STEP(gv, gi, dppf_x2, dpp_x2); RT_ARGMAX_STEP(gv, gi, dppf_hm, dpp_hm);
            float ge = (j < 4) ? expf(gmine - gv) : 0.f;
            ge = sum8(ge);
            const float gw = 1.0f / ge; const int gt = gi;
            const float ev = RT_DOT(4 + gt * 8 + j) * rs + K.in(15)[(size_t)l * 32 + gt * 8 + j];
#undef RT_DOT
            float m0 = ev; int i0 = j;
            RT_ARGMAX_STEP(m0, i0, dppf_x1, dpp_x1); RT_ARGMAX_STEP(m0, i0, dppf_x2, dpp_x2); RT_ARGMAX_STEP(m0, i0, dppf_hm, dpp_hm);
            float m1 = (j == i0) ? -INFINITY : ev; int i1 = j;
            RT_ARGMAX_STEP(m1, i1, dppf_x1, dpp_x1); RT_ARGMAX_STEP(m1, i1, dppf_x2, dpp_x2); RT_ARGMAX_STEP(m1, i1, dppf_hm, dpp_hm);
#undef RT_ARGMAX_STEP
            if (j == 0) {
                ((LAS float*)(lds + RT_RS))[tt] = rs;
                const float e1 = expf(m1 - m0);
                const float w0 = gw / (1.0f + e1), w1 = gw * e1 / (1.0f + e1);
                const int e0i = gt * 8 + i0, e1i = gt * 8 + i1;
                K.eid()[2 * t] = e0i; K.eid()[2 * t + 1] = e1i; K.ew()[2 * t] = w0; K.ew()[2 * t + 1] = w1;
                LAS int* hist = (LAS int*)(lds + RT_HIST);
                K.slot_of()[2 * t] = __hip_atomic_fetch_add(hist + e0i, 1, __ATOMIC_RELAXED, __HIP_MEMORY_SCOPE_WORKGROUP);
                K.slot_of()[2 * t + 1] = __hip_atomic_fetch_add(hist + e1i, 1, __ATOMIC_RELAXED, __HIP_MEMORY_SCOPE_WORKGROUP);
            }
        }
        __syncthreads();
        if (tid < NE) K.blkcnt()[(size_t)(l * (T / 64) + blk) * NE + tid] = ((LAS int*)(lds + RT_HIST))[tid];
        {
            bf16* hp = K.XN() + (size_t)(blk * 64 + fr) * D + 128 * wave + 8 * fq;
#pragma unroll
            for (int t = 0; t < 4; ++t) {
                const float rs = ((const LAS float*)(lds + RT_RS))[16 * t + fr];
#pragma unroll
                for (int ks = 0; ks < 4; ++ks) {
                    float xv[8]; unpack8(*(const v4u*)(xr + (size_t)(16 * t) * D + 32 * ks), xv);
                    *(v4u*)(hp + (size_t)(16 * t) * D + 32 * ks) = (v4u){pk2(xv[0] * rs * g0[ks].x, xv[1] * rs * g0[ks].y), pk2(xv[2] * rs * g0[ks].z, xv[3] * rs * g0[ks].w), pk2(xv[4] * rs * g1[ks].x, xv[5] * rs * g1[ks].y), pk2(xv[6] * rs * g1[ks].z, xv[7] * rs * g1[ks].w)};
                }
            }
        }
    }
}
__device__ __forceinline__ void phase_scatter(Frame& F, int l) {
    const KA K = KA::fresh(); PHASE_TID;
    LAS int* sm = (LAS int*)F.lds;
    const int* bc = K.blkcnt() + (size_t)l * (T / 64) * NE;
    constexpr int NBLK = T / 64;
#pragma unroll 1
    for (int blk = F.bx; blk < NBLK; blk += F.G) {
        __syncthreads();
        {   const int e = tid & 31, part = tid >> 5;
            int tot = 0, pre = 0;
#pragma unroll
            for (int j = 0; j < NBLK / 16; ++j) { const int bb = part * (NBLK / 16) + j; const int c = bc[bb * NE + e]; tot += c; if (bb < blk) pre += c; }
            sm[part * 32 + e] = tot; sm[512 + part * 32 + e] = pre; }
        __syncthreads();
        if (tid < 32) { int tot = 0, pre = 0;
#pragma unroll
            for (int p = 0; p < 16; ++p) { tot += sm[p * 32 + tid]; pre += sm[512 + p * 32 + tid]; }
            sm[1056 + tid] = tot; sm[1024 + tid] = pre; }
        __syncthreads();
        if (tid == 0) { int a = 0; for (int e = 0; e < NE; ++e) { const int c = sm[1056 + e]; sm[1024 + e] += a; a += c; } }
        if (blk == 0 && tid < 32) ((int*)(K.ctl() + CW_CNT + 64 * l))[tid] = sm[1056 + tid];
        __syncthreads();
        if (tid < 128) { const int a = blk * 128 + tid; const int e = K.eid()[a]; const int pos = sm[1024 + e] + K.slot_of()[a]; K.slot_tok()[pos] = a >> 1; K.slot_of()[a] = pos; }
    }
    __syncthreads();
}
template <bool DUAL>
__device__ __forceinline__ void gemm_core(const bf16* A, const int* rowoff, int K, const float* B0, const float* B1, int ldb, int n0,
                                          float (&acc0)[4][4], float (&acc1)[4][4], float* As, float* Bs0, float* Bs1) {
    const int tid = __builtin_amdgcn_readfirstlane(threadIdx.x >> 6) * 64 + fresh_lane(), tx = tid & 15, ty = tid >> 4;
    const int ar = tid >> 2, ak = (tid & 3) * 4;
    const int bk = (tid >> 4) & 15, bn = (tid & 15) * 4;
    const long aoff = rowoff[ar];
#pragma unroll
    for (int i = 0; i < 4; ++i)
#pragma unroll
        for (int j = 0; j < 4; ++j) { acc0[i][j] = 0.f; acc1[i][j] = 0.f; }
#pragma unroll 1
    for (int k0 = 0; k0 < K; k0 += 16) {
        v2u av = (v2u){0u, 0u};
        if (aoff >= 0) av = *(const v2u*)(A + aoff + k0 + ak);
        f32x4 bv0 = (f32x4){0.f, 0.f, 0.f, 0.f}, bv1 = bv0;
        if (tid < 256) { bv0 = *(const f32x4*)(B0 + (size_t)(k0 + bk) * ldb + n0 + bn); if (DUAL) bv1 = *(const f32x4*)(B1 + (size_t)(k0 + bk) * ldb + n0 + bn); }
        __syncthreads();
        As[(ak + 0) * 132 + ar] = bflo(av.x); As[(ak + 1) * 132 + ar] = bfhi(av.x); As[(ak + 2) * 132 + ar] = bflo(av.y); As[(ak + 3) * 132 + ar] = bfhi(av.y);
        if (tid < 256) { *(f32x4*)(Bs0 + bk * 64 + bn) = bv0; if (DUAL) *(f32x4*)(Bs1 + bk * 64 + bn) = bv1; }
        __syncthreads();
#pragma unroll
        for (int kk = 0; kk < 16; ++kk) {
            const f32x4 a4 = *(const f32x4*)(As + kk * 132 + ty * 4);
            const f32x4 b4 = *(const f32x4*)(Bs0 + kk * 64 + tx * 4);
#pragma unroll
            for (int i = 0; i < 4; ++i)
#pragma unroll
                for (int j = 0; j < 4; ++j) acc0[i][j] += a4[i] * b4[j];
            if (DUAL) {
                const f32x4 c4 = *(const f32x4*)(Bs1 + kk * 64 + tx * 4);
#pragma unroll
                for (int i = 0; i < 4; ++i)
#pragma unroll
                    for (int j = 0; j < 4; ++j) acc1[i][j] += a4[i] * c4[j];
            }
        }
    }
}
template <int MODE>
__device__ __forceinline__ void phase_moe_ref(Frame& F, int l) {
    const KA K = KA::fresh(); PHASE_TID;
    float* As = F.smem; float* Bs0 = F.smem + 16 * 132; float* Bs1 = Bs0 + 16 * 64; int* rowoff = (int*)(Bs1 + 16 * 64); int* offs = rowoff + 128; int* toff = offs + 33;
    int* cnt = (int*)(K.ctl() + CW_CNT + 64 * l);
    const int tx = tid & 15, ty = tid >> 4;
    __syncthreads();
    if (tid == 0) { int a = 0, tt = 0; for (int e = 0; e < NE; ++e) { offs[e] = a; toff[e] = tt; const int c = cnt[e]; a += c; tt += (c + 127) / 128; } offs[NE] = a; toff[NE] = tt; }
    __syncthreads();
    constexpr int N = (MODE == 1) ? DE : D, KD = (MODE == 1) ? D : DE, NTN = N / 64;
    const int ntiles = toff[NE] * NTN;
#pragma unroll 1
    for (int t = F.bx; t < ntiles; t += F.G) {
        const int rt = t / NTN, tn = t % NTN;
        int e = 0;
        for (int j = 1; j < NE; ++j) if (toff[j] <= rt) e = j;
        const int r0 = offs[e] + (rt - toff[e]) * 128, rend = offs[e + 1];
        __syncthreads();
        if (tid < 128) { const int r = r0 + tid; rowoff[tid] = (r < rend) ? ((MODE == 1) ? K.slot_tok()[r] * D : r * DE) : -1; }
        __syncthreads();
        float acc0[4][4], acc1[4][4];
        if (MODE == 1) {
            const float* Wg = K.in(16) + ((size_t)l * NE + e) * D * DE; const float* Wu = K.in(17) + ((size_t)l * NE + e) * D * DE;
            gemm_core<true>(K.XN(), rowoff, KD, Wg, Wu, DE, tn * 64, acc0, acc1, As, Bs0, Bs1);
        } else {
            const float* Wd = K.in(18) + ((size_t)l * NE + e) * DE * D;
            gemm_core<false>(K.H1(), rowoff, KD, Wd, nullptr, D, tn * 64, acc0, acc1, As, Bs0, nullptr);
        }
#pragma unroll
        for (int i = 0; i < 4; ++i) {
            const int r = r0 + ty * 4 + i;
            if (r < rend) {
                v2u o;
                if (MODE == 1) { o.x = pk2(silu(acc0[i][0]) * acc1[i][0], silu(acc0[i][1]) * acc1[i][1]); o.y = pk2(silu(acc0[i][2]) * acc1[i][2], silu(acc0[i][3]) * acc1[i][3]);
                    *(v2u*)(K.H1() + (size_t)r * DE + tn * 64 + tx * 4) = o; }
                else { o.x = pk2(acc0[i][0], acc0[i][1]); o.y = pk2(acc0[i][2], acc0[i][3]); *(v2u*)(K.Y() + (size_t)r * D + tn * 64 + tx * 4) = o; }
            }
        }
    }
    __syncthreads();
}

constexpr int TAB_OFF = LDSCTL_OFF + 1024;
__device__ __forceinline__ void moe_tables(Frame& F, int l) {
    const KA K = KA::fresh(); PHASE_TID;
    LAS int* tab = (LAS int*)(F.lds + TAB_OFF); LAS int* offs = tab + 4 + 4 * 164; LAS int* fpre = offs + 40; LAS int* ppre = fpre + 40;
    const int* cnt = (const int*)(K.ctl() + CW_CNT + 64 * l);
    __syncthreads();
    if (tid == 0) { int a = 0, f = 0, p = 0; for (int e = 0; e < NE; ++e) { const int c = cnt[e]; offs[e] = a; fpre[e] = f; ppre[e] = p; a += c; f += c >> 8; p += (c & 255) ? 1 : 0; }
        offs[NE] = a; fpre[NE] = f; ppre[NE] = p; tab[0] = f + p; }
    __syncthreads();
    const int nfull = fpre[NE], ntile = nfull + ppre[NE];
    if (tid < nfull) { int e = 0; for (int j = 1; j < NE; ++j) if (fpre[j] <= tid) e = j; tab[4 + 4 * tid] = e; tab[5 + 4 * tid] = offs[e] + (tid - fpre[e]) * 256; tab[6 + 4 * tid] = offs[e + 1]; }
    else if (tid < nfull + NE) {
        const int e = tid - nfull, rows = (offs[e + 1] - offs[e]) & 255;
        if (rows) { int rank = 0; for (int j = 0; j < NE; ++j) { const int rj = (offs[j + 1] - offs[j]) & 255; rank += (rj > rows || (rj == rows && j < e)) ? 1 : 0; }
            const int q = nfull + rank; tab[4 + 4 * q] = e; tab[5 + 4 * q] = offs[e] + (fpre[e + 1] - fpre[e]) * 256; tab[6 + 4 * q] = offs[e + 1]; }
    }
    __syncthreads();
    (void)ntile;
}
template <int SUB>
__device__ __forceinline__ void phase_moe(Frame& F, int l) {
    if (SUB == 0) moe_tables(F, l);
    const KA K = KA::fresh();
    int c_ = F.bx; asm volatile("" : "+s"(c_));
    const int G = F.G, c = (c_ & 7) * (G >> 3) + (c_ >> 3);
    const LAS int* tab = (const LAS int*)(F.lds + TAB_OFF);
    const int ntile = __builtin_amdgcn_readfirstlane(tab[0]), ngu = 2 * ntile, nleft = ngu > G ? ngu - G : 0, jX = ngu > G ? (G >> 1) : ntile, W = G - nleft;
    const int yd = (jX * 4 < 2 * W) ? jX * 4 : 2 * W;
    bool do_gu = false, do_dn = false; pg8::MoeSched So{tab, 2, 0, 0, G, c};
    if (SUB == 0) { do_gu = true; So.npn = 2; So.first = 0; So.end = ngu < G ? ngu : G; So.stride = G; So.c = c; }
    if (SUB == 1) { if (c < nleft) { do_gu = true; So.npn = 2; So.first = G; So.end = ngu; So.stride = G; So.c = c; }
                    else { do_dn = true; So.npn = 4; So.first = 0; So.end = yd; So.stride = W; So.c = c - nleft; } }
    if (SUB == 2) { do_dn = true; So.npn = 4; So.first = yd; So.end = ntile * 4; So.stride = G; So.c = c; }
    if (do_gu) { pg8::EpiMoeH E{K.H1()};
        pg8::gemm_phase_moe<pg8::EpiMoeH, pg8::MoeSched, true, 512, D>(F.lds, K.XN(), K.WguT() + (size_t)l * NE * 512 * D, K.slot_tok(), So, E, F.wave); }
    if (do_dn) { pg8::EpiMoeY E{K.Y()};
        pg8::gemm_phase_moe<pg8::EpiMoeY, pg8::MoeSched, false, D, DE>(F.lds, K.H1(), K.WdT() + (size_t)l * NE * D * DE, nullptr, So, E, F.wave); }
}
__device__ __forceinline__ void phase_combine(Frame& F, int l) {
    const KA K = KA::fresh(); PHASE_TID;
    const bool last = (l == DEPTH - 1);
    const float* gain = last ? K.in(19) : (K.in(1) + (size_t)(l + 1) * D);
#pragma unroll 1
    for (int t = F.bx * NWAVES + wave; t < T; t += F.G * NWAVES) {
        const int s0 = K.slot_of()[2 * t], s1 = K.slot_of()[2 * t + 1]; const float w0 = K.ew()[2 * t], w1 = K.ew()[2 * t + 1];
        v2u* xr = (v2u*)(K.XR() + (size_t)t * D) + lane;
        const v2u* y0 = (const v2u*)(K.Y() + (size_t)s0 * D) + lane; const v2u* y1 = (const v2u*)(K.Y() + (size_t)s1 * D) + lane;
        f32x4 v[4]; float s = 0.f;
#pragma unroll
        for (int j = 0; j < 4; ++j) { const v2u xw = xr[64 * j], a = y0[64 * j], b = y1[64 * j];
            v[j].x = bflo(xw.x) + w0 * bflo(a.x) + w1 * bflo(b.x); v[j].y = bfhi(xw.x) + w0 * bfhi(a.x) + w1 * bfhi(b.x); v[j].z = bflo(xw.y) + w0 * bflo(a.y) + w1 * bflo(b.y); v[j].w = bfhi(xw.y) + w0 * bfhi(a.y) + w1 * bfhi(b.y);
            s += (v[j].x * v[j].x + v[j].y * v[j].y) + (v[j].z * v[j].z + v[j].w * v[j].w); }
        const float rs = rsqrtf(wave_sum(s) * (1.f / D) + EPS);
        if (last) {
            f32x4* orow = (f32x4*)(K.out() + (size_t)t * D) + lane;
#pragma unroll
            for (int j = 0; j < 4; ++j) { const f32x4 g = ((const f32x4*)gain)[lane + 64 * j]; orow[64 * j] = (f32x4){v[j].x * rs * g.x, v[j].y * rs * g.y, v[j].z * rs * g.z, v[j].w * rs * g.w}; }
        } else {
            v2u* o8 = (v2u*)(K.XN() + (size_t)t * D) + lane;
#pragma unroll
            for (int j = 0; j < 4; ++j) { xr[64 * j] = (v2u){pk2(v[j].x, v[j].y), pk2(v[j].z, v[j].w)}; const f32x4 g = ((const f32x4*)gain)[lane + 64 * j];
                o8[64 * j] = (v2u){pk2(v[j].x * rs * g.x, v[j].y * rs * g.y), pk2(v[j].z * rs * g.z, v[j].w * rs * g.w)}; }
        }
    }
}

struct Args { const float* in[20]; float* out; unsigned char* ws; };
__global__ void __launch_bounds__(NT, 2) fwd_kernel(Args args) {
    extern __shared__ __attribute__((aligned(16))) unsigned char lds_raw[];
    Frame F;
    F.lds = (LAS unsigned char*)lds_raw; F.smem = (float*)lds_raw;
    F.G = gridDim.x; F.bx = blockIdx.x; F.wave = __builtin_amdgcn_readfirstlane(threadIdx.x >> 6);
    volatile LAS unsigned* MISC = (volatile LAS unsigned*)(F.lds + MISC_OFF);
    for (int u = threadIdx.x; u < (LDS_BYTES - LDSCTL_OFF) / 4; u += NT) ((LAS unsigned*)(F.lds + LDSCTL_OFF))[u] = 0u;
    __syncthreads();
    XcdBarrier bar; { const KA K = KA::fresh(); bar = xcd_barrier_post(K.ctl() + CW_BAR, MISC + 8); }
#define GRID_BAR() xcd_barrier(bar)

    p0_prologue(F);
    GRID_BAR();
    for (int l = 0; l < DEPTH; ++l) {
        {
            const KA K = KA::fresh(); PHASE_TID;
            pg8::Gemm g{K.XN(), K.WinT() + (size_t)l * PLD * D, T, PLD, D}; pg8::StaticOrder So; int c_ = F.bx; asm volatile("" : "+s"(c_)); So.init(T, PLD, F.G, c_);
            pg8::EpiBf16Plain E{K.P(), PLD};
            pg8::gemm_phase<pg8::EpiBf16Plain, pg8::StaticOrder, PG8_ALIGN, PG8_SP2>(F.lds, g, So, E, F.wave);
        }
        GRID_BAR();
        phase_gla_A2(F, l);
        phase_gmlp_mfma(F, l);
        phase_conv(F, l);
        GRID_BAR();
        phase_gla_aggscan(F);
        GRID_BAR();
        phase_gla_C2(F, l);
        GRID_BAR();
        {
            const KA K = KA::fresh(); PHASE_TID;
            pg8::Gemm g{K.XN(), K.WoutT() + (size_t)l * D * D, T, D, D}; pg8::StaticOrder So; int c_ = F.bx; asm volatile("" : "+s"(c_)); So.init(T, D, F.G, c_);
            if (l == 0) { pg8::EpiBf16Res<true> E{K.XR(), K.in(0), D}; pg8::gemm_phase<pg8::EpiBf16Res<true>, pg8::StaticOrder, PG8_ALIGN, PG8_SP2>(F.lds, g, So, E, F.wave); }
            else { pg8::EpiBf16Res<false> E{K.XR(), K.XR(), D}; pg8::gemm_phase<pg8::EpiBf16Res<false>, pg8::StaticOrder, PG8_ALIGN, PG8_SP2>(F.lds, g, So, E, F.wave); }
        }
        GRID_BAR();
        phase_norm_router_mfma(F, l);
        GRID_BAR();
        phase_scatter(F, l);
        GRID_BAR();
        phase_moe<0>(F, l);
        GRID_BAR();
        phase_moe<1>(F, l);
        GRID_BAR();
        phase_moe<2>(F, l);
        GRID_BAR();
        phase_combine(F, l);
        if (l + 1 < DEPTH) GRID_BAR();
    }
}

extern "C" void kernel_launch(void* const* d_in, const int* in_sizes, int n_in, void* d_out, int out_size, void* d_ws, size_t ws_size, hipStream_t stream) {
    static int grid_blocks = 0;
    if (!grid_blocks) {
        int dev = 0, cus = 0, per_cu = 0;
        (void)hipGetDevice(&dev);
        (void)hipDeviceGetAttribute(&cus, hipDeviceAttributeMultiprocessorCount, dev);
        (void)hipFuncSetAttribute((const void*)fwd_kernel, hipFuncAttributeMaxDynamicSharedMemorySize, LDS_BYTES);
        (void)hipOccupancyMaxActiveBlocksPerMultiprocessor(&per_cu, fwd_kernel, NT, LDS_BYTES);
        if (per_cu < 1) { fprintf(stderr, "kernel_launch: occupancy query says %d blocks/CU\n", per_cu); per_cu = 1; }
        grid_blocks = cus;
        if (ws_size < WS_END) { fprintf(stderr, "kernel_launch: workspace too small (%zu < %zu)\n", ws_size, (size_t)WS_END); grid_blocks = -1; }
    }
    if (grid_blocks < 0) return;
    (void)hipMemsetAsync((char*)d_ws + WS_CTL, 0, 131072, stream);
    Args a{};
    for (int i = 0; i < 20; ++i) a.in[i] = (const float*)d_in[i];
    a.out = (float*)d_out; a.ws = (unsigned char*)d_ws;
    void* args[] = {&a};
    hipError_t e = hipLaunchCooperativeKernel((void*)fwd_kernel, dim3(grid_blocks), dim3(NT), args, LDS_BYTES, stream);
    if (e != hipSuccess) fprintf(stderr, "cooperative launch failed: %s (grid %d)\n", hipGetErrorString(e), grid_blocks);
}
```

```cpp
#include <hip/hip_runtime.h>
#include <hip/hip_cooperative_groups.h>
#include <cstdio>
#include <cstdint>
namespace cg = cooperative_groups;
__device__ __forceinline__ int fresh_lane() { unsigned m = 0xffffffffu; asm volatile("" : "+s"(m)); return (int)__builtin_amdgcn_mbcnt_hi(m, __builtin_amdgcn_mbcnt_lo(m, 0u)); }
__device__ __forceinline__ float shx(float v, int o) { return __int_as_float(__builtin_amdgcn_ds_bpermute((fresh_lane() ^ o) << 2, __float_as_int(v))); }
__device__ __forceinline__ int dpp_x1(int v) { return __builtin_amdgcn_update_dpp(v, v, 0xB1, 0xF, 0xF, false); }
__device__ __forceinline__ int dpp_x2(int v) { return __builtin_amdgcn_update_dpp(v, v, 0x4E, 0xF, 0xF, false); }
__device__ __forceinline__ int dpp_hm(int v) { return __builtin_amdgcn_update_dpp(v, v, 0x141, 0xF, 0xF, false); }
__device__ __forceinline__ int dpp_rm(int v) { return __builtin_amdgcn_update_dpp(v, v, 0x140, 0xF, 0xF, false); }
__device__ __forceinline__ float dppf_x1(float v) { return __int_as_float(dpp_x1(__float_as_int(v))); }
__device__ __forceinline__ float dppf_x2(float v) { return __int_as_float(dpp_x2(__float_as_int(v))); }
__device__ __forceinline__ float dppf_hm(float v) { return __int_as_float(dpp_hm(__float_as_int(v))); }
__device__ __forceinline__ float dppf_rm(float v) { return __int_as_float(dpp_rm(__float_as_int(v))); }
__device__ __forceinline__ float sum8(float v) { v += dppf_x1(v); v += dppf_x2(v); v += dppf_hm(v); return v; }
__device__ __forceinline__ float sum16(float v) { v = sum8(v); v += dppf_rm(v); return v; }
namespace pg8 {
#define PG8_LAS __attribute__((address_space(3)))
typedef unsigned short bf16_t;
typedef short bf16x8 __attribute__((ext_vector_type(8)));
typedef float f32x4 __attribute__((ext_vector_type(4)));
typedef unsigned u32x4 __attribute__((ext_vector_type(4)));
constexpr int BM = 256, BK = 64, HALF = 128, HTB = HALF * BK * 2  , STAGE_BYTES = 8 * HTB, NXCD = 8, WGM = 8;

__host__ __device__ __forceinline__ int lds_byte(int r, int c) { const int st = (r >> 4) * 2 + (c >> 5), rr = r & 15, cc = c & 31, ob = rr * 64 + cc * 2; return st * 1024 + (ob ^ (((ob >> 9) & 1) << 5)); }
__host__ __device__ __forceinline__ void stage_rc(int b, int& R, int& C) { const int st = b / 1024, sb = b % 1024, swz = sb ^ (((sb >> 9) & 1) << 5); R = (st >> 1) * 16 + swz / 64; C = (st & 1) * 32 + (swz % 64) / 2; }
__host__ __device__ __forceinline__ int perm32(int rho) { const int n = rho >> 4, i = rho & 15; return 8 * (i >> 2) + 4 * n + (i & 3); }

struct Unit { int pm, pn; };
struct Gemm { const bf16_t* A; const bf16_t* Bt; int M, N, K; };

struct StaticOrder {
    int nM, nN, nwg, G, c;
    __host__ __device__ void init(int M, int N, int G_, int c_) { nM = M / BM; nN = N / BM; nwg = nM * nN; G = G_; c = c_; }
    __host__ __device__ bool next(int i, Unit& u) const {
        const long L = (long)i * G + c; if (L >= nwg) return false;
        int wgid = (int)L; { const int q = nwg / NXCD, r = nwg % NXCD, xcd = wgid % NXCD, off = wgid / NXCD; wgid = (xcd < r ? xcd * (q + 1) : r * (q + 1) + (xcd - r) * q) + off; }
        const int nig = WGM * nN, gid = wgid / nig, fm = gid * WGM, gsz = (nM - fm) < WGM ? (nM - fm) : WGM;
        u.pm = fm + ((wgid % nig) % gsz); u.pn = (wgid % nig) / gsz; return true;
    }
    __device__ __forceinline__ void a_ready(const Unit&) const {}
    __device__ __forceinline__ void done(const Unit&) const {}
};


__device__ __forceinline__ unsigned cvt_pk_bf16(float lo, float hi) { unsigned r; asm volatile("v_cvt_pk_bf16_f32 %0, %1, %2" : "=v"(r) : "v"(lo), "v"(hi)); return r; }
struct EpiBf16Plain {
    static constexpr bool PERM = true, AFTER_DRAIN = false;
    bf16_t* O; int ldc;
    __device__ __forceinline__ void operator()(const f32x4 (&acc)[2][2][4][2], const Unit& u, int wr, int wc, int fr, int fq) const {
        const int row0 = u.pm * BM + wr * 64 + fr, col0 = u.pn * BM + wc * 32 + 8 * fq;
#pragma unroll
        for (int ai = 0; ai < 2; ++ai)
#pragma unroll
            for (int m = 0; m < 4; ++m) { bf16_t* rowp = O + (size_t)(row0 + ai * HALF + m * 16) * ldc + col0;
#pragma unroll
                for (int bj = 0; bj < 2; ++bj) { const f32x4 v0 = acc[ai][bj][m][0], v1 = acc[ai][bj][m][1];
                    u32x4 w; w.x = cvt_pk_bf16(v0[0], v0[1]); w.y = cvt_pk_bf16(v0[2], v0[3]); w.z = cvt_pk_bf16(v1[0], v1[1]); w.w = cvt_pk_bf16(v1[2], v1[3]);
                    *(u32x4*)(rowp + bj * HALF) = w; } }
    }
};
template <bool RES_F32>
struct EpiBf16Res {
    static constexpr bool PERM = true, AFTER_DRAIN = false;
    bf16_t* O; const void* R; int ldc;
    __device__ __forceinline__ void operator()(const f32x4 (&acc)[2][2][4][2], const Unit& u, int wr, int wc, int fr, int fq) const {
        const int row0 = u.pm * BM + wr * 64 + fr, col0 = u.pn * BM + wc * 32 + 8 * fq;
#pragma unroll
        for (int ai = 0; ai < 2; ++ai)
#pragma unroll
            for (int m = 0; m < 4; ++m) { const size_t off = (size_t)(row0 + ai * HALF + m * 16) * ldc + col0;
#pragma unroll
                for (int bj = 0; bj < 2; ++bj) { f32x4 v0 = acc[ai][bj][m][0], v1 = acc[ai][bj][m][1];
                    if (RES_F32) { const float* rp = (const float*)R + off + bj * HALF; v0 += *(const f32x4*)rp; v1 += *(const f32x4*)(rp + 4); }
                    else { const u32x4 rw = *(const u32x4*)((const bf16_t*)R + off + bj * HALF);
                        v0[0] += __uint_as_float(rw.x << 16); v0[1] += __uint_as_float(rw.x & 0xffff0000u); v0[2] += __uint_as_float(rw.y << 16); v0[3] += __uint_as_float(rw.y & 0xffff0000u);
                        v1[0] += __uint_as_float(rw.z << 16); v1[1] += __uint_as_float(rw.z & 0xffff0000u); v1[2] += __uint_as_float(rw.w << 16); v1[3] += __uint_as_float(rw.w & 0xffff0000u); }
                    u32x4 w; w.x = cvt_pk_bf16(v0[0], v0[1]); w.y = cvt_pk_bf16(v0[2], v0[3]); w.z = cvt_pk_bf16(v1[0], v1[1]); w.w = cvt_pk_bf16(v1[2], v1[3]);
                    *(u32x4*)(O + off + bj * HALF) = w; } }
    }
};
struct EpiF32Res {
    static constexpr bool PERM = false, AFTER_DRAIN = false;
    float* C; const float* R; int ldc;
    __device__ __forceinline__ void operator()(const f32x4 (&acc)[2][2][4][2], const Unit& u, int wr, int wc, int fr, int fq) const {
        const int row0 = u.pm * BM + wr * 64 + fr, col0 = u.pn * BM + wc * 32 + 4 * fq;
#pragma unroll
        for (int ai = 0; ai < 2; ++ai)
#pragma unroll
            for (int m = 0; m < 4; ++m) { const size_t off = (size_t)(row0 + ai * HALF + m * 16) * ldc + col0;
#pragma unroll
                for (int bj = 0; bj < 2; ++bj)
#pragma unroll
                    for (int n = 0; n < 2; ++n) { const f32x4 r = *(const f32x4*)(R + off + bj * HALF + n * 16); *(f32x4*)(C + off + bj * HALF + n * 16) = r + acc[ai][bj][m][n]; } }
    }
};
template <class Epi, class Sched, bool ALIGN_EPI = false, bool SP2 = false>
__device__ __forceinline__ void gemm_phase(PG8_LAS unsigned char* lds, const Gemm g, const Sched& S, const Epi& E, int wave_id) {
    asm volatile("" : "+s"(wave_id));
    const int lane = fresh_lane(), wid = wave_id, tid = wid * 64 + lane, wr = wid >> 2, wc = wid & 3, fr = lane & 15, fq = lane >> 4;
    const int K = g.K, nt = K / BK;
    unsigned voffA[2], voffB[2];
#pragma unroll
    for (int i = 0; i < 2; ++i) { int R, C; stage_rc(tid * 16 + i * 8192, R, C); const int Rb = Epi::PERM ? ((R & ~31) + perm32(R & 31)) : R;
        voffA[i] = (unsigned)(R * K + C) * 2u; voffB[i] = (unsigned)(Rb * K + C) * 2u; }
    const size_t kstep = (size_t)(BK * 2);
    const size_t hstep = (size_t)HALF * K * 2;
    const size_t tstep = 2 * hstep;
    const unsigned ldsw = (unsigned)wid * 1024u;
    const int aoff = lds_byte(wr * 64 + fr, fq * 8), boff = lds_byte(wc * 32 + fr, fq * 8);
#define PG8_SA(b, h) (((b) * 2 + (h)) * HTB)
#define PG8_SB(b, h) ((4 + (b) * 2 + (h)) * HTB)
#define PG8_STAGE(bufoff, gbase, voff) do { _Pragma("unroll") for (int _i = 0; _i < 2; ++_i) \
        __builtin_amdgcn_global_load_lds((const unsigned*)((const char*)(gbase) + (voff)[_i]), (PG8_LAS unsigned*)(lds + (bufoff) + ldsw + _i * 8192), 16, 0, 0); } while (0)
#define PG8_LDA(dst, b, h) do { _Pragma("unroll") for (int m = 0; m < 4; ++m) _Pragma("unroll") for (int k = 0; k < 2; ++k) dst[m][k] = *(const PG8_LAS bf16x8*)(lds + PG8_SA(b, h) + aoff + m * 2048 + k * 1024); } while (0)
#define PG8_LDB(dst, b, h) do { _Pragma("unroll") for (int n = 0; n < 2; ++n) _Pragma("unroll") for (int k = 0; k < 2; ++k) dst[n][k] = *(const PG8_LAS bf16x8*)(lds + PG8_SB(b, h) + boff + n * 2048 + k * 1024); } while (0)
#define PG8_MMA(ai, bj, At, Bt) do { __builtin_amdgcn_s_setprio(1); _Pragma("unroll") for (int m = 0; m < 4; ++m) _Pragma("unroll") for (int n = 0; n < 2; ++n) _Pragma("unroll") for (int k = 0; k < 2; ++k) \
        acc[ai][bj][m][n] = __builtin_amdgcn_mfma_f32_16x16x32_bf16(Bt[n][k], At[m][k], acc[ai][bj][m][n], 0, 0, 0); __builtin_amdgcn_s_setprio(0); } while (0)
#define PG8_WAIT_V(n) asm volatile("s_waitcnt vmcnt(" #n ")" ::: "memory")
#define PG8_WAIT_L(n) asm volatile("s_waitcnt lgkmcnt(" #n ")" ::: "memory")
#define PG8_BAR __builtin_amdgcn_s_barrier()
#define PG8_SCHED __builtin_amdgcn_sched_barrier(0)
    Unit cur, nxt; int ui = 0;
    if (!S.next(0, cur)) return;
    f32x4 acc[2][2][4][2];
#pragma unroll
    for (int a = 0; a < 2; ++a)
#pragma unroll
        for (int b = 0; b < 2; ++b)
#pragma unroll
            for (int m = 0; m < 4; ++m)
#pragma unroll
                for (int n = 0; n < 2; ++n) acc[a][b][m][n] = (f32x4){0.f, 0.f, 0.f, 0.f};
    bf16x8 At[4][2], B0[2][2], B1[2][2];
    const char* cA = (const char*)g.A + (size_t)cur.pm * tstep; const char* cB = (const char*)g.Bt + (size_t)cur.pn * tstep;
    S.a_ready(cur);
    if constexpr (SP2) {
        PG8_STAGE(PG8_SB(0, 0), cB, voffB); PG8_STAGE(PG8_SB(0, 1), cB + hstep, voffB); PG8_STAGE(PG8_SA(0, 0), cA, voffA); PG8_STAGE(PG8_SA(0, 1), cA + hstep, voffA);
        if (wr == 1) PG8_BAR;
        PG8_WAIT_V(2); PG8_BAR;
        PG8_STAGE(PG8_SB(1, 0), cB + kstep, voffB); PG8_STAGE(PG8_SA(1, 0), cA + kstep, voffA); PG8_STAGE(PG8_SB(1, 1), cB + hstep + kstep, voffB);
        PG8_WAIT_V(6); PG8_BAR;
    } else {
        PG8_STAGE(PG8_SB(0, 0), cB, voffB); PG8_STAGE(PG8_SA(0, 0), cA, voffA); PG8_STAGE(PG8_SB(0, 1), cB + hstep, voffB); PG8_STAGE(PG8_SA(0, 1), cA + hstep, voffA);
        if (wr == 1) PG8_BAR;
        PG8_WAIT_V(4); PG8_BAR;
        PG8_STAGE(PG8_SB(1, 0), cB + kstep, voffB); PG8_STAGE(PG8_SA(1, 0), cA + kstep, voffA); PG8_STAGE(PG8_SB(1, 1), cB + hstep + kstep, voffB);
        PG8_WAIT_V(6); PG8_BAR;
    }
    for (;;) {
        const bool has_next = S.next(ui + 1, nxt);
        const char* nA = has_next ? (const char*)g.A + (size_t)nxt.pm * tstep : cA; const char* nB = has_next ? (const char*)g.Bt + (size_t)nxt.pn * tstep : cB;
        for (int t = 0; t < nt; t += 2) {
            const bool last = (t == nt - 2);
            const char* a1 = cA + (size_t)(t + 1) * kstep;
            const char* a2 = last ? nA : cA + (size_t)(t + 2) * kstep; const char* b2 = last ? nB : cB + (size_t)(t + 2) * kstep;
            const char* a3 = a2 + kstep; const char* b3 = b2 + kstep;
            if (last && has_next) S.a_ready(nxt);
            if constexpr (SP2) {
            PG8_LDB(B0, 0, 0); PG8_LDB(B1, 0, 1); PG8_SCHED; PG8_LDA(At, 0, 0); PG8_STAGE(PG8_SA(1, 1), a1 + hstep, voffA);
            PG8_WAIT_V(8); PG8_WAIT_L(0); PG8_BAR; PG8_MMA(0, 0, At, B0); PG8_MMA(0, 1, At, B1); PG8_BAR; PG8_SCHED;
            PG8_LDA(At, 0, 1); PG8_STAGE(PG8_SB(0, 0), b2, voffB); PG8_STAGE(PG8_SB(0, 1), b2 + hstep, voffB); PG8_STAGE(PG8_SA(0, 0), a2, voffA);
            PG8_WAIT_V(8); PG8_WAIT_L(0); PG8_BAR; PG8_MMA(1, 0, At, B0); PG8_MMA(1, 1, At, B1); PG8_BAR; PG8_SCHED;
            PG8_LDB(B0, 1, 0); PG8_LDB(B1, 1, 1); PG8_SCHED; PG8_LDA(At, 1, 0); PG8_STAGE(PG8_SA(0, 1), a2 + hstep, voffA);
            PG8_WAIT_V(8); PG8_WAIT_L(0); PG8_BAR; PG8_MMA(0, 0, At, B0); PG8_MMA(0, 1, At, B1); PG8_BAR; PG8_SCHED;
            PG8_LDA(At, 1, 1); PG8_STAGE(PG8_SB(1, 0), b3, voffB); PG8_STAGE(PG8_SB(1, 1), b3 + hstep, voffB); PG8_STAGE(PG8_SA(1, 0), a3, voffA);
            PG8_WAIT_V(8); PG8_WAIT_L(0); PG8_BAR; PG8_MMA(1, 0, At, B0); PG8_MMA(1, 1, At, B1); PG8_BAR; PG8_SCHED;
            } else {
            PG8_LDB(B0, 0, 0); PG8_SCHED; PG8_LDA(At, 0, 0); PG8_STAGE(PG8_SA(1, 1), a1 + hstep, voffA);
            PG8_WAIT_L(8); PG8_BAR; PG8_WAIT_L(0); PG8_MMA(0, 0, At, B0); PG8_BAR; PG8_SCHED;
            PG8_LDB(B1, 0, 1); PG8_STAGE(PG8_SB(0, 0), b2, voffB);
            PG8_BAR; PG8_WAIT_L(0); PG8_MMA(0, 1, At, B1); PG8_BAR;
            PG8_LDA(At, 0, 1); PG8_STAGE(PG8_SA(0, 0), a2, voffA);
            PG8_BAR; PG8_WAIT_L(0); PG8_MMA(1, 0, At, B0); PG8_BAR; PG8_SCHED;
            PG8_STAGE(PG8_SB(0, 1), b2 + hstep, voffB);
            PG8_WAIT_V(6); PG8_BAR; PG8_MMA(1, 1, At, B1); PG8_BAR;
            PG8_LDB(B0, 1, 0); PG8_SCHED; PG8_LDA(At, 1, 0); PG8_STAGE(PG8_SA(0, 1), a2 + hstep, voffA);
            PG8_WAIT_L(8); PG8_BAR; PG8_WAIT_L(0); PG8_MMA(0, 0, At, B0); PG8_BAR; PG8_SCHED;
            PG8_LDB(B1, 1, 1); PG8_STAGE(PG8_SB(1, 0), b3, voffB);
            PG8_BAR; PG8_WAIT_L(0); PG8_MMA(0, 1, At, B1); PG8_BAR;
            PG8_LDA(At, 1, 1); PG8_STAGE(PG8_SA(1, 0), a3, voffA);
            PG8_BAR; PG8_WAIT_L(0); PG8_MMA(1, 0, At, B0); PG8_BAR; PG8_SCHED;
            PG8_STAGE(PG8_SB(1, 1), b3 + hstep, voffB);
            PG8_WAIT_V(6); PG8_BAR; PG8_MMA(1, 1, At, B1); PG8_BAR;
            }
        }
        if constexpr (ALIGN_EPI) { if (wr == 0) PG8_BAR; }
        if constexpr (!Epi::AFTER_DRAIN) { E(acc, cur, wr, wc, fr, fq); S.done(cur); }
        if (!has_next) break;
#pragma unroll
        for (int a = 0; a < 2; ++a)
#pragma unroll
            for (int b = 0; b < 2; ++b)
#pragma unroll
                for (int m = 0; m < 4; ++m)
#pragma unroll
                    for (int n = 0; n < 2; ++n) acc[a][b][m][n] = (f32x4){0.f, 0.f, 0.f, 0.f};
        cur = nxt; cA = nA; cB = nB; ++ui;
        if constexpr (ALIGN_EPI) { if (wr == 1) PG8_BAR; }
    }
    PG8_WAIT_V(0);
    if constexpr (!ALIGN_EPI) { if (wr == 0) PG8_BAR; }
    PG8_BAR;
    if constexpr (Epi::AFTER_DRAIN) { E.fused(acc, cur, wr, wc, fr, fq, lds, wid, lane); S.done(cur); }
#undef PG8_SA
#undef PG8_SB
#undef PG8_STAGE
#undef PG8_LDA
#undef PG8_LDB
#undef PG8_MMA
#undef PG8_WAIT_V
#undef PG8_WAIT_L
#undef PG8_BAR
#undef PG8_SCHED
}

struct MUnit { int r0, rend, e, pn; };
#define MG_LANE_OFFS(u, o) do { const int _t = wid * 64 + fresh_lane(); _Pragma("unroll") for (int _i = 0; _i < 2; ++_i) { int _R, _C; stage_rc(_t * 16 + _i * 8192, _R, _C); _Pragma("unroll") for (int _h = 0; _h < 2; ++_h) { const int _r = (u).r0 + _h * HALF + _R; \
        int _row = _r; if (GATHER) { _row = 0; if (_r < (u).rend) _row = slot_tok[_r]; } (o)[_h][_i] = (unsigned)(_row * K + _C) * 2u; } } } while (0)
template <class Epi, class Sched, bool GATHER, int N, int K>
__device__ __forceinline__ void gemm_phase_moe(PG8_LAS unsigned char* lds, const bf16_t* A, const bf16_t* Bt, const int* slot_tok, const Sched& S, const Epi& E, int wave_id) {
    asm volatile("" : "+s"(wave_id));
    const int lane = fresh_lane(), wid = wave_id, tid = wid * 64 + lane, wr = wid >> 2, wc = wid & 3, fr = lane & 15, fq = lane >> 4;
    constexpr int nt = K / BK;
#define MG_OFFP(par) ((PG8_LAS unsigned*)(lds + STAGE_BYTES + 8192) + (par) * 2048 + tid)
#define MG_VOFFB ((PG8_LAS unsigned*)(lds + STAGE_BYTES + 24576) + tid)
#pragma unroll
    for (int i = 0; i < 2; ++i) { int R, C; stage_rc(tid * 16 + i * 8192, R, C); const int Rb = Epi::PERM ? ((R & ~31) + perm32(R & 31)) : R; MG_VOFFB[i * 512] = (unsigned)(Rb * K + C) * 2u; }
    constexpr size_t kstep = (size_t)(BK * 2);
    constexpr size_t hstep = (size_t)HALF * K * 2;
    constexpr size_t tstep = 2 * hstep;
    constexpr size_t estep = (size_t)N * K * 2;
    const unsigned ldsw = (unsigned)wid * 1024u;
    const int aoff = lds_byte(wr * 64 + fr, fq * 8), boff = lds_byte(wc * 32 + fr, fq * 8);
#define PG8_SA(b, h) (((b) * 2 + (h)) * HTB)
#define PG8_SB(b, h) ((4 + (b) * 2 + (h)) * HTB)
#define PG8_STAGE(bufoff, gbase, voff) do { _Pragma("unroll") for (int _i = 0; _i < 2; ++_i) \
        __builtin_amdgcn_global_load_lds((const unsigned*)((const char*)(gbase) + MG_VOFFB[_i * 512]), (PG8_LAS unsigned*)(lds + (bufoff) + ldsw + _i * 8192), 16, 0, 0); } while (0)
#define MG_STAGE_A(bufoff, par, h, kb) do { _Pragma("unroll") for (int _i = 0; _i < 2; ++_i) \
        __builtin_amdgcn_global_load_lds((const unsigned*)((const char*)A + (size_t)MG_OFFP(par)[((h) * 2 + _i) * 512] + (kb)), (PG8_LAS unsigned*)(lds + (bufoff) + ldsw + _i * 8192), 16, 0, 0); } while (0)
#define PG8_LDA(dst, b, h) do { _Pragma("unroll") for (int m = 0; m < 4; ++m) _Pragma("unroll") for (int k = 0; k < 2; ++k) dst[m][k] = *(const PG8_LAS bf16x8*)(lds + PG8_SA(b, h) + aoff + m * 2048 + k * 1024); } while (0)
#define PG8_LDB(dst, b, h) do { _Pragma("unroll") for (int n = 0; n < 2; ++n) _Pragma("unroll") for (int k = 0; k < 2; ++k) dst[n][k] = *(const PG8_LAS bf16x8*)(lds + PG8_SB(b, h) + boff + n * 2048 + k * 1024); } while (0)
#define PG8_MMA(ai, bj, At, Bt_) do { __builtin_amdgcn_s_setprio(1); _Pragma("unroll") for (int m = 0; m < 4; ++m) _Pragma("unroll") for (int n = 0; n < 2; ++n) _Pragma("unroll") for (int k = 0; k < 2; ++k) \
        acc[ai][bj][m][n] = __builtin_amdgcn_mfma_f32_16x16x32_bf16(Bt_[n][k], At[m][k], acc[ai][bj][m][n], 0, 0, 0); __builtin_amdgcn_s_setprio(0); } while (0)
#define PG8_WAIT_V(n) asm volatile("s_waitcnt vmcnt(" #n ")" ::: "memory")
#define PG8_WAIT_L(n) asm volatile("s_waitcnt lgkmcnt(" #n ")" ::: "memory")
#define PG8_BAR __builtin_amdgcn_s_barrier()
#define PG8_SCHED __builtin_amdgcn_sched_barrier(0)
    MUnit cur, nxt; int ui = 0;
    if (!S.next(0, cur)) return;
    f32x4 acc[2][2][4][2];
#pragma unroll
    for (int a = 0; a < 2; ++a)
#pragma unroll
        for (int b = 0; b < 2; ++b)
#pragma unroll
            for (int m = 0; m < 4; ++m)
#pragma unroll
                for (int n = 0; n < 2; ++n) acc[a][b][m][n] = (f32x4){0.f, 0.f, 0.f, 0.f};
    bf16x8 At[4][2], B0[2][2], B1[2][2];
    { unsigned o_[2][2]; MG_LANE_OFFS(cur, o_); PG8_LAS unsigned* p_ = MG_OFFP(0); p_[0] = o_[0][0]; p_[512] = o_[0][1]; p_[1024] = o_[1][0]; p_[1536] = o_[1][1]; }
    const char* cB = (const char*)Bt + (size_t)cur.e * estep + (size_t)cur.pn * tstep;
    PG8_STAGE(PG8_SB(0, 0), cB, voffB); PG8_STAGE(PG8_SB(0, 1), cB + hstep, voffB); MG_STAGE_A(PG8_SA(0, 0), 0, 0, 0); MG_STAGE_A(PG8_SA(0, 1), 0, 1, 0);
    if (wr == 1) PG8_BAR;
    PG8_WAIT_V(2); PG8_BAR;
    PG8_STAGE(PG8_SB(1, 0), cB + kstep, voffB); MG_STAGE_A(PG8_SA(1, 0), 0, 0, kstep); PG8_STAGE(PG8_SB(1, 1), cB + hstep + kstep, voffB);
    PG8_WAIT_V(6); PG8_BAR;
    for (;;) {
        const bool has_next = S.next(ui + 1, nxt);
        const bool hi_rows = (cur.rend - cur.r0) > HALF;
        const char* nB = cB;
        const int pc = ui & 1, pn_ = has_next ? (pc ^ 1) : pc;
        if (has_next) { unsigned on[2][2]; MG_LANE_OFFS(nxt, on); nB = (const char*)Bt + (size_t)nxt.e * estep + (size_t)nxt.pn * tstep;
            PG8_LAS unsigned* p_ = MG_OFFP(pn_); p_[0] = on[0][0]; p_[512] = on[0][1]; p_[1024] = on[1][0]; p_[1536] = on[1][1]; }
        for (int t = 0; t < nt; t += 2) {
            const bool last = (t == nt - 2);
            const size_t k1 = (size_t)(t + 1) * kstep, k2 = last ? (size_t)0 : (size_t)(t + 2) * kstep, k3 = k2 + kstep;
            const char* b2 = last ? nB : cB + (size_t)(t + 2) * kstep; const char* b3 = b2 + kstep;
            const int p2 = last ? pn_ : pc;
            PG8_LDB(B0, 0, 0); PG8_LDB(B1, 0, 1); PG8_SCHED; PG8_LDA(At, 0, 0); MG_STAGE_A(PG8_SA(1, 1), pc, 1, k1);
            PG8_WAIT_V(8); PG8_WAIT_L(0); PG8_BAR; PG8_MMA(0, 0, At, B0); PG8_MMA(0, 1, At, B1); PG8_BAR; PG8_SCHED;
            PG8_LDA(At, 0, 1); PG8_STAGE(PG8_SB(0, 0), b2, voffB); PG8_STAGE(PG8_SB(0, 1), b2 + hstep, voffB); MG_STAGE_A(PG8_SA(0, 0), p2, 0, k2);
            PG8_WAIT_V(8); PG8_WAIT_L(0); PG8_BAR; if (hi_rows) { PG8_MMA(1, 0, At, B0); PG8_MMA(1, 1, At, B1); } PG8_BAR; PG8_SCHED;
            PG8_LDB(B0, 1, 0); PG8_LDB(B1, 1, 1); PG8_SCHED; PG8_LDA(At, 1, 0); MG_STAGE_A(PG8_SA(0, 1), p2, 1, k2);
            PG8_WAIT_V(8); PG8_WAIT_L(0); PG8_BAR; PG8_MMA(0, 0, At, B0); PG8_MMA(0, 1, At, B1); PG8_BAR; PG8_SCHED;
            PG8_LDA(At, 1, 1); PG8_STAGE(PG8_SB(1, 0), b3, voffB); PG8_STAGE(PG8_SB(1, 1), b3 + hstep, voffB); MG_STAGE_A(PG8_SA(1, 0), p2, 0, k3);
            PG8_WAIT_V(8); PG8_WAIT_L(0); PG8_BAR; if (hi_rows) { PG8_MMA(1, 0, At, B0); PG8_MMA(1, 1, At, B1); } PG8_BAR; PG8_SCHED;
        }
        if (wr == 0) PG8_BAR;
        E(acc, cur, wr, wc, fr, fq);
        if (!has_next) break;
#pragma unroll
        for (int a = 0; a < 2; ++a)
#pragma unroll
            for (int b = 0; b < 2; ++b)
#pragma unroll
                for (int m = 0; m < 4; ++m)
#pragma unroll
                    for (int n = 0; n < 2; ++n) acc[a][b][m][n] = (f32x4){0.f, 0.f, 0.f, 0.f};
        cur = nxt; cB = nB; ++ui;
        if (wr == 1) PG8_BAR;
    }
    PG8_WAIT_V(0);
    PG8_BAR;
#undef PG8_SA
#undef PG8_SB
#undef PG8_STAGE
#undef MG_STAGE_A
#undef MG_OFFP
#undef MG_VOFFB
#undef PG8_LDA
#undef PG8_LDB
#undef PG8_MMA
#undef PG8_WAIT_V
#undef PG8_WAIT_L
#undef PG8_BAR
#undef PG8_SCHED
}
__device__ __forceinline__ float fast_silu(float x) { return x * __builtin_amdgcn_rcpf(1.0f + __builtin_amdgcn_exp2f(-1.4426950408889634f * x)); }
struct EpiMoeH {
    static constexpr bool PERM = true;
    bf16_t* H;
    __device__ __forceinline__ void operator()(const f32x4 (&acc)[2][2][4][2], const MUnit& u, int wr, int wc, int fr, int fq) const {
        { const int t_ = fresh_lane(); fr = t_ & 15; fq = t_ >> 4; }
        const int col0 = u.pn * 128 + wc * 32 + 8 * fq;
#pragma unroll
        for (int ai = 0; ai < 2; ++ai)
#pragma unroll
            for (int m = 0; m < 4; ++m) { const int r = u.r0 + ai * HALF + wr * 64 + m * 16 + fr;
                const f32x4 g0 = acc[ai][0][m][0], g1 = acc[ai][0][m][1], u0 = acc[ai][1][m][0], u1 = acc[ai][1][m][1];
                u32x4 w; w.x = cvt_pk_bf16(fast_silu(g0[0]) * u0[0], fast_silu(g0[1]) * u0[1]); w.y = cvt_pk_bf16(fast_silu(g0[2]) * u0[2], fast_silu(g0[3]) * u0[3]);
                w.z = cvt_pk_bf16(fast_silu(g1[0]) * u1[0], fast_silu(g1[1]) * u1[1]); w.w = cvt_pk_bf16(fast_silu(g1[2]) * u1[2], fast_silu(g1[3]) * u1[3]);
                if (r < u.rend) *(u32x4*)(H + (size_t)r * 256 + col0) = w; }
    }
};
struct EpiMoeY {
    static constexpr bool PERM = true;
    bf16_t* Y;
    __device__ __forceinline__ void operator()(const f32x4 (&acc)[2][2][4][2], const MUnit& u, int wr, int wc, int fr, int fq) const {
        { const int t_ = fresh_lane(); fr = t_ & 15; fq = t_ >> 4; }
        const int col0 = u.pn * BM + wc * 32 + 8 * fq;
#pragma unroll
        for (int ai = 0; ai < 2; ++ai)
#pragma unroll
            for (int m = 0; m < 4; ++m) { const int r = u.r0 + ai * HALF + wr * 64 + m * 16 + fr;
#pragma unroll
                for (int bj = 0; bj < 2; ++bj) { const f32x4 v0 = acc[ai][bj][m][0], v1 = acc[ai][bj][m][1];
                    u32x4 w; w.x = cvt_pk_bf16(v0[0], v0[1]); w.y = cvt_pk_bf16(v0[2], v0[3]); w.z = cvt_pk_bf16(v1[0], v1[1]); w.w = cvt_pk_bf16(v1[2], v1[3]);
                    if (r < u.rend) *(u32x4*)(Y + (size_t)r * 1024 + col0 + bj * HALF) = w; } }
    }
};
struct MoeSched {
    const PG8_LAS int* tab;
    int npn, first, end, stride, c;
    __device__ __forceinline__ bool next(int i, MUnit& u) const {
        const int L = first + c + i * stride;
        if (c < 0 || L >= end) return false;
        const int j = L / npn; u.pn = L % npn;
        u.e = __builtin_amdgcn_readfirstlane(tab[4 + 4 * j]); u.r0 = __builtin_amdgcn_readfirstlane(tab[5 + 4 * j]); u.rend = __builtin_amdgcn_readfirstlane(tab[6 + 4 * j]);
        return true;
    }
};
}

#ifndef PG8_SP2
#define PG8_SP2 true
#endif
#ifndef PG8_ALIGN
#define PG8_ALIGN true
#endif

constexpr int NWAVES = 8, NT = NWAVES * 64;
constexpr int D = 1024, NB = 2, S = 8192, T = NB * S, DEPTH = 2;
constexpr int DIN = 2832, PLD = 3072;
constexpr int C_Q = 0, C_K = 256, C_V = 512, C_G = 1024, C_GK = 1536, C_U = 1552, C_VG = 1808, C_XI = 2064, C_BG = 2320, C_CG = 2576;
constexpr int GH = 4, GC = 64, GN = S / GC;
constexpr int MH = 4, MC = 128, MN = S / MC;
constexpr int NE = 32, DE = 256;
constexpr float EPS = 1e-6f;
constexpr size_t MiB = 1u << 20;
constexpr size_t WS_CTL = 0, CTL_BYTES = 1 * MiB;
constexpr size_t WS_WIN = 1 * MiB;
constexpr size_t WS_WOUT = 13 * MiB;
constexpr size_t WS_WGU = 17 * MiB;
constexpr size_t WS_WD = 81 * MiB;
constexpr size_t WS_XN = 113 * MiB;
constexpr size_t WS_P = 145 * MiB;
constexpr size_t WS_Y = WS_P + 17 * MiB;
constexpr size_t WS_S = 276 * MiB;
constexpr size_t WS_XRES = 241 * MiB;
constexpr size_t WS_DEC = 273 * MiB;
constexpr size_t WS_MISC = 274 * MiB;
constexpr size_t WS_WSP = WS_MISC + 524288;
constexpr size_t WS_WR = 275 * MiB;
constexpr size_t WS_BLKCNT = WS_WR + 524288;
constexpr size_t WS_END = 284 * MiB;
constexpr int CW_BAR = 4096, CW_CNT = 16384;
constexpr int RING_BYTES = 131072, LDSCTL_OFF = RING_BYTES, MISC_OFF = LDSCTL_OFF + 320, LDS_BYTES = 163840;

#define GAS __attribute__((address_space(1)))
#define LAS __attribute__((address_space(3)))
typedef unsigned short bf16;
typedef unsigned v4u __attribute__((ext_vector_type(4)));
typedef unsigned v2u __attribute__((ext_vector_type(2)));
typedef float f32x4 __attribute__((ext_vector_type(4)));
typedef __bf16 bf16x2_t __attribute__((ext_vector_type(2)));
typedef float f32x2_t __attribute__((ext_vector_type(2)));
__device__ __forceinline__ unsigned f2bf(float f) { return (unsigned)__builtin_bit_cast(unsigned short, (__bf16)f); }
__device__ __forceinline__ unsigned pk2(float lo, float hi) { f32x2_t v = {lo, hi}; bf16x2_t b = __builtin_convertvector(v, bf16x2_t); return __builtin_bit_cast(unsigned, b); }
__device__ __forceinline__ float bf2f(unsigned v) { return __uint_as_float(v << 16); }
__device__ __forceinline__ float bflo(unsigned w) { return __uint_as_float(w << 16); }
__device__ __forceinline__ float bfhi(unsigned w) { return __uint_as_float(w & 0xffff0000u); }
__device__ __forceinline__ void unpack8(const v4u q, float (&f)[8]) { f[0] = bflo(q.x); f[1] = bfhi(q.x); f[2] = bflo(q.y); f[3] = bfhi(q.y); f[4] = bflo(q.z); f[5] = bfhi(q.z); f[6] = bflo(q.w); f[7] = bfhi(q.w); }
__device__ __forceinline__ float gelu_tanh(float x) { const float u = 0.7978845608028654f * (x + 0.044715f * x * x * x); return 0.5f * x * (1.0f + tanhf(u)); }
__device__ __forceinline__ float silu(float x) { return x / (1.0f + expf(-x)); }
__device__ __forceinline__ float log_sigmoid(float x) { return fminf(x, 0.f) - log1pf(expf(-fabsf(x))); }

#define XB_TMO      128
#define XB_XCNT(j)  (256  + 64 * (j))
#define XB_XSUB(j)  (1280 + 64 * (j))
#define XB_XGEN(j)  (2304 + 64 * (j))
#define XB_TOP      3328
#define XB_TOPGEN   3392
#define XCD_BAR_WORDS 3456
#define XB_SPIN_CAP (1u << 18)

__device__ __forceinline__ unsigned xb_ld(unsigned* p)              { return __hip_atomic_load(p, __ATOMIC_RELAXED, __HIP_MEMORY_SCOPE_AGENT); }
__device__ __forceinline__ unsigned xb_add(unsigned* p, unsigned v) { return __hip_atomic_fetch_add(p, v, __ATOMIC_RELAXED, __HIP_MEMORY_SCOPE_AGENT); }
__device__ __forceinline__ unsigned xb_xcc_id() { return (unsigned)__builtin_amdgcn_s_getreg((3 << 11) | 20) & 0xFu; }
#define XB_SPIN(cond, bar) do { unsigned _sp = 0; while (cond) { __builtin_amdgcn_s_sleep(1); \
    if ((++_sp & 255u) == 0u) { if (xb_ld(&(bar)[XB_TMO])) break; if (_sp > XB_SPIN_CAP) { atomicAdd(&(bar)[XB_TMO], 1u); break; } } } } while (0)

struct XcdBarrier {
    int wave;
    unsigned* bar; unsigned x;
    volatile LAS unsigned* st;
};

__device__ __forceinline__ XcdBarrier xcd_barrier_post(unsigned* bar, volatile LAS unsigned* st) {
    XcdBarrier b; b.bar = bar; b.x = xb_xcc_id(); b.st = st; b.wave = __builtin_amdgcn_readfirstlane(threadIdx.x >> 6);
    if (threadIdx.x == 0) (void)xb_add(&bar[XB_XCNT(b.x)], 1u);
    return b;
}
__device__ __forceinline__ void xcd_barrier_complete(unsigned* bar, unsigned x, unsigned& nloc, unsigned& nx) {
    const unsigned G = gridDim.x * gridDim.y * gridDim.z;
    unsigned sum, cnt, mine, sp = 0u;
    for (;;) {
        sum = 0u; cnt = 0u; mine = 0u;
#pragma unroll
        for (unsigned j = 0; j < 16; ++j) { const unsigned c = xb_ld(&bar[XB_XCNT(j)]); sum += c; cnt += (c > 0u) ? 1u : 0u; mine = (j == x) ? c : mine; }
        if (sum == G) break;
        __builtin_amdgcn_s_sleep(1);
        if ((++sp & 255u) == 0u) { if (xb_ld(&bar[XB_TMO])) break; if (sp > XB_SPIN_CAP) { atomicAdd(&bar[XB_TMO], 1u); break; } }
    }
    nloc = mine > 0u ? mine : 1u; nx = cnt > 0u ? cnt : 1u;
}

__device__ __forceinline__ void xcd_barrier(const XcdBarrier& b) {
    asm volatile("s_waitcnt vmcnt(0)" ::: "memory");
    __syncthreads();
    if (b.wave == 0 && fresh_lane() == 0) {
        unsigned* bar = b.bar; asm volatile("" : "+s"(bar));
        __builtin_amdgcn_s_waitcnt(0);
        unsigned nloc = b.st[0], nx = b.st[1];
        if (nloc == 0u) { xcd_barrier_complete(bar, b.x, nloc, nx); b.st[0] = nloc; b.st[1] = nx; }
        const unsigned old = xb_add(&bar[XB_XSUB(b.x)], 1u);
        const unsigned gen = old / nloc;
        if (old + 1u == (gen + 1u) * nloc) {
            __builtin_amdgcn_fence(__ATOMIC_RELEASE, "agent");
            asm volatile("s_waitcnt vmcnt(0)" ::: "memory");
            const unsigned og = xb_add(&bar[XB_TOP], 1u);
            const unsigned tg = og / nx;
            if (og + 1u == (tg + 1u) * nx) xb_add(&bar[XB_TOPGEN], 1u);
            else XB_SPIN(xb_ld(&bar[XB_TOPGEN]) == tg, bar);
            __builtin_amdgcn_fence(__ATOMIC_ACQUIRE, "agent");
            xb_add(&bar[XB_XGEN(b.x)], 1u);
            asm volatile("s_waitcnt vmcnt(0)" ::: "memory");
        } else {
            XB_SPIN(xb_ld(&bar[XB_XGEN(b.x)]) == gen, bar);
            __builtin_amdgcn_fence(__ATOMIC_ACQUIRE, "agent");
            asm volatile("s_waitcnt vmcnt(0)" ::: "memory");
        }
    }
    __syncthreads();
}

#define AS4 __attribute__((address_space(4)))
struct KA {
    const AS4 char* ka;
    static __device__ __forceinline__ KA fresh() { KA k; k.ka = (const AS4 char*)__builtin_amdgcn_kernarg_segment_ptr(); asm volatile("" : "+s"(k.ka)); return k; }
    __device__ __forceinline__ const float* in(int i) const { return *(const float* const AS4*)(ka + 8 * i); }
    __device__ __forceinline__ float* out() const { return *(float* const AS4*)(ka + 160); }
    __device__ __forceinline__ unsigned char* ws() const { return *(unsigned char* const AS4*)(ka + 168); }
    __device__ __forceinline__ unsigned* ctl() const { return (unsigned*)(ws() + WS_CTL); }
    __device__ __forceinline__ bf16* WinT() const { return (bf16*)(ws() + WS_WIN); }
    __device__ __forceinline__ bf16* WoutT() const { return (bf16*)(ws() + WS_WOUT); }
    __device__ __forceinline__ bf16* WguT() const { return (bf16*)(ws() + WS_WGU); }
    __device__ __forceinline__ bf16* WdT() const { return (bf16*)(ws() + WS_WD); }
    __device__ __forceinline__ bf16* XN() const { return (bf16*)(ws() + WS_XN); }
    __device__ __forceinline__ bf16* P() const { return (bf16*)(ws() + WS_P); }
    __device__ __forceinline__ bf16* H1() const { return (bf16*)(ws() + WS_P); }
    __device__ __forceinline__ bf16* Y() const { return (bf16*)(ws() + WS_Y); }
    __device__ __forceinline__ float* Sst() const { return (float*)(ws() + WS_S); }
    __device__ __forceinline__ float* dec() const { return (float*)(ws() + WS_DEC); }
    __device__ __forceinline__ int* eid() const { return (int*)(ws() + WS_MISC); }
    __device__ __forceinline__ float* ew() const { return (float*)(ws() + WS_MISC + 131072); }
    __device__ __forceinline__ int* slot_tok() const { return (int*)(ws() + WS_MISC + 2 * 131072); }
    __device__ __forceinline__ int* slot_of() const { return (int*)(ws() + WS_MISC + 3 * 131072); }
    __device__ __forceinline__ bf16* Wsp() const { return (bf16*)(ws() + WS_WSP); }
    __device__ __forceinline__ bf16* Wr() const { return (bf16*)(ws() + WS_WR); }
    __device__ __forceinline__ bf16* XR() const { return (bf16*)(ws() + WS_XRES); }
    __device__ __forceinline__ int* blkcnt() const { return (int*)(ws() + WS_BLKCNT); }
};
struct Frame {
    LAS unsigned char* lds; float* smem;
    int G, bx, wave;
};
#define PHASE_TID const int lane = fresh_lane(), wave = F.wave, tid = wave * 64 + lane; (void)lane; (void)wave; (void)tid

__device__ __forceinline__ float wave_sum(float v) {
    v = sum16(v);
    const int iv = __float_as_int(v);
    return (__int_as_float(__builtin_amdgcn_readlane(iv, 0)) + __int_as_float(__builtin_amdgcn_readlane(iv, 16))) + (__int_as_float(__builtin_amdgcn_readlane(iv, 32)) + __int_as_float(__builtin_amdgcn_readlane(iv, 48)));
}

struct TrItem { const float* W; bf16* WT; int ldw, nvalid, k0, n0, ldt, drow0; };
__device__ __forceinline__ void transpose_load(const TrItem& t, int lane, f32x4 (&v)[8]) {
    const int sub = lane >> 3, c4 = (lane & 7) * 4;
#pragma unroll
    for (int i = 0; i < 8; ++i) v[i] = (c4 < t.nvalid) ? __builtin_nontemporal_load((const f32x4*)(t.W + (size_t)(t.k0 + 8 * i + sub) * t.ldw + t.n0 + c4)) : (f32x4){0.f, 0.f, 0.f, 0.f};
}
__device__ __forceinline__ void transpose_store(const TrItem& t, int lane, const f32x4 (&v)[8], LAS float* scr) {
    const int sub = lane >> 3, c4 = (lane & 7) * 4;
#pragma unroll
    for (int i = 0; i < 8; ++i) { LAS float* d = scr + (8 * i + sub) * 33 + c4; d[0] = v[i].x; d[1] = v[i].y; d[2] = v[i].z; d[3] = v[i].w; }
    asm volatile("s_waitcnt lgkmcnt(0)" ::: "memory");
    const int c = lane & 7;
#pragma unroll
    for (int j = 0; j < 4; ++j) { const int n = (lane >> 3) + 8 * j; const LAS float* s = scr + (8 * c) * 33 + n;
        v4u o; o.x = pk2(s[0 * 33], s[1 * 33]); o.y = pk2(s[2 * 33], s[3 * 33]); o.z = pk2(s[4 * 33], s[5 * 33]); o.w = pk2(s[6 * 33], s[7 * 33]);
        if (n < t.nvalid) *(GAS v4u*)(t.WT + (size_t)(t.drow0 + n) * t.ldt + t.k0 + 8 * c) = o; }
    asm volatile("s_waitcnt lgkmcnt(0)" ::: "memory");
}
__device__ __forceinline__ void rms_row_to_bf16(const float* xrow, const float* gain, bf16* orow, int lane) {
    const f32x4* xr = (const f32x4*)xrow + lane;
    f32x4 v[4]; float s = 0.f;
#pragma unroll
    for (int j = 0; j < 4; ++j) { v[j] = xr[64 * j]; s += (v[j].x * v[j].x + v[j].y * v[j].y) + (v[j].z * v[j].z + v[j].w * v[j].w); }
    const float rs = rsqrtf(wave_sum(s) * (1.f / D) + EPS);
    v2u* o8 = (v2u*)orow + lane;
#pragma unroll
    for (int j = 0; j < 4; ++j) { const f32x4 g = ((const f32x4*)gain)[lane + 64 * j]; v2u w; w.x = pk2(v[j].x * rs * g.x, v[j].y * rs * g.y); w.y = pk2(v[j].z * rs * g.z, v[j].w * rs * g.w); o8[64 * j] = w; }
}
__device__ __forceinline__ void p0_prologue(Frame& F) {
    const KA K = KA::fresh(); PHASE_TID;
    LAS float* scr = (LAS float*)(F.lds + wave * 16384);
    const int gw = F.bx * NWAVES + wave, NGW = F.G * NWAVES;
    constexpr int I_IN = 16 * 89, I_OUT = 16 * 32, I_G = 32 * 16 * 8, I_D = 32 * 4 * 32, I_L = I_IN + I_OUT + 2 * I_G + I_D;
#define TR_DECODE(it_, t_) do { const int l_ = (it_) / I_L; int r_ = (it_) % I_L; \
        if (r_ < I_IN) { const int kb = r_ / 89, nb = r_ % 89; t_ = TrItem{K.in(2) + (size_t)l_ * D * DIN, K.WinT() + (size_t)l_ * PLD * D, DIN, (nb == 88) ? 16 : 32, kb * 64, nb * 32, D, nb * 32}; } \
        else if (r_ < I_IN + I_OUT) { r_ -= I_IN; const int kb = r_ / 32, nb = r_ % 32; t_ = TrItem{K.in(10) + (size_t)l_ * D * D, K.WoutT() + (size_t)l_ * D * D, D, 32, kb * 64, nb * 32, D, nb * 32}; } \
        else if (r_ < I_IN + I_OUT + 2 * I_G) { r_ -= I_IN + I_OUT; const int sel = r_ / I_G; r_ %= I_G; const int e = r_ / 128, kb = (r_ % 128) / 8, n0 = (r_ % 8) * 32; \
            t_ = TrItem{K.in(16 + sel) + ((size_t)l_ * NE + e) * D * DE, K.WguT() + ((size_t)l_ * NE + e) * 512 * D, DE, 32, kb * 64, n0, D, (n0 >> 7) * 256 + sel * 128 + (n0 & 127)}; } \
        else { r_ -= I_IN + I_OUT + 2 * I_G; const int e = r_ / 128, kb = (r_ % 128) / 32, nb = r_ % 32; t_ = TrItem{K.in(18) + ((size_t)l_ * NE + e) * DE * D, K.WdT() + ((size_t)l_ * NE + e) * D * DE, D, 32, kb * 64, nb * 32, DE, nb * 32}; } } while (0)
    {
        TrItem cur, nxt; f32x4 vc[8], vn[8];
        int it = gw;
        if (it < DEPTH * I_L) { TR_DECODE(it, cur); transpose_load(cur, lane, vc); }
#pragma unroll 1
        for (; it < DEPTH * I_L; it += NGW) {
            const bool more = it + NGW < DEPTH * I_L;
            if (more) { TR_DECODE(it + NGW, nxt); transpose_load(nxt, lane, vn); }
            transpose_store(cur, lane, vc, scr);
            cur = nxt;
#pragma unroll
            for (int i = 0; i < 8; ++i) vc[i] = vn[i];
        }
    }
#undef TR_DECODE
    for (int i = F.bx * NT + tid; i < DEPTH * 240 * 128; i += F.G * NT) { const int l = i / (240 * 128), rr = (i / 128) % 240, c = i % 128;
        *(GAS v4u*)(K.WinT() + ((size_t)l * PLD + DIN + rr) * D + c * 8) = (v4u){0u, 0u, 0u, 0u}; }
    for (int i = F.bx * NT + tid; i < DEPTH * 48 * D; i += F.G * NT) { const int ll = i / (48 * D), n = (i / D) % 48, k = i % D;
        float w = 0.f;
        if (n < 4) w = K.in(12)[((size_t)ll * D + k) * 4 + n]; else if (n < 36) w = K.in(14)[((size_t)ll * D + k) * 32 + (n - 4)];
        w *= K.in(11)[(size_t)ll * D + k];
        const unsigned hi = f2bf(w), lo = f2bf(w - bf2f(hi));
        K.Wr()[((size_t)ll * 2 + 0) * 48 * D + (size_t)n * D + k] = (bf16)hi; K.Wr()[((size_t)ll * 2 + 1) * 48 * D + (size_t)n * D + k] = (bf16)lo; }
    for (int i = F.bx * NT + tid; i < DEPTH * MH * 128 * 128 / 8; i += F.G * NT) { const int e0 = i * 8, s0 = e0 & 127, t = (e0 >> 7) & 127;
        const f32x4 a = *(const f32x4*)(K.in(7) + e0), c = *(const f32x4*)(K.in(7) + e0 + 4);
        const float v[8] = {a.x, a.y, a.z, a.w, c.x, c.y, c.z, c.w}; unsigned w[4];
#pragma unroll
        for (int j = 0; j < 4; ++j) w[j] = pk2((s0 + 2 * j <= t) ? v[2 * j] : 0.f, (s0 + 2 * j + 1 <= t) ? v[2 * j + 1] : 0.f);
        *(GAS v4u*)(K.Wsp() + e0) = (v4u){w[0], w[1], w[2], w[3]}; }
    {
        f32x4 g4[4], v[4], vn[4];
#pragma unroll
        for (int j = 0; j < 4; ++j) g4[j] = ((const f32x4*)K.in(1))[lane + 64 * j];
        int m = gw;
        if (m < T) {
#pragma unroll
            for (int j = 0; j < 4; ++j) v[j] = __builtin_nontemporal_load((const f32x4*)(K.in(0) + (size_t)m * D) + lane + 64 * j); }
#pragma unroll 1
        for (; m < T; m += NGW) {
            if (m + NGW < T) {
#pragma unroll
                for (int j = 0; j < 4; ++j) vn[j] = __builtin_nontemporal_load((const f32x4*)(K.in(0) + (size_t)(m + NGW) * D) + lane + 64 * j); }
            float s_ = 0.f;
#pragma unroll
            for (int j = 0; j < 4; ++j) s_ += (v[j].x * v[j].x + v[j].y * v[j].y) + (v[j].z * v[j].z + v[j].w * v[j].w);
            const float rs = rsqrtf(wave_sum(s_) * (1.f / D) + EPS);
            v2u* o8 = (v2u*)(K.XN() + (size_t)m * D) + lane;
#pragma unroll
            for (int j = 0; j < 4; ++j) { o8[64 * j] = (v2u){pk2(v[j].x * rs * g4[j].x, v[j].y * rs * g4[j].y), pk2(v[j].z * rs * g4[j].z, v[j].w * rs * g4[j].w)}; v[j] = vn[j]; }
        }
    }
}

__device__ __forceinline__ void gla_cumdecay(Frame& F, const KA& K, int tid, int l, int h, int t0, float* bb) {
    const float* wup = K.in(3) + (size_t)l * 16 * 256; const float* bgk = K.in(4) + (size_t)l * 256;
    for (int e = tid; e < 64 * 64; e += NT) {
        const int c = e >> 6, d = e & 63;
        const bf16* gl = K.P() + (size_t)(t0 + c) * PLD + C_GK;
        float a = bgk[h * 64 + d];
#pragma unroll
        for (int r = 0; r < 16; ++r) a += bf2f(gl[r]) * wup[r * 256 + h * 64 + d];
        bb[c * 64 + d] = log_sigmoid(a) * (1.0f / 16.0f);
    }
    __syncthreads();
    if (tid < 64) { float run = 0.f; for (int c = 0; c < 64; ++c) { run += bb[c * 64 + tid]; bb[c * 64 + tid] = run; } }
    __syncthreads();
}
__device__ __forceinline__ void phase_gla_kv(Frame& F, int l) {
    const KA K = KA::fresh(); PHASE_TID;
    float* bb = F.smem; float* kd = F.smem + 4096;
#pragma unroll 1
    for (int ci = F.bx; ci < NB * GH * GN; ci += F.G) {
        const int b = ci / (GH * GN), h = (ci / GN) % GH, n = ci % GN, t0 = b * S + n * GC;
        __syncthreads();
        gla_cumdecay(F, K, tid, l, h, t0, bb);
        for (int e = tid; e < 4096; e += NT) { const int c = e >> 6, d = e & 63; kd[e] = bf2f(K.P()[(size_t)(t0 + c) * PLD + C_K + h * 64 + d]) * expf(bb[63 * 64 + d] - bb[e]); }
        __syncthreads();
        const int d = tid >> 3, v0 = (tid & 7) * 16;
        float acc[16];
#pragma unroll
        for (int j = 0; j < 16; ++j) acc[j] = 0.f;
#pragma unroll 2
        for (int c = 0; c < 64; ++c) {
            const float kk = kd[c * 64 + d];
            const v4u* vr = (const v4u*)(K.P() + (size_t)(t0 + c) * PLD + C_V + h * 128 + v0);
            float f[8]; unpack8(vr[0], f);
#pragma unroll
            for (int j = 0; j < 8; ++j) acc[j] += kk * f[j];
            unpack8(vr[1], f);
#pragma unroll
            for (int j = 0; j < 8; ++j) acc[8 + j] += kk * f[j];
        }
        f32x4* o = (f32x4*)(K.Sst() + ((size_t)ci * 64 + d) * 128 + v0);
#pragma unroll
        for (int j = 0; j < 4; ++j) o[j] = (f32x4){acc[4 * j], acc[4 * j + 1], acc[4 * j + 2], acc[4 * j + 3]};
        if (tid < 64) K.dec()[(size_t)ci * 64 + tid] = expf(bb[63 * 64 + tid]);
    }
}
__device__ __forceinline__ void phase_gla_scan(Frame& F) {
    const KA K = KA::fresh(); PHASE_TID;
#pragma unroll 1
    for (int e = F.bx * NT + tid; e < NB * GH * 64 * 128; e += F.G * NT) {
        const int bh = e >> 13, d = (e >> 7) & 63, v = e & 127;
        float* base = K.Sst() + ((size_t)bh * GN * 64 + d) * 128 + v; const float* db = K.dec() + (size_t)bh * GN * 64 + d;
        float st = 0.f;
#pragma unroll 1
        for (int n0 = 0; n0 < GN; n0 += 16) {
            float kvv[16], dd[16];
#pragma unroll
            for (int j = 0; j < 16; ++j) { kvv[j] = base[(size_t)(n0 + j) * 8192]; dd[j] = db[(n0 + j) * 64]; }
#pragma unroll
            for (int j = 0; j < 16; ++j) { base[(size_t)(n0 + j) * 8192] = st; st = dd[j] * st + kvv[j]; }
        }
    }
}
__device__ __forceinline__ void phase_gla_out(Frame& F, int l) {
    const KA K = KA::fresh(); PHASE_TID;
    float* bb = F.smem; float* qd = F.smem + 4096; float* ki = F.smem + 4096 + 64 * 65; float* sc = bb;
    const float* gnorm = K.in(5) + (size_t)l * 128;
#pragma unroll 1
    for (int ci = F.bx; ci < NB * GH * GN; ci += F.G) {
        const int b = ci / (GH * GN), h = (ci / GN) % GH, n = ci % GN, t0 = b * S + n * GC;
        __syncthreads();
        gla_cumdecay(F, K, tid, l, h, t0, bb);
        for (int e = tid; e < 4096; e += NT) {
            const int c = e >> 6, d = e & 63; const float bv = bb[e];
            const bf16* row = K.P() + (size_t)(t0 + c) * PLD;
            qd[c * 65 + d] = bf2f(row[C_Q + h * 64 + d]) * 0.125f * expf(bv);
            ki[c * 65 + d] = bf2f(row[C_K + h * 64 + d]) * expf(-bv);
        }
        __syncthreads();
        {
            const int c = tid >> 3, s0 = (tid & 7) * 8;
            float a[8];
#pragma unroll
            for (int j = 0; j < 8; ++j) a[j] = 0.f;
#pragma unroll 4
            for (int d = 0; d < 64; ++d) { const float qv = qd[c * 65 + d];
#pragma unroll
                for (int j = 0; j < 8; ++j) a[j] += qv * ki[(s0 + j) * 65 + d]; }
#pragma unroll
            for (int j = 0; j < 8; ++j) sc[c * 64 + s0 + j] = (s0 + j <= c) ? a[j] : 0.f;
        }
        __syncthreads();
        const int c = tid >> 3, v0 = (tid & 7) * 16;
        float acc[16];
#pragma unroll
        for (int j = 0; j < 16; ++j) acc[j] = 0.f;
#pragma unroll 2
        for (int s = 0; s <= c; ++s) {
            const float w = sc[c * 64 + s];
            const v4u* vr = (const v4u*)(K.P() + (size_t)(t0 + s) * PLD + C_V + h * 128 + v0);
            float f[8]; unpack8(vr[0], f);
#pragma unroll
            for (int j = 0; j < 8; ++j) acc[j] += w * f[j];
            unpack8(vr[1], f);
#pragma unroll
            for (int j = 0; j < 8; ++j) acc[8 + j] += w * f[j];
        }
#pragma unroll 2
        for (int d = 0; d < 64; ++d) {
            const float w = qd[c * 65 + d];
            const f32x4* sr = (const f32x4*)(K.Sst() + ((size_t)ci * 64 + d) * 128 + v0);
#pragma unroll
            for (int j = 0; j < 4; ++j) { const f32x4 v4 = sr[j]; acc[4 * j] += w * v4.x; acc[4 * j + 1] += w * v4.y; acc[4 * j + 2] += w * v4.z; acc[4 * j + 3] += w * v4.w; }
        }
        float ss = 0.f;
#pragma unroll
        for (int j = 0; j < 16; ++j) ss += acc[j] * acc[j];
        ss = sum8(ss);
        const float rs = rsqrtf(ss * (1.0f / 128.0f) + EPS);
        const v4u* gr = (const v4u*)(K.P() + (size_t)(t0 + c) * PLD + C_G + h * 128 + v0);
        float g0[8], g1[8]; unpack8(gr[0], g0); unpack8(gr[1], g1);
        float o[16];
#pragma unroll
        for (int j = 0; j < 8; ++j) { o[j] = acc[j] * rs * gnorm[v0 + j] * silu(g0[j]); o[8 + j] = acc[8 + j] * rs * gnorm[v0 + 8 + j] * silu(g1[j]); }
        v4u* op = (v4u*)(K.XN() + (size_t)(t0 + c) * D + h * 128 + v0);
        op[0] = (v4u){pk2(o[0], o[1]), pk2(o[2], o[3]), pk2(o[4], o[5]), pk2(o[6], o[7])};
        op[1] = (v4u){pk2(o[8], o[9]), pk2(o[10], o[11]), pk2(o[12], o[13]), pk2(o[14], o[15])};
    }
}
__device__ __forceinline__ void phase_gmlp(Frame& F, int l) {
    const KA K = KA::fresh(); PHASE_TID;
    float* vs = F.smem;
    const float* gn = K.in(6) + (size_t)l * 256; const float* wsp = K.in(7) + (size_t)l * MH * 128 * 128; const float* bsp = K.in(8) + (size_t)l * MH * 128;
#pragma unroll 1
    for (int u = F.bx; u < NB * MN * MH; u += F.G) {
        const int b = u / (MN * MH), n = (u / MH) % MN, h = u % MH, t0 = b * S + n * MC;
        __syncthreads();
        const int s = tid >> 2, d0 = (tid & 3) * 16;
        {
            const v4u* vr = (const v4u*)(K.P() + (size_t)(t0 + s) * PLD + C_VG + h * 64 + d0);
            float g[16]; { float f[8]; unpack8(vr[0], f);
#pragma unroll
                for (int j = 0; j < 8; ++j) g[j] = gelu_tanh(f[j]);
                unpack8(vr[1], f);
#pragma unroll
                for (int j = 0; j < 8; ++j) g[8 + j] = gelu_tanh(f[j]); }
            float ss = 0.f;
#pragma unroll
            for (int j = 0; j < 16; ++j) ss += g[j] * g[j];
            ss += shx(ss, 1); ss += shx(ss, 2);
            const float rs = rsqrtf(ss * (1.0f / 64.0f) + EPS);
#pragma unroll
            for (int j = 0; j < 16; ++j) vs[s * 64 + d0 + j] = g[j] * rs * gn[h * 64 + d0 + j];
        }
        __syncthreads();
        const int t = s;
        float acc[16];
#pragma unroll
        for (int j = 0; j < 16; ++j) acc[j] = 0.f;
        const float* wr = wsp + ((size_t)h * 128 + t) * 128;
#pragma unroll 2
        for (int s2 = 0; s2 <= t; ++s2) { const float w = wr[s2];
#pragma unroll
            for (int j = 0; j < 16; ++j) acc[j] += w * vs[s2 * 64 + d0 + j]; }
        const float bias = bsp[h * 128 + t];
        const v4u* ur = (const v4u*)(K.P() + (size_t)(t0 + t) * PLD + C_U + h * 64 + d0);
        float u0[8], u1[8]; unpack8(ur[0], u0); unpack8(ur[1], u1);
        float o[16];
#pragma unroll
        for (int j = 0; j < 8; ++j) { o[j] = gelu_tanh(u0[j]) * (acc[j] + bias); o[8 + j] = gelu_tanh(u1[j]) * (acc[8 + j] + bias); }
        v4u* op = (v4u*)(K.XN() + (size_t)(t0 + t) * D + 512 + h * 64 + d0);
        op[0] = (v4u){pk2(o[0], o[1]), pk2(o[2], o[3]), pk2(o[4], o[5]), pk2(o[6], o[7])};
        op[1] = (v4u){pk2(o[8], o[9]), pk2(o[10], o[11]), pk2(o[12], o[13]), pk2(o[14], o[15])};
    }
}
typedef short bf16x8 __attribute__((ext_vector_type(8)));
__device__ __forceinline__ float fexp(float x) { return __builtin_amdgcn_exp2f(x * 1.4426950408889634f); }
__device__ __forceinline__ float logsig_fast(float x) { return fminf(x, 0.f) - __log2f(1.0f + fexp(-fabsf(x))) * 0.6931471805599453f; }
__device__ __forceinline__ float silu_fast(float x) { return x * __builtin_amdgcn_rcpf(1.0f + __builtin_amdgcn_exp2f(-1.4426950408889634f * x)); }
__device__ __forceinline__ float gelu_fast(float x) { const float u = 0.7978845608028654f * (x + 0.044715f * x * x * x); return x * __builtin_amdgcn_rcpf(1.0f + __builtin_amdgcn_exp2f(-2.8853900817779268f * u)); }
__device__ __forceinline__ f32x4 mfma16(bf16x8 a, bf16x8 b, f32x4 c) { return __builtin_amdgcn_mfma_f32_16x16x32_bf16(a, b, c, 0, 0, 0); }
constexpr int LROWB = 144;
constexpr int L_QD = 0, L_KI = 9216, L_KDT = 18432, L_VT = 27648, L_S = 46080, L_ST = 55296, L_OB = 73728, L_TOT = 107520, OBROW = 528;
#define FRAG(base, row, kel) (*(const LAS bf16x8*)(lds + (base) + (row) * LROWB + (kel) * 2))

__device__ __forceinline__ float gla_b8(const KA& K, LAS unsigned char* lds, int l, int h, int t0, int lane, int wave, float (&bv)[8]) {
    const float* wup = K.in(3) + (size_t)l * 16 * 256 + h * 64 + lane;
    float wu[16];
#pragma unroll
    for (int r = 0; r < 16; ++r) wu[r] = wup[r * 256];
    const float bg = K.in(4)[l * 256 + h * 64 + lane];
    const bf16* P = K.P();
    float run = 0.f;
#pragma unroll
    for (int j = 0; j < 8; ++j) {
        const bf16* gl = P + (size_t)(t0 + 8 * wave + j) * PLD + C_GK;
        float f0[8], f1[8]; unpack8(*(const v4u*)gl, f0); unpack8(*(const v4u*)(gl + 8), f1);
        float a = bg;
#pragma unroll
        for (int r = 0; r < 8; ++r) a += f0[r] * wu[r];
#pragma unroll
        for (int r = 0; r < 8; ++r) a += f1[r] * wu[8 + r];
        run += logsig_fast(a) * (1.0f / 16.0f); bv[j] = run;
    }
    LAS float* tot = (LAS float*)(lds + L_TOT);
    tot[wave * 64 + lane] = run;
    __syncthreads();
    float base = 0.f, all = 0.f;
#pragma unroll
    for (int g = 0; g < 8; ++g) { const float tv = tot[g * 64 + lane]; all += tv; if (g < wave) base += tv; }
#pragma unroll
    for (int j = 0; j < 8; ++j) bv[j] += base;
    return all;
}
__device__ __forceinline__ void gla_stage_vT(const bf16* P, LAS unsigned char* lds, int h, int t0, int tid) {
    const int vv = tid & 127, cq = tid >> 7;
    const bf16* vp = P + (size_t)(t0 + 16 * cq) * PLD + C_V + h * 128 + vv;
    unsigned w[8];
#pragma unroll
    for (int j = 0; j < 8; ++j) w[j] = (unsigned)vp[(size_t)(2 * j) * PLD] | ((unsigned)vp[(size_t)(2 * j + 1) * PLD] << 16);
    LAS v4u* dst = (LAS v4u*)(lds + L_VT + vv * LROWB + cq * 32);
    dst[0] = (v4u){w[0], w[1], w[2], w[3]}; dst[1] = (v4u){w[4], w[5], w[6], w[7]};
}

__device__ __forceinline__ void phase_gla_kv_mfma(Frame& F, int l) {
    const KA K = KA::fresh(); PHASE_TID;
    LAS unsigned char* lds = F.lds;
    const int fr = lane & 15, fq = lane >> 4;
#pragma unroll 1
    for (int ci = F.bx; ci < NB * GH * GN; ci += F.G) {
        const int b = ci / (GH * GN), h = (ci / GN) % GH, n = ci % GN, t0 = b * S + n * GC;
        const bf16* P = K.P();
        __syncthreads();
        float bv[8]; const float bl = gla_b8(K, lds, l, h, t0, lane, wave, bv);
        {
            const bf16* kp = P + (size_t)(t0 + 8 * wave) * PLD + C_K + h * 64 + lane;
            float kd[8];
#pragma unroll
            for (int j = 0; j < 8; ++j) kd[j] = bf2f(kp[(size_t)j * PLD]) * fexp(bl - bv[j]);
            *(LAS v4u*)(lds + L_KDT + lane * LROWB + wave * 16) = (v4u){pk2(kd[0], kd[1]), pk2(kd[2], kd[3]), pk2(kd[4], kd[5]), pk2(kd[6], kd[7])};
        }
        gla_stage_vT(P, lds, h, t0, tid);
        if (wave == 0) K.dec()[(size_t)ci * 64 + lane] = fexp(bl);
        __syncthreads();
        bf16x8 Bf[2];
#pragma unroll
        for (int ks = 0; ks < 2; ++ks) Bf[ks] = FRAG(L_VT, 16 * wave + fr, 32 * ks + 8 * fq);
        float* so = K.Sst() + (size_t)ci * 64 * 128 + 16 * wave + fr;
#pragma unroll
        for (int dt = 0; dt < 4; ++dt) {
            f32x4 acc = (f32x4){0.f, 0.f, 0.f, 0.f};
#pragma unroll
            for (int ks = 0; ks < 2; ++ks) acc = mfma16(FRAG(L_KDT, 16 * dt + fr, 32 * ks + 8 * fq), Bf[ks], acc);
#pragma unroll
            for (int r = 0; r < 4; ++r) so[(size_t)(16 * dt + 4 * fq + r) * 128] = acc[r];
        }
    }
}

__device__ __forceinline__ void phase_gla_out_mfma(Frame& F, int l) {
    const KA K = KA::fresh(); PHASE_TID;
    LAS unsigned char* lds = F.lds;
    const int fr = lane & 15, fq = lane >> 4;
    const float* gnorm = K.in(5) + (size_t)l * 128;
#pragma unroll 1
    for (int ci = F.bx; ci < NB * GH * GN; ci += F.G) {
        const int b = ci / (GH * GN), h = (ci / GN) % GH, n = ci % GN, t0 = b * S + n * GC;
        const bf16* P = K.P();
        __syncthreads();
        float bv[8]; (void)gla_b8(K, lds, l, h, t0, lane, wave, bv);
        {
            const bf16* qp = P + (size_t)(t0 + 8 * wave) * PLD + C_Q + h * 64 + lane;
            const bf16* kp = qp + (C_K - C_Q);
#pragma unroll
            for (int j = 0; j < 8; ++j) {
                const float e = fexp(bv[j]);
                const float qv = bf2f(qp[(size_t)j * PLD]) * 0.125f * e, kv = bf2f(kp[(size_t)j * PLD]) * __builtin_amdgcn_rcpf(e);
                *(LAS bf16*)(lds + L_QD + (8 * wave + j) * LROWB + lane * 2) = (bf16)f2bf(qv);
                *(LAS bf16*)(lds + L_KI + (8 * wave + j) * LROWB + lane * 2) = (bf16)f2bf(kv);
            }
        }
        gla_stage_vT(P, lds, h, t0, tid);
        {
            const int vv = tid & 127, dq = tid >> 7;
            const float* sp = K.Sst() + ((size_t)ci * 64 + 16 * dq) * 128 + vv;
            unsigned w[8];
#pragma unroll
            for (int j = 0; j < 8; ++j) w[j] = pk2(sp[(size_t)(2 * j) * 128], sp[(size_t)(2 * j + 1) * 128]);
            LAS v4u* dst = (LAS v4u*)(lds + L_ST + vv * LROWB + dq * 32);
            dst[0] = (v4u){w[0], w[1], w[2], w[3]}; dst[1] = (v4u){w[4], w[5], w[6], w[7]};
        }
        __syncthreads();
#pragma unroll
        for (int i = 0; i < 2; ++i) {
            const int tix = 2 * wave + i, st = tix >> 2, ct = tix & 3;
            f32x4 acc = (f32x4){0.f, 0.f, 0.f, 0.f};
#pragma unroll
            for (int ks = 0; ks < 2; ++ks) acc = mfma16(FRAG(L_KI, 16 * st + fr, 32 * ks + 8 * fq), FRAG(L_QD, 16 * ct + fr, 32 * ks + 8 * fq), acc);
            const int s0 = 16 * st + 4 * fq, c = 16 * ct + fr;
            float m[4];
#pragma unroll
            for (int r = 0; r < 4; ++r) m[r] = (s0 + r <= c) ? acc[r] : 0.f;
            *(LAS v2u*)(lds + L_S + c * LROWB + s0 * 2) = (v2u){pk2(m[0], m[1]), pk2(m[2], m[3])};
        }
        __syncthreads();
        {
            bf16x8 Av[2], As[2];
#pragma unroll
            for (int ks = 0; ks < 2; ++ks) { Av[ks] = FRAG(L_VT, 16 * wave + fr, 32 * ks + 8 * fq); As[ks] = FRAG(L_ST, 16 * wave + fr, 32 * ks + 8 * fq); }
#pragma unroll
            for (int ct = 0; ct < 4; ++ct) {
                f32x4 acc = (f32x4){0.f, 0.f, 0.f, 0.f};
#pragma unroll
                for (int ks = 0; ks < 2; ++ks) { acc = mfma16(Av[ks], FRAG(L_S, 16 * ct + fr, 32 * ks + 8 * fq), acc); acc = mfma16(As[ks], FRAG(L_QD, 16 * ct + fr, 32 * ks + 8 * fq), acc); }
                *(LAS f32x4*)(lds + L_OB + (16 * ct + fr) * OBROW + (16 * wave + 4 * fq) * 4) = acc;
            }
        }
        __syncthreads();
        {
            const int c = tid >> 3, vg = tid & 7;
            const LAS f32x4* ob = (const LAS f32x4*)(lds + L_OB + c * OBROW + vg * 64);
            f32x4 o[4]; float ss = 0.f;
#pragma unroll
            for (int j = 0; j < 4; ++j) { o[j] = ob[j]; ss += (o[j].x * o[j].x + o[j].y * o[j].y) + (o[j].z * o[j].z + o[j].w * o[j].w); }
            ss = sum8(ss);
            const float rs = rsqrtf(ss * (1.0f / 128.0f) + EPS);
            const v4u* gr = (const v4u*)(P + (size_t)(t0 + c) * PLD + C_G + h * 128 + 16 * vg);
            float g0[8], g1[8]; unpack8(gr[0], g0); unpack8(gr[1], g1);
            const f32x4* gn = (const f32x4*)(gnorm + 16 * vg);
            const f32x4 n0 = gn[0], n1 = gn[1], n2 = gn[2], n3 = gn[3];
            v4u w0, w1;
            w0.x = pk2(o[0].x * rs * n0.x * silu_fast(g0[0]), o[0].y * rs * n0.y * silu_fast(g0[1])); w0.y = pk2(o[0].z * rs * n0.z * silu_fast(g0[2]), o[0].w * rs * n0.w * silu_fast(g0[3]));
            w0.z = pk2(o[1].x * rs * n1.x * silu_fast(g0[4]), o[1].y * rs * n1.y * silu_fast(g0[5])); w0.w = pk2(o[1].z * rs * n1.z * silu_fast(g0[6]), o[1].w * rs * n1.w * silu_fast(g0[7]));
            w1.x = pk2(o[2].x * rs * n2.x * silu_fast(g1[0]), o[2].y * rs * n2.y * silu_fast(g1[1])); w1.y = pk2(o[2].z * rs * n2.z * silu_fast(g1[2]), o[2].w * rs * n2.w * silu_fast(g1[3]));
            w1.z = pk2(o[3].x * rs * n3.x * silu_fast(g1[4]), o[3].y * rs * n3.y * silu_fast(g1[5])); w1.w = pk2(o[3].z * rs * n3.z * silu_fast(g1[6]), o[3].w * rs * n3.w * silu_fast(g1[7]));
            v4u* op = (v4u*)(K.XN() + (size_t)(t0 + c) * D + h * 128 + 16 * vg);
            op[0] = w0; op[1] = w1;
        }
    }
}
#undef FRAG


constexpr int L_GKL = 109568, L_BL = 117760, SCN = 4, NSC = GN / SCN, NITEM = NB * GH * NSC;
#define FRAG(base, row, kel) (*(const LAS bf16x8*)(lds + (base) + (row) * LROWB + (kel) * 2))
struct GlaPre { unsigned short k[8], q[8], v[16]; v4u g0, g1; };
template <bool WITH_Q>
__device__ __forceinline__ void gla_prefetch(GlaPre& p, const bf16* P, int h, int t0, int tid, int lane, int wave) {
    const bf16* kp = P + (size_t)(t0 + 8 * wave) * PLD + C_K + h * 64 + lane;
#pragma unroll
    for (int j = 0; j < 8; ++j) p.k[j] = kp[(size_t)j * PLD];
    const int vv = tid & 127, cq = tid >> 7;
    const bf16* vp = P + (size_t)(t0 + 16 * cq) * PLD + C_V + h * 128 + vv;
#pragma unroll
    for (int j = 0; j < 16; ++j) p.v[j] = vp[(size_t)j * PLD];
    if (WITH_Q) {
        const bf16* qp = kp + (C_Q - C_K);
#pragma unroll
        for (int j = 0; j < 8; ++j) p.q[j] = qp[(size_t)j * PLD];
        const v4u* gr = (const v4u*)(P + (size_t)(t0 + (tid >> 3)) * PLD + C_G + h * 128 + 16 * (tid & 7));
        p.g0 = gr[0]; p.g1 = gr[1];
    }
}
__device__ __forceinline__ void gla_stage_gkl(const bf16* P, LAS unsigned char* lds, int tok0, int tid) {
    *(LAS v4u*)(lds + L_GKL + tid * 16) = *(const v4u*)(P + (size_t)(tok0 + (tid >> 1)) * PLD + C_GK + 8 * (tid & 1));
}
__device__ __forceinline__ void gla_b8_part(LAS unsigned char* lds, const float (&wu)[16], float bg, int n, int lane, int wave, float (&bv)[8]) {
    float run = 0.f;
#pragma unroll
    for (int j = 0; j < 8; ++j) {
        const LAS v4u* gl = (const LAS v4u*)(lds + L_GKL + (n * 64 + 8 * wave + j) * 32);
        float f0[8], f1[8]; unpack8(gl[0], f0); unpack8(gl[1], f1);
        float a = bg;
#pragma unroll
        for (int r = 0; r < 8; ++r) a += f0[r] * wu[r];
#pragma unroll
        for (int r = 0; r < 8; ++r) a += f1[r] * wu[8 + r];
        run += logsig_fast(a) * (1.0f / 16.0f); bv[j] = run;
    }
    ((LAS float*)(lds + L_TOT))[wave * 64 + lane] = run;
}
__device__ __forceinline__ float gla_b8_finish(LAS unsigned char* lds, int lane, int wave, float (&bv)[8]) {
    const LAS float* tot = (const LAS float*)(lds + L_TOT);
    float base = 0.f, all = 0.f;
#pragma unroll
    for (int g = 0; g < 8; ++g) { const float tv = tot[g * 64 + lane]; all += tv; if (g < wave) base += tv; }
#pragma unroll
    for (int j = 0; j < 8; ++j) bv[j] += base;
    return all;
}
__device__ __forceinline__ void gla_write_kdT_vT(LAS unsigned char* lds, const GlaPre& p, const float (&bv)[8], float bl, int tid, int lane, int wave) {
    float kd[8];
#pragma unroll
    for (int j = 0; j < 8; ++j) kd[j] = bf2f(p.k[j]) * fexp(bl - bv[j]);
    *(LAS v4u*)(lds + L_KDT + lane * LROWB + wave * 16) = (v4u){pk2(kd[0], kd[1]), pk2(kd[2], kd[3]), pk2(kd[4], kd[5]), pk2(kd[6], kd[7])};
    const int vv = tid & 127, cq = tid >> 7;
    LAS v4u* dst = (LAS v4u*)(lds + L_VT + vv * LROWB + cq * 32);
    dst[0] = (v4u){(unsigned)p.v[0] | ((unsigned)p.v[1] << 16), (unsigned)p.v[2] | ((unsigned)p.v[3] << 16), (unsigned)p.v[4] | ((unsigned)p.v[5] << 16), (unsigned)p.v[6] | ((unsigned)p.v[7] << 16)};
    dst[1] = (v4u){(unsigned)p.v[8] | ((unsigned)p.v[9] << 16), (unsigned)p.v[10] | ((unsigned)p.v[11] << 16), (unsigned)p.v[12] | ((unsigned)p.v[13] << 16), (unsigned)p.v[14] | ((unsigned)p.v[15] << 16)};
    if (wave == 0) ((LAS float*)(lds + L_BL))[lane] = bl;
}
__device__ __forceinline__ void gla_kv_mfma(LAS unsigned char* lds, int wave, int fr, int fq, f32x4 (&acc)[4]) {
    bf16x8 Bf[2];
#pragma unroll
    for (int ks = 0; ks < 2; ++ks) Bf[ks] = FRAG(L_VT, 16 * wave + fr, 32 * ks + 8 * fq);
#pragma unroll
    for (int dt = 0; dt < 4; ++dt) { acc[dt] = (f32x4){0.f, 0.f, 0.f, 0.f};
#pragma unroll
        for (int ks = 0; ks < 2; ++ks) acc[dt] = mfma16(FRAG(L_KDT, 16 * dt + fr, 32 * ks + 8 * fq), Bf[ks], acc[dt]); }
}

__device__ __forceinline__ void phase_gla_A2(Frame& F, int l) {
    const KA K = KA::fresh(); PHASE_TID;
    LAS unsigned char* lds = F.lds;
    const int fr = lane & 15, fq = lane >> 4;
#pragma unroll 1
    for (int it = F.bx; it < NITEM; it += F.G) {
        const int b = it / (GH * NSC), h = (it / NSC) % GH, sc = it % NSC, tok0 = b * S + sc * SCN * GC;
        const bf16* P = K.P();
        float wu[16];
        { const float* wup = K.in(3) + (size_t)l * 16 * 256 + h * 64 + lane;
#pragma unroll
          for (int r = 0; r < 16; ++r) wu[r] = wup[r * 256]; }
        const float bg = K.in(4)[l * 256 + h * 64 + lane];
        GlaPre pre[2]; gla_prefetch<false>(pre[0], P, h, tok0, tid, lane, wave); gla_prefetch<false>(pre[1], P, h, tok0 + GC, tid, lane, wave);
        __syncthreads();
        gla_stage_gkl(P, lds, tok0, tid);
        __syncthreads();
        f32x4 Sl[4], bs[4];
#pragma unroll
        for (int dt = 0; dt < 4; ++dt) { Sl[dt] = (f32x4){0.f, 0.f, 0.f, 0.f}; bs[dt] = (f32x4){0.f, 0.f, 0.f, 0.f}; }
#pragma unroll
        for (int n = 0; n < SCN; ++n) {
            float bv[8]; gla_b8_part(lds, wu, bg, n, lane, wave, bv);
            __syncthreads();
            const float bl = gla_b8_finish(lds, lane, wave, bv);
            gla_write_kdT_vT(lds, pre[n & 1], bv, bl, tid, lane, wave);
            if (n + 2 < SCN) gla_prefetch<false>(pre[n & 1], P, h, tok0 + (n + 2) * GC, tid, lane, wave);
            __syncthreads();
            f32x4 acc[4]; gla_kv_mfma(lds, wave, fr, fq, acc);
#pragma unroll
            for (int dt = 0; dt < 4; ++dt) { const f32x4 bl4 = *(const LAS f32x4*)(lds + L_BL + (16 * dt + 4 * fq) * 4);
                bs[dt] = bs[dt] + bl4;
#pragma unroll
                for (int r = 0; r < 4; ++r) Sl[dt][r] = fexp(bl4[r]) * Sl[dt][r] + acc[dt][r]; }
        }
        f32x4* ag = (f32x4*)K.Sst() + ((size_t)(it * 8 + wave) * 4) * 64 + lane;
#pragma unroll
        for (int dt = 0; dt < 4; ++dt) ag[dt * 64] = Sl[dt];
        if (wave == 0 && fr == 0) { f32x4* dp = (f32x4*)K.dec() + (size_t)it * 16 + fq;
#pragma unroll
            for (int dt = 0; dt < 4; ++dt) dp[dt * 4] = (f32x4){fexp(bs[dt][0]), fexp(bs[dt][1]), fexp(bs[dt][2]), fexp(bs[dt][3])}; }
    }
}


__device__ __forceinline__ void phase_gla_aggscan(Frame& F) {
    const KA K = KA::fresh(); PHASE_TID;
#pragma unroll 1
    for (int e = F.bx * NT + tid; e < NB * GH * 8192; e += F.G * NT) {
        const int bh = e >> 13, el = e & 8191, ln = (el >> 2) & 63, dt = (el >> 8) & 3, r = el & 3;
        float* ap = K.Sst() + (size_t)bh * NSC * 8192 + el; const float* dp = K.dec() + (size_t)bh * NSC * 64 + dt * 16 + (ln >> 4) * 4 + r;
        float a[NSC], d[NSC];
#pragma unroll
        for (int j = 0; j < NSC; ++j) { a[j] = ap[(size_t)j * 8192]; d[j] = dp[j * 64]; }
        float st = 0.f;
#pragma unroll
        for (int j = 0; j < NSC; ++j) { ap[(size_t)j * 8192] = st; st = d[j] * st + a[j]; }
    }
}
__device__ __forceinline__ void phase_gla_C2(Frame& F, int l) {
    const KA K = KA::fresh(); PHASE_TID;
    LAS unsigned char* lds = F.lds;
    const int fr = lane & 15, fq = lane >> 4;
    const float* gnorm = K.in(5) + (size_t)l * 128;
#pragma unroll 1
    for (int it = F.bx; it < NITEM; it += F.G) {
        const int b = it / (GH * NSC), h = (it / NSC) % GH, sc = it % NSC, tok0 = b * S + sc * SCN * GC;
        const bf16* P = K.P();
        float wu[16];
        { const float* wup = K.in(3) + (size_t)l * 16 * 256 + h * 64 + lane;
#pragma unroll
          for (int r = 0; r < 16; ++r) wu[r] = wup[r * 256]; }
        const float bg = K.in(4)[l * 256 + h * 64 + lane];
        GlaPre pre[2]; gla_prefetch<true>(pre[0], P, h, tok0, tid, lane, wave); gla_prefetch<true>(pre[1], P, h, tok0 + GC, tid, lane, wave);
        __syncthreads();
        gla_stage_gkl(P, lds, tok0, tid);
        f32x4 Sm[4];
        { const f32x4* ag = (const f32x4*)K.Sst() + ((size_t)(it * 8 + wave) * 4) * 64 + lane;
#pragma unroll
          for (int dt = 0; dt < 4; ++dt) Sm[dt] = ag[dt * 64]; }
        __syncthreads();
#pragma unroll
        for (int n = 0; n < SCN; ++n) {
            const int t0 = tok0 + n * GC;
            GlaPre& pr = pre[n & 1];
            float bv[8]; gla_b8_part(lds, wu, bg, n, lane, wave, bv);
            __syncthreads();
            const float bl = gla_b8_finish(lds, lane, wave, bv);
            gla_write_kdT_vT(lds, pr, bv, bl, tid, lane, wave);
#pragma unroll
            for (int j = 0; j < 8; ++j) {
                const float e = fexp(bv[j]);
                *(LAS bf16*)(lds + L_QD + (8 * wave + j) * LROWB + lane * 2) = (bf16)f2bf(bf2f(pr.q[j]) * 0.125f * e);
                *(LAS bf16*)(lds + L_KI + (8 * wave + j) * LROWB + lane * 2) = (bf16)f2bf(bf2f(pr.k[j]) * __builtin_amdgcn_rcpf(e));
            }
#pragma unroll
            for (int dt = 0; dt < 4; ++dt) *(LAS v2u*)(lds + L_ST + (16 * wave + fr) * LROWB + (16 * dt + 4 * fq) * 2) = (v2u){pk2(Sm[dt][0], Sm[dt][1]), pk2(Sm[dt][2], Sm[dt][3])};
            const v4u gq0 = pr.g0, gq1 = pr.g1;
            if (n + 2 < SCN) gla_prefetch<true>(pr, P, h, t0 + 2 * GC, tid, lane, wave);
            __syncthreads();
#pragma unroll
            for (int i = 0; i < 2; ++i) {
                const int tix = 2 * wave + i, st = tix >> 2, ct = tix & 3;
                f32x4 a = (f32x4){0.f, 0.f, 0.f, 0.f};
#pragma unroll
                for (int ks = 0; ks < 2; ++ks) a = mfma16(FRAG(L_KI, 16 * st + fr, 32 * ks + 8 * fq), FRAG(L_QD, 16 * ct + fr, 32 * ks + 8 * fq), a);
                const int s0 = 16 * st + 4 * fq, c = 16 * ct + fr;
                float m[4];
#pragma unroll
                for (int r = 0; r < 4; ++r) m[r] = (s0 + r <= c) ? a[r] : 0.f;
                *(LAS v2u*)(lds + L_S + c * LROWB + s0 * 2) = (v2u){pk2(m[0], m[1]), pk2(m[2], m[3])};
            }
            f32x4 kv[4]; gla_kv_mfma(lds, wave, fr, fq, kv);
            __syncthreads();
            {
                bf16x8 Av[2], As[2];
#pragma unroll
                for (int ks = 0; ks < 2; ++ks) { Av[ks] = FRAG(L_VT, 16 * wave + fr, 32 * ks + 8 * fq); As[ks] = FRAG(L_ST, 16 * wave + fr, 32 * ks + 8 * fq); }
#pragma unroll
                for (int ct = 0; ct < 4; ++ct) {
                    f32x4 a = (f32x4){0.f, 0.f, 0.f, 0.f};
#pragma unroll
                    for (int ks = 0; ks < 2; ++ks) { a = mfma16(Av[ks], FRAG(L_S, 16 * ct + fr, 32 * ks + 8 * fq), a); a = mfma16(As[ks], FRAG(L_QD, 16 * ct + fr, 32 * ks + 8 * fq), a); }
                    *(LAS f32x4*)(lds + L_OB + (16 * ct + fr) * OBROW + (16 * wave + 4 * fq) * 4) = a;
                }
            }
#pragma unroll
            for (int dt = 0; dt < 4; ++dt) { const f32x4 bl4 = *(const LAS f32x4*)(lds + L_BL + (16 * dt + 4 * fq) * 4);
#pragma unroll
                for (int r = 0; r < 4; ++r) Sm[dt][r] = fexp(bl4[r]) * Sm[dt][r] + kv[dt][r]; }
            __syncthreads();
            {
                const int c = tid >> 3, vg = tid & 7;
                const LAS f32x4* ob = (const LAS f32x4*)(lds + L_OB + c * OBROW + vg * 64);
                f32x4 o[4]; float ss = 0.f;
#pragma unroll
                for (int j = 0; j < 4; ++j) { o[j] = ob[j]; ss += (o[j].x * o[j].x + o[j].y * o[j].y) + (o[j].z * o[j].z + o[j].w * o[j].w); }
                ss = sum8(ss);
                const float rs = rsqrtf(ss * (1.0f / 128.0f) + EPS);
                float g0[8], g1[8]; unpack8(gq0, g0); unpack8(gq1, g1);
                const f32x4* gn = (const f32x4*)(gnorm + 16 * vg);
                const f32x4 n0 = gn[0], n1 = gn[1], n2 = gn[2], n3 = gn[3];
                v4u w0, w1;
                w0.x = pk2(o[0].x * rs * n0.x * silu_fast(g0[0]), o[0].y * rs * n0.y * silu_fast(g0[1])); w0.y = pk2(o[0].z * rs * n0.z * silu_fast(g0[2]), o[0].w * rs * n0.w * silu_fast(g0[3]));
                w0.z = pk2(o[1].x * rs * n1.x * silu_fast(g0[4]), o[1].y * rs * n1.y * silu_fast(g0[5])); w0.w = pk2(o[1].z * rs * n1.z * silu_fast(g0[6]), o[1].w * rs * n1.w * silu_fast(g0[7]));
                w1.x = pk2(o[2].x * rs * n2.x * silu_fast(g1[0]), o[2].y * rs * n2.y * silu_fast(g1[1])); w1.y = pk2(o[2].z * rs * n2.z * silu_fast(g1[2]), o[2].w * rs * n2.w * silu_fast(g1[3]));
                w1.z = pk2(o[3].x * rs * n3.x * silu_fast(g1[4]), o[3].y * rs * n3.y * silu_fast(g1[5])); w1.w = pk2(o[3].z * rs * n3.z * silu_fast(g1[6]), o[3].w * rs * n3.w * silu_fast(g1[7]));
                v4u* op = (v4u*)(K.XN() + (size_t)(t0 + c) * D + h * 128 + 16 * vg);
                op[0] = w0; op[1] = w1;
            }
        }
    }
}
#undef FRAG

constexpr int GM_ROWB = 272;
__device__ __forceinline__ void phase_gmlp_mfma(Frame& F, int l) {
    const KA K = KA::fresh(); PHASE_TID;
    LAS unsigned char* lds = F.lds;
    const int fr = lane & 15, fq = lane >> 4;
    const int nks = (16 * wave + 15) / 32 + 1;
#pragma unroll 1
    for (int u = F.bx; u < NB * MN * MH; u += F.G) {
        const int b = u / (MN * MH), n = (u / MH) % MN, h = u % MH, t0 = b * S + n * MC;
        const bf16* P = K.P();
        const float gn = K.in(6)[(size_t)l * 256 + h * 64 + lane];
        unsigned short vraw[16];
#pragma unroll
        for (int i = 0; i < 16; ++i) vraw[i] = P[(size_t)(t0 + 16 * wave + i) * PLD + C_VG + h * 64 + lane];
        const bf16* Wb = K.Wsp() + ((size_t)(l * MH + h) * 128 + 16 * wave + fr) * 128 + 8 * fq;
        bf16x8 Bf[4];
#pragma unroll
        for (int ks = 0; ks < 4; ++ks) Bf[ks] = (ks < nks) ? *(const bf16x8*)(Wb + 32 * ks) : (bf16x8){0, 0, 0, 0, 0, 0, 0, 0};
        const int t = 16 * wave + fr;
        const float bias = K.in(8)[(size_t)l * MH * 128 + h * 128 + t];
        const bf16* up = P + (size_t)(t0 + t) * PLD + C_U + h * 64 + 4 * fq;
        v2u uw[4];
#pragma unroll
        for (int dt = 0; dt < 4; ++dt) uw[dt] = *(const v2u*)(up + 16 * dt);
        __syncthreads();
#pragma unroll
        for (int q = 0; q < 2; ++q) {
            float vs[8];
#pragma unroll
            for (int i = 0; i < 8; ++i) {
                const float g = gelu_fast(bf2f(vraw[8 * q + i]));
                const float ss = wave_sum(g * g);
                vs[i] = g * rsqrtf(ss * (1.0f / 64.0f) + EPS) * gn;
            }
            *(LAS v4u*)(lds + lane * GM_ROWB + (16 * wave + 8 * q) * 2) = (v4u){pk2(vs[0], vs[1]), pk2(vs[2], vs[3]), pk2(vs[4], vs[5]), pk2(vs[6], vs[7])};
        }
        __syncthreads();
        f32x4 acc[4];
#pragma unroll
        for (int dt = 0; dt < 4; ++dt) acc[dt] = (f32x4){0.f, 0.f, 0.f, 0.f};
#pragma unroll
        for (int ks = 0; ks < 4; ++ks) if (ks < nks) {
#pragma unroll
            for (int dt = 0; dt < 4; ++dt) acc[dt] = mfma16(*(const LAS bf16x8*)(lds + (16 * dt + fr) * GM_ROWB + (32 * ks + 8 * fq) * 2), Bf[ks], acc[dt]);
        }
        bf16* op = K.XN() + (size_t)(t0 + t) * D + 512 + h * 64 + 4 * fq;
#pragma unroll
        for (int dt = 0; dt < 4; ++dt) {
            const float o0 = gelu_fast(bflo(uw[dt].x)) * (acc[dt][0] + bias), o1 = gelu_fast(bfhi(uw[dt].x)) * (acc[dt][1] + bias), o2 = gelu_fast(bflo(uw[dt].y)) * (acc[dt][2] + bias), o3 = gelu_fast(bfhi(uw[dt].y)) * (acc[dt][3] + bias);
            *(v2u*)(op + 16 * dt) = (v2u){pk2(o0, o1), pk2(o2, o3)};
        }
    }
}
__device__ __forceinline__ void phase_conv(Frame& F, int l) {
    const KA K = KA::fresh(); PHASE_TID;
    const float* wc = K.in(9) + (size_t)l * 3 * 256;
#pragma unroll 1
    for (int e = F.bx * NT + tid; e < T * 32; e += F.G * NT) {
        const int t = e >> 5, c0 = (e & 31) * 8, tl = t % S;
        const bf16* row = K.P() + (size_t)t * PLD;
        float y[8], xi[8], cg[8], bg[8];
        unpack8(*(const v4u*)(row + C_XI + c0), xi); unpack8(*(const v4u*)(row + C_CG + c0), cg); unpack8(*(const v4u*)(row + C_BG + c0), bg);
#pragma unroll
        for (int j = 0; j < 8; ++j) y[j] = wc[2 * 256 + c0 + j] * cg[j] * xi[j];
        if (tl >= 1) { unpack8(*(const v4u*)(row - PLD + C_XI + c0), xi); unpack8(*(const v4u*)(row - PLD + C_CG + c0), cg);
#pragma unroll
            for (int j = 0; j < 8; ++j) y[j] += wc[1 * 256 + c0 + j] * cg[j] * xi[j]; }
        if (tl >= 2) { unpack8(*(const v4u*)(row - 2 * PLD + C_XI + c0), xi); unpack8(*(const v4u*)(row - 2 * PLD + C_CG + c0), cg);
#pragma unroll
            for (int j = 0; j < 8; ++j) y[j] += wc[0 * 256 + c0 + j] * cg[j] * xi[j]; }
#pragma unroll
        for (int j = 0; j < 8; ++j) y[j] *= bg[j];
        *(v4u*)(K.XN() + (size_t)t * D + 768 + c0) = (v4u){pk2(y[0], y[1]), pk2(y[2], y[3]), pk2(y[4], y[5]), pk2(y[6], y[7])};
    }
}
__device__ __forceinline__ void phase_norm_router(Frame& F, int l) {
    const KA K = KA::fresh(); PHASE_TID;
    const float* gain = K.in(11) + (size_t)l * D;
    const float* wrg = K.in(12) + (size_t)l * D * 4; const float* brg = K.in(13) + (size_t)l * 4;
    const float* wre = K.in(14) + (size_t)l * D * 32; const float* bre = K.in(15) + (size_t)l * 32;
    int* cnt = (int*)(K.ctl() + CW_CNT + 64 * l);
#pragma unroll 1
    for (int t = F.bx * NWAVES + wave; t < T; t += F.G * NWAVES) {
        const f32x4* xr = (const f32x4*)(K.out() + (size_t)t * D) + lane;
        f32x4 v[4]; float s = 0.f;
#pragma unroll
        for (int j = 0; j < 4; ++j) { v[j] = xr[64 * j]; s += (v[j].x * v[j].x + v[j].y * v[j].y) + (v[j].z * v[j].z + v[j].w * v[j].w); }
        const float rs = rsqrtf(wave_sum(s) * (1.f / D) + EPS);
        v2u* o8 = (v2u*)(K.XN() + (size_t)t * D) + lane;
        float acc[36];
#pragma unroll
        for (int j = 0; j < 36; ++j) acc[j] = 0.f;
#pragma unroll
        for (int j = 0; j < 4; ++j) {
            const f32x4 g = ((const f32x4*)gain)[lane + 64 * j];
            const float hv[4] = {v[j].x * rs * g.x, v[j].y * rs * g.y, v[j].z * rs * g.z, v[j].w * rs * g.w};
            v2u w; w.x = pk2(hv[0], hv[1]); w.y = pk2(hv[2], hv[3]); o8[64 * j] = w;
#pragma unroll
            for (int i = 0; i < 4; ++i) {
                const int k = 4 * lane + 256 * j + i; const float xv = hv[i];
                const f32x4 g4 = *(const f32x4*)(wrg + (size_t)k * 4);
                acc[0] += xv * g4.x; acc[1] += xv * g4.y; acc[2] += xv * g4.z; acc[3] += xv * g4.w;
                const f32x4* e4 = (const f32x4*)(wre + (size_t)k * 32);
#pragma unroll
                for (int q = 0; q < 8; ++q) { const f32x4 w4 = e4[q]; acc[4 + 4 * q] += xv * w4.x; acc[5 + 4 * q] += xv * w4.y; acc[6 + 4 * q] += xv * w4.z; acc[7 + 4 * q] += xv * w4.w; }
            }
        }
#pragma unroll
        for (int j = 0; j < 36; ++j) acc[j] = wave_sum(acc[j]);
        if (lane == 0) {
            float gl[4]; int gt = 0;
#pragma unroll
            for (int j = 0; j < 4; ++j) gl[j] = acc[j] + brg[j];
            float gmax = gl[0];
#pragma unroll
            for (int j = 1; j < 4; ++j) if (gl[j] > gmax) { gmax = gl[j]; gt = j; }
            float gs = 0.f;
#pragma unroll
            for (int j = 0; j < 4; ++j) gs += expf(gl[j] - gmax);
            const float gw = 1.0f / gs;
            float el[8];
#pragma unroll
            for (int j = 0; j < 8; ++j) { float vv = 0.f;
#pragma unroll
                for (int g = 0; g < 4; ++g) if (g == gt) vv = acc[4 + g * 8 + j] + bre[g * 8 + j];
                el[j] = vv; }
            int i0 = 0; float m0 = el[0];
#pragma unroll
            for (int j = 1; j < 8; ++j) if (el[j] > m0) { m0 = el[j]; i0 = j; }
            int i1 = -1; float m1 = -INFINITY;
#pragma unroll
            for (int j = 0; j < 8; ++j) if (j != i0 && el[j] > m1) { m1 = el[j]; i1 = j; }
            const float e1 = expf(m1 - m0);
            const float w0 = gw / (1.0f + e1), w1 = gw * e1 / (1.0f + e1);
            const int e0i = gt * 8 + i0, e1i = gt * 8 + i1;
            K.eid()[2 * t] = e0i; K.eid()[2 * t + 1] = e1i; K.ew()[2 * t] = w0; K.ew()[2 * t + 1] = w1;
            atomicAdd(&cnt[e0i], 1); atomicAdd(&cnt[e1i], 1);
        }
    }
}
constexpr int RT_PART = 0, RT_SS = RT_PART + 4 * 8 * 16 * 48 * 4, RT_RS = RT_SS + 4 * 8 * 16 * 4, RT_HIST = RT_RS + 64 * 4;
__device__ __forceinline__ void phase_norm_router_mfma(Frame& F, int l) {
    const KA K = KA::fresh(); PHASE_TID;
    LAS unsigned char* lds = F.lds;
    const int fr = lane & 15, fq = lane >> 4;
    const bf16* whi = K.Wr() + (size_t)l * 2 * 48 * D + (size_t)fr * D + 128 * wave + 8 * fq; const bf16* wlo = whi + 48 * D;
    bf16x8 Wh[4][3], Wl[4][3];
#pragma unroll
    for (int ks = 0; ks < 4; ++ks)
#pragma unroll
        for (int nt = 0; nt < 3; ++nt) { Wh[ks][nt] = *(const bf16x8*)(whi + (size_t)(16 * nt) * D + 32 * ks); Wl[ks][nt] = *(const bf16x8*)(wlo + (size_t)(16 * nt) * D + 32 * ks); }
    f32x4 g0[4], g1[4];
    { const float* gp = K.in(11) + (size_t)l * D + 128 * wave + 8 * fq;
#pragma unroll
      for (int ks = 0; ks < 4; ++ks) { g0[ks] = *(const f32x4*)(gp + 32 * ks); g1[ks] = *(const f32x4*)(gp + 32 * ks + 4); } }
#pragma unroll 1
    for (int blk = F.bx; blk < T / 64; blk += F.G) {
        const bf16* xr = K.XR() + (size_t)(blk * 64 + fr) * D + 128 * wave + 8 * fq;
        __syncthreads();
        if (tid < NE) ((LAS int*)(lds + RT_HIST))[tid] = 0;
#pragma unroll
        for (int tp = 0; tp < 2; ++tp) {
            v4u xa[2][4];
#pragma unroll
            for (int t2 = 0; t2 < 2; ++t2)
#pragma unroll
                for (int ks = 0; ks < 4; ++ks) xa[t2][ks] = *(const v4u*)(xr + (size_t)(16 * (2 * tp + t2)) * D + 32 * ks);
#pragma unroll
            for (int t2 = 0; t2 < 2; ++t2) {
                const int t = 2 * tp + t2;
                f32x4 acc[3]; float ss = 0.f;
#pragma unroll
                for (int nt = 0; nt < 3; ++nt) acc[nt] = (f32x4){0.f, 0.f, 0.f, 0.f};
#pragma unroll
                for (int ks = 0; ks < 4; ++ks) {
                    float xv[8]; unpack8(xa[t2][ks], xv);
#pragma unroll
                    for (int j = 0; j < 8; ++j) ss += xv[j] * xv[j];
                    const bf16x8 Ah = __builtin_bit_cast(bf16x8, xa[t2][ks]);
#pragma unroll
                    for (int nt = 0; nt < 3; ++nt) { acc[nt] = mfma16(Ah, Wh[ks][nt], acc[nt]); acc[nt] = mfma16(Ah, Wl[ks][nt], acc[nt]); }
                }
                ss += shx(ss, 16); ss += shx(ss, 32);
                LAS float* part = (LAS float*)(lds + RT_PART) + (t * 8 + wave) * 16 * 48;
#pragma unroll
                for (int nt = 0; nt < 3; ++nt)
#pragma unroll
                    for (int r = 0; r < 4; ++r) part[(4 * fq + r) * 48 + 16 * nt + fr] = acc[nt][r];
                if (fq == 0) ((LAS float*)(lds + RT_SS))[(t * 8 + wave) * 16 + fr] = ss;
            }
        }
        __syncthreads();
        {
            const int tt = tid >> 3, j = tid & 7, t = blk * 64 + tt;
            const LAS float* p0 = (const LAS float*)(lds + RT_PART) + ((tt >> 4) * 8 * 16 + (tt & 15)) * 48;
            const LAS float* s2 = (const LAS float*)(lds + RT_SS) + (tt >> 4) * 8 * 16 + (tt & 15);
            float sq = 0.f;
#pragma unroll
            for (int w = 0; w < 8; ++w) sq += s2[w * 16];
            const float rs = rsqrtf(sq * (1.f / D) + EPS);
#define RT_DOT(n) (((p0[(n)] + p0[768 + (n)]) + (p0[1536 + (n)] + p0[2304 + (n)])) + ((p0[3072 + (n)] + p0[3840 + (n)]) + (p0[4608 + (n)] + p0[5376 + (n)])))
            float gv = (j < 4) ? RT_DOT(j & 3) * rs + K.in(13)[(size_t)l * 4 + (j & 3)] : -INFINITY; int gi = j;
            const float gmine = gv;
#define RT_ARGMAX_STEP(V, I, FV, FI) do { const float ov = FV(V); const int oi = FI(I); if (ov > V || (ov == V && oi < I)) { V = ov; I = oi; } } while (0)
            RT_ARGMAX_STEP(gv, gi, dppf_x1, dpp_x1); RT_ARGMAX_STEP(gv, gi, dppf_x2, dpp_x2); RT_ARGMAX_STEP(gv, gi, dppf_hm, dpp_hm);
            float ge = (j < 4) ? expf(gmine - gv) : 0.f;
            ge = sum8(ge);
            const float gw = 1.0f / ge; const int gt = gi;
            const float ev = RT_DOT(4 + gt * 8 + j) * rs + K.in(15)[(size_t)l * 32 + gt * 8 + j];
#undef RT_DOT
            float m0 = ev; int i0 = j;
            RT_ARGMAX_STEP(m0, i0, dppf_x1, dpp_x1); RT_ARGMAX_STEP(m0, i0, dppf_x2, dpp_x2); RT_ARGMAX_STEP(m0, i0, dppf_hm, dpp_hm);
            float m1 = (j == i0) ? -INFINITY : ev; int i1 = j;
            RT_ARGMAX_STEP(m1, i1, dppf_x1, dpp_x1); RT_ARGMAX_STEP(m1, i1, dppf_x2, dpp_x2); RT_ARGMAX_STEP(m1, i1, dppf_hm, dpp_hm);
#undef RT_ARGMAX_STEP
            if (j == 0) {
                ((LAS float*)(lds + RT_RS))[tt] = rs;
                const float e1 = expf(m1 - m0);
                const float w0 = gw / (1.0f + e1), w1 = gw * e1 / (1.0f + e1);
                const int e0i = gt * 8 + i0, e1i = gt * 8 + i1;
                K.eid()[2 * t] = e0i; K.eid()[2 * t + 1] = e1i; K.ew()[2 * t] = w0; K.ew()[2 * t + 1] = w1;
                LAS int* hist = (LAS int*)(lds + RT_HIST);
                K.slot_of()[2 * t] = __hip_atomic_fetch_add(hist + e0i, 1, __ATOMIC_RELAXED, __HIP_MEMORY_SCOPE_WORKGROUP);
                K.slot_of()[2 * t + 1] = __hip_atomic_fetch_add(hist + e1i, 1, __ATOMIC_RELAXED, __HIP_MEMORY_SCOPE_WORKGROUP);
            }
        }
        __syncthreads();
        if (tid < NE) K.blkcnt()[(size_t)(l * (T / 64) + blk) * NE + tid] = ((LAS int*)(lds + RT_HIST))[tid];
        {
            bf16* hp = K.XN() + (size_t)(blk * 64 + fr) * D + 128 * wave + 8 * fq;
#pragma unroll
            for (int t = 0; t < 4; ++t) {
                const float rs = ((const LAS float*)(lds + RT_RS))[16 * t + fr];
#pragma unroll
                for (int ks = 0; ks < 4; ++ks) {
                    float xv[8]; unpack8(*(const v4u*)(xr + (size_t)(16 * t) * D + 32 * ks), xv);
                    *(v4u*)(hp + (size_t)(16 * t) * D + 32 * ks) = (v4u){pk2(xv[0] * rs * g0[ks].x, xv[1] * rs * g0[ks].y), pk2(xv[2] * rs * g0[ks].z, xv[3] * rs * g0[ks].w), pk2(xv[4] * rs * g1[ks].x, xv[5] * rs * g1[ks].y), pk2(xv[6] * rs * g1[ks].z, xv[7] * rs * g1[ks].w)};
                }
            }
        }
    }
}
__device__ __forceinline__ void phase_scatter(Frame& F, int l) {
    const KA K = KA::fresh(); PHASE_TID;
    LAS int* sm = (LAS int*)F.lds;
    const int* bc = K.blkcnt() + (size_t)l * (T / 64) * NE;
    constexpr int NBLK = T / 64;
#pragma unroll 1
    for (int blk = F.bx; blk < NBLK; blk += F.G) {
        __syncthreads();
        {   const int e = tid & 31, part = tid >> 5;
            int tot = 0, pre = 0;
#pragma unroll
            for (int j = 0; j < NBLK / 16; ++j) { const int bb = part * (NBLK / 16) + j; const int c = bc[bb * NE + e]; tot += c; if (bb < blk) pre += c; }
            sm[part * 32 + e] = tot; sm[512 + part * 32 + e] = pre; }
        __syncthreads();
        if (tid < 32) { int tot = 0, pre = 0;
#pragma unroll
            for (int p = 0; p < 16; ++p) { tot += sm[p * 32 + tid]; pre += sm[512 + p * 32 + tid]; }
            sm[1056 + tid] = tot; sm[1024 + tid] = pre; }
        __syncthreads();
        if (tid == 0) { int a = 0; for (int e = 0; e < NE; ++e) { const int c = sm[1056 + e]; sm[1024 + e] += a; a += c; } }
        if (blk == 0 && tid < 32) ((int*)(K.ctl() + CW_CNT + 64 * l))[tid] = sm[1056 + tid];
        __syncthreads();
        if (tid < 128) { const int a = blk * 128 + tid; const int e = K.eid()[a]; const int pos = sm[1024 + e] + K.slot_of()[a]; K.slot_tok()[pos] = a >> 1; K.slot_of()[a] = pos; }
    }
    __syncthreads();
}
template <bool DUAL>
__device__ __forceinline__ void gemm_core(const bf16* A, const int* rowoff, int K, const float* B0, const float* B1, int ldb, int n0,
                                          float (&acc0)[4][4], float (&acc1)[4][4], float* As, float* Bs0, float* Bs1) {
    const int tid = __builtin_amdgcn_readfirstlane(threadIdx.x >> 6) * 64 + fresh_lane(), tx = tid & 15, ty = tid >> 4;
    const int ar = tid >> 2, ak = (tid & 3) * 4;
    const int bk = (tid >> 4) & 15, bn = (tid & 15) * 4;
    const long aoff = rowoff[ar];
#pragma unroll
    for (int i = 0; i < 4; ++i)
#pragma unroll
        for (int j = 0; j < 4; ++j) { acc0[i][j] = 0.f; acc1[i][j] = 0.f; }
#pragma unroll 1
    for (int k0 = 0; k0 < K; k0 += 16) {
        v2u av = (v2u){0u, 0u};
        if (aoff >= 0) av = *(const v2u*)(A + aoff + k0 + ak);
        f32x4 bv0 = (f32x4){0.f, 0.f, 0.f, 0.f}, bv1 = bv0;
        if (tid < 256) { bv0 = *(const f32x4*)(B0 + (size_t)(k0 + bk) * ldb + n0 + bn); if (DUAL) bv1 = *(const f32x4*)(B1 + (size_t)(k0 + bk) * ldb + n0 + bn); }
        __syncthreads();
        As[(ak + 0) * 132 + ar] = bflo(av.x); As[(ak + 1) * 132 + ar] = bfhi(av.x); As[(ak + 2) * 132 + ar] = bflo(av.y); As[(ak + 3) * 132 + ar] = bfhi(av.y);
        if (tid < 256) { *(f32x4*)(Bs0 + bk * 64 + bn) = bv0; if (DUAL) *(f32x4*)(Bs1 + bk * 64 + bn) = bv1; }
        __syncthreads();
#pragma unroll
        for (int kk = 0; kk < 16; ++kk) {
            const f32x4 a4 = *(const f32x4*)(As + kk * 132 + ty * 4);
            const f32x4 b4 = *(const f32x4*)(Bs0 + kk * 64 + tx * 4);
#pragma unroll
            for (int i = 0; i < 4; ++i)
#pragma unroll
                for (int j = 0; j < 4; ++j) acc0[i][j] += a4[i] * b4[j];
            if (DUAL) {
                const f32x4 c4 = *(const f32x4*)(Bs1 + kk * 64 + tx * 4);
#pragma unroll
                for (int i = 0; i < 4; ++i)
#pragma unroll
                    for (int j = 0; j < 4; ++j) acc1[i][j] += a4[i] * c4[j];
            }
        }
    }
}
template <int MODE>
__device__ __forceinline__ void phase_moe_ref(Frame& F, int l) {
    const KA K = KA::fresh(); PHASE_TID;
    float* As = F.smem; float* Bs0 = F.smem + 16 * 132; float* Bs1 = Bs0 + 16 * 64; int* rowoff = (int*)(Bs1 + 16 * 64); int* offs = rowoff + 128; int* toff = offs + 33;
    int* cnt = (int*)(K.ctl() + CW_CNT + 64 * l);
    const int tx = tid & 15, ty = tid >> 4;
    __syncthreads();
    if (tid == 0) { int a = 0, tt = 0; for (int e = 0; e < NE; ++e) { offs[e] = a; toff[e] = tt; const int c = cnt[e]; a += c; tt += (c + 127) / 128; } offs[NE] = a; toff[NE] = tt; }
    __syncthreads();
    constexpr int N = (MODE == 1) ? DE : D, KD = (MODE == 1) ? D : DE, NTN = N / 64;
    const int ntiles = toff[NE] * NTN;
#pragma unroll 1
    for (int t = F.bx; t < ntiles; t += F.G) {
        const int rt = t / NTN, tn = t % NTN;
        int e = 0;
        for (int j = 1; j < NE; ++j) if (toff[j] <= rt) e = j;
        const int r0 = offs[e] + (rt - toff[e]) * 128, rend = offs[e + 1];
        __syncthreads();
        if (tid < 128) { const int r = r0 + tid; rowoff[tid] = (r < rend) ? ((MODE == 1) ? K.slot_tok()[r] * D : r * DE) : -1; }
        __syncthreads();
        float acc0[4][4], acc1[4][4];
        if (MODE == 1) {
            const float* Wg = K.in(16) + ((size_t)l * NE + e) * D * DE; const float* Wu = K.in(17) + ((size_t)l * NE + e) * D * DE;
            gemm_core<true>(K.XN(), rowoff, KD, Wg, Wu, DE, tn * 64, acc0, acc1, As, Bs0, Bs1);
        } else {
            const float* Wd = K.in(18) + ((size_t)l * NE + e) * DE * D;
            gemm_core<false>(K.H1(), rowoff, KD, Wd, nullptr, D, tn * 64, acc0, acc1, As, Bs0, nullptr);
        }
#pragma unroll
        for (int i = 0; i < 4; ++i) {
            const int r = r0 + ty * 4 + i;
            if (r < rend) {
                v2u o;
                if (MODE == 1) { o.x = pk2(silu(acc0[i][0]) * acc1[i][0], silu(acc0[i][1]) * acc1[i][1]); o.y = pk2(silu(acc0[i][2]) * acc1[i][2], silu(acc0[i][3]) * acc1[i][3]);
                    *(v2u*)(K.H1() + (size_t)r * DE + tn * 64 + tx * 4) = o; }
                else { o.x = pk2(acc0[i][0], acc0[i][1]); o.y = pk2(acc0[i][2], acc0[i][3]); *(v2u*)(K.Y() + (size_t)r * D + tn * 64 + tx * 4) = o; }
            }
        }
    }
    __syncthreads();
}

constexpr int TAB_OFF = LDSCTL_OFF + 1024;
__device__ __forceinline__ void moe_tables(Frame& F, int l) {
    const KA K = KA::fresh(); PHASE_TID;
    LAS int* tab = (LAS int*)(F.lds + TAB_OFF); LAS int* offs = tab + 4 + 4 * 164; LAS int* fpre = offs + 40; LAS int* ppre = fpre + 40;
    const int* cnt = (const int*)(K.ctl() + CW_CNT + 64 * l);
    __syncthreads();
    if (tid == 0) { int a = 0, f = 0, p = 0; for (int e = 0; e < NE; ++e) { const int c = cnt[e]; offs[e] = a; fpre[e] = f; ppre[e] = p; a += c; f += c >> 8; p += (c & 255) ? 1 : 0; }
        offs[NE] = a; fpre[NE] = f; ppre[NE] = p; tab[0] = f + p; }
    __syncthreads();
    const int nfull = fpre[NE], ntile = nfull + ppre[NE];
    if (tid < nfull) { int e = 0; for (int j = 1; j < NE; ++j) if (fpre[j] <= tid) e = j; tab[4 + 4 * tid] = e; tab[5 + 4 * tid] = offs[e] + (tid - fpre[e]) * 256; tab[6 + 4 * tid] = offs[e + 1]; }
    else if (tid < nfull + NE) {
        const int e = tid - nfull, rows = (offs[e + 1] - offs[e]) & 255;
        if (rows) { int rank = 0; for (int j = 0; j < NE; ++j) { const int rj = (offs[j + 1] - offs[j]) & 255; rank += (rj > rows || (rj == rows && j < e)) ? 1 : 0; }
            const int q = nfull + rank; tab[4 + 4 * q] = e; tab[5 + 4 * q] = offs[e] + (fpre[e + 1] - fpre[e]) * 256; tab[6 + 4 * q] = offs[e + 1]; }
    }
    __syncthreads();
    (void)ntile;
}
template <int SUB>
__device__ __forceinline__ void phase_moe(Frame& F, int l) {
    if (SUB == 0) moe_tables(F, l);
    const KA K = KA::fresh();
    int c_ = F.bx; asm volatile("" : "+s"(c_));
    const int G = F.G, c = (c_ & 7) * (G >> 3) + (c_ >> 3);
    const LAS int* tab = (const LAS int*)(F.lds + TAB_OFF);
    const int ntile = __builtin_amdgcn_readfirstlane(tab[0]), ngu = 2 * ntile, nleft = ngu > G ? ngu - G : 0, jX = ngu > G ? (G >> 1) : ntile, W = G - nleft;
    const int yd = (jX * 4 < 2 * W) ? jX * 4 : 2 * W;
    bool do_gu = false, do_dn = false; pg8::MoeSched So{tab, 2, 0, 0, G, c};
    if (SUB == 0) { do_gu = true; So.npn = 2; So.first = 0; So.end = ngu < G ? ngu : G; So.stride = G; So.c = c; }
    if (SUB == 1) { if (c < nleft) { do_gu = true; So.npn = 2; So.first = G; So.end = ngu; So.stride = G; So.c = c; }
                    else { do_dn = true; So.npn = 4; So.first = 0; So.end = yd; So.stride = W; So.c = c - nleft; } }
    if (SUB == 2) { do_dn = true; So.npn = 4; So.first = yd; So.end = ntile * 4; So.stride = G; So.c = c; }
    if (do_gu) { pg8::EpiMoeH E{K.H1()};
        pg8::gemm_phase_moe<pg8::EpiMoeH, pg8::MoeSched, true, 512, D>(F.lds, K.XN(), K.WguT() + (size_t)l * NE * 512 * D, K.slot_tok(), So, E, F.wave); }
    if (do_dn) { pg8::EpiMoeY E{K.Y()};
        pg8::gemm_phase_moe<pg8::EpiMoeY, pg8::MoeSched, false, D, DE>(F.lds, K.H1(), K.WdT() + (size_t)l * NE * D * DE, nullptr, So, E, F.wave); }
}
__device__ __forceinline__ void phase_combine(Frame& F, int l) {
    const KA K = KA::fresh(); PHASE_TID;
    const bool last = (l == DEPTH - 1);
    const float* gain = last ? K.in(19) : (K.in(1) + (size_t)(l + 1) * D);
    f32x4 g4[4];
#pragma unroll
    for (int j = 0; j < 4; ++j) g4[j] = ((const f32x4*)gain)[lane + 64 * j];
    const int tstep = F.G * NWAVES;
    int t = F.bx * NWAVES + wave;
    v2u xw[4], ya[4], yb[4]; float w0 = 0.f, w1 = 0.f;
#define CB_LOAD(tt) do { const int s0_ = K.slot_of()[2 * (tt)], s1_ = K.slot_of()[2 * (tt) + 1]; w0n = K.ew()[2 * (tt)]; w1n = K.ew()[2 * (tt) + 1]; \
        const v2u* xr_ = (const v2u*)(K.XR() + (size_t)(tt) * D) + lane; const v2u* y0_ = (const v2u*)(K.Y() + (size_t)s0_ * D) + lane; const v2u* y1_ = (const v2u*)(K.Y() + (size_t)s1_ * D) + lane; \
        _Pragma("unroll") for (int j = 0; j < 4; ++j) { xn[j] = xr_[64 * j]; an[j] = y0_[64 * j]; bn[j] = y1_[64 * j]; } } while (0)
    { v2u xn[4], an[4], bn[4]; float w0n = 0.f, w1n = 0.f;
      if (t < T) { CB_LOAD(t);
#pragma unroll
        for (int j = 0; j < 4; ++j) { xw[j] = xn[j]; ya[j] = an[j]; yb[j] = bn[j]; } w0 = w0n; w1 = w1n; } }
#pragma unroll 1
    for (; t < T; t += tstep) {
        v2u xn[4], an[4], bn[4]; float w0n = 0.f, w1n = 0.f;
        if (t + tstep < T) CB_LOAD(t + tstep);
        f32x4 v[4]; float s = 0.f;
#pragma unroll
        for (int j = 0; j < 4; ++j) { const v2u x_ = xw[j], a = ya[j], b = yb[j];
            v[j].x = bflo(x_.x) + w0 * bflo(a.x) + w1 * bflo(b.x); v[j].y = bfhi(x_.x) + w0 * bfhi(a.x) + w1 * bfhi(b.x); v[j].z = bflo(x_.y) + w0 * bflo(a.y) + w1 * bflo(b.y); v[j].w = bfhi(x_.y) + w0 * bfhi(a.y) + w1 * bfhi(b.y);
            s += (v[j].x * v[j].x + v[j].y * v[j].y) + (v[j].z * v[j].z + v[j].w * v[j].w); }
        const float rs = rsqrtf(wave_sum(s) * (1.f / D) + EPS);
        if (last) {
            f32x4* orow = (f32x4*)(K.out() + (size_t)t * D) + lane;
#pragma unroll
            for (int j = 0; j < 4; ++j) orow[64 * j] = (f32x4){v[j].x * rs * g4[j].x, v[j].y * rs * g4[j].y, v[j].z * rs * g4[j].z, v[j].w * rs * g4[j].w};
        } else {
            v2u* xr = (v2u*)(K.XR() + (size_t)t * D) + lane; v2u* o8 = (v2u*)(K.XN() + (size_t)t * D) + lane;
#pragma unroll
            for (int j = 0; j < 4; ++j) { xr[64 * j] = (v2u){pk2(v[j].x, v[j].y), pk2(v[j].z, v[j].w)};
                o8[64 * j] = (v2u){pk2(v[j].x * rs * g4[j].x, v[j].y * rs * g4[j].y), pk2(v[j].z * rs * g4[j].z, v[j].w * rs * g4[j].w)}; }
        }
#pragma unroll
        for (int j = 0; j < 4; ++j) { xw[j] = xn[j]; ya[j] = an[j]; yb[j] = bn[j]; }
        w0 = w0n; w1 = w1n;
    }
#undef CB_LOAD
}

struct Args { const float* in[20]; float* out; unsigned char* ws; };
__global__ void __launch_bounds__(NT, 2) fwd_kernel(Args args) {
    extern __shared__ __attribute__((aligned(16))) unsigned char lds_raw[];
    Frame F;
    F.lds = (LAS unsigned char*)lds_raw; F.smem = (float*)lds_raw;
    F.G = gridDim.x; F.bx = blockIdx.x; F.wave = __builtin_amdgcn_readfirstlane(threadIdx.x >> 6);
    volatile LAS unsigned* MISC = (volatile LAS unsigned*)(F.lds + MISC_OFF);
    for (int u = threadIdx.x; u < (LDS_BYTES - LDSCTL_OFF) / 4; u += NT) ((LAS unsigned*)(F.lds + LDSCTL_OFF))[u] = 0u;
    __syncthreads();
    XcdBarrier bar; { const KA K = KA::fresh(); bar = xcd_barrier_post(K.ctl() + CW_BAR, MISC + 8); }
#define GRID_BAR() xcd_barrier(bar)

    p0_prologue(F);
    GRID_BAR();
    for (int l = 0; l < DEPTH; ++l) {
        {
            const KA K = KA::fresh(); PHASE_TID;
            pg8::Gemm g{K.XN(), K.WinT() + (size_t)l * PLD * D, T, PLD, D}; pg8::StaticOrder So; int c_ = F.bx; asm volatile("" : "+s"(c_)); So.init(T, PLD, F.G, c_);
            pg8::EpiBf16Plain E{K.P(), PLD};
            pg8::gemm_phase<pg8::EpiBf16Plain, pg8::StaticOrder, PG8_ALIGN, PG8_SP2>(F.lds, g, So, E, F.wave);
        }
        GRID_BAR();
        phase_gla_A2(F, l);
        phase_gmlp_mfma(F, l);
        phase_conv(F, l);
        GRID_BAR();
        phase_gla_aggscan(F);
        GRID_BAR();
        phase_gla_C2(F, l);
        GRID_BAR();
        {
            const KA K = KA::fresh(); PHASE_TID;
            pg8::Gemm g{K.XN(), K.WoutT() + (size_t)l * D * D, T, D, D}; pg8::StaticOrder So; int c_ = F.bx; asm volatile("" : "+s"(c_)); So.init(T, D, F.G, c_);
            if (l == 0) { pg8::EpiBf16Res<true> E{K.XR(), K.in(0), D}; pg8::gemm_phase<pg8::EpiBf16Res<true>, pg8::StaticOrder, PG8_ALIGN, PG8_SP2>(F.lds, g, So, E, F.wave); }
            else { pg8::EpiBf16Res<false> E{K.XR(), K.XR(), D}; pg8::gemm_phase<pg8::EpiBf16Res<false>, pg8::StaticOrder, PG8_ALIGN, PG8_SP2>(F.lds, g, So, E, F.wave); }
        }
        GRID_BAR();
        phase_norm_router_mfma(F, l);
        GRID_BAR();
        phase_scatter(F, l);
        GRID_BAR();
        phase_moe<0>(F, l);
        GRID_BAR();
        phase_moe<1>(F, l);
        GRID_BAR();
        phase_moe<2>(F, l);
        GRID_BAR();
        phase_combine(F, l);
        if (l + 1 < DEPTH) GRID_BAR();
    }
}

extern "C" void kernel_launch(void* const* d_in, const int* in_sizes, int n_in, void* d_out, int out_size, void* d_ws, size_t ws_size, hipStream_t stream) {
    static int grid_blocks = 0;
    if (!grid_blocks) {
        int dev = 0, cus = 0, per_cu = 0;
        (void)hipGetDevice(&dev);
        (void)hipDeviceGetAttribute(&cus, hipDeviceAttributeMultiprocessorCount, dev);
        (void)hipFuncSetAttribute((const void*)fwd_kernel, hipFuncAttributeMaxDynamicSharedMemorySize, LDS_BYTES);
        (void)hipOccupancyMaxActiveBlocksPerMultiprocessor(&per_cu, fwd_kernel, NT, LDS_BYTES);
        if (per_cu < 1) { fprintf(stderr, "kernel_launch: occupancy query says %d blocks/CU\n", per_cu); per_cu = 1; }
        grid_blocks = cus;
        if (ws_size < WS_END) { fprintf(stderr, "kernel_launch: workspace too small (%zu < %zu)\n", ws_size, (size_t)WS_END); grid_blocks = -1; }
    }
    if (grid_blocks < 0) return;
    (void)hipMemsetAsync((char*)d_ws + WS_CTL, 0, 131072, stream);
    Args a{};
    for (int i = 0; i < 20; ++i) a.in[i] = (const float*)d_in[i];
    a.out = (float*)d_out; a.ws = (unsigned char*)d_ws;
    void* args[] = {&a};
    hipError_t e = hipLaunchCooperativeKernel((void*)fwd_kernel, dim3(grid_blocks), dim3(NT), args, LDS_BYTES, stream);
    if (e != hipSuccess) fprintf(stderr, "cooperative launch failed: %s (grid %d)\n", hipGetErrorString(e), grid_blocks);
}
```

```cpp
#include <hip/hip_runtime.h>
#include <hip/hip_cooperative_groups.h>
#include <cstdio>
#include <cstdint>
namespace cg = cooperative_groups;
__device__ __forceinline__ int fresh_lane() { unsigned m = 0xffffffffu; asm volatile("" : "+s"(m)); return (int)__builtin_amdgcn_mbcnt_hi(m, __builtin_amdgcn_mbcnt_lo(m, 0u)); }
__device__ __forceinline__ float shx(float v, int o) { return __int_as_float(__builtin_amdgcn_ds_bpermute((fresh_lane() ^ o) << 2, __float_as_int(v))); }
__device__ __forceinline__ int dpp_x1(int v) { return __builtin_amdgcn_update_dpp(v, v, 0xB1, 0xF, 0xF, false); }
__device__ __forceinline__ int dpp_x2(int v) { return __builtin_amdgcn_update_dpp(v, v, 0x4E, 0xF, 0xF, false); }
__device__ __forceinline__ int dpp_hm(int v) { return __builtin_amdgcn_update_dpp(v, v, 0x141, 0xF, 0xF, false); }
__device__ __forceinline__ int dpp_rm(int v) { return __builtin_amdgcn_update_dpp(v, v, 0x140, 0xF, 0xF, false); }
__device__ __forceinline__ float dppf_x1(float v) { return __int_as_float(dpp_x1(__float_as_int(v))); }
__device__ __forceinline__ float dppf_x2(float v) { return __int_as_float(dpp_x2(__float_as_int(v))); }
__device__ __forceinline__ float dppf_hm(float v) { return __int_as_float(dpp_hm(__float_as_int(v))); }
__device__ __forceinline__ float dppf_rm(float v) { return __int_as_float(dpp_rm(__float_as_int(v))); }
__device__ __forceinline__ float sum8(float v) { v += dppf_x1(v); v += dppf_x2(v); v += dppf_hm(v); return v; }
__device__ __forceinline__ float sum16(float v) { v = sum8(v); v += dppf_rm(v); return v; }
namespace pg8 {
#define PG8_LAS __attribute__((address_space(3)))
typedef unsigned short bf16_t;
typedef short bf16x8 __attribute__((ext_vector_type(8)));
typedef float f32x4 __attribute__((ext_vector_type(4)));
typedef unsigned u32x4 __attribute__((ext_vector_type(4)));
constexpr int BM = 256, BK = 64, HALF = 128, HTB = HALF * BK * 2  , STAGE_BYTES = 8 * HTB, NXCD = 8, WGM = 8;

__host__ __device__ __forceinline__ int lds_byte(int r, int c) { const int st = (r >> 4) * 2 + (c >> 5), rr = r & 15, cc = c & 31, ob = rr * 64 + cc * 2; return st * 1024 + (ob ^ (((ob >> 9) & 1) << 5)); }
__host__ __device__ __forceinline__ void stage_rc(int b, int& R, int& C) { const int st = b / 1024, sb = b % 1024, swz = sb ^ (((sb >> 9) & 1) << 5); R = (st >> 1) * 16 + swz / 64; C = (st & 1) * 32 + (swz % 64) / 2; }
__host__ __device__ __forceinline__ int perm32(int rho) { const int n = rho >> 4, i = rho & 15; return 8 * (i >> 2) + 4 * n + (i & 3); }

struct Unit { int pm, pn; };
struct Gemm { const bf16_t* A; const bf16_t* Bt; int M, N, K; };

struct StaticOrder {
    int nM, nN, nwg, G, c;
    __host__ __device__ void init(int M, int N, int G_, int c_) { nM = M / BM; nN = N / BM; nwg = nM * nN; G = G_; c = c_; }
    __host__ __device__ bool next(int i, Unit& u) const {
        const long L = (long)i * G + c; if (L >= nwg) return false;
        int wgid = (int)L; { const int q = nwg / NXCD, r = nwg % NXCD, xcd = wgid % NXCD, off = wgid / NXCD; wgid = (xcd < r ? xcd * (q + 1) : r * (q + 1) + (xcd - r) * q) + off; }
        const int nig = WGM * nN, gid = wgid / nig, fm = gid * WGM, gsz = (nM - fm) < WGM ? (nM - fm) : WGM;
        u.pm = fm + ((wgid % nig) % gsz); u.pn = (wgid % nig) / gsz; return true;
    }
    __device__ __forceinline__ void a_ready(const Unit&) const {}
    __device__ __forceinline__ void done(const Unit&) const {}
};


__device__ __forceinline__ unsigned cvt_pk_bf16(float lo, float hi) { unsigned r; asm volatile("v_cvt_pk_bf16_f32 %0, %1, %2" : "=v"(r) : "v"(lo), "v"(hi)); return r; }
struct EpiBf16Plain {
    static constexpr bool PERM = true, AFTER_DRAIN = false;
    bf16_t* O; int ldc;
    __device__ __forceinline__ void operator()(const f32x4 (&acc)[2][2][4][2], const Unit& u, int wr, int wc, int fr, int fq) const {
        const int row0 = u.pm * BM + wr * 64 + fr, col0 = u.pn * BM + wc * 32 + 8 * fq;
#pragma unroll
        for (int ai = 0; ai < 2; ++ai)
#pragma unroll
            for (int m = 0; m < 4; ++m) { bf16_t* rowp = O + (size_t)(row0 + ai * HALF + m * 16) * ldc + col0;
#pragma unroll
                for (int bj = 0; bj < 2; ++bj) { const f32x4 v0 = acc[ai][bj][m][0], v1 = acc[ai][bj][m][1];
                    u32x4 w; w.x = cvt_pk_bf16(v0[0], v0[1]); w.y = cvt_pk_bf16(v0[2], v0[3]); w.z = cvt_pk_bf16(v1[0], v1[1]); w.w = cvt_pk_bf16(v1[2], v1[3]);
                    *(u32x4*)(rowp + bj * HALF) = w; } }
    }
};
template <bool RES_F32>
struct EpiBf16Res {
    static constexpr bool PERM = true, AFTER_DRAIN = false;
    bf16_t* O; const void* R; int ldc;
    __device__ __forceinline__ void operator()(const f32x4 (&acc)[2][2][4][2], const Unit& u, int wr, int wc, int fr, int fq) const {
        const int row0 = u.pm * BM + wr * 64 + fr, col0 = u.pn * BM + wc * 32 + 8 * fq;
#pragma unroll
        for (int ai = 0; ai < 2; ++ai)
#pragma unroll
            for (int m = 0; m < 4; ++m) { const size_t off = (size_t)(row0 + ai * HALF + m * 16) * ldc + col0;
#pragma unroll
                for (int bj = 0; bj < 2; ++bj) { f32x4 v0 = acc[ai][bj][m][0], v1 = acc[ai][bj][m][1];
                    if (RES_F32) { const float* rp = (const float*)R + off + bj * HALF; v0 += *(const f32x4*)rp; v1 += *(const f32x4*)(rp + 4); }
                    else { const u32x4 rw = *(const u32x4*)((const bf16_t*)R + off + bj * HALF);
                        v0[0] += __uint_as_float(rw.x << 16); v0[1] += __uint_as_float(rw.x & 0xffff0000u); v0[2] += __uint_as_float(rw.y << 16); v0[3] += __uint_as_float(rw.y & 0xffff0000u);
                        v1[0] += __uint_as_float(rw.z << 16); v1[1] += __uint_as_float(rw.z & 0xffff0000u); v1[2] += __uint_as_float(rw.w << 16); v1[3] += __uint_as_float(rw.w & 0xffff0000u); }
                    u32x4 w; w.x = cvt_pk_bf16(v0[0], v0[1]); w.y = cvt_pk_bf16(v0[2], v0[3]); w.z = cvt_pk_bf16(v1[0], v1[1]); w.w = cvt_pk_bf16(v1[2], v1[3]);
                    *(u32x4*)(O + off + bj * HALF) = w; } }
    }
};
struct EpiF32Res {
    static constexpr bool PERM = false, AFTER_DRAIN = false;
    float* C; const float* R; int ldc;
    __device__ __forceinline__ void operator()(const f32x4 (&acc)[2][2][4][2], const Unit& u, int wr, int wc, int fr, int fq) const {
        const int row0 = u.pm * BM + wr * 64 + fr, col0 = u.pn * BM + wc * 32 + 4 * fq;
#pragma unroll
        for (int ai = 0; ai < 2; ++ai)
#pragma unroll
            for (int m = 0; m < 4; ++m) { const size_t off = (size_t)(row0 + ai * HALF + m * 16) * ldc + col0;
#pragma unroll
                for (int bj = 0; bj < 2; ++bj)
#pragma unroll
                    for (int n = 0; n < 2; ++n) { const f32x4 r = *(const f32x4*)(R + off + bj * HALF + n * 16); *(f32x4*)(C + off + bj * HALF + n * 16) = r + acc[ai][bj][m][n]; } }
    }
};
template <class Epi, class Sched, bool ALIGN_EPI = false, bool SP2 = false>
__device__ __forceinline__ void gemm_phase(PG8_LAS unsigned char* lds, const Gemm g, const Sched& S, const Epi& E, int wave_id) {
    asm volatile("" : "+s"(wave_id));
    const int lane = fresh_lane(), wid = wave_id, tid = wid * 64 + lane, wr = wid >> 2, wc = wid & 3, fr = lane & 15, fq = lane >> 4;
    const int K = g.K, nt = K / BK;
    unsigned voffA[2], voffB[2];
#pragma unroll
    for (int i = 0; i < 2; ++i) { int R, C; stage_rc(tid * 16 + i * 8192, R, C); const int Rb = Epi::PERM ? ((R & ~31) + perm32(R & 31)) : R;
        voffA[i] = (unsigned)(R * K + C) * 2u; voffB[i] = (unsigned)(Rb * K + C) * 2u; }
    const size_t kstep = (size_t)(BK * 2);
    const size_t hstep = (size_t)HALF * K * 2;
    const size_t tstep = 2 * hstep;
    const unsigned ldsw = (unsigned)wid * 1024u;
    const int aoff = lds_byte(wr * 64 + fr, fq * 8), boff = lds_byte(wc * 32 + fr, fq * 8);
#define PG8_SA(b, h) (((b) * 2 + (h)) * HTB)
#define PG8_SB(b, h) ((4 + (b) * 2 + (h)) * HTB)
#define PG8_STAGE(bufoff, gbase, voff) do { _Pragma("unroll") for (int _i = 0; _i < 2; ++_i) \
        __builtin_amdgcn_global_load_lds((const unsigned*)((const char*)(gbase) + (voff)[_i]), (PG8_LAS unsigned*)(lds + (bufoff) + ldsw + _i * 8192), 16, 0, 0); } while (0)
#define PG8_LDA(dst, b, h) do { _Pragma("unroll") for (int m = 0; m < 4; ++m) _Pragma("unroll") for (int k = 0; k < 2; ++k) dst[m][k] = *(const PG8_LAS bf16x8*)(lds + PG8_SA(b, h) + aoff + m * 2048 + k * 1024); } while (0)
#define PG8_LDB(dst, b, h) do { _Pragma("unroll") for (int n = 0; n < 2; ++n) _Pragma("unroll") for (int k = 0; k < 2; ++k) dst[n][k] = *(const PG8_LAS bf16x8*)(lds + PG8_SB(b, h) + boff + n * 2048 + k * 1024); } while (0)
#define PG8_MMA(ai, bj, At, Bt) do { __builtin_amdgcn_s_setprio(1); _Pragma("unroll") for (int m = 0; m < 4; ++m) _Pragma("unroll") for (int n = 0; n < 2; ++n) _Pragma("unroll") for (int k = 0; k < 2; ++k) \
        acc[ai][bj][m][n] = __builtin_amdgcn_mfma_f32_16x16x32_bf16(Bt[n][k], At[m][k], acc[ai][bj][m][n], 0, 0, 0); __builtin_amdgcn_s_setprio(0); } while (0)
#define PG8_WAIT_V(n) asm volatile("s_waitcnt vmcnt(" #n ")" ::: "memory")
#define PG8_WAIT_L(n) asm volatile("s_waitcnt lgkmcnt(" #n ")" ::: "memory")
#define PG8_BAR __builtin_amdgcn_s_barrier()
#define PG8_SCHED __builtin_amdgcn_sched_barrier(0)
    Unit cur, nxt; int ui = 0;
    if (!S.next(0, cur)) return;
    f32x4 acc[2][2][4][2];
#pragma unroll
    for (int a = 0; a < 2; ++a)
#pragma unroll
        for (int b = 0; b < 2; ++b)
#pragma unroll
            for (int m = 0; m < 4; ++m)
#pragma unroll
                for (int n = 0; n < 2; ++n) acc[a][b][m][n] = (f32x4){0.f, 0.f, 0.f, 0.f};
    bf16x8 At[4][2], B0[2][2], B1[2][2];
    const char* cA = (const char*)g.A + (size_t)cur.pm * tstep; const char* cB = (const char*)g.Bt + (size_t)cur.pn * tstep;
    S.a_ready(cur);
    if constexpr (SP2) {
        PG8_STAGE(PG8_SB(0, 0), cB, voffB); PG8_STAGE(PG8_SB(0, 1), cB + hstep, voffB); PG8_STAGE(PG8_SA(0, 0), cA, voffA); PG8_STAGE(PG8_SA(0, 1), cA + hstep, voffA);
        if (wr == 1) PG8_BAR;
        PG8_WAIT_V(2); PG8_BAR;
        PG8_STAGE(PG8_SB(1, 0), cB + kstep, voffB); PG8_STAGE(PG8_SA(1, 0), cA + kstep, voffA); PG8_STAGE(PG8_SB(1, 1), cB + hstep + kstep, voffB);
        PG8_WAIT_V(6); PG8_BAR;
    } else {
        PG8_STAGE(PG8_SB(0, 0), cB, voffB); PG8_STAGE(PG8_SA(0, 0), cA, voffA); PG8_STAGE(PG8_SB(0, 1), cB + hstep, voffB); PG8_STAGE(PG8_SA(0, 1), cA + hstep, voffA);
        if (wr == 1) PG8_BAR;
        PG8_WAIT_V(4); PG8_BAR;
        PG8_STAGE(PG8_SB(1, 0), cB + kstep, voffB); PG8_STAGE(PG8_SA(1, 0), cA + kstep, voffA); PG8_STAGE(PG8_SB(1, 1), cB + hstep + kstep, voffB);
        PG8_WAIT_V(6); PG8_BAR;
    }
    for (;;) {
        const bool has_next = S.next(ui + 1, nxt);
        const char* nA = has_next ? (const char*)g.A + (size_t)nxt.pm * tstep : cA; const char* nB = has_next ? (const char*)g.Bt + (size_t)nxt.pn * tstep : cB;
        for (int t = 0; t < nt; t += 2) {
            const bool last = (t == nt - 2);
            const char* a1 = cA + (size_t)(t + 1) * kstep;
            const char* a2 = last ? nA : cA + (size_t)(t + 2) * kstep; const char* b2 = last ? nB : cB + (size_t)(t + 2) * kstep;
            const char* a3 = a2 + kstep; const char* b3 = b2 + kstep;
            if (last && has_next) S.a_ready(nxt);
            if constexpr (SP2) {
            PG8_LDB(B0, 0, 0); PG8_LDB(B1, 0, 1); PG8_SCHED; PG8_LDA(At, 0, 0); PG8_STAGE(PG8_SA(1, 1), a1 + hstep, voffA);
            PG8_WAIT_V(8); PG8_WAIT_L(0); PG8_BAR; PG8_MMA(0, 0, At, B0); PG8_MMA(0, 1, At, B1); PG8_BAR; PG8_SCHED;
            PG8_LDA(At, 0, 1); PG8_STAGE(PG8_SB(0, 0), b2, voffB); PG8_STAGE(PG8_SB(0, 1), b2 + hstep, voffB); PG8_STAGE(PG8_SA(0, 0), a2, voffA);
            PG8_WAIT_V(8); PG8_WAIT_L(0); PG8_BAR; PG8_MMA(1, 0, At, B0); PG8_MMA(1, 1, At, B1); PG8_BAR; PG8_SCHED;
            PG8_LDB(B0, 1, 0); PG8_LDB(B1, 1, 1); PG8_SCHED; PG8_LDA(At, 1, 0); PG8_STAGE(PG8_SA(0, 1), a2 + hstep, voffA);
            PG8_WAIT_V(8); PG8_WAIT_L(0); PG8_BAR; PG8_MMA(0, 0, At, B0); PG8_MMA(0, 1, At, B1); PG8_BAR; PG8_SCHED;
            PG8_LDA(At, 1, 1); PG8_STAGE(PG8_SB(1, 0), b3, voffB); PG8_STAGE(PG8_SB(1, 1), b3 + hstep, voffB); PG8_STAGE(PG8_SA(1, 0), a3, voffA);
            PG8_WAIT_V(8); PG8_WAIT_L(0); PG8_BAR; PG8_MMA(1, 0, At, B0); PG8_MMA(1, 1, At, B1); PG8_BAR; PG8_SCHED;
            } else {
            PG8_LDB(B0, 0, 0); PG8_SCHED; PG8_LDA(At, 0, 0); PG8_STAGE(PG8_SA(1, 1), a1 + hstep, voffA);
            PG8_WAIT_L(8); PG8_BAR; PG8_WAIT_L(0); PG8_MMA(0, 0, At, B0); PG8_BAR; PG8_SCHED;
            PG8_LDB(B1, 0, 1); PG8_STAGE(PG8_SB(0, 0), b2, voffB);
            PG8_BAR; PG8_WAIT_L(0); PG8_MMA(0, 1, At, B1); PG8_BAR;
            PG8_LDA(At, 0, 1); PG8_STAGE(PG8_SA(0, 0), a2, voffA);
            PG8_BAR; PG8_WAIT_L(0); PG8_MMA(1, 0, At, B0); PG8_BAR; PG8_SCHED;
            PG8_STAGE(PG8_SB(0, 1), b2 + hstep, voffB);
            PG8_WAIT_V(6); PG8_BAR; PG8_MMA(1, 1, At, B1); PG8_BAR;
            PG8_LDB(B0, 1, 0); PG8_SCHED; PG8_LDA(At, 1, 0); PG8_STAGE(PG8_SA(0, 1), a2 + hstep, voffA);
            PG8_WAIT_L(8); PG8_BAR; PG8_WAIT_L(0); PG8_MMA(0, 0, At, B0); PG8_BAR; PG8_SCHED;
            PG8_LDB(B1, 1, 1); PG8_STAGE(PG8_SB(1, 0), b3, voffB);
            PG8_BAR; PG8_WAIT_L(0); PG8_MMA(0, 1, At, B1); PG8_BAR;
            PG8_LDA(At, 1, 1); PG8_STAGE(PG8_SA(1, 0), a3, voffA);
            PG8_BAR; PG8_WAIT_L(0); PG8_MMA(1, 0, At, B0); PG8_BAR; PG8_SCHED;
            PG8_STAGE(PG8_SB(1, 1), b3 + hstep, voffB);
            PG8_WAIT_V(6); PG8_BAR; PG8_MMA(1, 1, At, B1); PG8_BAR;
            }
        }
        if constexpr (ALIGN_EPI) { if (wr == 0) PG8_BAR; }
        if constexpr (!Epi::AFTER_DRAIN) { E(acc, cur, wr, wc, fr, fq); S.done(cur); }
        if (!has_next) break;
#pragma unroll
        for (int a = 0; a < 2; ++a)
#pragma unroll
            for (int b = 0; b < 2; ++b)
#pragma unroll
                for (int m = 0; m < 4; ++m)
#pragma unroll
                    for (int n = 0; n < 2; ++n) acc[a][b][m][n] = (f32x4){0.f, 0.f, 0.f, 0.f};
        cur = nxt; cA = nA; cB = nB; ++ui;
        if constexpr (ALIGN_EPI) { if (wr == 1) PG8_BAR; }
    }
    PG8_WAIT_V(0);
    if constexpr (!ALIGN_EPI) { if (wr == 0) PG8_BAR; }
    PG8_BAR;
    if constexpr (Epi::AFTER_DRAIN) { E.fused(acc, cur, wr, wc, fr, fq, lds, wid, lane); S.done(cur); }
#undef PG8_SA
#undef PG8_SB
#undef PG8_STAGE
#undef PG8_LDA
#undef PG8_LDB
#undef PG8_MMA
#undef PG8_WAIT_V
#undef PG8_WAIT_L
#undef PG8_BAR
#undef PG8_SCHED
}

struct MUnit { int r0, rend, e, pn; };
#define MG_LANE_OFFS(u, o) do { const int _t = wid * 64 + fresh_lane(); _Pragma("unroll") for (int _i = 0; _i < 2; ++_i) { int _R, _C; stage_rc(_t * 16 + _i * 8192, _R, _C); _Pragma("unroll") for (int _h = 0; _h < 2; ++_h) { const int _r = (u).r0 + _h * HALF + _R; \
        int _row = _r; if (GATHER) { _row = 0; if (_r < (u).rend) _row = slot_tok[_r]; } (o)[_h][_i] = (unsigned)(_row * K + _C) * 2u; } } } while (0)
template <class Epi, class Sched, bool GATHER, int N, int K>
__device__ __forceinline__ void gemm_phase_moe(PG8_LAS unsigned char* lds, const bf16_t* A, const bf16_t* Bt, const int* slot_tok, const Sched& S, const Epi& E, int wave_id) {
    asm volatile("" : "+s"(wave_id));
    const int lane = fresh_lane(), wid = wave_id, tid = wid * 64 + lane, wr = wid >> 2, wc = wid & 3, fr = lane & 15, fq = lane >> 4;
    constexpr int nt = K / BK;
#define MG_OFFP(par) ((PG8_LAS unsigned*)(lds + STAGE_BYTES + 8192) + (par) * 2048 + tid)
#define MG_VOFFB ((PG8_LAS unsigned*)(lds + STAGE_BYTES + 24576) + tid)
#pragma unroll
    for (int i = 0; i < 2; ++i) { int R, C; stage_rc(tid * 16 + i * 8192, R, C); const int Rb = Epi::PERM ? ((R & ~31) + perm32(R & 31)) : R; MG_VOFFB[i * 512] = (unsigned)(Rb * K + C) * 2u; }
    constexpr size_t kstep = (size_t)(BK * 2);
    constexpr size_t hstep = (size_t)HALF * K * 2;
    constexpr size_t tstep = 2 * hstep;
    constexpr size_t estep = (size_t)N * K * 2;
    const unsigned ldsw = (unsigned)wid * 1024u;
    const int aoff = lds_byte(wr * 64 + fr, fq * 8), boff = lds_byte(wc * 32 + fr, fq * 8);
#define PG8_SA(b, h) (((b) * 2 + (h)) * HTB)
#define PG8_SB(b, h) ((4 + (b) * 2 + (h)) * HTB)
#define PG8_STAGE(bufoff, gbase, voff) do { _Pragma("unroll") for (int _i = 0; _i < 2; ++_i) \
        __builtin_amdgcn_global_load_lds((const unsigned*)((const char*)(gbase) + MG_VOFFB[_i * 512]), (PG8_LAS unsigned*)(lds + (bufoff) + ldsw + _i * 8192), 16, 0, 0); } while (0)
#define MG_STAGE_A(bufoff, par, h, kb) do { _Pragma("unroll") for (int _i = 0; _i < 2; ++_i) \
        __builtin_amdgcn_global_load_lds((const unsigned*)((const char*)A + (size_t)MG_OFFP(par)[((h) * 2 + _i) * 512] + (kb)), (PG8_LAS unsigned*)(lds + (bufoff) + ldsw + _i * 8192), 16, 0, 0); } while (0)
#define PG8_LDA(dst, b, h) do { _Pragma("unroll") for (int m = 0; m < 4; ++m) _Pragma("unroll") for (int k = 0; k < 2; ++k) dst[m][k] = *(const PG8_LAS bf16x8*)(lds + PG8_SA(b, h) + aoff + m * 2048 + k * 1024); } while (0)
#define PG8_LDB(dst, b, h) do { _Pragma("unroll") for (int n = 0; n < 2; ++n) _Pragma("unroll") for (int k = 0; k < 2; ++k) dst[n][k] = *(const PG8_LAS bf16x8*)(lds + PG8_SB(b, h) + boff + n * 2048 + k * 1024); } while (0)
#define PG8_MMA(ai, bj, At, Bt_) do { __builtin_amdgcn_s_setprio(1); _Pragma("unroll") for (int m = 0; m < 4; ++m) _Pragma("unroll") for (int n = 0; n < 2; ++n) _Pragma("unroll") for (int k = 0; k < 2; ++k) \
        acc[ai][bj][m][n] = __builtin_amdgcn_mfma_f32_16x16x32_bf16(Bt_[n][k], At[m][k], acc[ai][bj][m][n], 0, 0, 0); __builtin_amdgcn_s_setprio(0); } while (0)
#define PG8_WAIT_V(n) asm volatile("s_waitcnt vmcnt(" #n ")" ::: "memory")
#define PG8_WAIT_L(n) asm volatile("s_waitcnt lgkmcnt(" #n ")" ::: "memory")
#define PG8_BAR __builtin_amdgcn_s_barrier()
#define PG8_SCHED __builtin_amdgcn_sched_barrier(0)
    MUnit cur, nxt; int ui = 0;
    if (!S.next(0, cur)) return;
    f32x4 acc[2][2][4][2];
#pragma unroll
    for (int a = 0; a < 2; ++a)
#pragma unroll
        for (int b = 0; b < 2; ++b)
#pragma unroll
            for (int m = 0; m < 4; ++m)
#pragma unroll
                for (int n = 0; n < 2; ++n) acc[a][b][m][n] = (f32x4){0.f, 0.f, 0.f, 0.f};
    bf16x8 At[4][2], B0[2][2], B1[2][2];
    { unsigned o_[2][2]; MG_LANE_OFFS(cur, o_); PG8_LAS unsigned* p_ = MG_OFFP(0); p_[0] = o_[0][0]; p_[512] = o_[0][1]; p_[1024] = o_[1][0]; p_[1536] = o_[1][1]; }
    const char* cB = (const char*)Bt + (size_t)cur.e * estep + (size_t)cur.pn * tstep;
    PG8_STAGE(PG8_SB(0, 0), cB, voffB); PG8_STAGE(PG8_SB(0, 1), cB + hstep, voffB); MG_STAGE_A(PG8_SA(0, 0), 0, 0, 0); MG_STAGE_A(PG8_SA(0, 1), 0, 1, 0);
    if (wr == 1) PG8_BAR;
    PG8_WAIT_V(2); PG8_BAR;
    PG8_STAGE(PG8_SB(1, 0), cB + kstep, voffB); MG_STAGE_A(PG8_SA(1, 0), 0, 0, kstep); PG8_STAGE(PG8_SB(1, 1), cB + hstep + kstep, voffB);
    PG8_WAIT_V(6); PG8_BAR;
    for (;;) {
        const bool has_next = S.next(ui + 1, nxt);
        const bool hi_rows = (cur.rend - cur.r0) > HALF;
        const char* nB = cB;
        const int pc = ui & 1, pn_ = has_next ? (pc ^ 1) : pc;
        if (has_next) { unsigned on[2][2]; MG_LANE_OFFS(nxt, on); nB = (const char*)Bt + (size_t)nxt.e * estep + (size_t)nxt.pn * tstep;
            PG8_LAS unsigned* p_ = MG_OFFP(pn_); p_[0] = on[0][0]; p_[512] = on[0][1]; p_[1024] = on[1][0]; p_[1536] = on[1][1]; }
        for (int t = 0; t < nt; t += 2) {
            const bool last = (t == nt - 2);
            const size_t k1 = (size_t)(t + 1) * kstep, k2 = last ? (size_t)0 : (size_t)(t + 2) * kstep, k3 = k2 + kstep;
            const char* b2 = last ? nB : cB + (size_t)(t + 2) * kstep; const char* b3 = b2 + kstep;
            const int p2 = last ? pn_ : pc;
            PG8_LDB(B0, 0, 0); PG8_LDB(B1, 0, 1); PG8_SCHED; PG8_LDA(At, 0, 0); MG_STAGE_A(PG8_SA(1, 1), pc, 1, k1);
            PG8_WAIT_V(8); PG8_WAIT_L(0); PG8_BAR; PG8_MMA(0, 0, At, B0); PG8_MMA(0, 1, At, B1); PG8_BAR; PG8_SCHED;
            PG8_LDA(At, 0, 1); PG8_STAGE(PG8_SB(0, 0), b2, voffB); PG8_STAGE(PG8_SB(0, 1), b2 + hstep, voffB); MG_STAGE_A(PG8_SA(0, 0), p2, 0, k2);
            PG8_WAIT_V(8); PG8_WAIT_L(0); PG8_BAR; if (hi_rows) { PG8_MMA(1, 0, At, B0); PG8_MMA(1, 1, At, B1); } PG8_BAR; PG8_SCHED;
            PG8_LDB(B0, 1, 0); PG8_LDB(B1, 1, 1); PG8_SCHED; PG8_LDA(At, 1, 0); MG_STAGE_A(PG8_SA(0, 1), p2, 1, k2);
            PG8_WAIT_V(8); PG8_WAIT_L(0); PG8_BAR; PG8_MMA(0, 0, At, B0); PG8_MMA(0, 1, At, B1); PG8_BAR; PG8_SCHED;
            PG8_LDA(At, 1, 1); PG8_STAGE(PG8_SB(1, 0), b3, voffB); PG8_STAGE(PG8_SB(1, 1), b3 + hstep, voffB); MG_STAGE_A(PG8_SA(1, 0), p2, 0, k3);
            PG8_WAIT_V(8); PG8_WAIT_L(0); PG8_BAR; if (hi_rows) { PG8_MMA(1, 0, At, B0); PG8_MMA(1, 1, At, B1); } PG8_BAR; PG8_SCHED;
        }
        if (wr == 0) PG8_BAR;
        E(acc, cur, wr, wc, fr, fq);
        if (!has_next) break;
#pragma unroll
        for (int a = 0; a < 2; ++a)
#pragma unroll
            for (int b = 0; b < 2; ++b)
#pragma unroll
                for (int m = 0; m < 4; ++m)
#pragma unroll
                    for (int n = 0; n < 2; ++n) acc[a][b][m][n] = (f32x4){0.f, 0.f, 0.f, 0.f};
        cur = nxt; cB = nB; ++ui;
        if (wr == 1) PG8_BAR;
    }
    PG8_WAIT_V(0);
    PG8_BAR;
#undef PG8_SA
#undef PG8_SB
#undef PG8_STAGE
#undef MG_STAGE_A
#undef MG_OFFP
#undef MG_VOFFB
#undef PG8_LDA
#undef PG8_LDB
#undef PG8_MMA
#undef PG8_WAIT_V
#undef PG8_WAIT_L
#undef PG8_BAR
#undef PG8_SCHED
}
__device__ __forceinline__ float fast_silu(float x) { return x * __builtin_amdgcn_rcpf(1.0f + __builtin_amdgcn_exp2f(-1.4426950408889634f * x)); }
struct EpiMoeH {
    static constexpr bool PERM = true;
    bf16_t* H;
    __device__ __forceinline__ void operator()(const f32x4 (&acc)[2][2][4][2], const MUnit& u, int wr, int wc, int fr, int fq) const {
        { const int t_ = fresh_lane(); fr = t_ & 15; fq = t_ >> 4; }
        const int col0 = u.pn * 128 + wc * 32 + 8 * fq;
#pragma unroll
        for (int ai = 0; ai < 2; ++ai)
#pragma unroll
            for (int m = 0; m < 4; ++m) { const int r = u.r0 + ai * HALF + wr * 64 + m * 16 + fr;
                const f32x4 g0 = acc[ai][0][m][0], g1 = acc[ai][0][m][1], u0 = acc[ai][1][m][0], u1 = acc[ai][1][m][1];
                u32x4 w; w.x = cvt_pk_bf16(fast_silu(g0[0]) * u0[0], fast_silu(g0[1]) * u0[1]); w.y = cvt_pk_bf16(fast_silu(g0[2]) * u0[2], fast_silu(g0[3]) * u0[3]);
                w.z = cvt_pk_bf16(fast_silu(g1[0]) * u1[0], fast_silu(g1[1]) * u1[1]); w.w = cvt_pk_bf16(fast_silu(g1[2]) * u1[2], fast_silu(g1[3]) * u1[3]);
                if (r < u.rend) *(u32x4*)(H + (size_t)r * 256 + col0) = w; }
    }
};
struct EpiMoeY {
    static constexpr bool PERM = true;
    bf16_t* Y;
    __device__ __forceinline__ void operator()(const f32x4 (&acc)[2][2][4][2], const MUnit& u, int wr, int wc, int fr, int fq) const {
        { const int t_ = fresh_lane(); fr = t_ & 15; fq = t_ >> 4; }
        const int col0 = u.pn * BM + wc * 32 + 8 * fq;
#pragma unroll
        for (int ai = 0; ai < 2; ++ai)
#pragma unroll
            for (int m = 0; m < 4; ++m) { const int r = u.r0 + ai * HALF + wr * 64 + m * 16 + fr;
#pragma unroll
                for (int bj = 0; bj < 2; ++bj) { const f32x4 v0 = acc[ai][bj][m][0], v1 = acc[ai][bj][m][1];
                    u32x4 w; w.x = cvt_pk_bf16(v0[0], v0[1]); w.y = cvt_pk_bf16(v0[2], v0[3]); w.z = cvt_pk_bf16(v1[0], v1[1]); w.w = cvt_pk_bf16(v1[2], v1[3]);
                    if (r < u.rend) *(u32x4*)(Y + (size_t)r * 1024 + col0 + bj * HALF) = w; } }
    }
};
struct MoeSched {
    const PG8_LAS int* tab;
    int npn, first, end, stride, c;
    __device__ __forceinline__ bool next(int i, MUnit& u) const {
        const int L = first + c + i * stride;
        if (c < 0 || L >= end) return false;
        const int j = L / npn; u.pn = L % npn;
        u.e = __builtin_amdgcn_readfirstlane(tab[4 + 4 * j]); u.r0 = __builtin_amdgcn_readfirstlane(tab[5 + 4 * j]); u.rend = __builtin_amdgcn_readfirstlane(tab[6 + 4 * j]);
        return true;
    }
};
}

#ifndef PG8_SP2
#define PG8_SP2 true
#endif
#ifndef PG8_ALIGN
#define PG8_ALIGN true
#endif

constexpr int NWAVES = 8, NT = NWAVES * 64;
constexpr int D = 1024, NB = 2, S = 8192, T = NB * S, DEPTH = 2;
constexpr int DIN = 2832, PLD = 3072;
constexpr int C_Q = 0, C_K = 256, C_V = 512, C_G = 1024, C_GK = 1536, C_U = 1552, C_VG = 1808, C_XI = 2064, C_BG = 2320, C_CG = 2576;
constexpr int GH = 4, GC = 64, GN = S / GC;
constexpr int MH = 4, MC = 128, MN = S / MC;
constexpr int NE = 32, DE = 256;
constexpr float EPS = 1e-6f;
constexpr size_t MiB = 1u << 20;
constexpr size_t WS_CTL = 0, CTL_BYTES = 1 * MiB;
constexpr size_t WS_WIN = 1 * MiB;
constexpr size_t WS_WOUT = 13 * MiB;
constexpr size_t WS_WGU = 17 * MiB;
constexpr size_t WS_WD = 81 * MiB;
constexpr size_t WS_XN = 113 * MiB;
constexpr size_t WS_P = 145 * MiB;
constexpr size_t WS_Y = WS_P + 17 * MiB;
constexpr size_t WS_S = 276 * MiB;
constexpr size_t WS_XRES = 241 * MiB;
constexpr size_t WS_DEC = 273 * MiB;
constexpr size_t WS_MISC = 274 * MiB;
constexpr size_t WS_WSP = WS_MISC + 524288;
constexpr size_t WS_WR = 275 * MiB;
constexpr size_t WS_BLKCNT = WS_WR + 524288;
constexpr size_t WS_END = 284 * MiB;
constexpr int CW_BAR = 4096, CW_CNT = 16384;
constexpr int RING_BYTES = 131072, LDSCTL_OFF = RING_BYTES, MISC_OFF = LDSCTL_OFF + 320, LDS_BYTES = 163840;

#define GAS __attribute__((address_space(1)))
#define LAS __attribute__((address_space(3)))
typedef unsigned short bf16;
typedef unsigned v4u __attribute__((ext_vector_type(4)));
typedef unsigned v2u __attribute__((ext_vector_type(2)));
typedef float f32x4 __attribute__((ext_vector_type(4)));
typedef __bf16 bf16x2_t __attribute__((ext_vector_type(2)));
typedef float f32x2_t __attribute__((ext_vector_type(2)));
__device__ __forceinline__ unsigned f2bf(float f) { return (unsigned)__builtin_bit_cast(unsigned short, (__bf16)f); }
__device__ __forceinline__ unsigned pk2(float lo, float hi) { f32x2_t v = {lo, hi}; bf16x2_t b = __builtin_convertvector(v, bf16x2_t); return __builtin_bit_cast(unsigned, b); }
__device__ __forceinline__ float bf2f(unsigned v) { return __uint_as_float(v << 16); }
__device__ __forceinline__ float bflo(unsigned w) { return __uint_as_float(w << 16); }
__device__ __forceinline__ float bfhi(unsigned w) { return __uint_as_float(w & 0xffff0000u); }
__device__ __forceinline__ void unpack8(const v4u q, float (&f)[8]) { f[0] = bflo(q.x); f[1] = bfhi(q.x); f[2] = bflo(q.y); f[3] = bfhi(q.y); f[4] = bflo(q.z); f[5] = bfhi(q.z); f[6] = bflo(q.w); f[7] = bfhi(q.w); }
__device__ __forceinline__ float gelu_tanh(float x) { const float u = 0.7978845608028654f * (x + 0.044715f * x * x * x); return 0.5f * x * (1.0f + tanhf(u)); }
__device__ __forceinline__ float silu(float x) { return x / (1.0f + expf(-x)); }
__device__ __forceinline__ float log_sigmoid(float x) { return fminf(x, 0.f) - log1pf(expf(-fabsf(x))); }

#define XB_TMO      128
#define XB_XCNT(j)  (256  + 64 * (j))
#define XB_XSUB(j)  (1280 + 64 * (j))
#define XB_XGEN(j)  (2304 + 64 * (j))
#define XB_TOP      3328
#define XB_TOPGEN   3392
#define XCD_BAR_WORDS 3456
#define XB_SPIN_CAP (1u << 18)

__device__ __forceinline__ unsigned xb_ld(unsigned* p)              { return __hip_atomic_load(p, __ATOMIC_RELAXED, __HIP_MEMORY_SCOPE_AGENT); }
__device__ __forceinline__ unsigned xb_add(unsigned* p, unsigned v) { return __hip_atomic_fetch_add(p, v, __ATOMIC_RELAXED, __HIP_MEMORY_SCOPE_AGENT); }
__device__ __forceinline__ unsigned xb_xcc_id() { return (unsigned)__builtin_amdgcn_s_getreg((3 << 11) | 20) & 0xFu; }
#define XB_SPIN(cond, bar) do { unsigned _sp = 0; while (cond) { __builtin_amdgcn_s_sleep(1); \
    if ((++_sp & 255u) == 0u) { if (xb_ld(&(bar)[XB_TMO])) break; if (_sp > XB_SPIN_CAP) { atomicAdd(&(bar)[XB_TMO], 1u); break; } } } } while (0)

struct XcdBarrier {
    int wave;
    unsigned* bar; unsigned x;
    volatile LAS unsigned* st;
};

__device__ __forceinline__ XcdBarrier xcd_barrier_post(unsigned* bar, volatile LAS unsigned* st) {
    XcdBarrier b; b.bar = bar; b.x = xb_xcc_id(); b.st = st; b.wave = __builtin_amdgcn_readfirstlane(threadIdx.x >> 6);
    if (threadIdx.x == 0) (void)xb_add(&bar[XB_XCNT(b.x)], 1u);
    return b;
}
__device__ __forceinline__ void xcd_barrier_complete(unsigned* bar, unsigned x, unsigned& nloc, unsigned& nx) {
    const unsigned G = gridDim.x * gridDim.y * gridDim.z;
    unsigned sum, cnt, mine, sp = 0u;
    for (;;) {
        sum = 0u; cnt = 0u; mine = 0u;
#pragma unroll
        for (unsigned j = 0; j < 16; ++j) { const unsigned c = xb_ld(&bar[XB_XCNT(j)]); sum += c; cnt += (c > 0u) ? 1u : 0u; mine = (j == x) ? c : mine; }
        if (sum == G) break;
        __builtin_amdgcn_s_sleep(1);
        if ((++sp & 255u) == 0u) { if (xb_ld(&bar[XB_TMO])) break; if (sp > XB_SPIN_CAP) { atomicAdd(&bar[XB_TMO], 1u); break; } }
    }
    nloc = mine > 0u ? mine : 1u; nx = cnt > 0u ? cnt : 1u;
}

__device__ __forceinline__ void xcd_barrier(const XcdBarrier& b) {
    asm volatile("s_waitcnt vmcnt(0)" ::: "memory");
    __syncthreads();
    if (b.wave == 0 && fresh_lane() == 0) {
        unsigned* bar = b.bar; asm volatile("" : "+s"(bar));
        __builtin_amdgcn_s_waitcnt(0);
        unsigned nloc = b.st[0], nx = b.st[1];
        if (nloc == 0u) { xcd_barrier_complete(bar, b.x, nloc, nx); b.st[0] = nloc; b.st[1] = nx; }
        const unsigned old = xb_add(&bar[XB_XSUB(b.x)], 1u);
        const unsigned gen = old / nloc;
        if (old + 1u == (gen + 1u) * nloc) {
            __builtin_amdgcn_fence(__ATOMIC_RELEASE, "agent");
            asm volatile("s_waitcnt vmcnt(0)" ::: "memory");
            const unsigned og = xb_add(&bar[XB_TOP], 1u);
            const unsigned tg = og / nx;
            if (og + 1u == (tg + 1u) * nx) xb_add(&bar[XB_TOPGEN], 1u);
            else XB_SPIN(xb_ld(&bar[XB_TOPGEN]) == tg, bar);
            __builtin_amdgcn_fence(__ATOMIC_ACQUIRE, "agent");
            xb_add(&bar[XB_XGEN(b.x)], 1u);
            asm volatile("s_waitcnt vmcnt(0)" ::: "memory");
        } else {
            XB_SPIN(xb_ld(&bar[XB_XGEN(b.x)]) == gen, bar);
            __builtin_amdgcn_fence(__ATOMIC_ACQUIRE, "agent");
            asm volatile("s_waitcnt vmcnt(0)" ::: "memory");
        }
    }
    __syncthreads();
}

#define AS4 __attribute__((address_space(4)))
struct KA {
    const AS4 char* ka;
    static __device__ __forceinline__ KA fresh() { KA k; k.ka = (const AS4 char*)__builtin_amdgcn_kernarg_segment_ptr(); asm volatile("" : "+s"(k.ka)); return k; }
    __device__ __forceinline__ const float* in(int i) const { return *(const float* const AS4*)(ka + 8 * i); }
    __device__ __forceinline__ float* out() const { return *(float* const AS4*)(ka + 160); }
    __device__ __forceinline__ unsigned char* ws() const { return *(unsigned char* const AS4*)(ka + 168); }
    __device__ __forceinline__ unsigned* ctl() const { return (unsigned*)(ws() + WS_CTL); }
    __device__ __forceinline__ bf16* WinT() const { return (bf16*)(ws() + WS_WIN); }
    __device__ __forceinline__ bf16* WoutT() const { return (bf16*)(ws() + WS_WOUT); }
    __device__ __forceinline__ bf16* WguT() const { return (bf16*)(ws() + WS_WGU); }
    __device__ __forceinline__ bf16* WdT() const { return (bf16*)(ws() + WS_WD); }
    __device__ __forceinline__ bf16* XN() const { return (bf16*)(ws() + WS_XN); }
    __device__ __forceinline__ bf16* P() const { return (bf16*)(ws() + WS_P); }
    __device__ __forceinline__ bf16* H1() const { return (bf16*)(ws() + WS_P); }
    __device__ __forceinline__ bf16* Y() const { return (bf16*)(ws() + WS_Y); }
    __device__ __forceinline__ float* Sst() const { return (float*)(ws() + WS_S); }
    __device__ __forceinline__ float* dec() const { return (float*)(ws() + WS_DEC); }
    __device__ __forceinline__ int* eid() const { return (int*)(ws() + WS_MISC); }
    __device__ __forceinline__ float* ew() const { return (float*)(ws() + WS_MISC + 131072); }
    __device__ __forceinline__ int* slot_tok() const { return (int*)(ws() + WS_MISC + 2 * 131072); }
    __device__ __forceinline__ int* slot_of() const { return (int*)(ws() + WS_MISC + 3 * 131072); }
    __device__ __forceinline__ bf16* Wsp() const { return (bf16*)(ws() + WS_WSP); }
    __device__ __forceinline__ bf16* Wr() const { return (bf16*)(ws() + WS_WR); }
    __device__ __forceinline__ bf16* XR() const { return (bf16*)(ws() + WS_XRES); }
    __device__ __forceinline__ int* blkcnt() const { return (int*)(ws() + WS_BLKCNT); }
};
struct Frame {
    LAS unsigned char* lds; float* smem;
    int G, bx, wave;
};
#define PHASE_TID const int lane = fresh_lane(), wave = F.wave, tid = wave * 64 + lane; (void)lane; (void)wave; (void)tid

__device__ __forceinline__ float wave_sum(float v) {
    v = sum16(v);
    const int iv = __float_as_int(v);
    return (__int_as_float(__builtin_amdgcn_readlane(iv, 0)) + __int_as_float(__builtin_amdgcn_readlane(iv, 16))) + (__int_as_float(__builtin_amdgcn_readlane(iv, 32)) + __int_as_float(__builtin_amdgcn_readlane(iv, 48)));
}

struct TrItem { const float* W; bf16* WT; int ldw, nvalid, k0, n0, ldt, drow0; };
__device__ __forceinline__ void transpose_load(const TrItem& t, int lane, f32x4 (&v)[8]) {
    const int sub = lane >> 3, c4 = (lane & 7) * 4;
#pragma unroll
    for (int i = 0; i < 8; ++i) v[i] = (c4 < t.nvalid) ? __builtin_nontemporal_load((const f32x4*)(t.W + (size_t)(t.k0 + 8 * i + sub) * t.ldw + t.n0 + c4)) : (f32x4){0.f, 0.f, 0.f, 0.f};
}
__device__ __forceinline__ void transpose_store(const TrItem& t, int lane, const f32x4 (&v)[8], LAS float* scr) {
    const int sub = lane >> 3, c4 = (lane & 7) * 4;
#pragma unroll
    for (int i = 0; i < 8; ++i) { LAS float* d = scr + (8 * i + sub) * 33 + c4; d[0] = v[i].x; d[1] = v[i].y; d[2] = v[i].z; d[3] = v[i].w; }
    asm volatile("s_waitcnt lgkmcnt(0)" ::: "memory");
    const int c = lane & 7;
#pragma unroll
    for (int j = 0; j < 4; ++j) { const int n = (lane >> 3) + 8 * j; const LAS float* s = scr + (8 * c) * 33 + n;
        v4u o; o.x = pk2(s[0 * 33], s[1 * 33]); o.y = pk2(s[2 * 33], s[3 * 33]); o.z = pk2(s[4 * 33], s[5 * 33]); o.w = pk2(s[6 * 33], s[7 * 33]);
        if (n < t.nvalid) *(GAS v4u*)(t.WT + (size_t)(t.drow0 + n) * t.ldt + t.k0 + 8 * c) = o; }
    asm volatile("s_waitcnt lgkmcnt(0)" ::: "memory");
}
__device__ __forceinline__ void rms_row_to_bf16(const float* xrow, const float* gain, bf16* orow, int lane) {
    const f32x4* xr = (const f32x4*)xrow + lane;
    f32x4 v[4]; float s = 0.f;
#pragma unroll
    for (int j = 0; j < 4; ++j) { v[j] = xr[64 * j]; s += (v[j].x * v[j].x + v[j].y * v[j].y) + (v[j].z * v[j].z + v[j].w * v[j].w); }
    const float rs = rsqrtf(wave_sum(s) * (1.f / D) + EPS);
    v2u* o8 = (v2u*)orow + lane;
#pragma unroll
    for (int j = 0; j < 4; ++j) { const f32x4 g = ((const f32x4*)gain)[lane + 64 * j]; v2u w; w.x = pk2(v[j].x * rs * g.x, v[j].y * rs * g.y); w.y = pk2(v[j].z * rs * g.z, v[j].w * rs * g.w); o8[64 * j] = w; }
}
__device__ __forceinline__ void p0_prologue(Frame& F) {
    const KA K = KA::fresh(); PHASE_TID;
    LAS float* scr = (LAS float*)(F.lds + wave * 16384);
    const int gw = F.bx * NWAVES + wave, NGW = F.G * NWAVES;
    constexpr int I_IN = 16 * 89, I_OUT = 16 * 32, I_G = 32 * 16 * 8, I_D = 32 * 4 * 32, I_L = I_IN + I_OUT + 2 * I_G + I_D;
#define TR_DECODE(it_, t_) do { const int l_ = (it_) / I_L; int r_ = (it_) % I_L; \
        if (r_ < I_IN) { const int kb = r_ / 89, nb = r_ % 89; t_ = TrItem{K.in(2) + (size_t)l_ * D * DIN, K.WinT() + (size_t)l_ * PLD * D, DIN, (nb == 88) ? 16 : 32, kb * 64, nb * 32, D, nb * 32}; } \
        else if (r_ < I_IN + I_OUT) { r_ -= I_IN; const int kb = r_ / 32, nb = r_ % 32; t_ = TrItem{K.in(10) + (size_t)l_ * D * D, K.WoutT() + (size_t)l_ * D * D, D, 32, kb * 64, nb * 32, D, nb * 32}; } \
        else if (r_ < I_IN + I_OUT + 2 * I_G) { r_ -= I_IN + I_OUT; const int sel = r_ / I_G; r_ %= I_G; const int e = r_ / 128, kb = (r_ % 128) / 8, n0 = (r_ % 8) * 32; \
            t_ = TrItem{K.in(16 + sel) + ((size_t)l_ * NE + e) * D * DE, K.WguT() + ((size_t)l_ * NE + e) * 512 * D, DE, 32, kb * 64, n0, D, (n0 >> 7) * 256 + sel * 128 + (n0 & 127)}; } \
        else { r_ -= I_IN + I_OUT + 2 * I_G; const int e = r_ / 128, kb = (r_ % 128) / 32, nb = r_ % 32; t_ = TrItem{K.in(18) + ((size_t)l_ * NE + e) * DE * D, K.WdT() + ((size_t)l_ * NE + e) * D * DE, D, 32, kb * 64, nb * 32, DE, nb * 32}; } } while (0)
    {
        TrItem cur, nxt; f32x4 vc[8], vn[8];
        int it = gw;
        if (it < DEPTH * I_L) { TR_DECODE(it, cur); transpose_load(cur, lane, vc); }
#pragma unroll 1
        for (; it < DEPTH * I_L; it += NGW) {
            const bool more = it + NGW < DEPTH * I_L;
            if (more) { TR_DECODE(it + NGW, nxt); transpose_load(nxt, lane, vn); }
            transpose_store(cur, lane, vc, scr);
            cur = nxt;
#pragma unroll
            for (int i = 0; i < 8; ++i) vc[i] = vn[i];
        }
    }
#undef TR_DECODE
    for (int i = F.bx * NT + tid; i < DEPTH * 240 * 128; i += F.G * NT) { const int l = i / (240 * 128), rr = (i / 128) % 240, c = i % 128;
        *(GAS v4u*)(K.WinT() + ((size_t)l * PLD + DIN + rr) * D + c * 8) = (v4u){0u, 0u, 0u, 0u}; }
    for (int i = F.bx * NT + tid; i < DEPTH * 48 * D; i += F.G * NT) { const int ll = i / (48 * D), n = (i / D) % 48, k = i % D;
        float w = 0.f;
        if (n < 4) w = K.in(12)[((size_t)ll * D + k) * 4 + n]; else if (n < 36) w = K.in(14)[((size_t)ll * D + k) * 32 + (n - 4)];
        w *= K.in(11)[(size_t)ll * D + k];
        const unsigned hi = f2bf(w), lo = f2bf(w - bf2f(hi));
        K.Wr()[((size_t)ll * 2 + 0) * 48 * D + (size_t)n * D + k] = (bf16)hi; K.Wr()[((size_t)ll * 2 + 1) * 48 * D + (size_t)n * D + k] = (bf16)lo; }
    for (int i = F.bx * NT + tid; i < DEPTH * MH * 128 * 128 / 8; i += F.G * NT) { const int e0 = i * 8, s0 = e0 & 127, t = (e0 >> 7) & 127;
        const f32x4 a = *(const f32x4*)(K.in(7) + e0), c = *(const f32x4*)(K.in(7) + e0 + 4);
        const float v[8] = {a.x, a.y, a.z, a.w, c.x, c.y, c.z, c.w}; unsigned w[4];
#pragma unroll
        for (int j = 0; j < 4; ++j) w[j] = pk2((s0 + 2 * j <= t) ? v[2 * j] : 0.f, (s0 + 2 * j + 1 <= t) ? v[2 * j + 1] : 0.f);
        *(GAS v4u*)(K.Wsp() + e0) = (v4u){w[0], w[1], w[2], w[3]}; }
    {
        f32x4 g4[4], v[4], vn[4];
#pragma unroll
        for (int j = 0; j < 4; ++j) g4[j] = ((const f32x4*)K.in(1))[lane + 64 * j];
        int m = gw;
        if (m < T) {
#pragma unroll
            for (int j = 0; j < 4; ++j) v[j] = __builtin_nontemporal_load((const f32x4*)(K.in(0) + (size_t)m * D) + lane + 64 * j); }
#pragma unroll 1
        for (; m < T; m += NGW) {
            if (m + NGW < T) {
#pragma unroll
                for (int j = 0; j < 4; ++j) vn[j] = __builtin_nontemporal_load((const f32x4*)(K.in(0) + (size_t)(m + NGW) * D) + lane + 64 * j); }
            float s_ = 0.f;
#pragma unroll
            for (int j = 0; j < 4; ++j) s_ += (v[j].x * v[j].x + v[j].y * v[j].y) + (v[j].z * v[j].z + v[j].w * v[j].w);
            const float rs = rsqrtf(wave_sum(s_) * (1.f / D) + EPS);
            v2u* o8 = (v2u*)(K.XN() + (size_t)m * D) + lane; v2u* r8 = (v2u*)(K.XR() + (size_t)m * D) + lane;
#pragma unroll
            for (int j = 0; j < 4; ++j) { o8[64 * j] = (v2u){pk2(v[j].x * rs * g4[j].x, v[j].y * rs * g4[j].y), pk2(v[j].z * rs * g4[j].z, v[j].w * rs * g4[j].w)};
                r8[64 * j] = (v2u){pk2(v[j].x, v[j].y), pk2(v[j].z, v[j].w)}; v[j] = vn[j]; }
        }
    }
}

__device__ __forceinline__ void gla_cumdecay(Frame& F, const KA& K, int tid, int l, int h, int t0, float* bb) {
    const float* wup = K.in(3) + (size_t)l * 16 * 256; const float* bgk = K.in(4) + (size_t)l * 256;
    for (int e = tid; e < 64 * 64; e += NT) {
        const int c = e >> 6, d = e & 63;
        const bf16* gl = K.P() + (size_t)(t0 + c) * PLD + C_GK;
        float a = bgk[h * 64 + d];
#pragma unroll
        for (int r = 0; r < 16; ++r) a += bf2f(gl[r]) * wup[r * 256 + h * 64 + d];
        bb[c * 64 + d] = log_sigmoid(a) * (1.0f / 16.0f);
    }
    __syncthreads();
    if (tid < 64) { float run = 0.f; for (int c = 0; c < 64; ++c) { run += bb[c * 64 + tid]; bb[c * 64 + tid] = run; } }
    __syncthreads();
}
__device__ __forceinline__ void phase_gla_kv(Frame& F, int l) {
    const KA K = KA::fresh(); PHASE_TID;
    float* bb = F.smem; float* kd = F.smem + 4096;
#pragma unroll 1
    for (int ci = F.bx; ci < NB * GH * GN; ci += F.G) {
        const int b = ci / (GH * GN), h = (ci / GN) % GH, n = ci % GN, t0 = b * S + n * GC;
        __syncthreads();
        gla_cumdecay(F, K, tid, l, h, t0, bb);
        for (int e = tid; e < 4096; e += NT) { const int c = e >> 6, d = e & 63; kd[e] = bf2f(K.P()[(size_t)(t0 + c) * PLD + C_K + h * 64 + d]) * expf(bb[63 * 64 + d] - bb[e]); }
        __syncthreads();
        const int d = tid >> 3, v0 = (tid & 7) * 16;
        float acc[16];
#pragma unroll
        for (int j = 0; j < 16; ++j) acc[j] = 0.f;
#pragma unroll 2
        for (int c = 0; c < 64; ++c) {
            const float kk = kd[c * 64 + d];
            const v4u* vr = (const v4u*)(K.P() + (size_t)(t0 + c) * PLD + C_V + h * 128 + v0);
            float f[8]; unpack8(vr[0], f);
#pragma unroll
            for (int j = 0; j < 8; ++j) acc[j] += kk * f[j];
            unpack8(vr[1], f);
#pragma unroll
            for (int j = 0; j < 8; ++j) acc[8 + j] += kk * f[j];
        }
        f32x4* o = (f32x4*)(K.Sst() + ((size_t)ci * 64 + d) * 128 + v0);
#pragma unroll
        for (int j = 0; j < 4; ++j) o[j] = (f32x4){acc[4 * j], acc[4 * j + 1], acc[4 * j + 2], acc[4 * j + 3]};
        if (tid < 64) K.dec()[(size_t)ci * 64 + tid] = expf(bb[63 * 64 + tid]);
    }
}
__device__ __forceinline__ void phase_gla_scan(Frame& F) {
    const KA K = KA::fresh(); PHASE_TID;
#pragma unroll 1
    for (int e = F.bx * NT + tid; e < NB * GH * 64 * 128; e += F.G * NT) {
        const int bh = e >> 13, d = (e >> 7) & 63, v = e & 127;
        float* base = K.Sst() + ((size_t)bh * GN * 64 + d) * 128 + v; const float* db = K.dec() + (size_t)bh * GN * 64 + d;
        float st = 0.f;
#pragma unroll 1
        for (int n0 = 0; n0 < GN; n0 += 16) {
            float kvv[16], dd[16];
#pragma unroll
            for (int j = 0; j < 16; ++j) { kvv[j] = base[(size_t)(n0 + j) * 8192]; dd[j] = db[(n0 + j) * 64]; }
#pragma unroll
            for (int j = 0; j < 16; ++j) { base[(size_t)(n0 + j) * 8192] = st; st = dd[j] * st + kvv[j]; }
        }
    }
}
__device__ __forceinline__ void phase_gla_out(Frame& F, int l) {
    const KA K = KA::fresh(); PHASE_TID;
    float* bb = F.smem; float* qd = F.smem + 4096; float* ki = F.smem + 4096 + 64 * 65; float* sc = bb;
    const float* gnorm = K.in(5) + (size_t)l * 128;
#pragma unroll 1
    for (int ci = F.bx; ci < NB * GH * GN; ci += F.G) {
        const int b = ci / (GH * GN), h = (ci / GN) % GH, n = ci % GN, t0 = b * S + n * GC;
        __syncthreads();
        gla_cumdecay(F, K, tid, l, h, t0, bb);
        for (int e = tid; e < 4096; e += NT) {
            const int c = e >> 6, d = e & 63; const float bv = bb[e];
            const bf16* row = K.P() + (size_t)(t0 + c) * PLD;
            qd[c * 65 + d] = bf2f(row[C_Q + h * 64 + d]) * 0.125f * expf(bv);
            ki[c * 65 + d] = bf2f(row[C_K + h * 64 + d]) * expf(-bv);
        }
        __syncthreads();
        {
            const int c = tid >> 3, s0 = (tid & 7) * 8;
            float a[8];
#pragma unroll
            for (int j = 0; j < 8; ++j) a[j] = 0.f;
#pragma unroll 4
            for (int d = 0; d < 64; ++d) { const float qv = qd[c * 65 + d];
#pragma unroll
                for (int j = 0; j < 8; ++j) a[j] += qv * ki[(s0 + j) * 65 + d]; }
#pragma unroll
            for (int j = 0; j < 8; ++j) sc[c * 64 + s0 + j] = (s0 + j <= c) ? a[j] : 0.f;
        }
        __syncthreads();
        const int c = tid >> 3, v0 = (tid & 7) * 16;
        float acc[16];
#pragma unroll
        for (int j = 0; j < 16; ++j) acc[j] = 0.f;
#pragma unroll 2
        for (int s = 0; s <= c; ++s) {
            const float w = sc[c * 64 + s];
            const v4u* vr = (const v4u*)(K.P() + (size_t)(t0 + s) * PLD + C_V + h * 128 + v0);
            float f[8]; unpack8(vr[0], f);
#pragma unroll
            for (int j = 0; j < 8; ++j) acc[j] += w * f[j];
            unpack8(vr[1], f);
#pragma unroll
            for (int j = 0; j < 8; ++j) acc[8 + j] += w * f[j];
        }
#pragma unroll 2
        for (int d = 0; d < 64; ++d) {
            const float w = qd[c * 65 + d];
            const f32x4* sr = (const f32x4*)(K.Sst() + ((size_t)ci * 64 + d) * 128 + v0);
#pragma unroll
            for (int j = 0; j < 4; ++j) { const f32x4 v4 = sr[j]; acc[4 * j] += w * v4.x; acc[4 * j + 1] += w * v4.y; acc[4 * j + 2] += w * v4.z; acc[4 * j + 3] += w * v4.w; }
        }
        float ss = 0.f;
#pragma unroll
        for (int j = 0; j < 16; ++j) ss += acc[j] * acc[j];
        ss = sum8(ss);
        const float rs = rsqrtf(ss * (1.0f / 128.0f) + EPS);
        const v4u* gr = (const v4u*)(K.P() + (size_t)(t0 + c) * PLD + C_G + h * 128 + v0);
        float g0[8], g1[8]; unpack8(gr[0], g0); unpack8(gr[1], g1);
        float o[16];
#pragma unroll
        for (int j = 0; j < 8; ++j) { o[j] = acc[j] * rs * gnorm[v0 + j] * silu(g0[j]); o[8 + j] = acc[8 + j] * rs * gnorm[v0 + 8 + j] * silu(g1[j]); }
        v4u* op = (v4u*)(K.XN() + (size_t)(t0 + c) * D + h * 128 + v0);
        op[0] = (v4u){pk2(o[0], o[1]), pk2(o[2], o[3]), pk2(o[4], o[5]), pk2(o[6], o[7])};
        op[1] = (v4u){pk2(o[8], o[9]), pk2(o[10], o[11]), pk2(o[12], o[13]), pk2(o[14], o[15])};
    }
}
__device__ __forceinline__ void phase_gmlp(Frame& F, int l) {
    const KA K = KA::fresh(); PHASE_TID;
    float* vs = F.smem;
    const float* gn = K.in(6) + (size_t)l * 256; const float* wsp = K.in(7) + (size_t)l * MH * 128 * 128; const float* bsp = K.in(8) + (size_t)l * MH * 128;
#pragma unroll 1
    for (int u = F.bx; u < NB * MN * MH; u += F.G) {
        const int b = u / (MN * MH), n = (u / MH) % MN, h = u % MH, t0 = b * S + n * MC;
        __syncthreads();
        const int s = tid >> 2, d0 = (tid & 3) * 16;
        {
            const v4u* vr = (const v4u*)(K.P() + (size_t)(t0 + s) * PLD + C_VG + h * 64 + d0);
            float g[16]; { float f[8]; unpack8(vr[0], f);
#pragma unroll
                for (int j = 0; j < 8; ++j) g[j] = gelu_tanh(f[j]);
                unpack8(vr[1], f);
#pragma unroll
                for (int j = 0; j < 8; ++j) g[8 + j] = gelu_tanh(f[j]); }
            float ss = 0.f;
#pragma unroll
            for (int j = 0; j < 16; ++j) ss += g[j] * g[j];
            ss += shx(ss, 1); ss += shx(ss, 2);
            const float rs = rsqrtf(ss * (1.0f / 64.0f) + EPS);
#pragma unroll
            for (int j = 0; j < 16; ++j) vs[s * 64 + d0 + j] = g[j] * rs * gn[h * 64 + d0 + j];
        }
        __syncthreads();
        const int t = s;
        float acc[16];
#pragma unroll
        for (int j = 0; j < 16; ++j) acc[j] = 0.f;
        const float* wr = wsp + ((size_t)h * 128 + t) * 128;
#pragma unroll 2
        for (int s2 = 0; s2 <= t; ++s2) { const float w = wr[s2];
#pragma unroll
            for (int j = 0; j < 16; ++j) acc[j] += w * vs[s2 * 64 + d0 + j]; }
        const float bias = bsp[h * 128 + t];
        const v4u* ur = (const v4u*)(K.P() + (size_t)(t0 + t) * PLD + C_U + h * 64 + d0);
        float u0[8], u1[8]; unpack8(ur[0], u0); unpack8(ur[1], u1);
        float o[16];
#pragma unroll
        for (int j = 0; j < 8; ++j) { o[j] = gelu_tanh(u0[j]) * (acc[j] + bias); o[8 + j] = gelu_tanh(u1[j]) * (acc[8 + j] + bias); }
        v4u* op = (v4u*)(K.XN() + (size_t)(t0 + t) * D + 512 + h * 64 + d0);
        op[0] = (v4u){pk2(o[0], o[1]), pk2(o[2], o[3]), pk2(o[4], o[5]), pk2(o[6], o[7])};
        op[1] = (v4u){pk2(o[8], o[9]), pk2(o[10], o[11]), pk2(o[12], o[13]), pk2(o[14], o[15])};
    }
}
typedef short bf16x8 __attribute__((ext_vector_type(8)));
__device__ __forceinline__ float fexp(float x) { return __builtin_amdgcn_exp2f(x * 1.4426950408889634f); }
__device__ __forceinline__ float logsig_fast(float x) { return fminf(x, 0.f) - __log2f(1.0f + fexp(-fabsf(x))) * 0.6931471805599453f; }
__device__ __forceinline__ float silu_fast(float x) { return x * __builtin_amdgcn_rcpf(1.0f + __builtin_amdgcn_exp2f(-1.4426950408889634f * x)); }
__device__ __forceinline__ float gelu_fast(float x) { const float u = 0.7978845608028654f * (x + 0.044715f * x * x * x); return x * __builtin_amdgcn_rcpf(1.0f + __builtin_amdgcn_exp2f(-2.8853900817779268f * u)); }
__device__ __forceinline__ f32x4 mfma16(bf16x8 a, bf16x8 b, f32x4 c) { return __builtin_amdgcn_mfma_f32_16x16x32_bf16(a, b, c, 0, 0, 0); }
constexpr int LROWB = 144;
constexpr int L_QD = 0, L_KI = 9216, L_KDT = 18432, L_VT = 27648, L_S = 46080, L_ST = 55296, L_OB = 73728, L_TOT = 107520, OBROW = 528;
#define FRAG(base, row, kel) (*(const LAS bf16x8*)(lds + (base) + (row) * LROWB + (kel) * 2))

__device__ __forceinline__ float gla_b8(const KA& K, LAS unsigned char* lds, int l, int h, int t0, int lane, int wave, float (&bv)[8]) {
    const float* wup = K.in(3) + (size_t)l * 16 * 256 + h * 64 + lane;
    float wu[16];
#pragma unroll
    for (int r = 0; r < 16; ++r) wu[r] = wup[r * 256];
    const float bg = K.in(4)[l * 256 + h * 64 + lane];
    const bf16* P = K.P();
    float run = 0.f;
#pragma unroll
    for (int j = 0; j < 8; ++j) {
        const bf16* gl = P + (size_t)(t0 + 8 * wave + j) * PLD + C_GK;
        float f0[8], f1[8]; unpack8(*(const v4u*)gl, f0); unpack8(*(const v4u*)(gl + 8), f1);
        float a = bg;
#pragma unroll
        for (int r = 0; r < 8; ++r) a += f0[r] * wu[r];
#pragma unroll
        for (int r = 0; r < 8; ++r) a += f1[r] * wu[8 + r];
        run += logsig_fast(a) * (1.0f / 16.0f); bv[j] = run;
    }
    LAS float* tot = (LAS float*)(lds + L_TOT);
    tot[wave * 64 + lane] = run;
    __syncthreads();
    float base = 0.f, all = 0.f;
#pragma unroll
    for (int g = 0; g < 8; ++g) { const float tv = tot[g * 64 + lane]; all += tv; if (g < wave) base += tv; }
#pragma unroll
    for (int j = 0; j < 8; ++j) bv[j] += base;
    return all;
}
__device__ __forceinline__ void gla_stage_vT(const bf16* P, LAS unsigned char* lds, int h, int t0, int tid) {
    const int vv = tid & 127, cq = tid >> 7;
    const bf16* vp = P + (size_t)(t0 + 16 * cq) * PLD + C_V + h * 128 + vv;
    unsigned w[8];
#pragma unroll
    for (int j = 0; j < 8; ++j) w[j] = (unsigned)vp[(size_t)(2 * j) * PLD] | ((unsigned)vp[(size_t)(2 * j + 1) * PLD] << 16);
    LAS v4u* dst = (LAS v4u*)(lds + L_VT + vv * LROWB + cq * 32);
    dst[0] = (v4u){w[0], w[1], w[2], w[3]}; dst[1] = (v4u){w[4], w[5], w[6], w[7]};
}

__device__ __forceinline__ void phase_gla_kv_mfma(Frame& F, int l) {
    const KA K = KA::fresh(); PHASE_TID;
    LAS unsigned char* lds = F.lds;
    const int fr = lane & 15, fq = lane >> 4;
#pragma unroll 1
    for (int ci = F.bx; ci < NB * GH * GN; ci += F.G) {
        const int b = ci / (GH * GN), h = (ci / GN) % GH, n = ci % GN, t0 = b * S + n * GC;
        const bf16* P = K.P();
        __syncthreads();
        float bv[8]; const float bl = gla_b8(K, lds, l, h, t0, lane, wave, bv);
        {
            const bf16* kp = P + (size_t)(t0 + 8 * wave) * PLD + C_K + h * 64 + lane;
            float kd[8];
#pragma unroll
            for (int j = 0; j < 8; ++j) kd[j] = bf2f(kp[(size_t)j * PLD]) * fexp(bl - bv[j]);
            *(LAS v4u*)(lds + L_KDT + lane * LROWB + wave * 16) = (v4u){pk2(kd[0], kd[1]), pk2(kd[2], kd[3]), pk2(kd[4], kd[5]), pk2(kd[6], kd[7])};
        }
        gla_stage_vT(P, lds, h, t0, tid);
        if (wave == 0) K.dec()[(size_t)ci * 64 + lane] = fexp(bl);
        __syncthreads();
        bf16x8 Bf[2];
#pragma unroll
        for (int ks = 0; ks < 2; ++ks) Bf[ks] = FRAG(L_VT, 16 * wave + fr, 32 * ks + 8 * fq);
        float* so = K.Sst() + (size_t)ci * 64 * 128 + 16 * wave + fr;
#pragma unroll
        for (int dt = 0; dt < 4; ++dt) {
            f32x4 acc = (f32x4){0.f, 0.f, 0.f, 0.f};
#pragma unroll
            for (int ks = 0; ks < 2; ++ks) acc = mfma16(FRAG(L_KDT, 16 * dt + fr, 32 * ks + 8 * fq), Bf[ks], acc);
#pragma unroll
            for (int r = 0; r < 4; ++r) so[(size_t)(16 * dt + 4 * fq + r) * 128] = acc[r];
        }
    }
}

__device__ __forceinline__ void phase_gla_out_mfma(Frame& F, int l) {
    const KA K = KA::fresh(); PHASE_TID;
    LAS unsigned char* lds = F.lds;
    const int fr = lane & 15, fq = lane >> 4;
    const float* gnorm = K.in(5) + (size_t)l * 128;
#pragma unroll 1
    for (int ci = F.bx; ci < NB * GH * GN; ci += F.G) {
        const int b = ci / (GH * GN), h = (ci / GN) % GH, n = ci % GN, t0 = b * S + n * GC;
        const bf16* P = K.P();
        __syncthreads();
        float bv[8]; (void)gla_b8(K, lds, l, h, t0, lane, wave, bv);
        {
            const bf16* qp = P + (size_t)(t0 + 8 * wave) * PLD + C_Q + h * 64 + lane;
            const bf16* kp = qp + (C_K - C_Q);
#pragma unroll
            for (int j = 0; j < 8; ++j) {
                const float e = fexp(bv[j]);
                const float qv = bf2f(qp[(size_t)j * PLD]) * 0.125f * e, kv = bf2f(kp[(size_t)j * PLD]) * __builtin_amdgcn_rcpf(e);
                *(LAS bf16*)(lds + L_QD + (8 * wave + j) * LROWB + lane * 2) = (bf16)f2bf(qv);
                *(LAS bf16*)(lds + L_KI + (8 * wave + j) * LROWB + lane * 2) = (bf16)f2bf(kv);
            }
        }
        gla_stage_vT(P, lds, h, t0, tid);
        {
            const int vv = tid & 127, dq = tid >> 7;
            const float* sp = K.Sst() + ((size_t)ci * 64 + 16 * dq) * 128 + vv;
            unsigned w[8];
#pragma unroll
            for (int j = 0; j < 8; ++j) w[j] = pk2(sp[(size_t)(2 * j) * 128], sp[(size_t)(2 * j + 1) * 128]);
            LAS v4u* dst = (LAS v4u*)(lds + L_ST + vv * LROWB + dq * 32);
            dst[0] = (v4u){w[0], w[1], w[2], w[3]}; dst[1] = (v4u){w[4], w[5], w[6], w[7]};
        }
        __syncthreads();
#pragma unroll
        for (int i = 0; i < 2; ++i) {
            const int tix = 2 * wave + i, st = tix >> 2, ct = tix & 3;
            f32x4 acc = (f32x4){0.f, 0.f, 0.f, 0.f};
#pragma unroll
            for (int ks = 0; ks < 2; ++ks) acc = mfma16(FRAG(L_KI, 16 * st + fr, 32 * ks + 8 * fq), FRAG(L_QD, 16 * ct + fr, 32 * ks + 8 * fq), acc);
            const int s0 = 16 * st + 4 * fq, c = 16 * ct + fr;
            float m[4];
#pragma unroll
            for (int r = 0; r < 4; ++r) m[r] = (s0 + r <= c) ? acc[r] : 0.f;
            *(LAS v2u*)(lds + L_S + c * LROWB + s0 * 2) = (v2u){pk2(m[0], m[1]), pk2(m[2], m[3])};
        }
        __syncthreads();
        {
            bf16x8 Av[2], As[2];
#pragma unroll
            for (int ks = 0; ks < 2; ++ks) { Av[ks] = FRAG(L_VT, 16 * wave + fr, 32 * ks + 8 * fq); As[ks] = FRAG(L_ST, 16 * wave + fr, 32 * ks + 8 * fq); }
#pragma unroll
            for (int ct = 0; ct < 4; ++ct) {
                f32x4 acc = (f32x4){0.f, 0.f, 0.f, 0.f};
#pragma unroll
                for (int ks = 0; ks < 2; ++ks) { acc = mfma16(Av[ks], FRAG(L_S, 16 * ct + fr, 32 * ks + 8 * fq), acc); acc = mfma16(As[ks], FRAG(L_QD, 16 * ct + fr, 32 * ks + 8 * fq), acc); }
                *(LAS f32x4*)(lds + L_OB + (16 * ct + fr) * OBROW + (16 * wave + 4 * fq) * 4) = acc;
            }
        }
        __syncthreads();
        {
            const int c = tid >> 3, vg = tid & 7;
            const LAS f32x4* ob = (const LAS f32x4*)(lds + L_OB + c * OBROW + vg * 64);
            f32x4 o[4]; float ss = 0.f;
#pragma unroll
            for (int j = 0; j < 4; ++j) { o[j] = ob[j]; ss += (o[j].x * o[j].x + o[j].y * o[j].y) + (o[j].z * o[j].z + o[j].w * o[j].w); }
            ss = sum8(ss);
            const float rs = rsqrtf(ss * (1.0f / 128.0f) + EPS);
            const v4u* gr = (const v4u*)(P + (size_t)(t0 + c) * PLD + C_G + h * 128 + 16 * vg);
            float g0[8], g1[8]; unpack8(gr[0], g0); unpack8(gr[1], g1);
            const f32x4* gn = (const f32x4*)(gnorm + 16 * vg);
            const f32x4 n0 = gn[0], n1 = gn[1], n2 = gn[2], n3 = gn[3];
            v4u w0, w1;
            w0.x = pk2(o[0].x * rs * n0.x * silu_fast(g0[0]), o[0].y * rs * n0.y * silu_fast(g0[1])); w0.y = pk2(o[0].z * rs * n0.z * silu_fast(g0[2]), o[0].w * rs * n0.w * silu_fast(g0[3]));
            w0.z = pk2(o[1].x * rs * n1.x * silu_fast(g0[4]), o[1].y * rs * n1.y * silu_fast(g0[5])); w0.w = pk2(o[1].z * rs * n1.z * silu_fast(g0[6]), o[1].w * rs * n1.w * silu_fast(g0[7]));
            w1.x = pk2(o[2].x * rs * n2.x * silu_fast(g1[0]), o[2].y * rs * n2.y * silu_fast(g1[1])); w1.y = pk2(o[2].z * rs * n2.z * silu_fast(g1[2]), o[2].w * rs * n2.w * silu_fast(g1[3]));
            w1.z = pk2(o[3].x * rs * n3.x * silu_fast(g1[4]), o[3].y * rs * n3.y * silu_fast(g1[5])); w1.w = pk2(o[3].z * rs * n3.z * silu_fast(g1[6]), o[3].w * rs * n3.w * silu_fast(g1[7]));
            v4u* op = (v4u*)(K.XN() + (size_t)(t0 + c) * D + h * 128 + 16 * vg);
            op[0] = w0; op[1] = w1;
        }
    }
}
#undef FRAG


constexpr int L_GKL = 109568, L_BL = 117760, SCN = 4, NSC = GN / SCN, NITEM = NB * GH * NSC;
#define FRAG(base, row, kel) (*(const LAS bf16x8*)(lds + (base) + (row) * LROWB + (kel) * 2))
struct GlaPre { unsigned short k[8], q[8], v[16]; v4u g0, g1; };
template <bool WITH_Q>
__device__ __forceinline__ void gla_prefetch(GlaPre& p, const bf16* P, int h, int t0, int tid, int lane, int wave) {
    const bf16* kp = P + (size_t)(t0 + 8 * wave) * PLD + C_K + h * 64 + lane;
#pragma unroll
    for (int j = 0; j < 8; ++j) p.k[j] = kp[(size_t)j * PLD];
    const int vv = tid & 127, cq = tid >> 7;
    const bf16* vp = P + (size_t)(t0 + 16 * cq) * PLD + C_V + h * 128 + vv;
#pragma unroll
    for (int j = 0; j < 16; ++j) p.v[j] = vp[(size_t)j * PLD];
    if (WITH_Q) {
        const bf16* qp = kp + (C_Q - C_K);
#pragma unroll
        for (int j = 0; j < 8; ++j) p.q[j] = qp[(size_t)j * PLD];
        const v4u* gr = (const v4u*)(P + (size_t)(t0 + (tid >> 3)) * PLD + C_G + h * 128 + 16 * (tid & 7));
        p.g0 = gr[0]; p.g1 = gr[1];
    }
}
__device__ __forceinline__ void gla_stage_gkl(const bf16* P, LAS unsigned char* lds, int tok0, int tid) {
    *(LAS v4u*)(lds + L_GKL + tid * 16) = *(const v4u*)(P + (size_t)(tok0 + (tid >> 1)) * PLD + C_GK + 8 * (tid & 1));
}
__device__ __forceinline__ void gla_b8_part(LAS unsigned char* lds, const float (&wu)[16], float bg, int n, int lane, int wave, float (&bv)[8]) {
    float run = 0.f;
#pragma unroll
    for (int j = 0; j < 8; ++j) {
        const LAS v4u* gl = (const LAS v4u*)(lds + L_GKL + (n * 64 + 8 * wave + j) * 32);
        float f0[8], f1[8]; unpack8(gl[0], f0); unpack8(gl[1], f1);
        float a = bg;
#pragma unroll
        for (int r = 0; r < 8; ++r) a += f0[r] * wu[r];
#pragma unroll
        for (int r = 0; r < 8; ++r) a += f1[r] * wu[8 + r];
        run += logsig_fast(a) * (1.0f / 16.0f); bv[j] = run;
    }
    ((LAS float*)(lds + L_TOT))[wave * 64 + lane] = run;
}
__device__ __forceinline__ float gla_b8_finish(LAS unsigned char* lds, int lane, int wave, float (&bv)[8]) {
    const LAS float* tot = (const LAS float*)(lds + L_TOT);
    float base = 0.f, all = 0.f;
#pragma unroll
    for (int g = 0; g < 8; ++g) { const float tv = tot[g * 64 + lane]; all += tv; if (g < wave) base += tv; }
#pragma unroll
    for (int j = 0; j < 8; ++j) bv[j] += base;
    return all;
}
__device__ __forceinline__ void gla_write_kdT_vT(LAS unsigned char* lds, const GlaPre& p, const float (&bv)[8], float bl, int tid, int lane, int wave) {
    float kd[8];
#pragma unroll
    for (int j = 0; j < 8; ++j) kd[j] = bf2f(p.k[j]) * fexp(bl - bv[j]);
    *(LAS v4u*)(lds + L_KDT + lane * LROWB + wave * 16) = (v4u){pk2(kd[0], kd[1]), pk2(kd[2], kd[3]), pk2(kd[4], kd[5]), pk2(kd[6], kd[7])};
    const int vv = tid & 127, cq = tid >> 7;
    LAS v4u* dst = (LAS v4u*)(lds + L_VT + vv * LROWB + cq * 32);
    dst[0] = (v4u){(unsigned)p.v[0] | ((unsigned)p.v[1] << 16), (unsigned)p.v[2] | ((unsigned)p.v[3] << 16), (unsigned)p.v[4] | ((unsigned)p.v[5] << 16), (unsigned)p.v[6] | ((unsigned)p.v[7] << 16)};
    dst[1] = (v4u){(unsigned)p.v[8] | ((unsigned)p.v[9] << 16), (unsigned)p.v[10] | ((unsigned)p.v[11] << 16), (unsigned)p.v[12] | ((unsigned)p.v[13] << 16), (unsigned)p.v[14] | ((unsigned)p.v[15] << 16)};
    if (wave == 0) ((LAS float*)(lds + L_BL))[lane] = bl;
}
__device__ __forceinline__ void gla_kv_mfma(LAS unsigned char* lds, int wave, int fr, int fq, f32x4 (&acc)[4]) {
    bf16x8 Bf[2];
#pragma unroll
    for (int ks = 0; ks < 2; ++ks) Bf[ks] = FRAG(L_VT, 16 * wave + fr, 32 * ks + 8 * fq);
#pragma unroll
    for (int dt = 0; dt < 4; ++dt) { acc[dt] = (f32x4){0.f, 0.f, 0.f, 0.f};
#pragma unroll
        for (int ks = 0; ks < 2; ++ks) acc[dt] = mfma16(FRAG(L_KDT, 16 * dt + fr, 32 * ks + 8 * fq), Bf[ks], acc[dt]); }
}

__device__ __forceinline__ void phase_gla_A2(Frame& F, int l) {
    const KA K = KA::fresh(); PHASE_TID;
    LAS unsigned char* lds = F.lds;
    const int fr = lane & 15, fq = lane >> 4;
#pragma unroll 1
    for (int it = F.bx; it < NITEM; it += F.G) {
        const int b = it / (GH * NSC), h = (it / NSC) % GH, sc = it % NSC, tok0 = b * S + sc * SCN * GC;
        const bf16* P = K.P();
        float wu[16];
        { const float* wup = K.in(3) + (size_t)l * 16 * 256 + h * 64 + lane;
#pragma unroll
          for (int r = 0; r < 16; ++r) wu[r] = wup[r * 256]; }
        const float bg = K.in(4)[l * 256 + h * 64 + lane];
        GlaPre pre[2]; gla_prefetch<false>(pre[0], P, h, tok0, tid, lane, wave); gla_prefetch<false>(pre[1], P, h, tok0 + GC, tid, lane, wave);
        __syncthreads();
        gla_stage_gkl(P, lds, tok0, tid);
        __syncthreads();
        f32x4 Sl[4], bs[4];
#pragma unroll
        for (int dt = 0; dt < 4; ++dt) { Sl[dt] = (f32x4){0.f, 0.f, 0.f, 0.f}; bs[dt] = (f32x4){0.f, 0.f, 0.f, 0.f}; }
#pragma unroll
        for (int n = 0; n < SCN; ++n) {
            float bv[8]; gla_b8_part(lds, wu, bg, n, lane, wave, bv);
            __syncthreads();
            const float bl = gla_b8_finish(lds, lane, wave, bv);
            gla_write_kdT_vT(lds, pre[n & 1], bv, bl, tid, lane, wave);
            if (n + 2 < SCN) gla_prefetch<false>(pre[n & 1], P, h, tok0 + (n + 2) * GC, tid, lane, wave);
            __syncthreads();
            f32x4 acc[4]; gla_kv_mfma(lds, wave, fr, fq, acc);
#pragma unroll
            for (int dt = 0; dt < 4; ++dt) { const f32x4 bl4 = *(const LAS f32x4*)(lds + L_BL + (16 * dt + 4 * fq) * 4);
                bs[dt] = bs[dt] + bl4;
#pragma unroll
                for (int r = 0; r < 4; ++r) Sl[dt][r] = fexp(bl4[r]) * Sl[dt][r] + acc[dt][r]; }
        }
        f32x4* ag = (f32x4*)K.Sst() + ((size_t)(it * 8 + wave) * 4) * 64 + lane;
#pragma unroll
        for (int dt = 0; dt < 4; ++dt) ag[dt * 64] = Sl[dt];
        if (wave == 0 && fr == 0) { f32x4* dp = (f32x4*)K.dec() + (size_t)it * 16 + fq;
#pragma unroll
            for (int dt = 0; dt < 4; ++dt) dp[dt * 4] = (f32x4){fexp(bs[dt][0]), fexp(bs[dt][1]), fexp(bs[dt][2]), fexp(bs[dt][3])}; }
    }
}


__device__ __forceinline__ void phase_gla_aggscan(Frame& F) {
    const KA K = KA::fresh(); PHASE_TID;
#pragma unroll 1
    for (int e = F.bx * NT + tid; e < NB * GH * 8192; e += F.G * NT) {
        const int bh = e >> 13, el = e & 8191, ln = (el >> 2) & 63, dt = (el >> 8) & 3, r = el & 3;
        float* ap = K.Sst() + (size_t)bh * NSC * 8192 + el; const float* dp = K.dec() + (size_t)bh * NSC * 64 + dt * 16 + (ln >> 4) * 4 + r;
        float a[NSC], d[NSC];
#pragma unroll
        for (int j = 0; j < NSC; ++j) { a[j] = ap[(size_t)j * 8192]; d[j] = dp[j * 64]; }
        float st = 0.f;
#pragma unroll
        for (int j = 0; j < NSC; ++j) { ap[(size_t)j * 8192] = st; st = d[j] * st + a[j]; }
    }
}
__device__ __forceinline__ void phase_gla_C2(Frame& F, int l) {
    const KA K = KA::fresh(); PHASE_TID;
    LAS unsigned char* lds = F.lds;
    const int fr = lane & 15, fq = lane >> 4;
    const float* gnorm = K.in(5) + (size_t)l * 128;
#pragma unroll 1
    for (int it = F.bx; it < NITEM; it += F.G) {
        const int b = it / (GH * NSC), h = (it / NSC) % GH, sc = it % NSC, tok0 = b * S + sc * SCN * GC;
        const bf16* P = K.P();
        float wu[16];
        { const float* wup = K.in(3) + (size_t)l * 16 * 256 + h * 64 + lane;
#pragma unroll
          for (int r = 0; r < 16; ++r) wu[r] = wup[r * 256]; }
        const float bg = K.in(4)[l * 256 + h * 64 + lane];
        GlaPre pre[2]; gla_prefetch<true>(pre[0], P, h, tok0, tid, lane, wave); gla_prefetch<true>(pre[1], P, h, tok0 + GC, tid, lane, wave);
        __syncthreads();
        gla_stage_gkl(P, lds, tok0, tid);
        f32x4 Sm[4];
        { const f32x4* ag = (const f32x4*)K.Sst() + ((size_t)(it * 8 + wave) * 4) * 64 + lane;
#pragma unroll
          for (int dt = 0; dt < 4; ++dt) Sm[dt] = ag[dt * 64]; }
        __syncthreads();
#pragma unroll
        for (int n = 0; n < SCN; ++n) {
            const int t0 = tok0 + n * GC;
            GlaPre& pr = pre[n & 1];
            float bv[8]; gla_b8_part(lds, wu, bg, n, lane, wave, bv);
            __syncthreads();
            const float bl = gla_b8_finish(lds, lane, wave, bv);
            gla_write_kdT_vT(lds, pr, bv, bl, tid, lane, wave);
#pragma unroll
            for (int j = 0; j < 8; ++j) {
                const float e = fexp(bv[j]);
                *(LAS bf16*)(lds + L_QD + (8 * wave + j) * LROWB + lane * 2) = (bf16)f2bf(bf2f(pr.q[j]) * 0.125f * e);
                *(LAS bf16*)(lds + L_KI + (8 * wave + j) * LROWB + lane * 2) = (bf16)f2bf(bf2f(pr.k[j]) * __builtin_amdgcn_rcpf(e));
            }
#pragma unroll
            for (int dt = 0; dt < 4; ++dt) *(LAS v2u*)(lds + L_ST + (16 * wave + fr) * LROWB + (16 * dt + 4 * fq) * 2) = (v2u){pk2(Sm[dt][0], Sm[dt][1]), pk2(Sm[dt][2], Sm[dt][3])};
            const v4u gq0 = pr.g0, gq1 = pr.g1;
            if (n + 2 < SCN) gla_prefetch<true>(pr, P, h, t0 + 2 * GC, tid, lane, wave);
            __syncthreads();
#pragma unroll
            for (int i = 0; i < 2; ++i) {
                const int tix = 2 * wave + i, st = tix >> 2, ct = tix & 3;
                f32x4 a = (f32x4){0.f, 0.f, 0.f, 0.f};
#pragma unroll
                for (int ks = 0; ks < 2; ++ks) a = mfma16(FRAG(L_KI, 16 * st + fr, 32 * ks + 8 * fq), FRAG(L_QD, 16 * ct + fr, 32 * ks + 8 * fq), a);
                const int s0 = 16 * st + 4 * fq, c = 16 * ct + fr;
                float m[4];
#pragma unroll
                for (int r = 0; r < 4; ++r) m[r] = (s0 + r <= c) ? a[r] : 0.f;
                *(LAS v2u*)(lds + L_S + c * LROWB + s0 * 2) = (v2u){pk2(m[0], m[1]), pk2(m[2], m[3])};
            }
            f32x4 kv[4]; gla_kv_mfma(lds, wave, fr, fq, kv);
            __syncthreads();
            {
                bf16x8 Av[2], As[2];
#pragma unroll
                for (int ks = 0; ks < 2; ++ks) { Av[ks] = FRAG(L_VT, 16 * wave + fr, 32 * ks + 8 * fq); As[ks] = FRAG(L_ST, 16 * wave + fr, 32 * ks + 8 * fq); }
#pragma unroll
                for (int ct = 0; ct < 4; ++ct) {
                    f32x4 a = (f32x4){0.f, 0.f, 0.f, 0.f};
#pragma unroll
                    for (int ks = 0; ks < 2; ++ks) { a = mfma16(Av[ks], FRAG(L_S, 16 * ct + fr, 32 * ks + 8 * fq), a); a = mfma16(As[ks], FRAG(L_QD, 16 * ct + fr, 32 * ks + 8 * fq), a); }
                    *(LAS f32x4*)(lds + L_OB + (16 * ct + fr) * OBROW + (16 * wave + 4 * fq) * 4) = a;
                }
            }
#pragma unroll
            for (int dt = 0; dt < 4; ++dt) { const f32x4 bl4 = *(const LAS f32x4*)(lds + L_BL + (16 * dt + 4 * fq) * 4);
#pragma unroll
                for (int r = 0; r < 4; ++r) Sm[dt][r] = fexp(bl4[r]) * Sm[dt][r] + kv[dt][r]; }
            __syncthreads();
            {
                const int c = tid >> 3, vg = tid & 7;
                const LAS f32x4* ob = (const LAS f32x4*)(lds + L_OB + c * OBROW + vg * 64);
                f32x4 o[4]; float ss = 0.f;
#pragma unroll
                for (int j = 0; j < 4; ++j) { o[j] = ob[j]; ss += (o[j].x * o[j].x + o[j].y * o[j].y) + (o[j].z * o[j].z + o[j].w * o[j].w); }
                ss = sum8(ss);
                const float rs = rsqrtf(ss * (1.0f / 128.0f) + EPS);
                float g0[8], g1[8]; unpack8(gq0, g0); unpack8(gq1, g1);
                const f32x4* gn = (const f32x4*)(gnorm + 16 * vg);
                const f32x4 n0 = gn[0], n1 = gn[1], n2 = gn[2], n3 = gn[3];
                v4u w0, w1;
                w0.x = pk2(o[0].x * rs * n0.x * silu_fast(g0[0]), o[0].y * rs * n0.y * silu_fast(g0[1])); w0.y = pk2(o[0].z * rs * n0.z * silu_fast(g0[2]), o[0].w * rs * n0.w * silu_fast(g0[3]));
                w0.z = pk2(o[1].x * rs * n1.x * silu_fast(g0[4]), o[1].y * rs * n1.y * silu_fast(g0[5])); w0.w = pk2(o[1].z * rs * n1.z * silu_fast(g0[6]), o[1].w * rs * n1.w * silu_fast(g0[7]));
                w1.x = pk2(o[2].x * rs * n2.x * silu_fast(g1[0]), o[2].y * rs * n2.y * silu_fast(g1[1])); w1.y = pk2(o[2].z * rs * n2.z * silu_fast(g1[2]), o[2].w * rs * n2.w * silu_fast(g1[3]));
                w1.z = pk2(o[3].x * rs * n3.x * silu_fast(g1[4]), o[3].y * rs * n3.y * silu_fast(g1[5])); w1.w = pk2(o[3].z * rs * n3.z * silu_fast(g1[6]), o[3].w * rs * n3.w * silu_fast(g1[7]));
                v4u* op = (v4u*)(K.XN() + (size_t)(t0 + c) * D + h * 128 + 16 * vg);
                op[0] = w0; op[1] = w1;
            }
        }
    }
}
#undef FRAG

constexpr int GM_ROWB = 272;
__device__ __forceinline__ void phase_gmlp_mfma(Frame& F, int l) {
    const KA K = KA::fresh(); PHASE_TID;
    LAS unsigned char* lds = F.lds;
    const int fr = lane & 15, fq = lane >> 4;
    const int nks = (16 * wave + 15) / 32 + 1;
#pragma unroll 1
    for (int u = F.bx; u < NB * MN * MH; u += F.G) {
        const int b = u / (MN * MH), n = (u / MH) % MN, h = u % MH, t0 = b * S + n * MC;
        const bf16* P = K.P();
        const float gn = K.in(6)[(size_t)l * 256 + h * 64 + lane];
        unsigned short vraw[16];
#pragma unroll
        for (int i = 0; i < 16; ++i) vraw[i] = P[(size_t)(t0 + 16 * wave + i) * PLD + C_VG + h * 64 + lane];
        const bf16* Wb = K.Wsp() + ((size_t)(l * MH + h) * 128 + 16 * wave + fr) * 128 + 8 * fq;
        bf16x8 Bf[4];
#pragma unroll
        for (int ks = 0; ks < 4; ++ks) Bf[ks] = (ks < nks) ? *(const bf16x8*)(Wb + 32 * ks) : (bf16x8){0, 0, 0, 0, 0, 0, 0, 0};
        const int t = 16 * wave + fr;
        const float bias = K.in(8)[(size_t)l * MH * 128 + h * 128 + t];
        const bf16* up = P + (size_t)(t0 + t) * PLD + C_U + h * 64 + 4 * fq;
        v2u uw[4];
#pragma unroll
        for (int dt = 0; dt < 4; ++dt) uw[dt] = *(const v2u*)(up + 16 * dt);
        __syncthreads();
#pragma unroll
        for (int q = 0; q < 2; ++q) {
            float vs[8];
#pragma unroll
            for (int i = 0; i < 8; ++i) {
                const float g = gelu_fast(bf2f(vraw[8 * q + i]));
                const float ss = wave_sum(g * g);
                vs[i] = g * rsqrtf(ss * (1.0f / 64.0f) + EPS) * gn;
            }
            *(LAS v4u*)(lds + lane * GM_ROWB + (16 * wave + 8 * q) * 2) = (v4u){pk2(vs[0], vs[1]), pk2(vs[2], vs[3]), pk2(vs[4], vs[5]), pk2(vs[6], vs[7])};
        }
        __syncthreads();
        f32x4 acc[4];
#pragma unroll
        for (int dt = 0; dt < 4; ++dt) acc[dt] = (f32x4){0.f, 0.f, 0.f, 0.f};
#pragma unroll
        for (int ks = 0; ks < 4; ++ks) if (ks < nks) {
#pragma unroll
            for (int dt = 0; dt < 4; ++dt) acc[dt] = mfma16(*(const LAS bf16x8*)(lds + (16 * dt + fr) * GM_ROWB + (32 * ks + 8 * fq) * 2), Bf[ks], acc[dt]);
        }
        bf16* op = K.XN() + (size_t)(t0 + t) * D + 512 + h * 64 + 4 * fq;
#pragma unroll
        for (int dt = 0; dt < 4; ++dt) {
            const float o0 = gelu_fast(bflo(uw[dt].x)) * (acc[dt][0] + bias), o1 = gelu_fast(bfhi(uw[dt].x)) * (acc[dt][1] + bias), o2 = gelu_fast(bflo(uw[dt].y)) * (acc[dt][2] + bias), o3 = gelu_fast(bfhi(uw[dt].y)) * (acc[dt][3] + bias);
            *(v2u*)(op + 16 * dt) = (v2u){pk2(o0, o1), pk2(o2, o3)};
        }
    }
}
__device__ __forceinline__ void phase_conv(Frame& F, int l) {
    const KA K = KA::fresh(); PHASE_TID;
    const float* wc = K.in(9) + (size_t)l * 3 * 256;
#pragma unroll 1
    for (int e = F.bx * NT + tid; e < T * 32; e += F.G * NT) {
        const int t = e >> 5, c0 = (e & 31) * 8, tl = t % S;
        const bf16* row = K.P() + (size_t)t * PLD;
        float y[8], xi[8], cg[8], bg[8];
        unpack8(*(const v4u*)(row + C_XI + c0), xi); unpack8(*(const v4u*)(row + C_CG + c0), cg); unpack8(*(const v4u*)(row + C_BG + c0), bg);
#pragma unroll
        for (int j = 0; j < 8; ++j) y[j] = wc[2 * 256 + c0 + j] * cg[j] * xi[j];
        if (tl >= 1) { unpack8(*(const v4u*)(row - PLD + C_XI + c0), xi); unpack8(*(const v4u*)(row - PLD + C_CG + c0), cg);
#pragma unroll
            for (int j = 0; j < 8; ++j) y[j] += wc[1 * 256 + c0 + j] * cg[j] * xi[j]; }
        if (tl >= 2) { unpack8(*(const v4u*)(row - 2 * PLD + C_XI + c0), xi); unpack8(*(const v4u*)(row - 2 * PLD + C_CG + c0), cg);
#pragma unroll
            for (int j = 0; j < 8; ++j) y[j] += wc[0 * 256 + c0 + j] * cg[j] * xi[j]; }
#pragma unroll
        for (int j = 0; j < 8; ++j) y[j] *= bg[j];
        *(v4u*)(K.XN() + (size_t)t * D + 768 + c0) = (v4u){pk2(y[0], y[1]), pk2(y[2], y[3]), pk2(y[4], y[5]), pk2(y[6], y[7])};
    }
}
__device__ __forceinline__ void phase_norm_router(Frame& F, int l) {
    const KA K = KA::fresh(); PHASE_TID;
    const float* gain = K.in(11) + (size_t)l * D;
    const float* wrg = K.in(12) + (size_t)l * D * 4; const float* brg = K.in(13) + (size_t)l * 4;
    const float* wre = K.in(14) + (size_t)l * D * 32; const float* bre = K.in(15) + (size_t)l * 32;
    int* cnt = (int*)(K.ctl() + CW_CNT + 64 * l);
#pragma unroll 1
    for (int t = F.bx * NWAVES + wave; t < T; t += F.G * NWAVES) {
        const f32x4* xr = (const f32x4*)(K.out() + (size_t)t * D) + lane;
        f32x4 v[4]; float s = 0.f;
#pragma unroll
        for (int j = 0; j < 4; ++j) { v[j] = xr[64 * j]; s += (v[j].x * v[j].x + v[j].y * v[j].y) + (v[j].z * v[j].z + v[j].w * v[j].w); }
        const float rs = rsqrtf(wave_sum(s) * (1.f / D) + EPS);
        v2u* o8 = (v2u*)(K.XN() + (size_t)t * D) + lane;
        float acc[36];
#pragma unroll
        for (int j = 0; j < 36; ++j) acc[j] = 0.f;
#pragma unroll
        for (int j = 0; j < 4; ++j) {
            const f32x4 g = ((const f32x4*)gain)[lane + 64 * j];
            const float hv[4] = {v[j].x * rs * g.x, v[j].y * rs * g.y, v[j].z * rs * g.z, v[j].w * rs * g.w};
            v2u w; w.x = pk2(hv[0], hv[1]); w.y = pk2(hv[2], hv[3]); o8[64 * j] = w;
#pragma unroll
            for (int i = 0; i < 4; ++i) {
                const int k = 4 * lane + 256 * j + i; const float xv = hv[i];
                const f32x4 g4 = *(const f32x4*)(wrg + (size_t)k * 4);
                acc[0] += xv * g4.x; acc[1] += xv * g4.y; acc[2] += xv * g4.z; acc[3] += xv * g4.w;
                const f32x4* e4 = (const f32x4*)(wre + (size_t)k * 32);
#pragma unroll
                for (int q = 0; q < 8; ++q) { const f32x4 w4 = e4[q]; acc[4 + 4 * q] += xv * w4.x; acc[5 + 4 * q] += xv * w4.y; acc[6 + 4 * q] += xv * w4.z; acc[7 + 4 * q] += xv * w4.w; }
            }
        }
#pragma unroll
        for (int j = 0; j < 36; ++j) acc[j] = wave_sum(acc[j]);
        if (lane == 0) {
            float gl[4]; int gt = 0;
#pragma unroll
            for (int j = 0; j < 4; ++j) gl[j] = acc[j] + brg[j];
            float gmax = gl[0];
#pragma unroll
            for (int j = 1; j < 4; ++j) if (gl[j] > gmax) { gmax = gl[j]; gt = j; }
            float gs = 0.f;
#pragma unroll
            for (int j = 0; j < 4; ++j) gs += expf(gl[j] - gmax);
            const float gw = 1.0f / gs;
            float el[8];
#pragma unroll
            for (int j = 0; j < 8; ++j) { float vv = 0.f;
#pragma unroll
                for (int g = 0; g < 4; ++g) if (g == gt) vv = acc[4 + g * 8 + j] + bre[g * 8 + j];
                el[j] = vv; }
            int i0 = 0; float m0 = el[0];
#pragma unroll
            for (int j = 1; j < 8; ++j) if (el[j] > m0) { m0 = el[j]; i0 = j; }
            int i1 = -1; float m1 = -INFINITY;
#pragma unroll
            for (int j = 0; j < 8; ++j) if (j != i0 && el[j] > m1) { m1 = el[j]; i1 = j; }
            const float e1 = expf(m1 - m0);
            const float w0 = gw / (1.0f + e1), w1 = gw * e1 / (1.0f + e1);
            const int e0i = gt * 8 + i0, e1i = gt * 8 + i1;
            K.eid()[2 * t] = e0i; K.eid()[2 * t + 1] = e1i; K.ew()[2 * t] = w0; K.ew()[2 * t + 1] = w1;
            atomicAdd(&cnt[e0i], 1); atomicAdd(&cnt[e1i], 1);
        }
    }
}
constexpr int RT_PART = 0, RT_SS = RT_PART + 4 * 8 * 16 * 48 * 4, RT_RS = RT_SS + 4 * 8 * 16 * 4, RT_HIST = RT_RS + 64 * 4;
__device__ __forceinline__ void phase_norm_router_mfma(Frame& F, int l) {
    const KA K = KA::fresh(); PHASE_TID;
    LAS unsigned char* lds = F.lds;
    const int fr = lane & 15, fq = lane >> 4;
    const bf16* whi = K.Wr() + (size_t)l * 2 * 48 * D + (size_t)fr * D + 128 * wave + 8 * fq; const bf16* wlo = whi + 48 * D;
    bf16x8 Wh[4][3], Wl[4][3];
#pragma unroll
    for (int ks = 0; ks < 4; ++ks)
#pragma unroll
        for (int nt = 0; nt < 3; ++nt) { Wh[ks][nt] = *(const bf16x8*)(whi + (size_t)(16 * nt) * D + 32 * ks); Wl[ks][nt] = *(const bf16x8*)(wlo + (size_t)(16 * nt) * D + 32 * ks); }
    f32x4 g0[4], g1[4];
    { const float* gp = K.in(11) + (size_t)l * D + 128 * wave + 8 * fq;
#pragma unroll
      for (int ks = 0; ks < 4; ++ks) { g0[ks] = *(const f32x4*)(gp + 32 * ks); g1[ks] = *(const f32x4*)(gp + 32 * ks + 4); } }
#pragma unroll 1
    for (int blk = F.bx; blk < T / 64; blk += F.G) {
        const bf16* xr = K.XR() + (size_t)(blk * 64 + fr) * D + 128 * wave + 8 * fq;
        __syncthreads();
        if (tid < NE) ((LAS int*)(lds + RT_HIST))[tid] = 0;
#pragma unroll
        for (int tp = 0; tp < 2; ++tp) {
            v4u xa[2][4];
#pragma unroll
            for (int t2 = 0; t2 < 2; ++t2)
#pragma unroll
                for (int ks = 0; ks < 4; ++ks) xa[t2][ks] = *(const v4u*)(xr + (size_t)(16 * (2 * tp + t2)) * D + 32 * ks);
#pragma unroll
            for (int t2 = 0; t2 < 2; ++t2) {
                const int t = 2 * tp + t2;
                f32x4 acc[3]; float ss = 0.f;
#pragma unroll
                for (int nt = 0; nt < 3; ++nt) acc[nt] = (f32x4){0.f, 0.f, 0.f, 0.f};
#pragma unroll
                for (int ks = 0; ks < 4; ++ks) {
                    float xv[8]; unpack8(xa[t2][ks], xv);
#pragma unroll
                    for (int j = 0; j < 8; ++j) ss += xv[j] * xv[j];
                    const bf16x8 Ah = __builtin_bit_cast(bf16x8, xa[t2][ks]);
#pragma unroll
                    for (int nt = 0; nt < 3; ++nt) { acc[nt] = mfma16(Ah, Wh[ks][nt], acc[nt]); acc[nt] = mfma16(Ah, Wl[ks][nt], acc[nt]); }
                }
                ss += shx(ss, 16); ss += shx(ss, 32);
                LAS float* part = (LAS float*)(lds + RT_PART) + (t * 8 + wave) * 16 * 48;
#pragma unroll
                for (int nt = 0; nt < 3; ++nt)
#pragma unroll
                    for (int r = 0; r < 4; ++r) part[(4 * fq + r) * 48 + 16 * nt + fr] = acc[nt][r];
                if (fq == 0) ((LAS float*)(lds + RT_SS))[(t * 8 + wave) * 16 + fr] = ss;
            }
        }
        __syncthreads();
        {
            const int tt = tid >> 3, j = tid & 7, t = blk * 64 + tt;
            const LAS float* p0 = (const LAS float*)(lds + RT_PART) + ((tt >> 4) * 8 * 16 + (tt & 15)) * 48;
            const LAS float* s2 = (const LAS float*)(lds + RT_SS) + (tt >> 4) * 8 * 16 + (tt & 15);
            float sq = 0.f;
#pragma unroll
            for (int w = 0; w < 8; ++w) sq += s2[w * 16];
            const float rs = rsqrtf(sq * (1.f / D) + EPS);
#define RT_DOT(n) (((p0[(n)] + p0[768 + (n)]) + (p0[1536 + (n)] + p0[2304 + (n)])) + ((p0[3072 + (n)] + p0[3840 + (n)]) + (p0[4608 + (n)] + p0[5376 + (n)])))
            float gv = (j < 4) ? RT_DOT(j & 3) * rs + K.in(13)[(size_t)l * 4 + (j & 3)] : -INFINITY; int gi = j;
            const float gmine = gv;
#define RT_ARGMAX_STEP(V, I, FV, FI) do { const float ov = FV(V); const int oi = FI(I); if (ov > V || (ov == V && oi < I)) { V = ov; I = oi; } } while (0)
            RT_ARGMAX_STEP(gv, gi, dppf_x1, dpp_x1); RT_ARGMAX_STEP(gv, gi, dppf_x2, dpp_x2); RT_ARGMAX_STEP(gv, gi, dppf_hm, dpp_hm);
            float ge = (j < 4) ? expf(gmine - gv) : 0.f;
            ge = sum8(ge);
            const float gw = 1.0f / ge; const int gt = gi;
            const float ev = RT_DOT(4 + gt * 8 + j) * rs + K.in(15)[(size_t)l * 32 + gt * 8 + j];
#undef RT_DOT
            float m0 = ev; int i0 = j;
            RT_ARGMAX_STEP(m0, i0, dppf_x1, dpp_x1); RT_ARGMAX_STEP(m0, i0, dppf_x2, dpp_x2); RT_ARGMAX_STEP(m0, i0, dppf_hm, dpp_hm);
            float m1 = (j == i0) ? -INFINITY : ev; int i1 = j;
            RT_ARGMAX_STEP(m1, i1, dppf_x1, dpp_x1); RT_ARGMAX_STEP(m1, i1, dppf_x2, dpp_x2); RT_ARGMAX_STEP(m1, i1, dppf_hm, dpp_hm);
#undef RT_ARGMAX_STEP
            if (j == 0) {
                ((LAS float*)(lds + RT_RS))[tt] = rs;
                const float e1 = expf(m1 - m0);
                const float w0 = gw / (1.0f + e1), w1 = gw * e1 / (1.0f + e1);
                const int e0i = gt * 8 + i0, e1i = gt * 8 + i1;
                K.eid()[2 * t] = e0i; K.eid()[2 * t + 1] = e1i; K.ew()[2 * t] = w0; K.ew()[2 * t + 1] = w1;
                LAS int* hist = (LAS int*)(lds + RT_HIST);
                K.slot_of()[2 * t] = __hip_atomic_fetch_add(hist + e0i, 1, __ATOMIC_RELAXED, __HIP_MEMORY_SCOPE_WORKGROUP);
                K.slot_of()[2 * t + 1] = __hip_atomic_fetch_add(hist + e1i, 1, __ATOMIC_RELAXED, __HIP_MEMORY_SCOPE_WORKGROUP);
            }
        }
        __syncthreads();
        if (tid < NE) K.blkcnt()[(size_t)(l * (T / 64) + blk) * NE + tid] = ((LAS int*)(lds + RT_HIST))[tid];
        {
            bf16* hp = K.XN() + (size_t)(blk * 64 + fr) * D + 128 * wave + 8 * fq;
#pragma unroll
            for (int t = 0; t < 4; ++t) {
                const float rs = ((const LAS float*)(lds + RT_RS))[16 * t + fr];
#pragma unroll
                for (int ks = 0; ks < 4; ++ks) {
                    float xv[8]; unpack8(*(const v4u*)(xr + (size_t)(16 * t) * D + 32 * ks), xv);
                    *(v4u*)(hp + (size_t)(16 * t) * D + 32 * ks) = (v4u){pk2(xv[0] * rs * g0[ks].x, xv[1] * rs * g0[ks].y), pk2(xv[2] * rs * g0[ks].z, xv[3] * rs * g0[ks].w), pk2(xv[4] * rs * g1[ks].x, xv[5] * rs * g1[ks].y), pk2(xv[6] * rs * g1[ks].z, xv[7] * rs * g1[ks].w)};
                }
            }
        }
    }
}
__device__ __forceinline__ void phase_scatter(Frame& F, int l) {
    const KA K = KA::fresh(); PHASE_TID;
    LAS int* sm = (LAS int*)F.lds;
    const int* bc = K.blkcnt() + (size_t)l * (T / 64) * NE;
    constexpr int NBLK = T / 64;
#pragma unroll 1
    for (int blk = F.bx; blk < NBLK; blk += F.G) {
        __syncthreads();
        {   const int e = tid & 31, part = tid >> 5;
            int tot = 0, pre = 0;
#pragma unroll
            for (int j = 0; j < NBLK / 16; ++j) { const int bb = part * (NBLK / 16) + j; const int c = bc[bb * NE + e]; tot += c; if (bb < blk) pre += c; }
            sm[part * 32 + e] = tot; sm[512 + part * 32 + e] = pre; }
        __syncthreads();
        if (tid < 32) { int tot = 0, pre = 0;
#pragma unroll
            for (int p = 0; p < 16; ++p) { tot += sm[p * 32 + tid]; pre += sm[512 + p * 32 + tid]; }
            sm[1056 + tid] = tot; sm[1024 + tid] = pre; }
        __syncthreads();
        if (tid == 0) { int a = 0; for (int e = 0; e < NE; ++e) { const int c = sm[1056 + e]; sm[1024 + e] += a; a += c; } }
        if (blk == 0 && tid < 32) ((int*)(K.ctl() + CW_CNT + 64 * l))[tid] = sm[1056 + tid];
        __syncthreads();
        if (tid < 128) { const int a = blk * 128 + tid; const int e = K.eid()[a]; const int pos = sm[1024 + e] + K.slot_of()[a]; K.slot_tok()[pos] = a >> 1; K.slot_of()[a] = pos; }
    }
    __syncthreads();
}
template <bool DUAL>
__device__ __forceinline__ void gemm_core(const bf16* A, const int* rowoff, int K, const float* B0, const float* B1, int ldb, int n0,
                                          float (&acc0)[4][4], float (&acc1)[4][4], float* As, float* Bs0, float* Bs1) {
    const int tid = __builtin_amdgcn_readfirstlane(threadIdx.x >> 6) * 64 + fresh_lane(), tx = tid & 15, ty = tid >> 4;
    const int ar = tid >> 2, ak = (tid & 3) * 4;
    const int bk = (tid >> 4) & 15, bn = (tid & 15) * 4;
    const long aoff = rowoff[ar];
#pragma unroll
    for (int i = 0; i < 4; ++i)
#pragma unroll
        for (int j = 0; j < 4; ++j) { acc0[i][j] = 0.f; acc1[i][j] = 0.f; }
#pragma unroll 1
    for (int k0 = 0; k0 < K; k0 += 16) {
        v2u av = (v2u){0u, 0u};
        if (aoff >= 0) av = *(const v2u*)(A + aoff + k0 + ak);
        f32x4 bv0 = (f32x4){0.f, 0.f, 0.f, 0.f}, bv1 = bv0;
        if (tid < 256) { bv0 = *(const f32x4*)(B0 + (size_t)(k0 + bk) * ldb + n0 + bn); if (DUAL) bv1 = *(const f32x4*)(B1 + (size_t)(k0 + bk) * ldb + n0 + bn); }
        __syncthreads();
        As[(ak + 0) * 132 + ar] = bflo(av.x); As[(ak + 1) * 132 + ar] = bfhi(av.x); As[(ak + 2) * 132 + ar] = bflo(av.y); As[(ak + 3) * 132 + ar] = bfhi(av.y);
        if (tid < 256) { *(f32x4*)(Bs0 + bk * 64 + bn) = bv0; if (DUAL) *(f32x4*)(Bs1 + bk * 64 + bn) = bv1; }
        __syncthreads();
#pragma unroll
        for (int kk = 0; kk < 16; ++kk) {
            const f32x4 a4 = *(const f32x4*)(As + kk * 132 + ty * 4);
            const f32x4 b4 = *(const f32x4*)(Bs0 + kk * 64 + tx * 4);
#pragma unroll
            for (int i = 0; i < 4; ++i)
#pragma unroll
                for (int j = 0; j < 4; ++j) acc0[i][j] += a4[i] * b4[j];
            if (DUAL) {
                const f32x4 c4 = *(const f32x4*)(Bs1 + kk * 64 + tx * 4);
#pragma unroll
                for (int i = 0; i < 4; ++i)
#pragma unroll
                    for (int j = 0; j < 4; ++j) acc1[i][j] += a4[i] * c4[j];
            }
        }
    }
}
template <int MODE>
__device__ __forceinline__ void phase_moe_ref(Frame& F, int l) {
    const KA K = KA::fresh(); PHASE_TID;
    float* As = F.smem; float* Bs0 = F.smem + 16 * 132; float* Bs1 = Bs0 + 16 * 64; int* rowoff = (int*)(Bs1 + 16 * 64); int* offs = rowoff + 128; int* toff = offs + 33;
    int* cnt = (int*)(K.ctl() + CW_CNT + 64 * l);
    const int tx = tid & 15, ty = tid >> 4;
    __syncthreads();
    if (tid == 0) { int a = 0, tt = 0; for (int e = 0; e < NE; ++e) { offs[e] = a; toff[e] = tt; const int c = cnt[e]; a += c; tt += (c + 127) / 128; } offs[NE] = a; toff[NE] = tt; }
    __syncthreads();
    constexpr int N = (MODE == 1) ? DE : D, KD = (MODE == 1) ? D : DE, NTN = N / 64;
    const int ntiles = toff[NE] * NTN;
#pragma unroll 1
    for (int t = F.bx; t < ntiles; t += F.G) {
        const int rt = t / NTN, tn = t % NTN;
        int e = 0;
        for (int j = 1; j < NE; ++j) if (toff[j] <= rt) e = j;
        const int r0 = offs[e] + (rt - toff[e]) * 128, rend = offs[e + 1];
        __syncthreads();
        if (tid < 128) { const int r = r0 + tid; rowoff[tid] = (r < rend) ? ((MODE == 1) ? K.slot_tok()[r] * D : r * DE) : -1; }
        __syncthreads();
        float acc0[4][4], acc1[4][4];
        if (MODE == 1) {
            const float* Wg = K.in(16) + ((size_t)l * NE + e) * D * DE; const float* Wu = K.in(17) + ((size_t)l * NE + e) * D * DE;
            gemm_core<true>(K.XN(), rowoff, KD, Wg, Wu, DE, tn * 64, acc0, acc1, As, Bs0, Bs1);
        } else {
            const float* Wd = K.in(18) + ((size_t)l * NE + e) * DE * D;
            gemm_core<false>(K.H1(), rowoff, KD, Wd, nullptr, D, tn * 64, acc0, acc1, As, Bs0, nullptr);
        }
#pragma unroll
        for (int i = 0; i < 4; ++i) {
            const int r = r0 + ty * 4 + i;
            if (r < rend) {
                v2u o;
                if (MODE == 1) { o.x = pk2(silu(acc0[i][0]) * acc1[i][0], silu(acc0[i][1]) * acc1[i][1]); o.y = pk2(silu(acc0[i][2]) * acc1[i][2], silu(acc0[i][3]) * acc1[i][3]);
                    *(v2u*)(K.H1() + (size_t)r * DE + tn * 64 + tx * 4) = o; }
                else { o.x = pk2(acc0[i][0], acc0[i][1]); o.y = pk2(acc0[i][2], acc0[i][3]); *(v2u*)(K.Y() + (size_t)r * D + tn * 64 + tx * 4) = o; }
            }
        }
    }
    __syncthreads();
}

constexpr int TAB_OFF = LDSCTL_OFF + 1024;
__device__ __forceinline__ void moe_tables(Frame& F, int l) {
    const KA K = KA::fresh(); PHASE_TID;
    LAS int* tab = (LAS int*)(F.lds + TAB_OFF); LAS int* offs = tab + 4 + 4 * 164; LAS int* fpre = offs + 40; LAS int* ppre = fpre + 40;
    const int* cnt = (const int*)(K.ctl() + CW_CNT + 64 * l);
    __syncthreads();
    if (tid == 0) { int a = 0, f = 0, p = 0; for (int e = 0; e < NE; ++e) { const int c = cnt[e]; offs[e] = a; fpre[e] = f; ppre[e] = p; a += c; f += c >> 8; p += (c & 255) ? 1 : 0; }
        offs[NE] = a; fpre[NE] = f; ppre[NE] = p; tab[0] = f + p; }
    __syncthreads();
    const int nfull = fpre[NE], ntile = nfull + ppre[NE];
    if (tid < nfull) { int e = 0; for (int j = 1; j < NE; ++j) if (fpre[j] <= tid) e = j; tab[4 + 4 * tid] = e; tab[5 + 4 * tid] = offs[e] + (tid - fpre[e]) * 256; tab[6 + 4 * tid] = offs[e + 1]; }
    else if (tid < nfull + NE) {
        const int e = tid - nfull, rows = (offs[e + 1] - offs[e]) & 255;
        if (rows) { int rank = 0; for (int j = 0; j < NE; ++j) { const int rj = (offs[j + 1] - offs[j]) & 255; rank += (rj > rows || (rj == rows && j < e)) ? 1 : 0; }
            const int q = nfull + rank; tab[4 + 4 * q] = e; tab[5 + 4 * q] = offs[e] + (fpre[e + 1] - fpre[e]) * 256; tab[6 + 4 * q] = offs[e + 1]; }
    }
    __syncthreads();
    (void)ntile;
}
template <int SUB>
__device__ __forceinline__ void phase_moe(Frame& F, int l) {
    if (SUB == 0) moe_tables(F, l);
    const KA K = KA::fresh();
    int c_ = F.bx; asm volatile("" : "+s"(c_));
    const int G = F.G, c = (c_ & 7) * (G >> 3) + (c_ >> 3);
    const LAS int* tab = (const LAS int*)(F.lds + TAB_OFF);
    const int ntile = __builtin_amdgcn_readfirstlane(tab[0]), ngu = 2 * ntile, nleft = ngu > G ? ngu - G : 0, jX = ngu > G ? (G >> 1) : ntile, W = G - nleft;
    const int yd = (jX * 4 < 2 * W) ? jX * 4 : 2 * W;
    bool do_gu = false, do_dn = false; pg8::MoeSched So{tab, 2, 0, 0, G, c};
    if (SUB == 0) { do_gu = true; So.npn = 2; So.first = 0; So.end = ngu < G ? ngu : G; So.stride = G; So.c = c; }
    if (SUB == 1) { if (c < nleft) { do_gu = true; So.npn = 2; So.first = G; So.end = ngu; So.stride = G; So.c = c; }
                    else { do_dn = true; So.npn = 4; So.first = 0; So.end = yd; So.stride = W; So.c = c - nleft; } }
    if (SUB == 2) { do_dn = true; So.npn = 4; So.first = yd; So.end = ntile * 4; So.stride = G; So.c = c; }
    if (do_gu) { pg8::EpiMoeH E{K.H1()};
        pg8::gemm_phase_moe<pg8::EpiMoeH, pg8::MoeSched, true, 512, D>(F.lds, K.XN(), K.WguT() + (size_t)l * NE * 512 * D, K.slot_tok(), So, E, F.wave); }
    if (do_dn) { pg8::EpiMoeY E{K.Y()};
        pg8::gemm_phase_moe<pg8::EpiMoeY, pg8::MoeSched, false, D, DE>(F.lds, K.H1(), K.WdT() + (size_t)l * NE * D * DE, nullptr, So, E, F.wave); }
}
__device__ __forceinline__ void phase_combine(Frame& F, int l) {
    const KA K = KA::fresh(); PHASE_TID;
    const bool last = (l == DEPTH - 1);
    const float* gain = last ? K.in(19) : (K.in(1) + (size_t)(l + 1) * D);
    f32x4 g4[4];
#pragma unroll
    for (int j = 0; j < 4; ++j) g4[j] = ((const f32x4*)gain)[lane + 64 * j];
    const int tstep = F.G * NWAVES;
    int t = F.bx * NWAVES + wave;
    v2u xw[4], ya[4], yb[4]; float w0 = 0.f, w1 = 0.f;
#define CB_LOAD(tt) do { const int s0_ = K.slot_of()[2 * (tt)], s1_ = K.slot_of()[2 * (tt) + 1]; w0n = K.ew()[2 * (tt)]; w1n = K.ew()[2 * (tt) + 1]; \
        const v2u* xr_ = (const v2u*)(K.XR() + (size_t)(tt) * D) + lane; const v2u* y0_ = (const v2u*)(K.Y() + (size_t)s0_ * D) + lane; const v2u* y1_ = (const v2u*)(K.Y() + (size_t)s1_ * D) + lane; \
        _Pragma("unroll") for (int j = 0; j < 4; ++j) { xn[j] = xr_[64 * j]; an[j] = y0_[64 * j]; bn[j] = y1_[64 * j]; } } while (0)
    { v2u xn[4], an[4], bn[4]; float w0n = 0.f, w1n = 0.f;
      if (t < T) { CB_LOAD(t);
#pragma unroll
        for (int j = 0; j < 4; ++j) { xw[j] = xn[j]; ya[j] = an[j]; yb[j] = bn[j]; } w0 = w0n; w1 = w1n; } }
#pragma unroll 1
    for (; t < T; t += tstep) {
        v2u xn[4], an[4], bn[4]; float w0n = 0.f, w1n = 0.f;
        if (t + tstep < T) CB_LOAD(t + tstep);
        f32x4 v[4]; float s = 0.f;
#pragma unroll
        for (int j = 0; j < 4; ++j) { const v2u x_ = xw[j], a = ya[j], b = yb[j];
            v[j].x = bflo(x_.x) + w0 * bflo(a.x) + w1 * bflo(b.x); v[j].y = bfhi(x_.x) + w0 * bfhi(a.x) + w1 * bfhi(b.x); v[j].z = bflo(x_.y) + w0 * bflo(a.y) + w1 * bflo(b.y); v[j].w = bfhi(x_.y) + w0 * bfhi(a.y) + w1 * bfhi(b.y);
            s += (v[j].x * v[j].x + v[j].y * v[j].y) + (v[j].z * v[j].z + v[j].w * v[j].w); }
        const float rs = rsqrtf(wave_sum(s) * (1.f / D) + EPS);
        if (last) {
            f32x4* orow = (f32x4*)(K.out() + (size_t)t * D) + lane;
#pragma unroll
            for (int j = 0; j < 4; ++j) orow[64 * j] = (f32x4){v[j].x * rs * g4[j].x, v[j].y * rs * g4[j].y, v[j].z * rs * g4[j].z, v[j].w * rs * g4[j].w};
        } else {
            v2u* xr = (v2u*)(K.XR() + (size_t)t * D) + lane; v2u* o8 = (v2u*)(K.XN() + (size_t)t * D) + lane;
#pragma unroll
            for (int j = 0; j < 4; ++j) { xr[64 * j] = (v2u){pk2(v[j].x, v[j].y), pk2(v[j].z, v[j].w)};
                o8[64 * j] = (v2u){pk2(v[j].x * rs * g4[j].x, v[j].y * rs * g4[j].y), pk2(v[j].z * rs * g4[j].z, v[j].w * rs * g4[j].w)}; }
        }
#pragma unroll
        for (int j = 0; j < 4; ++j) { xw[j] = xn[j]; ya[j] = an[j]; yb[j] = bn[j]; }
        w0 = w0n; w1 = w1n;
    }
#undef CB_LOAD
}

struct Args { const float* in[20]; float* out; unsigned char* ws; };
__global__ void __launch_bounds__(NT, 2) fwd_kernel(Args args) {
    extern __shared__ __attribute__((aligned(16))) unsigned char lds_raw[];
    Frame F;
    F.lds = (LAS unsigned char*)lds_raw; F.smem = (float*)lds_raw;
    F.G = gridDim.x; F.bx = blockIdx.x; F.wave = __builtin_amdgcn_readfirstlane(threadIdx.x >> 6);
    volatile LAS unsigned* MISC = (volatile LAS unsigned*)(F.lds + MISC_OFF);
    for (int u = threadIdx.x; u < (LDS_BYTES - LDSCTL_OFF) / 4; u += NT) ((LAS unsigned*)(F.lds + LDSCTL_OFF))[u] = 0u;
    __syncthreads();
    XcdBarrier bar; { const KA K = KA::fresh(); bar = xcd_barrier_post(K.ctl() + CW_BAR, MISC + 8); }
#define GRID_BAR() xcd_barrier(bar)

    p0_prologue(F);
    GRID_BAR();
    for (int l = 0; l < DEPTH; ++l) {
        {
            const KA K = KA::fresh(); PHASE_TID;
            pg8::Gemm g{K.XN(), K.WinT() + (size_t)l * PLD * D, T, PLD, D}; pg8::StaticOrder So; int c_ = F.bx; asm volatile("" : "+s"(c_)); So.init(T, PLD, F.G, c_);
            pg8::EpiBf16Plain E{K.P(), PLD};
            pg8::gemm_phase<pg8::EpiBf16Plain, pg8::StaticOrder, PG8_ALIGN, PG8_SP2>(F.lds, g, So, E, F.wave);
        }
        GRID_BAR();
        phase_gla_A2(F, l);
        phase_gmlp_mfma(F, l);
        phase_conv(F, l);
        GRID_BAR();
        phase_gla_aggscan(F);
        GRID_BAR();
        phase_gla_C2(F, l);
        GRID_BAR();
        {
            const KA K = KA::fresh(); PHASE_TID;
            pg8::Gemm g{K.XN(), K.WoutT() + (size_t)l * D * D, T, D, D}; pg8::StaticOrder So; int c_ = F.bx; asm volatile("" : "+s"(c_)); So.init(T, D, F.G, c_);
            pg8::EpiBf16Res<false> E{K.XR(), K.XR(), D}; pg8::gemm_phase<pg8::EpiBf16Res<false>, pg8::StaticOrder, PG8_ALIGN, PG8_SP2>(F.lds, g, So, E, F.wave);
        }
        GRID_BAR();
        phase_norm_router_mfma(F, l);
        GRID_BAR();
        phase_scatter(F, l);
        GRID_BAR();
        phase_moe<0>(F, l);
        GRID_BAR();
        phase_moe<1>(F, l);
        GRID_BAR();
        phase_moe<2>(F, l);
        GRID_BAR();
        phase_combine(F, l);
        if (l + 1 < DEPTH) GRID_BAR();
    }
}

extern "C" void kernel_launch(void* const* d_in, const int* in_sizes, int n_in, void* d_out, int out_size, void* d_ws, size_t ws_size, hipStream_t stream) {
    static int grid_blocks = 0;
    if (!grid_blocks) {
        int dev = 0, cus = 0, per_cu = 0;
        (void)hipGetDevice(&dev);
        (void)hipDeviceGetAttribute(&cus, hipDeviceAttributeMultiprocessorCount, dev);
        (void)hipFuncSetAttribute((const void*)fwd_kernel, hipFuncAttributeMaxDynamicSharedMemorySize, LDS_BYTES);
        (void)hipOccupancyMaxActiveBlocksPerMultiprocessor(&per_cu, fwd_kernel, NT, LDS_BYTES);
        if (per_cu < 1) { fprintf(stderr, "kernel_launch: occupancy query says %d blocks/CU\n", per_cu); per_cu = 1; }
        grid_blocks = cus;
        if (ws_size < WS_END) { fprintf(stderr, "kernel_launch: workspace too small (%zu < %zu)\n", ws_size, (size_t)WS_END); grid_blocks = -1; }
    }
    if (grid_blocks < 0) return;
    (void)hipMemsetAsync((char*)d_ws + WS_CTL, 0, 131072, stream);
    Args a{};
    for (int i = 0; i < 20; ++i) a.in[i] = (const float*)d_in[i];
    a.out = (float*)d_out; a.ws = (unsigned char*)d_ws;
    void* args[] = {&a};
    hipError_t e = hipLaunchCooperativeKernel((void*)fwd_kernel, dim3(grid_blocks), dim3(NT), args, LDS_BYTES, stream);
    if (e != hipSuccess) fprintf(stderr, "cooperative launch failed: %s (grid %d)\n", hipGetErrorString(e), grid_blocks);
}
```

```cpp
#include <hip/hip_runtime.h>
#include <cstdio>
#include <cstdint>
__device__ __forceinline__ int fresh_lane() { unsigned m = 0xffffffffu; asm volatile("" : "+s"(m)); return (int)__builtin_amdgcn_mbcnt_hi(m, __builtin_amdgcn_mbcnt_lo(m, 0u)); }
__device__ __forceinline__ float shx(float v, int o) { return __int_as_float(__builtin_amdgcn_ds_bpermute((fresh_lane() ^ o) << 2, __float_as_int(v))); }
__device__ __forceinline__ int dpp_x1(int v) { return __builtin_amdgcn_update_dpp(v, v, 0xB1, 0xF, 0xF, false); }
__device__ __forceinline__ int dpp_x2(int v) { return __builtin_amdgcn_update_dpp(v, v, 0x4E, 0xF, 0xF, false); }
__device__ __forceinline__ int dpp_hm(int v) { return __builtin_amdgcn_update_dpp(v, v, 0x141, 0xF, 0xF, false); }
__device__ __forceinline__ int dpp_rm(int v) { return __builtin_amdgcn_update_dpp(v, v, 0x140, 0xF, 0xF, false); }
__device__ __forceinline__ float dppf_x1(float v) { return __int_as_float(dpp_x1(__float_as_int(v))); }
__device__ __forceinline__ float dppf_x2(float v) { return __int_as_float(dpp_x2(__float_as_int(v))); }
__device__ __forceinline__ float dppf_hm(float v) { return __int_as_float(dpp_hm(__float_as_int(v))); }
__device__ __forceinline__ float dppf_rm(float v) { return __int_as_float(dpp_rm(__float_as_int(v))); }
__device__ __forceinline__ float sum8(float v) { v += dppf_x1(v); v += dppf_x2(v); v += dppf_hm(v); return v; }
__device__ __forceinline__ float sum16(float v) { v = sum8(v); v += dppf_rm(v); return v; }
namespace pg8 {
#define PG8_LAS __attribute__((address_space(3)))
typedef unsigned short bf16_t;
typedef short bf16x8 __attribute__((ext_vector_type(8)));
typedef float f32x4 __attribute__((ext_vector_type(4)));
typedef unsigned u32x4 __attribute__((ext_vector_type(4)));
constexpr int BM = 256, BK = 64, HALF = 128, HTB = HALF * BK * 2  , STAGE_BYTES = 8 * HTB, NXCD = 8, WGM = 8;

__host__ __device__ __forceinline__ int lds_byte(int r, int c) { const int st = (r >> 4) * 2 + (c >> 5), rr = r & 15, cc = c & 31, ob = rr * 64 + cc * 2; return st * 1024 + (ob ^ (((ob >> 9) & 1) << 5)); }
__host__ __device__ __forceinline__ void stage_rc(int b, int& R, int& C) { const int st = b / 1024, sb = b % 1024, swz = sb ^ (((sb >> 9) & 1) << 5); R = (st >> 1) * 16 + swz / 64; C = (st & 1) * 32 + (swz % 64) / 2; }
__host__ __device__ __forceinline__ int perm32(int rho) { const int n = rho >> 4, i = rho & 15; return 8 * (i >> 2) + 4 * n + (i & 3); }

struct Unit { int pm, pn; };
struct Gemm { const bf16_t* A; const bf16_t* Bt; int M, N, K; };

struct StaticOrder {
    int nM, nN, nwg, G, c;
    __host__ __device__ void init(int M, int N, int G_, int c_) { nM = M / BM; nN = N / BM; nwg = nM * nN; G = G_; c = c_; }
    __host__ __device__ bool next(int i, Unit& u) const {
        const long L = (long)i * G + c; if (L >= nwg) return false;
        int wgid = (int)L; { const int q = nwg / NXCD, r = nwg % NXCD, xcd = wgid % NXCD, off = wgid / NXCD; wgid = (xcd < r ? xcd * (q + 1) : r * (q + 1) + (xcd - r) * q) + off; }
        const int nig = WGM * nN, gid = wgid / nig, fm = gid * WGM, gsz = (nM - fm) < WGM ? (nM - fm) : WGM;
        u.pm = fm + ((wgid % nig) % gsz); u.pn = (wgid % nig) / gsz; return true;
    }
    __device__ __forceinline__ void a_ready(const Unit&) const {}
    __device__ __forceinline__ void done(const Unit&) const {}
};


__device__ __forceinline__ unsigned cvt_pk_bf16(float lo, float hi) { unsigned r; asm volatile("v_cvt_pk_bf16_f32 %0, %1, %2" : "=v"(r) : "v"(lo), "v"(hi)); return r; }
struct EpiBf16Plain {
    static constexpr bool PERM = true, AFTER_DRAIN = false;
    bf16_t* O; int ldc; int ncols;
    __device__ __forceinline__ void operator()(const f32x4 (&acc)[2][2][4][2], const Unit& u, int wr, int wc, int fr, int fq) const {
        const int row0 = u.pm * BM + wr * 64 + fr, col0 = u.pn * BM + wc * 32 + 8 * fq;
#pragma unroll
        for (int ai = 0; ai < 2; ++ai)
#pragma unroll
            for (int m = 0; m < 4; ++m) { bf16_t* rowp = O + (size_t)(row0 + ai * HALF + m * 16) * ldc + col0;
#pragma unroll
                for (int bj = 0; bj < 2; ++bj) { const f32x4 v0 = acc[ai][bj][m][0], v1 = acc[ai][bj][m][1];
                    u32x4 w; w.x = cvt_pk_bf16(v0[0], v0[1]); w.y = cvt_pk_bf16(v0[2], v0[3]); w.z = cvt_pk_bf16(v1[0], v1[1]); w.w = cvt_pk_bf16(v1[2], v1[3]);
                    if (col0 + bj * HALF < ncols) *(u32x4*)(rowp + bj * HALF) = w; } }
    }
};
template <bool RES_F32>
struct EpiBf16Res {
    static constexpr bool PERM = true, AFTER_DRAIN = false;
    bf16_t* O; const void* R; int ldc;
    __device__ __forceinline__ void operator()(const f32x4 (&acc)[2][2][4][2], const Unit& u, int wr, int wc, int fr, int fq) const {
        const int row0 = u.pm * BM + wr * 64 + fr, col0 = u.pn * BM + wc * 32 + 8 * fq;
#pragma unroll
        for (int ai = 0; ai < 2; ++ai)
#pragma unroll
            for (int m = 0; m < 4; ++m) { const size_t off = (size_t)(row0 + ai * HALF + m * 16) * ldc + col0;
#pragma unroll
                for (int bj = 0; bj < 2; ++bj) { f32x4 v0 = acc[ai][bj][m][0], v1 = acc[ai][bj][m][1];
                    if (RES_F32) { const float* rp = (const float*)R + off + bj * HALF; v0 += *(const f32x4*)rp; v1 += *(const f32x4*)(rp + 4); }
                    else { const u32x4 rw = *(const u32x4*)((const bf16_t*)R + off + bj * HALF);
                        v0[0] += __uint_as_float(rw.x << 16); v0[1] += __uint_as_float(rw.x & 0xffff0000u); v0[2] += __uint_as_float(rw.y << 16); v0[3] += __uint_as_float(rw.y & 0xffff0000u);
                        v1[0] += __uint_as_float(rw.z << 16); v1[1] += __uint_as_float(rw.z & 0xffff0000u); v1[2] += __uint_as_float(rw.w << 16); v1[3] += __uint_as_float(rw.w & 0xffff0000u); }
                    u32x4 w; w.x = cvt_pk_bf16(v0[0], v0[1]); w.y = cvt_pk_bf16(v0[2], v0[3]); w.z = cvt_pk_bf16(v1[0], v1[1]); w.w = cvt_pk_bf16(v1[2], v1[3]);
                    *(u32x4*)(O + off + bj * HALF) = w; } }
    }
};

template <class Epi, class Sched, bool ALIGN_EPI = false, bool SP2 = false>
__device__ __forceinline__ void gemm_phase(PG8_LAS unsigned char* lds, const Gemm g, const Sched& S, const Epi& E, int wave_id) {
    asm volatile("" : "+s"(wave_id));
    const int lane = fresh_lane(), wid = wave_id, tid = wid * 64 + lane, wr = wid >> 2, wc = wid & 3, fr = lane & 15, fq = lane >> 4;
    const int K = g.K, nt = K / BK;
    unsigned voffA[2], voffB[2];
#pragma unroll
    for (int i = 0; i < 2; ++i) { int R, C; stage_rc(tid * 16 + i * 8192, R, C); const int Rb = Epi::PERM ? ((R & ~31) + perm32(R & 31)) : R;
        voffA[i] = (unsigned)(R * K + C) * 2u; voffB[i] = (unsigned)(Rb * K + C) * 2u; }
    const size_t kstep = (size_t)(BK * 2);
    const size_t hstep = (size_t)HALF * K * 2;
    const size_t tstep = 2 * hstep;
    const unsigned ldsw = (unsigned)wid * 1024u;
    const int aoff = lds_byte(wr * 64 + fr, fq * 8), boff = lds_byte(wc * 32 + fr, fq * 8);
#define PG8_SA(b, h) (((b) * 2 + (h)) * HTB)
#define PG8_SB(b, h) ((4 + (b) * 2 + (h)) * HTB)
#define PG8_STAGE(bufoff, gbase, voff) do { _Pragma("unroll") for (int _i = 0; _i < 2; ++_i) \
        __builtin_amdgcn_global_load_lds((const unsigned*)((const char*)(gbase) + (voff)[_i]), (PG8_LAS unsigned*)(lds + (bufoff) + ldsw + _i * 8192), 16, 0, 0); } while (0)
#define PG8_LDA(dst, b, h) do { _Pragma("unroll") for (int m = 0; m < 4; ++m) _Pragma("unroll") for (int k = 0; k < 2; ++k) dst[m][k] = *(const PG8_LAS bf16x8*)(lds + PG8_SA(b, h) + aoff + m * 2048 + k * 1024); } while (0)
#define PG8_LDB(dst, b, h) do { _Pragma("unroll") for (int n = 0; n < 2; ++n) _Pragma("unroll") for (int k = 0; k < 2; ++k) dst[n][k] = *(const PG8_LAS bf16x8*)(lds + PG8_SB(b, h) + boff + n * 2048 + k * 1024); } while (0)
#define PG8_MMA(ai, bj, At, Bt) do { __builtin_amdgcn_s_setprio(1); _Pragma("unroll") for (int m = 0; m < 4; ++m) _Pragma("unroll") for (int n = 0; n < 2; ++n) _Pragma("unroll") for (int k = 0; k < 2; ++k) \
        acc[ai][bj][m][n] = __builtin_amdgcn_mfma_f32_16x16x32_bf16(Bt[n][k], At[m][k], acc[ai][bj][m][n], 0, 0, 0); __builtin_amdgcn_s_setprio(0); } while (0)
#define PG8_WAIT_V(n) asm volatile("s_waitcnt vmcnt(" #n ")" ::: "memory")
#define PG8_WAIT_L(n) asm volatile("s_waitcnt lgkmcnt(" #n ")" ::: "memory")
#define PG8_BAR __builtin_amdgcn_s_barrier()
#define PG8_SCHED __builtin_amdgcn_sched_barrier(0)
    Unit cur, nxt; int ui = 0;
    if (!S.next(0, cur)) return;
    f32x4 acc[2][2][4][2];
#pragma unroll
    for (int a = 0; a < 2; ++a)
#pragma unroll
        for (int b = 0; b < 2; ++b)
#pragma unroll
            for (int m = 0; m < 4; ++m)
#pragma unroll
                for (int n = 0; n < 2; ++n) acc[a][b][m][n] = (f32x4){0.f, 0.f, 0.f, 0.f};
    bf16x8 At[4][2], B0[2][2], B1[2][2];
    const char* cA = (const char*)g.A + (size_t)cur.pm * tstep; const char* cB = (const char*)g.Bt + (size_t)cur.pn * tstep;
    S.a_ready(cur);
    if constexpr (SP2) {
        PG8_STAGE(PG8_SB(0, 0), cB, voffB); PG8_STAGE(PG8_SB(0, 1), cB + hstep, voffB); PG8_STAGE(PG8_SA(0, 0), cA, voffA); PG8_STAGE(PG8_SA(0, 1), cA + hstep, voffA);
        if (wr == 1) PG8_BAR;
        PG8_WAIT_V(2); PG8_BAR;
        PG8_STAGE(PG8_SB(1, 0), cB + kstep, voffB); PG8_STAGE(PG8_SA(1, 0), cA + kstep, voffA); PG8_STAGE(PG8_SB(1, 1), cB + hstep + kstep, voffB);
        PG8_WAIT_V(6); PG8_BAR;
    } else {
        PG8_STAGE(PG8_SB(0, 0), cB, voffB); PG8_STAGE(PG8_SA(0, 0), cA, voffA); PG8_STAGE(PG8_SB(0, 1), cB + hstep, voffB); PG8_STAGE(PG8_SA(0, 1), cA + hstep, voffA);
        if (wr == 1) PG8_BAR;
        PG8_WAIT_V(4); PG8_BAR;
        PG8_STAGE(PG8_SB(1, 0), cB + kstep, voffB); PG8_STAGE(PG8_SA(1, 0), cA + kstep, voffA); PG8_STAGE(PG8_SB(1, 1), cB + hstep + kstep, voffB);
        PG8_WAIT_V(6); PG8_BAR;
    }
    for (;;) {
        const bool has_next = S.next(ui + 1, nxt);
        const char* nA = has_next ? (const char*)g.A + (size_t)nxt.pm * tstep : cA; const char* nB = has_next ? (const char*)g.Bt + (size_t)nxt.pn * tstep : cB;
        for (int t = 0; t < nt; t += 2) {
            const bool last = (t == nt - 2);
            const char* a1 = cA + (size_t)(t + 1) * kstep;
            const char* a2 = last ? nA : cA + (size_t)(t + 2) * kstep; const char* b2 = last ? nB : cB + (size_t)(t + 2) * kstep;
            const char* a3 = a2 + kstep; const char* b3 = b2 + kstep;
            if (last && has_next) S.a_ready(nxt);
            if constexpr (SP2) {
            PG8_LDB(B0, 0, 0); PG8_LDB(B1, 0, 1); PG8_SCHED; PG8_LDA(At, 0, 0); PG8_STAGE(PG8_SA(1, 1), a1 + hstep, voffA);
            PG8_WAIT_V(8); PG8_WAIT_L(0); PG8_BAR; PG8_MMA(0, 0, At, B0); PG8_MMA(0, 1, At, B1); PG8_BAR; PG8_SCHED;
            PG8_LDA(At, 0, 1); PG8_STAGE(PG8_SB(0, 0), b2, voffB); PG8_STAGE(PG8_SB(0, 1), b2 + hstep, voffB); PG8_STAGE(PG8_SA(0, 0), a2, voffA);
            PG8_WAIT_V(8); PG8_WAIT_L(0); PG8_BAR; PG8_MMA(1, 0, At, B0); PG8_MMA(1, 1, At, B1); PG8_BAR; PG8_SCHED;
            PG8_LDB(B0, 1, 0); PG8_LDB(B1, 1, 1); PG8_SCHED; PG8_LDA(At, 1, 0); PG8_STAGE(PG8_SA(0, 1), a2 + hstep, voffA);
            PG8_WAIT_V(8); PG8_WAIT_L(0); PG8_BAR; PG8_MMA(0, 0, At, B0); PG8_MMA(0, 1, At, B1); PG8_BAR; PG8_SCHED;
            PG8_LDA(At, 1, 1); PG8_STAGE(PG8_SB(1, 0), b3, voffB); PG8_STAGE(PG8_SB(1, 1), b3 + hstep, voffB); PG8_STAGE(PG8_SA(1, 0), a3, voffA);
            PG8_WAIT_V(8); PG8_WAIT_L(0); PG8_BAR; PG8_MMA(1, 0, At, B0); PG8_MMA(1, 1, At, B1); PG8_BAR; PG8_SCHED;
            } else {
            PG8_LDB(B0, 0, 0); PG8_SCHED; PG8_LDA(At, 0, 0); PG8_STAGE(PG8_SA(1, 1), a1 + hstep, voffA);
            PG8_WAIT_L(8); PG8_BAR; PG8_WAIT_L(0); PG8_MMA(0, 0, At, B0); PG8_BAR; PG8_SCHED;
            PG8_LDB(B1, 0, 1); PG8_STAGE(PG8_SB(0, 0), b2, voffB);
            PG8_BAR; PG8_WAIT_L(0); PG8_MMA(0, 1, At, B1); PG8_BAR;
            PG8_LDA(At, 0, 1); PG8_STAGE(PG8_SA(0, 0), a2, voffA);
            PG8_BAR; PG8_WAIT_L(0); PG8_MMA(1, 0, At, B0); PG8_BAR; PG8_SCHED;
            PG8_STAGE(PG8_SB(0, 1), b2 + hstep, voffB);
            PG8_WAIT_V(6); PG8_BAR; PG8_MMA(1, 1, At, B1); PG8_BAR;
            PG8_LDB(B0, 1, 0); PG8_SCHED; PG8_LDA(At, 1, 0); PG8_STAGE(PG8_SA(0, 1), a2 + hstep, voffA);
            PG8_WAIT_L(8); PG8_BAR; PG8_WAIT_L(0); PG8_MMA(0, 0, At, B0); PG8_BAR; PG8_SCHED;
            PG8_LDB(B1, 1, 1); PG8_STAGE(PG8_SB(1, 0), b3, voffB);
            PG8_BAR; PG8_WAIT_L(0); PG8_MMA(0, 1, At, B1); PG8_BAR;
            PG8_LDA(At, 1, 1); PG8_STAGE(PG8_SA(1, 0), a3, voffA);
            PG8_BAR; PG8_WAIT_L(0); PG8_MMA(1, 0, At, B0); PG8_BAR; PG8_SCHED;
            PG8_STAGE(PG8_SB(1, 1), b3 + hstep, voffB);
            PG8_WAIT_V(6); PG8_BAR; PG8_MMA(1, 1, At, B1); PG8_BAR;
            }
        }
        if constexpr (ALIGN_EPI) { if (wr == 0) PG8_BAR; }
        if constexpr (!Epi::AFTER_DRAIN) { E(acc, cur, wr, wc, fr, fq); S.done(cur); }
        if (!has_next) break;
#pragma unroll
        for (int a = 0; a < 2; ++a)
#pragma unroll
            for (int b = 0; b < 2; ++b)
#pragma unroll
                for (int m = 0; m < 4; ++m)
#pragma unroll
                    for (int n = 0; n < 2; ++n) acc[a][b][m][n] = (f32x4){0.f, 0.f, 0.f, 0.f};
        cur = nxt; cA = nA; cB = nB; ++ui;
        if constexpr (ALIGN_EPI) { if (wr == 1) PG8_BAR; }
    }
    PG8_WAIT_V(0);
    if constexpr (!ALIGN_EPI) { if (wr == 0) PG8_BAR; }
    PG8_BAR;
    if constexpr (Epi::AFTER_DRAIN) { E.fused(acc, cur, wr, wc, fr, fq, lds, wid, lane); S.done(cur); }
#undef PG8_SA
#undef PG8_SB
#undef PG8_STAGE
#undef PG8_LDA
#undef PG8_LDB
#undef PG8_MMA
#undef PG8_WAIT_V
#undef PG8_WAIT_L
#undef PG8_BAR
#undef PG8_SCHED
}

struct MUnit { int r0, rend, e, pn; };
#define MG_LANE_OFFS(u, o) do { const int _t = wid * 64 + fresh_lane(); _Pragma("unroll") for (int _i = 0; _i < 2; ++_i) { int _R, _C; stage_rc(_t * 16 + _i * 8192, _R, _C); _Pragma("unroll") for (int _h = 0; _h < 2; ++_h) { const int _r = (u).r0 + _h * HALF + _R; \
        int _row = _r; if (GATHER) { _row = 0; if (_r < (u).rend) _row = slot_tok[_r]; } (o)[_h][_i] = (unsigned)(_row * K + _C) * 2u; } } } while (0)
template <class Epi, class Sched, bool GATHER, int N, int K>
__device__ __forceinline__ void gemm_phase_moe(PG8_LAS unsigned char* lds, const bf16_t* A, const bf16_t* Bt, const int* slot_tok, const Sched& S, const Epi& E, int wave_id) {
    asm volatile("" : "+s"(wave_id));
    const int lane = fresh_lane(), wid = wave_id, tid = wid * 64 + lane, wr = wid >> 2, wc = wid & 3, fr = lane & 15, fq = lane >> 4;
    constexpr int nt = K / BK;
#define MG_OFFP(par) ((PG8_LAS unsigned*)(lds + STAGE_BYTES + 8192) + (par) * 2048 + tid)
#define MG_VOFFB ((PG8_LAS unsigned*)(lds + STAGE_BYTES + 24576) + tid)
#pragma unroll
    for (int i = 0; i < 2; ++i) { int R, C; stage_rc(tid * 16 + i * 8192, R, C); const int Rb = Epi::PERM ? ((R & ~31) + perm32(R & 31)) : R; MG_VOFFB[i * 512] = (unsigned)(Rb * K + C) * 2u; }
    constexpr size_t kstep = (size_t)(BK * 2);
    constexpr size_t hstep = (size_t)HALF * K * 2;
    constexpr size_t tstep = 2 * hstep;
    constexpr size_t estep = (size_t)N * K * 2;
    const unsigned ldsw = (unsigned)wid * 1024u;
    const int aoff = lds_byte(wr * 64 + fr, fq * 8), boff = lds_byte(wc * 32 + fr, fq * 8);
#define PG8_SA(b, h) (((b) * 2 + (h)) * HTB)
#define PG8_SB(b, h) ((4 + (b) * 2 + (h)) * HTB)
#define PG8_STAGE(bufoff, gbase, voff) do { _Pragma("unroll") for (int _i = 0; _i < 2; ++_i) \
        __builtin_amdgcn_global_load_lds((const unsigned*)((const char*)(gbase) + MG_VOFFB[_i * 512]), (PG8_LAS unsigned*)(lds + (bufoff) + ldsw + _i * 8192), 16, 0, 0); } while (0)
#define MG_STAGE_A(bufoff, par, h, kb) do { _Pragma("unroll") for (int _i = 0; _i < 2; ++_i) \
        __builtin_amdgcn_global_load_lds((const unsigned*)((const char*)A + (size_t)MG_OFFP(par)[((h) * 2 + _i) * 512] + (kb)), (PG8_LAS unsigned*)(lds + (bufoff) + ldsw + _i * 8192), 16, 0, 0); } while (0)
#define PG8_LDA(dst, b, h) do { _Pragma("unroll") for (int m = 0; m < 4; ++m) _Pragma("unroll") for (int k = 0; k < 2; ++k) dst[m][k] = *(const PG8_LAS bf16x8*)(lds + PG8_SA(b, h) + aoff + m * 2048 + k * 1024); } while (0)
#define PG8_LDB(dst, b, h) do { _Pragma("unroll") for (int n = 0; n < 2; ++n) _Pragma("unroll") for (int k = 0; k < 2; ++k) dst[n][k] = *(const PG8_LAS bf16x8*)(lds + PG8_SB(b, h) + boff + n * 2048 + k * 1024); } while (0)
#define PG8_MMA(ai, bj, At, Bt_) do { __builtin_amdgcn_s_setprio(1); _Pragma("unroll") for (int m = 0; m < 4; ++m) _Pragma("unroll") for (int n = 0; n < 2; ++n) _Pragma("unroll") for (int k = 0; k < 2; ++k) \
        acc[ai][bj][m][n] = __builtin_amdgcn_mfma_f32_16x16x32_bf16(Bt_[n][k], At[m][k], acc[ai][bj][m][n], 0, 0, 0); __builtin_amdgcn_s_setprio(0); } while (0)
#define PG8_WAIT_V(n) asm volatile("s_waitcnt vmcnt(" #n ")" ::: "memory")
#define PG8_WAIT_L(n) asm volatile("s_waitcnt lgkmcnt(" #n ")" ::: "memory")
#define PG8_BAR __builtin_amdgcn_s_barrier()
#define PG8_SCHED __builtin_amdgcn_sched_barrier(0)
    MUnit cur, nxt; int ui = 0;
    if (!S.next(0, cur)) return;
    f32x4 acc[2][2][4][2];
#pragma unroll
    for (int a = 0; a < 2; ++a)
#pragma unroll
        for (int b = 0; b < 2; ++b)
#pragma unroll
            for (int m = 0; m < 4; ++m)
#pragma unroll
                for (int n = 0; n < 2; ++n) acc[a][b][m][n] = (f32x4){0.f, 0.f, 0.f, 0.f};
    bf16x8 At[4][2], B0[2][2], B1[2][2];
    { unsigned o_[2][2]; MG_LANE_OFFS(cur, o_); PG8_LAS unsigned* p_ = MG_OFFP(0); p_[0] = o_[0][0]; p_[512] = o_[0][1]; p_[1024] = o_[1][0]; p_[1536] = o_[1][1]; }
    const char* cB = (const char*)Bt + (size_t)cur.e * estep + (size_t)cur.pn * tstep;
    PG8_STAGE(PG8_SB(0, 0), cB, voffB); PG8_STAGE(PG8_SB(0, 1), cB + hstep, voffB); MG_STAGE_A(PG8_SA(0, 0), 0, 0, 0); MG_STAGE_A(PG8_SA(0, 1), 0, 1, 0);
    if (wr == 1) PG8_BAR;
    PG8_WAIT_V(2); PG8_BAR;
    PG8_STAGE(PG8_SB(1, 0), cB + kstep, voffB); MG_STAGE_A(PG8_SA(1, 0), 0, 0, kstep); PG8_STAGE(PG8_SB(1, 1), cB + hstep + kstep, voffB);
    PG8_WAIT_V(6); PG8_BAR;
    for (;;) {
        const bool has_next = S.next(ui + 1, nxt);
        const bool hi_rows = (cur.rend - cur.r0) > HALF;
        const char* nB = cB;
        const int pc = ui & 1, pn_ = has_next ? (pc ^ 1) : pc;
        if (has_next) { unsigned on[2][2]; MG_LANE_OFFS(nxt, on); nB = (const char*)Bt + (size_t)nxt.e * estep + (size_t)nxt.pn * tstep;
            PG8_LAS unsigned* p_ = MG_OFFP(pn_); p_[0] = on[0][0]; p_[512] = on[0][1]; p_[1024] = on[1][0]; p_[1536] = on[1][1]; }
        for (int t = 0; t < nt; t += 2) {
            const bool last = (t == nt - 2);
            const size_t k1 = (size_t)(t + 1) * kstep, k2 = last ? (size_t)0 : (size_t)(t + 2) * kstep, k3 = k2 + kstep;
            const char* b2 = last ? nB : cB + (size_t)(t + 2) * kstep; const char* b3 = b2 + kstep;
            const int p2 = last ? pn_ : pc;
            PG8_LDB(B0, 0, 0); PG8_LDB(B1, 0, 1); PG8_SCHED; PG8_LDA(At, 0, 0); MG_STAGE_A(PG8_SA(1, 1), pc, 1, k1);
            PG8_WAIT_V(8); PG8_WAIT_L(0); PG8_BAR; PG8_MMA(0, 0, At, B0); PG8_MMA(0, 1, At, B1); PG8_BAR; PG8_SCHED;
            PG8_LDA(At, 0, 1); PG8_STAGE(PG8_SB(0, 0), b2, voffB); PG8_STAGE(PG8_SB(0, 1), b2 + hstep, voffB); MG_STAGE_A(PG8_SA(0, 0), p2, 0, k2);
            PG8_WAIT_V(8); PG8_WAIT_L(0); PG8_BAR; if (hi_rows) { PG8_MMA(1, 0, At, B0); PG8_MMA(1, 1, At, B1); } PG8_BAR; PG8_SCHED;
            PG8_LDB(B0, 1, 0); PG8_LDB(B1, 1, 1); PG8_SCHED; PG8_LDA(At, 1, 0); MG_STAGE_A(PG8_SA(0, 1), p2, 1, k2);
            PG8_WAIT_V(8); PG8_WAIT_L(0); PG8_BAR; PG8_MMA(0, 0, At, B0); PG8_MMA(0, 1, At, B1); PG8_BAR; PG8_SCHED;
            PG8_LDA(At, 1, 1); PG8_STAGE(PG8_SB(1, 0), b3, voffB); PG8_STAGE(PG8_SB(1, 1), b3 + hstep, voffB); MG_STAGE_A(PG8_SA(1, 0), p2, 0, k3);
            PG8_WAIT_V(8); PG8_WAIT_L(0); PG8_BAR; if (hi_rows) { PG8_MMA(1, 0, At, B0); PG8_MMA(1, 1, At, B1); } PG8_BAR; PG8_SCHED;
        }
        if (wr == 0) PG8_BAR;
        E(acc, cur, wr, wc, fr, fq);
        if (!has_next) break;
#pragma unroll
        for (int a = 0; a < 2; ++a)
#pragma unroll
            for (int b = 0; b < 2; ++b)
#pragma unroll
                for (int m = 0; m < 4; ++m)
#pragma unroll
                    for (int n = 0; n < 2; ++n) acc[a][b][m][n] = (f32x4){0.f, 0.f, 0.f, 0.f};
        cur = nxt; cB = nB; ++ui;
        if (wr == 1) PG8_BAR;
    }
    PG8_WAIT_V(0);
    PG8_BAR;
#undef PG8_SA
#undef PG8_SB
#undef PG8_STAGE
#undef MG_STAGE_A
#undef MG_OFFP
#undef MG_VOFFB
#undef PG8_LDA
#undef PG8_LDB
#undef PG8_MMA
#undef PG8_WAIT_V
#undef PG8_WAIT_L
#undef PG8_BAR
#undef PG8_SCHED
}
__device__ __forceinline__ float fast_silu(float x) { return x * __builtin_amdgcn_rcpf(1.0f + __builtin_amdgcn_exp2f(-1.4426950408889634f * x)); }
struct EpiMoeH {
    static constexpr bool PERM = true;
    bf16_t* H;
    __device__ __forceinline__ void operator()(const f32x4 (&acc)[2][2][4][2], const MUnit& u, int wr, int wc, int fr, int fq) const {
        { const int t_ = fresh_lane(); fr = t_ & 15; fq = t_ >> 4; }
        const int col0 = u.pn * 128 + wc * 32 + 8 * fq;
#pragma unroll
        for (int ai = 0; ai < 2; ++ai)
#pragma unroll
            for (int m = 0; m < 4; ++m) { const int r = u.r0 + ai * HALF + wr * 64 + m * 16 + fr;
                const f32x4 g0 = acc[ai][0][m][0], g1 = acc[ai][0][m][1], u0 = acc[ai][1][m][0], u1 = acc[ai][1][m][1];
                u32x4 w; w.x = cvt_pk_bf16(fast_silu(g0[0]) * u0[0], fast_silu(g0[1]) * u0[1]); w.y = cvt_pk_bf16(fast_silu(g0[2]) * u0[2], fast_silu(g0[3]) * u0[3]);
                w.z = cvt_pk_bf16(fast_silu(g1[0]) * u1[0], fast_silu(g1[1]) * u1[1]); w.w = cvt_pk_bf16(fast_silu(g1[2]) * u1[2], fast_silu(g1[3]) * u1[3]);
                if (r < u.rend) *(u32x4*)(H + (size_t)r * 256 + col0) = w; }
    }
};
struct EpiMoeY {
    static constexpr bool PERM = true;
    bf16_t* Y;
    __device__ __forceinline__ void operator()(const f32x4 (&acc)[2][2][4][2], const MUnit& u, int wr, int wc, int fr, int fq) const {
        { const int t_ = fresh_lane(); fr = t_ & 15; fq = t_ >> 4; }
        const int col0 = u.pn * BM + wc * 32 + 8 * fq;
#pragma unroll
        for (int ai = 0; ai < 2; ++ai)
#pragma unroll
            for (int m = 0; m < 4; ++m) { const int r = u.r0 + ai * HALF + wr * 64 + m * 16 + fr;
#pragma unroll
                for (int bj = 0; bj < 2; ++bj) { const f32x4 v0 = acc[ai][bj][m][0], v1 = acc[ai][bj][m][1];
                    u32x4 w; w.x = cvt_pk_bf16(v0[0], v0[1]); w.y = cvt_pk_bf16(v0[2], v0[3]); w.z = cvt_pk_bf16(v1[0], v1[1]); w.w = cvt_pk_bf16(v1[2], v1[3]);
                    if (r < u.rend) *(u32x4*)(Y + (size_t)r * 1024 + col0 + bj * HALF) = w; } }
    }
};
struct MoeSched {
    const PG8_LAS int* tab;
    int npn, first, end, stride, c, split;
    __device__ __forceinline__ bool next(int i, MUnit& u) const {
        int L = first + c + i * stride;
        if (c < 0 || L >= end) return false;
        const int half = split ? (L & 1) : 0; if (split) L >>= 1;
        const int j = L / npn; u.pn = L % npn;
        u.e = __builtin_amdgcn_readfirstlane(tab[4 + 4 * j]); u.r0 = __builtin_amdgcn_readfirstlane(tab[5 + 4 * j]); u.rend = __builtin_amdgcn_readfirstlane(tab[6 + 4 * j]);
        if (split) { u.r0 += HALF * half; const int cap = u.r0 + HALF; u.rend = u.rend < cap ? u.rend : cap; }
        return true;
    }
};
}

#ifndef PG8_SP2
#define PG8_SP2 true
#endif
#ifndef PG8_ALIGN
#define PG8_ALIGN true
#endif

constexpr int NWAVES = 8, NT = NWAVES * 64;
constexpr int D = 1024, NB = 2, S = 8192, T = NB * S, DEPTH = 2;
constexpr int DIN = 2832, PLD = 3072;
constexpr int C_Q = 0, C_K = 256, C_V = 512, C_G = 1024, C_GK = 1536, C_U = 1552, C_VG = 1808, C_XI = 2064, C_BG = 2320, C_CG = 2576;
constexpr int GH = 4, GC = 64, GN = S / GC;
constexpr int MH = 4, MC = 128, MN = S / MC;
constexpr int NE = 32, DE = 256;
constexpr float EPS = 1e-6f;
constexpr size_t MiB = 1u << 20;
constexpr size_t WS_CTL = 0, CTL_BYTES = 1 * MiB;
constexpr size_t WS_WIN = 1 * MiB;
constexpr size_t WS_WOUT = 13 * MiB;
constexpr size_t WS_WGU = 17 * MiB;
constexpr size_t WS_WD = 81 * MiB;
constexpr size_t WS_XN = 113 * MiB;
constexpr size_t WS_P = 145 * MiB;
constexpr size_t WS_Y = WS_P + 17 * MiB;
constexpr size_t WS_S = 276 * MiB;
constexpr size_t WS_XRES = 241 * MiB;
constexpr size_t WS_DEC = 273 * MiB;
constexpr size_t WS_MISC = 274 * MiB;
constexpr size_t WS_WSP = WS_MISC + 524288;
constexpr size_t WS_WR = 275 * MiB;
constexpr size_t WS_BLKCNT = WS_WR + 524288;
constexpr size_t WS_END = 284 * MiB;
constexpr int CW_BAR = 4096, CW_CNT = 16384;
constexpr int RING_BYTES = 131072, LDSCTL_OFF = RING_BYTES, MISC_OFF = LDSCTL_OFF + 320, LDS_BYTES = 163840;

#define GAS __attribute__((address_space(1)))
#define LAS __attribute__((address_space(3)))
typedef unsigned short bf16;
typedef unsigned v4u __attribute__((ext_vector_type(4)));
typedef unsigned v2u __attribute__((ext_vector_type(2)));
typedef float f32x4 __attribute__((ext_vector_type(4)));
typedef __bf16 bf16x2_t __attribute__((ext_vector_type(2)));
typedef float f32x2_t __attribute__((ext_vector_type(2)));
__device__ __forceinline__ unsigned f2bf(float f) { return (unsigned)__builtin_bit_cast(unsigned short, (__bf16)f); }
__device__ __forceinline__ unsigned pk2(float lo, float hi) { f32x2_t v = {lo, hi}; bf16x2_t b = __builtin_convertvector(v, bf16x2_t); return __builtin_bit_cast(unsigned, b); }
__device__ __forceinline__ float bf2f(unsigned v) { return __uint_as_float(v << 16); }
__device__ __forceinline__ float bflo(unsigned w) { return __uint_as_float(w << 16); }
__device__ __forceinline__ float bfhi(unsigned w) { return __uint_as_float(w & 0xffff0000u); }
__device__ __forceinline__ void unpack8(const v4u q, float (&f)[8]) { f[0] = bflo(q.x); f[1] = bfhi(q.x); f[2] = bflo(q.y); f[3] = bfhi(q.y); f[4] = bflo(q.z); f[5] = bfhi(q.z); f[6] = bflo(q.w); f[7] = bfhi(q.w); }
__device__ __forceinline__ float gelu_tanh(float x) { const float u = 0.7978845608028654f * (x + 0.044715f * x * x * x); return 0.5f * x * (1.0f + tanhf(u)); }
__device__ __forceinline__ float silu(float x) { return x / (1.0f + expf(-x)); }
__device__ __forceinline__ float log_sigmoid(float x) { return fminf(x, 0.f) - log1pf(expf(-fabsf(x))); }

#define XB_TMO      128
#define XB_XCNT(j)  (256  + 64 * (j))
#define XB_XSUB(j)  (1280 + 64 * (j))
#define XB_XGEN(j)  (2304 + 64 * (j))
#define XB_TOP      3328
#define XB_TOPGEN   3392
#define XCD_BAR_WORDS 3456
#define XB_SPIN_CAP (1u << 18)

__device__ __forceinline__ unsigned xb_ld(unsigned* p)              { return __hip_atomic_load(p, __ATOMIC_RELAXED, __HIP_MEMORY_SCOPE_AGENT); }
__device__ __forceinline__ unsigned xb_add(unsigned* p, unsigned v) { return __hip_atomic_fetch_add(p, v, __ATOMIC_RELAXED, __HIP_MEMORY_SCOPE_AGENT); }
__device__ __forceinline__ unsigned xb_xcc_id() { return (unsigned)__builtin_amdgcn_s_getreg((3 << 11) | 20) & 0xFu; }
#define XB_SPIN(cond, bar) do { unsigned _sp = 0; while (cond) { __builtin_amdgcn_s_sleep(1); \
    if ((++_sp & 255u) == 0u) { if (xb_ld(&(bar)[XB_TMO])) break; if (_sp > XB_SPIN_CAP) { atomicAdd(&(bar)[XB_TMO], 1u); break; } } } } while (0)

struct XcdBarrier {
    int wave;
    unsigned* bar; unsigned x;
    volatile LAS unsigned* st;
};

__device__ __forceinline__ XcdBarrier xcd_barrier_post(unsigned* bar, volatile LAS unsigned* st) {
    XcdBarrier b; b.bar = bar; b.x = xb_xcc_id(); b.st = st; b.wave = __builtin_amdgcn_readfirstlane(threadIdx.x >> 6);
    if (threadIdx.x == 0) (void)xb_add(&bar[XB_XCNT(b.x)], 1u);
    return b;
}
__device__ __forceinline__ void xcd_barrier_complete(unsigned* bar, unsigned x, unsigned& nloc, unsigned& nx) {
    const unsigned G = gridDim.x * gridDim.y * gridDim.z;
    unsigned sum, cnt, mine, sp = 0u;
    for (;;) {
        sum = 0u; cnt = 0u; mine = 0u;
#pragma unroll
        for (unsigned j = 0; j < 16; ++j) { const unsigned c = xb_ld(&bar[XB_XCNT(j)]); sum += c; cnt += (c > 0u) ? 1u : 0u; mine = (j == x) ? c : mine; }
        if (sum == G) break;
        __builtin_amdgcn_s_sleep(1);
        if ((++sp & 255u) == 0u) { if (xb_ld(&bar[XB_TMO])) break; if (sp > XB_SPIN_CAP) { atomicAdd(&bar[XB_TMO], 1u); break; } }
    }
    nloc = mine > 0u ? mine : 1u; nx = cnt > 0u ? cnt : 1u;
}

__device__ __forceinline__ void xcd_barrier(const XcdBarrier& b) {
    asm volatile("s_waitcnt vmcnt(0)" ::: "memory");
    __syncthreads();
    if (b.wave == 0 && fresh_lane() == 0) {
        unsigned* bar = b.bar; asm volatile("" : "+s"(bar));
        __builtin_amdgcn_s_waitcnt(0);
        unsigned nloc = b.st[0], nx = b.st[1];
        if (nloc == 0u) { xcd_barrier_complete(bar, b.x, nloc, nx); b.st[0] = nloc; b.st[1] = nx; }
        const unsigned old = xb_add(&bar[XB_XSUB(b.x)], 1u);
        const unsigned gen = old / nloc;
        if (old + 1u == (gen + 1u) * nloc) {
            __builtin_amdgcn_fence(__ATOMIC_RELEASE, "agent");
            asm volatile("s_waitcnt vmcnt(0)" ::: "memory");
            const unsigned og = xb_add(&bar[XB_TOP], 1u);
            const unsigned tg = og / nx;
            if (og + 1u == (tg + 1u) * nx) xb_add(&bar[XB_TOPGEN], 1u);
            else XB_SPIN(xb_ld(&bar[XB_TOPGEN]) == tg, bar);
            __builtin_amdgcn_fence(__ATOMIC_ACQUIRE, "agent");
            xb_add(&bar[XB_XGEN(b.x)], 1u);
            asm volatile("s_waitcnt vmcnt(0)" ::: "memory");
        } else {
            XB_SPIN(xb_ld(&bar[XB_XGEN(b.x)]) == gen, bar);
            __builtin_amdgcn_fence(__ATOMIC_ACQUIRE, "agent");
            asm volatile("s_waitcnt vmcnt(0)" ::: "memory");
        }
    }
    __syncthreads();
}

#define AS4 __attribute__((address_space(4)))
struct KA {
    const AS4 char* ka;
    static __device__ __forceinline__ KA fresh() { KA k; k.ka = (const AS4 char*)__builtin_amdgcn_kernarg_segment_ptr(); asm volatile("" : "+s"(k.ka)); return k; }
    __device__ __forceinline__ const float* in(int i) const { return *(const float* const AS4*)(ka + 8 * i); }
    __device__ __forceinline__ float* out() const { return *(float* const AS4*)(ka + 160); }
    __device__ __forceinline__ unsigned char* ws() const { return *(unsigned char* const AS4*)(ka + 168); }
    __device__ __forceinline__ unsigned* ctl() const { return (unsigned*)(ws() + WS_CTL); }
    __device__ __forceinline__ bf16* WinT() const { return (bf16*)(ws() + WS_WIN); }
    __device__ __forceinline__ bf16* WoutT() const { return (bf16*)(ws() + WS_WOUT); }
    __device__ __forceinline__ bf16* WguT() const { return (bf16*)(ws() + WS_WGU); }
    __device__ __forceinline__ bf16* WdT() const { return (bf16*)(ws() + WS_WD); }
    __device__ __forceinline__ bf16* XN() const { return (bf16*)(ws() + WS_XN); }
    __device__ __forceinline__ bf16* P() const { return (bf16*)(ws() + WS_P); }
    __device__ __forceinline__ bf16* H1() const { return (bf16*)(ws() + WS_P); }
    __device__ __forceinline__ bf16* Y() const { return (bf16*)(ws() + WS_Y); }
    __device__ __forceinline__ float* Sst() const { return (float*)(ws() + WS_S); }
    __device__ __forceinline__ float* dec() const { return (float*)(ws() + WS_DEC); }
    __device__ __forceinline__ int* eid() const { return (int*)(ws() + WS_MISC); }
    __device__ __forceinline__ float* ew() const { return (float*)(ws() + WS_MISC + 131072); }
    __device__ __forceinline__ int* slot_tok() const { return (int*)(ws() + WS_MISC + 2 * 131072); }
    __device__ __forceinline__ int* slot_of() const { return (int*)(ws() + WS_MISC + 3 * 131072); }
    __device__ __forceinline__ bf16* Wsp() const { return (bf16*)(ws() + WS_WSP); }
    __device__ __forceinline__ bf16* Wr() const { return (bf16*)(ws() + WS_WR); }
    __device__ __forceinline__ bf16* XR() const { return (bf16*)(ws() + WS_XRES); }
    __device__ __forceinline__ int* blkcnt() const { return (int*)(ws() + WS_BLKCNT); }
};
struct Frame {
    LAS unsigned char* lds; float* smem;
    int G, bx, wave;
};
#define PHASE_TID const int lane = fresh_lane(), wave = F.wave, tid = wave * 64 + lane; (void)lane; (void)wave; (void)tid

__device__ __forceinline__ float wave_sum(float v) {
    v = sum16(v);
    const int iv = __float_as_int(v);
    return (__int_as_float(__builtin_amdgcn_readlane(iv, 0)) + __int_as_float(__builtin_amdgcn_readlane(iv, 16))) + (__int_as_float(__builtin_amdgcn_readlane(iv, 32)) + __int_as_float(__builtin_amdgcn_readlane(iv, 48)));
}

struct TrItem { const float* W; bf16* WT; int ldw, nvalid, k0, n0, ldt, drow0; };
__device__ __forceinline__ void transpose_load(const TrItem& t, int lane, f32x4 (&v)[8]) {
    const int sub = lane >> 3, c4 = (lane & 7) * 4;
#pragma unroll
    for (int i = 0; i < 8; ++i) v[i] = (c4 < t.nvalid) ? __builtin_nontemporal_load((const f32x4*)(t.W + (size_t)(t.k0 + 8 * i + sub) * t.ldw + t.n0 + c4)) : (f32x4){0.f, 0.f, 0.f, 0.f};
}
__device__ __forceinline__ void transpose_store(const TrItem& t, int lane, const f32x4 (&v)[8], LAS float* scr) {
    const int sub = lane >> 3, c4 = (lane & 7) * 4;
#pragma unroll
    for (int i = 0; i < 8; ++i) { LAS float* d = scr + (8 * i + sub) * 33 + c4; d[0] = v[i].x; d[1] = v[i].y; d[2] = v[i].z; d[3] = v[i].w; }
    asm volatile("s_waitcnt lgkmcnt(0)" ::: "memory");
    const int c = lane & 7;
#pragma unroll
    for (int j = 0; j < 4; ++j) { const int n = (lane >> 3) + 8 * j; const LAS float* s = scr + (8 * c) * 33 + n;
        v4u o; o.x = pk2(s[0 * 33], s[1 * 33]); o.y = pk2(s[2 * 33], s[3 * 33]); o.z = pk2(s[4 * 33], s[5 * 33]); o.w = pk2(s[6 * 33], s[7 * 33]);
        if (n < t.nvalid) *(GAS v4u*)(t.WT + (size_t)(t.drow0 + n) * t.ldt + t.k0 + 8 * c) = o; }
    asm volatile("s_waitcnt lgkmcnt(0)" ::: "memory");
}
__device__ __forceinline__ void p0_prologue(Frame& F) {
    const KA K = KA::fresh(); PHASE_TID;
    LAS float* scr = (LAS float*)(F.lds + wave * 16384);
    const int gw = F.bx * NWAVES + wave, NGW = F.G * NWAVES;
    constexpr int I_IN = 16 * 89, I_OUT = 16 * 32, I_G = 32 * 16 * 8, I_D = 32 * 4 * 32, I_L = I_IN + I_OUT + 2 * I_G + I_D;
#define TR_DECODE(it_, t_) do { const int l_ = (it_) / I_L; int r_ = (it_) % I_L; \
        if (r_ < I_IN) { const int kb = r_ / 89, nb = r_ % 89; t_ = TrItem{K.in(2) + (size_t)l_ * D * DIN, K.WinT() + (size_t)l_ * PLD * D, DIN, (nb == 88) ? 16 : 32, kb * 64, nb * 32, D, nb * 32}; } \
        else if (r_ < I_IN + I_OUT) { r_ -= I_IN; const int kb = r_ / 32, nb = r_ % 32; t_ = TrItem{K.in(10) + (size_t)l_ * D * D, K.WoutT() + (size_t)l_ * D * D, D, 32, kb * 64, nb * 32, D, nb * 32}; } \
        else if (r_ < I_IN + I_OUT + 2 * I_G) { r_ -= I_IN + I_OUT; const int sel = r_ / I_G; r_ %= I_G; const int e = r_ / 128, kb = (r_ % 128) / 8, n0 = (r_ % 8) * 32; \
            t_ = TrItem{K.in(16 + sel) + ((size_t)l_ * NE + e) * D * DE, K.WguT() + ((size_t)l_ * NE + e) * 512 * D, DE, 32, kb * 64, n0, D, (n0 >> 7) * 256 + sel * 128 + (n0 & 127)}; } \
        else { r_ -= I_IN + I_OUT + 2 * I_G; const int e = r_ / 128, kb = (r_ % 128) / 32, nb = r_ % 32; t_ = TrItem{K.in(18) + ((size_t)l_ * NE + e) * DE * D, K.WdT() + ((size_t)l_ * NE + e) * D * DE, D, 32, kb * 64, nb * 32, DE, nb * 32}; } } while (0)
    {
        TrItem cur, nxt; f32x4 vc[8], vn[8];
        int it = gw;
        if (it < DEPTH * I_L) { TR_DECODE(it, cur); transpose_load(cur, lane, vc); }
#pragma unroll 1
        for (; it < DEPTH * I_L; it += NGW) {
            const bool more = it + NGW < DEPTH * I_L;
            if (more) { TR_DECODE(it + NGW, nxt); transpose_load(nxt, lane, vn); }
            transpose_store(cur, lane, vc, scr);
            cur = nxt;
#pragma unroll
            for (int i = 0; i < 8; ++i) vc[i] = vn[i];
        }
    }
#undef TR_DECODE
    for (int i = F.bx * NT + tid; i < DEPTH * 240 * 128; i += F.G * NT) { const int l = i / (240 * 128), rr = (i / 128) % 240, c = i % 128;
        *(GAS v4u*)(K.WinT() + ((size_t)l * PLD + DIN + rr) * D + c * 8) = (v4u){0u, 0u, 0u, 0u}; }
    for (int i = F.bx * NT + tid; i < DEPTH * 48 * D; i += F.G * NT) { const int ll = i / (48 * D), n = (i / D) % 48, k = i % D;
        float w = 0.f;
        if (n < 4) w = K.in(12)[((size_t)ll * D + k) * 4 + n]; else if (n < 36) w = K.in(14)[((size_t)ll * D + k) * 32 + (n - 4)];
        w *= K.in(11)[(size_t)ll * D + k];
        const unsigned hi = f2bf(w), lo = f2bf(w - bf2f(hi));
        K.Wr()[((size_t)ll * 2 + 0) * 48 * D + (size_t)n * D + k] = (bf16)hi; K.Wr()[((size_t)ll * 2 + 1) * 48 * D + (size_t)n * D + k] = (bf16)lo; }
    for (int i = F.bx * NT + tid; i < DEPTH * MH * 128 * 128 / 8; i += F.G * NT) { const int e0 = i * 8, s0 = e0 & 127, t = (e0 >> 7) & 127;
        const f32x4 a = *(const f32x4*)(K.in(7) + e0), c = *(const f32x4*)(K.in(7) + e0 + 4);
        const float v[8] = {a.x, a.y, a.z, a.w, c.x, c.y, c.z, c.w}; unsigned w[4];
#pragma unroll
        for (int j = 0; j < 4; ++j) w[j] = pk2((s0 + 2 * j <= t) ? v[2 * j] : 0.f, (s0 + 2 * j + 1 <= t) ? v[2 * j + 1] : 0.f);
        *(GAS v4u*)(K.Wsp() + e0) = (v4u){w[0], w[1], w[2], w[3]}; }
    {
        f32x4 g4[4], v[4], vn[4];
#pragma unroll
        for (int j = 0; j < 4; ++j) g4[j] = ((const f32x4*)K.in(1))[lane + 64 * j];
        int m = gw;
        if (m < T) {
#pragma unroll
            for (int j = 0; j < 4; ++j) v[j] = __builtin_nontemporal_load((const f32x4*)(K.in(0) + (size_t)m * D) + lane + 64 * j); }
#pragma unroll 1
        for (; m < T; m += NGW) {
            if (m + NGW < T) {
#pragma unroll
                for (int j = 0; j < 4; ++j) vn[j] = __builtin_nontemporal_load((const f32x4*)(K.in(0) + (size_t)(m + NGW) * D) + lane + 64 * j); }
            float s_ = 0.f;
#pragma unroll
            for (int j = 0; j < 4; ++j) s_ += (v[j].x * v[j].x + v[j].y * v[j].y) + (v[j].z * v[j].z + v[j].w * v[j].w);
            const float rs = rsqrtf(wave_sum(s_) * (1.f / D) + EPS);
            v2u* o8 = (v2u*)(K.XN() + (size_t)m * D) + lane; v2u* r8 = (v2u*)(K.XR() + (size_t)m * D) + lane;
#pragma unroll
            for (int j = 0; j < 4; ++j) { o8[64 * j] = (v2u){pk2(v[j].x * rs * g4[j].x, v[j].y * rs * g4[j].y), pk2(v[j].z * rs * g4[j].z, v[j].w * rs * g4[j].w)};
                r8[64 * j] = (v2u){pk2(v[j].x, v[j].y), pk2(v[j].z, v[j].w)}; v[j] = vn[j]; }
        }
    }
}

typedef short bf16x8 __attribute__((ext_vector_type(8)));
__device__ __forceinline__ float fexp(float x) { return __builtin_amdgcn_exp2f(x * 1.4426950408889634f); }
__device__ __forceinline__ float logsig_fast(float x) { return fminf(x, 0.f) - __log2f(1.0f + fexp(-fabsf(x))) * 0.6931471805599453f; }
__device__ __forceinline__ float silu_fast(float x) { return x * __builtin_amdgcn_rcpf(1.0f + __builtin_amdgcn_exp2f(-1.4426950408889634f * x)); }
__device__ __forceinline__ float gelu_fast(float x) { const float u = 0.7978845608028654f * (x + 0.044715f * x * x * x); return x * __builtin_amdgcn_rcpf(1.0f + __builtin_amdgcn_exp2f(-2.8853900817779268f * u)); }
__device__ __forceinline__ f32x4 mfma16(bf16x8 a, bf16x8 b, f32x4 c) { return __builtin_amdgcn_mfma_f32_16x16x32_bf16(a, b, c, 0, 0, 0); }
constexpr int LROWB = 144;
constexpr int L_QD = 0, L_KI = 9216, L_KDT = 18432, L_VT = 27648, L_S = 46080, L_ST = 55296, L_OB = 73728, L_TOT = 107520, OBROW = 528;
#define FRAG(base, row, kel) (*(const LAS bf16x8*)(lds + (base) + (row) * LROWB + (kel) * 2))

constexpr int L_GKL = 109568, L_BL = 117760, SCN = 4, NSC = GN / SCN, NITEM = NB * GH * NSC;
#define FRAG(base, row, kel) (*(const LAS bf16x8*)(lds + (base) + (row) * LROWB + (kel) * 2))
struct GlaPre { unsigned short k[8], q[8], v[16]; v4u g0, g1; };
template <bool WITH_Q>
__device__ __forceinline__ void gla_prefetch(GlaPre& p, const bf16* P, int h, int t0, int tid, int lane, int wave) {
    const bf16* kp = P + (size_t)(t0 + 8 * wave) * PLD + C_K + h * 64 + lane;
#pragma unroll
    for (int j = 0; j < 8; ++j) p.k[j] = kp[(size_t)j * PLD];
    const int vv = tid & 127, cq = tid >> 7;
    const bf16* vp = P + (size_t)(t0 + 16 * cq) * PLD + C_V + h * 128 + vv;
#pragma unroll
    for (int j = 0; j < 16; ++j) p.v[j] = vp[(size_t)j * PLD];
    if (WITH_Q) {
        const bf16* qp = kp + (C_Q - C_K);
#pragma unroll
        for (int j = 0; j < 8; ++j) p.q[j] = qp[(size_t)j * PLD];
        const v4u* gr = (const v4u*)(P + (size_t)(t0 + (tid >> 3)) * PLD + C_G + h * 128 + 16 * (tid & 7));
        p.g0 = gr[0]; p.g1 = gr[1];
    }
}
__device__ __forceinline__ void gla_stage_gkl(const bf16* P, LAS unsigned char* lds, int tok0, int tid) {
    *(LAS v4u*)(lds + L_GKL + tid * 16) = *(const v4u*)(P + (size_t)(tok0 + (tid >> 1)) * PLD + C_GK + 8 * (tid & 1));
}
__device__ __forceinline__ void gla_b8_part(LAS unsigned char* lds, const float (&wu)[16], float bg, int n, int lane, int wave, float (&bv)[8]) {
    float run = 0.f;
#pragma unroll
    for (int j = 0; j < 8; ++j) {
        const LAS v4u* gl = (const LAS v4u*)(lds + L_GKL + (n * 64 + 8 * wave + j) * 32);
        float f0[8], f1[8]; unpack8(gl[0], f0); unpack8(gl[1], f1);
        float a = bg;
#pragma unroll
        for (int r = 0; r < 8; ++r) a += f0[r] * wu[r];
#pragma unroll
        for (int r = 0; r < 8; ++r) a += f1[r] * wu[8 + r];
        run += logsig_fast(a) * (1.0f / 16.0f); bv[j] = run;
    }
    ((LAS float*)(lds + L_TOT))[wave * 64 + lane] = run;
}
__device__ __forceinline__ float gla_b8_finish(LAS unsigned char* lds, int lane, int wave, float (&bv)[8]) {
    const LAS float* tot = (const LAS float*)(lds + L_TOT);
    float base = 0.f, all = 0.f;
#pragma unroll
    for (int g = 0; g < 8; ++g) { const float tv = tot[g * 64 + lane]; all += tv; if (g < wave) base += tv; }
#pragma unroll
    for (int j = 0; j < 8; ++j) bv[j] += base;
    return all;
}
__device__ __forceinline__ void gla_write_kdT_vT(LAS unsigned char* lds, const GlaPre& p, const float (&bv)[8], float bl, int tid, int lane, int wave) {
    float kd[8];
#pragma unroll
    for (int j = 0; j < 8; ++j) kd[j] = bf2f(p.k[j]) * fexp(bl - bv[j]);
    *(LAS v4u*)(lds + L_KDT + lane * LROWB + wave * 16) = (v4u){pk2(kd[0], kd[1]), pk2(kd[2], kd[3]), pk2(kd[4], kd[5]), pk2(kd[6], kd[7])};
    const int vv = tid & 127, cq = tid >> 7;
    LAS v4u* dst = (LAS v4u*)(lds + L_VT + vv * LROWB + cq * 32);
    dst[0] = (v4u){(unsigned)p.v[0] | ((unsigned)p.v[1] << 16), (unsigned)p.v[2] | ((unsigned)p.v[3] << 16), (unsigned)p.v[4] | ((unsigned)p.v[5] << 16), (unsigned)p.v[6] | ((unsigned)p.v[7] << 16)};
    dst[1] = (v4u){(unsigned)p.v[8] | ((unsigned)p.v[9] << 16), (unsigned)p.v[10] | ((unsigned)p.v[11] << 16), (unsigned)p.v[12] | ((unsigned)p.v[13] << 16), (unsigned)p.v[14] | ((unsigned)p.v[15] << 16)};
    if (wave == 0) ((LAS float*)(lds + L_BL))[lane] = bl;
}
__device__ __forceinline__ void gla_kv_mfma(LAS unsigned char* lds, int wave, int fr, int fq, f32x4 (&acc)[4]) {
    bf16x8 Bf[2];
#pragma unroll
    for (int ks = 0; ks < 2; ++ks) Bf[ks] = FRAG(L_VT, 16 * wave + fr, 32 * ks + 8 * fq);
#pragma unroll
    for (int dt = 0; dt < 4; ++dt) { acc[dt] = (f32x4){0.f, 0.f, 0.f, 0.f};
#pragma unroll
        for (int ks = 0; ks < 2; ++ks) acc[dt] = mfma16(FRAG(L_KDT, 16 * dt + fr, 32 * ks + 8 * fq), Bf[ks], acc[dt]); }
}

__device__ __forceinline__ void phase_gla_A2(Frame& F, int l) {
    const KA K = KA::fresh(); PHASE_TID;
    LAS unsigned char* lds = F.lds;
    const int fr = lane & 15, fq = lane >> 4;
#pragma unroll 1
    for (int it = F.bx; it < NITEM; it += F.G) {
        const int b = it / (GH * NSC), h = (it / NSC) % GH, sc = it % NSC, tok0 = b * S + sc * SCN * GC;
        const bf16* P = K.P();
        float wu[16];
        { const float* wup = K.in(3) + (size_t)l * 16 * 256 + h * 64 + lane;
#pragma unroll
          for (int r = 0; r < 16; ++r) wu[r] = wup[r * 256]; }
        const float bg = K.in(4)[l * 256 + h * 64 + lane];
        GlaPre pre[2]; gla_prefetch<false>(pre[0], P, h, tok0, tid, lane, wave); gla_prefetch<false>(pre[1], P, h, tok0 + GC, tid, lane, wave);
        __syncthreads();
        gla_stage_gkl(P, lds, tok0, tid);
        __syncthreads();
        f32x4 Sl[4], bs[4];
#pragma unroll
        for (int dt = 0; dt < 4; ++dt) { Sl[dt] = (f32x4){0.f, 0.f, 0.f, 0.f}; bs[dt] = (f32x4){0.f, 0.f, 0.f, 0.f}; }
#pragma unroll
        for (int n = 0; n < SCN; ++n) {
            float bv[8]; gla_b8_part(lds, wu, bg, n, lane, wave, bv);
            __syncthreads();
            const float bl = gla_b8_finish(lds, lane, wave, bv);
            gla_write_kdT_vT(lds, pre[n & 1], bv, bl, tid, lane, wave);
            if (n + 2 < SCN) gla_prefetch<false>(pre[n & 1], P, h, tok0 + (n + 2) * GC, tid, lane, wave);
            __syncthreads();
            f32x4 acc[4]; gla_kv_mfma(lds, wave, fr, fq, acc);
#pragma unroll
            for (int dt = 0; dt < 4; ++dt) { const f32x4 bl4 = *(const LAS f32x4*)(lds + L_BL + (16 * dt + 4 * fq) * 4);
                bs[dt] = bs[dt] + bl4;
#pragma unroll
                for (int r = 0; r < 4; ++r) Sl[dt][r] = fexp(bl4[r]) * Sl[dt][r] + acc[dt][r]; }
        }
        f32x4* ag = (f32x4*)K.Sst() + ((size_t)(it * 8 + wave) * 4) * 64 + lane;
#pragma unroll
        for (int dt = 0; dt < 4; ++dt) ag[dt * 64] = Sl[dt];
        if (wave == 0 && fr == 0) { f32x4* dp = (f32x4*)K.dec() + (size_t)it * 16 + fq;
#pragma unroll
            for (int dt = 0; dt < 4; ++dt) dp[dt * 4] = (f32x4){fexp(bs[dt][0]), fexp(bs[dt][1]), fexp(bs[dt][2]), fexp(bs[dt][3])}; }
    }
}


__device__ __forceinline__ void phase_gla_aggscan(Frame& F) {
    const KA K = KA::fresh(); PHASE_TID;
#pragma unroll 1
    for (int e = F.bx * NT + tid; e < NB * GH * 8192; e += F.G * NT) {
        const int bh = e >> 13, el = e & 8191, ln = (el >> 2) & 63, dt = (el >> 8) & 3, r = el & 3;
        float* ap = K.Sst() + (size_t)bh * NSC * 8192 + el; const float* dp = K.dec() + (size_t)bh * NSC * 64 + dt * 16 + (ln >> 4) * 4 + r;
        float st = 0.f;
#pragma unroll 1
        for (int j0 = 0; j0 < NSC; j0 += 16) {
            float a[16], d[16];
#pragma unroll
            for (int j = 0; j < 16; ++j) { a[j] = ap[(size_t)(j0 + j) * 8192]; d[j] = dp[(j0 + j) * 64]; }
#pragma unroll
            for (int j = 0; j < 16; ++j) { ap[(size_t)(j0 + j) * 8192] = st; st = d[j] * st + a[j]; }
        }
    }
}
template <class Bar>
__device__ __forceinline__ void phase_gla_C2(Frame& F, int l, const Bar& bar) {
    const KA K = KA::fresh(); PHASE_TID;
    LAS unsigned char* lds = F.lds;
    const int fr = lane & 15, fq = lane >> 4;
    const float* gnorm = K.in(5) + (size_t)l * 128;
#pragma unroll 1
    for (int it = F.bx; it < NITEM; it += F.G) {
        const int b = it / (GH * NSC), h = (it / NSC) % GH, sc = it % NSC, tok0 = b * S + sc * SCN * GC;
        const bf16* P = K.P();
        float wu[16];
        { const float* wup = K.in(3) + (size_t)l * 16 * 256 + h * 64 + lane;
#pragma unroll
          for (int r = 0; r < 16; ++r) wu[r] = wup[r * 256]; }
        const float bg = K.in(4)[l * 256 + h * 64 + lane];
        GlaPre pre[2]; gla_prefetch<true>(pre[0], P, h, tok0, tid, lane, wave); gla_prefetch<true>(pre[1], P, h, tok0 + GC, tid, lane, wave);
        __syncthreads();
        gla_stage_gkl(P, lds, tok0, tid);
        if (it == F.bx) { phase_gla_aggscan(F); xcd_barrier(bar); }
        f32x4 Sm[4];
        { const f32x4* ag = (const f32x4*)K.Sst() + ((size_t)(it * 8 + wave) * 4) * 64 + lane;
#pragma unroll
          for (int dt = 0; dt < 4; ++dt) Sm[dt] = ag[dt * 64]; }
        __syncthreads();
#pragma unroll
        for (int n = 0; n < SCN; ++n) {
            const int t0 = tok0 + n * GC;
            GlaPre& pr = pre[n & 1];
            float bv[8]; gla_b8_part(lds, wu, bg, n, lane, wave, bv);
            __syncthreads();
            const float bl = gla_b8_finish(lds, lane, wave, bv);
            gla_write_kdT_vT(lds, pr, bv, bl, tid, lane, wave);
#pragma unroll
            for (int j = 0; j < 8; ++j) {
                const float e = fexp(bv[j]);
                *(LAS bf16*)(lds + L_QD + (8 * wave + j) * LROWB + lane * 2) = (bf16)f2bf(bf2f(pr.q[j]) * 0.125f * e);
                *(LAS bf16*)(lds + L_KI + (8 * wave + j) * LROWB + lane * 2) = (bf16)f2bf(bf2f(pr.k[j]) * __builtin_amdgcn_rcpf(e));
            }
#pragma unroll
            for (int dt = 0; dt < 4; ++dt) *(LAS v2u*)(lds + L_ST + (16 * wave + fr) * LROWB + (16 * dt + 4 * fq) * 2) = (v2u){pk2(Sm[dt][0], Sm[dt][1]), pk2(Sm[dt][2], Sm[dt][3])};
            const v4u gq0 = pr.g0, gq1 = pr.g1;
            if (n + 2 < SCN) gla_prefetch<true>(pr, P, h, t0 + 2 * GC, tid, lane, wave);
            __syncthreads();
#pragma unroll
            for (int i = 0; i < 2; ++i) {
                const int tix = 2 * wave + i, st = tix >> 2, ct = tix & 3;
                f32x4 a = (f32x4){0.f, 0.f, 0.f, 0.f};
#pragma unroll
                for (int ks = 0; ks < 2; ++ks) a = mfma16(FRAG(L_KI, 16 * st + fr, 32 * ks + 8 * fq), FRAG(L_QD, 16 * ct + fr, 32 * ks + 8 * fq), a);
                const int s0 = 16 * st + 4 * fq, c = 16 * ct + fr;
                float m[4];
#pragma unroll
                for (int r = 0; r < 4; ++r) m[r] = (s0 + r <= c) ? a[r] : 0.f;
                *(LAS v2u*)(lds + L_S + c * LROWB + s0 * 2) = (v2u){pk2(m[0], m[1]), pk2(m[2], m[3])};
            }
            f32x4 kv[4]; gla_kv_mfma(lds, wave, fr, fq, kv);
            __syncthreads();
            {
                bf16x8 Av[2], As[2];
#pragma unroll
                for (int ks = 0; ks < 2; ++ks) { Av[ks] = FRAG(L_VT, 16 * wave + fr, 32 * ks + 8 * fq); As[ks] = FRAG(L_ST, 16 * wave + fr, 32 * ks + 8 * fq); }
#pragma unroll
                for (int ct = 0; ct < 4; ++ct) {
                    f32x4 a = (f32x4){0.f, 0.f, 0.f, 0.f};
#pragma unroll
                    for (int ks = 0; ks < 2; ++ks) { a = mfma16(Av[ks], FRAG(L_S, 16 * ct + fr, 32 * ks + 8 * fq), a); a = mfma16(As[ks], FRAG(L_QD, 16 * ct + fr, 32 * ks + 8 * fq), a); }
                    *(LAS f32x4*)(lds + L_OB + (16 * ct + fr) * OBROW + (16 * wave + 4 * fq) * 4) = a;
                }
            }
#pragma unroll
            for (int dt = 0; dt < 4; ++dt) { const f32x4 bl4 = *(const LAS f32x4*)(lds + L_BL + (16 * dt + 4 * fq) * 4);
#pragma unroll
                for (int r = 0; r < 4; ++r) Sm[dt][r] = fexp(bl4[r]) * Sm[dt][r] + kv[dt][r]; }
            __syncthreads();
            {
                const int c = tid >> 3, vg = tid & 7;
                const LAS f32x4* ob = (const LAS f32x4*)(lds + L_OB + c * OBROW + vg * 64);
                f32x4 o[4]; float ss = 0.f;
#pragma unroll
                for (int j = 0; j < 4; ++j) { o[j] = ob[j]; ss += (o[j].x * o[j].x + o[j].y * o[j].y) + (o[j].z * o[j].z + o[j].w * o[j].w); }
                ss = sum8(ss);
                const float rs = rsqrtf(ss * (1.0f / 128.0f) + EPS);
                float g0[8], g1[8]; unpack8(gq0, g0); unpack8(gq1, g1);
                const f32x4* gn = (const f32x4*)(gnorm + 16 * vg);
                const f32x4 n0 = gn[0], n1 = gn[1], n2 = gn[2], n3 = gn[3];
                v4u w0, w1;
                w0.x = pk2(o[0].x * rs * n0.x * silu_fast(g0[0]), o[0].y * rs * n0.y * silu_fast(g0[1])); w0.y = pk2(o[0].z * rs * n0.z * silu_fast(g0[2]), o[0].w * rs * n0.w * silu_fast(g0[3]));
                w0.z = pk2(o[1].x * rs * n1.x * silu_fast(g0[4]), o[1].y * rs * n1.y * silu_fast(g0[5])); w0.w = pk2(o[1].z * rs * n1.z * silu_fast(g0[6]), o[1].w * rs * n1.w * silu_fast(g0[7]));
                w1.x = pk2(o[2].x * rs * n2.x * silu_fast(g1[0]), o[2].y * rs * n2.y * silu_fast(g1[1])); w1.y = pk2(o[2].z * rs * n2.z * silu_fast(g1[2]), o[2].w * rs * n2.w * silu_fast(g1[3]));
                w1.z = pk2(o[3].x * rs * n3.x * silu_fast(g1[4]), o[3].y * rs * n3.y * silu_fast(g1[5])); w1.w = pk2(o[3].z * rs * n3.z * silu_fast(g1[6]), o[3].w * rs * n3.w * silu_fast(g1[7]));
                v4u* op = (v4u*)(K.XN() + (size_t)(t0 + c) * D + h * 128 + 16 * vg);
                op[0] = w0; op[1] = w1;
            }
        }
    }
    if (F.bx >= NITEM) { phase_gla_aggscan(F); xcd_barrier(bar); }
}
#undef FRAG

constexpr int GM_ROWB = 272;
__device__ __forceinline__ void phase_gmlp_mfma(Frame& F, int l) {
    const KA K = KA::fresh(); PHASE_TID;
    LAS unsigned char* lds = F.lds;
    const int fr = lane & 15, fq = lane >> 4;
    const int nks = (16 * wave + 15) / 32 + 1;
#pragma unroll 1
    for (int u = F.bx; u < NB * MN * MH; u += F.G) {
        const int b = u / (MN * MH), n = (u / MH) % MN, h = u % MH, t0 = b * S + n * MC;
        const bf16* P = K.P();
        const float gn = K.in(6)[(size_t)l * 256 + h * 64 + lane];
        unsigned short vraw[16];
#pragma unroll
        for (int i = 0; i < 16; ++i) vraw[i] = P[(size_t)(t0 + 16 * wave + i) * PLD + C_VG + h * 64 + lane];
        const bf16* Wb = K.Wsp() + ((size_t)(l * MH + h) * 128 + 16 * wave + fr) * 128 + 8 * fq;
        bf16x8 Bf[4];
#pragma unroll
        for (int ks = 0; ks < 4; ++ks) Bf[ks] = (ks < nks) ? *(const bf16x8*)(Wb + 32 * ks) : (bf16x8){0, 0, 0, 0, 0, 0, 0, 0};
        const int t = 16 * wave + fr;
        const float bias = K.in(8)[(size_t)l * MH * 128 + h * 128 + t];
        const bf16* up = P + (size_t)(t0 + t) * PLD + C_U + h * 64 + 4 * fq;
        v2u uw[4];
#pragma unroll
        for (int dt = 0; dt < 4; ++dt) uw[dt] = *(const v2u*)(up + 16 * dt);
        __syncthreads();
#pragma unroll
        for (int q = 0; q < 2; ++q) {
            float vs[8];
#pragma unroll
            for (int i = 0; i < 8; ++i) {
                const float g = gelu_fast(bf2f(vraw[8 * q + i]));
                const float ss = wave_sum(g * g);
                vs[i] = g * rsqrtf(ss * (1.0f / 64.0f) + EPS) * gn;
            }
            *(LAS v4u*)(lds + lane * GM_ROWB + (16 * wave + 8 * q) * 2) = (v4u){pk2(vs[0], vs[1]), pk2(vs[2], vs[3]), pk2(vs[4], vs[5]), pk2(vs[6], vs[7])};
        }
        __syncthreads();
        f32x4 acc[4];
#pragma unroll
        for (int dt = 0; dt < 4; ++dt) acc[dt] = (f32x4){0.f, 0.f, 0.f, 0.f};
#pragma unroll
        for (int ks = 0; ks < 4; ++ks) if (ks < nks) {
#pragma unroll
            for (int dt = 0; dt < 4; ++dt) acc[dt] = mfma16(*(const LAS bf16x8*)(lds + (16 * dt + fr) * GM_ROWB + (32 * ks + 8 * fq) * 2), Bf[ks], acc[dt]);
        }
        bf16* op = K.XN() + (size_t)(t0 + t) * D + 512 + h * 64 + 4 * fq;
#pragma unroll
        for (int dt = 0; dt < 4; ++dt) {
            const float o0 = gelu_fast(bflo(uw[dt].x)) * (acc[dt][0] + bias), o1 = gelu_fast(bfhi(uw[dt].x)) * (acc[dt][1] + bias), o2 = gelu_fast(bflo(uw[dt].y)) * (acc[dt][2] + bias), o3 = gelu_fast(bfhi(uw[dt].y)) * (acc[dt][3] + bias);
            *(v2u*)(op + 16 * dt) = (v2u){pk2(o0, o1), pk2(o2, o3)};
        }
    }
}
__device__ __forceinline__ void phase_conv(Frame& F, int l) {
    const KA K = KA::fresh(); PHASE_TID;
    const float* wc = K.in(9) + (size_t)l * 3 * 256;
#pragma unroll 1
    for (int e = F.bx * NT + tid; e < T * 32; e += F.G * NT) {
        const int t = e >> 5, c0 = (e & 31) * 8, tl = t % S;
        const bf16* row = K.P() + (size_t)t * PLD;
        float y[8], xi[8], cg[8], bg[8];
        unpack8(*(const v4u*)(row + C_XI + c0), xi); unpack8(*(const v4u*)(row + C_CG + c0), cg); unpack8(*(const v4u*)(row + C_BG + c0), bg);
#pragma unroll
        for (int j = 0; j < 8; ++j) y[j] = wc[2 * 256 + c0 + j] * cg[j] * xi[j];
        if (tl >= 1) { unpack8(*(const v4u*)(row - PLD + C_XI + c0), xi); unpack8(*(const v4u*)(row - PLD + C_CG + c0), cg);
#pragma unroll
            for (int j = 0; j < 8; ++j) y[j] += wc[1 * 256 + c0 + j] * cg[j] * xi[j]; }
        if (tl >= 2) { unpack8(*(const v4u*)(row - 2 * PLD + C_XI + c0), xi); unpack8(*(const v4u*)(row - 2 * PLD + C_CG + c0), cg);
#pragma unroll
            for (int j = 0; j < 8; ++j) y[j] += wc[0 * 256 + c0 + j] * cg[j] * xi[j]; }
#pragma unroll
        for (int j = 0; j < 8; ++j) y[j] *= bg[j];
        *(v4u*)(K.XN() + (size_t)t * D + 768 + c0) = (v4u){pk2(y[0], y[1]), pk2(y[2], y[3]), pk2(y[4], y[5]), pk2(y[6], y[7])};
    }
}
constexpr int RT_PART = 0, RT_SS = RT_PART + 4 * 8 * 16 * 48 * 4, RT_RS = RT_SS + 4 * 8 * 16 * 4, RT_HIST = RT_RS + 64 * 4;
__device__ __forceinline__ void phase_norm_router_mfma(Frame& F, int l) {
    const KA K = KA::fresh(); PHASE_TID;
    LAS unsigned char* lds = F.lds;
    const int fr = lane & 15, fq = lane >> 4;
    const bf16* whi = K.Wr() + (size_t)l * 2 * 48 * D + (size_t)fr * D + 128 * wave + 8 * fq; const bf16* wlo = whi + 48 * D;
    bf16x8 Wh[4][3], Wl[4][3];
#pragma unroll
    for (int ks = 0; ks < 4; ++ks)
#pragma unroll
        for (int nt = 0; nt < 3; ++nt) { Wh[ks][nt] = *(const bf16x8*)(whi + (size_t)(16 * nt) * D + 32 * ks); Wl[ks][nt] = *(const bf16x8*)(wlo + (size_t)(16 * nt) * D + 32 * ks); }
    f32x4 g0[4], g1[4];
    { const float* gp = K.in(11) + (size_t)l * D + 128 * wave + 8 * fq;
#pragma unroll
      for (int ks = 0; ks < 4; ++ks) { g0[ks] = *(const f32x4*)(gp + 32 * ks); g1[ks] = *(const f32x4*)(gp + 32 * ks + 4); } }
#pragma unroll 1
    for (int blk = F.bx; blk < T / 64; blk += F.G) {
        const bf16* xr = K.XR() + (size_t)(blk * 64 + fr) * D + 128 * wave + 8 * fq;
        __syncthreads();
        if (tid < NE) ((LAS int*)(lds + RT_HIST))[tid] = 0;
        v4u xa[4][4];
#pragma unroll
        for (int t = 0; t < 4; ++t)
#pragma unroll
            for (int ks = 0; ks < 4; ++ks) xa[t][ks] = *(const v4u*)(xr + (size_t)(16 * t) * D + 32 * ks);
#pragma unroll
        for (int t = 0; t < 4; ++t) {
            f32x4 acc[3]; float ss = 0.f;
#pragma unroll
            for (int nt = 0; nt < 3; ++nt) acc[nt] = (f32x4){0.f, 0.f, 0.f, 0.f};
#pragma unroll
            for (int ks = 0; ks < 4; ++ks) {
                float xv[8]; unpack8(xa[t][ks], xv);
#pragma unroll
                for (int j = 0; j < 8; ++j) ss += xv[j] * xv[j];
                const bf16x8 Ah = __builtin_bit_cast(bf16x8, xa[t][ks]);
#pragma unroll
                for (int nt = 0; nt < 3; ++nt) { acc[nt] = mfma16(Ah, Wh[ks][nt], acc[nt]); acc[nt] = mfma16(Ah, Wl[ks][nt], acc[nt]); }
            }
            ss += shx(ss, 16); ss += shx(ss, 32);
            LAS float* part = (LAS float*)(lds + RT_PART) + (t * 8 + wave) * 16 * 48;
#pragma unroll
            for (int nt = 0; nt < 3; ++nt)
#pragma unroll
                for (int r = 0; r < 4; ++r) part[(4 * fq + r) * 48 + 16 * nt + fr] = acc[nt][r];
            if (fq == 0) ((LAS float*)(lds + RT_SS))[(t * 8 + wave) * 16 + fr] = ss;
        }
        __syncthreads();
        {
            const int tt = tid >> 3, j = tid & 7, t = blk * 64 + tt;
            const LAS float* p0 = (const LAS float*)(lds + RT_PART) + ((tt >> 4) * 8 * 16 + (tt & 15)) * 48;
            const LAS float* s2 = (const LAS float*)(lds + RT_SS) + (tt >> 4) * 8 * 16 + (tt & 15);
            float sq = 0.f;
#pragma unroll
            for (int w = 0; w < 8; ++w) sq += s2[w * 16];
            const float rs = rsqrtf(sq * (1.f / D) + EPS);
#define RT_DOT(n) (((p0[(n)] + p0[768 + (n)]) + (p0[1536 + (n)] + p0[2304 + (n)])) + ((p0[3072 + (n)] + p0[3840 + (n)]) + (p0[4608 + (n)] + p0[5376 + (n)])))
            float gv = (j < 4) ? RT_DOT(j & 3) * rs + K.in(13)[(size_t)l * 4 + (j & 3)] : -INFINITY; int gi = j;
            const float gmine = gv;
#define RT_ARGMAX_STEP(V, I, FV, FI) do { const float ov = FV(V); const int oi = FI(I); if (ov > V || (ov == V && oi < I)) { V = ov; I = oi; } } while (0)
            RT_ARGMAX_STEP(gv, gi, dppf_x1, dpp_x1); RT_ARGMAX_STEP(gv, gi, dppf_x2, dpp_x2); RT_ARGMAX_STEP(gv, gi, dppf_hm, dpp_hm);
            float ge = (j < 4) ? expf(gmine - gv) : 0.f;
            ge = sum8(ge);
            const float gw = 1.0f / ge; const int gt = gi;
            const float ev = RT_DOT(4 + gt * 8 + j) * rs + K.in(15)[(size_t)l * 32 + gt * 8 + j];
#undef RT_DOT
            float m0 = ev; int i0 = j;
            RT_ARGMAX_STEP(m0, i0, dppf_x1, dpp_x1); RT_ARGMAX_STEP(m0, i0, dppf_x2, dpp_x2); RT_ARGMAX_STEP(m0, i0, dppf_hm, dpp_hm);
            float m1 = (j == i0) ? -INFINITY : ev; int i1 = j;
            RT_ARGMAX_STEP(m1, i1, dppf_x1, dpp_x1); RT_ARGMAX_STEP(m1, i1, dppf_x2, dpp_x2); RT_ARGMAX_STEP(m1, i1, dppf_hm, dpp_hm);
#undef RT_ARGMAX_STEP
            if (j == 0) {
                ((LAS float*)(lds + RT_RS))[tt] = rs;
                const float e1 = expf(m1 - m0);
                const float w0 = gw / (1.0f + e1), w1 = gw * e1 / (1.0f + e1);
                const int e0i = gt * 8 + i0, e1i = gt * 8 + i1;
                K.eid()[2 * t] = e0i; K.eid()[2 * t + 1] = e1i; K.ew()[2 * t] = w0; K.ew()[2 * t + 1] = w1;
                LAS int* hist = (LAS int*)(lds + RT_HIST);
                K.slot_of()[2 * t] = __hip_atomic_fetch_add(hist + e0i, 1, __ATOMIC_RELAXED, __HIP_MEMORY_SCOPE_WORKGROUP);
                K.slot_of()[2 * t + 1] = __hip_atomic_fetch_add(hist + e1i, 1, __ATOMIC_RELAXED, __HIP_MEMORY_SCOPE_WORKGROUP);
            }
        }
        __syncthreads();
        if (tid < NE) K.blkcnt()[(size_t)(l * (T / 64) + blk) * NE + tid] = ((LAS int*)(lds + RT_HIST))[tid];
        {
            bf16* hp = K.XN() + (size_t)(blk * 64 + fr) * D + 128 * wave + 8 * fq;
#pragma unroll
            for (int t = 0; t < 4; ++t) {
                const float rs = ((const LAS float*)(lds + RT_RS))[16 * t + fr];
#pragma unroll
                for (int ks = 0; ks < 4; ++ks) {
                    asm volatile("" : "+v"(xa[t][ks]));
                    float xv[8]; unpack8(xa[t][ks], xv);
                    *(v4u*)(hp + (size_t)(16 * t) * D + 32 * ks) = (v4u){pk2(xv[0] * rs * g0[ks].x, xv[1] * rs * g0[ks].y), pk2(xv[2] * rs * g0[ks].z, xv[3] * rs * g0[ks].w), pk2(xv[4] * rs * g1[ks].x, xv[5] * rs * g1[ks].y), pk2(xv[6] * rs * g1[ks].z, xv[7] * rs * g1[ks].w)};
                }
            }
        }
    }
}
constexpr int TAB_OFF = LDSCTL_OFF + 1024;
__device__ __forceinline__ void moe_tables_lds(Frame& F, const LAS int* tot, int tid) {
    LAS int* tab = (LAS int*)(F.lds + TAB_OFF); LAS int* offs = tab + 4 + 4 * 164; LAS int* fpre = offs + 40; LAS int* ppre = fpre + 40;
    if (tid == 0) { int a = 0, f = 0, p = 0; for (int e = 0; e < NE; ++e) { const int c = tot[e]; offs[e] = a; fpre[e] = f; ppre[e] = p; a += c; f += c >> 8; p += (c & 255) ? 1 : 0; }
        offs[NE] = a; fpre[NE] = f; ppre[NE] = p; tab[0] = f + p; }
    __syncthreads();
    const int nfull = fpre[NE];
    if (tid < nfull) { int e = 0; for (int j = 1; j < NE; ++j) if (fpre[j] <= tid) e = j; tab[4 + 4 * tid] = e; tab[5 + 4 * tid] = offs[e] + (tid - fpre[e]) * 256; tab[6 + 4 * tid] = offs[e + 1]; }
    else if (tid < nfull + NE) {
        const int e = tid - nfull, rows = (offs[e + 1] - offs[e]) & 255;
        if (rows) { int rank = 0; for (int j = 0; j < NE; ++j) { const int rj = (offs[j + 1] - offs[j]) & 255; rank += (rj > rows || (rj == rows && j < e)) ? 1 : 0; }
            const int q = nfull + rank; tab[4 + 4 * q] = e; tab[5 + 4 * q] = offs[e] + (fpre[e + 1] - fpre[e]) * 256; tab[6 + 4 * q] = offs[e + 1]; }
    }
    __syncthreads();
}
__device__ __forceinline__ void phase_scatter(Frame& F, int l) {
    const KA K = KA::fresh(); PHASE_TID;
    LAS int* sm = (LAS int*)F.lds;
    const int* bc = K.blkcnt() + (size_t)l * (T / 64) * NE;
    constexpr int NBLK = T / 64;
#pragma unroll 1
    for (int blk = F.bx, trip = 0; blk < NBLK || trip == 0; blk += F.G, ++trip) {
        __syncthreads();
        {   const int e = tid & 31, part = tid >> 5;
            int tot = 0, pre = 0;
#pragma unroll
            for (int j = 0; j < NBLK / 16; ++j) { const int bb = part * (NBLK / 16) + j; const int c = bc[bb * NE + e]; tot += c; if (bb < blk) pre += c; }
            sm[part * 32 + e] = tot; sm[512 + part * 32 + e] = pre; }
        __syncthreads();
        if (tid < 32) { int tot = 0, pre = 0;
#pragma unroll
            for (int p = 0; p < 16; ++p) { tot += sm[p * 32 + tid]; pre += sm[512 + p * 32 + tid]; }
            sm[1056 + tid] = tot; sm[1024 + tid] = pre; }
        __syncthreads();
        if (tid == 0) { int a = 0; for (int e = 0; e < NE; ++e) { const int c = sm[1056 + e]; sm[1024 + e] += a; a += c; } }
        __syncthreads();
        if (blk < NBLK && tid < 128) { const int a = blk * 128 + tid; const int e = K.eid()[a]; const int pos = sm[1024 + e] + K.slot_of()[a]; K.slot_tok()[pos] = a >> 1; K.slot_of()[a] = pos; }
    }
    __syncthreads();
    moe_tables_lds(F, sm + 1056, tid);
}
template <int SUB>
__device__ __forceinline__ void phase_moe(Frame& F, int l) {
    const KA K = KA::fresh();
    int c_ = F.bx; asm volatile("" : "+s"(c_));
    const int G = F.G, c = (c_ & 7) * (G >> 3) + (c_ >> 3);
    const LAS int* tab = (const LAS int*)(F.lds + TAB_OFF);
    const int ntile = __builtin_amdgcn_readfirstlane(tab[0]), ngu = 2 * ntile, nleft = ngu > G ? ngu - G : 0, jX = ngu > G ? (G >> 1) : ntile, W = G - nleft;
    const int yd = (jX * 4 < 2 * W) ? jX * 4 : 2 * W;
    bool do_gu = false, do_dn = false; pg8::MoeSched So{tab, 2, 0, 0, G, c, 0};
    if (SUB == 0) { do_gu = true; So.npn = 2; So.first = 0; So.end = ngu < G ? ngu : G; So.stride = G; So.c = c; }
    if (SUB == 1) { if (c < nleft) { do_gu = true; So.npn = 2; So.first = G; So.end = ngu; So.stride = G; So.c = c; }
                    else { do_dn = true; So.npn = 4; So.first = 0; So.end = yd; So.stride = W; So.c = c - nleft; } }
    if (SUB == 2) { do_dn = true; So.npn = 4; So.first = 2 * yd; So.end = 2 * ntile * 4; So.stride = G; So.c = c; So.split = 1; }
    if (do_gu) { pg8::EpiMoeH E{K.H1()};
        pg8::gemm_phase_moe<pg8::EpiMoeH, pg8::MoeSched, true, 512, D>(F.lds, K.XN(), K.WguT() + (size_t)l * NE * 512 * D, K.slot_tok(), So, E, F.wave); }
    if (do_dn) { pg8::EpiMoeY E{K.Y()};
        pg8::gemm_phase_moe<pg8::EpiMoeY, pg8::MoeSched, false, D, DE>(F.lds, K.H1(), K.WdT() + (size_t)l * NE * D * DE, nullptr, So, E, F.wave); }
}
__device__ __forceinline__ void phase_combine(Frame& F, int l) {
    const KA K = KA::fresh(); PHASE_TID;
    const bool last = (l == DEPTH - 1);
    const float* gain = last ? K.in(19) : (K.in(1) + (size_t)(l + 1) * D);
    f32x4 g4[4];
#pragma unroll
    for (int j = 0; j < 4; ++j) g4[j] = ((const f32x4*)gain)[lane + 64 * j];
    const int tstep = F.G * NWAVES;
    int t = F.bx * NWAVES + wave;
    v2u xw[4], ya[4], yb[4]; float w0 = 0.f, w1 = 0.f;
#define CB_LOAD(tt) do { const int s0_ = K.slot_of()[2 * (tt)], s1_ = K.slot_of()[2 * (tt) + 1]; w0n = K.ew()[2 * (tt)]; w1n = K.ew()[2 * (tt) + 1]; \
        const v2u* xr_ = (const v2u*)(K.XR() + (size_t)(tt) * D) + lane; const v2u* y0_ = (const v2u*)(K.Y() + (size_t)s0_ * D) + lane; const v2u* y1_ = (const v2u*)(K.Y() + (size_t)s1_ * D) + lane; \
        _Pragma("unroll") for (int j = 0; j < 4; ++j) { xn[j] = xr_[64 * j]; an[j] = y0_[64 * j]; bn[j] = y1_[64 * j]; } } while (0)
    { v2u xn[4], an[4], bn[4]; float w0n = 0.f, w1n = 0.f;
      if (t < T) { CB_LOAD(t);
#pragma unroll
        for (int j = 0; j < 4; ++j) { xw[j] = xn[j]; ya[j] = an[j]; yb[j] = bn[j]; } w0 = w0n; w1 = w1n; } }
#pragma unroll 1
    for (; t < T; t += tstep) {
        v2u xn[4], an[4], bn[4]; float w0n = 0.f, w1n = 0.f;
        if (t + tstep < T) CB_LOAD(t + tstep);
        f32x4 v[4]; float s = 0.f;
#pragma unroll
        for (int j = 0; j < 4; ++j) { const v2u x_ = xw[j], a = ya[j], b = yb[j];
            v[j].x = bflo(x_.x) + w0 * bflo(a.x) + w1 * bflo(b.x); v[j].y = bfhi(x_.x) + w0 * bfhi(a.x) + w1 * bfhi(b.x); v[j].z = bflo(x_.y) + w0 * bflo(a.y) + w1 * bflo(b.y); v[j].w = bfhi(x_.y) + w0 * bfhi(a.y) + w1 * bfhi(b.y);
            s += (v[j].x * v[j].x + v[j].y * v[j].y) + (v[j].z * v[j].z + v[j].w * v[j].w); }
        const float rs = rsqrtf(wave_sum(s) * (1.f / D) + EPS);
        if (last) {
            f32x4* orow = (f32x4*)(K.out() + (size_t)t * D) + lane;
#pragma unroll
            for (int j = 0; j < 4; ++j) __builtin_nontemporal_store((f32x4){v[j].x * rs * g4[j].x, v[j].y * rs * g4[j].y, v[j].z * rs * g4[j].z, v[j].w * rs * g4[j].w}, orow + 64 * j);
        } else {
            v2u* xr = (v2u*)(K.XR() + (size_t)t * D) + lane; v2u* o8 = (v2u*)(K.XN() + (size_t)t * D) + lane;
#pragma unroll
            for (int j = 0; j < 4; ++j) { xr[64 * j] = (v2u){pk2(v[j].x, v[j].y), pk2(v[j].z, v[j].w)};
                o8[64 * j] = (v2u){pk2(v[j].x * rs * g4[j].x, v[j].y * rs * g4[j].y), pk2(v[j].z * rs * g4[j].z, v[j].w * rs * g4[j].w)}; }
        }
#pragma unroll
        for (int j = 0; j < 4; ++j) { xw[j] = xn[j]; ya[j] = an[j]; yb[j] = bn[j]; }
        w0 = w0n; w1 = w1n;
    }
#undef CB_LOAD
}

struct Args { const float* in[20]; float* out; unsigned char* ws; };
__global__ void __launch_bounds__(NT, 2) fwd_kernel(Args args) {
    extern __shared__ __attribute__((aligned(16))) unsigned char lds_raw[];
    Frame F;
    F.lds = (LAS unsigned char*)lds_raw; F.smem = (float*)lds_raw;
    F.G = gridDim.x; F.bx = blockIdx.x; F.wave = __builtin_amdgcn_readfirstlane(threadIdx.x >> 6);
    volatile LAS unsigned* MISC = (volatile LAS unsigned*)(F.lds + MISC_OFF);
    for (int u = threadIdx.x; u < (LDS_BYTES - LDSCTL_OFF) / 4; u += NT) ((LAS unsigned*)(F.lds + LDSCTL_OFF))[u] = 0u;
    __syncthreads();
    XcdBarrier bar; { const KA K = KA::fresh(); bar = xcd_barrier_post(K.ctl() + CW_BAR, MISC + 8); }
#define GRID_BAR() xcd_barrier(bar)

    p0_prologue(F);
    GRID_BAR();
    for (int l = 0; l < DEPTH; ++l) {
        {
            const KA K = KA::fresh(); PHASE_TID;
            pg8::Gemm g{K.XN(), K.WinT() + (size_t)l * PLD * D, T, PLD, D}; pg8::StaticOrder So; int c_ = F.bx; asm volatile("" : "+s"(c_)); So.init(T, PLD, F.G, c_);
            pg8::EpiBf16Plain E{K.P(), PLD, DIN};
            pg8::gemm_phase<pg8::EpiBf16Plain, pg8::StaticOrder, PG8_ALIGN, PG8_SP2>(F.lds, g, So, E, F.wave);
        }
        GRID_BAR();
        phase_gla_A2(F, l);
        phase_gmlp_mfma(F, l);
        phase_conv(F, l);
        GRID_BAR();
        phase_gla_C2(F, l, bar);
        GRID_BAR();
        {
            const KA K = KA::fresh(); PHASE_TID;
            pg8::Gemm g{K.XN(), K.WoutT() + (size_t)l * D * D, T, D, D}; pg8::StaticOrder So; int c_ = F.bx; asm volatile("" : "+s"(c_)); So.init(T, D, F.G, c_);
            pg8::EpiBf16Res<false> E{K.XR(), K.XR(), D}; pg8::gemm_phase<pg8::EpiBf16Res<false>, pg8::StaticOrder, PG8_ALIGN, PG8_SP2>(F.lds, g, So, E, F.wave);
        }
        GRID_BAR();
        phase_norm_router_mfma(F, l);
        GRID_BAR();
        phase_scatter(F, l);
        GRID_BAR();
        phase_moe<0>(F, l);
        GRID_BAR();
        phase_moe<1>(F, l);
        GRID_BAR();
        phase_moe<2>(F, l);
        GRID_BAR();
        phase_combine(F, l);
        if (l + 1 < DEPTH) GRID_BAR();
    }
}

extern "C" void kernel_launch(void* const* d_in, const int* in_sizes, int n_in, void* d_out, int out_size, void* d_ws, size_t ws_size, hipStream_t stream) {
    static int grid_blocks = 0;
    if (!grid_blocks) {
        int dev = 0, cus = 0, per_cu = 0;
        (void)hipGetDevice(&dev);
        (void)hipDeviceGetAttribute(&cus, hipDeviceAttributeMultiprocessorCount, dev);
        (void)hipFuncSetAttribute((const void*)fwd_kernel, hipFuncAttributeMaxDynamicSharedMemorySize, LDS_BYTES);
        (void)hipOccupancyMaxActiveBlocksPerMultiprocessor(&per_cu, fwd_kernel, NT, LDS_BYTES);
        if (per_cu < 1) { fprintf(stderr, "kernel_launch: occupancy query says %d blocks/CU\n", per_cu); per_cu = 1; }
        grid_blocks = cus;
        if (ws_size < WS_END) { fprintf(stderr, "kernel_launch: workspace too small (%zu < %zu)\n", ws_size, (size_t)WS_END); grid_blocks = -1; }
    }
    if (grid_blocks < 0) return;
    (void)hipMemsetAsync((char*)d_ws + WS_CTL, 0, 131072, stream);
    Args a{};
    for (int i = 0; i < 20; ++i) a.in[i] = (const float*)d_in[i];
    a.out = (float*)d_out; a.ws = (unsigned char*)d_ws;
    void* args[] = {&a};
    hipError_t e = hipLaunchCooperativeKernel((void*)fwd_kernel, dim3(grid_blocks), dim3(NT), args, LDS_BYTES, stream);
    if (e != hipSuccess) fprintf(stderr, "cooperative launch failed: %s (grid %d)\n", hipGetErrorString(e), grid_blocks);
}
```

```cpp
#include <hip/hip_runtime.h>
#include <cstdio>
#include <cstdint>
__device__ __forceinline__ int fresh_lane() { unsigned m = 0xffffffffu; asm volatile("" : "+s"(m)); return (int)__builtin_amdgcn_mbcnt_hi(m, __builtin_amdgcn_mbcnt_lo(m, 0u)); }
__device__ __forceinline__ float shx(float v, int o) { return __int_as_float(__builtin_amdgcn_ds_bpermute((fresh_lane() ^ o) << 2, __float_as_int(v))); }
__device__ __forceinline__ int dpp_x1(int v) { return __builtin_amdgcn_update_dpp(v, v, 0xB1, 0xF, 0xF, false); }
__device__ __forceinline__ int dpp_x2(int v) { return __builtin_amdgcn_update_dpp(v, v, 0x4E, 0xF, 0xF, false); }
__device__ __forceinline__ int dpp_hm(int v) { return __builtin_amdgcn_update_dpp(v, v, 0x141, 0xF, 0xF, false); }
__device__ __forceinline__ int dpp_rm(int v) { return __builtin_amdgcn_update_dpp(v, v, 0x140, 0xF, 0xF, false); }
__device__ __forceinline__ float dppf_x1(float v) { return __int_as_float(dpp_x1(__float_as_int(v))); }
__device__ __forceinline__ float dppf_x2(float v) { return __int_as_float(dpp_x2(__float_as_int(v))); }
__device__ __forceinline__ float dppf_hm(float v) { return __int_as_float(dpp_hm(__float_as_int(v))); }
__device__ __forceinline__ float dppf_rm(float v) { return __int_as_float(dpp_rm(__float_as_int(v))); }
__device__ __forceinline__ float sum8(float v) { v += dppf_x1(v); v += dppf_x2(v); v += dppf_hm(v); return v; }
__device__ __forceinline__ float sum16(float v) { v = sum8(v); v += dppf_rm(v); return v; }
namespace pg8 {
#define PG8_LAS __attribute__((address_space(3)))
typedef unsigned short bf16_t;
typedef short bf16x8 __attribute__((ext_vector_type(8)));
typedef float f32x4 __attribute__((ext_vector_type(4)));
typedef unsigned u32x4 __attribute__((ext_vector_type(4)));
constexpr int BM = 256, BK = 64, HALF = 128, HTB = HALF * BK * 2  , STAGE_BYTES = 8 * HTB, NXCD = 8, WGM = 8;

__host__ __device__ __forceinline__ int lds_byte(int r, int c) { const int st = (r >> 4) * 2 + (c >> 5), rr = r & 15, cc = c & 31, ob = rr * 64 + cc * 2; return st * 1024 + (ob ^ (((ob >> 9) & 1) << 5)); }
__host__ __device__ __forceinline__ void stage_rc(int b, int& R, int& C) { const int st = b / 1024, sb = b % 1024, swz = sb ^ (((sb >> 9) & 1) << 5); R = (st >> 1) * 16 + swz / 64; C = (st & 1) * 32 + (swz % 64) / 2; }
__host__ __device__ __forceinline__ int perm32(int rho) { const int n = rho >> 4, i = rho & 15; return 8 * (i >> 2) + 4 * n + (i & 3); }

struct Unit { int pm, pn; };
struct Gemm { const bf16_t* A; const bf16_t* Bt; int M, N, K; };

struct StaticOrder {
    int nM, nN, nwg, G, c;
    __host__ __device__ void init(int M, int N, int G_, int c_) { nM = M / BM; nN = N / BM; nwg = nM * nN; G = G_; c = c_; }
    __host__ __device__ bool next(int i, Unit& u) const {
        const long L = (long)i * G + c; if (L >= nwg) return false;
        int wgid = (int)L; { const int q = nwg / NXCD, r = nwg % NXCD, xcd = wgid % NXCD, off = wgid / NXCD; wgid = (xcd < r ? xcd * (q + 1) : r * (q + 1) + (xcd - r) * q) + off; }
        const int nig = WGM * nN, gid = wgid / nig, fm = gid * WGM, gsz = (nM - fm) < WGM ? (nM - fm) : WGM;
        u.pm = fm + ((wgid % nig) % gsz); u.pn = (wgid % nig) / gsz; return true;
    }
    __device__ __forceinline__ void a_ready(const Unit&) const {}
    __device__ __forceinline__ void done(const Unit&) const {}
};


__device__ __forceinline__ unsigned cvt_pk_bf16(float lo, float hi) { unsigned r; asm volatile("v_cvt_pk_bf16_f32 %0, %1, %2" : "=v"(r) : "v"(lo), "v"(hi)); return r; }
struct EpiBf16Plain {
    static constexpr bool PERM = true, AFTER_DRAIN = false;
    bf16_t* O; int ldc;
    __device__ __forceinline__ void operator()(const f32x4 (&acc)[2][2][4][2], const Unit& u, int wr, int wc, int fr, int fq) const {
        const int row0 = u.pm * BM + wr * 64 + fr, col0 = u.pn * BM + wc * 32 + 8 * fq;
#pragma unroll
        for (int ai = 0; ai < 2; ++ai)
#pragma unroll
            for (int m = 0; m < 4; ++m) { bf16_t* rowp = O + (size_t)(row0 + ai * HALF + m * 16) * ldc + col0;
#pragma unroll
                for (int bj = 0; bj < 2; ++bj) { const f32x4 v0 = acc[ai][bj][m][0], v1 = acc[ai][bj][m][1];
                    u32x4 w; w.x = cvt_pk_bf16(v0[0], v0[1]); w.y = cvt_pk_bf16(v0[2], v0[3]); w.z = cvt_pk_bf16(v1[0], v1[1]); w.w = cvt_pk_bf16(v1[2], v1[3]);
                    *(u32x4*)(rowp + bj * HALF) = w; } }
    }
};
struct EpiBf16Scale {
    static constexpr bool PERM = true, AFTER_DRAIN = false;
    bf16_t* O; int ldc; const float* rs;
    __device__ __forceinline__ void operator()(const f32x4 (&acc)[2][2][4][2], const Unit& u, int wr, int wc, int fr, int fq) const {
        const int row0 = u.pm * BM + wr * 64 + fr, col0 = u.pn * BM + wc * 32 + 8 * fq;
        float sc[2][4];
#pragma unroll
        for (int ai = 0; ai < 2; ++ai)
#pragma unroll
            for (int m = 0; m < 4; ++m) sc[ai][m] = rs[row0 + ai * HALF + m * 16];
#pragma unroll
        for (int ai = 0; ai < 2; ++ai)
#pragma unroll
            for (int m = 0; m < 4; ++m) { bf16_t* rowp = O + (size_t)(row0 + ai * HALF + m * 16) * ldc + col0; const float s_ = sc[ai][m];
#pragma unroll
                for (int bj = 0; bj < 2; ++bj) { const f32x4 v0 = acc[ai][bj][m][0] * s_, v1 = acc[ai][bj][m][1] * s_;
                    u32x4 w; w.x = cvt_pk_bf16(v0[0], v0[1]); w.y = cvt_pk_bf16(v0[2], v0[3]); w.z = cvt_pk_bf16(v1[0], v1[1]); w.w = cvt_pk_bf16(v1[2], v1[3]);
                    *(u32x4*)(rowp + bj * HALF) = w; } }
    }
};
template <bool RES_F32>
struct EpiBf16Res {
    static constexpr bool PERM = true, AFTER_DRAIN = false;
    bf16_t* O; const void* R; int ldc;
    __device__ __forceinline__ void operator()(const f32x4 (&acc)[2][2][4][2], const Unit& u, int wr, int wc, int fr, int fq) const {
        const int row0 = u.pm * BM + wr * 64 + fr, col0 = u.pn * BM + wc * 32 + 8 * fq;
#pragma unroll
        for (int ai = 0; ai < 2; ++ai)
#pragma unroll
            for (int m = 0; m < 4; ++m) { const size_t off = (size_t)(row0 + ai * HALF + m * 16) * ldc + col0;
#pragma unroll
                for (int bj = 0; bj < 2; ++bj) { f32x4 v0 = acc[ai][bj][m][0], v1 = acc[ai][bj][m][1];
                    if (RES_F32) { const float* rp = (const float*)R + off + bj * HALF; v0 += *(const f32x4*)rp; v1 += *(const f32x4*)(rp + 4); }
                    else { const u32x4 rw = *(const u32x4*)((const bf16_t*)R + off + bj * HALF);
                        v0[0] += __uint_as_float(rw.x << 16); v0[1] += __uint_as_float(rw.x & 0xffff0000u); v0[2] += __uint_as_float(rw.y << 16); v0[3] += __uint_as_float(rw.y & 0xffff0000u);
                        v1[0] += __uint_as_float(rw.z << 16); v1[1] += __uint_as_float(rw.z & 0xffff0000u); v1[2] += __uint_as_float(rw.w << 16); v1[3] += __uint_as_float(rw.w & 0xffff0000u); }
                    u32x4 w; w.x = cvt_pk_bf16(v0[0], v0[1]); w.y = cvt_pk_bf16(v0[2], v0[3]); w.z = cvt_pk_bf16(v1[0], v1[1]); w.w = cvt_pk_bf16(v1[2], v1[3]);
                    *(u32x4*)(O + off + bj * HALF) = w; } }
    }
};

template <class Epi, class Sched, bool ALIGN_EPI = false, bool SP2 = false>
__device__ __forceinline__ void gemm_phase(PG8_LAS unsigned char* lds, const Gemm g, const Sched& S, const Epi& E, int wave_id) {
    asm volatile("" : "+s"(wave_id));
    const int lane = fresh_lane(), wid = wave_id, tid = wid * 64 + lane, wr = wid >> 2, wc = wid & 3, fr = lane & 15, fq = lane >> 4;
    const int K = g.K, nt = K / BK;
    unsigned voffA[2], voffB[2];
#pragma unroll
    for (int i = 0; i < 2; ++i) { int R, C; stage_rc(tid * 16 + i * 8192, R, C); const int Rb = Epi::PERM ? ((R & ~31) + perm32(R & 31)) : R;
        voffA[i] = (unsigned)(R * K + C) * 2u; voffB[i] = (unsigned)(Rb * K + C) * 2u; }
    const size_t kstep = (size_t)(BK * 2);
    const size_t hstep = (size_t)HALF * K * 2;
    const size_t tstep = 2 * hstep;
    const unsigned ldsw = (unsigned)wid * 1024u;
    const int aoff = lds_byte(wr * 64 + fr, fq * 8), boff = lds_byte(wc * 32 + fr, fq * 8);
#define PG8_SA(b, h) (((b) * 2 + (h)) * HTB)
#define PG8_SB(b, h) ((4 + (b) * 2 + (h)) * HTB)
#define PG8_STAGE(bufoff, gbase, voff) do { _Pragma("unroll") for (int _i = 0; _i < 2; ++_i) \
        __builtin_amdgcn_global_load_lds((const unsigned*)((const char*)(gbase) + (voff)[_i]), (PG8_LAS unsigned*)(lds + (bufoff) + ldsw + _i * 8192), 16, 0, 0); } while (0)
#define PG8_LDA(dst, b, h) do { _Pragma("unroll") for (int m = 0; m < 4; ++m) _Pragma("unroll") for (int k = 0; k < 2; ++k) dst[m][k] = *(const PG8_LAS bf16x8*)(lds + PG8_SA(b, h) + aoff + m * 2048 + k * 1024); } while (0)
#define PG8_LDB(dst, b, h) do { _Pragma("unroll") for (int n = 0; n < 2; ++n) _Pragma("unroll") for (int k = 0; k < 2; ++k) dst[n][k] = *(const PG8_LAS bf16x8*)(lds + PG8_SB(b, h) + boff + n * 2048 + k * 1024); } while (0)
#define PG8_MMA(ai, bj, At, Bt) do { __builtin_amdgcn_s_setprio(1); _Pragma("unroll") for (int m = 0; m < 4; ++m) _Pragma("unroll") for (int n = 0; n < 2; ++n) _Pragma("unroll") for (int k = 0; k < 2; ++k) \
        acc[ai][bj][m][n] = __builtin_amdgcn_mfma_f32_16x16x32_bf16(Bt[n][k], At[m][k], acc[ai][bj][m][n], 0, 0, 0); __builtin_amdgcn_s_setprio(0); } while (0)
#define PG8_WAIT_V(n) asm volatile("s_waitcnt vmcnt(" #n ")" ::: "memory")
#define PG8_WAIT_L(n) asm volatile("s_waitcnt lgkmcnt(" #n ")" ::: "memory")
#define PG8_BAR __builtin_amdgcn_s_barrier()
#define PG8_SCHED __builtin_amdgcn_sched_barrier(0)
    Unit cur, nxt; int ui = 0;
    if (!S.next(0, cur)) return;
    f32x4 acc[2][2][4][2];
#pragma unroll
    for (int a = 0; a < 2; ++a)
#pragma unroll
        for (int b = 0; b < 2; ++b)
#pragma unroll
            for (int m = 0; m < 4; ++m)
#pragma unroll
                for (int n = 0; n < 2; ++n) acc[a][b][m][n] = (f32x4){0.f, 0.f, 0.f, 0.f};
    bf16x8 At[4][2], B0[2][2], B1[2][2];
    const char* cA = (const char*)g.A + (size_t)cur.pm * tstep; const char* cB = (const char*)g.Bt + (size_t)cur.pn * tstep;
    S.a_ready(cur);
    if constexpr (SP2) {
        PG8_STAGE(PG8_SB(0, 0), cB, voffB); PG8_STAGE(PG8_SB(0, 1), cB + hstep, voffB); PG8_STAGE(PG8_SA(0, 0), cA, voffA); PG8_STAGE(PG8_SA(0, 1), cA + hstep, voffA);
        if (wr == 1) PG8_BAR;
        PG8_WAIT_V(2); PG8_BAR;
        PG8_STAGE(PG8_SB(1, 0), cB + kstep, voffB); PG8_STAGE(PG8_SA(1, 0), cA + kstep, voffA); PG8_STAGE(PG8_SB(1, 1), cB + hstep + kstep, voffB);
        PG8_WAIT_V(6); PG8_BAR;
    } else {
        PG8_STAGE(PG8_SB(0, 0), cB, voffB); PG8_STAGE(PG8_SA(0, 0), cA, voffA); PG8_STAGE(PG8_SB(0, 1), cB + hstep, voffB); PG8_STAGE(PG8_SA(0, 1), cA + hstep, voffA);
        if (wr == 1) PG8_BAR;
        PG8_WAIT_V(4); PG8_BAR;
        PG8_STAGE(PG8_SB(1, 0), cB + kstep, voffB); PG8_STAGE(PG8_SA(1, 0), cA + kstep, voffA); PG8_STAGE(PG8_SB(1, 1), cB + hstep + kstep, voffB);
        PG8_WAIT_V(6); PG8_BAR;
    }
    for (;;) {
        const bool has_next = S.next(ui + 1, nxt);
        const char* nA = has_next ? (const char*)g.A + (size_t)nxt.pm * tstep : cA; const char* nB = has_next ? (const char*)g.Bt + (size_t)nxt.pn * tstep : cB;
        for (int t = 0; t < nt; t += 2) {
            const bool last = (t == nt - 2);
            const char* a1 = cA + (size_t)(t + 1) * kstep;
            const char* a2 = last ? nA : cA + (size_t)(t + 2) * kstep; const char* b2 = last ? nB : cB + (size_t)(t + 2) * kstep;
            const char* a3 = a2 + kstep; const char* b3 = b2 + kstep;
            if (last && has_next) S.a_ready(nxt);
            if constexpr (SP2) {
            PG8_LDB(B0, 0, 0); PG8_LDB(B1, 0, 1); PG8_SCHED; PG8_LDA(At, 0, 0); PG8_STAGE(PG8_SA(1, 1), a1 + hstep, voffA);
            PG8_WAIT_V(8); PG8_WAIT_L(0); PG8_BAR; PG8_MMA(0, 0, At, B0); PG8_MMA(0, 1, At, B1); PG8_BAR; PG8_SCHED;
            PG8_LDA(At, 0, 1); PG8_STAGE(PG8_SB(0, 0), b2, voffB); PG8_STAGE(PG8_SB(0, 1), b2 + hstep, voffB); PG8_STAGE(PG8_SA(0, 0), a2, voffA);
            PG8_WAIT_V(8); PG8_WAIT_L(0); PG8_BAR; PG8_MMA(1, 0, At, B0); PG8_MMA(1, 1, At, B1); PG8_BAR; PG8_SCHED;
            PG8_LDB(B0, 1, 0); PG8_LDB(B1, 1, 1); PG8_SCHED; PG8_LDA(At, 1, 0); PG8_STAGE(PG8_SA(0, 1), a2 + hstep, voffA);
            PG8_WAIT_V(8); PG8_WAIT_L(0); PG8_BAR; PG8_MMA(0, 0, At, B0); PG8_MMA(0, 1, At, B1); PG8_BAR; PG8_SCHED;
            PG8_LDA(At, 1, 1); PG8_STAGE(PG8_SB(1, 0), b3, voffB); PG8_STAGE(PG8_SB(1, 1), b3 + hstep, voffB); PG8_STAGE(PG8_SA(1, 0), a3, voffA);
            PG8_WAIT_V(8); PG8_WAIT_L(0); PG8_BAR; PG8_MMA(1, 0, At, B0); PG8_MMA(1, 1, At, B1); PG8_BAR; PG8_SCHED;
            } else {
            PG8_LDB(B0, 0, 0); PG8_SCHED; PG8_LDA(At, 0, 0); PG8_STAGE(PG8_SA(1, 1), a1 + hstep, voffA);
            PG8_WAIT_L(8); PG8_BAR; PG8_WAIT_L(0); PG8_MMA(0, 0, At, B0); PG8_BAR; PG8_SCHED;
            PG8_LDB(B1, 0, 1); PG8_STAGE(PG8_SB(0, 0), b2, voffB);
            PG8_BAR; PG8_WAIT_L(0); PG8_MMA(0, 1, At, B1); PG8_BAR;
            PG8_LDA(At, 0, 1); PG8_STAGE(PG8_SA(0, 0), a2, voffA);
            PG8_BAR; PG8_WAIT_L(0); PG8_MMA(1, 0, At, B0); PG8_BAR; PG8_SCHED;
            PG8_STAGE(PG8_SB(0, 1), b2 + hstep, voffB);
            PG8_WAIT_V(6); PG8_BAR; PG8_MMA(1, 1, At, B1); PG8_BAR;
            PG8_LDB(B0, 1, 0); PG8_SCHED; PG8_LDA(At, 1, 0); PG8_STAGE(PG8_SA(0, 1), a2 + hstep, voffA);
            PG8_WAIT_L(8); PG8_BAR; PG8_WAIT_L(0); PG8_MMA(0, 0, At, B0); PG8_BAR; PG8_SCHED;
            PG8_LDB(B1, 1, 1); PG8_STAGE(PG8_SB(1, 0), b3, voffB);
            PG8_BAR; PG8_WAIT_L(0); PG8_MMA(0, 1, At, B1); PG8_BAR;
            PG8_LDA(At, 1, 1); PG8_STAGE(PG8_SA(1, 0), a3, voffA);
            PG8_BAR; PG8_WAIT_L(0); PG8_MMA(1, 0, At, B0); PG8_BAR; PG8_SCHED;
            PG8_STAGE(PG8_SB(1, 1), b3 + hstep, voffB);
            PG8_WAIT_V(6); PG8_BAR; PG8_MMA(1, 1, At, B1); PG8_BAR;
            }
        }
        if constexpr (ALIGN_EPI) { if (wr == 0) PG8_BAR; }
        if constexpr (!Epi::AFTER_DRAIN) { E(acc, cur, wr, wc, fr, fq); S.done(cur); }
        if (!has_next) break;
#pragma unroll
        for (int a = 0; a < 2; ++a)
#pragma unroll
            for (int b = 0; b < 2; ++b)
#pragma unroll
                for (int m = 0; m < 4; ++m)
#pragma unroll
                    for (int n = 0; n < 2; ++n) acc[a][b][m][n] = (f32x4){0.f, 0.f, 0.f, 0.f};
        cur = nxt; cA = nA; cB = nB; ++ui;
        if constexpr (ALIGN_EPI) { if (wr == 1) PG8_BAR; }
    }
    PG8_WAIT_V(0);
    if constexpr (!ALIGN_EPI) { if (wr == 0) PG8_BAR; }
    PG8_BAR;
    if constexpr (Epi::AFTER_DRAIN) { E.fused(acc, cur, wr, wc, fr, fq, lds, wid, lane); S.done(cur); }
#undef PG8_SA
#undef PG8_SB
#undef PG8_STAGE
#undef PG8_LDA
#undef PG8_LDB
#undef PG8_MMA
#undef PG8_WAIT_V
#undef PG8_WAIT_L
#undef PG8_BAR
#undef PG8_SCHED
}

struct MUnit { int r0, rend, e, pn; };
#define MG_LANE_OFFS(u, o) do { const int _t = wid * 64 + fresh_lane(); _Pragma("unroll") for (int _i = 0; _i < 2; ++_i) { int _R, _C; stage_rc(_t * 16 + _i * 8192, _R, _C); _Pragma("unroll") for (int _h = 0; _h < 2; ++_h) { const int _r = (u).r0 + _h * HALF + _R; \
        int _row = _r; if (GATHER) { _row = 0; if (_r < (u).rend) _row = slot_tok[_r]; } (o)[_h][_i] = (unsigned)(_row * K + _C) * 2u; } } } while (0)
template <class Epi, class Sched, bool GATHER, int N, int K>
__device__ __forceinline__ void gemm_phase_moe(PG8_LAS unsigned char* lds, const bf16_t* A, const bf16_t* Bt, const int* slot_tok, const Sched& S, const Epi& E, int wave_id) {
    asm volatile("" : "+s"(wave_id));
    const int lane = fresh_lane(), wid = wave_id, tid = wid * 64 + lane, wr = wid >> 2, wc = wid & 3, fr = lane & 15, fq = lane >> 4;
    constexpr int nt = K / BK;
#define MG_OFFP(par) ((PG8_LAS unsigned*)(lds + STAGE_BYTES + 8192) + (par) * 2048 + tid)
#define MG_VOFFB ((PG8_LAS unsigned*)(lds + STAGE_BYTES + 24576) + tid)
#pragma unroll
    for (int i = 0; i < 2; ++i) { int R, C; stage_rc(tid * 16 + i * 8192, R, C); const int Rb = Epi::PERM ? ((R & ~31) + perm32(R & 31)) : R; MG_VOFFB[i * 512] = (unsigned)(Rb * K + C) * 2u; }
    constexpr size_t kstep = (size_t)(BK * 2);
    constexpr size_t hstep = (size_t)HALF * K * 2;
    constexpr size_t tstep = 2 * hstep;
    constexpr size_t estep = (size_t)N * K * 2;
    const unsigned ldsw = (unsigned)wid * 1024u;
    const int aoff = lds_byte(wr * 64 + fr, fq * 8), boff = lds_byte(wc * 32 + fr, fq * 8);
#define PG8_SA(b, h) (((b) * 2 + (h)) * HTB)
#define PG8_SB(b, h) ((4 + (b) * 2 + (h)) * HTB)
#define PG8_STAGE(bufoff, gbase, voff) do { _Pragma("unroll") for (int _i = 0; _i < 2; ++_i) \
        __builtin_amdgcn_global_load_lds((const unsigned*)((const char*)(gbase) + MG_VOFFB[_i * 512]), (PG8_LAS unsigned*)(lds + (bufoff) + ldsw + _i * 8192), 16, 0, 0); } while (0)
#define MG_STAGE_A(bufoff, par, h, kb) do { _Pragma("unroll") for (int _i = 0; _i < 2; ++_i) \
        __builtin_amdgcn_global_load_lds((const unsigned*)((const char*)A + (size_t)MG_OFFP(par)[((h) * 2 + _i) * 512] + (kb)), (PG8_LAS unsigned*)(lds + (bufoff) + ldsw + _i * 8192), 16, 0, 0); } while (0)
#define PG8_LDA(dst, b, h) do { _Pragma("unroll") for (int m = 0; m < 4; ++m) _Pragma("unroll") for (int k = 0; k < 2; ++k) dst[m][k] = *(const PG8_LAS bf16x8*)(lds + PG8_SA(b, h) + aoff + m * 2048 + k * 1024); } while (0)
#define PG8_LDB(dst, b, h) do { _Pragma("unroll") for (int n = 0; n < 2; ++n) _Pragma("unroll") for (int k = 0; k < 2; ++k) dst[n][k] = *(const PG8_LAS bf16x8*)(lds + PG8_SB(b, h) + boff + n * 2048 + k * 1024); } while (0)
#define PG8_MMA(ai, bj, At, Bt_) do { __builtin_amdgcn_s_setprio(1); _Pragma("unroll") for (int m = 0; m < 4; ++m) _Pragma("unroll") for (int n = 0; n < 2; ++n) _Pragma("unroll") for (int k = 0; k < 2; ++k) \
        acc[ai][bj][m][n] = __builtin_amdgcn_mfma_f32_16x16x32_bf16(Bt_[n][k], At[m][k], acc[ai][bj][m][n], 0, 0, 0); __builtin_amdgcn_s_setprio(0); } while (0)
#define PG8_WAIT_V(n) asm volatile("s_waitcnt vmcnt(" #n ")" ::: "memory")
#define PG8_WAIT_L(n) asm volatile("s_waitcnt lgkmcnt(" #n ")" ::: "memory")
#define PG8_BAR __builtin_amdgcn_s_barrier()
#define PG8_SCHED __builtin_amdgcn_sched_barrier(0)
    MUnit cur, nxt; int ui = 0;
    if (!S.next(0, cur)) return;
    f32x4 acc[2][2][4][2];
#pragma unroll
    for (int a = 0; a < 2; ++a)
#pragma unroll
        for (int b = 0; b < 2; ++b)
#pragma unroll
            for (int m = 0; m < 4; ++m)
#pragma unroll
                for (int n = 0; n < 2; ++n) acc[a][b][m][n] = (f32x4){0.f, 0.f, 0.f, 0.f};
    bf16x8 At[4][2], B0[2][2], B1[2][2];
    { unsigned o_[2][2]; MG_LANE_OFFS(cur, o_); PG8_LAS unsigned* p_ = MG_OFFP(0); p_[0] = o_[0][0]; p_[512] = o_[0][1]; p_[1024] = o_[1][0]; p_[1536] = o_[1][1]; }
    const char* cB = (const char*)Bt + (size_t)cur.e * estep + (size_t)cur.pn * tstep;
    PG8_STAGE(PG8_SB(0, 0), cB, voffB); PG8_STAGE(PG8_SB(0, 1), cB + hstep, voffB); MG_STAGE_A(PG8_SA(0, 0), 0, 0, 0); MG_STAGE_A(PG8_SA(0, 1), 0, 1, 0);
    if (wr == 1) PG8_BAR;
    PG8_WAIT_V(2); PG8_BAR;
    PG8_STAGE(PG8_SB(1, 0), cB + kstep, voffB); MG_STAGE_A(PG8_SA(1, 0), 0, 0, kstep); PG8_STAGE(PG8_SB(1, 1), cB + hstep + kstep, voffB);
    PG8_WAIT_V(6); PG8_BAR;
    for (;;) {
        const bool has_next = S.next(ui + 1, nxt);
        const bool hi_rows = (cur.rend - cur.r0) > HALF;
        const char* nB = cB;
        const int pc = ui & 1, pn_ = has_next ? (pc ^ 1) : pc;
        if (has_next) { unsigned on[2][2]; MG_LANE_OFFS(nxt, on); nB = (const char*)Bt + (size_t)nxt.e * estep + (size_t)nxt.pn * tstep;
            PG8_LAS unsigned* p_ = MG_OFFP(pn_); p_[0] = on[0][0]; p_[512] = on[0][1]; p_[1024] = on[1][0]; p_[1536] = on[1][1]; }
        for (int t = 0; t < nt; t += 2) {
            const bool last = (t == nt - 2);
            const size_t k1 = (size_t)(t + 1) * kstep, k2 = last ? (size_t)0 : (size_t)(t + 2) * kstep, k3 = k2 + kstep;
            const char* b2 = last ? nB : cB + (size_t)(t + 2) * kstep; const char* b3 = b2 + kstep;
            const int p2 = last ? pn_ : pc;
            PG8_LDB(B0, 0, 0); PG8_LDB(B1, 0, 1); PG8_SCHED; PG8_LDA(At, 0, 0); MG_STAGE_A(PG8_SA(1, 1), pc, 1, k1);
            PG8_WAIT_V(8); PG8_WAIT_L(0); PG8_BAR; PG8_MMA(0, 0, At, B0); PG8_MMA(0, 1, At, B1); PG8_BAR; PG8_SCHED;
            PG8_LDA(At, 0, 1); PG8_STAGE(PG8_SB(0, 0), b2, voffB); PG8_STAGE(PG8_SB(0, 1), b2 + hstep, voffB); MG_STAGE_A(PG8_SA(0, 0), p2, 0, k2);
            PG8_WAIT_V(8); PG8_WAIT_L(0); PG8_BAR; if (hi_rows) { PG8_MMA(1, 0, At, B0); PG8_MMA(1, 1, At, B1); } PG8_BAR; PG8_SCHED;
            PG8_LDB(B0, 1, 0); PG8_LDB(B1, 1, 1); PG8_SCHED; PG8_LDA(At, 1, 0); MG_STAGE_A(PG8_SA(0, 1), p2, 1, k2);
            PG8_WAIT_V(8); PG8_WAIT_L(0); PG8_BAR; PG8_MMA(0, 0, At, B0); PG8_MMA(0, 1, At, B1); PG8_BAR; PG8_SCHED;
            PG8_LDA(At, 1, 1); PG8_STAGE(PG8_SB(1, 0), b3, voffB); PG8_STAGE(PG8_SB(1, 1), b3 + hstep, voffB); MG_STAGE_A(PG8_SA(1, 0), p2, 0, k3);
            PG8_WAIT_V(8); PG8_WAIT_L(0); PG8_BAR; if (hi_rows) { PG8_MMA(1, 0, At, B0); PG8_MMA(1, 1, At, B1); } PG8_BAR; PG8_SCHED;
        }
        if (wr == 0) PG8_BAR;
        E(acc, cur, wr, wc, fr, fq);
        if (!has_next) break;
#pragma unroll
        for (int a = 0; a < 2; ++a)
#pragma unroll
            for (int b = 0; b < 2; ++b)
#pragma unroll
                for (int m = 0; m < 4; ++m)
#pragma unroll
                    for (int n = 0; n < 2; ++n) acc[a][b][m][n] = (f32x4){0.f, 0.f, 0.f, 0.f};
        cur = nxt; cB = nB; ++ui;
        if (wr == 1) PG8_BAR;
    }
    PG8_WAIT_V(0);
    PG8_BAR;
#undef PG8_SA
#undef PG8_SB
#undef PG8_STAGE
#undef MG_STAGE_A
#undef MG_OFFP
#undef MG_VOFFB
#undef PG8_LDA
#undef PG8_LDB
#undef PG8_MMA
#undef PG8_WAIT_V
#undef PG8_WAIT_L
#undef PG8_BAR
#undef PG8_SCHED
}
__device__ __forceinline__ float fast_silu(float x) { return x * __builtin_amdgcn_rcpf(1.0f + __builtin_amdgcn_exp2f(-1.4426950408889634f * x)); }
struct EpiMoeH {
    static constexpr bool PERM = true;
    bf16_t* H;
    __device__ __forceinline__ void operator()(const f32x4 (&acc)[2][2][4][2], const MUnit& u, int wr, int wc, int fr, int fq) const {
        { const int t_ = fresh_lane(); fr = t_ & 15; fq = t_ >> 4; }
        const int col0 = u.pn * 128 + wc * 32 + 8 * fq;
#pragma unroll
        for (int ai = 0; ai < 2; ++ai)
#pragma unroll
            for (int m = 0; m < 4; ++m) { const int r = u.r0 + ai * HALF + wr * 64 + m * 16 + fr;
                const f32x4 g0 = acc[ai][0][m][0], g1 = acc[ai][0][m][1], u0 = acc[ai][1][m][0], u1 = acc[ai][1][m][1];
                u32x4 w; w.x = cvt_pk_bf16(fast_silu(g0[0]) * u0[0], fast_silu(g0[1]) * u0[1]); w.y = cvt_pk_bf16(fast_silu(g0[2]) * u0[2], fast_silu(g0[3]) * u0[3]);
                w.z = cvt_pk_bf16(fast_silu(g1[0]) * u1[0], fast_silu(g1[1]) * u1[1]); w.w = cvt_pk_bf16(fast_silu(g1[2]) * u1[2], fast_silu(g1[3]) * u1[3]);
                if (r < u.rend) *(u32x4*)(H + (size_t)r * 256 + col0) = w; }
    }
};
struct EpiMoeY {
    static constexpr bool PERM = true;
    bf16_t* Y;
    __device__ __forceinline__ void operator()(const f32x4 (&acc)[2][2][4][2], const MUnit& u, int wr, int wc, int fr, int fq) const {
        { const int t_ = fresh_lane(); fr = t_ & 15; fq = t_ >> 4; }
        const int col0 = u.pn * BM + wc * 32 + 8 * fq;
#pragma unroll
        for (int ai = 0; ai < 2; ++ai)
#pragma unroll
            for (int m = 0; m < 4; ++m) { const int r = u.r0 + ai * HALF + wr * 64 + m * 16 + fr;
#pragma unroll
                for (int bj = 0; bj < 2; ++bj) { const f32x4 v0 = acc[ai][bj][m][0], v1 = acc[ai][bj][m][1];
                    u32x4 w; w.x = cvt_pk_bf16(v0[0], v0[1]); w.y = cvt_pk_bf16(v0[2], v0[3]); w.z = cvt_pk_bf16(v1[0], v1[1]); w.w = cvt_pk_bf16(v1[2], v1[3]);
                    if (r < u.rend) *(u32x4*)(Y + (size_t)r * 1024 + col0 + bj * HALF) = w; } }
    }
};
struct MoeSched {
    const PG8_LAS int* tab;
    int npn, first, end, stride, c, split;
    __device__ __forceinline__ bool next(int i, MUnit& u) const {
        int L = first + c + i * stride;
        if (c < 0 || L >= end) return false;
        const int half = split ? (L & 1) : 0; if (split) L >>= 1;
        const int j = L / npn; u.pn = L % npn;
        u.e = __builtin_amdgcn_readfirstlane(tab[4 + 4 * j]); u.r0 = __builtin_amdgcn_readfirstlane(tab[5 + 4 * j]); u.rend = __builtin_amdgcn_readfirstlane(tab[6 + 4 * j]);
        if (split) { u.r0 += HALF * half; const int cap = u.r0 + HALF; u.rend = u.rend < cap ? u.rend : cap; }
        return true;
    }
};
}

#ifndef PG8_SP2
#define PG8_SP2 true
#endif
#ifndef PG8_ALIGN
#define PG8_ALIGN true
#endif

constexpr int NWAVES = 8, NT = NWAVES * 64;
constexpr int D = 1024, NB = 2, S = 8192, T = NB * S, DEPTH = 2;
constexpr int DIN = 2832, PLD = 3072;
constexpr int C_Q = 0, C_K = 256, C_V = 512, C_G = 1024, C_GK = 1536, C_U = 1552, C_VG = 1808, C_XI = 2064, C_BG = 2320, C_CG = 2576;
constexpr int GH = 4, GC = 64, GN = S / GC;
constexpr int MH = 4, MC = 128, MN = S / MC;
constexpr int NE = 32, DE = 256;
constexpr float EPS = 1e-6f;
constexpr size_t MiB = 1u << 20;
constexpr size_t WS_CTL = 0, CTL_BYTES = 1 * MiB;
constexpr size_t WS_WIN = 1 * MiB;
constexpr size_t WS_WOUT = 13 * MiB;
constexpr size_t WS_WGU = 17 * MiB;
constexpr size_t WS_WD = 81 * MiB;
constexpr size_t WS_XN = 113 * MiB;
constexpr size_t WS_P = 145 * MiB;
constexpr size_t WS_Y = WS_P + 17 * MiB;
constexpr size_t WS_S = 276 * MiB;
constexpr size_t WS_XRES = 241 * MiB;
constexpr size_t WS_DEC = 273 * MiB;
constexpr size_t WS_MISC = 274 * MiB;
constexpr size_t WS_WSP = WS_MISC + 524288;
constexpr size_t WS_RINV1 = WS_MISC + 786432, WS_RINV2 = WS_RINV1 + 65536, WS_SRINV = WS_RINV2 + 65536;
constexpr size_t WS_WR = 275 * MiB;
constexpr size_t WS_BLKCNT = WS_WR + 524288;
constexpr size_t WS_END = 284 * MiB;
constexpr int CW_BAR = 4096, CW_CNT = 16384;
constexpr int RING_BYTES = 131072, LDSCTL_OFF = RING_BYTES, MISC_OFF = LDSCTL_OFF + 320, LDS_BYTES = 163840;

#define GAS __attribute__((address_space(1)))
#define LAS __attribute__((address_space(3)))
typedef unsigned short bf16;
typedef unsigned v4u __attribute__((ext_vector_type(4)));
typedef unsigned v2u __attribute__((ext_vector_type(2)));
typedef float f32x4 __attribute__((ext_vector_type(4)));
typedef __bf16 bf16x2_t __attribute__((ext_vector_type(2)));
typedef float f32x2_t __attribute__((ext_vector_type(2)));
__device__ __forceinline__ unsigned f2bf(float f) { return (unsigned)__builtin_bit_cast(unsigned short, (__bf16)f); }
__device__ __forceinline__ unsigned pk2(float lo, float hi) { f32x2_t v = {lo, hi}; bf16x2_t b = __builtin_convertvector(v, bf16x2_t); return __builtin_bit_cast(unsigned, b); }
__device__ __forceinline__ float bf2f(unsigned v) { return __uint_as_float(v << 16); }
__device__ __forceinline__ float bflo(unsigned w) { return __uint_as_float(w << 16); }
__device__ __forceinline__ float bfhi(unsigned w) { return __uint_as_float(w & 0xffff0000u); }
__device__ __forceinline__ void unpack8(const v4u q, float (&f)[8]) { f[0] = bflo(q.x); f[1] = bfhi(q.x); f[2] = bflo(q.y); f[3] = bfhi(q.y); f[4] = bflo(q.z); f[5] = bfhi(q.z); f[6] = bflo(q.w); f[7] = bfhi(q.w); }
__device__ __forceinline__ float gelu_tanh(float x) { const float u = 0.7978845608028654f * (x + 0.044715f * x * x * x); return 0.5f * x * (1.0f + tanhf(u)); }
__device__ __forceinline__ float silu(float x) { return x / (1.0f + expf(-x)); }
__device__ __forceinline__ float log_sigmoid(float x) { return fminf(x, 0.f) - log1pf(expf(-fabsf(x))); }

#define XB_TMO      128
#define XB_XCNT(j)  (256  + 64 * (j))
#define XB_XSUB(j)  (1280 + 64 * (j))
#define XB_XGEN(j)  (2304 + 64 * (j))
#define XB_TOP      3328
#define XB_TOPGEN   3392
#define XCD_BAR_WORDS 3456
#define XB_SPIN_CAP (1u << 18)

__device__ __forceinline__ unsigned xb_ld(unsigned* p)              { return __hip_atomic_load(p, __ATOMIC_RELAXED, __HIP_MEMORY_SCOPE_AGENT); }
__device__ __forceinline__ unsigned xb_add(unsigned* p, unsigned v) { return __hip_atomic_fetch_add(p, v, __ATOMIC_RELAXED, __HIP_MEMORY_SCOPE_AGENT); }
__device__ __forceinline__ unsigned xb_xcc_id() { return (unsigned)__builtin_amdgcn_s_getreg((3 << 11) | 20) & 0xFu; }
#define XB_SPIN(cond, bar) do { unsigned _sp = 0; while (cond) { __builtin_amdgcn_s_sleep(1); \
    if ((++_sp & 255u) == 0u) { if (xb_ld(&(bar)[XB_TMO])) break; if (_sp > XB_SPIN_CAP) { atomicAdd(&(bar)[XB_TMO], 1u); break; } } } } while (0)

struct XcdBarrier {
    int wave;
    unsigned* bar; unsigned x;
    volatile LAS unsigned* st;
};

__device__ __forceinline__ XcdBarrier xcd_barrier_post(unsigned* bar, volatile LAS unsigned* st) {
    XcdBarrier b; b.bar = bar; b.x = xb_xcc_id(); b.st = st; b.wave = __builtin_amdgcn_readfirstlane(threadIdx.x >> 6);
    if (threadIdx.x == 0) (void)xb_add(&bar[XB_XCNT(b.x)], 1u);
    return b;
}
__device__ __forceinline__ void xcd_barrier_complete(unsigned* bar, unsigned x, unsigned& nloc, unsigned& nx) {
    const unsigned G = gridDim.x * gridDim.y * gridDim.z;
    unsigned sum, cnt, mine, sp = 0u;
    for (;;) {
        sum = 0u; cnt = 0u; mine = 0u;
#pragma unroll
        for (unsigned j = 0; j < 16; ++j) { const unsigned c = xb_ld(&bar[XB_XCNT(j)]); sum += c; cnt += (c > 0u) ? 1u : 0u; mine = (j == x) ? c : mine; }
        if (sum == G) break;
        __builtin_amdgcn_s_sleep(1);
        if ((++sp & 255u) == 0u) { if (xb_ld(&bar[XB_TMO])) break; if (sp > XB_SPIN_CAP) { atomicAdd(&bar[XB_TMO], 1u); break; } }
    }
    nloc = mine > 0u ? mine : 1u; nx = cnt > 0u ? cnt : 1u;
}

__device__ __forceinline__ void xcd_barrier(const XcdBarrier& b) {
    asm volatile("s_waitcnt vmcnt(0)" ::: "memory");
    __syncthreads();
    if (b.wave == 0 && fresh_lane() == 0) {
        unsigned* bar = b.bar; asm volatile("" : "+s"(bar));
        __builtin_amdgcn_s_waitcnt(0);
        unsigned nloc = b.st[0], nx = b.st[1];
        if (nloc == 0u) { xcd_barrier_complete(bar, b.x, nloc, nx); b.st[0] = nloc; b.st[1] = nx; }
        const unsigned old = xb_add(&bar[XB_XSUB(b.x)], 1u);
        const unsigned gen = old / nloc;
        if (old + 1u == (gen + 1u) * nloc) {
            __builtin_amdgcn_fence(__ATOMIC_RELEASE, "agent");
            asm volatile("s_waitcnt vmcnt(0)" ::: "memory");
            const unsigned og = xb_add(&bar[XB_TOP], 1u);
            const unsigned tg = og / nx;
            if (og + 1u == (tg + 1u) * nx) xb_add(&bar[XB_TOPGEN], 1u);
            else XB_SPIN(xb_ld(&bar[XB_TOPGEN]) == tg, bar);
            __builtin_amdgcn_fence(__ATOMIC_ACQUIRE, "agent");
            xb_add(&bar[XB_XGEN(b.x)], 1u);
            asm volatile("s_waitcnt vmcnt(0)" ::: "memory");
        } else {
            XB_SPIN(xb_ld(&bar[XB_XGEN(b.x)]) == gen, bar);
            __builtin_amdgcn_fence(__ATOMIC_ACQUIRE, "agent");
            asm volatile("s_waitcnt vmcnt(0)" ::: "memory");
        }
    }
    __syncthreads();
}

#define AS4 __attribute__((address_space(4)))
struct KA {
    const AS4 char* ka;
    static __device__ __forceinline__ KA fresh() { KA k; k.ka = (const AS4 char*)__builtin_amdgcn_kernarg_segment_ptr(); asm volatile("" : "+s"(k.ka)); return k; }
    __device__ __forceinline__ const float* in(int i) const { return *(const float* const AS4*)(ka + 8 * i); }
    __device__ __forceinline__ float* out() const { return *(float* const AS4*)(ka + 160); }
    __device__ __forceinline__ unsigned char* ws() const { return *(unsigned char* const AS4*)(ka + 168); }
    __device__ __forceinline__ unsigned* ctl() const { return (unsigned*)(ws() + WS_CTL); }
    __device__ __forceinline__ bf16* WinT() const { return (bf16*)(ws() + WS_WIN); }
    __device__ __forceinline__ bf16* WoutT() const { return (bf16*)(ws() + WS_WOUT); }
    __device__ __forceinline__ bf16* WguT() const { return (bf16*)(ws() + WS_WGU); }
    __device__ __forceinline__ bf16* WdT() const { return (bf16*)(ws() + WS_WD); }
    __device__ __forceinline__ bf16* XN() const { return (bf16*)(ws() + WS_XN); }
    __device__ __forceinline__ bf16* P() const { return (bf16*)(ws() + WS_P); }
    __device__ __forceinline__ bf16* H1() const { return (bf16*)(ws() + WS_P); }
    __device__ __forceinline__ bf16* Y() const { return (bf16*)(ws() + WS_Y); }
    __device__ __forceinline__ float* Sst() const { return (float*)(ws() + WS_S); }
    __device__ __forceinline__ float* dec() const { return (float*)(ws() + WS_DEC); }
    __device__ __forceinline__ int* eid() const { return (int*)(ws() + WS_MISC); }
    __device__ __forceinline__ float* ew() const { return (float*)(ws() + WS_MISC + 131072); }
    __device__ __forceinline__ int* slot_tok() const { return (int*)(ws() + WS_MISC + 2 * 131072); }
    __device__ __forceinline__ int* slot_of() const { return (int*)(ws() + WS_MISC + 3 * 131072); }
    __device__ __forceinline__ bf16* Wsp() const { return (bf16*)(ws() + WS_WSP); }
    __device__ __forceinline__ bf16* Wr() const { return (bf16*)(ws() + WS_WR); }
    __device__ __forceinline__ bf16* XR() const { return (bf16*)(ws() + WS_XRES); }
    __device__ __forceinline__ int* blkcnt() const { return (int*)(ws() + WS_BLKCNT); }
    __device__ __forceinline__ float* rinv1() const { return (float*)(ws() + WS_RINV1); }
    __device__ __forceinline__ float* rinv2() const { return (float*)(ws() + WS_RINV2); }
    __device__ __forceinline__ float* srinv() const { return (float*)(ws() + WS_SRINV); }
};
struct Frame {
    LAS unsigned char* lds; float* smem;
    int G, bx, wave;
};
#define PHASE_TID const int lane = fresh_lane(), wave = F.wave, tid = wave * 64 + lane; (void)lane; (void)wave; (void)tid

__device__ __forceinline__ float wave_sum(float v) {
    v = sum16(v);
    const int iv = __float_as_int(v);
    return (__int_as_float(__builtin_amdgcn_readlane(iv, 0)) + __int_as_float(__builtin_amdgcn_readlane(iv, 16))) + (__int_as_float(__builtin_amdgcn_readlane(iv, 32)) + __int_as_float(__builtin_amdgcn_readlane(iv, 48)));
}

struct TrItem { const float* W; bf16* WT; int ldw, nvalid, k0, n0, ldt, drow0; const float* gain; };
__device__ __forceinline__ void transpose_load(const TrItem& t, int lane, f32x4 (&v)[8]) {
    const int sub = lane >> 3, c4 = (lane & 7) * 4;
#pragma unroll
    for (int i = 0; i < 8; ++i) v[i] = (c4 < t.nvalid) ? __builtin_nontemporal_load((const f32x4*)(t.W + (size_t)(t.k0 + 8 * i + sub) * t.ldw + t.n0 + c4)) : (f32x4){0.f, 0.f, 0.f, 0.f};
    if (t.gain) {
#pragma unroll
        for (int i = 0; i < 8; ++i) v[i] *= t.gain[t.k0 + 8 * i + sub]; }
}
__device__ __forceinline__ void transpose_store(const TrItem& t, int lane, const f32x4 (&v)[8], LAS float* scr) {
    const int sub = lane >> 3, c4 = (lane & 7) * 4;
#pragma unroll
    for (int i = 0; i < 8; ++i) { LAS float* d = scr + (8 * i + sub) * 33 + c4; d[0] = v[i].x; d[1] = v[i].y; d[2] = v[i].z; d[3] = v[i].w; }
    asm volatile("s_waitcnt lgkmcnt(0)" ::: "memory");
    const int c = lane & 7;
#pragma unroll
    for (int j = 0; j < 4; ++j) { const int n = (lane >> 3) + 8 * j; const LAS float* s = scr + (8 * c) * 33 + n;
        v4u o; o.x = pk2(s[0 * 33], s[1 * 33]); o.y = pk2(s[2 * 33], s[3 * 33]); o.z = pk2(s[4 * 33], s[5 * 33]); o.w = pk2(s[6 * 33], s[7 * 33]);
        if (n < t.nvalid) *(GAS v4u*)(t.WT + (size_t)(t.drow0 + n) * t.ldt + t.k0 + 8 * c) = o; }
    asm volatile("s_waitcnt lgkmcnt(0)" ::: "memory");
}
__device__ __forceinline__ void p0_prologue(Frame& F) {
    const KA K = KA::fresh(); PHASE_TID;
    LAS float* scr = (LAS float*)(F.lds + wave * 16384);
    const int gw = F.bx * NWAVES + wave, NGW = F.G * NWAVES;
    constexpr int I_IN = 16 * 89, I_OUT = 16 * 32, I_G = 32 * 16 * 8, I_D = 32 * 4 * 32, I_L = I_IN + I_OUT + 2 * I_G + I_D;
#define TR_DECODE(it_, t_) do { const int l_ = (it_) / I_L; int r_ = (it_) % I_L; \
        if (r_ < I_IN) { const int kb = r_ / 89, nb = r_ % 89; t_ = TrItem{K.in(2) + (size_t)l_ * D * DIN, K.WinT() + (size_t)l_ * PLD * D, DIN, (nb == 88) ? 16 : 32, kb * 64, nb * 32, D, nb * 32, K.in(1) + (size_t)l_ * D}; } \
        else if (r_ < I_IN + I_OUT) { r_ -= I_IN; const int kb = r_ / 32, nb = r_ % 32; t_ = TrItem{K.in(10) + (size_t)l_ * D * D, K.WoutT() + (size_t)l_ * D * D, D, 32, kb * 64, nb * 32, D, nb * 32, nullptr}; } \
        else if (r_ < I_IN + I_OUT + 2 * I_G) { r_ -= I_IN + I_OUT; const int sel = r_ / I_G; r_ %= I_G; const int e = r_ / 128, kb = (r_ % 128) / 8, n0 = (r_ % 8) * 32; \
            t_ = TrItem{K.in(16 + sel) + ((size_t)l_ * NE + e) * D * DE, K.WguT() + ((size_t)l_ * NE + e) * 512 * D, DE, 32, kb * 64, n0, D, (n0 >> 7) * 256 + sel * 128 + (n0 & 127), nullptr}; } \
        else { r_ -= I_IN + I_OUT + 2 * I_G; const int e = r_ / 128, kb = (r_ % 128) / 32, nb = r_ % 32; t_ = TrItem{K.in(18) + ((size_t)l_ * NE + e) * DE * D, K.WdT() + ((size_t)l_ * NE + e) * D * DE, D, 32, kb * 64, nb * 32, DE, nb * 32, nullptr}; } } while (0)
    {
        TrItem cur, nxt; f32x4 vc[8], vn[8];
        int it = gw;
        if (it < DEPTH * I_L) { TR_DECODE(it, cur); transpose_load(cur, lane, vc); }
#pragma unroll 1
        for (; it < DEPTH * I_L; it += NGW) {
            const bool more = it + NGW < DEPTH * I_L;
            if (more) { TR_DECODE(it + NGW, nxt); transpose_load(nxt, lane, vn); }
            transpose_store(cur, lane, vc, scr);
            cur = nxt;
#pragma unroll
            for (int i = 0; i < 8; ++i) vc[i] = vn[i];
        }
    }
#undef TR_DECODE
    for (int i = F.bx * NT + tid; i < DEPTH * 240 * 128; i += F.G * NT) { const int l = i / (240 * 128), rr = (i / 128) % 240, c = i % 128;
        *(GAS v4u*)(K.WinT() + ((size_t)l * PLD + DIN + rr) * D + c * 8) = (v4u){0u, 0u, 0u, 0u}; }
    for (int i = F.bx * NT + tid; i < DEPTH * 48 * D; i += F.G * NT) { const int ll = i / (48 * D), n = (i / D) % 48, k = i % D;
        float w = 0.f;
        if (n < 4) w = K.in(12)[((size_t)ll * D + k) * 4 + n]; else if (n < 36) w = K.in(14)[((size_t)ll * D + k) * 32 + (n - 4)];
        w *= K.in(11)[(size_t)ll * D + k];
        const unsigned hi = f2bf(w), lo = f2bf(w - bf2f(hi));
        K.Wr()[((size_t)ll * 2 + 0) * 48 * D + (size_t)n * D + k] = (bf16)hi; K.Wr()[((size_t)ll * 2 + 1) * 48 * D + (size_t)n * D + k] = (bf16)lo; }
    for (int i = F.bx * NT + tid; i < DEPTH * MH * 128 * 128 / 8; i += F.G * NT) { const int e0 = i * 8, s0 = e0 & 127, t = (e0 >> 7) & 127;
        const f32x4 a = *(const f32x4*)(K.in(7) + e0), c = *(const f32x4*)(K.in(7) + e0 + 4);
        const float v[8] = {a.x, a.y, a.z, a.w, c.x, c.y, c.z, c.w}; unsigned w[4];
#pragma unroll
        for (int j = 0; j < 4; ++j) w[j] = pk2((s0 + 2 * j <= t) ? v[2 * j] : 0.f, (s0 + 2 * j + 1 <= t) ? v[2 * j + 1] : 0.f);
        *(GAS v4u*)(K.Wsp() + e0) = (v4u){w[0], w[1], w[2], w[3]}; }
    {
        f32x4 v[4], vn[4];
        int m = gw;
        if (m < T) {
#pragma unroll
            for (int j = 0; j < 4; ++j) v[j] = __builtin_nontemporal_load((const f32x4*)(K.in(0) + (size_t)m * D) + lane + 64 * j); }
#pragma unroll 1
        for (; m < T; m += NGW) {
            if (m + NGW < T) {
#pragma unroll
                for (int j = 0; j < 4; ++j) vn[j] = __builtin_nontemporal_load((const f32x4*)(K.in(0) + (size_t)(m + NGW) * D) + lane + 64 * j); }
            float s_ = 0.f;
#pragma unroll
            for (int j = 0; j < 4; ++j) s_ += (v[j].x * v[j].x + v[j].y * v[j].y) + (v[j].z * v[j].z + v[j].w * v[j].w);
            const float rs = rsqrtf(wave_sum(s_) * (1.f / D) + EPS);
            v2u* r8 = (v2u*)(K.XR() + (size_t)m * D) + lane;
            if (lane == 0) K.rinv1()[m] = rs;
#pragma unroll
            for (int j = 0; j < 4; ++j) { r8[64 * j] = (v2u){pk2(v[j].x, v[j].y), pk2(v[j].z, v[j].w)}; v[j] = vn[j]; }
        }
    }
}

typedef short bf16x8 __attribute__((ext_vector_type(8)));
__device__ __forceinline__ float fexp(float x) { return __builtin_amdgcn_exp2f(x * 1.4426950408889634f); }
__device__ __forceinline__ float logsig_fast(float x) { return fminf(x, 0.f) - __log2f(1.0f + fexp(-fabsf(x))) * 0.6931471805599453f; }
__device__ __forceinline__ float silu_fast(float x) { return x * __builtin_amdgcn_rcpf(1.0f + __builtin_amdgcn_exp2f(-1.4426950408889634f * x)); }
__device__ __forceinline__ float gelu_fast(float x) { const float u = 0.7978845608028654f * (x + 0.044715f * x * x * x); return x * __builtin_amdgcn_rcpf(1.0f + __builtin_amdgcn_exp2f(-2.8853900817779268f * u)); }
__device__ __forceinline__ f32x4 mfma16(bf16x8 a, bf16x8 b, f32x4 c) { return __builtin_amdgcn_mfma_f32_16x16x32_bf16(a, b, c, 0, 0, 0); }
constexpr int LROWB = 144;
constexpr int L_QD = 0, L_KI = 9216, L_KDT = 18432, L_VT = 27648, L_S = 46080, L_ST = 55296, L_OB = 73728, L_TOT = 107520, OBROW = 528;
#define FRAG(base, row, kel) (*(const LAS bf16x8*)(lds + (base) + (row) * LROWB + (kel) * 2))

constexpr int L_GKL = 109568, L_BL = 117760, SCN = 4, NSC = GN / SCN, NITEM = NB * GH * NSC;
#define FRAG(base, row, kel) (*(const LAS bf16x8*)(lds + (base) + (row) * LROWB + (kel) * 2))
struct GlaPre { unsigned short k[8], q[8], v[16]; v4u g0, g1; };
template <bool WITH_Q>
__device__ __forceinline__ void gla_prefetch(GlaPre& p, const bf16* P, int h, int t0, int tid, int lane, int wave) {
    const bf16* kp = P + (size_t)(t0 + 8 * wave) * PLD + C_K + h * 64 + lane;
#pragma unroll
    for (int j = 0; j < 8; ++j) p.k[j] = kp[(size_t)j * PLD];
    const int vv = tid & 127, cq = tid >> 7;
    const bf16* vp = P + (size_t)(t0 + 16 * cq) * PLD + C_V + h * 128 + vv;
#pragma unroll
    for (int j = 0; j < 16; ++j) p.v[j] = vp[(size_t)j * PLD];
    if (WITH_Q) {
        const bf16* qp = kp + (C_Q - C_K);
#pragma unroll
        for (int j = 0; j < 8; ++j) p.q[j] = qp[(size_t)j * PLD];
        const v4u* gr = (const v4u*)(P + (size_t)(t0 + (tid >> 3)) * PLD + C_G + h * 128 + 16 * (tid & 7));
        p.g0 = gr[0]; p.g1 = gr[1];
    }
}
__device__ __forceinline__ void gla_stage_gkl(const bf16* P, LAS unsigned char* lds, int tok0, int tid) {
    *(LAS v4u*)(lds + L_GKL + tid * 16) = *(const v4u*)(P + (size_t)(tok0 + (tid >> 1)) * PLD + C_GK + 8 * (tid & 1));
}
__device__ __forceinline__ void gla_b8_part(LAS unsigned char* lds, const float (&wu)[16], float bg, int n, int lane, int wave, float (&bv)[8]) {
    float run = 0.f;
#pragma unroll
    for (int j = 0; j < 8; ++j) {
        const LAS v4u* gl = (const LAS v4u*)(lds + L_GKL + (n * 64 + 8 * wave + j) * 32);
        float f0[8], f1[8]; unpack8(gl[0], f0); unpack8(gl[1], f1);
        float a = bg;
#pragma unroll
        for (int r = 0; r < 8; ++r) a += f0[r] * wu[r];
#pragma unroll
        for (int r = 0; r < 8; ++r) a += f1[r] * wu[8 + r];
        run += logsig_fast(a) * (1.0f / 16.0f); bv[j] = run;
    }
    ((LAS float*)(lds + L_TOT))[wave * 64 + lane] = run;
}
__device__ __forceinline__ float gla_b8_finish(LAS unsigned char* lds, int lane, int wave, float (&bv)[8]) {
    const LAS float* tot = (const LAS float*)(lds + L_TOT);
    float base = 0.f, all = 0.f;
#pragma unroll
    for (int g = 0; g < 8; ++g) { const float tv = tot[g * 64 + lane]; all += tv; if (g < wave) base += tv; }
#pragma unroll
    for (int j = 0; j < 8; ++j) bv[j] += base;
    return all;
}
__device__ __forceinline__ void gla_write_kdT_vT(LAS unsigned char* lds, const GlaPre& p, const float (&bv)[8], float bl, int tid, int lane, int wave) {
    float kd[8];
#pragma unroll
    for (int j = 0; j < 8; ++j) kd[j] = bf2f(p.k[j]) * fexp(bl - bv[j]);
    *(LAS v4u*)(lds + L_KDT + lane * LROWB + wave * 16) = (v4u){pk2(kd[0], kd[1]), pk2(kd[2], kd[3]), pk2(kd[4], kd[5]), pk2(kd[6], kd[7])};
    const int vv = tid & 127, cq = tid >> 7;
    LAS v4u* dst = (LAS v4u*)(lds + L_VT + vv * LROWB + cq * 32);
    dst[0] = (v4u){(unsigned)p.v[0] | ((unsigned)p.v[1] << 16), (unsigned)p.v[2] | ((unsigned)p.v[3] << 16), (unsigned)p.v[4] | ((unsigned)p.v[5] << 16), (unsigned)p.v[6] | ((unsigned)p.v[7] << 16)};
    dst[1] = (v4u){(unsigned)p.v[8] | ((unsigned)p.v[9] << 16), (unsigned)p.v[10] | ((unsigned)p.v[11] << 16), (unsigned)p.v[12] | ((unsigned)p.v[13] << 16), (unsigned)p.v[14] | ((unsigned)p.v[15] << 16)};
    if (wave == 0) ((LAS float*)(lds + L_BL))[lane] = bl;
}
__device__ __forceinline__ void gla_kv_mfma(LAS unsigned char* lds, int wave, int fr, int fq, f32x4 (&acc)[4]) {
    bf16x8 Bf[2];
#pragma unroll
    for (int ks = 0; ks < 2; ++ks) Bf[ks] = FRAG(L_VT, 16 * wave + fr, 32 * ks + 8 * fq);
#pragma unroll
    for (int dt = 0; dt < 4; ++dt) { acc[dt] = (f32x4){0.f, 0.f, 0.f, 0.f};
#pragma unroll
        for (int ks = 0; ks < 2; ++ks) acc[dt] = mfma16(FRAG(L_KDT, 16 * dt + fr, 32 * ks + 8 * fq), Bf[ks], acc[dt]); }
}

__device__ __forceinline__ void phase_gla_A2(Frame& F, int l) {
    const KA K = KA::fresh(); PHASE_TID;
    LAS unsigned char* lds = F.lds;
    const int fr = lane & 15, fq = lane >> 4;
#pragma unroll 1
    for (int it = F.bx; it < NITEM; it += F.G) {
        const int b = it / (GH * NSC), h = (it / NSC) % GH, sc = it % NSC, tok0 = b * S + sc * SCN * GC;
        const bf16* P = K.P();
        float wu[16];
        { const float* wup = K.in(3) + (size_t)l * 16 * 256 + h * 64 + lane;
#pragma unroll
          for (int r = 0; r < 16; ++r) wu[r] = wup[r * 256]; }
        const float bg = K.in(4)[l * 256 + h * 64 + lane];
        GlaPre pre[2]; gla_prefetch<false>(pre[0], P, h, tok0, tid, lane, wave); gla_prefetch<false>(pre[1], P, h, tok0 + GC, tid, lane, wave);
        __syncthreads();
        gla_stage_gkl(P, lds, tok0, tid);
        __syncthreads();
        f32x4 Sl[4], bs[4];
#pragma unroll
        for (int dt = 0; dt < 4; ++dt) { Sl[dt] = (f32x4){0.f, 0.f, 0.f, 0.f}; bs[dt] = (f32x4){0.f, 0.f, 0.f, 0.f}; }
#pragma unroll
        for (int n = 0; n < SCN; ++n) {
            float bv[8]; gla_b8_part(lds, wu, bg, n, lane, wave, bv);
            __syncthreads();
            const float bl = gla_b8_finish(lds, lane, wave, bv);
            gla_write_kdT_vT(lds, pre[n & 1], bv, bl, tid, lane, wave);
            if (n + 2 < SCN) gla_prefetch<false>(pre[n & 1], P, h, tok0 + (n + 2) * GC, tid, lane, wave);
            __syncthreads();
            f32x4 acc[4]; gla_kv_mfma(lds, wave, fr, fq, acc);
#pragma unroll
            for (int dt = 0; dt < 4; ++dt) { const f32x4 bl4 = *(const LAS f32x4*)(lds + L_BL + (16 * dt + 4 * fq) * 4);
                bs[dt] = bs[dt] + bl4;
#pragma unroll
                for (int r = 0; r < 4; ++r) Sl[dt][r] = fexp(bl4[r]) * Sl[dt][r] + acc[dt][r]; }
        }
        f32x4* ag = (f32x4*)K.Sst() + ((size_t)(it * 8 + wave) * 4) * 64 + lane;
#pragma unroll
        for (int dt = 0; dt < 4; ++dt) ag[dt * 64] = Sl[dt];
        if (wave == 0 && fr == 0) { f32x4* dp = (f32x4*)K.dec() + (size_t)it * 16 + fq;
#pragma unroll
            for (int dt = 0; dt < 4; ++dt) dp[dt * 4] = (f32x4){fexp(bs[dt][0]), fexp(bs[dt][1]), fexp(bs[dt][2]), fexp(bs[dt][3])}; }
    }
}


__device__ __forceinline__ void phase_gla_aggscan(Frame& F) {
    const KA K = KA::fresh(); PHASE_TID;
#pragma unroll 1
    for (int e = F.bx * NT + tid; e < NB * GH * 8192; e += F.G * NT) {
        const int bh = e >> 13, el = e & 8191, ln = (el >> 2) & 63, dt = (el >> 8) & 3, r = el & 3;
        float* ap = K.Sst() + (size_t)bh * NSC * 8192 + el; const float* dp = K.dec() + (size_t)bh * NSC * 64 + dt * 16 + (ln >> 4) * 4 + r;
        float st = 0.f;
#pragma unroll 1
        for (int j0 = 0; j0 < NSC; j0 += 16) {
            float a[16], d[16];
#pragma unroll
            for (int j = 0; j < 16; ++j) { a[j] = ap[(size_t)(j0 + j) * 8192]; d[j] = dp[(j0 + j) * 64]; }
#pragma unroll
            for (int j = 0; j < 16; ++j) { ap[(size_t)(j0 + j) * 8192] = st; st = d[j] * st + a[j]; }
        }
    }
}
template <class Bar>
__device__ __forceinline__ void phase_gla_C2(Frame& F, int l, const Bar& bar) {
    const KA K = KA::fresh(); PHASE_TID;
    LAS unsigned char* lds = F.lds;
    const int fr = lane & 15, fq = lane >> 4;
    const float* gnorm = K.in(5) + (size_t)l * 128;
#pragma unroll 1
    for (int it = F.bx; it < NITEM; it += F.G) {
        const int b = it / (GH * NSC), h = (it / NSC) % GH, sc = it % NSC, tok0 = b * S + sc * SCN * GC;
        const bf16* P = K.P();
        float wu[16];
        { const float* wup = K.in(3) + (size_t)l * 16 * 256 + h * 64 + lane;
#pragma unroll
          for (int r = 0; r < 16; ++r) wu[r] = wup[r * 256]; }
        const float bg = K.in(4)[l * 256 + h * 64 + lane];
        GlaPre pre[2]; gla_prefetch<true>(pre[0], P, h, tok0, tid, lane, wave); gla_prefetch<true>(pre[1], P, h, tok0 + GC, tid, lane, wave);
        __syncthreads();
        gla_stage_gkl(P, lds, tok0, tid);
        if (it == F.bx) { phase_gla_aggscan(F); xcd_barrier(bar); }
        f32x4 Sm[4];
        { const f32x4* ag = (const f32x4*)K.Sst() + ((size_t)(it * 8 + wave) * 4) * 64 + lane;
#pragma unroll
          for (int dt = 0; dt < 4; ++dt) Sm[dt] = ag[dt * 64]; }
        __syncthreads();
#pragma unroll
        for (int n = 0; n < SCN; ++n) {
            const int t0 = tok0 + n * GC;
            GlaPre& pr = pre[n & 1];
            float bv[8]; gla_b8_part(lds, wu, bg, n, lane, wave, bv);
            __syncthreads();
            const float bl = gla_b8_finish(lds, lane, wave, bv);
            gla_write_kdT_vT(lds, pr, bv, bl, tid, lane, wave);
#pragma unroll
            for (int j = 0; j < 8; ++j) {
                const float e = fexp(bv[j]);
                *(LAS bf16*)(lds + L_QD + (8 * wave + j) * LROWB + lane * 2) = (bf16)f2bf(bf2f(pr.q[j]) * 0.125f * e);
                *(LAS bf16*)(lds + L_KI + (8 * wave + j) * LROWB + lane * 2) = (bf16)f2bf(bf2f(pr.k[j]) * __builtin_amdgcn_rcpf(e));
            }
#pragma unroll
            for (int dt = 0; dt < 4; ++dt) *(LAS v2u*)(lds + L_ST + (16 * wave + fr) * LROWB + (16 * dt + 4 * fq) * 2) = (v2u){pk2(Sm[dt][0], Sm[dt][1]), pk2(Sm[dt][2], Sm[dt][3])};
            const v4u gq0 = pr.g0, gq1 = pr.g1;
            if (n + 2 < SCN) gla_prefetch<true>(pr, P, h, t0 + 2 * GC, tid, lane, wave);
            __syncthreads();
#pragma unroll
            for (int i = 0; i < 2; ++i) {
                const int tix = 2 * wave + i, st = tix >> 2, ct = tix & 3;
                f32x4 a = (f32x4){0.f, 0.f, 0.f, 0.f};
#pragma unroll
                for (int ks = 0; ks < 2; ++ks) a = mfma16(FRAG(L_KI, 16 * st + fr, 32 * ks + 8 * fq), FRAG(L_QD, 16 * ct + fr, 32 * ks + 8 * fq), a);
                const int s0 = 16 * st + 4 * fq, c = 16 * ct + fr;
                float m[4];
#pragma unroll
                for (int r = 0; r < 4; ++r) m[r] = (s0 + r <= c) ? a[r] : 0.f;
                *(LAS v2u*)(lds + L_S + c * LROWB + s0 * 2) = (v2u){pk2(m[0], m[1]), pk2(m[2], m[3])};
            }
            f32x4 kv[4]; gla_kv_mfma(lds, wave, fr, fq, kv);
            __syncthreads();
            {
                bf16x8 Av[2], As[2];
#pragma unroll
                for (int ks = 0; ks < 2; ++ks) { Av[ks] = FRAG(L_VT, 16 * wave + fr, 32 * ks + 8 * fq); As[ks] = FRAG(L_ST, 16 * wave + fr, 32 * ks + 8 * fq); }
#pragma unroll
                for (int ct = 0; ct < 4; ++ct) {
                    f32x4 a = (f32x4){0.f, 0.f, 0.f, 0.f};
#pragma unroll
                    for (int ks = 0; ks < 2; ++ks) { a = mfma16(Av[ks], FRAG(L_S, 16 * ct + fr, 32 * ks + 8 * fq), a); a = mfma16(As[ks], FRAG(L_QD, 16 * ct + fr, 32 * ks + 8 * fq), a); }
                    *(LAS f32x4*)(lds + L_OB + (16 * ct + fr) * OBROW + (16 * wave + 4 * fq) * 4) = a;
                }
            }
#pragma unroll
            for (int dt = 0; dt < 4; ++dt) { const f32x4 bl4 = *(const LAS f32x4*)(lds + L_BL + (16 * dt + 4 * fq) * 4);
#pragma unroll
                for (int r = 0; r < 4; ++r) Sm[dt][r] = fexp(bl4[r]) * Sm[dt][r] + kv[dt][r]; }
            __syncthreads();
            {
                const int c = tid >> 3, vg = tid & 7;
                const LAS f32x4* ob = (const LAS f32x4*)(lds + L_OB + c * OBROW + vg * 64);
                f32x4 o[4]; float ss = 0.f;
#pragma unroll
                for (int j = 0; j < 4; ++j) { o[j] = ob[j]; ss += (o[j].x * o[j].x + o[j].y * o[j].y) + (o[j].z * o[j].z + o[j].w * o[j].w); }
                ss = sum8(ss);
                const float rs = rsqrtf(ss * (1.0f / 128.0f) + EPS);
                float g0[8], g1[8]; unpack8(gq0, g0); unpack8(gq1, g1);
                const f32x4* gn = (const f32x4*)(gnorm + 16 * vg);
                const f32x4 n0 = gn[0], n1 = gn[1], n2 = gn[2], n3 = gn[3];
                v4u w0, w1;
                w0.x = pk2(o[0].x * rs * n0.x * silu_fast(g0[0]), o[0].y * rs * n0.y * silu_fast(g0[1])); w0.y = pk2(o[0].z * rs * n0.z * silu_fast(g0[2]), o[0].w * rs * n0.w * silu_fast(g0[3]));
                w0.z = pk2(o[1].x * rs * n1.x * silu_fast(g0[4]), o[1].y * rs * n1.y * silu_fast(g0[5])); w0.w = pk2(o[1].z * rs * n1.z * silu_fast(g0[6]), o[1].w * rs * n1.w * silu_fast(g0[7]));
                w1.x = pk2(o[2].x * rs * n2.x * silu_fast(g1[0]), o[2].y * rs * n2.y * silu_fast(g1[1])); w1.y = pk2(o[2].z * rs * n2.z * silu_fast(g1[2]), o[2].w * rs * n2.w * silu_fast(g1[3]));
                w1.z = pk2(o[3].x * rs * n3.x * silu_fast(g1[4]), o[3].y * rs * n3.y * silu_fast(g1[5])); w1.w = pk2(o[3].z * rs * n3.z * silu_fast(g1[6]), o[3].w * rs * n3.w * silu_fast(g1[7]));
                v4u* op = (v4u*)(K.XN() + (size_t)(t0 + c) * D + h * 128 + 16 * vg);
                op[0] = w0; op[1] = w1;
            }
        }
    }
    if (F.bx >= NITEM) { phase_gla_aggscan(F); xcd_barrier(bar); }
}
#undef FRAG

constexpr int GM_ROWB = 272;
__device__ __forceinline__ void phase_gmlp_mfma(Frame& F, int l) {
    const KA K = KA::fresh(); PHASE_TID;
    LAS unsigned char* lds = F.lds;
    const int fr = lane & 15, fq = lane >> 4;
    const int nks = (16 * wave + 15) / 32 + 1;
#pragma unroll 1
    for (int u = F.bx; u < NB * MN * MH; u += F.G) {
        const int b = u / (MN * MH), n = (u / MH) % MN, h = u % MH, t0 = b * S + n * MC;
        const bf16* P = K.P();
        const float gn = K.in(6)[(size_t)l * 256 + h * 64 + lane];
        unsigned short vraw[16];
#pragma unroll
        for (int i = 0; i < 16; ++i) vraw[i] = P[(size_t)(t0 + 16 * wave + i) * PLD + C_VG + h * 64 + lane];
        const bf16* Wb = K.Wsp() + ((size_t)(l * MH + h) * 128 + 16 * wave + fr) * 128 + 8 * fq;
        bf16x8 Bf[4];
#pragma unroll
        for (int ks = 0; ks < 4; ++ks) Bf[ks] = (ks < nks) ? *(const bf16x8*)(Wb + 32 * ks) : (bf16x8){0, 0, 0, 0, 0, 0, 0, 0};
        const int t = 16 * wave + fr;
        const float bias = K.in(8)[(size_t)l * MH * 128 + h * 128 + t];
        const bf16* up = P + (size_t)(t0 + t) * PLD + C_U + h * 64 + 4 * fq;
        v2u uw[4];
#pragma unroll
        for (int dt = 0; dt < 4; ++dt) uw[dt] = *(const v2u*)(up + 16 * dt);
        __syncthreads();
#pragma unroll
        for (int q = 0; q < 2; ++q) {
            float vs[8];
#pragma unroll
            for (int i = 0; i < 8; ++i) {
                const float g = gelu_fast(bf2f(vraw[8 * q + i]));
                const float ss = wave_sum(g * g);
                vs[i] = g * rsqrtf(ss * (1.0f / 64.0f) + EPS) * gn;
            }
            *(LAS v4u*)(lds + lane * GM_ROWB + (16 * wave + 8 * q) * 2) = (v4u){pk2(vs[0], vs[1]), pk2(vs[2], vs[3]), pk2(vs[4], vs[5]), pk2(vs[6], vs[7])};
        }
        __syncthreads();
        f32x4 acc[4];
#pragma unroll
        for (int dt = 0; dt < 4; ++dt) acc[dt] = (f32x4){0.f, 0.f, 0.f, 0.f};
#pragma unroll
        for (int ks = 0; ks < 4; ++ks) if (ks < nks) {
#pragma unroll
            for (int dt = 0; dt < 4; ++dt) acc[dt] = mfma16(*(const LAS bf16x8*)(lds + (16 * dt + fr) * GM_ROWB + (32 * ks + 8 * fq) * 2), Bf[ks], acc[dt]);
        }
        bf16* op = K.XN() + (size_t)(t0 + t) * D + 512 + h * 64 + 4 * fq;
#pragma unroll
        for (int dt = 0; dt < 4; ++dt) {
            const float o0 = gelu_fast(bflo(uw[dt].x)) * (acc[dt][0] + bias), o1 = gelu_fast(bfhi(uw[dt].x)) * (acc[dt][1] + bias), o2 = gelu_fast(bflo(uw[dt].y)) * (acc[dt][2] + bias), o3 = gelu_fast(bfhi(uw[dt].y)) * (acc[dt][3] + bias);
            *(v2u*)(op + 16 * dt) = (v2u){pk2(o0, o1), pk2(o2, o3)};
        }
    }
}
__device__ __forceinline__ void phase_conv(Frame& F, int l) {
    const KA K = KA::fresh(); PHASE_TID;
    const float* wc = K.in(9) + (size_t)l * 3 * 256;
#pragma unroll 1
    for (int e = F.bx * NT + tid; e < T * 32; e += F.G * NT) {
        const int t = e >> 5, c0 = (e & 31) * 8, tl = t % S;
        const bf16* row = K.P() + (size_t)t * PLD;
        float y[8], xi[8], cg[8], bg[8];
        unpack8(*(const v4u*)(row + C_XI + c0), xi); unpack8(*(const v4u*)(row + C_CG + c0), cg); unpack8(*(const v4u*)(row + C_BG + c0), bg);
#pragma unroll
        for (int j = 0; j < 8; ++j) y[j] = wc[2 * 256 + c0 + j] * cg[j] * xi[j];
        if (tl >= 1) { unpack8(*(const v4u*)(row - PLD + C_XI + c0), xi); unpack8(*(const v4u*)(row - PLD + C_CG + c0), cg);
#pragma unroll
            for (int j = 0; j < 8; ++j) y[j] += wc[1 * 256 + c0 + j] * cg[j] * xi[j]; }
        if (tl >= 2) { unpack8(*(const v4u*)(row - 2 * PLD + C_XI + c0), xi); unpack8(*(const v4u*)(row - 2 * PLD + C_CG + c0), cg);
#pragma unroll
            for (int j = 0; j < 8; ++j) y[j] += wc[0 * 256 + c0 + j] * cg[j] * xi[j]; }
#pragma unroll
        for (int j = 0; j < 8; ++j) y[j] *= bg[j];
        *(v4u*)(K.XN() + (size_t)t * D + 768 + c0) = (v4u){pk2(y[0], y[1]), pk2(y[2], y[3]), pk2(y[4], y[5]), pk2(y[6], y[7])};
    }
}
constexpr int RT_PART = 0, RT_SS = RT_PART + 4 * 8 * 16 * 48 * 4, RT_RS = RT_SS + 4 * 8 * 16 * 4, RT_HIST = RT_RS + 64 * 4;
__device__ __forceinline__ void phase_norm_router_mfma(Frame& F, int l) {
    const KA K = KA::fresh(); PHASE_TID;
    LAS unsigned char* lds = F.lds;
    const int fr = lane & 15, fq = lane >> 4;
    const bf16* whi = K.Wr() + (size_t)l * 2 * 48 * D + (size_t)fr * D + 128 * wave + 8 * fq; const bf16* wlo = whi + 48 * D;
    bf16x8 Wh[4][3], Wl[4][3];
#pragma unroll
    for (int ks = 0; ks < 4; ++ks)
#pragma unroll
        for (int nt = 0; nt < 3; ++nt) { Wh[ks][nt] = *(const bf16x8*)(whi + (size_t)(16 * nt) * D + 32 * ks); Wl[ks][nt] = *(const bf16x8*)(wlo + (size_t)(16 * nt) * D + 32 * ks); }
    f32x4 g0[4], g1[4];
    { const float* gp = K.in(11) + (size_t)l * D + 128 * wave + 8 * fq;
#pragma unroll
      for (int ks = 0; ks < 4; ++ks) { g0[ks] = *(const f32x4*)(gp + 32 * ks); g1[ks] = *(const f32x4*)(gp + 32 * ks + 4); } }
#pragma unroll 1
    for (int blk = F.bx; blk < T / 64; blk += F.G) {
        const bf16* xr = K.XR() + (size_t)(blk * 64 + fr) * D + 128 * wave + 8 * fq;
        __syncthreads();
        if (tid < NE) ((LAS int*)(lds + RT_HIST))[tid] = 0;
        v4u xa[4][4];
#pragma unroll
        for (int t = 0; t < 4; ++t)
#pragma unroll
            for (int ks = 0; ks < 4; ++ks) xa[t][ks] = *(const v4u*)(xr + (size_t)(16 * t) * D + 32 * ks);
#pragma unroll
        for (int t = 0; t < 4; ++t) {
            f32x4 acc[3]; float ss = 0.f;
#pragma unroll
            for (int nt = 0; nt < 3; ++nt) acc[nt] = (f32x4){0.f, 0.f, 0.f, 0.f};
#pragma unroll
            for (int ks = 0; ks < 4; ++ks) {
                float xv[8]; unpack8(xa[t][ks], xv);
#pragma unroll
                for (int j = 0; j < 8; ++j) ss += xv[j] * xv[j];
                const bf16x8 Ah = __builtin_bit_cast(bf16x8, xa[t][ks]);
#pragma unroll
                for (int nt = 0; nt < 3; ++nt) { acc[nt] = mfma16(Ah, Wh[ks][nt], acc[nt]); acc[nt] = mfma16(Ah, Wl[ks][nt], acc[nt]); }
            }
            ss += shx(ss, 16); ss += shx(ss, 32);
            LAS float* part = (LAS float*)(lds + RT_PART) + (t * 8 + wave) * 16 * 48;
#pragma unroll
            for (int nt = 0; nt < 3; ++nt)
#pragma unroll
                for (int r = 0; r < 4; ++r) part[(4 * fq + r) * 48 + 16 * nt + fr] = acc[nt][r];
            if (fq == 0) ((LAS float*)(lds + RT_SS))[(t * 8 + wave) * 16 + fr] = ss;
        }
        __syncthreads();
        {
            const int tt = tid >> 3, j = tid & 7, t = blk * 64 + tt;
            const LAS float* p0 = (const LAS float*)(lds + RT_PART) + ((tt >> 4) * 8 * 16 + (tt & 15)) * 48;
            const LAS float* s2 = (const LAS float*)(lds + RT_SS) + (tt >> 4) * 8 * 16 + (tt & 15);
            float sq = 0.f;
#pragma unroll
            for (int w = 0; w < 8; ++w) sq += s2[w * 16];
            const float rs = rsqrtf(sq * (1.f / D) + EPS);
#define RT_DOT(n) (((p0[(n)] + p0[768 + (n)]) + (p0[1536 + (n)] + p0[2304 + (n)])) + ((p0[3072 + (n)] + p0[3840 + (n)]) + (p0[4608 + (n)] + p0[5376 + (n)])))
            float gv = (j < 4) ? RT_DOT(j & 3) * rs + K.in(13)[(size_t)l * 4 + (j & 3)] : -INFINITY; int gi = j;
            const float gmine = gv;
#define RT_ARGMAX_STEP(V, I, FV, FI) do { const float ov = FV(V); const int oi = FI(I); if (ov > V || (ov == V && oi < I)) { V = ov; I = oi; } } while (0)
            RT_ARGMAX_STEP(gv, gi, dppf_x1, dpp_x1); RT_ARGMAX_STEP(gv, gi, dppf_x2, dpp_x2); RT_ARGMAX_STEP(gv, gi, dppf_hm, dpp_hm);
            float ge = (j < 4) ? expf(gmine - gv) : 0.f;
            ge = sum8(ge);
            const float gw = 1.0f / ge; const int gt = gi;
            const float ev = RT_DOT(4 + gt * 8 + j) * rs + K.in(15)[(size_t)l * 32 + gt * 8 + j];
#undef RT_DOT
            float m0 = ev; int i0 = j;
            RT_ARGMAX_STEP(m0, i0, dppf_x1, dpp_x1); RT_ARGMAX_STEP(m0, i0, dppf_x2, dpp_x2); RT_ARGMAX_STEP(m0, i0, dppf_hm, dpp_hm);
            float m1 = (j == i0) ? -INFINITY : ev; int i1 = j;
            RT_ARGMAX_STEP(m1, i1, dppf_x1, dpp_x1); RT_ARGMAX_STEP(m1, i1, dppf_x2, dpp_x2); RT_ARGMAX_STEP(m1, i1, dppf_hm, dpp_hm);
#undef RT_ARGMAX_STEP
            if (j == 0) {
                ((LAS float*)(lds + RT_RS))[tt] = rs;
                const float e1 = expf(m1 - m0);
                const float w0 = gw / (1.0f + e1), w1 = gw * e1 / (1.0f + e1);
                const int e0i = gt * 8 + i0, e1i = gt * 8 + i1;
                K.eid()[2 * t] = e0i; K.eid()[2 * t + 1] = e1i; K.ew()[2 * t] = w0; K.ew()[2 * t + 1] = w1;
                LAS int* hist = (LAS int*)(lds + RT_HIST);
                K.slot_of()[2 * t] = __hip_atomic_fetch_add(hist + e0i, 1, __ATOMIC_RELAXED, __HIP_MEMORY_SCOPE_WORKGROUP);
                K.slot_of()[2 * t + 1] = __hip_atomic_fetch_add(hist + e1i, 1, __ATOMIC_RELAXED, __HIP_MEMORY_SCOPE_WORKGROUP);
            }
        }
        __syncthreads();
        if (tid < NE) K.blkcnt()[(size_t)(l * (T / 64) + blk) * NE + tid] = ((LAS int*)(lds + RT_HIST))[tid];
        {
            bf16* hp = K.XN() + (size_t)(blk * 64 + fr) * D + 128 * wave + 8 * fq;
#pragma unroll
            for (int t = 0; t < 4; ++t) {
                const float rs = ((const LAS float*)(lds + RT_RS))[16 * t + fr];
#pragma unroll
                for (int ks = 0; ks < 4; ++ks) {
                    asm volatile("" : "+v"(xa[t][ks]));
                    float xv[8]; unpack8(xa[t][ks], xv);
                    *(v4u*)(hp + (size_t)(16 * t) * D + 32 * ks) = (v4u){pk2(xv[0] * rs * g0[ks].x, xv[1] * rs * g0[ks].y), pk2(xv[2] * rs * g0[ks].z, xv[3] * rs * g0[ks].w), pk2(xv[4] * rs * g1[ks].x, xv[5] * rs * g1[ks].y), pk2(xv[6] * rs * g1[ks].z, xv[7] * rs * g1[ks].w)};
                }
            }
        }
    }
}
constexpr int TAB_OFF = LDSCTL_OFF + 1024;
__device__ __forceinline__ void moe_tables_lds(Frame& F, const LAS int* tot, int tid) {
    LAS int* tab = (LAS int*)(F.lds + TAB_OFF); LAS int* offs = tab + 4 + 4 * 164; LAS int* fpre = offs + 40; LAS int* ppre = fpre + 40;
    if (tid == 0) { int a = 0, f = 0, p = 0; for (int e = 0; e < NE; ++e) { const int c = tot[e]; offs[e] = a; fpre[e] = f; ppre[e] = p; a += c; f += c >> 8; p += (c & 255) ? 1 : 0; }
        offs[NE] = a; fpre[NE] = f; ppre[NE] = p; tab[0] = f + p; }
    __syncthreads();
    const int nfull = fpre[NE];
    if (tid < nfull) { int e = 0; for (int j = 1; j < NE; ++j) if (fpre[j] <= tid) e = j; tab[4 + 4 * tid] = e; tab[5 + 4 * tid] = offs[e] + (tid - fpre[e]) * 256; tab[6 + 4 * tid] = offs[e + 1]; }
    else if (tid < nfull + NE) {
        const int e = tid - nfull, rows = (offs[e + 1] - offs[e]) & 255;
        if (rows) { int rank = 0; for (int j = 0; j < NE; ++j) { const int rj = (offs[j + 1] - offs[j]) & 255; rank += (rj > rows || (rj == rows && j < e)) ? 1 : 0; }
            const int q = nfull + rank; tab[4 + 4 * q] = e; tab[5 + 4 * q] = offs[e] + (fpre[e + 1] - fpre[e]) * 256; tab[6 + 4 * q] = offs[e + 1]; }
    }
    __syncthreads();
}
__device__ __forceinline__ void phase_scatter(Frame& F, int l) {
    const KA K = KA::fresh(); PHASE_TID;
    LAS int* sm = (LAS int*)F.lds;
    const int* bc = K.blkcnt() + (size_t)l * (T / 64) * NE;
    constexpr int NBLK = T / 64;
#pragma unroll 1
    for (int blk = F.bx, trip = 0; blk < NBLK || trip == 0; blk += F.G, ++trip) {
        __syncthreads();
        {   const int e = tid & 31, part = tid >> 5;
            int tot = 0, pre = 0;
#pragma unroll
            for (int j = 0; j < NBLK / 16; ++j) { const int bb = part * (NBLK / 16) + j; const int c = bc[bb * NE + e]; tot += c; if (bb < blk) pre += c; }
            sm[part * 32 + e] = tot; sm[512 + part * 32 + e] = pre; }
        __syncthreads();
        if (tid < 32) { int tot = 0, pre = 0;
#pragma unroll
            for (int p = 0; p < 16; ++p) { tot += sm[p * 32 + tid]; pre += sm[512 + p * 32 + tid]; }
            sm[1056 + tid] = tot; sm[1024 + tid] = pre; }
        __syncthreads();
        if (tid == 0) { int a = 0; for (int e = 0; e < NE; ++e) { const int c = sm[1056 + e]; sm[1024 + e] += a; a += c; } }
        __syncthreads();
        if (blk < NBLK && tid < 128) { const int a = blk * 128 + tid; const int e = K.eid()[a]; const int pos = sm[1024 + e] + K.slot_of()[a]; K.slot_tok()[pos] = a >> 1; K.slot_of()[a] = pos; }
    }
    __syncthreads();
    moe_tables_lds(F, sm + 1056, tid);
}
template <int SUB>
__device__ __forceinline__ void phase_moe(Frame& F, int l) {
    const KA K = KA::fresh();
    int c_ = F.bx; asm volatile("" : "+s"(c_));
    const int G = F.G, c = (c_ & 7) * (G >> 3) + (c_ >> 3);
    const LAS int* tab = (const LAS int*)(F.lds + TAB_OFF);
    const int ntile = __builtin_amdgcn_readfirstlane(tab[0]), ngu = 2 * ntile, nleft = ngu > G ? ngu - G : 0, jX = ngu > G ? (G >> 1) : ntile, W = G - nleft;
    const int yd = (jX * 4 < 2 * W) ? jX * 4 : 2 * W;
    bool do_gu = false, do_dn = false; pg8::MoeSched So{tab, 2, 0, 0, G, c, 0};
    if (SUB == 0) { do_gu = true; So.npn = 2; So.first = 0; So.end = ngu < G ? ngu : G; So.stride = G; So.c = c; }
    if (SUB == 1) { if (c < nleft) { do_gu = true; So.npn = 2; So.first = G; So.end = ngu; So.stride = G; So.c = c; }
                    else { do_dn = true; So.npn = 4; So.first = 0; So.end = yd; So.stride = W; So.c = c - nleft; } }
    if (SUB == 2) { do_dn = true; So.npn = 4; So.first = 2 * yd; So.end = 2 * ntile * 4; So.stride = G; So.c = c; So.split = 1; }
    if (do_gu) { pg8::EpiMoeH E{K.H1()};
        pg8::gemm_phase_moe<pg8::EpiMoeH, pg8::MoeSched, true, 512, D>(F.lds, K.XN(), K.WguT() + (size_t)l * NE * 512 * D, K.slot_tok(), So, E, F.wave); }
    if (do_dn) { pg8::EpiMoeY E{K.Y()};
        pg8::gemm_phase_moe<pg8::EpiMoeY, pg8::MoeSched, false, D, DE>(F.lds, K.H1(), K.WdT() + (size_t)l * NE * D * DE, nullptr, So, E, F.wave); }
}
__device__ __forceinline__ void phase_combine(Frame& F, int l) {
    const KA K = KA::fresh(); PHASE_TID;
    const bool last = (l == DEPTH - 1);
    f32x4 g4[4];
    if (last) {
#pragma unroll
        for (int j = 0; j < 4; ++j) g4[j] = ((const f32x4*)K.in(19))[lane + 64 * j]; }
    const int tstep = F.G * NWAVES;
    int t = F.bx * NWAVES + wave;
    v2u xw[4], ya[4], yb[4]; float w0 = 0.f, w1 = 0.f;
#define CB_LOAD(tt) do { const int s0_ = K.slot_of()[2 * (tt)], s1_ = K.slot_of()[2 * (tt) + 1]; w0n = K.ew()[2 * (tt)]; w1n = K.ew()[2 * (tt) + 1]; \
        const v2u* xr_ = (const v2u*)(K.XR() + (size_t)(tt) * D) + lane; const v2u* y0_ = (const v2u*)(K.Y() + (size_t)s0_ * D) + lane; const v2u* y1_ = (const v2u*)(K.Y() + (size_t)s1_ * D) + lane; \
        _Pragma("unroll") for (int j = 0; j < 4; ++j) { xn[j] = xr_[64 * j]; an[j] = y0_[64 * j]; bn[j] = y1_[64 * j]; } } while (0)
    { v2u xn[4], an[4], bn[4]; float w0n = 0.f, w1n = 0.f;
      if (t < T) { CB_LOAD(t);
#pragma unroll
        for (int j = 0; j < 4; ++j) { xw[j] = xn[j]; ya[j] = an[j]; yb[j] = bn[j]; } w0 = w0n; w1 = w1n; } }
#pragma unroll 1
    for (; t < T; t += tstep) {
        v2u xn[4], an[4], bn[4]; float w0n = 0.f, w1n = 0.f;
        if (t + tstep < T) CB_LOAD(t + tstep);
        f32x4 v[4]; float s = 0.f;
#pragma unroll
        for (int j = 0; j < 4; ++j) { const v2u x_ = xw[j], a = ya[j], b = yb[j];
            v[j].x = bflo(x_.x) + w0 * bflo(a.x) + w1 * bflo(b.x); v[j].y = bfhi(x_.x) + w0 * bfhi(a.x) + w1 * bfhi(b.x); v[j].z = bflo(x_.y) + w0 * bflo(a.y) + w1 * bflo(b.y); v[j].w = bfhi(x_.y) + w0 * bfhi(a.y) + w1 * bfhi(b.y);
            s += (v[j].x * v[j].x + v[j].y * v[j].y) + (v[j].z * v[j].z + v[j].w * v[j].w); }
        const float rs = rsqrtf(wave_sum(s) * (1.f / D) + EPS);
        if (last) {
            f32x4* orow = (f32x4*)(K.out() + (size_t)t * D) + lane;
#pragma unroll
            for (int j = 0; j < 4; ++j) __builtin_nontemporal_store((f32x4){v[j].x * rs * g4[j].x, v[j].y * rs * g4[j].y, v[j].z * rs * g4[j].z, v[j].w * rs * g4[j].w}, orow + 64 * j);
        } else {
            v2u* xr = (v2u*)(K.XR() + (size_t)t * D) + lane;
            if (lane == 0) K.rinv1()[t] = rs;
#pragma unroll
            for (int j = 0; j < 4; ++j) xr[64 * j] = (v2u){pk2(v[j].x, v[j].y), pk2(v[j].z, v[j].w)};
        }
#pragma unroll
        for (int j = 0; j < 4; ++j) { xw[j] = xn[j]; ya[j] = an[j]; yb[j] = bn[j]; }
        w0 = w0n; w1 = w1n;
    }
#undef CB_LOAD
}

struct Args { const float* in[20]; float* out; unsigned char* ws; };
__global__ void __launch_bounds__(NT, 2) fwd_kernel(Args args) {
    extern __shared__ __attribute__((aligned(16))) unsigned char lds_raw[];
    Frame F;
    F.lds = (LAS unsigned char*)lds_raw; F.smem = (float*)lds_raw;
    F.G = gridDim.x; F.bx = blockIdx.x; F.wave = __builtin_amdgcn_readfirstlane(threadIdx.x >> 6);
    volatile LAS unsigned* MISC = (volatile LAS unsigned*)(F.lds + MISC_OFF);
    for (int u = threadIdx.x; u < (LDS_BYTES - LDSCTL_OFF) / 4; u += NT) ((LAS unsigned*)(F.lds + LDSCTL_OFF))[u] = 0u;
    __syncthreads();
    XcdBarrier bar; { const KA K = KA::fresh(); bar = xcd_barrier_post(K.ctl() + CW_BAR, MISC + 8); }
#define GRID_BAR() xcd_barrier(bar)

    p0_prologue(F);
    GRID_BAR();
    for (int l = 0; l < DEPTH; ++l) {
        {
            const KA K = KA::fresh(); PHASE_TID;
            pg8::Gemm g{K.XR(), K.WinT() + (size_t)l * PLD * D, T, PLD, D}; pg8::StaticOrder So; int c_ = F.bx; asm volatile("" : "+s"(c_)); So.init(T, PLD, F.G, c_);
            pg8::EpiBf16Scale E{K.P(), PLD, K.rinv1()};
            pg8::gemm_phase<pg8::EpiBf16Scale, pg8::StaticOrder, PG8_ALIGN, PG8_SP2>(F.lds, g, So, E, F.wave);
        }
        GRID_BAR();
        phase_gla_A2(F, l);
        phase_gmlp_mfma(F, l);
        phase_conv(F, l);
        GRID_BAR();
        phase_gla_C2(F, l, bar);
        GRID_BAR();
        {
            const KA K = KA::fresh(); PHASE_TID;
            pg8::Gemm g{K.XN(), K.WoutT() + (size_t)l * D * D, T, D, D}; pg8::StaticOrder So; int c_ = F.bx; asm volatile("" : "+s"(c_)); So.init(T, D, F.G, c_);
            pg8::EpiBf16Res<false> E{K.XR(), K.XR(), D}; pg8::gemm_phase<pg8::EpiBf16Res<false>, pg8::StaticOrder, PG8_ALIGN, PG8_SP2>(F.lds, g, So, E, F.wave);
        }
        GRID_BAR();
        phase_norm_router_mfma(F, l);
        GRID_BAR();
        phase_scatter(F, l);
        GRID_BAR();
        phase_moe<0>(F, l);
        GRID_BAR();
        phase_moe<1>(F, l);
        GRID_BAR();
        phase_moe<2>(F, l);
        GRID_BAR();
        phase_combine(F, l);
        if (l + 1 < DEPTH) GRID_BAR();
    }
}

extern "C" void kernel_launch(void* const* d_in, const int* in_sizes, int n_in, void* d_out, int out_size, void* d_ws, size_t ws_size, hipStream_t stream) {
    static int grid_blocks = 0;
    if (!grid_blocks) {
        int dev = 0, cus = 0, per_cu = 0;
        (void)hipGetDevice(&dev);
        (void)hipDeviceGetAttribute(&cus, hipDeviceAttributeMultiprocessorCount, dev);
        (void)hipFuncSetAttribute((const void*)fwd_kernel, hipFuncAttributeMaxDynamicSharedMemorySize, LDS_BYTES);
        (void)hipOccupancyMaxActiveBlocksPerMultiprocessor(&per_cu, fwd_kernel, NT, LDS_BYTES);
        if (per_cu < 1) { fprintf(stderr, "kernel_launch: occupancy query says %d blocks/CU\n", per_cu); per_cu = 1; }
        grid_blocks = cus;
        if (ws_size < WS_END) { fprintf(stderr, "kernel_launch: workspace too small (%zu < %zu)\n", ws_size, (size_t)WS_END); grid_blocks = -1; }
    }
    if (grid_blocks < 0) return;
    (void)hipMemsetAsync((char*)d_ws + WS_CTL, 0, 131072, stream);
    Args a{};
    for (int i = 0; i < 20; ++i) a.in[i] = (const float*)d_in[i];
    a.out = (float*)d_out; a.ws = (unsigned char*)d_ws;
    void* args[] = {&a};
    hipError_t e = hipLaunchCooperativeKernel((void*)fwd_kernel, dim3(grid_blocks), dim3(NT), args, LDS_BYTES, stream);
    if (e != hipSuccess) fprintf(stderr, "cooperative launch failed: %s (grid %d)\n", hipGetErrorString(e), grid_blocks);
}
```

```cpp
#include <hip/hip_runtime.h>
#include <cstdio>
#include <cstdint>
__device__ __forceinline__ int fresh_lane() { unsigned m = 0xffffffffu; asm volatile("" : "+s"(m)); return (int)__builtin_amdgcn_mbcnt_hi(m, __builtin_amdgcn_mbcnt_lo(m, 0u)); }
__device__ __forceinline__ float shx(float v, int o) { return __int_as_float(__builtin_amdgcn_ds_bpermute((fresh_lane() ^ o) << 2, __float_as_int(v))); }
__device__ __forceinline__ int dpp_x1(int v) { return __builtin_amdgcn_update_dpp(v, v, 0xB1, 0xF, 0xF, false); }
__device__ __forceinline__ int dpp_x2(int v) { return __builtin_amdgcn_update_dpp(v, v, 0x4E, 0xF, 0xF, false); }
__device__ __forceinline__ int dpp_hm(int v) { return __builtin_amdgcn_update_dpp(v, v, 0x141, 0xF, 0xF, false); }
__device__ __forceinline__ int dpp_rm(int v) { return __builtin_amdgcn_update_dpp(v, v, 0x140, 0xF, 0xF, false); }
__device__ __forceinline__ float dppf_x1(float v) { return __int_as_float(dpp_x1(__float_as_int(v))); }
__device__ __forceinline__ float dppf_x2(float v) { return __int_as_float(dpp_x2(__float_as_int(v))); }
__device__ __forceinline__ float dppf_hm(float v) { return __int_as_float(dpp_hm(__float_as_int(v))); }
__device__ __forceinline__ float dppf_rm(float v) { return __int_as_float(dpp_rm(__float_as_int(v))); }
__device__ __forceinline__ float sum8(float v) { v += dppf_x1(v); v += dppf_x2(v); v += dppf_hm(v); return v; }
__device__ __forceinline__ float sum16(float v) { v = sum8(v); v += dppf_rm(v); return v; }
namespace pg8 {
#define PG8_LAS __attribute__((address_space(3)))
typedef unsigned short bf16_t;
typedef short bf16x8 __attribute__((ext_vector_type(8)));
typedef float f32x4 __attribute__((ext_vector_type(4)));
typedef unsigned u32x4 __attribute__((ext_vector_type(4)));
constexpr int BM = 256, BK = 64, HALF = 128, HTB = HALF * BK * 2  , STAGE_BYTES = 8 * HTB, NXCD = 8, WGM = 8;

__host__ __device__ __forceinline__ int lds_byte(int r, int c) { const int st = (r >> 4) * 2 + (c >> 5), rr = r & 15, cc = c & 31, ob = rr * 64 + cc * 2; return st * 1024 + (ob ^ (((ob >> 9) & 1) << 5)); }
__host__ __device__ __forceinline__ void stage_rc(int b, int& R, int& C) { const int st = b / 1024, sb = b % 1024, swz = sb ^ (((sb >> 9) & 1) << 5); R = (st >> 1) * 16 + swz / 64; C = (st & 1) * 32 + (swz % 64) / 2; }
__host__ __device__ __forceinline__ int perm32(int rho) { const int n = rho >> 4, i = rho & 15; return 8 * (i >> 2) + 4 * n + (i & 3); }

struct Unit { int pm, pn; };
struct Gemm { const bf16_t* A; const bf16_t* Bt; int M, N, K; };

struct StaticOrder {
    int nM, nN, nwg, G, c;
    __host__ __device__ void init(int M, int N, int G_, int c_) { nM = M / BM; nN = N / BM; nwg = nM * nN; G = G_; c = c_; }
    __host__ __device__ bool next(int i, Unit& u) const {
        const long L = (long)i * G + c; if (L >= nwg) return false;
        int wgid = (int)L; { const int q = nwg / NXCD, r = nwg % NXCD, xcd = wgid % NXCD, off = wgid / NXCD; wgid = (xcd < r ? xcd * (q + 1) : r * (q + 1) + (xcd - r) * q) + off; }
        const int nig = WGM * nN, gid = wgid / nig, fm = gid * WGM, gsz = (nM - fm) < WGM ? (nM - fm) : WGM;
        u.pm = fm + ((wgid % nig) % gsz); u.pn = (wgid % nig) / gsz; return true;
    }
    __device__ __forceinline__ void a_ready(const Unit&) const {}
    __device__ __forceinline__ void done(const Unit&) const {}
};


__device__ __forceinline__ unsigned cvt_pk_bf16(float lo, float hi) { unsigned r; asm volatile("v_cvt_pk_bf16_f32 %0, %1, %2" : "=v"(r) : "v"(lo), "v"(hi)); return r; }
struct EpiBf16Plain {
    static constexpr bool PERM = true, AFTER_DRAIN = false;
    bf16_t* O; int ldc;
    __device__ __forceinline__ void operator()(const f32x4 (&acc)[2][2][4][2], const Unit& u, int wr, int wc, int fr, int fq) const {
        const int row0 = u.pm * BM + wr * 64 + fr, col0 = u.pn * BM + wc * 32 + 8 * fq;
#pragma unroll
        for (int ai = 0; ai < 2; ++ai)
#pragma unroll
            for (int m = 0; m < 4; ++m) { bf16_t* rowp = O + (size_t)(row0 + ai * HALF + m * 16) * ldc + col0;
#pragma unroll
                for (int bj = 0; bj < 2; ++bj) { const f32x4 v0 = acc[ai][bj][m][0], v1 = acc[ai][bj][m][1];
                    u32x4 w; w.x = cvt_pk_bf16(v0[0], v0[1]); w.y = cvt_pk_bf16(v0[2], v0[3]); w.z = cvt_pk_bf16(v1[0], v1[1]); w.w = cvt_pk_bf16(v1[2], v1[3]);
                    *(u32x4*)(rowp + bj * HALF) = w; } }
    }
};
struct EpiBf16Scale {
    static constexpr bool PERM = true, AFTER_DRAIN = false;
    bf16_t* O; int ldc; const float* rs;
    __device__ __forceinline__ void operator()(const f32x4 (&acc)[2][2][4][2], const Unit& u, int wr, int wc, int fr, int fq) const {
        const int row0 = u.pm * BM + wr * 64 + fr, col0 = u.pn * BM + wc * 32 + 8 * fq;
        float sc[2][4];
#pragma unroll
        for (int ai = 0; ai < 2; ++ai)
#pragma unroll
            for (int m = 0; m < 4; ++m) sc[ai][m] = rs[row0 + ai * HALF + m * 16];
#pragma unroll
        for (int ai = 0; ai < 2; ++ai)
#pragma unroll
            for (int m = 0; m < 4; ++m) { bf16_t* rowp = O + (size_t)(row0 + ai * HALF + m * 16) * ldc + col0; const float s_ = sc[ai][m];
#pragma unroll
                for (int bj = 0; bj < 2; ++bj) { const f32x4 v0 = acc[ai][bj][m][0] * s_, v1 = acc[ai][bj][m][1] * s_;
                    u32x4 w; w.x = cvt_pk_bf16(v0[0], v0[1]); w.y = cvt_pk_bf16(v0[2], v0[3]); w.z = cvt_pk_bf16(v1[0], v1[1]); w.w = cvt_pk_bf16(v1[2], v1[3]);
                    *(u32x4*)(rowp + bj * HALF) = w; } }
    }
};
template <bool RES_F32>
struct EpiBf16Res {
    static constexpr bool PERM = true, AFTER_DRAIN = false;
    bf16_t* O; const void* R; int ldc;
    __device__ __forceinline__ void operator()(const f32x4 (&acc)[2][2][4][2], const Unit& u, int wr, int wc, int fr, int fq) const {
        const int row0 = u.pm * BM + wr * 64 + fr, col0 = u.pn * BM + wc * 32 + 8 * fq;
#pragma unroll
        for (int ai = 0; ai < 2; ++ai)
#pragma unroll
            for (int m = 0; m < 4; ++m) { const size_t off = (size_t)(row0 + ai * HALF + m * 16) * ldc + col0;
#pragma unroll
                for (int bj = 0; bj < 2; ++bj) { f32x4 v0 = acc[ai][bj][m][0], v1 = acc[ai][bj][m][1];
                    if (RES_F32) { const float* rp = (const float*)R + off + bj * HALF; v0 += *(const f32x4*)rp; v1 += *(const f32x4*)(rp + 4); }
                    else { const u32x4 rw = *(const u32x4*)((const bf16_t*)R + off + bj * HALF);
                        v0[0] += __uint_as_float(rw.x << 16); v0[1] += __uint_as_float(rw.x & 0xffff0000u); v0[2] += __uint_as_float(rw.y << 16); v0[3] += __uint_as_float(rw.y & 0xffff0000u);
                        v1[0] += __uint_as_float(rw.z << 16); v1[1] += __uint_as_float(rw.z & 0xffff0000u); v1[2] += __uint_as_float(rw.w << 16); v1[3] += __uint_as_float(rw.w & 0xffff0000u); }
                    u32x4 w; w.x = cvt_pk_bf16(v0[0], v0[1]); w.y = cvt_pk_bf16(v0[2], v0[3]); w.z = cvt_pk_bf16(v1[0], v1[1]); w.w = cvt_pk_bf16(v1[2], v1[3]);
                    *(u32x4*)(O + off + bj * HALF) = w; } }
    }
};

template <class Epi, class Sched, bool ALIGN_EPI = false, bool SP2 = false>
__device__ __forceinline__ void gemm_phase(PG8_LAS unsigned char* lds, const Gemm g, const Sched& S, const Epi& E, int wave_id) {
    asm volatile("" : "+s"(wave_id));
    const int lane = fresh_lane(), wid = wave_id, tid = wid * 64 + lane, wr = wid >> 2, wc = wid & 3, fr = lane & 15, fq = lane >> 4;
    const int K = g.K, nt = K / BK;
    unsigned voffA[2], voffB[2];
#pragma unroll
    for (int i = 0; i < 2; ++i) { int R, C; stage_rc(tid * 16 + i * 8192, R, C); const int Rb = Epi::PERM ? ((R & ~31) + perm32(R & 31)) : R;
        voffA[i] = (unsigned)(R * K + C) * 2u; voffB[i] = (unsigned)(Rb * K + C) * 2u; }
    const size_t kstep = (size_t)(BK * 2);
    const size_t hstep = (size_t)HALF * K * 2;
    const size_t tstep = 2 * hstep;
    const unsigned ldsw = (unsigned)wid * 1024u;
    const int aoff = lds_byte(wr * 64 + fr, fq * 8), boff = lds_byte(wc * 32 + fr, fq * 8);
#define PG8_SA(b, h) (((b) * 2 + (h)) * HTB)
#define PG8_SB(b, h) ((4 + (b) * 2 + (h)) * HTB)
#define PG8_STAGE(bufoff, gbase, voff) do { _Pragma("unroll") for (int _i = 0; _i < 2; ++_i) \
        __builtin_amdgcn_global_load_lds((const unsigned*)((const char*)(gbase) + (voff)[_i]), (PG8_LAS unsigned*)(lds + (bufoff) + ldsw + _i * 8192), 16, 0, 0); } while (0)
#define PG8_LDA(dst, b, h) do { _Pragma("unroll") for (int m = 0; m < 4; ++m) _Pragma("unroll") for (int k = 0; k < 2; ++k) dst[m][k] = *(const PG8_LAS bf16x8*)(lds + PG8_SA(b, h) + aoff + m * 2048 + k * 1024); } while (0)
#define PG8_LDB(dst, b, h) do { _Pragma("unroll") for (int n = 0; n < 2; ++n) _Pragma("unroll") for (int k = 0; k < 2; ++k) dst[n][k] = *(const PG8_LAS bf16x8*)(lds + PG8_SB(b, h) + boff + n * 2048 + k * 1024); } while (0)
#define PG8_MMA(ai, bj, At, Bt) do { __builtin_amdgcn_s_setprio(1); _Pragma("unroll") for (int m = 0; m < 4; ++m) _Pragma("unroll") for (int n = 0; n < 2; ++n) _Pragma("unroll") for (int k = 0; k < 2; ++k) \
        acc[ai][bj][m][n] = __builtin_amdgcn_mfma_f32_16x16x32_bf16(Bt[n][k], At[m][k], acc[ai][bj][m][n], 0, 0, 0); __builtin_amdgcn_s_setprio(0); } while (0)
#define PG8_WAIT_V(n) asm volatile("s_waitcnt vmcnt(" #n ")" ::: "memory")
#define PG8_WAIT_L(n) asm volatile("s_waitcnt lgkmcnt(" #n ")" ::: "memory")
#define PG8_BAR __builtin_amdgcn_s_barrier()
#define PG8_SCHED __builtin_amdgcn_sched_barrier(0)
    Unit cur, nxt; int ui = 0;
    if (!S.next(0, cur)) return;
    f32x4 acc[2][2][4][2];
#pragma unroll
    for (int a = 0; a < 2; ++a)
#pragma unroll
        for (int b = 0; b < 2; ++b)
#pragma unroll
            for (int m = 0; m < 4; ++m)
#pragma unroll
                for (int n = 0; n < 2; ++n) acc[a][b][m][n] = (f32x4){0.f, 0.f, 0.f, 0.f};
    bf16x8 At[4][2], B0[2][2], B1[2][2];
    const char* cA = (const char*)g.A + (size_t)cur.pm * tstep; const char* cB = (const char*)g.Bt + (size_t)cur.pn * tstep;
    S.a_ready(cur);
    if constexpr (SP2) {
        PG8_STAGE(PG8_SB(0, 0), cB, voffB); PG8_STAGE(PG8_SB(0, 1), cB + hstep, voffB); PG8_STAGE(PG8_SA(0, 0), cA, voffA); PG8_STAGE(PG8_SA(0, 1), cA + hstep, voffA);
        if (wr == 1) PG8_BAR;
        PG8_WAIT_V(2); PG8_BAR;
        PG8_STAGE(PG8_SB(1, 0), cB + kstep, voffB); PG8_STAGE(PG8_SA(1, 0), cA + kstep, voffA); PG8_STAGE(PG8_SB(1, 1), cB + hstep + kstep, voffB);
        PG8_WAIT_V(6); PG8_BAR;
    } else {
        PG8_STAGE(PG8_SB(0, 0), cB, voffB); PG8_STAGE(PG8_SA(0, 0), cA, voffA); PG8_STAGE(PG8_SB(0, 1), cB + hstep, voffB); PG8_STAGE(PG8_SA(0, 1), cA + hstep, voffA);
        if (wr == 1) PG8_BAR;
        PG8_WAIT_V(4); PG8_BAR;
        PG8_STAGE(PG8_SB(1, 0), cB + kstep, voffB); PG8_STAGE(PG8_SA(1, 0), cA + kstep, voffA); PG8_STAGE(PG8_SB(1, 1), cB + hstep + kstep, voffB);
        PG8_WAIT_V(6); PG8_BAR;
    }
    for (;;) {
        const bool has_next = S.next(ui + 1, nxt);
        const char* nA = has_next ? (const char*)g.A + (size_t)nxt.pm * tstep : cA; const char* nB = has_next ? (const char*)g.Bt + (size_t)nxt.pn * tstep : cB;
        for (int t = 0; t < nt; t += 2) {
            const bool last = (t == nt - 2);
            const char* a1 = cA + (size_t)(t + 1) * kstep;
            const char* a2 = last ? nA : cA + (size_t)(t + 2) * kstep; const char* b2 = last ? nB : cB + (size_t)(t + 2) * kstep;
            const char* a3 = a2 + kstep; const char* b3 = b2 + kstep;
            if (last && has_next) S.a_ready(nxt);
            if constexpr (SP2) {
            PG8_LDB(B0, 0, 0); PG8_LDB(B1, 0, 1); PG8_SCHED; PG8_LDA(At, 0, 0); PG8_STAGE(PG8_SA(1, 1), a1 + hstep, voffA);
            PG8_WAIT_V(8); PG8_WAIT_L(0); PG8_BAR; PG8_MMA(0, 0, At, B0); PG8_MMA(0, 1, At, B1); PG8_BAR; PG8_SCHED;
            PG8_LDA(At, 0, 1); PG8_STAGE(PG8_SB(0, 0), b2, voffB); PG8_STAGE(PG8_SB(0, 1), b2 + hstep, voffB); PG8_STAGE(PG8_SA(0, 0), a2, voffA);
            PG8_WAIT_V(8); PG8_WAIT_L(0); PG8_BAR; PG8_MMA(1, 0, At, B0); PG8_MMA(1, 1, At, B1); PG8_BAR; PG8_SCHED;
            PG8_LDB(B0, 1, 0); PG8_LDB(B1, 1, 1); PG8_SCHED; PG8_LDA(At, 1, 0); PG8_STAGE(PG8_SA(0, 1), a2 + hstep, voffA);
            PG8_WAIT_V(8); PG8_WAIT_L(0); PG8_BAR; PG8_MMA(0, 0, At, B0); PG8_MMA(0, 1, At, B1); PG8_BAR; PG8_SCHED;
            PG8_LDA(At, 1, 1); PG8_STAGE(PG8_SB(1, 0), b3, voffB); PG8_STAGE(PG8_SB(1, 1), b3 + hstep, voffB); PG8_STAGE(PG8_SA(1, 0), a3, voffA);
            PG8_WAIT_V(8); PG8_WAIT_L(0); PG8_BAR; PG8_MMA(1, 0, At, B0); PG8_MMA(1, 1, At, B1); PG8_BAR; PG8_SCHED;
            } else {
            PG8_LDB(B0, 0, 0); PG8_SCHED; PG8_LDA(At, 0, 0); PG8_STAGE(PG8_SA(1, 1), a1 + hstep, voffA);
            PG8_WAIT_L(8); PG8_BAR; PG8_WAIT_L(0); PG8_MMA(0, 0, At, B0); PG8_BAR; PG8_SCHED;
            PG8_LDB(B1, 0, 1); PG8_STAGE(PG8_SB(0, 0), b2, voffB);
            PG8_BAR; PG8_WAIT_L(0); PG8_MMA(0, 1, At, B1); PG8_BAR;
            PG8_LDA(At, 0, 1); PG8_STAGE(PG8_SA(0, 0), a2, voffA);
            PG8_BAR; PG8_WAIT_L(0); PG8_MMA(1, 0, At, B0); PG8_BAR; PG8_SCHED;
            PG8_STAGE(PG8_SB(0, 1), b2 + hstep, voffB);
            PG8_WAIT_V(6); PG8_BAR; PG8_MMA(1, 1, At, B1); PG8_BAR;
            PG8_LDB(B0, 1, 0); PG8_SCHED; PG8_LDA(At, 1, 0); PG8_STAGE(PG8_SA(0, 1), a2 + hstep, voffA);
            PG8_WAIT_L(8); PG8_BAR; PG8_WAIT_L(0); PG8_MMA(0, 0, At, B0); PG8_BAR; PG8_SCHED;
            PG8_LDB(B1, 1, 1); PG8_STAGE(PG8_SB(1, 0), b3, voffB);
            PG8_BAR; PG8_WAIT_L(0); PG8_MMA(0, 1, At, B1); PG8_BAR;
            PG8_LDA(At, 1, 1); PG8_STAGE(PG8_SA(1, 0), a3, voffA);
            PG8_BAR; PG8_WAIT_L(0); PG8_MMA(1, 0, At, B0); PG8_BAR; PG8_SCHED;
            PG8_STAGE(PG8_SB(1, 1), b3 + hstep, voffB);
            PG8_WAIT_V(6); PG8_BAR; PG8_MMA(1, 1, At, B1); PG8_BAR;
            }
        }
        if constexpr (ALIGN_EPI) { if (wr == 0) PG8_BAR; }
        if constexpr (!Epi::AFTER_DRAIN) { E(acc, cur, wr, wc, fr, fq); S.done(cur); }
        if (!has_next) break;
#pragma unroll
        for (int a = 0; a < 2; ++a)
#pragma unroll
            for (int b = 0; b < 2; ++b)
#pragma unroll
                for (int m = 0; m < 4; ++m)
#pragma unroll
                    for (int n = 0; n < 2; ++n) acc[a][b][m][n] = (f32x4){0.f, 0.f, 0.f, 0.f};
        cur = nxt; cA = nA; cB = nB; ++ui;
        if constexpr (ALIGN_EPI) { if (wr == 1) PG8_BAR; }
    }
    PG8_WAIT_V(0);
    if constexpr (!ALIGN_EPI) { if (wr == 0) PG8_BAR; }
    PG8_BAR;
    if constexpr (Epi::AFTER_DRAIN) { E.fused(acc, cur, wr, wc, fr, fq, lds, wid, lane); S.done(cur); }
#undef PG8_SA
#undef PG8_SB
#undef PG8_STAGE
#undef PG8_LDA
#undef PG8_LDB
#undef PG8_MMA
#undef PG8_WAIT_V
#undef PG8_WAIT_L
#undef PG8_BAR
#undef PG8_SCHED
}

struct MUnit { int r0, rend, e, pn; };
#define MG_LANE_OFFS(u, o) do { const int _t = wid * 64 + fresh_lane(); _Pragma("unroll") for (int _i = 0; _i < 2; ++_i) { int _R, _C; stage_rc(_t * 16 + _i * 8192, _R, _C); _Pragma("unroll") for (int _h = 0; _h < 2; ++_h) { const int _r = (u).r0 + _h * HALF + _R; \
        int _row = _r; if (GATHER) { _row = 0; if (_r < (u).rend) _row = slot_tok[_r]; } (o)[_h][_i] = (unsigned)(_row * K + _C) * 2u; } } } while (0)
template <class Epi, class Sched, bool GATHER, int N, int K>
__device__ __forceinline__ void gemm_phase_moe(PG8_LAS unsigned char* lds, const bf16_t* A, const bf16_t* Bt, const int* slot_tok, const Sched& S, const Epi& E, int wave_id) {
    asm volatile("" : "+s"(wave_id));
    const int lane = fresh_lane(), wid = wave_id, tid = wid * 64 + lane, wr = wid >> 2, wc = wid & 3, fr = lane & 15, fq = lane >> 4;
    constexpr int nt = K / BK;
#define MG_OFFP(par) ((PG8_LAS unsigned*)(lds + STAGE_BYTES + 8192) + (par) * 2048 + tid)
#define MG_VOFFB ((PG8_LAS unsigned*)(lds + STAGE_BYTES + 24576) + tid)
#pragma unroll
    for (int i = 0; i < 2; ++i) { int R, C; stage_rc(tid * 16 + i * 8192, R, C); const int Rb = Epi::PERM ? ((R & ~31) + perm32(R & 31)) : R; MG_VOFFB[i * 512] = (unsigned)(Rb * K + C) * 2u; }
    constexpr size_t kstep = (size_t)(BK * 2);
    constexpr size_t hstep = (size_t)HALF * K * 2;
    constexpr size_t tstep = 2 * hstep;
    constexpr size_t estep = (size_t)N * K * 2;
    const unsigned ldsw = (unsigned)wid * 1024u;
    const int aoff = lds_byte(wr * 64 + fr, fq * 8), boff = lds_byte(wc * 32 + fr, fq * 8);
#define PG8_SA(b, h) (((b) * 2 + (h)) * HTB)
#define PG8_SB(b, h) ((4 + (b) * 2 + (h)) * HTB)
#define PG8_STAGE(bufoff, gbase, voff) do { _Pragma("unroll") for (int _i = 0; _i < 2; ++_i) \
        __builtin_amdgcn_global_load_lds((const unsigned*)((const char*)(gbase) + MG_VOFFB[_i * 512]), (PG8_LAS unsigned*)(lds + (bufoff) + ldsw + _i * 8192), 16, 0, 0); } while (0)
#define MG_STAGE_A(bufoff, par, h, kb) do { _Pragma("unroll") for (int _i = 0; _i < 2; ++_i) \
        __builtin_amdgcn_global_load_lds((const unsigned*)((const char*)A + (size_t)MG_OFFP(par)[((h) * 2 + _i) * 512] + (kb)), (PG8_LAS unsigned*)(lds + (bufoff) + ldsw + _i * 8192), 16, 0, 0); } while (0)
#define PG8_LDA(dst, b, h) do { _Pragma("unroll") for (int m = 0; m < 4; ++m) _Pragma("unroll") for (int k = 0; k < 2; ++k) dst[m][k] = *(const PG8_LAS bf16x8*)(lds + PG8_SA(b, h) + aoff + m * 2048 + k * 1024); } while (0)
#define PG8_LDB(dst, b, h) do { _Pragma("unroll") for (int n = 0; n < 2; ++n) _Pragma("unroll") for (int k = 0; k < 2; ++k) dst[n][k] = *(const PG8_LAS bf16x8*)(lds + PG8_SB(b, h) + boff + n * 2048 + k * 1024); } while (0)
#define PG8_MMA(ai, bj, At, Bt_) do { __builtin_amdgcn_s_setprio(1); _Pragma("unroll") for (int m = 0; m < 4; ++m) _Pragma("unroll") for (int n = 0; n < 2; ++n) _Pragma("unroll") for (int k = 0; k < 2; ++k) \
        acc[ai][bj][m][n] = __builtin_amdgcn_mfma_f32_16x16x32_bf16(Bt_[n][k], At[m][k], acc[ai][bj][m][n], 0, 0, 0); __builtin_amdgcn_s_setprio(0); } while (0)
#define PG8_WAIT_V(n) asm volatile("s_waitcnt vmcnt(" #n ")" ::: "memory")
#define PG8_WAIT_L(n) asm volatile("s_waitcnt lgkmcnt(" #n ")" ::: "memory")
#define PG8_BAR __builtin_amdgcn_s_barrier()
#define PG8_SCHED __builtin_amdgcn_sched_barrier(0)
    MUnit cur, nxt; int ui = 0;
    if (!S.next(0, cur)) return;
    f32x4 acc[2][2][4][2];
#pragma unroll
    for (int a = 0; a < 2; ++a)
#pragma unroll
        for (int b = 0; b < 2; ++b)
#pragma unroll
            for (int m = 0; m < 4; ++m)
#pragma unroll
                for (int n = 0; n < 2; ++n) acc[a][b][m][n] = (f32x4){0.f, 0.f, 0.f, 0.f};
    bf16x8 At[4][2], B0[2][2], B1[2][2];
    { unsigned o_[2][2]; MG_LANE_OFFS(cur, o_); PG8_LAS unsigned* p_ = MG_OFFP(0); p_[0] = o_[0][0]; p_[512] = o_[0][1]; p_[1024] = o_[1][0]; p_[1536] = o_[1][1]; }
    const char* cB = (const char*)Bt + (size_t)cur.e * estep + (size_t)cur.pn * tstep;
    PG8_STAGE(PG8_SB(0, 0), cB, voffB); PG8_STAGE(PG8_SB(0, 1), cB + hstep, voffB); MG_STAGE_A(PG8_SA(0, 0), 0, 0, 0); MG_STAGE_A(PG8_SA(0, 1), 0, 1, 0);
    if (wr == 1) PG8_BAR;
    PG8_WAIT_V(2); PG8_BAR;
    PG8_STAGE(PG8_SB(1, 0), cB + kstep, voffB); MG_STAGE_A(PG8_SA(1, 0), 0, 0, kstep); PG8_STAGE(PG8_SB(1, 1), cB + hstep + kstep, voffB);
    PG8_WAIT_V(6); PG8_BAR;
    for (;;) {
        const bool has_next = S.next(ui + 1, nxt);
        const bool hi_rows = (cur.rend - cur.r0) > HALF;
        const char* nB = cB;
        const int pc = ui & 1, pn_ = has_next ? (pc ^ 1) : pc;
        if (has_next) { unsigned on[2][2]; MG_LANE_OFFS(nxt, on); nB = (const char*)Bt + (size_t)nxt.e * estep + (size_t)nxt.pn * tstep;
            PG8_LAS unsigned* p_ = MG_OFFP(pn_); p_[0] = on[0][0]; p_[512] = on[0][1]; p_[1024] = on[1][0]; p_[1536] = on[1][1]; }
        for (int t = 0; t < nt; t += 2) {
            const bool last = (t == nt - 2);
            const size_t k1 = (size_t)(t + 1) * kstep, k2 = last ? (size_t)0 : (size_t)(t + 2) * kstep, k3 = k2 + kstep;
            const char* b2 = last ? nB : cB + (size_t)(t + 2) * kstep; const char* b3 = b2 + kstep;
            const int p2 = last ? pn_ : pc;
            PG8_LDB(B0, 0, 0); PG8_LDB(B1, 0, 1); PG8_SCHED; PG8_LDA(At, 0, 0); MG_STAGE_A(PG8_SA(1, 1), pc, 1, k1);
            PG8_WAIT_V(8); PG8_WAIT_L(0); PG8_BAR; PG8_MMA(0, 0, At, B0); PG8_MMA(0, 1, At, B1); PG8_BAR; PG8_SCHED;
            PG8_LDA(At, 0, 1); PG8_STAGE(PG8_SB(0, 0), b2, voffB); PG8_STAGE(PG8_SB(0, 1), b2 + hstep, voffB); MG_STAGE_A(PG8_SA(0, 0), p2, 0, k2);
            PG8_WAIT_V(8); PG8_WAIT_L(0); PG8_BAR; if (hi_rows) { PG8_MMA(1, 0, At, B0); PG8_MMA(1, 1, At, B1); } PG8_BAR; PG8_SCHED;
            PG8_LDB(B0, 1, 0); PG8_LDB(B1, 1, 1); PG8_SCHED; PG8_LDA(At, 1, 0); MG_STAGE_A(PG8_SA(0, 1), p2, 1, k2);
            PG8_WAIT_V(8); PG8_WAIT_L(0); PG8_BAR; PG8_MMA(0, 0, At, B0); PG8_MMA(0, 1, At, B1); PG8_BAR; PG8_SCHED;
            PG8_LDA(At, 1, 1); PG8_STAGE(PG8_SB(1, 0), b3, voffB); PG8_STAGE(PG8_SB(1, 1), b3 + hstep, voffB); MG_STAGE_A(PG8_SA(1, 0), p2, 0, k3);
            PG8_WAIT_V(8); PG8_WAIT_L(0); PG8_BAR; if (hi_rows) { PG8_MMA(1, 0, At, B0); PG8_MMA(1, 1, At, B1); } PG8_BAR; PG8_SCHED;
        }
        if (wr == 0) PG8_BAR;
        E(acc, cur, wr, wc, fr, fq);
        if (!has_next) break;
#pragma unroll
        for (int a = 0; a < 2; ++a)
#pragma unroll
            for (int b = 0; b < 2; ++b)
#pragma unroll
                for (int m = 0; m < 4; ++m)
#pragma unroll
                    for (int n = 0; n < 2; ++n) acc[a][b][m][n] = (f32x4){0.f, 0.f, 0.f, 0.f};
        cur = nxt; cB = nB; ++ui;
        if (wr == 1) PG8_BAR;
    }
    PG8_WAIT_V(0);
    PG8_BAR;
#undef PG8_SA
#undef PG8_SB
#undef PG8_STAGE
#undef MG_STAGE_A
#undef MG_OFFP
#undef MG_VOFFB
#undef PG8_LDA
#undef PG8_LDB
#undef PG8_MMA
#undef PG8_WAIT_V
#undef PG8_WAIT_L
#undef PG8_BAR
#undef PG8_SCHED
}
__device__ __forceinline__ float fast_silu(float x) { return x * __builtin_amdgcn_rcpf(1.0f + __builtin_amdgcn_exp2f(-1.4426950408889634f * x)); }
struct EpiMoeH {
    static constexpr bool PERM = true;
    bf16_t* H; const float* rs;
    __device__ __forceinline__ void operator()(const f32x4 (&acc)[2][2][4][2], const MUnit& u, int wr, int wc, int fr, int fq) const {
        { const int t_ = fresh_lane(); fr = t_ & 15; fq = t_ >> 4; }
        const int col0 = u.pn * 128 + wc * 32 + 8 * fq;
        float sc[2][4];
#pragma unroll
        for (int ai = 0; ai < 2; ++ai)
#pragma unroll
            for (int m = 0; m < 4; ++m) { const int r = u.r0 + ai * HALF + wr * 64 + m * 16 + fr; sc[ai][m] = (r < u.rend) ? rs[r] : 0.f; }
#pragma unroll
        for (int ai = 0; ai < 2; ++ai)
#pragma unroll
            for (int m = 0; m < 4; ++m) { const int r = u.r0 + ai * HALF + wr * 64 + m * 16 + fr;
                const float s_ = sc[ai][m];
                const f32x4 g0 = acc[ai][0][m][0] * s_, g1 = acc[ai][0][m][1] * s_, u0 = acc[ai][1][m][0] * s_, u1 = acc[ai][1][m][1] * s_;
                u32x4 w; w.x = cvt_pk_bf16(fast_silu(g0[0]) * u0[0], fast_silu(g0[1]) * u0[1]); w.y = cvt_pk_bf16(fast_silu(g0[2]) * u0[2], fast_silu(g0[3]) * u0[3]);
                w.z = cvt_pk_bf16(fast_silu(g1[0]) * u1[0], fast_silu(g1[1]) * u1[1]); w.w = cvt_pk_bf16(fast_silu(g1[2]) * u1[2], fast_silu(g1[3]) * u1[3]);
                if (r < u.rend) *(u32x4*)(H + (size_t)r * 256 + col0) = w; }
    }
};
struct EpiMoeY {
    static constexpr bool PERM = true;
    bf16_t* Y;
    __device__ __forceinline__ void operator()(const f32x4 (&acc)[2][2][4][2], const MUnit& u, int wr, int wc, int fr, int fq) const {
        { const int t_ = fresh_lane(); fr = t_ & 15; fq = t_ >> 4; }
        const int col0 = u.pn * BM + wc * 32 + 8 * fq;
#pragma unroll
        for (int ai = 0; ai < 2; ++ai)
#pragma unroll
            for (int m = 0; m < 4; ++m) { const int r = u.r0 + ai * HALF + wr * 64 + m * 16 + fr;
#pragma unroll
                for (int bj = 0; bj < 2; ++bj) { const f32x4 v0 = acc[ai][bj][m][0], v1 = acc[ai][bj][m][1];
                    u32x4 w; w.x = cvt_pk_bf16(v0[0], v0[1]); w.y = cvt_pk_bf16(v0[2], v0[3]); w.z = cvt_pk_bf16(v1[0], v1[1]); w.w = cvt_pk_bf16(v1[2], v1[3]);
                    if (r < u.rend) *(u32x4*)(Y + (size_t)r * 1024 + col0 + bj * HALF) = w; } }
    }
};
struct MoeSched {
    const PG8_LAS int* tab;
    int npn, first, end, stride, c, split;
    __device__ __forceinline__ bool next(int i, MUnit& u) const {
        int L = first + c + i * stride;
        if (c < 0 || L >= end) return false;
        const int half = split ? (L & 1) : 0; if (split) L >>= 1;
        const int j = L / npn; u.pn = L % npn;
        u.e = __builtin_amdgcn_readfirstlane(tab[4 + 4 * j]); u.r0 = __builtin_amdgcn_readfirstlane(tab[5 + 4 * j]); u.rend = __builtin_amdgcn_readfirstlane(tab[6 + 4 * j]);
        if (split) { u.r0 += HALF * half; const int cap = u.r0 + HALF; u.rend = u.rend < cap ? u.rend : cap; }
        return true;
    }
};
}

#ifndef PG8_SP2
#define PG8_SP2 true
#endif
#ifndef PG8_ALIGN
#define PG8_ALIGN true
#endif

constexpr int NWAVES = 8, NT = NWAVES * 64;
constexpr int D = 1024, NB = 2, S = 8192, T = NB * S, DEPTH = 2;
constexpr int DIN = 2832, PLD = 3072;
constexpr int C_Q = 0, C_K = 256, C_V = 512, C_G = 1024, C_GK = 1536, C_U = 1552, C_VG = 1808, C_XI = 2064, C_BG = 2320, C_CG = 2576;
constexpr int GH = 4, GC = 64, GN = S / GC;
constexpr int MH = 4, MC = 128, MN = S / MC;
constexpr int NE = 32, DE = 256;
constexpr float EPS = 1e-6f;
constexpr size_t MiB = 1u << 20;
constexpr size_t WS_CTL = 0, CTL_BYTES = 1 * MiB;
constexpr size_t WS_WIN = 1 * MiB;
constexpr size_t WS_WOUT = 13 * MiB;
constexpr size_t WS_WGU = 17 * MiB;
constexpr size_t WS_WD = 81 * MiB;
constexpr size_t WS_XN = 113 * MiB;
constexpr size_t WS_P = 145 * MiB;
constexpr size_t WS_Y = WS_P + 17 * MiB;
constexpr size_t WS_S = 276 * MiB;
constexpr size_t WS_XRES = 241 * MiB;
constexpr size_t WS_DEC = 273 * MiB;
constexpr size_t WS_MISC = 274 * MiB;
constexpr size_t WS_WSP = WS_MISC + 524288;
constexpr size_t WS_RINV1 = WS_MISC + 786432, WS_RINV2 = WS_RINV1 + 65536, WS_SRINV = WS_RINV2 + 65536;
constexpr size_t WS_WR = 275 * MiB;
constexpr size_t WS_BLKCNT = WS_WR + 524288;
constexpr size_t WS_END = 284 * MiB;
constexpr int CW_BAR = 4096, CW_CNT = 16384;
constexpr int RING_BYTES = 131072, LDSCTL_OFF = RING_BYTES, MISC_OFF = LDSCTL_OFF + 320, LDS_BYTES = 163840;

#define GAS __attribute__((address_space(1)))
#define LAS __attribute__((address_space(3)))
typedef unsigned short bf16;
typedef unsigned v4u __attribute__((ext_vector_type(4)));
typedef unsigned v2u __attribute__((ext_vector_type(2)));
typedef float f32x4 __attribute__((ext_vector_type(4)));
typedef __bf16 bf16x2_t __attribute__((ext_vector_type(2)));
typedef float f32x2_t __attribute__((ext_vector_type(2)));
__device__ __forceinline__ unsigned f2bf(float f) { return (unsigned)__builtin_bit_cast(unsigned short, (__bf16)f); }
__device__ __forceinline__ unsigned pk2(float lo, float hi) { f32x2_t v = {lo, hi}; bf16x2_t b = __builtin_convertvector(v, bf16x2_t); return __builtin_bit_cast(unsigned, b); }
__device__ __forceinline__ float bf2f(unsigned v) { return __uint_as_float(v << 16); }
__device__ __forceinline__ float bflo(unsigned w) { return __uint_as_float(w << 16); }
__device__ __forceinline__ float bfhi(unsigned w) { return __uint_as_float(w & 0xffff0000u); }
__device__ __forceinline__ void unpack8(const v4u q, float (&f)[8]) { f[0] = bflo(q.x); f[1] = bfhi(q.x); f[2] = bflo(q.y); f[3] = bfhi(q.y); f[4] = bflo(q.z); f[5] = bfhi(q.z); f[6] = bflo(q.w); f[7] = bfhi(q.w); }
__device__ __forceinline__ float gelu_tanh(float x) { const float u = 0.7978845608028654f * (x + 0.044715f * x * x * x); return 0.5f * x * (1.0f + tanhf(u)); }
__device__ __forceinline__ float silu(float x) { return x / (1.0f + expf(-x)); }
__device__ __forceinline__ float log_sigmoid(float x) { return fminf(x, 0.f) - log1pf(expf(-fabsf(x))); }

#define XB_TMO      128
#define XB_XCNT(j)  (256  + 64 * (j))
#define XB_XSUB(j)  (1280 + 64 * (j))
#define XB_XGEN(j)  (2304 + 64 * (j))
#define XB_TOP      3328
#define XB_TOPGEN   3392
#define XCD_BAR_WORDS 3456
#define XB_SPIN_CAP (1u << 18)

__device__ __forceinline__ unsigned xb_ld(unsigned* p)              { return __hip_atomic_load(p, __ATOMIC_RELAXED, __HIP_MEMORY_SCOPE_AGENT); }
__device__ __forceinline__ unsigned xb_add(unsigned* p, unsigned v) { return __hip_atomic_fetch_add(p, v, __ATOMIC_RELAXED, __HIP_MEMORY_SCOPE_AGENT); }
__device__ __forceinline__ unsigned xb_xcc_id() { return (unsigned)__builtin_amdgcn_s_getreg((3 << 11) | 20) & 0xFu; }
#define XB_SPIN(cond, bar) do { unsigned _sp = 0; while (cond) { __builtin_amdgcn_s_sleep(1); \
    if ((++_sp & 255u) == 0u) { if (xb_ld(&(bar)[XB_TMO])) break; if (_sp > XB_SPIN_CAP) { atomicAdd(&(bar)[XB_TMO], 1u); break; } } } } while (0)

struct XcdBarrier {
    int wave;
    unsigned* bar; unsigned x;
    volatile LAS unsigned* st;
};

__device__ __forceinline__ XcdBarrier xcd_barrier_post(unsigned* bar, volatile LAS unsigned* st) {
    XcdBarrier b; b.bar = bar; b.x = xb_xcc_id(); b.st = st; b.wave = __builtin_amdgcn_readfirstlane(threadIdx.x >> 6);
    if (threadIdx.x == 0) (void)xb_add(&bar[XB_XCNT(b.x)], 1u);
    return b;
}
__device__ __forceinline__ void xcd_barrier_complete(unsigned* bar, unsigned x, unsigned& nloc, unsigned& nx) {
    const unsigned G = gridDim.x * gridDim.y * gridDim.z;
    unsigned sum, cnt, mine, sp = 0u;
    for (;;) {
        sum = 0u; cnt = 0u; mine = 0u;
#pragma unroll
        for (unsigned j = 0; j < 16; ++j) { const unsigned c = xb_ld(&bar[XB_XCNT(j)]); sum += c; cnt += (c > 0u) ? 1u : 0u; mine = (j == x) ? c : mine; }
        if (sum == G) break;
        __builtin_amdgcn_s_sleep(1);
        if ((++sp & 255u) == 0u) { if (xb_ld(&bar[XB_TMO])) break; if (sp > XB_SPIN_CAP) { atomicAdd(&bar[XB_TMO], 1u); break; } }
    }
    nloc = mine > 0u ? mine : 1u; nx = cnt > 0u ? cnt : 1u;
}

__device__ __forceinline__ void xcd_barrier(const XcdBarrier& b) {
    asm volatile("s_waitcnt vmcnt(0)" ::: "memory");
    __syncthreads();
    if (b.wave == 0 && fresh_lane() == 0) {
        unsigned* bar = b.bar; asm volatile("" : "+s"(bar));
        __builtin_amdgcn_s_waitcnt(0);
        unsigned nloc = b.st[0], nx = b.st[1];
        if (nloc == 0u) { xcd_barrier_complete(bar, b.x, nloc, nx); b.st[0] = nloc; b.st[1] = nx; }
        const unsigned old = xb_add(&bar[XB_XSUB(b.x)], 1u);
        const unsigned gen = old / nloc;
        if (old + 1u == (gen + 1u) * nloc) {
            __builtin_amdgcn_fence(__ATOMIC_RELEASE, "agent");
            asm volatile("s_waitcnt vmcnt(0)" ::: "memory");
            const unsigned og = xb_add(&bar[XB_TOP], 1u);
            const unsigned tg = og / nx;
            if (og + 1u == (tg + 1u) * nx) xb_add(&bar[XB_TOPGEN], 1u);
            else XB_SPIN(xb_ld(&bar[XB_TOPGEN]) == tg, bar);
            __builtin_amdgcn_fence(__ATOMIC_ACQUIRE, "agent");
            xb_add(&bar[XB_XGEN(b.x)], 1u);
            asm volatile("s_waitcnt vmcnt(0)" ::: "memory");
        } else {
            XB_SPIN(xb_ld(&bar[XB_XGEN(b.x)]) == gen, bar);
            __builtin_amdgcn_fence(__ATOMIC_ACQUIRE, "agent");
            asm volatile("s_waitcnt vmcnt(0)" ::: "memory");
        }
    }
    __syncthreads();
}

#define AS4 __attribute__((address_space(4)))
struct KA {
    const AS4 char* ka;
    static __device__ __forceinline__ KA fresh() { KA k; k.ka = (const AS4 char*)__builtin_amdgcn_kernarg_segment_ptr(); asm volatile("" : "+s"(k.ka)); return k; }
    __device__ __forceinline__ const float* in(int i) const { return *(const float* const AS4*)(ka + 8 * i); }
    __device__ __forceinline__ float* out() const { return *(float* const AS4*)(ka + 160); }
    __device__ __forceinline__ unsigned char* ws() const { return *(unsigned char* const AS4*)(ka + 168); }
    __device__ __forceinline__ unsigned* ctl() const { return (unsigned*)(ws() + WS_CTL); }
    __device__ __forceinline__ bf16* WinT() const { return (bf16*)(ws() + WS_WIN); }
    __device__ __forceinline__ bf16* WoutT() const { return (bf16*)(ws() + WS_WOUT); }
    __device__ __forceinline__ bf16* WguT() const { return (bf16*)(ws() + WS_WGU); }
    __device__ __forceinline__ bf16* WdT() const { return (bf16*)(ws() + WS_WD); }
    __device__ __forceinline__ bf16* XN() const { return (bf16*)(ws() + WS_XN); }
    __device__ __forceinline__ bf16* P() const { return (bf16*)(ws() + WS_P); }
    __device__ __forceinline__ bf16* H1() const { return (bf16*)(ws() + WS_P); }
    __device__ __forceinline__ bf16* Y() const { return (bf16*)(ws() + WS_Y); }
    __device__ __forceinline__ float* Sst() const { return (float*)(ws() + WS_S); }
    __device__ __forceinline__ float* dec() const { return (float*)(ws() + WS_DEC); }
    __device__ __forceinline__ int* eid() const { return (int*)(ws() + WS_MISC); }
    __device__ __forceinline__ float* ew() const { return (float*)(ws() + WS_MISC + 131072); }
    __device__ __forceinline__ int* slot_tok() const { return (int*)(ws() + WS_MISC + 2 * 131072); }
    __device__ __forceinline__ int* slot_of() const { return (int*)(ws() + WS_MISC + 3 * 131072); }
    __device__ __forceinline__ bf16* Wsp() const { return (bf16*)(ws() + WS_WSP); }
    __device__ __forceinline__ bf16* Wr() const { return (bf16*)(ws() + WS_WR); }
    __device__ __forceinline__ bf16* XR() const { return (bf16*)(ws() + WS_XRES); }
    __device__ __forceinline__ int* blkcnt() const { return (int*)(ws() + WS_BLKCNT); }
    __device__ __forceinline__ float* rinv1() const { return (float*)(ws() + WS_RINV1); }
    __device__ __forceinline__ float* rinv2() const { return (float*)(ws() + WS_RINV2); }
    __device__ __forceinline__ float* srinv() const { return (float*)(ws() + WS_SRINV); }
};
struct Frame {
    LAS unsigned char* lds; float* smem;
    int G, bx, wave;
};
#define PHASE_TID const int lane = fresh_lane(), wave = F.wave, tid = wave * 64 + lane; (void)lane; (void)wave; (void)tid

__device__ __forceinline__ float wave_sum(float v) {
    v = sum16(v);
    const int iv = __float_as_int(v);
    return (__int_as_float(__builtin_amdgcn_readlane(iv, 0)) + __int_as_float(__builtin_amdgcn_readlane(iv, 16))) + (__int_as_float(__builtin_amdgcn_readlane(iv, 32)) + __int_as_float(__builtin_amdgcn_readlane(iv, 48)));
}

struct TrItem { const float* W; bf16* WT; int ldw, nvalid, k0, n0, ldt, drow0; const float* gain; };
__device__ __forceinline__ void transpose_load(const TrItem& t, int lane, f32x4 (&v)[8]) {
    const int sub = lane >> 3, c4 = (lane & 7) * 4;
#pragma unroll
    for (int i = 0; i < 8; ++i) v[i] = (c4 < t.nvalid) ? __builtin_nontemporal_load((const f32x4*)(t.W + (size_t)(t.k0 + 8 * i + sub) * t.ldw + t.n0 + c4)) : (f32x4){0.f, 0.f, 0.f, 0.f};
    if (t.gain) {
#pragma unroll
        for (int i = 0; i < 8; ++i) v[i] *= t.gain[t.k0 + 8 * i + sub]; }
}
__device__ __forceinline__ void transpose_store(const TrItem& t, int lane, const f32x4 (&v)[8], LAS float* scr) {
    const int sub = lane >> 3, c4 = (lane & 7) * 4;
#pragma unroll
    for (int i = 0; i < 8; ++i) { LAS float* d = scr + (8 * i + sub) * 33 + c4; d[0] = v[i].x; d[1] = v[i].y; d[2] = v[i].z; d[3] = v[i].w; }
    asm volatile("s_waitcnt lgkmcnt(0)" ::: "memory");
    const int c = lane & 7;
#pragma unroll
    for (int j = 0; j < 4; ++j) { const int n = (lane >> 3) + 8 * j; const LAS float* s = scr + (8 * c) * 33 + n;
        v4u o; o.x = pk2(s[0 * 33], s[1 * 33]); o.y = pk2(s[2 * 33], s[3 * 33]); o.z = pk2(s[4 * 33], s[5 * 33]); o.w = pk2(s[6 * 33], s[7 * 33]);
        if (n < t.nvalid) *(GAS v4u*)(t.WT + (size_t)(t.drow0 + n) * t.ldt + t.k0 + 8 * c) = o; }
    asm volatile("s_waitcnt lgkmcnt(0)" ::: "memory");
}
__device__ __forceinline__ void p0_prologue(Frame& F) {
    const KA K = KA::fresh(); PHASE_TID;
    LAS float* scr = (LAS float*)(F.lds + wave * 16384);
    const int gw = F.bx * NWAVES + wave, NGW = F.G * NWAVES;
    constexpr int I_IN = 16 * 89, I_OUT = 16 * 32, I_G = 32 * 16 * 8, I_D = 32 * 4 * 32, I_L = I_IN + I_OUT + 2 * I_G + I_D;
#define TR_DECODE(it_, t_) do { const int l_ = (it_) / I_L; int r_ = (it_) % I_L; \
        if (r_ < I_IN) { const int kb = r_ / 89, nb = r_ % 89; t_ = TrItem{K.in(2) + (size_t)l_ * D * DIN, K.WinT() + (size_t)l_ * PLD * D, DIN, (nb == 88) ? 16 : 32, kb * 64, nb * 32, D, nb * 32, K.in(1) + (size_t)l_ * D}; } \
        else if (r_ < I_IN + I_OUT) { r_ -= I_IN; const int kb = r_ / 32, nb = r_ % 32; t_ = TrItem{K.in(10) + (size_t)l_ * D * D, K.WoutT() + (size_t)l_ * D * D, D, 32, kb * 64, nb * 32, D, nb * 32, nullptr}; } \
        else if (r_ < I_IN + I_OUT + 2 * I_G) { r_ -= I_IN + I_OUT; const int sel = r_ / I_G; r_ %= I_G; const int e = r_ / 128, kb = (r_ % 128) / 8, n0 = (r_ % 8) * 32; \
            t_ = TrItem{K.in(16 + sel) + ((size_t)l_ * NE + e) * D * DE, K.WguT() + ((size_t)l_ * NE + e) * 512 * D, DE, 32, kb * 64, n0, D, (n0 >> 7) * 256 + sel * 128 + (n0 & 127), K.in(11) + (size_t)l_ * D}; } \
        else { r_ -= I_IN + I_OUT + 2 * I_G; const int e = r_ / 128, kb = (r_ % 128) / 32, nb = r_ % 32; t_ = TrItem{K.in(18) + ((size_t)l_ * NE + e) * DE * D, K.WdT() + ((size_t)l_ * NE + e) * D * DE, D, 32, kb * 64, nb * 32, DE, nb * 32, nullptr}; } } while (0)
    {
        TrItem cur, nxt; f32x4 vc[8], vn[8];
        int it = gw;
        if (it < DEPTH * I_L) { TR_DECODE(it, cur); transpose_load(cur, lane, vc); }
#pragma unroll 1
        for (; it < DEPTH * I_L; it += NGW) {
            const bool more = it + NGW < DEPTH * I_L;
            if (more) { TR_DECODE(it + NGW, nxt); transpose_load(nxt, lane, vn); }
            transpose_store(cur, lane, vc, scr);
            cur = nxt;
#pragma unroll
            for (int i = 0; i < 8; ++i) vc[i] = vn[i];
        }
    }
#undef TR_DECODE
    for (int i = F.bx * NT + tid; i < DEPTH * 240 * 128; i += F.G * NT) { const int l = i / (240 * 128), rr = (i / 128) % 240, c = i % 128;
        *(GAS v4u*)(K.WinT() + ((size_t)l * PLD + DIN + rr) * D + c * 8) = (v4u){0u, 0u, 0u, 0u}; }
    for (int i = F.bx * NT + tid; i < DEPTH * 48 * D; i += F.G * NT) { const int ll = i / (48 * D), n = (i / D) % 48, k = i % D;
        float w = 0.f;
        if (n < 4) w = K.in(12)[((size_t)ll * D + k) * 4 + n]; else if (n < 36) w = K.in(14)[((size_t)ll * D + k) * 32 + (n - 4)];
        w *= K.in(11)[(size_t)ll * D + k];
        const unsigned hi = f2bf(w), lo = f2bf(w - bf2f(hi));
        K.Wr()[((size_t)ll * 2 + 0) * 48 * D + (size_t)n * D + k] = (bf16)hi; K.Wr()[((size_t)ll * 2 + 1) * 48 * D + (size_t)n * D + k] = (bf16)lo; }
    for (int i = F.bx * NT + tid; i < DEPTH * MH * 128 * 128 / 8; i += F.G * NT) { const int e0 = i * 8, s0 = e0 & 127, t = (e0 >> 7) & 127;
        const f32x4 a = *(const f32x4*)(K.in(7) + e0), c = *(const f32x4*)(K.in(7) + e0 + 4);
        const float v[8] = {a.x, a.y, a.z, a.w, c.x, c.y, c.z, c.w}; unsigned w[4];
#pragma unroll
        for (int j = 0; j < 4; ++j) w[j] = pk2((s0 + 2 * j <= t) ? v[2 * j] : 0.f, (s0 + 2 * j + 1 <= t) ? v[2 * j + 1] : 0.f);
        *(GAS v4u*)(K.Wsp() + e0) = (v4u){w[0], w[1], w[2], w[3]}; }
    {
        f32x4 v[4], vn[4];
        int m = gw;
        if (m < T) {
#pragma unroll
            for (int j = 0; j < 4; ++j) v[j] = __builtin_nontemporal_load((const f32x4*)(K.in(0) + (size_t)m * D) + lane + 64 * j); }
#pragma unroll 1
        for (; m < T; m += NGW) {
            if (m + NGW < T) {
#pragma unroll
                for (int j = 0; j < 4; ++j) vn[j] = __builtin_nontemporal_load((const f32x4*)(K.in(0) + (size_t)(m + NGW) * D) + lane + 64 * j); }
            float s_ = 0.f;
#pragma unroll
            for (int j = 0; j < 4; ++j) s_ += (v[j].x * v[j].x + v[j].y * v[j].y) + (v[j].z * v[j].z + v[j].w * v[j].w);
            const float rs = rsqrtf(wave_sum(s_) * (1.f / D) + EPS);
            v2u* r8 = (v2u*)(K.XR() + (size_t)m * D) + lane;
            if (lane == 0) K.rinv1()[m] = rs;
#pragma unroll
            for (int j = 0; j < 4; ++j) { r8[64 * j] = (v2u){pk2(v[j].x, v[j].y), pk2(v[j].z, v[j].w)}; v[j] = vn[j]; }
        }
    }
}

typedef short bf16x8 __attribute__((ext_vector_type(8)));
__device__ __forceinline__ float fexp(float x) { return __builtin_amdgcn_exp2f(x * 1.4426950408889634f); }
__device__ __forceinline__ float logsig_fast(float x) { return fminf(x, 0.f) - __log2f(1.0f + fexp(-fabsf(x))) * 0.6931471805599453f; }
__device__ __forceinline__ float silu_fast(float x) { return x * __builtin_amdgcn_rcpf(1.0f + __builtin_amdgcn_exp2f(-1.4426950408889634f * x)); }
__device__ __forceinline__ float gelu_fast(float x) { const float u = 0.7978845608028654f * (x + 0.044715f * x * x * x); return x * __builtin_amdgcn_rcpf(1.0f + __builtin_amdgcn_exp2f(-2.8853900817779268f * u)); }
__device__ __forceinline__ f32x4 mfma16(bf16x8 a, bf16x8 b, f32x4 c) { return __builtin_amdgcn_mfma_f32_16x16x32_bf16(a, b, c, 0, 0, 0); }
constexpr int LROWB = 144;
constexpr int L_QD = 0, L_KI = 9216, L_KDT = 18432, L_VT = 27648, L_S = 46080, L_ST = 55296, L_OB = 73728, L_TOT = 107520, OBROW = 528;
#define FRAG(base, row, kel) (*(const LAS bf16x8*)(lds + (base) + (row) * LROWB + (kel) * 2))

constexpr int L_GKL = 109568, L_BL = 117760, SCN = 4, NSC = GN / SCN, NITEM = NB * GH * NSC;
#define FRAG(base, row, kel) (*(const LAS bf16x8*)(lds + (base) + (row) * LROWB + (kel) * 2))
struct GlaPre { unsigned short k[8], q[8], v[16]; v4u g0, g1; };
template <bool WITH_Q>
__device__ __forceinline__ void gla_prefetch(GlaPre& p, const bf16* P, int h, int t0, int tid, int lane, int wave) {
    const bf16* kp = P + (size_t)(t0 + 8 * wave) * PLD + C_K + h * 64 + lane;
#pragma unroll
    for (int j = 0; j < 8; ++j) p.k[j] = kp[(size_t)j * PLD];
    const int vv = tid & 127, cq = tid >> 7;
    const bf16* vp = P + (size_t)(t0 + 16 * cq) * PLD + C_V + h * 128 + vv;
#pragma unroll
    for (int j = 0; j < 16; ++j) p.v[j] = vp[(size_t)j * PLD];
    if (WITH_Q) {
        const bf16* qp = kp + (C_Q - C_K);
#pragma unroll
        for (int j = 0; j < 8; ++j) p.q[j] = qp[(size_t)j * PLD];
        const v4u* gr = (const v4u*)(P + (size_t)(t0 + (tid >> 3)) * PLD + C_G + h * 128 + 16 * (tid & 7));
        p.g0 = gr[0]; p.g1 = gr[1];
    }
}
__device__ __forceinline__ void gla_stage_gkl(const bf16* P, LAS unsigned char* lds, int tok0, int tid) {
    *(LAS v4u*)(lds + L_GKL + tid * 16) = *(const v4u*)(P + (size_t)(tok0 + (tid >> 1)) * PLD + C_GK + 8 * (tid & 1));
}
__device__ __forceinline__ void gla_b8_part(LAS unsigned char* lds, const float (&wu)[16], float bg, int n, int lane, int wave, float (&bv)[8]) {
    float run = 0.f;
#pragma unroll
    for (int j = 0; j < 8; ++j) {
        const LAS v4u* gl = (const LAS v4u*)(lds + L_GKL + (n * 64 + 8 * wave + j) * 32);
        float f0[8], f1[8]; unpack8(gl[0], f0); unpack8(gl[1], f1);
        float a = bg;
#pragma unroll
        for (int r = 0; r < 8; ++r) a += f0[r] * wu[r];
#pragma unroll
        for (int r = 0; r < 8; ++r) a += f1[r] * wu[8 + r];
        run += logsig_fast(a) * (1.0f / 16.0f); bv[j] = run;
    }
    ((LAS float*)(lds + L_TOT))[wave * 64 + lane] = run;
}
__device__ __forceinline__ float gla_b8_finish(LAS unsigned char* lds, int lane, int wave, float (&bv)[8]) {
    const LAS float* tot = (const LAS float*)(lds + L_TOT);
    float base = 0.f, all = 0.f;
#pragma unroll
    for (int g = 0; g < 8; ++g) { const float tv = tot[g * 64 + lane]; all += tv; if (g < wave) base += tv; }
#pragma unroll
    for (int j = 0; j < 8; ++j) bv[j] += base;
    return all;
}
__device__ __forceinline__ void gla_write_kdT_vT(LAS unsigned char* lds, const GlaPre& p, const float (&bv)[8], float bl, int tid, int lane, int wave) {
    float kd[8];
#pragma unroll
    for (int j = 0; j < 8; ++j) kd[j] = bf2f(p.k[j]) * fexp(bl - bv[j]);
    *(LAS v4u*)(lds + L_KDT + lane * LROWB + wave * 16) = (v4u){pk2(kd[0], kd[1]), pk2(kd[2], kd[3]), pk2(kd[4], kd[5]), pk2(kd[6], kd[7])};
    const int vv = tid & 127, cq = tid >> 7;
    LAS v4u* dst = (LAS v4u*)(lds + L_VT + vv * LROWB + cq * 32);
    dst[0] = (v4u){(unsigned)p.v[0] | ((unsigned)p.v[1] << 16), (unsigned)p.v[2] | ((unsigned)p.v[3] << 16), (unsigned)p.v[4] | ((unsigned)p.v[5] << 16), (unsigned)p.v[6] | ((unsigned)p.v[7] << 16)};
    dst[1] = (v4u){(unsigned)p.v[8] | ((unsigned)p.v[9] << 16), (unsigned)p.v[10] | ((unsigned)p.v[11] << 16), (unsigned)p.v[12] | ((unsigned)p.v[13] << 16), (unsigned)p.v[14] | ((unsigned)p.v[15] << 16)};
    if (wave == 0) ((LAS float*)(lds + L_BL))[lane] = bl;
}
__device__ __forceinline__ void gla_kv_mfma(LAS unsigned char* lds, int wave, int fr, int fq, f32x4 (&acc)[4]) {
    bf16x8 Bf[2];
#pragma unroll
    for (int ks = 0; ks < 2; ++ks) Bf[ks] = FRAG(L_VT, 16 * wave + fr, 32 * ks + 8 * fq);
#pragma unroll
    for (int dt = 0; dt < 4; ++dt) { acc[dt] = (f32x4){0.f, 0.f, 0.f, 0.f};
#pragma unroll
        for (int ks = 0; ks < 2; ++ks) acc[dt] = mfma16(FRAG(L_KDT, 16 * dt + fr, 32 * ks + 8 * fq), Bf[ks], acc[dt]); }
}

__device__ __forceinline__ void phase_gla_A2(Frame& F, int l) {
    const KA K = KA::fresh(); PHASE_TID;
    LAS unsigned char* lds = F.lds;
    const int fr = lane & 15, fq = lane >> 4;
#pragma unroll 1
    for (int it = F.bx; it < NITEM; it += F.G) {
        const int b = it / (GH * NSC), h = (it / NSC) % GH, sc = it % NSC, tok0 = b * S + sc * SCN * GC;
        const bf16* P = K.P();
        float wu[16];
        { const float* wup = K.in(3) + (size_t)l * 16 * 256 + h * 64 + lane;
#pragma unroll
          for (int r = 0; r < 16; ++r) wu[r] = wup[r * 256]; }
        const float bg = K.in(4)[l * 256 + h * 64 + lane];
        GlaPre pre[2]; gla_prefetch<false>(pre[0], P, h, tok0, tid, lane, wave); gla_prefetch<false>(pre[1], P, h, tok0 + GC, tid, lane, wave);
        __syncthreads();
        gla_stage_gkl(P, lds, tok0, tid);
        __syncthreads();
        f32x4 Sl[4], bs[4];
#pragma unroll
        for (int dt = 0; dt < 4; ++dt) { Sl[dt] = (f32x4){0.f, 0.f, 0.f, 0.f}; bs[dt] = (f32x4){0.f, 0.f, 0.f, 0.f}; }
#pragma unroll
        for (int n = 0; n < SCN; ++n) {
            float bv[8]; gla_b8_part(lds, wu, bg, n, lane, wave, bv);
            __syncthreads();
            const float bl = gla_b8_finish(lds, lane, wave, bv);
            gla_write_kdT_vT(lds, pre[n & 1], bv, bl, tid, lane, wave);
            if (n + 2 < SCN) gla_prefetch<false>(pre[n & 1], P, h, tok0 + (n + 2) * GC, tid, lane, wave);
            __syncthreads();
            f32x4 acc[4]; gla_kv_mfma(lds, wave, fr, fq, acc);
#pragma unroll
            for (int dt = 0; dt < 4; ++dt) { const f32x4 bl4 = *(const LAS f32x4*)(lds + L_BL + (16 * dt + 4 * fq) * 4);
                bs[dt] = bs[dt] + bl4;
#pragma unroll
                for (int r = 0; r < 4; ++r) Sl[dt][r] = fexp(bl4[r]) * Sl[dt][r] + acc[dt][r]; }
        }
        f32x4* ag = (f32x4*)K.Sst() + ((size_t)(it * 8 + wave) * 4) * 64 + lane;
#pragma unroll
        for (int dt = 0; dt < 4; ++dt) ag[dt * 64] = Sl[dt];
        if (wave == 0 && fr == 0) { f32x4* dp = (f32x4*)K.dec() + (size_t)it * 16 + fq;
#pragma unroll
            for (int dt = 0; dt < 4; ++dt) dp[dt * 4] = (f32x4){fexp(bs[dt][0]), fexp(bs[dt][1]), fexp(bs[dt][2]), fexp(bs[dt][3])}; }
    }
}


__device__ __forceinline__ void phase_gla_aggscan(Frame& F) {
    const KA K = KA::fresh(); PHASE_TID;
#pragma unroll 1
    for (int e = F.bx * NT + tid; e < NB * GH * 8192; e += F.G * NT) {
        const int bh = e >> 13, el = e & 8191, ln = (el >> 2) & 63, dt = (el >> 8) & 3, r = el & 3;
        float* ap = K.Sst() + (size_t)bh * NSC * 8192 + el; const float* dp = K.dec() + (size_t)bh * NSC * 64 + dt * 16 + (ln >> 4) * 4 + r;
        float st = 0.f;
#pragma unroll 1
        for (int j0 = 0; j0 < NSC; j0 += 16) {
            float a[16], d[16];
#pragma unroll
            for (int j = 0; j < 16; ++j) { a[j] = ap[(size_t)(j0 + j) * 8192]; d[j] = dp[(j0 + j) * 64]; }
#pragma unroll
            for (int j = 0; j < 16; ++j) { ap[(size_t)(j0 + j) * 8192] = st; st = d[j] * st + a[j]; }
        }
    }
}
template <class Bar>
__device__ __forceinline__ void phase_gla_C2(Frame& F, int l, const Bar& bar) {
    const KA K = KA::fresh(); PHASE_TID;
    LAS unsigned char* lds = F.lds;
    const int fr = lane & 15, fq = lane >> 4;
    const float* gnorm = K.in(5) + (size_t)l * 128;
#pragma unroll 1
    for (int it = F.bx; it < NITEM; it += F.G) {
        const int b = it / (GH * NSC), h = (it / NSC) % GH, sc = it % NSC, tok0 = b * S + sc * SCN * GC;
        const bf16* P = K.P();
        float wu[16];
        { const float* wup = K.in(3) + (size_t)l * 16 * 256 + h * 64 + lane;
#pragma unroll
          for (int r = 0; r < 16; ++r) wu[r] = wup[r * 256]; }
        const float bg = K.in(4)[l * 256 + h * 64 + lane];
        GlaPre pre[2]; gla_prefetch<true>(pre[0], P, h, tok0, tid, lane, wave); gla_prefetch<true>(pre[1], P, h, tok0 + GC, tid, lane, wave);
        __syncthreads();
        gla_stage_gkl(P, lds, tok0, tid);
        if (it == F.bx) { phase_gla_aggscan(F); xcd_barrier(bar); }
        f32x4 Sm[4];
        { const f32x4* ag = (const f32x4*)K.Sst() + ((size_t)(it * 8 + wave) * 4) * 64 + lane;
#pragma unroll
          for (int dt = 0; dt < 4; ++dt) Sm[dt] = ag[dt * 64]; }
        __syncthreads();
#pragma unroll
        for (int n = 0; n < SCN; ++n) {
            const int t0 = tok0 + n * GC;
            GlaPre& pr = pre[n & 1];
            float bv[8]; gla_b8_part(lds, wu, bg, n, lane, wave, bv);
            __syncthreads();
            const float bl = gla_b8_finish(lds, lane, wave, bv);
            gla_write_kdT_vT(lds, pr, bv, bl, tid, lane, wave);
#pragma unroll
            for (int j = 0; j < 8; ++j) {
                const float e = fexp(bv[j]);
                *(LAS bf16*)(lds + L_QD + (8 * wave + j) * LROWB + lane * 2) = (bf16)f2bf(bf2f(pr.q[j]) * 0.125f * e);
                *(LAS bf16*)(lds + L_KI + (8 * wave + j) * LROWB + lane * 2) = (bf16)f2bf(bf2f(pr.k[j]) * __builtin_amdgcn_rcpf(e));
            }
#pragma unroll
            for (int dt = 0; dt < 4; ++dt) *(LAS v2u*)(lds + L_ST + (16 * wave + fr) * LROWB + (16 * dt + 4 * fq) * 2) = (v2u){pk2(Sm[dt][0], Sm[dt][1]), pk2(Sm[dt][2], Sm[dt][3])};
            const v4u gq0 = pr.g0, gq1 = pr.g1;
            if (n + 2 < SCN) gla_prefetch<true>(pr, P, h, t0 + 2 * GC, tid, lane, wave);
            __syncthreads();
#pragma unroll
            for (int i = 0; i < 2; ++i) {
                const int tix = 2 * wave + i, st = tix >> 2, ct = tix & 3;
                f32x4 a = (f32x4){0.f, 0.f, 0.f, 0.f};
#pragma unroll
                for (int ks = 0; ks < 2; ++ks) a = mfma16(FRAG(L_KI, 16 * st + fr, 32 * ks + 8 * fq), FRAG(L_QD, 16 * ct + fr, 32 * ks + 8 * fq), a);
                const int s0 = 16 * st + 4 * fq, c = 16 * ct + fr;
                float m[4];
#pragma unroll
                for (int r = 0; r < 4; ++r) m[r] = (s0 + r <= c) ? a[r] : 0.f;
                *(LAS v2u*)(lds + L_S + c * LROWB + s0 * 2) = (v2u){pk2(m[0], m[1]), pk2(m[2], m[3])};
            }
            f32x4 kv[4]; gla_kv_mfma(lds, wave, fr, fq, kv);
            __syncthreads();
            {
                bf16x8 Av[2], As[2];
#pragma unroll
                for (int ks = 0; ks < 2; ++ks) { Av[ks] = FRAG(L_VT, 16 * wave + fr, 32 * ks + 8 * fq); As[ks] = FRAG(L_ST, 16 * wave + fr, 32 * ks + 8 * fq); }
#pragma unroll
                for (int ct = 0; ct < 4; ++ct) {
                    f32x4 a = (f32x4){0.f, 0.f, 0.f, 0.f};
#pragma unroll
                    for (int ks = 0; ks < 2; ++ks) { a = mfma16(Av[ks], FRAG(L_S, 16 * ct + fr, 32 * ks + 8 * fq), a); a = mfma16(As[ks], FRAG(L_QD, 16 * ct + fr, 32 * ks + 8 * fq), a); }
                    *(LAS f32x4*)(lds + L_OB + (16 * ct + fr) * OBROW + (16 * wave + 4 * fq) * 4) = a;
                }
            }
#pragma unroll
            for (int dt = 0; dt < 4; ++dt) { const f32x4 bl4 = *(const LAS f32x4*)(lds + L_BL + (16 * dt + 4 * fq) * 4);
#pragma unroll
                for (int r = 0; r < 4; ++r) Sm[dt][r] = fexp(bl4[r]) * Sm[dt][r] + kv[dt][r]; }
            __syncthreads();
            {
                const int c = tid >> 3, vg = tid & 7;
                const LAS f32x4* ob = (const LAS f32x4*)(lds + L_OB + c * OBROW + vg * 64);
                f32x4 o[4]; float ss = 0.f;
#pragma unroll
                for (int j = 0; j < 4; ++j) { o[j] = ob[j]; ss += (o[j].x * o[j].x + o[j].y * o[j].y) + (o[j].z * o[j].z + o[j].w * o[j].w); }
                ss = sum8(ss);
                const float rs = rsqrtf(ss * (1.0f / 128.0f) + EPS);
                float g0[8], g1[8]; unpack8(gq0, g0); unpack8(gq1, g1);
                const f32x4* gn = (const f32x4*)(gnorm + 16 * vg);
                const f32x4 n0 = gn[0], n1 = gn[1], n2 = gn[2], n3 = gn[3];
                v4u w0, w1;
                w0.x = pk2(o[0].x * rs * n0.x * silu_fast(g0[0]), o[0].y * rs * n0.y * silu_fast(g0[1])); w0.y = pk2(o[0].z * rs * n0.z * silu_fast(g0[2]), o[0].w * rs * n0.w * silu_fast(g0[3]));
                w0.z = pk2(o[1].x * rs * n1.x * silu_fast(g0[4]), o[1].y * rs * n1.y * silu_fast(g0[5])); w0.w = pk2(o[1].z * rs * n1.z * silu_fast(g0[6]), o[1].w * rs * n1.w * silu_fast(g0[7]));
                w1.x = pk2(o[2].x * rs * n2.x * silu_fast(g1[0]), o[2].y * rs * n2.y * silu_fast(g1[1])); w1.y = pk2(o[2].z * rs * n2.z * silu_fast(g1[2]), o[2].w * rs * n2.w * silu_fast(g1[3]));
                w1.z = pk2(o[3].x * rs * n3.x * silu_fast(g1[4]), o[3].y * rs * n3.y * silu_fast(g1[5])); w1.w = pk2(o[3].z * rs * n3.z * silu_fast(g1[6]), o[3].w * rs * n3.w * silu_fast(g1[7]));
                v4u* op = (v4u*)(K.XN() + (size_t)(t0 + c) * D + h * 128 + 16 * vg);
                op[0] = w0; op[1] = w1;
            }
        }
    }
    if (F.bx >= NITEM) { phase_gla_aggscan(F); xcd_barrier(bar); }
}
#undef FRAG

constexpr int GM_ROWB = 272;
__device__ __forceinline__ void phase_gmlp_mfma(Frame& F, int l) {
    const KA K = KA::fresh(); PHASE_TID;
    LAS unsigned char* lds = F.lds;
    const int fr = lane & 15, fq = lane >> 4;
    const int nks = (16 * wave + 15) / 32 + 1;
#pragma unroll 1
    for (int u = F.bx; u < NB * MN * MH; u += F.G) {
        const int b = u / (MN * MH), n = (u / MH) % MN, h = u % MH, t0 = b * S + n * MC;
        const bf16* P = K.P();
        const float gn = K.in(6)[(size_t)l * 256 + h * 64 + lane];
        unsigned short vraw[16];
#pragma unroll
        for (int i = 0; i < 16; ++i) vraw[i] = P[(size_t)(t0 + 16 * wave + i) * PLD + C_VG + h * 64 + lane];
        const bf16* Wb = K.Wsp() + ((size_t)(l * MH + h) * 128 + 16 * wave + fr) * 128 + 8 * fq;
        bf16x8 Bf[4];
#pragma unroll
        for (int ks = 0; ks < 4; ++ks) Bf[ks] = (ks < nks) ? *(const bf16x8*)(Wb + 32 * ks) : (bf16x8){0, 0, 0, 0, 0, 0, 0, 0};
        const int t = 16 * wave + fr;
        const float bias = K.in(8)[(size_t)l * MH * 128 + h * 128 + t];
        const bf16* up = P + (size_t)(t0 + t) * PLD + C_U + h * 64 + 4 * fq;
        v2u uw[4];
#pragma unroll
        for (int dt = 0; dt < 4; ++dt) uw[dt] = *(const v2u*)(up + 16 * dt);
        __syncthreads();
#pragma unroll
        for (int q = 0; q < 2; ++q) {
            float vs[8];
#pragma unroll
            for (int i = 0; i < 8; ++i) {
                const float g = gelu_fast(bf2f(vraw[8 * q + i]));
                const float ss = wave_sum(g * g);
                vs[i] = g * rsqrtf(ss * (1.0f / 64.0f) + EPS) * gn;
            }
            *(LAS v4u*)(lds + lane * GM_ROWB + (16 * wave + 8 * q) * 2) = (v4u){pk2(vs[0], vs[1]), pk2(vs[2], vs[3]), pk2(vs[4], vs[5]), pk2(vs[6], vs[7])};
        }
        __syncthreads();
        f32x4 acc[4];
#pragma unroll
        for (int dt = 0; dt < 4; ++dt) acc[dt] = (f32x4){0.f, 0.f, 0.f, 0.f};
#pragma unroll
        for (int ks = 0; ks < 4; ++ks) if (ks < nks) {
#pragma unroll
            for (int dt = 0; dt < 4; ++dt) acc[dt] = mfma16(*(const LAS bf16x8*)(lds + (16 * dt + fr) * GM_ROWB + (32 * ks + 8 * fq) * 2), Bf[ks], acc[dt]);
        }
        bf16* op = K.XN() + (size_t)(t0 + t) * D + 512 + h * 64 + 4 * fq;
#pragma unroll
        for (int dt = 0; dt < 4; ++dt) {
            const float o0 = gelu_fast(bflo(uw[dt].x)) * (acc[dt][0] + bias), o1 = gelu_fast(bfhi(uw[dt].x)) * (acc[dt][1] + bias), o2 = gelu_fast(bflo(uw[dt].y)) * (acc[dt][2] + bias), o3 = gelu_fast(bfhi(uw[dt].y)) * (acc[dt][3] + bias);
            *(v2u*)(op + 16 * dt) = (v2u){pk2(o0, o1), pk2(o2, o3)};
        }
    }
}
__device__ __forceinline__ void phase_conv(Frame& F, int l) {
    const KA K = KA::fresh(); PHASE_TID;
    const float* wc = K.in(9) + (size_t)l * 3 * 256;
#pragma unroll 1
    for (int e = F.bx * NT + tid; e < T * 32; e += F.G * NT) {
        const int t = e >> 5, c0 = (e & 31) * 8, tl = t % S;
        const bf16* row = K.P() + (size_t)t * PLD;
        float y[8], xi[8], cg[8], bg[8];
        unpack8(*(const v4u*)(row + C_XI + c0), xi); unpack8(*(const v4u*)(row + C_CG + c0), cg); unpack8(*(const v4u*)(row + C_BG + c0), bg);
#pragma unroll
        for (int j = 0; j < 8; ++j) y[j] = wc[2 * 256 + c0 + j] * cg[j] * xi[j];
        if (tl >= 1) { unpack8(*(const v4u*)(row - PLD + C_XI + c0), xi); unpack8(*(const v4u*)(row - PLD + C_CG + c0), cg);
#pragma unroll
            for (int j = 0; j < 8; ++j) y[j] += wc[1 * 256 + c0 + j] * cg[j] * xi[j]; }
        if (tl >= 2) { unpack8(*(const v4u*)(row - 2 * PLD + C_XI + c0), xi); unpack8(*(const v4u*)(row - 2 * PLD + C_CG + c0), cg);
#pragma unroll
            for (int j = 0; j < 8; ++j) y[j] += wc[0 * 256 + c0 + j] * cg[j] * xi[j]; }
#pragma unroll
        for (int j = 0; j < 8; ++j) y[j] *= bg[j];
        *(v4u*)(K.XN() + (size_t)t * D + 768 + c0) = (v4u){pk2(y[0], y[1]), pk2(y[2], y[3]), pk2(y[4], y[5]), pk2(y[6], y[7])};
    }
}
constexpr int RT_PART = 0, RT_SS = RT_PART + 4 * 8 * 16 * 48 * 4, RT_RS = RT_SS + 4 * 8 * 16 * 4, RT_HIST = RT_RS + 64 * 4;
__device__ __forceinline__ void phase_norm_router_mfma(Frame& F, int l) {
    const KA K = KA::fresh(); PHASE_TID;
    LAS unsigned char* lds = F.lds;
    const int fr = lane & 15, fq = lane >> 4;
    const bf16* whi = K.Wr() + (size_t)l * 2 * 48 * D + (size_t)fr * D + 128 * wave + 8 * fq; const bf16* wlo = whi + 48 * D;
    bf16x8 Wh[4][3], Wl[4][3];
#pragma unroll
    for (int ks = 0; ks < 4; ++ks)
#pragma unroll
        for (int nt = 0; nt < 3; ++nt) { Wh[ks][nt] = *(const bf16x8*)(whi + (size_t)(16 * nt) * D + 32 * ks); Wl[ks][nt] = *(const bf16x8*)(wlo + (size_t)(16 * nt) * D + 32 * ks); }
#pragma unroll 1
    for (int blk = F.bx; blk < T / 64; blk += F.G) {
        const bf16* xr = K.XR() + (size_t)(blk * 64 + fr) * D + 128 * wave + 8 * fq;
        __syncthreads();
        if (tid < NE) ((LAS int*)(lds + RT_HIST))[tid] = 0;
        v4u xa[4][4];
#pragma unroll
        for (int t = 0; t < 4; ++t)
#pragma unroll
            for (int ks = 0; ks < 4; ++ks) xa[t][ks] = *(const v4u*)(xr + (size_t)(16 * t) * D + 32 * ks);
#pragma unroll
        for (int t = 0; t < 4; ++t) {
            f32x4 acc[3]; float ss = 0.f;
#pragma unroll
            for (int nt = 0; nt < 3; ++nt) acc[nt] = (f32x4){0.f, 0.f, 0.f, 0.f};
#pragma unroll
            for (int ks = 0; ks < 4; ++ks) {
                float xv[8]; unpack8(xa[t][ks], xv);
#pragma unroll
                for (int j = 0; j < 8; ++j) ss += xv[j] * xv[j];
                const bf16x8 Ah = __builtin_bit_cast(bf16x8, xa[t][ks]);
#pragma unroll
                for (int nt = 0; nt < 3; ++nt) { acc[nt] = mfma16(Ah, Wh[ks][nt], acc[nt]); acc[nt] = mfma16(Ah, Wl[ks][nt], acc[nt]); }
            }
            ss += shx(ss, 16); ss += shx(ss, 32);
            LAS float* part = (LAS float*)(lds + RT_PART) + (t * 8 + wave) * 16 * 48;
#pragma unroll
            for (int nt = 0; nt < 3; ++nt)
#pragma unroll
                for (int r = 0; r < 4; ++r) part[(4 * fq + r) * 48 + 16 * nt + fr] = acc[nt][r];
            if (fq == 0) ((LAS float*)(lds + RT_SS))[(t * 8 + wave) * 16 + fr] = ss;
        }
        __syncthreads();
        {
            const int tt = tid >> 3, j = tid & 7, t = blk * 64 + tt;
            const LAS float* p0 = (const LAS float*)(lds + RT_PART) + ((tt >> 4) * 8 * 16 + (tt & 15)) * 48;
            const LAS float* s2 = (const LAS float*)(lds + RT_SS) + (tt >> 4) * 8 * 16 + (tt & 15);
            float sq = 0.f;
#pragma unroll
            for (int w = 0; w < 8; ++w) sq += s2[w * 16];
            const float rs = rsqrtf(sq * (1.f / D) + EPS);
#define RT_DOT(n) (((p0[(n)] + p0[768 + (n)]) + (p0[1536 + (n)] + p0[2304 + (n)])) + ((p0[3072 + (n)] + p0[3840 + (n)]) + (p0[4608 + (n)] + p0[5376 + (n)])))
            float gv = (j < 4) ? RT_DOT(j & 3) * rs + K.in(13)[(size_t)l * 4 + (j & 3)] : -INFINITY; int gi = j;
            const float gmine = gv;
#define RT_ARGMAX_STEP(V, I, FV, FI) do { const float ov = FV(V); const int oi = FI(I); if (ov > V || (ov == V && oi < I)) { V = ov; I = oi; } } while (0)
            RT_ARGMAX_STEP(gv, gi, dppf_x1, dpp_x1); RT_ARGMAX_STEP(gv, gi, dppf_x2, dpp_x2); RT_ARGMAX_STEP(gv, gi, dppf_hm, dpp_hm);
            float ge = (j < 4) ? expf(gmine - gv) : 0.f;
            ge = sum8(ge);
            const float gw = 1.0f / ge; const int gt = gi;
            const float ev = RT_DOT(4 + gt * 8 + j) * rs + K.in(15)[(size_t)l * 32 + gt * 8 + j];
#undef RT_DOT
            float m0 = ev; int i0 = j;
            RT_ARGMAX_STEP(m0, i0, dppf_x1, dpp_x1); RT_ARGMAX_STEP(m0, i0, dppf_x2, dpp_x2); RT_ARGMAX_STEP(m0, i0, dppf_hm, dpp_hm);
            float m1 = (j == i0) ? -INFINITY : ev; int i1 = j;
            RT_ARGMAX_STEP(m1, i1, dppf_x1, dpp_x1); RT_ARGMAX_STEP(m1, i1, dppf_x2, dpp_x2); RT_ARGMAX_STEP(m1, i1, dppf_hm, dpp_hm);
#undef RT_ARGMAX_STEP
            if (j == 0) {
                K.rinv2()[t] = rs;
                const float e1 = expf(m1 - m0);
                const float w0 = gw / (1.0f + e1), w1 = gw * e1 / (1.0f + e1);
                const int e0i = gt * 8 + i0, e1i = gt * 8 + i1;
                K.eid()[2 * t] = e0i; K.eid()[2 * t + 1] = e1i; K.ew()[2 * t] = w0; K.ew()[2 * t + 1] = w1;
                LAS int* hist = (LAS int*)(lds + RT_HIST);
                K.slot_of()[2 * t] = __hip_atomic_fetch_add(hist + e0i, 1, __ATOMIC_RELAXED, __HIP_MEMORY_SCOPE_WORKGROUP);
                K.slot_of()[2 * t + 1] = __hip_atomic_fetch_add(hist + e1i, 1, __ATOMIC_RELAXED, __HIP_MEMORY_SCOPE_WORKGROUP);
            }
        }
        __syncthreads();
        if (tid < NE) K.blkcnt()[(size_t)(l * (T / 64) + blk) * NE + tid] = ((LAS int*)(lds + RT_HIST))[tid];
    }
}
constexpr int TAB_OFF = LDSCTL_OFF + 1024;
__device__ __forceinline__ void moe_tables_lds(Frame& F, const LAS int* tot, int tid) {
    LAS int* tab = (LAS int*)(F.lds + TAB_OFF); LAS int* offs = tab + 4 + 4 * 164; LAS int* fpre = offs + 40; LAS int* ppre = fpre + 40;
    if (tid == 0) { int a = 0, f = 0, p = 0; for (int e = 0; e < NE; ++e) { const int c = tot[e]; offs[e] = a; fpre[e] = f; ppre[e] = p; a += c; f += c >> 8; p += (c & 255) ? 1 : 0; }
        offs[NE] = a; fpre[NE] = f; ppre[NE] = p; tab[0] = f + p; }
    __syncthreads();
    const int nfull = fpre[NE];
    if (tid < nfull) { int e = 0; for (int j = 1; j < NE; ++j) if (fpre[j] <= tid) e = j; tab[4 + 4 * tid] = e; tab[5 + 4 * tid] = offs[e] + (tid - fpre[e]) * 256; tab[6 + 4 * tid] = offs[e + 1]; }
    else if (tid < nfull + NE) {
        const int e = tid - nfull, rows = (offs[e + 1] - offs[e]) & 255;
        if (rows) { int rank = 0; for (int j = 0; j < NE; ++j) { const int rj = (offs[j + 1] - offs[j]) & 255; rank += (rj > rows || (rj == rows && j < e)) ? 1 : 0; }
            const int q = nfull + rank; tab[4 + 4 * q] = e; tab[5 + 4 * q] = offs[e] + (fpre[e + 1] - fpre[e]) * 256; tab[6 + 4 * q] = offs[e + 1]; }
    }
    __syncthreads();
}
__device__ __forceinline__ void phase_scatter(Frame& F, int l) {
    const KA K = KA::fresh(); PHASE_TID;
    LAS int* sm = (LAS int*)F.lds;
    const int* bc = K.blkcnt() + (size_t)l * (T / 64) * NE;
    constexpr int NBLK = T / 64;
#pragma unroll 1
    for (int blk = F.bx, trip = 0; blk < NBLK || trip == 0; blk += F.G, ++trip) {
        __syncthreads();
        {   const int e = tid & 31, part = tid >> 5;
            int tot = 0, pre = 0;
#pragma unroll
            for (int j = 0; j < NBLK / 16; ++j) { const int bb = part * (NBLK / 16) + j; const int c = bc[bb * NE + e]; tot += c; if (bb < blk) pre += c; }
            sm[part * 32 + e] = tot; sm[512 + part * 32 + e] = pre; }
        __syncthreads();
        if (tid < 32) { int tot = 0, pre = 0;
#pragma unroll
            for (int p = 0; p < 16; ++p) { tot += sm[p * 32 + tid]; pre += sm[512 + p * 32 + tid]; }
            sm[1056 + tid] = tot; sm[1024 + tid] = pre; }
        __syncthreads();
        if (tid == 0) { int a = 0; for (int e = 0; e < NE; ++e) { const int c = sm[1056 + e]; sm[1024 + e] += a; a += c; } }
        __syncthreads();
        if (blk < NBLK && tid < 128) { const int a = blk * 128 + tid; const int e = K.eid()[a]; const int pos = sm[1024 + e] + K.slot_of()[a]; K.slot_tok()[pos] = a >> 1; K.slot_of()[a] = pos; K.srinv()[pos] = K.rinv2()[a >> 1]; }
    }
    __syncthreads();
    moe_tables_lds(F, sm + 1056, tid);
}
template <int SUB>
__device__ __forceinline__ void phase_moe(Frame& F, int l) {
    const KA K = KA::fresh();
    int c_ = F.bx; asm volatile("" : "+s"(c_));
    const int G = F.G, c = (c_ & 7) * (G >> 3) + (c_ >> 3);
    const LAS int* tab = (const LAS int*)(F.lds + TAB_OFF);
    const int ntile = __builtin_amdgcn_readfirstlane(tab[0]), ngu = 2 * ntile, nleft = ngu > G ? ngu - G : 0, jX = ngu > G ? (G >> 1) : ntile, W = G - nleft;
    const int yd = (jX * 4 < 2 * W) ? jX * 4 : 2 * W;
    bool do_gu = false, do_dn = false; pg8::MoeSched So{tab, 2, 0, 0, G, c, 0};
    if (SUB == 0) { do_gu = true; So.npn = 2; So.first = 0; So.end = ngu < G ? ngu : G; So.stride = G; So.c = c; }
    if (SUB == 1) { if (c < nleft) { do_gu = true; So.npn = 2; So.first = G; So.end = ngu; So.stride = G; So.c = c; }
                    else { do_dn = true; So.npn = 4; So.first = 0; So.end = yd; So.stride = W; So.c = c - nleft; } }
    if (SUB == 2) { do_dn = true; So.npn = 4; So.first = 2 * yd; So.end = 2 * ntile * 4; So.stride = G; So.c = c; So.split = 1; }
    if (do_gu) { pg8::EpiMoeH E{K.H1(), K.srinv()};
        pg8::gemm_phase_moe<pg8::EpiMoeH, pg8::MoeSched, true, 512, D>(F.lds, K.XR(), K.WguT() + (size_t)l * NE * 512 * D, K.slot_tok(), So, E, F.wave); }
    if (do_dn) { pg8::EpiMoeY E{K.Y()};
        pg8::gemm_phase_moe<pg8::EpiMoeY, pg8::MoeSched, false, D, DE>(F.lds, K.H1(), K.WdT() + (size_t)l * NE * D * DE, nullptr, So, E, F.wave); }
}
__device__ __forceinline__ void phase_combine(Frame& F, int l) {
    const KA K = KA::fresh(); PHASE_TID;
    const bool last = (l == DEPTH - 1);
    f32x4 g4[4];
    if (last) {
#pragma unroll
        for (int j = 0; j < 4; ++j) g4[j] = ((const f32x4*)K.in(19))[lane + 64 * j]; }
    const int tstep = F.G * NWAVES;
    int t = F.bx * NWAVES + wave;
    v2u xw[4], ya[4], yb[4]; float w0 = 0.f, w1 = 0.f;
#define CB_LOAD(tt) do { const int s0_ = K.slot_of()[2 * (tt)], s1_ = K.slot_of()[2 * (tt) + 1]; w0n = K.ew()[2 * (tt)]; w1n = K.ew()[2 * (tt) + 1]; \
        const v2u* xr_ = (const v2u*)(K.XR() + (size_t)(tt) * D) + lane; const v2u* y0_ = (const v2u*)(K.Y() + (size_t)s0_ * D) + lane; const v2u* y1_ = (const v2u*)(K.Y() + (size_t)s1_ * D) + lane; \
        _Pragma("unroll") for (int j = 0; j < 4; ++j) { xn[j] = xr_[64 * j]; an[j] = y0_[64 * j]; bn[j] = y1_[64 * j]; } } while (0)
    { v2u xn[4], an[4], bn[4]; float w0n = 0.f, w1n = 0.f;
      if (t < T) { CB_LOAD(t);
#pragma unroll
        for (int j = 0; j < 4; ++j) { xw[j] = xn[j]; ya[j] = an[j]; yb[j] = bn[j]; } w0 = w0n; w1 = w1n; } }
#pragma unroll 1
    for (; t < T; t += tstep) {
        v2u xn[4], an[4], bn[4]; float w0n = 0.f, w1n = 0.f;
        if (t + tstep < T) CB_LOAD(t + tstep);
        f32x4 v[4]; float s = 0.f;
#pragma unroll
        for (int j = 0; j < 4; ++j) { const v2u x_ = xw[j], a = ya[j], b = yb[j];
            v[j].x = bflo(x_.x) + w0 * bflo(a.x) + w1 * bflo(b.x); v[j].y = bfhi(x_.x) + w0 * bfhi(a.x) + w1 * bfhi(b.x); v[j].z = bflo(x_.y) + w0 * bflo(a.y) + w1 * bflo(b.y); v[j].w = bfhi(x_.y) + w0 * bfhi(a.y) + w1 * bfhi(b.y);
            s += (v[j].x * v[j].x + v[j].y * v[j].y) + (v[j].z * v[j].z + v[j].w * v[j].w); }
        const float rs = rsqrtf(wave_sum(s) * (1.f / D) + EPS);
        if (last) {
            f32x4* orow = (f32x4*)(K.out() + (size_t)t * D) + lane;
#pragma unroll
            for (int j = 0; j < 4; ++j) __builtin_nontemporal_store((f32x4){v[j].x * rs * g4[j].x, v[j].y * rs * g4[j].y, v[j].z * rs * g4[j].z, v[j].w * rs * g4[j].w}, orow + 64 * j);
        } else {
            v2u* xr = (v2u*)(K.XR() + (size_t)t * D) + lane;
            if (lane == 0) K.rinv1()[t] = rs;
#pragma unroll
            for (int j = 0; j < 4; ++j) xr[64 * j] = (v2u){pk2(v[j].x, v[j].y), pk2(v[j].z, v[j].w)};
        }
#pragma unroll
        for (int j = 0; j < 4; ++j) { xw[j] = xn[j]; ya[j] = an[j]; yb[j] = bn[j]; }
        w0 = w0n; w1 = w1n;
    }
#undef CB_LOAD
}

struct Args { const float* in[20]; float* out; unsigned char* ws; };
__global__ void __launch_bounds__(NT, 2) fwd_kernel(Args args) {
    extern __shared__ __attribute__((aligned(16))) unsigned char lds_raw[];
    Frame F;
    F.lds = (LAS unsigned char*)lds_raw; F.smem = (float*)lds_raw;
    F.G = gridDim.x; F.bx = blockIdx.x; F.wave = __builtin_amdgcn_readfirstlane(threadIdx.x >> 6);
    volatile LAS unsigned* MISC = (volatile LAS unsigned*)(F.lds + MISC_OFF);
    for (int u = threadIdx.x; u < (LDS_BYTES - LDSCTL_OFF) / 4; u += NT) ((LAS unsigned*)(F.lds + LDSCTL_OFF))[u] = 0u;
    __syncthreads();
    XcdBarrier bar; { const KA K = KA::fresh(); bar = xcd_barrier_post(K.ctl() + CW_BAR, MISC + 8); }
#define GRID_BAR() xcd_barrier(bar)

    p0_prologue(F);
    GRID_BAR();
    for (int l = 0; l < DEPTH; ++l) {
        {
            const KA K = KA::fresh(); PHASE_TID;
            pg8::Gemm g{K.XR(), K.WinT() + (size_t)l * PLD * D, T, PLD, D}; pg8::StaticOrder So; int c_ = F.bx; asm volatile("" : "+s"(c_)); So.init(T, PLD, F.G, c_);
            pg8::EpiBf16Scale E{K.P(), PLD, K.rinv1()};
            pg8::gemm_phase<pg8::EpiBf16Scale, pg8::StaticOrder, PG8_ALIGN, PG8_SP2>(F.lds, g, So, E, F.wave);
        }
        GRID_BAR();
        phase_gla_A2(F, l);
        phase_gmlp_mfma(F, l);
        phase_conv(F, l);
        GRID_BAR();
        phase_gla_C2(F, l, bar);
        GRID_BAR();
        {
            const KA K = KA::fresh(); PHASE_TID;
            pg8::Gemm g{K.XN(), K.WoutT() + (size_t)l * D * D, T, D, D}; pg8::StaticOrder So; int c_ = F.bx; asm volatile("" : "+s"(c_)); So.init(T, D, F.G, c_);
            pg8::EpiBf16Res<false> E{K.XR(), K.XR(), D}; pg8::gemm_phase<pg8::EpiBf16Res<false>, pg8::StaticOrder, PG8_ALIGN, PG8_SP2>(F.lds, g, So, E, F.wave);
        }
        GRID_BAR();
        phase_norm_router_mfma(F, l);
        GRID_BAR();
        phase_scatter(F, l);
        GRID_BAR();
        phase_moe<0>(F, l);
        GRID_BAR();
        phase_moe<1>(F, l);
        GRID_BAR();
        phase_moe<2>(F, l);
        GRID_BAR();
        phase_combine(F, l);
        if (l + 1 < DEPTH) GRID_BAR();
    }
}

extern "C" void kernel_launch(void* const* d_in, const int* in_sizes, int n_in, void* d_out, int out_size, void* d_ws, size_t ws_size, hipStream_t stream) {
    static int grid_blocks = 0;
    if (!grid_blocks) {
        int dev = 0, cus = 0, per_cu = 0;
        (void)hipGetDevice(&dev);
        (void)hipDeviceGetAttribute(&cus, hipDeviceAttributeMultiprocessorCount, dev);
        (void)hipFuncSetAttribute((const void*)fwd_kernel, hipFuncAttributeMaxDynamicSharedMemorySize, LDS_BYTES);
        (void)hipOccupancyMaxActiveBlocksPerMultiprocessor(&per_cu, fwd_kernel, NT, LDS_BYTES);
        if (per_cu < 1) { fprintf(stderr, "kernel_launch: occupancy query says %d blocks/CU\n", per_cu); per_cu = 1; }
        grid_blocks = cus;
        if (ws_size < WS_END) { fprintf(stderr, "kernel_launch: workspace too small (%zu < %zu)\n", ws_size, (size_t)WS_END); grid_blocks = -1; }
    }
    if (grid_blocks < 0) return;
    (void)hipMemsetAsync((char*)d_ws + WS_CTL, 0, 131072, stream);
    Args a{};
    for (int i = 0; i < 20; ++i) a.in[i] = (const float*)d_in[i];
    a.out = (float*)d_out; a.ws = (unsigned char*)d_ws;
    void* args[] = {&a};
    hipError_t e = hipLaunchCooperativeKernel((void*)fwd_kernel, dim3(grid_blocks), dim3(NT), args, LDS_BYTES, stream);
    if (e != hipSuccess) fprintf(stderr, "cooperative launch failed: %s (grid %d)\n", hipGetErrorString(e), grid_blocks);
}
```

```cpp
#include <hip/hip_runtime.h>
#include <cstdio>
#include <cstdint>
__device__ __forceinline__ int fresh_lane() { unsigned m = 0xffffffffu; asm volatile("" : "+s"(m)); return (int)__builtin_amdgcn_mbcnt_hi(m, __builtin_amdgcn_mbcnt_lo(m, 0u)); }
__device__ __forceinline__ float shx(float v, int o) { return __int_as_float(__builtin_amdgcn_ds_bpermute((fresh_lane() ^ o) << 2, __float_as_int(v))); }
__device__ __forceinline__ int dpp_x1(int v) { return __builtin_amdgcn_update_dpp(v, v, 0xB1, 0xF, 0xF, false); }
__device__ __forceinline__ int dpp_x2(int v) { return __builtin_amdgcn_update_dpp(v, v, 0x4E, 0xF, 0xF, false); }
__device__ __forceinline__ int dpp_hm(int v) { return __builtin_amdgcn_update_dpp(v, v, 0x141, 0xF, 0xF, false); }
__device__ __forceinline__ int dpp_rm(int v) { return __builtin_amdgcn_update_dpp(v, v, 0x140, 0xF, 0xF, false); }
__device__ __forceinline__ float dppf_x1(float v) { return __int_as_float(dpp_x1(__float_as_int(v))); }
__device__ __forceinline__ float dppf_x2(float v) { return __int_as_float(dpp_x2(__float_as_int(v))); }
__device__ __forceinline__ float dppf_hm(float v) { return __int_as_float(dpp_hm(__float_as_int(v))); }
__device__ __forceinline__ float dppf_rm(float v) { return __int_as_float(dpp_rm(__float_as_int(v))); }
__device__ __forceinline__ float sum8(float v) { v += dppf_x1(v); v += dppf_x2(v); v += dppf_hm(v); return v; }
__device__ __forceinline__ float sum16(float v) { v = sum8(v); v += dppf_rm(v); return v; }
namespace pg8 {
#define PG8_LAS __attribute__((address_space(3)))
typedef unsigned short bf16_t;
typedef short bf16x8 __attribute__((ext_vector_type(8)));
typedef float f32x4 __attribute__((ext_vector_type(4)));
typedef unsigned u32x4 __attribute__((ext_vector_type(4)));
constexpr int BM = 256, BK = 64, HALF = 128, HTB = HALF * BK * 2  , STAGE_BYTES = 8 * HTB, NXCD = 8, WGM = 8;

__host__ __device__ __forceinline__ int lds_byte(int r, int c) { const int st = (r >> 4) * 2 + (c >> 5), rr = r & 15, cc = c & 31, ob = rr * 64 + cc * 2; return st * 1024 + (ob ^ (((ob >> 9) & 1) << 5)); }
__host__ __device__ __forceinline__ void stage_rc(int b, int& R, int& C) { const int st = b / 1024, sb = b % 1024, swz = sb ^ (((sb >> 9) & 1) << 5); R = (st >> 1) * 16 + swz / 64; C = (st & 1) * 32 + (swz % 64) / 2; }
__host__ __device__ __forceinline__ int perm32(int rho) { const int n = rho >> 4, i = rho & 15; return 8 * (i >> 2) + 4 * n + (i & 3); }

struct Unit { int pm, pn, par; };
struct Gemm { const bf16_t* A; const bf16_t* Bt; int M, N, K; };

struct StaticOrder {
    int nM, nN, nwg, G, c;
    __host__ __device__ void init(int M, int N, int G_, int c_) { nM = M / BM; nN = N / BM; nwg = nM * nN; G = G_; c = c_; }
    __host__ __device__ bool next(int i, Unit& u) const {
        const long L = (long)i * G + c; if (L >= nwg) return false;
        int wgid = (int)L; { const int q = nwg / NXCD, r = nwg % NXCD, xcd = wgid % NXCD, off = wgid / NXCD; wgid = (xcd < r ? xcd * (q + 1) : r * (q + 1) + (xcd - r) * q) + off; }
        const int nig = WGM * nN, gid = wgid / nig, fm = gid * WGM, gsz = (nM - fm) < WGM ? (nM - fm) : WGM;
        u.pm = fm + ((wgid % nig) % gsz); u.pn = (wgid % nig) / gsz; return true;
    }
    __device__ __forceinline__ void a_ready(const Unit&) const {}
    __device__ __forceinline__ void done(const Unit&) const {}
};


__device__ __forceinline__ unsigned cvt_pk_bf16(float lo, float hi) { unsigned r; asm volatile("v_cvt_pk_bf16_f32 %0, %1, %2" : "=v"(r) : "v"(lo), "v"(hi)); return r; }
struct EpiBf16Plain {
    static constexpr bool PERM = true, AFTER_DRAIN = false, PREFETCH = false;
    bf16_t* O; int ldc;
    __device__ __forceinline__ void operator()(const f32x4 (&acc)[2][2][4][2], const Unit& u, int wr, int wc, int fr, int fq) const {
        const int row0 = u.pm * BM + wr * 64 + fr, col0 = u.pn * BM + wc * 32 + 8 * fq;
#pragma unroll
        for (int ai = 0; ai < 2; ++ai)
#pragma unroll
            for (int m = 0; m < 4; ++m) { bf16_t* rowp = O + (size_t)(row0 + ai * HALF + m * 16) * ldc + col0;
#pragma unroll
                for (int bj = 0; bj < 2; ++bj) { const f32x4 v0 = acc[ai][bj][m][0], v1 = acc[ai][bj][m][1];
                    u32x4 w; w.x = cvt_pk_bf16(v0[0], v0[1]); w.y = cvt_pk_bf16(v0[2], v0[3]); w.z = cvt_pk_bf16(v1[0], v1[1]); w.w = cvt_pk_bf16(v1[2], v1[3]);
                    *(u32x4*)(rowp + bj * HALF) = w; } }
    }
};
struct EpiBf16Scale {
    static constexpr bool PERM = true, AFTER_DRAIN = false;
    static constexpr bool PREFETCH = true;
    bf16_t* O; int ldc; const float* rs; PG8_LAS float* lrs;
    __device__ __forceinline__ void prefetch(const Unit& u, int wid, int lane) const {
        if (wid < 4) __builtin_amdgcn_global_load_lds((const unsigned*)(rs + u.pm * BM + wid * 64 + lane), (PG8_LAS unsigned*)(lrs + u.par * 256 + wid * 64), 4, 0, 0); }
    __device__ __forceinline__ void operator()(const f32x4 (&acc)[2][2][4][2], const Unit& u, int wr, int wc, int fr, int fq) const {
        const int row0 = u.pm * BM + wr * 64 + fr, col0 = u.pn * BM + wc * 32 + 8 * fq;
        float sc[2][4];
#pragma unroll
        for (int ai = 0; ai < 2; ++ai)
#pragma unroll
            for (int m = 0; m < 4; ++m) sc[ai][m] = lrs[u.par * 256 + wr * 64 + fr + ai * HALF + m * 16];
#pragma unroll
        for (int ai = 0; ai < 2; ++ai)
#pragma unroll
            for (int m = 0; m < 4; ++m) { bf16_t* rowp = O + (size_t)(row0 + ai * HALF + m * 16) * ldc + col0; const float s_ = sc[ai][m];
#pragma unroll
                for (int bj = 0; bj < 2; ++bj) { const f32x4 v0 = acc[ai][bj][m][0] * s_, v1 = acc[ai][bj][m][1] * s_;
                    u32x4 w; w.x = cvt_pk_bf16(v0[0], v0[1]); w.y = cvt_pk_bf16(v0[2], v0[3]); w.z = cvt_pk_bf16(v1[0], v1[1]); w.w = cvt_pk_bf16(v1[2], v1[3]);
                    *(u32x4*)(rowp + bj * HALF) = w; } }
    }
};
__device__ __forceinline__ float sat_fp8(float v) { return __builtin_amdgcn_fmed3f(v, -448.f, 448.f); }
__device__ __forceinline__ unsigned pk4_fp8(float a, float b, float c, float d) { unsigned q = 0u; q = __builtin_amdgcn_cvt_pk_fp8_f32(sat_fp8(a), sat_fp8(b), q, false); q = __builtin_amdgcn_cvt_pk_fp8_f32(sat_fp8(c), sat_fp8(d), q, true); return q; }
template <bool RES_F32>
struct EpiBf16Res {
    static constexpr bool PERM = true, AFTER_DRAIN = false, PREFETCH = false;
    bf16_t* O; const void* R; int ldc; unsigned char* Q;
    __device__ __forceinline__ void operator()(const f32x4 (&acc)[2][2][4][2], const Unit& u, int wr, int wc, int fr, int fq) const {
        const int row0 = u.pm * BM + wr * 64 + fr, col0 = u.pn * BM + wc * 32 + 8 * fq;
#pragma unroll
        for (int ai = 0; ai < 2; ++ai)
#pragma unroll
            for (int m = 0; m < 4; ++m) { const size_t off = (size_t)(row0 + ai * HALF + m * 16) * ldc + col0;
#pragma unroll
                for (int bj = 0; bj < 2; ++bj) { f32x4 v0 = acc[ai][bj][m][0], v1 = acc[ai][bj][m][1];
                    if (RES_F32) { const float* rp = (const float*)R + off + bj * HALF; v0 += *(const f32x4*)rp; v1 += *(const f32x4*)(rp + 4); }
                    else { const u32x4 rw = *(const u32x4*)((const bf16_t*)R + off + bj * HALF);
                        v0[0] += __uint_as_float(rw.x << 16); v0[1] += __uint_as_float(rw.x & 0xffff0000u); v0[2] += __uint_as_float(rw.y << 16); v0[3] += __uint_as_float(rw.y & 0xffff0000u);
                        v1[0] += __uint_as_float(rw.z << 16); v1[1] += __uint_as_float(rw.z & 0xffff0000u); v1[2] += __uint_as_float(rw.w << 16); v1[3] += __uint_as_float(rw.w & 0xffff0000u); }
                    u32x4 w; w.x = cvt_pk_bf16(v0[0], v0[1]); w.y = cvt_pk_bf16(v0[2], v0[3]); w.z = cvt_pk_bf16(v1[0], v1[1]); w.w = cvt_pk_bf16(v1[2], v1[3]);
                    *(u32x4*)(O + off + bj * HALF) = w;
                    if (Q) { typedef unsigned u32x2q __attribute__((ext_vector_type(2))); *(u32x2q*)(Q + off + bj * HALF) = (u32x2q){pk4_fp8(v0[0], v0[1], v0[2], v0[3]), pk4_fp8(v1[0], v1[1], v1[2], v1[3])}; } } }
    }
};

template <class Epi, class Sched, bool ALIGN_EPI = false, bool SP2 = false>
__device__ __forceinline__ void gemm_phase(PG8_LAS unsigned char* lds, const Gemm g, const Sched& S, const Epi& E, int wave_id) {
    asm volatile("" : "+s"(wave_id));
    const int lane = fresh_lane(), wid = wave_id, tid = wid * 64 + lane, wr = wid >> 2, wc = wid & 3, fr = lane & 15, fq = lane >> 4;
    const int K = g.K, nt = K / BK;
    unsigned voffA[2], voffB[2];
#pragma unroll
    for (int i = 0; i < 2; ++i) { int R, C; stage_rc(tid * 16 + i * 8192, R, C); const int Rb = Epi::PERM ? ((R & ~31) + perm32(R & 31)) : R;
        voffA[i] = (unsigned)(R * K + C) * 2u; voffB[i] = (unsigned)(Rb * K + C) * 2u; }
    const size_t kstep = (size_t)(BK * 2);
    const size_t hstep = (size_t)HALF * K * 2;
    const size_t tstep = 2 * hstep;
    const unsigned ldsw = (unsigned)wid * 1024u;
    const int aoff = lds_byte(wr * 64 + fr, fq * 8), boff = lds_byte(wc * 32 + fr, fq * 8);
#define PG8_SA(b, h) (((b) * 2 + (h)) * HTB)
#define PG8_SB(b, h) ((4 + (b) * 2 + (h)) * HTB)
#define PG8_STAGE(bufoff, gbase, voff) do { _Pragma("unroll") for (int _i = 0; _i < 2; ++_i) \
        __builtin_amdgcn_global_load_lds((const unsigned*)((const char*)(gbase) + (voff)[_i]), (PG8_LAS unsigned*)(lds + (bufoff) + ldsw + _i * 8192), 16, 0, 0); } while (0)
#define PG8_LDA(dst, b, h) do { _Pragma("unroll") for (int m = 0; m < 4; ++m) _Pragma("unroll") for (int k = 0; k < 2; ++k) dst[m][k] = *(const PG8_LAS bf16x8*)(lds + PG8_SA(b, h) + aoff + m * 2048 + k * 1024); } while (0)
#define PG8_LDB(dst, b, h) do { _Pragma("unroll") for (int n = 0; n < 2; ++n) _Pragma("unroll") for (int k = 0; k < 2; ++k) dst[n][k] = *(const PG8_LAS bf16x8*)(lds + PG8_SB(b, h) + boff + n * 2048 + k * 1024); } while (0)
#define PG8_MMA(ai, bj, At, Bt) do { __builtin_amdgcn_s_setprio(1); _Pragma("unroll") for (int m = 0; m < 4; ++m) _Pragma("unroll") for (int n = 0; n < 2; ++n) _Pragma("unroll") for (int k = 0; k < 2; ++k) \
        acc[ai][bj][m][n] = __builtin_amdgcn_mfma_f32_16x16x32_bf16(Bt[n][k], At[m][k], acc[ai][bj][m][n], 0, 0, 0); __builtin_amdgcn_s_setprio(0); } while (0)
#define PG8_WAIT_V(n) asm volatile("s_waitcnt vmcnt(" #n ")" ::: "memory")
#define PG8_WAIT_L(n) asm volatile("s_waitcnt lgkmcnt(" #n ")" ::: "memory")
#define PG8_BAR __builtin_amdgcn_s_barrier()
#define PG8_SCHED __builtin_amdgcn_sched_barrier(0)
    Unit cur, nxt; int ui = 0;
    if (!S.next(0, cur)) return;
    f32x4 acc[2][2][4][2];
#pragma unroll
    for (int a = 0; a < 2; ++a)
#pragma unroll
        for (int b = 0; b < 2; ++b)
#pragma unroll
            for (int m = 0; m < 4; ++m)
#pragma unroll
                for (int n = 0; n < 2; ++n) acc[a][b][m][n] = (f32x4){0.f, 0.f, 0.f, 0.f};
    bf16x8 At[4][2], B0[2][2], B1[2][2];
    const char* cA = (const char*)g.A + (size_t)cur.pm * tstep; const char* cB = (const char*)g.Bt + (size_t)cur.pn * tstep;
    S.a_ready(cur);
    cur.par = 0; if constexpr (Epi::PREFETCH) E.prefetch(cur, wid, lane);
    if constexpr (SP2) {
        PG8_STAGE(PG8_SB(0, 0), cB, voffB); PG8_STAGE(PG8_SB(0, 1), cB + hstep, voffB); PG8_STAGE(PG8_SA(0, 0), cA, voffA); PG8_STAGE(PG8_SA(0, 1), cA + hstep, voffA);
        if (wr == 1) PG8_BAR;
        PG8_WAIT_V(2); PG8_BAR;
        PG8_STAGE(PG8_SB(1, 0), cB + kstep, voffB); PG8_STAGE(PG8_SA(1, 0), cA + kstep, voffA); PG8_STAGE(PG8_SB(1, 1), cB + hstep + kstep, voffB);
        PG8_WAIT_V(6); PG8_BAR;
    } else {
        PG8_STAGE(PG8_SB(0, 0), cB, voffB); PG8_STAGE(PG8_SA(0, 0), cA, voffA); PG8_STAGE(PG8_SB(0, 1), cB + hstep, voffB); PG8_STAGE(PG8_SA(0, 1), cA + hstep, voffA);
        if (wr == 1) PG8_BAR;
        PG8_WAIT_V(4); PG8_BAR;
        PG8_STAGE(PG8_SB(1, 0), cB + kstep, voffB); PG8_STAGE(PG8_SA(1, 0), cA + kstep, voffA); PG8_STAGE(PG8_SB(1, 1), cB + hstep + kstep, voffB);
        PG8_WAIT_V(6); PG8_BAR;
    }
    for (;;) {
        const bool has_next = S.next(ui + 1, nxt); nxt.par = (ui + 1) & 1;
        const char* nA = has_next ? (const char*)g.A + (size_t)nxt.pm * tstep : cA; const char* nB = has_next ? (const char*)g.Bt + (size_t)nxt.pn * tstep : cB;
        for (int t = 0; t < nt; t += 2) {
            const bool last = (t == nt - 2);
            const char* a1 = cA + (size_t)(t + 1) * kstep;
            const char* a2 = last ? nA : cA + (size_t)(t + 2) * kstep; const char* b2 = last ? nB : cB + (size_t)(t + 2) * kstep;
            const char* a3 = a2 + kstep; const char* b3 = b2 + kstep;
            if (last && has_next) S.a_ready(nxt);
            if constexpr (SP2) {
            PG8_LDB(B0, 0, 0); PG8_LDB(B1, 0, 1); PG8_SCHED; PG8_LDA(At, 0, 0); PG8_STAGE(PG8_SA(1, 1), a1 + hstep, voffA);
            PG8_WAIT_V(8); PG8_WAIT_L(0); PG8_BAR; PG8_MMA(0, 0, At, B0); PG8_MMA(0, 1, At, B1); PG8_BAR; PG8_SCHED;
            PG8_LDA(At, 0, 1); PG8_STAGE(PG8_SB(0, 0), b2, voffB); PG8_STAGE(PG8_SB(0, 1), b2 + hstep, voffB); PG8_STAGE(PG8_SA(0, 0), a2, voffA);
            PG8_WAIT_V(8); PG8_WAIT_L(0); PG8_BAR; PG8_MMA(1, 0, At, B0); PG8_MMA(1, 1, At, B1); PG8_BAR; PG8_SCHED;
            PG8_LDB(B0, 1, 0); PG8_LDB(B1, 1, 1); PG8_SCHED; PG8_LDA(At, 1, 0); PG8_STAGE(PG8_SA(0, 1), a2 + hstep, voffA);
            PG8_WAIT_V(8); PG8_WAIT_L(0); PG8_BAR; PG8_MMA(0, 0, At, B0); PG8_MMA(0, 1, At, B1); PG8_BAR; PG8_SCHED;
            PG8_LDA(At, 1, 1); PG8_STAGE(PG8_SB(1, 0), b3, voffB); PG8_STAGE(PG8_SB(1, 1), b3 + hstep, voffB); PG8_STAGE(PG8_SA(1, 0), a3, voffA);
            PG8_WAIT_V(8); PG8_WAIT_L(0); PG8_BAR; PG8_MMA(1, 0, At, B0); PG8_MMA(1, 1, At, B1); PG8_BAR; PG8_SCHED;
            } else {
            PG8_LDB(B0, 0, 0); PG8_SCHED; PG8_LDA(At, 0, 0); PG8_STAGE(PG8_SA(1, 1), a1 + hstep, voffA);
            PG8_WAIT_L(8); PG8_BAR; PG8_WAIT_L(0); PG8_MMA(0, 0, At, B0); PG8_BAR; PG8_SCHED;
            PG8_LDB(B1, 0, 1); PG8_STAGE(PG8_SB(0, 0), b2, voffB);
            PG8_BAR; PG8_WAIT_L(0); PG8_MMA(0, 1, At, B1); PG8_BAR;
            PG8_LDA(At, 0, 1); PG8_STAGE(PG8_SA(0, 0), a2, voffA);
            PG8_BAR; PG8_WAIT_L(0); PG8_MMA(1, 0, At, B0); PG8_BAR; PG8_SCHED;
            PG8_STAGE(PG8_SB(0, 1), b2 + hstep, voffB);
            PG8_WAIT_V(6); PG8_BAR; PG8_MMA(1, 1, At, B1); PG8_BAR;
            PG8_LDB(B0, 1, 0); PG8_SCHED; PG8_LDA(At, 1, 0); PG8_STAGE(PG8_SA(0, 1), a2 + hstep, voffA);
            PG8_WAIT_L(8); PG8_BAR; PG8_WAIT_L(0); PG8_MMA(0, 0, At, B0); PG8_BAR; PG8_SCHED;
            PG8_LDB(B1, 1, 1); PG8_STAGE(PG8_SB(1, 0), b3, voffB);
            PG8_BAR; PG8_WAIT_L(0); PG8_MMA(0, 1, At, B1); PG8_BAR;
            PG8_LDA(At, 1, 1); PG8_STAGE(PG8_SA(1, 0), a3, voffA);
            PG8_BAR; PG8_WAIT_L(0); PG8_MMA(1, 0, At, B0); PG8_BAR; PG8_SCHED;
            PG8_STAGE(PG8_SB(1, 1), b3 + hstep, voffB);
            PG8_WAIT_V(6); PG8_BAR; PG8_MMA(1, 1, At, B1); PG8_BAR;
            }
        }
        if constexpr (ALIGN_EPI) { if (wr == 0) PG8_BAR; }
        if constexpr (!Epi::AFTER_DRAIN) { E(acc, cur, wr, wc, fr, fq); S.done(cur); }
        if (!has_next) break;
#pragma unroll
        for (int a = 0; a < 2; ++a)
#pragma unroll
            for (int b = 0; b < 2; ++b)
#pragma unroll
                for (int m = 0; m < 4; ++m)
#pragma unroll
                    for (int n = 0; n < 2; ++n) acc[a][b][m][n] = (f32x4){0.f, 0.f, 0.f, 0.f};
        cur = nxt; cA = nA; cB = nB; ++ui;
        if constexpr (Epi::PREFETCH) E.prefetch(cur, wid, lane);
        if constexpr (ALIGN_EPI) { if (wr == 1) PG8_BAR; }
    }
    PG8_WAIT_V(0);
    if constexpr (!ALIGN_EPI) { if (wr == 0) PG8_BAR; }
    PG8_BAR;
    if constexpr (Epi::AFTER_DRAIN) { E.fused(acc, cur, wr, wc, fr, fq, lds, wid, lane); S.done(cur); }
#undef PG8_SA
#undef PG8_SB
#undef PG8_STAGE
#undef PG8_LDA
#undef PG8_LDB
#undef PG8_MMA
#undef PG8_WAIT_V
#undef PG8_WAIT_L
#undef PG8_BAR
#undef PG8_SCHED
}

struct MUnit { int r0, rend, e, pn, par; };
#define MG_LANE_OFFS(u, o) do { const int _t = wid * 64 + fresh_lane(); int _tk[2][2], _cc[2]; \
        _Pragma("unroll") for (int _i = 0; _i < 2; ++_i) { int _R, _C; stage_rc(_t * 16 + _i * 8192, _R, _C); _cc[_i] = _C; _Pragma("unroll") for (int _h = 0; _h < 2; ++_h) { const int _r = (u).r0 + _h * HALF + _R; \
            if (GATHER) { const int _rc = _r < (u).rend ? _r : (u).rend - 1; _tk[_h][_i] = slot_tok[_rc]; } else _tk[_h][_i] = _r; } } \
        if (GATHER) asm volatile("" : "+v"(_tk[0][0]), "+v"(_tk[0][1]), "+v"(_tk[1][0]), "+v"(_tk[1][1]));        \
        _Pragma("unroll") for (int _i = 0; _i < 2; ++_i) { int _R, _C; stage_rc(_t * 16 + _i * 8192, _R, _C); _Pragma("unroll") for (int _h = 0; _h < 2; ++_h) { const int _r = (u).r0 + _h * HALF + _R; \
            int _row = _tk[_h][_i]; if (GATHER && _r >= (u).rend) _row = 0; (o)[_h][_i] = (unsigned)(_row * K + _cc[_i]) * 2u; } } } while (0)
typedef int v8i_t __attribute__((ext_vector_type(8)));
typedef int v4i_t __attribute__((ext_vector_type(4)));
template <class Epi, class Sched, bool GATHER, int N, int K, bool F8 = false>
__device__ __forceinline__ void gemm_phase_moe(PG8_LAS unsigned char* lds, const bf16_t* A, const bf16_t* Bt, const int* slot_tok, const Sched& S, const Epi& E, int wave_id) {
    asm volatile("" : "+s"(wave_id));
    const int lane = fresh_lane(), wid = wave_id, tid = wid * 64 + lane, wr = wid >> 2, wc = wid & 3, fr = lane & 15, fq = lane >> 4;
    constexpr int nt = K / BK;
#define MG_OFFP(par) ((PG8_LAS unsigned*)(lds + STAGE_BYTES + 8192) + (par) * 2048 + tid)
#define MG_VOFFB ((PG8_LAS unsigned*)(lds + STAGE_BYTES + 24576) + tid)
#pragma unroll
    for (int i = 0; i < 2; ++i) { int R, C; stage_rc(tid * 16 + i * 8192, R, C); const int Rb = Epi::PERM ? ((R & ~31) + perm32(R & 31)) : R; MG_VOFFB[i * 512] = (unsigned)(Rb * K + C) * 2u; }
    constexpr size_t kstep = (size_t)(BK * 2);
    constexpr size_t hstep = (size_t)HALF * K * 2;
    constexpr size_t tstep = 2 * hstep;
    constexpr size_t estep = (size_t)N * K * 2;
    const unsigned ldsw = (unsigned)wid * 1024u;
    const int aoff = lds_byte(wr * 64 + fr, fq * 8), boff = lds_byte(wc * 32 + fr, fq * 8);
#define PG8_SA(b, h) (((b) * 2 + (h)) * HTB)
#define PG8_SB(b, h) ((4 + (b) * 2 + (h)) * HTB)
#define PG8_STAGE(bufoff, gbase, voff) do { _Pragma("unroll") for (int _i = 0; _i < 2; ++_i) \
        __builtin_amdgcn_global_load_lds((const unsigned*)((const char*)(gbase) + MG_VOFFB[_i * 512]), (PG8_LAS unsigned*)(lds + (bufoff) + ldsw + _i * 8192), 16, 0, 0); } while (0)
#define MG_STAGE_A(bufoff, par, h, kb) do { _Pragma("unroll") for (int _i = 0; _i < 2; ++_i) \
        __builtin_amdgcn_global_load_lds((const unsigned*)((const char*)A + (size_t)MG_OFFP(par)[((h) * 2 + _i) * 512] + (kb)), (PG8_LAS unsigned*)(lds + (bufoff) + ldsw + _i * 8192), 16, 0, 0); } while (0)
#define PG8_LDA(dst, b, h) do { _Pragma("unroll") for (int m = 0; m < 4; ++m) { const PG8_LAS unsigned char* p_ = lds + PG8_SA(b, h) + aoff + m * 2048; dst[m] = __builtin_shufflevector(*(const PG8_LAS v4i_t*)p_, *(const PG8_LAS v4i_t*)(p_ + 1024), 0, 1, 2, 3, 4, 5, 6, 7); } } while (0)
#define PG8_LDB(dst, b, h) do { _Pragma("unroll") for (int n = 0; n < 2; ++n) { const PG8_LAS unsigned char* p_ = lds + PG8_SB(b, h) + boff + n * 2048; dst[n] = __builtin_shufflevector(*(const PG8_LAS v4i_t*)p_, *(const PG8_LAS v4i_t*)(p_ + 1024), 0, 1, 2, 3, 4, 5, 6, 7); } } while (0)
#define PG8_MMA(ai, bj, At, Bt_) do { __builtin_amdgcn_s_setprio(1); \
        if constexpr (F8) { _Pragma("unroll") for (int m = 0; m < 4; ++m) _Pragma("unroll") for (int n = 0; n < 2; ++n) \
            acc[ai][bj][m][n] = __builtin_amdgcn_mfma_scale_f32_16x16x128_f8f6f4(Bt_[n], At[m], acc[ai][bj][m][n], 0, 0, 0, 0, 0, 0); } \
        else { _Pragma("unroll") for (int m = 0; m < 4; ++m) _Pragma("unroll") for (int n = 0; n < 2; ++n) { \
            acc[ai][bj][m][n] = __builtin_amdgcn_mfma_f32_16x16x32_bf16(__builtin_bit_cast(bf16x8, __builtin_shufflevector(Bt_[n], Bt_[n], 0, 1, 2, 3)), __builtin_bit_cast(bf16x8, __builtin_shufflevector(At[m], At[m], 0, 1, 2, 3)), acc[ai][bj][m][n], 0, 0, 0); \
            acc[ai][bj][m][n] = __builtin_amdgcn_mfma_f32_16x16x32_bf16(__builtin_bit_cast(bf16x8, __builtin_shufflevector(Bt_[n], Bt_[n], 4, 5, 6, 7)), __builtin_bit_cast(bf16x8, __builtin_shufflevector(At[m], At[m], 4, 5, 6, 7)), acc[ai][bj][m][n], 0, 0, 0); } } \
        __builtin_amdgcn_s_setprio(0); } while (0)
#define PG8_WAIT_V(n) asm volatile("s_waitcnt vmcnt(" #n ")" ::: "memory")
#define PG8_WAIT_L(n) asm volatile("s_waitcnt lgkmcnt(" #n ")" ::: "memory")
#define PG8_BAR __builtin_amdgcn_s_barrier()
#define PG8_SCHED __builtin_amdgcn_sched_barrier(0)
    MUnit cur, nxt; int ui = 0;
    if (!S.next(0, cur)) return;
    f32x4 acc[2][2][4][2];
#pragma unroll
    for (int a = 0; a < 2; ++a)
#pragma unroll
        for (int b = 0; b < 2; ++b)
#pragma unroll
            for (int m = 0; m < 4; ++m)
#pragma unroll
                for (int n = 0; n < 2; ++n) acc[a][b][m][n] = (f32x4){0.f, 0.f, 0.f, 0.f};
    v8i_t At[4], B0[2], B1[2];
    cur.par = 0; if constexpr (Epi::PREFETCH) E.prefetch(cur, wid, lane);
    { unsigned o_[2][2]; MG_LANE_OFFS(cur, o_); PG8_LAS unsigned* p_ = MG_OFFP(0); p_[0] = o_[0][0]; p_[512] = o_[0][1]; p_[1024] = o_[1][0]; p_[1536] = o_[1][1]; }
    const char* cB = (const char*)Bt + (size_t)cur.e * estep + (size_t)cur.pn * tstep;
    PG8_STAGE(PG8_SB(0, 0), cB, voffB); PG8_STAGE(PG8_SB(0, 1), cB + hstep, voffB); MG_STAGE_A(PG8_SA(0, 0), 0, 0, 0); MG_STAGE_A(PG8_SA(0, 1), 0, 1, 0);
    if (wr == 1) PG8_BAR;
    PG8_WAIT_V(2); PG8_BAR;
    PG8_STAGE(PG8_SB(1, 0), cB + kstep, voffB); MG_STAGE_A(PG8_SA(1, 0), 0, 0, kstep); PG8_STAGE(PG8_SB(1, 1), cB + hstep + kstep, voffB);
    PG8_WAIT_V(6); PG8_BAR;
    for (;;) {
        const bool has_next = S.next(ui + 1, nxt); nxt.par = (ui + 1) & 1;
        const bool hi_rows = (cur.rend - cur.r0) > HALF;
        const char* nB = cB;
        const int pc = ui & 1, pn_ = has_next ? (pc ^ 1) : pc;
        if (has_next) { unsigned on[2][2]; MG_LANE_OFFS(nxt, on); nB = (const char*)Bt + (size_t)nxt.e * estep + (size_t)nxt.pn * tstep;
            PG8_LAS unsigned* p_ = MG_OFFP(pn_); p_[0] = on[0][0]; p_[512] = on[0][1]; p_[1024] = on[1][0]; p_[1536] = on[1][1]; }
        for (int t = 0; t < nt; t += 2) {
            const bool last = (t == nt - 2);
            const size_t k1 = (size_t)(t + 1) * kstep, k2 = last ? (size_t)0 : (size_t)(t + 2) * kstep, k3 = k2 + kstep;
            const char* b2 = last ? nB : cB + (size_t)(t + 2) * kstep; const char* b3 = b2 + kstep;
            const int p2 = last ? pn_ : pc;
            PG8_LDB(B0, 0, 0); PG8_LDB(B1, 0, 1); PG8_SCHED; PG8_LDA(At, 0, 0); MG_STAGE_A(PG8_SA(1, 1), pc, 1, k1);
            PG8_WAIT_V(8); PG8_WAIT_L(0); PG8_BAR; PG8_MMA(0, 0, At, B0); PG8_MMA(0, 1, At, B1); PG8_BAR; PG8_SCHED;
            PG8_LDA(At, 0, 1); PG8_STAGE(PG8_SB(0, 0), b2, voffB); PG8_STAGE(PG8_SB(0, 1), b2 + hstep, voffB); MG_STAGE_A(PG8_SA(0, 0), p2, 0, k2);
            PG8_WAIT_V(8); PG8_WAIT_L(0); PG8_BAR; if (hi_rows) { PG8_MMA(1, 0, At, B0); PG8_MMA(1, 1, At, B1); } PG8_BAR; PG8_SCHED;
            PG8_LDB(B0, 1, 0); PG8_LDB(B1, 1, 1); PG8_SCHED; PG8_LDA(At, 1, 0); MG_STAGE_A(PG8_SA(0, 1), p2, 1, k2);
            PG8_WAIT_V(8); PG8_WAIT_L(0); PG8_BAR; PG8_MMA(0, 0, At, B0); PG8_MMA(0, 1, At, B1); PG8_BAR; PG8_SCHED;
            PG8_LDA(At, 1, 1); PG8_STAGE(PG8_SB(1, 0), b3, voffB); PG8_STAGE(PG8_SB(1, 1), b3 + hstep, voffB); MG_STAGE_A(PG8_SA(1, 0), p2, 0, k3);
            PG8_WAIT_V(8); PG8_WAIT_L(0); PG8_BAR; if (hi_rows) { PG8_MMA(1, 0, At, B0); PG8_MMA(1, 1, At, B1); } PG8_BAR; PG8_SCHED;
        }
        if (wr == 0) PG8_BAR;
        E(acc, cur, wr, wc, fr, fq);
        if (!has_next) break;
#pragma unroll
        for (int a = 0; a < 2; ++a)
#pragma unroll
            for (int b = 0; b < 2; ++b)
#pragma unroll
                for (int m = 0; m < 4; ++m)
#pragma unroll
                    for (int n = 0; n < 2; ++n) acc[a][b][m][n] = (f32x4){0.f, 0.f, 0.f, 0.f};
        cur = nxt; cB = nB; ++ui;
        if constexpr (Epi::PREFETCH) E.prefetch(cur, wid, lane);
        if (wr == 1) PG8_BAR;
    }
    PG8_WAIT_V(0);
    PG8_BAR;
#undef PG8_SA
#undef PG8_SB
#undef PG8_STAGE
#undef MG_STAGE_A
#undef MG_OFFP
#undef MG_VOFFB
#undef PG8_LDA
#undef PG8_LDB
#undef PG8_MMA
#undef PG8_WAIT_V
#undef PG8_WAIT_L
#undef PG8_BAR
#undef PG8_SCHED
}
__device__ __forceinline__ float fast_silu(float x) { return x * __builtin_amdgcn_rcpf(1.0f + __builtin_amdgcn_exp2f(-1.4426950408889634f * x)); }
struct EpiMoeH {
    static constexpr bool PERM = true;
    static constexpr bool PREFETCH = true;
    bf16_t* H; const float* rs; PG8_LAS float* lrs;
    __device__ __forceinline__ void prefetch(const MUnit& u, int wid, int lane) const {
        if (wid < 4) __builtin_amdgcn_global_load_lds((const unsigned*)(rs + u.r0 + wid * 64 + lane), (PG8_LAS unsigned*)(lrs + u.par * 256 + wid * 64), 4, 0, 0); }
    __device__ __forceinline__ void operator()(const f32x4 (&acc)[2][2][4][2], const MUnit& u, int wr, int wc, int fr, int fq) const {
        { const int t_ = fresh_lane(); fr = t_ & 15; fq = t_ >> 4; }
        const int col0 = u.pn * 128 + wc * 32 + 8 * fq;
        float sc[2][4];
#pragma unroll
        for (int ai = 0; ai < 2; ++ai)
#pragma unroll
            for (int m = 0; m < 4; ++m) sc[ai][m] = lrs[u.par * 256 + ai * HALF + wr * 64 + m * 16 + fr];
#pragma unroll
        for (int ai = 0; ai < 2; ++ai)
#pragma unroll
            for (int m = 0; m < 4; ++m) { const int r = u.r0 + ai * HALF + wr * 64 + m * 16 + fr;
                const float s_ = sc[ai][m] * (1.0f / 64.0f);
                const f32x4 g0 = acc[ai][0][m][0] * s_, g1 = acc[ai][0][m][1] * s_, u0 = acc[ai][1][m][0] * s_, u1 = acc[ai][1][m][1] * s_;
                typedef unsigned u32x2q __attribute__((ext_vector_type(2)));
                u32x2q w; w.x = pk4_fp8(8.f * fast_silu(g0[0]) * u0[0], 8.f * fast_silu(g0[1]) * u0[1], 8.f * fast_silu(g0[2]) * u0[2], 8.f * fast_silu(g0[3]) * u0[3]);
                w.y = pk4_fp8(8.f * fast_silu(g1[0]) * u1[0], 8.f * fast_silu(g1[1]) * u1[1], 8.f * fast_silu(g1[2]) * u1[2], 8.f * fast_silu(g1[3]) * u1[3]);
                if (r < u.rend) *(u32x2q*)((unsigned char*)H + (size_t)r * 256 + col0) = w; }
    }
};
struct EpiMoeY {
    static constexpr bool PERM = true, PREFETCH = false;
    bf16_t* Y;
    __device__ __forceinline__ void operator()(const f32x4 (&acc)[2][2][4][2], const MUnit& u, int wr, int wc, int fr, int fq) const {
        { const int t_ = fresh_lane(); fr = t_ & 15; fq = t_ >> 4; }
        const int col0 = u.pn * BM + wc * 32 + 8 * fq;
#pragma unroll
        for (int ai = 0; ai < 2; ++ai)
#pragma unroll
            for (int m = 0; m < 4; ++m) { const int r = u.r0 + ai * HALF + wr * 64 + m * 16 + fr;
#pragma unroll
                for (int bj = 0; bj < 2; ++bj) { const f32x4 v0 = acc[ai][bj][m][0] * (1.0f / 64.0f), v1 = acc[ai][bj][m][1] * (1.0f / 64.0f);
                    typedef unsigned u32x2q __attribute__((ext_vector_type(2)));
                    if (r < u.rend) *(u32x2q*)((unsigned char*)Y + (size_t)r * 1024 + col0 + bj * HALF) = (u32x2q){pk4_fp8(v0[0], v0[1], v0[2], v0[3]), pk4_fp8(v1[0], v1[1], v1[2], v1[3])}; } }
    }
};
struct EpiMoeRes {
    static constexpr bool PERM = true, PREFETCH = false;
    bf16_t* O; unsigned char* Q; float scale;
    __device__ __forceinline__ void operator()(const f32x4 (&acc)[2][2][4][2], const MUnit& u, int wr, int wc, int fr, int fq) const {
        { const int t_ = fresh_lane(); fr = t_ & 15; fq = t_ >> 4; }
        const int col0 = u.pn * BM + wc * 32 + 8 * fq;
#pragma unroll
        for (int ai = 0; ai < 2; ++ai)
#pragma unroll
            for (int m = 0; m < 4; ++m) { const size_t off = (size_t)(u.r0 + ai * HALF + wr * 64 + m * 16 + fr) * 1024 + col0;
#pragma unroll
                for (int bj = 0; bj < 2; ++bj) { f32x4 v0 = acc[ai][bj][m][0] * scale, v1 = acc[ai][bj][m][1] * scale;
                    const u32x4 rw = *(const u32x4*)(O + off + bj * HALF);
                    v0[0] += __uint_as_float(rw.x << 16); v0[1] += __uint_as_float(rw.x & 0xffff0000u); v0[2] += __uint_as_float(rw.y << 16); v0[3] += __uint_as_float(rw.y & 0xffff0000u);
                    v1[0] += __uint_as_float(rw.z << 16); v1[1] += __uint_as_float(rw.z & 0xffff0000u); v1[2] += __uint_as_float(rw.w << 16); v1[3] += __uint_as_float(rw.w & 0xffff0000u);
                    u32x4 w; w.x = cvt_pk_bf16(v0[0], v0[1]); w.y = cvt_pk_bf16(v0[2], v0[3]); w.z = cvt_pk_bf16(v1[0], v1[1]); w.w = cvt_pk_bf16(v1[2], v1[3]);
                    *(u32x4*)(O + off + bj * HALF) = w;
                    typedef unsigned u32x2q __attribute__((ext_vector_type(2))); *(u32x2q*)(Q + off + bj * HALF) = (u32x2q){pk4_fp8(v0[0], v0[1], v0[2], v0[3]), pk4_fp8(v1[0], v1[1], v1[2], v1[3])}; } }
    }
};
struct MoeSched {
    const PG8_LAS int* tab;
    int npn, first, end, stride, c, split;
    __device__ __forceinline__ bool next(int i, MUnit& u) const {
        int L = first + c + i * stride;
        if (c < 0 || L >= end) return false;
        const int half = split ? (L & 1) : 0; if (split) L >>= 1;
        const int j = L / npn; u.pn = L % npn;
        u.e = __builtin_amdgcn_readfirstlane(tab[4 + 4 * j]); u.r0 = __builtin_amdgcn_readfirstlane(tab[5 + 4 * j]); u.rend = __builtin_amdgcn_readfirstlane(tab[6 + 4 * j]);
        if (split) { u.r0 += HALF * half; const int cap = u.r0 + HALF; u.rend = u.rend < cap ? u.rend : cap; }
        return true;
    }
};
}

#ifndef PG8_SP2
#define PG8_SP2 true
#endif
#ifndef PG8_ALIGN
#define PG8_ALIGN true
#endif

constexpr int NWAVES = 8, NT = NWAVES * 64;
constexpr int D = 1024, NB = 2, S = 8192, T = NB * S, DEPTH = 2;
constexpr int DIN = 2832, PLD = 3072;
constexpr int C_Q = 0, C_K = 256, C_V = 512, C_G = 1024, C_U = 1536, C_VG = 1792, C_XI = 2048, C_BG = 2304, C_CG = 2560, C_PRE = 2816;
constexpr int W_GK = 1536;
constexpr int GH = 4, GC = 64, GN = S / GC;
constexpr int MH = 4, MC = 128, MN = S / MC;
constexpr int NE = 32, DE = 256;
constexpr float EPS = 1e-6f;
constexpr size_t MiB = 1u << 20;
constexpr size_t WS_CTL = 0, CTL_BYTES = 1 * MiB;
constexpr size_t WS_WIN = 1 * MiB;
constexpr size_t WS_WOUT = 13 * MiB;
constexpr size_t WS_WGU = 17 * MiB;
constexpr size_t WS_XQ = 49 * MiB;
constexpr size_t WS_WD = 81 * MiB;
constexpr size_t WS_XN = 113 * MiB;
constexpr size_t WS_P = 145 * MiB;
constexpr size_t WS_Y = WS_P + 17 * MiB;
constexpr size_t WS_S = 276 * MiB;
constexpr size_t WS_XRES = 241 * MiB;
constexpr size_t WS_DEC = 273 * MiB;
constexpr size_t WS_MISC = 274 * MiB;
constexpr size_t WS_WSP = WS_MISC + 524288;
constexpr size_t WS_RINV1 = WS_MISC + 786432, WS_RINV2 = WS_RINV1 + 65536, WS_SRINV = WS_RINV2 + 65536;
constexpr size_t WS_WR = 275 * MiB;
constexpr size_t WS_BLKCNT = WS_WR + 524288;
constexpr size_t WS_END = 284 * MiB;
constexpr int CW_BAR = 4096, CW_CNT = 16384;
constexpr int RING_BYTES = 131072, LDSCTL_OFF = RING_BYTES, MISC_OFF = LDSCTL_OFF + 320, LDS_BYTES = 163840;

constexpr float MIXS = 16.0f, CONVS = 8.0f;
#define GAS __attribute__((address_space(1)))
#define LAS __attribute__((address_space(3)))
typedef unsigned short bf16;
typedef unsigned v4u __attribute__((ext_vector_type(4)));
typedef unsigned v2u __attribute__((ext_vector_type(2)));
typedef float f32x4 __attribute__((ext_vector_type(4)));
typedef __bf16 bf16x2_t __attribute__((ext_vector_type(2)));
typedef float f32x2_t __attribute__((ext_vector_type(2)));
__device__ __forceinline__ unsigned f2bf(float f) { return (unsigned)__builtin_bit_cast(unsigned short, (__bf16)f); }
__device__ __forceinline__ unsigned pk2(float lo, float hi) { f32x2_t v = {lo, hi}; bf16x2_t b = __builtin_convertvector(v, bf16x2_t); return __builtin_bit_cast(unsigned, b); }
__device__ __forceinline__ float bf2f(unsigned v) { return __uint_as_float(v << 16); }
__device__ __forceinline__ float bflo(unsigned w) { return __uint_as_float(w << 16); }
__device__ __forceinline__ float bfhi(unsigned w) { return __uint_as_float(w & 0xffff0000u); }
__device__ __forceinline__ void unpack8(const v4u q, float (&f)[8]) { f[0] = bflo(q.x); f[1] = bfhi(q.x); f[2] = bflo(q.y); f[3] = bfhi(q.y); f[4] = bflo(q.z); f[5] = bfhi(q.z); f[6] = bflo(q.w); f[7] = bfhi(q.w); }
__device__ __forceinline__ float gelu_tanh(float x) { const float u = 0.7978845608028654f * (x + 0.044715f * x * x * x); return 0.5f * x * (1.0f + tanhf(u)); }
__device__ __forceinline__ float silu(float x) { return x / (1.0f + expf(-x)); }
__device__ __forceinline__ float log_sigmoid(float x) { return fminf(x, 0.f) - log1pf(expf(-fabsf(x))); }

#define XB_TMO      128
#define XB_XCNT(j)  (256  + 64 * (j))
#define XB_XSUB(j)  (1280 + 64 * (j))
#define XB_XGEN(j)  (2304 + 64 * (j))
#define XB_TOP      3328
#define XB_TOPGEN   3392
#define XCD_BAR_WORDS 3456
#define XB_SPIN_CAP (1u << 18)

__device__ __forceinline__ unsigned xb_ld(unsigned* p)              { return __hip_atomic_load(p, __ATOMIC_RELAXED, __HIP_MEMORY_SCOPE_AGENT); }
__device__ __forceinline__ unsigned xb_add(unsigned* p, unsigned v) { return __hip_atomic_fetch_add(p, v, __ATOMIC_RELAXED, __HIP_MEMORY_SCOPE_AGENT); }
__device__ __forceinline__ unsigned xb_xcc_id() { return (unsigned)__builtin_amdgcn_s_getreg((3 << 11) | 20) & 0xFu; }
#define XB_SPIN(cond, bar) do { unsigned _sp = 0; while (cond) { __builtin_amdgcn_s_sleep(1); \
    if ((++_sp & 255u) == 0u) { if (xb_ld(&(bar)[XB_TMO])) break; if (_sp > XB_SPIN_CAP) { atomicAdd(&(bar)[XB_TMO], 1u); break; } } } } while (0)

struct XcdBarrier {
    int wave;
    unsigned* bar; unsigned x;
    volatile LAS unsigned* st;
};

__device__ __forceinline__ XcdBarrier xcd_barrier_post(unsigned* bar, volatile LAS unsigned* st) {
    XcdBarrier b; b.bar = bar; b.x = xb_xcc_id(); b.st = st; b.wave = __builtin_amdgcn_readfirstlane(threadIdx.x >> 6);
    if (threadIdx.x == 0) (void)xb_add(&bar[XB_XCNT(b.x)], 1u);
    return b;
}
__device__ __forceinline__ void xcd_barrier_complete(unsigned* bar, unsigned x, unsigned& nloc, unsigned& nx) {
    const unsigned G = gridDim.x * gridDim.y * gridDim.z;
    unsigned sum, cnt, mine, sp = 0u;
    for (;;) {
        sum = 0u; cnt = 0u; mine = 0u;
#pragma unroll
        for (unsigned j = 0; j < 16; ++j) { const unsigned c = xb_ld(&bar[XB_XCNT(j)]); sum += c; cnt += (c > 0u) ? 1u : 0u; mine = (j == x) ? c : mine; }
        if (sum == G) break;
        __builtin_amdgcn_s_sleep(1);
        if ((++sp & 255u) == 0u) { if (xb_ld(&bar[XB_TMO])) break; if (sp > XB_SPIN_CAP) { atomicAdd(&bar[XB_TMO], 1u); break; } }
    }
    nloc = mine > 0u ? mine : 1u; nx = cnt > 0u ? cnt : 1u;
}

__device__ __forceinline__ void xcd_barrier(const XcdBarrier& b) {
    asm volatile("s_waitcnt vmcnt(0)" ::: "memory");
    __syncthreads();
    if (b.wave == 0 && fresh_lane() == 0) {
        unsigned* bar = b.bar; asm volatile("" : "+s"(bar));
        __builtin_amdgcn_s_waitcnt(0);
        unsigned nloc = b.st[0], nx = b.st[1];
        if (nloc == 0u) { xcd_barrier_complete(bar, b.x, nloc, nx); b.st[0] = nloc; b.st[1] = nx; }
        const unsigned old = xb_add(&bar[XB_XSUB(b.x)], 1u);
        const unsigned gen = old / nloc;
        if (old + 1u == (gen + 1u) * nloc) {
            __builtin_amdgcn_fence(__ATOMIC_RELEASE, "agent");
            asm volatile("s_waitcnt vmcnt(0)" ::: "memory");
#pragma unroll
            for (unsigned j = 0; j < 16; ++j) xb_add(&bar[XB_XGEN(j)], 1u);
        }
        XB_SPIN((int)(xb_ld(&bar[XB_XGEN(b.x)]) - (gen + 1u) * nx) < 0, bar);
        __builtin_amdgcn_fence(__ATOMIC_ACQUIRE, "agent");
        asm volatile("s_waitcnt vmcnt(0)" ::: "memory");
    }
    __syncthreads();
}

__device__ __forceinline__ void xcd_barrier_arrive(const XcdBarrier& b) {
    asm volatile("s_waitcnt vmcnt(0)" ::: "memory");
    __syncthreads();
    if (b.wave == 0 && fresh_lane() == 0) {
        unsigned* bar = b.bar; asm volatile("" : "+s"(bar));
        __builtin_amdgcn_s_waitcnt(0);
        unsigned nloc = b.st[0], nx = b.st[1];
        if (nloc == 0u) { xcd_barrier_complete(bar, b.x, nloc, nx); b.st[0] = nloc; b.st[1] = nx; }
        const unsigned old = xb_add(&bar[XB_XSUB(b.x)], 1u);
        const unsigned gen = old / nloc;
        if (old + 1u == (gen + 1u) * nloc) {
            __builtin_amdgcn_fence(__ATOMIC_RELEASE, "agent");
            asm volatile("s_waitcnt vmcnt(0)" ::: "memory");
#pragma unroll
            for (unsigned j = 0; j < 16; ++j) xb_add(&bar[XB_XGEN(j)], 1u);
        }
        b.st[2] = (gen + 1u) * nx;
    }
}
__device__ __forceinline__ void xcd_barrier_wait(const XcdBarrier& b) {
    if (b.wave == 0 && fresh_lane() == 0) {
        unsigned* bar = b.bar; asm volatile("" : "+s"(bar));
        const unsigned target = b.st[2];
        XB_SPIN((int)(xb_ld(&bar[XB_XGEN(b.x)]) - target) < 0, bar);
        __builtin_amdgcn_fence(__ATOMIC_ACQUIRE, "agent");
        asm volatile("s_waitcnt vmcnt(0)" ::: "memory");
    }
    __syncthreads();
}

#define AS4 __attribute__((address_space(4)))
struct KA {
    const AS4 char* ka;
    static __device__ __forceinline__ KA fresh() { KA k; k.ka = (const AS4 char*)__builtin_amdgcn_kernarg_segment_ptr(); asm volatile("" : "+s"(k.ka)); return k; }
    __device__ __forceinline__ const float* in(int i) const { return *(const float* const AS4*)(ka + 8 * i); }
    __device__ __forceinline__ float* out() const { return *(float* const AS4*)(ka + 160); }
    __device__ __forceinline__ unsigned char* ws() const { return *(unsigned char* const AS4*)(ka + 168); }
    __device__ __forceinline__ unsigned* ctl() const { return (unsigned*)(ws() + WS_CTL); }
    __device__ __forceinline__ bf16* WinT() const { return (bf16*)(ws() + WS_WIN); }
    __device__ __forceinline__ bf16* WoutT() const { return (bf16*)(ws() + WS_WOUT); }
    __device__ __forceinline__ bf16* WguT() const { return (bf16*)(ws() + WS_WGU); }
    __device__ __forceinline__ bf16* WdT() const { return (bf16*)(ws() + WS_WD); }
    __device__ __forceinline__ unsigned char* XQ() const { return ws() + WS_XQ; }
    __device__ __forceinline__ bf16* XN() const { return (bf16*)(ws() + WS_XN); }
    __device__ __forceinline__ bf16* P() const { return (bf16*)(ws() + WS_P); }
    __device__ __forceinline__ bf16* H1() const { return (bf16*)(ws() + WS_P); }
    __device__ __forceinline__ bf16* Y() const { return (bf16*)(ws() + WS_Y); }
    __device__ __forceinline__ float* Sst() const { return (float*)(ws() + WS_S); }
    __device__ __forceinline__ float* dec() const { return (float*)(ws() + WS_DEC); }
    __device__ __forceinline__ int* eid() const { return (int*)(ws() + WS_MISC); }
    __device__ __forceinline__ float* ew() const { return (float*)(ws() + WS_MISC + 131072); }
    __device__ __forceinline__ int* slot_tok() const { return (int*)(ws() + WS_MISC + 2 * 131072); }
    __device__ __forceinline__ int* slot_of() const { return (int*)(ws() + WS_MISC + 3 * 131072); }
    __device__ __forceinline__ bf16* Wsp() const { return (bf16*)(ws() + WS_WSP); }
    __device__ __forceinline__ bf16* Wr() const { return (bf16*)(ws() + WS_WR); }
    __device__ __forceinline__ bf16* XR() const { return (bf16*)(ws() + WS_XRES); }
    __device__ __forceinline__ int* blkcnt() const { return (int*)(ws() + WS_BLKCNT); }
    __device__ __forceinline__ float* rinv1() const { return (float*)(ws() + WS_RINV1); }
    __device__ __forceinline__ float* rinv2() const { return (float*)(ws() + WS_RINV2); }
    __device__ __forceinline__ float* srinv() const { return (float*)(ws() + WS_SRINV); }
};
struct Frame {
    LAS unsigned char* lds; float* smem;
    int G, bx, wave;
};
#define PHASE_TID const int lane = fresh_lane(), wave = F.wave, tid = wave * 64 + lane; (void)lane; (void)wave; (void)tid

__device__ __forceinline__ float wave_sum(float v) {
    v = sum16(v);
    const int iv = __float_as_int(v);
    return (__int_as_float(__builtin_amdgcn_readlane(iv, 0)) + __int_as_float(__builtin_amdgcn_readlane(iv, 16))) + (__int_as_float(__builtin_amdgcn_readlane(iv, 32)) + __int_as_float(__builtin_amdgcn_readlane(iv, 48)));
}

struct TrItem { const float* W; bf16* WT; int ldw, nvalid, k0, n0, ldt, drow0; const float* gain; int f8; int kthr; float kscale; const float* wup; };
__device__ __forceinline__ void transpose_load(const TrItem& t, int lane, f32x4 (&v)[8], float (&g)[8]) {
    const int sub = lane >> 3, c4 = (lane & 7) * 4;
#pragma unroll
    for (int i = 0; i < 8; ++i) v[i] = (c4 < t.nvalid && !t.wup) ? __builtin_nontemporal_load((const f32x4*)(t.W + (size_t)(t.k0 + 8 * i + sub) * t.ldw + t.n0 + c4)) : (f32x4){0.f, 0.f, 0.f, 0.f};
#pragma unroll
    for (int i = 0; i < 8; ++i) g[i] = t.gain ? t.gain[t.k0 + 8 * i + sub] : 1.f;
    if (t.wup) {
#pragma unroll
        for (int rg = 0; rg < 4; ++rg) {
            f32x4 wu[4];
#pragma unroll
            for (int r = 0; r < 4; ++r) wu[r] = *(const f32x4*)(t.wup + (4 * rg + r) * 256 + t.n0 + c4);
#pragma unroll
            for (int i = 0; i < 8; ++i) { const f32x4 a = *(const f32x4*)(t.W + (size_t)(t.k0 + 8 * i + sub) * t.ldw + W_GK + 4 * rg);
                v[i] += wu[0] * a.x + wu[1] * a.y + wu[2] * a.z + wu[3] * a.w; } } }
}
__device__ __forceinline__ void transpose_finish(const TrItem& t, int lane, f32x4 (&v)[8], const float (&g)[8]) {
    const int sub = lane >> 3;
#pragma unroll
    for (int i = 0; i < 8; ++i) v[i] *= g[i] * (t.f8 ? ((t.k0 + 8 * i + sub >= t.kthr) ? 64.f * t.kscale : 64.f) : 1.f);
}
__device__ __forceinline__ void transpose_store(const TrItem& t, int lane, const f32x4 (&v)[8], LAS float* scr) {
    const int sub = lane >> 3, c4 = (lane & 7) * 4;
#pragma unroll
    for (int i = 0; i < 8; ++i) { LAS float* d = scr + (8 * i + sub) * 33 + c4; d[0] = v[i].x; d[1] = v[i].y; d[2] = v[i].z; d[3] = v[i].w; }
    asm volatile("s_waitcnt lgkmcnt(0)" ::: "memory");
    const int c = lane & 7;
#pragma unroll
    for (int j = 0; j < 4; ++j) { const int n = (lane >> 3) + 8 * j; const LAS float* s = scr + (8 * c) * 33 + n;
        v4u o; o.x = pk2(s[0 * 33], s[1 * 33]); o.y = pk2(s[2 * 33], s[3 * 33]); o.z = pk2(s[4 * 33], s[5 * 33]); o.w = pk2(s[6 * 33], s[7 * 33]);
        if (t.f8) { unsigned q0 = 0u, q1 = 0u;
            q0 = pg8::pk4_fp8(s[0 * 33], s[1 * 33], s[2 * 33], s[3 * 33]); q1 = pg8::pk4_fp8(s[4 * 33], s[5 * 33], s[6 * 33], s[7 * 33]);
            *(GAS v2u*)((unsigned char*)t.WT + (size_t)(t.drow0 + n) * t.ldt + t.k0 + 8 * c) = (v2u){q0, q1}; }
        else if (n < t.nvalid) *(GAS v4u*)(t.WT + (size_t)(t.drow0 + n) * t.ldt + t.k0 + 8 * c) = o; }
    asm volatile("s_waitcnt lgkmcnt(0)" ::: "memory");
}
constexpr int I_IN = 16 * 88 + 16 * 8, I_OUT = 16 * 32, I_G = 32 * 16 * 8, I_D = 32 * 4 * 32, I_L = I_IN + I_OUT + 2 * I_G + I_D;
#define TR_DECODE(it_, t_) do { const int l_ = (it_) / I_L; int r_ = (it_) % I_L; \
        if (r_ < 16 * 88) { const int kb = r_ / 88, nb = r_ % 88; t_ = TrItem{K.in(2) + (size_t)l_ * D * DIN, K.WinT() + (size_t)l_ * PLD * D, DIN, 32, kb * 64, (nb < 48) ? nb * 32 : nb * 32 + 16, D, nb * 32, K.in(1) + (size_t)l_ * D, 0, 1 << 30, 1.f, nullptr}; } \
        else if (r_ < I_IN) { r_ -= 16 * 88; const int kb = r_ / 8, nb = r_ % 8; t_ = TrItem{K.in(2) + (size_t)l_ * D * DIN, K.WinT() + (size_t)l_ * PLD * D, DIN, 32, kb * 64, nb * 32, D, C_PRE + nb * 32, K.in(1) + (size_t)l_ * D, 0, 1 << 30, 1.f, K.in(3) + (size_t)l_ * 16 * 256}; } \
        else if (r_ < I_IN + I_OUT) { r_ -= I_IN; const int kb = r_ / 32, nb = r_ % 32; t_ = TrItem{K.in(10) + (size_t)l_ * D * D, (bf16*)((unsigned char*)K.WoutT() + (size_t)l_ * D * D), D, 32, kb * 64, nb * 32, D, nb * 32, nullptr, 1, 768, MIXS / CONVS, nullptr}; } \
        else if (r_ < I_IN + I_OUT + 2 * I_G) { r_ -= I_IN + I_OUT; const int sel = r_ / I_G; r_ %= I_G; const int e = r_ / 128, kb = (r_ % 128) / 8, n0 = (r_ % 8) * 32; \
            t_ = TrItem{K.in(16 + sel) + ((size_t)l_ * NE + e) * D * DE, (bf16*)((unsigned char*)K.WguT() + ((size_t)l_ * NE + e) * 512 * D), DE, 32, kb * 64, n0, D, (n0 >> 7) * 256 + sel * 128 + (n0 & 127), K.in(11) + (size_t)l_ * D, 1, 1 << 30, 1.f, nullptr}; } \
        else { r_ -= I_IN + I_OUT + 2 * I_G; const int e = r_ / 128, kb = (r_ % 128) / 32, nb = r_ % 32; t_ = TrItem{K.in(18) + ((size_t)l_ * NE + e) * DE * D, (bf16*)((unsigned char*)K.WdT() + ((size_t)l_ * NE + e) * D * DE), D, 32, kb * 64, nb * 32, DE, nb * 32, nullptr, 1, 1 << 30, 1.f, nullptr}; } } while (0)
__device__ __forceinline__ void tr_items(Frame& F, int lo, int hi) {
    const KA K = KA::fresh(); PHASE_TID; (void)tid;
    LAS float* scr = (LAS float*)(F.lds + wave * 16384);
    const int gw = F.bx * NWAVES + wave, NGW = F.G * NWAVES;
    {
        TrItem tA, tB; f32x4 vA[8], vB[8]; float gA[8], gB[8];
        const int NIT = hi;
        int it = lo + gw;
        if (it < NIT) { TR_DECODE(it, tA); transpose_load(tA, lane, vA, gA); }
#pragma unroll 1
        for (; it < NIT; it += 2 * NGW) {
            if (it + NGW < NIT) { TR_DECODE(it + NGW, tB); transpose_load(tB, lane, vB, gB); }
            transpose_finish(tA, lane, vA, gA); transpose_store(tA, lane, vA, scr);
            if (it + NGW < NIT) {
                if (it + 2 * NGW < NIT) { TR_DECODE(it + 2 * NGW, tA); transpose_load(tA, lane, vA, gA); }
                transpose_finish(tB, lane, vB, gB); transpose_store(tB, lane, vB, scr); }
        }
    }
}
__device__ __forceinline__ void tr_items_1(Frame& F, int lo, int hi) {
    const KA K = KA::fresh(); PHASE_TID; (void)tid;
    LAS float* scr = (LAS float*)(F.lds + wave * 16384);
    const int NGW = F.G * NWAVES;
#pragma unroll 1
    for (int it = lo + wave * F.G + F.bx; it < hi; it += NGW) { TrItem t;        f32x4 v[8]; float g[8]; TR_DECODE(it, t); transpose_load(t, lane, v, g); transpose_finish(t, lane, v, g); transpose_store(t, lane, v, scr); }
}
#undef TR_DECODE
__device__ __forceinline__ void p0_prologue(Frame& F) {
    tr_items(F, 0, I_IN);
    const KA K = KA::fresh(); PHASE_TID;
    const int gw = F.bx * NWAVES + wave, NGW = F.G * NWAVES;
    {   const int lane = fresh_lane(), tid = wave * 64 + lane; (void)tid;
    for (int i = F.bx * NT + tid; i < DEPTH * 48 * D; i += F.G * NT) { const int ll = i / (48 * D), n = (i / D) % 48, k = i % D;
        float w = 0.f;
        if (n < 4) w = K.in(12)[((size_t)ll * D + k) * 4 + n]; else if (n < 36) w = K.in(14)[((size_t)ll * D + k) * 32 + (n - 4)];
        w *= K.in(11)[(size_t)ll * D + k];
        const unsigned hi = f2bf(w), lo = f2bf(w - bf2f(hi));
        K.Wr()[((size_t)ll * 2 + 0) * 48 * D + (size_t)n * D + k] = (bf16)hi; K.Wr()[((size_t)ll * 2 + 1) * 48 * D + (size_t)n * D + k] = (bf16)lo; }
    for (int i = F.bx * NT + tid; i < DEPTH * MH * 128 * 128 / 8; i += F.G * NT) { const int e0 = i * 8, s0 = e0 & 127, t = (e0 >> 7) & 127;
        const f32x4 a = *(const f32x4*)(K.in(7) + e0), c = *(const f32x4*)(K.in(7) + e0 + 4);
        const float v[8] = {a.x, a.y, a.z, a.w, c.x, c.y, c.z, c.w}; unsigned w[4];
#pragma unroll
        for (int j = 0; j < 4; ++j) w[j] = pk2((s0 + 2 * j <= t) ? v[2 * j] : 0.f, (s0 + 2 * j + 1 <= t) ? v[2 * j + 1] : 0.f);
        *(GAS v4u*)(K.Wsp() + e0) = (v4u){w[0], w[1], w[2], w[3]}; }
    {
        f32x4 v[4], vn[4];
        int m = gw;
        if (m < T) {
#pragma unroll
            for (int j = 0; j < 4; ++j) v[j] = __builtin_nontemporal_load((const f32x4*)(K.in(0) + (size_t)m * D) + lane + 64 * j); }
#pragma unroll 1
        for (; m < T; m += NGW) {
            if (m + NGW < T) {
#pragma unroll
                for (int j = 0; j < 4; ++j) vn[j] = __builtin_nontemporal_load((const f32x4*)(K.in(0) + (size_t)(m + NGW) * D) + lane + 64 * j); }
            float s_ = 0.f;
#pragma unroll
            for (int j = 0; j < 4; ++j) s_ += (v[j].x * v[j].x + v[j].y * v[j].y) + (v[j].z * v[j].z + v[j].w * v[j].w);
            const float rs = rsqrtf(wave_sum(s_) * (1.f / D) + EPS);
            v2u* r8 = (v2u*)(K.XR() + (size_t)m * D) + lane;
            if (lane == 0) K.rinv1()[m] = rs;
#pragma unroll
            for (int j = 0; j < 4; ++j) { r8[64 * j] = (v2u){pk2(v[j].x, v[j].y), pk2(v[j].z, v[j].w)}; v[j] = vn[j]; }
        }
    }
    }
}

typedef short bf16x8 __attribute__((ext_vector_type(8)));
__device__ __forceinline__ float fexp(float x) { return __builtin_amdgcn_exp2f(x * 1.4426950408889634f); }
__device__ __forceinline__ float logsig_fast(float x) { return fminf(x, 0.f) - __log2f(1.0f + fexp(-fabsf(x))) * 0.6931471805599453f; }
__device__ __forceinline__ float silu_fast(float x) { return x * __builtin_amdgcn_rcpf(1.0f + __builtin_amdgcn_exp2f(-1.4426950408889634f * x)); }
__device__ __forceinline__ float gelu_fast(float x) { const float u = 0.7978845608028654f * (x + 0.044715f * x * x * x); return x * __builtin_amdgcn_rcpf(1.0f + __builtin_amdgcn_exp2f(-2.8853900817779268f * u)); }
__device__ __forceinline__ f32x4 mfma16(bf16x8 a, bf16x8 b, f32x4 c) { return __builtin_amdgcn_mfma_f32_16x16x32_bf16(a, b, c, 0, 0, 0); }
constexpr int LROWB = 144;
constexpr int L_QD = 0, L_KI = 9216, L_KDT = 18432, L_VT = 27648, L_S = 46080, L_ST = 55296, L_OB = 73728, L_TOT = 107520, OBROW = 528;
#define FRAG(base, row, kel) (*(const LAS bf16x8*)(lds + (base) + (row) * LROWB + (kel) * 2))

constexpr int L_BL = 117760, SCN = 4, NSC = GN / SCN, NITEM = NB * GH * NSC;
#define FRAG(base, row, kel) (*(const LAS bf16x8*)(lds + (base) + (row) * LROWB + (kel) * 2))
struct GlaPre { unsigned short k[8], q[8], v[16], a[8]; v4u g0, g1; };
typedef __amdgpu_buffer_rsrc_t prs_t;
__device__ __forceinline__ prs_t gla_rsrc(const bf16* P) { return __builtin_amdgcn_make_buffer_rsrc((void*)P, 0, T * PLD * 2, 0x00020000); }
template <bool WITH_Q>
__device__ __forceinline__ void gla_prefetch(GlaPre& p, const prs_t rs, int h, int t0, int tid, int lane, int wave) {
    const int rowb = ((t0 + 8 * wave) * PLD + h * 64) * 2;
    const int lo = lane * 2;
#pragma unroll
    for (int j = 0; j < 8; ++j) p.k[j] = (unsigned short)__builtin_amdgcn_raw_buffer_load_b16(rs, lo, rowb + (j * PLD + C_K) * 2, 0);
#pragma unroll
    for (int j = 0; j < 8; ++j) p.a[j] = (unsigned short)__builtin_amdgcn_raw_buffer_load_b16(rs, lo, rowb + (j * PLD + C_PRE) * 2, 0);
    const int vb = ((t0 + 16 * (wave >> 1)) * PLD + C_V + h * 128 + (wave & 1) * 64) * 2;
#pragma unroll
    for (int j = 0; j < 16; ++j) p.v[j] = (unsigned short)__builtin_amdgcn_raw_buffer_load_b16(rs, lo, vb + j * PLD * 2, 0);
    if (WITH_Q) {
#pragma unroll
        for (int j = 0; j < 8; ++j) p.q[j] = (unsigned short)__builtin_amdgcn_raw_buffer_load_b16(rs, lo, rowb + (j * PLD + C_Q) * 2, 0);
        const int gb = ((t0 + 8 * wave) * PLD + C_G + h * 128) * 2;
        const int go = ((lane >> 3) * PLD + 16 * (lane & 7)) * 2;
        p.g0 = __builtin_amdgcn_raw_buffer_load_b128(rs, go, gb, 0); p.g1 = __builtin_amdgcn_raw_buffer_load_b128(rs, go + 16, gb, 0);
    }
}
__device__ __forceinline__ void gla_b8_part(LAS unsigned char* lds, const GlaPre& p, float bias, int lane, int wave, float (&bv)[8]) {
    float run = 0.f;
#pragma unroll
    for (int j = 0; j < 8; ++j) { run += logsig_fast(bf2f(p.a[j]) + bias) * (1.0f / 16.0f); bv[j] = run; }
    ((LAS float*)(lds + L_TOT))[wave * 64 + lane] = run;
}
__device__ __forceinline__ float gla_b8_finish(LAS unsigned char* lds, int lane, int wave, float (&bv)[8]) {
    const LAS float* tot = (const LAS float*)(lds + L_TOT);
    float base = 0.f, all = 0.f;
#pragma unroll
    for (int g = 0; g < 8; ++g) { const float tv = tot[g * 64 + lane]; all += tv; if (g < wave) base += tv; }
#pragma unroll
    for (int j = 0; j < 8; ++j) bv[j] += base;
    return all;
}
constexpr int L_EBL = L_BL + 256;
__device__ __forceinline__ void gla_write_kdT_vT(LAS unsigned char* lds, const GlaPre& p, const float (&kf)[8], float bl, float ebl, int tid, int lane, int wave) {
    float kd[8];
#pragma unroll
    for (int j = 0; j < 8; ++j) kd[j] = bf2f(p.k[j]) * kf[j];
    *(LAS v4u*)(lds + L_KDT + lane * LROWB + wave * 16) = (v4u){pk2(kd[0], kd[1]), pk2(kd[2], kd[3]), pk2(kd[4], kd[5]), pk2(kd[6], kd[7])};
    const int vv = tid & 127, cq = tid >> 7;
    LAS v4u* dst = (LAS v4u*)(lds + L_VT + vv * LROWB + cq * 32);
    dst[0] = (v4u){(unsigned)p.v[0] | ((unsigned)p.v[1] << 16), (unsigned)p.v[2] | ((unsigned)p.v[3] << 16), (unsigned)p.v[4] | ((unsigned)p.v[5] << 16), (unsigned)p.v[6] | ((unsigned)p.v[7] << 16)};
    dst[1] = (v4u){(unsigned)p.v[8] | ((unsigned)p.v[9] << 16), (unsigned)p.v[10] | ((unsigned)p.v[11] << 16), (unsigned)p.v[12] | ((unsigned)p.v[13] << 16), (unsigned)p.v[14] | ((unsigned)p.v[15] << 16)};
    if (wave == 0) { ((LAS float*)(lds + L_BL))[lane] = bl; ((LAS float*)(lds + L_EBL))[lane] = ebl; }
}
__device__ __forceinline__ void gla_kv_mfma(LAS unsigned char* lds, int wave, int fr, int fq, f32x4 (&acc)[4]) {
    bf16x8 Bf[2];
#pragma unroll
    for (int ks = 0; ks < 2; ++ks) Bf[ks] = FRAG(L_VT, 16 * wave + fr, 32 * ks + 8 * fq);
#pragma unroll
    for (int dt = 0; dt < 4; ++dt) { acc[dt] = (f32x4){0.f, 0.f, 0.f, 0.f};
#pragma unroll
        for (int ks = 0; ks < 2; ++ks) acc[dt] = mfma16(FRAG(L_KDT, 16 * dt + fr, 32 * ks + 8 * fq), Bf[ks], acc[dt]); }
}

__device__ __forceinline__ void phase_gla_A2(Frame& F, int l) {
    const KA K = KA::fresh(); PHASE_TID;
    LAS unsigned char* lds = F.lds;
    const int fr = lane & 15, fq = lane >> 4;
#pragma unroll 1
    for (int it = F.bx; it < NITEM; it += F.G) {
        const int b = it / (GH * NSC), h = (it / NSC) % GH, sc = it % NSC, tok0 = b * S + sc * SCN * GC;
        const prs_t P = gla_rsrc(K.P());
        const float gbias = K.in(4)[l * 256 + h * 64 + lane];
        GlaPre pre[2]; gla_prefetch<false>(pre[0], P, h, tok0, tid, lane, wave); gla_prefetch<false>(pre[1], P, h, tok0 + GC, tid, lane, wave);
        __syncthreads();
        f32x4 Sl[4], bs[4];
#pragma unroll
        for (int dt = 0; dt < 4; ++dt) { Sl[dt] = (f32x4){0.f, 0.f, 0.f, 0.f}; bs[dt] = (f32x4){1.f, 1.f, 1.f, 1.f}; }
#pragma unroll
        for (int n = 0; n < SCN; ++n) {
            float bv[8]; gla_b8_part(lds, pre[n & 1], gbias, lane, wave, bv);
            __syncthreads();
            const float bl = gla_b8_finish(lds, lane, wave, bv);
            { float kf[8];
#pragma unroll
              for (int j = 0; j < 8; ++j) kf[j] = fexp(bl - bv[j]);
              gla_write_kdT_vT(lds, pre[n & 1], kf, bl, fexp(bl), tid, lane, wave); }
            if (n + 2 < SCN) gla_prefetch<false>(pre[n & 1], P, h, tok0 + (n + 2) * GC, tid, lane, wave);
            __syncthreads();
            f32x4 acc[4]; gla_kv_mfma(lds, wave, fr, fq, acc);
#pragma unroll
            for (int dt = 0; dt < 4; ++dt) { const f32x4 eb4 = *(const LAS f32x4*)(lds + L_EBL + (16 * dt + 4 * fq) * 4);
                bs[dt] = bs[dt] * eb4;
#pragma unroll
                for (int r = 0; r < 4; ++r) Sl[dt][r] = eb4[r] * Sl[dt][r] + acc[dt][r]; }
        }
        f32x4* ag = (f32x4*)K.Sst() + ((size_t)(it * 8 + wave) * 4) * 64 + lane;
#pragma unroll
        for (int dt = 0; dt < 4; ++dt) ag[dt * 64] = Sl[dt];
        if (wave == 0 && fr == 0) { f32x4* dp = (f32x4*)K.dec() + (size_t)it * 16 + fq;
#pragma unroll
            for (int dt = 0; dt < 4; ++dt) dp[dt * 4] = bs[dt]; }
    }
}


__device__ __forceinline__ void phase_gla_aggscan(Frame& F) {
    const KA K = KA::fresh(); PHASE_TID;
#pragma unroll 1
    for (int e2 = F.bx * NT + tid; e2 < NB * GH * 8192 * 2; e2 += F.G * NT) {
        const int e = e2 >> 1, half = e2 & 1;
        const int bh = e >> 13, el = e & 8191, ln = (el >> 2) & 63, dt = (el >> 8) & 3, r = el & 3;
        float* ap = K.Sst() + (size_t)bh * NSC * 8192 + (size_t)(16 * half) * 8192 + el; const float* dp = K.dec() + (size_t)bh * NSC * 64 + (16 * half) * 64 + dt * 16 + (ln >> 4) * 4 + r;
        float a[16], d[16];
#pragma unroll
        for (int j = 0; j < 16; ++j) { a[j] = ap[(size_t)j * 8192]; d[j] = dp[j * 64]; }
        float C = 0.f, Pp = 1.f;
#pragma unroll
        for (int j = 0; j < 16; ++j) { const float aj = a[j], dj = d[j]; a[j] = C; d[j] = Pp; C = dj * C + aj; Pp = dj * Pp; }
        const float oc = dppf_x1(C);
        const float st_in = half ? oc : 0.f;
#pragma unroll
        for (int j = 0; j < 16; ++j) ap[(size_t)j * 8192] = d[j] * st_in + a[j];
    }
}
template <class Bar>
__device__ __forceinline__ void phase_gla_C2(Frame& F, int l, const Bar& bar) {
    const KA K = KA::fresh(); PHASE_TID;
    LAS unsigned char* lds = F.lds;
    const int fr = lane & 15, fq = lane >> 4;
    const float* gnorm = K.in(5) + (size_t)l * 128;
#pragma unroll 1
    for (int it = F.bx; it < NITEM; it += F.G) {
        const int b = it / (GH * NSC), h = (it / NSC) % GH, sc = it % NSC, tok0 = b * S + sc * SCN * GC;
        const prs_t P = gla_rsrc(K.P());
        const float gbias = K.in(4)[l * 256 + h * 64 + lane];
        GlaPre pre[2]; gla_prefetch<true>(pre[0], P, h, tok0, tid, lane, wave); gla_prefetch<true>(pre[1], P, h, tok0 + GC, tid, lane, wave);
        __syncthreads();
        if (it == F.bx) xcd_barrier_wait(bar);
        f32x4 Sm[4];
        { const f32x4* ag = (const f32x4*)K.Sst() + ((size_t)(it * 8 + wave) * 4) * 64 + lane;
#pragma unroll
          for (int dt = 0; dt < 4; ++dt) Sm[dt] = ag[dt * 64]; }
        __syncthreads();
#pragma unroll
        for (int n = 0; n < SCN; ++n) {
            const int t0 = tok0 + n * GC;
            GlaPre& pr = pre[n & 1];
            float bv[8]; gla_b8_part(lds, pr, gbias, lane, wave, bv);
            __syncthreads();
            const float bl = gla_b8_finish(lds, lane, wave, bv);
            const float ebl = fexp(bl);
            float ie[8];
#pragma unroll
            for (int j = 0; j < 8; ++j) {
                const float e = fexp(bv[j]); ie[j] = __builtin_amdgcn_rcpf(e);
                *(LAS bf16*)(lds + L_QD + (8 * wave + j) * LROWB + lane * 2) = (bf16)f2bf(bf2f(pr.q[j]) * 0.125f * e);
                *(LAS bf16*)(lds + L_KI + (8 * wave + j) * LROWB + lane * 2) = (bf16)f2bf(bf2f(pr.k[j]) * ie[j]);
            }
            { float kf[8];
#pragma unroll
              for (int j = 0; j < 8; ++j) kf[j] = ebl * ie[j];
              gla_write_kdT_vT(lds, pr, kf, bl, ebl, tid, lane, wave); }
#pragma unroll
            for (int dt = 0; dt < 4; ++dt) *(LAS v2u*)(lds + L_ST + (16 * wave + fr) * LROWB + (16 * dt + 4 * fq) * 2) = (v2u){pk2(Sm[dt][0], Sm[dt][1]), pk2(Sm[dt][2], Sm[dt][3])};
            const v4u gq0 = pr.g0, gq1 = pr.g1;
            __syncthreads();
#pragma unroll
            for (int i = 0; i < 2; ++i) {
                const int tix = 2 * wave + i, st = tix >> 2, ct = tix & 3;
                f32x4 a = (f32x4){0.f, 0.f, 0.f, 0.f};
#pragma unroll
                for (int ks = 0; ks < 2; ++ks) a = mfma16(FRAG(L_KI, 16 * st + fr, 32 * ks + 8 * fq), FRAG(L_QD, 16 * ct + fr, 32 * ks + 8 * fq), a);
                const int s0 = 16 * st + 4 * fq, c = 16 * ct + fr;
                float m[4];
#pragma unroll
                for (int r = 0; r < 4; ++r) m[r] = (s0 + r <= c) ? a[r] : 0.f;
                *(LAS v2u*)(lds + L_S + c * LROWB + s0 * 2) = (v2u){pk2(m[0], m[1]), pk2(m[2], m[3])};
            }
            f32x4 kv[4]; gla_kv_mfma(lds, wave, fr, fq, kv);
            __syncthreads();
            if (n + 2 < SCN) gla_prefetch<true>(pr, P, h, t0 + 2 * GC, tid, lane, wave);
            {
                bf16x8 Av[2], As[2];
#pragma unroll
                for (int ks = 0; ks < 2; ++ks) { Av[ks] = FRAG(L_VT, 16 * wave + fr, 32 * ks + 8 * fq); As[ks] = FRAG(L_ST, 16 * wave + fr, 32 * ks + 8 * fq); }
#pragma unroll
                for (int ct = 0; ct < 4; ++ct) {
                    f32x4 a = (f32x4){0.f, 0.f, 0.f, 0.f};
#pragma unroll
                    for (int ks = 0; ks < 2; ++ks) { a = mfma16(Av[ks], FRAG(L_S, 16 * ct + fr, 32 * ks + 8 * fq), a); a = mfma16(As[ks], FRAG(L_QD, 16 * ct + fr, 32 * ks + 8 * fq), a); }
                    *(LAS f32x4*)(lds + L_OB + (16 * ct + fr) * OBROW + (16 * wave + 4 * fq) * 4) = a;
                }
            }
#pragma unroll
            for (int dt = 0; dt < 4; ++dt) { const f32x4 eb4 = *(const LAS f32x4*)(lds + L_EBL + (16 * dt + 4 * fq) * 4);
#pragma unroll
                for (int r = 0; r < 4; ++r) Sm[dt][r] = eb4[r] * Sm[dt][r] + kv[dt][r]; }
            __syncthreads();
            {
                const int c = tid >> 3, vg = tid & 7;
                const LAS f32x4* ob = (const LAS f32x4*)(lds + L_OB + c * OBROW + vg * 64);
                float ss = 0.f;
#pragma unroll
                for (int j = 0; j < 4; ++j) { const f32x4 t_ = ob[j]; ss += (t_.x * t_.x + t_.y * t_.y) + (t_.z * t_.z + t_.w * t_.w); }
                ss = sum8(ss);
                const float rq = rsqrtf(ss * (1.0f / 128.0f) + EPS) * MIXS;
                const f32x4* gn = (const f32x4*)(gnorm + 16 * vg);
                const unsigned gw[8] = {gq0.x, gq0.y, gq0.z, gq0.w, gq1.x, gq1.y, gq1.z, gq1.w};
                v4u w;
#pragma unroll
                for (int j = 0; j < 4; ++j) {
                    const f32x4 oj = ob[j], nj = gn[j]; const unsigned ga = gw[2 * j], gb = gw[2 * j + 1];
                    w[j] = pg8::pk4_fp8(oj.x * rq * nj.x * silu_fast(bflo(ga)), oj.y * rq * nj.y * silu_fast(bfhi(ga)), oj.z * rq * nj.z * silu_fast(bflo(gb)), oj.w * rq * nj.w * silu_fast(bfhi(gb)));
                    __builtin_amdgcn_sched_barrier(0);
                }
                *(v4u*)((unsigned char*)K.XN() + (size_t)(t0 + c) * D + h * 128 + 16 * vg) = w;
            }
        }
    }
    if (F.bx >= NITEM) xcd_barrier_wait(bar);
}
#undef FRAG

constexpr int GM_ROWB = 272;
__device__ __forceinline__ void phase_gmlp_mfma(Frame& F, int l) {
    const KA K = KA::fresh(); PHASE_TID;
    LAS unsigned char* lds = F.lds;
    const int fr = lane & 15, fq = lane >> 4;
    const int nks = (16 * wave + 15) / 32 + 1;
#pragma unroll 1
    for (int u = F.bx; u < NB * MN * MH; u += F.G) {
        const int b = u / (MN * MH), n = (u / MH) % MN, h = u % MH, t0 = b * S + n * MC;
        const bf16* P = K.P();
        const float gn = K.in(6)[(size_t)l * 256 + h * 64 + lane];
        unsigned short vraw[16];
#pragma unroll
        for (int i = 0; i < 16; ++i) vraw[i] = P[(size_t)(t0 + 16 * wave + i) * PLD + C_VG + h * 64 + lane];
        const bf16* Wb = K.Wsp() + ((size_t)(l * MH + h) * 128 + 16 * wave + fr) * 128 + 8 * fq;
        bf16x8 Bf[4];
#pragma unroll
        for (int ks = 0; ks < 4; ++ks) Bf[ks] = (ks < nks) ? *(const bf16x8*)(Wb + 32 * ks) : (bf16x8){0, 0, 0, 0, 0, 0, 0, 0};
        const int t = 16 * wave + fr;
        const float bias = K.in(8)[(size_t)l * MH * 128 + h * 128 + t];
        const bf16* up = P + (size_t)(t0 + t) * PLD + C_U + h * 64 + 4 * fq;
        v2u uw[4];
#pragma unroll
        for (int dt = 0; dt < 4; ++dt) uw[dt] = *(const v2u*)(up + 16 * dt);
        __syncthreads();
        {   float g[16], a[8];
#pragma unroll
            for (int i = 0; i < 16; ++i) g[i] = gelu_fast(bf2f(vraw[i]));
            const bool b5 = lane & 32, b4 = lane & 16, b3 = lane & 8, b2 = lane & 4;
#pragma unroll
            for (int k = 0; k < 8; ++k) { const float lo = g[k] * g[k], hi = g[k + 8] * g[k + 8]; a[k] = (b5 ? hi : lo) + shx(b5 ? lo : hi, 32); }
#pragma unroll
            for (int k = 0; k < 4; ++k) a[k] = (b4 ? a[k + 4] : a[k]) + shx(b4 ? a[k] : a[k + 4], 16);
#pragma unroll
            for (int k = 0; k < 2; ++k) a[k] = (b3 ? a[k + 2] : a[k]) + shx(b3 ? a[k] : a[k + 2], 8);
            float ssum = (b2 ? a[1] : a[0]) + shx(b2 ? a[0] : a[1], 4);
            ssum += dppf_x2(ssum); ssum += dppf_x1(ssum);
            const int rsi = __float_as_int(rsqrtf(ssum * (1.0f / 64.0f) + EPS));
#pragma unroll
            for (int q = 0; q < 2; ++q) {
                float vs[8];
#pragma unroll
                for (int i = 0; i < 8; ++i) vs[i] = g[8 * q + i] * __int_as_float(__builtin_amdgcn_readlane(rsi, 4 * (8 * q + i))) * gn;
                *(LAS v4u*)(lds + lane * GM_ROWB + (16 * wave + 8 * q) * 2) = (v4u){pk2(vs[0], vs[1]), pk2(vs[2], vs[3]), pk2(vs[4], vs[5]), pk2(vs[6], vs[7])};
            }
        }
        __syncthreads();
        f32x4 acc[4];
#pragma unroll
        for (int dt = 0; dt < 4; ++dt) acc[dt] = (f32x4){0.f, 0.f, 0.f, 0.f};
#pragma unroll
        for (int ks = 0; ks < 4; ++ks) if (ks < nks) {
#pragma unroll
            for (int dt = 0; dt < 4; ++dt) acc[dt] = mfma16(*(const LAS bf16x8*)(lds + (16 * dt + fr) * GM_ROWB + (32 * ks + 8 * fq) * 2), Bf[ks], acc[dt]);
        }
        unsigned char* op = (unsigned char*)K.XN() + (size_t)(t0 + t) * D + 512 + h * 64 + 4 * fq;
#pragma unroll
        for (int dt = 0; dt < 4; ++dt) {
            const float o0 = gelu_fast(bflo(uw[dt].x)) * (acc[dt][0] + bias), o1 = gelu_fast(bfhi(uw[dt].x)) * (acc[dt][1] + bias), o2 = gelu_fast(bflo(uw[dt].y)) * (acc[dt][2] + bias), o3 = gelu_fast(bfhi(uw[dt].y)) * (acc[dt][3] + bias);
            *(unsigned*)(op + 16 * dt) = pg8::pk4_fp8(MIXS * o0, MIXS * o1, MIXS * o2, MIXS * o3);
        }
    }
}
__device__ __forceinline__ void phase_conv(Frame& F, int l) {
    const KA K = KA::fresh(); PHASE_TID;
    const float* wc = K.in(9) + (size_t)l * 3 * 256;
#pragma unroll 1
    for (int e = F.bx * NT + tid; e < T * 32; e += F.G * NT) {
        const int t = e >> 5, c0 = (e & 31) * 8, tl = t % S;
        const bf16* row = K.P() + (size_t)t * PLD;
        float y[8], xi[8], cg[8], bg[8];
        unpack8(*(const v4u*)(row + C_XI + c0), xi); unpack8(*(const v4u*)(row + C_CG + c0), cg); unpack8(*(const v4u*)(row + C_BG + c0), bg);
#pragma unroll
        for (int j = 0; j < 8; ++j) y[j] = wc[2 * 256 + c0 + j] * cg[j] * xi[j];
        if (tl >= 1) { unpack8(*(const v4u*)(row - PLD + C_XI + c0), xi); unpack8(*(const v4u*)(row - PLD + C_CG + c0), cg);
#pragma unroll
            for (int j = 0; j < 8; ++j) y[j] += wc[1 * 256 + c0 + j] * cg[j] * xi[j]; }
        if (tl >= 2) { unpack8(*(const v4u*)(row - 2 * PLD + C_XI + c0), xi); unpack8(*(const v4u*)(row - 2 * PLD + C_CG + c0), cg);
#pragma unroll
            for (int j = 0; j < 8; ++j) y[j] += wc[0 * 256 + c0 + j] * cg[j] * xi[j]; }
#pragma unroll
        for (int j = 0; j < 8; ++j) y[j] *= bg[j];
        *(v2u*)((unsigned char*)K.XN() + (size_t)t * D + 768 + c0) = (v2u){pg8::pk4_fp8(CONVS * y[0], CONVS * y[1], CONVS * y[2], CONVS * y[3]), pg8::pk4_fp8(CONVS * y[4], CONVS * y[5], CONVS * y[6], CONVS * y[7])};
    }
}
constexpr int RT_PART = 0, RT_SS = RT_PART + 4 * 8 * 16 * 48 * 4, RT_RS = RT_SS + 4 * 8 * 16 * 4, RT_HIST = RT_RS + 64 * 4;
__device__ __forceinline__ void phase_norm_router_mfma(Frame& F, int l) {
    const KA K = KA::fresh(); PHASE_TID;
    LAS unsigned char* lds = F.lds;
    const int fr = lane & 15, fq = lane >> 4;
    const bf16* whi = K.Wr() + (size_t)l * 2 * 48 * D + (size_t)fr * D + 128 * wave + 8 * fq; const bf16* wlo = whi + 48 * D;
    bf16x8 Wh[4][3], Wl[4][3];
#pragma unroll
    for (int ks = 0; ks < 4; ++ks)
#pragma unroll
        for (int nt = 0; nt < 3; ++nt) { Wh[ks][nt] = *(const bf16x8*)(whi + (size_t)(16 * nt) * D + 32 * ks); Wl[ks][nt] = *(const bf16x8*)(wlo + (size_t)(16 * nt) * D + 32 * ks); }
    float gbias_ = 0.f, eb_[4];
    { const int j_ = tid & 7; if (j_ < 4) gbias_ = K.in(13)[(size_t)l * 4 + j_];
#pragma unroll
      for (int g = 0; g < 4; ++g) eb_[g] = K.in(15)[(size_t)l * 32 + g * 8 + j_]; }
#pragma unroll 1
    for (int blk = F.bx; blk < T / 64; blk += F.G) {
        const bf16* xr = K.XR() + (size_t)(blk * 64 + fr) * D + 128 * wave + 8 * fq;
        __syncthreads();
        if (tid < NE) ((LAS int*)(lds + RT_HIST))[tid] = 0;
        v4u xa[4][4];
#pragma unroll
        for (int t = 0; t < 4; ++t)
#pragma unroll
            for (int ks = 0; ks < 4; ++ks) xa[t][ks] = *(const v4u*)(xr + (size_t)(16 * t) * D + 32 * ks);
#pragma unroll
        for (int t = 0; t < 4; ++t) {
            f32x4 acc[3]; float ss = 0.f;
#pragma unroll
            for (int nt = 0; nt < 3; ++nt) acc[nt] = (f32x4){0.f, 0.f, 0.f, 0.f};
#pragma unroll
            for (int ks = 0; ks < 4; ++ks) {
                float xv[8]; unpack8(xa[t][ks], xv);
#pragma unroll
                for (int j = 0; j < 8; ++j) ss += xv[j] * xv[j];
                const bf16x8 Ah = __builtin_bit_cast(bf16x8, xa[t][ks]);
#pragma unroll
                for (int nt = 0; nt < 3; ++nt) { acc[nt] = mfma16(Ah, Wh[ks][nt], acc[nt]); acc[nt] = mfma16(Ah, Wl[ks][nt], acc[nt]); }
            }
            ss += shx(ss, 16); ss += shx(ss, 32);
            LAS float* part = (LAS float*)(lds + RT_PART) + (t * 8 + wave) * 16 * 48;
#pragma unroll
            for (int nt = 0; nt < 3; ++nt)
#pragma unroll
                for (int r = 0; r < 4; ++r) part[(4 * fq + r) * 48 + 16 * nt + fr] = acc[nt][r];
            if (fq == 0) ((LAS float*)(lds + RT_SS))[(t * 8 + wave) * 16 + fr] = ss;
        }
        __syncthreads();
        {
            const int tt = tid >> 3, j = tid & 7, t = blk * 64 + tt;
            const LAS float* p0 = (const LAS float*)(lds + RT_PART) + ((tt >> 4) * 8 * 16 + (tt & 15)) * 48;
            const LAS float* s2 = (const LAS float*)(lds + RT_SS) + (tt >> 4) * 8 * 16 + (tt & 15);
            float sq = 0.f;
#pragma unroll
            for (int w = 0; w < 8; ++w) sq += s2[w * 16];
            const float rs = rsqrtf(sq * (1.f / D) + EPS);
#define RT_DOT(n) (((p0[(n)] + p0[768 + (n)]) + (p0[1536 + (n)] + p0[2304 + (n)])) + ((p0[3072 + (n)] + p0[3840 + (n)]) + (p0[4608 + (n)] + p0[5376 + (n)])))
            float gv = (j < 4) ? RT_DOT(j & 3) * rs + gbias_ : -INFINITY; int gi = j;
            const float gmine = gv;
#define RT_ARGMAX_STEP(V, I, FV, FI) do { const float ov = FV(V); const int oi = FI(I); if (ov > V || (ov == V && oi < I)) { V = ov; I = oi; } } while (0)
            RT_ARGMAX_STEP(gv, gi, dppf_x1, dpp_x1); RT_ARGMAX_STEP(gv, gi, dppf_x2, dpp_x2); RT_ARGMAX_STEP(gv, gi, dppf_hm, dpp_hm);
            float ge = (j < 4) ? expf(gmine - gv) : 0.f;
            ge = sum8(ge);
            const float gw = 1.0f / ge; const int gt = gi;
            const float ev = RT_DOT(4 + gt * 8 + j) * rs + (gt == 0 ? eb_[0] : gt == 1 ? eb_[1] : gt == 2 ? eb_[2] : eb_[3]);
#undef RT_DOT
            float m0 = ev; int i0 = j;
            RT_ARGMAX_STEP(m0, i0, dppf_x1, dpp_x1); RT_ARGMAX_STEP(m0, i0, dppf_x2, dpp_x2); RT_ARGMAX_STEP(m0, i0, dppf_hm, dpp_hm);
            float m1 = (j == i0) ? -INFINITY : ev; int i1 = j;
            RT_ARGMAX_STEP(m1, i1, dppf_x1, dpp_x1); RT_ARGMAX_STEP(m1, i1, dppf_x2, dpp_x2); RT_ARGMAX_STEP(m1, i1, dppf_hm, dpp_hm);
#undef RT_ARGMAX_STEP
            if (j == 0) {
                K.rinv2()[t] = rs;
                const float e1 = expf(m1 - m0);
                const float w0 = gw / (1.0f + e1), w1 = gw * e1 / (1.0f + e1);
                const int e0i = gt * 8 + i0, e1i = gt * 8 + i1;
                K.eid()[2 * t] = e0i; K.eid()[2 * t + 1] = e1i; K.ew()[2 * t] = w0; K.ew()[2 * t + 1] = w1;
                LAS int* hist = (LAS int*)(lds + RT_HIST);
                K.slot_of()[2 * t] = __hip_atomic_fetch_add(hist + e0i, 1, __ATOMIC_RELAXED, __HIP_MEMORY_SCOPE_WORKGROUP);
                K.slot_of()[2 * t + 1] = __hip_atomic_fetch_add(hist + e1i, 1, __ATOMIC_RELAXED, __HIP_MEMORY_SCOPE_WORKGROUP);
            }
        }
        __syncthreads();
        if (tid < NE) K.blkcnt()[(size_t)(l * (T / 64) + blk) * NE + tid] = ((LAS int*)(lds + RT_HIST))[tid];
    }
}
__device__ __forceinline__ int lane_up(int v, int d, int lane) { return __builtin_amdgcn_ds_bpermute(4 * (lane - d), v); }
__device__ __forceinline__ int scan32_incl(int v, int lane) {
#pragma unroll
    for (int d = 1; d < 32; d <<= 1) { const int t = lane_up(v, d, lane); if (lane >= d) v += t; }
    return v; }
constexpr int TAB_OFF = LDSCTL_OFF + 1024;
__device__ __forceinline__ void moe_tables_lds(Frame& F, const LAS int* tot, int tid) {
    LAS int* tab = (LAS int*)(F.lds + TAB_OFF); LAS int* offs = tab + 4 + 4 * 164; LAS int* fpre = offs + 40; LAS int* ppre = fpre + 40;
    if (tid < 64) {
        const int c = tid < NE ? tot[tid] : 0, fc = c >> 8, pc = (c & 255) ? 1 : 0;
        const int a = scan32_incl(c, tid), f = scan32_incl(fc, tid), p = scan32_incl(pc, tid);
        if (tid < NE) { offs[tid] = a - c; fpre[tid] = f - fc; ppre[tid] = p - pc; }
        if (tid == NE - 1) { offs[NE] = a; fpre[NE] = f; ppre[NE] = p; tab[0] = f + p; } }
    __syncthreads();
    const int nfull = fpre[NE];
    if (tid < nfull) { int e = 0; for (int j = 1; j < NE; ++j) if (fpre[j] <= tid) e = j; tab[4 + 4 * tid] = e; tab[5 + 4 * tid] = offs[e] + (tid - fpre[e]) * 256; tab[6 + 4 * tid] = offs[e + 1]; }
    else if (tid < nfull + NE) {
        const int e = tid - nfull, rows = (offs[e + 1] - offs[e]) & 255;
        if (rows) { int rank = 0; for (int j = 0; j < NE; ++j) { const int rj = (offs[j + 1] - offs[j]) & 255; rank += (rj > rows || (rj == rows && j < e)) ? 1 : 0; }
            const int q = nfull + rank; tab[4 + 4 * q] = e; tab[5 + 4 * q] = offs[e] + (fpre[e + 1] - fpre[e]) * 256; tab[6 + 4 * q] = offs[e + 1]; }
    }
    __syncthreads();
}
__device__ __forceinline__ void phase_scatter(Frame& F, int l) {
    const KA K = KA::fresh(); PHASE_TID;
    LAS int* sm = (LAS int*)F.lds;
    const int* bc = K.blkcnt() + (size_t)l * (T / 64) * NE;
    constexpr int NBLK = T / 64;
#pragma unroll 1
    for (int blk = F.bx, trip = 0; blk < NBLK || trip == 0; blk += F.G, ++trip) {
        __syncthreads();
        int as_e = 0, as_so = 0; float as_rs = 0.f;
        if (blk < NBLK && tid < 128) { const int a = blk * 128 + tid; as_e = K.eid()[a]; as_so = K.slot_of()[a]; as_rs = K.rinv2()[a >> 1]; }
        {   const int e = tid & 31, part = tid >> 5;
            int tot = 0, pre = 0;
            int cv[NBLK / 16];
#pragma unroll
            for (int j = 0; j < NBLK / 16; ++j) cv[j] = bc[(part * (NBLK / 16) + j) * NE + e];
#pragma unroll
            for (int j = 0; j < NBLK / 16; ++j) { const int bb = part * (NBLK / 16) + j; const int c = cv[j]; tot += c; if (bb < blk) pre += c; }
            sm[part * 32 + e] = tot; sm[512 + part * 32 + e] = pre; }
        __syncthreads();
        if (tid < 64) { int tot = 0, pre = 0;
            if (tid < 32) {
#pragma unroll
                for (int p = 0; p < 16; ++p) { tot += sm[p * 32 + tid]; pre += sm[512 + p * 32 + tid]; } }
            const int incl = scan32_incl(tot, tid);
            if (tid < 32) { sm[1056 + tid] = tot; sm[1024 + tid] = pre + incl - tot; } }
        __syncthreads();
        if (blk < NBLK && tid < 128) { const int a = blk * 128 + tid; const int pos = sm[1024 + as_e] + as_so; K.slot_tok()[pos] = a >> 1; K.slot_of()[a] = pos; K.srinv()[pos] = as_rs; }
    }
    __syncthreads();
    moe_tables_lds(F, sm + 1056, tid);
}
template <int SUB>
__device__ __forceinline__ void phase_moe(Frame& F, int l) {
    const KA K = KA::fresh();
    int c_ = F.bx; asm volatile("" : "+s"(c_));
    const int G = F.G, c = (c_ & 7) * (G >> 3) + (c_ >> 3);
    const LAS int* tab = (const LAS int*)(F.lds + TAB_OFF);
    const int ntile = __builtin_amdgcn_readfirstlane(tab[0]), ngu = 2 * ntile, nleft = ngu > G ? ngu - G : 0, jX = ngu > G ? (G >> 1) : ntile, W = G - nleft;
    const int yd = (jX * 4 < 2 * W) ? jX * 4 : 2 * W;
    bool do_gu = false, do_dn = false; pg8::MoeSched So{tab, 2, 0, 0, G, c, 0};
    if (SUB == 0) { do_gu = true; So.npn = 2; So.first = 0; So.end = ngu < G ? ngu : G; So.stride = G; So.c = c; }
    if (SUB == 1) { if (c < nleft) { do_gu = true; So.npn = 2; So.first = G; So.end = ngu; So.stride = G; So.c = c; }
                    else { do_dn = true; So.npn = 4; So.first = 0; So.end = yd; So.stride = W; So.c = c - nleft; } }
    if (SUB == 2) { do_dn = true; So.npn = 4; So.first = 2 * yd; So.end = 2 * ntile * 4; So.stride = G; So.c = c; So.split = 1; }
    if (do_gu) { pg8::EpiMoeH E{K.H1(), K.srinv(), (LAS float*)(F.lds + LDSCTL_OFF + 28672)};
        pg8::gemm_phase_moe<pg8::EpiMoeH, pg8::MoeSched, true, 512, D / 2, true>(F.lds, (const bf16*)K.XQ(), (const bf16*)((const unsigned char*)K.WguT() + (size_t)l * NE * 512 * D), K.slot_tok(), So, E, F.wave); }
    if (do_dn) { pg8::EpiMoeY E{K.Y()};
        pg8::gemm_phase_moe<pg8::EpiMoeY, pg8::MoeSched, false, D, DE / 2, true>(F.lds, K.H1(), (const bf16*)((const unsigned char*)K.WdT() + (size_t)l * NE * D * DE), nullptr, So, E, F.wave); }
}
__device__ __forceinline__ void phase_combine(Frame& F, int l) {
    const KA K = KA::fresh(); PHASE_TID;
    const bool last = (l == DEPTH - 1);
    f32x4 g4[4];
    if (last) {
#pragma unroll
        for (int j = 0; j < 4; ++j) g4[j] = ((const f32x4*)K.in(19))[lane + 64 * j]; }
    const int tstep = F.G * NWAVES;
    int t = F.bx * NWAVES + wave;
    v2u xw[4]; unsigned ya[4], yb[4]; float w0 = 0.f, w1 = 0.f;
#define CB_LOAD(tt) do { const int s0_ = K.slot_of()[2 * (tt)], s1_ = K.slot_of()[2 * (tt) + 1]; w0n = K.ew()[2 * (tt)] * 0.125f; w1n = K.ew()[2 * (tt) + 1] * 0.125f; \
        const v2u* xr_ = (const v2u*)(K.XR() + (size_t)(tt) * D) + lane; const unsigned* y0_ = (const unsigned*)((const unsigned char*)K.Y() + (size_t)s0_ * D) + lane; const unsigned* y1_ = (const unsigned*)((const unsigned char*)K.Y() + (size_t)s1_ * D) + lane; \
        _Pragma("unroll") for (int j = 0; j < 4; ++j) { xn[j] = xr_[64 * j]; an[j] = y0_[64 * j]; bn[j] = y1_[64 * j]; } } while (0)
    { v2u xn[4]; unsigned an[4], bn[4]; float w0n = 0.f, w1n = 0.f;
      if (t < T) { CB_LOAD(t);
#pragma unroll
        for (int j = 0; j < 4; ++j) { xw[j] = xn[j]; ya[j] = an[j]; yb[j] = bn[j]; } w0 = w0n; w1 = w1n; } }
#pragma unroll 1
    for (; t < T; t += tstep) {
        v2u xn[4]; unsigned an[4], bn[4]; float w0n = 0.f, w1n = 0.f;
        if (t + tstep < T) CB_LOAD(t + tstep);
        f32x4 v[4]; float s = 0.f;
#pragma unroll
        for (int j = 0; j < 4; ++j) { const v2u x_ = xw[j]; typedef float f32x2q __attribute__((ext_vector_type(2)));
            const f32x2q a0 = __builtin_amdgcn_cvt_pk_f32_fp8(ya[j], false), a1 = __builtin_amdgcn_cvt_pk_f32_fp8(ya[j], true), b0 = __builtin_amdgcn_cvt_pk_f32_fp8(yb[j], false), b1 = __builtin_amdgcn_cvt_pk_f32_fp8(yb[j], true);
            v[j].x = bflo(x_.x) + w0 * a0.x + w1 * b0.x; v[j].y = bfhi(x_.x) + w0 * a0.y + w1 * b0.y; v[j].z = bflo(x_.y) + w0 * a1.x + w1 * b1.x; v[j].w = bfhi(x_.y) + w0 * a1.y + w1 * b1.y;
            s += (v[j].x * v[j].x + v[j].y * v[j].y) + (v[j].z * v[j].z + v[j].w * v[j].w); }
        const float rs = rsqrtf(wave_sum(s) * (1.f / D) + EPS);
        if (last) {
            f32x4* orow = (f32x4*)(K.out() + (size_t)t * D) + lane;
#pragma unroll
            for (int j = 0; j < 4; ++j) __builtin_nontemporal_store((f32x4){v[j].x * rs * g4[j].x, v[j].y * rs * g4[j].y, v[j].z * rs * g4[j].z, v[j].w * rs * g4[j].w}, orow + 64 * j);
        } else {
            v2u* xr = (v2u*)(K.XR() + (size_t)t * D) + lane;
            if (lane == 0) K.rinv1()[t] = rs;
#pragma unroll
            for (int j = 0; j < 4; ++j) xr[64 * j] = (v2u){pk2(v[j].x, v[j].y), pk2(v[j].z, v[j].w)};
        }
#pragma unroll
        for (int j = 0; j < 4; ++j) { xw[j] = xn[j]; ya[j] = an[j]; yb[j] = bn[j]; }
        w0 = w0n; w1 = w1n;
    }
#undef CB_LOAD
}

struct Args { const float* in[20]; float* out; unsigned char* ws; };
__global__ void __launch_bounds__(NT, 2) fwd_kernel(Args args) {
    extern __shared__ __attribute__((aligned(16))) unsigned char lds_raw[];
    Frame F;
    F.lds = (LAS unsigned char*)lds_raw; F.smem = (float*)lds_raw;
    F.G = gridDim.x; F.bx = blockIdx.x; F.wave = __builtin_amdgcn_readfirstlane(threadIdx.x >> 6);
    volatile LAS unsigned* MISC = (volatile LAS unsigned*)(F.lds + MISC_OFF);
    for (int u = threadIdx.x; u < (LDS_BYTES - LDSCTL_OFF) / 4; u += NT) ((LAS unsigned*)(F.lds + LDSCTL_OFF))[u] = 0u;
    __syncthreads();
    XcdBarrier bar; { const KA K = KA::fresh(); bar = xcd_barrier_post(K.ctl() + CW_BAR, MISC + 8); }
#define GRID_BAR() xcd_barrier(bar)
    constexpr int TR_NSH = 14, TR_XTRA = 632, TR_SLICE = (I_L - 2 * TR_XTRA + TR_NSH - 1) / TR_NSH;
#define GRID_BAR_SH(k) do { const int sh_ = 9 * l + (k); if (sh_ < TR_NSH) { xcd_barrier_arrive(bar); { const int lo_ = I_L + sh_ * TR_SLICE + (sh_ > 0 ? TR_XTRA : 0) + (sh_ > 9 ? TR_XTRA : 0), hi_ = lo_ + TR_SLICE + ((sh_ == 0 || sh_ == 9) ? TR_XTRA : 0); tr_items_1(F, lo_, hi_ < 2 * I_L ? hi_ : 2 * I_L); } xcd_barrier_wait(bar); } else xcd_barrier(bar); } while (0)

    p0_prologue(F);
    xcd_barrier_arrive(bar);
    tr_items(F, I_IN, I_L);
    xcd_barrier_wait(bar);
    for (int l = 0; l < DEPTH; ++l) {
        {
            const KA K = KA::fresh(); PHASE_TID;
            pg8::Gemm g{K.XR(), K.WinT() + (size_t)l * PLD * D, T, PLD, D}; pg8::StaticOrder So; int c_ = F.bx; asm volatile("" : "+s"(c_)); So.init(T, PLD, F.G, c_);
            pg8::EpiBf16Scale E{K.P(), PLD, K.rinv1(), (LAS float*)(F.lds + LDSCTL_OFF + 28672)};
            pg8::gemm_phase<pg8::EpiBf16Scale, pg8::StaticOrder, PG8_ALIGN, PG8_SP2>(F.lds, g, So, E, F.wave);
        }
        GRID_BAR_SH(0);
        phase_gla_A2(F, l);
        xcd_barrier_arrive(bar);
        phase_gmlp_mfma(F, l);
        xcd_barrier_wait(bar);
        phase_gla_aggscan(F); xcd_barrier_arrive(bar);
        phase_conv(F, l);
        phase_gla_C2(F, l, bar);
        GRID_BAR_SH(1);
        {
            const KA K = KA::fresh(); PHASE_TID;
            LAS int* tab = (LAS int*)(F.lds + TAB_OFF);
            __syncthreads();
            if (tid < T / 256) { tab[4 + 4 * tid] = 0; tab[5 + 4 * tid] = 256 * tid; tab[6 + 4 * tid] = T; }
            if (tid == 0) tab[0] = T / 256;
            __syncthreads();
            int c_ = F.bx; asm volatile("" : "+s"(c_));
            const int c = (c_ & 7) * (F.G >> 3) + (c_ >> 3);
            pg8::MoeSched So{tab, 4, 0, (T / 256) * 4, F.G, c, 0};
            pg8::EpiMoeRes E{K.XR(), K.XQ(), 1.0f / (64.0f * MIXS)};
            pg8::gemm_phase_moe<pg8::EpiMoeRes, pg8::MoeSched, false, D, D / 2, true>(F.lds, K.XN(), (const bf16*)((const unsigned char*)K.WoutT() + (size_t)l * D * D), nullptr, So, E, F.wave);
        }
        GRID_BAR_SH(2);
        phase_norm_router_mfma(F, l);
        GRID_BAR_SH(3);
        phase_scatter(F, l);
        GRID_BAR_SH(4);
        phase_moe<0>(F, l);
        GRID_BAR_SH(5);
        phase_moe<1>(F, l);
        GRID_BAR_SH(6);
        phase_moe<2>(F, l);
        GRID_BAR_SH(7);
        phase_combine(F, l);
        if (l + 1 < DEPTH) GRID_BAR_SH(8);
    }
}

extern "C" void kernel_launch(void* const* d_in, const int* in_sizes, int n_in, void* d_out, int out_size, void* d_ws, size_t ws_size, hipStream_t stream) {
    static int grid_blocks = 0;
    if (!grid_blocks) {
        int dev = 0, cus = 0, per_cu = 0;
        (void)hipGetDevice(&dev);
        (void)hipDeviceGetAttribute(&cus, hipDeviceAttributeMultiprocessorCount, dev);
        (void)hipFuncSetAttribute((const void*)fwd_kernel, hipFuncAttributeMaxDynamicSharedMemorySize, LDS_BYTES);
        (void)hipOccupancyMaxActiveBlocksPerMultiprocessor(&per_cu, fwd_kernel, NT, LDS_BYTES);
        if (per_cu < 1) { fprintf(stderr, "kernel_launch: occupancy query says %d blocks/CU\n", per_cu); per_cu = 1; }
        grid_blocks = cus;
        if (ws_size < WS_END) { fprintf(stderr, "kernel_launch: workspace too small (%zu < %zu)\n", ws_size, (size_t)WS_END); grid_blocks = -1; }
    }
    if (grid_blocks < 0) return;
    (void)hipMemsetAsync((char*)d_ws + WS_CTL, 0, 131072, stream);
    Args a{};
    for (int i = 0; i < 20; ++i) a.in[i] = (const float*)d_in[i];
    a.out = (float*)d_out; a.ws = (unsigned char*)d_ws;
    void* args[] = {&a};
    hipError_t e = hipLaunchCooperativeKernel((void*)fwd_kernel, dim3(grid_blocks), dim3(NT), args, LDS_BYTES, stream);
    if (e != hipSuccess) fprintf(stderr, "cooperative launch failed: %s (grid %d)\n", hipGetErrorString(e), grid_blocks);
}
```
